# Optimizing an MI355X kernel written in HIP

```python
import math
import jax, jax.numpy as jnp
from jax import lax
import numpy as np

D_MODEL = 1024
BATCH = 8
SEQ = 4096
DEPTH = 1

RNN_WIDTH = D_MODEL
RNN_BLOCKS = 8
RNN_BLOCK = RNN_WIDTH // RNN_BLOCKS
CONV_WIDTH = 4
LRU_C = 8.0
LRU_A_MIN, LRU_A_MAX = 0.9, 0.999
S5_WIDTH = D_MODEL // 2
S5_GROUP = 16
S5_GROUPS = S5_WIDTH // S5_GROUP
S5_STATE = 64
DT_MIN, DT_MAX = 1e-3, 1e-1
N_BRANCHES = 2
IN_COLS = 2 * RNN_WIDTH + S5_WIDTH + N_BRANCHES * D_MODEL
N_EXPERTS = 32
TOP_K = 4
D_FF = D_MODEL
SWIGLU_LIMIT = 7.0
SWIGLU_ALPHA = 1.702
ROUTE_BLOCK = 128
LN_EPS = 1e-5
DEEPNORM_ALPHA = (2.0 * DEPTH) ** 0.25
DEEPNORM_BETA = (8.0 * DEPTH) ** -0.25
N_MOD = 6

kernel_name = "hybrid_rglru_s5_moe_deepnorm_adaln"


def layer_norm(x, gain, bias):
    xf = x.astype(jnp.float32)
    mu = jnp.mean(xf, axis=-1, keepdims=True)
    var = jnp.mean(jnp.square(xf - mu), axis=-1, keepdims=True)
    y = (xf - mu) * lax.rsqrt(var + LN_EPS)
    return (y * gain.astype(jnp.float32) + bias.astype(jnp.float32)).astype(x.dtype)


def causal_depthwise_conv(x, w, b):
    C = x.shape[-1]
    y = lax.conv_general_dilated(
        x, w[:, None, :].astype(x.dtype), window_strides=(1,),
        padding=[(CONV_WIDTH - 1, 0)],
        dimension_numbers=("NWC", "WIO", "NWC"), feature_group_count=C)
    return y + b


def rg_lru(x, w_a, b_a, w_x, b_x, lam):
    Bn, S, C = x.shape
    xf = x.astype(jnp.float32)
    xb = xf.reshape(Bn, S, RNN_BLOCKS, RNN_BLOCK)
    r = jax.nn.sigmoid(jnp.einsum("bshi,hij->bshj", xb, w_a.astype(jnp.float32)).reshape(Bn, S, C) + b_a.astype(jnp.float32))
    i = jax.nn.sigmoid(jnp.einsum("bshi,hij->bshj", xb, w_x.astype(jnp.float32)).reshape(Bn, S, C) + b_x.astype(jnp.float32))
    log_a = -LRU_C * r * jax.nn.softplus(-lam.astype(jnp.float32))
    a = jnp.exp(log_a)
    u = jnp.sqrt(-jnp.expm1(2.0 * log_a)) * (i * xf)

    def step(h, au):
        a_t, u_t = au
        h = a_t * h + u_t
        return h, h

    h0 = jnp.zeros((Bn, C), jnp.float32)
    _, hs = lax.scan(step, h0, (jnp.swapaxes(a, 0, 1), jnp.swapaxes(u, 0, 1)))
    return jnp.swapaxes(hs, 0, 1).astype(x.dtype)


def s5_ssm(u, lam_re, lam_im, log_dt, b_re, b_im, c_re, c_im, d_skip):
    Bn, S, _ = u.shape
    f32 = jnp.float32
    ug = u.reshape(Bn, S, S5_GROUPS, S5_GROUP).astype(f32)
    lr, li = lam_re.astype(f32), lam_im.astype(f32)
    dt = jnp.exp(log_dt.astype(f32))[:, None]
    mag = jnp.exp(lr * dt)
    ab_re, ab_im = mag * jnp.cos(li * dt), mag * jnp.sin(li * dt)
    den = lr * lr + li * li
    q_re = ((ab_re - 1.0) * lr + ab_im * li) / den
    q_im = (ab_im * lr - (ab_re - 1.0) * li) / den
    br, bi = b_re.astype(f32), b_im.astype(f32)
    bb_re = q_re[..., None] * br - q_im[..., None] * bi
    bb_im = q_re[..., None] * bi + q_im[..., None] * br
    bu_re = jnp.einsum("bsgc,gpc->bsgp", ug, bb_re)
    bu_im = jnp.einsum("bsgc,gpc->bsgp", ug, bb_im)
    a_re = jnp.broadcast_to(ab_re, bu_re.shape)
    a_im = jnp.broadcast_to(ab_im, bu_im.shape)

    def combine(left, right):
        a1r, a1i, b1r, b1i = left
        a2r, a2i, b2r, b2i = right
        return (a2r * a1r - a2i * a1i,
                a2r * a1i + a2i * a1r,
                a2r * b1r - a2i * b1i + b2r,
                a2r * b1i + a2i * b1r + b2i)

    _, _, st_re, st_im = lax.associative_scan(combine, (a_re, a_im, bu_re, bu_im), axis=1)
    y = (jnp.einsum("bsgp,gcp->bsgc", st_re, c_re.astype(f32))
         - jnp.einsum("bsgp,gcp->bsgc", st_im, c_im.astype(f32))
         + d_skip.astype(f32) * ug)
    return y.reshape(Bn, S, S5_WIDTH).astype(u.dtype)


def mixer_sublayer(h, w_in, b_in, conv_w, conv_b, w_rg_a, b_rg_a, w_rg_x, b_rg_x, lru_lambda,
                   w_rnn_out, s5_lambda_re, s5_lambda_im, s5_log_dt, s5_b_re, s5_b_im,
                   s5_c_re, s5_c_im, s5_d, w_glu, w_out):
    proj = h @ w_in + b_in
    x_rnn, y_rnn, u_s5, g_logits = jnp.split(
        proj, [RNN_WIDTH, 2 * RNN_WIDTH, 2 * RNN_WIDTH + S5_WIDTH], axis=-1)
    xr = causal_depthwise_conv(x_rnn, conv_w, conv_b)
    hr = rg_lru(xr, w_rg_a, b_rg_a, w_rg_x, b_rg_x, lru_lambda)
    branch_a = (jax.nn.gelu(y_rnn) * hr) @ w_rnn_out
    ys = jax.nn.gelu(s5_ssm(u_s5, s5_lambda_re, s5_lambda_im, s5_log_dt, s5_b_re, s5_b_im,
                            s5_c_re, s5_c_im, s5_d))
    glu = ys @ w_glu
    branch_b = glu[..., :D_MODEL] * jax.nn.sigmoid(glu[..., D_MODEL:])
    gates = jax.nn.sigmoid(g_logits).reshape(*g_logits.shape[:-1], N_BRANCHES, D_MODEL)
    merged = gates[..., 0, :] * branch_a + gates[..., 1, :] * branch_b
    return merged @ w_out


def moe_sublayer(h, w_router, b_router, w_gu, b_gu, w_down, b_down):
    Bn, S, D = h.shape
    T = Bn * S
    xt = h.reshape(T, D)
    logits = (xt @ w_router + b_router).astype(jnp.float32)
    top_val, top_idx = lax.top_k(logits, TOP_K)
    probs = jax.nn.softmax(top_val, axis=-1)
    N = T * TOP_K
    flat_e = top_idx.reshape(N).astype(jnp.int32)
    flat_tok = jnp.repeat(jnp.arange(T, dtype=jnp.int32), TOP_K)
    flat_w = probs.reshape(N)
    order = jnp.argsort(flat_e)
    sorted_e = flat_e[order]
    counts = jnp.bincount(flat_e, length=N_EXPERTS).astype(jnp.int32)
    padded = (counts + ROUTE_BLOCK - 1) // ROUTE_BLOCK * ROUTE_BLOCK
    pad_end = jnp.cumsum(padded)
    pad_start = pad_end - padded
    start = jnp.cumsum(counts) - counts
    dest = pad_start[sorted_e] + jnp.arange(N, dtype=jnp.int32) - start[sorted_e]
    n_blocks = -(-(N + N_EXPERTS * (ROUTE_BLOCK - 1)) // ROUTE_BLOCK)
    n_rows = n_blocks * ROUTE_BLOCK
    row_tok = jnp.full((n_rows,), T, jnp.int32).at[dest].set(flat_tok[order])
    row_w = jnp.zeros((n_rows,), jnp.float32).at[dest].set(flat_w[order])
    block_e = jnp.minimum(
        jnp.searchsorted(pad_end, jnp.arange(n_blocks, dtype=jnp.int32) * ROUTE_BLOCK, side="right"),
        N_EXPERTS - 1)
    x_pad = jnp.concatenate([xt, jnp.zeros((1, D), xt.dtype)], axis=0)
    xb = x_pad[row_tok].reshape(n_blocks, ROUTE_BLOCK, D)

    def expert_block(args):
        xblk, e = args
        gu = xblk @ w_gu[e] + b_gu[e]
        gate = jnp.minimum(gu[:, :D_FF], SWIGLU_LIMIT)
        up = jnp.clip(gu[:, D_FF:], -SWIGLU_LIMIT, SWIGLU_LIMIT)
        act = gate * jax.nn.sigmoid(SWIGLU_ALPHA * gate) * (up + 1.0)
        return act @ w_down[e] + b_down[e]

    yb = lax.map(expert_block, (xb, block_e))
    y = jnp.zeros((T + 1, D), jnp.float32).at[row_tok].add(
        yb.reshape(n_rows, D).astype(jnp.float32) * row_w[:, None])
    return y[:T].reshape(Bn, S, D).astype(h.dtype)


def setup_inputs(seed: int = 0) -> dict:
    key = jax.random.key(seed)
    ks = iter(jax.random.split(key, 40))
    nrm = lambda shape, s: jax.random.normal(next(ks), shape, jnp.float32) * s
    L, D = DEPTH, D_MODEL
    a0 = jax.random.uniform(next(ks), (L, RNN_WIDTH), jnp.float32, LRU_A_MIN, LRU_A_MAX)
    return {
        "x": nrm((BATCH, SEQ, D), 1.0),
        "c": nrm((BATCH, D), 1.0),
        "w_ada": nrm((L, D, N_MOD * D), 0.2 * D ** -0.5),
        "b_ada": nrm((L, N_MOD * D), 0.01),
        "w_in": nrm((L, D, IN_COLS), D ** -0.5),
        "b_in": nrm((L, IN_COLS), 0.01),
        "conv_w": nrm((L, CONV_WIDTH, RNN_WIDTH), CONV_WIDTH ** -0.5),
        "conv_b": nrm((L, RNN_WIDTH), 0.01),
        "w_rg_a": nrm((L, RNN_BLOCKS, RNN_BLOCK, RNN_BLOCK), RNN_BLOCK ** -0.5),
        "b_rg_a": nrm((L, RNN_WIDTH), 0.01),
        "w_rg_x": nrm((L, RNN_BLOCKS, RNN_BLOCK, RNN_BLOCK), RNN_BLOCK ** -0.5),
        "b_rg_x": nrm((L, RNN_WIDTH), 0.01),
        "lru_lambda": jnp.log(a0) - jnp.log1p(-a0),
        "w_rnn_out": nrm((L, RNN_WIDTH, D), RNN_WIDTH ** -0.5),
        "s5_lambda_re": -0.5 + nrm((L, S5_GROUPS, S5_STATE), 0.01),
        "s5_lambda_im": jnp.pi * jnp.arange(S5_STATE, dtype=jnp.float32) + nrm((L, S5_GROUPS, S5_STATE), 0.01),
        "s5_log_dt": jax.random.uniform(next(ks), (L, S5_GROUPS), jnp.float32, math.log(DT_MIN), math.log(DT_MAX)),
        "s5_b_re": nrm((L, S5_GROUPS, S5_STATE, S5_GROUP), (2 * S5_GROUP) ** -0.5),
        "s5_b_im": nrm((L, S5_GROUPS, S5_STATE, S5_GROUP), (2 * S5_GROUP) ** -0.5),
        "s5_c_re": nrm((L, S5_GROUPS, S5_GROUP, S5_STATE), S5_STATE ** -0.5),
        "s5_c_im": nrm((L, S5_GROUPS, S5_GROUP, S5_STATE), S5_STATE ** -0.5),
        "s5_d": nrm((L, S5_GROUPS, S5_GROUP), 1.0),
        "w_glu": nrm((L, S5_WIDTH, 2 * D), S5_WIDTH ** -0.5),
        "w_out": nrm((L, D, D), DEEPNORM_BETA * D ** -0.5),
        "ln1_g": 1.0 + nrm((L, D), 0.01),
        "ln1_b": nrm((L, D), 0.01),
        "w_router": nrm((L, D, N_EXPERTS), D ** -0.5),
        "b_router": nrm((L, N_EXPERTS), 0.01),
        "w_gu": nrm((L, N_EXPERTS, D, 2 * D_FF), D ** -0.5),
        "b_gu": nrm((L, N_EXPERTS, 2 * D_FF), 0.01),
        "w_down": nrm((L, N_EXPERTS, D_FF, D), DEEPNORM_BETA * D_FF ** -0.5),
        "b_down": nrm((L, N_EXPERTS, D), 0.01),
        "ln2_g": 1.0 + nrm((L, D), 0.01),
        "ln2_b": nrm((L, D), 0.01),
    }


def reference(x, c, w_ada, b_ada, w_in, b_in, conv_w, conv_b, w_rg_a, b_rg_a, w_rg_x, b_rg_x,
              lru_lambda, w_rnn_out, s5_lambda_re, s5_lambda_im, s5_log_dt, s5_b_re, s5_b_im,
              s5_c_re, s5_c_im, s5_d, w_glu, w_out, ln1_g, ln1_b, w_router, b_router,
              w_gu, b_gu, w_down, b_down, ln2_g, ln2_b):
    c_act = jax.nn.silu(c)
    for l in range(DEPTH):
        mod = (c_act @ w_ada[l] + b_ada[l])[:, None, :]
        sh1, sc1, g1, sh2, sc2, g2 = jnp.split(mod, N_MOD, axis=-1)
        h = x * (1.0 + sc1) + sh1
        mix = mixer_sublayer(h, w_in[l], b_in[l], conv_w[l], conv_b[l], w_rg_a[l], b_rg_a[l],
                             w_rg_x[l], b_rg_x[l], lru_lambda[l], w_rnn_out[l],
                             s5_lambda_re[l], s5_lambda_im[l], s5_log_dt[l], s5_b_re[l], s5_b_im[l],
                             s5_c_re[l], s5_c_im[l], s5_d[l], w_glu[l], w_out[l])
        x = layer_norm(DEEPNORM_ALPHA * x + (1.0 + g1) * mix, ln1_g[l], ln1_b[l])
        h = x * (1.0 + sc2) + sh2
        ffn = moe_sublayer(h, w_router[l], b_router[l], w_gu[l], b_gu[l], w_down[l], b_down[l])
        x = layer_norm(DEEPNORM_ALPHA * x + (1.0 + g2) * ffn, ln2_g[l], ln2_b[l])
    return x
```

```cpp
#include <hip/hip_runtime.h>
#include <cstdio>
#include <cstdint>

#ifndef MK_N_LAUNCHES
#define MK_N_LAUNCHES 1
#endif
constexpr int N_PHASES = 13;

#define GAS __attribute__((address_space(1)))
#define LAS __attribute__((address_space(3)))
typedef unsigned short bf16;
typedef short bf16x8 __attribute__((ext_vector_type(8)));
typedef float f32x4 __attribute__((ext_vector_type(4)));
typedef float f32x2 __attribute__((ext_vector_type(2)));
typedef unsigned u32x4 __attribute__((ext_vector_type(4)));
typedef unsigned u32x2 __attribute__((ext_vector_type(2)));
typedef GAS unsigned gu32;

constexpr int NB = 8, SEQ = 4096, T = NB * SEQ, D = 1024, INC = 4608, NE = 32, DFF = 1024;
constexpr int S5L = 32, S5G = 32, S5ROW = 128 + S5L * 16  , S5M = T / S5L  , S5CPB = SEQ / S5L  ;
constexpr int RGL = 128, RGC = SEQ / RGL  ;
constexpr float LN_EPS = 1e-5f, DN_ALPHA = 1.189207115002721f;
constexpr int ACT_ROWS = T * 4 + NE * 256;

constexpr size_t MiB = 1u << 20;
constexpr size_t WS_XRNN = 0, WS_GY = 64 * MiB, WS_GATES = 128 * MiB, WS_V1 = 0, WS_ACT = 0;
constexpr size_t WS_HBF = 272 * MiB, WS_HA = 272 * MiB, WS_YS = 336 * MiB, WS_GB = 368 * MiB, WS_MERGED = 432 * MiB, WS_ACAT = 496 * MiB, WS_YB = 272 * MiB;
constexpr size_t WS_X1 = 544 * MiB, WS_H2 = 608 * MiB;
constexpr size_t WS_WGU = 672 * MiB, WS_WD = 800 * MiB, WS_WIN = 864 * MiB, WS_WG = 873 * MiB, WS_WRNN = 874 * MiB, WS_WGLU = 876 * MiB, WS_WOUT = 878 * MiB;
constexpr size_t WS_WS = 880 * MiB, WS_WY = 888 * MiB, WS_S = 908 * MiB;
constexpr size_t WS_MOD = 924 * MiB, WS_AL = 925 * MiB, WS_RGAGG = 926 * MiB, WS_HIN = 928 * MiB, WS_TOK = 929 * MiB, WS_POS = 933 * MiB, WS_PROB = 934 * MiB, WS_CTL = 935 * MiB;
constexpr size_t WS_END = 936 * MiB, CTL_BYTES = 1 * MiB;
static_assert((size_t)ACT_ROWS * DFF * 2 <= 272 * MiB, "act/yb size");
static_assert(WS_ACAT + (size_t)S5G * S5M * S5ROW * 2 <= WS_X1, "acat");
constexpr int CW_BAR = 4096, CW_CNT = 8192  ;

constexpr int LDS_BYTES = 147456, MISC_OFF = LDS_BYTES - 256, TAB_OFF = 131072 + 1024;

__device__ __forceinline__ unsigned f2bf(float f) { unsigned u = __builtin_bit_cast(unsigned, f); return (u + 0x7fffu + ((u >> 16) & 1u)) >> 16; }
typedef __bf16 bf16x2v __attribute__((ext_vector_type(2)));
__device__ __forceinline__ unsigned pk2(float lo, float hi) { const f32x2 v = {lo, hi}; const bf16x2v b = __builtin_convertvector(v, bf16x2v); return __builtin_bit_cast(unsigned, b); }
__device__ __forceinline__ float bflo(unsigned w) { return __builtin_bit_cast(float, w << 16); }
__device__ __forceinline__ float bfhi(unsigned w) { return __builtin_bit_cast(float, w & 0xffff0000u); }
__device__ __forceinline__ float bf1(bf16 h) { return __builtin_bit_cast(float, ((unsigned)h) << 16); }
__device__ __forceinline__ float fast_sigmoid(float x) { return __builtin_amdgcn_rcpf(1.0f + __builtin_amdgcn_exp2f(-1.4426950409f * x)); }
__device__ __forceinline__ float gelu_tanh(float x) { const float u = x + 0.044715f * x * x * x; return x * __builtin_amdgcn_rcpf(1.0f + __builtin_amdgcn_exp2f(-2.3022082f * u)); }
__device__ __forceinline__ float wave_sum(float v) {
#pragma unroll
    for (int o = 1; o < 64; o <<= 1) v += __shfl_xor(v, o);
    return v;
}
__device__ __forceinline__ u32x4 pack8(f32x4 a, f32x4 b) { u32x4 w; w.x = pk2(a[0], a[1]); w.y = pk2(a[2], a[3]); w.z = pk2(b[0], b[1]); w.w = pk2(b[2], b[3]); return w; }
__device__ __forceinline__ void unpack8(u32x4 w, f32x4& a, f32x4& b) { a = (f32x4){bflo(w.x), bfhi(w.x), bflo(w.y), bfhi(w.y)}; b = (f32x4){bflo(w.z), bfhi(w.z), bflo(w.w), bfhi(w.w)}; }

#define XB_TMO      128
#define XB_XCNT(j)  (256  + 64 * (j))
#define XB_XSUB(j)  (1280 + 64 * (j))
#define XB_XGEN(j)  (2304 + 64 * (j))
#define XB_TOP      3328
#define XB_TOPGEN   3392
#define XCD_BAR_WORDS 3456
#define XB_SPIN_CAP (1u << 18)
__device__ __forceinline__ unsigned xb_ld(unsigned* p)              { return __hip_atomic_load(p, __ATOMIC_RELAXED, __HIP_MEMORY_SCOPE_AGENT); }
__device__ __forceinline__ unsigned xb_add(unsigned* p, unsigned v) { return __hip_atomic_fetch_add(p, v, __ATOMIC_RELAXED, __HIP_MEMORY_SCOPE_AGENT); }
__device__ __forceinline__ unsigned xb_xcc_id() { return (unsigned)__builtin_amdgcn_s_getreg((3 << 11) | 20) & 0xFu; }
#define XB_SPIN(cond, bar) do { unsigned _sp = 0; while (cond) { __builtin_amdgcn_s_sleep(1); \
    if ((++_sp & 255u) == 0u) { if (xb_ld(&(bar)[XB_TMO])) break; if (_sp > XB_SPIN_CAP) { atomicAdd(&(bar)[XB_TMO], 1u); break; } } } } while (0)
struct XcdBarrier { unsigned* bar; unsigned x; volatile LAS unsigned* st; };
__device__ __forceinline__ XcdBarrier xcd_barrier_post(unsigned* bar, volatile LAS unsigned* st) {
    XcdBarrier b; b.bar = bar; b.x = xb_xcc_id(); b.st = st;
    if (threadIdx.x == 0) (void)xb_add(&bar[XB_XCNT(b.x)], 1u);
    return b;
}
__device__ __forceinline__ void xcd_barrier_complete(unsigned* bar, unsigned x, unsigned& nloc, unsigned& nx) {
    const unsigned G = gridDim.x * gridDim.y * gridDim.z;
    unsigned sum, cnt, mine, sp = 0u;
    for (;;) {
        sum = 0u; cnt = 0u; mine = 0u;
#pragma unroll
        for (unsigned j = 0; j < 16; ++j) { const unsigned c = xb_ld(&bar[XB_XCNT(j)]); sum += c; cnt += (c > 0u) ? 1u : 0u; mine = (j == x) ? c : mine; }
        if (sum == G) break;
        __builtin_amdgcn_s_sleep(1);
        if ((++sp & 255u) == 0u) { if (xb_ld(&bar[XB_TMO])) break; if (sp > XB_SPIN_CAP) { atomicAdd(&bar[XB_TMO], 1u); break; } }
    }
    nloc = mine > 0u ? mine : 1u; nx = cnt > 0u ? cnt : 1u;
}
__device__ __forceinline__ void xcd_barrier(const XcdBarrier& b) {
    asm volatile("s_waitcnt vmcnt(0)" ::: "memory");
    __syncthreads();
    if (threadIdx.x == 0) {
        unsigned* bar = b.bar;
        __builtin_amdgcn_s_waitcnt(0);
        unsigned nloc = b.st[0], nx = b.st[1];
        if (nloc == 0u) { xcd_barrier_complete(bar, b.x, nloc, nx); b.st[0] = nloc; b.st[1] = nx; }
        const unsigned old = xb_add(&bar[XB_XSUB(b.x)], 1u);
        const unsigned gen = old / nloc;
        if (old + 1u == (gen + 1u) * nloc) {
            __builtin_amdgcn_fence(__ATOMIC_RELEASE, "agent");
            asm volatile("s_waitcnt vmcnt(0)" ::: "memory");
            const unsigned og = xb_add(&bar[XB_TOP], 1u);
            const unsigned tg = og / nx;
            if (og + 1u == (tg + 1u) * nx) xb_add(&bar[XB_TOPGEN], 1u);
            else XB_SPIN(xb_ld(&bar[XB_TOPGEN]) == tg, bar);
            __builtin_amdgcn_fence(__ATOMIC_ACQUIRE, "agent");
            xb_add(&bar[XB_XGEN(b.x)], 1u);
            asm volatile("s_waitcnt vmcnt(0)" ::: "memory");
        } else {
            XB_SPIN(xb_ld(&bar[XB_XGEN(b.x)]) == gen, bar);
            __builtin_amdgcn_fence(__ATOMIC_ACQUIRE, "agent");
            asm volatile("s_waitcnt vmcnt(0)" ::: "memory");
        }
    }
    __syncthreads();
}

namespace g8 {
constexpr int BM = 256, BK = 64, HALF = 128, HTB = HALF * BK * 2, STAGE_BYTES = 8 * HTB;
__device__ __forceinline__ int lds_byte(int r, int c) { const int st = (r >> 4) * 2 + (c >> 5), rr = r & 15, cc = c & 31, ob = rr * 64 + cc * 2; return st * 1024 + (ob ^ (((ob >> 9) & 1) << 5)); }
__device__ __forceinline__ void stage_rc(int b, int& R, int& C) { const int st = b / 1024, sb = b % 1024, swz = sb ^ (((sb >> 9) & 1) << 5); R = (st >> 1) * 16 + swz / 64; C = (st & 1) * 32 + (swz % 64) / 2; }
__device__ __forceinline__ int perm32(int rho) { const int n = rho >> 4, i = rho & 15; return 8 * (i >> 2) + 4 * n + (i & 3); }

struct Unit { int pm, pn, z, rl; const char* A; const char* B; };

template <class Epi, class Sched, bool GATHER>
__device__ __forceinline__ void gemm_phase(LAS unsigned char* lds, const int K, const int lda, const int ldb, const Sched& S, const Epi& E) {
    const int tid = threadIdx.x, wid = __builtin_amdgcn_readfirstlane(tid >> 6), lane = tid & 63, wr = wid >> 2, wc = wid & 3, fr = lane & 15, fq = lane >> 4;
    const int nt = K / BK;
    unsigned voffB[2], cvo[2][2], nvo[2][2]; int Rr[2], Cc[2];
#pragma unroll
    for (int i = 0; i < 2; ++i) { int R, C; stage_rc(tid * 16 + i * 8192, R, C); const int Rb = (R & ~31) + perm32(R & 31);
        voffB[i] = (unsigned)(Rb * ldb + C) * 2u; Rr[i] = R; Cc[i] = C;
#pragma unroll
        for (int h = 0; h < 2; ++h) { cvo[h][i] = (unsigned)((h * HALF + R) * lda + C) * 2u; nvo[h][i] = cvo[h][i]; } }
    const size_t kstep = (size_t)(BK * 2);
    const size_t hstepB = (size_t)HALF * ldb * 2;
    const unsigned ldsw = (unsigned)wid * 1024u;
    const int aoff = lds_byte(wr * 64 + fr, fq * 8), boff = lds_byte(wc * 32 + fr, fq * 8);
#define G8_SA(b, h) (((b) * 2 + (h)) * HTB)
#define G8_SB(b, h) ((4 + (b) * 2 + (h)) * HTB)
#define G8_STGB(bufoff, gbase) do { _Pragma("unroll") for (int _i = 0; _i < 2; ++_i) \
        __builtin_amdgcn_global_load_lds((const unsigned*)((const char*)(gbase) + voffB[_i]), (LAS unsigned*)(lds + (bufoff) + ldsw + _i * 8192), 16, 0, 0); } while (0)
#define G8_STGA(bufoff, gbase, VO, h) do { _Pragma("unroll") for (int _i = 0; _i < 2; ++_i) \
        __builtin_amdgcn_global_load_lds((const unsigned*)((const char*)(gbase) + VO[h][_i]), (LAS unsigned*)(lds + (bufoff) + ldsw + _i * 8192), 16, 0, 0); } while (0)
#define G8_LDA(dst, b, h) do { _Pragma("unroll") for (int m = 0; m < 4; ++m) _Pragma("unroll") for (int k = 0; k < 2; ++k) dst[m][k] = *(const LAS bf16x8*)(lds + G8_SA(b, h) + aoff + m * 2048 + k * 1024); } while (0)
#define G8_LDB(dst, b, h) do { _Pragma("unroll") for (int n = 0; n < 2; ++n) _Pragma("unroll") for (int k = 0; k < 2; ++k) dst[n][k] = *(const LAS bf16x8*)(lds + G8_SB(b, h) + boff + n * 2048 + k * 1024); } while (0)
#define G8_MMA(ai, bj, At, Bt) do { __builtin_amdgcn_s_setprio(1); _Pragma("unroll") for (int m = 0; m < 4; ++m) _Pragma("unroll") for (int n = 0; n < 2; ++n) _Pragma("unroll") for (int k = 0; k < 2; ++k) \
        acc[ai][bj][m][n] = __builtin_amdgcn_mfma_f32_16x16x32_bf16(Bt[n][k], At[m][k], acc[ai][bj][m][n], 0, 0, 0); __builtin_amdgcn_s_setprio(0); } while (0)
#define G8_WAIT_V(n) asm volatile("s_waitcnt vmcnt(" #n ")" ::: "memory")
#define G8_WAIT_L(n) asm volatile("s_waitcnt lgkmcnt(" #n ")" ::: "memory")
#define G8_BAR __builtin_amdgcn_s_barrier()
#define G8_SCHED __builtin_amdgcn_sched_barrier(0)
    Unit cur, nxt; int ui = 0;
    if (!S.next(0, cur)) return;
    bool has_next = S.next(1, nxt);
    if constexpr (GATHER) { S.gather(cur, Rr, Cc, cvo); if (has_next) S.gather(nxt, Rr, Cc, nvo); else {
#pragma unroll
        for (int h = 0; h < 2; ++h)
#pragma unroll
            for (int i = 0; i < 2; ++i) nvo[h][i] = cvo[h][i]; } }
    f32x4 acc[2][2][4][2];
#pragma unroll
    for (int a = 0; a < 2; ++a)
#pragma unroll
        for (int b = 0; b < 2; ++b)
#pragma unroll
            for (int m = 0; m < 4; ++m)
#pragma unroll
                for (int n = 0; n < 2; ++n) acc[a][b][m][n] = (f32x4){0.f, 0.f, 0.f, 0.f};
    bf16x8 At[4][2], B0[2][2], B1[2][2];
    const char* cA = cur.A; const char* cB = cur.B;
    G8_STGB(G8_SB(0, 0), cB); G8_STGB(G8_SB(0, 1), cB + hstepB); G8_STGA(G8_SA(0, 0), cA, cvo, 0); G8_STGA(G8_SA(0, 1), cA, cvo, 1);
    if (wr == 1) G8_BAR;
    G8_WAIT_V(2); G8_BAR;
    G8_STGB(G8_SB(1, 0), cB + kstep); G8_STGA(G8_SA(1, 0), cA + kstep, cvo, 0); G8_STGB(G8_SB(1, 1), cB + hstepB + kstep);
    G8_WAIT_V(6); G8_BAR;
    for (;;) {
        const char* nA = has_next ? nxt.A : cA; const char* nB = has_next ? nxt.B : cB;
        for (int t = 0; t < nt; t += 2) {
            const bool last = (t == nt - 2);
            const char* a1 = cA + (size_t)(t + 1) * kstep;
            const char* a2 = last ? nA : cA + (size_t)(t + 2) * kstep; const char* b2 = last ? nB : cB + (size_t)(t + 2) * kstep;
            const char* a3 = a2 + kstep; const char* b3 = b2 + kstep;
            unsigned vo2[2][2];
#pragma unroll
            for (int h = 0; h < 2; ++h)
#pragma unroll
                for (int i = 0; i < 2; ++i) vo2[h][i] = (GATHER && last) ? nvo[h][i] : cvo[h][i];
            G8_LDB(B0, 0, 0); G8_LDB(B1, 0, 1); G8_SCHED; G8_LDA(At, 0, 0); G8_STGA(G8_SA(1, 1), a1, cvo, 1);
            G8_WAIT_V(8); G8_WAIT_L(0); G8_BAR; G8_MMA(0, 0, At, B0); G8_MMA(0, 1, At, B1); G8_BAR; G8_SCHED;
            G8_LDA(At, 0, 1); G8_STGB(G8_SB(0, 0), b2); G8_STGB(G8_SB(0, 1), b2 + hstepB); G8_STGA(G8_SA(0, 0), a2, vo2, 0);
            G8_WAIT_V(8); G8_WAIT_L(0); G8_BAR; G8_MMA(1, 0, At, B0); G8_MMA(1, 1, At, B1); G8_BAR; G8_SCHED;
            G8_LDB(B0, 1, 0); G8_LDB(B1, 1, 1); G8_SCHED; G8_LDA(At, 1, 0); G8_STGA(G8_SA(0, 1), a2, vo2, 1);
            G8_WAIT_V(8); G8_WAIT_L(0); G8_BAR; G8_MMA(0, 0, At, B0); G8_MMA(0, 1, At, B1); G8_BAR; G8_SCHED;
            G8_LDA(At, 1, 1); G8_STGB(G8_SB(1, 0), b3); G8_STGB(G8_SB(1, 1), b3 + hstepB); G8_STGA(G8_SA(1, 0), a3, vo2, 0);
            G8_WAIT_V(8); G8_WAIT_L(0); G8_BAR; G8_MMA(1, 0, At, B0); G8_MMA(1, 1, At, B1); G8_BAR; G8_SCHED;
        }
        if (wr == 0) G8_BAR;
        Unit nn; bool has_nn = false;
        if (has_next) has_nn = S.next(ui + 2, nn);
        unsigned nnvo[2][2];
        if constexpr (GATHER) { if (has_nn) S.gather(nn, Rr, Cc, nnvo); }
        E(acc, cur, wr, wc, fr, fq);
        if (!has_next) break;
#pragma unroll
        for (int a = 0; a < 2; ++a)
#pragma unroll
            for (int b = 0; b < 2; ++b)
#pragma unroll
                for (int m = 0; m < 4; ++m)
#pragma unroll
                    for (int n = 0; n < 2; ++n) acc[a][b][m][n] = (f32x4){0.f, 0.f, 0.f, 0.f};
        cur = nxt; cA = nA; cB = nB; ++ui;
        if constexpr (GATHER) {
#pragma unroll
            for (int h = 0; h < 2; ++h)
#pragma unroll
                for (int i = 0; i < 2; ++i) { cvo[h][i] = nvo[h][i]; if (has_nn) nvo[h][i] = nnvo[h][i]; } }
        nxt = nn; has_next = has_nn;
        if (wr == 1) G8_BAR;
    }
    G8_WAIT_V(0);
    G8_BAR;
#undef G8_SA
#undef G8_SB
#undef G8_STGB
#undef G8_STGA
#undef G8_LDA
#undef G8_LDB
#undef G8_MMA
#undef G8_WAIT_V
#undef G8_WAIT_L
#undef G8_BAR
#undef G8_SCHED
}

struct GridOrder {
    int nM, nN, nwg, G, c; const char* A; const char* B; size_t tstepA, tstepB;
    __device__ __forceinline__ void init(int M, int N, int G_, int c_, const void* A_, const void* B_, int lda, int ldb) { nM = M / BM; nN = N / BM; nwg = nM * nN; G = G_; c = c_; A = (const char*)A_; B = (const char*)B_; tstepA = (size_t)BM * lda * 2; tstepB = (size_t)BM * ldb * 2; }
    __device__ __forceinline__ bool next(int i, Unit& u) const {
        const long L = (long)i * G + c; if (L >= nwg) return false;
        int wgid = (int)L; { const int q = nwg / 8, r = nwg % 8, xcd = wgid % 8, off = wgid / 8; wgid = (xcd < r ? xcd * (q + 1) : r * (q + 1) + (xcd - r) * q) + off; }
        const int nig = 8 * nN, gid = wgid / nig, fm = gid * 8, gsz = (nM - fm) < 8 ? (nM - fm) : 8;
        u.pm = fm + ((wgid % nig) % gsz); u.pn = (wgid % nig) / gsz; u.z = 0; u.rl = 0;
        u.A = A + (size_t)u.pm * tstepA; u.B = B + (size_t)u.pn * tstepB; return true;
    }
};
}

struct Frame {
    LAS unsigned char* lds; volatile LAS unsigned* MISC; unsigned* ctl;
    int tid, lane, wave, vcu, G;
    const float* in[34]; float* out; unsigned char* ws;
};
#define WSP(T_, off) ((T_*)(F.ws + (off)))

struct EpiInProj {
    const float* bias; bf16 *xrnn, *gy, *acat, *gates;
    __device__ __forceinline__ void operator()(const f32x4 (&acc)[2][2][4][2], const g8::Unit& u, int wr, int wc, int fr, int fq) const {
        const int pn = u.pn, colb = pn * 256 + wc * 32 + 8 * fq;
        f32x4 bv[2][2];
#pragma unroll
        for (int bj = 0; bj < 2; ++bj)
#pragma unroll
            for (int n = 0; n < 2; ++n) bv[bj][n] = *(const f32x4*)(bias + colb + bj * 128 + 4 * n);
#pragma unroll
        for (int ai = 0; ai < 2; ++ai)
#pragma unroll
            for (int m = 0; m < 4; ++m) { const int t = u.pm * 256 + ai * 128 + wr * 64 + m * 16 + fr;
#pragma unroll
                for (int bj = 0; bj < 2; ++bj) { f32x4 v0 = acc[ai][bj][m][0] + bv[bj][0], v1 = acc[ai][bj][m][1] + bv[bj][1]; const int col = colb + bj * 128;
                    if (pn < 4) { *(u32x4*)(xrnn + (size_t)t * 1024 + col) = pack8(v0, v1); }
                    else if (pn < 8) {
#pragma unroll
                        for (int j = 0; j < 4; ++j) { v0[j] = gelu_tanh(v0[j]); v1[j] = gelu_tanh(v1[j]); }
                        *(u32x4*)(gy + (size_t)t * 1024 + (col - 1024)) = pack8(v0, v1); }
                    else if (pn < 10) { const int cu = col - 2048, g = cu >> 4, c = cu & 15;
                        *(u32x4*)(acat + ((size_t)(g * S5M + (t >> 5)) * S5ROW + 128 + (t & 31) * 16 + c)) = pack8(v0, v1); }
                    else {
#pragma unroll
                        for (int j = 0; j < 4; ++j) { v0[j] = fast_sigmoid(v0[j]); v1[j] = fast_sigmoid(v1[j]); }
                        *(u32x4*)(gates + (size_t)t * 2048 + (col - 2560)) = pack8(v0, v1); } } }
    }
};
struct EpiS5A {
    float* S;
    __device__ __forceinline__ void operator()(const f32x4 (&acc)[2][2][4][2], const g8::Unit& u, int wr, int wc, int fr, int fq) const {
        const int col = wc * 32 + 8 * fq;
#pragma unroll
        for (int ai = 0; ai < 2; ++ai)
#pragma unroll
            for (int m = 0; m < 4; ++m) { const int row = u.pm * 256 + ai * 128 + wr * 64 + m * 16 + fr; float* p = S + ((size_t)(u.z * S5M + row)) * 128 + col;
                *(f32x4*)p = acc[ai][0][m][0]; *(f32x4*)(p + 4) = acc[ai][0][m][1]; }
    }
};
struct EpiS5C {
    bf16* ys;
    __device__ __forceinline__ void operator()(const f32x4 (&acc)[2][2][4][2], const g8::Unit& u, int wr, int wc, int fr, int fq) const {
#pragma unroll
        for (int ai = 0; ai < 2; ++ai)
#pragma unroll
            for (int m = 0; m < 4; ++m) { const int row = u.pm * 256 + ai * 128 + wr * 64 + m * 16 + fr;
#pragma unroll
                for (int bj = 0; bj < 2; ++bj) { const int n = u.pn * 256 + bj * 128 + wc * 32 + 8 * fq, i = n >> 4, c = n & 15; f32x4 v0 = acc[ai][bj][m][0], v1 = acc[ai][bj][m][1];
#pragma unroll
                    for (int j = 0; j < 4; ++j) { v0[j] = gelu_tanh(v0[j]); v1[j] = gelu_tanh(v1[j]); }
                    *(u32x4*)(ys + (size_t)(row * 32 + i) * 512 + u.z * 16 + c) = pack8(v0, v1); } }
    }
};
struct EpiGlu {
    const bf16* gates; bf16* gb;
    __device__ __forceinline__ void operator()(const f32x4 (&acc)[2][2][4][2], const g8::Unit& u, int wr, int wc, int fr, int fq) const {
        const int f = u.pn * 128 + wc * 32 + 8 * fq;
#pragma unroll
        for (int ai = 0; ai < 2; ++ai)
#pragma unroll
            for (int m = 0; m < 4; ++m) { const int t = u.pm * 256 + ai * 128 + wr * 64 + m * 16 + fr;
                const u32x4 gw = *(const u32x4*)(gates + (size_t)t * 2048 + 1024 + f); f32x4 g0, g1; unpack8(gw, g0, g1);
                f32x4 v0 = acc[ai][0][m][0], v1 = acc[ai][0][m][1]; const f32x4 s0 = acc[ai][1][m][0], s1 = acc[ai][1][m][1];
#pragma unroll
                for (int j = 0; j < 4; ++j) { v0[j] = g0[j] * v0[j] * fast_sigmoid(s0[j]); v1[j] = g1[j] * v1[j] * fast_sigmoid(s1[j]); }
                *(u32x4*)(gb + (size_t)t * 1024 + f) = pack8(v0, v1); }
    }
};
struct EpiRnn {
    const bf16* gates; const bf16* gb; bf16* merged;
    __device__ __forceinline__ void operator()(const f32x4 (&acc)[2][2][4][2], const g8::Unit& u, int wr, int wc, int fr, int fq) const {
#pragma unroll
        for (int ai = 0; ai < 2; ++ai)
#pragma unroll
            for (int m = 0; m < 4; ++m) { const int t = u.pm * 256 + ai * 128 + wr * 64 + m * 16 + fr;
#pragma unroll
                for (int bj = 0; bj < 2; ++bj) { const int col = u.pn * 256 + bj * 128 + wc * 32 + 8 * fq;
                    const u32x4 gw = *(const u32x4*)(gates + (size_t)t * 2048 + col), bw = *(const u32x4*)(gb + (size_t)t * 1024 + col);
                    f32x4 g0, g1, b0, b1; unpack8(gw, g0, g1); unpack8(bw, b0, b1);
                    const f32x4 v0 = g0 * acc[ai][bj][m][0] + b0, v1 = g1 * acc[ai][bj][m][1] + b1;
                    *(u32x4*)(merged + (size_t)t * 1024 + col) = pack8(v0, v1); } }
    }
};
struct EpiOut {
    const float* x; const float* mod; bf16* v1;
    __device__ __forceinline__ void operator()(const f32x4 (&acc)[2][2][4][2], const g8::Unit& u, int wr, int wc, int fr, int fq) const {
        const int b = (u.pm * 256) >> 12;
#pragma unroll
        for (int bj = 0; bj < 2; ++bj) { const int col = u.pn * 256 + bj * 128 + wc * 32 + 8 * fq;
            const f32x4 ga = *(const f32x4*)(mod + b * 6144 + 2048 + col) + 1.0f, gb_ = *(const f32x4*)(mod + b * 6144 + 2048 + col + 4) + 1.0f;
#pragma unroll
            for (int ai = 0; ai < 2; ++ai)
#pragma unroll
                for (int m = 0; m < 4; ++m) { const int t = u.pm * 256 + ai * 128 + wr * 64 + m * 16 + fr;
                    const f32x4 x0 = *(const f32x4*)(x + (size_t)t * 1024 + col), x1 = *(const f32x4*)(x + (size_t)t * 1024 + col + 4);
                    const f32x4 v0 = x0 * DN_ALPHA + ga * acc[ai][bj][m][0], v1_ = x1 * DN_ALPHA + gb_ * acc[ai][bj][m][1];
                    *(u32x4*)(v1 + (size_t)t * 1024 + col) = pack8(v0, v1_); } }
    }
};
struct EpiMoe1 {
    const float* bgu; bf16* act;
    __device__ __forceinline__ void operator()(const f32x4 (&acc)[2][2][4][2], const g8::Unit& u, int wr, int wc, int fr, int fq) const {
        const int f = u.pn * 128 + wc * 32 + 8 * fq; const float* bp = bgu + (size_t)u.z * 2048 + f;
        const f32x4 bg0 = *(const f32x4*)bp, bg1 = *(const f32x4*)(bp + 4), bu0 = *(const f32x4*)(bp + 1024), bu1 = *(const f32x4*)(bp + 1028);
#pragma unroll
        for (int ai = 0; ai < 2; ++ai)
#pragma unroll
            for (int m = 0; m < 4; ++m) { const int row = u.pm * 256 + ai * 128 + wr * 64 + m * 16 + fr;
                f32x4 g0 = acc[ai][0][m][0] + bg0, g1 = acc[ai][0][m][1] + bg1, u0 = acc[ai][1][m][0] + bu0, u1 = acc[ai][1][m][1] + bu1;
#pragma unroll
                for (int j = 0; j < 4; ++j) { const float ga = fminf(g0[j], 7.0f), gb_ = fminf(g1[j], 7.0f), ua = fminf(fmaxf(u0[j], -7.0f), 7.0f), ub = fminf(fmaxf(u1[j], -7.0f), 7.0f);
                    g0[j] = ga * fast_sigmoid(1.702f * ga) * (ua + 1.0f); g1[j] = gb_ * fast_sigmoid(1.702f * gb_) * (ub + 1.0f); }
                *(u32x4*)(act + (size_t)row * 1024 + f) = pack8(g0, g1); }
    }
};
struct EpiMoe2 {
    const float* bd; bf16* yb;
    __device__ __forceinline__ void operator()(const f32x4 (&acc)[2][2][4][2], const g8::Unit& u, int wr, int wc, int fr, int fq) const {
#pragma unroll
        for (int bj = 0; bj < 2; ++bj) { const int col = u.pn * 256 + bj * 128 + wc * 32 + 8 * fq; const float* bp = bd + (size_t)u.z * 1024 + col;
            const f32x4 b0 = *(const f32x4*)bp, b1 = *(const f32x4*)(bp + 4);
#pragma unroll
            for (int ai = 0; ai < 2; ++ai)
#pragma unroll
                for (int m = 0; m < 4; ++m) { const int row = u.pm * 256 + ai * 128 + wr * 64 + m * 16 + fr;
                    *(u32x4*)(yb + (size_t)row * 1024 + col) = pack8(acc[ai][bj][m][0] + b0, acc[ai][bj][m][1] + b1); } }
    }
};

struct S5AOrder { int G, c; const char* acat; const char* ws;
    __device__ __forceinline__ bool next(int i, g8::Unit& u) const { const int L = i * G + c; if (L >= S5G * 4) return false; u.z = L >> 2; u.pm = L & 3; u.pn = 0; u.rl = 0;
        u.A = acat + ((size_t)(u.z * S5M + u.pm * 256) * S5ROW + 128) * 2; u.B = ws + (size_t)u.z * 256 * (S5L * 16) * 2; return true; } };
struct S5COrder { int G, c; const char* acat; const char* wy;
    __device__ __forceinline__ bool next(int i, g8::Unit& u) const { const int L = i * G + c; if (L >= S5G * 8) return false; u.z = L >> 3; u.pm = (L >> 1) & 3; u.pn = L & 1; u.rl = 0;
        u.A = acat + ((size_t)(u.z * S5M + u.pm * 256) * S5ROW) * 2; u.B = wy + ((size_t)(u.z * 512 + u.pn * 256) * S5ROW) * 2; return true; } };
struct MoeOrder { int G, c, NT, RT; const LAS int* tstart; const LAS int* cnt; const int* toklist; const char* A; const char* B; size_t bstride_e; int lda; bool gatherA;
    __device__ __forceinline__ bool next(int i, g8::Unit& u) const { const long L = (long)i * G + c; if (L >= (long)RT * NT) return false; const int rt = (int)(L / NT); u.pn = (int)(L % NT);
        int e = 0;
#pragma unroll 1
        for (int k = 1; k < NE; ++k) if (tstart[k] <= rt) e = k;
        u.z = e; u.pm = rt; u.rl = rt - tstart[e]; u.B = B + (size_t)e * bstride_e + (size_t)u.pn * 256 * 1024 * 2; u.A = gatherA ? A : A + (size_t)rt * 256 * 1024 * 2; return true; }
    __device__ __forceinline__ void gather(const g8::Unit& u, const int (&Rr)[2], const int (&Cc)[2], unsigned (&vo)[2][2]) const {
        const int n = cnt[u.z];
#pragma unroll
        for (int h = 0; h < 2; ++h)
#pragma unroll
            for (int i = 0; i < 2; ++i) { const int r = u.rl * 256 + h * 128 + Rr[i]; const int tok = r < n ? toklist[u.z * T + r] : 0; vo[h][i] = (unsigned)(tok * lda + Cc[i]) * 2u; } }
};

__device__ __forceinline__ void transpose_item(const float* W, int N, int k0, int n0, bf16* dst, int ldd, int drow0, LAS float* scr, int lane) {
#pragma unroll 8
    for (int i = 0; i < 32; ++i) { const int kk = 2 * i + (lane >> 5); scr[kk * 33 + (lane & 31)] = W[(size_t)(k0 + kk) * N + n0 + (lane & 31)]; }
    asm volatile("s_waitcnt lgkmcnt(0)" ::: "memory");
    const int c = lane & 7;
#pragma unroll
    for (int j = 0; j < 4; ++j) { const int n = (lane >> 3) + 8 * j; const LAS float* s = scr + (8 * c) * 33 + n;
        u32x4 o; o.x = pk2(s[0 * 33], s[1 * 33]); o.y = pk2(s[2 * 33], s[3 * 33]); o.z = pk2(s[4 * 33], s[5 * 33]); o.w = pk2(s[6 * 33], s[7 * 33]);
        *(u32x4*)(dst + (size_t)(drow0 + n) * ldd + k0 + 8 * c) = o; }
    asm volatile("s_waitcnt lgkmcnt(0)" ::: "memory");
}
__device__ __forceinline__ int pair_row(int n) { const int f = n & 1023, hi = n >> 10; return (f >> 7) * 256 + hi * 128 + (f & 127); }

__device__ __forceinline__ void moe_tables(Frame& F) {
    LAS int* tstart = (LAS int*)(F.lds + TAB_OFF); LAS int* cl = tstart + 40;
    if (F.tid == 0) { int acc = 0; for (int e = 0; e < NE; ++e) { const int c = (int)F.ctl[CW_CNT + 64 * e]; cl[e] = c; tstart[e] = acc; acc += (c + 255) >> 8; } tstart[NE] = acc; }
    __syncthreads();
}

__device__ __forceinline__ void p0_mod_job(Frame& F, int job) {
    LAS float* sc = (LAS float*)F.lds;
    LAS float* red = sc + 8 * 1024;
    const float* c = F.in[1]; const float* w = F.in[2]; const float* bias = F.in[3];
    for (int i = F.tid; i < 8 * 1024; i += 512) { const float v = c[i]; sc[i] = v * fast_sigmoid(v); }
    __syncthreads();
    const int col = F.tid & 31, kg = F.tid >> 5, j = job * 32 + col;
    float a[8];
#pragma unroll
    for (int b = 0; b < 8; ++b) a[b] = 0.f;
#pragma unroll 8
    for (int k = kg * 64; k < kg * 64 + 64; ++k) { const float wv = w[(size_t)k * 6144 + j];
#pragma unroll
        for (int b = 0; b < 8; ++b) a[b] += sc[b * 1024 + k] * wv; }
#pragma unroll
    for (int b = 0; b < 8; ++b) red[(kg * 8 + b) * 32 + col] = a[b];
    __syncthreads();
    if (F.tid < 256) { const int b = F.tid >> 5, cc = F.tid & 31; float s = 0.f;
#pragma unroll
        for (int g = 0; g < 16; ++g) s += red[(g * 8 + b) * 32 + cc];
        WSP(float, WS_MOD)[b * 6144 + job * 32 + cc] = s + bias[job * 32 + cc]; }
    __syncthreads();
}
__device__ __forceinline__ void p0_s5_job(Frame& F, int g) {
    LAS f32x2* Bb = (LAS f32x2*)F.lds;
    LAS f32x2* Cc = Bb + 1024;
    LAS f32x2* Ap = Cc + 1024;
    LAS float* Kt = (LAS float*)(Ap + 33 * 64);
    const float* lre = F.in[14] + g * 64; const float* lim = F.in[15] + g * 64; const float dt = expf(F.in[16][g]);
    const float* bre = F.in[17] + g * 1024; const float* bim = F.in[18] + g * 1024; const float* cre = F.in[19] + g * 1024; const float* cim = F.in[20] + g * 1024; const float* dsk = F.in[21] + g * 16;
    for (int i = F.tid; i < 1024; i += 512) { const int p = i >> 4; const float lr = lre[p], li = lim[p]; const float mag = expf(lr * dt); float sn, cs; sincosf(li * dt, &sn, &cs);
        const float ar = mag * cs, ai = mag * sn, den = lr * lr + li * li, qr = ((ar - 1.f) * lr + ai * li) / den, qi = (ai * lr - (ar - 1.f) * li) / den;
        const float br = bre[i], bi = bim[i]; Bb[i] = (f32x2){qr * br - qi * bi, qr * bi + qi * br};
        Cc[i] = (f32x2){cre[i], cim[i]}; }
    for (int i = F.tid; i < 33 * 64; i += 512) { const int k = i >> 6, p = i & 63; const float lr = lre[p], li = lim[p]; const float mag = expf((float)k * lr * dt); float sn, cs; sincosf((float)k * li * dt, &sn, &cs);
        Ap[i] = (f32x2){mag * cs, mag * sn}; if (k == S5L) WSP(f32x2, WS_AL)[g * 64 + p] = (f32x2){mag * cs, mag * sn}; }
    __syncthreads();
    for (int e = F.tid; e < 32 * 256; e += 512) { const int k = e >> 8, c = (e >> 4) & 15, c2 = e & 15; float s = 0.f;
        for (int p = 0; p < 64; ++p) { const f32x2 cv = Cc[c * 64 + p], av = Ap[k * 64 + p], bv = Bb[p * 16 + c2];
            const float car = cv.x * av.x - cv.y * av.y, cai = cv.x * av.y + cv.y * av.x; s += car * bv.x - cai * bv.y; }
        Kt[e] = s; }
    __syncthreads();
    bf16* wy = WSP(bf16, WS_WY) + (size_t)g * 512 * S5ROW;
    for (int ch = F.tid; ch < 512 * (S5ROW / 8); ch += 512) { const int n = ch / (S5ROW / 8), k8 = (ch % (S5ROW / 8)) * 8, i = n >> 4, c = n & 15; float v[8];
        if (k8 < 128) {
#pragma unroll
            for (int j = 0; j < 8; j += 2) { const int p = (k8 + j) >> 1; const f32x2 cv = Cc[c * 64 + p], av = Ap[(i + 1) * 64 + p]; v[j] = cv.x * av.x - cv.y * av.y; v[j + 1] = -(cv.x * av.y + cv.y * av.x); } }
        else { const int jj = (k8 - 128) >> 4, c2 = (k8 - 128) & 15;
#pragma unroll
            for (int j = 0; j < 8; ++j) { float x = 0.f; if (jj <= i) { x = Kt[(i - jj) * 256 + c * 16 + c2 + j]; if (jj == i && c == c2 + j) x += dsk[c]; } v[j] = x; } }
        u32x4 o; o.x = pk2(v[0], v[1]); o.y = pk2(v[2], v[3]); o.z = pk2(v[4], v[5]); o.w = pk2(v[6], v[7]);
        *(u32x4*)(wy + (size_t)n * S5ROW + k8) = o; }
    bf16* wsm = WSP(bf16, WS_WS) + (size_t)g * 256 * 512;
    for (int ch = F.tid; ch < 256 * 64; ch += 512) { const int n = ch >> 6, k8 = (ch & 63) * 8, jj = k8 >> 4, c2 = k8 & 15; float v[8];
#pragma unroll
        for (int j = 0; j < 8; ++j) { float x = 0.f; if (n < 128) { const int p = n >> 1; const f32x2 av = Ap[(S5L - 1 - jj) * 64 + p], bv = Bb[p * 16 + c2 + j]; x = (n & 1) ? (av.x * bv.y + av.y * bv.x) : (av.x * bv.x - av.y * bv.y); } v[j] = x; }
        u32x4 o; o.x = pk2(v[0], v[1]); o.y = pk2(v[2], v[3]); o.z = pk2(v[4], v[5]); o.w = pk2(v[6], v[7]);
        *(u32x4*)(wsm + (size_t)n * 512 + k8) = o; }
    __syncthreads();
}
__device__ __forceinline__ void p0_small_transposes(Frame& F) {
    LAS float* scr = (LAS float*)(F.lds + F.wave * 16384);
    const int gw = F.vcu * 8 + F.wave, NGW = F.G * 8;
    constexpr int I_IN = 16 * 144, I_RNN = 16 * 32, I_OUT = 16 * 32, I_GLU = 8 * 64, I_RG = 16 * 8;
    for (int it = gw; it < I_IN + I_RNN + I_OUT + I_GLU + I_RG; it += NGW) { int r = it;
        if (r < I_IN) { const int kb = r / 144, nb = r % 144; transpose_item(F.in[4], INC, kb * 64, nb * 32, WSP(bf16, WS_WIN), 1024, nb * 32, scr, F.lane); continue; } r -= I_IN;
        if (r < I_RNN) { const int kb = r / 32, nb = r % 32; transpose_item(F.in[13], 1024, kb * 64, nb * 32, WSP(bf16, WS_WRNN), 1024, nb * 32, scr, F.lane); continue; } r -= I_RNN;
        if (r < I_OUT) { const int kb = r / 32, nb = r % 32; transpose_item(F.in[23], 1024, kb * 64, nb * 32, WSP(bf16, WS_WOUT), 1024, nb * 32, scr, F.lane); continue; } r -= I_OUT;
        if (r < I_GLU) { const int kb = r / 64, nb = r % 64; transpose_item(F.in[22], 2048, kb * 64, nb * 32, WSP(bf16, WS_WGLU), 512, pair_row(nb * 32), scr, F.lane); continue; } r -= I_GLU;
        { const int mat = r >> 3, kb = (r >> 2) & 1, nb = r & 3, hd = mat & 7, gx = mat >> 3;
          transpose_item(F.in[gx ? 10 : 8] + (size_t)hd * 128 * 128, 128, kb * 64, nb * 32, WSP(bf16, WS_WG), 128, hd * 256 + gx * 128 + nb * 32, scr, F.lane); }
    }
}
__device__ __forceinline__ void p1_body(Frame& F) {
    const int gw = F.vcu * 8 + F.wave, NGW = F.G * 8; const float* mod = WSP(float, WS_MOD); bf16* hbf = WSP(bf16, WS_HBF);
    for (int t = gw; t < T; t += NGW) { const int b = t >> 12; const f32x4* xr = (const f32x4*)(F.in[0] + (size_t)t * 1024) + F.lane; const f32x4* sh = (const f32x4*)(mod + b * 6144) + F.lane; const f32x4* sc = (const f32x4*)(mod + b * 6144 + 1024) + F.lane;
        u32x2* o = (u32x2*)(hbf + (size_t)t * 1024) + F.lane;
#pragma unroll
        for (int j = 0; j < 4; ++j) { const f32x4 v = xr[64 * j] * (sc[64 * j] + 1.0f) + sh[64 * j]; u32x2 w; w.x = pk2(v[0], v[1]); w.y = pk2(v[2], v[3]); o[64 * j] = w; } }
    LAS float* scr = (LAS float*)(F.lds + F.wave * 16384);
    constexpr int I_GU = 16 * 64, I_D = 16 * 32;
    for (int it = gw; it < NE * (I_GU + I_D); it += NGW) { const int e = it / (I_GU + I_D); int r = it % (I_GU + I_D);
        if (r < I_GU) { const int kb = r / 64, nb = r % 64; transpose_item(F.in[28] + (size_t)e * 1024 * 2048, 2048, kb * 64, nb * 32, WSP(bf16, WS_WGU) + (size_t)e * 2048 * 1024, 1024, pair_row(nb * 32), scr, F.lane); }
        else { r -= I_GU; const int kb = r / 32, nb = r % 32; transpose_item(F.in[30] + (size_t)e * 1024 * 1024, 1024, kb * 64, nb * 32, WSP(bf16, WS_WD) + (size_t)e * 1024 * 1024, 1024, nb * 32, scr, F.lane); } }
}
constexpr int XR_LD = 136;
template <int PASS>
__device__ __forceinline__ void rglru_item(Frame& F, int item) {
    const int hd = item & 7, c = (item >> 3) & 31, b = item >> 8, t0 = b * SEQ + c * RGL;
    LAS bf16* xr = (LAS bf16*)F.lds;
    const bf16* xrnn = WSP(bf16, WS_XRNN); const float* cw = F.in[6]; const float* cb = F.in[7];
#pragma unroll
    for (int q = 0; q < 4; ++q) { const int idx = F.tid + q * 512, r = idx >> 4, c8 = (idx & 15) * 8, ch = hd * 128 + c8;
        f32x4 a0 = *(const f32x4*)(cb + ch), a1 = *(const f32x4*)(cb + ch + 4);
#pragma unroll
        for (int k = 0; k < 4; ++k) { const int tp = c * RGL + r - 3 + k;
            if (tp >= 0) { const u32x4 xw = *(const u32x4*)(xrnn + (size_t)(b * SEQ + tp) * 1024 + ch); f32x4 x0, x1; unpack8(xw, x0, x1);
                a0 += *(const f32x4*)(cw + k * 1024 + ch) * x0; a1 += *(const f32x4*)(cw + k * 1024 + ch + 4) * x1; } }
        *(LAS u32x4*)(xr + r * XR_LD + c8) = pack8(a0, a1); }
    __syncthreads();
    const int w = F.wave, q = F.lane >> 4, col = F.lane & 15, chl = 16 * w + col, ch = hd * 128 + chl;
    const bf16* wg = WSP(bf16, WS_WG) + (size_t)hd * 256 * 128;
    bf16x8 Bf[2][4];
#pragma unroll
    for (int gt = 0; gt < 2; ++gt)
#pragma unroll
        for (int kk = 0; kk < 4; ++kk) Bf[gt][kk] = *(const bf16x8*)(wg + (size_t)(gt * 128 + chl) * 128 + kk * 32 + q * 8);
    f32x4 acc[8][2];
#pragma unroll
    for (int m = 0; m < 8; ++m) { acc[m][0] = (f32x4){0.f, 0.f, 0.f, 0.f}; acc[m][1] = (f32x4){0.f, 0.f, 0.f, 0.f}; }
#pragma unroll
    for (int kk = 0; kk < 4; ++kk)
#pragma unroll
        for (int m = 0; m < 8; ++m) { const bf16x8 Af = *(const LAS bf16x8*)(xr + (16 * m + col) * XR_LD + kk * 32 + q * 8);
            acc[m][0] = __builtin_amdgcn_mfma_f32_16x16x32_bf16(Af, Bf[0][kk], acc[m][0], 0, 0, 0);
            acc[m][1] = __builtin_amdgcn_mfma_f32_16x16x32_bf16(Af, Bf[1][kk], acc[m][1], 0, 0, 0); }
    const float ba = F.in[9][ch], bx = F.in[11][ch], lam = F.in[12][ch];
    const float sp = (lam > 15.f) ? __expf(-lam) : log1pf(__expf(-lam));
    float carryH = 0.f, carryP = 1.f;
    if (PASS) carryH = WSP(float, WS_HIN)[(size_t)(b * RGC + c) * 1024 + ch];
    const bf16* gy = WSP(bf16, WS_GY); bf16* ha = WSP(bf16, WS_HA);
#pragma unroll
    for (int m = 0; m < 8; ++m) {
        float a[4], uu[4];
#pragma unroll
        for (int j = 0; j < 4; ++j) { const int tl = 16 * m + 4 * q + j;
            const float r = fast_sigmoid(acc[m][0][j] + ba), ii = fast_sigmoid(acc[m][1][j] + bx);
            const float la = -8.0f * r * sp; a[j] = __expf(la); const float mult = sqrtf(fmaxf(-expm1f(2.0f * la), 0.f));
            uu[j] = mult * ii * bf1(xr[tl * XR_LD + chl]); }
        float sP = a[0], sH = uu[0];
#pragma unroll
        for (int j = 1; j < 4; ++j) { sH = a[j] * sH + uu[j]; sP *= a[j]; }
        float iP = sP, iH = sH;
        { const float pP = __shfl_up(iP, 16), pH = __shfl_up(iH, 16); if (q >= 1) { iH = iP * pH + iH; iP = iP * pP; } }
        { const float pP = __shfl_up(iP, 32), pH = __shfl_up(iH, 32); if (q >= 2) { iH = iP * pH + iH; iP = iP * pP; } }
        float eP = __shfl_up(iP, 16), eH = __shfl_up(iH, 16); if (q == 0) { eP = 1.f; eH = 0.f; }
        const float tP = __shfl(iP, col + 48), tH = __shfl(iH, col + 48);
        if (PASS) { float h = eP * carryH + eH;
#pragma unroll
            for (int j = 0; j < 4; ++j) { const int tl = 16 * m + 4 * q + j; h = a[j] * h + uu[j];
                const size_t o = (size_t)(t0 + tl) * 1024 + ch; ha[o] = (bf16)f2bf(h * bf1(gy[o])); } }
        carryH = tP * carryH + tH; carryP *= tP;
    }
    if (!PASS && q == 0) { f32x2* ag = WSP(f32x2, WS_RGAGG); ag[(size_t)(b * RGC + c) * 1024 + ch] = (f32x2){carryP, carryH}; }
    __syncthreads();
}
__device__ __forceinline__ void p4_carries(Frame& F) {
    if (F.vcu < 32) {
        const int id = F.vcu * 512 + F.tid, p = id & 63, g = (id >> 6) & 31, b = id >> 11;
        const f32x2 al = WSP(f32x2, WS_AL)[g * 64 + p]; const f32x2* Sb = WSP(f32x2, WS_S) + ((size_t)(g * S5M + b * S5CPB)) * 64 + p; unsigned* ac = (unsigned*)(WSP(bf16, WS_ACAT) + ((size_t)(g * S5M + b * S5CPB)) * S5ROW) + p;
        float xr_ = 0.f, xi = 0.f;
#pragma unroll 16
        for (int m = 0; m < S5CPB; ++m) { ac[(size_t)m * (S5ROW / 2)] = pk2(xr_, xi); const f32x2 s = Sb[(size_t)m * 64];
            const float nr = al.x * xr_ - al.y * xi + s.x, ni = al.x * xi + al.y * xr_ + s.y; xr_ = nr; xi = ni; }
    } else if (F.vcu < 48) {
        const int id = (F.vcu - 32) * 512 + F.tid, ch = id & 1023, b = id >> 10; const f32x2* ag = WSP(f32x2, WS_RGAGG) + (size_t)b * RGC * 1024 + ch; float* hin = WSP(float, WS_HIN) + (size_t)b * RGC * 1024 + ch;
        float h = 0.f;
#pragma unroll 16
        for (int c = 0; c < RGC; ++c) { hin[(size_t)c * 1024] = h; const f32x2 a = ag[(size_t)c * 1024]; h = a.x * h + a.y; }
    }
}
constexpr int WR_LD = 1028;
__device__ __forceinline__ void p9_router(Frame& F) {
    LAS float* wrt = (LAS float*)F.lds;
    LAS unsigned* rec = (LAS unsigned*)(F.lds + 32 * WR_LD * 4);
    LAS float* recp = (LAS float*)(rec + 512);
    LAS int* lcnt = (LAS int*)(recp + 512);
    LAS int* gbase = lcnt + 32;
    const float* wr = F.in[26];
    for (int i = F.tid; i < 1024 * 32; i += 512) wrt[(i & 31) * WR_LD + (i >> 5)] = wr[i];
    if (F.tid < 32) lcnt[F.tid] = 0;
    __syncthreads();
    const float* mod = WSP(float, WS_MOD); const bf16* v1 = WSP(bf16, WS_V1); bf16* x1 = WSP(bf16, WS_X1); bf16* h2 = WSP(bf16, WS_H2);
    const int lane = F.lane;
    f32x4 lg[4], lb[4];
#pragma unroll
    for (int j = 0; j < 4; ++j) { lg[j] = *((const f32x4*)F.in[24] + 64 * j + lane); lb[j] = *((const f32x4*)F.in[25] + 64 * j + lane); }
    const float brt = F.in[27][lane >> 1];
    for (int blk = F.vcu; blk < T / 128; blk += F.G) {
        for (int it = 0; it < 16; ++it) { const int ti = F.wave * 16 + it, t = blk * 128 + ti, b = t >> 12;
            f32x4 v[4]; float s = 0.f;
#pragma unroll
            for (int j = 0; j < 4; ++j) { const u32x2 w = *((const u32x2*)(v1 + (size_t)t * 1024) + 64 * j + lane); v[j] = (f32x4){bflo(w.x), bfhi(w.x), bflo(w.y), bfhi(w.y)}; s += (v[j][0] + v[j][1]) + (v[j][2] + v[j][3]); }
            const float mean = wave_sum(s) * (1.f / 1024.f); float s2 = 0.f;
#pragma unroll
            for (int j = 0; j < 4; ++j) { v[j] = v[j] - mean; s2 += (v[j][0] * v[j][0] + v[j][1] * v[j][1]) + (v[j][2] * v[j][2] + v[j][3] * v[j][3]); }
            const float rstd = 1.f / sqrtf(wave_sum(s2) * (1.f / 1024.f) + LN_EPS);
            f32x4 hh[4];
#pragma unroll
            for (int j = 0; j < 4; ++j) { const f32x4 xv = v[j] * rstd * lg[j] + lb[j]; u32x2 w; w.x = pk2(xv[0], xv[1]); w.y = pk2(xv[2], xv[3]); *((u32x2*)(x1 + (size_t)t * 1024) + 64 * j + lane) = w;
                const f32x4 sh = *((const f32x4*)(mod + b * 6144 + 3072) + 64 * j + lane), sc = *((const f32x4*)(mod + b * 6144 + 4096) + 64 * j + lane);
                hh[j] = xv * (sc + 1.0f) + sh; u32x2 w2; w2.x = pk2(hh[j][0], hh[j][1]); w2.y = pk2(hh[j][2], hh[j][3]); *((u32x2*)(h2 + (size_t)t * 1024) + 64 * j + lane) = w2; }
            float lgt[32];
#pragma unroll
            for (int e = 0; e < 32; ++e) { float a = 0.f;
#pragma unroll
                for (int j = 0; j < 4; ++j) { const f32x4 wv = *((const LAS f32x4*)(wrt + e * WR_LD) + 64 * j + lane); a += (hh[j][0] * wv[0] + hh[j][1] * wv[1]) + (hh[j][2] * wv[2] + hh[j][3] * wv[3]); }
                lgt[e] = a; }
#pragma unroll
            for (int i = 0; i < 16; ++i) { const bool up = (lane & 32) != 0; const float send = up ? lgt[i] : lgt[i + 16], keep = up ? lgt[i + 16] : lgt[i]; lgt[i] = keep + __shfl_xor(send, 32); }
#pragma unroll
            for (int i = 0; i < 8; ++i) { const bool up = (lane & 16) != 0; const float send = up ? lgt[i] : lgt[i + 8], keep = up ? lgt[i + 8] : lgt[i]; lgt[i] = keep + __shfl_xor(send, 16); }
#pragma unroll
            for (int i = 0; i < 4; ++i) { const bool up = (lane & 8) != 0; const float send = up ? lgt[i] : lgt[i + 4], keep = up ? lgt[i + 4] : lgt[i]; lgt[i] = keep + __shfl_xor(send, 8); }
#pragma unroll
            for (int i = 0; i < 2; ++i) { const bool up = (lane & 4) != 0; const float send = up ? lgt[i] : lgt[i + 2], keep = up ? lgt[i + 2] : lgt[i]; lgt[i] = keep + __shfl_xor(send, 4); }
            { const bool up = (lane & 2) != 0; const float send = up ? lgt[0] : lgt[1], keep = up ? lgt[1] : lgt[0]; lgt[0] = keep + __shfl_xor(send, 2); }
            const float logit = lgt[0] + __shfl_xor(lgt[0], 1) + brt;
            int rank = 0; const int me = lane >> 1;
#pragma unroll
            for (int e = 0; e < 32; ++e) { const float o = __shfl(logit, 2 * e); rank += (o > logit || (o == logit && e < me)) ? 1 : 0; }
            float tv[4]; int te[4];
#pragma unroll
            for (int k = 0; k < 4; ++k) { const unsigned long long mk = __ballot(rank == k && (lane & 1) == 0); const int src = __builtin_ctzll(mk); te[k] = src >> 1; tv[k] = __shfl(logit, src); }
            float pe[4], ps = 0.f;
#pragma unroll
            for (int k = 0; k < 4; ++k) { pe[k] = __expf(tv[k] - tv[0]); ps += pe[k]; }
            if (lane < 4) { const int e = te[0] * (lane == 0) + te[1] * (lane == 1) + te[2] * (lane == 2) + te[3] * (lane == 3);
                const float p = (pe[0] * (lane == 0) + pe[1] * (lane == 1) + pe[2] * (lane == 2) + pe[3] * (lane == 3)) / ps;
                const int lr = __hip_atomic_fetch_add(lcnt + e, 1, __ATOMIC_RELAXED, __HIP_MEMORY_SCOPE_WORKGROUP); rec[ti * 4 + lane] = ((unsigned)e << 16) | (unsigned)lr; recp[ti * 4 + lane] = p; }
        }
        __syncthreads();
        if (F.tid < 32) { const int n = lcnt[F.tid]; gbase[F.tid] = n ? (int)atomicAdd(F.ctl + CW_CNT + 64 * F.tid, (unsigned)n) : 0; lcnt[F.tid] = 0; }
        __syncthreads();
        { const unsigned r = rec[F.tid]; const int e = r >> 16, rk = gbase[e] + (int)(r & 0xffffu), t = blk * 128 + (F.tid >> 2);
          WSP(int, WS_TOK)[(size_t)e * T + rk] = t; WSP(unsigned, WS_POS)[(size_t)t * 4 + (F.tid & 3)] = ((unsigned)e << 20) | (unsigned)rk; WSP(float, WS_PROB)[(size_t)t * 4 + (F.tid & 3)] = recp[F.tid]; }
        __syncthreads();
    }
}
__device__ __forceinline__ void p12_final(Frame& F) {
    moe_tables(F);
    const LAS int* tstart = (const LAS int*)(F.lds + TAB_OFF);
    const float* mod = WSP(float, WS_MOD); const bf16* x1 = WSP(bf16, WS_X1); const bf16* yb = WSP(bf16, WS_YB); const unsigned* pos = WSP(unsigned, WS_POS); const float* prob = WSP(float, WS_PROB);
    const int lane = F.lane, gw = F.vcu * 8 + F.wave, NGW = F.G * 8;
    f32x4 lg[4], lb[4];
#pragma unroll
    for (int j = 0; j < 4; ++j) { lg[j] = *((const f32x4*)F.in[32] + 64 * j + lane); lb[j] = *((const f32x4*)F.in[33] + 64 * j + lane); }
    for (int t = gw; t < T; t += NGW) { const int b = t >> 12;
        f32x4 f[4];
#pragma unroll
        for (int j = 0; j < 4; ++j) f[j] = (f32x4){0.f, 0.f, 0.f, 0.f};
#pragma unroll
        for (int k = 0; k < 4; ++k) { const unsigned pp = pos[(size_t)t * 4 + k]; const float pw = prob[(size_t)t * 4 + k]; const int e = pp >> 20, rk = pp & 0xfffffu; const size_t slot = (size_t)tstart[e] * 256 + rk;
#pragma unroll
            for (int j = 0; j < 4; ++j) { const u32x2 w = *((const u32x2*)(yb + slot * 1024) + 64 * j + lane); f[j] += (f32x4){bflo(w.x), bfhi(w.x), bflo(w.y), bfhi(w.y)} * pw; } }
        f32x4 v[4]; float s = 0.f;
#pragma unroll
        for (int j = 0; j < 4; ++j) { const u32x2 w = *((const u32x2*)(x1 + (size_t)t * 1024) + 64 * j + lane); const f32x4 g2 = *((const f32x4*)(mod + b * 6144 + 5120) + 64 * j + lane) + 1.0f;
            v[j] = (f32x4){bflo(w.x), bfhi(w.x), bflo(w.y), bfhi(w.y)} * DN_ALPHA + g2 * f[j]; s += (v[j][0] + v[j][1]) + (v[j][2] + v[j][3]); }
        const float mean = wave_sum(s) * (1.f / 1024.f); float s2 = 0.f;
#pragma unroll
        for (int j = 0; j < 4; ++j) { v[j] = v[j] - mean; s2 += (v[j][0] * v[j][0] + v[j][1] * v[j][1]) + (v[j][2] * v[j][2] + v[j][3] * v[j][3]); }
        const float rstd = 1.f / sqrtf(wave_sum(s2) * (1.f / 1024.f) + LN_EPS);
#pragma unroll
        for (int j = 0; j < 4; ++j) *((f32x4*)(F.out + (size_t)t * 1024) + 64 * j + lane) = v[j] * rstd * lg[j] + lb[j];
    }
}

struct Args { const float* in[34]; float* out; unsigned char* ws; int ph_lo, ph_hi; };
__global__ void __launch_bounds__(512, 2) fwd_kernel(Args args) {
    extern __shared__ __attribute__((aligned(16))) unsigned char lds_raw[];
    Frame F;
    F.lds = (LAS unsigned char*)lds_raw; F.MISC = (volatile LAS unsigned*)(F.lds + MISC_OFF);
    F.tid = threadIdx.x; F.lane = F.tid & 63; F.wave = __builtin_amdgcn_readfirstlane(F.tid >> 6);
    F.G = gridDim.x; { const int bx = blockIdx.x; F.vcu = (F.G % 8 == 0) ? (bx % 8) * (F.G / 8) + bx / 8 : bx; }
#pragma unroll
    for (int i = 0; i < 34; ++i) F.in[i] = args.in[i];
    F.out = args.out; F.ws = args.ws; F.ctl = (unsigned*)(args.ws + WS_CTL);
    if (F.tid < 64) F.MISC[F.tid] = 0u;
    __syncthreads();
    XcdBarrier bar; bar.bar = F.ctl + CW_BAR; bar.x = 0; bar.st = nullptr;
    if (MK_N_LAUNCHES == 1) bar = xcd_barrier_post(F.ctl + CW_BAR, F.MISC + 8);
    const int lo = args.ph_lo, hi = args.ph_hi;
#define IN(k) (lo <= (k) && (k) < hi)
#define SEAM(k) do { if (IN(k) && IN((k) + 1)) xcd_barrier(bar); } while (0)

    if (IN(0)) {
        if (F.vcu < 192) p0_mod_job(F, F.vcu); else if (F.vcu < 224) p0_s5_job(F, F.vcu - 192);
        for (int j = F.vcu + F.G; j < 224; j += F.G) { if (j < 192) p0_mod_job(F, j); else p0_s5_job(F, j - 192); }
        p0_small_transposes(F);
    }
    SEAM(0);
    if (IN(1)) p1_body(F);
    SEAM(1);
    if (IN(2)) {
        g8::GridOrder S; S.init(T, INC, F.G, (int)blockIdx.x, WSP(bf16, WS_HBF), WSP(bf16, WS_WIN), 1024, 1024);
        EpiInProj E{F.in[5], WSP(bf16, WS_XRNN), WSP(bf16, WS_GY), WSP(bf16, WS_ACAT), WSP(bf16, WS_GATES)};
        g8::gemm_phase<EpiInProj, g8::GridOrder, false>(F.lds, 1024, 1024, 1024, S, E);
    }
    SEAM(2);
    if (IN(3)) {
        { S5AOrder S{F.G, F.vcu, (const char*)WSP(bf16, WS_ACAT), (const char*)WSP(bf16, WS_WS)}; EpiS5A E{WSP(float, WS_S)};
          g8::gemm_phase<EpiS5A, S5AOrder, false>(F.lds, S5L * 16, S5ROW, S5L * 16, S, E); }
        __syncthreads();
        for (int it = F.vcu; it < NB * RGC * 8; it += F.G) rglru_item<0>(F, it);
    }
    SEAM(3);
    if (IN(4)) p4_carries(F);
    SEAM(4);
    if (IN(5)) {
        { S5COrder S{F.G, F.vcu, (const char*)WSP(bf16, WS_ACAT), (const char*)WSP(bf16, WS_WY)}; EpiS5C E{WSP(bf16, WS_YS)};
          g8::gemm_phase<EpiS5C, S5COrder, false>(F.lds, S5ROW, S5ROW, S5ROW, S, E); }
        __syncthreads();
        for (int it = F.vcu; it < NB * RGC * 8; it += F.G) rglru_item<1>(F, it);
    }
    SEAM(5);
    if (IN(6)) {
        g8::GridOrder S; S.init(T, 2048, F.G, (int)blockIdx.x, WSP(bf16, WS_YS), WSP(bf16, WS_WGLU), 512, 512);
        EpiGlu E{WSP(bf16, WS_GATES), WSP(bf16, WS_GB)};
        g8::gemm_phase<EpiGlu, g8::GridOrder, false>(F.lds, 512, 512, 512, S, E);
    }
    SEAM(6);
    if (IN(7)) {
        g8::GridOrder S; S.init(T, 1024, F.G, (int)blockIdx.x, WSP(bf16, WS_HA), WSP(bf16, WS_WRNN), 1024, 1024);
        EpiRnn E{WSP(bf16, WS_GATES), WSP(bf16, WS_GB), WSP(bf16, WS_MERGED)};
        g8::gemm_phase<EpiRnn, g8::GridOrder, false>(F.lds, 1024, 1024, 1024, S, E);
    }
    SEAM(7);
    if (IN(8)) {
        g8::GridOrder S; S.init(T, 1024, F.G, (int)blockIdx.x, WSP(bf16, WS_MERGED), WSP(bf16, WS_WOUT), 1024, 1024);
        EpiOut E{F.in[0], WSP(float, WS_MOD), WSP(bf16, WS_V1)};
        g8::gemm_phase<EpiOut, g8::GridOrder, false>(F.lds, 1024, 1024, 1024, S, E);
    }
    SEAM(8);
    if (IN(9)) p9_router(F);
    SEAM(9);
    if (IN(10)) {
        moe_tables(F);
        const LAS int* tstart = (const LAS int*)(F.lds + TAB_OFF);
        MoeOrder S{F.G, (int)blockIdx.x, 8, tstart[NE], tstart, tstart + 40, WSP(int, WS_TOK), (const char*)WSP(bf16, WS_H2), (const char*)WSP(bf16, WS_WGU), (size_t)2048 * 1024 * 2, 1024, true};
        EpiMoe1 E{F.in[29], WSP(bf16, WS_ACT)};
        g8::gemm_phase<EpiMoe1, MoeOrder, true>(F.lds, 1024, 1024, 1024, S, E);
    }
    SEAM(10);
    if (IN(11)) {
        moe_tables(F);
        const LAS int* tstart = (const LAS int*)(F.lds + TAB_OFF);
        MoeOrder S{F.G, (int)blockIdx.x, 4, tstart[NE], tstart, tstart + 40, WSP(int, WS_TOK), (const char*)WSP(bf16, WS_ACT), (const char*)WSP(bf16, WS_WD), (size_t)1024 * 1024 * 2, 1024, false};
        EpiMoe2 E{F.in[31], WSP(bf16, WS_YB)};
        g8::gemm_phase<EpiMoe2, MoeOrder, false>(F.lds, 1024, 1024, 1024, S, E);
    }
    SEAM(11);
    if (IN(12)) p12_final(F);
#undef IN
#undef SEAM
}

extern "C" void kernel_launch(void* const* d_in, const int* in_sizes, int n_in, void* d_out, int out_size, void* d_ws, size_t ws_size, hipStream_t stream) {
    static int grid = 0;
    if (grid == 0) {
        if (n_in != 34 || in_sizes[0] != T * D || out_size != T * D || ws_size < WS_END) { fprintf(stderr, "kernel_launch: unexpected shapes (n_in %d, ws %zu < %zu)\n", n_in, ws_size, (size_t)WS_END); grid = -1; return; }
        int dev = 0, cus = 0;
        if (hipGetDevice(&dev) != hipSuccess || hipDeviceGetAttribute(&cus, hipDeviceAttributeMultiprocessorCount, dev) != hipSuccess) { grid = -1; return; }
        if (hipFuncSetAttribute((const void*)fwd_kernel, hipFuncAttributeMaxDynamicSharedMemorySize, LDS_BYTES) != hipSuccess) { fprintf(stderr, "kernel_launch: hipFuncSetAttribute failed\n"); grid = -1; return; }
        int per_cu = 0; (void)hipOccupancyMaxActiveBlocksPerMultiprocessor(&per_cu, (const void*)fwd_kernel, 512, LDS_BYTES); (void)hipGetLastError();
        grid = cus;
    }
    if (grid < 0) return;
    (void)hipMemsetAsync((char*)d_ws + WS_CTL, 0, CTL_BYTES, stream);
    Args a{};
    for (int i = 0; i < 34; ++i) a.in[i] = (const float*)d_in[i];
    a.out = (float*)d_out; a.ws = (unsigned char*)d_ws;
    if (MK_N_LAUNCHES == 1) { a.ph_lo = 0; a.ph_hi = N_PHASES; hipLaunchKernelGGL(fwd_kernel, dim3(grid), dim3(512), LDS_BYTES, stream, a); }
    else for (int p = 0; p < N_PHASES; ++p) { a.ph_lo = p; a.ph_hi = p + 1; hipLaunchKernelGGL(fwd_kernel, dim3(grid), dim3(512), LDS_BYTES, stream, a); }
}
```

```cpp
#include <hip/hip_runtime.h>
#include <cstdio>
#include <cstdint>

#ifndef MK_N_LAUNCHES
#define MK_N_LAUNCHES 1
#endif
constexpr int N_PHASES = 13;
#ifndef DUP_PHASE
#define DUP_PHASE -1
#endif
#define REPS(k) for (int rep_ = 0; rep_ < ((DUP_PHASE == (k)) ? 2 : 1); ++rep_)

#define GAS __attribute__((address_space(1)))
#define LAS __attribute__((address_space(3)))
typedef unsigned short bf16;
typedef short bf16x8 __attribute__((ext_vector_type(8)));
typedef float f32x4 __attribute__((ext_vector_type(4)));
typedef float f32x2 __attribute__((ext_vector_type(2)));
typedef unsigned u32x4 __attribute__((ext_vector_type(4)));
typedef unsigned u32x2 __attribute__((ext_vector_type(2)));
typedef GAS unsigned gu32;

constexpr int NB = 8, SEQ = 4096, T = NB * SEQ, D = 1024, INC = 4608, NE = 32, DFF = 1024;
constexpr int S5L = 32, S5G = 32, S5ROW = 128 + S5L * 16  , S5M = T / S5L  , S5CPB = SEQ / S5L  ;
constexpr int RGL = 128, RGC = SEQ / RGL  ;
constexpr float LN_EPS = 1e-5f, DN_ALPHA = 1.189207115002721f;
constexpr int ACT_ROWS = T * 4 + NE * 256;

constexpr size_t MiB = 1u << 20;
constexpr size_t WS_XRNN = 0, WS_GY = 64 * MiB, WS_GATES = 128 * MiB, WS_V1 = 0, WS_ACT = 0;
constexpr size_t WS_HBF = 272 * MiB, WS_HA = 272 * MiB, WS_YS = 336 * MiB, WS_GB = 368 * MiB, WS_MERGED = 432 * MiB, WS_ACAT = 496 * MiB, WS_YB = 272 * MiB;
constexpr size_t WS_X1 = 544 * MiB, WS_H2 = 608 * MiB;
constexpr size_t WS_WGU = 672 * MiB, WS_WD = 800 * MiB, WS_WIN = 864 * MiB, WS_WG = 873 * MiB, WS_WRNN = 874 * MiB, WS_WGLU = 876 * MiB, WS_WOUT = 878 * MiB;
constexpr size_t WS_WS = 880 * MiB, WS_WY = 888 * MiB, WS_S = 908 * MiB;
constexpr size_t WS_MOD = 924 * MiB, WS_AL = 925 * MiB, WS_RGAGG = 926 * MiB, WS_HIN = 928 * MiB, WS_TOK = 929 * MiB, WS_POS = 933 * MiB, WS_PROB = 934 * MiB, WS_CTL = 935 * MiB;
constexpr size_t WS_END = 936 * MiB, CTL_BYTES = 1 * MiB;
static_assert((size_t)ACT_ROWS * DFF * 2 <= 272 * MiB, "act/yb size");
static_assert(WS_ACAT + (size_t)S5G * S5M * S5ROW * 2 <= WS_X1, "acat");
constexpr int CW_BAR = 4096, CW_CNT = 8192  ;

constexpr int LDS_BYTES = 147456, MISC_OFF = LDS_BYTES - 256, TAB_OFF = 131072 + 1024;

__device__ __forceinline__ unsigned f2bf(float f) { unsigned u = __builtin_bit_cast(unsigned, f); return (u + 0x7fffu + ((u >> 16) & 1u)) >> 16; }
typedef __bf16 bf16x2v __attribute__((ext_vector_type(2)));
__device__ __forceinline__ unsigned pk2(float lo, float hi) { const f32x2 v = {lo, hi}; const bf16x2v b = __builtin_convertvector(v, bf16x2v); return __builtin_bit_cast(unsigned, b); }
__device__ __forceinline__ float bflo(unsigned w) { return __builtin_bit_cast(float, w << 16); }
__device__ __forceinline__ float bfhi(unsigned w) { return __builtin_bit_cast(float, w & 0xffff0000u); }
__device__ __forceinline__ float bf1(bf16 h) { return __builtin_bit_cast(float, ((unsigned)h) << 16); }
__device__ __forceinline__ float fast_sigmoid(float x) { return __builtin_amdgcn_rcpf(1.0f + __builtin_amdgcn_exp2f(-1.4426950409f * x)); }
__device__ __forceinline__ float gelu_tanh(float x) { const float u = x + 0.044715f * x * x * x; return x * __builtin_amdgcn_rcpf(1.0f + __builtin_amdgcn_exp2f(-2.3022082f * u)); }
__device__ __forceinline__ float wave_sum(float v) {
#pragma unroll
    for (int o = 1; o < 64; o <<= 1) v += __shfl_xor(v, o);
    return v;
}
__device__ __forceinline__ u32x4 pack8(f32x4 a, f32x4 b) { u32x4 w; w.x = pk2(a[0], a[1]); w.y = pk2(a[2], a[3]); w.z = pk2(b[0], b[1]); w.w = pk2(b[2], b[3]); return w; }
__device__ __forceinline__ void unpack8(u32x4 w, f32x4& a, f32x4& b) { a = (f32x4){bflo(w.x), bfhi(w.x), bflo(w.y), bfhi(w.y)}; b = (f32x4){bflo(w.z), bfhi(w.z), bflo(w.w), bfhi(w.w)}; }

#define XB_TMO      128
#define XB_XCNT(j)  (256  + 64 * (j))
#define XB_XSUB(j)  (1280 + 64 * (j))
#define XB_XGEN(j)  (2304 + 64 * (j))
#define XB_TOP      3328
#define XB_TOPGEN   3392
#define XCD_BAR_WORDS 3456
#define XB_SPIN_CAP (1u << 18)
__device__ __forceinline__ unsigned xb_ld(unsigned* p)              { return __hip_atomic_load(p, __ATOMIC_RELAXED, __HIP_MEMORY_SCOPE_AGENT); }
__device__ __forceinline__ unsigned xb_add(unsigned* p, unsigned v) { return __hip_atomic_fetch_add(p, v, __ATOMIC_RELAXED, __HIP_MEMORY_SCOPE_AGENT); }
__device__ __forceinline__ unsigned xb_xcc_id() { return (unsigned)__builtin_amdgcn_s_getreg((3 << 11) | 20) & 0xFu; }
#define XB_SPIN(cond, bar) do { unsigned _sp = 0; while (cond) { __builtin_amdgcn_s_sleep(1); \
    if ((++_sp & 255u) == 0u) { if (xb_ld(&(bar)[XB_TMO])) break; if (_sp > XB_SPIN_CAP) { atomicAdd(&(bar)[XB_TMO], 1u); break; } } } } while (0)
struct XcdBarrier { unsigned* bar; unsigned x; volatile LAS unsigned* st; };
__device__ __forceinline__ XcdBarrier xcd_barrier_post(unsigned* bar, volatile LAS unsigned* st) {
    XcdBarrier b; b.bar = bar; b.x = xb_xcc_id(); b.st = st;
    if (threadIdx.x == 0) (void)xb_add(&bar[XB_XCNT(b.x)], 1u);
    return b;
}
__device__ __forceinline__ void xcd_barrier_complete(unsigned* bar, unsigned x, unsigned& nloc, unsigned& nx) {
    const unsigned G = gridDim.x * gridDim.y * gridDim.z;
    unsigned sum, cnt, mine, sp = 0u;
    for (;;) {
        sum = 0u; cnt = 0u; mine = 0u;
#pragma unroll
        for (unsigned j = 0; j < 16; ++j) { const unsigned c = xb_ld(&bar[XB_XCNT(j)]); sum += c; cnt += (c > 0u) ? 1u : 0u; mine = (j == x) ? c : mine; }
        if (sum == G) break;
        __builtin_amdgcn_s_sleep(1);
        if ((++sp & 255u) == 0u) { if (xb_ld(&bar[XB_TMO])) break; if (sp > XB_SPIN_CAP) { atomicAdd(&bar[XB_TMO], 1u); break; } }
    }
    nloc = mine > 0u ? mine : 1u; nx = cnt > 0u ? cnt : 1u;
}
__device__ __forceinline__ void xcd_barrier(const XcdBarrier& b) {
    asm volatile("s_waitcnt vmcnt(0)" ::: "memory");
    __syncthreads();
    if (threadIdx.x == 0) {
        unsigned* bar = b.bar;
        __builtin_amdgcn_s_waitcnt(0);
        unsigned nloc = b.st[0], nx = b.st[1];
        if (nloc == 0u) { xcd_barrier_complete(bar, b.x, nloc, nx); b.st[0] = nloc; b.st[1] = nx; }
        const unsigned old = xb_add(&bar[XB_XSUB(b.x)], 1u);
        const unsigned gen = old / nloc;
        if (old + 1u == (gen + 1u) * nloc) {
            __builtin_amdgcn_fence(__ATOMIC_RELEASE, "agent");
            asm volatile("s_waitcnt vmcnt(0)" ::: "memory");
            const unsigned og = xb_add(&bar[XB_TOP], 1u);
            const unsigned tg = og / nx;
            if (og + 1u == (tg + 1u) * nx) xb_add(&bar[XB_TOPGEN], 1u);
            else XB_SPIN(xb_ld(&bar[XB_TOPGEN]) == tg, bar);
            __builtin_amdgcn_fence(__ATOMIC_ACQUIRE, "agent");
            xb_add(&bar[XB_XGEN(b.x)], 1u);
            asm volatile("s_waitcnt vmcnt(0)" ::: "memory");
        } else {
            XB_SPIN(xb_ld(&bar[XB_XGEN(b.x)]) == gen, bar);
            __builtin_amdgcn_fence(__ATOMIC_ACQUIRE, "agent");
            asm volatile("s_waitcnt vmcnt(0)" ::: "memory");
        }
    }
    __syncthreads();
}

namespace g8 {
constexpr int BM = 256, BK = 64, HALF = 128, HTB = HALF * BK * 2, STAGE_BYTES = 8 * HTB;
__device__ __forceinline__ int lds_byte(int r, int c) { const int st = (r >> 4) * 2 + (c >> 5), rr = r & 15, cc = c & 31, ob = rr * 64 + cc * 2; return st * 1024 + (ob ^ (((ob >> 9) & 1) << 5)); }
__device__ __forceinline__ void stage_rc(int b, int& R, int& C) { const int st = b / 1024, sb = b % 1024, swz = sb ^ (((sb >> 9) & 1) << 5); R = (st >> 1) * 16 + swz / 64; C = (st & 1) * 32 + (swz % 64) / 2; }
__device__ __forceinline__ int perm32(int rho) { const int n = rho >> 4, i = rho & 15; return 8 * (i >> 2) + 4 * n + (i & 3); }

struct Unit { int pm, pn, z, rl; const char* A; const char* B; };

template <class Epi, class Sched, bool GATHER>
__device__ __forceinline__ void gemm_phase(LAS unsigned char* lds, const int K, const int lda, const int ldb, const Sched& S, const Epi& E) {
    const int tid = threadIdx.x, wid = __builtin_amdgcn_readfirstlane(tid >> 6), lane = tid & 63, wr = wid >> 2, wc = wid & 3, fr = lane & 15, fq = lane >> 4;
    const int nt = K / BK;
    unsigned voffB[2], cvo[2][2], nvo[2][2]; int Rr[2], Cc[2];
#pragma unroll
    for (int i = 0; i < 2; ++i) { int R, C; stage_rc(tid * 16 + i * 8192, R, C); const int Rb = (R & ~31) + perm32(R & 31);
        voffB[i] = (unsigned)(Rb * ldb + C) * 2u; Rr[i] = R; Cc[i] = C;
#pragma unroll
        for (int h = 0; h < 2; ++h) { cvo[h][i] = (unsigned)((h * HALF + R) * lda + C) * 2u; nvo[h][i] = cvo[h][i]; } }
    const size_t kstep = (size_t)(BK * 2);
    const size_t hstepB = (size_t)HALF * ldb * 2;
    const unsigned ldsw = (unsigned)wid * 1024u;
    const int aoff = lds_byte(wr * 64 + fr, fq * 8), boff = lds_byte(wc * 32 + fr, fq * 8);
#define G8_SA(b, h) (((b) * 2 + (h)) * HTB)
#define G8_SB(b, h) ((4 + (b) * 2 + (h)) * HTB)
#define G8_STGB(bufoff, gbase) do { _Pragma("unroll") for (int _i = 0; _i < 2; ++_i) \
        __builtin_amdgcn_global_load_lds((const unsigned*)((const char*)(gbase) + voffB[_i]), (LAS unsigned*)(lds + (bufoff) + ldsw + _i * 8192), 16, 0, 0); } while (0)
#define G8_STGA(bufoff, gbase, VO, h) do { _Pragma("unroll") for (int _i = 0; _i < 2; ++_i) \
        __builtin_amdgcn_global_load_lds((const unsigned*)((const char*)(gbase) + VO[h][_i]), (LAS unsigned*)(lds + (bufoff) + ldsw + _i * 8192), 16, 0, 0); } while (0)
#define G8_LDA(dst, b, h) do { _Pragma("unroll") for (int m = 0; m < 4; ++m) _Pragma("unroll") for (int k = 0; k < 2; ++k) dst[m][k] = *(const LAS bf16x8*)(lds + G8_SA(b, h) + aoff + m * 2048 + k * 1024); } while (0)
#define G8_LDB(dst, b, h) do { _Pragma("unroll") for (int n = 0; n < 2; ++n) _Pragma("unroll") for (int k = 0; k < 2; ++k) dst[n][k] = *(const LAS bf16x8*)(lds + G8_SB(b, h) + boff + n * 2048 + k * 1024); } while (0)
#define G8_MMA(ai, bj, At, Bt) do { __builtin_amdgcn_s_setprio(1); _Pragma("unroll") for (int m = 0; m < 4; ++m) _Pragma("unroll") for (int n = 0; n < 2; ++n) _Pragma("unroll") for (int k = 0; k < 2; ++k) \
        acc[ai][bj][m][n] = __builtin_amdgcn_mfma_f32_16x16x32_bf16(Bt[n][k], At[m][k], acc[ai][bj][m][n], 0, 0, 0); __builtin_amdgcn_s_setprio(0); } while (0)
#define G8_WAIT_V(n) asm volatile("s_waitcnt vmcnt(" #n ")" ::: "memory")
#define G8_WAIT_L(n) asm volatile("s_waitcnt lgkmcnt(" #n ")" ::: "memory")
#define G8_BAR __builtin_amdgcn_s_barrier()
#define G8_SCHED __builtin_amdgcn_sched_barrier(0)
    Unit cur, nxt; int ui = 0;
    if (!S.next(0, cur)) return;
    bool has_next = S.next(1, nxt);
    if constexpr (GATHER) { S.gather(cur, Rr, Cc, cvo); if (has_next) S.gather(nxt, Rr, Cc, nvo); else {
#pragma unroll
        for (int h = 0; h < 2; ++h)
#pragma unroll
            for (int i = 0; i < 2; ++i) nvo[h][i] = cvo[h][i]; } }
    f32x4 acc[2][2][4][2];
#pragma unroll
    for (int a = 0; a < 2; ++a)
#pragma unroll
        for (int b = 0; b < 2; ++b)
#pragma unroll
            for (int m = 0; m < 4; ++m)
#pragma unroll
                for (int n = 0; n < 2; ++n) acc[a][b][m][n] = (f32x4){0.f, 0.f, 0.f, 0.f};
    bf16x8 At[4][2], B0[2][2], B1[2][2];
    const char* cA = cur.A; const char* cB = cur.B;
    G8_STGB(G8_SB(0, 0), cB); G8_STGB(G8_SB(0, 1), cB + hstepB); G8_STGA(G8_SA(0, 0), cA, cvo, 0); G8_STGA(G8_SA(0, 1), cA, cvo, 1);
    if (wr == 1) G8_BAR;
    G8_WAIT_V(2); G8_BAR;
    G8_STGB(G8_SB(1, 0), cB + kstep); G8_STGA(G8_SA(1, 0), cA + kstep, cvo, 0); G8_STGB(G8_SB(1, 1), cB + hstepB + kstep);
    G8_WAIT_V(6); G8_BAR;
    for (;;) {
        const char* nA = has_next ? nxt.A : cA; const char* nB = has_next ? nxt.B : cB;
        for (int t = 0; t < nt; t += 2) {
            const bool last = (t == nt - 2);
            const char* a1 = cA + (size_t)(t + 1) * kstep;
            const char* a2 = last ? nA : cA + (size_t)(t + 2) * kstep; const char* b2 = last ? nB : cB + (size_t)(t + 2) * kstep;
            const char* a3 = a2 + kstep; const char* b3 = b2 + kstep;
            unsigned vo2[2][2];
#pragma unroll
            for (int h = 0; h < 2; ++h)
#pragma unroll
                for (int i = 0; i < 2; ++i) vo2[h][i] = (GATHER && last) ? nvo[h][i] : cvo[h][i];
            G8_LDB(B0, 0, 0); G8_LDB(B1, 0, 1); G8_SCHED; G8_LDA(At, 0, 0); G8_STGA(G8_SA(1, 1), a1, cvo, 1);
            G8_WAIT_V(8); G8_WAIT_L(0); G8_BAR; G8_MMA(0, 0, At, B0); G8_MMA(0, 1, At, B1); G8_BAR; G8_SCHED;
            G8_LDA(At, 0, 1); G8_STGB(G8_SB(0, 0), b2); G8_STGB(G8_SB(0, 1), b2 + hstepB); G8_STGA(G8_SA(0, 0), a2, vo2, 0);
            G8_WAIT_V(8); G8_WAIT_L(0); G8_BAR; G8_MMA(1, 0, At, B0); G8_MMA(1, 1, At, B1); G8_BAR; G8_SCHED;
            G8_LDB(B0, 1, 0); G8_LDB(B1, 1, 1); G8_SCHED; G8_LDA(At, 1, 0); G8_STGA(G8_SA(0, 1), a2, vo2, 1);
            G8_WAIT_V(8); G8_WAIT_L(0); G8_BAR; G8_MMA(0, 0, At, B0); G8_MMA(0, 1, At, B1); G8_BAR; G8_SCHED;
            G8_LDA(At, 1, 1); G8_STGB(G8_SB(1, 0), b3); G8_STGB(G8_SB(1, 1), b3 + hstepB); G8_STGA(G8_SA(1, 0), a3, vo2, 0);
            G8_WAIT_V(8); G8_WAIT_L(0); G8_BAR; G8_MMA(1, 0, At, B0); G8_MMA(1, 1, At, B1); G8_BAR; G8_SCHED;
        }
        if (wr == 0) G8_BAR;
        Unit nn; bool has_nn = false;
        if (has_next) has_nn = S.next(ui + 2, nn);
        unsigned nnvo[2][2];
        if constexpr (GATHER) { if (has_nn) S.gather(nn, Rr, Cc, nnvo); }
        E(acc, cur, wr, wc, fr, fq);
        if (!has_next) break;
#pragma unroll
        for (int a = 0; a < 2; ++a)
#pragma unroll
            for (int b = 0; b < 2; ++b)
#pragma unroll
                for (int m = 0; m < 4; ++m)
#pragma unroll
                    for (int n = 0; n < 2; ++n) acc[a][b][m][n] = (f32x4){0.f, 0.f, 0.f, 0.f};
        cur = nxt; cA = nA; cB = nB; ++ui;
        if constexpr (GATHER) {
#pragma unroll
            for (int h = 0; h < 2; ++h)
#pragma unroll
                for (int i = 0; i < 2; ++i) { cvo[h][i] = nvo[h][i]; if (has_nn) nvo[h][i] = nnvo[h][i]; } }
        nxt = nn; has_next = has_nn;
        if (wr == 1) G8_BAR;
    }
    G8_WAIT_V(0);
    G8_BAR;
#undef G8_SA
#undef G8_SB
#undef G8_STGB
#undef G8_STGA
#undef G8_LDA
#undef G8_LDB
#undef G8_MMA
#undef G8_WAIT_V
#undef G8_WAIT_L
#undef G8_BAR
#undef G8_SCHED
}

struct GridOrder {
    int nM, nN, nwg, G, c; const char* A; const char* B; size_t tstepA, tstepB;
    __device__ __forceinline__ void init(int M, int N, int G_, int c_, const void* A_, const void* B_, int lda, int ldb) { nM = M / BM; nN = N / BM; nwg = nM * nN; G = G_; c = c_; A = (const char*)A_; B = (const char*)B_; tstepA = (size_t)BM * lda * 2; tstepB = (size_t)BM * ldb * 2; }
    __device__ __forceinline__ bool next(int i, Unit& u) const {
        const long L = (long)i * G + c; if (L >= nwg) return false;
        int wgid = (int)L; { const int q = nwg / 8, r = nwg % 8, xcd = wgid % 8, off = wgid / 8; wgid = (xcd < r ? xcd * (q + 1) : r * (q + 1) + (xcd - r) * q) + off; }
        const int nig = 8 * nN, gid = wgid / nig, fm = gid * 8, gsz = (nM - fm) < 8 ? (nM - fm) : 8;
        u.pm = fm + ((wgid % nig) % gsz); u.pn = (wgid % nig) / gsz; u.z = 0; u.rl = 0;
        u.A = A + (size_t)u.pm * tstepA; u.B = B + (size_t)u.pn * tstepB; return true;
    }
};
}

struct Frame {
    LAS unsigned char* lds; volatile LAS unsigned* MISC; unsigned* ctl;
    int tid, lane, wave, vcu, G;
    const float* in[34]; float* out; unsigned char* ws;
};
#define WSP(T_, off) ((T_*)(F.ws + (off)))

struct EpiInProj {
    const float* bias; bf16 *xrnn, *gy, *acat, *gates;
    __device__ __forceinline__ void operator()(const f32x4 (&acc)[2][2][4][2], const g8::Unit& u, int wr, int wc, int fr, int fq) const {
        const int pn = u.pn, colb = pn * 256 + wc * 32 + 8 * fq;
        f32x4 bv[2][2];
#pragma unroll
        for (int bj = 0; bj < 2; ++bj)
#pragma unroll
            for (int n = 0; n < 2; ++n) bv[bj][n] = *(const f32x4*)(bias + colb + bj * 128 + 4 * n);
#pragma unroll
        for (int ai = 0; ai < 2; ++ai)
#pragma unroll
            for (int m = 0; m < 4; ++m) { const int t = u.pm * 256 + ai * 128 + wr * 64 + m * 16 + fr;
#pragma unroll
                for (int bj = 0; bj < 2; ++bj) { f32x4 v0 = acc[ai][bj][m][0] + bv[bj][0], v1 = acc[ai][bj][m][1] + bv[bj][1]; const int col = colb + bj * 128;
                    if (pn < 4) { *(u32x4*)(xrnn + (size_t)t * 1024 + col) = pack8(v0, v1); }
                    else if (pn < 8) {
#pragma unroll
                        for (int j = 0; j < 4; ++j) { v0[j] = gelu_tanh(v0[j]); v1[j] = gelu_tanh(v1[j]); }
                        *(u32x4*)(gy + (size_t)t * 1024 + (col - 1024)) = pack8(v0, v1); }
                    else if (pn < 10) { const int cu = col - 2048, g = cu >> 4, c = cu & 15;
                        *(u32x4*)(acat + ((size_t)(g * S5M + (t >> 5)) * S5ROW + 128 + (t & 31) * 16 + c)) = pack8(v0, v1); }
                    else {
#pragma unroll
                        for (int j = 0; j < 4; ++j) { v0[j] = fast_sigmoid(v0[j]); v1[j] = fast_sigmoid(v1[j]); }
                        *(u32x4*)(gates + (size_t)t * 2048 + (col - 2560)) = pack8(v0, v1); } } }
    }
};
struct EpiS5A {
    float* S;
    __device__ __forceinline__ void operator()(const f32x4 (&acc)[2][2][4][2], const g8::Unit& u, int wr, int wc, int fr, int fq) const {
        const int col = wc * 32 + 8 * fq;
#pragma unroll
        for (int ai = 0; ai < 2; ++ai)
#pragma unroll
            for (int m = 0; m < 4; ++m) { const int row = u.pm * 256 + ai * 128 + wr * 64 + m * 16 + fr; float* p = S + ((size_t)(u.z * S5M + row)) * 128 + col;
                *(f32x4*)p = acc[ai][0][m][0]; *(f32x4*)(p + 4) = acc[ai][0][m][1]; }
    }
};
struct EpiS5C {
    bf16* ys;
    __device__ __forceinline__ void operator()(const f32x4 (&acc)[2][2][4][2], const g8::Unit& u, int wr, int wc, int fr, int fq) const {
#pragma unroll
        for (int ai = 0; ai < 2; ++ai)
#pragma unroll
            for (int m = 0; m < 4; ++m) { const int row = u.pm * 256 + ai * 128 + wr * 64 + m * 16 + fr;
#pragma unroll
                for (int bj = 0; bj < 2; ++bj) { const int n = u.pn * 256 + bj * 128 + wc * 32 + 8 * fq, i = n >> 4, c = n & 15; f32x4 v0 = acc[ai][bj][m][0], v1 = acc[ai][bj][m][1];
#pragma unroll
                    for (int j = 0; j < 4; ++j) { v0[j] = gelu_tanh(v0[j]); v1[j] = gelu_tanh(v1[j]); }
                    *(u32x4*)(ys + (size_t)(row * 32 + i) * 512 + u.z * 16 + c) = pack8(v0, v1); } }
    }
};
struct EpiGlu {
    const bf16* gates; bf16* gb;
    __device__ __forceinline__ void operator()(const f32x4 (&acc)[2][2][4][2], const g8::Unit& u, int wr, int wc, int fr, int fq) const {
        const int f = u.pn * 128 + wc * 32 + 8 * fq;
#pragma unroll
        for (int ai = 0; ai < 2; ++ai)
#pragma unroll
            for (int m = 0; m < 4; ++m) { const int t = u.pm * 256 + ai * 128 + wr * 64 + m * 16 + fr;
                const u32x4 gw = *(const u32x4*)(gates + (size_t)t * 2048 + 1024 + f); f32x4 g0, g1; unpack8(gw, g0, g1);
                f32x4 v0 = acc[ai][0][m][0], v1 = acc[ai][0][m][1]; const f32x4 s0 = acc[ai][1][m][0], s1 = acc[ai][1][m][1];
#pragma unroll
                for (int j = 0; j < 4; ++j) { v0[j] = g0[j] * v0[j] * fast_sigmoid(s0[j]); v1[j] = g1[j] * v1[j] * fast_sigmoid(s1[j]); }
                *(u32x4*)(gb + (size_t)t * 1024 + f) = pack8(v0, v1); }
    }
};
struct EpiRnn {
    const bf16* gates; const bf16* gb; bf16* merged;
    __device__ __forceinline__ void operator()(const f32x4 (&acc)[2][2][4][2], const g8::Unit& u, int wr, int wc, int fr, int fq) const {
#pragma unroll
        for (int ai = 0; ai < 2; ++ai)
#pragma unroll
            for (int m = 0; m < 4; ++m) { const int t = u.pm * 256 + ai * 128 + wr * 64 + m * 16 + fr;
#pragma unroll
                for (int bj = 0; bj < 2; ++bj) { const int col = u.pn * 256 + bj * 128 + wc * 32 + 8 * fq;
                    const u32x4 gw = *(const u32x4*)(gates + (size_t)t * 2048 + col), bw = *(const u32x4*)(gb + (size_t)t * 1024 + col);
                    f32x4 g0, g1, b0, b1; unpack8(gw, g0, g1); unpack8(bw, b0, b1);
                    const f32x4 v0 = g0 * acc[ai][bj][m][0] + b0, v1 = g1 * acc[ai][bj][m][1] + b1;
                    *(u32x4*)(merged + (size_t)t * 1024 + col) = pack8(v0, v1); } }
    }
};
struct EpiOut {
    const float* x; const float* mod; bf16* v1;
    __device__ __forceinline__ void operator()(const f32x4 (&acc)[2][2][4][2], const g8::Unit& u, int wr, int wc, int fr, int fq) const {
        const int b = (u.pm * 256) >> 12;
#pragma unroll
        for (int bj = 0; bj < 2; ++bj) { const int col = u.pn * 256 + bj * 128 + wc * 32 + 8 * fq;
            const f32x4 ga = *(const f32x4*)(mod + b * 6144 + 2048 + col) + 1.0f, gb_ = *(const f32x4*)(mod + b * 6144 + 2048 + col + 4) + 1.0f;
#pragma unroll
            for (int ai = 0; ai < 2; ++ai)
#pragma unroll
                for (int m = 0; m < 4; ++m) { const int t = u.pm * 256 + ai * 128 + wr * 64 + m * 16 + fr;
                    const f32x4 x0 = *(const f32x4*)(x + (size_t)t * 1024 + col), x1 = *(const f32x4*)(x + (size_t)t * 1024 + col + 4);
                    const f32x4 v0 = x0 * DN_ALPHA + ga * acc[ai][bj][m][0], v1_ = x1 * DN_ALPHA + gb_ * acc[ai][bj][m][1];
                    *(u32x4*)(v1 + (size_t)t * 1024 + col) = pack8(v0, v1_); } }
    }
};
struct EpiMoe1 {
    const float* bgu; bf16* act;
    __device__ __forceinline__ void operator()(const f32x4 (&acc)[2][2][4][2], const g8::Unit& u, int wr, int wc, int fr, int fq) const {
        const int f = u.pn * 128 + wc * 32 + 8 * fq; const float* bp = bgu + (size_t)u.z * 2048 + f;
        const f32x4 bg0 = *(const f32x4*)bp, bg1 = *(const f32x4*)(bp + 4), bu0 = *(const f32x4*)(bp + 1024), bu1 = *(const f32x4*)(bp + 1028);
#pragma unroll
        for (int ai = 0; ai < 2; ++ai)
#pragma unroll
            for (int m = 0; m < 4; ++m) { const int row = u.pm * 256 + ai * 128 + wr * 64 + m * 16 + fr;
                f32x4 g0 = acc[ai][0][m][0] + bg0, g1 = acc[ai][0][m][1] + bg1, u0 = acc[ai][1][m][0] + bu0, u1 = acc[ai][1][m][1] + bu1;
#pragma unroll
                for (int j = 0; j < 4; ++j) { const float ga = fminf(g0[j], 7.0f), gb_ = fminf(g1[j], 7.0f), ua = fminf(fmaxf(u0[j], -7.0f), 7.0f), ub = fminf(fmaxf(u1[j], -7.0f), 7.0f);
                    g0[j] = ga * fast_sigmoid(1.702f * ga) * (ua + 1.0f); g1[j] = gb_ * fast_sigmoid(1.702f * gb_) * (ub + 1.0f); }
                *(u32x4*)(act + (size_t)row * 1024 + f) = pack8(g0, g1); }
    }
};
struct EpiMoe2 {
    const float* bd; bf16* yb;
    __device__ __forceinline__ void operator()(const f32x4 (&acc)[2][2][4][2], const g8::Unit& u, int wr, int wc, int fr, int fq) const {
#pragma unroll
        for (int bj = 0; bj < 2; ++bj) { const int col = u.pn * 256 + bj * 128 + wc * 32 + 8 * fq; const float* bp = bd + (size_t)u.z * 1024 + col;
            const f32x4 b0 = *(const f32x4*)bp, b1 = *(const f32x4*)(bp + 4);
#pragma unroll
            for (int ai = 0; ai < 2; ++ai)
#pragma unroll
                for (int m = 0; m < 4; ++m) { const int row = u.pm * 256 + ai * 128 + wr * 64 + m * 16 + fr;
                    *(u32x4*)(yb + (size_t)row * 1024 + col) = pack8(acc[ai][bj][m][0] + b0, acc[ai][bj][m][1] + b1); } }
    }
};

struct S5AOrder { int G, c; const char* acat; const char* ws;
    __device__ __forceinline__ bool next(int i, g8::Unit& u) const { const int L = i * G + c; if (L >= S5G * 4) return false; u.z = L >> 2; u.pm = L & 3; u.pn = 0; u.rl = 0;
        u.A = acat + ((size_t)(u.z * S5M + u.pm * 256) * S5ROW + 128) * 2; u.B = ws + (size_t)u.z * 256 * (S5L * 16) * 2; return true; } };
struct S5COrder { int G, c; const char* acat; const char* wy;
    __device__ __forceinline__ bool next(int i, g8::Unit& u) const { const int L = i * G + c; if (L >= S5G * 8) return false; u.z = L >> 3; u.pm = (L >> 1) & 3; u.pn = L & 1; u.rl = 0;
        u.A = acat + ((size_t)(u.z * S5M + u.pm * 256) * S5ROW) * 2; u.B = wy + ((size_t)(u.z * 512 + u.pn * 256) * S5ROW) * 2; return true; } };
struct MoeOrder { int G, c, NT, RT; const LAS int* tstart; const LAS int* cnt; const int* toklist; const char* A; const char* B; size_t bstride_e; int lda; bool gatherA;
    __device__ __forceinline__ bool next(int i, g8::Unit& u) const { const long L = (long)i * G + c; if (L >= (long)RT * NT) return false; const int rt = (int)(L / NT); u.pn = (int)(L % NT);
        int e = 0;
#pragma unroll 1
        for (int k = 1; k < NE; ++k) if (tstart[k] <= rt) e = k;
        u.z = e; u.pm = rt; u.rl = rt - tstart[e]; u.B = B + (size_t)e * bstride_e + (size_t)u.pn * 256 * 1024 * 2; u.A = gatherA ? A : A + (size_t)rt * 256 * 1024 * 2; return true; }
    __device__ __forceinline__ void gather(const g8::Unit& u, const int (&Rr)[2], const int (&Cc)[2], unsigned (&vo)[2][2]) const {
        const int n = cnt[u.z];
#pragma unroll
        for (int h = 0; h < 2; ++h)
#pragma unroll
            for (int i = 0; i < 2; ++i) { const int r = u.rl * 256 + h * 128 + Rr[i]; const int tok = r < n ? toklist[u.z * T + r] : 0; vo[h][i] = (unsigned)(tok * lda + Cc[i]) * 2u; } }
};

__device__ __forceinline__ void transpose_item(const float* W, int N, int k0, int n0, bf16* dst, int ldd, int drow0, LAS float* scr, int lane) {
#pragma unroll 8
    for (int i = 0; i < 32; ++i) { const int kk = 2 * i + (lane >> 5); scr[kk * 33 + (lane & 31)] = W[(size_t)(k0 + kk) * N + n0 + (lane & 31)]; }
    asm volatile("s_waitcnt lgkmcnt(0)" ::: "memory");
    const int c = lane & 7;
#pragma unroll
    for (int j = 0; j < 4; ++j) { const int n = (lane >> 3) + 8 * j; const LAS float* s = scr + (8 * c) * 33 + n;
        u32x4 o; o.x = pk2(s[0 * 33], s[1 * 33]); o.y = pk2(s[2 * 33], s[3 * 33]); o.z = pk2(s[4 * 33], s[5 * 33]); o.w = pk2(s[6 * 33], s[7 * 33]);
        *(u32x4*)(dst + (size_t)(drow0 + n) * ldd + k0 + 8 * c) = o; }
    asm volatile("s_waitcnt lgkmcnt(0)" ::: "memory");
}
__device__ __forceinline__ int pair_row(int n) { const int f = n & 1023, hi = n >> 10; return (f >> 7) * 256 + hi * 128 + (f & 127); }

__device__ __forceinline__ void moe_tables(Frame& F) {
    LAS int* tstart = (LAS int*)(F.lds + TAB_OFF); LAS int* cl = tstart + 40;
    if (F.tid == 0) { int acc = 0; for (int e = 0; e < NE; ++e) { const int c = (int)F.ctl[CW_CNT + 64 * e]; cl[e] = c; tstart[e] = acc; acc += (c + 255) >> 8; } tstart[NE] = acc; }
    __syncthreads();
}

__device__ __forceinline__ void p0_mod_job(Frame& F, int job) {
    LAS float* sc = (LAS float*)F.lds;
    LAS float* red = sc + 8 * 1024;
    const float* c = F.in[1]; const float* w = F.in[2]; const float* bias = F.in[3];
    for (int i = F.tid; i < 8 * 1024; i += 512) { const float v = c[i]; sc[i] = v * fast_sigmoid(v); }
    __syncthreads();
    const int col = F.tid & 31, kg = F.tid >> 5, j = job * 32 + col;
    float a[8];
#pragma unroll
    for (int b = 0; b < 8; ++b) a[b] = 0.f;
#pragma unroll 8
    for (int k = kg * 64; k < kg * 64 + 64; ++k) { const float wv = w[(size_t)k * 6144 + j];
#pragma unroll
        for (int b = 0; b < 8; ++b) a[b] += sc[b * 1024 + k] * wv; }
#pragma unroll
    for (int b = 0; b < 8; ++b) red[(kg * 8 + b) * 32 + col] = a[b];
    __syncthreads();
    if (F.tid < 256) { const int b = F.tid >> 5, cc = F.tid & 31; float s = 0.f;
#pragma unroll
        for (int g = 0; g < 16; ++g) s += red[(g * 8 + b) * 32 + cc];
        WSP(float, WS_MOD)[b * 6144 + job * 32 + cc] = s + bias[job * 32 + cc]; }
    __syncthreads();
}
__device__ __forceinline__ void s5_setup(Frame& F, int g, int kmin, int kmax, LAS f32x2* Bb, LAS f32x2* Cc, LAS f32x2* Ap) {
    const float* lre = F.in[14] + g * 64; const float* lim = F.in[15] + g * 64; const float dt = expf(F.in[16][g]);
    const float* bre = F.in[17] + g * 1024; const float* bim = F.in[18] + g * 1024; const float* cre = F.in[19] + g * 1024; const float* cim = F.in[20] + g * 1024;
    for (int i = F.tid; i < 1024; i += 512) { const int p = i >> 4; const float lr = lre[p], li = lim[p]; const float mag = expf(lr * dt); float sn, cs; sincosf(li * dt, &sn, &cs);
        const float ar = mag * cs, ai = mag * sn, den = lr * lr + li * li, qr = ((ar - 1.f) * lr + ai * li) / den, qi = (ai * lr - (ar - 1.f) * li) / den;
        const float br = bre[i], bi = bim[i]; Bb[i] = (f32x2){qr * br - qi * bi, qr * bi + qi * br};
        Cc[i] = (f32x2){cre[i], cim[i]}; }
    for (int i = kmin * 64 + F.tid; i < (kmax + 1) * 64; i += 512) { const int k = i >> 6, p = i & 63; const float lr = lre[p], li = lim[p]; const float mag = expf((float)k * lr * dt); float sn, cs; sincosf((float)k * li * dt, &sn, &cs);
        Ap[i] = (f32x2){mag * cs, mag * sn}; }
    __syncthreads();
}
constexpr size_t WS_KTAB = WS_S;
__device__ __forceinline__ void p0_s5k_job(Frame& F, int job) {
    const int g = job >> 3, part = job & 7;
    LAS f32x2* Bb = (LAS f32x2*)F.lds; LAS f32x2* Cc = Bb + 1024; LAS f32x2* Ap = Cc + 1024;
    s5_setup(F, g, 4 * part, 4 * part + 3, Bb, Cc, Ap);
    float* kt = WSP(float, WS_KTAB) + (size_t)g * 32 * 256;
    for (int e = 4 * part * 256 + F.tid; e < (4 * part + 4) * 256; e += 512) { const int k = e >> 8, c = (e >> 4) & 15, c2 = e & 15; float s = 0.f;
        for (int p = 0; p < 64; ++p) { const f32x2 cv = Cc[c * 64 + p], av = Ap[k * 64 + p], bv = Bb[p * 16 + c2];
            const float car = cv.x * av.x - cv.y * av.y, cai = cv.x * av.y + cv.y * av.x; s += car * bv.x - cai * bv.y; }
        kt[e] = s; }
    __syncthreads();
}
__device__ __forceinline__ void p1_s5w_job(Frame& F, int job) {
    const int g = job >> 3, part = job & 7;
    LAS f32x2* Bb = (LAS f32x2*)F.lds; LAS f32x2* Cc = Bb + 1024; LAS f32x2* Ap = Cc + 1024; LAS float* Kt = (LAS float*)(Ap + 33 * 64);
    const float* ktg = WSP(float, WS_KTAB) + (size_t)g * 32 * 256; const float* dsk = F.in[21] + g * 16;
    for (int i = F.tid; i < 32 * 256; i += 512) Kt[i] = ktg[i];
    s5_setup(F, g, 0, S5L, Bb, Cc, Ap);
    if (part == 0 && F.tid < 64) WSP(f32x2, WS_AL)[g * 64 + F.tid] = Ap[S5L * 64 + F.tid];
    bf16* wy = WSP(bf16, WS_WY) + (size_t)g * 512 * S5ROW;
    for (int ch = F.tid; ch < 64 * (S5ROW / 8); ch += 512) { const int n = part * 64 + ch / (S5ROW / 8), k8 = (ch % (S5ROW / 8)) * 8, i = n >> 4, c = n & 15; float v[8];
        if (k8 < 128) {
#pragma unroll
            for (int j = 0; j < 8; j += 2) { const int p = (k8 + j) >> 1; const f32x2 cv = Cc[c * 64 + p], av = Ap[(i + 1) * 64 + p]; v[j] = cv.x * av.x - cv.y * av.y; v[j + 1] = -(cv.x * av.y + cv.y * av.x); } }
        else { const int jj = (k8 - 128) >> 4, c2 = (k8 - 128) & 15;
#pragma unroll
            for (int j = 0; j < 8; ++j) { float x = 0.f; if (jj <= i) { x = Kt[(i - jj) * 256 + c * 16 + c2 + j]; if (jj == i && c == c2 + j) x += dsk[c]; } v[j] = x; } }
        u32x4 o; o.x = pk2(v[0], v[1]); o.y = pk2(v[2], v[3]); o.z = pk2(v[4], v[5]); o.w = pk2(v[6], v[7]);
        *(u32x4*)(wy + (size_t)n * S5ROW + k8) = o; }
    bf16* wsm = WSP(bf16, WS_WS) + (size_t)g * 256 * 512;
    for (int ch = F.tid; ch < 32 * 64; ch += 512) { const int n = part * 32 + (ch >> 6), k8 = (ch & 63) * 8, jj = k8 >> 4, c2 = k8 & 15; float v[8];
#pragma unroll
        for (int j = 0; j < 8; ++j) { float x = 0.f; if (n < 128) { const int p = n >> 1; const f32x2 av = Ap[(S5L - 1 - jj) * 64 + p], bv = Bb[p * 16 + c2 + j]; x = (n & 1) ? (av.x * bv.y + av.y * bv.x) : (av.x * bv.x - av.y * bv.y); } v[j] = x; }
        u32x4 o; o.x = pk2(v[0], v[1]); o.y = pk2(v[2], v[3]); o.z = pk2(v[4], v[5]); o.w = pk2(v[6], v[7]);
        *(u32x4*)(wsm + (size_t)n * 512 + k8) = o; }
    __syncthreads();
}
__device__ __forceinline__ void p0_small_transposes(Frame& F) {
    LAS float* scr = (LAS float*)(F.lds + F.wave * 16384);
    const int gw = F.vcu * 8 + F.wave, NGW = F.G * 8;
    constexpr int I_IN = 16 * 144, I_RNN = 16 * 32, I_OUT = 16 * 32, I_GLU = 8 * 64, I_RG = 16 * 8;
    for (int it = gw; it < I_IN + I_RNN + I_OUT + I_GLU + I_RG; it += NGW) { int r = it;
        if (r < I_IN) { const int kb = r / 144, nb = r % 144; transpose_item(F.in[4], INC, kb * 64, nb * 32, WSP(bf16, WS_WIN), 1024, nb * 32, scr, F.lane); continue; } r -= I_IN;
        if (r < I_RNN) { const int kb = r / 32, nb = r % 32; transpose_item(F.in[13], 1024, kb * 64, nb * 32, WSP(bf16, WS_WRNN), 1024, nb * 32, scr, F.lane); continue; } r -= I_RNN;
        if (r < I_OUT) { const int kb = r / 32, nb = r % 32; transpose_item(F.in[23], 1024, kb * 64, nb * 32, WSP(bf16, WS_WOUT), 1024, nb * 32, scr, F.lane); continue; } r -= I_OUT;
        if (r < I_GLU) { const int kb = r / 64, nb = r % 64; transpose_item(F.in[22], 2048, kb * 64, nb * 32, WSP(bf16, WS_WGLU), 512, pair_row(nb * 32), scr, F.lane); continue; } r -= I_GLU;
        { const int mat = r >> 3, kb = (r >> 2) & 1, nb = r & 3, hd = mat & 7, gx = mat >> 3;
          transpose_item(F.in[gx ? 10 : 8] + (size_t)hd * 128 * 128, 128, kb * 64, nb * 32, WSP(bf16, WS_WG), 128, hd * 256 + gx * 128 + nb * 32, scr, F.lane); }
    }
}
__device__ __forceinline__ void p1_body(Frame& F) {
    const int gw = F.vcu * 8 + F.wave, NGW = F.G * 8; const float* mod = WSP(float, WS_MOD); bf16* hbf = WSP(bf16, WS_HBF);
    for (int t = gw; t < T; t += NGW) { const int b = t >> 12; const f32x4* xr = (const f32x4*)(F.in[0] + (size_t)t * 1024) + F.lane; const f32x4* sh = (const f32x4*)(mod + b * 6144) + F.lane; const f32x4* sc = (const f32x4*)(mod + b * 6144 + 1024) + F.lane;
        u32x2* o = (u32x2*)(hbf + (size_t)t * 1024) + F.lane;
#pragma unroll
        for (int j = 0; j < 4; ++j) { const f32x4 v = xr[64 * j] * (sc[64 * j] + 1.0f) + sh[64 * j]; u32x2 w; w.x = pk2(v[0], v[1]); w.y = pk2(v[2], v[3]); o[64 * j] = w; } }
    LAS float* scr = (LAS float*)(F.lds + F.wave * 16384);
    constexpr int I_GU = 16 * 64, I_D = 16 * 32;
    for (int it = gw; it < NE * (I_GU + I_D); it += NGW) { const int e = it / (I_GU + I_D); int r = it % (I_GU + I_D);
        if (r < I_GU) { const int kb = r / 64, nb = r % 64; transpose_item(F.in[28] + (size_t)e * 1024 * 2048, 2048, kb * 64, nb * 32, WSP(bf16, WS_WGU) + (size_t)e * 2048 * 1024, 1024, pair_row(nb * 32), scr, F.lane); }
        else { r -= I_GU; const int kb = r / 32, nb = r % 32; transpose_item(F.in[30] + (size_t)e * 1024 * 1024, 1024, kb * 64, nb * 32, WSP(bf16, WS_WD) + (size_t)e * 1024 * 1024, 1024, nb * 32, scr, F.lane); } }
}
constexpr int XR_LD = 136, XR_TILE = 128 * XR_LD;
__device__ __forceinline__ void rg_issue(const bf16* xrnn, const bf16* gy, int item, int tid, u32x4 (&xraw)[4][4], u32x4 (&graw)[4], bool pass1) {
    const int hd = item & 7, c = (item >> 3) & 31, b = item >> 8, r0 = tid >> 4, ch = hd * 128 + (tid & 15) * 8;
#pragma unroll
    for (int q = 0; q < 4; ++q) { const int r = r0 + 32 * q;
#pragma unroll
        for (int k = 0; k < 4; ++k) { const int tp = c * RGL + r - 3 + k, tpc = tp < 0 ? 0 : tp; xraw[q][k] = *(const u32x4*)(xrnn + (size_t)(b * SEQ + tpc) * 1024 + ch); }
        if (pass1) graw[q] = *(const u32x4*)(gy + (size_t)(b * SEQ + c * RGL + r) * 1024 + ch); }
}
__device__ __forceinline__ void rg_convwrite(const float* cw, const float* cb, int item, int tid, const u32x4 (&xraw)[4][4], const u32x4 (&graw)[4], LAS bf16* xr, LAS bf16* gyt, bool pass1) {
    const int hd = item & 7, c = (item >> 3) & 31, r0 = tid >> 4, c8 = (tid & 15) * 8, ch = hd * 128 + c8;
    const f32x4 b0 = *(const f32x4*)(cb + ch), b1 = *(const f32x4*)(cb + ch + 4);
    f32x4 w0[4], w1[4];
#pragma unroll
    for (int k = 0; k < 4; ++k) { w0[k] = *(const f32x4*)(cw + k * 1024 + ch); w1[k] = *(const f32x4*)(cw + k * 1024 + ch + 4); }
#pragma unroll
    for (int q = 0; q < 4; ++q) { const int r = r0 + 32 * q; f32x4 a0 = b0, a1 = b1;
#pragma unroll
        for (int k = 0; k < 4; ++k) { const int tp = c * RGL + r - 3 + k; f32x4 x0, x1; unpack8(xraw[q][k], x0, x1); if (tp < 0) { x0 = (f32x4){0.f, 0.f, 0.f, 0.f}; x1 = x0; } a0 += w0[k] * x0; a1 += w1[k] * x1; }
        *(LAS u32x4*)(xr + r * XR_LD + c8) = pack8(a0, a1);
        if (pass1) *(LAS u32x4*)(gyt + r * XR_LD + c8) = graw[q]; }
}
template <int PASS>
__device__ __forceinline__ void rglru_phase(Frame& F) {
    const int NIT = NB * RGC * 8;
    int it = F.vcu; if (it >= NIT) return;
    LAS bf16* xr = (LAS bf16*)F.lds; LAS bf16* gyt0 = xr + XR_TILE;
    const bf16* xrnn = WSP(bf16, WS_XRNN); const bf16* gy = WSP(bf16, WS_GY); bf16* ha = WSP(bf16, WS_HA); const float* cw = F.in[6]; const float* cb = F.in[7];
    const int tid = F.tid, w = F.wave, q = F.lane >> 4, col = F.lane & 15, chl = 16 * w + col;
    u32x4 xraw[4][4], graw[4];
    rg_issue(xrnn, gy, it, tid, xraw, graw, PASS);
    rg_convwrite(cw, cb, it, tid, xraw, graw, xr, gyt0, PASS);
    int hd_loaded = -1; bf16x8 Bf[2][4]; float ba = 0.f, bx = 0.f, sp = 0.f;
    __syncthreads();
    for (int i = 0; it < NIT; ++i) {
        const int nit = it + F.G; const bool has_next = nit < NIT;
        const int hd = it & 7, c = (it >> 3) & 31, b = it >> 8, t0 = b * SEQ + c * RGL, ch = hd * 128 + chl;
        LAS bf16* gyt = gyt0 + (i & 1) * XR_TILE; LAS bf16* gytn = gyt0 + ((i & 1) ^ 1) * XR_TILE;
        if (has_next) rg_issue(xrnn, gy, nit, tid, xraw, graw, PASS);
        if (hd != hd_loaded) { hd_loaded = hd; const bf16* wg = WSP(bf16, WS_WG) + (size_t)hd * 256 * 128;
#pragma unroll
            for (int gt = 0; gt < 2; ++gt)
#pragma unroll
                for (int kk = 0; kk < 4; ++kk) Bf[gt][kk] = *(const bf16x8*)(wg + (size_t)(gt * 128 + chl) * 128 + kk * 32 + q * 8);
            ba = F.in[9][ch]; bx = F.in[11][ch]; const float lam = F.in[12][ch]; sp = (lam > 15.f) ? __expf(-lam) : log1pf(__expf(-lam)); }
        float carryH = 0.f, carryP = 1.f;
        if (PASS) carryH = WSP(float, WS_HIN)[(size_t)(b * RGC + c) * 1024 + ch];
        __builtin_amdgcn_sched_barrier(0);
        f32x4 acc[8][2];
#pragma unroll
        for (int m = 0; m < 8; ++m) { acc[m][0] = (f32x4){0.f, 0.f, 0.f, 0.f}; acc[m][1] = (f32x4){0.f, 0.f, 0.f, 0.f}; }
#pragma unroll
        for (int kk = 0; kk < 4; ++kk)
#pragma unroll
            for (int m = 0; m < 8; ++m) { const bf16x8 Af = *(const LAS bf16x8*)(xr + (16 * m + col) * XR_LD + kk * 32 + q * 8);
                acc[m][0] = __builtin_amdgcn_mfma_f32_16x16x32_bf16(Af, Bf[0][kk], acc[m][0], 0, 0, 0);
                acc[m][1] = __builtin_amdgcn_mfma_f32_16x16x32_bf16(Af, Bf[1][kk], acc[m][1], 0, 0, 0); }
#pragma unroll
        for (int m = 0; m < 8; ++m) {
            float a[4], uu[4];
#pragma unroll
            for (int j = 0; j < 4; ++j) { const int tl = 16 * m + 4 * q + j;
                const float r = fast_sigmoid(acc[m][0][j] + ba), ii = fast_sigmoid(acc[m][1][j] + bx);
                const float la = -11.541560327f * r * sp; a[j] = __builtin_amdgcn_exp2f(la); const float mult = __builtin_amdgcn_sqrtf(fmaxf(1.0f - a[j] * a[j], 0.f));
                uu[j] = mult * ii * bf1(xr[tl * XR_LD + chl]); }
            float sP = a[0], sH = uu[0];
#pragma unroll
            for (int j = 1; j < 4; ++j) { sH = a[j] * sH + uu[j]; sP *= a[j]; }
            float iP = sP, iH = sH;
            { const float pP = __shfl_up(iP, 16), pH = __shfl_up(iH, 16); if (q >= 1) { iH = iP * pH + iH; iP = iP * pP; } }
            { const float pP = __shfl_up(iP, 32), pH = __shfl_up(iH, 32); if (q >= 2) { iH = iP * pH + iH; iP = iP * pP; } }
            float eP = __shfl_up(iP, 16), eH = __shfl_up(iH, 16); if (q == 0) { eP = 1.f; eH = 0.f; }
            const float tP = __shfl(iP, col + 48), tH = __shfl(iH, col + 48);
            if (PASS) { float h = eP * carryH + eH;
#pragma unroll
                for (int j = 0; j < 4; ++j) { const int tl = 16 * m + 4 * q + j; h = a[j] * h + uu[j]; LAS bf16* gp = gyt + tl * XR_LD + chl; *gp = (bf16)f2bf(h * bf1(*gp)); } }
            carryH = tP * carryH + tH; carryP *= tP;
        }
        if (!PASS && q == 0) { f32x2* ag = WSP(f32x2, WS_RGAGG); ag[(size_t)(b * RGC + c) * 1024 + ch] = (f32x2){carryP, carryH}; }
        __syncthreads();
        if (PASS) { const int r0 = tid >> 4, c8 = (tid & 15) * 8;
#pragma unroll
            for (int qq = 0; qq < 4; ++qq) { const int r = r0 + 32 * qq; *(u32x4*)(ha + (size_t)(t0 + r) * 1024 + hd * 128 + c8) = *(const LAS u32x4*)(gyt + r * XR_LD + c8); } }
        if (has_next) rg_convwrite(cw, cb, nit, tid, xraw, graw, xr, gytn, PASS);
        __syncthreads();
        it = nit;
    }
}
__device__ __forceinline__ void p4_carries(Frame& F) {
    LAS f32x2* seg = (LAS f32x2*)F.lds;
    for (int job = F.vcu; job < NB * S5G; job += F.G) {
        const int b = job >> 5, g = job & 31, p = F.lane, w = F.wave;
        const f32x2 al = WSP(f32x2, WS_AL)[g * 64 + p];
        const f32x2* Sb = WSP(f32x2, WS_S) + ((size_t)(g * S5M + b * S5CPB + 16 * w)) * 64 + p; unsigned* ac = (unsigned*)(WSP(bf16, WS_ACAT) + ((size_t)(g * S5M + b * S5CPB + 16 * w)) * S5ROW) + p;
        f32x2 sv[16];
#pragma unroll
        for (int i = 0; i < 16; ++i) sv[i] = Sb[(size_t)i * 64];
        float xr_ = 0.f, xi = 0.f;
#pragma unroll
        for (int i = 0; i < 16; ++i) { const float nr = al.x * xr_ - al.y * xi + sv[i].x, ni = al.x * xi + al.y * xr_ + sv[i].y; xr_ = nr; xi = ni; }
        seg[w * 64 + p] = (f32x2){xr_, xi};
        float ar = al.x, ai = al.y;
#pragma unroll
        for (int q = 0; q < 4; ++q) { const float nr = ar * ar - ai * ai, ni = 2.f * ar * ai; ar = nr; ai = ni; }
        __syncthreads();
        xr_ = 0.f; xi = 0.f;
        for (int ww = 0; ww < w; ++ww) { const f32x2 sg = seg[ww * 64 + p]; const float nr = ar * xr_ - ai * xi + sg.x, ni = ar * xi + ai * xr_ + sg.y; xr_ = nr; xi = ni; }
#pragma unroll
        for (int i = 0; i < 16; ++i) { ac[(size_t)i * (S5ROW / 2)] = pk2(xr_, xi); const float nr = al.x * xr_ - al.y * xi + sv[i].x, ni = al.x * xi + al.y * xr_ + sv[i].y; xr_ = nr; xi = ni; }
        __syncthreads();
    }
    if (F.vcu < 16) {
        const int id = F.vcu * 512 + F.tid, ch = id & 1023, b = id >> 10; const f32x2* ag = WSP(f32x2, WS_RGAGG) + (size_t)b * RGC * 1024 + ch; float* hin = WSP(float, WS_HIN) + (size_t)b * RGC * 1024 + ch;
        f32x2 a[RGC];
#pragma unroll
        for (int c = 0; c < RGC; ++c) a[c] = ag[(size_t)c * 1024];
        float h = 0.f;
#pragma unroll
        for (int c = 0; c < RGC; ++c) { hin[(size_t)c * 1024] = h; h = a[c].x * h + a[c].y; }
    }
}
constexpr int WR_LD = 1028;
__device__ __forceinline__ void p9_router(Frame& F) {
    LAS float* wrt = (LAS float*)F.lds;
    LAS unsigned* rec = (LAS unsigned*)(F.lds + 32 * WR_LD * 4);
    LAS float* recp = (LAS float*)(rec + 512);
    LAS int* lcnt = (LAS int*)(recp + 512);
    LAS int* gbase = lcnt + 32;
    const float* wr = F.in[26];
    for (int i = F.tid; i < 1024 * 32; i += 512) wrt[(i & 31) * WR_LD + (i >> 5)] = wr[i];
    if (F.tid < 32) lcnt[F.tid] = 0;
    __syncthreads();
    const float* mod = WSP(float, WS_MOD); const bf16* v1 = WSP(bf16, WS_V1); bf16* x1 = WSP(bf16, WS_X1); bf16* h2 = WSP(bf16, WS_H2);
    const int lane = F.lane;
    f32x4 lg[4], lb[4];
#pragma unroll
    for (int j = 0; j < 4; ++j) { lg[j] = *((const f32x4*)F.in[24] + 64 * j + lane); lb[j] = *((const f32x4*)F.in[25] + 64 * j + lane); }
    const float brt = F.in[27][lane >> 1];
    for (int blk = F.vcu; blk < T / 128; blk += F.G) {
        for (int it = 0; it < 16; ++it) { const int ti = F.wave * 16 + it, t = blk * 128 + ti, b = t >> 12;
            f32x4 v[4]; float s = 0.f;
#pragma unroll
            for (int j = 0; j < 4; ++j) { const u32x2 w = *((const u32x2*)(v1 + (size_t)t * 1024) + 64 * j + lane); v[j] = (f32x4){bflo(w.x), bfhi(w.x), bflo(w.y), bfhi(w.y)}; s += (v[j][0] + v[j][1]) + (v[j][2] + v[j][3]); }
            const float mean = wave_sum(s) * (1.f / 1024.f); float s2 = 0.f;
#pragma unroll
            for (int j = 0; j < 4; ++j) { v[j] = v[j] - mean; s2 += (v[j][0] * v[j][0] + v[j][1] * v[j][1]) + (v[j][2] * v[j][2] + v[j][3] * v[j][3]); }
            const float rstd = 1.f / sqrtf(wave_sum(s2) * (1.f / 1024.f) + LN_EPS);
            f32x4 hh[4];
#pragma unroll
            for (int j = 0; j < 4; ++j) { const f32x4 xv = v[j] * rstd * lg[j] + lb[j]; u32x2 w; w.x = pk2(xv[0], xv[1]); w.y = pk2(xv[2], xv[3]); *((u32x2*)(x1 + (size_t)t * 1024) + 64 * j + lane) = w;
                const f32x4 sh = *((const f32x4*)(mod + b * 6144 + 3072) + 64 * j + lane), sc = *((const f32x4*)(mod + b * 6144 + 4096) + 64 * j + lane);
                hh[j] = xv * (sc + 1.0f) + sh; u32x2 w2; w2.x = pk2(hh[j][0], hh[j][1]); w2.y = pk2(hh[j][2], hh[j][3]); *((u32x2*)(h2 + (size_t)t * 1024) + 64 * j + lane) = w2; }
            float lgt[32];
#pragma unroll
            for (int e = 0; e < 32; ++e) { float a = 0.f;
#pragma unroll
                for (int j = 0; j < 4; ++j) { const f32x4 wv = *((const LAS f32x4*)(wrt + e * WR_LD) + 64 * j + lane); a += (hh[j][0] * wv[0] + hh[j][1] * wv[1]) + (hh[j][2] * wv[2] + hh[j][3] * wv[3]); }
                lgt[e] = a; }
#pragma unroll
            for (int i = 0; i < 16; ++i) { const bool up = (lane & 32) != 0; const float send = up ? lgt[i] : lgt[i + 16], keep = up ? lgt[i + 16] : lgt[i]; lgt[i] = keep + __shfl_xor(send, 32); }
#pragma unroll
            for (int i = 0; i < 8; ++i) { const bool up = (lane & 16) != 0; const float send = up ? lgt[i] : lgt[i + 8], keep = up ? lgt[i + 8] : lgt[i]; lgt[i] = keep + __shfl_xor(send, 16); }
#pragma unroll
            for (int i = 0; i < 4; ++i) { const bool up = (lane & 8) != 0; const float send = up ? lgt[i] : lgt[i + 4], keep = up ? lgt[i + 4] : lgt[i]; lgt[i] = keep + __shfl_xor(send, 8); }
#pragma unroll
            for (int i = 0; i < 2; ++i) { const bool up = (lane & 4) != 0; const float send = up ? lgt[i] : lgt[i + 2], keep = up ? lgt[i + 2] : lgt[i]; lgt[i] = keep + __shfl_xor(send, 4); }
            { const bool up = (lane & 2) != 0; const float send = up ? lgt[0] : lgt[1], keep = up ? lgt[1] : lgt[0]; lgt[0] = keep + __shfl_xor(send, 2); }
            const float logit = lgt[0] + __shfl_xor(lgt[0], 1) + brt;
            int rank = 0; const int me = lane >> 1;
#pragma unroll
            for (int e = 0; e < 32; ++e) { const float o = __shfl(logit, 2 * e); rank += (o > logit || (o == logit && e < me)) ? 1 : 0; }
            float tv[4]; int te[4];
#pragma unroll
            for (int k = 0; k < 4; ++k) { const unsigned long long mk = __ballot(rank == k && (lane & 1) == 0); const int src = __builtin_ctzll(mk); te[k] = src >> 1; tv[k] = __shfl(logit, src); }
            float pe[4], ps = 0.f;
#pragma unroll
            for (int k = 0; k < 4; ++k) { pe[k] = __expf(tv[k] - tv[0]); ps += pe[k]; }
            if (lane < 4) { const int e = te[0] * (lane == 0) + te[1] * (lane == 1) + te[2] * (lane == 2) + te[3] * (lane == 3);
                const float p = (pe[0] * (lane == 0) + pe[1] * (lane == 1) + pe[2] * (lane == 2) + pe[3] * (lane == 3)) / ps;
                const int lr = __hip_atomic_fetch_add(lcnt + e, 1, __ATOMIC_RELAXED, __HIP_MEMORY_SCOPE_WORKGROUP); rec[ti * 4 + lane] = ((unsigned)e << 16) | (unsigned)lr; recp[ti * 4 + lane] = p; }
        }
        __syncthreads();
        if (F.tid < 32) { const int n = lcnt[F.tid]; gbase[F.tid] = n ? (int)atomicAdd(F.ctl + CW_CNT + 64 * F.tid, (unsigned)n) : 0; lcnt[F.tid] = 0; }
        __syncthreads();
        { const unsigned r = rec[F.tid]; const int e = r >> 16, rk = gbase[e] + (int)(r & 0xffffu), t = blk * 128 + (F.tid >> 2);
          WSP(int, WS_TOK)[(size_t)e * T + rk] = t; WSP(unsigned, WS_POS)[(size_t)t * 4 + (F.tid & 3)] = ((unsigned)e << 20) | (unsigned)rk; WSP(float, WS_PROB)[(size_t)t * 4 + (F.tid & 3)] = recp[F.tid]; }
        __syncthreads();
    }
}
__device__ __forceinline__ void p12_final(Frame& F) {
    moe_tables(F);
    const LAS int* tstart = (const LAS int*)(F.lds + TAB_OFF);
    const float* mod = WSP(float, WS_MOD); const bf16* x1 = WSP(bf16, WS_X1); const bf16* yb = WSP(bf16, WS_YB); const unsigned* pos = WSP(unsigned, WS_POS); const float* prob = WSP(float, WS_PROB);
    const int lane = F.lane, gw = F.vcu * 8 + F.wave, NGW = F.G * 8;
    f32x4 lg[4], lb[4];
#pragma unroll
    for (int j = 0; j < 4; ++j) { lg[j] = *((const f32x4*)F.in[32] + 64 * j + lane); lb[j] = *((const f32x4*)F.in[33] + 64 * j + lane); }
    for (int tb = gw; tb < T; tb += 2 * NGW) {
        unsigned pp[2][4]; float pw[2][4]; u32x2 yw[2][4][4], xw[2][4];
#pragma unroll
        for (int q = 0; q < 2; ++q) { const int t = tb + q * NGW; const u32x4 p4 = *(const u32x4*)(pos + (size_t)t * 4); const f32x4 w4 = *(const f32x4*)(prob + (size_t)t * 4);
            pp[q][0] = p4.x; pp[q][1] = p4.y; pp[q][2] = p4.z; pp[q][3] = p4.w; pw[q][0] = w4[0]; pw[q][1] = w4[1]; pw[q][2] = w4[2]; pw[q][3] = w4[3]; }
#pragma unroll
        for (int q = 0; q < 2; ++q) { const int t = tb + q * NGW;
#pragma unroll
            for (int k = 0; k < 4; ++k) { const int e = pp[q][k] >> 20, rk = pp[q][k] & 0xfffffu; const size_t slot = (size_t)tstart[e] * 256 + rk;
#pragma unroll
                for (int j = 0; j < 4; ++j) yw[q][k][j] = *((const u32x2*)(yb + slot * 1024) + 64 * j + lane); }
#pragma unroll
            for (int j = 0; j < 4; ++j) xw[q][j] = *((const u32x2*)(x1 + (size_t)t * 1024) + 64 * j + lane); }
#pragma unroll
        for (int q = 0; q < 2; ++q) { const int t = tb + q * NGW, b = t >> 12;
            f32x4 v[4]; float s = 0.f;
#pragma unroll
            for (int j = 0; j < 4; ++j) { f32x4 f = (f32x4){0.f, 0.f, 0.f, 0.f};
#pragma unroll
                for (int k = 0; k < 4; ++k) { const u32x2 w = yw[q][k][j]; f += (f32x4){bflo(w.x), bfhi(w.x), bflo(w.y), bfhi(w.y)} * pw[q][k]; }
                const u32x2 w = xw[q][j]; const f32x4 g2 = *((const f32x4*)(mod + b * 6144 + 5120) + 64 * j + lane) + 1.0f;
                v[j] = (f32x4){bflo(w.x), bfhi(w.x), bflo(w.y), bfhi(w.y)} * DN_ALPHA + g2 * f; s += (v[j][0] + v[j][1]) + (v[j][2] + v[j][3]); }
            const float mean = wave_sum(s) * (1.f / 1024.f); float s2 = 0.f;
#pragma unroll
            for (int j = 0; j < 4; ++j) { v[j] = v[j] - mean; s2 += (v[j][0] * v[j][0] + v[j][1] * v[j][1]) + (v[j][2] * v[j][2] + v[j][3] * v[j][3]); }
            const float rstd = 1.f / sqrtf(wave_sum(s2) * (1.f / 1024.f) + LN_EPS);
#pragma unroll
            for (int j = 0; j < 4; ++j) *((f32x4*)(F.out + (size_t)t * 1024) + 64 * j + lane) = v[j] * rstd * lg[j] + lb[j]; }
    }
}

struct Args { const float* in[34]; float* out; unsigned char* ws; int ph_lo, ph_hi; };
__global__ void __launch_bounds__(512, 2) fwd_kernel(Args args) {
    extern __shared__ __attribute__((aligned(16))) unsigned char lds_raw[];
    Frame F;
    F.lds = (LAS unsigned char*)lds_raw; F.MISC = (volatile LAS unsigned*)(F.lds + MISC_OFF);
    F.tid = threadIdx.x; F.lane = F.tid & 63; F.wave = __builtin_amdgcn_readfirstlane(F.tid >> 6);
    F.G = gridDim.x; { const int bx = blockIdx.x; F.vcu = (F.G % 8 == 0) ? (bx % 8) * (F.G / 8) + bx / 8 : bx; }
#pragma unroll
    for (int i = 0; i < 34; ++i) F.in[i] = args.in[i];
    F.out = args.out; F.ws = args.ws; F.ctl = (unsigned*)(args.ws + WS_CTL);
    if (F.tid < 64) F.MISC[F.tid] = 0u;
    __syncthreads();
    XcdBarrier bar; bar.bar = F.ctl + CW_BAR; bar.x = 0; bar.st = nullptr;
    if (MK_N_LAUNCHES == 1) bar = xcd_barrier_post(F.ctl + CW_BAR, F.MISC + 8);
    const int lo = args.ph_lo, hi = args.ph_hi;
#define IN(k) (lo <= (k) && (k) < hi)
#define SEAM(k) do { if (IN(k) && IN((k) + 1)) xcd_barrier(bar); } while (0)

    if (IN(0)) REPS(0) { if (rep_) xcd_barrier(bar);
        for (int j = F.vcu; j < 192; j += F.G) p0_mod_job(F, j);
        for (int j = F.vcu; j < S5G * 8; j += F.G) p0_s5k_job(F, j);
        p0_small_transposes(F);
    }
    SEAM(0);
    if (IN(1)) REPS(1) { if (rep_) xcd_barrier(bar); for (int j = F.vcu; j < S5G * 8; j += F.G) p1_s5w_job(F, j); p1_body(F); }
    SEAM(1);
    if (IN(2)) REPS(2) { if (rep_) xcd_barrier(bar);
        g8::GridOrder S; S.init(T, INC, F.G, (int)blockIdx.x, WSP(bf16, WS_HBF), WSP(bf16, WS_WIN), 1024, 1024);
        EpiInProj E{F.in[5], WSP(bf16, WS_XRNN), WSP(bf16, WS_GY), WSP(bf16, WS_ACAT), WSP(bf16, WS_GATES)};
        g8::gemm_phase<EpiInProj, g8::GridOrder, false>(F.lds, 1024, 1024, 1024, S, E);
    }
    SEAM(2);
    if (IN(3)) REPS(3) { if (rep_) xcd_barrier(bar);
        { S5AOrder S{F.G, F.vcu, (const char*)WSP(bf16, WS_ACAT), (const char*)WSP(bf16, WS_WS)}; EpiS5A E{WSP(float, WS_S)};
          g8::gemm_phase<EpiS5A, S5AOrder, false>(F.lds, S5L * 16, S5ROW, S5L * 16, S, E); }
        __syncthreads();
        rglru_phase<0>(F);
    }
    SEAM(3);
    if (IN(4)) REPS(4) { if (rep_) xcd_barrier(bar); p4_carries(F); }
    SEAM(4);
    if (IN(5)) REPS(5) { if (rep_) xcd_barrier(bar);
        { S5COrder S{F.G, F.vcu, (const char*)WSP(bf16, WS_ACAT), (const char*)WSP(bf16, WS_WY)}; EpiS5C E{WSP(bf16, WS_YS)};
          g8::gemm_phase<EpiS5C, S5COrder, false>(F.lds, S5ROW, S5ROW, S5ROW, S, E); }
        __syncthreads();
        rglru_phase<1>(F);
    }
    SEAM(5);
    if (IN(6)) REPS(6) { if (rep_) xcd_barrier(bar);
        g8::GridOrder S; S.init(T, 2048, F.G, (int)blockIdx.x, WSP(bf16, WS_YS), WSP(bf16, WS_WGLU), 512, 512);
        EpiGlu E{WSP(bf16, WS_GATES), WSP(bf16, WS_GB)};
        g8::gemm_phase<EpiGlu, g8::GridOrder, false>(F.lds, 512, 512, 512, S, E);
    }
    SEAM(6);
    if (IN(7)) REPS(7) { if (rep_) xcd_barrier(bar);
        g8::GridOrder S; S.init(T, 1024, F.G, (int)blockIdx.x, WSP(bf16, WS_HA), WSP(bf16, WS_WRNN), 1024, 1024);
        EpiRnn E{WSP(bf16, WS_GATES), WSP(bf16, WS_GB), WSP(bf16, WS_MERGED)};
        g8::gemm_phase<EpiRnn, g8::GridOrder, false>(F.lds, 1024, 1024, 1024, S, E);
    }
    SEAM(7);
    if (IN(8)) REPS(8) { if (rep_) xcd_barrier(bar);
        g8::GridOrder S; S.init(T, 1024, F.G, (int)blockIdx.x, WSP(bf16, WS_MERGED), WSP(bf16, WS_WOUT), 1024, 1024);
        EpiOut E{F.in[0], WSP(float, WS_MOD), WSP(bf16, WS_V1)};
        g8::gemm_phase<EpiOut, g8::GridOrder, false>(F.lds, 1024, 1024, 1024, S, E);
    }
    SEAM(8);
    if (IN(9)) REPS(9) { if (rep_) xcd_barrier(bar); p9_router(F); }
    SEAM(9);
    if (IN(10)) REPS(10) { if (rep_) xcd_barrier(bar);
        moe_tables(F);
        const LAS int* tstart = (const LAS int*)(F.lds + TAB_OFF);
        MoeOrder S{F.G, (int)blockIdx.x, 8, tstart[NE], tstart, tstart + 40, WSP(int, WS_TOK), (const char*)WSP(bf16, WS_H2), (const char*)WSP(bf16, WS_WGU), (size_t)2048 * 1024 * 2, 1024, true};
        EpiMoe1 E{F.in[29], WSP(bf16, WS_ACT)};
        g8::gemm_phase<EpiMoe1, MoeOrder, true>(F.lds, 1024, 1024, 1024, S, E);
    }
    SEAM(10);
    if (IN(11)) REPS(11) { if (rep_) xcd_barrier(bar);
        moe_tables(F);
        const LAS int* tstart = (const LAS int*)(F.lds + TAB_OFF);
        MoeOrder S{F.G, (int)blockIdx.x, 4, tstart[NE], tstart, tstart + 40, WSP(int, WS_TOK), (const char*)WSP(bf16, WS_ACT), (const char*)WSP(bf16, WS_WD), (size_t)1024 * 1024 * 2, 1024, false};
        EpiMoe2 E{F.in[31], WSP(bf16, WS_YB)};
        g8::gemm_phase<EpiMoe2, MoeOrder, false>(F.lds, 1024, 1024, 1024, S, E);
    }
    SEAM(11);
    if (IN(12)) REPS(12) { if (rep_) xcd_barrier(bar); p12_final(F); }
#undef IN
#undef SEAM
}

extern "C" void kernel_launch(void* const* d_in, const int* in_sizes, int n_in, void* d_out, int out_size, void* d_ws, size_t ws_size, hipStream_t stream) {
    static int grid = 0;
    if (grid == 0) {
        if (n_in != 34 || in_sizes[0] != T * D || out_size != T * D || ws_size < WS_END) { fprintf(stderr, "kernel_launch: unexpected shapes (n_in %d, ws %zu < %zu)\n", n_in, ws_size, (size_t)WS_END); grid = -1; return; }
        int dev = 0, cus = 0;
        if (hipGetDevice(&dev) != hipSuccess || hipDeviceGetAttribute(&cus, hipDeviceAttributeMultiprocessorCount, dev) != hipSuccess) { grid = -1; return; }
        if (hipFuncSetAttribute((const void*)fwd_kernel, hipFuncAttributeMaxDynamicSharedMemorySize, LDS_BYTES) != hipSuccess) { fprintf(stderr, "kernel_launch: hipFuncSetAttribute failed\n"); grid = -1; return; }
        int per_cu = 0; (void)hipOccupancyMaxActiveBlocksPerMultiprocessor(&per_cu, (const void*)fwd_kernel, 512, LDS_BYTES); (void)hipGetLastError();
        grid = cus;
    }
    if (grid < 0) return;
    (void)hipMemsetAsync((char*)d_ws + WS_CTL, 0, CTL_BYTES, stream);
    Args a{};
    for (int i = 0; i < 34; ++i) a.in[i] = (const float*)d_in[i];
    a.out = (float*)d_out; a.ws = (unsigned char*)d_ws;
    if (MK_N_LAUNCHES == 1) { a.ph_lo = 0; a.ph_hi = N_PHASES; hipLaunchKernelGGL(fwd_kernel, dim3(grid), dim3(512), LDS_BYTES, stream, a); }
    else for (int p = 0; p < N_PHASES; ++p) { a.ph_lo = p; a.ph_hi = p + 1; hipLaunchKernelGGL(fwd_kernel, dim3(grid), dim3(512), LDS_BYTES, stream, a); }
}
```

```cpp
#include <hip/hip_runtime.h>
#include <cstdio>
#include <cstdint>

#ifndef MK_N_LAUNCHES
#define MK_N_LAUNCHES 1
#endif
constexpr int N_PHASES = 13;
#ifndef DUP_PHASE
#define DUP_PHASE -1
#endif
#define REPS(k) for (int rep_ = 0; rep_ < ((DUP_PHASE == (k)) ? 2 : 1); ++rep_)

#define GAS __attribute__((address_space(1)))
#define LAS __attribute__((address_space(3)))
typedef unsigned short bf16;
typedef short bf16x8 __attribute__((ext_vector_type(8)));
typedef float f32x4 __attribute__((ext_vector_type(4)));
typedef float f32x2 __attribute__((ext_vector_type(2)));
typedef unsigned u32x4 __attribute__((ext_vector_type(4)));
typedef unsigned u32x2 __attribute__((ext_vector_type(2)));
typedef GAS unsigned gu32;

constexpr int NB = 8, SEQ = 4096, T = NB * SEQ, D = 1024, INC = 4608, NE = 32, DFF = 1024;
constexpr int S5L = 32, S5G = 32, S5ROW = 128 + S5L * 16  , S5M = T / S5L  , S5CPB = SEQ / S5L  ;
constexpr int RGL = 128, RGC = SEQ / RGL  ;
constexpr float LN_EPS = 1e-5f, DN_ALPHA = 1.189207115002721f;
constexpr int ACT_ROWS = T * 4 + NE * 256;

constexpr size_t MiB = 1u << 20;
constexpr size_t WS_XRNN = 0, WS_GY = 64 * MiB, WS_GATES = 128 * MiB, WS_V1 = 0, WS_ACT = 0;
constexpr size_t WS_HBF = 272 * MiB, WS_HA = 272 * MiB, WS_YS = 336 * MiB, WS_GB = 368 * MiB, WS_MERGED = 432 * MiB, WS_ACAT = 496 * MiB, WS_YB = 272 * MiB;
constexpr size_t WS_X1 = 544 * MiB, WS_H2 = 608 * MiB;
constexpr size_t WS_WGU = 672 * MiB, WS_WD = 800 * MiB, WS_WIN = 864 * MiB, WS_WG = 873 * MiB, WS_WRNN = 874 * MiB, WS_WGLU = 876 * MiB, WS_WOUT = 878 * MiB;
constexpr size_t WS_WS = 880 * MiB, WS_WY = 888 * MiB, WS_S = 908 * MiB;
constexpr size_t WS_MOD = 924 * MiB, WS_AL = 925 * MiB, WS_RGAGG = 926 * MiB, WS_HIN = 928 * MiB, WS_TOK = 929 * MiB, WS_POS = 933 * MiB, WS_PROB = 934 * MiB, WS_CTL = 935 * MiB;
constexpr size_t WS_END = 936 * MiB, CTL_BYTES = 1 * MiB;
static_assert((size_t)ACT_ROWS * DFF * 2 <= 272 * MiB, "act/yb size");
static_assert(WS_ACAT + (size_t)S5G * S5M * S5ROW * 2 <= WS_X1, "acat");
constexpr int CW_BAR = 4096, CW_CNT = 8192  ;

constexpr int LDS_BYTES = 147456, MISC_OFF = LDS_BYTES - 256, TAB_OFF = 131072 + 1024;

__device__ __forceinline__ unsigned f2bf(float f) { unsigned u = __builtin_bit_cast(unsigned, f); return (u + 0x7fffu + ((u >> 16) & 1u)) >> 16; }
typedef __bf16 bf16x2v __attribute__((ext_vector_type(2)));
__device__ __forceinline__ unsigned pk2(float lo, float hi) { const f32x2 v = {lo, hi}; const bf16x2v b = __builtin_convertvector(v, bf16x2v); return __builtin_bit_cast(unsigned, b); }
__device__ __forceinline__ unsigned pk4_fp8(float a, float b, float c, float d) { int w = 0; w = __builtin_amdgcn_cvt_pk_fp8_f32(a, b, w, false); w = __builtin_amdgcn_cvt_pk_fp8_f32(c, d, w, true); return (unsigned)w; }
__device__ __forceinline__ float bflo(unsigned w) { return __builtin_bit_cast(float, w << 16); }
__device__ __forceinline__ float bfhi(unsigned w) { return __builtin_bit_cast(float, w & 0xffff0000u); }
__device__ __forceinline__ float bf1(bf16 h) { return __builtin_bit_cast(float, ((unsigned)h) << 16); }
__device__ __forceinline__ float fast_sigmoid(float x) { return __builtin_amdgcn_rcpf(1.0f + __builtin_amdgcn_exp2f(-1.4426950409f * x)); }
__device__ __forceinline__ float gelu_tanh(float x) { const float u = x + 0.044715f * x * x * x; return x * __builtin_amdgcn_rcpf(1.0f + __builtin_amdgcn_exp2f(-2.3022082f * u)); }
__device__ __forceinline__ float wave_sum(float v) {
#pragma unroll
    for (int o = 1; o < 64; o <<= 1) v += __shfl_xor(v, o);
    return v;
}
__device__ __forceinline__ u32x4 pack8(f32x4 a, f32x4 b) { u32x4 w; w.x = pk2(a[0], a[1]); w.y = pk2(a[2], a[3]); w.z = pk2(b[0], b[1]); w.w = pk2(b[2], b[3]); return w; }
__device__ __forceinline__ void unpack8(u32x4 w, f32x4& a, f32x4& b) { a = (f32x4){bflo(w.x), bfhi(w.x), bflo(w.y), bfhi(w.y)}; b = (f32x4){bflo(w.z), bfhi(w.z), bflo(w.w), bfhi(w.w)}; }

#define XB_TMO      128
#define XB_XCNT(j)  (256  + 64 * (j))
#define XB_XSUB(j)  (1280 + 64 * (j))
#define XB_XGEN(j)  (2304 + 64 * (j))
#define XB_TOP      3328
#define XB_TOPGEN   3392
#define XCD_BAR_WORDS 3456
#define XB_SPIN_CAP (1u << 18)
__device__ __forceinline__ unsigned xb_ld(unsigned* p)              { return __hip_atomic_load(p, __ATOMIC_RELAXED, __HIP_MEMORY_SCOPE_AGENT); }
__device__ __forceinline__ unsigned xb_add(unsigned* p, unsigned v) { return __hip_atomic_fetch_add(p, v, __ATOMIC_RELAXED, __HIP_MEMORY_SCOPE_AGENT); }
__device__ __forceinline__ unsigned xb_xcc_id() { return (unsigned)__builtin_amdgcn_s_getreg((3 << 11) | 20) & 0xFu; }
#define XB_SPIN(cond, bar) do { unsigned _sp = 0; while (cond) { __builtin_amdgcn_s_sleep(1); \
    if ((++_sp & 255u) == 0u) { if (xb_ld(&(bar)[XB_TMO])) break; if (_sp > XB_SPIN_CAP) { atomicAdd(&(bar)[XB_TMO], 1u); break; } } } } while (0)
struct XcdBarrier { unsigned* bar; unsigned x; volatile LAS unsigned* st; };
__device__ __forceinline__ XcdBarrier xcd_barrier_post(unsigned* bar, volatile LAS unsigned* st) {
    XcdBarrier b; b.bar = bar; b.x = xb_xcc_id(); b.st = st;
    if (threadIdx.x == 0) (void)xb_add(&bar[XB_XCNT(b.x)], 1u);
    return b;
}
__device__ __forceinline__ void xcd_barrier_complete(unsigned* bar, unsigned x, unsigned& nloc, unsigned& nx) {
    const unsigned G = gridDim.x * gridDim.y * gridDim.z;
    unsigned sum, cnt, mine, sp = 0u;
    for (;;) {
        sum = 0u; cnt = 0u; mine = 0u;
#pragma unroll
        for (unsigned j = 0; j < 16; ++j) { const unsigned c = xb_ld(&bar[XB_XCNT(j)]); sum += c; cnt += (c > 0u) ? 1u : 0u; mine = (j == x) ? c : mine; }
        if (sum == G) break;
        __builtin_amdgcn_s_sleep(1);
        if ((++sp & 255u) == 0u) { if (xb_ld(&bar[XB_TMO])) break; if (sp > XB_SPIN_CAP) { atomicAdd(&bar[XB_TMO], 1u); break; } }
    }
    nloc = mine > 0u ? mine : 1u; nx = cnt > 0u ? cnt : 1u;
}
__device__ __forceinline__ void xcd_barrier(const XcdBarrier& b) {
    asm volatile("s_waitcnt vmcnt(0)" ::: "memory");
    __syncthreads();
    if (threadIdx.x == 0) {
        unsigned* bar = b.bar;
        __builtin_amdgcn_s_waitcnt(0);
        unsigned nloc = b.st[0], nx = b.st[1];
        if (nloc == 0u) { xcd_barrier_complete(bar, b.x, nloc, nx); b.st[0] = nloc; b.st[1] = nx; }
        const unsigned old = xb_add(&bar[XB_XSUB(b.x)], 1u);
        const unsigned gen = old / nloc;
        if (old + 1u == (gen + 1u) * nloc) {
            __builtin_amdgcn_fence(__ATOMIC_RELEASE, "agent");
            asm volatile("s_waitcnt vmcnt(0)" ::: "memory");
            const unsigned og = xb_add(&bar[XB_TOP], 1u);
            const unsigned tg = og / nx;
            if (og + 1u == (tg + 1u) * nx) xb_add(&bar[XB_TOPGEN], 1u);
            else XB_SPIN(xb_ld(&bar[XB_TOPGEN]) == tg, bar);
            __builtin_amdgcn_fence(__ATOMIC_ACQUIRE, "agent");
            xb_add(&bar[XB_XGEN(b.x)], 1u);
            asm volatile("s_waitcnt vmcnt(0)" ::: "memory");
        } else {
            XB_SPIN(xb_ld(&bar[XB_XGEN(b.x)]) == gen, bar);
            __builtin_amdgcn_fence(__ATOMIC_ACQUIRE, "agent");
            asm volatile("s_waitcnt vmcnt(0)" ::: "memory");
        }
    }
    __syncthreads();
}

namespace g8 {
constexpr int BM = 256, BK = 64, HALF = 128, HTB = HALF * BK * 2, STAGE_BYTES = 8 * HTB;
__device__ __forceinline__ int lds_byte(int r, int c) { const int st = (r >> 4) * 2 + (c >> 5), rr = r & 15, cc = c & 31, ob = rr * 64 + cc * 2; return st * 1024 + (ob ^ (((ob >> 9) & 1) << 5)); }
__device__ __forceinline__ void stage_rc(int b, int& R, int& C) { const int st = b / 1024, sb = b % 1024, swz = sb ^ (((sb >> 9) & 1) << 5); R = (st >> 1) * 16 + swz / 64; C = (st & 1) * 32 + (swz % 64) / 2; }
__device__ __forceinline__ int perm32(int rho) { const int n = rho >> 4, i = rho & 15; return 8 * (i >> 2) + 4 * n + (i & 3); }

struct Unit { int pm, pn, z, rl; const char* A; const char* B; };

typedef int v8i __attribute__((ext_vector_type(8)));
typedef int v4i __attribute__((ext_vector_type(4)));
typedef short s16x16 __attribute__((ext_vector_type(16)));
typedef s16x16 s16x16_a16 __attribute__((aligned(16)));
__device__ __forceinline__ v8i cat8(bf16x8 lo, bf16x8 hi) { const v4i a = __builtin_bit_cast(v4i, lo), b = __builtin_bit_cast(v4i, hi); return __builtin_shufflevector(a, b, 0, 1, 2, 3, 4, 5, 6, 7); }
template <class Epi, class Sched, bool GATHER, bool FP8 = false>
__device__ __forceinline__ void gemm_phase(LAS unsigned char* lds, const int Kb, const int ldaB, const int ldbB, const Sched& S, const Epi& E) {
    const int tid = threadIdx.x, wid = __builtin_amdgcn_readfirstlane(tid >> 6), lane = tid & 63, wr = wid >> 2, wc = wid & 3, fr = lane & 15, fq = lane >> 4;
    const int nt = Kb / 128;
    unsigned voffB[2], cvo[2][2], nvo[2][2]; int Rr[2], Cc[2];
#pragma unroll
    for (int i = 0; i < 2; ++i) { int R, C; stage_rc(tid * 16 + i * 8192, R, C); const int Rb = (R & ~31) + perm32(R & 31);
        voffB[i] = (unsigned)(Rb * ldbB + C * 2); Rr[i] = R; Cc[i] = C;
#pragma unroll
        for (int h = 0; h < 2; ++h) { cvo[h][i] = (unsigned)((h * HALF + R) * ldaB + C * 2); nvo[h][i] = cvo[h][i]; } }
    const size_t kstep = (size_t)(BK * 2);
    const size_t hstepB = (size_t)HALF * ldbB;
    const unsigned ldsw = (unsigned)wid * 1024u;
    const int aoff = FP8 ? lds_byte(wr * 64 + fr, (fq >> 1) * 32 + (fq & 1) * 16) : lds_byte(wr * 64 + fr, fq * 8), boff = FP8 ? lds_byte(wc * 32 + fr, (fq >> 1) * 32 + (fq & 1) * 16) : lds_byte(wc * 32 + fr, fq * 8);
#define G8_SA(b, h) (((b) * 2 + (h)) * HTB)
#define G8_SB(b, h) ((4 + (b) * 2 + (h)) * HTB)
#define G8_STGB(bufoff, gbase) do { _Pragma("unroll") for (int _i = 0; _i < 2; ++_i) \
        __builtin_amdgcn_global_load_lds((const unsigned*)((const char*)(gbase) + voffB[_i]), (LAS unsigned*)(lds + (bufoff) + ldsw + _i * 8192), 16, 0, 0); } while (0)
#define G8_STGA(bufoff, gbase, VO, h) do { _Pragma("unroll") for (int _i = 0; _i < 2; ++_i) \
        __builtin_amdgcn_global_load_lds((const unsigned*)((const char*)(gbase) + VO[h][_i]), (LAS unsigned*)(lds + (bufoff) + ldsw + _i * 8192), 16, 0, 0); } while (0)
#define G8_LDA(dst, b, h) do { _Pragma("unroll") for (int m = 0; m < 4; ++m) { if constexpr (FP8) { dst##8[m] = cat8(*(const LAS bf16x8*)(lds + G8_SA(b, h) + aoff + m * 2048), *(const LAS bf16x8*)(lds + G8_SA(b, h) + aoff + m * 2048 + 16)); } \
        else { _Pragma("unroll") for (int k = 0; k < 2; ++k) dst[m][k] = *(const LAS bf16x8*)(lds + G8_SA(b, h) + aoff + m * 2048 + k * 1024); } } } while (0)
#define G8_LDB(dst, b, h) do { _Pragma("unroll") for (int n = 0; n < 2; ++n) { if constexpr (FP8) { dst##8[n] = cat8(*(const LAS bf16x8*)(lds + G8_SB(b, h) + boff + n * 2048), *(const LAS bf16x8*)(lds + G8_SB(b, h) + boff + n * 2048 + 16)); } \
        else { _Pragma("unroll") for (int k = 0; k < 2; ++k) dst[n][k] = *(const LAS bf16x8*)(lds + G8_SB(b, h) + boff + n * 2048 + k * 1024); } } } while (0)
#define G8_MMA(ai, bj, At, Bt) do { __builtin_amdgcn_s_setprio(1); _Pragma("unroll") for (int m = 0; m < 4; ++m) _Pragma("unroll") for (int n = 0; n < 2; ++n) { \
        if constexpr (FP8) asm volatile("s_nop 1\n\tv_mfma_scale_f32_16x16x128_f8f6f4 %0, %1, %2, %0, %3, %4 op_sel_hi:[0,0,0]" : "+v"(acc[ai][bj][m][n]) : "v"(Bt##8[n]), "v"(At##8[m]), "v"(sc_w), "v"(sc_a)); \
        else { _Pragma("unroll") for (int k = 0; k < 2; ++k) acc[ai][bj][m][n] = __builtin_amdgcn_mfma_f32_16x16x32_bf16(Bt[n][k], At[m][k], acc[ai][bj][m][n], 0, 0, 0); } } __builtin_amdgcn_s_setprio(0); } while (0)
#define G8_WAIT_V(n) asm volatile("s_waitcnt vmcnt(" #n ")" ::: "memory")
#define G8_WAIT_L(n) asm volatile("s_waitcnt lgkmcnt(" #n ")" ::: "memory")
#define G8_BAR __builtin_amdgcn_s_barrier()
#define G8_SCHED __builtin_amdgcn_sched_barrier(0)
    Unit cur, nxt; int ui = 0;
    if (!S.next(0, cur)) return;
    bool has_next = S.next(1, nxt);
    if constexpr (GATHER) { S.gather(cur, Rr, Cc, cvo); if (has_next) S.gather(nxt, Rr, Cc, nvo); else {
#pragma unroll
        for (int h = 0; h < 2; ++h)
#pragma unroll
            for (int i = 0; i < 2; ++i) nvo[h][i] = cvo[h][i]; } }
    f32x4 acc[2][2][4][2];
#pragma unroll
    for (int a = 0; a < 2; ++a)
#pragma unroll
        for (int b = 0; b < 2; ++b)
#pragma unroll
            for (int m = 0; m < 4; ++m)
#pragma unroll
                for (int n = 0; n < 2; ++n) acc[a][b][m][n] = (f32x4){0.f, 0.f, 0.f, 0.f};
    const int sc_w = 0x7a7a7a7a, sc_a = 0x7f7f7f7f;
    bf16x8 At[4][2], B0[2][2], B1[2][2]; v8i At8[4], B08[2], B18[2];
    const char* cA = cur.A; const char* cB = cur.B;
    G8_STGB(G8_SB(0, 0), cB); G8_STGB(G8_SB(0, 1), cB + hstepB); G8_STGA(G8_SA(0, 0), cA, cvo, 0); G8_STGA(G8_SA(0, 1), cA, cvo, 1);
    if (wr == 1) G8_BAR;
    G8_WAIT_V(2); G8_BAR;
    G8_STGB(G8_SB(1, 0), cB + kstep); G8_STGA(G8_SA(1, 0), cA + kstep, cvo, 0); G8_STGB(G8_SB(1, 1), cB + hstepB + kstep);
    G8_WAIT_V(6); G8_BAR;
    for (;;) {
        const char* nA = has_next ? nxt.A : cA; const char* nB = has_next ? nxt.B : cB;
        for (int t = 0; t < nt; t += 2) {
            const bool last = (t == nt - 2);
            const char* a1 = cA + (size_t)(t + 1) * kstep;
            const char* a2 = last ? nA : cA + (size_t)(t + 2) * kstep; const char* b2 = last ? nB : cB + (size_t)(t + 2) * kstep;
            const char* a3 = a2 + kstep; const char* b3 = b2 + kstep;
            unsigned vo2[2][2];
#pragma unroll
            for (int h = 0; h < 2; ++h)
#pragma unroll
                for (int i = 0; i < 2; ++i) vo2[h][i] = (GATHER && last) ? nvo[h][i] : cvo[h][i];
            G8_LDB(B0, 0, 0); G8_LDB(B1, 0, 1); G8_SCHED; G8_LDA(At, 0, 0); G8_STGA(G8_SA(1, 1), a1, cvo, 1);
            G8_WAIT_V(8); G8_WAIT_L(0); G8_BAR; G8_SCHED; G8_MMA(0, 0, At, B0); G8_MMA(0, 1, At, B1); G8_SCHED; G8_BAR; G8_SCHED;
            G8_LDA(At, 0, 1); G8_STGB(G8_SB(0, 0), b2); G8_STGB(G8_SB(0, 1), b2 + hstepB); G8_STGA(G8_SA(0, 0), a2, vo2, 0);
            G8_WAIT_V(8); G8_WAIT_L(0); G8_BAR; G8_SCHED; G8_MMA(1, 0, At, B0); G8_MMA(1, 1, At, B1); G8_SCHED; G8_BAR; G8_SCHED;
            G8_LDB(B0, 1, 0); G8_LDB(B1, 1, 1); G8_SCHED; G8_LDA(At, 1, 0); G8_STGA(G8_SA(0, 1), a2, vo2, 1);
            G8_WAIT_V(8); G8_WAIT_L(0); G8_BAR; G8_SCHED; G8_MMA(0, 0, At, B0); G8_MMA(0, 1, At, B1); G8_SCHED; G8_BAR; G8_SCHED;
            G8_LDA(At, 1, 1); G8_STGB(G8_SB(1, 0), b3); G8_STGB(G8_SB(1, 1), b3 + hstepB); G8_STGA(G8_SA(1, 0), a3, vo2, 0);
            G8_WAIT_V(8); G8_WAIT_L(0); G8_BAR; G8_SCHED; G8_MMA(1, 0, At, B0); G8_MMA(1, 1, At, B1); G8_SCHED; G8_BAR; G8_SCHED;
        }
        if (wr == 0) G8_BAR;
        Unit nn; bool has_nn = false;
        if (has_next) has_nn = S.next(ui + 2, nn);
        unsigned nnvo[2][2];
        if constexpr (GATHER) { if (has_nn) S.gather(nn, Rr, Cc, nnvo); }
        if constexpr (FP8) asm volatile("s_nop 15\n\ts_nop 15" ::: "memory");
        E(acc, cur, wr, wc, fr, fq);
        if (!has_next) break;
#pragma unroll
        for (int a = 0; a < 2; ++a)
#pragma unroll
            for (int b = 0; b < 2; ++b)
#pragma unroll
                for (int m = 0; m < 4; ++m)
#pragma unroll
                    for (int n = 0; n < 2; ++n) acc[a][b][m][n] = (f32x4){0.f, 0.f, 0.f, 0.f};
        cur = nxt; cA = nA; cB = nB; ++ui;
        if constexpr (GATHER) {
#pragma unroll
            for (int h = 0; h < 2; ++h)
#pragma unroll
                for (int i = 0; i < 2; ++i) { cvo[h][i] = nvo[h][i]; if (has_nn) nvo[h][i] = nnvo[h][i]; } }
        nxt = nn; has_next = has_nn;
        if (wr == 1) G8_BAR;
    }
    G8_WAIT_V(0);
    G8_BAR;
#undef G8_SA
#undef G8_SB
#undef G8_STGB
#undef G8_STGA
#undef G8_LDA
#undef G8_LDB
#undef G8_MMA
#undef G8_WAIT_V
#undef G8_WAIT_L
#undef G8_BAR
#undef G8_SCHED
}

struct GridOrder {
    int nM, nN, nwg, G, c; const char* A; const char* B; size_t tstepA, tstepB;
    __device__ __forceinline__ void init(int M, int N, int G_, int c_, const void* A_, const void* B_, int lda, int ldb) { nM = M / BM; nN = N / BM; nwg = nM * nN; G = G_; c = c_; A = (const char*)A_; B = (const char*)B_; tstepA = (size_t)BM * lda * 2; tstepB = (size_t)BM * ldb * 2; }
    __device__ __forceinline__ bool next(int i, Unit& u) const {
        const long L = (long)i * G + c; if (L >= nwg) return false;
        int wgid = (int)L; { const int q = nwg / 8, r = nwg % 8, xcd = wgid % 8, off = wgid / 8; wgid = (xcd < r ? xcd * (q + 1) : r * (q + 1) + (xcd - r) * q) + off; }
        const int nig = 8 * nN, gid = wgid / nig, fm = gid * 8, gsz = (nM - fm) < 8 ? (nM - fm) : 8;
        u.pm = fm + ((wgid % nig) % gsz); u.pn = (wgid % nig) / gsz; u.z = 0; u.rl = 0;
        u.A = A + (size_t)u.pm * tstepA; u.B = B + (size_t)u.pn * tstepB; return true;
    }
};
}

struct Frame {
    LAS unsigned char* lds; volatile LAS unsigned* MISC; unsigned* ctl;
    int tid, lane, wave, vcu, G;
    const float* in[34]; float* out; unsigned char* ws;
};
#define WSP(T_, off) ((T_*)(F.ws + (off)))

struct EpiInProj {
    const float* bias; bf16 *xrnn, *gy, *acat, *gates;
    __device__ __forceinline__ void operator()(const f32x4 (&acc)[2][2][4][2], const g8::Unit& u, int wr, int wc, int fr, int fq) const {
        const int pn = u.pn, colb = pn * 256 + wc * 32 + 8 * fq;
        f32x4 bv[2][2];
#pragma unroll
        for (int bj = 0; bj < 2; ++bj)
#pragma unroll
            for (int n = 0; n < 2; ++n) bv[bj][n] = *(const f32x4*)(bias + colb + bj * 128 + 4 * n);
#pragma unroll
        for (int ai = 0; ai < 2; ++ai)
#pragma unroll
            for (int m = 0; m < 4; ++m) { const int t = u.pm * 256 + ai * 128 + wr * 64 + m * 16 + fr;
#pragma unroll
                for (int bj = 0; bj < 2; ++bj) { f32x4 v0 = acc[ai][bj][m][0] + bv[bj][0], v1 = acc[ai][bj][m][1] + bv[bj][1]; const int col = colb + bj * 128;
                    if (pn < 4) { *(u32x4*)(xrnn + (size_t)t * 1024 + col) = pack8(v0, v1); }
                    else if (pn < 8) {
#pragma unroll
                        for (int j = 0; j < 4; ++j) { v0[j] = gelu_tanh(v0[j]); v1[j] = gelu_tanh(v1[j]); }
                        *(u32x4*)(gy + (size_t)t * 1024 + (col - 1024)) = pack8(v0, v1); }
                    else if (pn < 10) { const int cu = col - 2048, g = cu >> 4, c = cu & 15;
                        *(u32x4*)(acat + ((size_t)(g * S5M + (t >> 5)) * S5ROW + 128 + (t & 31) * 16 + c)) = pack8(v0, v1); }
                    else {
#pragma unroll
                        for (int j = 0; j < 4; ++j) { v0[j] = fast_sigmoid(v0[j]); v1[j] = fast_sigmoid(v1[j]); }
                        *(u32x4*)(gates + (size_t)t * 2048 + (col - 2560)) = pack8(v0, v1); } } }
    }
};
struct EpiS5A {
    float* S;
    __device__ __forceinline__ void operator()(const f32x4 (&acc)[2][2][4][2], const g8::Unit& u, int wr, int wc, int fr, int fq) const {
        const int col = wc * 32 + 8 * fq;
#pragma unroll
        for (int ai = 0; ai < 2; ++ai)
#pragma unroll
            for (int m = 0; m < 4; ++m) { const int row = u.pm * 256 + ai * 128 + wr * 64 + m * 16 + fr; float* p = S + ((size_t)(u.z * S5M + row)) * 128 + col;
                *(f32x4*)p = acc[ai][0][m][0]; *(f32x4*)(p + 4) = acc[ai][0][m][1]; }
    }
};
struct EpiS5C {
    bf16* ys;
    __device__ __forceinline__ void operator()(const f32x4 (&acc)[2][2][4][2], const g8::Unit& u, int wr, int wc, int fr, int fq) const {
#pragma unroll
        for (int ai = 0; ai < 2; ++ai)
#pragma unroll
            for (int m = 0; m < 4; ++m) { const int row = u.pm * 256 + ai * 128 + wr * 64 + m * 16 + fr;
#pragma unroll
                for (int bj = 0; bj < 2; ++bj) { const int n = u.pn * 256 + bj * 128 + wc * 32 + 8 * fq, i = n >> 4, c = n & 15; f32x4 v0 = acc[ai][bj][m][0], v1 = acc[ai][bj][m][1];
#pragma unroll
                    for (int j = 0; j < 4; ++j) { v0[j] = gelu_tanh(v0[j]); v1[j] = gelu_tanh(v1[j]); }
                    *(u32x4*)(ys + (size_t)(row * 32 + i) * 512 + u.z * 16 + c) = pack8(v0, v1); } }
    }
};
struct EpiGlu {
    const bf16* gates; bf16* gb;
    __device__ __forceinline__ void operator()(const f32x4 (&acc)[2][2][4][2], const g8::Unit& u, int wr, int wc, int fr, int fq) const {
        const int f = u.pn * 128 + wc * 32 + 8 * fq;
#pragma unroll
        for (int ai = 0; ai < 2; ++ai)
#pragma unroll
            for (int m = 0; m < 4; ++m) { const int t = u.pm * 256 + ai * 128 + wr * 64 + m * 16 + fr;
                const u32x4 gw = *(const u32x4*)(gates + (size_t)t * 2048 + 1024 + f); f32x4 g0, g1; unpack8(gw, g0, g1);
                f32x4 v0 = acc[ai][0][m][0], v1 = acc[ai][0][m][1]; const f32x4 s0 = acc[ai][1][m][0], s1 = acc[ai][1][m][1];
#pragma unroll
                for (int j = 0; j < 4; ++j) { v0[j] = g0[j] * v0[j] * fast_sigmoid(s0[j]); v1[j] = g1[j] * v1[j] * fast_sigmoid(s1[j]); }
                *(u32x4*)(gb + (size_t)t * 1024 + f) = pack8(v0, v1); }
    }
};
struct EpiRnn {
    const bf16* gates; const bf16* gb; bf16* merged;
    __device__ __forceinline__ void operator()(const f32x4 (&acc)[2][2][4][2], const g8::Unit& u, int wr, int wc, int fr, int fq) const {
#pragma unroll
        for (int ai = 0; ai < 2; ++ai)
#pragma unroll
            for (int m = 0; m < 4; ++m) { const int t = u.pm * 256 + ai * 128 + wr * 64 + m * 16 + fr;
#pragma unroll
                for (int bj = 0; bj < 2; ++bj) { const int col = u.pn * 256 + bj * 128 + wc * 32 + 8 * fq;
                    const u32x4 gw = *(const u32x4*)(gates + (size_t)t * 2048 + col), bw = *(const u32x4*)(gb + (size_t)t * 1024 + col);
                    f32x4 g0, g1, b0, b1; unpack8(gw, g0, g1); unpack8(bw, b0, b1);
                    const f32x4 v0 = g0 * acc[ai][bj][m][0] + b0, v1 = g1 * acc[ai][bj][m][1] + b1;
                    *(u32x4*)(merged + (size_t)t * 1024 + col) = pack8(v0, v1); } }
    }
};
struct EpiOut {
    const float* x; const float* mod; bf16* v1;
    __device__ __forceinline__ void operator()(const f32x4 (&acc)[2][2][4][2], const g8::Unit& u, int wr, int wc, int fr, int fq) const {
        const int b = (u.pm * 256) >> 12;
#pragma unroll
        for (int bj = 0; bj < 2; ++bj) { const int col = u.pn * 256 + bj * 128 + wc * 32 + 8 * fq;
            const f32x4 ga = *(const f32x4*)(mod + b * 6144 + 2048 + col) + 1.0f, gb_ = *(const f32x4*)(mod + b * 6144 + 2048 + col + 4) + 1.0f;
#pragma unroll
            for (int ai = 0; ai < 2; ++ai)
#pragma unroll
                for (int m = 0; m < 4; ++m) { const int t = u.pm * 256 + ai * 128 + wr * 64 + m * 16 + fr;
                    const f32x4 x0 = *(const f32x4*)(x + (size_t)t * 1024 + col), x1 = *(const f32x4*)(x + (size_t)t * 1024 + col + 4);
                    const f32x4 v0 = x0 * DN_ALPHA + ga * acc[ai][bj][m][0], v1_ = x1 * DN_ALPHA + gb_ * acc[ai][bj][m][1];
                    *(u32x4*)(v1 + (size_t)t * 1024 + col) = pack8(v0, v1_); } }
    }
};
struct EpiMoe1 {
    const float* bgu; bf16* act;
    __device__ __forceinline__ void operator()(const f32x4 (&acc)[2][2][4][2], const g8::Unit& u, int wr, int wc, int fr, int fq) const {
        const int f = u.pn * 128 + wc * 32 + 8 * fq; const float* bp = bgu + (size_t)u.z * 2048 + f;
        const f32x4 bg0 = *(const f32x4*)bp, bg1 = *(const f32x4*)(bp + 4), bu0 = *(const f32x4*)(bp + 1024), bu1 = *(const f32x4*)(bp + 1028);
#pragma unroll
        for (int ai = 0; ai < 2; ++ai)
#pragma unroll
            for (int m = 0; m < 4; ++m) { const int row = u.pm * 256 + ai * 128 + wr * 64 + m * 16 + fr;
                f32x4 g0 = acc[ai][0][m][0] + bg0, g1 = acc[ai][0][m][1] + bg1, u0 = acc[ai][1][m][0] + bu0, u1 = acc[ai][1][m][1] + bu1;
#pragma unroll
                for (int j = 0; j < 4; ++j) { const float ga = fminf(g0[j], 7.0f), gb_ = fminf(g1[j], 7.0f), ua = fminf(fmaxf(u0[j], -7.0f), 7.0f), ub = fminf(fmaxf(u1[j], -7.0f), 7.0f);
                    g0[j] = ga * fast_sigmoid(1.702f * ga) * (ua + 1.0f); g1[j] = gb_ * fast_sigmoid(1.702f * gb_) * (ub + 1.0f); }
                u32x2 w8; w8.x = pk4_fp8(g0[0], g0[1], g0[2], g0[3]); w8.y = pk4_fp8(g1[0], g1[1], g1[2], g1[3]); *(u32x2*)((unsigned char*)act + (size_t)row * 1024 + f) = w8; }
    }
};
struct EpiMoe2 {
    const float* bd; bf16* yb;
    __device__ __forceinline__ void operator()(const f32x4 (&acc)[2][2][4][2], const g8::Unit& u, int wr, int wc, int fr, int fq) const {
#pragma unroll
        for (int bj = 0; bj < 2; ++bj) { const int col = u.pn * 256 + bj * 128 + wc * 32 + 8 * fq; const float* bp = bd + (size_t)u.z * 1024 + col;
            const f32x4 b0 = *(const f32x4*)bp, b1 = *(const f32x4*)(bp + 4);
#pragma unroll
            for (int ai = 0; ai < 2; ++ai)
#pragma unroll
                for (int m = 0; m < 4; ++m) { const int row = u.pm * 256 + ai * 128 + wr * 64 + m * 16 + fr;
                    *(u32x4*)(yb + (size_t)row * 1024 + col) = pack8(acc[ai][bj][m][0] + b0, acc[ai][bj][m][1] + b1); } }
    }
};

struct S5AOrder { int G, c; const char* acat; const char* ws;
    __device__ __forceinline__ bool next(int i, g8::Unit& u) const { const int L = i * G + c; if (L >= S5G * 4) return false; u.z = L >> 2; u.pm = L & 3; u.pn = 0; u.rl = 0;
        u.A = acat + ((size_t)(u.z * S5M + u.pm * 256) * S5ROW + 128) * 2; u.B = ws + (size_t)u.z * 256 * (S5L * 16) * 2; return true; } };
struct S5COrder { int G, c; const char* acat; const char* wy;
    __device__ __forceinline__ bool next(int i, g8::Unit& u) const { const int L = i * G + c; if (L >= S5G * 8) return false; u.z = L >> 3; u.pm = (L >> 1) & 3; u.pn = L & 1; u.rl = 0;
        u.A = acat + ((size_t)(u.z * S5M + u.pm * 256) * S5ROW) * 2; u.B = wy + ((size_t)(u.z * 512 + u.pn * 256) * S5ROW) * 2; return true; } };
struct MoeOrder { int G, c, NT, RT; const LAS int* tstart; const LAS int* cnt; const int* toklist; const char* A; const char* B; size_t bstride_e; int lda; bool gatherA;
    __device__ __forceinline__ bool next(int i, g8::Unit& u) const { const long L = (long)i * G + c; if (L >= (long)RT * NT) return false; const int rt = (int)(L / NT); u.pn = (int)(L % NT);
        int e = 0;
#pragma unroll 1
        for (int k = 1; k < NE; ++k) if (tstart[k] <= rt) e = k;
        u.z = e; u.pm = rt; u.rl = rt - tstart[e]; u.B = B + (size_t)e * bstride_e + (size_t)u.pn * 256 * 1024; u.A = gatherA ? A : A + (size_t)rt * 256 * 1024; return true; }
    __device__ __forceinline__ void gather(const g8::Unit& u, const int (&Rr)[2], const int (&Cc)[2], unsigned (&vo)[2][2]) const {
        const int n = cnt[u.z];
#pragma unroll
        for (int h = 0; h < 2; ++h)
#pragma unroll
            for (int i = 0; i < 2; ++i) { const int r = u.rl * 256 + h * 128 + Rr[i]; const int tok = r < n ? toklist[u.z * T + r] : 0; vo[h][i] = (unsigned)(tok * lda + Cc[i] * 2); } }
};

__device__ __forceinline__ void transpose_item(const float* W, int N, int k0, int n0, bf16* dst, int ldd, int drow0, LAS float* scr, int lane) {
#pragma unroll 8
    for (int i = 0; i < 32; ++i) { const int kk = 2 * i + (lane >> 5); scr[kk * 33 + (lane & 31)] = W[(size_t)(k0 + kk) * N + n0 + (lane & 31)]; }
    asm volatile("s_waitcnt lgkmcnt(0)" ::: "memory");
    const int c = lane & 7;
#pragma unroll
    for (int j = 0; j < 4; ++j) { const int n = (lane >> 3) + 8 * j; const LAS float* s = scr + (8 * c) * 33 + n;
        u32x4 o; o.x = pk2(s[0 * 33], s[1 * 33]); o.y = pk2(s[2 * 33], s[3 * 33]); o.z = pk2(s[4 * 33], s[5 * 33]); o.w = pk2(s[6 * 33], s[7 * 33]);
        *(u32x4*)(dst + (size_t)(drow0 + n) * ldd + k0 + 8 * c) = o; }
    asm volatile("s_waitcnt lgkmcnt(0)" ::: "memory");
}
__device__ __forceinline__ void transpose_item8(const float* W, int N, int k0, int n0, unsigned char* dst, int ldd, int drow0, LAS float* scr, int lane) {
#pragma unroll 8
    for (int i = 0; i < 32; ++i) { const int kk = 2 * i + (lane >> 5); scr[kk * 33 + (lane & 31)] = W[(size_t)(k0 + kk) * N + n0 + (lane & 31)]; }
    asm volatile("s_waitcnt lgkmcnt(0)" ::: "memory");
    const int c = lane & 7;
#pragma unroll
    for (int j = 0; j < 4; ++j) { const int n = (lane >> 3) + 8 * j; const LAS float* s = scr + (8 * c) * 33 + n;
        u32x2 o; o.x = pk4_fp8(32.f * s[0 * 33], 32.f * s[1 * 33], 32.f * s[2 * 33], 32.f * s[3 * 33]); o.y = pk4_fp8(32.f * s[4 * 33], 32.f * s[5 * 33], 32.f * s[6 * 33], 32.f * s[7 * 33]);
        *(u32x2*)(dst + (size_t)(drow0 + n) * ldd + k0 + 8 * c) = o; }
    asm volatile("s_waitcnt lgkmcnt(0)" ::: "memory");
}
__device__ __forceinline__ int pair_row(int n) { const int f = n & 1023, hi = n >> 10; return (f >> 7) * 256 + hi * 128 + (f & 127); }

__device__ __forceinline__ void moe_tables(Frame& F) {
    LAS int* tstart = (LAS int*)(F.lds + TAB_OFF); LAS int* cl = tstart + 40;
    if (F.tid == 0) { int acc = 0; for (int e = 0; e < NE; ++e) { const int c = (int)F.ctl[CW_CNT + 64 * e]; cl[e] = c; tstart[e] = acc; acc += (c + 255) >> 8; } tstart[NE] = acc; }
    __syncthreads();
}

__device__ __forceinline__ void p0_mod_job(Frame& F, int job) {
    LAS float* sc = (LAS float*)F.lds;
    LAS float* red = sc + 8 * 1024;
    const float* c = F.in[1]; const float* w = F.in[2]; const float* bias = F.in[3];
    for (int i = F.tid; i < 8 * 1024; i += 512) { const float v = c[i]; sc[i] = v * fast_sigmoid(v); }
    __syncthreads();
    const int col = F.tid & 31, kg = F.tid >> 5, j = job * 32 + col;
    float a[8];
#pragma unroll
    for (int b = 0; b < 8; ++b) a[b] = 0.f;
#pragma unroll 8
    for (int k = kg * 64; k < kg * 64 + 64; ++k) { const float wv = w[(size_t)k * 6144 + j];
#pragma unroll
        for (int b = 0; b < 8; ++b) a[b] += sc[b * 1024 + k] * wv; }
#pragma unroll
    for (int b = 0; b < 8; ++b) red[(kg * 8 + b) * 32 + col] = a[b];
    __syncthreads();
    if (F.tid < 256) { const int b = F.tid >> 5, cc = F.tid & 31; float s = 0.f;
#pragma unroll
        for (int g = 0; g < 16; ++g) s += red[(g * 8 + b) * 32 + cc];
        WSP(float, WS_MOD)[b * 6144 + job * 32 + cc] = s + bias[job * 32 + cc]; }
    __syncthreads();
}
__device__ __forceinline__ void s5_setup(Frame& F, int g, int kmin, int kmax, LAS f32x2* Bb, LAS f32x2* Cc, LAS f32x2* Ap) {
    const float* lre = F.in[14] + g * 64; const float* lim = F.in[15] + g * 64; const float dt = expf(F.in[16][g]);
    const float* bre = F.in[17] + g * 1024; const float* bim = F.in[18] + g * 1024; const float* cre = F.in[19] + g * 1024; const float* cim = F.in[20] + g * 1024;
    for (int i = F.tid; i < 1024; i += 512) { const int p = i >> 4; const float lr = lre[p], li = lim[p]; const float mag = expf(lr * dt); float sn, cs; sincosf(li * dt, &sn, &cs);
        const float ar = mag * cs, ai = mag * sn, den = lr * lr + li * li, qr = ((ar - 1.f) * lr + ai * li) / den, qi = (ai * lr - (ar - 1.f) * li) / den;
        const float br = bre[i], bi = bim[i]; Bb[i] = (f32x2){qr * br - qi * bi, qr * bi + qi * br};
        Cc[i] = (f32x2){cre[i], cim[i]}; }
    for (int i = kmin * 64 + F.tid; i < (kmax + 1) * 64; i += 512) { const int k = i >> 6, p = i & 63; const float lr = lre[p], li = lim[p]; const float mag = expf((float)k * lr * dt); float sn, cs; sincosf((float)k * li * dt, &sn, &cs);
        Ap[i] = (f32x2){mag * cs, mag * sn}; }
    __syncthreads();
}
constexpr size_t WS_KTAB = WS_S;
__device__ __forceinline__ void p0_s5k_job(Frame& F, int job) {
    const int g = job >> 3, part = job & 7;
    LAS f32x2* Bb = (LAS f32x2*)F.lds; LAS f32x2* Cc = Bb + 1024; LAS f32x2* Ap = Cc + 1024;
    s5_setup(F, g, 4 * part, 4 * part + 3, Bb, Cc, Ap);
    float* kt = WSP(float, WS_KTAB) + (size_t)g * 32 * 256;
    for (int e = 4 * part * 256 + F.tid; e < (4 * part + 4) * 256; e += 512) { const int k = e >> 8, c = (e >> 4) & 15, c2 = e & 15; float s = 0.f;
        for (int p = 0; p < 64; ++p) { const f32x2 cv = Cc[c * 64 + p], av = Ap[k * 64 + p], bv = Bb[p * 16 + c2];
            const float car = cv.x * av.x - cv.y * av.y, cai = cv.x * av.y + cv.y * av.x; s += car * bv.x - cai * bv.y; }
        kt[e] = s; }
    __syncthreads();
}
__device__ __forceinline__ void p1_s5w_job(Frame& F, int job) {
    const int g = job >> 3, part = job & 7;
    LAS f32x2* Bb = (LAS f32x2*)F.lds; LAS f32x2* Cc = Bb + 1024; LAS f32x2* Ap = Cc + 1024; LAS float* Kt = (LAS float*)(Ap + 33 * 64);
    const float* ktg = WSP(float, WS_KTAB) + (size_t)g * 32 * 256; const float* dsk = F.in[21] + g * 16;
    for (int i = F.tid; i < 32 * 256; i += 512) Kt[i] = ktg[i];
    s5_setup(F, g, 0, S5L, Bb, Cc, Ap);
    if (part == 0 && F.tid < 64) WSP(f32x2, WS_AL)[g * 64 + F.tid] = Ap[S5L * 64 + F.tid];
    bf16* wy = WSP(bf16, WS_WY) + (size_t)g * 512 * S5ROW;
    for (int ch = F.tid; ch < 64 * (S5ROW / 8); ch += 512) { const int n = part * 64 + ch / (S5ROW / 8), k8 = (ch % (S5ROW / 8)) * 8, i = n >> 4, c = n & 15; float v[8];
        if (k8 < 128) {
#pragma unroll
            for (int j = 0; j < 8; j += 2) { const int p = (k8 + j) >> 1; const f32x2 cv = Cc[c * 64 + p], av = Ap[(i + 1) * 64 + p]; v[j] = cv.x * av.x - cv.y * av.y; v[j + 1] = -(cv.x * av.y + cv.y * av.x); } }
        else { const int jj = (k8 - 128) >> 4, c2 = (k8 - 128) & 15;
#pragma unroll
            for (int j = 0; j < 8; ++j) { float x = 0.f; if (jj <= i) { x = Kt[(i - jj) * 256 + c * 16 + c2 + j]; if (jj == i && c == c2 + j) x += dsk[c]; } v[j] = x; } }
        u32x4 o; o.x = pk2(v[0], v[1]); o.y = pk2(v[2], v[3]); o.z = pk2(v[4], v[5]); o.w = pk2(v[6], v[7]);
        *(u32x4*)(wy + (size_t)n * S5ROW + k8) = o; }
    bf16* wsm = WSP(bf16, WS_WS) + (size_t)g * 256 * 512;
    for (int ch = F.tid; ch < 32 * 64; ch += 512) { const int n = part * 32 + (ch >> 6), k8 = (ch & 63) * 8, jj = k8 >> 4, c2 = k8 & 15; float v[8];
#pragma unroll
        for (int j = 0; j < 8; ++j) { float x = 0.f; if (n < 128) { const int p = n >> 1; const f32x2 av = Ap[(S5L - 1 - jj) * 64 + p], bv = Bb[p * 16 + c2 + j]; x = (n & 1) ? (av.x * bv.y + av.y * bv.x) : (av.x * bv.x - av.y * bv.y); } v[j] = x; }
        u32x4 o; o.x = pk2(v[0], v[1]); o.y = pk2(v[2], v[3]); o.z = pk2(v[4], v[5]); o.w = pk2(v[6], v[7]);
        *(u32x4*)(wsm + (size_t)n * 512 + k8) = o; }
    __syncthreads();
}
__device__ __forceinline__ void p0_small_transposes(Frame& F) {
    LAS float* scr = (LAS float*)(F.lds + F.wave * 16384);
    const int gw = F.vcu * 8 + F.wave, NGW = F.G * 8;
    constexpr int I_IN = 16 * 144, I_RNN = 16 * 32, I_OUT = 16 * 32, I_GLU = 8 * 64, I_RG = 16 * 8;
    for (int it = gw; it < I_IN + I_RNN + I_OUT + I_GLU + I_RG; it += NGW) { int r = it;
        if (r < I_IN) { const int kb = r / 144, nb = r % 144; transpose_item(F.in[4], INC, kb * 64, nb * 32, WSP(bf16, WS_WIN), 1024, nb * 32, scr, F.lane); continue; } r -= I_IN;
        if (r < I_RNN) { const int kb = r / 32, nb = r % 32; transpose_item(F.in[13], 1024, kb * 64, nb * 32, WSP(bf16, WS_WRNN), 1024, nb * 32, scr, F.lane); continue; } r -= I_RNN;
        if (r < I_OUT) { const int kb = r / 32, nb = r % 32; transpose_item(F.in[23], 1024, kb * 64, nb * 32, WSP(bf16, WS_WOUT), 1024, nb * 32, scr, F.lane); continue; } r -= I_OUT;
        if (r < I_GLU) { const int kb = r / 64, nb = r % 64; transpose_item(F.in[22], 2048, kb * 64, nb * 32, WSP(bf16, WS_WGLU), 512, pair_row(nb * 32), scr, F.lane); continue; } r -= I_GLU;
        { const int mat = r >> 3, kb = (r >> 2) & 1, nb = r & 3, hd = mat & 7, gx = mat >> 3;
          transpose_item(F.in[gx ? 10 : 8] + (size_t)hd * 128 * 128, 128, kb * 64, nb * 32, WSP(bf16, WS_WG), 128, hd * 256 + gx * 128 + nb * 32, scr, F.lane); }
    }
}
__device__ __forceinline__ void p1_body(Frame& F) {
    const int gw = F.vcu * 8 + F.wave, NGW = F.G * 8; const float* mod = WSP(float, WS_MOD); bf16* hbf = WSP(bf16, WS_HBF);
    for (int t = gw; t < T; t += NGW) { const int b = t >> 12; const f32x4* xr = (const f32x4*)(F.in[0] + (size_t)t * 1024) + F.lane; const f32x4* sh = (const f32x4*)(mod + b * 6144) + F.lane; const f32x4* sc = (const f32x4*)(mod + b * 6144 + 1024) + F.lane;
        u32x2* o = (u32x2*)(hbf + (size_t)t * 1024) + F.lane;
#pragma unroll
        for (int j = 0; j < 4; ++j) { const f32x4 v = xr[64 * j] * (sc[64 * j] + 1.0f) + sh[64 * j]; u32x2 w; w.x = pk2(v[0], v[1]); w.y = pk2(v[2], v[3]); o[64 * j] = w; } }
    LAS float* scr = (LAS float*)(F.lds + F.wave * 16384);
    constexpr int I_GU = 16 * 64, I_D = 16 * 32;
    for (int it = gw; it < NE * (I_GU + I_D); it += NGW) { const int e = it / (I_GU + I_D); int r = it % (I_GU + I_D);
        if (r < I_GU) { const int kb = r / 64, nb = r % 64; transpose_item8(F.in[28] + (size_t)e * 1024 * 2048, 2048, kb * 64, nb * 32, WSP(unsigned char, WS_WGU) + (size_t)e * 2048 * 1024, 1024, pair_row(nb * 32), scr, F.lane); }
        else { r -= I_GU; const int kb = r / 32, nb = r % 32; transpose_item8(F.in[30] + (size_t)e * 1024 * 1024, 1024, kb * 64, nb * 32, WSP(unsigned char, WS_WD) + (size_t)e * 1024 * 1024, 1024, nb * 32, scr, F.lane); } }
}
constexpr int XR_LD = 136, XR_TILE = 128 * XR_LD;
__device__ __forceinline__ void rg_issue(const bf16* xrnn, const bf16* gy, int item, int tid, u32x4 (&xraw)[4][4], u32x4 (&graw)[4], bool pass1) {
    const int hd = item & 7, c = (item >> 3) & 31, b = item >> 8, r0 = tid >> 4, ch = hd * 128 + (tid & 15) * 8;
#pragma unroll
    for (int q = 0; q < 4; ++q) { const int r = r0 + 32 * q;
#pragma unroll
        for (int k = 0; k < 4; ++k) { const int tp = c * RGL + r - 3 + k, tpc = tp < 0 ? 0 : tp; xraw[q][k] = *(const u32x4*)(xrnn + (size_t)(b * SEQ + tpc) * 1024 + ch); }
        if (pass1) graw[q] = *(const u32x4*)(gy + (size_t)(b * SEQ + c * RGL + r) * 1024 + ch); }
}
__device__ __forceinline__ void rg_convwrite(const float* cw, const float* cb, int item, int tid, const u32x4 (&xraw)[4][4], const u32x4 (&graw)[4], LAS bf16* xr, LAS bf16* gyt, bool pass1) {
    const int hd = item & 7, c = (item >> 3) & 31, r0 = tid >> 4, c8 = (tid & 15) * 8, ch = hd * 128 + c8;
    const f32x4 b0 = *(const f32x4*)(cb + ch), b1 = *(const f32x4*)(cb + ch + 4);
    f32x4 w0[4], w1[4];
#pragma unroll
    for (int k = 0; k < 4; ++k) { w0[k] = *(const f32x4*)(cw + k * 1024 + ch); w1[k] = *(const f32x4*)(cw + k * 1024 + ch + 4); }
#pragma unroll
    for (int q = 0; q < 4; ++q) { const int r = r0 + 32 * q; f32x4 a0 = b0, a1 = b1;
#pragma unroll
        for (int k = 0; k < 4; ++k) { const int tp = c * RGL + r - 3 + k; f32x4 x0, x1; unpack8(xraw[q][k], x0, x1); if (tp < 0) { x0 = (f32x4){0.f, 0.f, 0.f, 0.f}; x1 = x0; } a0 += w0[k] * x0; a1 += w1[k] * x1; }
        *(LAS u32x4*)(xr + r * XR_LD + c8) = pack8(a0, a1);
        if (pass1) *(LAS u32x4*)(gyt + r * XR_LD + c8) = graw[q]; }
}
template <int PASS>
__device__ __forceinline__ void rglru_phase(Frame& F) {
    const int NIT = NB * RGC * 8;
    int it = F.vcu; if (it >= NIT) return;
    LAS bf16* xr = (LAS bf16*)F.lds; LAS bf16* gyt0 = xr + XR_TILE;
    const bf16* xrnn = WSP(bf16, WS_XRNN); const bf16* gy = WSP(bf16, WS_GY); bf16* ha = WSP(bf16, WS_HA); const float* cw = F.in[6]; const float* cb = F.in[7];
    const int tid = F.tid, w = F.wave, q = F.lane >> 4, col = F.lane & 15, chl = 16 * w + col;
    u32x4 xraw[4][4], graw[4];
    rg_issue(xrnn, gy, it, tid, xraw, graw, PASS);
    rg_convwrite(cw, cb, it, tid, xraw, graw, xr, gyt0, PASS);
    int hd_loaded = -1; bf16x8 Bf[2][4]; float ba = 0.f, bx = 0.f, sp = 0.f;
    __syncthreads();
    for (int i = 0; it < NIT; ++i) {
        const int nit = it + F.G; const bool has_next = nit < NIT;
        const int hd = it & 7, c = (it >> 3) & 31, b = it >> 8, t0 = b * SEQ + c * RGL, ch = hd * 128 + chl;
        LAS bf16* gyt = gyt0 + (i & 1) * XR_TILE; LAS bf16* gytn = gyt0 + ((i & 1) ^ 1) * XR_TILE;
        if (has_next) rg_issue(xrnn, gy, nit, tid, xraw, graw, PASS);
        if (hd != hd_loaded) { hd_loaded = hd; const bf16* wg = WSP(bf16, WS_WG) + (size_t)hd * 256 * 128;
#pragma unroll
            for (int gt = 0; gt < 2; ++gt)
#pragma unroll
                for (int kk = 0; kk < 4; ++kk) Bf[gt][kk] = *(const bf16x8*)(wg + (size_t)(gt * 128 + chl) * 128 + kk * 32 + q * 8);
            ba = F.in[9][ch]; bx = F.in[11][ch]; const float lam = F.in[12][ch]; sp = (lam > 15.f) ? __expf(-lam) : log1pf(__expf(-lam)); }
        float carryH = 0.f, carryP = 1.f;
        if (PASS) carryH = WSP(float, WS_HIN)[(size_t)(b * RGC + c) * 1024 + ch];
        __builtin_amdgcn_sched_barrier(0);
        f32x4 acc[8][2];
#pragma unroll
        for (int m = 0; m < 8; ++m) { acc[m][0] = (f32x4){0.f, 0.f, 0.f, 0.f}; acc[m][1] = (f32x4){0.f, 0.f, 0.f, 0.f}; }
#pragma unroll
        for (int kk = 0; kk < 4; ++kk)
#pragma unroll
            for (int m = 0; m < 8; ++m) { const bf16x8 Af = *(const LAS bf16x8*)(xr + (16 * m + col) * XR_LD + kk * 32 + q * 8);
                acc[m][0] = __builtin_amdgcn_mfma_f32_16x16x32_bf16(Af, Bf[0][kk], acc[m][0], 0, 0, 0);
                acc[m][1] = __builtin_amdgcn_mfma_f32_16x16x32_bf16(Af, Bf[1][kk], acc[m][1], 0, 0, 0); }
#pragma unroll
        for (int m = 0; m < 8; ++m) {
            float a[4], uu[4];
#pragma unroll
            for (int j = 0; j < 4; ++j) { const int tl = 16 * m + 4 * q + j;
                const float r = fast_sigmoid(acc[m][0][j] + ba), ii = fast_sigmoid(acc[m][1][j] + bx);
                const float la = -11.541560327f * r * sp; a[j] = __builtin_amdgcn_exp2f(la); const float mult = __builtin_amdgcn_sqrtf(fmaxf(1.0f - a[j] * a[j], 0.f));
                uu[j] = mult * ii * bf1(xr[tl * XR_LD + chl]); }
            float sP = a[0], sH = uu[0];
#pragma unroll
            for (int j = 1; j < 4; ++j) { sH = a[j] * sH + uu[j]; sP *= a[j]; }
            float iP = sP, iH = sH;
            { const float pP = __shfl_up(iP, 16), pH = __shfl_up(iH, 16); if (q >= 1) { iH = iP * pH + iH; iP = iP * pP; } }
            { const float pP = __shfl_up(iP, 32), pH = __shfl_up(iH, 32); if (q >= 2) { iH = iP * pH + iH; iP = iP * pP; } }
            float eP = __shfl_up(iP, 16), eH = __shfl_up(iH, 16); if (q == 0) { eP = 1.f; eH = 0.f; }
            const float tP = __shfl(iP, col + 48), tH = __shfl(iH, col + 48);
            if (PASS) { float h = eP * carryH + eH;
#pragma unroll
                for (int j = 0; j < 4; ++j) { const int tl = 16 * m + 4 * q + j; h = a[j] * h + uu[j]; LAS bf16* gp = gyt + tl * XR_LD + chl; *gp = (bf16)f2bf(h * bf1(*gp)); } }
            carryH = tP * carryH + tH; carryP *= tP;
        }
        if (!PASS && q == 0) { f32x2* ag = WSP(f32x2, WS_RGAGG); ag[(size_t)(b * RGC + c) * 1024 + ch] = (f32x2){carryP, carryH}; }
        __syncthreads();
        if (PASS) { const int r0 = tid >> 4, c8 = (tid & 15) * 8;
#pragma unroll
            for (int qq = 0; qq < 4; ++qq) { const int r = r0 + 32 * qq; *(u32x4*)(ha + (size_t)(t0 + r) * 1024 + hd * 128 + c8) = *(const LAS u32x4*)(gyt + r * XR_LD + c8); } }
        if (has_next) rg_convwrite(cw, cb, nit, tid, xraw, graw, xr, gytn, PASS);
        __syncthreads();
        it = nit;
    }
}
__device__ __forceinline__ void p4_carries(Frame& F) {
    LAS f32x2* seg = (LAS f32x2*)F.lds;
    for (int job = F.vcu; job < NB * S5G; job += F.G) {
        const int b = job >> 5, g = job & 31, p = F.lane, w = F.wave;
        const f32x2 al = WSP(f32x2, WS_AL)[g * 64 + p];
        const f32x2* Sb = WSP(f32x2, WS_S) + ((size_t)(g * S5M + b * S5CPB + 16 * w)) * 64 + p; unsigned* ac = (unsigned*)(WSP(bf16, WS_ACAT) + ((size_t)(g * S5M + b * S5CPB + 16 * w)) * S5ROW) + p;
        f32x2 sv[16];
#pragma unroll
        for (int i = 0; i < 16; ++i) sv[i] = Sb[(size_t)i * 64];
        float xr_ = 0.f, xi = 0.f;
#pragma unroll
        for (int i = 0; i < 16; ++i) { const float nr = al.x * xr_ - al.y * xi + sv[i].x, ni = al.x * xi + al.y * xr_ + sv[i].y; xr_ = nr; xi = ni; }
        seg[w * 64 + p] = (f32x2){xr_, xi};
        float ar = al.x, ai = al.y;
#pragma unroll
        for (int q = 0; q < 4; ++q) { const float nr = ar * ar - ai * ai, ni = 2.f * ar * ai; ar = nr; ai = ni; }
        __syncthreads();
        xr_ = 0.f; xi = 0.f;
        for (int ww = 0; ww < w; ++ww) { const f32x2 sg = seg[ww * 64 + p]; const float nr = ar * xr_ - ai * xi + sg.x, ni = ar * xi + ai * xr_ + sg.y; xr_ = nr; xi = ni; }
#pragma unroll
        for (int i = 0; i < 16; ++i) { ac[(size_t)i * (S5ROW / 2)] = pk2(xr_, xi); const float nr = al.x * xr_ - al.y * xi + sv[i].x, ni = al.x * xi + al.y * xr_ + sv[i].y; xr_ = nr; xi = ni; }
        __syncthreads();
    }
    if (F.vcu < 16) {
        const int id = F.vcu * 512 + F.tid, ch = id & 1023, b = id >> 10; const f32x2* ag = WSP(f32x2, WS_RGAGG) + (size_t)b * RGC * 1024 + ch; float* hin = WSP(float, WS_HIN) + (size_t)b * RGC * 1024 + ch;
        f32x2 a[RGC];
#pragma unroll
        for (int c = 0; c < RGC; ++c) a[c] = ag[(size_t)c * 1024];
        float h = 0.f;
#pragma unroll
        for (int c = 0; c < RGC; ++c) { hin[(size_t)c * 1024] = h; h = a[c].x * h + a[c].y; }
    }
}
constexpr int WR_LD = 1028;
__device__ __forceinline__ void p9_router(Frame& F) {
    LAS float* wrt = (LAS float*)F.lds;
    LAS unsigned* rec = (LAS unsigned*)(F.lds + 32 * WR_LD * 4);
    LAS float* recp = (LAS float*)(rec + 512);
    LAS int* lcnt = (LAS int*)(recp + 512);
    LAS int* gbase = lcnt + 32;
    const float* wr = F.in[26];
    for (int i = F.tid; i < 1024 * 32; i += 512) wrt[(i & 31) * WR_LD + (i >> 5)] = wr[i];
    if (F.tid < 32) lcnt[F.tid] = 0;
    __syncthreads();
    const float* mod = WSP(float, WS_MOD); const bf16* v1 = WSP(bf16, WS_V1); bf16* x1 = WSP(bf16, WS_X1); bf16* h2 = WSP(bf16, WS_H2);
    const int lane = F.lane;
    f32x4 lg[4], lb[4];
#pragma unroll
    for (int j = 0; j < 4; ++j) { lg[j] = *((const f32x4*)F.in[24] + 64 * j + lane); lb[j] = *((const f32x4*)F.in[25] + 64 * j + lane); }
    const float brt = F.in[27][lane >> 1];
    for (int blk = F.vcu; blk < T / 128; blk += F.G) {
        for (int it = 0; it < 16; ++it) { const int ti = F.wave * 16 + it, t = blk * 128 + ti, b = t >> 12;
            f32x4 v[4]; float s = 0.f;
#pragma unroll
            for (int j = 0; j < 4; ++j) { const u32x2 w = *((const u32x2*)(v1 + (size_t)t * 1024) + 64 * j + lane); v[j] = (f32x4){bflo(w.x), bfhi(w.x), bflo(w.y), bfhi(w.y)}; s += (v[j][0] + v[j][1]) + (v[j][2] + v[j][3]); }
            const float mean = wave_sum(s) * (1.f / 1024.f); float s2 = 0.f;
#pragma unroll
            for (int j = 0; j < 4; ++j) { v[j] = v[j] - mean; s2 += (v[j][0] * v[j][0] + v[j][1] * v[j][1]) + (v[j][2] * v[j][2] + v[j][3] * v[j][3]); }
            const float rstd = 1.f / sqrtf(wave_sum(s2) * (1.f / 1024.f) + LN_EPS);
            f32x4 hh[4];
#pragma unroll
            for (int j = 0; j < 4; ++j) { const f32x4 xv = v[j] * rstd * lg[j] + lb[j]; u32x2 w; w.x = pk2(xv[0], xv[1]); w.y = pk2(xv[2], xv[3]); *((u32x2*)(x1 + (size_t)t * 1024) + 64 * j + lane) = w;
                const f32x4 sh = *((const f32x4*)(mod + b * 6144 + 3072) + 64 * j + lane), sc = *((const f32x4*)(mod + b * 6144 + 4096) + 64 * j + lane);
                hh[j] = xv * (sc + 1.0f) + sh; *((unsigned*)((unsigned char*)h2 + (size_t)t * 1024) + 64 * j + lane) = pk4_fp8(hh[j][0], hh[j][1], hh[j][2], hh[j][3]); }
            float lgt[32];
#pragma unroll
            for (int e = 0; e < 32; ++e) { float a = 0.f;
#pragma unroll
                for (int j = 0; j < 4; ++j) { const f32x4 wv = *((const LAS f32x4*)(wrt + e * WR_LD) + 64 * j + lane); a += (hh[j][0] * wv[0] + hh[j][1] * wv[1]) + (hh[j][2] * wv[2] + hh[j][3] * wv[3]); }
                lgt[e] = a; }
#pragma unroll
            for (int i = 0; i < 16; ++i) { const bool up = (lane & 32) != 0; const float send = up ? lgt[i] : lgt[i + 16], keep = up ? lgt[i + 16] : lgt[i]; lgt[i] = keep + __shfl_xor(send, 32); }
#pragma unroll
            for (int i = 0; i < 8; ++i) { const bool up = (lane & 16) != 0; const float send = up ? lgt[i] : lgt[i + 8], keep = up ? lgt[i + 8] : lgt[i]; lgt[i] = keep + __shfl_xor(send, 16); }
#pragma unroll
            for (int i = 0; i < 4; ++i) { const bool up = (lane & 8) != 0; const float send = up ? lgt[i] : lgt[i + 4], keep = up ? lgt[i + 4] : lgt[i]; lgt[i] = keep + __shfl_xor(send, 8); }
#pragma unroll
            for (int i = 0; i < 2; ++i) { const bool up = (lane & 4) != 0; const float send = up ? lgt[i] : lgt[i + 2], keep = up ? lgt[i + 2] : lgt[i]; lgt[i] = keep + __shfl_xor(send, 4); }
            { const bool up = (lane & 2) != 0; const float send = up ? lgt[0] : lgt[1], keep = up ? lgt[1] : lgt[0]; lgt[0] = keep + __shfl_xor(send, 2); }
            const float logit = lgt[0] + __shfl_xor(lgt[0], 1) + brt;
            int rank = 0; const int me = lane >> 1;
#pragma unroll
            for (int e = 0; e < 32; ++e) { const float o = __shfl(logit, 2 * e); rank += (o > logit || (o == logit && e < me)) ? 1 : 0; }
            float tv[4]; int te[4];
#pragma unroll
            for (int k = 0; k < 4; ++k) { const unsigned long long mk = __ballot(rank == k && (lane & 1) == 0); const int src = __builtin_ctzll(mk); te[k] = src >> 1; tv[k] = __shfl(logit, src); }
            float pe[4], ps = 0.f;
#pragma unroll
            for (int k = 0; k < 4; ++k) { pe[k] = __expf(tv[k] - tv[0]); ps += pe[k]; }
            if (lane < 4) { const int e = te[0] * (lane == 0) + te[1] * (lane == 1) + te[2] * (lane == 2) + te[3] * (lane == 3);
                const float p = (pe[0] * (lane == 0) + pe[1] * (lane == 1) + pe[2] * (lane == 2) + pe[3] * (lane == 3)) / ps;
                const int lr = __hip_atomic_fetch_add(lcnt + e, 1, __ATOMIC_RELAXED, __HIP_MEMORY_SCOPE_WORKGROUP); rec[ti * 4 + lane] = ((unsigned)e << 16) | (unsigned)lr; recp[ti * 4 + lane] = p; }
        }
        __syncthreads();
        if (F.tid < 32) { const int n = lcnt[F.tid]; gbase[F.tid] = n ? (int)atomicAdd(F.ctl + CW_CNT + 64 * F.tid, (unsigned)n) : 0; lcnt[F.tid] = 0; }
        __syncthreads();
        { const unsigned r = rec[F.tid]; const int e = r >> 16, rk = gbase[e] + (int)(r & 0xffffu), t = blk * 128 + (F.tid >> 2);
          WSP(int, WS_TOK)[(size_t)e * T + rk] = t; WSP(unsigned, WS_POS)[(size_t)t * 4 + (F.tid & 3)] = ((unsigned)e << 20) | (unsigned)rk; WSP(float, WS_PROB)[(size_t)t * 4 + (F.tid & 3)] = recp[F.tid]; }
        __syncthreads();
    }
}
__device__ __forceinline__ void p12_final(Frame& F) {
    moe_tables(F);
    const LAS int* tstart = (const LAS int*)(F.lds + TAB_OFF);
    const float* mod = WSP(float, WS_MOD); const bf16* x1 = WSP(bf16, WS_X1); const bf16* yb = WSP(bf16, WS_YB); const unsigned* pos = WSP(unsigned, WS_POS); const float* prob = WSP(float, WS_PROB);
    const int lane = F.lane, gw = F.vcu * 8 + F.wave, NGW = F.G * 8;
    f32x4 lg[4], lb[4];
#pragma unroll
    for (int j = 0; j < 4; ++j) { lg[j] = *((const f32x4*)F.in[32] + 64 * j + lane); lb[j] = *((const f32x4*)F.in[33] + 64 * j + lane); }
    for (int tb = gw; tb < T; tb += 2 * NGW) {
        unsigned pp[2][4]; float pw[2][4]; u32x2 yw[2][4][4], xw[2][4];
#pragma unroll
        for (int q = 0; q < 2; ++q) { const int t = tb + q * NGW; const u32x4 p4 = *(const u32x4*)(pos + (size_t)t * 4); const f32x4 w4 = *(const f32x4*)(prob + (size_t)t * 4);
            pp[q][0] = p4.x; pp[q][1] = p4.y; pp[q][2] = p4.z; pp[q][3] = p4.w; pw[q][0] = w4[0]; pw[q][1] = w4[1]; pw[q][2] = w4[2]; pw[q][3] = w4[3]; }
#pragma unroll
        for (int q = 0; q < 2; ++q) { const int t = tb + q * NGW;
#pragma unroll
            for (int k = 0; k < 4; ++k) { const int e = pp[q][k] >> 20, rk = pp[q][k] & 0xfffffu; const size_t slot = (size_t)tstart[e] * 256 + rk;
#pragma unroll
                for (int j = 0; j < 4; ++j) yw[q][k][j] = *((const u32x2*)(yb + slot * 1024) + 64 * j + lane); }
#pragma unroll
            for (int j = 0; j < 4; ++j) xw[q][j] = *((const u32x2*)(x1 + (size_t)t * 1024) + 64 * j + lane); }
#pragma unroll
        for (int q = 0; q < 2; ++q) { const int t = tb + q * NGW, b = t >> 12;
            f32x4 v[4]; float s = 0.f;
#pragma unroll
            for (int j = 0; j < 4; ++j) { f32x4 f = (f32x4){0.f, 0.f, 0.f, 0.f};
#pragma unroll
                for (int k = 0; k < 4; ++k) { const u32x2 w = yw[q][k][j]; f += (f32x4){bflo(w.x), bfhi(w.x), bflo(w.y), bfhi(w.y)} * pw[q][k]; }
                const u32x2 w = xw[q][j]; const f32x4 g2 = *((const f32x4*)(mod + b * 6144 + 5120) + 64 * j + lane) + 1.0f;
                v[j] = (f32x4){bflo(w.x), bfhi(w.x), bflo(w.y), bfhi(w.y)} * DN_ALPHA + g2 * f; s += (v[j][0] + v[j][1]) + (v[j][2] + v[j][3]); }
            const float mean = wave_sum(s) * (1.f / 1024.f); float s2 = 0.f;
#pragma unroll
            for (int j = 0; j < 4; ++j) { v[j] = v[j] - mean; s2 += (v[j][0] * v[j][0] + v[j][1] * v[j][1]) + (v[j][2] * v[j][2] + v[j][3] * v[j][3]); }
            const float rstd = 1.f / sqrtf(wave_sum(s2) * (1.f / 1024.f) + LN_EPS);
#pragma unroll
            for (int j = 0; j < 4; ++j) *((f32x4*)(F.out + (size_t)t * 1024) + 64 * j + lane) = v[j] * rstd * lg[j] + lb[j]; }
    }
}

struct Args { const float* in[34]; float* out; unsigned char* ws; int ph_lo, ph_hi; };
__global__ void __launch_bounds__(512, 2) fwd_kernel(Args args) {
    extern __shared__ __attribute__((aligned(16))) unsigned char lds_raw[];
    Frame F;
    F.lds = (LAS unsigned char*)lds_raw; F.MISC = (volatile LAS unsigned*)(F.lds + MISC_OFF);
    F.tid = threadIdx.x; F.lane = F.tid & 63; F.wave = __builtin_amdgcn_readfirstlane(F.tid >> 6);
    F.G = gridDim.x; { const int bx = blockIdx.x; F.vcu = (F.G % 8 == 0) ? (bx % 8) * (F.G / 8) + bx / 8 : bx; }
#pragma unroll
    for (int i = 0; i < 34; ++i) F.in[i] = args.in[i];
    F.out = args.out; F.ws = args.ws; F.ctl = (unsigned*)(args.ws + WS_CTL);
    if (F.tid < 64) F.MISC[F.tid] = 0u;
    __syncthreads();
    XcdBarrier bar; bar.bar = F.ctl + CW_BAR; bar.x = 0; bar.st = nullptr;
    if (MK_N_LAUNCHES == 1) bar = xcd_barrier_post(F.ctl + CW_BAR, F.MISC + 8);
    const int lo = args.ph_lo, hi = args.ph_hi;
#define IN(k) (lo <= (k) && (k) < hi)
#define SEAM(k) do { if (IN(k) && IN((k) + 1)) xcd_barrier(bar); } while (0)

    if (IN(0)) REPS(0) { if (rep_) xcd_barrier(bar);
        for (int j = F.vcu; j < 192; j += F.G) p0_mod_job(F, j);
        for (int j = F.vcu; j < S5G * 8; j += F.G) p0_s5k_job(F, j);
        p0_small_transposes(F);
    }
    SEAM(0);
    if (IN(1)) REPS(1) { if (rep_) xcd_barrier(bar); for (int j = F.vcu; j < S5G * 8; j += F.G) p1_s5w_job(F, j); p1_body(F); }
    SEAM(1);
    if (IN(2)) REPS(2) { if (rep_) xcd_barrier(bar);
        g8::GridOrder S; S.init(T, INC, F.G, (int)blockIdx.x, WSP(bf16, WS_HBF), WSP(bf16, WS_WIN), 1024, 1024);
        EpiInProj E{F.in[5], WSP(bf16, WS_XRNN), WSP(bf16, WS_GY), WSP(bf16, WS_ACAT), WSP(bf16, WS_GATES)};
        g8::gemm_phase<EpiInProj, g8::GridOrder, false>(F.lds, 2048, 2048, 2048, S, E);
    }
    SEAM(2);
    if (IN(3)) REPS(3) { if (rep_) xcd_barrier(bar);
        { S5AOrder S{F.G, F.vcu, (const char*)WSP(bf16, WS_ACAT), (const char*)WSP(bf16, WS_WS)}; EpiS5A E{WSP(float, WS_S)};
          g8::gemm_phase<EpiS5A, S5AOrder, false>(F.lds, S5L * 32, S5ROW * 2, S5L * 32, S, E); }
        __syncthreads();
        rglru_phase<0>(F);
    }
    SEAM(3);
    if (IN(4)) REPS(4) { if (rep_) xcd_barrier(bar); p4_carries(F); }
    SEAM(4);
    if (IN(5)) REPS(5) { if (rep_) xcd_barrier(bar);
        { S5COrder S{F.G, F.vcu, (const char*)WSP(bf16, WS_ACAT), (const char*)WSP(bf16, WS_WY)}; EpiS5C E{WSP(bf16, WS_YS)};
          g8::gemm_phase<EpiS5C, S5COrder, false>(F.lds, S5ROW * 2, S5ROW * 2, S5ROW * 2, S, E); }
        __syncthreads();
        rglru_phase<1>(F);
    }
    SEAM(5);
    if (IN(6)) REPS(6) { if (rep_) xcd_barrier(bar);
        g8::GridOrder S; S.init(T, 2048, F.G, (int)blockIdx.x, WSP(bf16, WS_YS), WSP(bf16, WS_WGLU), 512, 512);
        EpiGlu E{WSP(bf16, WS_GATES), WSP(bf16, WS_GB)};
        g8::gemm_phase<EpiGlu, g8::GridOrder, false>(F.lds, 1024, 1024, 1024, S, E);
    }
    SEAM(6);
    if (IN(7)) REPS(7) { if (rep_) xcd_barrier(bar);
        g8::GridOrder S; S.init(T, 1024, F.G, (int)blockIdx.x, WSP(bf16, WS_HA), WSP(bf16, WS_WRNN), 1024, 1024);
        EpiRnn E{WSP(bf16, WS_GATES), WSP(bf16, WS_GB), WSP(bf16, WS_MERGED)};
        g8::gemm_phase<EpiRnn, g8::GridOrder, false>(F.lds, 2048, 2048, 2048, S, E);
    }
    SEAM(7);
    if (IN(8)) REPS(8) { if (rep_) xcd_barrier(bar);
        g8::GridOrder S; S.init(T, 1024, F.G, (int)blockIdx.x, WSP(bf16, WS_MERGED), WSP(bf16, WS_WOUT), 1024, 1024);
        EpiOut E{F.in[0], WSP(float, WS_MOD), WSP(bf16, WS_V1)};
        g8::gemm_phase<EpiOut, g8::GridOrder, false>(F.lds, 2048, 2048, 2048, S, E);
    }
    SEAM(8);
    if (IN(9)) REPS(9) { if (rep_) xcd_barrier(bar); p9_router(F); }
    SEAM(9);
    if (IN(10)) REPS(10) { if (rep_) xcd_barrier(bar);
        moe_tables(F);
        const LAS int* tstart = (const LAS int*)(F.lds + TAB_OFF);
        MoeOrder S{F.G, (int)blockIdx.x, 8, tstart[NE], tstart, tstart + 40, WSP(int, WS_TOK), (const char*)WSP(bf16, WS_H2), (const char*)WSP(bf16, WS_WGU), (size_t)2048 * 1024, 1024, true};
        EpiMoe1 E{F.in[29], WSP(bf16, WS_ACT)};
        g8::gemm_phase<EpiMoe1, MoeOrder, true, true>(F.lds, 1024, 1024, 1024, S, E);
    }
    SEAM(10);
    if (IN(11)) REPS(11) { if (rep_) xcd_barrier(bar);
        moe_tables(F);
        const LAS int* tstart = (const LAS int*)(F.lds + TAB_OFF);
        MoeOrder S{F.G, (int)blockIdx.x, 4, tstart[NE], tstart, tstart + 40, WSP(int, WS_TOK), (const char*)WSP(bf16, WS_ACT), (const char*)WSP(bf16, WS_WD), (size_t)1024 * 1024, 1024, false};
        EpiMoe2 E{F.in[31], WSP(bf16, WS_YB)};
        g8::gemm_phase<EpiMoe2, MoeOrder, false, true>(F.lds, 1024, 1024, 1024, S, E);
    }
    SEAM(11);
    if (IN(12)) REPS(12) { if (rep_) xcd_barrier(bar); p12_final(F); }
#undef IN
#undef SEAM
}

extern "C" void kernel_launch(void* const* d_in, const int* in_sizes, int n_in, void* d_out, int out_size, void* d_ws, size_t ws_size, hipStream_t stream) {
    static int grid = 0;
    if (grid == 0) {
        if (n_in != 34 || in_sizes[0] != T * D || out_size != T * D || ws_size < WS_END) { fprintf(stderr, "kernel_launch: unexpected shapes (n_in %d, ws %zu < %zu)\n", n_in, ws_size, (size_t)WS_END); grid = -1; return; }
        int dev = 0, cus = 0;
        if (hipGetDevice(&dev) != hipSuccess || hipDeviceGetAttribute(&cus, hipDeviceAttributeMultiprocessorCount, dev) != hipSuccess) { grid = -1; return; }
        if (hipFuncSetAttribute((const void*)fwd_kernel, hipFuncAttributeMaxDynamicSharedMemorySize, LDS_BYTES) != hipSuccess) { fprintf(stderr, "kernel_launch: hipFuncSetAttribute failed\n"); grid = -1; return; }
        int per_cu = 0; (void)hipOccupancyMaxActiveBlocksPerMultiprocessor(&per_cu, (const void*)fwd_kernel, 512, LDS_BYTES); (void)hipGetLastError();
        grid = cus;
    }
    if (grid < 0) return;
    (void)hipMemsetAsync((char*)d_ws + WS_CTL, 0, CTL_BYTES, stream);
    Args a{};
    for (int i = 0; i < 34; ++i) a.in[i] = (const float*)d_in[i];
    a.out = (float*)d_out; a.ws = (unsigned char*)d_ws;
    if (MK_N_LAUNCHES == 1) { a.ph_lo = 0; a.ph_hi = N_PHASES; hipLaunchKernelGGL(fwd_kernel, dim3(grid), dim3(512), LDS_BYTES, stream, a); }
    else for (int p = 0; p < N_PHASES; ++p) { a.ph_lo = p; a.ph_hi = p + 1; hipLaunchKernelGGL(fwd_kernel, dim3(grid), dim3(512), LDS_BYTES, stream, a); }
}
```

```cpp
#include <hip/hip_runtime.h>
#include <cstdio>
#include <cstdint>

#ifndef MK_N_LAUNCHES
#define MK_N_LAUNCHES 1
#endif
constexpr int N_PHASES = 13;
#ifndef DUP_PHASE
#define DUP_PHASE -1
#endif
#define REPS(k) for (int rep_ = 0; rep_ < ((DUP_PHASE == (k)) ? 2 : 1); ++rep_)

#define GAS __attribute__((address_space(1)))
#define LAS __attribute__((address_space(3)))
typedef unsigned short bf16;
typedef short bf16x8 __attribute__((ext_vector_type(8)));
typedef float f32x4 __attribute__((ext_vector_type(4)));
typedef float f32x2 __attribute__((ext_vector_type(2)));
typedef unsigned u32x4 __attribute__((ext_vector_type(4)));
typedef unsigned u32x2 __attribute__((ext_vector_type(2)));
typedef GAS unsigned gu32;

constexpr int NB = 8, SEQ = 4096, T = NB * SEQ, D = 1024, INC = 4608, NE = 32, DFF = 1024;
constexpr int S5L = 32, S5G = 32, S5ROW = 128 + S5L * 16  , S5M = T / S5L  , S5CPB = SEQ / S5L  ;
constexpr int RGL = 128, RGC = SEQ / RGL  ;
constexpr float LN_EPS = 1e-5f, DN_ALPHA = 1.189207115002721f;
constexpr int ACT_ROWS = T * 4 + NE * 256;

constexpr size_t MiB = 1u << 20;
constexpr size_t WS_XRNN = 0, WS_GY = 64 * MiB, WS_GATES = 128 * MiB, WS_V1 = 0, WS_ACT = 0;
constexpr size_t WS_HBF = 272 * MiB, WS_HA = 272 * MiB, WS_YS = 336 * MiB, WS_GB = 368 * MiB, WS_MERGED = 432 * MiB, WS_ACAT = 496 * MiB, WS_YB = 272 * MiB;
constexpr size_t WS_X1 = 544 * MiB, WS_H2 = 608 * MiB;
constexpr size_t WS_WGU = 672 * MiB, WS_WD = 800 * MiB, WS_WIN = 864 * MiB, WS_WG = 873 * MiB, WS_WRNN = 874 * MiB, WS_WGLU = 876 * MiB, WS_WOUT = 878 * MiB;
constexpr size_t WS_WS = 880 * MiB, WS_WY = 888 * MiB, WS_S = 908 * MiB;
constexpr size_t WS_MOD = 924 * MiB, WS_AL = 925 * MiB, WS_RGAGG = 926 * MiB, WS_HIN = 928 * MiB, WS_TOK = 929 * MiB, WS_POS = 933 * MiB, WS_PROB = 934 * MiB, WS_CTL = 935 * MiB;
constexpr size_t WS_END = 936 * MiB, CTL_BYTES = 1 * MiB;
static_assert((size_t)ACT_ROWS * DFF * 2 <= 272 * MiB, "act/yb size");
static_assert(WS_ACAT + (size_t)S5G * S5M * S5ROW * 2 <= WS_X1, "acat");
constexpr int CW_BAR = 4096, CW_CNT = 8192  ;

constexpr int LDS_BYTES = 147456, MISC_OFF = LDS_BYTES - 256, TAB_OFF = 131072 + 1024;

__device__ __forceinline__ unsigned f2bf(float f) { unsigned u = __builtin_bit_cast(unsigned, f); return (u + 0x7fffu + ((u >> 16) & 1u)) >> 16; }
typedef __bf16 bf16x2v __attribute__((ext_vector_type(2)));
__device__ __forceinline__ unsigned pk2(float lo, float hi) { const f32x2 v = {lo, hi}; const bf16x2v b = __builtin_convertvector(v, bf16x2v); return __builtin_bit_cast(unsigned, b); }
__device__ __forceinline__ unsigned pk4_fp8(float a, float b, float c, float d) { int w = 0; w = __builtin_amdgcn_cvt_pk_fp8_f32(a, b, w, false); w = __builtin_amdgcn_cvt_pk_fp8_f32(c, d, w, true); return (unsigned)w; }
__device__ __forceinline__ float bflo(unsigned w) { return __builtin_bit_cast(float, w << 16); }
__device__ __forceinline__ float bfhi(unsigned w) { return __builtin_bit_cast(float, w & 0xffff0000u); }
__device__ __forceinline__ float bf1(bf16 h) { return __builtin_bit_cast(float, ((unsigned)h) << 16); }
__device__ __forceinline__ float fast_sigmoid(float x) { return __builtin_amdgcn_rcpf(1.0f + __builtin_amdgcn_exp2f(-1.4426950409f * x)); }
__device__ __forceinline__ float gelu_tanh(float x) { const float u = x + 0.044715f * x * x * x; return x * __builtin_amdgcn_rcpf(1.0f + __builtin_amdgcn_exp2f(-2.3022082f * u)); }
__device__ __forceinline__ float wave_sum(float v) {
#pragma unroll
    for (int o = 1; o < 64; o <<= 1) v += __shfl_xor(v, o);
    return v;
}
__device__ __forceinline__ u32x4 pack8(f32x4 a, f32x4 b) { u32x4 w; w.x = pk2(a[0], a[1]); w.y = pk2(a[2], a[3]); w.z = pk2(b[0], b[1]); w.w = pk2(b[2], b[3]); return w; }
__device__ __forceinline__ void unpack8(u32x4 w, f32x4& a, f32x4& b) { a = (f32x4){bflo(w.x), bfhi(w.x), bflo(w.y), bfhi(w.y)}; b = (f32x4){bflo(w.z), bfhi(w.z), bflo(w.w), bfhi(w.w)}; }

#define XB_TMO      128
#define XB_XCNT(j)  (256  + 64 * (j))
#define XB_XSUB(j)  (1280 + 64 * (j))
#define XB_XGEN(j)  (2304 + 64 * (j))
#define XB_TOP      3328
#define XB_TOPGEN   3392
#define XCD_BAR_WORDS 3456
#define XB_SPIN_CAP (1u << 18)
__device__ __forceinline__ unsigned xb_ld(unsigned* p)              { return __hip_atomic_load(p, __ATOMIC_RELAXED, __HIP_MEMORY_SCOPE_AGENT); }
__device__ __forceinline__ unsigned xb_add(unsigned* p, unsigned v) { return __hip_atomic_fetch_add(p, v, __ATOMIC_RELAXED, __HIP_MEMORY_SCOPE_AGENT); }
__device__ __forceinline__ unsigned xb_xcc_id() { return (unsigned)__builtin_amdgcn_s_getreg((3 << 11) | 20) & 0xFu; }
#define XB_SPIN(cond, bar) do { unsigned _sp = 0; while (cond) { __builtin_amdgcn_s_sleep(1); \
    if ((++_sp & 255u) == 0u) { if (xb_ld(&(bar)[XB_TMO])) break; if (_sp > XB_SPIN_CAP) { atomicAdd(&(bar)[XB_TMO], 1u); break; } } } } while (0)
struct XcdBarrier { unsigned* bar; unsigned x; volatile LAS unsigned* st; };
__device__ __forceinline__ XcdBarrier xcd_barrier_post(unsigned* bar, volatile LAS unsigned* st) {
    XcdBarrier b; b.bar = bar; b.x = xb_xcc_id(); b.st = st;
    if (threadIdx.x == 0) (void)xb_add(&bar[XB_XCNT(b.x)], 1u);
    return b;
}
__device__ __forceinline__ void xcd_barrier_complete(unsigned* bar, unsigned x, unsigned& nloc, unsigned& nx) {
    const unsigned G = gridDim.x * gridDim.y * gridDim.z;
    unsigned sum, cnt, mine, sp = 0u;
    for (;;) {
        sum = 0u; cnt = 0u; mine = 0u;
#pragma unroll
        for (unsigned j = 0; j < 16; ++j) { const unsigned c = xb_ld(&bar[XB_XCNT(j)]); sum += c; cnt += (c > 0u) ? 1u : 0u; mine = (j == x) ? c : mine; }
        if (sum == G) break;
        __builtin_amdgcn_s_sleep(1);
        if ((++sp & 255u) == 0u) { if (xb_ld(&bar[XB_TMO])) break; if (sp > XB_SPIN_CAP) { atomicAdd(&bar[XB_TMO], 1u); break; } }
    }
    nloc = mine > 0u ? mine : 1u; nx = cnt > 0u ? cnt : 1u;
}
__device__ __forceinline__ void xcd_barrier(const XcdBarrier& b) {
    asm volatile("s_waitcnt vmcnt(0)" ::: "memory");
    __syncthreads();
    if (threadIdx.x == 0) {
        unsigned* bar = b.bar;
        __builtin_amdgcn_s_waitcnt(0);
        unsigned nloc = b.st[0], nx = b.st[1];
        if (nloc == 0u) { xcd_barrier_complete(bar, b.x, nloc, nx); b.st[0] = nloc; b.st[1] = nx; }
        const unsigned old = xb_add(&bar[XB_XSUB(b.x)], 1u);
        const unsigned gen = old / nloc;
        if (old + 1u == (gen + 1u) * nloc) {
            __builtin_amdgcn_fence(__ATOMIC_RELEASE, "agent");
            asm volatile("s_waitcnt vmcnt(0)" ::: "memory");
            const unsigned og = xb_add(&bar[XB_TOP], 1u);
            const unsigned tg = og / nx;
            if (og + 1u == (tg + 1u) * nx) xb_add(&bar[XB_TOPGEN], 1u);
            else XB_SPIN(xb_ld(&bar[XB_TOPGEN]) == tg, bar);
            __builtin_amdgcn_fence(__ATOMIC_ACQUIRE, "agent");
            xb_add(&bar[XB_XGEN(b.x)], 1u);
            asm volatile("s_waitcnt vmcnt(0)" ::: "memory");
        } else {
            XB_SPIN(xb_ld(&bar[XB_XGEN(b.x)]) == gen, bar);
            __builtin_amdgcn_fence(__ATOMIC_ACQUIRE, "agent");
            asm volatile("s_waitcnt vmcnt(0)" ::: "memory");
        }
    }
    __syncthreads();
}

namespace g8 {
constexpr int BM = 256, BK = 64, HALF = 128, HTB = HALF * BK * 2, STAGE_BYTES = 8 * HTB;
__device__ __forceinline__ int lds_byte(int r, int c) { const int st = (r >> 4) * 2 + (c >> 5), rr = r & 15, cc = c & 31, ob = rr * 64 + cc * 2; return st * 1024 + (ob ^ (((ob >> 9) & 1) << 5)); }
__device__ __forceinline__ void stage_rc(int b, int& R, int& C) { const int st = b / 1024, sb = b % 1024, swz = sb ^ (((sb >> 9) & 1) << 5); R = (st >> 1) * 16 + swz / 64; C = (st & 1) * 32 + (swz % 64) / 2; }
__device__ __forceinline__ int perm32(int rho) { const int n = rho >> 4, i = rho & 15; return 8 * (i >> 2) + 4 * n + (i & 3); }

struct Unit { int pm, pn, z, rl; const char* A; const char* B; };

typedef int v8i __attribute__((ext_vector_type(8)));
typedef int v4i __attribute__((ext_vector_type(4)));
typedef short s16x16 __attribute__((ext_vector_type(16)));
typedef s16x16 s16x16_a16 __attribute__((aligned(16)));
__device__ __forceinline__ v8i cat8(bf16x8 lo, bf16x8 hi) { const v4i a = __builtin_bit_cast(v4i, lo), b = __builtin_bit_cast(v4i, hi); return __builtin_shufflevector(a, b, 0, 1, 2, 3, 4, 5, 6, 7); }
template <class Epi, class Sched, bool GATHER, bool FP8 = false>
__device__ __forceinline__ void gemm_phase(LAS unsigned char* lds, const int Kb, const int ldaB, const int ldbB, const Sched& S, const Epi& E) {
    const int tid = threadIdx.x, wid = __builtin_amdgcn_readfirstlane(tid >> 6), lane = tid & 63, wr = wid >> 2, wc = wid & 3, fr = lane & 15, fq = lane >> 4;
    const int nt = Kb / 128;
    unsigned voffB[2], cvo[2][2], nvo[2][2]; int Rr[2], Cc[2];
#pragma unroll
    for (int i = 0; i < 2; ++i) { int R, C; stage_rc(tid * 16 + i * 8192, R, C); const int Rb = (R & ~31) + perm32(R & 31);
        voffB[i] = (unsigned)(Rb * ldbB + C * 2); Rr[i] = R; Cc[i] = C;
#pragma unroll
        for (int h = 0; h < 2; ++h) { cvo[h][i] = (unsigned)((h * HALF + R) * ldaB + C * 2); nvo[h][i] = cvo[h][i]; } }
    const size_t kstep = (size_t)(BK * 2);
    const size_t hstepB = (size_t)HALF * ldbB;
    const unsigned ldsw = (unsigned)wid * 1024u;
    const int aoff = FP8 ? lds_byte(wr * 64 + fr, (fq >> 1) * 32 + (fq & 1) * 16) : lds_byte(wr * 64 + fr, fq * 8), boff = FP8 ? lds_byte(wc * 32 + fr, (fq >> 1) * 32 + (fq & 1) * 16) : lds_byte(wc * 32 + fr, fq * 8);
#define G8_SA(b, h) (((b) * 2 + (h)) * HTB)
#define G8_SB(b, h) ((4 + (b) * 2 + (h)) * HTB)
#define G8_STGB(bufoff, gbase) do { _Pragma("unroll") for (int _i = 0; _i < 2; ++_i) \
        __builtin_amdgcn_global_load_lds((const unsigned*)((const char*)(gbase) + voffB[_i]), (LAS unsigned*)(lds + (bufoff) + ldsw + _i * 8192), 16, 0, 0); } while (0)
#define G8_STGA(bufoff, gbase, VO, h) do { _Pragma("unroll") for (int _i = 0; _i < 2; ++_i) \
        __builtin_amdgcn_global_load_lds((const unsigned*)((const char*)(gbase) + VO[h][_i]), (LAS unsigned*)(lds + (bufoff) + ldsw + _i * 8192), 16, 0, 0); } while (0)
#define G8_LDA(dst, b, h) do { _Pragma("unroll") for (int m = 0; m < 4; ++m) { if constexpr (FP8) { dst##8[m] = cat8(*(const LAS bf16x8*)(lds + G8_SA(b, h) + aoff + m * 2048), *(const LAS bf16x8*)(lds + G8_SA(b, h) + aoff + m * 2048 + 16)); } \
        else { _Pragma("unroll") for (int k = 0; k < 2; ++k) dst[m][k] = *(const LAS bf16x8*)(lds + G8_SA(b, h) + aoff + m * 2048 + k * 1024); } } } while (0)
#define G8_LDB(dst, b, h) do { _Pragma("unroll") for (int n = 0; n < 2; ++n) { if constexpr (FP8) { dst##8[n] = cat8(*(const LAS bf16x8*)(lds + G8_SB(b, h) + boff + n * 2048), *(const LAS bf16x8*)(lds + G8_SB(b, h) + boff + n * 2048 + 16)); } \
        else { _Pragma("unroll") for (int k = 0; k < 2; ++k) dst[n][k] = *(const LAS bf16x8*)(lds + G8_SB(b, h) + boff + n * 2048 + k * 1024); } } } while (0)
#define G8_MMA(ai, bj, At, Bt) do { __builtin_amdgcn_s_setprio(1); _Pragma("unroll") for (int m = 0; m < 4; ++m) _Pragma("unroll") for (int n = 0; n < 2; ++n) { \
        if constexpr (FP8) asm volatile("s_nop 1\n\tv_mfma_scale_f32_16x16x128_f8f6f4 %0, %1, %2, %0, %3, %4 op_sel_hi:[0,0,0]" : "+v"(acc[ai][bj][m][n]) : "v"(Bt##8[n]), "v"(At##8[m]), "v"(sc_w), "v"(sc_a)); \
        else { _Pragma("unroll") for (int k = 0; k < 2; ++k) acc[ai][bj][m][n] = __builtin_amdgcn_mfma_f32_16x16x32_bf16(Bt[n][k], At[m][k], acc[ai][bj][m][n], 0, 0, 0); } } __builtin_amdgcn_s_setprio(0); } while (0)
#define G8_WAIT_V(n) asm volatile("s_waitcnt vmcnt(" #n ")" ::: "memory")
#define G8_WAIT_L(n) asm volatile("s_waitcnt lgkmcnt(" #n ")" ::: "memory")
#define G8_BAR __builtin_amdgcn_s_barrier()
#define G8_SCHED __builtin_amdgcn_sched_barrier(0)
    Unit cur, nxt; int ui = 0;
    if (!S.next(0, cur)) return;
    bool has_next = S.next(1, nxt);
    if constexpr (GATHER) { S.gather(cur, Rr, Cc, cvo); if (has_next) S.gather(nxt, Rr, Cc, nvo); else {
#pragma unroll
        for (int h = 0; h < 2; ++h)
#pragma unroll
            for (int i = 0; i < 2; ++i) nvo[h][i] = cvo[h][i]; } }
    f32x4 acc[2][2][4][2];
#pragma unroll
    for (int a = 0; a < 2; ++a)
#pragma unroll
        for (int b = 0; b < 2; ++b)
#pragma unroll
            for (int m = 0; m < 4; ++m)
#pragma unroll
                for (int n = 0; n < 2; ++n) acc[a][b][m][n] = (f32x4){0.f, 0.f, 0.f, 0.f};
    const int sc_w = 0x7a7a7a7a, sc_a = 0x7f7f7f7f;
    bf16x8 At[4][2], B0[2][2], B1[2][2]; v8i At8[4], B08[2], B18[2];
    const char* cA = cur.A; const char* cB = cur.B;
    G8_STGB(G8_SB(0, 0), cB); G8_STGB(G8_SB(0, 1), cB + hstepB); G8_STGA(G8_SA(0, 0), cA, cvo, 0); G8_STGA(G8_SA(0, 1), cA, cvo, 1);
    if (wr == 1) G8_BAR;
    G8_WAIT_V(2); G8_BAR;
    G8_STGB(G8_SB(1, 0), cB + kstep); G8_STGA(G8_SA(1, 0), cA + kstep, cvo, 0); G8_STGB(G8_SB(1, 1), cB + hstepB + kstep);
    G8_WAIT_V(6); G8_BAR;
    for (;;) {
        const char* nA = has_next ? nxt.A : cA; const char* nB = has_next ? nxt.B : cB;
        for (int t = 0; t < nt; t += 2) {
            const bool last = (t == nt - 2);
            const char* a1 = cA + (size_t)(t + 1) * kstep;
            const char* a2 = last ? nA : cA + (size_t)(t + 2) * kstep; const char* b2 = last ? nB : cB + (size_t)(t + 2) * kstep;
            const char* a3 = a2 + kstep; const char* b3 = b2 + kstep;
            unsigned vo2[2][2];
#pragma unroll
            for (int h = 0; h < 2; ++h)
#pragma unroll
                for (int i = 0; i < 2; ++i) vo2[h][i] = (GATHER && last) ? nvo[h][i] : cvo[h][i];
            G8_LDB(B0, 0, 0); G8_LDB(B1, 0, 1); G8_SCHED; G8_LDA(At, 0, 0); G8_STGA(G8_SA(1, 1), a1, cvo, 1);
            G8_WAIT_V(8); G8_WAIT_L(0); G8_BAR; G8_SCHED; G8_MMA(0, 0, At, B0); G8_MMA(0, 1, At, B1); G8_SCHED; G8_BAR; G8_SCHED;
            G8_LDA(At, 0, 1); G8_STGB(G8_SB(0, 0), b2); G8_STGB(G8_SB(0, 1), b2 + hstepB); G8_STGA(G8_SA(0, 0), a2, vo2, 0);
            G8_WAIT_V(8); G8_WAIT_L(0); G8_BAR; G8_SCHED; G8_MMA(1, 0, At, B0); G8_MMA(1, 1, At, B1); G8_SCHED; G8_BAR; G8_SCHED;
            G8_LDB(B0, 1, 0); G8_LDB(B1, 1, 1); G8_SCHED; G8_LDA(At, 1, 0); G8_STGA(G8_SA(0, 1), a2, vo2, 1);
            G8_WAIT_V(8); G8_WAIT_L(0); G8_BAR; G8_SCHED; G8_MMA(0, 0, At, B0); G8_MMA(0, 1, At, B1); G8_SCHED; G8_BAR; G8_SCHED;
            G8_LDA(At, 1, 1); G8_STGB(G8_SB(1, 0), b3); G8_STGB(G8_SB(1, 1), b3 + hstepB); G8_STGA(G8_SA(1, 0), a3, vo2, 0);
            G8_WAIT_V(8); G8_WAIT_L(0); G8_BAR; G8_SCHED; G8_MMA(1, 0, At, B0); G8_MMA(1, 1, At, B1); G8_SCHED; G8_BAR; G8_SCHED;
        }
        if (wr == 0) G8_BAR;
        Unit nn; bool has_nn = false;
        if (has_next) has_nn = S.next(ui + 2, nn);
        unsigned nnvo[2][2];
        if constexpr (GATHER) { if (has_nn) S.gather(nn, Rr, Cc, nnvo); }
        if constexpr (FP8) asm volatile("s_nop 15\n\ts_nop 15" ::: "memory");
        E(acc, cur, wr, wc, fr, fq);
        if (!has_next) break;
#pragma unroll
        for (int a = 0; a < 2; ++a)
#pragma unroll
            for (int b = 0; b < 2; ++b)
#pragma unroll
                for (int m = 0; m < 4; ++m)
#pragma unroll
                    for (int n = 0; n < 2; ++n) acc[a][b][m][n] = (f32x4){0.f, 0.f, 0.f, 0.f};
        cur = nxt; cA = nA; cB = nB; ++ui;
        if constexpr (GATHER) {
#pragma unroll
            for (int h = 0; h < 2; ++h)
#pragma unroll
                for (int i = 0; i < 2; ++i) { cvo[h][i] = nvo[h][i]; if (has_nn) nvo[h][i] = nnvo[h][i]; } }
        nxt = nn; has_next = has_nn;
        if (wr == 1) G8_BAR;
    }
    G8_WAIT_V(0);
    G8_BAR;
#undef G8_SA
#undef G8_SB
#undef G8_STGB
#undef G8_STGA
#undef G8_LDA
#undef G8_LDB
#undef G8_MMA
#undef G8_WAIT_V
#undef G8_WAIT_L
#undef G8_BAR
#undef G8_SCHED
}

struct GridOrder {
    int nM, nN, nwg, G, c; const char* A; const char* B; size_t tstepA, tstepB;
    __device__ __forceinline__ void init(int M, int N, int G_, int c_, const void* A_, const void* B_, int ldaB, int ldbB) { nM = M / BM; nN = N / BM; nwg = nM * nN; G = G_; c = c_; A = (const char*)A_; B = (const char*)B_; tstepA = (size_t)BM * ldaB; tstepB = (size_t)BM * ldbB; }
    __device__ __forceinline__ bool next(int i, Unit& u) const {
        const long L = (long)i * G + c; if (L >= nwg) return false;
        int wgid = (int)L; { const int q = nwg / 8, r = nwg % 8, xcd = wgid % 8, off = wgid / 8; wgid = (xcd < r ? xcd * (q + 1) : r * (q + 1) + (xcd - r) * q) + off; }
        const int nig = 8 * nN, gid = wgid / nig, fm = gid * 8, gsz = (nM - fm) < 8 ? (nM - fm) : 8;
        u.pm = fm + ((wgid % nig) % gsz); u.pn = (wgid % nig) / gsz; u.z = 0; u.rl = 0;
        u.A = A + (size_t)u.pm * tstepA; u.B = B + (size_t)u.pn * tstepB; return true;
    }
};
}

struct Frame {
    LAS unsigned char* lds; volatile LAS unsigned* MISC; unsigned* ctl;
    int tid, lane, wave, vcu, G;
    const float* in[34]; float* out; unsigned char* ws;
};
#define WSP(T_, off) ((T_*)(F.ws + (off)))

struct EpiInProj {
    const float* bias; bf16 *xrnn, *gy, *acat, *gates;
    __device__ __forceinline__ void operator()(const f32x4 (&acc)[2][2][4][2], const g8::Unit& u, int wr, int wc, int fr, int fq) const {
        const int pn = u.pn, colb = pn * 256 + wc * 32 + 8 * fq;
        f32x4 bv[2][2];
#pragma unroll
        for (int bj = 0; bj < 2; ++bj)
#pragma unroll
            for (int n = 0; n < 2; ++n) bv[bj][n] = *(const f32x4*)(bias + colb + bj * 128 + 4 * n);
#pragma unroll
        for (int ai = 0; ai < 2; ++ai)
#pragma unroll
            for (int m = 0; m < 4; ++m) { const int t = u.pm * 256 + ai * 128 + wr * 64 + m * 16 + fr;
#pragma unroll
                for (int bj = 0; bj < 2; ++bj) { f32x4 v0 = acc[ai][bj][m][0] + bv[bj][0], v1 = acc[ai][bj][m][1] + bv[bj][1]; const int col = colb + bj * 128;
                    if (pn < 4) { *(u32x4*)(xrnn + (size_t)t * 1024 + col) = pack8(v0, v1); }
                    else if (pn < 8) {
#pragma unroll
                        for (int j = 0; j < 4; ++j) { v0[j] = gelu_tanh(v0[j]); v1[j] = gelu_tanh(v1[j]); }
                        *(u32x4*)(gy + (size_t)t * 1024 + (col - 1024)) = pack8(v0, v1); }
                    else if (pn < 10) { const int cu = col - 2048, g = cu >> 4, c = cu & 15;
                        *(u32x4*)(acat + ((size_t)(g * S5M + (t >> 5)) * S5ROW + 128 + (t & 31) * 16 + c)) = pack8(v0, v1); }
                    else {
#pragma unroll
                        for (int j = 0; j < 4; ++j) { v0[j] = fast_sigmoid(v0[j]); v1[j] = fast_sigmoid(v1[j]); }
                        *(u32x4*)(gates + (size_t)t * 2048 + (col - 2560)) = pack8(v0, v1); } } }
    }
};
struct EpiS5A {
    float* S;
    __device__ __forceinline__ void operator()(const f32x4 (&acc)[2][2][4][2], const g8::Unit& u, int wr, int wc, int fr, int fq) const {
        const int col = wc * 32 + 8 * fq;
#pragma unroll
        for (int ai = 0; ai < 2; ++ai)
#pragma unroll
            for (int m = 0; m < 4; ++m) { const int row = u.pm * 256 + ai * 128 + wr * 64 + m * 16 + fr; float* p = S + ((size_t)(u.z * S5M + row)) * 128 + col;
                *(f32x4*)p = acc[ai][0][m][0]; *(f32x4*)(p + 4) = acc[ai][0][m][1]; }
    }
};
struct EpiS5C {
    bf16* ys;
    __device__ __forceinline__ void operator()(const f32x4 (&acc)[2][2][4][2], const g8::Unit& u, int wr, int wc, int fr, int fq) const {
#pragma unroll
        for (int ai = 0; ai < 2; ++ai)
#pragma unroll
            for (int m = 0; m < 4; ++m) { const int row = u.pm * 256 + ai * 128 + wr * 64 + m * 16 + fr;
#pragma unroll
                for (int bj = 0; bj < 2; ++bj) { const int n = u.pn * 256 + bj * 128 + wc * 32 + 8 * fq, i = n >> 4, c = n & 15; f32x4 v0 = acc[ai][bj][m][0], v1 = acc[ai][bj][m][1];
#pragma unroll
                    for (int j = 0; j < 4; ++j) { v0[j] = gelu_tanh(v0[j]); v1[j] = gelu_tanh(v1[j]); }
                    u32x2 w8; w8.x = pk4_fp8(v0[0], v0[1], v0[2], v0[3]); w8.y = pk4_fp8(v1[0], v1[1], v1[2], v1[3]); *(u32x2*)((unsigned char*)ys + (size_t)(row * 32 + i) * 512 + u.z * 16 + c) = w8; } }
    }
};
struct EpiGlu {
    const bf16* gates; bf16* gb;
    __device__ __forceinline__ void operator()(const f32x4 (&acc)[2][2][4][2], const g8::Unit& u, int wr, int wc, int fr, int fq) const {
        const int f = u.pn * 128 + wc * 32 + 8 * fq;
#pragma unroll
        for (int ai = 0; ai < 2; ++ai)
#pragma unroll
            for (int m = 0; m < 4; ++m) { const int t = u.pm * 256 + ai * 128 + wr * 64 + m * 16 + fr;
                const u32x4 gw = *(const u32x4*)(gates + (size_t)t * 2048 + 1024 + f); f32x4 g0, g1; unpack8(gw, g0, g1);
                f32x4 v0 = acc[ai][0][m][0], v1 = acc[ai][0][m][1]; const f32x4 s0 = acc[ai][1][m][0], s1 = acc[ai][1][m][1];
#pragma unroll
                for (int j = 0; j < 4; ++j) { v0[j] = g0[j] * v0[j] * fast_sigmoid(s0[j]); v1[j] = g1[j] * v1[j] * fast_sigmoid(s1[j]); }
                *(u32x4*)(gb + (size_t)t * 1024 + f) = pack8(v0, v1); }
    }
};
struct EpiRnn {
    const bf16* gates; const bf16* gb; bf16* merged;
    __device__ __forceinline__ void operator()(const f32x4 (&acc)[2][2][4][2], const g8::Unit& u, int wr, int wc, int fr, int fq) const {
#pragma unroll
        for (int ai = 0; ai < 2; ++ai)
#pragma unroll
            for (int m = 0; m < 4; ++m) { const int t = u.pm * 256 + ai * 128 + wr * 64 + m * 16 + fr;
#pragma unroll
                for (int bj = 0; bj < 2; ++bj) { const int col = u.pn * 256 + bj * 128 + wc * 32 + 8 * fq;
                    const u32x4 gw = *(const u32x4*)(gates + (size_t)t * 2048 + col), bw = *(const u32x4*)(gb + (size_t)t * 1024 + col);
                    f32x4 g0, g1, b0, b1; unpack8(gw, g0, g1); unpack8(bw, b0, b1);
                    const f32x4 v0 = g0 * acc[ai][bj][m][0] + b0, v1 = g1 * acc[ai][bj][m][1] + b1;
                    u32x2 w8; w8.x = pk4_fp8(v0[0], v0[1], v0[2], v0[3]); w8.y = pk4_fp8(v1[0], v1[1], v1[2], v1[3]); *(u32x2*)((unsigned char*)merged + (size_t)t * 1024 + col) = w8; } }
    }
};
struct EpiOut {
    const float* x; const float* mod; bf16* v1;
    __device__ __forceinline__ void operator()(const f32x4 (&acc)[2][2][4][2], const g8::Unit& u, int wr, int wc, int fr, int fq) const {
        const int b = (u.pm * 256) >> 12;
#pragma unroll
        for (int bj = 0; bj < 2; ++bj) { const int col = u.pn * 256 + bj * 128 + wc * 32 + 8 * fq;
            const f32x4 ga = *(const f32x4*)(mod + b * 6144 + 2048 + col) + 1.0f, gb_ = *(const f32x4*)(mod + b * 6144 + 2048 + col + 4) + 1.0f;
#pragma unroll
            for (int ai = 0; ai < 2; ++ai)
#pragma unroll
                for (int m = 0; m < 4; ++m) { const int t = u.pm * 256 + ai * 128 + wr * 64 + m * 16 + fr;
                    const f32x4 x0 = *(const f32x4*)(x + (size_t)t * 1024 + col), x1 = *(const f32x4*)(x + (size_t)t * 1024 + col + 4);
                    const f32x4 v0 = x0 * DN_ALPHA + ga * acc[ai][bj][m][0], v1_ = x1 * DN_ALPHA + gb_ * acc[ai][bj][m][1];
                    *(u32x4*)(v1 + (size_t)t * 1024 + col) = pack8(v0, v1_); } }
    }
};
struct EpiMoe1 {
    const float* bgu; bf16* act;
    __device__ __forceinline__ void operator()(const f32x4 (&acc)[2][2][4][2], const g8::Unit& u, int wr, int wc, int fr, int fq) const {
        const int f = u.pn * 128 + wc * 32 + 8 * fq; const float* bp = bgu + (size_t)u.z * 2048 + f;
        const f32x4 bg0 = *(const f32x4*)bp, bg1 = *(const f32x4*)(bp + 4), bu0 = *(const f32x4*)(bp + 1024), bu1 = *(const f32x4*)(bp + 1028);
#pragma unroll
        for (int ai = 0; ai < 2; ++ai)
#pragma unroll
            for (int m = 0; m < 4; ++m) { const int row = u.pm * 256 + ai * 128 + wr * 64 + m * 16 + fr;
                f32x4 g0 = acc[ai][0][m][0] + bg0, g1 = acc[ai][0][m][1] + bg1, u0 = acc[ai][1][m][0] + bu0, u1 = acc[ai][1][m][1] + bu1;
#pragma unroll
                for (int j = 0; j < 4; ++j) { const float ga = fminf(g0[j], 7.0f), gb_ = fminf(g1[j], 7.0f), ua = fminf(fmaxf(u0[j], -7.0f), 7.0f), ub = fminf(fmaxf(u1[j], -7.0f), 7.0f);
                    g0[j] = ga * fast_sigmoid(1.702f * ga) * (ua + 1.0f); g1[j] = gb_ * fast_sigmoid(1.702f * gb_) * (ub + 1.0f); }
                u32x2 w8; w8.x = pk4_fp8(g0[0], g0[1], g0[2], g0[3]); w8.y = pk4_fp8(g1[0], g1[1], g1[2], g1[3]); *(u32x2*)((unsigned char*)act + (size_t)row * 1024 + f) = w8; }
    }
};
struct EpiMoe2 {
    const float* bd; bf16* yb;
    __device__ __forceinline__ void operator()(const f32x4 (&acc)[2][2][4][2], const g8::Unit& u, int wr, int wc, int fr, int fq) const {
#pragma unroll
        for (int bj = 0; bj < 2; ++bj) { const int col = u.pn * 256 + bj * 128 + wc * 32 + 8 * fq; const float* bp = bd + (size_t)u.z * 1024 + col;
            const f32x4 b0 = *(const f32x4*)bp, b1 = *(const f32x4*)(bp + 4);
#pragma unroll
            for (int ai = 0; ai < 2; ++ai)
#pragma unroll
                for (int m = 0; m < 4; ++m) { const int row = u.pm * 256 + ai * 128 + wr * 64 + m * 16 + fr;
                    *(u32x4*)(yb + (size_t)row * 1024 + col) = pack8(acc[ai][bj][m][0] + b0, acc[ai][bj][m][1] + b1); } }
    }
};

struct S5AOrder { int G, c; const char* acat; const char* ws;
    __device__ __forceinline__ bool next(int i, g8::Unit& u) const { const int L = i * G + c; if (L >= S5G * 4) return false; u.z = L >> 2; u.pm = L & 3; u.pn = 0; u.rl = 0;
        u.A = acat + ((size_t)(u.z * S5M + u.pm * 256) * S5ROW + 128) * 2; u.B = ws + (size_t)u.z * 256 * (S5L * 16) * 2; return true; } };
struct S5COrder { int G, c; const char* acat; const char* wy;
    __device__ __forceinline__ bool next(int i, g8::Unit& u) const { const int L = i * G + c; if (L >= S5G * 8) return false; u.z = L >> 3; u.pm = (L >> 1) & 3; u.pn = L & 1; u.rl = 0;
        u.A = acat + ((size_t)(u.z * S5M + u.pm * 256) * S5ROW) * 2; u.B = wy + ((size_t)(u.z * 512 + u.pn * 256) * S5ROW) * 2; return true; } };
struct MoeOrder { int G, c, NT, RT; const LAS int* tstart; const LAS int* cnt; const int* toklist; const char* A; const char* B; size_t bstride_e; int lda; bool gatherA;
    __device__ __forceinline__ bool next(int i, g8::Unit& u) const { const long L = (long)i * G + c; if (L >= (long)RT * NT) return false; const int rt = (int)(L / NT); u.pn = (int)(L % NT);
        int e = 0;
#pragma unroll 1
        for (int k = 1; k < NE; ++k) if (tstart[k] <= rt) e = k;
        u.z = e; u.pm = rt; u.rl = rt - tstart[e]; u.B = B + (size_t)e * bstride_e + (size_t)u.pn * 256 * 1024; u.A = gatherA ? A : A + (size_t)rt * 256 * 1024; return true; }
    __device__ __forceinline__ void gather(const g8::Unit& u, const int (&Rr)[2], const int (&Cc)[2], unsigned (&vo)[2][2]) const {
        const int n = cnt[u.z];
#pragma unroll
        for (int h = 0; h < 2; ++h)
#pragma unroll
            for (int i = 0; i < 2; ++i) { const int r = u.rl * 256 + h * 128 + Rr[i]; const int tok = r < n ? toklist[u.z * T + r] : 0; vo[h][i] = (unsigned)(tok * lda + Cc[i] * 2); } }
};

__device__ __forceinline__ void transpose_item(const float* W, int N, int k0, int n0, bf16* dst, int ldd, int drow0, LAS float* scr, int lane) {
#pragma unroll 8
    for (int i = 0; i < 32; ++i) { const int kk = 2 * i + (lane >> 5); scr[kk * 33 + (lane & 31)] = W[(size_t)(k0 + kk) * N + n0 + (lane & 31)]; }
    asm volatile("s_waitcnt lgkmcnt(0)" ::: "memory");
    const int c = lane & 7;
#pragma unroll
    for (int j = 0; j < 4; ++j) { const int n = (lane >> 3) + 8 * j; const LAS float* s = scr + (8 * c) * 33 + n;
        u32x4 o; o.x = pk2(s[0 * 33], s[1 * 33]); o.y = pk2(s[2 * 33], s[3 * 33]); o.z = pk2(s[4 * 33], s[5 * 33]); o.w = pk2(s[6 * 33], s[7 * 33]);
        *(u32x4*)(dst + (size_t)(drow0 + n) * ldd + k0 + 8 * c) = o; }
    asm volatile("s_waitcnt lgkmcnt(0)" ::: "memory");
}
__device__ __forceinline__ void transpose_item8(const float* W, int N, int k0, int n0, unsigned char* dst, int ldd, int drow0, LAS float* scr, int lane) {
#pragma unroll 8
    for (int i = 0; i < 32; ++i) { const int kk = 2 * i + (lane >> 5); scr[kk * 33 + (lane & 31)] = W[(size_t)(k0 + kk) * N + n0 + (lane & 31)]; }
    asm volatile("s_waitcnt lgkmcnt(0)" ::: "memory");
    const int c = lane & 7;
#pragma unroll
    for (int j = 0; j < 4; ++j) { const int n = (lane >> 3) + 8 * j; const LAS float* s = scr + (8 * c) * 33 + n;
        u32x2 o; o.x = pk4_fp8(32.f * s[0 * 33], 32.f * s[1 * 33], 32.f * s[2 * 33], 32.f * s[3 * 33]); o.y = pk4_fp8(32.f * s[4 * 33], 32.f * s[5 * 33], 32.f * s[6 * 33], 32.f * s[7 * 33]);
        *(u32x2*)(dst + (size_t)(drow0 + n) * ldd + k0 + 8 * c) = o; }
    asm volatile("s_waitcnt lgkmcnt(0)" ::: "memory");
}
__device__ __forceinline__ int pair_row(int n) { const int f = n & 1023, hi = n >> 10; return (f >> 7) * 256 + hi * 128 + (f & 127); }

__device__ __forceinline__ void moe_tables(Frame& F) {
    LAS int* tstart = (LAS int*)(F.lds + TAB_OFF); LAS int* cl = tstart + 40;
    if (F.tid == 0) { int acc = 0; for (int e = 0; e < NE; ++e) { const int c = (int)F.ctl[CW_CNT + 64 * e]; cl[e] = c; tstart[e] = acc; acc += (c + 255) >> 8; } tstart[NE] = acc; }
    __syncthreads();
}

__device__ __forceinline__ void p0_mod_job(Frame& F, int job) {
    LAS float* sc = (LAS float*)F.lds;
    LAS float* red = sc + 8 * 1024;
    const float* c = F.in[1]; const float* w = F.in[2]; const float* bias = F.in[3];
    for (int i = F.tid; i < 8 * 1024; i += 512) { const float v = c[i]; sc[i] = v * fast_sigmoid(v); }
    __syncthreads();
    const int col = F.tid & 31, kg = F.tid >> 5, j = job * 32 + col;
    float a[8];
#pragma unroll
    for (int b = 0; b < 8; ++b) a[b] = 0.f;
#pragma unroll 8
    for (int k = kg * 64; k < kg * 64 + 64; ++k) { const float wv = w[(size_t)k * 6144 + j];
#pragma unroll
        for (int b = 0; b < 8; ++b) a[b] += sc[b * 1024 + k] * wv; }
#pragma unroll
    for (int b = 0; b < 8; ++b) red[(kg * 8 + b) * 32 + col] = a[b];
    __syncthreads();
    if (F.tid < 256) { const int b = F.tid >> 5, cc = F.tid & 31; float s = 0.f;
#pragma unroll
        for (int g = 0; g < 16; ++g) s += red[(g * 8 + b) * 32 + cc];
        WSP(float, WS_MOD)[b * 6144 + job * 32 + cc] = s + bias[job * 32 + cc]; }
    __syncthreads();
}
__device__ __forceinline__ void s5_setup(Frame& F, int g, int kmin, int kmax, LAS f32x2* Bb, LAS f32x2* Cc, LAS f32x2* Ap) {
    const float* lre = F.in[14] + g * 64; const float* lim = F.in[15] + g * 64; const float dt = expf(F.in[16][g]);
    const float* bre = F.in[17] + g * 1024; const float* bim = F.in[18] + g * 1024; const float* cre = F.in[19] + g * 1024; const float* cim = F.in[20] + g * 1024;
    for (int i = F.tid; i < 1024; i += 512) { const int p = i >> 4; const float lr = lre[p], li = lim[p]; const float mag = expf(lr * dt); float sn, cs; sincosf(li * dt, &sn, &cs);
        const float ar = mag * cs, ai = mag * sn, den = lr * lr + li * li, qr = ((ar - 1.f) * lr + ai * li) / den, qi = (ai * lr - (ar - 1.f) * li) / den;
        const float br = bre[i], bi = bim[i]; Bb[i] = (f32x2){qr * br - qi * bi, qr * bi + qi * br};
        Cc[i] = (f32x2){cre[i], cim[i]}; }
    for (int i = kmin * 64 + F.tid; i < (kmax + 1) * 64; i += 512) { const int k = i >> 6, p = i & 63; const float lr = lre[p], li = lim[p]; const float mag = expf((float)k * lr * dt); float sn, cs; sincosf((float)k * li * dt, &sn, &cs);
        Ap[i] = (f32x2){mag * cs, mag * sn}; }
    __syncthreads();
}
constexpr size_t WS_KTAB = WS_S;
__device__ __forceinline__ void p0_s5k_job(Frame& F, int job) {
    const int g = job >> 3, part = job & 7;
    LAS f32x2* Bb = (LAS f32x2*)F.lds; LAS f32x2* Cc = Bb + 1024; LAS f32x2* Ap = Cc + 1024;
    s5_setup(F, g, 4 * part, 4 * part + 3, Bb, Cc, Ap);
    float* kt = WSP(float, WS_KTAB) + (size_t)g * 32 * 256;
    for (int e = 4 * part * 256 + F.tid; e < (4 * part + 4) * 256; e += 512) { const int k = e >> 8, c = (e >> 4) & 15, c2 = e & 15; float s = 0.f;
        for (int p = 0; p < 64; ++p) { const f32x2 cv = Cc[c * 64 + p], av = Ap[k * 64 + p], bv = Bb[p * 16 + c2];
            const float car = cv.x * av.x - cv.y * av.y, cai = cv.x * av.y + cv.y * av.x; s += car * bv.x - cai * bv.y; }
        kt[e] = s; }
    __syncthreads();
}
__device__ __forceinline__ void p1_s5w_job(Frame& F, int job) {
    const int g = job >> 3, part = job & 7;
    LAS f32x2* Bb = (LAS f32x2*)F.lds; LAS f32x2* Cc = Bb + 1024; LAS f32x2* Ap = Cc + 1024; LAS float* Kt = (LAS float*)(Ap + 33 * 64);
    const float* ktg = WSP(float, WS_KTAB) + (size_t)g * 32 * 256; const float* dsk = F.in[21] + g * 16;
    for (int i = F.tid; i < 32 * 256; i += 512) Kt[i] = ktg[i];
    s5_setup(F, g, 0, S5L, Bb, Cc, Ap);
    if (part == 0 && F.tid < 64) WSP(f32x2, WS_AL)[g * 64 + F.tid] = Ap[S5L * 64 + F.tid];
    bf16* wy = WSP(bf16, WS_WY) + (size_t)g * 512 * S5ROW;
    for (int ch = F.tid; ch < 64 * (S5ROW / 8); ch += 512) { const int n = part * 64 + ch / (S5ROW / 8), k8 = (ch % (S5ROW / 8)) * 8, i = n >> 4, c = n & 15; float v[8];
        if (k8 < 128) {
#pragma unroll
            for (int j = 0; j < 8; j += 2) { const int p = (k8 + j) >> 1; const f32x2 cv = Cc[c * 64 + p], av = Ap[(i + 1) * 64 + p]; v[j] = cv.x * av.x - cv.y * av.y; v[j + 1] = -(cv.x * av.y + cv.y * av.x); } }
        else { const int jj = (k8 - 128) >> 4, c2 = (k8 - 128) & 15;
#pragma unroll
            for (int j = 0; j < 8; ++j) { float x = 0.f; if (jj <= i) { x = Kt[(i - jj) * 256 + c * 16 + c2 + j]; if (jj == i && c == c2 + j) x += dsk[c]; } v[j] = x; } }
        u32x4 o; o.x = pk2(v[0], v[1]); o.y = pk2(v[2], v[3]); o.z = pk2(v[4], v[5]); o.w = pk2(v[6], v[7]);
        *(u32x4*)(wy + (size_t)n * S5ROW + k8) = o; }
    bf16* wsm = WSP(bf16, WS_WS) + (size_t)g * 256 * 512;
    for (int ch = F.tid; ch < 32 * 64; ch += 512) { const int n = part * 32 + (ch >> 6), k8 = (ch & 63) * 8, jj = k8 >> 4, c2 = k8 & 15; float v[8];
#pragma unroll
        for (int j = 0; j < 8; ++j) { float x = 0.f; if (n < 128) { const int p = n >> 1; const f32x2 av = Ap[(S5L - 1 - jj) * 64 + p], bv = Bb[p * 16 + c2 + j]; x = (n & 1) ? (av.x * bv.y + av.y * bv.x) : (av.x * bv.x - av.y * bv.y); } v[j] = x; }
        u32x4 o; o.x = pk2(v[0], v[1]); o.y = pk2(v[2], v[3]); o.z = pk2(v[4], v[5]); o.w = pk2(v[6], v[7]);
        *(u32x4*)(wsm + (size_t)n * 512 + k8) = o; }
    __syncthreads();
}
__device__ __forceinline__ void p0_small_transposes(Frame& F) {
    LAS float* scr = (LAS float*)(F.lds + F.wave * 16384);
    const int gw = F.vcu * 8 + F.wave, NGW = F.G * 8;
    constexpr int I_IN = 16 * 144, I_RNN = 16 * 32, I_OUT = 16 * 32, I_GLU = 8 * 64, I_RG = 16 * 8;
    for (int it = gw; it < I_IN + I_RNN + I_OUT + I_GLU + I_RG; it += NGW) { int r = it;
        if (r < I_IN) { const int kb = r / 144, nb = r % 144; transpose_item8(F.in[4], INC, kb * 64, nb * 32, WSP(unsigned char, WS_WIN), 1024, nb * 32, scr, F.lane); continue; } r -= I_IN;
        if (r < I_RNN) { const int kb = r / 32, nb = r % 32; transpose_item8(F.in[13], 1024, kb * 64, nb * 32, WSP(unsigned char, WS_WRNN), 1024, nb * 32, scr, F.lane); continue; } r -= I_RNN;
        if (r < I_OUT) { const int kb = r / 32, nb = r % 32; transpose_item8(F.in[23], 1024, kb * 64, nb * 32, WSP(unsigned char, WS_WOUT), 1024, nb * 32, scr, F.lane); continue; } r -= I_OUT;
        if (r < I_GLU) { const int kb = r / 64, nb = r % 64; transpose_item8(F.in[22], 2048, kb * 64, nb * 32, WSP(unsigned char, WS_WGLU), 512, pair_row(nb * 32), scr, F.lane); continue; } r -= I_GLU;
        { const int mat = r >> 3, kb = (r >> 2) & 1, nb = r & 3, hd = mat & 7, gx = mat >> 3;
          transpose_item(F.in[gx ? 10 : 8] + (size_t)hd * 128 * 128, 128, kb * 64, nb * 32, WSP(bf16, WS_WG), 128, hd * 256 + gx * 128 + nb * 32, scr, F.lane); }
    }
}
__device__ __forceinline__ void p1_body(Frame& F) {
    const int gw = F.vcu * 8 + F.wave, NGW = F.G * 8; const float* mod = WSP(float, WS_MOD); bf16* hbf = WSP(bf16, WS_HBF);
    for (int t = gw; t < T; t += NGW) { const int b = t >> 12; const f32x4* xr = (const f32x4*)(F.in[0] + (size_t)t * 1024) + F.lane; const f32x4* sh = (const f32x4*)(mod + b * 6144) + F.lane; const f32x4* sc = (const f32x4*)(mod + b * 6144 + 1024) + F.lane;
        unsigned* o = (unsigned*)((unsigned char*)hbf + (size_t)t * 1024) + F.lane;
#pragma unroll
        for (int j = 0; j < 4; ++j) { const f32x4 v = xr[64 * j] * (sc[64 * j] + 1.0f) + sh[64 * j]; o[64 * j] = pk4_fp8(v[0], v[1], v[2], v[3]); } }
    LAS float* scr = (LAS float*)(F.lds + F.wave * 16384);
    constexpr int I_GU = 16 * 64, I_D = 16 * 32;
    for (int it = gw; it < NE * (I_GU + I_D); it += NGW) { const int e = it / (I_GU + I_D); int r = it % (I_GU + I_D);
        if (r < I_GU) { const int kb = r / 64, nb = r % 64; transpose_item8(F.in[28] + (size_t)e * 1024 * 2048, 2048, kb * 64, nb * 32, WSP(unsigned char, WS_WGU) + (size_t)e * 2048 * 1024, 1024, pair_row(nb * 32), scr, F.lane); }
        else { r -= I_GU; const int kb = r / 32, nb = r % 32; transpose_item8(F.in[30] + (size_t)e * 1024 * 1024, 1024, kb * 64, nb * 32, WSP(unsigned char, WS_WD) + (size_t)e * 1024 * 1024, 1024, nb * 32, scr, F.lane); } }
}
constexpr int XR_LD = 136, XR_TILE = 128 * XR_LD;
__device__ __forceinline__ void rg_issue(const bf16* xrnn, const bf16* gy, int item, int tid, u32x4 (&xraw)[4][4], u32x4 (&graw)[4], bool pass1) {
    const int hd = item & 7, c = (item >> 3) & 31, b = item >> 8, r0 = tid >> 4, ch = hd * 128 + (tid & 15) * 8;
#pragma unroll
    for (int q = 0; q < 4; ++q) { const int r = r0 + 32 * q;
#pragma unroll
        for (int k = 0; k < 4; ++k) { const int tp = c * RGL + r - 3 + k, tpc = tp < 0 ? 0 : tp; xraw[q][k] = *(const u32x4*)(xrnn + (size_t)(b * SEQ + tpc) * 1024 + ch); }
        if (pass1) graw[q] = *(const u32x4*)(gy + (size_t)(b * SEQ + c * RGL + r) * 1024 + ch); }
}
__device__ __forceinline__ void rg_convwrite(const float* cw, const float* cb, int item, int tid, const u32x4 (&xraw)[4][4], const u32x4 (&graw)[4], LAS bf16* xr, LAS bf16* gyt, bool pass1) {
    const int hd = item & 7, c = (item >> 3) & 31, r0 = tid >> 4, c8 = (tid & 15) * 8, ch = hd * 128 + c8;
    const f32x4 b0 = *(const f32x4*)(cb + ch), b1 = *(const f32x4*)(cb + ch + 4);
    f32x4 w0[4], w1[4];
#pragma unroll
    for (int k = 0; k < 4; ++k) { w0[k] = *(const f32x4*)(cw + k * 1024 + ch); w1[k] = *(const f32x4*)(cw + k * 1024 + ch + 4); }
#pragma unroll
    for (int q = 0; q < 4; ++q) { const int r = r0 + 32 * q; f32x4 a0 = b0, a1 = b1;
#pragma unroll
        for (int k = 0; k < 4; ++k) { const int tp = c * RGL + r - 3 + k; f32x4 x0, x1; unpack8(xraw[q][k], x0, x1); if (tp < 0) { x0 = (f32x4){0.f, 0.f, 0.f, 0.f}; x1 = x0; } a0 += w0[k] * x0; a1 += w1[k] * x1; }
        *(LAS u32x4*)(xr + r * XR_LD + c8) = pack8(a0, a1);
        if (pass1) *(LAS u32x4*)(gyt + r * XR_LD + c8) = graw[q]; }
}
template <int PASS>
__device__ __forceinline__ void rglru_phase(Frame& F) {
    const int NIT = NB * RGC * 8;
    int it = F.vcu; if (it >= NIT) return;
    LAS bf16* xr = (LAS bf16*)F.lds; LAS bf16* gyt0 = xr + XR_TILE;
    const bf16* xrnn = WSP(bf16, WS_XRNN); const bf16* gy = WSP(bf16, WS_GY); bf16* ha = WSP(bf16, WS_HA); const float* cw = F.in[6]; const float* cb = F.in[7];
    const int tid = F.tid, w = F.wave, q = F.lane >> 4, col = F.lane & 15, chl = 16 * w + col;
    u32x4 xraw[4][4], graw[4];
    rg_issue(xrnn, gy, it, tid, xraw, graw, PASS);
    rg_convwrite(cw, cb, it, tid, xraw, graw, xr, gyt0, PASS);
    int hd_loaded = -1; bf16x8 Bf[2][4]; float ba = 0.f, bx = 0.f, sp = 0.f;
    __syncthreads();
    for (int i = 0; it < NIT; ++i) {
        const int nit = it + F.G; const bool has_next = nit < NIT;
        const int hd = it & 7, c = (it >> 3) & 31, b = it >> 8, t0 = b * SEQ + c * RGL, ch = hd * 128 + chl;
        LAS bf16* gyt = gyt0 + (i & 1) * XR_TILE; LAS bf16* gytn = gyt0 + ((i & 1) ^ 1) * XR_TILE;
        if (has_next) rg_issue(xrnn, gy, nit, tid, xraw, graw, PASS);
        if (hd != hd_loaded) { hd_loaded = hd; const bf16* wg = WSP(bf16, WS_WG) + (size_t)hd * 256 * 128;
#pragma unroll
            for (int gt = 0; gt < 2; ++gt)
#pragma unroll
                for (int kk = 0; kk < 4; ++kk) Bf[gt][kk] = *(const bf16x8*)(wg + (size_t)(gt * 128 + chl) * 128 + kk * 32 + q * 8);
            ba = F.in[9][ch]; bx = F.in[11][ch]; const float lam = F.in[12][ch]; sp = (lam > 15.f) ? __expf(-lam) : log1pf(__expf(-lam)); }
        float carryH = 0.f, carryP = 1.f;
        if (PASS) carryH = WSP(float, WS_HIN)[(size_t)(b * RGC + c) * 1024 + ch];
        __builtin_amdgcn_sched_barrier(0);
        f32x4 acc[8][2];
#pragma unroll
        for (int m = 0; m < 8; ++m) { acc[m][0] = (f32x4){0.f, 0.f, 0.f, 0.f}; acc[m][1] = (f32x4){0.f, 0.f, 0.f, 0.f}; }
#pragma unroll
        for (int kk = 0; kk < 4; ++kk)
#pragma unroll
            for (int m = 0; m < 8; ++m) { const bf16x8 Af = *(const LAS bf16x8*)(xr + (16 * m + col) * XR_LD + kk * 32 + q * 8);
                acc[m][0] = __builtin_amdgcn_mfma_f32_16x16x32_bf16(Af, Bf[0][kk], acc[m][0], 0, 0, 0);
                acc[m][1] = __builtin_amdgcn_mfma_f32_16x16x32_bf16(Af, Bf[1][kk], acc[m][1], 0, 0, 0); }
#pragma unroll
        for (int m = 0; m < 8; ++m) {
            float a[4], uu[4];
#pragma unroll
            for (int j = 0; j < 4; ++j) { const int tl = 16 * m + 4 * q + j;
                const float r = fast_sigmoid(acc[m][0][j] + ba), ii = fast_sigmoid(acc[m][1][j] + bx);
                const float la = -11.541560327f * r * sp; a[j] = __builtin_amdgcn_exp2f(la); const float mult = __builtin_amdgcn_sqrtf(fmaxf(1.0f - a[j] * a[j], 0.f));
                uu[j] = mult * ii * bf1(xr[tl * XR_LD + chl]); }
            float sP = a[0], sH = uu[0];
#pragma unroll
            for (int j = 1; j < 4; ++j) { sH = a[j] * sH + uu[j]; sP *= a[j]; }
            float iP = sP, iH = sH;
            { const float pP = __shfl_up(iP, 16), pH = __shfl_up(iH, 16); if (q >= 1) { iH = iP * pH + iH; iP = iP * pP; } }
            { const float pP = __shfl_up(iP, 32), pH = __shfl_up(iH, 32); if (q >= 2) { iH = iP * pH + iH; iP = iP * pP; } }
            float eP = __shfl_up(iP, 16), eH = __shfl_up(iH, 16); if (q == 0) { eP = 1.f; eH = 0.f; }
            const float tP = __shfl(iP, col + 48), tH = __shfl(iH, col + 48);
            if (PASS) { float h = eP * carryH + eH;
#pragma unroll
                for (int j = 0; j < 4; ++j) { const int tl = 16 * m + 4 * q + j; h = a[j] * h + uu[j]; LAS bf16* gp = gyt + tl * XR_LD + chl; *gp = (bf16)f2bf(h * bf1(*gp)); } }
            carryH = tP * carryH + tH; carryP *= tP;
        }
        if (!PASS && q == 0) { f32x2* ag = WSP(f32x2, WS_RGAGG); ag[(size_t)(b * RGC + c) * 1024 + ch] = (f32x2){carryP, carryH}; }
        __syncthreads();
        if (PASS) { const int r0 = tid >> 4, c8 = (tid & 15) * 8;
#pragma unroll
            for (int qq = 0; qq < 4; ++qq) { const int r = r0 + 32 * qq; f32x4 h0, h1; unpack8(*(const LAS u32x4*)(gyt + r * XR_LD + c8), h0, h1); u32x2 w8; w8.x = pk4_fp8(h0[0], h0[1], h0[2], h0[3]); w8.y = pk4_fp8(h1[0], h1[1], h1[2], h1[3]);
                *(u32x2*)((unsigned char*)ha + (size_t)(t0 + r) * 1024 + hd * 128 + c8) = w8; } }
        if (has_next) rg_convwrite(cw, cb, nit, tid, xraw, graw, xr, gytn, PASS);
        __syncthreads();
        it = nit;
    }
}
__device__ __forceinline__ void p4_carries(Frame& F) {
    LAS f32x2* seg = (LAS f32x2*)F.lds;
    for (int job = F.vcu; job < NB * S5G; job += F.G) {
        const int b = job >> 5, g = job & 31, p = F.lane, w = F.wave;
        const f32x2 al = WSP(f32x2, WS_AL)[g * 64 + p];
        const f32x2* Sb = WSP(f32x2, WS_S) + ((size_t)(g * S5M + b * S5CPB + 16 * w)) * 64 + p; unsigned* ac = (unsigned*)(WSP(bf16, WS_ACAT) + ((size_t)(g * S5M + b * S5CPB + 16 * w)) * S5ROW) + p;
        f32x2 sv[16];
#pragma unroll
        for (int i = 0; i < 16; ++i) sv[i] = Sb[(size_t)i * 64];
        float xr_ = 0.f, xi = 0.f;
#pragma unroll
        for (int i = 0; i < 16; ++i) { const float nr = al.x * xr_ - al.y * xi + sv[i].x, ni = al.x * xi + al.y * xr_ + sv[i].y; xr_ = nr; xi = ni; }
        seg[w * 64 + p] = (f32x2){xr_, xi};
        float ar = al.x, ai = al.y;
#pragma unroll
        for (int q = 0; q < 4; ++q) { const float nr = ar * ar - ai * ai, ni = 2.f * ar * ai; ar = nr; ai = ni; }
        __syncthreads();
        xr_ = 0.f; xi = 0.f;
        for (int ww = 0; ww < w; ++ww) { const f32x2 sg = seg[ww * 64 + p]; const float nr = ar * xr_ - ai * xi + sg.x, ni = ar * xi + ai * xr_ + sg.y; xr_ = nr; xi = ni; }
#pragma unroll
        for (int i = 0; i < 16; ++i) { ac[(size_t)i * (S5ROW / 2)] = pk2(xr_, xi); const float nr = al.x * xr_ - al.y * xi + sv[i].x, ni = al.x * xi + al.y * xr_ + sv[i].y; xr_ = nr; xi = ni; }
        __syncthreads();
    }
    if (F.vcu < 16) {
        const int id = F.vcu * 512 + F.tid, ch = id & 1023, b = id >> 10; const f32x2* ag = WSP(f32x2, WS_RGAGG) + (size_t)b * RGC * 1024 + ch; float* hin = WSP(float, WS_HIN) + (size_t)b * RGC * 1024 + ch;
        f32x2 a[RGC];
#pragma unroll
        for (int c = 0; c < RGC; ++c) a[c] = ag[(size_t)c * 1024];
        float h = 0.f;
#pragma unroll
        for (int c = 0; c < RGC; ++c) { hin[(size_t)c * 1024] = h; h = a[c].x * h + a[c].y; }
    }
}
constexpr int WR_LD = 1028;
__device__ __forceinline__ void p9_router(Frame& F) {
    LAS float* wrt = (LAS float*)F.lds;
    LAS unsigned* rec = (LAS unsigned*)(F.lds + 32 * WR_LD * 4);
    LAS float* recp = (LAS float*)(rec + 512);
    LAS int* lcnt = (LAS int*)(recp + 512);
    LAS int* gbase = lcnt + 32;
    const float* wr = F.in[26];
    for (int i = F.tid; i < 1024 * 32; i += 512) wrt[(i & 31) * WR_LD + (i >> 5)] = wr[i];
    if (F.tid < 32) lcnt[F.tid] = 0;
    __syncthreads();
    const float* mod = WSP(float, WS_MOD); const bf16* v1 = WSP(bf16, WS_V1); bf16* x1 = WSP(bf16, WS_X1); bf16* h2 = WSP(bf16, WS_H2);
    const int lane = F.lane;
    f32x4 lg[4], lb[4];
#pragma unroll
    for (int j = 0; j < 4; ++j) { lg[j] = *((const f32x4*)F.in[24] + 64 * j + lane); lb[j] = *((const f32x4*)F.in[25] + 64 * j + lane); }
    const float brt = F.in[27][lane >> 1];
    for (int blk = F.vcu; blk < T / 128; blk += F.G) {
        for (int it = 0; it < 16; ++it) { const int ti = F.wave * 16 + it, t = blk * 128 + ti, b = t >> 12;
            f32x4 v[4]; float s = 0.f;
#pragma unroll
            for (int j = 0; j < 4; ++j) { const u32x2 w = *((const u32x2*)(v1 + (size_t)t * 1024) + 64 * j + lane); v[j] = (f32x4){bflo(w.x), bfhi(w.x), bflo(w.y), bfhi(w.y)}; s += (v[j][0] + v[j][1]) + (v[j][2] + v[j][3]); }
            const float mean = wave_sum(s) * (1.f / 1024.f); float s2 = 0.f;
#pragma unroll
            for (int j = 0; j < 4; ++j) { v[j] = v[j] - mean; s2 += (v[j][0] * v[j][0] + v[j][1] * v[j][1]) + (v[j][2] * v[j][2] + v[j][3] * v[j][3]); }
            const float rstd = 1.f / sqrtf(wave_sum(s2) * (1.f / 1024.f) + LN_EPS);
            f32x4 hh[4];
#pragma unroll
            for (int j = 0; j < 4; ++j) { const f32x4 xv = v[j] * rstd * lg[j] + lb[j]; u32x2 w; w.x = pk2(xv[0], xv[1]); w.y = pk2(xv[2], xv[3]); *((u32x2*)(x1 + (size_t)t * 1024) + 64 * j + lane) = w;
                const f32x4 sh = *((const f32x4*)(mod + b * 6144 + 3072) + 64 * j + lane), sc = *((const f32x4*)(mod + b * 6144 + 4096) + 64 * j + lane);
                hh[j] = xv * (sc + 1.0f) + sh; *((unsigned*)((unsigned char*)h2 + (size_t)t * 1024) + 64 * j + lane) = pk4_fp8(hh[j][0], hh[j][1], hh[j][2], hh[j][3]); }
            float lgt[32];
#pragma unroll
            for (int e = 0; e < 32; ++e) { float a = 0.f;
#pragma unroll
                for (int j = 0; j < 4; ++j) { const f32x4 wv = *((const LAS f32x4*)(wrt + e * WR_LD) + 64 * j + lane); a += (hh[j][0] * wv[0] + hh[j][1] * wv[1]) + (hh[j][2] * wv[2] + hh[j][3] * wv[3]); }
                lgt[e] = a; }
#pragma unroll
            for (int i = 0; i < 16; ++i) { const bool up = (lane & 32) != 0; const float send = up ? lgt[i] : lgt[i + 16], keep = up ? lgt[i + 16] : lgt[i]; lgt[i] = keep + __shfl_xor(send, 32); }
#pragma unroll
            for (int i = 0; i < 8; ++i) { const bool up = (lane & 16) != 0; const float send = up ? lgt[i] : lgt[i + 8], keep = up ? lgt[i + 8] : lgt[i]; lgt[i] = keep + __shfl_xor(send, 16); }
#pragma unroll
            for (int i = 0; i < 4; ++i) { const bool up = (lane & 8) != 0; const float send = up ? lgt[i] : lgt[i + 4], keep = up ? lgt[i + 4] : lgt[i]; lgt[i] = keep + __shfl_xor(send, 8); }
#pragma unroll
            for (int i = 0; i < 2; ++i) { const bool up = (lane & 4) != 0; const float send = up ? lgt[i] : lgt[i + 2], keep = up ? lgt[i + 2] : lgt[i]; lgt[i] = keep + __shfl_xor(send, 4); }
            { const bool up = (lane & 2) != 0; const float send = up ? lgt[0] : lgt[1], keep = up ? lgt[1] : lgt[0]; lgt[0] = keep + __shfl_xor(send, 2); }
            const float logit = lgt[0] + __shfl_xor(lgt[0], 1) + brt;
            int rank = 0; const int me = lane >> 1;
#pragma unroll
            for (int e = 0; e < 32; ++e) { const float o = __shfl(logit, 2 * e); rank += (o > logit || (o == logit && e < me)) ? 1 : 0; }
            float tv[4]; int te[4];
#pragma unroll
            for (int k = 0; k < 4; ++k) { const unsigned long long mk = __ballot(rank == k && (lane & 1) == 0); const int src = __builtin_ctzll(mk); te[k] = src >> 1; tv[k] = __shfl(logit, src); }
            float pe[4], ps = 0.f;
#pragma unroll
            for (int k = 0; k < 4; ++k) { pe[k] = __expf(tv[k] - tv[0]); ps += pe[k]; }
            if (lane < 4) { const int e = te[0] * (lane == 0) + te[1] * (lane == 1) + te[2] * (lane == 2) + te[3] * (lane == 3);
                const float p = (pe[0] * (lane == 0) + pe[1] * (lane == 1) + pe[2] * (lane == 2) + pe[3] * (lane == 3)) / ps;
                const int lr = __hip_atomic_fetch_add(lcnt + e, 1, __ATOMIC_RELAXED, __HIP_MEMORY_SCOPE_WORKGROUP); rec[ti * 4 + lane] = ((unsigned)e << 16) | (unsigned)lr; recp[ti * 4 + lane] = p; }
        }
        __syncthreads();
        if (F.tid < 32) { const int n = lcnt[F.tid]; gbase[F.tid] = n ? (int)atomicAdd(F.ctl + CW_CNT + 64 * F.tid, (unsigned)n) : 0; lcnt[F.tid] = 0; }
        __syncthreads();
        { const unsigned r = rec[F.tid]; const int e = r >> 16, rk = gbase[e] + (int)(r & 0xffffu), t = blk * 128 + (F.tid >> 2);
          WSP(int, WS_TOK)[(size_t)e * T + rk] = t; WSP(unsigned, WS_POS)[(size_t)t * 4 + (F.tid & 3)] = ((unsigned)e << 20) | (unsigned)rk; WSP(float, WS_PROB)[(size_t)t * 4 + (F.tid & 3)] = recp[F.tid]; }
        __syncthreads();
    }
}
__device__ __forceinline__ void p12_final(Frame& F) {
    moe_tables(F);
    const LAS int* tstart = (const LAS int*)(F.lds + TAB_OFF);
    const float* mod = WSP(float, WS_MOD); const bf16* x1 = WSP(bf16, WS_X1); const bf16* yb = WSP(bf16, WS_YB); const unsigned* pos = WSP(unsigned, WS_POS); const float* prob = WSP(float, WS_PROB);
    const int lane = F.lane, gw = F.vcu * 8 + F.wave, NGW = F.G * 8;
    f32x4 lg[4], lb[4];
#pragma unroll
    for (int j = 0; j < 4; ++j) { lg[j] = *((const f32x4*)F.in[32] + 64 * j + lane); lb[j] = *((const f32x4*)F.in[33] + 64 * j + lane); }
    for (int tb = gw; tb < T; tb += 2 * NGW) {
        unsigned pp[2][4]; float pw[2][4]; u32x2 yw[2][4][4], xw[2][4];
#pragma unroll
        for (int q = 0; q < 2; ++q) { const int t = tb + q * NGW; const u32x4 p4 = *(const u32x4*)(pos + (size_t)t * 4); const f32x4 w4 = *(const f32x4*)(prob + (size_t)t * 4);
            pp[q][0] = p4.x; pp[q][1] = p4.y; pp[q][2] = p4.z; pp[q][3] = p4.w; pw[q][0] = w4[0]; pw[q][1] = w4[1]; pw[q][2] = w4[2]; pw[q][3] = w4[3]; }
#pragma unroll
        for (int q = 0; q < 2; ++q) { const int t = tb + q * NGW;
#pragma unroll
            for (int k = 0; k < 4; ++k) { const int e = pp[q][k] >> 20, rk = pp[q][k] & 0xfffffu; const size_t slot = (size_t)tstart[e] * 256 + rk;
#pragma unroll
                for (int j = 0; j < 4; ++j) yw[q][k][j] = *((const u32x2*)(yb + slot * 1024) + 64 * j + lane); }
#pragma unroll
            for (int j = 0; j < 4; ++j) xw[q][j] = *((const u32x2*)(x1 + (size_t)t * 1024) + 64 * j + lane); }
#pragma unroll
        for (int q = 0; q < 2; ++q) { const int t = tb + q * NGW, b = t >> 12;
            f32x4 v[4]; float s = 0.f;
#pragma unroll
            for (int j = 0; j < 4; ++j) { f32x4 f = (f32x4){0.f, 0.f, 0.f, 0.f};
#pragma unroll
                for (int k = 0; k < 4; ++k) { const u32x2 w = yw[q][k][j]; f += (f32x4){bflo(w.x), bfhi(w.x), bflo(w.y), bfhi(w.y)} * pw[q][k]; }
                const u32x2 w = xw[q][j]; const f32x4 g2 = *((const f32x4*)(mod + b * 6144 + 5120) + 64 * j + lane) + 1.0f;
                v[j] = (f32x4){bflo(w.x), bfhi(w.x), bflo(w.y), bfhi(w.y)} * DN_ALPHA + g2 * f; s += (v[j][0] + v[j][1]) + (v[j][2] + v[j][3]); }
            const float mean = wave_sum(s) * (1.f / 1024.f); float s2 = 0.f;
#pragma unroll
            for (int j = 0; j < 4; ++j) { v[j] = v[j] - mean; s2 += (v[j][0] * v[j][0] + v[j][1] * v[j][1]) + (v[j][2] * v[j][2] + v[j][3] * v[j][3]); }
            const float rstd = 1.f / sqrtf(wave_sum(s2) * (1.f / 1024.f) + LN_EPS);
#pragma unroll
            for (int j = 0; j < 4; ++j) *((f32x4*)(F.out + (size_t)t * 1024) + 64 * j + lane) = v[j] * rstd * lg[j] + lb[j]; }
    }
}

struct Args { const float* in[34]; float* out; unsigned char* ws; int ph_lo, ph_hi; };
__global__ void __launch_bounds__(512, 2) fwd_kernel(Args args) {
    extern __shared__ __attribute__((aligned(16))) unsigned char lds_raw[];
    Frame F;
    F.lds = (LAS unsigned char*)lds_raw; F.MISC = (volatile LAS unsigned*)(F.lds + MISC_OFF);
    F.tid = threadIdx.x; F.lane = F.tid & 63; F.wave = __builtin_amdgcn_readfirstlane(F.tid >> 6);
    F.G = gridDim.x; { const int bx = blockIdx.x; F.vcu = (F.G % 8 == 0) ? (bx % 8) * (F.G / 8) + bx / 8 : bx; }
#pragma unroll
    for (int i = 0; i < 34; ++i) F.in[i] = args.in[i];
    F.out = args.out; F.ws = args.ws; F.ctl = (unsigned*)(args.ws + WS_CTL);
    if (F.tid < 64) F.MISC[F.tid] = 0u;
    __syncthreads();
    XcdBarrier bar; bar.bar = F.ctl + CW_BAR; bar.x = 0; bar.st = nullptr;
    if (MK_N_LAUNCHES == 1) bar = xcd_barrier_post(F.ctl + CW_BAR, F.MISC + 8);
    const int lo = args.ph_lo, hi = args.ph_hi;
#define IN(k) (lo <= (k) && (k) < hi)
#define SEAM(k) do { if (IN(k) && IN((k) + 1)) xcd_barrier(bar); } while (0)

    if (IN(0)) REPS(0) { if (rep_) xcd_barrier(bar);
        for (int j = F.vcu; j < 192; j += F.G) p0_mod_job(F, j);
        for (int j = F.vcu; j < S5G * 8; j += F.G) p0_s5k_job(F, j);
        p0_small_transposes(F);
    }
    SEAM(0);
    if (IN(1)) REPS(1) { if (rep_) xcd_barrier(bar); for (int j = F.vcu; j < S5G * 8; j += F.G) p1_s5w_job(F, j); p1_body(F); }
    SEAM(1);
    if (IN(2)) REPS(2) { if (rep_) xcd_barrier(bar);
        g8::GridOrder S; S.init(T, INC, F.G, (int)blockIdx.x, WSP(bf16, WS_HBF), WSP(bf16, WS_WIN), 1024, 1024);
        EpiInProj E{F.in[5], WSP(bf16, WS_XRNN), WSP(bf16, WS_GY), WSP(bf16, WS_ACAT), WSP(bf16, WS_GATES)};
        g8::gemm_phase<EpiInProj, g8::GridOrder, false, true>(F.lds, 1024, 1024, 1024, S, E);
    }
    SEAM(2);
    if (IN(3)) REPS(3) { if (rep_) xcd_barrier(bar);
        { S5AOrder S{F.G, F.vcu, (const char*)WSP(bf16, WS_ACAT), (const char*)WSP(bf16, WS_WS)}; EpiS5A E{WSP(float, WS_S)};
          g8::gemm_phase<EpiS5A, S5AOrder, false>(F.lds, S5L * 32, S5ROW * 2, S5L * 32, S, E); }
        __syncthreads();
        rglru_phase<0>(F);
    }
    SEAM(3);
    if (IN(4)) REPS(4) { if (rep_) xcd_barrier(bar); p4_carries(F); }
    SEAM(4);
    if (IN(5)) REPS(5) { if (rep_) xcd_barrier(bar);
        { S5COrder S{F.G, F.vcu, (const char*)WSP(bf16, WS_ACAT), (const char*)WSP(bf16, WS_WY)}; EpiS5C E{WSP(bf16, WS_YS)};
          g8::gemm_phase<EpiS5C, S5COrder, false>(F.lds, S5ROW * 2, S5ROW * 2, S5ROW * 2, S, E); }
        __syncthreads();
        rglru_phase<1>(F);
    }
    SEAM(5);
    if (IN(6)) REPS(6) { if (rep_) xcd_barrier(bar);
        g8::GridOrder S; S.init(T, 2048, F.G, (int)blockIdx.x, WSP(bf16, WS_YS), WSP(bf16, WS_WGLU), 512, 512);
        EpiGlu E{WSP(bf16, WS_GATES), WSP(bf16, WS_GB)};
        g8::gemm_phase<EpiGlu, g8::GridOrder, false, true>(F.lds, 512, 512, 512, S, E);
    }
    SEAM(6);
    if (IN(7)) REPS(7) { if (rep_) xcd_barrier(bar);
        g8::GridOrder S; S.init(T, 1024, F.G, (int)blockIdx.x, WSP(bf16, WS_HA), WSP(bf16, WS_WRNN), 1024, 1024);
        EpiRnn E{WSP(bf16, WS_GATES), WSP(bf16, WS_GB), WSP(bf16, WS_MERGED)};
        g8::gemm_phase<EpiRnn, g8::GridOrder, false, true>(F.lds, 1024, 1024, 1024, S, E);
    }
    SEAM(7);
    if (IN(8)) REPS(8) { if (rep_) xcd_barrier(bar);
        g8::GridOrder S; S.init(T, 1024, F.G, (int)blockIdx.x, WSP(bf16, WS_MERGED), WSP(bf16, WS_WOUT), 1024, 1024);
        EpiOut E{F.in[0], WSP(float, WS_MOD), WSP(bf16, WS_V1)};
        g8::gemm_phase<EpiOut, g8::GridOrder, false, true>(F.lds, 1024, 1024, 1024, S, E);
    }
    SEAM(8);
    if (IN(9)) REPS(9) { if (rep_) xcd_barrier(bar); p9_router(F); }
    SEAM(9);
    if (IN(10)) REPS(10) { if (rep_) xcd_barrier(bar);
        moe_tables(F);
        const LAS int* tstart = (const LAS int*)(F.lds + TAB_OFF);
        MoeOrder S{F.G, (int)blockIdx.x, 8, tstart[NE], tstart, tstart + 40, WSP(int, WS_TOK), (const char*)WSP(bf16, WS_H2), (const char*)WSP(bf16, WS_WGU), (size_t)2048 * 1024, 1024, true};
        EpiMoe1 E{F.in[29], WSP(bf16, WS_ACT)};
        g8::gemm_phase<EpiMoe1, MoeOrder, true, true>(F.lds, 1024, 1024, 1024, S, E);
    }
    SEAM(10);
    if (IN(11)) REPS(11) { if (rep_) xcd_barrier(bar);
        moe_tables(F);
        const LAS int* tstart = (const LAS int*)(F.lds + TAB_OFF);
        MoeOrder S{F.G, (int)blockIdx.x, 4, tstart[NE], tstart, tstart + 40, WSP(int, WS_TOK), (const char*)WSP(bf16, WS_ACT), (const char*)WSP(bf16, WS_WD), (size_t)1024 * 1024, 1024, false};
        EpiMoe2 E{F.in[31], WSP(bf16, WS_YB)};
        g8::gemm_phase<EpiMoe2, MoeOrder, false, true>(F.lds, 1024, 1024, 1024, S, E);
    }
    SEAM(11);
    if (IN(12)) REPS(12) { if (rep_) xcd_barrier(bar); p12_final(F); }
#undef IN
#undef SEAM
}

extern "C" void kernel_launch(void* const* d_in, const int* in_sizes, int n_in, void* d_out, int out_size, void* d_ws, size_t ws_size, hipStream_t stream) {
    static int grid = 0;
    if (grid == 0) {
        if (n_in != 34 || in_sizes[0] != T * D || out_size != T * D || ws_size < WS_END) { fprintf(stderr, "kernel_launch: unexpected shapes (n_in %d, ws %zu < %zu)\n", n_in, ws_size, (size_t)WS_END); grid = -1; return; }
        int dev = 0, cus = 0;
        if (hipGetDevice(&dev) != hipSuccess || hipDeviceGetAttribute(&cus, hipDeviceAttributeMultiprocessorCount, dev) != hipSuccess) { grid = -1; return; }
        if (hipFuncSetAttribute((const void*)fwd_kernel, hipFuncAttributeMaxDynamicSharedMemorySize, LDS_BYTES) != hipSuccess) { fprintf(stderr, "kernel_launch: hipFuncSetAttribute failed\n"); grid = -1; return; }
        int per_cu = 0; (void)hipOccupancyMaxActiveBlocksPerMultiprocessor(&per_cu, (const void*)fwd_kernel, 512, LDS_BYTES); (void)hipGetLastError();
        grid = cus;
    }
    if (grid < 0) return;
    (void)hipMemsetAsync((char*)d_ws + WS_CTL, 0, CTL_BYTES, stream);
    Args a{};
    for (int i = 0; i < 34; ++i) a.in[i] = (const float*)d_in[i];
    a.out = (float*)d_out; a.ws = (unsigned char*)d_ws;
    if (MK_N_LAUNCHES == 1) { a.ph_lo = 0; a.ph_hi = N_PHASES; hipLaunchKernelGGL(fwd_kernel, dim3(grid), dim3(512), LDS_BYTES, stream, a); }
    else for (int p = 0; p < N_PHASES; ++p) { a.ph_lo = p; a.ph_hi = p + 1; hipLaunchKernelGGL(fwd_kernel, dim3(grid), dim3(512), LDS_BYTES, stream, a); }
}
```

```cpp
#include <hip/hip_runtime.h>
#include <cstdio>
#include <cstdint>

#ifndef MK_N_LAUNCHES
#define MK_N_LAUNCHES 1
#endif
constexpr int N_PHASES = 13;
#ifndef DUP_PHASE
#define DUP_PHASE -1
#endif
#define REPS(k) for (int rep_ = 0; rep_ < ((DUP_PHASE == (k)) ? 2 : 1); ++rep_)

#define GAS __attribute__((address_space(1)))
#define LAS __attribute__((address_space(3)))
typedef unsigned short bf16;
typedef short bf16x8 __attribute__((ext_vector_type(8)));
typedef float f32x4 __attribute__((ext_vector_type(4)));
typedef float f32x2 __attribute__((ext_vector_type(2)));
typedef unsigned u32x4 __attribute__((ext_vector_type(4)));
typedef unsigned u32x2 __attribute__((ext_vector_type(2)));
typedef GAS unsigned gu32;

constexpr int NB = 8, SEQ = 4096, T = NB * SEQ, D = 1024, INC = 4608, NE = 32, DFF = 1024;
constexpr int S5L = 32, S5G = 32, S5ROW = 128 + S5L * 16  , S5M = T / S5L  , S5CPB = SEQ / S5L  ;
constexpr int RGL = 128, RGC = SEQ / RGL  ;
constexpr float LN_EPS = 1e-5f, DN_ALPHA = 1.189207115002721f;
constexpr int ACT_ROWS = T * 4 + NE * 256;

constexpr size_t MiB = 1u << 20;
constexpr size_t WS_XRNN = 0, WS_GY = 64 * MiB, WS_GATES = 128 * MiB, WS_V1 = 0, WS_ACT = 0;
constexpr size_t WS_HBF = 272 * MiB, WS_HA = 272 * MiB, WS_YS = 336 * MiB, WS_GB = 368 * MiB, WS_MERGED = 432 * MiB, WS_ACAT = 496 * MiB, WS_YB = 272 * MiB;
constexpr size_t WS_X1 = 544 * MiB, WS_H2 = 608 * MiB;
constexpr size_t WS_WGU = 672 * MiB, WS_WD = 800 * MiB, WS_WIN = 864 * MiB, WS_WG = 873 * MiB, WS_WRNN = 874 * MiB, WS_WGLU = 876 * MiB, WS_WOUT = 878 * MiB;
constexpr size_t WS_WS = 880 * MiB, WS_WY = 888 * MiB, WS_S = 908 * MiB;
constexpr size_t WS_MOD = 924 * MiB, WS_AL = 925 * MiB, WS_RGAGG = 926 * MiB, WS_HIN = 928 * MiB, WS_TOK = 929 * MiB, WS_POS = 933 * MiB, WS_PROB = 934 * MiB, WS_CTL = 935 * MiB;
constexpr size_t WS_END = 936 * MiB, CTL_BYTES = 1 * MiB;
static_assert((size_t)ACT_ROWS * DFF * 2 <= 272 * MiB, "act/yb size");
static_assert(WS_ACAT + (size_t)S5G * S5M * S5ROW * 2 <= WS_X1, "acat");
constexpr int CW_BAR = 4096, CW_CNT = 8192  ;

constexpr int LDS_BYTES = 147456, MISC_OFF = LDS_BYTES - 256, TAB_OFF = 131072 + 1024;

__device__ __forceinline__ unsigned f2bf(float f) { unsigned u = __builtin_bit_cast(unsigned, f); return (u + 0x7fffu + ((u >> 16) & 1u)) >> 16; }
typedef __bf16 bf16x2v __attribute__((ext_vector_type(2)));
__device__ __forceinline__ unsigned pk2(float lo, float hi) { const f32x2 v = {lo, hi}; const bf16x2v b = __builtin_convertvector(v, bf16x2v); return __builtin_bit_cast(unsigned, b); }
__device__ __forceinline__ unsigned pk4_fp8(float a, float b, float c, float d) { int w = 0; w = __builtin_amdgcn_cvt_pk_fp8_f32(a, b, w, false); w = __builtin_amdgcn_cvt_pk_fp8_f32(c, d, w, true); return (unsigned)w; }
__device__ __forceinline__ float bflo(unsigned w) { return __builtin_bit_cast(float, w << 16); }
__device__ __forceinline__ float bfhi(unsigned w) { return __builtin_bit_cast(float, w & 0xffff0000u); }
__device__ __forceinline__ float bf1(bf16 h) { return __builtin_bit_cast(float, ((unsigned)h) << 16); }
__device__ __forceinline__ float fast_sigmoid(float x) { return __builtin_amdgcn_rcpf(1.0f + __builtin_amdgcn_exp2f(-1.4426950409f * x)); }
__device__ __forceinline__ float gelu_tanh(float x) { const float u = x + 0.044715f * x * x * x; return x * __builtin_amdgcn_rcpf(1.0f + __builtin_amdgcn_exp2f(-2.3022082f * u)); }
__device__ __forceinline__ float wave_sum(float v) {
#pragma unroll
    for (int o = 1; o < 64; o <<= 1) v += __shfl_xor(v, o);
    return v;
}
__device__ __forceinline__ u32x4 pack8(f32x4 a, f32x4 b) { u32x4 w; w.x = pk2(a[0], a[1]); w.y = pk2(a[2], a[3]); w.z = pk2(b[0], b[1]); w.w = pk2(b[2], b[3]); return w; }
__device__ __forceinline__ void unpack8(u32x4 w, f32x4& a, f32x4& b) { a = (f32x4){bflo(w.x), bfhi(w.x), bflo(w.y), bfhi(w.y)}; b = (f32x4){bflo(w.z), bfhi(w.z), bflo(w.w), bfhi(w.w)}; }

#define XB_TMO      128
#define XB_XCNT(j)  (256  + 64 * (j))
#define XB_XSUB(j)  (1280 + 64 * (j))
#define XB_XGEN(j)  (2304 + 64 * (j))
#define XB_TOP      3328
#define XB_TOPGEN   3392
#define XCD_BAR_WORDS 3456
#define XB_SPIN_CAP (1u << 18)
__device__ __forceinline__ unsigned xb_ld(unsigned* p)              { return __hip_atomic_load(p, __ATOMIC_RELAXED, __HIP_MEMORY_SCOPE_AGENT); }
__device__ __forceinline__ unsigned xb_add(unsigned* p, unsigned v) { return __hip_atomic_fetch_add(p, v, __ATOMIC_RELAXED, __HIP_MEMORY_SCOPE_AGENT); }
__device__ __forceinline__ unsigned xb_xcc_id() { return (unsigned)__builtin_amdgcn_s_getreg((3 << 11) | 20) & 0xFu; }
#define XB_SPIN(cond, bar) do { unsigned _sp = 0; while (cond) { __builtin_amdgcn_s_sleep(1); \
    if ((++_sp & 255u) == 0u) { if (xb_ld(&(bar)[XB_TMO])) break; if (_sp > XB_SPIN_CAP) { atomicAdd(&(bar)[XB_TMO], 1u); break; } } } } while (0)
struct XcdBarrier { unsigned* bar; unsigned x; volatile LAS unsigned* st; };
__device__ __forceinline__ XcdBarrier xcd_barrier_post(unsigned* bar, volatile LAS unsigned* st) {
    XcdBarrier b; b.bar = bar; b.x = xb_xcc_id(); b.st = st;
    if (threadIdx.x == 0) (void)xb_add(&bar[XB_XCNT(b.x)], 1u);
    return b;
}
__device__ __forceinline__ void xcd_barrier_complete(unsigned* bar, unsigned x, unsigned& nloc, unsigned& nx) {
    const unsigned G = gridDim.x * gridDim.y * gridDim.z;
    unsigned sum, cnt, mine, sp = 0u;
    for (;;) {
        sum = 0u; cnt = 0u; mine = 0u;
#pragma unroll
        for (unsigned j = 0; j < 16; ++j) { const unsigned c = xb_ld(&bar[XB_XCNT(j)]); sum += c; cnt += (c > 0u) ? 1u : 0u; mine = (j == x) ? c : mine; }
        if (sum == G) break;
        __builtin_amdgcn_s_sleep(1);
        if ((++sp & 255u) == 0u) { if (xb_ld(&bar[XB_TMO])) break; if (sp > XB_SPIN_CAP) { atomicAdd(&bar[XB_TMO], 1u); break; } }
    }
    nloc = mine > 0u ? mine : 1u; nx = cnt > 0u ? cnt : 1u;
}
__device__ __forceinline__ void xcd_barrier(const XcdBarrier& b) {
    asm volatile("s_waitcnt vmcnt(0)" ::: "memory");
    __syncthreads();
    if (threadIdx.x == 0) {
        unsigned* bar = b.bar;
        __builtin_amdgcn_s_waitcnt(0);
        unsigned nloc = b.st[0], nx = b.st[1];
        if (nloc == 0u) { xcd_barrier_complete(bar, b.x, nloc, nx); b.st[0] = nloc; b.st[1] = nx; }
        const unsigned old = xb_add(&bar[XB_XSUB(b.x)], 1u);
        const unsigned gen = old / nloc;
        if (old + 1u == (gen + 1u) * nloc) {
            __builtin_amdgcn_fence(__ATOMIC_RELEASE, "agent");
            asm volatile("s_waitcnt vmcnt(0)" ::: "memory");
            const unsigned og = xb_add(&bar[XB_TOP], 1u);
            const unsigned tg = og / nx;
            if (og + 1u == (tg + 1u) * nx) xb_add(&bar[XB_TOPGEN], 1u);
            else XB_SPIN(xb_ld(&bar[XB_TOPGEN]) == tg, bar);
            __builtin_amdgcn_fence(__ATOMIC_ACQUIRE, "agent");
            xb_add(&bar[XB_XGEN(b.x)], 1u);
            asm volatile("s_waitcnt vmcnt(0)" ::: "memory");
        } else {
            XB_SPIN(xb_ld(&bar[XB_XGEN(b.x)]) == gen, bar);
            __builtin_amdgcn_fence(__ATOMIC_ACQUIRE, "agent");
            asm volatile("s_waitcnt vmcnt(0)" ::: "memory");
        }
    }
    __syncthreads();
}

namespace g8 {
constexpr int BM = 256, BK = 64, HALF = 128, HTB = HALF * BK * 2, STAGE_BYTES = 8 * HTB;
__device__ __forceinline__ int lds_byte(int r, int c) { const int st = (r >> 4) * 2 + (c >> 5), rr = r & 15, cc = c & 31, ob = rr * 64 + cc * 2; return st * 1024 + (ob ^ (((ob >> 9) & 1) << 5)); }
__device__ __forceinline__ void stage_rc(int b, int& R, int& C) { const int st = b / 1024, sb = b % 1024, swz = sb ^ (((sb >> 9) & 1) << 5); R = (st >> 1) * 16 + swz / 64; C = (st & 1) * 32 + (swz % 64) / 2; }
__device__ __forceinline__ int perm32(int rho) { const int n = rho >> 4, i = rho & 15; return 8 * (i >> 2) + 4 * n + (i & 3); }

struct Unit { int pm, pn, z, rl; const char* A; const char* B; };

typedef int v8i __attribute__((ext_vector_type(8)));
typedef int v4i __attribute__((ext_vector_type(4)));
typedef short s16x16 __attribute__((ext_vector_type(16)));
typedef s16x16 s16x16_a16 __attribute__((aligned(16)));
__device__ __forceinline__ v8i cat8(bf16x8 lo, bf16x8 hi) { const v4i a = __builtin_bit_cast(v4i, lo), b = __builtin_bit_cast(v4i, hi); return __builtin_shufflevector(a, b, 0, 1, 2, 3, 4, 5, 6, 7); }
template <class Epi, class Sched, bool GATHER, bool FP8 = false>
__device__ __forceinline__ void gemm_phase(LAS unsigned char* lds, const int Kb, const int ldaB, const int ldbB, const Sched& S, const Epi& E) {
    const int tid = threadIdx.x, wid = __builtin_amdgcn_readfirstlane(tid >> 6), lane = tid & 63, wr = wid >> 2, wc = wid & 3, fr = lane & 15, fq = lane >> 4;
    const int nt = Kb / 128;
    unsigned voffB[2], cvo[2][2], nvo[2][2]; int Rr[2], Cc[2];
#pragma unroll
    for (int i = 0; i < 2; ++i) { int R, C; stage_rc(tid * 16 + i * 8192, R, C); const int Rb = (R & ~31) + perm32(R & 31);
        voffB[i] = (unsigned)(Rb * ldbB + C * 2); Rr[i] = R; Cc[i] = C;
#pragma unroll
        for (int h = 0; h < 2; ++h) { cvo[h][i] = (unsigned)((h * HALF + R) * ldaB + C * 2); nvo[h][i] = cvo[h][i]; } }
    const size_t kstep = (size_t)(BK * 2);
    const size_t hstepB = (size_t)HALF * ldbB;
    const unsigned ldsw = (unsigned)wid * 1024u;
    const int aoff = FP8 ? lds_byte(wr * 64 + fr, (fq >> 1) * 32 + (fq & 1) * 24) : lds_byte(wr * 64 + fr, fq * 8), boff = FP8 ? lds_byte(wc * 32 + fr, (fq >> 1) * 32 + (fq & 1) * 24) : lds_byte(wc * 32 + fr, fq * 8);
    const int aoff2 = FP8 ? lds_byte(wr * 64 + fr, (fq >> 1) * 32 + 8 + (fq & 1) * 8) : 0, boff2 = FP8 ? lds_byte(wc * 32 + fr, (fq >> 1) * 32 + 8 + (fq & 1) * 8) : 0;
#define G8_SA(b, h) (((b) * 2 + (h)) * HTB)
#define G8_SB(b, h) ((4 + (b) * 2 + (h)) * HTB)
#define G8_STGB(bufoff, gbase) do { _Pragma("unroll") for (int _i = 0; _i < 2; ++_i) \
        __builtin_amdgcn_global_load_lds((const unsigned*)((const char*)(gbase) + voffB[_i]), (LAS unsigned*)(lds + (bufoff) + ldsw + _i * 8192), 16, 0, 0); } while (0)
#define G8_STGA(bufoff, gbase, VO, h) do { _Pragma("unroll") for (int _i = 0; _i < 2; ++_i) \
        __builtin_amdgcn_global_load_lds((const unsigned*)((const char*)(gbase) + VO[h][_i]), (LAS unsigned*)(lds + (bufoff) + ldsw + _i * 8192), 16, 0, 0); } while (0)
#define G8_LDA(dst, b, h) do { _Pragma("unroll") for (int m = 0; m < 4; ++m) { if constexpr (FP8) { dst##8[m] = cat8(*(const LAS bf16x8*)(lds + G8_SA(b, h) + aoff + m * 2048), *(const LAS bf16x8*)(lds + G8_SA(b, h) + aoff2 + m * 2048)); } \
        else { _Pragma("unroll") for (int k = 0; k < 2; ++k) dst[m][k] = *(const LAS bf16x8*)(lds + G8_SA(b, h) + aoff + m * 2048 + k * 1024); } } } while (0)
#define G8_LDB(dst, b, h) do { _Pragma("unroll") for (int n = 0; n < 2; ++n) { if constexpr (FP8) { dst##8[n] = cat8(*(const LAS bf16x8*)(lds + G8_SB(b, h) + boff + n * 2048), *(const LAS bf16x8*)(lds + G8_SB(b, h) + boff2 + n * 2048)); } \
        else { _Pragma("unroll") for (int k = 0; k < 2; ++k) dst[n][k] = *(const LAS bf16x8*)(lds + G8_SB(b, h) + boff + n * 2048 + k * 1024); } } } while (0)
#define G8_MMA(ai, bj, At, Bt) do { __builtin_amdgcn_s_setprio(1); _Pragma("unroll") for (int m = 0; m < 4; ++m) _Pragma("unroll") for (int n = 0; n < 2; ++n) { \
        if constexpr (FP8) asm volatile("s_nop 1\n\tv_mfma_scale_f32_16x16x128_f8f6f4 %0, %1, %2, %0, %3, %4 op_sel_hi:[0,0,0]" : "+v"(acc[ai][bj][m][n]) : "v"(Bt##8[n]), "v"(At##8[m]), "v"(sc_w), "v"(sc_a)); \
        else { _Pragma("unroll") for (int k = 0; k < 2; ++k) acc[ai][bj][m][n] = __builtin_amdgcn_mfma_f32_16x16x32_bf16(Bt[n][k], At[m][k], acc[ai][bj][m][n], 0, 0, 0); } } __builtin_amdgcn_s_setprio(0); } while (0)
#define G8_WAIT_V(n) asm volatile("s_waitcnt vmcnt(" #n ")" ::: "memory")
#define G8_WAIT_L(n) asm volatile("s_waitcnt lgkmcnt(" #n ")" ::: "memory")
#define G8_BAR __builtin_amdgcn_s_barrier()
#define G8_SCHED __builtin_amdgcn_sched_barrier(0)
    Unit cur, nxt; int ui = 0;
    if (!S.next(0, cur)) return;
    bool has_next = S.next(1, nxt);
    if constexpr (GATHER) { S.gather(cur, Rr, Cc, cvo); if (has_next) S.gather(nxt, Rr, Cc, nvo); else {
#pragma unroll
        for (int h = 0; h < 2; ++h)
#pragma unroll
            for (int i = 0; i < 2; ++i) nvo[h][i] = cvo[h][i]; } }
    f32x4 acc[2][2][4][2];
#pragma unroll
    for (int a = 0; a < 2; ++a)
#pragma unroll
        for (int b = 0; b < 2; ++b)
#pragma unroll
            for (int m = 0; m < 4; ++m)
#pragma unroll
                for (int n = 0; n < 2; ++n) acc[a][b][m][n] = (f32x4){0.f, 0.f, 0.f, 0.f};
    const int sc_w = 0x7a7a7a7a, sc_a = 0x7f7f7f7f;
    bf16x8 At[4][2], B0[2][2], B1[2][2]; v8i At8[4], B08[2], B18[2];
    const char* cA = cur.A; const char* cB = cur.B;
    G8_STGB(G8_SB(0, 0), cB); G8_STGB(G8_SB(0, 1), cB + hstepB); G8_STGA(G8_SA(0, 0), cA, cvo, 0); G8_STGA(G8_SA(0, 1), cA, cvo, 1);
    if (wr == 1) G8_BAR;
    G8_WAIT_V(2); G8_BAR;
    G8_STGB(G8_SB(1, 0), cB + kstep); G8_STGA(G8_SA(1, 0), cA + kstep, cvo, 0); G8_STGB(G8_SB(1, 1), cB + hstepB + kstep);
    G8_WAIT_V(6); G8_BAR;
    for (;;) {
        const char* nA = has_next ? nxt.A : cA; const char* nB = has_next ? nxt.B : cB;
        for (int t = 0; t < nt; t += 2) {
            const bool last = (t == nt - 2);
            const char* a1 = cA + (size_t)(t + 1) * kstep;
            const char* a2 = last ? nA : cA + (size_t)(t + 2) * kstep; const char* b2 = last ? nB : cB + (size_t)(t + 2) * kstep;
            const char* a3 = a2 + kstep; const char* b3 = b2 + kstep;
            unsigned vo2[2][2];
#pragma unroll
            for (int h = 0; h < 2; ++h)
#pragma unroll
                for (int i = 0; i < 2; ++i) vo2[h][i] = (GATHER && last) ? nvo[h][i] : cvo[h][i];
            G8_LDB(B0, 0, 0); G8_LDB(B1, 0, 1); G8_SCHED; G8_LDA(At, 0, 0); G8_STGA(G8_SA(1, 1), a1, cvo, 1);
            G8_WAIT_V(8); G8_WAIT_L(0); G8_BAR; G8_SCHED; G8_MMA(0, 0, At, B0); G8_MMA(0, 1, At, B1); G8_SCHED; G8_BAR; G8_SCHED;
            G8_LDA(At, 0, 1); G8_STGB(G8_SB(0, 0), b2); G8_STGB(G8_SB(0, 1), b2 + hstepB); G8_STGA(G8_SA(0, 0), a2, vo2, 0);
            G8_WAIT_V(8); G8_WAIT_L(0); G8_BAR; G8_SCHED; G8_MMA(1, 0, At, B0); G8_MMA(1, 1, At, B1); G8_SCHED; G8_BAR; G8_SCHED;
            G8_LDB(B0, 1, 0); G8_LDB(B1, 1, 1); G8_SCHED; G8_LDA(At, 1, 0); G8_STGA(G8_SA(0, 1), a2, vo2, 1);
            G8_WAIT_V(8); G8_WAIT_L(0); G8_BAR; G8_SCHED; G8_MMA(0, 0, At, B0); G8_MMA(0, 1, At, B1); G8_SCHED; G8_BAR; G8_SCHED;
            G8_LDA(At, 1, 1); G8_STGB(G8_SB(1, 0), b3); G8_STGB(G8_SB(1, 1), b3 + hstepB); G8_STGA(G8_SA(1, 0), a3, vo2, 0);
            G8_WAIT_V(8); G8_WAIT_L(0); G8_BAR; G8_SCHED; G8_MMA(1, 0, At, B0); G8_MMA(1, 1, At, B1); G8_SCHED; G8_BAR; G8_SCHED;
        }
        if (wr == 0) G8_BAR;
        Unit nn; bool has_nn = false;
        if (has_next) has_nn = S.next(ui + 2, nn);
        unsigned nnvo[2][2];
        if constexpr (GATHER) { if (has_nn) S.gather(nn, Rr, Cc, nnvo); }
        if constexpr (FP8) asm volatile("s_nop 15\n\ts_nop 15" ::: "memory");
        E(acc, cur, wr, wc, fr, fq);
        if (!has_next) break;
#pragma unroll
        for (int a = 0; a < 2; ++a)
#pragma unroll
            for (int b = 0; b < 2; ++b)
#pragma unroll
                for (int m = 0; m < 4; ++m)
#pragma unroll
                    for (int n = 0; n < 2; ++n) acc[a][b][m][n] = (f32x4){0.f, 0.f, 0.f, 0.f};
        cur = nxt; cA = nA; cB = nB; ++ui;
        if constexpr (GATHER) {
#pragma unroll
            for (int h = 0; h < 2; ++h)
#pragma unroll
                for (int i = 0; i < 2; ++i) { cvo[h][i] = nvo[h][i]; if (has_nn) nvo[h][i] = nnvo[h][i]; } }
        nxt = nn; has_next = has_nn;
        if (wr == 1) G8_BAR;
    }
    G8_WAIT_V(0);
    G8_BAR;
#undef G8_SA
#undef G8_SB
#undef G8_STGB
#undef G8_STGA
#undef G8_LDA
#undef G8_LDB
#undef G8_MMA
#undef G8_WAIT_V
#undef G8_WAIT_L
#undef G8_BAR
#undef G8_SCHED
}

struct GridOrder {
    int nM, nN, nwg, G, c; const char* A; const char* B; size_t tstepA, tstepB;
    __device__ __forceinline__ void init(int M, int N, int G_, int c_, const void* A_, const void* B_, int ldaB, int ldbB) { nM = M / BM; nN = N / BM; nwg = nM * nN; G = G_; c = c_; A = (const char*)A_; B = (const char*)B_; tstepA = (size_t)BM * ldaB; tstepB = (size_t)BM * ldbB; }
    __device__ __forceinline__ bool next(int i, Unit& u) const {
        const long L = (long)i * G + c; if (L >= nwg) return false;
        int wgid = (int)L; { const int q = nwg / 8, r = nwg % 8, xcd = wgid % 8, off = wgid / 8; wgid = (xcd < r ? xcd * (q + 1) : r * (q + 1) + (xcd - r) * q) + off; }
        const int nig = 8 * nN, gid = wgid / nig, fm = gid * 8, gsz = (nM - fm) < 8 ? (nM - fm) : 8;
        u.pm = fm + ((wgid % nig) % gsz); u.pn = (wgid % nig) / gsz; u.z = 0; u.rl = 0;
        u.A = A + (size_t)u.pm * tstepA; u.B = B + (size_t)u.pn * tstepB; return true;
    }
};
}

struct Frame {
    LAS unsigned char* lds; volatile LAS unsigned* MISC; unsigned* ctl;
    int tid, lane, wave, vcu, G;
    const float* in[34]; float* out; unsigned char* ws;
};
#define WSP(T_, off) ((T_*)(F.ws + (off)))

struct EpiInProj {
    const float* bias; bf16 *xrnn, *gy, *acat, *gates;
    __device__ __forceinline__ void operator()(const f32x4 (&acc)[2][2][4][2], const g8::Unit& u, int wr, int wc, int fr, int fq) const {
        const int pn = u.pn, colb = pn * 256 + wc * 32 + 8 * fq;
        f32x4 bv[2][2];
#pragma unroll
        for (int bj = 0; bj < 2; ++bj)
#pragma unroll
            for (int n = 0; n < 2; ++n) bv[bj][n] = *(const f32x4*)(bias + colb + bj * 128 + 4 * n);
#pragma unroll
        for (int ai = 0; ai < 2; ++ai)
#pragma unroll
            for (int m = 0; m < 4; ++m) { const int t = u.pm * 256 + ai * 128 + wr * 64 + m * 16 + fr;
#pragma unroll
                for (int bj = 0; bj < 2; ++bj) { f32x4 v0 = acc[ai][bj][m][0] + bv[bj][0], v1 = acc[ai][bj][m][1] + bv[bj][1]; const int col = colb + bj * 128;
                    if (pn < 4) { *(u32x4*)(xrnn + (size_t)t * 1024 + col) = pack8(v0, v1); }
                    else if (pn < 8) {
#pragma unroll
                        for (int j = 0; j < 4; ++j) { v0[j] = gelu_tanh(v0[j]); v1[j] = gelu_tanh(v1[j]); }
                        *(u32x4*)(gy + (size_t)t * 1024 + (col - 1024)) = pack8(v0, v1); }
                    else if (pn < 10) { const int cu = col - 2048, g = cu >> 4, c = cu & 15;
                        *(u32x4*)(acat + ((size_t)(g * S5M + (t >> 5)) * S5ROW + 128 + (t & 31) * 16 + c)) = pack8(v0, v1); }
                    else {
#pragma unroll
                        for (int j = 0; j < 4; ++j) { v0[j] = fast_sigmoid(v0[j]); v1[j] = fast_sigmoid(v1[j]); }
                        *(u32x4*)(gates + (size_t)t * 2048 + (col - 2560)) = pack8(v0, v1); } } }
    }
};
struct EpiS5A {
    float* S;
    __device__ __forceinline__ void operator()(const f32x4 (&acc)[2][2][4][2], const g8::Unit& u, int wr, int wc, int fr, int fq) const {
        const int col = wc * 32 + 8 * fq;
#pragma unroll
        for (int ai = 0; ai < 2; ++ai)
#pragma unroll
            for (int m = 0; m < 4; ++m) { const int row = u.pm * 256 + ai * 128 + wr * 64 + m * 16 + fr; float* p = S + ((size_t)(u.z * S5M + row)) * 128 + col;
                *(f32x4*)p = acc[ai][0][m][0]; *(f32x4*)(p + 4) = acc[ai][0][m][1]; }
    }
};
struct EpiS5C {
    bf16* ys;
    __device__ __forceinline__ void operator()(const f32x4 (&acc)[2][2][4][2], const g8::Unit& u, int wr, int wc, int fr, int fq) const {
#pragma unroll
        for (int ai = 0; ai < 2; ++ai)
#pragma unroll
            for (int m = 0; m < 4; ++m) { const int row = u.pm * 256 + ai * 128 + wr * 64 + m * 16 + fr;
#pragma unroll
                for (int bj = 0; bj < 2; ++bj) { const int n = u.pn * 256 + bj * 128 + wc * 32 + 8 * fq, i = n >> 4, c = n & 15; f32x4 v0 = acc[ai][bj][m][0], v1 = acc[ai][bj][m][1];
#pragma unroll
                    for (int j = 0; j < 4; ++j) { v0[j] = gelu_tanh(v0[j]); v1[j] = gelu_tanh(v1[j]); }
                    u32x2 w8; w8.x = pk4_fp8(v0[0], v0[1], v0[2], v0[3]); w8.y = pk4_fp8(v1[0], v1[1], v1[2], v1[3]); *(u32x2*)((unsigned char*)ys + (size_t)(row * 32 + i) * 512 + u.z * 16 + c) = w8; } }
    }
};
struct EpiGlu {
    const bf16* gates; bf16* gb;
    __device__ __forceinline__ void operator()(const f32x4 (&acc)[2][2][4][2], const g8::Unit& u, int wr, int wc, int fr, int fq) const {
        const int f = u.pn * 128 + wc * 32 + 8 * fq;
#pragma unroll
        for (int ai = 0; ai < 2; ++ai)
#pragma unroll
            for (int m = 0; m < 4; ++m) { const int t = u.pm * 256 + ai * 128 + wr * 64 + m * 16 + fr;
                const u32x4 gw = *(const u32x4*)(gates + (size_t)t * 2048 + 1024 + f); f32x4 g0, g1; unpack8(gw, g0, g1);
                f32x4 v0 = acc[ai][0][m][0], v1 = acc[ai][0][m][1]; const f32x4 s0 = acc[ai][1][m][0], s1 = acc[ai][1][m][1];
#pragma unroll
                for (int j = 0; j < 4; ++j) { v0[j] = g0[j] * v0[j] * fast_sigmoid(s0[j]); v1[j] = g1[j] * v1[j] * fast_sigmoid(s1[j]); }
                *(u32x4*)(gb + (size_t)t * 1024 + f) = pack8(v0, v1); }
    }
};
struct EpiRnn {
    const bf16* gates; const bf16* gb; bf16* merged;
    __device__ __forceinline__ void operator()(const f32x4 (&acc)[2][2][4][2], const g8::Unit& u, int wr, int wc, int fr, int fq) const {
#pragma unroll
        for (int ai = 0; ai < 2; ++ai)
#pragma unroll
            for (int m = 0; m < 4; ++m) { const int t = u.pm * 256 + ai * 128 + wr * 64 + m * 16 + fr;
#pragma unroll
                for (int bj = 0; bj < 2; ++bj) { const int col = u.pn * 256 + bj * 128 + wc * 32 + 8 * fq;
                    const u32x4 gw = *(const u32x4*)(gates + (size_t)t * 2048 + col), bw = *(const u32x4*)(gb + (size_t)t * 1024 + col);
                    f32x4 g0, g1, b0, b1; unpack8(gw, g0, g1); unpack8(bw, b0, b1);
                    const f32x4 v0 = g0 * acc[ai][bj][m][0] + b0, v1 = g1 * acc[ai][bj][m][1] + b1;
                    u32x2 w8; w8.x = pk4_fp8(v0[0], v0[1], v0[2], v0[3]); w8.y = pk4_fp8(v1[0], v1[1], v1[2], v1[3]); *(u32x2*)((unsigned char*)merged + (size_t)t * 1024 + col) = w8; } }
    }
};
struct EpiOut {
    const float* x; const float* mod; bf16* v1;
    __device__ __forceinline__ void operator()(const f32x4 (&acc)[2][2][4][2], const g8::Unit& u, int wr, int wc, int fr, int fq) const {
        const int b = (u.pm * 256) >> 12;
#pragma unroll
        for (int bj = 0; bj < 2; ++bj) { const int col = u.pn * 256 + bj * 128 + wc * 32 + 8 * fq;
            const f32x4 ga = *(const f32x4*)(mod + b * 6144 + 2048 + col) + 1.0f, gb_ = *(const f32x4*)(mod + b * 6144 + 2048 + col + 4) + 1.0f;
#pragma unroll
            for (int ai = 0; ai < 2; ++ai)
#pragma unroll
                for (int m = 0; m < 4; ++m) { const int t = u.pm * 256 + ai * 128 + wr * 64 + m * 16 + fr;
                    const f32x4 x0 = *(const f32x4*)(x + (size_t)t * 1024 + col), x1 = *(const f32x4*)(x + (size_t)t * 1024 + col + 4);
                    const f32x4 v0 = x0 * DN_ALPHA + ga * acc[ai][bj][m][0], v1_ = x1 * DN_ALPHA + gb_ * acc[ai][bj][m][1];
                    *(u32x4*)(v1 + (size_t)t * 1024 + col) = pack8(v0, v1_); } }
    }
};
struct EpiMoe1 {
    const float* bgu; bf16* act;
    __device__ __forceinline__ void operator()(const f32x4 (&acc)[2][2][4][2], const g8::Unit& u, int wr, int wc, int fr, int fq) const {
        const int f = u.pn * 128 + wc * 32 + 8 * fq; const float* bp = bgu + (size_t)u.z * 2048 + f;
        const f32x4 bg0 = *(const f32x4*)bp, bg1 = *(const f32x4*)(bp + 4), bu0 = *(const f32x4*)(bp + 1024), bu1 = *(const f32x4*)(bp + 1028);
#pragma unroll
        for (int ai = 0; ai < 2; ++ai)
#pragma unroll
            for (int m = 0; m < 4; ++m) { const int row = u.pm * 256 + ai * 128 + wr * 64 + m * 16 + fr;
                f32x4 g0 = acc[ai][0][m][0] + bg0, g1 = acc[ai][0][m][1] + bg1, u0 = acc[ai][1][m][0] + bu0, u1 = acc[ai][1][m][1] + bu1;
#pragma unroll
                for (int j = 0; j < 4; ++j) { const float ga = fminf(g0[j], 7.0f), gb_ = fminf(g1[j], 7.0f), ua = fminf(fmaxf(u0[j], -7.0f), 7.0f), ub = fminf(fmaxf(u1[j], -7.0f), 7.0f);
                    g0[j] = ga * fast_sigmoid(1.702f * ga) * (ua + 1.0f); g1[j] = gb_ * fast_sigmoid(1.702f * gb_) * (ub + 1.0f); }
                u32x2 w8; w8.x = pk4_fp8(g0[0], g0[1], g0[2], g0[3]); w8.y = pk4_fp8(g1[0], g1[1], g1[2], g1[3]); *(u32x2*)((unsigned char*)act + (size_t)row * 1024 + f) = w8; }
    }
};
struct EpiMoe2 {
    const float* bd; bf16* yb;
    __device__ __forceinline__ void operator()(const f32x4 (&acc)[2][2][4][2], const g8::Unit& u, int wr, int wc, int fr, int fq) const {
#pragma unroll
        for (int bj = 0; bj < 2; ++bj) { const int col = u.pn * 256 + bj * 128 + wc * 32 + 8 * fq; const float* bp = bd + (size_t)u.z * 1024 + col;
            const f32x4 b0 = *(const f32x4*)bp, b1 = *(const f32x4*)(bp + 4);
#pragma unroll
            for (int ai = 0; ai < 2; ++ai)
#pragma unroll
                for (int m = 0; m < 4; ++m) { const int row = u.pm * 256 + ai * 128 + wr * 64 + m * 16 + fr;
                    *(u32x4*)(yb + (size_t)row * 1024 + col) = pack8(acc[ai][bj][m][0] + b0, acc[ai][bj][m][1] + b1); } }
    }
};

struct S5AOrder { int G, c; const char* acat; const char* ws;
    __device__ __forceinline__ bool next(int i, g8::Unit& u) const { const int L = i * G + c; if (L >= S5G * 4) return false; u.z = L >> 2; u.pm = L & 3; u.pn = 0; u.rl = 0;
        u.A = acat + ((size_t)(u.z * S5M + u.pm * 256) * S5ROW + 128) * 2; u.B = ws + (size_t)u.z * 256 * (S5L * 16) * 2; return true; } };
struct S5COrder { int G, c; const char* acat; const char* wy;
    __device__ __forceinline__ bool next(int i, g8::Unit& u) const { const int L = i * G + c; if (L >= S5G * 8) return false; u.z = L >> 3; u.pm = (L >> 1) & 3; u.pn = L & 1; u.rl = 0;
        u.A = acat + ((size_t)(u.z * S5M + u.pm * 256) * S5ROW) * 2; u.B = wy + ((size_t)(u.z * 512 + u.pn * 256) * S5ROW) * 2; return true; } };
struct MoeOrder { int G, c, NT, RT; const LAS int* tstart; const LAS int* cnt; const int* toklist; const char* A; const char* B; size_t bstride_e; int lda; bool gatherA;
    __device__ __forceinline__ bool next(int i, g8::Unit& u) const { const int per = G >> 3, xcd = c & 7, slot = c >> 3, rpx = per / NT;
        const int rt = (i * 8 + xcd) * rpx + slot / NT; if (rt >= RT) return false; u.pn = slot % NT;
        int e = 0;
#pragma unroll 1
        for (int k = 1; k < NE; ++k) if (tstart[k] <= rt) e = k;
        u.z = e; u.pm = rt; u.rl = rt - tstart[e]; u.B = B + (size_t)e * bstride_e + (size_t)u.pn * 256 * 1024; u.A = gatherA ? A : A + (size_t)rt * 256 * 1024; return true; }
    __device__ __forceinline__ void gather(const g8::Unit& u, const int (&Rr)[2], const int (&Cc)[2], unsigned (&vo)[2][2]) const {
        const int n = cnt[u.z];
#pragma unroll
        for (int h = 0; h < 2; ++h)
#pragma unroll
            for (int i = 0; i < 2; ++i) { const int r = u.rl * 256 + h * 128 + Rr[i]; const int tok = r < n ? toklist[u.z * T + r] : 0; vo[h][i] = (unsigned)(tok * lda + Cc[i] * 2); } }
};

__device__ __forceinline__ void transpose_item(const float* W, int N, int k0, int n0, bf16* dst, int ldd, int drow0, LAS float* scr, int lane) {
#pragma unroll 8
    for (int i = 0; i < 32; ++i) { const int kk = 2 * i + (lane >> 5); scr[kk * 33 + (lane & 31)] = W[(size_t)(k0 + kk) * N + n0 + (lane & 31)]; }
    asm volatile("s_waitcnt lgkmcnt(0)" ::: "memory");
    const int c = lane & 7;
#pragma unroll
    for (int j = 0; j < 4; ++j) { const int n = (lane >> 3) + 8 * j; const LAS float* s = scr + (8 * c) * 33 + n;
        u32x4 o; o.x = pk2(s[0 * 33], s[1 * 33]); o.y = pk2(s[2 * 33], s[3 * 33]); o.z = pk2(s[4 * 33], s[5 * 33]); o.w = pk2(s[6 * 33], s[7 * 33]);
        *(u32x4*)(dst + (size_t)(drow0 + n) * ldd + k0 + 8 * c) = o; }
    asm volatile("s_waitcnt lgkmcnt(0)" ::: "memory");
}
__device__ __forceinline__ void transpose_item8(const float* W, int N, int k0, int n0, unsigned char* dst, int ldd, int drow0, LAS float* scr, int lane) {
#pragma unroll 8
    for (int i = 0; i < 32; ++i) { const int kk = 2 * i + (lane >> 5); scr[kk * 33 + (lane & 31)] = W[(size_t)(k0 + kk) * N + n0 + (lane & 31)]; }
    asm volatile("s_waitcnt lgkmcnt(0)" ::: "memory");
    const int c = lane & 7;
#pragma unroll
    for (int j = 0; j < 4; ++j) { const int n = (lane >> 3) + 8 * j; const LAS float* s = scr + (8 * c) * 33 + n;
        u32x2 o; o.x = pk4_fp8(32.f * s[0 * 33], 32.f * s[1 * 33], 32.f * s[2 * 33], 32.f * s[3 * 33]); o.y = pk4_fp8(32.f * s[4 * 33], 32.f * s[5 * 33], 32.f * s[6 * 33], 32.f * s[7 * 33]);
        *(u32x2*)(dst + (size_t)(drow0 + n) * ldd + k0 + 8 * c) = o; }
    asm volatile("s_waitcnt lgkmcnt(0)" ::: "memory");
}
__device__ __forceinline__ int pair_row(int n) { const int f = n & 1023, hi = n >> 10; return (f >> 7) * 256 + hi * 128 + (f & 127); }

__device__ __forceinline__ void moe_tables(Frame& F) {
    LAS int* tstart = (LAS int*)(F.lds + TAB_OFF); LAS int* cl = tstart + 40;
    if (F.tid == 0) { int acc = 0; for (int e = 0; e < NE; ++e) { const int c = (int)F.ctl[CW_CNT + 64 * e]; cl[e] = c; tstart[e] = acc; acc += (c + 255) >> 8; } tstart[NE] = acc; }
    __syncthreads();
}

__device__ __forceinline__ void p0_mod_job(Frame& F, int job) {
    LAS float* sc = (LAS float*)F.lds;
    LAS float* red = sc + 8 * 1024;
    const float* c = F.in[1]; const float* w = F.in[2]; const float* bias = F.in[3];
    for (int i = F.tid; i < 8 * 1024; i += 512) { const float v = c[i]; sc[i] = v * fast_sigmoid(v); }
    __syncthreads();
    const int col = F.tid & 31, kg = F.tid >> 5, j = job * 32 + col;
    float a[8];
#pragma unroll
    for (int b = 0; b < 8; ++b) a[b] = 0.f;
#pragma unroll 8
    for (int k = kg * 64; k < kg * 64 + 64; ++k) { const float wv = w[(size_t)k * 6144 + j];
#pragma unroll
        for (int b = 0; b < 8; ++b) a[b] += sc[b * 1024 + k] * wv; }
#pragma unroll
    for (int b = 0; b < 8; ++b) red[(kg * 8 + b) * 32 + col] = a[b];
    __syncthreads();
    if (F.tid < 256) { const int b = F.tid >> 5, cc = F.tid & 31; float s = 0.f;
#pragma unroll
        for (int g = 0; g < 16; ++g) s += red[(g * 8 + b) * 32 + cc];
        WSP(float, WS_MOD)[b * 6144 + job * 32 + cc] = s + bias[job * 32 + cc]; }
    __syncthreads();
}
__device__ __forceinline__ void s5_setup(Frame& F, int g, int kmin, int kmax, LAS f32x2* Bb, LAS f32x2* Cc, LAS f32x2* Ap) {
    const float* lre = F.in[14] + g * 64; const float* lim = F.in[15] + g * 64; const float dt = expf(F.in[16][g]);
    const float* bre = F.in[17] + g * 1024; const float* bim = F.in[18] + g * 1024; const float* cre = F.in[19] + g * 1024; const float* cim = F.in[20] + g * 1024;
    for (int i = F.tid; i < 1024; i += 512) { const int p = i >> 4; const float lr = lre[p], li = lim[p]; const float mag = expf(lr * dt); float sn, cs; sincosf(li * dt, &sn, &cs);
        const float ar = mag * cs, ai = mag * sn, den = lr * lr + li * li, qr = ((ar - 1.f) * lr + ai * li) / den, qi = (ai * lr - (ar - 1.f) * li) / den;
        const float br = bre[i], bi = bim[i]; Bb[i] = (f32x2){qr * br - qi * bi, qr * bi + qi * br};
        Cc[i] = (f32x2){cre[i], cim[i]}; }
    for (int i = kmin * 64 + F.tid; i < (kmax + 1) * 64; i += 512) { const int k = i >> 6, p = i & 63; const float lr = lre[p], li = lim[p]; const float mag = expf((float)k * lr * dt); float sn, cs; sincosf((float)k * li * dt, &sn, &cs);
        Ap[i] = (f32x2){mag * cs, mag * sn}; }
    __syncthreads();
}
constexpr size_t WS_KTAB = WS_S;
__device__ __forceinline__ void p0_s5k_job(Frame& F, int job) {
    const int g = job >> 3, part = job & 7;
    LAS f32x2* Bb = (LAS f32x2*)F.lds; LAS f32x2* Cc = Bb + 1024; LAS f32x2* Ap = Cc + 1024;
    s5_setup(F, g, 4 * part, 4 * part + 3, Bb, Cc, Ap);
    float* kt = WSP(float, WS_KTAB) + (size_t)g * 32 * 256;
    for (int e = 4 * part * 256 + F.tid; e < (4 * part + 4) * 256; e += 512) { const int k = e >> 8, c = (e >> 4) & 15, c2 = e & 15; float s = 0.f;
        for (int p = 0; p < 64; ++p) { const f32x2 cv = Cc[c * 64 + p], av = Ap[k * 64 + p], bv = Bb[p * 16 + c2];
            const float car = cv.x * av.x - cv.y * av.y, cai = cv.x * av.y + cv.y * av.x; s += car * bv.x - cai * bv.y; }
        kt[e] = s; }
    __syncthreads();
}
__device__ __forceinline__ void p1_s5w_job(Frame& F, int job) {
    const int g = job >> 3, part = job & 7;
    LAS f32x2* Bb = (LAS f32x2*)F.lds; LAS f32x2* Cc = Bb + 1024; LAS f32x2* Ap = Cc + 1024; LAS float* Kt = (LAS float*)(Ap + 33 * 64);
    const float* ktg = WSP(float, WS_KTAB) + (size_t)g * 32 * 256; const float* dsk = F.in[21] + g * 16;
    for (int i = F.tid; i < 32 * 256; i += 512) Kt[i] = ktg[i];
    s5_setup(F, g, 0, S5L, Bb, Cc, Ap);
    if (part == 0 && F.tid < 64) WSP(f32x2, WS_AL)[g * 64 + F.tid] = Ap[S5L * 64 + F.tid];
    bf16* wy = WSP(bf16, WS_WY) + (size_t)g * 512 * S5ROW;
    for (int ch = F.tid; ch < 64 * (S5ROW / 8); ch += 512) { const int n = part * 64 + ch / (S5ROW / 8), k8 = (ch % (S5ROW / 8)) * 8, i = n >> 4, c = n & 15; float v[8];
        if (k8 < 128) {
#pragma unroll
            for (int j = 0; j < 8; j += 2) { const int p = (k8 + j) >> 1; const f32x2 cv = Cc[c * 64 + p], av = Ap[(i + 1) * 64 + p]; v[j] = cv.x * av.x - cv.y * av.y; v[j + 1] = -(cv.x * av.y + cv.y * av.x); } }
        else { const int jj = (k8 - 128) >> 4, c2 = (k8 - 128) & 15;
#pragma unroll
            for (int j = 0; j < 8; ++j) { float x = 0.f; if (jj <= i) { x = Kt[(i - jj) * 256 + c * 16 + c2 + j]; if (jj == i && c == c2 + j) x += dsk[c]; } v[j] = x; } }
        u32x4 o; o.x = pk2(v[0], v[1]); o.y = pk2(v[2], v[3]); o.z = pk2(v[4], v[5]); o.w = pk2(v[6], v[7]);
        *(u32x4*)(wy + (size_t)n * S5ROW + k8) = o; }
    bf16* wsm = WSP(bf16, WS_WS) + (size_t)g * 256 * 512;
    for (int ch = F.tid; ch < 32 * 64; ch += 512) { const int n = part * 32 + (ch >> 6), k8 = (ch & 63) * 8, jj = k8 >> 4, c2 = k8 & 15; float v[8];
#pragma unroll
        for (int j = 0; j < 8; ++j) { float x = 0.f; if (n < 128) { const int p = n >> 1; const f32x2 av = Ap[(S5L - 1 - jj) * 64 + p], bv = Bb[p * 16 + c2 + j]; x = (n & 1) ? (av.x * bv.y + av.y * bv.x) : (av.x * bv.x - av.y * bv.y); } v[j] = x; }
        u32x4 o; o.x = pk2(v[0], v[1]); o.y = pk2(v[2], v[3]); o.z = pk2(v[4], v[5]); o.w = pk2(v[6], v[7]);
        *(u32x4*)(wsm + (size_t)n * 512 + k8) = o; }
    __syncthreads();
}
__device__ __forceinline__ void p0_small_transposes(Frame& F) {
    LAS float* scr = (LAS float*)(F.lds + F.wave * 16384);
    const int gw = F.vcu * 8 + F.wave, NGW = F.G * 8;
    constexpr int I_IN = 16 * 144, I_RNN = 16 * 32, I_OUT = 16 * 32, I_GLU = 8 * 64, I_RG = 16 * 8;
    for (int it = gw; it < I_IN + I_RNN + I_OUT + I_GLU + I_RG; it += NGW) { int r = it;
        if (r < I_IN) { const int kb = r / 144, nb = r % 144; transpose_item8(F.in[4], INC, kb * 64, nb * 32, WSP(unsigned char, WS_WIN), 1024, nb * 32, scr, F.lane); continue; } r -= I_IN;
        if (r < I_RNN) { const int kb = r / 32, nb = r % 32; transpose_item8(F.in[13], 1024, kb * 64, nb * 32, WSP(unsigned char, WS_WRNN), 1024, nb * 32, scr, F.lane); continue; } r -= I_RNN;
        if (r < I_OUT) { const int kb = r / 32, nb = r % 32; transpose_item8(F.in[23], 1024, kb * 64, nb * 32, WSP(unsigned char, WS_WOUT), 1024, nb * 32, scr, F.lane); continue; } r -= I_OUT;
        if (r < I_GLU) { const int kb = r / 64, nb = r % 64; transpose_item8(F.in[22], 2048, kb * 64, nb * 32, WSP(unsigned char, WS_WGLU), 512, pair_row(nb * 32), scr, F.lane); continue; } r -= I_GLU;
        { const int mat = r >> 3, kb = (r >> 2) & 1, nb = r & 3, hd = mat & 7, gx = mat >> 3;
          transpose_item(F.in[gx ? 10 : 8] + (size_t)hd * 128 * 128, 128, kb * 64, nb * 32, WSP(bf16, WS_WG), 128, hd * 256 + gx * 128 + nb * 32, scr, F.lane); }
    }
}
__device__ __forceinline__ void p1_body(Frame& F) {
    const int gw = F.vcu * 8 + F.wave, NGW = F.G * 8; const float* mod = WSP(float, WS_MOD); bf16* hbf = WSP(bf16, WS_HBF);
    for (int t = gw; t < T; t += NGW) { const int b = t >> 12; const f32x4* xr = (const f32x4*)(F.in[0] + (size_t)t * 1024) + F.lane; const f32x4* sh = (const f32x4*)(mod + b * 6144) + F.lane; const f32x4* sc = (const f32x4*)(mod + b * 6144 + 1024) + F.lane;
        unsigned* o = (unsigned*)((unsigned char*)hbf + (size_t)t * 1024) + F.lane;
#pragma unroll
        for (int j = 0; j < 4; ++j) { const f32x4 v = xr[64 * j] * (sc[64 * j] + 1.0f) + sh[64 * j]; o[64 * j] = pk4_fp8(v[0], v[1], v[2], v[3]); } }
    LAS float* scr = (LAS float*)(F.lds + F.wave * 16384);
    constexpr int I_GU = 16 * 64, I_D = 16 * 32;
    for (int it = gw; it < NE * (I_GU + I_D); it += NGW) { const int e = it / (I_GU + I_D); int r = it % (I_GU + I_D);
        if (r < I_GU) { const int kb = r / 64, nb = r % 64; transpose_item8(F.in[28] + (size_t)e * 1024 * 2048, 2048, kb * 64, nb * 32, WSP(unsigned char, WS_WGU) + (size_t)e * 2048 * 1024, 1024, pair_row(nb * 32), scr, F.lane); }
        else { r -= I_GU; const int kb = r / 32, nb = r % 32; transpose_item8(F.in[30] + (size_t)e * 1024 * 1024, 1024, kb * 64, nb * 32, WSP(unsigned char, WS_WD) + (size_t)e * 1024 * 1024, 1024, nb * 32, scr, F.lane); } }
}
constexpr int XR_LD = 136, XR_TILE = 128 * XR_LD;
__device__ __forceinline__ void rg_issue(const bf16* xrnn, const bf16* gy, int item, int tid, u32x4 (&xraw)[4][4], u32x4 (&graw)[4], bool pass1) {
    const int hd = item & 7, c = (item >> 3) & 31, b = item >> 8, r0 = tid >> 4, ch = hd * 128 + (tid & 15) * 8;
#pragma unroll
    for (int q = 0; q < 4; ++q) { const int r = r0 + 32 * q;
#pragma unroll
        for (int k = 0; k < 4; ++k) { const int tp = c * RGL + r - 3 + k, tpc = tp < 0 ? 0 : tp; xraw[q][k] = *(const u32x4*)(xrnn + (size_t)(b * SEQ + tpc) * 1024 + ch); }
        if (pass1) graw[q] = *(const u32x4*)(gy + (size_t)(b * SEQ + c * RGL + r) * 1024 + ch); }
}
__device__ __forceinline__ void rg_convwrite(const float* cw, const float* cb, int item, int tid, const u32x4 (&xraw)[4][4], const u32x4 (&graw)[4], LAS bf16* xr, LAS bf16* gyt, bool pass1) {
    const int hd = item & 7, c = (item >> 3) & 31, r0 = tid >> 4, c8 = (tid & 15) * 8, ch = hd * 128 + c8;
    const f32x4 b0 = *(const f32x4*)(cb + ch), b1 = *(const f32x4*)(cb + ch + 4);
    f32x4 w0[4], w1[4];
#pragma unroll
    for (int k = 0; k < 4; ++k) { w0[k] = *(const f32x4*)(cw + k * 1024 + ch); w1[k] = *(const f32x4*)(cw + k * 1024 + ch + 4); }
#pragma unroll
    for (int q = 0; q < 4; ++q) { const int r = r0 + 32 * q; f32x4 a0 = b0, a1 = b1;
#pragma unroll
        for (int k = 0; k < 4; ++k) { const int tp = c * RGL + r - 3 + k; f32x4 x0, x1; unpack8(xraw[q][k], x0, x1); if (tp < 0) { x0 = (f32x4){0.f, 0.f, 0.f, 0.f}; x1 = x0; } a0 += w0[k] * x0; a1 += w1[k] * x1; }
        *(LAS u32x4*)(xr + r * XR_LD + c8) = pack8(a0, a1);
        if (pass1) *(LAS u32x4*)(gyt + r * XR_LD + c8) = graw[q]; }
}
template <int PASS>
__device__ __forceinline__ void rglru_phase(Frame& F) {
    const int NIT = NB * RGC * 8;
    int it = F.vcu; if (it >= NIT) return;
    LAS bf16* xr = (LAS bf16*)F.lds; LAS bf16* gyt0 = xr + XR_TILE;
    const bf16* xrnn = WSP(bf16, WS_XRNN); const bf16* gy = WSP(bf16, WS_GY); bf16* ha = WSP(bf16, WS_HA); const float* cw = F.in[6]; const float* cb = F.in[7];
    const int tid = F.tid, w = F.wave, q = F.lane >> 4, col = F.lane & 15, chl = 16 * w + col;
    u32x4 xraw[4][4], graw[4];
    rg_issue(xrnn, gy, it, tid, xraw, graw, PASS);
    rg_convwrite(cw, cb, it, tid, xraw, graw, xr, gyt0, PASS);
    int hd_loaded = -1; bf16x8 Bf[2][4]; float ba = 0.f, bx = 0.f, sp = 0.f;
    __syncthreads();
    for (int i = 0; it < NIT; ++i) {
        const int nit = it + F.G; const bool has_next = nit < NIT;
        const int hd = it & 7, c = (it >> 3) & 31, b = it >> 8, t0 = b * SEQ + c * RGL, ch = hd * 128 + chl;
        LAS bf16* gyt = gyt0 + (i & 1) * XR_TILE; LAS bf16* gytn = gyt0 + ((i & 1) ^ 1) * XR_TILE;
        if (has_next) rg_issue(xrnn, gy, nit, tid, xraw, graw, PASS);
        if (hd != hd_loaded) { hd_loaded = hd; const bf16* wg = WSP(bf16, WS_WG) + (size_t)hd * 256 * 128;
#pragma unroll
            for (int gt = 0; gt < 2; ++gt)
#pragma unroll
                for (int kk = 0; kk < 4; ++kk) Bf[gt][kk] = *(const bf16x8*)(wg + (size_t)(gt * 128 + chl) * 128 + kk * 32 + q * 8);
            ba = F.in[9][ch]; bx = F.in[11][ch]; const float lam = F.in[12][ch]; sp = (lam > 15.f) ? __expf(-lam) : log1pf(__expf(-lam)); }
        float carryH = 0.f, carryP = 1.f;
        if (PASS) carryH = WSP(float, WS_HIN)[(size_t)(b * RGC + c) * 1024 + ch];
        __builtin_amdgcn_sched_barrier(0);
        f32x4 acc[8][2];
#pragma unroll
        for (int m = 0; m < 8; ++m) { acc[m][0] = (f32x4){0.f, 0.f, 0.f, 0.f}; acc[m][1] = (f32x4){0.f, 0.f, 0.f, 0.f}; }
#pragma unroll
        for (int kk = 0; kk < 4; ++kk)
#pragma unroll
            for (int m = 0; m < 8; ++m) { const bf16x8 Af = *(const LAS bf16x8*)(xr + (16 * m + col) * XR_LD + kk * 32 + q * 8);
                acc[m][0] = __builtin_amdgcn_mfma_f32_16x16x32_bf16(Af, Bf[0][kk], acc[m][0], 0, 0, 0);
                acc[m][1] = __builtin_amdgcn_mfma_f32_16x16x32_bf16(Af, Bf[1][kk], acc[m][1], 0, 0, 0); }
#pragma unroll
        for (int m = 0; m < 8; ++m) {
            float a[4], uu[4];
#pragma unroll
            for (int j = 0; j < 4; ++j) { const int tl = 16 * m + 4 * q + j;
                const float r = fast_sigmoid(acc[m][0][j] + ba), ii = fast_sigmoid(acc[m][1][j] + bx);
                const float la = -11.541560327f * r * sp; a[j] = __builtin_amdgcn_exp2f(la); const float mult = __builtin_amdgcn_sqrtf(fmaxf(1.0f - a[j] * a[j], 0.f));
                uu[j] = mult * ii * bf1(xr[tl * XR_LD + chl]); }
            float sP = a[0], sH = uu[0];
#pragma unroll
            for (int j = 1; j < 4; ++j) { sH = a[j] * sH + uu[j]; sP *= a[j]; }
            float iP = sP, iH = sH;
            { const float pP = __shfl_up(iP, 16), pH = __shfl_up(iH, 16); if (q >= 1) { iH = iP * pH + iH; iP = iP * pP; } }
            { const float pP = __shfl_up(iP, 32), pH = __shfl_up(iH, 32); if (q >= 2) { iH = iP * pH + iH; iP = iP * pP; } }
            float eP = __shfl_up(iP, 16), eH = __shfl_up(iH, 16); if (q == 0) { eP = 1.f; eH = 0.f; }
            const float tP = __shfl(iP, col + 48), tH = __shfl(iH, col + 48);
            if (PASS) { float h = eP * carryH + eH;
#pragma unroll
                for (int j = 0; j < 4; ++j) { const int tl = 16 * m + 4 * q + j; h = a[j] * h + uu[j]; LAS bf16* gp = gyt + tl * XR_LD + chl; *gp = (bf16)f2bf(h * bf1(*gp)); } }
            carryH = tP * carryH + tH; carryP *= tP;
        }
        if (!PASS && q == 0) { f32x2* ag = WSP(f32x2, WS_RGAGG); ag[(size_t)(b * RGC + c) * 1024 + ch] = (f32x2){carryP, carryH}; }
        __syncthreads();
        if (PASS) { const int r0 = tid >> 4, c8 = (tid & 15) * 8;
#pragma unroll
            for (int qq = 0; qq < 4; ++qq) { const int r = r0 + 32 * qq; f32x4 h0, h1; unpack8(*(const LAS u32x4*)(gyt + r * XR_LD + c8), h0, h1); u32x2 w8; w8.x = pk4_fp8(h0[0], h0[1], h0[2], h0[3]); w8.y = pk4_fp8(h1[0], h1[1], h1[2], h1[3]);
                *(u32x2*)((unsigned char*)ha + (size_t)(t0 + r) * 1024 + hd * 128 + c8) = w8; } }
        if (has_next) rg_convwrite(cw, cb, nit, tid, xraw, graw, xr, gytn, PASS);
        __syncthreads();
        it = nit;
    }
}
__device__ __forceinline__ void p4_carries(Frame& F) {
    LAS f32x2* seg = (LAS f32x2*)F.lds;
    for (int job = F.vcu; job < NB * S5G; job += F.G) {
        const int b = job >> 5, g = job & 31, p = F.lane, w = F.wave;
        const f32x2 al = WSP(f32x2, WS_AL)[g * 64 + p];
        const f32x2* Sb = WSP(f32x2, WS_S) + ((size_t)(g * S5M + b * S5CPB + 16 * w)) * 64 + p; unsigned* ac = (unsigned*)(WSP(bf16, WS_ACAT) + ((size_t)(g * S5M + b * S5CPB + 16 * w)) * S5ROW) + p;
        f32x2 sv[16];
#pragma unroll
        for (int i = 0; i < 16; ++i) sv[i] = Sb[(size_t)i * 64];
        float xr_ = 0.f, xi = 0.f;
#pragma unroll
        for (int i = 0; i < 16; ++i) { const float nr = al.x * xr_ - al.y * xi + sv[i].x, ni = al.x * xi + al.y * xr_ + sv[i].y; xr_ = nr; xi = ni; }
        seg[w * 64 + p] = (f32x2){xr_, xi};
        float ar = al.x, ai = al.y;
#pragma unroll
        for (int q = 0; q < 4; ++q) { const float nr = ar * ar - ai * ai, ni = 2.f * ar * ai; ar = nr; ai = ni; }
        __syncthreads();
        xr_ = 0.f; xi = 0.f;
        for (int ww = 0; ww < w; ++ww) { const f32x2 sg = seg[ww * 64 + p]; const float nr = ar * xr_ - ai * xi + sg.x, ni = ar * xi + ai * xr_ + sg.y; xr_ = nr; xi = ni; }
#pragma unroll
        for (int i = 0; i < 16; ++i) { ac[(size_t)i * (S5ROW / 2)] = pk2(xr_, xi); const float nr = al.x * xr_ - al.y * xi + sv[i].x, ni = al.x * xi + al.y * xr_ + sv[i].y; xr_ = nr; xi = ni; }
        __syncthreads();
    }
    if (F.vcu < 16) {
        const int id = F.vcu * 512 + F.tid, ch = id & 1023, b = id >> 10; const f32x2* ag = WSP(f32x2, WS_RGAGG) + (size_t)b * RGC * 1024 + ch; float* hin = WSP(float, WS_HIN) + (size_t)b * RGC * 1024 + ch;
        f32x2 a[RGC];
#pragma unroll
        for (int c = 0; c < RGC; ++c) a[c] = ag[(size_t)c * 1024];
        float h = 0.f;
#pragma unroll
        for (int c = 0; c < RGC; ++c) { hin[(size_t)c * 1024] = h; h = a[c].x * h + a[c].y; }
    }
}
constexpr int WR_LD = 1028;
__device__ __forceinline__ void p9_router(Frame& F) {
    LAS float* wrt = (LAS float*)F.lds;
    LAS unsigned* rec = (LAS unsigned*)(F.lds + 32 * WR_LD * 4);
    LAS float* recp = (LAS float*)(rec + 512);
    LAS int* lcnt = (LAS int*)(recp + 512);
    LAS int* gbase = lcnt + 32;
    const float* wr = F.in[26];
    for (int i = F.tid; i < 1024 * 32; i += 512) wrt[(i & 31) * WR_LD + (i >> 5)] = wr[i];
    if (F.tid < 32) lcnt[F.tid] = 0;
    __syncthreads();
    const float* mod = WSP(float, WS_MOD); const bf16* v1 = WSP(bf16, WS_V1); bf16* x1 = WSP(bf16, WS_X1); bf16* h2 = WSP(bf16, WS_H2);
    const int lane = F.lane;
    f32x4 lg[4], lb[4];
#pragma unroll
    for (int j = 0; j < 4; ++j) { lg[j] = *((const f32x4*)F.in[24] + 64 * j + lane); lb[j] = *((const f32x4*)F.in[25] + 64 * j + lane); }
    const float brt = F.in[27][lane >> 1];
    for (int blk = F.vcu; blk < T / 128; blk += F.G) {
        for (int it = 0; it < 16; ++it) { const int ti = F.wave * 16 + it, t = blk * 128 + ti, b = t >> 12;
            f32x4 v[4]; float s = 0.f;
#pragma unroll
            for (int j = 0; j < 4; ++j) { const u32x2 w = *((const u32x2*)(v1 + (size_t)t * 1024) + 64 * j + lane); v[j] = (f32x4){bflo(w.x), bfhi(w.x), bflo(w.y), bfhi(w.y)}; s += (v[j][0] + v[j][1]) + (v[j][2] + v[j][3]); }
            const float mean = wave_sum(s) * (1.f / 1024.f); float s2 = 0.f;
#pragma unroll
            for (int j = 0; j < 4; ++j) { v[j] = v[j] - mean; s2 += (v[j][0] * v[j][0] + v[j][1] * v[j][1]) + (v[j][2] * v[j][2] + v[j][3] * v[j][3]); }
            const float rstd = 1.f / sqrtf(wave_sum(s2) * (1.f / 1024.f) + LN_EPS);
            f32x4 hh[4];
#pragma unroll
            for (int j = 0; j < 4; ++j) { const f32x4 xv = v[j] * rstd * lg[j] + lb[j]; u32x2 w; w.x = pk2(xv[0], xv[1]); w.y = pk2(xv[2], xv[3]); *((u32x2*)(x1 + (size_t)t * 1024) + 64 * j + lane) = w;
                const f32x4 sh = *((const f32x4*)(mod + b * 6144 + 3072) + 64 * j + lane), sc = *((const f32x4*)(mod + b * 6144 + 4096) + 64 * j + lane);
                hh[j] = xv * (sc + 1.0f) + sh; *((unsigned*)((unsigned char*)h2 + (size_t)t * 1024) + 64 * j + lane) = pk4_fp8(hh[j][0], hh[j][1], hh[j][2], hh[j][3]); }
            float lgt[32];
#pragma unroll
            for (int e = 0; e < 32; ++e) { float a = 0.f;
#pragma unroll
                for (int j = 0; j < 4; ++j) { const f32x4 wv = *((const LAS f32x4*)(wrt + e * WR_LD) + 64 * j + lane); a += (hh[j][0] * wv[0] + hh[j][1] * wv[1]) + (hh[j][2] * wv[2] + hh[j][3] * wv[3]); }
                lgt[e] = a; }
#pragma unroll
            for (int i = 0; i < 16; ++i) { const bool up = (lane & 32) != 0; const float send = up ? lgt[i] : lgt[i + 16], keep = up ? lgt[i + 16] : lgt[i]; lgt[i] = keep + __shfl_xor(send, 32); }
#pragma unroll
            for (int i = 0; i < 8; ++i) { const bool up = (lane & 16) != 0; const float send = up ? lgt[i] : lgt[i + 8], keep = up ? lgt[i + 8] : lgt[i]; lgt[i] = keep + __shfl_xor(send, 16); }
#pragma unroll
            for (int i = 0; i < 4; ++i) { const bool up = (lane & 8) != 0; const float send = up ? lgt[i] : lgt[i + 4], keep = up ? lgt[i + 4] : lgt[i]; lgt[i] = keep + __shfl_xor(send, 8); }
#pragma unroll
            for (int i = 0; i < 2; ++i) { const bool up = (lane & 4) != 0; const float send = up ? lgt[i] : lgt[i + 2], keep = up ? lgt[i + 2] : lgt[i]; lgt[i] = keep + __shfl_xor(send, 4); }
            { const bool up = (lane & 2) != 0; const float send = up ? lgt[0] : lgt[1], keep = up ? lgt[1] : lgt[0]; lgt[0] = keep + __shfl_xor(send, 2); }
            const float logit = lgt[0] + __shfl_xor(lgt[0], 1) + brt;
            int rank = 0; const int me = lane >> 1;
#pragma unroll
            for (int e = 0; e < 32; ++e) { const float o = __shfl(logit, 2 * e); rank += (o > logit || (o == logit && e < me)) ? 1 : 0; }
            float tv[4]; int te[4];
#pragma unroll
            for (int k = 0; k < 4; ++k) { const unsigned long long mk = __ballot(rank == k && (lane & 1) == 0); const int src = __builtin_ctzll(mk); te[k] = src >> 1; tv[k] = __shfl(logit, src); }
            float pe[4], ps = 0.f;
#pragma unroll
            for (int k = 0; k < 4; ++k) { pe[k] = __expf(tv[k] - tv[0]); ps += pe[k]; }
            if (lane < 4) { const int e = te[0] * (lane == 0) + te[1] * (lane == 1) + te[2] * (lane == 2) + te[3] * (lane == 3);
                const float p = (pe[0] * (lane == 0) + pe[1] * (lane == 1) + pe[2] * (lane == 2) + pe[3] * (lane == 3)) / ps;
                const int lr = __hip_atomic_fetch_add(lcnt + e, 1, __ATOMIC_RELAXED, __HIP_MEMORY_SCOPE_WORKGROUP); rec[ti * 4 + lane] = ((unsigned)e << 16) | (unsigned)lr; recp[ti * 4 + lane] = p; }
        }
        __syncthreads();
        if (F.tid < 32) { const int n = lcnt[F.tid]; gbase[F.tid] = n ? (int)atomicAdd(F.ctl + CW_CNT + 64 * F.tid, (unsigned)n) : 0; lcnt[F.tid] = 0; }
        __syncthreads();
        { const unsigned r = rec[F.tid]; const int e = r >> 16, rk = gbase[e] + (int)(r & 0xffffu), t = blk * 128 + (F.tid >> 2);
          WSP(int, WS_TOK)[(size_t)e * T + rk] = t; WSP(unsigned, WS_POS)[(size_t)t * 4 + (F.tid & 3)] = ((unsigned)e << 20) | (unsigned)rk; WSP(float, WS_PROB)[(size_t)t * 4 + (F.tid & 3)] = recp[F.tid]; }
        __syncthreads();
    }
}
__device__ __forceinline__ void p12_final(Frame& F) {
    moe_tables(F);
    const LAS int* tstart = (const LAS int*)(F.lds + TAB_OFF);
    const float* mod = WSP(float, WS_MOD); const bf16* x1 = WSP(bf16, WS_X1); const bf16* yb = WSP(bf16, WS_YB); const unsigned* pos = WSP(unsigned, WS_POS); const float* prob = WSP(float, WS_PROB);
    const int lane = F.lane, gw = F.vcu * 8 + F.wave, NGW = F.G * 8;
    f32x4 lg[4], lb[4];
#pragma unroll
    for (int j = 0; j < 4; ++j) { lg[j] = *((const f32x4*)F.in[32] + 64 * j + lane); lb[j] = *((const f32x4*)F.in[33] + 64 * j + lane); }
    for (int tb = gw; tb < T; tb += 2 * NGW) {
        unsigned pp[2][4]; float pw[2][4]; u32x2 yw[2][4][4], xw[2][4];
#pragma unroll
        for (int q = 0; q < 2; ++q) { const int t = tb + q * NGW; const u32x4 p4 = *(const u32x4*)(pos + (size_t)t * 4); const f32x4 w4 = *(const f32x4*)(prob + (size_t)t * 4);
            pp[q][0] = p4.x; pp[q][1] = p4.y; pp[q][2] = p4.z; pp[q][3] = p4.w; pw[q][0] = w4[0]; pw[q][1] = w4[1]; pw[q][2] = w4[2]; pw[q][3] = w4[3]; }
#pragma unroll
        for (int q = 0; q < 2; ++q) { const int t = tb + q * NGW;
#pragma unroll
            for (int k = 0; k < 4; ++k) { const int e = pp[q][k] >> 20, rk = pp[q][k] & 0xfffffu; const size_t slot = (size_t)tstart[e] * 256 + rk;
#pragma unroll
                for (int j = 0; j < 4; ++j) yw[q][k][j] = *((const u32x2*)(yb + slot * 1024) + 64 * j + lane); }
#pragma unroll
            for (int j = 0; j < 4; ++j) xw[q][j] = *((const u32x2*)(x1 + (size_t)t * 1024) + 64 * j + lane); }
#pragma unroll
        for (int q = 0; q < 2; ++q) { const int t = tb + q * NGW, b = t >> 12;
            f32x4 v[4]; float s = 0.f;
#pragma unroll
            for (int j = 0; j < 4; ++j) { f32x4 f = (f32x4){0.f, 0.f, 0.f, 0.f};
#pragma unroll
                for (int k = 0; k < 4; ++k) { const u32x2 w = yw[q][k][j]; f += (f32x4){bflo(w.x), bfhi(w.x), bflo(w.y), bfhi(w.y)} * pw[q][k]; }
                const u32x2 w = xw[q][j]; const f32x4 g2 = *((const f32x4*)(mod + b * 6144 + 5120) + 64 * j + lane) + 1.0f;
                v[j] = (f32x4){bflo(w.x), bfhi(w.x), bflo(w.y), bfhi(w.y)} * DN_ALPHA + g2 * f; s += (v[j][0] + v[j][1]) + (v[j][2] + v[j][3]); }
            const float mean = wave_sum(s) * (1.f / 1024.f); float s2 = 0.f;
#pragma unroll
            for (int j = 0; j < 4; ++j) { v[j] = v[j] - mean; s2 += (v[j][0] * v[j][0] + v[j][1] * v[j][1]) + (v[j][2] * v[j][2] + v[j][3] * v[j][3]); }
            const float rstd = 1.f / sqrtf(wave_sum(s2) * (1.f / 1024.f) + LN_EPS);
#pragma unroll
            for (int j = 0; j < 4; ++j) *((f32x4*)(F.out + (size_t)t * 1024) + 64 * j + lane) = v[j] * rstd * lg[j] + lb[j]; }
    }
}

struct Args { const float* in[34]; float* out; unsigned char* ws; int ph_lo, ph_hi; };
__global__ void __launch_bounds__(512, 2) fwd_kernel(Args args) {
    extern __shared__ __attribute__((aligned(16))) unsigned char lds_raw[];
    Frame F;
    F.lds = (LAS unsigned char*)lds_raw; F.MISC = (volatile LAS unsigned*)(F.lds + MISC_OFF);
    F.tid = threadIdx.x; F.lane = F.tid & 63; F.wave = __builtin_amdgcn_readfirstlane(F.tid >> 6);
    F.G = gridDim.x; { const int bx = blockIdx.x; F.vcu = (F.G % 8 == 0) ? (bx % 8) * (F.G / 8) + bx / 8 : bx; }
#pragma unroll
    for (int i = 0; i < 34; ++i) F.in[i] = args.in[i];
    F.out = args.out; F.ws = args.ws; F.ctl = (unsigned*)(args.ws + WS_CTL);
    if (F.tid < 64) F.MISC[F.tid] = 0u;
    __syncthreads();
    XcdBarrier bar; bar.bar = F.ctl + CW_BAR; bar.x = 0; bar.st = nullptr;
    if (MK_N_LAUNCHES == 1) bar = xcd_barrier_post(F.ctl + CW_BAR, F.MISC + 8);
    const int lo = args.ph_lo, hi = args.ph_hi;
#define IN(k) (lo <= (k) && (k) < hi)
#define SEAM(k) do { if (IN(k) && IN((k) + 1)) xcd_barrier(bar); } while (0)

    if (IN(0)) REPS(0) { if (rep_) xcd_barrier(bar);
        for (int j = F.vcu; j < 192; j += F.G) p0_mod_job(F, j);
        for (int j = F.vcu; j < S5G * 8; j += F.G) p0_s5k_job(F, j);
        p0_small_transposes(F);
    }
    SEAM(0);
    if (IN(1)) REPS(1) { if (rep_) xcd_barrier(bar); for (int j = F.vcu; j < S5G * 8; j += F.G) p1_s5w_job(F, j); p1_body(F); }
    SEAM(1);
    if (IN(2)) REPS(2) { if (rep_) xcd_barrier(bar);
        g8::GridOrder S; S.init(T, INC, F.G, (int)blockIdx.x, WSP(bf16, WS_HBF), WSP(bf16, WS_WIN), 1024, 1024);
        EpiInProj E{F.in[5], WSP(bf16, WS_XRNN), WSP(bf16, WS_GY), WSP(bf16, WS_ACAT), WSP(bf16, WS_GATES)};
        g8::gemm_phase<EpiInProj, g8::GridOrder, false, true>(F.lds, 1024, 1024, 1024, S, E);
    }
    SEAM(2);
    if (IN(3)) REPS(3) { if (rep_) xcd_barrier(bar);
        { S5AOrder S{F.G, F.vcu, (const char*)WSP(bf16, WS_ACAT), (const char*)WSP(bf16, WS_WS)}; EpiS5A E{WSP(float, WS_S)};
          g8::gemm_phase<EpiS5A, S5AOrder, false>(F.lds, S5L * 32, S5ROW * 2, S5L * 32, S, E); }
        __syncthreads();
        rglru_phase<0>(F);
    }
    SEAM(3);
    if (IN(4)) REPS(4) { if (rep_) xcd_barrier(bar); p4_carries(F); }
    SEAM(4);
    if (IN(5)) REPS(5) { if (rep_) xcd_barrier(bar);
        { S5COrder S{F.G, F.vcu, (const char*)WSP(bf16, WS_ACAT), (const char*)WSP(bf16, WS_WY)}; EpiS5C E{WSP(bf16, WS_YS)};
          g8::gemm_phase<EpiS5C, S5COrder, false>(F.lds, S5ROW * 2, S5ROW * 2, S5ROW * 2, S, E); }
        __syncthreads();
        rglru_phase<1>(F);
    }
    SEAM(5);
    if (IN(6)) REPS(6) { if (rep_) xcd_barrier(bar);
        g8::GridOrder S; S.init(T, 2048, F.G, (int)blockIdx.x, WSP(bf16, WS_YS), WSP(bf16, WS_WGLU), 512, 512);
        EpiGlu E{WSP(bf16, WS_GATES), WSP(bf16, WS_GB)};
        g8::gemm_phase<EpiGlu, g8::GridOrder, false, true>(F.lds, 512, 512, 512, S, E);
    }
    SEAM(6);
    if (IN(7)) REPS(7) { if (rep_) xcd_barrier(bar);
        g8::GridOrder S; S.init(T, 1024, F.G, (int)blockIdx.x, WSP(bf16, WS_HA), WSP(bf16, WS_WRNN), 1024, 1024);
        EpiRnn E{WSP(bf16, WS_GATES), WSP(bf16, WS_GB), WSP(bf16, WS_MERGED)};
        g8::gemm_phase<EpiRnn, g8::GridOrder, false, true>(F.lds, 1024, 1024, 1024, S, E);
    }
    SEAM(7);
    if (IN(8)) REPS(8) { if (rep_) xcd_barrier(bar);
        g8::GridOrder S; S.init(T, 1024, F.G, (int)blockIdx.x, WSP(bf16, WS_MERGED), WSP(bf16, WS_WOUT), 1024, 1024);
        EpiOut E{F.in[0], WSP(float, WS_MOD), WSP(bf16, WS_V1)};
        g8::gemm_phase<EpiOut, g8::GridOrder, false, true>(F.lds, 1024, 1024, 1024, S, E);
    }
    SEAM(8);
    if (IN(9)) REPS(9) { if (rep_) xcd_barrier(bar); p9_router(F); }
    SEAM(9);
    if (IN(10)) REPS(10) { if (rep_) xcd_barrier(bar);
        moe_tables(F);
        const LAS int* tstart = (const LAS int*)(F.lds + TAB_OFF);
        MoeOrder S{F.G, (int)blockIdx.x, 8, tstart[NE], tstart, tstart + 40, WSP(int, WS_TOK), (const char*)WSP(bf16, WS_H2), (const char*)WSP(bf16, WS_WGU), (size_t)2048 * 1024, 1024, true};
        EpiMoe1 E{F.in[29], WSP(bf16, WS_ACT)};
        g8::gemm_phase<EpiMoe1, MoeOrder, true, true>(F.lds, 1024, 1024, 1024, S, E);
    }
    SEAM(10);
    if (IN(11)) REPS(11) { if (rep_) xcd_barrier(bar);
        moe_tables(F);
        const LAS int* tstart = (const LAS int*)(F.lds + TAB_OFF);
        MoeOrder S{F.G, (int)blockIdx.x, 4, tstart[NE], tstart, tstart + 40, WSP(int, WS_TOK), (const char*)WSP(bf16, WS_ACT), (const char*)WSP(bf16, WS_WD), (size_t)1024 * 1024, 1024, false};
        EpiMoe2 E{F.in[31], WSP(bf16, WS_YB)};
        g8::gemm_phase<EpiMoe2, MoeOrder, false, true>(F.lds, 1024, 1024, 1024, S, E);
    }
    SEAM(11);
    if (IN(12)) REPS(12) { if (rep_) xcd_barrier(bar); p12_final(F); }
#undef IN
#undef SEAM
}

extern "C" void kernel_launch(void* const* d_in, const int* in_sizes, int n_in, void* d_out, int out_size, void* d_ws, size_t ws_size, hipStream_t stream) {
    static int grid = 0;
    if (grid == 0) {
        if (n_in != 34 || in_sizes[0] != T * D || out_size != T * D || ws_size < WS_END) { fprintf(stderr, "kernel_launch: unexpected shapes (n_in %d, ws %zu < %zu)\n", n_in, ws_size, (size_t)WS_END); grid = -1; return; }
        int dev = 0, cus = 0;
        if (hipGetDevice(&dev) != hipSuccess || hipDeviceGetAttribute(&cus, hipDeviceAttributeMultiprocessorCount, dev) != hipSuccess) { grid = -1; return; }
        if (hipFuncSetAttribute((const void*)fwd_kernel, hipFuncAttributeMaxDynamicSharedMemorySize, LDS_BYTES) != hipSuccess) { fprintf(stderr, "kernel_launch: hipFuncSetAttribute failed\n"); grid = -1; return; }
        int per_cu = 0; (void)hipOccupancyMaxActiveBlocksPerMultiprocessor(&per_cu, (const void*)fwd_kernel, 512, LDS_BYTES); (void)hipGetLastError();
        grid = cus;
    }
    if (grid < 0) return;
    (void)hipMemsetAsync((char*)d_ws + WS_CTL, 0, CTL_BYTES, stream);
    Args a{};
    for (int i = 0; i < 34; ++i) a.in[i] = (const float*)d_in[i];
    a.out = (float*)d_out; a.ws = (unsigned char*)d_ws;
    if (MK_N_LAUNCHES == 1) { a.ph_lo = 0; a.ph_hi = N_PHASES; hipLaunchKernelGGL(fwd_kernel, dim3(grid), dim3(512), LDS_BYTES, stream, a); }
    else for (int p = 0; p < N_PHASES; ++p) { a.ph_lo = p; a.ph_hi = p + 1; hipLaunchKernelGGL(fwd_kernel, dim3(grid), dim3(512), LDS_BYTES, stream, a); }
}
```

```cpp
#include <hip/hip_runtime.h>
#include <cstdio>
#include <cstdint>

#ifndef MK_N_LAUNCHES
#define MK_N_LAUNCHES 1
#endif
constexpr int N_PHASES = 13;
#ifndef DUP_PHASE
#define DUP_PHASE -1
#endif
#define REPS(k) for (int rep_ = 0; rep_ < ((DUP_PHASE == (k)) ? 2 : 1); ++rep_)

#define GAS __attribute__((address_space(1)))
#define LAS __attribute__((address_space(3)))
typedef unsigned short bf16;
typedef short bf16x8 __attribute__((ext_vector_type(8)));
typedef float f32x4 __attribute__((ext_vector_type(4)));
typedef float f32x2 __attribute__((ext_vector_type(2)));
typedef unsigned u32x4 __attribute__((ext_vector_type(4)));
typedef unsigned u32x2 __attribute__((ext_vector_type(2)));
typedef GAS unsigned gu32;

constexpr int NB = 8, SEQ = 4096, T = NB * SEQ, D = 1024, INC = 4608, NE = 32, DFF = 1024;
constexpr int S5L = 32, S5G = 32, S5ROW = 128 + S5L * 16  , S5M = T / S5L  , S5CPB = SEQ / S5L  ;
constexpr int RGL = 128, RGC = SEQ / RGL  ;
constexpr float LN_EPS = 1e-5f, DN_ALPHA = 1.189207115002721f;
constexpr int ACT_ROWS = T * 4 + NE * 256;

constexpr size_t MiB = 1u << 20;
constexpr size_t WS_XRNN = 0, WS_GY = 64 * MiB, WS_GATES = 128 * MiB, WS_V1 = 0, WS_ACT = 0;
constexpr size_t WS_HBF = 272 * MiB, WS_HA = 272 * MiB, WS_YS = 336 * MiB, WS_GB = 368 * MiB, WS_MERGED = 432 * MiB, WS_ACAT = 496 * MiB, WS_YB = 272 * MiB;
constexpr size_t WS_X1 = 544 * MiB, WS_H2 = 608 * MiB;
constexpr size_t WS_WGU = 672 * MiB, WS_WD = 800 * MiB, WS_WIN = 864 * MiB, WS_WG = 873 * MiB, WS_WRNN = 874 * MiB, WS_WGLU = 876 * MiB, WS_WOUT = 878 * MiB;
constexpr size_t WS_WS = 880 * MiB, WS_WY = 888 * MiB, WS_S = 908 * MiB;
constexpr size_t WS_MOD = 924 * MiB, WS_AL = 925 * MiB, WS_RGAGG = 926 * MiB, WS_HIN = 928 * MiB, WS_TOK = 929 * MiB, WS_POS = 933 * MiB, WS_PROB = 934 * MiB, WS_CTL = 935 * MiB;
constexpr size_t WS_END = 936 * MiB, CTL_BYTES = 1 * MiB;
static_assert((size_t)ACT_ROWS * DFF * 2 <= 272 * MiB, "act/yb size");
static_assert(WS_ACAT + (size_t)S5G * S5M * S5ROW * 2 <= WS_X1, "acat");
constexpr int CW_BAR = 4096, CW_CNT = 8192  ;

constexpr int LDS_BYTES = 147456, MISC_OFF = LDS_BYTES - 256, TAB_OFF = 131072 + 1024;

__device__ __forceinline__ unsigned f2bf(float f) { unsigned u = __builtin_bit_cast(unsigned, f); return (u + 0x7fffu + ((u >> 16) & 1u)) >> 16; }
typedef __bf16 bf16x2v __attribute__((ext_vector_type(2)));
__device__ __forceinline__ unsigned pk2(float lo, float hi) { const f32x2 v = {lo, hi}; const bf16x2v b = __builtin_convertvector(v, bf16x2v); return __builtin_bit_cast(unsigned, b); }
__device__ __forceinline__ unsigned pk4_fp8(float a, float b, float c, float d) { int w = 0; w = __builtin_amdgcn_cvt_pk_fp8_f32(a, b, w, false); w = __builtin_amdgcn_cvt_pk_fp8_f32(c, d, w, true); return (unsigned)w; }
__device__ __forceinline__ float bflo(unsigned w) { return __builtin_bit_cast(float, w << 16); }
__device__ __forceinline__ float bfhi(unsigned w) { return __builtin_bit_cast(float, w & 0xffff0000u); }
__device__ __forceinline__ float bf1(bf16 h) { return __builtin_bit_cast(float, ((unsigned)h) << 16); }
__device__ __forceinline__ float fast_sigmoid(float x) { return __builtin_amdgcn_rcpf(1.0f + __builtin_amdgcn_exp2f(-1.4426950409f * x)); }
__device__ __forceinline__ float gelu_tanh(float x) { const float u = x + 0.044715f * x * x * x; return x * __builtin_amdgcn_rcpf(1.0f + __builtin_amdgcn_exp2f(-2.3022082f * u)); }
__device__ __forceinline__ float wave_sum(float v) {
#pragma unroll
    for (int o = 1; o < 64; o <<= 1) v += __shfl_xor(v, o);
    return v;
}
__device__ __forceinline__ u32x4 pack8(f32x4 a, f32x4 b) { u32x4 w; w.x = pk2(a[0], a[1]); w.y = pk2(a[2], a[3]); w.z = pk2(b[0], b[1]); w.w = pk2(b[2], b[3]); return w; }
__device__ __forceinline__ void unpack8(u32x4 w, f32x4& a, f32x4& b) { a = (f32x4){bflo(w.x), bfhi(w.x), bflo(w.y), bfhi(w.y)}; b = (f32x4){bflo(w.z), bfhi(w.z), bflo(w.w), bfhi(w.w)}; }

#define XB_TMO      128
#define XB_XCNT(j)  (256  + 64 * (j))
#define XB_XSUB(j)  (1280 + 64 * (j))
#define XB_XGEN(j)  (2304 + 64 * (j))
#define XB_TOP      3328
#define XB_TOPGEN   3392
#define XCD_BAR_WORDS 3456
#define XB_SPIN_CAP (1u << 18)
__device__ __forceinline__ unsigned xb_ld(unsigned* p)              { return __hip_atomic_load(p, __ATOMIC_RELAXED, __HIP_MEMORY_SCOPE_AGENT); }
__device__ __forceinline__ unsigned xb_add(unsigned* p, unsigned v) { return __hip_atomic_fetch_add(p, v, __ATOMIC_RELAXED, __HIP_MEMORY_SCOPE_AGENT); }
__device__ __forceinline__ unsigned xb_xcc_id() { return (unsigned)__builtin_amdgcn_s_getreg((3 << 11) | 20) & 0xFu; }
#define XB_SPIN(cond, bar) do { unsigned _sp = 0; while (cond) { __builtin_amdgcn_s_sleep(1); \
    if ((++_sp & 255u) == 0u) { if (xb_ld(&(bar)[XB_TMO])) break; if (_sp > XB_SPIN_CAP) { atomicAdd(&(bar)[XB_TMO], 1u); break; } } } } while (0)
struct XcdBarrier { unsigned* bar; unsigned x; volatile LAS unsigned* st; };
__device__ __forceinline__ XcdBarrier xcd_barrier_post(unsigned* bar, volatile LAS unsigned* st) {
    XcdBarrier b; b.bar = bar; b.x = xb_xcc_id(); b.st = st;
    if (threadIdx.x == 0) (void)xb_add(&bar[XB_XCNT(b.x)], 1u);
    return b;
}
__device__ __forceinline__ void xcd_barrier_complete(unsigned* bar, unsigned x, unsigned& nloc, unsigned& nx) {
    const unsigned G = gridDim.x * gridDim.y * gridDim.z;
    unsigned sum, cnt, mine, sp = 0u;
    for (;;) {
        sum = 0u; cnt = 0u; mine = 0u;
#pragma unroll
        for (unsigned j = 0; j < 16; ++j) { const unsigned c = xb_ld(&bar[XB_XCNT(j)]); sum += c; cnt += (c > 0u) ? 1u : 0u; mine = (j == x) ? c : mine; }
        if (sum == G) break;
        __builtin_amdgcn_s_sleep(1);
        if ((++sp & 255u) == 0u) { if (xb_ld(&bar[XB_TMO])) break; if (sp > XB_SPIN_CAP) { atomicAdd(&bar[XB_TMO], 1u); break; } }
    }
    nloc = mine > 0u ? mine : 1u; nx = cnt > 0u ? cnt : 1u;
}
__device__ __forceinline__ void xcd_barrier(const XcdBarrier& b) {
    asm volatile("s_waitcnt vmcnt(0)" ::: "memory");
    __syncthreads();
    if (threadIdx.x == 0) {
        unsigned* bar = b.bar;
        __builtin_amdgcn_s_waitcnt(0);
        unsigned nloc = b.st[0], nx = b.st[1];
        if (nloc == 0u) { xcd_barrier_complete(bar, b.x, nloc, nx); b.st[0] = nloc; b.st[1] = nx; }
        const unsigned old = xb_add(&bar[XB_XSUB(b.x)], 1u);
        const unsigned gen = old / nloc;
        if (old + 1u == (gen + 1u) * nloc) {
            __builtin_amdgcn_fence(__ATOMIC_RELEASE, "agent");
            asm volatile("s_waitcnt vmcnt(0)" ::: "memory");
            const unsigned og = xb_add(&bar[XB_TOP], 1u);
            const unsigned tg = og / nx;
            if (og + 1u == (tg + 1u) * nx) xb_add(&bar[XB_TOPGEN], 1u);
            else XB_SPIN(xb_ld(&bar[XB_TOPGEN]) == tg, bar);
            __builtin_amdgcn_fence(__ATOMIC_ACQUIRE, "agent");
            xb_add(&bar[XB_XGEN(b.x)], 1u);
            asm volatile("s_waitcnt vmcnt(0)" ::: "memory");
        } else {
            XB_SPIN(xb_ld(&bar[XB_XGEN(b.x)]) == gen, bar);
            __builtin_amdgcn_fence(__ATOMIC_ACQUIRE, "agent");
            asm volatile("s_waitcnt vmcnt(0)" ::: "memory");
        }
    }
    __syncthreads();
}

namespace g8 {
constexpr int BM = 256, BK = 64, HALF = 128, HTB = HALF * BK * 2, STAGE_BYTES = 8 * HTB;
__device__ __forceinline__ int lds_byte(int r, int c) { const int st = (r >> 4) * 2 + (c >> 5), rr = r & 15, cc = c & 31, ob = rr * 64 + cc * 2; return st * 1024 + (ob ^ (((ob >> 9) & 1) << 5)); }
__device__ __forceinline__ void stage_rc(int b, int& R, int& C) { const int st = b / 1024, sb = b % 1024, swz = sb ^ (((sb >> 9) & 1) << 5); R = (st >> 1) * 16 + swz / 64; C = (st & 1) * 32 + (swz % 64) / 2; }
__device__ __forceinline__ int perm32(int rho) { const int n = rho >> 4, i = rho & 15; return 8 * (i >> 2) + 4 * n + (i & 3); }

struct Unit { int pm, pn, z, rl; const char* A; const char* B; };

typedef int v8i __attribute__((ext_vector_type(8)));
typedef int v4i __attribute__((ext_vector_type(4)));
typedef short s16x16 __attribute__((ext_vector_type(16)));
typedef s16x16 s16x16_a16 __attribute__((aligned(16)));
__device__ __forceinline__ v8i cat8(bf16x8 lo, bf16x8 hi) { const v4i a = __builtin_bit_cast(v4i, lo), b = __builtin_bit_cast(v4i, hi); return __builtin_shufflevector(a, b, 0, 1, 2, 3, 4, 5, 6, 7); }
template <class Epi, class Sched, bool GATHER, bool FP8 = false>
__device__ __forceinline__ void gemm_phase(LAS unsigned char* lds, const int Kb, const int ldaB, const int ldbB, const Sched& S, const Epi& E) {
    const int tid = threadIdx.x, wid = __builtin_amdgcn_readfirstlane(tid >> 6), lane = tid & 63, wr = wid >> 2, wc = wid & 3, fr = lane & 15, fq = lane >> 4;
    const int nt = Kb / 128;
    unsigned voffB[2], cvo[2][2], nvo[2][2]; int Rr[2], Cc[2];
#pragma unroll
    for (int i = 0; i < 2; ++i) { int R, C; stage_rc(tid * 16 + i * 8192, R, C); const int Rb = (R & ~31) + perm32(R & 31);
        voffB[i] = (unsigned)(Rb * ldbB + C * 2); Rr[i] = R; Cc[i] = C;
#pragma unroll
        for (int h = 0; h < 2; ++h) { cvo[h][i] = (unsigned)((h * HALF + R) * ldaB + C * 2); nvo[h][i] = cvo[h][i]; } }
    const size_t kstep = (size_t)(BK * 2);
    const size_t hstepB = (size_t)HALF * ldbB;
    const unsigned ldsw = (unsigned)wid * 1024u;
    const int aoff = FP8 ? lds_byte(wr * 64 + fr, (fq >> 1) * 32 + (fq & 1) * 24) : lds_byte(wr * 64 + fr, fq * 8), boff = FP8 ? lds_byte(wc * 32 + fr, (fq >> 1) * 32 + (fq & 1) * 24) : lds_byte(wc * 32 + fr, fq * 8);
    const int aoff2 = FP8 ? lds_byte(wr * 64 + fr, (fq >> 1) * 32 + 8 + (fq & 1) * 8) : 0, boff2 = FP8 ? lds_byte(wc * 32 + fr, (fq >> 1) * 32 + 8 + (fq & 1) * 8) : 0;
#define G8_SA(b, h) (((b) * 2 + (h)) * HTB)
#define G8_SB(b, h) ((4 + (b) * 2 + (h)) * HTB)
#define G8_STGB(bufoff, gbase) do { _Pragma("unroll") for (int _i = 0; _i < 2; ++_i) \
        __builtin_amdgcn_global_load_lds((const unsigned*)((const char*)(gbase) + voffB[_i]), (LAS unsigned*)(lds + (bufoff) + ldsw + _i * 8192), 16, 0, 0); } while (0)
#define G8_STGA(bufoff, gbase, VO, h) do { _Pragma("unroll") for (int _i = 0; _i < 2; ++_i) \
        __builtin_amdgcn_global_load_lds((const unsigned*)((const char*)(gbase) + VO[h][_i]), (LAS unsigned*)(lds + (bufoff) + ldsw + _i * 8192), 16, 0, 0); } while (0)
#define G8_LDA(dst, b, h) do { _Pragma("unroll") for (int m = 0; m < 4; ++m) { if constexpr (FP8) { dst##8[m] = cat8(*(const LAS bf16x8*)(lds + G8_SA(b, h) + aoff + m * 2048), *(const LAS bf16x8*)(lds + G8_SA(b, h) + aoff2 + m * 2048)); } \
        else { _Pragma("unroll") for (int k = 0; k < 2; ++k) dst[m][k] = *(const LAS bf16x8*)(lds + G8_SA(b, h) + aoff + m * 2048 + k * 1024); } } } while (0)
#define G8_LDB(dst, b, h) do { _Pragma("unroll") for (int n = 0; n < 2; ++n) { if constexpr (FP8) { dst##8[n] = cat8(*(const LAS bf16x8*)(lds + G8_SB(b, h) + boff + n * 2048), *(const LAS bf16x8*)(lds + G8_SB(b, h) + boff2 + n * 2048)); } \
        else { _Pragma("unroll") for (int k = 0; k < 2; ++k) dst[n][k] = *(const LAS bf16x8*)(lds + G8_SB(b, h) + boff + n * 2048 + k * 1024); } } } while (0)
#define G8_MMA(ai, bj, At, Bt) do { __builtin_amdgcn_s_setprio(1); _Pragma("unroll") for (int m = 0; m < 4; ++m) _Pragma("unroll") for (int n = 0; n < 2; ++n) { \
        if constexpr (FP8) asm volatile("s_nop 1\n\tv_mfma_scale_f32_16x16x128_f8f6f4 %0, %1, %2, %0, %3, %4 op_sel_hi:[0,0,0]" : "+v"(acc[ai][bj][m][n]) : "v"(Bt##8[n]), "v"(At##8[m]), "v"(sc_w), "v"(sc_a)); \
        else { _Pragma("unroll") for (int k = 0; k < 2; ++k) acc[ai][bj][m][n] = __builtin_amdgcn_mfma_f32_16x16x32_bf16(Bt[n][k], At[m][k], acc[ai][bj][m][n], 0, 0, 0); } } __builtin_amdgcn_s_setprio(0); } while (0)
#define G8_WAIT_V(n) asm volatile("s_waitcnt vmcnt(" #n ")" ::: "memory")
#define G8_WAIT_L(n) asm volatile("s_waitcnt lgkmcnt(" #n ")" ::: "memory")
#define G8_BAR __builtin_amdgcn_s_barrier()
#define G8_SCHED __builtin_amdgcn_sched_barrier(0)
    Unit cur, nxt; int ui = 0;
    if (!S.next(0, cur)) return;
    bool has_next = S.next(1, nxt);
    if constexpr (GATHER) { S.gather(cur, Rr, Cc, cvo); if (has_next) S.gather(nxt, Rr, Cc, nvo); else {
#pragma unroll
        for (int h = 0; h < 2; ++h)
#pragma unroll
            for (int i = 0; i < 2; ++i) nvo[h][i] = cvo[h][i]; } }
    f32x4 acc[2][2][4][2];
#pragma unroll
    for (int a = 0; a < 2; ++a)
#pragma unroll
        for (int b = 0; b < 2; ++b)
#pragma unroll
            for (int m = 0; m < 4; ++m)
#pragma unroll
                for (int n = 0; n < 2; ++n) acc[a][b][m][n] = (f32x4){0.f, 0.f, 0.f, 0.f};
    const int sc_w = 0x7a7a7a7a, sc_a = 0x7f7f7f7f;
    bf16x8 At[4][2], B0[2][2], B1[2][2]; v8i At8[4], B08[2], B18[2];
    const char* cA = cur.A; const char* cB = cur.B;
    G8_STGB(G8_SB(0, 0), cB); G8_STGB(G8_SB(0, 1), cB + hstepB); G8_STGA(G8_SA(0, 0), cA, cvo, 0); G8_STGA(G8_SA(0, 1), cA, cvo, 1);
    if (wr == 1) G8_BAR;
    G8_WAIT_V(2); G8_BAR;
    G8_STGB(G8_SB(1, 0), cB + kstep); G8_STGA(G8_SA(1, 0), cA + kstep, cvo, 0); G8_STGB(G8_SB(1, 1), cB + hstepB + kstep);
    G8_WAIT_V(6); G8_BAR;
    for (;;) {
        const char* nA = has_next ? nxt.A : cA; const char* nB = has_next ? nxt.B : cB;
        for (int t = 0; t < nt; t += 2) {
            const bool last = (t == nt - 2);
            const char* a1 = cA + (size_t)(t + 1) * kstep;
            const char* a2 = last ? nA : cA + (size_t)(t + 2) * kstep; const char* b2 = last ? nB : cB + (size_t)(t + 2) * kstep;
            const char* a3 = a2 + kstep; const char* b3 = b2 + kstep;
            unsigned vo2[2][2];
#pragma unroll
            for (int h = 0; h < 2; ++h)
#pragma unroll
                for (int i = 0; i < 2; ++i) vo2[h][i] = (GATHER && last) ? nvo[h][i] : cvo[h][i];
            G8_LDB(B0, 0, 0); G8_LDB(B1, 0, 1); G8_SCHED; G8_LDA(At, 0, 0); G8_STGA(G8_SA(1, 1), a1, cvo, 1);
            G8_WAIT_V(8); G8_WAIT_L(0); G8_BAR; G8_SCHED; G8_MMA(0, 0, At, B0); G8_MMA(0, 1, At, B1); G8_SCHED; G8_BAR; G8_SCHED;
            G8_LDA(At, 0, 1); G8_STGB(G8_SB(0, 0), b2); G8_STGB(G8_SB(0, 1), b2 + hstepB); G8_STGA(G8_SA(0, 0), a2, vo2, 0);
            G8_WAIT_V(8); G8_WAIT_L(0); G8_BAR; G8_SCHED; G8_MMA(1, 0, At, B0); G8_MMA(1, 1, At, B1); G8_SCHED; G8_BAR; G8_SCHED;
            G8_LDB(B0, 1, 0); G8_LDB(B1, 1, 1); G8_SCHED; G8_LDA(At, 1, 0); G8_STGA(G8_SA(0, 1), a2, vo2, 1);
            G8_WAIT_V(8); G8_WAIT_L(0); G8_BAR; G8_SCHED; G8_MMA(0, 0, At, B0); G8_MMA(0, 1, At, B1); G8_SCHED; G8_BAR; G8_SCHED;
            G8_LDA(At, 1, 1); G8_STGB(G8_SB(1, 0), b3); G8_STGB(G8_SB(1, 1), b3 + hstepB); G8_STGA(G8_SA(1, 0), a3, vo2, 0);
            G8_WAIT_V(8); G8_WAIT_L(0); G8_BAR; G8_SCHED; G8_MMA(1, 0, At, B0); G8_MMA(1, 1, At, B1); G8_SCHED; G8_BAR; G8_SCHED;
        }
        if (wr == 0) G8_BAR;
        Unit nn; bool has_nn = false;
        if (has_next) has_nn = S.next(ui + 2, nn);
        unsigned nnvo[2][2];
        if constexpr (GATHER) { if (has_nn) S.gather(nn, Rr, Cc, nnvo); }
        if constexpr (FP8) asm volatile("s_nop 15\n\ts_nop 15" ::: "memory");
        E(acc, cur, wr, wc, fr, fq);
        if (!has_next) break;
#pragma unroll
        for (int a = 0; a < 2; ++a)
#pragma unroll
            for (int b = 0; b < 2; ++b)
#pragma unroll
                for (int m = 0; m < 4; ++m)
#pragma unroll
                    for (int n = 0; n < 2; ++n) acc[a][b][m][n] = (f32x4){0.f, 0.f, 0.f, 0.f};
        cur = nxt; cA = nA; cB = nB; ++ui;
        if constexpr (GATHER) {
#pragma unroll
            for (int h = 0; h < 2; ++h)
#pragma unroll
                for (int i = 0; i < 2; ++i) { cvo[h][i] = nvo[h][i]; if (has_nn) nvo[h][i] = nnvo[h][i]; } }
        nxt = nn; has_next = has_nn;
        if (wr == 1) G8_BAR;
    }
    G8_WAIT_V(0);
    G8_BAR;
#undef G8_SA
#undef G8_SB
#undef G8_STGB
#undef G8_STGA
#undef G8_LDA
#undef G8_LDB
#undef G8_MMA
#undef G8_WAIT_V
#undef G8_WAIT_L
#undef G8_BAR
#undef G8_SCHED
}

struct GridOrder {
    int nM, nN, nwg, G, c; const char* A; const char* B; size_t tstepA, tstepB;
    __device__ __forceinline__ void init(int M, int N, int G_, int c_, const void* A_, const void* B_, int ldaB, int ldbB) { nM = M / BM; nN = N / BM; nwg = nM * nN; G = G_; c = c_; A = (const char*)A_; B = (const char*)B_; tstepA = (size_t)BM * ldaB; tstepB = (size_t)BM * ldbB; }
    __device__ __forceinline__ bool next(int i, Unit& u) const {
        const long L = (long)i * G + c; if (L >= nwg) return false;
        int wgid = (int)L; { const int q = nwg / 8, r = nwg % 8, xcd = wgid % 8, off = wgid / 8; wgid = (xcd < r ? xcd * (q + 1) : r * (q + 1) + (xcd - r) * q) + off; }
        const int nig = 8 * nN, gid = wgid / nig, fm = gid * 8, gsz = (nM - fm) < 8 ? (nM - fm) : 8;
        u.pm = fm + ((wgid % nig) % gsz); u.pn = (wgid % nig) / gsz; u.z = 0; u.rl = 0;
        u.A = A + (size_t)u.pm * tstepA; u.B = B + (size_t)u.pn * tstepB; return true;
    }
};
}

struct Frame {
    LAS unsigned char* lds; volatile LAS unsigned* MISC; unsigned* ctl;
    int tid, lane, wave, vcu, G;
    const float* in[34]; float* out; unsigned char* ws;
};
#define WSP(T_, off) ((T_*)(F.ws + (off)))

struct EpiInProj {
    const float* bias; bf16 *xrnn, *gy, *acat, *gates;
    __device__ __forceinline__ void operator()(const f32x4 (&acc)[2][2][4][2], const g8::Unit& u, int wr, int wc, int fr, int fq) const {
        const int pn = u.pn, colb = pn * 256 + wc * 32 + 8 * fq;
        f32x4 bv[2][2];
#pragma unroll
        for (int bj = 0; bj < 2; ++bj)
#pragma unroll
            for (int n = 0; n < 2; ++n) bv[bj][n] = *(const f32x4*)(bias + colb + bj * 128 + 4 * n);
#pragma unroll
        for (int ai = 0; ai < 2; ++ai)
#pragma unroll
            for (int m = 0; m < 4; ++m) { const int t = u.pm * 256 + ai * 128 + wr * 64 + m * 16 + fr;
#pragma unroll
                for (int bj = 0; bj < 2; ++bj) { f32x4 v0 = acc[ai][bj][m][0] + bv[bj][0], v1 = acc[ai][bj][m][1] + bv[bj][1]; const int col = colb + bj * 128;
                    if (pn < 4) { *(u32x4*)(xrnn + (size_t)t * 1024 + col) = pack8(v0, v1); }
                    else if (pn < 8) {
#pragma unroll
                        for (int j = 0; j < 4; ++j) { v0[j] = gelu_tanh(v0[j]); v1[j] = gelu_tanh(v1[j]); }
                        *(u32x4*)(gy + (size_t)t * 1024 + (col - 1024)) = pack8(v0, v1); }
                    else if (pn < 10) { const int cu = col - 2048, g = cu >> 4, c = cu & 15;
                        *(u32x4*)(acat + ((size_t)(g * S5M + (t >> 5)) * S5ROW + 128 + (t & 31) * 16 + c)) = pack8(v0, v1); }
                    else {
#pragma unroll
                        for (int j = 0; j < 4; ++j) { v0[j] = fast_sigmoid(v0[j]); v1[j] = fast_sigmoid(v1[j]); }
                        *(u32x4*)(gates + (size_t)t * 2048 + (col - 2560)) = pack8(v0, v1); } } }
    }
};
struct EpiS5A {
    float* S;
    __device__ __forceinline__ void operator()(const f32x4 (&acc)[2][2][4][2], const g8::Unit& u, int wr, int wc, int fr, int fq) const {
        const int col = wc * 32 + 8 * fq;
#pragma unroll
        for (int ai = 0; ai < 2; ++ai)
#pragma unroll
            for (int m = 0; m < 4; ++m) { const int row = u.pm * 256 + ai * 128 + wr * 64 + m * 16 + fr; float* p = S + ((size_t)(u.z * S5M + row)) * 128 + col;
                *(f32x4*)p = acc[ai][0][m][0]; *(f32x4*)(p + 4) = acc[ai][0][m][1]; }
    }
};
struct EpiS5C {
    bf16* ys;
    __device__ __forceinline__ void operator()(const f32x4 (&acc)[2][2][4][2], const g8::Unit& u, int wr, int wc, int fr, int fq) const {
#pragma unroll
        for (int ai = 0; ai < 2; ++ai)
#pragma unroll
            for (int m = 0; m < 4; ++m) { const int row = u.pm * 256 + ai * 128 + wr * 64 + m * 16 + fr;
#pragma unroll
                for (int bj = 0; bj < 2; ++bj) { const int n = u.pn * 256 + bj * 128 + wc * 32 + 8 * fq, i = n >> 4, c = n & 15; f32x4 v0 = acc[ai][bj][m][0], v1 = acc[ai][bj][m][1];
#pragma unroll
                    for (int j = 0; j < 4; ++j) { v0[j] = gelu_tanh(v0[j]); v1[j] = gelu_tanh(v1[j]); }
                    u32x2 w8; w8.x = pk4_fp8(v0[0], v0[1], v0[2], v0[3]); w8.y = pk4_fp8(v1[0], v1[1], v1[2], v1[3]); *(u32x2*)((unsigned char*)ys + (size_t)(row * 32 + i) * 512 + u.z * 16 + c) = w8; } }
    }
};
struct EpiGlu {
    const bf16* gates; bf16* gb;
    __device__ __forceinline__ void operator()(const f32x4 (&acc)[2][2][4][2], const g8::Unit& u, int wr, int wc, int fr, int fq) const {
        const int f = u.pn * 128 + wc * 32 + 8 * fq;
#pragma unroll
        for (int ai = 0; ai < 2; ++ai)
#pragma unroll
            for (int m = 0; m < 4; ++m) { const int t = u.pm * 256 + ai * 128 + wr * 64 + m * 16 + fr;
                const u32x4 gw = *(const u32x4*)(gates + (size_t)t * 2048 + 1024 + f); f32x4 g0, g1; unpack8(gw, g0, g1);
                f32x4 v0 = acc[ai][0][m][0], v1 = acc[ai][0][m][1]; const f32x4 s0 = acc[ai][1][m][0], s1 = acc[ai][1][m][1];
#pragma unroll
                for (int j = 0; j < 4; ++j) { v0[j] = g0[j] * v0[j] * fast_sigmoid(s0[j]); v1[j] = g1[j] * v1[j] * fast_sigmoid(s1[j]); }
                *(u32x4*)(gb + (size_t)t * 1024 + f) = pack8(v0, v1); }
    }
};
struct EpiRnn {
    const bf16* gates; const bf16* gb; bf16* merged;
    __device__ __forceinline__ void operator()(const f32x4 (&acc)[2][2][4][2], const g8::Unit& u, int wr, int wc, int fr, int fq) const {
#pragma unroll
        for (int ai = 0; ai < 2; ++ai)
#pragma unroll
            for (int m = 0; m < 4; ++m) { const int t = u.pm * 256 + ai * 128 + wr * 64 + m * 16 + fr;
#pragma unroll
                for (int bj = 0; bj < 2; ++bj) { const int col = u.pn * 256 + bj * 128 + wc * 32 + 8 * fq;
                    const u32x4 gw = *(const u32x4*)(gates + (size_t)t * 2048 + col), bw = *(const u32x4*)(gb + (size_t)t * 1024 + col);
                    f32x4 g0, g1, b0, b1; unpack8(gw, g0, g1); unpack8(bw, b0, b1);
                    const f32x4 v0 = g0 * acc[ai][bj][m][0] + b0, v1 = g1 * acc[ai][bj][m][1] + b1;
                    u32x2 w8; w8.x = pk4_fp8(v0[0], v0[1], v0[2], v0[3]); w8.y = pk4_fp8(v1[0], v1[1], v1[2], v1[3]); *(u32x2*)((unsigned char*)merged + (size_t)t * 1024 + col) = w8; } }
    }
};
struct EpiOut {
    const float* x; const float* mod; bf16* v1;
    __device__ __forceinline__ void operator()(const f32x4 (&acc)[2][2][4][2], const g8::Unit& u, int wr, int wc, int fr, int fq) const {
        const int b = (u.pm * 256) >> 12;
#pragma unroll
        for (int bj = 0; bj < 2; ++bj) { const int col = u.pn * 256 + bj * 128 + wc * 32 + 8 * fq;
            const f32x4 ga = *(const f32x4*)(mod + b * 6144 + 2048 + col) + 1.0f, gb_ = *(const f32x4*)(mod + b * 6144 + 2048 + col + 4) + 1.0f;
#pragma unroll
            for (int ai = 0; ai < 2; ++ai)
#pragma unroll
                for (int m = 0; m < 4; ++m) { const int t = u.pm * 256 + ai * 128 + wr * 64 + m * 16 + fr;
                    const f32x4 x0 = *(const f32x4*)(x + (size_t)t * 1024 + col), x1 = *(const f32x4*)(x + (size_t)t * 1024 + col + 4);
                    const f32x4 v0 = x0 * DN_ALPHA + ga * acc[ai][bj][m][0], v1_ = x1 * DN_ALPHA + gb_ * acc[ai][bj][m][1];
                    *(u32x4*)(v1 + (size_t)t * 1024 + col) = pack8(v0, v1_); } }
    }
};
struct EpiMoe1 {
    const float* bgu; bf16* act;
    __device__ __forceinline__ void operator()(const f32x4 (&acc)[2][2][4][2], const g8::Unit& u, int wr, int wc, int fr, int fq) const {
        const int f = u.pn * 128 + wc * 32 + 8 * fq; const float* bp = bgu + (size_t)u.z * 2048 + f;
        const f32x4 bg0 = *(const f32x4*)bp, bg1 = *(const f32x4*)(bp + 4), bu0 = *(const f32x4*)(bp + 1024), bu1 = *(const f32x4*)(bp + 1028);
#pragma unroll
        for (int ai = 0; ai < 2; ++ai)
#pragma unroll
            for (int m = 0; m < 4; ++m) { const int row = u.pm * 256 + ai * 128 + wr * 64 + m * 16 + fr;
                f32x4 g0 = acc[ai][0][m][0] + bg0, g1 = acc[ai][0][m][1] + bg1, u0 = acc[ai][1][m][0] + bu0, u1 = acc[ai][1][m][1] + bu1;
#pragma unroll
                for (int j = 0; j < 4; ++j) { const float ga = fminf(g0[j], 7.0f), gb_ = fminf(g1[j], 7.0f), ua = fminf(fmaxf(u0[j], -7.0f), 7.0f), ub = fminf(fmaxf(u1[j], -7.0f), 7.0f);
                    g0[j] = ga * fast_sigmoid(1.702f * ga) * (ua + 1.0f); g1[j] = gb_ * fast_sigmoid(1.702f * gb_) * (ub + 1.0f); }
                u32x2 w8; w8.x = pk4_fp8(g0[0], g0[1], g0[2], g0[3]); w8.y = pk4_fp8(g1[0], g1[1], g1[2], g1[3]); *(u32x2*)((unsigned char*)act + (size_t)row * 1024 + f) = w8; }
    }
};
struct EpiMoe2 {
    const float* bd; bf16* yb;
    __device__ __forceinline__ void operator()(const f32x4 (&acc)[2][2][4][2], const g8::Unit& u, int wr, int wc, int fr, int fq) const {
#pragma unroll
        for (int bj = 0; bj < 2; ++bj) { const int col = u.pn * 256 + bj * 128 + wc * 32 + 8 * fq; const float* bp = bd + (size_t)u.z * 1024 + col;
            const f32x4 b0 = *(const f32x4*)bp, b1 = *(const f32x4*)(bp + 4);
#pragma unroll
            for (int ai = 0; ai < 2; ++ai)
#pragma unroll
                for (int m = 0; m < 4; ++m) { const int row = u.pm * 256 + ai * 128 + wr * 64 + m * 16 + fr;
                    *(u32x4*)(yb + (size_t)row * 1024 + col) = pack8(acc[ai][bj][m][0] + b0, acc[ai][bj][m][1] + b1); } }
    }
};

struct S5AOrder { int G, c; const char* acat; const char* ws;
    __device__ __forceinline__ bool next(int i, g8::Unit& u) const { const int L = i * G + c; if (L >= S5G * 4) return false; u.z = L >> 2; u.pm = L & 3; u.pn = 0; u.rl = 0;
        u.A = acat + ((size_t)(u.z * S5M + u.pm * 256) * S5ROW + 128) * 2; u.B = ws + (size_t)u.z * 256 * (S5L * 16) * 2; return true; } };
struct S5COrder { int G, c; const char* acat; const char* wy;
    __device__ __forceinline__ bool next(int i, g8::Unit& u) const { const int L = i * G + c; if (L >= S5G * 8) return false; u.z = L >> 3; u.pm = (L >> 1) & 3; u.pn = L & 1; u.rl = 0;
        u.A = acat + ((size_t)(u.z * S5M + u.pm * 256) * S5ROW) * 2; u.B = wy + ((size_t)(u.z * 512 + u.pn * 256) * S5ROW) * 2; return true; } };
struct MoeOrder { int G, c, NT, RT; const LAS int* tstart; const LAS int* cnt; const int* toklist; const char* A; const char* B; size_t bstride_e; int lda; bool gatherA;
    __device__ __forceinline__ bool next(int i, g8::Unit& u) const { const int per = G >> 3, xcd = c & 7, slot = c >> 3, rpx = per / NT;
        const int rt = (i * 8 + xcd) * rpx + slot / NT; if (rt >= RT) return false; u.pn = slot % NT;
        int e = 0;
#pragma unroll 1
        for (int k = 1; k < NE; ++k) if (tstart[k] <= rt) e = k;
        u.z = e; u.pm = rt; u.rl = rt - tstart[e]; u.B = B + (size_t)e * bstride_e + (size_t)u.pn * 256 * 1024; u.A = gatherA ? A : A + (size_t)rt * 256 * 1024; return true; }
    __device__ __forceinline__ void gather(const g8::Unit& u, const int (&Rr)[2], const int (&Cc)[2], unsigned (&vo)[2][2]) const {
        const int n = cnt[u.z];
#pragma unroll
        for (int h = 0; h < 2; ++h)
#pragma unroll
            for (int i = 0; i < 2; ++i) { const int r = u.rl * 256 + h * 128 + Rr[i]; const int tok = r < n ? toklist[u.z * T + r] : 0; vo[h][i] = (unsigned)(tok * lda + Cc[i] * 2); } }
};

__device__ __forceinline__ void transpose_item(const float* W, int N, int k0, int n0, bf16* dst, int ldd, int drow0, LAS float* scr, int lane) {
#pragma unroll 8
    for (int i = 0; i < 32; ++i) { const int kk = 2 * i + (lane >> 5); scr[kk * 33 + (lane & 31)] = W[(size_t)(k0 + kk) * N + n0 + (lane & 31)]; }
    asm volatile("s_waitcnt lgkmcnt(0)" ::: "memory");
    const int c = lane & 7;
#pragma unroll
    for (int j = 0; j < 4; ++j) { const int n = (lane >> 3) + 8 * j; const LAS float* s = scr + (8 * c) * 33 + n;
        u32x4 o; o.x = pk2(s[0 * 33], s[1 * 33]); o.y = pk2(s[2 * 33], s[3 * 33]); o.z = pk2(s[4 * 33], s[5 * 33]); o.w = pk2(s[6 * 33], s[7 * 33]);
        *(u32x4*)(dst + (size_t)(drow0 + n) * ldd + k0 + 8 * c) = o; }
    asm volatile("s_waitcnt lgkmcnt(0)" ::: "memory");
}
__device__ __forceinline__ void transpose_item8(const float* W, int N, int k0, int n0, unsigned char* dst, int ldd, int drow0, LAS float* scr, int lane) {
#pragma unroll 8
    for (int i = 0; i < 32; ++i) { const int kk = 2 * i + (lane >> 5); scr[kk * 33 + (lane & 31)] = W[(size_t)(k0 + kk) * N + n0 + (lane & 31)]; }
    asm volatile("s_waitcnt lgkmcnt(0)" ::: "memory");
    const int c = lane & 7;
#pragma unroll
    for (int j = 0; j < 4; ++j) { const int n = (lane >> 3) + 8 * j; const LAS float* s = scr + (8 * c) * 33 + n;
        u32x2 o; o.x = pk4_fp8(32.f * s[0 * 33], 32.f * s[1 * 33], 32.f * s[2 * 33], 32.f * s[3 * 33]); o.y = pk4_fp8(32.f * s[4 * 33], 32.f * s[5 * 33], 32.f * s[6 * 33], 32.f * s[7 * 33]);
        *(u32x2*)(dst + (size_t)(drow0 + n) * ldd + k0 + 8 * c) = o; }
    asm volatile("s_waitcnt lgkmcnt(0)" ::: "memory");
}
__device__ __forceinline__ int pair_row(int n) { const int f = n & 1023, hi = n >> 10; return (f >> 7) * 256 + hi * 128 + (f & 127); }

__device__ __forceinline__ void moe_tables(Frame& F) {
    LAS int* tstart = (LAS int*)(F.lds + TAB_OFF); LAS int* cl = tstart + 40;
    if (F.tid == 0) { int acc = 0; for (int e = 0; e < NE; ++e) { const int c = (int)F.ctl[CW_CNT + 64 * e]; cl[e] = c; tstart[e] = acc; acc += (c + 255) >> 8; } tstart[NE] = acc; }
    __syncthreads();
}

__device__ __forceinline__ void p0_mod_job(Frame& F, int job) {
    LAS float* sc = (LAS float*)F.lds;
    LAS float* red = sc + 8 * 1024;
    const float* c = F.in[1]; const float* w = F.in[2]; const float* bias = F.in[3];
    for (int i = F.tid; i < 8 * 1024; i += 512) { const float v = c[i]; sc[i] = v * fast_sigmoid(v); }
    __syncthreads();
    const int col = F.tid & 31, kg = F.tid >> 5, j = job * 32 + col;
    float a[8];
#pragma unroll
    for (int b = 0; b < 8; ++b) a[b] = 0.f;
#pragma unroll 8
    for (int k = kg * 64; k < kg * 64 + 64; ++k) { const float wv = w[(size_t)k * 6144 + j];
#pragma unroll
        for (int b = 0; b < 8; ++b) a[b] += sc[b * 1024 + k] * wv; }
#pragma unroll
    for (int b = 0; b < 8; ++b) red[(kg * 8 + b) * 32 + col] = a[b];
    __syncthreads();
    if (F.tid < 256) { const int b = F.tid >> 5, cc = F.tid & 31; float s = 0.f;
#pragma unroll
        for (int g = 0; g < 16; ++g) s += red[(g * 8 + b) * 32 + cc];
        WSP(float, WS_MOD)[b * 6144 + job * 32 + cc] = s + bias[job * 32 + cc]; }
    __syncthreads();
}
__device__ __forceinline__ void s5_setup(Frame& F, int g, int kmin, int kmax, LAS f32x2* Bb, LAS f32x2* Cc, LAS f32x2* Ap) {
    const float* lre = F.in[14] + g * 64; const float* lim = F.in[15] + g * 64; const float dt = expf(F.in[16][g]);
    const float* bre = F.in[17] + g * 1024; const float* bim = F.in[18] + g * 1024; const float* cre = F.in[19] + g * 1024; const float* cim = F.in[20] + g * 1024;
    for (int i = F.tid; i < 1024; i += 512) { const int p = i >> 4; const float lr = lre[p], li = lim[p]; const float mag = expf(lr * dt); float sn, cs; sincosf(li * dt, &sn, &cs);
        const float ar = mag * cs, ai = mag * sn, den = lr * lr + li * li, qr = ((ar - 1.f) * lr + ai * li) / den, qi = (ai * lr - (ar - 1.f) * li) / den;
        const float br = bre[i], bi = bim[i]; Bb[i] = (f32x2){qr * br - qi * bi, qr * bi + qi * br};
        Cc[i] = (f32x2){cre[i], cim[i]}; }
    for (int i = kmin * 64 + F.tid; i < (kmax + 1) * 64; i += 512) { const int k = i >> 6, p = i & 63; const float lr = lre[p], li = lim[p]; const float mag = expf((float)k * lr * dt); float sn, cs; sincosf((float)k * li * dt, &sn, &cs);
        Ap[i] = (f32x2){mag * cs, mag * sn}; }
    __syncthreads();
}
constexpr size_t WS_KTAB = WS_S;
__device__ __forceinline__ void p0_s5k_job(Frame& F, int job) {
    const int g = job >> 3, part = job & 7;
    LAS f32x2* Bb = (LAS f32x2*)F.lds; LAS f32x2* Cc = Bb + 1024; LAS f32x2* Ap = Cc + 1024;
    s5_setup(F, g, 4 * part, 4 * part + 3, Bb, Cc, Ap);
    float* kt = WSP(float, WS_KTAB) + (size_t)g * 32 * 256;
    for (int e = 4 * part * 256 + F.tid; e < (4 * part + 4) * 256; e += 512) { const int k = e >> 8, c = (e >> 4) & 15, c2 = e & 15; float s = 0.f;
        for (int p = 0; p < 64; ++p) { const f32x2 cv = Cc[c * 64 + p], av = Ap[k * 64 + p], bv = Bb[p * 16 + c2];
            const float car = cv.x * av.x - cv.y * av.y, cai = cv.x * av.y + cv.y * av.x; s += car * bv.x - cai * bv.y; }
        kt[e] = s; }
    __syncthreads();
}
__device__ __forceinline__ void p1_s5w_job(Frame& F, int job) {
    const int g = job >> 3, part = job & 7;
    LAS f32x2* Bb = (LAS f32x2*)F.lds; LAS f32x2* Cc = Bb + 1024; LAS f32x2* Ap = Cc + 1024; LAS float* Kt = (LAS float*)(Ap + 33 * 64);
    const float* ktg = WSP(float, WS_KTAB) + (size_t)g * 32 * 256; const float* dsk = F.in[21] + g * 16;
    for (int i = F.tid; i < 32 * 256; i += 512) Kt[i] = ktg[i];
    s5_setup(F, g, 0, S5L, Bb, Cc, Ap);
    if (part == 0 && F.tid < 64) WSP(f32x2, WS_AL)[g * 64 + F.tid] = Ap[S5L * 64 + F.tid];
    bf16* wy = WSP(bf16, WS_WY) + (size_t)g * 512 * S5ROW;
    for (int ch = F.tid; ch < 64 * (S5ROW / 8); ch += 512) { const int n = part * 64 + ch / (S5ROW / 8), k8 = (ch % (S5ROW / 8)) * 8, i = n >> 4, c = n & 15; float v[8];
        if (k8 < 128) {
#pragma unroll
            for (int j = 0; j < 8; j += 2) { const int p = (k8 + j) >> 1; const f32x2 cv = Cc[c * 64 + p], av = Ap[(i + 1) * 64 + p]; v[j] = cv.x * av.x - cv.y * av.y; v[j + 1] = -(cv.x * av.y + cv.y * av.x); } }
        else { const int jj = (k8 - 128) >> 4, c2 = (k8 - 128) & 15;
#pragma unroll
            for (int j = 0; j < 8; ++j) { float x = 0.f; if (jj <= i) { x = Kt[(i - jj) * 256 + c * 16 + c2 + j]; if (jj == i && c == c2 + j) x += dsk[c]; } v[j] = x; } }
        u32x4 o; o.x = pk2(v[0], v[1]); o.y = pk2(v[2], v[3]); o.z = pk2(v[4], v[5]); o.w = pk2(v[6], v[7]);
        *(u32x4*)(wy + (size_t)n * S5ROW + k8) = o; }
    bf16* wsm = WSP(bf16, WS_WS) + (size_t)g * 256 * 512;
    for (int ch = F.tid; ch < 32 * 64; ch += 512) { const int n = part * 32 + (ch >> 6), k8 = (ch & 63) * 8, jj = k8 >> 4, c2 = k8 & 15; float v[8];
#pragma unroll
        for (int j = 0; j < 8; ++j) { float x = 0.f; if (n < 128) { const int p = n >> 1; const f32x2 av = Ap[(S5L - 1 - jj) * 64 + p], bv = Bb[p * 16 + c2 + j]; x = (n & 1) ? (av.x * bv.y + av.y * bv.x) : (av.x * bv.x - av.y * bv.y); } v[j] = x; }
        u32x4 o; o.x = pk2(v[0], v[1]); o.y = pk2(v[2], v[3]); o.z = pk2(v[4], v[5]); o.w = pk2(v[6], v[7]);
        *(u32x4*)(wsm + (size_t)n * 512 + k8) = o; }
    __syncthreads();
}
__device__ __forceinline__ void p0_small_transposes(Frame& F) {
    LAS float* scr = (LAS float*)(F.lds + F.wave * 16384);
    const int gw = F.vcu * 8 + F.wave, NGW = F.G * 8;
    constexpr int I_IN = 16 * 144, I_RNN = 16 * 32, I_OUT = 16 * 32, I_GLU = 8 * 64, I_RG = 16 * 8;
    for (int it = gw; it < I_IN + I_RNN + I_OUT + I_GLU + I_RG; it += NGW) { int r = it;
        if (r < I_IN) { const int kb = r / 144, nb = r % 144; transpose_item8(F.in[4], INC, kb * 64, nb * 32, WSP(unsigned char, WS_WIN), 1024, nb * 32, scr, F.lane); continue; } r -= I_IN;
        if (r < I_RNN) { const int kb = r / 32, nb = r % 32; transpose_item8(F.in[13], 1024, kb * 64, nb * 32, WSP(unsigned char, WS_WRNN), 1024, nb * 32, scr, F.lane); continue; } r -= I_RNN;
        if (r < I_OUT) { const int kb = r / 32, nb = r % 32; transpose_item8(F.in[23], 1024, kb * 64, nb * 32, WSP(unsigned char, WS_WOUT), 1024, nb * 32, scr, F.lane); continue; } r -= I_OUT;
        if (r < I_GLU) { const int kb = r / 64, nb = r % 64; transpose_item8(F.in[22], 2048, kb * 64, nb * 32, WSP(unsigned char, WS_WGLU), 512, pair_row(nb * 32), scr, F.lane); continue; } r -= I_GLU;
        { const int mat = r >> 3, kb = (r >> 2) & 1, nb = r & 3, hd = mat & 7, gx = mat >> 3;
          transpose_item(F.in[gx ? 10 : 8] + (size_t)hd * 128 * 128, 128, kb * 64, nb * 32, WSP(bf16, WS_WG), 128, hd * 256 + gx * 128 + nb * 32, scr, F.lane); }
    }
}
__device__ __forceinline__ void p1_body(Frame& F) {
    const int gw = F.vcu * 8 + F.wave, NGW = F.G * 8; const float* mod = WSP(float, WS_MOD); bf16* hbf = WSP(bf16, WS_HBF);
    for (int t = gw; t < T; t += NGW) { const int b = t >> 12; const f32x4* xr = (const f32x4*)(F.in[0] + (size_t)t * 1024) + F.lane; const f32x4* sh = (const f32x4*)(mod + b * 6144) + F.lane; const f32x4* sc = (const f32x4*)(mod + b * 6144 + 1024) + F.lane;
        unsigned* o = (unsigned*)((unsigned char*)hbf + (size_t)t * 1024) + F.lane;
#pragma unroll
        for (int j = 0; j < 4; ++j) { const f32x4 v = xr[64 * j] * (sc[64 * j] + 1.0f) + sh[64 * j]; o[64 * j] = pk4_fp8(v[0], v[1], v[2], v[3]); } }
    LAS float* scr = (LAS float*)(F.lds + F.wave * 16384);
    constexpr int I_GU = 16 * 64, I_D = 16 * 32;
    for (int it = gw; it < NE * (I_GU + I_D); it += NGW) { const int e = it / (I_GU + I_D); int r = it % (I_GU + I_D);
        if (r < I_GU) { const int kb = r / 64, nb = r % 64; transpose_item8(F.in[28] + (size_t)e * 1024 * 2048, 2048, kb * 64, nb * 32, WSP(unsigned char, WS_WGU) + (size_t)e * 2048 * 1024, 1024, pair_row(nb * 32), scr, F.lane); }
        else { r -= I_GU; const int kb = r / 32, nb = r % 32; transpose_item8(F.in[30] + (size_t)e * 1024 * 1024, 1024, kb * 64, nb * 32, WSP(unsigned char, WS_WD) + (size_t)e * 1024 * 1024, 1024, nb * 32, scr, F.lane); } }
}
constexpr int XR_LD = 136, XR_TILE = 128 * XR_LD;
__device__ __forceinline__ void rg_issue(const bf16* xrnn, const bf16* gy, int item, int tid, u32x4 (&xraw)[4][4], u32x4 (&graw)[4], bool pass1) {
    const int hd = item & 7, c = (item >> 3) & 31, b = item >> 8, r0 = tid >> 4, ch = hd * 128 + (tid & 15) * 8;
#pragma unroll
    for (int q = 0; q < 4; ++q) { const int r = r0 + 32 * q;
#pragma unroll
        for (int k = 0; k < 4; ++k) { const int tp = c * RGL + r - 3 + k, tpc = tp < 0 ? 0 : tp; xraw[q][k] = *(const u32x4*)(xrnn + (size_t)(b * SEQ + tpc) * 1024 + ch); }
        if (pass1) graw[q] = *(const u32x4*)(gy + (size_t)(b * SEQ + c * RGL + r) * 1024 + ch); }
}
__device__ __forceinline__ void rg_convwrite(const float* cw, const float* cb, int item, int tid, const u32x4 (&xraw)[4][4], const u32x4 (&graw)[4], LAS bf16* xr, LAS bf16* gyt, bool pass1) {
    const int hd = item & 7, c = (item >> 3) & 31, r0 = tid >> 4, c8 = (tid & 15) * 8, ch = hd * 128 + c8;
    const f32x4 b0 = *(const f32x4*)(cb + ch), b1 = *(const f32x4*)(cb + ch + 4);
    f32x4 w0[4], w1[4];
#pragma unroll
    for (int k = 0; k < 4; ++k) { w0[k] = *(const f32x4*)(cw + k * 1024 + ch); w1[k] = *(const f32x4*)(cw + k * 1024 + ch + 4); }
#pragma unroll
    for (int q = 0; q < 4; ++q) { const int r = r0 + 32 * q; f32x4 a0 = b0, a1 = b1;
#pragma unroll
        for (int k = 0; k < 4; ++k) { const int tp = c * RGL + r - 3 + k; f32x4 x0, x1; unpack8(xraw[q][k], x0, x1); if (tp < 0) { x0 = (f32x4){0.f, 0.f, 0.f, 0.f}; x1 = x0; } a0 += w0[k] * x0; a1 += w1[k] * x1; }
        *(LAS u32x4*)(xr + r * XR_LD + c8) = pack8(a0, a1);
        if (pass1) *(LAS u32x4*)(gyt + r * XR_LD + c8) = graw[q]; }
}
template <int PASS>
__device__ __forceinline__ void rglru_phase(Frame& F) {
    const int NIT = NB * RGC * 8;
    int it = F.vcu; if (it >= NIT) return;
    LAS bf16* xr = (LAS bf16*)F.lds; LAS bf16* gyt0 = xr + XR_TILE;
    const bf16* xrnn = WSP(bf16, WS_XRNN); const bf16* gy = WSP(bf16, WS_GY); bf16* ha = WSP(bf16, WS_HA); const float* cw = F.in[6]; const float* cb = F.in[7];
    const int tid = F.tid, w = F.wave, q = F.lane >> 4, col = F.lane & 15, chl = 16 * w + col;
    u32x4 xraw[4][4], graw[4];
    rg_issue(xrnn, gy, it, tid, xraw, graw, PASS);
    rg_convwrite(cw, cb, it, tid, xraw, graw, xr, gyt0, PASS);
    int hd_loaded = -1; bf16x8 Bf[2][4]; float ba = 0.f, bx = 0.f, sp = 0.f;
    __syncthreads();
    for (int i = 0; it < NIT; ++i) {
        const int nit = it + F.G; const bool has_next = nit < NIT;
        const int hd = it & 7, c = (it >> 3) & 31, b = it >> 8, t0 = b * SEQ + c * RGL, ch = hd * 128 + chl;
        LAS bf16* gyt = gyt0 + (i & 1) * XR_TILE; LAS bf16* gytn = gyt0 + ((i & 1) ^ 1) * XR_TILE;
        if (has_next) rg_issue(xrnn, gy, nit, tid, xraw, graw, PASS);
        if (hd != hd_loaded) { hd_loaded = hd; const bf16* wg = WSP(bf16, WS_WG) + (size_t)hd * 256 * 128;
#pragma unroll
            for (int gt = 0; gt < 2; ++gt)
#pragma unroll
                for (int kk = 0; kk < 4; ++kk) Bf[gt][kk] = *(const bf16x8*)(wg + (size_t)(gt * 128 + chl) * 128 + kk * 32 + q * 8);
            ba = F.in[9][ch]; bx = F.in[11][ch]; const float lam = F.in[12][ch]; sp = (lam > 15.f) ? __expf(-lam) : log1pf(__expf(-lam)); }
        float carryH = 0.f, carryP = 1.f;
        if (PASS) carryH = WSP(float, WS_HIN)[(size_t)(b * RGC + c) * 1024 + ch];
        __builtin_amdgcn_sched_barrier(0);
        f32x4 acc[8][2];
#pragma unroll
        for (int m = 0; m < 8; ++m) { acc[m][0] = (f32x4){0.f, 0.f, 0.f, 0.f}; acc[m][1] = (f32x4){0.f, 0.f, 0.f, 0.f}; }
#pragma unroll
        for (int kk = 0; kk < 4; ++kk)
#pragma unroll
            for (int m = 0; m < 8; ++m) { const bf16x8 Af = *(const LAS bf16x8*)(xr + (16 * m + col) * XR_LD + kk * 32 + q * 8);
                acc[m][0] = __builtin_amdgcn_mfma_f32_16x16x32_bf16(Af, Bf[0][kk], acc[m][0], 0, 0, 0);
                acc[m][1] = __builtin_amdgcn_mfma_f32_16x16x32_bf16(Af, Bf[1][kk], acc[m][1], 0, 0, 0); }
#pragma unroll
        for (int m = 0; m < 8; ++m) {
            float a[4], uu[4];
#pragma unroll
            for (int j = 0; j < 4; ++j) { const int tl = 16 * m + 4 * q + j;
                const float r = fast_sigmoid(acc[m][0][j] + ba), ii = fast_sigmoid(acc[m][1][j] + bx);
                const float la = -11.541560327f * r * sp; a[j] = __builtin_amdgcn_exp2f(la); const float mult = __builtin_amdgcn_sqrtf(fmaxf(1.0f - a[j] * a[j], 0.f));
                uu[j] = mult * ii * bf1(xr[tl * XR_LD + chl]); }
            float sP = a[0], sH = uu[0];
#pragma unroll
            for (int j = 1; j < 4; ++j) { sH = a[j] * sH + uu[j]; sP *= a[j]; }
            float iP = sP, iH = sH;
            { const float pP = __shfl_up(iP, 16), pH = __shfl_up(iH, 16); if (q >= 1) { iH = iP * pH + iH; iP = iP * pP; } }
            { const float pP = __shfl_up(iP, 32), pH = __shfl_up(iH, 32); if (q >= 2) { iH = iP * pH + iH; iP = iP * pP; } }
            float eP = __shfl_up(iP, 16), eH = __shfl_up(iH, 16); if (q == 0) { eP = 1.f; eH = 0.f; }
            const float tP = __shfl(iP, col + 48), tH = __shfl(iH, col + 48);
            if (PASS) { float h = eP * carryH + eH;
#pragma unroll
                for (int j = 0; j < 4; ++j) { const int tl = 16 * m + 4 * q + j; h = a[j] * h + uu[j]; LAS bf16* gp = gyt + tl * XR_LD + chl; *gp = (bf16)f2bf(h * bf1(*gp)); } }
            carryH = tP * carryH + tH; carryP *= tP;
        }
        if (!PASS && q == 0) { f32x2* ag = WSP(f32x2, WS_RGAGG); ag[(size_t)(b * RGC + c) * 1024 + ch] = (f32x2){carryP, carryH}; }
        __syncthreads();
        if (PASS) { const int r0 = tid >> 4, c8 = (tid & 15) * 8;
#pragma unroll
            for (int qq = 0; qq < 4; ++qq) { const int r = r0 + 32 * qq; f32x4 h0, h1; unpack8(*(const LAS u32x4*)(gyt + r * XR_LD + c8), h0, h1); u32x2 w8; w8.x = pk4_fp8(h0[0], h0[1], h0[2], h0[3]); w8.y = pk4_fp8(h1[0], h1[1], h1[2], h1[3]);
                *(u32x2*)((unsigned char*)ha + (size_t)(t0 + r) * 1024 + hd * 128 + c8) = w8; } }
        if (has_next) rg_convwrite(cw, cb, nit, tid, xraw, graw, xr, gytn, PASS);
        __syncthreads();
        it = nit;
    }
}
__device__ __forceinline__ void p4_carries(Frame& F) {
    LAS f32x2* seg = (LAS f32x2*)F.lds;
    for (int job = F.vcu; job < NB * S5G; job += F.G) {
        const int b = job >> 5, g = job & 31, p = F.lane, w = F.wave;
        const f32x2 al = WSP(f32x2, WS_AL)[g * 64 + p];
        const f32x2* Sb = WSP(f32x2, WS_S) + ((size_t)(g * S5M + b * S5CPB + 16 * w)) * 64 + p; unsigned* ac = (unsigned*)(WSP(bf16, WS_ACAT) + ((size_t)(g * S5M + b * S5CPB + 16 * w)) * S5ROW) + p;
        f32x2 sv[16];
#pragma unroll
        for (int i = 0; i < 16; ++i) sv[i] = Sb[(size_t)i * 64];
        float xr_ = 0.f, xi = 0.f;
#pragma unroll
        for (int i = 0; i < 16; ++i) { const float nr = al.x * xr_ - al.y * xi + sv[i].x, ni = al.x * xi + al.y * xr_ + sv[i].y; xr_ = nr; xi = ni; }
        seg[w * 64 + p] = (f32x2){xr_, xi};
        float ar = al.x, ai = al.y;
#pragma unroll
        for (int q = 0; q < 4; ++q) { const float nr = ar * ar - ai * ai, ni = 2.f * ar * ai; ar = nr; ai = ni; }
        __syncthreads();
        xr_ = 0.f; xi = 0.f;
        for (int ww = 0; ww < w; ++ww) { const f32x2 sg = seg[ww * 64 + p]; const float nr = ar * xr_ - ai * xi + sg.x, ni = ar * xi + ai * xr_ + sg.y; xr_ = nr; xi = ni; }
#pragma unroll
        for (int i = 0; i < 16; ++i) { ac[(size_t)i * (S5ROW / 2)] = pk2(xr_, xi); const float nr = al.x * xr_ - al.y * xi + sv[i].x, ni = al.x * xi + al.y * xr_ + sv[i].y; xr_ = nr; xi = ni; }
        __syncthreads();
    }
    if (F.vcu < 16) {
        const int id = F.vcu * 512 + F.tid, ch = id & 1023, b = id >> 10; const f32x2* ag = WSP(f32x2, WS_RGAGG) + (size_t)b * RGC * 1024 + ch; float* hin = WSP(float, WS_HIN) + (size_t)b * RGC * 1024 + ch;
        f32x2 a[RGC];
#pragma unroll
        for (int c = 0; c < RGC; ++c) a[c] = ag[(size_t)c * 1024];
        float h = 0.f;
#pragma unroll
        for (int c = 0; c < RGC; ++c) { hin[(size_t)c * 1024] = h; h = a[c].x * h + a[c].y; }
    }
}
constexpr int WR_LD = 1032;
__device__ __forceinline__ void p9_router(Frame& F) {
    LAS bf16* wH = (LAS bf16*)F.lds; LAS bf16* wL = wH + 32 * WR_LD;
    LAS f32x2* sel = (LAS f32x2*)(wL + 32 * WR_LD);
    LAS unsigned* rec = (LAS unsigned*)(sel + 512);
    LAS float* recp = (LAS float*)(rec + 512);
    LAS int* lcnt = (LAS int*)(recp + 512);
    LAS int* gbase = lcnt + 32;
    const float* wr = F.in[26];
    for (int i = F.tid; i < 1024 * 32; i += 512) { const float w = wr[i]; const unsigned hb = f2bf(w); const float hf = __builtin_bit_cast(float, hb << 16);
        wH[(i & 31) * WR_LD + (i >> 5)] = (bf16)hb; wL[(i & 31) * WR_LD + (i >> 5)] = (bf16)f2bf(w - hf); }
    if (F.tid < 32) lcnt[F.tid] = 0;
    __syncthreads();
    const float* mod = WSP(float, WS_MOD); const bf16* v1 = WSP(bf16, WS_V1); bf16* x1 = WSP(bf16, WS_X1); unsigned char* h2 = WSP(unsigned char, WS_H2);
    const int lane = F.lane, m = lane & 15, kq = lane >> 4, w = F.wave;
    for (int blk = F.vcu; blk < T / 128; blk += F.G) {
        const int t = blk * 128 + w * 16 + m, b = (blk * 128) >> 12;
        const bf16* vrow = v1 + (size_t)t * 1024 + 8 * kq;
        float sum = 0.f, sq = 0.f;
#pragma unroll 8
        for (int s_ = 0; s_ < 32; ++s_) { f32x4 a, c; unpack8(*(const u32x4*)(vrow + 32 * s_), a, c); sum += ((a[0] + a[1]) + (a[2] + a[3])) + ((c[0] + c[1]) + (c[2] + c[3]));
            sq += ((a[0] * a[0] + a[1] * a[1]) + (a[2] * a[2] + a[3] * a[3])) + ((c[0] * c[0] + c[1] * c[1]) + (c[2] * c[2] + c[3] * c[3])); }
        sum += __shfl_xor(sum, 16); sum += __shfl_xor(sum, 32); sq += __shfl_xor(sq, 16); sq += __shfl_xor(sq, 32);
        const float mean = sum * (1.f / 1024.f); const float rstd = 1.f / sqrtf(fmaxf(sq * (1.f / 1024.f) - mean * mean, 0.f) + LN_EPS);
        f32x4 acc[2] = {(f32x4){0.f, 0.f, 0.f, 0.f}, (f32x4){0.f, 0.f, 0.f, 0.f}};
        const float* lng = F.in[24] + 8 * kq; const float* lnb = F.in[25] + 8 * kq; const float* shp = mod + b * 6144 + 3072 + 8 * kq; const float* scp = mod + b * 6144 + 4096 + 8 * kq;
        bf16* x1row = x1 + (size_t)t * 1024 + 8 * kq; unsigned char* h2row = h2 + (size_t)t * 1024 + 8 * kq;
        const LAS bf16* wHr = wH + m * WR_LD + 8 * kq; const LAS bf16* wLr = wL + m * WR_LD + 8 * kq;
#pragma unroll 2
        for (int s_ = 0; s_ < 32; ++s_) { const int ko = 32 * s_;
            f32x4 a, c; unpack8(*(const u32x4*)(vrow + ko), a, c);
            const f32x4 g0 = *(const f32x4*)(lng + ko), g1 = *(const f32x4*)(lng + ko + 4), b0 = *(const f32x4*)(lnb + ko), b1 = *(const f32x4*)(lnb + ko + 4);
            const f32x4 x0 = (a - mean) * rstd * g0 + b0, x1v = (c - mean) * rstd * g1 + b1;
            *(u32x4*)(x1row + ko) = pack8(x0, x1v);
            const f32x4 sh0 = *(const f32x4*)(shp + ko), sh1 = *(const f32x4*)(shp + ko + 4), sc0 = *(const f32x4*)(scp + ko), sc1 = *(const f32x4*)(scp + ko + 4);
            const f32x4 h0 = x0 * (sc0 + 1.0f) + sh0, h1 = x1v * (sc1 + 1.0f) + sh1;
            u32x2 w8; w8.x = pk4_fp8(h0[0], h0[1], h0[2], h0[3]); w8.y = pk4_fp8(h1[0], h1[1], h1[2], h1[3]); *(u32x2*)(h2row + ko) = w8;
            const u32x4 hi = pack8(h0, h1); f32x4 r0, r1; unpack8(hi, r0, r1); const u32x4 lo = pack8(h0 - r0, h1 - r1);
            const bf16x8 ah = __builtin_bit_cast(bf16x8, hi), al = __builtin_bit_cast(bf16x8, lo);
#pragma unroll
            for (int nf = 0; nf < 2; ++nf) { const bf16x8 bh = *(const LAS bf16x8*)(wHr + nf * 16 * WR_LD + ko), bl = *(const LAS bf16x8*)(wLr + nf * 16 * WR_LD + ko);
                acc[nf] = __builtin_amdgcn_mfma_f32_16x16x32_bf16(bh, ah, acc[nf], 0, 0, 0);
                acc[nf] = __builtin_amdgcn_mfma_f32_16x16x32_bf16(bl, ah, acc[nf], 0, 0, 0);
                acc[nf] = __builtin_amdgcn_mfma_f32_16x16x32_bf16(bh, al, acc[nf], 0, 0, 0); } }
        float lv[8];
#pragma unroll
        for (int nf = 0; nf < 2; ++nf)
#pragma unroll
            for (int j = 0; j < 4; ++j) lv[nf * 4 + j] = acc[nf][j] + F.in[27][nf * 16 + 4 * kq + j];
        int rank[8];
#pragma unroll
        for (int i = 0; i < 8; ++i) { rank[i] = 0;
#pragma unroll
            for (int i2 = 0; i2 < 8; ++i2) if (i2 != i) { const int e1 = (i >> 2) * 16 + 4 * kq + (i & 3), e2 = (i2 >> 2) * 16 + 4 * kq + (i2 & 3); rank[i] += (lv[i2] > lv[i] || (lv[i2] == lv[i] && e2 < e1)) ? 1 : 0; } }
#pragma unroll
        for (int dq = 1; dq < 4; ++dq) { const int q2 = kq ^ dq;
#pragma unroll
            for (int i2 = 0; i2 < 8; ++i2) { const float o = __shfl_xor(lv[i2], 16 * dq); const int e2 = (i2 >> 2) * 16 + 4 * q2 + (i2 & 3);
#pragma unroll
                for (int i = 0; i < 8; ++i) { const int e1 = (i >> 2) * 16 + 4 * kq + (i & 3); rank[i] += (o > lv[i] || (o == lv[i] && e2 < e1)) ? 1 : 0; } } }
#pragma unroll
        for (int i = 0; i < 8; ++i) if (rank[i] < 4) { const int e1 = (i >> 2) * 16 + 4 * kq + (i & 3); sel[(w * 16 + m) * 4 + rank[i]] = (f32x2){__builtin_bit_cast(float, e1), lv[i]}; }
        asm volatile("s_waitcnt lgkmcnt(0)" ::: "memory");
        { const int tm = lane >> 2, k = lane & 3; const f32x2 s0 = sel[(w * 16 + tm) * 4 + 0], s1 = sel[(w * 16 + tm) * 4 + 1], s2 = sel[(w * 16 + tm) * 4 + 2], s3 = sel[(w * 16 + tm) * 4 + 3];
          const float p0 = 1.f, p1 = __expf(s1.y - s0.y), p2 = __expf(s2.y - s0.y), p3 = __expf(s3.y - s0.y), ps = (p0 + p1) + (p2 + p3);
          const f32x2 mine = k == 0 ? s0 : (k == 1 ? s1 : (k == 2 ? s2 : s3)); const float pm = (k == 0 ? p0 : (k == 1 ? p1 : (k == 2 ? p2 : p3))) / ps;
          const int e = __builtin_bit_cast(int, mine.x);
          const int lr = __hip_atomic_fetch_add(lcnt + e, 1, __ATOMIC_RELAXED, __HIP_MEMORY_SCOPE_WORKGROUP);
          rec[(w * 16 + tm) * 4 + k] = ((unsigned)e << 16) | (unsigned)lr; recp[(w * 16 + tm) * 4 + k] = pm; }
        __syncthreads();
        if (F.tid < 32) { const int n = lcnt[F.tid]; gbase[F.tid] = n ? (int)atomicAdd(F.ctl + CW_CNT + 64 * F.tid, (unsigned)n) : 0; lcnt[F.tid] = 0; }
        __syncthreads();
        { const unsigned r = rec[F.tid]; const int e = r >> 16, rk = gbase[e] + (int)(r & 0xffffu), tt = blk * 128 + (F.tid >> 2);
          WSP(int, WS_TOK)[(size_t)e * T + rk] = tt; WSP(unsigned, WS_POS)[(size_t)tt * 4 + (F.tid & 3)] = ((unsigned)e << 20) | (unsigned)rk; WSP(float, WS_PROB)[(size_t)tt * 4 + (F.tid & 3)] = recp[F.tid]; }
        __syncthreads();
    }
}
__device__ __forceinline__ void p12_final(Frame& F) {
    moe_tables(F);
    const LAS int* tstart = (const LAS int*)(F.lds + TAB_OFF);
    const float* mod = WSP(float, WS_MOD); const bf16* x1 = WSP(bf16, WS_X1); const bf16* yb = WSP(bf16, WS_YB); const unsigned* pos = WSP(unsigned, WS_POS); const float* prob = WSP(float, WS_PROB);
    const int lane = F.lane, gw = F.vcu * 8 + F.wave, NGW = F.G * 8;
    f32x4 lg[4], lb[4];
#pragma unroll
    for (int j = 0; j < 4; ++j) { lg[j] = *((const f32x4*)F.in[32] + 64 * j + lane); lb[j] = *((const f32x4*)F.in[33] + 64 * j + lane); }
    for (int tb = gw; tb < T; tb += 2 * NGW) {
        unsigned pp[2][4]; float pw[2][4]; u32x2 yw[2][4][4], xw[2][4];
#pragma unroll
        for (int q = 0; q < 2; ++q) { const int t = tb + q * NGW; const u32x4 p4 = *(const u32x4*)(pos + (size_t)t * 4); const f32x4 w4 = *(const f32x4*)(prob + (size_t)t * 4);
            pp[q][0] = p4.x; pp[q][1] = p4.y; pp[q][2] = p4.z; pp[q][3] = p4.w; pw[q][0] = w4[0]; pw[q][1] = w4[1]; pw[q][2] = w4[2]; pw[q][3] = w4[3]; }
#pragma unroll
        for (int q = 0; q < 2; ++q) { const int t = tb + q * NGW;
#pragma unroll
            for (int k = 0; k < 4; ++k) { const int e = pp[q][k] >> 20, rk = pp[q][k] & 0xfffffu; const size_t slot = (size_t)tstart[e] * 256 + rk;
#pragma unroll
                for (int j = 0; j < 4; ++j) yw[q][k][j] = *((const u32x2*)(yb + slot * 1024) + 64 * j + lane); }
#pragma unroll
            for (int j = 0; j < 4; ++j) xw[q][j] = *((const u32x2*)(x1 + (size_t)t * 1024) + 64 * j + lane); }
#pragma unroll
        for (int q = 0; q < 2; ++q) { const int t = tb + q * NGW, b = t >> 12;
            f32x4 v[4]; float s = 0.f;
#pragma unroll
            for (int j = 0; j < 4; ++j) { f32x4 f = (f32x4){0.f, 0.f, 0.f, 0.f};
#pragma unroll
                for (int k = 0; k < 4; ++k) { const u32x2 w = yw[q][k][j]; f += (f32x4){bflo(w.x), bfhi(w.x), bflo(w.y), bfhi(w.y)} * pw[q][k]; }
                const u32x2 w = xw[q][j]; const f32x4 g2 = *((const f32x4*)(mod + b * 6144 + 5120) + 64 * j + lane) + 1.0f;
                v[j] = (f32x4){bflo(w.x), bfhi(w.x), bflo(w.y), bfhi(w.y)} * DN_ALPHA + g2 * f; s += (v[j][0] + v[j][1]) + (v[j][2] + v[j][3]); }
            const float mean = wave_sum(s) * (1.f / 1024.f); float s2 = 0.f;
#pragma unroll
            for (int j = 0; j < 4; ++j) { v[j] = v[j] - mean; s2 += (v[j][0] * v[j][0] + v[j][1] * v[j][1]) + (v[j][2] * v[j][2] + v[j][3] * v[j][3]); }
            const float rstd = 1.f / sqrtf(wave_sum(s2) * (1.f / 1024.f) + LN_EPS);
#pragma unroll
            for (int j = 0; j < 4; ++j) *((f32x4*)(F.out + (size_t)t * 1024) + 64 * j + lane) = v[j] * rstd * lg[j] + lb[j]; }
    }
}

struct Args { const float* in[34]; float* out; unsigned char* ws; int ph_lo, ph_hi; };
__global__ void __launch_bounds__(512, 2) fwd_kernel(Args args) {
    extern __shared__ __attribute__((aligned(16))) unsigned char lds_raw[];
    Frame F;
    F.lds = (LAS unsigned char*)lds_raw; F.MISC = (volatile LAS unsigned*)(F.lds + MISC_OFF);
    F.tid = threadIdx.x; F.lane = F.tid & 63; F.wave = __builtin_amdgcn_readfirstlane(F.tid >> 6);
    F.G = gridDim.x; { const int bx = blockIdx.x; F.vcu = (F.G % 8 == 0) ? (bx % 8) * (F.G / 8) + bx / 8 : bx; }
#pragma unroll
    for (int i = 0; i < 34; ++i) F.in[i] = args.in[i];
    F.out = args.out; F.ws = args.ws; F.ctl = (unsigned*)(args.ws + WS_CTL);
    if (F.tid < 64) F.MISC[F.tid] = 0u;
    __syncthreads();
    XcdBarrier bar; bar.bar = F.ctl + CW_BAR; bar.x = 0; bar.st = nullptr;
    if (MK_N_LAUNCHES == 1) bar = xcd_barrier_post(F.ctl + CW_BAR, F.MISC + 8);
    const int lo = args.ph_lo, hi = args.ph_hi;
#define IN(k) (lo <= (k) && (k) < hi)
#define SEAM(k) do { if (IN(k) && IN((k) + 1)) xcd_barrier(bar); } while (0)

    if (IN(0)) REPS(0) { if (rep_) xcd_barrier(bar);
        for (int j = F.vcu; j < 192; j += F.G) p0_mod_job(F, j);
        for (int j = F.vcu; j < S5G * 8; j += F.G) p0_s5k_job(F, j);
        p0_small_transposes(F);
    }
    SEAM(0);
    if (IN(1)) REPS(1) { if (rep_) xcd_barrier(bar); for (int j = F.vcu; j < S5G * 8; j += F.G) p1_s5w_job(F, j); p1_body(F); }
    SEAM(1);
    if (IN(2)) REPS(2) { if (rep_) xcd_barrier(bar);
        g8::GridOrder S; S.init(T, INC, F.G, (int)blockIdx.x, WSP(bf16, WS_HBF), WSP(bf16, WS_WIN), 1024, 1024);
        EpiInProj E{F.in[5], WSP(bf16, WS_XRNN), WSP(bf16, WS_GY), WSP(bf16, WS_ACAT), WSP(bf16, WS_GATES)};
        g8::gemm_phase<EpiInProj, g8::GridOrder, false, true>(F.lds, 1024, 1024, 1024, S, E);
    }
    SEAM(2);
    if (IN(3)) REPS(3) { if (rep_) xcd_barrier(bar);
        { S5AOrder S{F.G, F.vcu, (const char*)WSP(bf16, WS_ACAT), (const char*)WSP(bf16, WS_WS)}; EpiS5A E{WSP(float, WS_S)};
          g8::gemm_phase<EpiS5A, S5AOrder, false>(F.lds, S5L * 32, S5ROW * 2, S5L * 32, S, E); }
        __syncthreads();
        rglru_phase<0>(F);
    }
    SEAM(3);
    if (IN(4)) REPS(4) { if (rep_) xcd_barrier(bar); p4_carries(F); }
    SEAM(4);
    if (IN(5)) REPS(5) { if (rep_) xcd_barrier(bar);
        { S5COrder S{F.G, F.vcu, (const char*)WSP(bf16, WS_ACAT), (const char*)WSP(bf16, WS_WY)}; EpiS5C E{WSP(bf16, WS_YS)};
          g8::gemm_phase<EpiS5C, S5COrder, false>(F.lds, S5ROW * 2, S5ROW * 2, S5ROW * 2, S, E); }
        __syncthreads();
        rglru_phase<1>(F);
    }
    SEAM(5);
    if (IN(6)) REPS(6) { if (rep_) xcd_barrier(bar);
        g8::GridOrder S; S.init(T, 2048, F.G, (int)blockIdx.x, WSP(bf16, WS_YS), WSP(bf16, WS_WGLU), 512, 512);
        EpiGlu E{WSP(bf16, WS_GATES), WSP(bf16, WS_GB)};
        g8::gemm_phase<EpiGlu, g8::GridOrder, false, true>(F.lds, 512, 512, 512, S, E);
    }
    SEAM(6);
    if (IN(7)) REPS(7) { if (rep_) xcd_barrier(bar);
        g8::GridOrder S; S.init(T, 1024, F.G, (int)blockIdx.x, WSP(bf16, WS_HA), WSP(bf16, WS_WRNN), 1024, 1024);
        EpiRnn E{WSP(bf16, WS_GATES), WSP(bf16, WS_GB), WSP(bf16, WS_MERGED)};
        g8::gemm_phase<EpiRnn, g8::GridOrder, false, true>(F.lds, 1024, 1024, 1024, S, E);
    }
    SEAM(7);
    if (IN(8)) REPS(8) { if (rep_) xcd_barrier(bar);
        g8::GridOrder S; S.init(T, 1024, F.G, (int)blockIdx.x, WSP(bf16, WS_MERGED), WSP(bf16, WS_WOUT), 1024, 1024);
        EpiOut E{F.in[0], WSP(float, WS_MOD), WSP(bf16, WS_V1)};
        g8::gemm_phase<EpiOut, g8::GridOrder, false, true>(F.lds, 1024, 1024, 1024, S, E);
    }
    SEAM(8);
    if (IN(9)) REPS(9) { if (rep_) xcd_barrier(bar); p9_router(F); }
    SEAM(9);
    if (IN(10)) REPS(10) { if (rep_) xcd_barrier(bar);
        moe_tables(F);
        const LAS int* tstart = (const LAS int*)(F.lds + TAB_OFF);
        MoeOrder S{F.G, (int)blockIdx.x, 8, tstart[NE], tstart, tstart + 40, WSP(int, WS_TOK), (const char*)WSP(bf16, WS_H2), (const char*)WSP(bf16, WS_WGU), (size_t)2048 * 1024, 1024, true};
        EpiMoe1 E{F.in[29], WSP(bf16, WS_ACT)};
        g8::gemm_phase<EpiMoe1, MoeOrder, true, true>(F.lds, 1024, 1024, 1024, S, E);
    }
    SEAM(10);
    if (IN(11)) REPS(11) { if (rep_) xcd_barrier(bar);
        moe_tables(F);
        const LAS int* tstart = (const LAS int*)(F.lds + TAB_OFF);
        MoeOrder S{F.G, (int)blockIdx.x, 4, tstart[NE], tstart, tstart + 40, WSP(int, WS_TOK), (const char*)WSP(bf16, WS_ACT), (const char*)WSP(bf16, WS_WD), (size_t)1024 * 1024, 1024, false};
        EpiMoe2 E{F.in[31], WSP(bf16, WS_YB)};
        g8::gemm_phase<EpiMoe2, MoeOrder, false, true>(F.lds, 1024, 1024, 1024, S, E);
    }
    SEAM(11);
    if (IN(12)) REPS(12) { if (rep_) xcd_barrier(bar); p12_final(F); }
#undef IN
#undef SEAM
}

extern "C" void kernel_launch(void* const* d_in, const int* in_sizes, int n_in, void* d_out, int out_size, void* d_ws, size_t ws_size, hipStream_t stream) {
    static int grid = 0;
    if (grid == 0) {
        if (n_in != 34 || in_sizes[0] != T * D || out_size != T * D || ws_size < WS_END) { fprintf(stderr, "kernel_launch: unexpected shapes (n_in %d, ws %zu < %zu)\n", n_in, ws_size, (size_t)WS_END); grid = -1; return; }
        int dev = 0, cus = 0;
        if (hipGetDevice(&dev) != hipSuccess || hipDeviceGetAttribute(&cus, hipDeviceAttributeMultiprocessorCount, dev) != hipSuccess) { grid = -1; return; }
        if (hipFuncSetAttribute((const void*)fwd_kernel, hipFuncAttributeMaxDynamicSharedMemorySize, LDS_BYTES) != hipSuccess) { fprintf(stderr, "kernel_launch: hipFuncSetAttribute failed\n"); grid = -1; return; }
        int per_cu = 0; (void)hipOccupancyMaxActiveBlocksPerMultiprocessor(&per_cu, (const void*)fwd_kernel, 512, LDS_BYTES); (void)hipGetLastError();
        grid = cus;
    }
    if (grid < 0) return;
    (void)hipMemsetAsync((char*)d_ws + WS_CTL, 0, CTL_BYTES, stream);
    Args a{};
    for (int i = 0; i < 34; ++i) a.in[i] = (const float*)d_in[i];
    a.out = (float*)d_out; a.ws = (unsigned char*)d_ws;
    if (MK_N_LAUNCHES == 1) { a.ph_lo = 0; a.ph_hi = N_PHASES; hipLaunchKernelGGL(fwd_kernel, dim3(grid), dim3(512), LDS_BYTES, stream, a); }
    else for (int p = 0; p < N_PHASES; ++p) { a.ph_lo = p; a.ph_hi = p + 1; hipLaunchKernelGGL(fwd_kernel, dim3(grid), dim3(512), LDS_BYTES, stream, a); }
}
```

```cpp
#include <hip/hip_runtime.h>
#include <cstdio>
#include <cstdint>

#ifndef MK_N_LAUNCHES
#define MK_N_LAUNCHES 1
#endif
constexpr int N_PHASES = 13;
#ifndef DUP_PHASE
#define DUP_PHASE -1
#endif
#define REPS(k) for (int rep_ = 0; rep_ < ((DUP_PHASE == (k)) ? 2 : 1); ++rep_)

#define GAS __attribute__((address_space(1)))
#define LAS __attribute__((address_space(3)))
typedef unsigned short bf16;
typedef short bf16x8 __attribute__((ext_vector_type(8)));
typedef float f32x4 __attribute__((ext_vector_type(4)));
typedef float f32x2 __attribute__((ext_vector_type(2)));
typedef unsigned u32x4 __attribute__((ext_vector_type(4)));
typedef unsigned u32x2 __attribute__((ext_vector_type(2)));
typedef GAS unsigned gu32;

constexpr int NB = 8, SEQ = 4096, T = NB * SEQ, D = 1024, INC = 4608, NE = 32, DFF = 1024;
constexpr int S5L = 32, S5G = 32, S5ROW = 128 + S5L * 16  , S5M = T / S5L  , S5CPB = SEQ / S5L  ;
constexpr int RGL = 128, RGC = SEQ / RGL  ;
constexpr float LN_EPS = 1e-5f, DN_ALPHA = 1.189207115002721f;
constexpr int ACT_ROWS = T * 4 + NE * 256;

constexpr size_t MiB = 1u << 20;
constexpr size_t WS_XRNN = 0, WS_GY = 64 * MiB, WS_GATES = 128 * MiB, WS_V1 = 0, WS_ACT = 0;
constexpr size_t WS_HBF = 272 * MiB, WS_HA = 272 * MiB, WS_YS = 336 * MiB, WS_GB = 368 * MiB, WS_MERGED = 432 * MiB, WS_ACAT = 496 * MiB, WS_YB = 272 * MiB;
constexpr size_t WS_X1 = 544 * MiB, WS_H2 = 608 * MiB;
constexpr size_t WS_WGU = 672 * MiB, WS_WD = 800 * MiB, WS_WIN = 864 * MiB, WS_WG = 873 * MiB, WS_WRNN = 874 * MiB, WS_WGLU = 876 * MiB, WS_WOUT = 878 * MiB;
constexpr size_t WS_WS = 880 * MiB, WS_WY = 888 * MiB, WS_S = 908 * MiB;
constexpr size_t WS_MOD = 924 * MiB, WS_AL = 925 * MiB, WS_RGAGG = 926 * MiB, WS_HIN = 928 * MiB, WS_TOK = 929 * MiB, WS_POS = 933 * MiB, WS_PROB = 934 * MiB, WS_CTL = 935 * MiB;
constexpr size_t WS_END = 936 * MiB, CTL_BYTES = 1 * MiB;
static_assert((size_t)ACT_ROWS * DFF * 2 <= 272 * MiB, "act/yb size");
static_assert(WS_ACAT + (size_t)S5G * S5M * S5ROW * 2 <= WS_X1, "acat");
constexpr int CW_BAR = 4096, CW_CNT = 8192  ;

constexpr int LDS_BYTES = 147456, MISC_OFF = LDS_BYTES - 256, TAB_OFF = 131072 + 1024;

__device__ __forceinline__ unsigned f2bf(float f) { unsigned u = __builtin_bit_cast(unsigned, f); return (u + 0x7fffu + ((u >> 16) & 1u)) >> 16; }
typedef __bf16 bf16x2v __attribute__((ext_vector_type(2)));
__device__ __forceinline__ unsigned pk2(float lo, float hi) { const f32x2 v = {lo, hi}; const bf16x2v b = __builtin_convertvector(v, bf16x2v); return __builtin_bit_cast(unsigned, b); }
__device__ __forceinline__ unsigned pk4_fp8(float a, float b, float c, float d) { int w = 0; w = __builtin_amdgcn_cvt_pk_fp8_f32(a, b, w, false); w = __builtin_amdgcn_cvt_pk_fp8_f32(c, d, w, true); return (unsigned)w; }
__device__ __forceinline__ float bflo(unsigned w) { return __builtin_bit_cast(float, w << 16); }
__device__ __forceinline__ float bfhi(unsigned w) { return __builtin_bit_cast(float, w & 0xffff0000u); }
__device__ __forceinline__ float bf1(bf16 h) { return __builtin_bit_cast(float, ((unsigned)h) << 16); }
__device__ __forceinline__ float fast_sigmoid(float x) { return __builtin_amdgcn_rcpf(1.0f + __builtin_amdgcn_exp2f(-1.4426950409f * x)); }
__device__ __forceinline__ float gelu_tanh(float x) { const float u = x + 0.044715f * x * x * x; return x * __builtin_amdgcn_rcpf(1.0f + __builtin_amdgcn_exp2f(-2.3022082f * u)); }
__device__ __forceinline__ float wave_sum(float v) {
#pragma unroll
    for (int o = 1; o < 64; o <<= 1) v += __shfl_xor(v, o);
    return v;
}
__device__ __forceinline__ u32x4 pack8(f32x4 a, f32x4 b) { u32x4 w; w.x = pk2(a[0], a[1]); w.y = pk2(a[2], a[3]); w.z = pk2(b[0], b[1]); w.w = pk2(b[2], b[3]); return w; }
__device__ __forceinline__ void unpack8(u32x4 w, f32x4& a, f32x4& b) { a = (f32x4){bflo(w.x), bfhi(w.x), bflo(w.y), bfhi(w.y)}; b = (f32x4){bflo(w.z), bfhi(w.z), bflo(w.w), bfhi(w.w)}; }

#define XB_TMO      128
#define XB_XCNT(j)  (256  + 64 * (j))
#define XB_XSUB(j)  (1280 + 64 * (j))
#define XB_XGEN(j)  (2304 + 64 * (j))
#define XB_TOP      3328
#define XB_TOPGEN   3392
#define XCD_BAR_WORDS 3456
#define XB_SPIN_CAP (1u << 18)
__device__ __forceinline__ unsigned xb_ld(unsigned* p)              { return __hip_atomic_load(p, __ATOMIC_RELAXED, __HIP_MEMORY_SCOPE_AGENT); }
__device__ __forceinline__ unsigned xb_add(unsigned* p, unsigned v) { return __hip_atomic_fetch_add(p, v, __ATOMIC_RELAXED, __HIP_MEMORY_SCOPE_AGENT); }
__device__ __forceinline__ unsigned xb_xcc_id() { return (unsigned)__builtin_amdgcn_s_getreg((3 << 11) | 20) & 0xFu; }
#define XB_SPIN(cond, bar) do { unsigned _sp = 0; while (cond) { __builtin_amdgcn_s_sleep(1); \
    if ((++_sp & 255u) == 0u) { if (xb_ld(&(bar)[XB_TMO])) break; if (_sp > XB_SPIN_CAP) { atomicAdd(&(bar)[XB_TMO], 1u); break; } } } } while (0)
struct XcdBarrier { unsigned* bar; unsigned x; volatile LAS unsigned* st; };
__device__ __forceinline__ XcdBarrier xcd_barrier_post(unsigned* bar, volatile LAS unsigned* st) {
    XcdBarrier b; b.bar = bar; b.x = xb_xcc_id(); b.st = st;
    if (threadIdx.x == 0) (void)xb_add(&bar[XB_XCNT(b.x)], 1u);
    return b;
}
__device__ __forceinline__ void xcd_barrier_complete(unsigned* bar, unsigned x, unsigned& nloc, unsigned& nx) {
    const unsigned G = gridDim.x * gridDim.y * gridDim.z;
    unsigned sum, cnt, mine, sp = 0u;
    for (;;) {
        sum = 0u; cnt = 0u; mine = 0u;
#pragma unroll
        for (unsigned j = 0; j < 16; ++j) { const unsigned c = xb_ld(&bar[XB_XCNT(j)]); sum += c; cnt += (c > 0u) ? 1u : 0u; mine = (j == x) ? c : mine; }
        if (sum == G) break;
        __builtin_amdgcn_s_sleep(1);
        if ((++sp & 255u) == 0u) { if (xb_ld(&bar[XB_TMO])) break; if (sp > XB_SPIN_CAP) { atomicAdd(&bar[XB_TMO], 1u); break; } }
    }
    nloc = mine > 0u ? mine : 1u; nx = cnt > 0u ? cnt : 1u;
}
__device__ __forceinline__ void xcd_barrier(const XcdBarrier& b) {
    asm volatile("s_waitcnt vmcnt(0)" ::: "memory");
    __syncthreads();
    if (threadIdx.x == 0) {
        unsigned* bar = b.bar;
        __builtin_amdgcn_s_waitcnt(0);
        unsigned nloc = b.st[0], nx = b.st[1];
        if (nloc == 0u) { xcd_barrier_complete(bar, b.x, nloc, nx); b.st[0] = nloc; b.st[1] = nx; }
        const unsigned old = xb_add(&bar[XB_XSUB(b.x)], 1u);
        const unsigned gen = old / nloc;
        if (old + 1u == (gen + 1u) * nloc) {
            __builtin_amdgcn_fence(__ATOMIC_RELEASE, "agent");
            asm volatile("s_waitcnt vmcnt(0)" ::: "memory");
            const unsigned og = xb_add(&bar[XB_TOP], 1u);
            const unsigned tg = og / nx;
            if (og + 1u == (tg + 1u) * nx) xb_add(&bar[XB_TOPGEN], 1u);
            else XB_SPIN(xb_ld(&bar[XB_TOPGEN]) == tg, bar);
            __builtin_amdgcn_fence(__ATOMIC_ACQUIRE, "agent");
            xb_add(&bar[XB_XGEN(b.x)], 1u);
            asm volatile("s_waitcnt vmcnt(0)" ::: "memory");
        } else {
            XB_SPIN(xb_ld(&bar[XB_XGEN(b.x)]) == gen, bar);
            __builtin_amdgcn_fence(__ATOMIC_ACQUIRE, "agent");
            asm volatile("s_waitcnt vmcnt(0)" ::: "memory");
        }
    }
    __syncthreads();
}

namespace g8 {
constexpr int BM = 256, BK = 64, HALF = 128, HTB = HALF * BK * 2, STAGE_BYTES = 8 * HTB;
__device__ __forceinline__ int lds_byte(int r, int c) { const int st = (r >> 4) * 2 + (c >> 5), rr = r & 15, cc = c & 31, ob = rr * 64 + cc * 2; return st * 1024 + (ob ^ (((ob >> 9) & 1) << 5)); }
__device__ __forceinline__ void stage_rc(int b, int& R, int& C) { const int st = b / 1024, sb = b % 1024, swz = sb ^ (((sb >> 9) & 1) << 5); R = (st >> 1) * 16 + swz / 64; C = (st & 1) * 32 + (swz % 64) / 2; }
__device__ __forceinline__ int perm32(int rho) { const int n = rho >> 4, i = rho & 15; return 8 * (i >> 2) + 4 * n + (i & 3); }

struct Unit { int pm, pn, z, rl; const char* A; const char* B; };

typedef int v8i __attribute__((ext_vector_type(8)));
typedef int v4i __attribute__((ext_vector_type(4)));
typedef short s16x16 __attribute__((ext_vector_type(16)));
typedef s16x16 s16x16_a16 __attribute__((aligned(16)));
__device__ __forceinline__ v8i cat8(bf16x8 lo, bf16x8 hi) { const v4i a = __builtin_bit_cast(v4i, lo), b = __builtin_bit_cast(v4i, hi); return __builtin_shufflevector(a, b, 0, 1, 2, 3, 4, 5, 6, 7); }
template <class Epi, class Sched, bool GATHER, bool FP8 = false>
__device__ __forceinline__ void gemm_phase(LAS unsigned char* lds, const int Kb, const int ldaB, const int ldbB, const Sched& S, const Epi& E) {
    const int tid = threadIdx.x, wid = __builtin_amdgcn_readfirstlane(tid >> 6), lane = tid & 63, wr = wid >> 2, wc = wid & 3, fr = lane & 15, fq = lane >> 4;
    const int nt = Kb / 128;
    unsigned voffB[2], cvo[2][2], nvo[2][2]; int Rr[2], Cc[2];
#pragma unroll
    for (int i = 0; i < 2; ++i) { int R, C; stage_rc(tid * 16 + i * 8192, R, C); const int Rb = (R & ~31) + perm32(R & 31);
        voffB[i] = (unsigned)(Rb * ldbB + C * 2); Rr[i] = R; Cc[i] = C;
#pragma unroll
        for (int h = 0; h < 2; ++h) { cvo[h][i] = (unsigned)((h * HALF + R) * ldaB + C * 2); nvo[h][i] = cvo[h][i]; } }
    const size_t kstep = (size_t)(BK * 2);
    const size_t hstepB = (size_t)HALF * ldbB;
    const unsigned ldsw = (unsigned)wid * 1024u;
    const int aoff = FP8 ? lds_byte(wr * 64 + fr, (fq >> 1) * 32 + (fq & 1) * 24) : lds_byte(wr * 64 + fr, fq * 8), boff = FP8 ? lds_byte(wc * 32 + fr, (fq >> 1) * 32 + (fq & 1) * 24) : lds_byte(wc * 32 + fr, fq * 8);
    const int aoff2 = FP8 ? lds_byte(wr * 64 + fr, (fq >> 1) * 32 + 8 + (fq & 1) * 8) : 0, boff2 = FP8 ? lds_byte(wc * 32 + fr, (fq >> 1) * 32 + 8 + (fq & 1) * 8) : 0;
#define G8_SA(b, h) (((b) * 2 + (h)) * HTB)
#define G8_SB(b, h) ((4 + (b) * 2 + (h)) * HTB)
#define G8_STGB(bufoff, gbase) do { _Pragma("unroll") for (int _i = 0; _i < 2; ++_i) \
        __builtin_amdgcn_global_load_lds((const unsigned*)((const char*)(gbase) + voffB[_i]), (LAS unsigned*)(lds + (bufoff) + ldsw + _i * 8192), 16, 0, 0); } while (0)
#define G8_STGA(bufoff, gbase, VO, h) do { _Pragma("unroll") for (int _i = 0; _i < 2; ++_i) \
        __builtin_amdgcn_global_load_lds((const unsigned*)((const char*)(gbase) + VO[h][_i]), (LAS unsigned*)(lds + (bufoff) + ldsw + _i * 8192), 16, 0, 0); } while (0)
#define G8_LDA(dst, b, h) do { _Pragma("unroll") for (int m = 0; m < 4; ++m) { if constexpr (FP8) { dst##8[m] = cat8(*(const LAS bf16x8*)(lds + G8_SA(b, h) + aoff + m * 2048), *(const LAS bf16x8*)(lds + G8_SA(b, h) + aoff2 + m * 2048)); } \
        else { _Pragma("unroll") for (int k = 0; k < 2; ++k) dst[m][k] = *(const LAS bf16x8*)(lds + G8_SA(b, h) + aoff + m * 2048 + k * 1024); } } } while (0)
#define G8_LDB(dst, b, h) do { _Pragma("unroll") for (int n = 0; n < 2; ++n) { if constexpr (FP8) { dst##8[n] = cat8(*(const LAS bf16x8*)(lds + G8_SB(b, h) + boff + n * 2048), *(const LAS bf16x8*)(lds + G8_SB(b, h) + boff2 + n * 2048)); } \
        else { _Pragma("unroll") for (int k = 0; k < 2; ++k) dst[n][k] = *(const LAS bf16x8*)(lds + G8_SB(b, h) + boff + n * 2048 + k * 1024); } } } while (0)
#define G8_MMA(ai, bj, At, Bt) do { __builtin_amdgcn_s_setprio(1); _Pragma("unroll") for (int m = 0; m < 4; ++m) _Pragma("unroll") for (int n = 0; n < 2; ++n) { \
        if constexpr (FP8) asm volatile("s_nop 1\n\tv_mfma_scale_f32_16x16x128_f8f6f4 %0, %1, %2, %0, %3, %4 op_sel_hi:[0,0,0]" : "+v"(acc[ai][bj][m][n]) : "v"(Bt##8[n]), "v"(At##8[m]), "v"(sc_w), "v"(sc_a)); \
        else { _Pragma("unroll") for (int k = 0; k < 2; ++k) acc[ai][bj][m][n] = __builtin_amdgcn_mfma_f32_16x16x32_bf16(Bt[n][k], At[m][k], acc[ai][bj][m][n], 0, 0, 0); } } __builtin_amdgcn_s_setprio(0); } while (0)
#define G8_WAIT_V(n) asm volatile("s_waitcnt vmcnt(" #n ")" ::: "memory")
#define G8_WAIT_L(n) asm volatile("s_waitcnt lgkmcnt(" #n ")" ::: "memory")
#define G8_BAR __builtin_amdgcn_s_barrier()
#define G8_SCHED __builtin_amdgcn_sched_barrier(0)
    Unit cur, nxt; int ui = 0;
    if (!S.next(0, cur)) return;
    bool has_next = S.next(1, nxt);
    if constexpr (GATHER) { S.gather(cur, Rr, Cc, cvo); if (has_next) S.gather(nxt, Rr, Cc, nvo); else {
#pragma unroll
        for (int h = 0; h < 2; ++h)
#pragma unroll
            for (int i = 0; i < 2; ++i) nvo[h][i] = cvo[h][i]; } }
    f32x4 acc[2][2][4][2];
#pragma unroll
    for (int a = 0; a < 2; ++a)
#pragma unroll
        for (int b = 0; b < 2; ++b)
#pragma unroll
            for (int m = 0; m < 4; ++m)
#pragma unroll
                for (int n = 0; n < 2; ++n) acc[a][b][m][n] = (f32x4){0.f, 0.f, 0.f, 0.f};
    const int sc_w = 0x7a7a7a7a, sc_a = 0x7f7f7f7f;
    bf16x8 At[4][2], B0[2][2], B1[2][2]; v8i At8[4], B08[2], B18[2];
    const char* cA = cur.A; const char* cB = cur.B;
    G8_STGB(G8_SB(0, 0), cB); G8_STGB(G8_SB(0, 1), cB + hstepB); G8_STGA(G8_SA(0, 0), cA, cvo, 0); G8_STGA(G8_SA(0, 1), cA, cvo, 1);
    if (wr == 1) G8_BAR;
    G8_WAIT_V(2); G8_BAR;
    G8_STGB(G8_SB(1, 0), cB + kstep); G8_STGA(G8_SA(1, 0), cA + kstep, cvo, 0); G8_STGB(G8_SB(1, 1), cB + hstepB + kstep);
    G8_WAIT_V(6); G8_BAR;
    for (;;) {
        const char* nA = has_next ? nxt.A : cA; const char* nB = has_next ? nxt.B : cB;
        for (int t = 0; t < nt; t += 2) {
            const bool last = (t == nt - 2);
            const char* a1 = cA + (size_t)(t + 1) * kstep;
            const char* a2 = last ? nA : cA + (size_t)(t + 2) * kstep; const char* b2 = last ? nB : cB + (size_t)(t + 2) * kstep;
            const char* a3 = a2 + kstep; const char* b3 = b2 + kstep;
            unsigned vo2[2][2];
#pragma unroll
            for (int h = 0; h < 2; ++h)
#pragma unroll
                for (int i = 0; i < 2; ++i) vo2[h][i] = (GATHER && last) ? nvo[h][i] : cvo[h][i];
            G8_LDB(B0, 0, 0); G8_LDB(B1, 0, 1); G8_SCHED; G8_LDA(At, 0, 0); G8_STGA(G8_SA(1, 1), a1, cvo, 1);
            G8_WAIT_V(8); G8_WAIT_L(0); G8_BAR; G8_SCHED; G8_MMA(0, 0, At, B0); G8_MMA(0, 1, At, B1); G8_SCHED; G8_BAR; G8_SCHED;
            G8_LDA(At, 0, 1); G8_STGB(G8_SB(0, 0), b2); G8_STGB(G8_SB(0, 1), b2 + hstepB); G8_STGA(G8_SA(0, 0), a2, vo2, 0);
            G8_WAIT_V(8); G8_WAIT_L(0); G8_BAR; G8_SCHED; G8_MMA(1, 0, At, B0); G8_MMA(1, 1, At, B1); G8_SCHED; G8_BAR; G8_SCHED;
            G8_LDB(B0, 1, 0); G8_LDB(B1, 1, 1); G8_SCHED; G8_LDA(At, 1, 0); G8_STGA(G8_SA(0, 1), a2, vo2, 1);
            G8_WAIT_V(8); G8_WAIT_L(0); G8_BAR; G8_SCHED; G8_MMA(0, 0, At, B0); G8_MMA(0, 1, At, B1); G8_SCHED; G8_BAR; G8_SCHED;
            G8_LDA(At, 1, 1); G8_STGB(G8_SB(1, 0), b3); G8_STGB(G8_SB(1, 1), b3 + hstepB); G8_STGA(G8_SA(1, 0), a3, vo2, 0);
            G8_WAIT_V(8); G8_WAIT_L(0); G8_BAR; G8_SCHED; G8_MMA(1, 0, At, B0); G8_MMA(1, 1, At, B1); G8_SCHED; G8_BAR; G8_SCHED;
        }
        if (wr == 0) G8_BAR;
        Unit nn; bool has_nn = false;
        if (has_next) has_nn = S.next(ui + 2, nn);
        unsigned nnvo[2][2];
        if constexpr (GATHER) { if (has_nn) S.gather(nn, Rr, Cc, nnvo); }
        if constexpr (FP8) asm volatile("s_nop 15\n\ts_nop 15" ::: "memory");
        E(acc, cur, wr, wc, fr, fq);
        if (!has_next) break;
#pragma unroll
        for (int a = 0; a < 2; ++a)
#pragma unroll
            for (int b = 0; b < 2; ++b)
#pragma unroll
                for (int m = 0; m < 4; ++m)
#pragma unroll
                    for (int n = 0; n < 2; ++n) acc[a][b][m][n] = (f32x4){0.f, 0.f, 0.f, 0.f};
        cur = nxt; cA = nA; cB = nB; ++ui;
        if constexpr (GATHER) {
#pragma unroll
            for (int h = 0; h < 2; ++h)
#pragma unroll
                for (int i = 0; i < 2; ++i) { cvo[h][i] = nvo[h][i]; if (has_nn) nvo[h][i] = nnvo[h][i]; } }
        nxt = nn; has_next = has_nn;
        if (wr == 1) G8_BAR;
    }
    G8_WAIT_V(0);
    G8_BAR;
#undef G8_SA
#undef G8_SB
#undef G8_STGB
#undef G8_STGA
#undef G8_LDA
#undef G8_LDB
#undef G8_MMA
#undef G8_WAIT_V
#undef G8_WAIT_L
#undef G8_BAR
#undef G8_SCHED
}

struct GridOrder {
    int nM, nN, nwg, G, c; const char* A; const char* B; size_t tstepA, tstepB;
    __device__ __forceinline__ void init(int M, int N, int G_, int c_, const void* A_, const void* B_, int ldaB, int ldbB) { nM = M / BM; nN = N / BM; nwg = nM * nN; G = G_; c = c_; A = (const char*)A_; B = (const char*)B_; tstepA = (size_t)BM * ldaB; tstepB = (size_t)BM * ldbB; }
    __device__ __forceinline__ bool next(int i, Unit& u) const {
        const long L = (long)i * G + c; if (L >= nwg) return false;
        int wgid = (int)L; { const int q = nwg / 8, r = nwg % 8, xcd = wgid % 8, off = wgid / 8; wgid = (xcd < r ? xcd * (q + 1) : r * (q + 1) + (xcd - r) * q) + off; }
        const int nig = 8 * nN, gid = wgid / nig, fm = gid * 8, gsz = (nM - fm) < 8 ? (nM - fm) : 8;
        u.pm = fm + ((wgid % nig) % gsz); u.pn = (wgid % nig) / gsz; u.z = 0; u.rl = 0;
        u.A = A + (size_t)u.pm * tstepA; u.B = B + (size_t)u.pn * tstepB; return true;
    }
};
}

struct Frame {
    LAS unsigned char* lds; volatile LAS unsigned* MISC; unsigned* ctl;
    int tid, lane, wave, vcu, G;
    const float* in[34]; float* out; unsigned char* ws;
};
#define WSP(T_, off) ((T_*)(F.ws + (off)))

struct EpiInProj {
    const float* bias; bf16 *xrnn, *gy, *acat, *gates;
    __device__ __forceinline__ void operator()(const f32x4 (&acc)[2][2][4][2], const g8::Unit& u, int wr, int wc, int fr, int fq) const {
        const int pn = u.pn, colb = pn * 256 + wc * 32 + 8 * fq;
        f32x4 bv[2][2];
#pragma unroll
        for (int bj = 0; bj < 2; ++bj)
#pragma unroll
            for (int n = 0; n < 2; ++n) bv[bj][n] = *(const f32x4*)(bias + colb + bj * 128 + 4 * n);
#pragma unroll
        for (int ai = 0; ai < 2; ++ai)
#pragma unroll
            for (int m = 0; m < 4; ++m) { const int t = u.pm * 256 + ai * 128 + wr * 64 + m * 16 + fr;
#pragma unroll
                for (int bj = 0; bj < 2; ++bj) { f32x4 v0 = acc[ai][bj][m][0] + bv[bj][0], v1 = acc[ai][bj][m][1] + bv[bj][1]; const int col = colb + bj * 128;
                    if (pn < 4) { *(u32x4*)(xrnn + (size_t)t * 1024 + col) = pack8(v0, v1); }
                    else if (pn < 8) {
#pragma unroll
                        for (int j = 0; j < 4; ++j) { v0[j] = gelu_tanh(v0[j]); v1[j] = gelu_tanh(v1[j]); }
                        *(u32x4*)(gy + (size_t)t * 1024 + (col - 1024)) = pack8(v0, v1); }
                    else if (pn < 10) { const int cu = col - 2048, g = cu >> 4, c = cu & 15;
                        *(u32x4*)(acat + ((size_t)(g * S5M + (t >> 5)) * S5ROW + 128 + (t & 31) * 16 + c)) = pack8(v0, v1); }
                    else {
#pragma unroll
                        for (int j = 0; j < 4; ++j) { v0[j] = fast_sigmoid(v0[j]); v1[j] = fast_sigmoid(v1[j]); }
                        *(u32x4*)(gates + (size_t)t * 2048 + (col - 2560)) = pack8(v0, v1); } } }
    }
};
struct EpiS5A {
    float* S;
    __device__ __forceinline__ void operator()(const f32x4 (&acc)[2][2][4][2], const g8::Unit& u, int wr, int wc, int fr, int fq) const {
        const int col = wc * 32 + 8 * fq;
#pragma unroll
        for (int ai = 0; ai < 2; ++ai)
#pragma unroll
            for (int m = 0; m < 4; ++m) { const int row = u.pm * 256 + ai * 128 + wr * 64 + m * 16 + fr; float* p = S + ((size_t)(u.z * S5M + row)) * 128 + col;
                *(f32x4*)p = acc[ai][0][m][0]; *(f32x4*)(p + 4) = acc[ai][0][m][1]; }
    }
};
struct EpiS5C {
    bf16* ys;
    __device__ __forceinline__ void operator()(const f32x4 (&acc)[2][2][4][2], const g8::Unit& u, int wr, int wc, int fr, int fq) const {
#pragma unroll
        for (int ai = 0; ai < 2; ++ai)
#pragma unroll
            for (int m = 0; m < 4; ++m) { const int row = u.pm * 256 + ai * 128 + wr * 64 + m * 16 + fr;
#pragma unroll
                for (int bj = 0; bj < 2; ++bj) { const int n = u.pn * 256 + bj * 128 + wc * 32 + 8 * fq, i = n >> 4, c = n & 15; f32x4 v0 = acc[ai][bj][m][0], v1 = acc[ai][bj][m][1];
#pragma unroll
                    for (int j = 0; j < 4; ++j) { v0[j] = gelu_tanh(v0[j]); v1[j] = gelu_tanh(v1[j]); }
                    u32x2 w8; w8.x = pk4_fp8(v0[0], v0[1], v0[2], v0[3]); w8.y = pk4_fp8(v1[0], v1[1], v1[2], v1[3]); *(u32x2*)((unsigned char*)ys + (size_t)(row * 32 + i) * 512 + u.z * 16 + c) = w8; } }
    }
};
struct EpiGlu {
    const bf16* gates; bf16* gb;
    __device__ __forceinline__ void operator()(const f32x4 (&acc)[2][2][4][2], const g8::Unit& u, int wr, int wc, int fr, int fq) const {
        const int f = u.pn * 128 + wc * 32 + 8 * fq;
#pragma unroll
        for (int ai = 0; ai < 2; ++ai)
#pragma unroll
            for (int m = 0; m < 4; ++m) { const int t = u.pm * 256 + ai * 128 + wr * 64 + m * 16 + fr;
                const u32x4 gw = *(const u32x4*)(gates + (size_t)t * 2048 + 1024 + f); f32x4 g0, g1; unpack8(gw, g0, g1);
                f32x4 v0 = acc[ai][0][m][0], v1 = acc[ai][0][m][1]; const f32x4 s0 = acc[ai][1][m][0], s1 = acc[ai][1][m][1];
#pragma unroll
                for (int j = 0; j < 4; ++j) { v0[j] = g0[j] * v0[j] * fast_sigmoid(s0[j]); v1[j] = g1[j] * v1[j] * fast_sigmoid(s1[j]); }
                *(u32x4*)(gb + (size_t)t * 1024 + f) = pack8(v0, v1); }
    }
};
struct EpiRnn {
    const bf16* gates; const bf16* gb; bf16* merged;
    __device__ __forceinline__ void operator()(const f32x4 (&acc)[2][2][4][2], const g8::Unit& u, int wr, int wc, int fr, int fq) const {
#pragma unroll
        for (int ai = 0; ai < 2; ++ai)
#pragma unroll
            for (int m = 0; m < 4; ++m) { const int t = u.pm * 256 + ai * 128 + wr * 64 + m * 16 + fr;
#pragma unroll
                for (int bj = 0; bj < 2; ++bj) { const int col = u.pn * 256 + bj * 128 + wc * 32 + 8 * fq;
                    const u32x4 gw = *(const u32x4*)(gates + (size_t)t * 2048 + col), bw = *(const u32x4*)(gb + (size_t)t * 1024 + col);
                    f32x4 g0, g1, b0, b1; unpack8(gw, g0, g1); unpack8(bw, b0, b1);
                    const f32x4 v0 = g0 * acc[ai][bj][m][0] + b0, v1 = g1 * acc[ai][bj][m][1] + b1;
                    u32x2 w8; w8.x = pk4_fp8(v0[0], v0[1], v0[2], v0[3]); w8.y = pk4_fp8(v1[0], v1[1], v1[2], v1[3]); *(u32x2*)((unsigned char*)merged + (size_t)t * 1024 + col) = w8; } }
    }
};
struct EpiOut {
    const float* x; const float* mod; bf16* v1;
    __device__ __forceinline__ void operator()(const f32x4 (&acc)[2][2][4][2], const g8::Unit& u, int wr, int wc, int fr, int fq) const {
        const int b = (u.pm * 256) >> 12;
#pragma unroll
        for (int bj = 0; bj < 2; ++bj) { const int col = u.pn * 256 + bj * 128 + wc * 32 + 8 * fq;
            const f32x4 ga = *(const f32x4*)(mod + b * 6144 + 2048 + col) + 1.0f, gb_ = *(const f32x4*)(mod + b * 6144 + 2048 + col + 4) + 1.0f;
#pragma unroll
            for (int ai = 0; ai < 2; ++ai)
#pragma unroll
                for (int m = 0; m < 4; ++m) { const int t = u.pm * 256 + ai * 128 + wr * 64 + m * 16 + fr;
                    const f32x4 x0 = *(const f32x4*)(x + (size_t)t * 1024 + col), x1 = *(const f32x4*)(x + (size_t)t * 1024 + col + 4);
                    const f32x4 v0 = x0 * DN_ALPHA + ga * acc[ai][bj][m][0], v1_ = x1 * DN_ALPHA + gb_ * acc[ai][bj][m][1];
                    *(u32x4*)(v1 + (size_t)t * 1024 + col) = pack8(v0, v1_); } }
    }
};
struct EpiMoe1 {
    const float* bgu; bf16* act;
    __device__ __forceinline__ void operator()(const f32x4 (&acc)[2][2][4][2], const g8::Unit& u, int wr, int wc, int fr, int fq) const {
        const int f = u.pn * 128 + wc * 32 + 8 * fq; const float* bp = bgu + (size_t)u.z * 2048 + f;
        const f32x4 bg0 = *(const f32x4*)bp, bg1 = *(const f32x4*)(bp + 4), bu0 = *(const f32x4*)(bp + 1024), bu1 = *(const f32x4*)(bp + 1028);
#pragma unroll
        for (int ai = 0; ai < 2; ++ai)
#pragma unroll
            for (int m = 0; m < 4; ++m) { const int row = u.pm * 256 + ai * 128 + wr * 64 + m * 16 + fr;
                f32x4 g0 = acc[ai][0][m][0] + bg0, g1 = acc[ai][0][m][1] + bg1, u0 = acc[ai][1][m][0] + bu0, u1 = acc[ai][1][m][1] + bu1;
#pragma unroll
                for (int j = 0; j < 4; ++j) { const float ga = fminf(g0[j], 7.0f), gb_ = fminf(g1[j], 7.0f), ua = fminf(fmaxf(u0[j], -7.0f), 7.0f), ub = fminf(fmaxf(u1[j], -7.0f), 7.0f);
                    g0[j] = ga * fast_sigmoid(1.702f * ga) * (ua + 1.0f); g1[j] = gb_ * fast_sigmoid(1.702f * gb_) * (ub + 1.0f); }
                u32x2 w8; w8.x = pk4_fp8(g0[0], g0[1], g0[2], g0[3]); w8.y = pk4_fp8(g1[0], g1[1], g1[2], g1[3]); *(u32x2*)((unsigned char*)act + (size_t)row * 1024 + f) = w8; }
    }
};
struct EpiMoe2 {
    const float* bd; bf16* yb;
    __device__ __forceinline__ void operator()(const f32x4 (&acc)[2][2][4][2], const g8::Unit& u, int wr, int wc, int fr, int fq) const {
#pragma unroll
        for (int bj = 0; bj < 2; ++bj) { const int col = u.pn * 256 + bj * 128 + wc * 32 + 8 * fq; const float* bp = bd + (size_t)u.z * 1024 + col;
            const f32x4 b0 = *(const f32x4*)bp, b1 = *(const f32x4*)(bp + 4);
#pragma unroll
            for (int ai = 0; ai < 2; ++ai)
#pragma unroll
                for (int m = 0; m < 4; ++m) { const int row = u.pm * 256 + ai * 128 + wr * 64 + m * 16 + fr;
                    const f32x4 y0 = acc[ai][bj][m][0] + b0, y1 = acc[ai][bj][m][1] + b1; u32x2 w8; w8.x = pk4_fp8(y0[0], y0[1], y0[2], y0[3]); w8.y = pk4_fp8(y1[0], y1[1], y1[2], y1[3]);
                    *(u32x2*)((unsigned char*)yb + (size_t)row * 1024 + col) = w8; } }
    }
};

struct S5AOrder { int G, c; const char* acat; const char* ws;
    __device__ __forceinline__ bool next(int i, g8::Unit& u) const { const int L = i * G + c; if (L >= S5G * 4) return false; u.z = L >> 2; u.pm = L & 3; u.pn = 0; u.rl = 0;
        u.A = acat + ((size_t)(u.z * S5M + u.pm * 256) * S5ROW + 128) * 2; u.B = ws + (size_t)u.z * 256 * (S5L * 16) * 2; return true; } };
struct S5COrder { int G, c; const char* acat; const char* wy;
    __device__ __forceinline__ bool next(int i, g8::Unit& u) const { const int L = i * G + c; if (L >= S5G * 8) return false; u.z = L >> 3; u.pm = (L >> 1) & 3; u.pn = L & 1; u.rl = 0;
        u.A = acat + ((size_t)(u.z * S5M + u.pm * 256) * S5ROW) * 2; u.B = wy + ((size_t)(u.z * 512 + u.pn * 256) * S5ROW) * 2; return true; } };
struct MoeOrder { int G, c, NT, RT; const LAS int* tstart; const LAS int* cnt; const int* toklist; const char* A; const char* B; size_t bstride_e; int lda; bool gatherA;
    __device__ __forceinline__ bool next(int i, g8::Unit& u) const { const int per = G >> 3, xcd = c & 7, slot = c >> 3, rpx = per / NT;
        const int rt = (i * 8 + xcd) * rpx + slot / NT; if (rt >= RT) return false; u.pn = slot % NT;
        int e = 0;
#pragma unroll 1
        for (int k = 1; k < NE; ++k) if (tstart[k] <= rt) e = k;
        u.z = e; u.pm = rt; u.rl = rt - tstart[e]; u.B = B + (size_t)e * bstride_e + (size_t)u.pn * 256 * 1024; u.A = gatherA ? A : A + (size_t)rt * 256 * 1024; return true; }
    __device__ __forceinline__ void gather(const g8::Unit& u, const int (&Rr)[2], const int (&Cc)[2], unsigned (&vo)[2][2]) const {
        const int n = cnt[u.z];
#pragma unroll
        for (int h = 0; h < 2; ++h)
#pragma unroll
            for (int i = 0; i < 2; ++i) { const int r = u.rl * 256 + h * 128 + Rr[i]; const int tok = r < n ? toklist[u.z * T + r] : 0; vo[h][i] = (unsigned)(tok * lda + Cc[i] * 2); } }
};

__device__ __forceinline__ void transpose_item(const float* W, int N, int k0, int n0, bf16* dst, int ldd, int drow0, LAS float* scr, int lane) {
#pragma unroll 8
    for (int i = 0; i < 32; ++i) { const int kk = 2 * i + (lane >> 5); scr[kk * 33 + (lane & 31)] = W[(size_t)(k0 + kk) * N + n0 + (lane & 31)]; }
    asm volatile("s_waitcnt lgkmcnt(0)" ::: "memory");
    const int c = lane & 7;
#pragma unroll
    for (int j = 0; j < 4; ++j) { const int n = (lane >> 3) + 8 * j; const LAS float* s = scr + (8 * c) * 33 + n;
        u32x4 o; o.x = pk2(s[0 * 33], s[1 * 33]); o.y = pk2(s[2 * 33], s[3 * 33]); o.z = pk2(s[4 * 33], s[5 * 33]); o.w = pk2(s[6 * 33], s[7 * 33]);
        *(u32x4*)(dst + (size_t)(drow0 + n) * ldd + k0 + 8 * c) = o; }
    asm volatile("s_waitcnt lgkmcnt(0)" ::: "memory");
}
__device__ __forceinline__ void transpose_item8(const float* W, int N, int k0, int n0, unsigned char* dst, int ldd, int drow0, LAS float* scr, int lane) {
#pragma unroll 8
    for (int i = 0; i < 32; ++i) { const int kk = 2 * i + (lane >> 5); scr[kk * 33 + (lane & 31)] = W[(size_t)(k0 + kk) * N + n0 + (lane & 31)]; }
    asm volatile("s_waitcnt lgkmcnt(0)" ::: "memory");
    const int c = lane & 7;
#pragma unroll
    for (int j = 0; j < 4; ++j) { const int n = (lane >> 3) + 8 * j; const LAS float* s = scr + (8 * c) * 33 + n;
        u32x2 o; o.x = pk4_fp8(32.f * s[0 * 33], 32.f * s[1 * 33], 32.f * s[2 * 33], 32.f * s[3 * 33]); o.y = pk4_fp8(32.f * s[4 * 33], 32.f * s[5 * 33], 32.f * s[6 * 33], 32.f * s[7 * 33]);
        *(u32x2*)(dst + (size_t)(drow0 + n) * ldd + k0 + 8 * c) = o; }
    asm volatile("s_waitcnt lgkmcnt(0)" ::: "memory");
}
__device__ __forceinline__ void transpose_item8w(const float* W, int N, int k0, int n0, unsigned char* dst, int ldd, int drow0, LAS float* scr, int lane) {
    float wv[64]; const float* wp = W + (size_t)(k0 + (lane >> 5)) * N + n0 + (lane & 31);
#pragma unroll
    for (int i = 0; i < 64; ++i) wv[i] = wp[(size_t)(2 * i) * N];
#pragma unroll
    for (int i = 0; i < 64; ++i) scr[(2 * i + (lane >> 5)) * 33 + (lane & 31)] = wv[i];
    asm volatile("s_waitcnt lgkmcnt(0)" ::: "memory");
    const int c = lane & 7;
#pragma unroll
    for (int j = 0; j < 4; ++j) { const int n = (lane >> 3) + 8 * j; const LAS float* s = scr + (16 * c) * 33 + n;
        u32x4 o; o.x = pk4_fp8(32.f * s[0 * 33], 32.f * s[1 * 33], 32.f * s[2 * 33], 32.f * s[3 * 33]); o.y = pk4_fp8(32.f * s[4 * 33], 32.f * s[5 * 33], 32.f * s[6 * 33], 32.f * s[7 * 33]);
        o.z = pk4_fp8(32.f * s[8 * 33], 32.f * s[9 * 33], 32.f * s[10 * 33], 32.f * s[11 * 33]); o.w = pk4_fp8(32.f * s[12 * 33], 32.f * s[13 * 33], 32.f * s[14 * 33], 32.f * s[15 * 33]);
        *(u32x4*)(dst + (size_t)(drow0 + n) * ldd + k0 + 16 * c) = o; }
    asm volatile("s_waitcnt lgkmcnt(0)" ::: "memory");
}
__device__ __forceinline__ int pair_row(int n) { const int f = n & 1023, hi = n >> 10; return (f >> 7) * 256 + hi * 128 + (f & 127); }

__device__ __forceinline__ void moe_tables(Frame& F) {
    LAS int* tstart = (LAS int*)(F.lds + TAB_OFF); LAS int* cl = tstart + 40;
    if (F.tid == 0) { int acc = 0; for (int e = 0; e < NE; ++e) { const int c = (int)F.ctl[CW_CNT + 64 * e]; cl[e] = c; tstart[e] = acc; acc += (c + 255) >> 8; } tstart[NE] = acc; }
    __syncthreads();
}

__device__ __forceinline__ void p0_mod_job(Frame& F, int job) {
    LAS float* sc = (LAS float*)F.lds;
    LAS float* red = sc + 8 * 1024;
    const float* c = F.in[1]; const float* w = F.in[2]; const float* bias = F.in[3];
    for (int i = F.tid; i < 8 * 1024; i += 512) { const float v = c[i]; sc[i] = v * fast_sigmoid(v); }
    __syncthreads();
    const int col = F.tid & 31, kg = F.tid >> 5, j = job * 32 + col;
    float a[8];
#pragma unroll
    for (int b = 0; b < 8; ++b) a[b] = 0.f;
#pragma unroll 8
    for (int k = kg * 64; k < kg * 64 + 64; ++k) { const float wv = w[(size_t)k * 6144 + j];
#pragma unroll
        for (int b = 0; b < 8; ++b) a[b] += sc[b * 1024 + k] * wv; }
#pragma unroll
    for (int b = 0; b < 8; ++b) red[(kg * 8 + b) * 32 + col] = a[b];
    __syncthreads();
    if (F.tid < 256) { const int b = F.tid >> 5, cc = F.tid & 31; float s = 0.f;
#pragma unroll
        for (int g = 0; g < 16; ++g) s += red[(g * 8 + b) * 32 + cc];
        WSP(float, WS_MOD)[b * 6144 + job * 32 + cc] = s + bias[job * 32 + cc]; }
    __syncthreads();
}
__device__ __forceinline__ void s5_setup(Frame& F, int g, int kmin, int kmax, LAS f32x2* Bb, LAS f32x2* Cc, LAS f32x2* Ap) {
    const float* lre = F.in[14] + g * 64; const float* lim = F.in[15] + g * 64; const float dt = expf(F.in[16][g]);
    const float* bre = F.in[17] + g * 1024; const float* bim = F.in[18] + g * 1024; const float* cre = F.in[19] + g * 1024; const float* cim = F.in[20] + g * 1024;
    for (int i = F.tid; i < 1024; i += 512) { const int p = i >> 4; const float lr = lre[p], li = lim[p]; const float mag = expf(lr * dt); float sn, cs; sincosf(li * dt, &sn, &cs);
        const float ar = mag * cs, ai = mag * sn, den = lr * lr + li * li, qr = ((ar - 1.f) * lr + ai * li) / den, qi = (ai * lr - (ar - 1.f) * li) / den;
        const float br = bre[i], bi = bim[i]; Bb[i] = (f32x2){qr * br - qi * bi, qr * bi + qi * br};
        Cc[i] = (f32x2){cre[i], cim[i]}; }
    for (int i = kmin * 64 + F.tid; i < (kmax + 1) * 64; i += 512) { const int k = i >> 6, p = i & 63; const float lr = lre[p], li = lim[p]; const float mag = expf((float)k * lr * dt); float sn, cs; sincosf((float)k * li * dt, &sn, &cs);
        Ap[i] = (f32x2){mag * cs, mag * sn}; }
    __syncthreads();
}
constexpr size_t WS_KTAB = WS_S;
constexpr size_t WS_WRIMG = WS_AL + 512 * 1024;
__device__ __forceinline__ void p0_s5k_job(Frame& F, int job) {
    const int g = job >> 3, part = job & 7;
    LAS f32x2* Bb = (LAS f32x2*)F.lds; LAS f32x2* Cc = Bb + 1024; LAS f32x2* Ap = Cc + 1024;
    s5_setup(F, g, 4 * part, 4 * part + 3, Bb, Cc, Ap);
    float* kt = WSP(float, WS_KTAB) + (size_t)g * 32 * 256;
    for (int e = 4 * part * 256 + F.tid; e < (4 * part + 4) * 256; e += 512) { const int k = e >> 8, c = (e >> 4) & 15, c2 = e & 15; float s = 0.f;
        for (int p = 0; p < 64; ++p) { const f32x2 cv = Cc[c * 64 + p], av = Ap[k * 64 + p], bv = Bb[p * 16 + c2];
            const float car = cv.x * av.x - cv.y * av.y, cai = cv.x * av.y + cv.y * av.x; s += car * bv.x - cai * bv.y; }
        kt[e] = s; }
    __syncthreads();
}
__device__ __forceinline__ void p1_s5w_job(Frame& F, int job) {
    const int g = job >> 3, part = job & 7;
    LAS f32x2* Bb = (LAS f32x2*)F.lds; LAS f32x2* Cc = Bb + 1024; LAS f32x2* Ap = Cc + 1024; LAS float* Kt = (LAS float*)(Ap + 33 * 64);
    const float* ktg = WSP(float, WS_KTAB) + (size_t)g * 32 * 256; const float* dsk = F.in[21] + g * 16;
    for (int i = F.tid; i < 32 * 256; i += 512) Kt[i] = ktg[i];
    s5_setup(F, g, 0, S5L, Bb, Cc, Ap);
    if (part == 0 && F.tid < 64) WSP(f32x2, WS_AL)[g * 64 + F.tid] = Ap[S5L * 64 + F.tid];
    bf16* wy = WSP(bf16, WS_WY) + (size_t)g * 512 * S5ROW;
    for (int ch = F.tid; ch < 64 * (S5ROW / 8); ch += 512) { const int n = part * 64 + ch / (S5ROW / 8), k8 = (ch % (S5ROW / 8)) * 8, i = n >> 4, c = n & 15; float v[8];
        if (k8 < 128) {
#pragma unroll
            for (int j = 0; j < 8; j += 2) { const int p = (k8 + j) >> 1; const f32x2 cv = Cc[c * 64 + p], av = Ap[(i + 1) * 64 + p]; v[j] = cv.x * av.x - cv.y * av.y; v[j + 1] = -(cv.x * av.y + cv.y * av.x); } }
        else { const int jj = (k8 - 128) >> 4, c2 = (k8 - 128) & 15;
#pragma unroll
            for (int j = 0; j < 8; ++j) { float x = 0.f; if (jj <= i) { x = Kt[(i - jj) * 256 + c * 16 + c2 + j]; if (jj == i && c == c2 + j) x += dsk[c]; } v[j] = x; } }
        u32x4 o; o.x = pk2(v[0], v[1]); o.y = pk2(v[2], v[3]); o.z = pk2(v[4], v[5]); o.w = pk2(v[6], v[7]);
        *(u32x4*)(wy + (size_t)n * S5ROW + k8) = o; }
    bf16* wsm = WSP(bf16, WS_WS) + (size_t)g * 256 * 512;
    for (int ch = F.tid; ch < 32 * 64; ch += 512) { const int n = part * 32 + (ch >> 6), k8 = (ch & 63) * 8, jj = k8 >> 4, c2 = k8 & 15; float v[8];
#pragma unroll
        for (int j = 0; j < 8; ++j) { float x = 0.f; if (n < 128) { const int p = n >> 1; const f32x2 av = Ap[(S5L - 1 - jj) * 64 + p], bv = Bb[p * 16 + c2 + j]; x = (n & 1) ? (av.x * bv.y + av.y * bv.x) : (av.x * bv.x - av.y * bv.y); } v[j] = x; }
        u32x4 o; o.x = pk2(v[0], v[1]); o.y = pk2(v[2], v[3]); o.z = pk2(v[4], v[5]); o.w = pk2(v[6], v[7]);
        *(u32x4*)(wsm + (size_t)n * 512 + k8) = o; }
    __syncthreads();
}
__device__ __forceinline__ void p0_small_transposes(Frame& F) {
    LAS float* scr = (LAS float*)(F.lds + F.wave * 16384);
    const int gw = F.vcu * 8 + F.wave, NGW = F.G * 8;
    constexpr int I_IN = 16 * 144, I_RNN = 16 * 32, I_OUT = 16 * 32, I_GLU = 8 * 64, I_RG = 16 * 8;
    for (int it = gw; it < I_IN + I_RNN + I_OUT + I_GLU + I_RG; it += NGW) { int r = it;
        if (r < I_IN) { const int kb = r / 144, nb = r % 144; transpose_item8(F.in[4], INC, kb * 64, nb * 32, WSP(unsigned char, WS_WIN), 1024, nb * 32, scr, F.lane); continue; } r -= I_IN;
        if (r < I_RNN) { const int kb = r / 32, nb = r % 32; transpose_item8(F.in[13], 1024, kb * 64, nb * 32, WSP(unsigned char, WS_WRNN), 1024, nb * 32, scr, F.lane); continue; } r -= I_RNN;
        if (r < I_OUT) { const int kb = r / 32, nb = r % 32; transpose_item8(F.in[23], 1024, kb * 64, nb * 32, WSP(unsigned char, WS_WOUT), 1024, nb * 32, scr, F.lane); continue; } r -= I_OUT;
        if (r < I_GLU) { const int kb = r / 64, nb = r % 64; transpose_item8(F.in[22], 2048, kb * 64, nb * 32, WSP(unsigned char, WS_WGLU), 512, pair_row(nb * 32), scr, F.lane); continue; } r -= I_GLU;
        { const int mat = r >> 3, kb = (r >> 2) & 1, nb = r & 3, hd = mat & 7, gx = mat >> 3;
          transpose_item(F.in[gx ? 10 : 8] + (size_t)hd * 128 * 128, 128, kb * 64, nb * 32, WSP(bf16, WS_WG), 128, hd * 256 + gx * 128 + nb * 32, scr, F.lane); }
    }
}
__device__ __forceinline__ void p1_body(Frame& F) {
    const int gw = F.vcu * 8 + F.wave, NGW = F.G * 8; const float* mod = WSP(float, WS_MOD); bf16* hbf = WSP(bf16, WS_HBF);
    for (int tb = gw; tb < T; tb += 4 * NGW) {
        f32x4 xv[4][4];
#pragma unroll
        for (int r = 0; r < 4; ++r) { const int t = tb + r * NGW; const f32x4* xr = (const f32x4*)(F.in[0] + (size_t)(t < T ? t : 0) * 1024) + F.lane;
#pragma unroll
            for (int j = 0; j < 4; ++j) xv[r][j] = xr[64 * j]; }
#pragma unroll
        for (int r = 0; r < 4; ++r) { const int t = tb + r * NGW; if (t < T) { const int b = t >> 12; const f32x4* sh = (const f32x4*)(mod + b * 6144) + F.lane; const f32x4* sc = (const f32x4*)(mod + b * 6144 + 1024) + F.lane;
            unsigned* o = (unsigned*)((unsigned char*)hbf + (size_t)t * 1024) + F.lane;
#pragma unroll
            for (int j = 0; j < 4; ++j) { const f32x4 v = xv[r][j] * (sc[64 * j] + 1.0f) + sh[64 * j]; o[64 * j] = pk4_fp8(v[0], v[1], v[2], v[3]); } } } }
    LAS float* scr = (LAS float*)(F.lds + F.wave * 17408);
    constexpr int I_GU = 8 * 64, I_D = 8 * 32;
    for (int it = gw; it < NE * (I_GU + I_D); it += NGW) { const int e = it / (I_GU + I_D); int r = it % (I_GU + I_D);
        if (r < I_GU) { const int kb = r / 64, nb = r % 64; transpose_item8w(F.in[28] + (size_t)e * 1024 * 2048, 2048, kb * 128, nb * 32, WSP(unsigned char, WS_WGU) + (size_t)e * 2048 * 1024, 1024, pair_row(nb * 32), scr, F.lane); }
        else { r -= I_GU; const int kb = r / 32, nb = r % 32; transpose_item8w(F.in[30] + (size_t)e * 1024 * 1024, 1024, kb * 128, nb * 32, WSP(unsigned char, WS_WD) + (size_t)e * 1024 * 1024, 1024, nb * 32, scr, F.lane); } }
}
constexpr int XR_LD = 136, XR_TILE = 128 * XR_LD;
__device__ __forceinline__ void rg_issue(const bf16* xrnn, const bf16* gy, int item, int tid, u32x4 (&xraw)[4][4], u32x4 (&graw)[4], bool pass1) {
    const int hd = item & 7, c = (item >> 3) & 31, b = item >> 8, r0 = tid >> 4, ch = hd * 128 + (tid & 15) * 8;
#pragma unroll
    for (int q = 0; q < 4; ++q) { const int r = r0 + 32 * q;
#pragma unroll
        for (int k = 0; k < 4; ++k) { const int tp = c * RGL + r - 3 + k, tpc = tp < 0 ? 0 : tp; xraw[q][k] = *(const u32x4*)(xrnn + (size_t)(b * SEQ + tpc) * 1024 + ch); }
        if (pass1) graw[q] = *(const u32x4*)(gy + (size_t)(b * SEQ + c * RGL + r) * 1024 + ch); }
}
__device__ __forceinline__ void rg_convwrite(const float* cw, const float* cb, int item, int tid, const u32x4 (&xraw)[4][4], const u32x4 (&graw)[4], LAS bf16* xr, LAS bf16* gyt, bool pass1) {
    const int hd = item & 7, c = (item >> 3) & 31, r0 = tid >> 4, c8 = (tid & 15) * 8, ch = hd * 128 + c8;
    const f32x4 b0 = *(const f32x4*)(cb + ch), b1 = *(const f32x4*)(cb + ch + 4);
    f32x4 w0[4], w1[4];
#pragma unroll
    for (int k = 0; k < 4; ++k) { w0[k] = *(const f32x4*)(cw + k * 1024 + ch); w1[k] = *(const f32x4*)(cw + k * 1024 + ch + 4); }
#pragma unroll
    for (int q = 0; q < 4; ++q) { const int r = r0 + 32 * q; f32x4 a0 = b0, a1 = b1;
#pragma unroll
        for (int k = 0; k < 4; ++k) { const int tp = c * RGL + r - 3 + k; f32x4 x0, x1; unpack8(xraw[q][k], x0, x1); if (tp < 0) { x0 = (f32x4){0.f, 0.f, 0.f, 0.f}; x1 = x0; } a0 += w0[k] * x0; a1 += w1[k] * x1; }
        *(LAS u32x4*)(xr + r * XR_LD + c8) = pack8(a0, a1);
        if (pass1) *(LAS u32x4*)(gyt + r * XR_LD + c8) = graw[q]; }
}
template <int PASS>
__device__ __forceinline__ void rglru_phase(Frame& F) {
    const int NIT = NB * RGC * 8;
    int it = F.vcu; if (it >= NIT) return;
    LAS bf16* xr = (LAS bf16*)F.lds; LAS bf16* gyt0 = xr + XR_TILE;
    const bf16* xrnn = WSP(bf16, WS_XRNN); const bf16* gy = WSP(bf16, WS_GY); bf16* ha = WSP(bf16, WS_HA); const float* cw = F.in[6]; const float* cb = F.in[7];
    const int tid = F.tid, w = F.wave, q = F.lane >> 4, col = F.lane & 15, chl = 16 * w + col;
    u32x4 xraw[4][4], graw[4];
    rg_issue(xrnn, gy, it, tid, xraw, graw, PASS);
    rg_convwrite(cw, cb, it, tid, xraw, graw, xr, gyt0, PASS);
    int hd_loaded = -1; bf16x8 Bf[2][4]; float ba = 0.f, bx = 0.f, sp = 0.f;
    __syncthreads();
    for (int i = 0; it < NIT; ++i) {
        const int nit = it + F.G; const bool has_next = nit < NIT;
        const int hd = it & 7, c = (it >> 3) & 31, b = it >> 8, t0 = b * SEQ + c * RGL, ch = hd * 128 + chl;
        LAS bf16* gyt = gyt0 + (i & 1) * XR_TILE; LAS bf16* gytn = gyt0 + ((i & 1) ^ 1) * XR_TILE;
        if (has_next) rg_issue(xrnn, gy, nit, tid, xraw, graw, PASS);
        if (hd != hd_loaded) { hd_loaded = hd; const bf16* wg = WSP(bf16, WS_WG) + (size_t)hd * 256 * 128;
#pragma unroll
            for (int gt = 0; gt < 2; ++gt)
#pragma unroll
                for (int kk = 0; kk < 4; ++kk) Bf[gt][kk] = *(const bf16x8*)(wg + (size_t)(gt * 128 + chl) * 128 + kk * 32 + q * 8);
            ba = F.in[9][ch]; bx = F.in[11][ch]; const float lam = F.in[12][ch]; sp = (lam > 15.f) ? __expf(-lam) : log1pf(__expf(-lam)); }
        float carryH = 0.f, carryP = 1.f;
        if (PASS) carryH = WSP(float, WS_HIN)[(size_t)(b * RGC + c) * 1024 + ch];
        __builtin_amdgcn_sched_barrier(0);
        f32x4 acc[8][2];
#pragma unroll
        for (int m = 0; m < 8; ++m) { acc[m][0] = (f32x4){0.f, 0.f, 0.f, 0.f}; acc[m][1] = (f32x4){0.f, 0.f, 0.f, 0.f}; }
#pragma unroll
        for (int kk = 0; kk < 4; ++kk)
#pragma unroll
            for (int m = 0; m < 8; ++m) { const bf16x8 Af = *(const LAS bf16x8*)(xr + (16 * m + col) * XR_LD + kk * 32 + q * 8);
                acc[m][0] = __builtin_amdgcn_mfma_f32_16x16x32_bf16(Af, Bf[0][kk], acc[m][0], 0, 0, 0);
                acc[m][1] = __builtin_amdgcn_mfma_f32_16x16x32_bf16(Af, Bf[1][kk], acc[m][1], 0, 0, 0); }
#pragma unroll
        for (int m = 0; m < 8; ++m) {
            float a[4], uu[4];
#pragma unroll
            for (int j = 0; j < 4; ++j) { const int tl = 16 * m + 4 * q + j;
                const float r = fast_sigmoid(acc[m][0][j] + ba), ii = fast_sigmoid(acc[m][1][j] + bx);
                const float la = -11.541560327f * r * sp; a[j] = __builtin_amdgcn_exp2f(la); const float mult = __builtin_amdgcn_sqrtf(fmaxf(1.0f - a[j] * a[j], 0.f));
                uu[j] = mult * ii * bf1(xr[tl * XR_LD + chl]); }
            float sP = a[0], sH = uu[0];
#pragma unroll
            for (int j = 1; j < 4; ++j) { sH = a[j] * sH + uu[j]; sP *= a[j]; }
            float iP = sP, iH = sH;
            { const float pP = __shfl_up(iP, 16), pH = __shfl_up(iH, 16); if (q >= 1) { iH = iP * pH + iH; iP = iP * pP; } }
            { const float pP = __shfl_up(iP, 32), pH = __shfl_up(iH, 32); if (q >= 2) { iH = iP * pH + iH; iP = iP * pP; } }
            float eP = __shfl_up(iP, 16), eH = __shfl_up(iH, 16); if (q == 0) { eP = 1.f; eH = 0.f; }
            const float tP = __shfl(iP, col + 48), tH = __shfl(iH, col + 48);
            if (PASS) { float h = eP * carryH + eH;
#pragma unroll
                for (int j = 0; j < 4; ++j) { const int tl = 16 * m + 4 * q + j; h = a[j] * h + uu[j]; LAS bf16* gp = gyt + tl * XR_LD + chl; *gp = (bf16)f2bf(h * bf1(*gp)); } }
            carryH = tP * carryH + tH; carryP *= tP;
        }
        if (!PASS && q == 0) { f32x2* ag = WSP(f32x2, WS_RGAGG); ag[(size_t)(b * RGC + c) * 1024 + ch] = (f32x2){carryP, carryH}; }
        __syncthreads();
        if (PASS) { const int r0 = tid >> 4, c8 = (tid & 15) * 8;
#pragma unroll
            for (int qq = 0; qq < 4; ++qq) { const int r = r0 + 32 * qq; f32x4 h0, h1; unpack8(*(const LAS u32x4*)(gyt + r * XR_LD + c8), h0, h1); u32x2 w8; w8.x = pk4_fp8(h0[0], h0[1], h0[2], h0[3]); w8.y = pk4_fp8(h1[0], h1[1], h1[2], h1[3]);
                *(u32x2*)((unsigned char*)ha + (size_t)(t0 + r) * 1024 + hd * 128 + c8) = w8; } }
        if (has_next) rg_convwrite(cw, cb, nit, tid, xraw, graw, xr, gytn, PASS);
        __syncthreads();
        it = nit;
    }
}
__device__ __forceinline__ void p4_carries(Frame& F) {
    LAS f32x2* seg = (LAS f32x2*)F.lds;
    for (int job = F.vcu; job < NB * S5G; job += F.G) {
        const int b = job >> 5, g = job & 31, p = F.lane, w = F.wave;
        const f32x2 al = WSP(f32x2, WS_AL)[g * 64 + p];
        const f32x2* Sb = WSP(f32x2, WS_S) + ((size_t)(g * S5M + b * S5CPB + 16 * w)) * 64 + p; unsigned* ac = (unsigned*)(WSP(bf16, WS_ACAT) + ((size_t)(g * S5M + b * S5CPB + 16 * w)) * S5ROW) + p;
        f32x2 sv[16];
#pragma unroll
        for (int i = 0; i < 16; ++i) sv[i] = Sb[(size_t)i * 64];
        float xr_ = 0.f, xi = 0.f;
#pragma unroll
        for (int i = 0; i < 16; ++i) { const float nr = al.x * xr_ - al.y * xi + sv[i].x, ni = al.x * xi + al.y * xr_ + sv[i].y; xr_ = nr; xi = ni; }
        seg[w * 64 + p] = (f32x2){xr_, xi};
        float ar = al.x, ai = al.y;
#pragma unroll
        for (int q = 0; q < 4; ++q) { const float nr = ar * ar - ai * ai, ni = 2.f * ar * ai; ar = nr; ai = ni; }
        __syncthreads();
        xr_ = 0.f; xi = 0.f;
        for (int ww = 0; ww < w; ++ww) { const f32x2 sg = seg[ww * 64 + p]; const float nr = ar * xr_ - ai * xi + sg.x, ni = ar * xi + ai * xr_ + sg.y; xr_ = nr; xi = ni; }
#pragma unroll
        for (int i = 0; i < 16; ++i) { ac[(size_t)i * (S5ROW / 2)] = pk2(xr_, xi); const float nr = al.x * xr_ - al.y * xi + sv[i].x, ni = al.x * xi + al.y * xr_ + sv[i].y; xr_ = nr; xi = ni; }
        __syncthreads();
    }
    if (F.vcu < 16) {
        const int id = F.vcu * 512 + F.tid, ch = id & 1023, b = id >> 10; const f32x2* ag = WSP(f32x2, WS_RGAGG) + (size_t)b * RGC * 1024 + ch; float* hin = WSP(float, WS_HIN) + (size_t)b * RGC * 1024 + ch;
        f32x2 a[RGC];
#pragma unroll
        for (int c = 0; c < RGC; ++c) a[c] = ag[(size_t)c * 1024];
        float h = 0.f;
#pragma unroll
        for (int c = 0; c < RGC; ++c) { hin[(size_t)c * 1024] = h; h = a[c].x * h + a[c].y; }
    }
}
constexpr int WR_LD = 1032;
__device__ __forceinline__ void p9_router(Frame& F) {
    LAS bf16* wH = (LAS bf16*)F.lds; LAS bf16* wL = wH + 32 * WR_LD;
    LAS f32x2* sel = (LAS f32x2*)(wL + 32 * WR_LD);
    LAS unsigned* rec = (LAS unsigned*)(sel + 512);
    LAS float* recp = (LAS float*)(rec + 512);
    LAS int* lcnt = (LAS int*)(recp + 512);
    LAS int* gbase = lcnt + 32;
    { const u32x4* img = WSP(u32x4, WS_WRIMG); LAS u32x4* dst = (LAS u32x4*)wH;
      for (int i = F.tid; i < 2 * 32 * WR_LD * 2 / 16; i += 512) dst[i] = img[i]; }
    if (F.tid < 32) lcnt[F.tid] = 0;
    __syncthreads();
    const float* mod = WSP(float, WS_MOD); const bf16* v1 = WSP(bf16, WS_V1); bf16* x1 = WSP(bf16, WS_X1); unsigned char* h2 = WSP(unsigned char, WS_H2);
    const int lane = F.lane, m = lane & 15, kq = lane >> 4, w = F.wave;
    for (int blk = F.vcu; blk < T / 128; blk += F.G) {
        const int t = blk * 128 + w * 16 + m, b = (blk * 128) >> 12;
        const bf16* vrow = v1 + (size_t)t * 1024 + 8 * kq;
        float sum = 0.f, sq = 0.f;
#pragma unroll 8
        for (int s_ = 0; s_ < 32; ++s_) { f32x4 a, c; unpack8(*(const u32x4*)(vrow + 32 * s_), a, c); sum += ((a[0] + a[1]) + (a[2] + a[3])) + ((c[0] + c[1]) + (c[2] + c[3]));
            sq += ((a[0] * a[0] + a[1] * a[1]) + (a[2] * a[2] + a[3] * a[3])) + ((c[0] * c[0] + c[1] * c[1]) + (c[2] * c[2] + c[3] * c[3])); }
        sum += __shfl_xor(sum, 16); sum += __shfl_xor(sum, 32); sq += __shfl_xor(sq, 16); sq += __shfl_xor(sq, 32);
        const float mean = sum * (1.f / 1024.f); const float rstd = 1.f / sqrtf(fmaxf(sq * (1.f / 1024.f) - mean * mean, 0.f) + LN_EPS);
        f32x4 acc[2] = {(f32x4){0.f, 0.f, 0.f, 0.f}, (f32x4){0.f, 0.f, 0.f, 0.f}};
        const float* lng = F.in[24] + 8 * kq; const float* lnb = F.in[25] + 8 * kq; const float* shp = mod + b * 6144 + 3072 + 8 * kq; const float* scp = mod + b * 6144 + 4096 + 8 * kq;
        bf16* x1row = x1 + (size_t)t * 1024 + 8 * kq; unsigned char* h2row = h2 + (size_t)t * 1024 + 8 * kq;
        const LAS bf16* wHr = wH + m * WR_LD + 8 * kq; const LAS bf16* wLr = wL + m * WR_LD + 8 * kq;
#pragma unroll 2
        for (int s_ = 0; s_ < 32; ++s_) { const int ko = 32 * s_;
            f32x4 a, c; unpack8(*(const u32x4*)(vrow + ko), a, c);
            const f32x4 g0 = *(const f32x4*)(lng + ko), g1 = *(const f32x4*)(lng + ko + 4), b0 = *(const f32x4*)(lnb + ko), b1 = *(const f32x4*)(lnb + ko + 4);
            const f32x4 x0 = (a - mean) * rstd * g0 + b0, x1v = (c - mean) * rstd * g1 + b1;
            *(u32x4*)(x1row + ko) = pack8(x0, x1v);
            const f32x4 sh0 = *(const f32x4*)(shp + ko), sh1 = *(const f32x4*)(shp + ko + 4), sc0 = *(const f32x4*)(scp + ko), sc1 = *(const f32x4*)(scp + ko + 4);
            const f32x4 h0 = x0 * (sc0 + 1.0f) + sh0, h1 = x1v * (sc1 + 1.0f) + sh1;
            u32x2 w8; w8.x = pk4_fp8(h0[0], h0[1], h0[2], h0[3]); w8.y = pk4_fp8(h1[0], h1[1], h1[2], h1[3]); *(u32x2*)(h2row + ko) = w8;
            const u32x4 hi = pack8(h0, h1); f32x4 r0, r1; unpack8(hi, r0, r1); const u32x4 lo = pack8(h0 - r0, h1 - r1);
            const bf16x8 ah = __builtin_bit_cast(bf16x8, hi), al = __builtin_bit_cast(bf16x8, lo);
#pragma unroll
            for (int nf = 0; nf < 2; ++nf) { const bf16x8 bh = *(const LAS bf16x8*)(wHr + nf * 16 * WR_LD + ko), bl = *(const LAS bf16x8*)(wLr + nf * 16 * WR_LD + ko);
                acc[nf] = __builtin_amdgcn_mfma_f32_16x16x32_bf16(bh, ah, acc[nf], 0, 0, 0);
                acc[nf] = __builtin_amdgcn_mfma_f32_16x16x32_bf16(bl, ah, acc[nf], 0, 0, 0);
                acc[nf] = __builtin_amdgcn_mfma_f32_16x16x32_bf16(bh, al, acc[nf], 0, 0, 0); } }
        float lv[8];
#pragma unroll
        for (int nf = 0; nf < 2; ++nf)
#pragma unroll
            for (int j = 0; j < 4; ++j) lv[nf * 4 + j] = acc[nf][j] + F.in[27][nf * 16 + 4 * kq + j];
        int rank[8];
#pragma unroll
        for (int i = 0; i < 8; ++i) { rank[i] = 0;
#pragma unroll
            for (int i2 = 0; i2 < 8; ++i2) if (i2 != i) { const int e1 = (i >> 2) * 16 + 4 * kq + (i & 3), e2 = (i2 >> 2) * 16 + 4 * kq + (i2 & 3); rank[i] += (lv[i2] > lv[i] || (lv[i2] == lv[i] && e2 < e1)) ? 1 : 0; } }
#pragma unroll
        for (int dq = 1; dq < 4; ++dq) { const int q2 = kq ^ dq;
#pragma unroll
            for (int i2 = 0; i2 < 8; ++i2) { const float o = __shfl_xor(lv[i2], 16 * dq); const int e2 = (i2 >> 2) * 16 + 4 * q2 + (i2 & 3);
#pragma unroll
                for (int i = 0; i < 8; ++i) { const int e1 = (i >> 2) * 16 + 4 * kq + (i & 3); rank[i] += (o > lv[i] || (o == lv[i] && e2 < e1)) ? 1 : 0; } } }
#pragma unroll
        for (int i = 0; i < 8; ++i) if (rank[i] < 4) { const int e1 = (i >> 2) * 16 + 4 * kq + (i & 3); sel[(w * 16 + m) * 4 + rank[i]] = (f32x2){__builtin_bit_cast(float, e1), lv[i]}; }
        asm volatile("s_waitcnt lgkmcnt(0)" ::: "memory");
        { const int tm = lane >> 2, k = lane & 3; const f32x2 s0 = sel[(w * 16 + tm) * 4 + 0], s1 = sel[(w * 16 + tm) * 4 + 1], s2 = sel[(w * 16 + tm) * 4 + 2], s3 = sel[(w * 16 + tm) * 4 + 3];
          const float p0 = 1.f, p1 = __expf(s1.y - s0.y), p2 = __expf(s2.y - s0.y), p3 = __expf(s3.y - s0.y), ps = (p0 + p1) + (p2 + p3);
          const f32x2 mine = k == 0 ? s0 : (k == 1 ? s1 : (k == 2 ? s2 : s3)); const float pm = (k == 0 ? p0 : (k == 1 ? p1 : (k == 2 ? p2 : p3))) / ps;
          const int e = __builtin_bit_cast(int, mine.x);
          const int lr = __hip_atomic_fetch_add(lcnt + e, 1, __ATOMIC_RELAXED, __HIP_MEMORY_SCOPE_WORKGROUP);
          rec[(w * 16 + tm) * 4 + k] = ((unsigned)e << 16) | (unsigned)lr; recp[(w * 16 + tm) * 4 + k] = pm; }
        __syncthreads();
        if (F.tid < 32) { const int n = lcnt[F.tid]; gbase[F.tid] = n ? (int)atomicAdd(F.ctl + CW_CNT + 64 * F.tid, (unsigned)n) : 0; lcnt[F.tid] = 0; }
        __syncthreads();
        { const unsigned r = rec[F.tid]; const int e = r >> 16, rk = gbase[e] + (int)(r & 0xffffu), tt = blk * 128 + (F.tid >> 2);
          WSP(int, WS_TOK)[(size_t)e * T + rk] = tt; WSP(unsigned, WS_POS)[(size_t)tt * 4 + (F.tid & 3)] = ((unsigned)e << 20) | (unsigned)rk; WSP(float, WS_PROB)[(size_t)tt * 4 + (F.tid & 3)] = recp[F.tid]; }
        __syncthreads();
    }
}
__device__ __forceinline__ void p12_final(Frame& F) {
    moe_tables(F);
    const LAS int* tstart = (const LAS int*)(F.lds + TAB_OFF);
    const float* mod = WSP(float, WS_MOD); const bf16* x1 = WSP(bf16, WS_X1); const bf16* yb = WSP(bf16, WS_YB); const unsigned* pos = WSP(unsigned, WS_POS); const float* prob = WSP(float, WS_PROB);
    const int lane = F.lane, gw = F.vcu * 8 + F.wave, NGW = F.G * 8;
    f32x4 lg[4], lb[4];
#pragma unroll
    for (int j = 0; j < 4; ++j) { lg[j] = *(const f32x4*)(F.in[32] + 512 * (j >> 1) + 8 * lane + 4 * (j & 1)); lb[j] = *(const f32x4*)(F.in[33] + 512 * (j >> 1) + 8 * lane + 4 * (j & 1)); }
#define P12_ROUTE(PP, PW, tt) do { const u32x4 p4_ = *(const u32x4*)(pos + (size_t)(tt) * 4); const f32x4 w4_ = *(const f32x4*)(prob + (size_t)(tt) * 4); \
        PP[0] = p4_.x; PP[1] = p4_.y; PP[2] = p4_.z; PP[3] = p4_.w; PW[0] = w4_[0]; PW[1] = w4_[1]; PW[2] = w4_[2]; PW[3] = w4_[3]; } while (0)
#define P12_ROWS(YW, XW, PP, tt) do { _Pragma("unroll") for (int k = 0; k < 4; ++k) { const int e_ = PP[k] >> 20, rk_ = PP[k] & 0xfffffu; const size_t slot_ = (size_t)tstart[e_] * 256 + rk_; \
            _Pragma("unroll") for (int j = 0; j < 2; ++j) YW[k][j] = *((const u32x2*)((const unsigned char*)yb + slot_ * 1024) + 64 * j + lane); } \
        _Pragma("unroll") for (int j = 0; j < 2; ++j) XW[j] = *((const u32x4*)(x1 + (size_t)(tt) * 1024) + 64 * j + lane); } while (0)
#define P12_COMPUTE(YW, XW, PW, tt) do { const int b_ = (tt) >> 12; f32x4 v[4]; float s_ = 0.f; \
        _Pragma("unroll") for (int j = 0; j < 2; ++j) { f32x4 f0 = (f32x4){0.f, 0.f, 0.f, 0.f}, f1 = f0; \
            _Pragma("unroll") for (int k = 0; k < 4; ++k) { const u32x2 yv_ = YW[k][j]; const f32x2 q0_ = __builtin_amdgcn_cvt_pk_f32_fp8((int)yv_.x, false), q1_ = __builtin_amdgcn_cvt_pk_f32_fp8((int)yv_.x, true), q2_ = __builtin_amdgcn_cvt_pk_f32_fp8((int)yv_.y, false), q3_ = __builtin_amdgcn_cvt_pk_f32_fp8((int)yv_.y, true); \
                f0 += (f32x4){q0_.x, q0_.y, q1_.x, q1_.y} * PW[k]; f1 += (f32x4){q2_.x, q2_.y, q3_.x, q3_.y} * PW[k]; } \
            f32x4 xa_, xc_; unpack8(XW[j], xa_, xc_); const float* gp_ = mod + b_ * 6144 + 5120 + 512 * j + 8 * lane; \
            v[2 * j] = xa_ * DN_ALPHA + (*(const f32x4*)gp_ + 1.0f) * f0; v[2 * j + 1] = xc_ * DN_ALPHA + (*(const f32x4*)(gp_ + 4) + 1.0f) * f1; \
            s_ += ((v[2 * j][0] + v[2 * j][1]) + (v[2 * j][2] + v[2 * j][3])) + ((v[2 * j + 1][0] + v[2 * j + 1][1]) + (v[2 * j + 1][2] + v[2 * j + 1][3])); } \
        const float mean_ = wave_sum(s_) * (1.f / 1024.f); float s2_ = 0.f; \
        _Pragma("unroll") for (int j = 0; j < 4; ++j) { v[j] = v[j] - mean_; s2_ += (v[j][0] * v[j][0] + v[j][1] * v[j][1]) + (v[j][2] * v[j][2] + v[j][3] * v[j][3]); } \
        const float rstd_ = 1.f / sqrtf(wave_sum(s2_) * (1.f / 1024.f) + LN_EPS); \
        _Pragma("unroll") for (int j = 0; j < 4; ++j) *(f32x4*)(F.out + (size_t)(tt) * 1024 + 512 * (j >> 1) + 8 * lane + 4 * (j & 1)) = v[j] * rstd_ * lg[j] + lb[j]; } while (0)
    const int nmine = (T - gw + NGW - 1) / NGW;
    unsigned ppA[4], ppB[4]; float pwA[4], pwB[4], pwN[4]; u32x2 ywA[4][2], ywB[4][2]; u32x4 xwA[2], xwB[2];
    if (nmine > 0) { P12_ROUTE(ppA, pwA, gw); P12_ROWS(ywA, xwA, ppA, gw); }
    if (nmine > 1) { P12_ROUTE(ppB, pwB, gw + NGW); }
    for (int i = 0; i < nmine; i += 2) {
        const int t0 = gw + i * NGW, t1 = t0 + NGW, t2 = t1 + NGW, t3 = t2 + NGW;
        if (i + 1 < nmine) { P12_ROWS(ywB, xwB, ppB, t1); }
        if (i + 2 < nmine) { P12_ROUTE(ppA, pwN, t2); }
        __builtin_amdgcn_sched_barrier(0);
        P12_COMPUTE(ywA, xwA, pwA, t0);
        if (i + 1 < nmine) {
#pragma unroll
            for (int k = 0; k < 4; ++k) pwA[k] = pwN[k];
            if (i + 2 < nmine) { P12_ROWS(ywA, xwA, ppA, t2); }
            if (i + 3 < nmine) { P12_ROUTE(ppB, pwN, t3); }
            __builtin_amdgcn_sched_barrier(0);
            P12_COMPUTE(ywB, xwB, pwB, t1);
#pragma unroll
            for (int k = 0; k < 4; ++k) pwB[k] = pwN[k];
        }
    }
#undef P12_ROUTE
#undef P12_ROWS
#undef P12_COMPUTE
}

struct Args { const float* in[34]; float* out; unsigned char* ws; int ph_lo, ph_hi; };
__global__ void __launch_bounds__(512, 2) fwd_kernel(Args args) {
    extern __shared__ __attribute__((aligned(16))) unsigned char lds_raw[];
    Frame F;
    F.lds = (LAS unsigned char*)lds_raw; F.MISC = (volatile LAS unsigned*)(F.lds + MISC_OFF);
    F.tid = threadIdx.x; F.lane = F.tid & 63; F.wave = __builtin_amdgcn_readfirstlane(F.tid >> 6);
    F.G = gridDim.x; { const int bx = blockIdx.x; F.vcu = (F.G % 8 == 0) ? (bx % 8) * (F.G / 8) + bx / 8 : bx; }
#pragma unroll
    for (int i = 0; i < 34; ++i) F.in[i] = args.in[i];
    F.out = args.out; F.ws = args.ws; F.ctl = (unsigned*)(args.ws + WS_CTL);
    if (F.tid < 64) F.MISC[F.tid] = 0u;
    __syncthreads();
    XcdBarrier bar; bar.bar = F.ctl + CW_BAR; bar.x = 0; bar.st = nullptr;
    if (MK_N_LAUNCHES == 1) bar = xcd_barrier_post(F.ctl + CW_BAR, F.MISC + 8);
    const int lo = args.ph_lo, hi = args.ph_hi;
#define IN(k) (lo <= (k) && (k) < hi)
#define SEAM(k) do { if (IN(k) && IN((k) + 1)) xcd_barrier(bar); } while (0)

    if (IN(0)) REPS(0) { if (rep_) xcd_barrier(bar);
        for (int j = F.vcu; j < 192; j += F.G) p0_mod_job(F, j);
        for (int j = F.vcu; j < S5G * 8; j += F.G) p0_s5k_job(F, j);
        { bf16* img = WSP(bf16, WS_WRIMG); const float* wr = F.in[26];
          for (int i = F.vcu * 512 + F.tid; i < 1024 * 32; i += F.G * 512) { const float w = wr[i]; const unsigned hb = f2bf(w); const float hf = __builtin_bit_cast(float, hb << 16);
              img[(i & 31) * 1032 + (i >> 5)] = (bf16)hb; img[32 * 1032 + (i & 31) * 1032 + (i >> 5)] = (bf16)f2bf(w - hf); } }
        p0_small_transposes(F);
    }
    SEAM(0);
    if (IN(1)) REPS(1) { if (rep_) xcd_barrier(bar); for (int j = F.vcu; j < S5G * 8; j += F.G) p1_s5w_job(F, j); p1_body(F); }
    SEAM(1);
    if (IN(2)) REPS(2) { if (rep_) xcd_barrier(bar);
        g8::GridOrder S; S.init(T, INC, F.G, (int)blockIdx.x, WSP(bf16, WS_HBF), WSP(bf16, WS_WIN), 1024, 1024);
        EpiInProj E{F.in[5], WSP(bf16, WS_XRNN), WSP(bf16, WS_GY), WSP(bf16, WS_ACAT), WSP(bf16, WS_GATES)};
        g8::gemm_phase<EpiInProj, g8::GridOrder, false, true>(F.lds, 1024, 1024, 1024, S, E);
    }
    SEAM(2);
    if (IN(3)) REPS(3) { if (rep_) xcd_barrier(bar);
        { S5AOrder S{F.G, F.vcu, (const char*)WSP(bf16, WS_ACAT), (const char*)WSP(bf16, WS_WS)}; EpiS5A E{WSP(float, WS_S)};
          g8::gemm_phase<EpiS5A, S5AOrder, false>(F.lds, S5L * 32, S5ROW * 2, S5L * 32, S, E); }
        __syncthreads();
        rglru_phase<0>(F);
    }
    SEAM(3);
    if (IN(4)) REPS(4) { if (rep_) xcd_barrier(bar); p4_carries(F); }
    SEAM(4);
    if (IN(5)) REPS(5) { if (rep_) xcd_barrier(bar);
        { S5COrder S{F.G, F.vcu, (const char*)WSP(bf16, WS_ACAT), (const char*)WSP(bf16, WS_WY)}; EpiS5C E{WSP(bf16, WS_YS)};
          g8::gemm_phase<EpiS5C, S5COrder, false>(F.lds, S5ROW * 2, S5ROW * 2, S5ROW * 2, S, E); }
        __syncthreads();
        rglru_phase<1>(F);
    }
    SEAM(5);
    if (IN(6)) REPS(6) { if (rep_) xcd_barrier(bar);
        g8::GridOrder S; S.init(T, 2048, F.G, (int)blockIdx.x, WSP(bf16, WS_YS), WSP(bf16, WS_WGLU), 512, 512);
        EpiGlu E{WSP(bf16, WS_GATES), WSP(bf16, WS_GB)};
        g8::gemm_phase<EpiGlu, g8::GridOrder, false, true>(F.lds, 512, 512, 512, S, E);
    }
    SEAM(6);
    if (IN(7)) REPS(7) { if (rep_) xcd_barrier(bar);
        g8::GridOrder S; S.init(T, 1024, F.G, (int)blockIdx.x, WSP(bf16, WS_HA), WSP(bf16, WS_WRNN), 1024, 1024);
        EpiRnn E{WSP(bf16, WS_GATES), WSP(bf16, WS_GB), WSP(bf16, WS_MERGED)};
        g8::gemm_phase<EpiRnn, g8::GridOrder, false, true>(F.lds, 1024, 1024, 1024, S, E);
    }
    SEAM(7);
    if (IN(8)) REPS(8) { if (rep_) xcd_barrier(bar);
        g8::GridOrder S; S.init(T, 1024, F.G, (int)blockIdx.x, WSP(bf16, WS_MERGED), WSP(bf16, WS_WOUT), 1024, 1024);
        EpiOut E{F.in[0], WSP(float, WS_MOD), WSP(bf16, WS_V1)};
        g8::gemm_phase<EpiOut, g8::GridOrder, false, true>(F.lds, 1024, 1024, 1024, S, E);
    }
    SEAM(8);
    if (IN(9)) REPS(9) { if (rep_) xcd_barrier(bar); p9_router(F); }
    SEAM(9);
    if (IN(10)) REPS(10) { if (rep_) xcd_barrier(bar);
        moe_tables(F);
        const LAS int* tstart = (const LAS int*)(F.lds + TAB_OFF);
        MoeOrder S{F.G, (int)blockIdx.x, 8, tstart[NE], tstart, tstart + 40, WSP(int, WS_TOK), (const char*)WSP(bf16, WS_H2), (const char*)WSP(bf16, WS_WGU), (size_t)2048 * 1024, 1024, true};
        EpiMoe1 E{F.in[29], WSP(bf16, WS_ACT)};
        g8::gemm_phase<EpiMoe1, MoeOrder, true, true>(F.lds, 1024, 1024, 1024, S, E);
    }
    SEAM(10);
    if (IN(11)) REPS(11) { if (rep_) xcd_barrier(bar);
        moe_tables(F);
        const LAS int* tstart = (const LAS int*)(F.lds + TAB_OFF);
        MoeOrder S{F.G, (int)blockIdx.x, 4, tstart[NE], tstart, tstart + 40, WSP(int, WS_TOK), (const char*)WSP(bf16, WS_ACT), (const char*)WSP(bf16, WS_WD), (size_t)1024 * 1024, 1024, false};
        EpiMoe2 E{F.in[31], WSP(bf16, WS_YB)};
        g8::gemm_phase<EpiMoe2, MoeOrder, false, true>(F.lds, 1024, 1024, 1024, S, E);
    }
    SEAM(11);
    if (IN(12)) REPS(12) { if (rep_) xcd_barrier(bar); p12_final(F); }
#undef IN
#undef SEAM
}

extern "C" void kernel_launch(void* const* d_in, const int* in_sizes, int n_in, void* d_out, int out_size, void* d_ws, size_t ws_size, hipStream_t stream) {
    static int grid = 0;
    if (grid == 0) {
        if (n_in != 34 || in_sizes[0] != T * D || out_size != T * D || ws_size < WS_END) { fprintf(stderr, "kernel_launch: unexpected shapes (n_in %d, ws %zu < %zu)\n", n_in, ws_size, (size_t)WS_END); grid = -1; return; }
        int dev = 0, cus = 0;
        if (hipGetDevice(&dev) != hipSuccess || hipDeviceGetAttribute(&cus, hipDeviceAttributeMultiprocessorCount, dev) != hipSuccess) { grid = -1; return; }
        if (hipFuncSetAttribute((const void*)fwd_kernel, hipFuncAttributeMaxDynamicSharedMemorySize, LDS_BYTES) != hipSuccess) { fprintf(stderr, "kernel_launch: hipFuncSetAttribute failed\n"); grid = -1; return; }
        int per_cu = 0; (void)hipOccupancyMaxActiveBlocksPerMultiprocessor(&per_cu, (const void*)fwd_kernel, 512, LDS_BYTES); (void)hipGetLastError();
        grid = cus;
    }
    if (grid < 0) return;
    (void)hipMemsetAsync((char*)d_ws + WS_CTL, 0, CTL_BYTES, stream);
    Args a{};
    for (int i = 0; i < 34; ++i) a.in[i] = (const float*)d_in[i];
    a.out = (float*)d_out; a.ws = (unsigned char*)d_ws;
    if (MK_N_LAUNCHES == 1) { a.ph_lo = 0; a.ph_hi = N_PHASES; hipLaunchKernelGGL(fwd_kernel, dim3(grid), dim3(512), LDS_BYTES, stream, a); }
    else for (int p = 0; p < N_PHASES; ++p) { a.ph_lo = p; a.ph_hi = p + 1; hipLaunchKernelGGL(fwd_kernel, dim3(grid), dim3(512), LDS_BYTES, stream, a); }
}
```

```cpp
#include <hip/hip_runtime.h>
#include <cstdio>
#include <cstdint>

#ifndef MK_N_LAUNCHES
#define MK_N_LAUNCHES 1
#endif
constexpr int N_PHASES = 13;
#ifndef DUP_PHASE
#define DUP_PHASE -1
#endif
#define REPS(k) for (int rep_ = 0; rep_ < ((DUP_PHASE == (k)) ? 2 : 1); ++rep_)

#define GAS __attribute__((address_space(1)))
#define LAS __attribute__((address_space(3)))
typedef unsigned short bf16;
typedef short bf16x8 __attribute__((ext_vector_type(8)));
typedef float f32x4 __attribute__((ext_vector_type(4)));
typedef float f32x2 __attribute__((ext_vector_type(2)));
typedef unsigned u32x4 __attribute__((ext_vector_type(4)));
typedef unsigned u32x2 __attribute__((ext_vector_type(2)));
typedef GAS unsigned gu32;

constexpr int NB = 8, SEQ = 4096, T = NB * SEQ, D = 1024, INC = 4608, NE = 32, DFF = 1024;
constexpr int S5L = 32, S5G = 32, S5ROW = 128 + S5L * 16  , S5M = T / S5L  , S5CPB = SEQ / S5L  ;
constexpr int RGL = 128, RGC = SEQ / RGL  ;
constexpr float LN_EPS = 1e-5f, DN_ALPHA = 1.189207115002721f;
constexpr int ACT_ROWS = T * 4 + NE * 256;

constexpr size_t MiB = 1u << 20;
constexpr size_t WS_XRNN = 0, WS_GY = 64 * MiB, WS_GATES = 128 * MiB, WS_V1 = 0, WS_ACT = 0;
constexpr size_t WS_HBF = 272 * MiB, WS_HA = 272 * MiB, WS_YS = 336 * MiB, WS_GB = 368 * MiB, WS_MERGED = 432 * MiB, WS_ACAT = 496 * MiB, WS_YB = 272 * MiB;
constexpr size_t WS_X1 = 544 * MiB, WS_H2 = 608 * MiB;
constexpr size_t WS_WGU = 672 * MiB, WS_WD = 800 * MiB, WS_WIN = 864 * MiB, WS_WG = 873 * MiB, WS_WRNN = 874 * MiB, WS_WGLU = 876 * MiB, WS_WOUT = 878 * MiB;
constexpr size_t WS_WS = 880 * MiB, WS_WY = 888 * MiB, WS_S = 908 * MiB;
constexpr size_t WS_MOD = 924 * MiB, WS_AL = 925 * MiB, WS_RGAGG = 926 * MiB, WS_HIN = 928 * MiB, WS_TOK = 929 * MiB, WS_POS = 933 * MiB, WS_PROB = 934 * MiB, WS_CTL = 935 * MiB;
constexpr size_t WS_END = 936 * MiB, CTL_BYTES = 1 * MiB;
static_assert((size_t)ACT_ROWS * DFF * 2 <= 272 * MiB, "act/yb size");
static_assert(WS_ACAT + (size_t)S5G * S5M * S5ROW * 2 <= WS_X1, "acat");
constexpr int CW_BAR = 4096, CW_CNT = 8192  ;

constexpr int LDS_BYTES = 147456, MISC_OFF = LDS_BYTES - 256, TAB_OFF = 131072 + 1024;

__device__ __forceinline__ unsigned f2bf(float f) { unsigned u = __builtin_bit_cast(unsigned, f); return (u + 0x7fffu + ((u >> 16) & 1u)) >> 16; }
typedef __bf16 bf16x2v __attribute__((ext_vector_type(2)));
__device__ __forceinline__ unsigned pk2(float lo, float hi) { const f32x2 v = {lo, hi}; const bf16x2v b = __builtin_convertvector(v, bf16x2v); return __builtin_bit_cast(unsigned, b); }
__device__ __forceinline__ unsigned pk4_fp8(float a, float b, float c, float d) { a = __builtin_amdgcn_fmed3f(a, -448.f, 448.f); b = __builtin_amdgcn_fmed3f(b, -448.f, 448.f); c = __builtin_amdgcn_fmed3f(c, -448.f, 448.f); d = __builtin_amdgcn_fmed3f(d, -448.f, 448.f); int w = 0; w = __builtin_amdgcn_cvt_pk_fp8_f32(a, b, w, false); w = __builtin_amdgcn_cvt_pk_fp8_f32(c, d, w, true); return (unsigned)w; }
__device__ __forceinline__ float bflo(unsigned w) { return __builtin_bit_cast(float, w << 16); }
__device__ __forceinline__ float bfhi(unsigned w) { return __builtin_bit_cast(float, w & 0xffff0000u); }
__device__ __forceinline__ float bf1(bf16 h) { return __builtin_bit_cast(float, ((unsigned)h) << 16); }
__device__ __forceinline__ float fast_sigmoid(float x) { return __builtin_amdgcn_rcpf(1.0f + __builtin_amdgcn_exp2f(-1.4426950409f * x)); }
__device__ __forceinline__ float gelu_tanh(float x) { const float u = x + 0.044715f * x * x * x; return x * __builtin_amdgcn_rcpf(1.0f + __builtin_amdgcn_exp2f(-2.3022082f * u)); }
__device__ __forceinline__ float wave_sum(float v) {
#pragma unroll
    for (int o = 1; o < 64; o <<= 1) v += __shfl_xor(v, o);
    return v;
}
__device__ __forceinline__ u32x4 pack8(f32x4 a, f32x4 b) { u32x4 w; w.x = pk2(a[0], a[1]); w.y = pk2(a[2], a[3]); w.z = pk2(b[0], b[1]); w.w = pk2(b[2], b[3]); return w; }
__device__ __forceinline__ void unpack8(u32x4 w, f32x4& a, f32x4& b) { a = (f32x4){bflo(w.x), bfhi(w.x), bflo(w.y), bfhi(w.y)}; b = (f32x4){bflo(w.z), bfhi(w.z), bflo(w.w), bfhi(w.w)}; }

#define XB_TMO      128
#define XB_XCNT(j)  (256  + 64 * (j))
#define XB_XSUB(j)  (1280 + 64 * (j))
#define XB_XGEN(j)  (2304 + 64 * (j))
#define XB_TOP      3328
#define XB_TOPGEN   3392
#define XCD_BAR_WORDS 3456
#define XB_SPIN_CAP (1u << 18)
__device__ __forceinline__ unsigned xb_ld(unsigned* p)              { return __hip_atomic_load(p, __ATOMIC_RELAXED, __HIP_MEMORY_SCOPE_AGENT); }
__device__ __forceinline__ unsigned xb_add(unsigned* p, unsigned v) { return __hip_atomic_fetch_add(p, v, __ATOMIC_RELAXED, __HIP_MEMORY_SCOPE_AGENT); }
__device__ __forceinline__ unsigned xb_xcc_id() { return (unsigned)__builtin_amdgcn_s_getreg((3 << 11) | 20) & 0xFu; }
#define XB_SPIN(cond, bar) do { unsigned _sp = 0; while (cond) { __builtin_amdgcn_s_sleep(1); \
    if ((++_sp & 255u) == 0u) { if (xb_ld(&(bar)[XB_TMO])) break; if (_sp > XB_SPIN_CAP) { atomicAdd(&(bar)[XB_TMO], 1u); break; } } } } while (0)
struct XcdBarrier { unsigned* bar; unsigned x; volatile LAS unsigned* st; };
__device__ __forceinline__ XcdBarrier xcd_barrier_post(unsigned* bar, volatile LAS unsigned* st) {
    XcdBarrier b; b.bar = bar; b.x = xb_xcc_id(); b.st = st;
    if (threadIdx.x == 0) (void)xb_add(&bar[XB_XCNT(b.x)], 1u);
    return b;
}
__device__ __forceinline__ void xcd_barrier_complete(unsigned* bar, unsigned x, unsigned& nloc, unsigned& nx) {
    const unsigned G = gridDim.x * gridDim.y * gridDim.z;
    unsigned sum, cnt, mine, sp = 0u;
    for (;;) {
        sum = 0u; cnt = 0u; mine = 0u;
#pragma unroll
        for (unsigned j = 0; j < 16; ++j) { const unsigned c = xb_ld(&bar[XB_XCNT(j)]); sum += c; cnt += (c > 0u) ? 1u : 0u; mine = (j == x) ? c : mine; }
        if (sum == G) break;
        __builtin_amdgcn_s_sleep(1);
        if ((++sp & 255u) == 0u) { if (xb_ld(&bar[XB_TMO])) break; if (sp > XB_SPIN_CAP) { atomicAdd(&bar[XB_TMO], 1u); break; } }
    }
    nloc = mine > 0u ? mine : 1u; nx = cnt > 0u ? cnt : 1u;
}
__device__ __forceinline__ void xcd_barrier(const XcdBarrier& b) {
    asm volatile("s_waitcnt vmcnt(0)" ::: "memory");
    __syncthreads();
    if (threadIdx.x == 0) {
        unsigned* bar = b.bar;
        __builtin_amdgcn_s_waitcnt(0);
        unsigned nloc = b.st[0], nx = b.st[1];
        if (nloc == 0u) { xcd_barrier_complete(bar, b.x, nloc, nx); b.st[0] = nloc; b.st[1] = nx; }
        const unsigned old = xb_add(&bar[XB_XSUB(b.x)], 1u);
        const unsigned gen = old / nloc;
        if (old + 1u == (gen + 1u) * nloc) {
            __builtin_amdgcn_fence(__ATOMIC_RELEASE, "agent");
            asm volatile("s_waitcnt vmcnt(0)" ::: "memory");
            const unsigned og = xb_add(&bar[XB_TOP], 1u);
            const unsigned tg = og / nx;
            if (og + 1u == (tg + 1u) * nx) xb_add(&bar[XB_TOPGEN], 1u);
            else XB_SPIN(xb_ld(&bar[XB_TOPGEN]) == tg, bar);
            __builtin_amdgcn_fence(__ATOMIC_ACQUIRE, "agent");
            xb_add(&bar[XB_XGEN(b.x)], 1u);
            asm volatile("s_waitcnt vmcnt(0)" ::: "memory");
        } else {
            XB_SPIN(xb_ld(&bar[XB_XGEN(b.x)]) == gen, bar);
            __builtin_amdgcn_fence(__ATOMIC_ACQUIRE, "agent");
            asm volatile("s_waitcnt vmcnt(0)" ::: "memory");
        }
    }
    __syncthreads();
}

namespace g8 {
constexpr int BM = 256, BK = 64, HALF = 128, HTB = HALF * BK * 2, STAGE_BYTES = 8 * HTB;
__device__ __forceinline__ int lds_byte(int r, int c) { const int st = (r >> 4) * 2 + (c >> 5), rr = r & 15, cc = c & 31, ob = rr * 64 + cc * 2; return st * 1024 + (ob ^ (((ob >> 9) & 1) << 5)); }
__device__ __forceinline__ void stage_rc(int b, int& R, int& C) { const int st = b / 1024, sb = b % 1024, swz = sb ^ (((sb >> 9) & 1) << 5); R = (st >> 1) * 16 + swz / 64; C = (st & 1) * 32 + (swz % 64) / 2; }
__device__ __forceinline__ int perm32(int rho) { const int n = rho >> 4, i = rho & 15; return 8 * (i >> 2) + 4 * n + (i & 3); }

struct Unit { int pm, pn, z, rl; const char* A; const char* B; };

typedef int v8i __attribute__((ext_vector_type(8)));
typedef int v4i __attribute__((ext_vector_type(4)));
typedef short s16x16 __attribute__((ext_vector_type(16)));
typedef s16x16 s16x16_a16 __attribute__((aligned(16)));
__device__ __forceinline__ v8i cat8(bf16x8 lo, bf16x8 hi) { const v4i a = __builtin_bit_cast(v4i, lo), b = __builtin_bit_cast(v4i, hi); return __builtin_shufflevector(a, b, 0, 1, 2, 3, 4, 5, 6, 7); }
template <class Epi, class Sched, bool GATHER, bool FP8 = false>
__device__ __forceinline__ void gemm_phase(LAS unsigned char* lds, const int Kb, const int ldaB, const int ldbB, const Sched& S, const Epi& E) {
    const int tid = threadIdx.x, wid = __builtin_amdgcn_readfirstlane(tid >> 6), lane = tid & 63, wr = wid >> 2, wc = wid & 3, fr = lane & 15, fq = lane >> 4;
    const int nt = Kb / 128;
    unsigned voffB[2], cvo[2][2], nvo[2][2]; int Rr[2], Cc[2];
#pragma unroll
    for (int i = 0; i < 2; ++i) { int R, C; stage_rc(tid * 16 + i * 8192, R, C); const int Rb = (R & ~31) + perm32(R & 31);
        voffB[i] = (unsigned)(Rb * ldbB + C * 2); Rr[i] = R; Cc[i] = C;
#pragma unroll
        for (int h = 0; h < 2; ++h) { cvo[h][i] = (unsigned)((h * HALF + R) * ldaB + C * 2); nvo[h][i] = cvo[h][i]; } }
    const size_t kstep = (size_t)(BK * 2);
    const size_t hstepB = (size_t)HALF * ldbB;
    const unsigned ldsw = (unsigned)wid * 1024u;
    const int aoff = FP8 ? lds_byte(wr * 64 + fr, (fq >> 1) * 32 + (fq & 1) * 24) : lds_byte(wr * 64 + fr, fq * 8), boff = FP8 ? lds_byte(wc * 32 + fr, (fq >> 1) * 32 + (fq & 1) * 24) : lds_byte(wc * 32 + fr, fq * 8);
    const int aoff2 = FP8 ? lds_byte(wr * 64 + fr, (fq >> 1) * 32 + 8 + (fq & 1) * 8) : 0, boff2 = FP8 ? lds_byte(wc * 32 + fr, (fq >> 1) * 32 + 8 + (fq & 1) * 8) : 0;
#define G8_SA(b, h) (((b) * 2 + (h)) * HTB)
#define G8_SB(b, h) ((4 + (b) * 2 + (h)) * HTB)
#define G8_STGB(bufoff, gbase) do { _Pragma("unroll") for (int _i = 0; _i < 2; ++_i) \
        __builtin_amdgcn_global_load_lds((const unsigned*)((const char*)(gbase) + voffB[_i]), (LAS unsigned*)(lds + (bufoff) + ldsw + _i * 8192), 16, 0, 0); } while (0)
#define G8_STGA(bufoff, gbase, VO, h) do { _Pragma("unroll") for (int _i = 0; _i < 2; ++_i) \
        __builtin_amdgcn_global_load_lds((const unsigned*)((const char*)(gbase) + VO[h][_i]), (LAS unsigned*)(lds + (bufoff) + ldsw + _i * 8192), 16, 0, 0); } while (0)
#define G8_LDA(dst, b, h) do { _Pragma("unroll") for (int m = 0; m < 4; ++m) { if constexpr (FP8) { dst##8[m] = cat8(*(const LAS bf16x8*)(lds + G8_SA(b, h) + aoff + m * 2048), *(const LAS bf16x8*)(lds + G8_SA(b, h) + aoff2 + m * 2048)); } \
        else { _Pragma("unroll") for (int k = 0; k < 2; ++k) dst[m][k] = *(const LAS bf16x8*)(lds + G8_SA(b, h) + aoff + m * 2048 + k * 1024); } } } while (0)
#define G8_LDB(dst, b, h) do { _Pragma("unroll") for (int n = 0; n < 2; ++n) { if constexpr (FP8) { dst##8[n] = cat8(*(const LAS bf16x8*)(lds + G8_SB(b, h) + boff + n * 2048), *(const LAS bf16x8*)(lds + G8_SB(b, h) + boff2 + n * 2048)); } \
        else { _Pragma("unroll") for (int k = 0; k < 2; ++k) dst[n][k] = *(const LAS bf16x8*)(lds + G8_SB(b, h) + boff + n * 2048 + k * 1024); } } } while (0)
#define G8_MMA(ai, bj, At, Bt) do { __builtin_amdgcn_s_setprio(1); _Pragma("unroll") for (int m = 0; m < 4; ++m) _Pragma("unroll") for (int n = 0; n < 2; ++n) { \
        if constexpr (FP8) asm volatile("s_nop 1\n\tv_mfma_scale_f32_16x16x128_f8f6f4 %0, %1, %2, %0, %3, %4 op_sel_hi:[0,0,0]" : "+v"(acc[ai][bj][m][n]) : "v"(Bt##8[n]), "v"(At##8[m]), "v"(sc_w), "v"(sc_a)); \
        else { _Pragma("unroll") for (int k = 0; k < 2; ++k) acc[ai][bj][m][n] = __builtin_amdgcn_mfma_f32_16x16x32_bf16(Bt[n][k], At[m][k], acc[ai][bj][m][n], 0, 0, 0); } } __builtin_amdgcn_s_setprio(0); } while (0)
#define G8_WAIT_V(n) asm volatile("s_waitcnt vmcnt(" #n ")" ::: "memory")
#define G8_WAIT_L(n) asm volatile("s_waitcnt lgkmcnt(" #n ")" ::: "memory")
#define G8_BAR __builtin_amdgcn_s_barrier()
#define G8_SCHED __builtin_amdgcn_sched_barrier(0)
    Unit cur, nxt; int ui = 0;
    if (!S.next(0, cur)) return;
    bool has_next = S.next(1, nxt);
    if constexpr (GATHER) { S.gather(cur, Rr, Cc, cvo); if (has_next) S.gather(nxt, Rr, Cc, nvo); else {
#pragma unroll
        for (int h = 0; h < 2; ++h)
#pragma unroll
            for (int i = 0; i < 2; ++i) nvo[h][i] = cvo[h][i]; } }
    f32x4 acc[2][2][4][2];
#pragma unroll
    for (int a = 0; a < 2; ++a)
#pragma unroll
        for (int b = 0; b < 2; ++b)
#pragma unroll
            for (int m = 0; m < 4; ++m)
#pragma unroll
                for (int n = 0; n < 2; ++n) acc[a][b][m][n] = (f32x4){0.f, 0.f, 0.f, 0.f};
    const int sc_w = 0x7a7a7a7a, sc_a = 0x7f7f7f7f;
    bf16x8 At[4][2], B0[2][2], B1[2][2]; v8i At8[4], B08[2], B18[2];
    const char* cA = cur.A; const char* cB = cur.B;
    G8_STGB(G8_SB(0, 0), cB); G8_STGB(G8_SB(0, 1), cB + hstepB); G8_STGA(G8_SA(0, 0), cA, cvo, 0); G8_STGA(G8_SA(0, 1), cA, cvo, 1);
    if (wr == 1) G8_BAR;
    G8_WAIT_V(2); G8_BAR;
    G8_STGB(G8_SB(1, 0), cB + kstep); G8_STGA(G8_SA(1, 0), cA + kstep, cvo, 0); G8_STGB(G8_SB(1, 1), cB + hstepB + kstep);
    G8_WAIT_V(6); G8_BAR;
    for (;;) {
        const char* nA = has_next ? nxt.A : cA; const char* nB = has_next ? nxt.B : cB;
        for (int t = 0; t < nt; t += 2) {
            const bool last = (t == nt - 2);
            const char* a1 = cA + (size_t)(t + 1) * kstep;
            const char* a2 = last ? nA : cA + (size_t)(t + 2) * kstep; const char* b2 = last ? nB : cB + (size_t)(t + 2) * kstep;
            const char* a3 = a2 + kstep; const char* b3 = b2 + kstep;
            unsigned vo2[2][2];
#pragma unroll
            for (int h = 0; h < 2; ++h)
#pragma unroll
                for (int i = 0; i < 2; ++i) vo2[h][i] = (GATHER && last) ? nvo[h][i] : cvo[h][i];
            G8_LDB(B0, 0, 0); G8_LDB(B1, 0, 1); G8_SCHED; G8_LDA(At, 0, 0); G8_STGA(G8_SA(1, 1), a1, cvo, 1);
            G8_WAIT_V(8); G8_WAIT_L(0); G8_BAR; G8_SCHED; G8_MMA(0, 0, At, B0); G8_MMA(0, 1, At, B1); G8_SCHED; G8_BAR; G8_SCHED;
            G8_LDA(At, 0, 1); G8_STGB(G8_SB(0, 0), b2); G8_STGB(G8_SB(0, 1), b2 + hstepB); G8_STGA(G8_SA(0, 0), a2, vo2, 0);
            G8_WAIT_V(8); G8_WAIT_L(0); G8_BAR; G8_SCHED; G8_MMA(1, 0, At, B0); G8_MMA(1, 1, At, B1); G8_SCHED; G8_BAR; G8_SCHED;
            G8_LDB(B0, 1, 0); G8_LDB(B1, 1, 1); G8_SCHED; G8_LDA(At, 1, 0); G8_STGA(G8_SA(0, 1), a2, vo2, 1);
            G8_WAIT_V(8); G8_WAIT_L(0); G8_BAR; G8_SCHED; G8_MMA(0, 0, At, B0); G8_MMA(0, 1, At, B1); G8_SCHED; G8_BAR; G8_SCHED;
            G8_LDA(At, 1, 1); G8_STGB(G8_SB(1, 0), b3); G8_STGB(G8_SB(1, 1), b3 + hstepB); G8_STGA(G8_SA(1, 0), a3, vo2, 0);
            G8_WAIT_V(8); G8_WAIT_L(0); G8_BAR; G8_SCHED; G8_MMA(1, 0, At, B0); G8_MMA(1, 1, At, B1); G8_SCHED; G8_BAR; G8_SCHED;
        }
        if (wr == 0) G8_BAR;
        Unit nn; bool has_nn = false;
        if (has_next) has_nn = S.next(ui + 2, nn);
        unsigned nnvo[2][2];
        if constexpr (GATHER) { if (has_nn) S.gather(nn, Rr, Cc, nnvo); }
        if constexpr (FP8) asm volatile("s_nop 15\n\ts_nop 15" ::: "memory");
        E(acc, cur, wr, wc, fr, fq);
        if (!has_next) break;
#pragma unroll
        for (int a = 0; a < 2; ++a)
#pragma unroll
            for (int b = 0; b < 2; ++b)
#pragma unroll
                for (int m = 0; m < 4; ++m)
#pragma unroll
                    for (int n = 0; n < 2; ++n) acc[a][b][m][n] = (f32x4){0.f, 0.f, 0.f, 0.f};
        cur = nxt; cA = nA; cB = nB; ++ui;
        if constexpr (GATHER) {
#pragma unroll
            for (int h = 0; h < 2; ++h)
#pragma unroll
                for (int i = 0; i < 2; ++i) { cvo[h][i] = nvo[h][i]; if (has_nn) nvo[h][i] = nnvo[h][i]; } }
        nxt = nn; has_next = has_nn;
        if (wr == 1) G8_BAR;
    }
    G8_WAIT_V(0);
    G8_BAR;
#undef G8_SA
#undef G8_SB
#undef G8_STGB
#undef G8_STGA
#undef G8_LDA
#undef G8_LDB
#undef G8_MMA
#undef G8_WAIT_V
#undef G8_WAIT_L
#undef G8_BAR
#undef G8_SCHED
}

struct GridOrder {
    int nM, nN, nwg, G, c; const char* A; const char* B; size_t tstepA, tstepB;
    __device__ __forceinline__ void init(int M, int N, int G_, int c_, const void* A_, const void* B_, int ldaB, int ldbB) { nM = M / BM; nN = N / BM; nwg = nM * nN; G = G_; c = c_; A = (const char*)A_; B = (const char*)B_; tstepA = (size_t)BM * ldaB; tstepB = (size_t)BM * ldbB; }
    __device__ __forceinline__ bool next(int i, Unit& u) const {
        const long L = (long)i * G + c; if (L >= nwg) return false;
        int wgid = (int)L; { const int q = nwg / 8, r = nwg % 8, xcd = wgid % 8, off = wgid / 8; wgid = (xcd < r ? xcd * (q + 1) : r * (q + 1) + (xcd - r) * q) + off; }
        const int nig = 8 * nN, gid = wgid / nig, fm = gid * 8, gsz = (nM - fm) < 8 ? (nM - fm) : 8;
        u.pm = fm + ((wgid % nig) % gsz); u.pn = (wgid % nig) / gsz; u.z = 0; u.rl = 0;
        u.A = A + (size_t)u.pm * tstepA; u.B = B + (size_t)u.pn * tstepB; return true;
    }
};
}

struct Frame {
    LAS unsigned char* lds; volatile LAS unsigned* MISC; unsigned* ctl;
    int tid, lane, wave, vcu, G;
    const float* in[34]; float* out; unsigned char* ws;
};
#define WSP(T_, off) ((T_*)(F.ws + (off)))

struct EpiInProj {
    const float* bias; bf16 *xrnn, *gy, *acat, *gates;
    __device__ __forceinline__ void operator()(const f32x4 (&acc)[2][2][4][2], const g8::Unit& u, int wr, int wc, int fr, int fq) const {
        const int pn = u.pn, colb = pn * 256 + wc * 32 + 8 * fq;
        f32x4 bv[2][2];
#pragma unroll
        for (int bj = 0; bj < 2; ++bj)
#pragma unroll
            for (int n = 0; n < 2; ++n) bv[bj][n] = *(const f32x4*)(bias + colb + bj * 128 + 4 * n);
#pragma unroll
        for (int ai = 0; ai < 2; ++ai)
#pragma unroll
            for (int m = 0; m < 4; ++m) { const int t = u.pm * 256 + ai * 128 + wr * 64 + m * 16 + fr;
#pragma unroll
                for (int bj = 0; bj < 2; ++bj) { f32x4 v0 = acc[ai][bj][m][0] + bv[bj][0], v1 = acc[ai][bj][m][1] + bv[bj][1]; const int col = colb + bj * 128;
                    if (pn < 4) { *(u32x4*)(xrnn + (size_t)t * 1024 + col) = pack8(v0, v1); }
                    else if (pn < 8) {
#pragma unroll
                        for (int j = 0; j < 4; ++j) { v0[j] = gelu_tanh(v0[j]); v1[j] = gelu_tanh(v1[j]); }
                        *(u32x4*)(gy + (size_t)t * 1024 + (col - 1024)) = pack8(v0, v1); }
                    else if (pn < 10) { const int cu = col - 2048, g = cu >> 4, c = cu & 15;
                        *(u32x4*)(acat + ((size_t)(g * S5M + (t >> 5)) * S5ROW + 128 + (t & 31) * 16 + c)) = pack8(v0, v1); }
                    else {
#pragma unroll
                        for (int j = 0; j < 4; ++j) { v0[j] = fast_sigmoid(v0[j]); v1[j] = fast_sigmoid(v1[j]); }
                        *(u32x4*)(gates + (size_t)t * 2048 + (col - 2560)) = pack8(v0, v1); } } }
    }
};
struct EpiS5A {
    float* S;
    __device__ __forceinline__ void operator()(const f32x4 (&acc)[2][2][4][2], const g8::Unit& u, int wr, int wc, int fr, int fq) const {
        const int col = wc * 32 + 8 * fq;
#pragma unroll
        for (int ai = 0; ai < 2; ++ai)
#pragma unroll
            for (int m = 0; m < 4; ++m) { const int row = u.pm * 256 + ai * 128 + wr * 64 + m * 16 + fr; float* p = S + ((size_t)(u.z * S5M + row)) * 128 + col;
                *(f32x4*)p = acc[ai][0][m][0]; *(f32x4*)(p + 4) = acc[ai][0][m][1]; }
    }
};
struct EpiS5C {
    bf16* ys;
    __device__ __forceinline__ void operator()(const f32x4 (&acc)[2][2][4][2], const g8::Unit& u, int wr, int wc, int fr, int fq) const {
#pragma unroll
        for (int ai = 0; ai < 2; ++ai)
#pragma unroll
            for (int m = 0; m < 4; ++m) { const int row = u.pm * 256 + ai * 128 + wr * 64 + m * 16 + fr;
#pragma unroll
                for (int bj = 0; bj < 2; ++bj) { const int n = u.pn * 256 + bj * 128 + wc * 32 + 8 * fq, i = n >> 4, c = n & 15; f32x4 v0 = acc[ai][bj][m][0], v1 = acc[ai][bj][m][1];
#pragma unroll
                    for (int j = 0; j < 4; ++j) { v0[j] = gelu_tanh(v0[j]); v1[j] = gelu_tanh(v1[j]); }
                    u32x2 w8; w8.x = pk4_fp8(v0[0], v0[1], v0[2], v0[3]); w8.y = pk4_fp8(v1[0], v1[1], v1[2], v1[3]); *(u32x2*)((unsigned char*)ys + (size_t)(row * 32 + i) * 512 + u.z * 16 + c) = w8; } }
    }
};
struct EpiGlu {
    const bf16* gates; bf16* gb;
    __device__ __forceinline__ void operator()(const f32x4 (&acc)[2][2][4][2], const g8::Unit& u, int wr, int wc, int fr, int fq) const {
        const int f = u.pn * 128 + wc * 32 + 8 * fq;
#pragma unroll
        for (int ai = 0; ai < 2; ++ai)
#pragma unroll
            for (int m = 0; m < 4; ++m) { const int t = u.pm * 256 + ai * 128 + wr * 64 + m * 16 + fr;
                const u32x4 gw = *(const u32x4*)(gates + (size_t)t * 2048 + 1024 + f); f32x4 g0, g1; unpack8(gw, g0, g1);
                f32x4 v0 = acc[ai][0][m][0], v1 = acc[ai][0][m][1]; const f32x4 s0 = acc[ai][1][m][0], s1 = acc[ai][1][m][1];
#pragma unroll
                for (int j = 0; j < 4; ++j) { v0[j] = g0[j] * v0[j] * fast_sigmoid(s0[j]); v1[j] = g1[j] * v1[j] * fast_sigmoid(s1[j]); }
                *(u32x4*)(gb + (size_t)t * 1024 + f) = pack8(v0, v1); }
    }
};
struct EpiRnn {
    const bf16* gates; const bf16* gb; bf16* merged;
    __device__ __forceinline__ void operator()(const f32x4 (&acc)[2][2][4][2], const g8::Unit& u, int wr, int wc, int fr, int fq) const {
#pragma unroll
        for (int ai = 0; ai < 2; ++ai)
#pragma unroll
            for (int m = 0; m < 4; ++m) { const int t = u.pm * 256 + ai * 128 + wr * 64 + m * 16 + fr;
#pragma unroll
                for (int bj = 0; bj < 2; ++bj) { const int col = u.pn * 256 + bj * 128 + wc * 32 + 8 * fq;
                    const u32x4 gw = *(const u32x4*)(gates + (size_t)t * 2048 + col), bw = *(const u32x4*)(gb + (size_t)t * 1024 + col);
                    f32x4 g0, g1, b0, b1; unpack8(gw, g0, g1); unpack8(bw, b0, b1);
                    const f32x4 v0 = g0 * acc[ai][bj][m][0] + b0, v1 = g1 * acc[ai][bj][m][1] + b1;
                    u32x2 w8; w8.x = pk4_fp8(v0[0], v0[1], v0[2], v0[3]); w8.y = pk4_fp8(v1[0], v1[1], v1[2], v1[3]); *(u32x2*)((unsigned char*)merged + (size_t)t * 1024 + col) = w8; } }
    }
};
struct EpiOut {
    const float* x; const float* mod; bf16* v1;
    __device__ __forceinline__ void operator()(const f32x4 (&acc)[2][2][4][2], const g8::Unit& u, int wr, int wc, int fr, int fq) const {
        const int b = (u.pm * 256) >> 12;
#pragma unroll
        for (int bj = 0; bj < 2; ++bj) { const int col = u.pn * 256 + bj * 128 + wc * 32 + 8 * fq;
            const f32x4 ga = *(const f32x4*)(mod + b * 6144 + 2048 + col) + 1.0f, gb_ = *(const f32x4*)(mod + b * 6144 + 2048 + col + 4) + 1.0f;
#pragma unroll
            for (int ai = 0; ai < 2; ++ai)
#pragma unroll
                for (int m = 0; m < 4; ++m) { const int t = u.pm * 256 + ai * 128 + wr * 64 + m * 16 + fr;
                    const f32x4 x0 = *(const f32x4*)(x + (size_t)t * 1024 + col), x1 = *(const f32x4*)(x + (size_t)t * 1024 + col + 4);
                    const f32x4 v0 = x0 * DN_ALPHA + ga * acc[ai][bj][m][0], v1_ = x1 * DN_ALPHA + gb_ * acc[ai][bj][m][1];
                    *(u32x4*)(v1 + (size_t)t * 1024 + col) = pack8(v0, v1_); } }
    }
};
struct EpiMoe1 {
    const float* bgu; bf16* act;
    __device__ __forceinline__ void operator()(const f32x4 (&acc)[2][2][4][2], const g8::Unit& u, int wr, int wc, int fr, int fq) const {
        const int f = u.pn * 128 + wc * 32 + 8 * fq; const float* bp = bgu + (size_t)u.z * 2048 + f;
        const f32x4 bg0 = *(const f32x4*)bp, bg1 = *(const f32x4*)(bp + 4), bu0 = *(const f32x4*)(bp + 1024), bu1 = *(const f32x4*)(bp + 1028);
#pragma unroll
        for (int ai = 0; ai < 2; ++ai)
#pragma unroll
            for (int m = 0; m < 4; ++m) { const int row = u.pm * 256 + ai * 128 + wr * 64 + m * 16 + fr;
                f32x4 g0 = acc[ai][0][m][0] + bg0, g1 = acc[ai][0][m][1] + bg1, u0 = acc[ai][1][m][0] + bu0, u1 = acc[ai][1][m][1] + bu1;
#pragma unroll
                for (int j = 0; j < 4; ++j) { const float ga = fminf(g0[j], 7.0f), gb_ = fminf(g1[j], 7.0f), ua = fminf(fmaxf(u0[j], -7.0f), 7.0f), ub = fminf(fmaxf(u1[j], -7.0f), 7.0f);
                    g0[j] = ga * fast_sigmoid(1.702f * ga) * (ua + 1.0f); g1[j] = gb_ * fast_sigmoid(1.702f * gb_) * (ub + 1.0f); }
                u32x2 w8; w8.x = pk4_fp8(g0[0], g0[1], g0[2], g0[3]); w8.y = pk4_fp8(g1[0], g1[1], g1[2], g1[3]); *(u32x2*)((unsigned char*)act + (size_t)row * 1024 + f) = w8; }
    }
};
struct EpiMoe2 {
    const float* bd; bf16* yb;
    __device__ __forceinline__ void operator()(const f32x4 (&acc)[2][2][4][2], const g8::Unit& u, int wr, int wc, int fr, int fq) const {
#pragma unroll
        for (int bj = 0; bj < 2; ++bj) { const int col = u.pn * 256 + bj * 128 + wc * 32 + 8 * fq; const float* bp = bd + (size_t)u.z * 1024 + col;
            const f32x4 b0 = *(const f32x4*)bp, b1 = *(const f32x4*)(bp + 4);
#pragma unroll
            for (int ai = 0; ai < 2; ++ai)
#pragma unroll
                for (int m = 0; m < 4; ++m) { const int row = u.pm * 256 + ai * 128 + wr * 64 + m * 16 + fr;
                    const f32x4 y0 = acc[ai][bj][m][0] + b0, y1 = acc[ai][bj][m][1] + b1; u32x2 w8; w8.x = pk4_fp8(y0[0], y0[1], y0[2], y0[3]); w8.y = pk4_fp8(y1[0], y1[1], y1[2], y1[3]);
                    *(u32x2*)((unsigned char*)yb + (size_t)row * 1024 + col) = w8; } }
    }
};

struct S5AOrder { int G, c; const char* acat; const char* ws;
    __device__ __forceinline__ bool next(int i, g8::Unit& u) const { const int L = i * G + c; if (L >= S5G * 4) return false; u.z = L >> 2; u.pm = L & 3; u.pn = 0; u.rl = 0;
        u.A = acat + ((size_t)(u.z * S5M + u.pm * 256) * S5ROW + 128) * 2; u.B = ws + (size_t)u.z * 256 * (S5L * 16) * 2; return true; } };
struct S5COrder { int G, c; const char* acat; const char* wy;
    __device__ __forceinline__ bool next(int i, g8::Unit& u) const { const int L = i * G + c; if (L >= S5G * 8) return false; u.z = L >> 3; u.pm = (L >> 1) & 3; u.pn = L & 1; u.rl = 0;
        u.A = acat + ((size_t)(u.z * S5M + u.pm * 256) * S5ROW) * 2; u.B = wy + ((size_t)(u.z * 512 + u.pn * 256) * S5ROW) * 2; return true; } };
struct MoeOrder { int G, c, NT, RT; const LAS int* tstart; const LAS int* cnt; const int* toklist; const char* A; const char* B; size_t bstride_e; int lda; bool gatherA;
    __device__ __forceinline__ bool next(int i, g8::Unit& u) const { const int per = G >> 3, xcd = c & 7, slot = c >> 3, rpx = per / NT;
        const int rt = (i * 8 + xcd) * rpx + slot / NT; if (rt >= RT) return false; u.pn = slot % NT;
        int e = 0;
#pragma unroll 1
        for (int k = 1; k < NE; ++k) if (tstart[k] <= rt) e = k;
        u.z = e; u.pm = rt; u.rl = rt - tstart[e]; u.B = B + (size_t)e * bstride_e + (size_t)u.pn * 256 * 1024; u.A = gatherA ? A : A + (size_t)rt * 256 * 1024; return true; }
    __device__ __forceinline__ void gather(const g8::Unit& u, const int (&Rr)[2], const int (&Cc)[2], unsigned (&vo)[2][2]) const {
        const int n = cnt[u.z];
#pragma unroll
        for (int h = 0; h < 2; ++h)
#pragma unroll
            for (int i = 0; i < 2; ++i) { const int r = u.rl * 256 + h * 128 + Rr[i]; const int tok = r < n ? toklist[u.z * T + r] : 0; vo[h][i] = (unsigned)(tok * lda + Cc[i] * 2); } }
};

__device__ __forceinline__ void transpose_item(const float* W, int N, int k0, int n0, bf16* dst, int ldd, int drow0, LAS float* scr, int lane) {
#pragma unroll 8
    for (int i = 0; i < 32; ++i) { const int kk = 2 * i + (lane >> 5); scr[kk * 33 + (lane & 31)] = W[(size_t)(k0 + kk) * N + n0 + (lane & 31)]; }
    asm volatile("s_waitcnt lgkmcnt(0)" ::: "memory");
    const int c = lane & 7;
#pragma unroll
    for (int j = 0; j < 4; ++j) { const int n = (lane >> 3) + 8 * j; const LAS float* s = scr + (8 * c) * 33 + n;
        u32x4 o; o.x = pk2(s[0 * 33], s[1 * 33]); o.y = pk2(s[2 * 33], s[3 * 33]); o.z = pk2(s[4 * 33], s[5 * 33]); o.w = pk2(s[6 * 33], s[7 * 33]);
        *(u32x4*)(dst + (size_t)(drow0 + n) * ldd + k0 + 8 * c) = o; }
    asm volatile("s_waitcnt lgkmcnt(0)" ::: "memory");
}
__device__ __forceinline__ void transpose_item8(const float* W, int N, int k0, int n0, unsigned char* dst, int ldd, int drow0, LAS float* scr, int lane) {
#pragma unroll 8
    for (int i = 0; i < 32; ++i) { const int kk = 2 * i + (lane >> 5); scr[kk * 33 + (lane & 31)] = W[(size_t)(k0 + kk) * N + n0 + (lane & 31)]; }
    asm volatile("s_waitcnt lgkmcnt(0)" ::: "memory");
    const int c = lane & 7;
#pragma unroll
    for (int j = 0; j < 4; ++j) { const int n = (lane >> 3) + 8 * j; const LAS float* s = scr + (8 * c) * 33 + n;
        u32x2 o; o.x = pk4_fp8(32.f * s[0 * 33], 32.f * s[1 * 33], 32.f * s[2 * 33], 32.f * s[3 * 33]); o.y = pk4_fp8(32.f * s[4 * 33], 32.f * s[5 * 33], 32.f * s[6 * 33], 32.f * s[7 * 33]);
        *(u32x2*)(dst + (size_t)(drow0 + n) * ldd + k0 + 8 * c) = o; }
    asm volatile("s_waitcnt lgkmcnt(0)" ::: "memory");
}
__device__ __forceinline__ void transpose_item8w(const float* W, int N, int k0, int n0, unsigned char* dst, int ldd, int drow0, LAS float* scr, int lane) {
    float wv[64]; const float* wp = W + (size_t)(k0 + (lane >> 5)) * N + n0 + (lane & 31);
#pragma unroll
    for (int i = 0; i < 64; ++i) wv[i] = wp[(size_t)(2 * i) * N];
#pragma unroll
    for (int i = 0; i < 64; ++i) scr[(2 * i + (lane >> 5)) * 33 + (lane & 31)] = wv[i];
    asm volatile("s_waitcnt lgkmcnt(0)" ::: "memory");
    const int c = lane & 7;
#pragma unroll
    for (int j = 0; j < 4; ++j) { const int n = (lane >> 3) + 8 * j; const LAS float* s = scr + (16 * c) * 33 + n;
        u32x4 o; o.x = pk4_fp8(32.f * s[0 * 33], 32.f * s[1 * 33], 32.f * s[2 * 33], 32.f * s[3 * 33]); o.y = pk4_fp8(32.f * s[4 * 33], 32.f * s[5 * 33], 32.f * s[6 * 33], 32.f * s[7 * 33]);
        o.z = pk4_fp8(32.f * s[8 * 33], 32.f * s[9 * 33], 32.f * s[10 * 33], 32.f * s[11 * 33]); o.w = pk4_fp8(32.f * s[12 * 33], 32.f * s[13 * 33], 32.f * s[14 * 33], 32.f * s[15 * 33]);
        *(u32x4*)(dst + (size_t)(drow0 + n) * ldd + k0 + 16 * c) = o; }
    asm volatile("s_waitcnt lgkmcnt(0)" ::: "memory");
}
__device__ __forceinline__ int pair_row(int n) { const int f = n & 1023, hi = n >> 10; return (f >> 7) * 256 + hi * 128 + (f & 127); }

__device__ __forceinline__ void moe_tables(Frame& F) {
    LAS int* tstart = (LAS int*)(F.lds + TAB_OFF); LAS int* cl = tstart + 40;
    if (F.tid == 0) { int acc = 0; for (int e = 0; e < NE; ++e) { const int c = (int)F.ctl[CW_CNT + 64 * e]; cl[e] = c; tstart[e] = acc; acc += (c + 255) >> 8; } tstart[NE] = acc; }
    __syncthreads();
}

__device__ __forceinline__ void p0_mod_job(Frame& F, int job) {
    LAS float* sc = (LAS float*)F.lds;
    LAS float* red = sc + 8 * 1024;
    const float* c = F.in[1]; const float* w = F.in[2]; const float* bias = F.in[3];
    for (int i = F.tid; i < 8 * 1024; i += 512) { const float v = c[i]; sc[i] = v * fast_sigmoid(v); }
    __syncthreads();
    const int col = F.tid & 31, kg = F.tid >> 5, j = job * 32 + col;
    float a[8];
#pragma unroll
    for (int b = 0; b < 8; ++b) a[b] = 0.f;
#pragma unroll 8
    for (int k = kg * 64; k < kg * 64 + 64; ++k) { const float wv = w[(size_t)k * 6144 + j];
#pragma unroll
        for (int b = 0; b < 8; ++b) a[b] += sc[b * 1024 + k] * wv; }
#pragma unroll
    for (int b = 0; b < 8; ++b) red[(kg * 8 + b) * 32 + col] = a[b];
    __syncthreads();
    if (F.tid < 256) { const int b = F.tid >> 5, cc = F.tid & 31; float s = 0.f;
#pragma unroll
        for (int g = 0; g < 16; ++g) s += red[(g * 8 + b) * 32 + cc];
        WSP(float, WS_MOD)[b * 6144 + job * 32 + cc] = s + bias[job * 32 + cc]; }
    __syncthreads();
}
__device__ __forceinline__ void s5_setup(Frame& F, int g, int kmin, int kmax, LAS f32x2* Bb, LAS f32x2* Cc, LAS f32x2* Ap) {
    const float* lre = F.in[14] + g * 64; const float* lim = F.in[15] + g * 64; const float dt = expf(F.in[16][g]);
    const float* bre = F.in[17] + g * 1024; const float* bim = F.in[18] + g * 1024; const float* cre = F.in[19] + g * 1024; const float* cim = F.in[20] + g * 1024;
    for (int i = F.tid; i < 1024; i += 512) { const int p = i >> 4; const float lr = lre[p], li = lim[p]; const float mag = expf(lr * dt); float sn, cs; sincosf(li * dt, &sn, &cs);
        const float ar = mag * cs, ai = mag * sn, den = lr * lr + li * li, qr = ((ar - 1.f) * lr + ai * li) / den, qi = (ai * lr - (ar - 1.f) * li) / den;
        const float br = bre[i], bi = bim[i]; Bb[i] = (f32x2){qr * br - qi * bi, qr * bi + qi * br};
        Cc[i] = (f32x2){cre[i], cim[i]}; }
    for (int i = kmin * 64 + F.tid; i < (kmax + 1) * 64; i += 512) { const int k = i >> 6, p = i & 63; const float lr = lre[p], li = lim[p]; const float mag = expf((float)k * lr * dt); float sn, cs; sincosf((float)k * li * dt, &sn, &cs);
        Ap[i] = (f32x2){mag * cs, mag * sn}; }
    __syncthreads();
}
constexpr size_t WS_KTAB = WS_S;
constexpr size_t WS_WRIMG = WS_AL + 512 * 1024;
__device__ __forceinline__ void p0_s5k_job(Frame& F, int job) {
    const int g = job >> 3, part = job & 7;
    LAS f32x2* Bb = (LAS f32x2*)F.lds; LAS f32x2* Cc = Bb + 1024; LAS f32x2* Ap = Cc + 1024;
    s5_setup(F, g, 4 * part, 4 * part + 3, Bb, Cc, Ap);
    float* kt = WSP(float, WS_KTAB) + (size_t)g * 32 * 256;
    for (int e = 4 * part * 256 + F.tid; e < (4 * part + 4) * 256; e += 512) { const int k = e >> 8, c = (e >> 4) & 15, c2 = e & 15; float s = 0.f;
        for (int p = 0; p < 64; ++p) { const f32x2 cv = Cc[c * 64 + p], av = Ap[k * 64 + p], bv = Bb[p * 16 + c2];
            const float car = cv.x * av.x - cv.y * av.y, cai = cv.x * av.y + cv.y * av.x; s += car * bv.x - cai * bv.y; }
        kt[e] = s; }
    __syncthreads();
}
__device__ __forceinline__ void p1_s5w_job(Frame& F, int job) {
    const int g = job >> 3, part = job & 7;
    LAS f32x2* Bb = (LAS f32x2*)F.lds; LAS f32x2* Cc = Bb + 1024; LAS f32x2* Ap = Cc + 1024; LAS float* Kt = (LAS float*)(Ap + 33 * 64);
    const float* ktg = WSP(float, WS_KTAB) + (size_t)g * 32 * 256; const float* dsk = F.in[21] + g * 16;
    for (int i = F.tid; i < 32 * 256; i += 512) Kt[i] = ktg[i];
    s5_setup(F, g, 0, S5L, Bb, Cc, Ap);
    if (part == 0 && F.tid < 64) WSP(f32x2, WS_AL)[g * 64 + F.tid] = Ap[S5L * 64 + F.tid];
    bf16* wy = WSP(bf16, WS_WY) + (size_t)g * 512 * S5ROW;
    for (int ch = F.tid; ch < 64 * (S5ROW / 8); ch += 512) { const int n = part * 64 + ch / (S5ROW / 8), k8 = (ch % (S5ROW / 8)) * 8, i = n >> 4, c = n & 15; float v[8];
        if (k8 < 128) {
#pragma unroll
            for (int j = 0; j < 8; j += 2) { const int p = (k8 + j) >> 1; const f32x2 cv = Cc[c * 64 + p], av = Ap[(i + 1) * 64 + p]; v[j] = cv.x * av.x - cv.y * av.y; v[j + 1] = -(cv.x * av.y + cv.y * av.x); } }
        else { const int jj = (k8 - 128) >> 4, c2 = (k8 - 128) & 15;
#pragma unroll
            for (int j = 0; j < 8; ++j) { float x = 0.f; if (jj <= i) { x = Kt[(i - jj) * 256 + c * 16 + c2 + j]; if (jj == i && c == c2 + j) x += dsk[c]; } v[j] = x; } }
        u32x4 o; o.x = pk2(v[0], v[1]); o.y = pk2(v[2], v[3]); o.z = pk2(v[4], v[5]); o.w = pk2(v[6], v[7]);
        *(u32x4*)(wy + (size_t)n * S5ROW + k8) = o; }
    bf16* wsm = WSP(bf16, WS_WS) + (size_t)g * 256 * 512;
    for (int ch = F.tid; ch < 32 * 64; ch += 512) { const int n = part * 32 + (ch >> 6), k8 = (ch & 63) * 8, jj = k8 >> 4, c2 = k8 & 15; float v[8];
#pragma unroll
        for (int j = 0; j < 8; ++j) { float x = 0.f; if (n < 128) { const int p = n >> 1; const f32x2 av = Ap[(S5L - 1 - jj) * 64 + p], bv = Bb[p * 16 + c2 + j]; x = (n & 1) ? (av.x * bv.y + av.y * bv.x) : (av.x * bv.x - av.y * bv.y); } v[j] = x; }
        u32x4 o; o.x = pk2(v[0], v[1]); o.y = pk2(v[2], v[3]); o.z = pk2(v[4], v[5]); o.w = pk2(v[6], v[7]);
        *(u32x4*)(wsm + (size_t)n * 512 + k8) = o; }
    __syncthreads();
}
__device__ __forceinline__ void p0_small_transposes(Frame& F) {
    LAS float* scr = (LAS float*)(F.lds + F.wave * 16384);
    const int gw = F.vcu * 8 + F.wave, NGW = F.G * 8;
    constexpr int I_IN = 16 * 144, I_RNN = 16 * 32, I_OUT = 16 * 32, I_GLU = 8 * 64, I_RG = 16 * 8;
    for (int it = gw; it < I_IN + I_RNN + I_OUT + I_GLU + I_RG; it += NGW) { int r = it;
        if (r < I_IN) { const int kb = r / 144, nb = r % 144; transpose_item8(F.in[4], INC, kb * 64, nb * 32, WSP(unsigned char, WS_WIN), 1024, nb * 32, scr, F.lane); continue; } r -= I_IN;
        if (r < I_RNN) { const int kb = r / 32, nb = r % 32; transpose_item8(F.in[13], 1024, kb * 64, nb * 32, WSP(unsigned char, WS_WRNN), 1024, nb * 32, scr, F.lane); continue; } r -= I_RNN;
        if (r < I_OUT) { const int kb = r / 32, nb = r % 32; transpose_item8(F.in[23], 1024, kb * 64, nb * 32, WSP(unsigned char, WS_WOUT), 1024, nb * 32, scr, F.lane); continue; } r -= I_OUT;
        if (r < I_GLU) { const int kb = r / 64, nb = r % 64; transpose_item8(F.in[22], 2048, kb * 64, nb * 32, WSP(unsigned char, WS_WGLU), 512, pair_row(nb * 32), scr, F.lane); continue; } r -= I_GLU;
        { const int mat = r >> 3, kb = (r >> 2) & 1, nb = r & 3, hd = mat & 7, gx = mat >> 3;
          transpose_item(F.in[gx ? 10 : 8] + (size_t)hd * 128 * 128, 128, kb * 64, nb * 32, WSP(bf16, WS_WG), 128, hd * 256 + gx * 128 + nb * 32, scr, F.lane); }
    }
}
__device__ __forceinline__ void p1_body(Frame& F) {
    const int gw = F.vcu * 8 + F.wave, NGW = F.G * 8; const float* mod = WSP(float, WS_MOD); bf16* hbf = WSP(bf16, WS_HBF);
    for (int tb = gw; tb < T; tb += 4 * NGW) {
        f32x4 xv[4][4];
#pragma unroll
        for (int r = 0; r < 4; ++r) { const int t = tb + r * NGW; const f32x4* xr = (const f32x4*)(F.in[0] + (size_t)(t < T ? t : 0) * 1024) + F.lane;
#pragma unroll
            for (int j = 0; j < 4; ++j) xv[r][j] = xr[64 * j]; }
#pragma unroll
        for (int r = 0; r < 4; ++r) { const int t = tb + r * NGW; if (t < T) { const int b = t >> 12; const f32x4* sh = (const f32x4*)(mod + b * 6144) + F.lane; const f32x4* sc = (const f32x4*)(mod + b * 6144 + 1024) + F.lane;
            unsigned* o = (unsigned*)((unsigned char*)hbf + (size_t)t * 1024) + F.lane;
#pragma unroll
            for (int j = 0; j < 4; ++j) { const f32x4 v = xv[r][j] * (sc[64 * j] + 1.0f) + sh[64 * j]; o[64 * j] = pk4_fp8(v[0], v[1], v[2], v[3]); } } } }
    constexpr int TP = 132;
    LAS float* tile = (LAS float*)F.lds;
    constexpr int TILES_GU = 8 * 16, TILES_D = 8 * 8, TILES_E = TILES_GU + TILES_D;
    const int lr = F.tid >> 5, lc4 = (F.tid & 31) * 4, tn = F.tid >> 2, kc = F.tid & 3;
    f32x4 pre[8];
    int ti = F.vcu;
#define P1_SRC(idx, src, N_, dstp, drow0_, k0_) do { const int e_ = (idx) / TILES_E, r_ = (idx) % TILES_E; \
        if (r_ < TILES_GU) { const int kb_ = r_ >> 4, nb_ = r_ & 15; N_ = 2048; src = F.in[28] + (size_t)e_ * 1024 * 2048 + (size_t)(kb_ * 128) * 2048 + nb_ * 128; dstp = WSP(unsigned char, WS_WGU) + (size_t)e_ * 2048 * 1024; drow0_ = pair_row(nb_ * 128); k0_ = kb_ * 128; } \
        else { const int q_ = r_ - TILES_GU, kb_ = q_ >> 3, nb_ = q_ & 7; N_ = 1024; src = F.in[30] + (size_t)e_ * 1024 * 1024 + (size_t)(kb_ * 128) * 1024 + nb_ * 128; dstp = WSP(unsigned char, WS_WD) + (size_t)e_ * 1024 * 1024; drow0_ = nb_ * 128; k0_ = kb_ * 128; } } while (0)
    if (ti < NE * TILES_E) { const float* src; unsigned char* dstp; int N_, d0, k0; P1_SRC(ti, src, N_, dstp, d0, k0);
#pragma unroll
        for (int i = 0; i < 8; ++i) pre[i] = *(const f32x4*)(src + (size_t)(lr + 16 * i) * N_ + lc4); }
    for (; ti < NE * TILES_E; ti += F.G) {
#pragma unroll
        for (int i = 0; i < 8; ++i) *(LAS f32x4*)(tile + (lr + 16 * i) * TP + lc4) = pre[i];
        __syncthreads();
        const int tnx = ti + F.G;
        if (tnx < NE * TILES_E) { const float* src; unsigned char* dstp; int N_, d0, k0; P1_SRC(tnx, src, N_, dstp, d0, k0);
#pragma unroll
            for (int i = 0; i < 8; ++i) pre[i] = *(const f32x4*)(src + (size_t)(lr + 16 * i) * N_ + lc4); }
        { const float* src; unsigned char* dstp; int N_, d0, k0; P1_SRC(ti, src, N_, dstp, d0, k0); (void)src; (void)N_;
          const LAS float* cp = tile + (32 * kc) * TP + tn; u32x4 o0, o1;
          o0.x = pk4_fp8(32.f * cp[0 * TP], 32.f * cp[1 * TP], 32.f * cp[2 * TP], 32.f * cp[3 * TP]); o0.y = pk4_fp8(32.f * cp[4 * TP], 32.f * cp[5 * TP], 32.f * cp[6 * TP], 32.f * cp[7 * TP]);
          o0.z = pk4_fp8(32.f * cp[8 * TP], 32.f * cp[9 * TP], 32.f * cp[10 * TP], 32.f * cp[11 * TP]); o0.w = pk4_fp8(32.f * cp[12 * TP], 32.f * cp[13 * TP], 32.f * cp[14 * TP], 32.f * cp[15 * TP]);
          o1.x = pk4_fp8(32.f * cp[16 * TP], 32.f * cp[17 * TP], 32.f * cp[18 * TP], 32.f * cp[19 * TP]); o1.y = pk4_fp8(32.f * cp[20 * TP], 32.f * cp[21 * TP], 32.f * cp[22 * TP], 32.f * cp[23 * TP]);
          o1.z = pk4_fp8(32.f * cp[24 * TP], 32.f * cp[25 * TP], 32.f * cp[26 * TP], 32.f * cp[27 * TP]); o1.w = pk4_fp8(32.f * cp[28 * TP], 32.f * cp[29 * TP], 32.f * cp[30 * TP], 32.f * cp[31 * TP]);
          unsigned char* op = dstp + (size_t)(d0 + tn) * 1024 + k0 + 32 * kc; *(u32x4*)op = o0; *(u32x4*)(op + 16) = o1; }
        __syncthreads();
    }
#undef P1_SRC
}
constexpr int XR_LD = 136, XR_TILE = 128 * XR_LD;
__device__ __forceinline__ void rg_issue(const bf16* xrnn, const bf16* gy, int item, int tid, u32x4 (&xraw)[4][4], u32x4 (&graw)[4], bool pass1) {
    const int hd = item & 7, c = (item >> 3) & 31, b = item >> 8, r0 = tid >> 4, ch = hd * 128 + (tid & 15) * 8;
#pragma unroll
    for (int q = 0; q < 4; ++q) { const int r = r0 + 32 * q;
#pragma unroll
        for (int k = 0; k < 4; ++k) { const int tp = c * RGL + r - 3 + k, tpc = tp < 0 ? 0 : tp; xraw[q][k] = *(const u32x4*)(xrnn + (size_t)(b * SEQ + tpc) * 1024 + ch); }
        if (pass1) graw[q] = *(const u32x4*)(gy + (size_t)(b * SEQ + c * RGL + r) * 1024 + ch); }
}
__device__ __forceinline__ void rg_convwrite(const float* cw, const float* cb, int item, int tid, const u32x4 (&xraw)[4][4], const u32x4 (&graw)[4], LAS bf16* xr, LAS bf16* gyt, bool pass1) {
    const int hd = item & 7, c = (item >> 3) & 31, r0 = tid >> 4, c8 = (tid & 15) * 8, ch = hd * 128 + c8;
    const f32x4 b0 = *(const f32x4*)(cb + ch), b1 = *(const f32x4*)(cb + ch + 4);
    f32x4 w0[4], w1[4];
#pragma unroll
    for (int k = 0; k < 4; ++k) { w0[k] = *(const f32x4*)(cw + k * 1024 + ch); w1[k] = *(const f32x4*)(cw + k * 1024 + ch + 4); }
#pragma unroll
    for (int q = 0; q < 4; ++q) { const int r = r0 + 32 * q; f32x4 a0 = b0, a1 = b1;
#pragma unroll
        for (int k = 0; k < 4; ++k) { const int tp = c * RGL + r - 3 + k; f32x4 x0, x1; unpack8(xraw[q][k], x0, x1); if (tp < 0) { x0 = (f32x4){0.f, 0.f, 0.f, 0.f}; x1 = x0; } a0 += w0[k] * x0; a1 += w1[k] * x1; }
        *(LAS u32x4*)(xr + r * XR_LD + c8) = pack8(a0, a1);
        if (pass1) *(LAS u32x4*)(gyt + r * XR_LD + c8) = graw[q]; }
}
template <int PASS>
__device__ __forceinline__ void rglru_phase(Frame& F) {
    const int NIT = NB * RGC * 8;
    int it = F.vcu; if (it >= NIT) return;
    LAS bf16* xr = (LAS bf16*)F.lds; LAS bf16* gyt0 = xr + XR_TILE;
    const bf16* xrnn = WSP(bf16, WS_XRNN); const bf16* gy = WSP(bf16, WS_GY); bf16* ha = WSP(bf16, WS_HA); const float* cw = F.in[6]; const float* cb = F.in[7];
    const int tid = F.tid, w = F.wave, q = F.lane >> 4, col = F.lane & 15, chl = 16 * w + col;
    u32x4 xraw[4][4], graw[4];
    rg_issue(xrnn, gy, it, tid, xraw, graw, PASS);
    rg_convwrite(cw, cb, it, tid, xraw, graw, xr, gyt0, PASS);
    int hd_loaded = -1; bf16x8 Bf[2][4]; float ba = 0.f, bx = 0.f, sp = 0.f;
    __syncthreads();
    for (int i = 0; it < NIT; ++i) {
        const int nit = it + F.G; const bool has_next = nit < NIT;
        const int hd = it & 7, c = (it >> 3) & 31, b = it >> 8, t0 = b * SEQ + c * RGL, ch = hd * 128 + chl;
        LAS bf16* gyt = gyt0 + (i & 1) * XR_TILE; LAS bf16* gytn = gyt0 + ((i & 1) ^ 1) * XR_TILE;
        if (has_next) rg_issue(xrnn, gy, nit, tid, xraw, graw, PASS);
        if (hd != hd_loaded) { hd_loaded = hd; const bf16* wg = WSP(bf16, WS_WG) + (size_t)hd * 256 * 128;
#pragma unroll
            for (int gt = 0; gt < 2; ++gt)
#pragma unroll
                for (int kk = 0; kk < 4; ++kk) Bf[gt][kk] = *(const bf16x8*)(wg + (size_t)(gt * 128 + chl) * 128 + kk * 32 + q * 8);
            ba = F.in[9][ch]; bx = F.in[11][ch]; const float lam = F.in[12][ch]; sp = (lam > 15.f) ? __expf(-lam) : log1pf(__expf(-lam)); }
        float carryH = 0.f, carryP = 1.f;
        if (PASS) carryH = WSP(float, WS_HIN)[(size_t)(b * RGC + c) * 1024 + ch];
        __builtin_amdgcn_sched_barrier(0);
        f32x4 acc[8][2];
#pragma unroll
        for (int m = 0; m < 8; ++m) { acc[m][0] = (f32x4){0.f, 0.f, 0.f, 0.f}; acc[m][1] = (f32x4){0.f, 0.f, 0.f, 0.f}; }
#pragma unroll
        for (int kk = 0; kk < 4; ++kk)
#pragma unroll
            for (int m = 0; m < 8; ++m) { const bf16x8 Af = *(const LAS bf16x8*)(xr + (16 * m + col) * XR_LD + kk * 32 + q * 8);
                acc[m][0] = __builtin_amdgcn_mfma_f32_16x16x32_bf16(Af, Bf[0][kk], acc[m][0], 0, 0, 0);
                acc[m][1] = __builtin_amdgcn_mfma_f32_16x16x32_bf16(Af, Bf[1][kk], acc[m][1], 0, 0, 0); }
#pragma unroll
        for (int m = 0; m < 8; ++m) {
            float a[4], uu[4];
#pragma unroll
            for (int j = 0; j < 4; ++j) { const int tl = 16 * m + 4 * q + j;
                const float r = fast_sigmoid(acc[m][0][j] + ba), ii = fast_sigmoid(acc[m][1][j] + bx);
                const float la = -11.541560327f * r * sp; a[j] = __builtin_amdgcn_exp2f(la); const float mult = __builtin_amdgcn_sqrtf(fmaxf(1.0f - a[j] * a[j], 0.f));
                uu[j] = mult * ii * bf1(xr[tl * XR_LD + chl]); }
            float sP = a[0], sH = uu[0];
#pragma unroll
            for (int j = 1; j < 4; ++j) { sH = a[j] * sH + uu[j]; sP *= a[j]; }
            float iP = sP, iH = sH;
            { const float pP = __shfl_up(iP, 16), pH = __shfl_up(iH, 16); if (q >= 1) { iH = iP * pH + iH; iP = iP * pP; } }
            { const float pP = __shfl_up(iP, 32), pH = __shfl_up(iH, 32); if (q >= 2) { iH = iP * pH + iH; iP = iP * pP; } }
            float eP = __shfl_up(iP, 16), eH = __shfl_up(iH, 16); if (q == 0) { eP = 1.f; eH = 0.f; }
            const float tP = __shfl(iP, col + 48), tH = __shfl(iH, col + 48);
            if (PASS) { float h = eP * carryH + eH;
#pragma unroll
                for (int j = 0; j < 4; ++j) { const int tl = 16 * m + 4 * q + j; h = a[j] * h + uu[j]; LAS bf16* gp = gyt + tl * XR_LD + chl; *gp = (bf16)f2bf(h * bf1(*gp)); } }
            carryH = tP * carryH + tH; carryP *= tP;
        }
        if (!PASS && q == 0) { f32x2* ag = WSP(f32x2, WS_RGAGG); ag[(size_t)(b * RGC + c) * 1024 + ch] = (f32x2){carryP, carryH}; }
        __syncthreads();
        if (PASS) { const int r0 = tid >> 4, c8 = (tid & 15) * 8;
#pragma unroll
            for (int qq = 0; qq < 4; ++qq) { const int r = r0 + 32 * qq; f32x4 h0, h1; unpack8(*(const LAS u32x4*)(gyt + r * XR_LD + c8), h0, h1); u32x2 w8; w8.x = pk4_fp8(h0[0], h0[1], h0[2], h0[3]); w8.y = pk4_fp8(h1[0], h1[1], h1[2], h1[3]);
                *(u32x2*)((unsigned char*)ha + (size_t)(t0 + r) * 1024 + hd * 128 + c8) = w8; } }
        if (has_next) rg_convwrite(cw, cb, nit, tid, xraw, graw, xr, gytn, PASS);
        __syncthreads();
        it = nit;
    }
}
__device__ __forceinline__ void p4_carries(Frame& F) {
    LAS f32x2* seg = (LAS f32x2*)F.lds;
    for (int job = F.vcu; job < NB * S5G; job += F.G) {
        const int b = job >> 5, g = job & 31, p = F.lane, w = F.wave;
        const f32x2 al = WSP(f32x2, WS_AL)[g * 64 + p];
        const f32x2* Sb = WSP(f32x2, WS_S) + ((size_t)(g * S5M + b * S5CPB + 16 * w)) * 64 + p; unsigned* ac = (unsigned*)(WSP(bf16, WS_ACAT) + ((size_t)(g * S5M + b * S5CPB + 16 * w)) * S5ROW) + p;
        f32x2 sv[16];
#pragma unroll
        for (int i = 0; i < 16; ++i) sv[i] = Sb[(size_t)i * 64];
        float xr_ = 0.f, xi = 0.f;
#pragma unroll
        for (int i = 0; i < 16; ++i) { const float nr = al.x * xr_ - al.y * xi + sv[i].x, ni = al.x * xi + al.y * xr_ + sv[i].y; xr_ = nr; xi = ni; }
        seg[w * 64 + p] = (f32x2){xr_, xi};
        float ar = al.x, ai = al.y;
#pragma unroll
        for (int q = 0; q < 4; ++q) { const float nr = ar * ar - ai * ai, ni = 2.f * ar * ai; ar = nr; ai = ni; }
        __syncthreads();
        xr_ = 0.f; xi = 0.f;
        for (int ww = 0; ww < w; ++ww) { const f32x2 sg = seg[ww * 64 + p]; const float nr = ar * xr_ - ai * xi + sg.x, ni = ar * xi + ai * xr_ + sg.y; xr_ = nr; xi = ni; }
#pragma unroll
        for (int i = 0; i < 16; ++i) { ac[(size_t)i * (S5ROW / 2)] = pk2(xr_, xi); const float nr = al.x * xr_ - al.y * xi + sv[i].x, ni = al.x * xi + al.y * xr_ + sv[i].y; xr_ = nr; xi = ni; }
        __syncthreads();
    }
    if (F.vcu < 16) {
        const int id = F.vcu * 512 + F.tid, ch = id & 1023, b = id >> 10; const f32x2* ag = WSP(f32x2, WS_RGAGG) + (size_t)b * RGC * 1024 + ch; float* hin = WSP(float, WS_HIN) + (size_t)b * RGC * 1024 + ch;
        f32x2 a[RGC];
#pragma unroll
        for (int c = 0; c < RGC; ++c) a[c] = ag[(size_t)c * 1024];
        float h = 0.f;
#pragma unroll
        for (int c = 0; c < RGC; ++c) { hin[(size_t)c * 1024] = h; h = a[c].x * h + a[c].y; }
    }
}
constexpr int WR_LD = 1032;
__device__ __forceinline__ void p9_router(Frame& F) {
    LAS bf16* wH = (LAS bf16*)F.lds; LAS bf16* wL = wH + 32 * WR_LD;
    LAS f32x2* sel = (LAS f32x2*)(wL + 32 * WR_LD);
    LAS unsigned* rec = (LAS unsigned*)(sel + 512);
    LAS float* recp = (LAS float*)(rec + 512);
    LAS int* lcnt = (LAS int*)(recp + 512);
    LAS int* gbase = lcnt + 32;
    { const u32x4* img = WSP(u32x4, WS_WRIMG); LAS u32x4* dst = (LAS u32x4*)wH;
      for (int i = F.tid; i < 2 * 32 * WR_LD * 2 / 16; i += 512) dst[i] = img[i]; }
    if (F.tid < 32) lcnt[F.tid] = 0;
    __syncthreads();
    const float* mod = WSP(float, WS_MOD); const bf16* v1 = WSP(bf16, WS_V1); bf16* x1 = WSP(bf16, WS_X1); unsigned char* h2 = WSP(unsigned char, WS_H2);
    const int lane = F.lane, m = lane & 15, kq = lane >> 4, w = F.wave;
    for (int blk = F.vcu; blk < T / 128; blk += F.G) {
        const int t = blk * 128 + w * 16 + m, b = (blk * 128) >> 12;
        const bf16* vrow = v1 + (size_t)t * 1024 + 8 * kq;
        float sum = 0.f, sq = 0.f;
#pragma unroll 32
        for (int s_ = 0; s_ < 32; ++s_) { f32x4 a, c; unpack8(*(const u32x4*)(vrow + 32 * s_), a, c); sum += ((a[0] + a[1]) + (a[2] + a[3])) + ((c[0] + c[1]) + (c[2] + c[3]));
            sq += ((a[0] * a[0] + a[1] * a[1]) + (a[2] * a[2] + a[3] * a[3])) + ((c[0] * c[0] + c[1] * c[1]) + (c[2] * c[2] + c[3] * c[3])); }
        sum += __shfl_xor(sum, 16); sum += __shfl_xor(sum, 32); sq += __shfl_xor(sq, 16); sq += __shfl_xor(sq, 32);
        const float mean = sum * (1.f / 1024.f); const float rstd = 1.f / sqrtf(fmaxf(sq * (1.f / 1024.f) - mean * mean, 0.f) + LN_EPS);
        f32x4 acc[2] = {(f32x4){0.f, 0.f, 0.f, 0.f}, (f32x4){0.f, 0.f, 0.f, 0.f}};
        const float* lng = F.in[24] + 8 * kq; const float* lnb = F.in[25] + 8 * kq; const float* shp = mod + b * 6144 + 3072 + 8 * kq; const float* scp = mod + b * 6144 + 4096 + 8 * kq;
        bf16* x1row = x1 + (size_t)t * 1024 + 8 * kq; unsigned char* h2row = h2 + (size_t)t * 1024 + 8 * kq;
        const LAS bf16* wHr = wH + m * WR_LD + 8 * kq; const LAS bf16* wLr = wL + m * WR_LD + 8 * kq;
#pragma unroll 4
        for (int s_ = 0; s_ < 32; ++s_) { const int ko = 32 * s_;
            f32x4 a, c; unpack8(*(const u32x4*)(vrow + ko), a, c);
            const f32x4 g0 = *(const f32x4*)(lng + ko), g1 = *(const f32x4*)(lng + ko + 4), b0 = *(const f32x4*)(lnb + ko), b1 = *(const f32x4*)(lnb + ko + 4);
            const f32x4 x0 = (a - mean) * rstd * g0 + b0, x1v = (c - mean) * rstd * g1 + b1;
            *(u32x4*)(x1row + ko) = pack8(x0, x1v);
            const f32x4 sh0 = *(const f32x4*)(shp + ko), sh1 = *(const f32x4*)(shp + ko + 4), sc0 = *(const f32x4*)(scp + ko), sc1 = *(const f32x4*)(scp + ko + 4);
            const f32x4 h0 = x0 * (sc0 + 1.0f) + sh0, h1 = x1v * (sc1 + 1.0f) + sh1;
            u32x2 w8; w8.x = pk4_fp8(h0[0], h0[1], h0[2], h0[3]); w8.y = pk4_fp8(h1[0], h1[1], h1[2], h1[3]); *(u32x2*)(h2row + ko) = w8;
            const u32x4 hi = pack8(h0, h1); f32x4 r0, r1; unpack8(hi, r0, r1); const u32x4 lo = pack8(h0 - r0, h1 - r1);
            const bf16x8 ah = __builtin_bit_cast(bf16x8, hi), al = __builtin_bit_cast(bf16x8, lo);
#pragma unroll
            for (int nf = 0; nf < 2; ++nf) { const bf16x8 bh = *(const LAS bf16x8*)(wHr + nf * 16 * WR_LD + ko), bl = *(const LAS bf16x8*)(wLr + nf * 16 * WR_LD + ko);
                acc[nf] = __builtin_amdgcn_mfma_f32_16x16x32_bf16(bh, ah, acc[nf], 0, 0, 0);
                acc[nf] = __builtin_amdgcn_mfma_f32_16x16x32_bf16(bl, ah, acc[nf], 0, 0, 0);
                acc[nf] = __builtin_amdgcn_mfma_f32_16x16x32_bf16(bh, al, acc[nf], 0, 0, 0); } }
        float lv[8];
#pragma unroll
        for (int nf = 0; nf < 2; ++nf)
#pragma unroll
            for (int j = 0; j < 4; ++j) lv[nf * 4 + j] = acc[nf][j] + F.in[27][nf * 16 + 4 * kq + j];
        int rank[8];
#pragma unroll
        for (int i = 0; i < 8; ++i) { rank[i] = 0;
#pragma unroll
            for (int i2 = 0; i2 < 8; ++i2) if (i2 != i) { const int e1 = (i >> 2) * 16 + 4 * kq + (i & 3), e2 = (i2 >> 2) * 16 + 4 * kq + (i2 & 3); rank[i] += (lv[i2] > lv[i] || (lv[i2] == lv[i] && e2 < e1)) ? 1 : 0; } }
#pragma unroll
        for (int dq = 1; dq < 4; ++dq) { const int q2 = kq ^ dq;
#pragma unroll
            for (int i2 = 0; i2 < 8; ++i2) { const float o = __shfl_xor(lv[i2], 16 * dq); const int e2 = (i2 >> 2) * 16 + 4 * q2 + (i2 & 3);
#pragma unroll
                for (int i = 0; i < 8; ++i) { const int e1 = (i >> 2) * 16 + 4 * kq + (i & 3); rank[i] += (o > lv[i] || (o == lv[i] && e2 < e1)) ? 1 : 0; } } }
#pragma unroll
        for (int i = 0; i < 8; ++i) if (rank[i] < 4) { const int e1 = (i >> 2) * 16 + 4 * kq + (i & 3); sel[(w * 16 + m) * 4 + rank[i]] = (f32x2){__builtin_bit_cast(float, e1), lv[i]}; }
        asm volatile("s_waitcnt lgkmcnt(0)" ::: "memory");
        { const int tm = lane >> 2, k = lane & 3; const f32x2 s0 = sel[(w * 16 + tm) * 4 + 0], s1 = sel[(w * 16 + tm) * 4 + 1], s2 = sel[(w * 16 + tm) * 4 + 2], s3 = sel[(w * 16 + tm) * 4 + 3];
          const float p0 = 1.f, p1 = __expf(s1.y - s0.y), p2 = __expf(s2.y - s0.y), p3 = __expf(s3.y - s0.y), ps = (p0 + p1) + (p2 + p3);
          const f32x2 mine = k == 0 ? s0 : (k == 1 ? s1 : (k == 2 ? s2 : s3)); const float pm = (k == 0 ? p0 : (k == 1 ? p1 : (k == 2 ? p2 : p3))) / ps;
          const int e = __builtin_bit_cast(int, mine.x);
          const int lr = __hip_atomic_fetch_add(lcnt + e, 1, __ATOMIC_RELAXED, __HIP_MEMORY_SCOPE_WORKGROUP);
          rec[(w * 16 + tm) * 4 + k] = ((unsigned)e << 16) | (unsigned)lr; recp[(w * 16 + tm) * 4 + k] = pm; }
        __syncthreads();
        if (F.tid < 32) { const int n = lcnt[F.tid]; gbase[F.tid] = n ? (int)atomicAdd(F.ctl + CW_CNT + 64 * F.tid, (unsigned)n) : 0; lcnt[F.tid] = 0; }
        __syncthreads();
        { const unsigned r = rec[F.tid]; const int e = r >> 16, rk = gbase[e] + (int)(r & 0xffffu), tt = blk * 128 + (F.tid >> 2);
          WSP(int, WS_TOK)[(size_t)e * T + rk] = tt; WSP(unsigned, WS_POS)[(size_t)tt * 4 + (F.tid & 3)] = ((unsigned)e << 20) | (unsigned)rk; WSP(float, WS_PROB)[(size_t)tt * 4 + (F.tid & 3)] = recp[F.tid]; }
        __syncthreads();
    }
}
__device__ __forceinline__ void p12_final(Frame& F) {
    moe_tables(F);
    const LAS int* tstart = (const LAS int*)(F.lds + TAB_OFF);
    const float* mod = WSP(float, WS_MOD); const bf16* x1 = WSP(bf16, WS_X1); const bf16* yb = WSP(bf16, WS_YB); const unsigned* pos = WSP(unsigned, WS_POS); const float* prob = WSP(float, WS_PROB);
    const int lane = F.lane, gw = F.vcu * 8 + F.wave, NGW = F.G * 8;
    f32x4 lg[4], lb[4];
#pragma unroll
    for (int j = 0; j < 4; ++j) { lg[j] = *(const f32x4*)(F.in[32] + 512 * (j >> 1) + 8 * lane + 4 * (j & 1)); lb[j] = *(const f32x4*)(F.in[33] + 512 * (j >> 1) + 8 * lane + 4 * (j & 1)); }
#define P12_ROUTE(PP, PW, tt) do { const u32x4 p4_ = *(const u32x4*)(pos + (size_t)(tt) * 4); const f32x4 w4_ = *(const f32x4*)(prob + (size_t)(tt) * 4); \
        PP[0] = p4_.x; PP[1] = p4_.y; PP[2] = p4_.z; PP[3] = p4_.w; PW[0] = w4_[0]; PW[1] = w4_[1]; PW[2] = w4_[2]; PW[3] = w4_[3]; } while (0)
#define P12_ROWS(YW, XW, PP, tt) do { _Pragma("unroll") for (int k = 0; k < 4; ++k) { const int e_ = PP[k] >> 20, rk_ = PP[k] & 0xfffffu; const size_t slot_ = (size_t)tstart[e_] * 256 + rk_; \
            _Pragma("unroll") for (int j = 0; j < 2; ++j) YW[k][j] = *((const u32x2*)((const unsigned char*)yb + slot_ * 1024) + 64 * j + lane); } \
        _Pragma("unroll") for (int j = 0; j < 2; ++j) XW[j] = *((const u32x4*)(x1 + (size_t)(tt) * 1024) + 64 * j + lane); } while (0)
#define P12_COMPUTE(YW, XW, PW, tt) do { const int b_ = (tt) >> 12; f32x4 v[4]; float s_ = 0.f; \
        _Pragma("unroll") for (int j = 0; j < 2; ++j) { f32x4 f0 = (f32x4){0.f, 0.f, 0.f, 0.f}, f1 = f0; \
            _Pragma("unroll") for (int k = 0; k < 4; ++k) { const u32x2 yv_ = YW[k][j]; const f32x2 q0_ = __builtin_amdgcn_cvt_pk_f32_fp8((int)yv_.x, false), q1_ = __builtin_amdgcn_cvt_pk_f32_fp8((int)yv_.x, true), q2_ = __builtin_amdgcn_cvt_pk_f32_fp8((int)yv_.y, false), q3_ = __builtin_amdgcn_cvt_pk_f32_fp8((int)yv_.y, true); \
                f0 += (f32x4){q0_.x, q0_.y, q1_.x, q1_.y} * PW[k]; f1 += (f32x4){q2_.x, q2_.y, q3_.x, q3_.y} * PW[k]; } \
            f32x4 xa_, xc_; unpack8(XW[j], xa_, xc_); const float* gp_ = mod + b_ * 6144 + 5120 + 512 * j + 8 * lane; \
            v[2 * j] = xa_ * DN_ALPHA + (*(const f32x4*)gp_ + 1.0f) * f0; v[2 * j + 1] = xc_ * DN_ALPHA + (*(const f32x4*)(gp_ + 4) + 1.0f) * f1; \
            s_ += ((v[2 * j][0] + v[2 * j][1]) + (v[2 * j][2] + v[2 * j][3])) + ((v[2 * j + 1][0] + v[2 * j + 1][1]) + (v[2 * j + 1][2] + v[2 * j + 1][3])); } \
        const float mean_ = wave_sum(s_) * (1.f / 1024.f); float s2_ = 0.f; \
        _Pragma("unroll") for (int j = 0; j < 4; ++j) { v[j] = v[j] - mean_; s2_ += (v[j][0] * v[j][0] + v[j][1] * v[j][1]) + (v[j][2] * v[j][2] + v[j][3] * v[j][3]); } \
        const float rstd_ = 1.f / sqrtf(wave_sum(s2_) * (1.f / 1024.f) + LN_EPS); \
        _Pragma("unroll") for (int j = 0; j < 4; ++j) *(f32x4*)(F.out + (size_t)(tt) * 1024 + 512 * (j >> 1) + 8 * lane + 4 * (j & 1)) = v[j] * rstd_ * lg[j] + lb[j]; } while (0)
    const int nmine = (T - gw + NGW - 1) / NGW;
    unsigned ppA[4], ppB[4]; float pwA[4], pwB[4], pwN[4]; u32x2 ywA[4][2], ywB[4][2]; u32x4 xwA[2], xwB[2];
    if (nmine > 0) { P12_ROUTE(ppA, pwA, gw); P12_ROWS(ywA, xwA, ppA, gw); }
    if (nmine > 1) { P12_ROUTE(ppB, pwB, gw + NGW); }
    for (int i = 0; i < nmine; i += 2) {
        const int t0 = gw + i * NGW, t1 = t0 + NGW, t2 = t1 + NGW, t3 = t2 + NGW;
        if (i + 1 < nmine) { P12_ROWS(ywB, xwB, ppB, t1); }
        if (i + 2 < nmine) { P12_ROUTE(ppA, pwN, t2); }
        __builtin_amdgcn_sched_barrier(0);
        P12_COMPUTE(ywA, xwA, pwA, t0);
        if (i + 1 < nmine) {
#pragma unroll
            for (int k = 0; k < 4; ++k) pwA[k] = pwN[k];
            if (i + 2 < nmine) { P12_ROWS(ywA, xwA, ppA, t2); }
            if (i + 3 < nmine) { P12_ROUTE(ppB, pwN, t3); }
            __builtin_amdgcn_sched_barrier(0);
            P12_COMPUTE(ywB, xwB, pwB, t1);
#pragma unroll
            for (int k = 0; k < 4; ++k) pwB[k] = pwN[k];
        }
    }
#undef P12_ROUTE
#undef P12_ROWS
#undef P12_COMPUTE
}

struct Args { const float* in[34]; float* out; unsigned char* ws; int ph_lo, ph_hi; };
__global__ void __launch_bounds__(512, 2) fwd_kernel(Args args) {
    extern __shared__ __attribute__((aligned(16))) unsigned char lds_raw[];
    Frame F;
    F.lds = (LAS unsigned char*)lds_raw; F.MISC = (volatile LAS unsigned*)(F.lds + MISC_OFF);
    F.tid = threadIdx.x; F.lane = F.tid & 63; F.wave = __builtin_amdgcn_readfirstlane(F.tid >> 6);
    F.G = gridDim.x; { const int bx = blockIdx.x; F.vcu = (F.G % 8 == 0) ? (bx % 8) * (F.G / 8) + bx / 8 : bx; }
#pragma unroll
    for (int i = 0; i < 34; ++i) F.in[i] = args.in[i];
    F.out = args.out; F.ws = args.ws; F.ctl = (unsigned*)(args.ws + WS_CTL);
    if (F.tid < 64) F.MISC[F.tid] = 0u;
    __syncthreads();
    XcdBarrier bar; bar.bar = F.ctl + CW_BAR; bar.x = 0; bar.st = nullptr;
    if (MK_N_LAUNCHES == 1) bar = xcd_barrier_post(F.ctl + CW_BAR, F.MISC + 8);
    const int lo = args.ph_lo, hi = args.ph_hi;
#define IN(k) (lo <= (k) && (k) < hi)
#define SEAM(k) do { if (IN(k) && IN((k) + 1)) xcd_barrier(bar); } while (0)

    if (IN(0)) REPS(0) { if (rep_) xcd_barrier(bar);
        for (int j = F.vcu; j < 192; j += F.G) p0_mod_job(F, j);
        for (int j = F.vcu; j < S5G * 8; j += F.G) p0_s5k_job(F, j);
        { bf16* img = WSP(bf16, WS_WRIMG); const float* wr = F.in[26];
          for (int i = F.vcu * 512 + F.tid; i < 1024 * 32; i += F.G * 512) { const float w = wr[i]; const unsigned hb = f2bf(w); const float hf = __builtin_bit_cast(float, hb << 16);
              img[(i & 31) * 1032 + (i >> 5)] = (bf16)hb; img[32 * 1032 + (i & 31) * 1032 + (i >> 5)] = (bf16)f2bf(w - hf); } }
        p0_small_transposes(F);
    }
    SEAM(0);
    if (IN(1)) REPS(1) { if (rep_) xcd_barrier(bar); for (int j = F.vcu; j < S5G * 8; j += F.G) p1_s5w_job(F, j); p1_body(F); }
    SEAM(1);
    if (IN(2)) REPS(2) { if (rep_) xcd_barrier(bar);
        g8::GridOrder S; S.init(T, INC, F.G, (int)blockIdx.x, WSP(bf16, WS_HBF), WSP(bf16, WS_WIN), 1024, 1024);
        EpiInProj E{F.in[5], WSP(bf16, WS_XRNN), WSP(bf16, WS_GY), WSP(bf16, WS_ACAT), WSP(bf16, WS_GATES)};
        g8::gemm_phase<EpiInProj, g8::GridOrder, false, true>(F.lds, 1024, 1024, 1024, S, E);
    }
    SEAM(2);
    if (IN(3)) REPS(3) { if (rep_) xcd_barrier(bar);
        { S5AOrder S{F.G, F.vcu, (const char*)WSP(bf16, WS_ACAT), (const char*)WSP(bf16, WS_WS)}; EpiS5A E{WSP(float, WS_S)};
          g8::gemm_phase<EpiS5A, S5AOrder, false>(F.lds, S5L * 32, S5ROW * 2, S5L * 32, S, E); }
        __syncthreads();
        rglru_phase<0>(F);
    }
    SEAM(3);
    if (IN(4)) REPS(4) { if (rep_) xcd_barrier(bar); p4_carries(F); }
    SEAM(4);
    if (IN(5)) REPS(5) { if (rep_) xcd_barrier(bar);
        { S5COrder S{F.G, F.vcu, (const char*)WSP(bf16, WS_ACAT), (const char*)WSP(bf16, WS_WY)}; EpiS5C E{WSP(bf16, WS_YS)};
          g8::gemm_phase<EpiS5C, S5COrder, false>(F.lds, S5ROW * 2, S5ROW * 2, S5ROW * 2, S, E); }
        __syncthreads();
        rglru_phase<1>(F);
    }
    SEAM(5);
    if (IN(6)) REPS(6) { if (rep_) xcd_barrier(bar);
        g8::GridOrder S; S.init(T, 2048, F.G, (int)blockIdx.x, WSP(bf16, WS_YS), WSP(bf16, WS_WGLU), 512, 512);
        EpiGlu E{WSP(bf16, WS_GATES), WSP(bf16, WS_GB)};
        g8::gemm_phase<EpiGlu, g8::GridOrder, false, true>(F.lds, 512, 512, 512, S, E);
    }
    SEAM(6);
    if (IN(7)) REPS(7) { if (rep_) xcd_barrier(bar);
        g8::GridOrder S; S.init(T, 1024, F.G, (int)blockIdx.x, WSP(bf16, WS_HA), WSP(bf16, WS_WRNN), 1024, 1024);
        EpiRnn E{WSP(bf16, WS_GATES), WSP(bf16, WS_GB), WSP(bf16, WS_MERGED)};
        g8::gemm_phase<EpiRnn, g8::GridOrder, false, true>(F.lds, 1024, 1024, 1024, S, E);
    }
    SEAM(7);
    if (IN(8)) REPS(8) { if (rep_) xcd_barrier(bar);
        g8::GridOrder S; S.init(T, 1024, F.G, (int)blockIdx.x, WSP(bf16, WS_MERGED), WSP(bf16, WS_WOUT), 1024, 1024);
        EpiOut E{F.in[0], WSP(float, WS_MOD), WSP(bf16, WS_V1)};
        g8::gemm_phase<EpiOut, g8::GridOrder, false, true>(F.lds, 1024, 1024, 1024, S, E);
    }
    SEAM(8);
    if (IN(9)) REPS(9) { if (rep_) xcd_barrier(bar); p9_router(F); }
    SEAM(9);
    if (IN(10)) REPS(10) { if (rep_) xcd_barrier(bar);
        moe_tables(F);
        const LAS int* tstart = (const LAS int*)(F.lds + TAB_OFF);
        MoeOrder S{F.G, (int)blockIdx.x, 8, tstart[NE], tstart, tstart + 40, WSP(int, WS_TOK), (const char*)WSP(bf16, WS_H2), (const char*)WSP(bf16, WS_WGU), (size_t)2048 * 1024, 1024, true};
        EpiMoe1 E{F.in[29], WSP(bf16, WS_ACT)};
        g8::gemm_phase<EpiMoe1, MoeOrder, true, true>(F.lds, 1024, 1024, 1024, S, E);
    }
    SEAM(10);
    if (IN(11)) REPS(11) { if (rep_) xcd_barrier(bar);
        moe_tables(F);
        const LAS int* tstart = (const LAS int*)(F.lds + TAB_OFF);
        MoeOrder S{F.G, (int)blockIdx.x, 4, tstart[NE], tstart, tstart + 40, WSP(int, WS_TOK), (const char*)WSP(bf16, WS_ACT), (const char*)WSP(bf16, WS_WD), (size_t)1024 * 1024, 1024, false};
        EpiMoe2 E{F.in[31], WSP(bf16, WS_YB)};
        g8::gemm_phase<EpiMoe2, MoeOrder, false, true>(F.lds, 1024, 1024, 1024, S, E);
    }
    SEAM(11);
    if (IN(12)) REPS(12) { if (rep_) xcd_barrier(bar); p12_final(F); }
#undef IN
#undef SEAM
}

extern "C" void kernel_launch(void* const* d_in, const int* in_sizes, int n_in, void* d_out, int out_size, void* d_ws, size_t ws_size, hipStream_t stream) {
    static int grid = 0;
    if (grid == 0) {
        if (n_in != 34 || in_sizes[0] != T * D || out_size != T * D || ws_size < WS_END) { fprintf(stderr, "kernel_launch: unexpected shapes (n_in %d, ws %zu < %zu)\n", n_in, ws_size, (size_t)WS_END); grid = -1; return; }
        int dev = 0, cus = 0;
        if (hipGetDevice(&dev) != hipSuccess || hipDeviceGetAttribute(&cus, hipDeviceAttributeMultiprocessorCount, dev) != hipSuccess) { grid = -1; return; }
        if (hipFuncSetAttribute((const void*)fwd_kernel, hipFuncAttributeMaxDynamicSharedMemorySize, LDS_BYTES) != hipSuccess) { fprintf(stderr, "kernel_launch: hipFuncSetAttribute failed\n"); grid = -1; return; }
        int per_cu = 0; (void)hipOccupancyMaxActiveBlocksPerMultiprocessor(&per_cu, (const void*)fwd_kernel, 512, LDS_BYTES); (void)hipGetLastError();
        grid = cus;
    }
    if (grid < 0) return;
    (void)hipMemsetAsync((char*)d_ws + WS_CTL, 0, CTL_BYTES, stream);
    Args a{};
    for (int i = 0; i < 34; ++i) a.in[i] = (const float*)d_in[i];
    a.out = (float*)d_out; a.ws = (unsigned char*)d_ws;
    if (MK_N_LAUNCHES == 1) { a.ph_lo = 0; a.ph_hi = N_PHASES; hipLaunchKernelGGL(fwd_kernel, dim3(grid), dim3(512), LDS_BYTES, stream, a); }
    else for (int p = 0; p < N_PHASES; ++p) { a.ph_lo = p; a.ph_hi = p + 1; hipLaunchKernelGGL(fwd_kernel, dim3(grid), dim3(512), LDS_BYTES, stream, a); }
}
```

```cpp
#include <hip/hip_runtime.h>
#include <cstdio>
#include <cstdint>

#ifndef MK_N_LAUNCHES
#define MK_N_LAUNCHES 1
#endif
constexpr int N_PHASES = 13;
#ifndef DUP_PHASE
#define DUP_PHASE -1
#endif
#define REPS(k) for (int rep_ = 0; rep_ < ((DUP_PHASE == (k)) ? 2 : 1); ++rep_)

#define GAS __attribute__((address_space(1)))
#define LAS __attribute__((address_space(3)))
typedef unsigned short bf16;
typedef short bf16x8 __attribute__((ext_vector_type(8)));
typedef float f32x4 __attribute__((ext_vector_type(4)));
typedef float f32x2 __attribute__((ext_vector_type(2)));
typedef unsigned u32x4 __attribute__((ext_vector_type(4)));
typedef unsigned u32x2 __attribute__((ext_vector_type(2)));
typedef GAS unsigned gu32;

constexpr int NB = 8, SEQ = 4096, T = NB * SEQ, D = 1024, INC = 4608, NE = 32, DFF = 1024;
constexpr int S5L = 32, S5G = 32, S5ROW = 128 + S5L * 16  , S5M = T / S5L  , S5CPB = SEQ / S5L  ;
constexpr int RGL = 128, RGC = SEQ / RGL  ;
constexpr float LN_EPS = 1e-5f, DN_ALPHA = 1.189207115002721f;
constexpr int ACT_ROWS = T * 4 + NE * 256;

constexpr size_t MiB = 1u << 20;
constexpr size_t WS_XRNN = 0, WS_GY = 64 * MiB, WS_GATES = 128 * MiB, WS_V1 = 0, WS_ACT = 0;
constexpr size_t WS_HBF = 272 * MiB, WS_HA = 272 * MiB, WS_YS = 336 * MiB, WS_GB = 368 * MiB, WS_MERGED = 432 * MiB, WS_ACAT = 496 * MiB, WS_YB = 272 * MiB;
constexpr size_t WS_X1 = 544 * MiB, WS_H2 = 608 * MiB;
constexpr size_t WS_WGU = 672 * MiB, WS_WD = 800 * MiB, WS_WIN = 864 * MiB, WS_WG = 873 * MiB, WS_WRNN = 874 * MiB, WS_WGLU = 876 * MiB, WS_WOUT = 878 * MiB;
constexpr size_t WS_WS = 880 * MiB, WS_WY = 888 * MiB, WS_S = 908 * MiB;
constexpr size_t WS_MOD = 924 * MiB, WS_AL = 925 * MiB, WS_RGAGG = 926 * MiB, WS_HIN = 928 * MiB, WS_TOK = 929 * MiB, WS_POS = 933 * MiB, WS_PROB = 934 * MiB, WS_CTL = 935 * MiB;
constexpr size_t WS_END = 936 * MiB, CTL_BYTES = 1 * MiB;
static_assert((size_t)ACT_ROWS * DFF * 2 <= 272 * MiB, "act/yb size");
static_assert(WS_ACAT + (size_t)S5G * S5M * S5ROW * 2 <= WS_X1, "acat");
constexpr int CW_BAR = 4096, CW_CNT = 8192  ;

constexpr int LDS_BYTES = 147456, MISC_OFF = LDS_BYTES - 256, TAB_OFF = 131072 + 1024;

__device__ __forceinline__ unsigned f2bf(float f) { unsigned u = __builtin_bit_cast(unsigned, f); return (u + 0x7fffu + ((u >> 16) & 1u)) >> 16; }
typedef __bf16 bf16x2v __attribute__((ext_vector_type(2)));
__device__ __forceinline__ unsigned pk2(float lo, float hi) { const f32x2 v = {lo, hi}; const bf16x2v b = __builtin_convertvector(v, bf16x2v); return __builtin_bit_cast(unsigned, b); }
__device__ __forceinline__ unsigned pk4_fp8(float a, float b, float c, float d) { a = __builtin_amdgcn_fmed3f(a, -448.f, 448.f); b = __builtin_amdgcn_fmed3f(b, -448.f, 448.f); c = __builtin_amdgcn_fmed3f(c, -448.f, 448.f); d = __builtin_amdgcn_fmed3f(d, -448.f, 448.f); int w = 0; w = __builtin_amdgcn_cvt_pk_fp8_f32(a, b, w, false); w = __builtin_amdgcn_cvt_pk_fp8_f32(c, d, w, true); return (unsigned)w; }
__device__ __forceinline__ float bflo(unsigned w) { return __builtin_bit_cast(float, w << 16); }
__device__ __forceinline__ float bfhi(unsigned w) { return __builtin_bit_cast(float, w & 0xffff0000u); }
__device__ __forceinline__ float bf1(bf16 h) { return __builtin_bit_cast(float, ((unsigned)h) << 16); }
__device__ __forceinline__ float fast_sigmoid(float x) { return __builtin_amdgcn_rcpf(1.0f + __builtin_amdgcn_exp2f(-1.4426950409f * x)); }
__device__ __forceinline__ float gelu_tanh(float x) { const float u = x + 0.044715f * x * x * x; return x * __builtin_amdgcn_rcpf(1.0f + __builtin_amdgcn_exp2f(-2.3022082f * u)); }
__device__ __forceinline__ float wave_sum(float v) {
#pragma unroll
    for (int o = 1; o < 64; o <<= 1) v += __shfl_xor(v, o);
    return v;
}
__device__ __forceinline__ u32x4 pack8(f32x4 a, f32x4 b) { u32x4 w; w.x = pk2(a[0], a[1]); w.y = pk2(a[2], a[3]); w.z = pk2(b[0], b[1]); w.w = pk2(b[2], b[3]); return w; }
__device__ __forceinline__ void unpack8(u32x4 w, f32x4& a, f32x4& b) { a = (f32x4){bflo(w.x), bfhi(w.x), bflo(w.y), bfhi(w.y)}; b = (f32x4){bflo(w.z), bfhi(w.z), bflo(w.w), bfhi(w.w)}; }

#define XB_TMO      128
#define XB_XCNT(j)  (256  + 64 * (j))
#define XB_XSUB(j)  (1280 + 64 * (j))
#define XB_XGEN(j)  (2304 + 64 * (j))
#define XB_TOP      3328
#define XB_TOPGEN   3392
#define XCD_BAR_WORDS 3456
#define XB_SPIN_CAP (1u << 18)
__device__ __forceinline__ unsigned xb_ld(unsigned* p)              { return __hip_atomic_load(p, __ATOMIC_RELAXED, __HIP_MEMORY_SCOPE_AGENT); }
__device__ __forceinline__ unsigned xb_add(unsigned* p, unsigned v) { return __hip_atomic_fetch_add(p, v, __ATOMIC_RELAXED, __HIP_MEMORY_SCOPE_AGENT); }
__device__ __forceinline__ unsigned xb_xcc_id() { return (unsigned)__builtin_amdgcn_s_getreg((3 << 11) | 20) & 0xFu; }
#define XB_SPIN(cond, bar) do { unsigned _sp = 0; while (cond) { __builtin_amdgcn_s_sleep(1); \
    if ((++_sp & 255u) == 0u) { if (xb_ld(&(bar)[XB_TMO])) break; if (_sp > XB_SPIN_CAP) { atomicAdd(&(bar)[XB_TMO], 1u); break; } } } } while (0)
struct XcdBarrier { unsigned* bar; unsigned x; volatile LAS unsigned* st; };
__device__ __forceinline__ XcdBarrier xcd_barrier_post(unsigned* bar, volatile LAS unsigned* st) {
    XcdBarrier b; b.bar = bar; b.x = xb_xcc_id(); b.st = st;
    if (threadIdx.x == 0) (void)xb_add(&bar[XB_XCNT(b.x)], 1u);
    return b;
}
__device__ __forceinline__ void xcd_barrier_complete(unsigned* bar, unsigned x, unsigned& nloc, unsigned& nx) {
    const unsigned G = gridDim.x * gridDim.y * gridDim.z;
    unsigned sum, cnt, mine, sp = 0u;
    for (;;) {
        sum = 0u; cnt = 0u; mine = 0u;
#pragma unroll
        for (unsigned j = 0; j < 16; ++j) { const unsigned c = xb_ld(&bar[XB_XCNT(j)]); sum += c; cnt += (c > 0u) ? 1u : 0u; mine = (j == x) ? c : mine; }
        if (sum == G) break;
        __builtin_amdgcn_s_sleep(1);
        if ((++sp & 255u) == 0u) { if (xb_ld(&bar[XB_TMO])) break; if (sp > XB_SPIN_CAP) { atomicAdd(&bar[XB_TMO], 1u); break; } }
    }
    nloc = mine > 0u ? mine : 1u; nx = cnt > 0u ? cnt : 1u;
}
__device__ __forceinline__ void xcd_barrier(const XcdBarrier& b) {
    asm volatile("s_waitcnt vmcnt(0)" ::: "memory");
    __syncthreads();
    if (threadIdx.x == 0) {
        unsigned* bar = b.bar;
        __builtin_amdgcn_s_waitcnt(0);
        unsigned nloc = b.st[0], nx = b.st[1];
        if (nloc == 0u) { xcd_barrier_complete(bar, b.x, nloc, nx); b.st[0] = nloc; b.st[1] = nx; }
        const unsigned old = xb_add(&bar[XB_XSUB(b.x)], 1u);
        const unsigned gen = old / nloc;
        if (old + 1u == (gen + 1u) * nloc) {
            __builtin_amdgcn_fence(__ATOMIC_RELEASE, "agent");
            asm volatile("s_waitcnt vmcnt(0)" ::: "memory");
            const unsigned og = xb_add(&bar[XB_TOP], 1u);
            const unsigned tg = og / nx;
            if (og + 1u == (tg + 1u) * nx) xb_add(&bar[XB_TOPGEN], 1u);
            else XB_SPIN(xb_ld(&bar[XB_TOPGEN]) == tg, bar);
            __builtin_amdgcn_fence(__ATOMIC_ACQUIRE, "agent");
            xb_add(&bar[XB_XGEN(b.x)], 1u);
            asm volatile("s_waitcnt vmcnt(0)" ::: "memory");
        } else {
            XB_SPIN(xb_ld(&bar[XB_XGEN(b.x)]) == gen, bar);
            __builtin_amdgcn_fence(__ATOMIC_ACQUIRE, "agent");
            asm volatile("s_waitcnt vmcnt(0)" ::: "memory");
        }
    }
    __syncthreads();
}

namespace g8 {
constexpr int BM = 256, BK = 64, HALF = 128, HTB = HALF * BK * 2, STAGE_BYTES = 8 * HTB;
__device__ __forceinline__ int lds_byte(int r, int c) { const int st = (r >> 4) * 2 + (c >> 5), rr = r & 15, cc = c & 31, ob = rr * 64 + cc * 2; return st * 1024 + (ob ^ (((ob >> 9) & 1) << 5)); }
__device__ __forceinline__ void stage_rc(int b, int& R, int& C) { const int st = b / 1024, sb = b % 1024, swz = sb ^ (((sb >> 9) & 1) << 5); R = (st >> 1) * 16 + swz / 64; C = (st & 1) * 32 + (swz % 64) / 2; }
__device__ __forceinline__ int perm32(int rho) { const int n = rho >> 4, i = rho & 15; return 8 * (i >> 2) + 4 * n + (i & 3); }

struct Unit { int pm, pn, z, rl; const char* A; const char* B; };

typedef int v8i __attribute__((ext_vector_type(8)));
typedef int v4i __attribute__((ext_vector_type(4)));
typedef short s16x16 __attribute__((ext_vector_type(16)));
typedef s16x16 s16x16_a16 __attribute__((aligned(16)));
__device__ __forceinline__ v8i cat8(bf16x8 lo, bf16x8 hi) { const v4i a = __builtin_bit_cast(v4i, lo), b = __builtin_bit_cast(v4i, hi); return __builtin_shufflevector(a, b, 0, 1, 2, 3, 4, 5, 6, 7); }
template <class Epi, class Sched, bool GATHER, bool FP8 = false>
__device__ __forceinline__ void gemm_phase(LAS unsigned char* lds, const int Kb, const int ldaB, const int ldbB, const Sched& S, const Epi& E) {
    const int tid = threadIdx.x, wid = __builtin_amdgcn_readfirstlane(tid >> 6), lane = tid & 63, wr = wid >> 2, wc = wid & 3, fr = lane & 15, fq = lane >> 4;
    const int nt = Kb / 128;
    unsigned voffB[2], cvo[2][2], nvo[2][2]; int Rr[2], Cc[2];
#pragma unroll
    for (int i = 0; i < 2; ++i) { int R, C; stage_rc(tid * 16 + i * 8192, R, C); const int Rb = (R & ~31) + perm32(R & 31);
        voffB[i] = (unsigned)(Rb * ldbB + C * 2); Rr[i] = R; Cc[i] = C;
#pragma unroll
        for (int h = 0; h < 2; ++h) { cvo[h][i] = (unsigned)((h * HALF + R) * ldaB + C * 2); nvo[h][i] = cvo[h][i]; } }
    const size_t kstep = (size_t)(BK * 2);
    const size_t hstepB = (size_t)HALF * ldbB;
    const unsigned ldsw = (unsigned)wid * 1024u;
    const int aoff = FP8 ? lds_byte(wr * 64 + fr, (fq >> 1) * 32 + (fq & 1) * 24) : lds_byte(wr * 64 + fr, fq * 8), boff = FP8 ? lds_byte(wc * 32 + fr, (fq >> 1) * 32 + (fq & 1) * 24) : lds_byte(wc * 32 + fr, fq * 8);
    const int aoff2 = FP8 ? lds_byte(wr * 64 + fr, (fq >> 1) * 32 + 8 + (fq & 1) * 8) : 0, boff2 = FP8 ? lds_byte(wc * 32 + fr, (fq >> 1) * 32 + 8 + (fq & 1) * 8) : 0;
#define G8_SA(b, h) (((b) * 2 + (h)) * HTB)
#define G8_SB(b, h) ((4 + (b) * 2 + (h)) * HTB)
#define G8_STGB(bufoff, gbase) do { _Pragma("unroll") for (int _i = 0; _i < 2; ++_i) \
        __builtin_amdgcn_global_load_lds((const unsigned*)((const char*)(gbase) + voffB[_i]), (LAS unsigned*)(lds + (bufoff) + ldsw + _i * 8192), 16, 0, 0); } while (0)
#define G8_STGA(bufoff, gbase, VO, h) do { _Pragma("unroll") for (int _i = 0; _i < 2; ++_i) \
        __builtin_amdgcn_global_load_lds((const unsigned*)((const char*)(gbase) + VO[h][_i]), (LAS unsigned*)(lds + (bufoff) + ldsw + _i * 8192), 16, 0, 0); } while (0)
#define G8_LDA(dst, b, h) do { _Pragma("unroll") for (int m = 0; m < 4; ++m) { if constexpr (FP8) { dst##8[m] = cat8(*(const LAS bf16x8*)(lds + G8_SA(b, h) + aoff + m * 2048), *(const LAS bf16x8*)(lds + G8_SA(b, h) + aoff2 + m * 2048)); } \
        else { _Pragma("unroll") for (int k = 0; k < 2; ++k) dst[m][k] = *(const LAS bf16x8*)(lds + G8_SA(b, h) + aoff + m * 2048 + k * 1024); } } } while (0)
#define G8_LDB(dst, b, h) do { _Pragma("unroll") for (int n = 0; n < 2; ++n) { if constexpr (FP8) { dst##8[n] = cat8(*(const LAS bf16x8*)(lds + G8_SB(b, h) + boff + n * 2048), *(const LAS bf16x8*)(lds + G8_SB(b, h) + boff2 + n * 2048)); } \
        else { _Pragma("unroll") for (int k = 0; k < 2; ++k) dst[n][k] = *(const LAS bf16x8*)(lds + G8_SB(b, h) + boff + n * 2048 + k * 1024); } } } while (0)
#define G8_MMA(ai, bj, At, Bt) do { __builtin_amdgcn_s_setprio(1); _Pragma("unroll") for (int m = 0; m < 4; ++m) _Pragma("unroll") for (int n = 0; n < 2; ++n) { \
        if constexpr (FP8) asm volatile("s_nop 1\n\tv_mfma_scale_f32_16x16x128_f8f6f4 %0, %1, %2, %0, %3, %4 op_sel_hi:[0,0,0]" : "+v"(acc[ai][bj][m][n]) : "v"(Bt##8[n]), "v"(At##8[m]), "v"(sc_w), "v"(sc_a)); \
        else { _Pragma("unroll") for (int k = 0; k < 2; ++k) acc[ai][bj][m][n] = __builtin_amdgcn_mfma_f32_16x16x32_bf16(Bt[n][k], At[m][k], acc[ai][bj][m][n], 0, 0, 0); } } __builtin_amdgcn_s_setprio(0); } while (0)
#define G8_WAIT_V(n) asm volatile("s_waitcnt vmcnt(" #n ")" ::: "memory")
#define G8_WAIT_L(n) asm volatile("s_waitcnt lgkmcnt(" #n ")" ::: "memory")
#define G8_BAR __builtin_amdgcn_s_barrier()
#define G8_SCHED __builtin_amdgcn_sched_barrier(0)
    Unit cur, nxt; int ui = 0;
    if (!S.next(0, cur)) return;
    bool has_next = S.next(1, nxt);
    if constexpr (GATHER) { S.gather(cur, Rr, Cc, cvo); if (has_next) S.gather(nxt, Rr, Cc, nvo); else {
#pragma unroll
        for (int h = 0; h < 2; ++h)
#pragma unroll
            for (int i = 0; i < 2; ++i) nvo[h][i] = cvo[h][i]; } }
    f32x4 acc[2][2][4][2];
#pragma unroll
    for (int a = 0; a < 2; ++a)
#pragma unroll
        for (int b = 0; b < 2; ++b)
#pragma unroll
            for (int m = 0; m < 4; ++m)
#pragma unroll
                for (int n = 0; n < 2; ++n) acc[a][b][m][n] = (f32x4){0.f, 0.f, 0.f, 0.f};
    const int sc_w = 0x7a7a7a7a, sc_a = 0x7f7f7f7f;
    bf16x8 At[4][2], B0[2][2], B1[2][2]; v8i At8[4], B08[2], B18[2];
    const char* cA = cur.A; const char* cB = cur.B;
    G8_STGB(G8_SB(0, 0), cB); G8_STGB(G8_SB(0, 1), cB + hstepB); G8_STGA(G8_SA(0, 0), cA, cvo, 0); G8_STGA(G8_SA(0, 1), cA, cvo, 1);
    if (wr == 1) G8_BAR;
    G8_WAIT_V(2); G8_BAR;
    G8_STGB(G8_SB(1, 0), cB + kstep); G8_STGA(G8_SA(1, 0), cA + kstep, cvo, 0); G8_STGB(G8_SB(1, 1), cB + hstepB + kstep);
    G8_WAIT_V(6); G8_BAR;
    for (;;) {
        const char* nA = has_next ? nxt.A : cA; const char* nB = has_next ? nxt.B : cB;
        for (int t = 0; t < nt; t += 2) {
            const bool last = (t == nt - 2);
            const char* a1 = cA + (size_t)(t + 1) * kstep;
            const char* a2 = last ? nA : cA + (size_t)(t + 2) * kstep; const char* b2 = last ? nB : cB + (size_t)(t + 2) * kstep;
            const char* a3 = a2 + kstep; const char* b3 = b2 + kstep;
            unsigned vo2[2][2];
#pragma unroll
            for (int h = 0; h < 2; ++h)
#pragma unroll
                for (int i = 0; i < 2; ++i) vo2[h][i] = (GATHER && last) ? nvo[h][i] : cvo[h][i];
            G8_LDB(B0, 0, 0); G8_LDB(B1, 0, 1); G8_SCHED; G8_LDA(At, 0, 0); G8_STGA(G8_SA(1, 1), a1, cvo, 1);
            G8_WAIT_V(8); G8_WAIT_L(0); G8_BAR; G8_SCHED; G8_MMA(0, 0, At, B0); G8_MMA(0, 1, At, B1); G8_SCHED; G8_BAR; G8_SCHED;
            G8_LDA(At, 0, 1); G8_STGB(G8_SB(0, 0), b2); G8_STGB(G8_SB(0, 1), b2 + hstepB); G8_STGA(G8_SA(0, 0), a2, vo2, 0);
            G8_WAIT_V(8); G8_WAIT_L(0); G8_BAR; G8_SCHED; G8_MMA(1, 0, At, B0); G8_MMA(1, 1, At, B1); G8_SCHED; G8_BAR; G8_SCHED;
            G8_LDB(B0, 1, 0); G8_LDB(B1, 1, 1); G8_SCHED; G8_LDA(At, 1, 0); G8_STGA(G8_SA(0, 1), a2, vo2, 1);
            G8_WAIT_V(8); G8_WAIT_L(0); G8_BAR; G8_SCHED; G8_MMA(0, 0, At, B0); G8_MMA(0, 1, At, B1); G8_SCHED; G8_BAR; G8_SCHED;
            G8_LDA(At, 1, 1); G8_STGB(G8_SB(1, 0), b3); G8_STGB(G8_SB(1, 1), b3 + hstepB); G8_STGA(G8_SA(1, 0), a3, vo2, 0);
            G8_WAIT_V(8); G8_WAIT_L(0); G8_BAR; G8_SCHED; G8_MMA(1, 0, At, B0); G8_MMA(1, 1, At, B1); G8_SCHED; G8_BAR; G8_SCHED;
        }
        if (wr == 0) G8_BAR;
        Unit nn; bool has_nn = false;
        if (has_next) has_nn = S.next(ui + 2, nn);
        unsigned nnvo[2][2];
        if constexpr (GATHER) { if (has_nn) S.gather(nn, Rr, Cc, nnvo); }
        if constexpr (FP8) asm volatile("s_nop 15\n\ts_nop 15" ::: "memory");
        E(acc, cur, wr, wc, fr, fq);
        if (!has_next) break;
#pragma unroll
        for (int a = 0; a < 2; ++a)
#pragma unroll
            for (int b = 0; b < 2; ++b)
#pragma unroll
                for (int m = 0; m < 4; ++m)
#pragma unroll
                    for (int n = 0; n < 2; ++n) acc[a][b][m][n] = (f32x4){0.f, 0.f, 0.f, 0.f};
        cur = nxt; cA = nA; cB = nB; ++ui;
        if constexpr (GATHER) {
#pragma unroll
            for (int h = 0; h < 2; ++h)
#pragma unroll
                for (int i = 0; i < 2; ++i) { cvo[h][i] = nvo[h][i]; if (has_nn) nvo[h][i] = nnvo[h][i]; } }
        nxt = nn; has_next = has_nn;
        if (wr == 1) G8_BAR;
    }
    G8_WAIT_V(0);
    G8_BAR;
#undef G8_SA
#undef G8_SB
#undef G8_STGB
#undef G8_STGA
#undef G8_LDA
#undef G8_LDB
#undef G8_MMA
#undef G8_WAIT_V
#undef G8_WAIT_L
#undef G8_BAR
#undef G8_SCHED
}

struct GridOrder {
    int nM, nN, nwg, G, c; const char* A; const char* B; size_t tstepA, tstepB;
    __device__ __forceinline__ void init(int M, int N, int G_, int c_, const void* A_, const void* B_, int ldaB, int ldbB) { nM = M / BM; nN = N / BM; nwg = nM * nN; G = G_; c = c_; A = (const char*)A_; B = (const char*)B_; tstepA = (size_t)BM * ldaB; tstepB = (size_t)BM * ldbB; }
    __device__ __forceinline__ bool next(int i, Unit& u) const {
        const long L = (long)i * G + c; if (L >= nwg) return false;
        int wgid = (int)L; { const int q = nwg / 8, r = nwg % 8, xcd = wgid % 8, off = wgid / 8; wgid = (xcd < r ? xcd * (q + 1) : r * (q + 1) + (xcd - r) * q) + off; }
        const int nig = 8 * nN, gid = wgid / nig, fm = gid * 8, gsz = (nM - fm) < 8 ? (nM - fm) : 8;
        u.pm = fm + ((wgid % nig) % gsz); u.pn = (wgid % nig) / gsz; u.z = 0; u.rl = 0;
        u.A = A + (size_t)u.pm * tstepA; u.B = B + (size_t)u.pn * tstepB; return true;
    }
};
}

struct Frame {
    LAS unsigned char* lds; volatile LAS unsigned* MISC; unsigned* ctl;
    int tid, lane, wave, vcu, G;
    const float* in[34]; float* out; unsigned char* ws;
};
#define WSP(T_, off) ((T_*)(F.ws + (off)))

struct EpiInProj {
    const float* bias; bf16 *xrnn, *gy, *acat, *gates;
    __device__ __forceinline__ void operator()(const f32x4 (&acc)[2][2][4][2], const g8::Unit& u, int wr, int wc, int fr, int fq) const {
        const int pn = u.pn, colb = pn * 256 + wc * 32 + 8 * fq;
        f32x4 bv[2][2];
#pragma unroll
        for (int bj = 0; bj < 2; ++bj)
#pragma unroll
            for (int n = 0; n < 2; ++n) bv[bj][n] = *(const f32x4*)(bias + colb + bj * 128 + 4 * n);
#pragma unroll
        for (int ai = 0; ai < 2; ++ai)
#pragma unroll
            for (int m = 0; m < 4; ++m) { const int t = u.pm * 256 + ai * 128 + wr * 64 + m * 16 + fr;
#pragma unroll
                for (int bj = 0; bj < 2; ++bj) { f32x4 v0 = acc[ai][bj][m][0] + bv[bj][0], v1 = acc[ai][bj][m][1] + bv[bj][1]; const int col = colb + bj * 128;
                    if (pn < 4) { *(u32x4*)(xrnn + (size_t)t * 1024 + col) = pack8(v0, v1); }
                    else if (pn < 8) {
#pragma unroll
                        for (int j = 0; j < 4; ++j) { v0[j] = gelu_tanh(v0[j]); v1[j] = gelu_tanh(v1[j]); }
                        *(u32x4*)(gy + (size_t)t * 1024 + (col - 1024)) = pack8(v0, v1); }
                    else if (pn < 10) { const int cu = col - 2048, g = cu >> 4, c = cu & 15;
                        *(u32x4*)(acat + ((size_t)(g * S5M + (t >> 5)) * S5ROW + 128 + (t & 31) * 16 + c)) = pack8(v0, v1); }
                    else {
#pragma unroll
                        for (int j = 0; j < 4; ++j) { v0[j] = fast_sigmoid(v0[j]); v1[j] = fast_sigmoid(v1[j]); }
                        *(u32x4*)(gates + (size_t)t * 2048 + (col - 2560)) = pack8(v0, v1); } } }
    }
};
struct EpiS5A {
    float* S;
    __device__ __forceinline__ void operator()(const f32x4 (&acc)[2][2][4][2], const g8::Unit& u, int wr, int wc, int fr, int fq) const {
        const int col = wc * 32 + 8 * fq;
#pragma unroll
        for (int ai = 0; ai < 2; ++ai)
#pragma unroll
            for (int m = 0; m < 4; ++m) { const int row = u.pm * 256 + ai * 128 + wr * 64 + m * 16 + fr; float* p = S + ((size_t)(u.z * S5M + row)) * 128 + col;
                *(f32x4*)p = acc[ai][0][m][0]; *(f32x4*)(p + 4) = acc[ai][0][m][1]; }
    }
};
struct EpiS5C {
    bf16* ys;
    __device__ __forceinline__ void operator()(const f32x4 (&acc)[2][2][4][2], const g8::Unit& u, int wr, int wc, int fr, int fq) const {
#pragma unroll
        for (int ai = 0; ai < 2; ++ai)
#pragma unroll
            for (int m = 0; m < 4; ++m) { const int row = u.pm * 256 + ai * 128 + wr * 64 + m * 16 + fr;
#pragma unroll
                for (int bj = 0; bj < 2; ++bj) { const int n = u.pn * 256 + bj * 128 + wc * 32 + 8 * fq, i = n >> 4, c = n & 15; f32x4 v0 = acc[ai][bj][m][0], v1 = acc[ai][bj][m][1];
#pragma unroll
                    for (int j = 0; j < 4; ++j) { v0[j] = gelu_tanh(v0[j]); v1[j] = gelu_tanh(v1[j]); }
                    u32x2 w8; w8.x = pk4_fp8(v0[0], v0[1], v0[2], v0[3]); w8.y = pk4_fp8(v1[0], v1[1], v1[2], v1[3]); *(u32x2*)((unsigned char*)ys + (size_t)(row * 32 + i) * 512 + u.z * 16 + c) = w8; } }
    }
};
struct EpiGlu {
    const bf16* gates; bf16* gb;
    __device__ __forceinline__ void operator()(const f32x4 (&acc)[2][2][4][2], const g8::Unit& u, int wr, int wc, int fr, int fq) const {
        const int f = u.pn * 128 + wc * 32 + 8 * fq;
#pragma unroll
        for (int ai = 0; ai < 2; ++ai)
#pragma unroll
            for (int m = 0; m < 4; ++m) { const int t = u.pm * 256 + ai * 128 + wr * 64 + m * 16 + fr;
                const u32x4 gw = *(const u32x4*)(gates + (size_t)t * 2048 + 1024 + f); f32x4 g0, g1; unpack8(gw, g0, g1);
                f32x4 v0 = acc[ai][0][m][0], v1 = acc[ai][0][m][1]; const f32x4 s0 = acc[ai][1][m][0], s1 = acc[ai][1][m][1];
#pragma unroll
                for (int j = 0; j < 4; ++j) { v0[j] = g0[j] * v0[j] * fast_sigmoid(s0[j]); v1[j] = g1[j] * v1[j] * fast_sigmoid(s1[j]); }
                *(u32x4*)(gb + (size_t)t * 1024 + f) = pack8(v0, v1); }
    }
};
struct EpiRnn {
    const bf16* gates; const bf16* gb; bf16* merged;
    __device__ __forceinline__ void operator()(const f32x4 (&acc)[2][2][4][2], const g8::Unit& u, int wr, int wc, int fr, int fq) const {
#pragma unroll
        for (int ai = 0; ai < 2; ++ai)
#pragma unroll
            for (int m = 0; m < 4; ++m) { const int t = u.pm * 256 + ai * 128 + wr * 64 + m * 16 + fr;
#pragma unroll
                for (int bj = 0; bj < 2; ++bj) { const int col = u.pn * 256 + bj * 128 + wc * 32 + 8 * fq;
                    const u32x4 gw = *(const u32x4*)(gates + (size_t)t * 2048 + col), bw = *(const u32x4*)(gb + (size_t)t * 1024 + col);
                    f32x4 g0, g1, b0, b1; unpack8(gw, g0, g1); unpack8(bw, b0, b1);
                    const f32x4 v0 = g0 * acc[ai][bj][m][0] + b0, v1 = g1 * acc[ai][bj][m][1] + b1;
                    u32x2 w8; w8.x = pk4_fp8(v0[0], v0[1], v0[2], v0[3]); w8.y = pk4_fp8(v1[0], v1[1], v1[2], v1[3]); *(u32x2*)((unsigned char*)merged + (size_t)t * 1024 + col) = w8; } }
    }
};
struct EpiOut {
    const float* x; const float* mod; bf16* v1;
    __device__ __forceinline__ void operator()(const f32x4 (&acc)[2][2][4][2], const g8::Unit& u, int wr, int wc, int fr, int fq) const {
        const int b = (u.pm * 256) >> 12;
#pragma unroll
        for (int bj = 0; bj < 2; ++bj) { const int col = u.pn * 256 + bj * 128 + wc * 32 + 8 * fq;
            const f32x4 ga = *(const f32x4*)(mod + b * 6144 + 2048 + col) + 1.0f, gb_ = *(const f32x4*)(mod + b * 6144 + 2048 + col + 4) + 1.0f;
#pragma unroll
            for (int ai = 0; ai < 2; ++ai)
#pragma unroll
                for (int m = 0; m < 4; ++m) { const int t = u.pm * 256 + ai * 128 + wr * 64 + m * 16 + fr;
                    const f32x4 x0 = *(const f32x4*)(x + (size_t)t * 1024 + col), x1 = *(const f32x4*)(x + (size_t)t * 1024 + col + 4);
                    const f32x4 v0 = x0 * DN_ALPHA + ga * acc[ai][bj][m][0], v1_ = x1 * DN_ALPHA + gb_ * acc[ai][bj][m][1];
                    *(u32x4*)(v1 + (size_t)t * 1024 + col) = pack8(v0, v1_); } }
    }
};
struct EpiMoe1 {
    const float* bgu; bf16* act;
    __device__ __forceinline__ void operator()(const f32x4 (&acc)[2][2][4][2], const g8::Unit& u, int wr, int wc, int fr, int fq) const {
        const int f = u.pn * 128 + wc * 32 + 8 * fq; const float* bp = bgu + (size_t)u.z * 2048 + f;
        const f32x4 bg0 = *(const f32x4*)bp, bg1 = *(const f32x4*)(bp + 4), bu0 = *(const f32x4*)(bp + 1024), bu1 = *(const f32x4*)(bp + 1028);
#pragma unroll
        for (int ai = 0; ai < 2; ++ai)
#pragma unroll
            for (int m = 0; m < 4; ++m) { const int row = u.pm * 256 + ai * 128 + wr * 64 + m * 16 + fr;
                f32x4 g0 = acc[ai][0][m][0] + bg0, g1 = acc[ai][0][m][1] + bg1, u0 = acc[ai][1][m][0] + bu0, u1 = acc[ai][1][m][1] + bu1;
#pragma unroll
                for (int j = 0; j < 4; ++j) { const float ga = fminf(g0[j], 7.0f), gb_ = fminf(g1[j], 7.0f), ua = fminf(fmaxf(u0[j], -7.0f), 7.0f), ub = fminf(fmaxf(u1[j], -7.0f), 7.0f);
                    g0[j] = ga * fast_sigmoid(1.702f * ga) * (ua + 1.0f); g1[j] = gb_ * fast_sigmoid(1.702f * gb_) * (ub + 1.0f); }
                u32x2 w8; w8.x = pk4_fp8(g0[0], g0[1], g0[2], g0[3]); w8.y = pk4_fp8(g1[0], g1[1], g1[2], g1[3]); *(u32x2*)((unsigned char*)act + (size_t)row * 1024 + f) = w8; }
    }
};
struct EpiMoe2 {
    const float* bd; bf16* yb;
    __device__ __forceinline__ void operator()(const f32x4 (&acc)[2][2][4][2], const g8::Unit& u, int wr, int wc, int fr, int fq) const {
#pragma unroll
        for (int bj = 0; bj < 2; ++bj) { const int col = u.pn * 256 + bj * 128 + wc * 32 + 8 * fq; const float* bp = bd + (size_t)u.z * 1024 + col;
            const f32x4 b0 = *(const f32x4*)bp, b1 = *(const f32x4*)(bp + 4);
#pragma unroll
            for (int ai = 0; ai < 2; ++ai)
#pragma unroll
                for (int m = 0; m < 4; ++m) { const int row = u.pm * 256 + ai * 128 + wr * 64 + m * 16 + fr;
                    const f32x4 y0 = acc[ai][bj][m][0] + b0, y1 = acc[ai][bj][m][1] + b1; u32x2 w8; w8.x = pk4_fp8(y0[0], y0[1], y0[2], y0[3]); w8.y = pk4_fp8(y1[0], y1[1], y1[2], y1[3]);
                    *(u32x2*)((unsigned char*)yb + (size_t)row * 1024 + col) = w8; } }
    }
};

struct S5AOrder { int G, c; const char* acat; const char* ws;
    __device__ __forceinline__ bool next(int i, g8::Unit& u) const { const int L = i * G + c; if (L >= S5G * 4) return false; u.z = L >> 2; u.pm = L & 3; u.pn = 0; u.rl = 0;
        u.A = acat + ((size_t)(u.z * S5M + u.pm * 256) * S5ROW + 128) * 2; u.B = ws + (size_t)u.z * 256 * (S5L * 16) * 2; return true; } };
struct S5COrder { int G, c; const char* acat; const char* wy;
    __device__ __forceinline__ bool next(int i, g8::Unit& u) const { const int L = i * G + c; if (L >= S5G * 8) return false; u.z = L >> 3; u.pm = (L >> 1) & 3; u.pn = L & 1; u.rl = 0;
        u.A = acat + ((size_t)(u.z * S5M + u.pm * 256) * S5ROW) * 2; u.B = wy + ((size_t)(u.z * 512 + u.pn * 256) * S5ROW) * 2; return true; } };
struct MoeOrder { int G, c, NT, RT; const LAS int* tstart; const LAS int* cnt; const int* toklist; const char* A; const char* B; size_t bstride_e; int lda; bool gatherA;
    __device__ __forceinline__ bool next(int i, g8::Unit& u) const { const int per = G >> 3, xcd = c & 7, slot = c >> 3, rpx = per / NT;
        const int rt = (i * 8 + xcd) * rpx + slot / NT; if (rt >= RT) return false; u.pn = slot % NT;
        const int lane_ = threadIdx.x & 63; const unsigned long long mk_ = __ballot(lane_ < NE && tstart[lane_ & 31] <= rt);
        const int e = __builtin_popcountll(mk_) - 1;
        u.z = e; u.pm = rt; u.rl = rt - tstart[e]; u.B = B + (size_t)e * bstride_e + (size_t)u.pn * 256 * 1024; u.A = gatherA ? A : A + (size_t)rt * 256 * 1024; return true; }
    __device__ __forceinline__ void gather(const g8::Unit& u, const int (&Rr)[2], const int (&Cc)[2], unsigned (&vo)[2][2]) const {
        const int n = cnt[u.z];
#pragma unroll
        for (int h = 0; h < 2; ++h)
#pragma unroll
            for (int i = 0; i < 2; ++i) { const int r = u.rl * 256 + h * 128 + Rr[i]; const int tok = r < n ? toklist[u.z * T + r] : 0; vo[h][i] = (unsigned)(tok * lda + Cc[i] * 2); } }
};

__device__ __forceinline__ void transpose_item(const float* W, int N, int k0, int n0, bf16* dst, int ldd, int drow0, LAS float* scr, int lane) {
    float wv_[32];
#pragma unroll
    for (int i = 0; i < 32; ++i) wv_[i] = W[(size_t)(k0 + 2 * i + (lane >> 5)) * N + n0 + (lane & 31)];
#pragma unroll
    for (int i = 0; i < 32; ++i) scr[(2 * i + (lane >> 5)) * 33 + (lane & 31)] = wv_[i];
    asm volatile("s_waitcnt lgkmcnt(0)" ::: "memory");
    const int c = lane & 7;
#pragma unroll
    for (int j = 0; j < 4; ++j) { const int n = (lane >> 3) + 8 * j; const LAS float* s = scr + (8 * c) * 33 + n;
        u32x4 o; o.x = pk2(s[0 * 33], s[1 * 33]); o.y = pk2(s[2 * 33], s[3 * 33]); o.z = pk2(s[4 * 33], s[5 * 33]); o.w = pk2(s[6 * 33], s[7 * 33]);
        *(u32x4*)(dst + (size_t)(drow0 + n) * ldd + k0 + 8 * c) = o; }
    asm volatile("s_waitcnt lgkmcnt(0)" ::: "memory");
}
__device__ __forceinline__ void transpose_item8(const float* W, int N, int k0, int n0, unsigned char* dst, int ldd, int drow0, LAS float* scr, int lane) {
    float wv_[32];
#pragma unroll
    for (int i = 0; i < 32; ++i) wv_[i] = W[(size_t)(k0 + 2 * i + (lane >> 5)) * N + n0 + (lane & 31)];
#pragma unroll
    for (int i = 0; i < 32; ++i) scr[(2 * i + (lane >> 5)) * 33 + (lane & 31)] = wv_[i];
    asm volatile("s_waitcnt lgkmcnt(0)" ::: "memory");
    const int c = lane & 7;
#pragma unroll
    for (int j = 0; j < 4; ++j) { const int n = (lane >> 3) + 8 * j; const LAS float* s = scr + (8 * c) * 33 + n;
        u32x2 o; o.x = pk4_fp8(32.f * s[0 * 33], 32.f * s[1 * 33], 32.f * s[2 * 33], 32.f * s[3 * 33]); o.y = pk4_fp8(32.f * s[4 * 33], 32.f * s[5 * 33], 32.f * s[6 * 33], 32.f * s[7 * 33]);
        *(u32x2*)(dst + (size_t)(drow0 + n) * ldd + k0 + 8 * c) = o; }
    asm volatile("s_waitcnt lgkmcnt(0)" ::: "memory");
}
__device__ __forceinline__ void transpose_item8w(const float* W, int N, int k0, int n0, unsigned char* dst, int ldd, int drow0, LAS float* scr, int lane) {
    float wv[64]; const float* wp = W + (size_t)(k0 + (lane >> 5)) * N + n0 + (lane & 31);
#pragma unroll
    for (int i = 0; i < 64; ++i) wv[i] = wp[(size_t)(2 * i) * N];
#pragma unroll
    for (int i = 0; i < 64; ++i) scr[(2 * i + (lane >> 5)) * 33 + (lane & 31)] = wv[i];
    asm volatile("s_waitcnt lgkmcnt(0)" ::: "memory");
    const int c = lane & 7;
#pragma unroll
    for (int j = 0; j < 4; ++j) { const int n = (lane >> 3) + 8 * j; const LAS float* s = scr + (16 * c) * 33 + n;
        u32x4 o; o.x = pk4_fp8(32.f * s[0 * 33], 32.f * s[1 * 33], 32.f * s[2 * 33], 32.f * s[3 * 33]); o.y = pk4_fp8(32.f * s[4 * 33], 32.f * s[5 * 33], 32.f * s[6 * 33], 32.f * s[7 * 33]);
        o.z = pk4_fp8(32.f * s[8 * 33], 32.f * s[9 * 33], 32.f * s[10 * 33], 32.f * s[11 * 33]); o.w = pk4_fp8(32.f * s[12 * 33], 32.f * s[13 * 33], 32.f * s[14 * 33], 32.f * s[15 * 33]);
        *(u32x4*)(dst + (size_t)(drow0 + n) * ldd + k0 + 16 * c) = o; }
    asm volatile("s_waitcnt lgkmcnt(0)" ::: "memory");
}
__device__ __forceinline__ int pair_row(int n) { const int f = n & 1023, hi = n >> 10; return (f >> 7) * 256 + hi * 128 + (f & 127); }

__device__ __forceinline__ void moe_tables(Frame& F) {
    LAS int* tstart = (LAS int*)(F.lds + TAB_OFF); LAS int* cl = tstart + 40;
    if (F.tid < 64) {
        const int e = F.lane & 31; const int c = (int)F.ctl[CW_CNT + 64 * e]; int inc = (c + 255) >> 8;
#pragma unroll
        for (int o = 1; o < 32; o <<= 1) { const int v = __shfl_up(inc, o); if ((F.lane & 31) >= o) inc += v; }
        if (F.lane < 32) { cl[e] = c; tstart[e] = inc - ((c + 255) >> 8); if (e == NE - 1) tstart[NE] = inc; }
    }
    __syncthreads();
}

__device__ __forceinline__ void p0_mod_job(Frame& F, int job) {
    LAS float* sc = (LAS float*)F.lds;
    LAS float* red = sc + 8 * 1024;
    const float* c = F.in[1]; const float* w = F.in[2]; const float* bias = F.in[3];
    for (int i = F.tid; i < 8 * 1024; i += 512) { const float v = c[i]; sc[i] = v * fast_sigmoid(v); }
    __syncthreads();
    const int col = F.tid & 31, kg = F.tid >> 5, j = job * 32 + col;
    float a[8];
#pragma unroll
    for (int b = 0; b < 8; ++b) a[b] = 0.f;
#pragma unroll 32
    for (int k = kg * 64; k < kg * 64 + 64; ++k) { const float wv = w[(size_t)k * 6144 + j];
#pragma unroll
        for (int b = 0; b < 8; ++b) a[b] += sc[b * 1024 + k] * wv; }
#pragma unroll
    for (int b = 0; b < 8; ++b) red[(kg * 8 + b) * 32 + col] = a[b];
    __syncthreads();
    if (F.tid < 256) { const int b = F.tid >> 5, cc = F.tid & 31; float s = 0.f;
#pragma unroll
        for (int g = 0; g < 16; ++g) s += red[(g * 8 + b) * 32 + cc];
        WSP(float, WS_MOD)[b * 6144 + job * 32 + cc] = s + bias[job * 32 + cc]; }
    __syncthreads();
}
__device__ __forceinline__ void s5_setup(Frame& F, int g, int kmin, int kmax, LAS f32x2* Bb, LAS f32x2* Cc, LAS f32x2* Ap) {
    const float* lre = F.in[14] + g * 64; const float* lim = F.in[15] + g * 64; const float dt = expf(F.in[16][g]);
    const float* bre = F.in[17] + g * 1024; const float* bim = F.in[18] + g * 1024; const float* cre = F.in[19] + g * 1024; const float* cim = F.in[20] + g * 1024;
    for (int i = F.tid; i < 1024; i += 512) { const int p = i >> 4; const float lr = lre[p], li = lim[p]; const float mag = expf(lr * dt); float sn, cs; sincosf(li * dt, &sn, &cs);
        const float ar = mag * cs, ai = mag * sn, den = lr * lr + li * li, qr = ((ar - 1.f) * lr + ai * li) / den, qi = (ai * lr - (ar - 1.f) * li) / den;
        const float br = bre[i], bi = bim[i]; Bb[i] = (f32x2){qr * br - qi * bi, qr * bi + qi * br};
        Cc[i] = (f32x2){cre[i], cim[i]}; }
    for (int i = kmin * 64 + F.tid; i < (kmax + 1) * 64; i += 512) { const int k = i >> 6, p = i & 63; const float lr = lre[p], li = lim[p]; const float mag = expf((float)k * lr * dt); float sn, cs; sincosf((float)k * li * dt, &sn, &cs);
        Ap[i] = (f32x2){mag * cs, mag * sn}; }
    __syncthreads();
}
constexpr size_t WS_KTAB = WS_S;
constexpr size_t WS_WRIMG = WS_AL + 512 * 1024;
__device__ __forceinline__ void p0_s5k_job(Frame& F, int job) {
    const int g = job >> 3, part = job & 7;
    LAS f32x2* Bb = (LAS f32x2*)F.lds; LAS f32x2* Cc = Bb + 1024; LAS f32x2* Ap = Cc + 1024;
    s5_setup(F, g, 4 * part, 4 * part + 3, Bb, Cc, Ap);
    float* kt = WSP(float, WS_KTAB) + (size_t)g * 32 * 256;
    for (int e = 4 * part * 256 + F.tid; e < (4 * part + 4) * 256; e += 512) { const int k = e >> 8, c = (e >> 4) & 15, c2 = e & 15; float s = 0.f;
        for (int p = 0; p < 64; ++p) { const f32x2 cv = Cc[c * 64 + p], av = Ap[k * 64 + p], bv = Bb[p * 16 + c2];
            const float car = cv.x * av.x - cv.y * av.y, cai = cv.x * av.y + cv.y * av.x; s += car * bv.x - cai * bv.y; }
        kt[e] = s; }
    __syncthreads();
}
__device__ __forceinline__ void p1_s5w_job(Frame& F, int job) {
    const int g = job >> 3, part = job & 7;
    LAS f32x2* Bb = (LAS f32x2*)F.lds; LAS f32x2* Cc = Bb + 1024; LAS f32x2* Ap = Cc + 1024; LAS float* Kt = (LAS float*)(Ap + 33 * 64);
    const float* ktg = WSP(float, WS_KTAB) + (size_t)g * 32 * 256; const float* dsk = F.in[21] + g * 16;
    for (int i = F.tid; i < 32 * 256; i += 512) Kt[i] = ktg[i];
    s5_setup(F, g, 0, S5L, Bb, Cc, Ap);
    if (part == 0 && F.tid < 64) WSP(f32x2, WS_AL)[g * 64 + F.tid] = Ap[S5L * 64 + F.tid];
    bf16* wy = WSP(bf16, WS_WY) + (size_t)g * 512 * S5ROW;
    for (int ch = F.tid; ch < 64 * (S5ROW / 8); ch += 512) { const int n = part * 64 + ch / (S5ROW / 8), k8 = (ch % (S5ROW / 8)) * 8, i = n >> 4, c = n & 15; float v[8];
        if (k8 < 128) {
#pragma unroll
            for (int j = 0; j < 8; j += 2) { const int p = (k8 + j) >> 1; const f32x2 cv = Cc[c * 64 + p], av = Ap[(i + 1) * 64 + p]; v[j] = cv.x * av.x - cv.y * av.y; v[j + 1] = -(cv.x * av.y + cv.y * av.x); } }
        else { const int jj = (k8 - 128) >> 4, c2 = (k8 - 128) & 15;
#pragma unroll
            for (int j = 0; j < 8; ++j) { float x = 0.f; if (jj <= i) { x = Kt[(i - jj) * 256 + c * 16 + c2 + j]; if (jj == i && c == c2 + j) x += dsk[c]; } v[j] = x; } }
        u32x4 o; o.x = pk2(v[0], v[1]); o.y = pk2(v[2], v[3]); o.z = pk2(v[4], v[5]); o.w = pk2(v[6], v[7]);
        *(u32x4*)(wy + (size_t)n * S5ROW + k8) = o; }
    bf16* wsm = WSP(bf16, WS_WS) + (size_t)g * 256 * 512;
    for (int ch = F.tid; ch < 32 * 64; ch += 512) { const int n = part * 32 + (ch >> 6), k8 = (ch & 63) * 8, jj = k8 >> 4, c2 = k8 & 15; float v[8];
#pragma unroll
        for (int j = 0; j < 8; ++j) { float x = 0.f; if (n < 128) { const int p = n >> 1; const f32x2 av = Ap[(S5L - 1 - jj) * 64 + p], bv = Bb[p * 16 + c2 + j]; x = (n & 1) ? (av.x * bv.y + av.y * bv.x) : (av.x * bv.x - av.y * bv.y); } v[j] = x; }
        u32x4 o; o.x = pk2(v[0], v[1]); o.y = pk2(v[2], v[3]); o.z = pk2(v[4], v[5]); o.w = pk2(v[6], v[7]);
        *(u32x4*)(wsm + (size_t)n * 512 + k8) = o; }
    __syncthreads();
}
__device__ __forceinline__ void p0_small_transposes(Frame& F) {
    LAS float* scr = (LAS float*)(F.lds + F.wave * 16384);
    const int gw = F.vcu * 8 + F.wave, NGW = F.G * 8;
    constexpr int I_IN = 16 * 144, I_RNN = 16 * 32, I_OUT = 16 * 32, I_GLU = 8 * 64, I_RG = 16 * 8;
    for (int it = gw; it < I_IN + I_RNN + I_OUT + I_GLU + I_RG; it += NGW) { int r = it;
        if (r < I_IN) { const int kb = r / 144, nb = r % 144; transpose_item8(F.in[4], INC, kb * 64, nb * 32, WSP(unsigned char, WS_WIN), 1024, nb * 32, scr, F.lane); continue; } r -= I_IN;
        if (r < I_RNN) { const int kb = r / 32, nb = r % 32; transpose_item8(F.in[13], 1024, kb * 64, nb * 32, WSP(unsigned char, WS_WRNN), 1024, nb * 32, scr, F.lane); continue; } r -= I_RNN;
        if (r < I_OUT) { const int kb = r / 32, nb = r % 32; transpose_item8(F.in[23], 1024, kb * 64, nb * 32, WSP(unsigned char, WS_WOUT), 1024, nb * 32, scr, F.lane); continue; } r -= I_OUT;
        if (r < I_GLU) { const int kb = r / 64, nb = r % 64; transpose_item8(F.in[22], 2048, kb * 64, nb * 32, WSP(unsigned char, WS_WGLU), 512, pair_row(nb * 32), scr, F.lane); continue; } r -= I_GLU;
        { const int mat = r >> 3, kb = (r >> 2) & 1, nb = r & 3, hd = mat & 7, gx = mat >> 3;
          transpose_item(F.in[gx ? 10 : 8] + (size_t)hd * 128 * 128, 128, kb * 64, nb * 32, WSP(bf16, WS_WG), 128, hd * 256 + gx * 128 + nb * 32, scr, F.lane); }
    }
}
__device__ __forceinline__ void p1_body(Frame& F) {
    const int gw = F.vcu * 8 + F.wave, NGW = F.G * 8; const float* mod = WSP(float, WS_MOD); bf16* hbf = WSP(bf16, WS_HBF);
    for (int tb = gw; tb < T; tb += 4 * NGW) {
        f32x4 xv[4][4];
#pragma unroll
        for (int r = 0; r < 4; ++r) { const int t = tb + r * NGW; const f32x4* xr = (const f32x4*)(F.in[0] + (size_t)(t < T ? t : 0) * 1024) + F.lane;
#pragma unroll
            for (int j = 0; j < 4; ++j) xv[r][j] = xr[64 * j]; }
#pragma unroll
        for (int r = 0; r < 4; ++r) { const int t = tb + r * NGW; if (t < T) { const int b = t >> 12; const f32x4* sh = (const f32x4*)(mod + b * 6144) + F.lane; const f32x4* sc = (const f32x4*)(mod + b * 6144 + 1024) + F.lane;
            unsigned* o = (unsigned*)((unsigned char*)hbf + (size_t)t * 1024) + F.lane;
#pragma unroll
            for (int j = 0; j < 4; ++j) { const f32x4 v = xv[r][j] * (sc[64 * j] + 1.0f) + sh[64 * j]; o[64 * j] = pk4_fp8(v[0], v[1], v[2], v[3]); } } } }
    constexpr int TP = 132;
    LAS float* tile = (LAS float*)F.lds;
    constexpr int TILES_GU = 8 * 16, TILES_D = 8 * 8, TILES_E = TILES_GU + TILES_D;
    const int lr = F.tid >> 5, lc4 = (F.tid & 31) * 4, tn = F.tid >> 2, kc = F.tid & 3;
    f32x4 pre[8];
    int ti = F.vcu;
#define P1_SRC(idx, src, N_, dstp, drow0_, k0_) do { const int e_ = (idx) / TILES_E, r_ = (idx) % TILES_E; \
        if (r_ < TILES_GU) { const int kb_ = r_ >> 4, nb_ = r_ & 15; N_ = 2048; src = F.in[28] + (size_t)e_ * 1024 * 2048 + (size_t)(kb_ * 128) * 2048 + nb_ * 128; dstp = WSP(unsigned char, WS_WGU) + (size_t)e_ * 2048 * 1024; drow0_ = pair_row(nb_ * 128); k0_ = kb_ * 128; } \
        else { const int q_ = r_ - TILES_GU, kb_ = q_ >> 3, nb_ = q_ & 7; N_ = 1024; src = F.in[30] + (size_t)e_ * 1024 * 1024 + (size_t)(kb_ * 128) * 1024 + nb_ * 128; dstp = WSP(unsigned char, WS_WD) + (size_t)e_ * 1024 * 1024; drow0_ = nb_ * 128; k0_ = kb_ * 128; } } while (0)
    if (ti < NE * TILES_E) { const float* src; unsigned char* dstp; int N_, d0, k0; P1_SRC(ti, src, N_, dstp, d0, k0);
#pragma unroll
        for (int i = 0; i < 8; ++i) pre[i] = *(const f32x4*)(src + (size_t)(lr + 16 * i) * N_ + lc4); }
    for (; ti < NE * TILES_E; ti += F.G) {
#pragma unroll
        for (int i = 0; i < 8; ++i) *(LAS f32x4*)(tile + (lr + 16 * i) * TP + lc4) = pre[i];
        __syncthreads();
        const int tnx = ti + F.G;
        if (tnx < NE * TILES_E) { const float* src; unsigned char* dstp; int N_, d0, k0; P1_SRC(tnx, src, N_, dstp, d0, k0);
#pragma unroll
            for (int i = 0; i < 8; ++i) pre[i] = *(const f32x4*)(src + (size_t)(lr + 16 * i) * N_ + lc4); }
        { const float* src; unsigned char* dstp; int N_, d0, k0; P1_SRC(ti, src, N_, dstp, d0, k0); (void)src; (void)N_;
          const LAS float* cp = tile + (32 * kc) * TP + tn; u32x4 o0, o1;
          o0.x = pk4_fp8(32.f * cp[0 * TP], 32.f * cp[1 * TP], 32.f * cp[2 * TP], 32.f * cp[3 * TP]); o0.y = pk4_fp8(32.f * cp[4 * TP], 32.f * cp[5 * TP], 32.f * cp[6 * TP], 32.f * cp[7 * TP]);
          o0.z = pk4_fp8(32.f * cp[8 * TP], 32.f * cp[9 * TP], 32.f * cp[10 * TP], 32.f * cp[11 * TP]); o0.w = pk4_fp8(32.f * cp[12 * TP], 32.f * cp[13 * TP], 32.f * cp[14 * TP], 32.f * cp[15 * TP]);
          o1.x = pk4_fp8(32.f * cp[16 * TP], 32.f * cp[17 * TP], 32.f * cp[18 * TP], 32.f * cp[19 * TP]); o1.y = pk4_fp8(32.f * cp[20 * TP], 32.f * cp[21 * TP], 32.f * cp[22 * TP], 32.f * cp[23 * TP]);
          o1.z = pk4_fp8(32.f * cp[24 * TP], 32.f * cp[25 * TP], 32.f * cp[26 * TP], 32.f * cp[27 * TP]); o1.w = pk4_fp8(32.f * cp[28 * TP], 32.f * cp[29 * TP], 32.f * cp[30 * TP], 32.f * cp[31 * TP]);
          unsigned char* op = dstp + (size_t)(d0 + tn) * 1024 + k0 + 32 * kc; *(u32x4*)op = o0; *(u32x4*)(op + 16) = o1; }
        __syncthreads();
    }
#undef P1_SRC
}
constexpr int XR_LD = 136, XR_TILE = 128 * XR_LD;
__device__ __forceinline__ void rg_issue(const bf16* xrnn, const bf16* gy, int item, int tid, u32x4 (&xraw)[4][4], u32x4 (&graw)[4], bool pass1) {
    const int hd = item & 7, c = (item >> 3) & 31, b = item >> 8, r0 = tid >> 4, ch = hd * 128 + (tid & 15) * 8;
#pragma unroll
    for (int q = 0; q < 4; ++q) { const int r = r0 + 32 * q;
#pragma unroll
        for (int k = 0; k < 4; ++k) { const int tp = c * RGL + r - 3 + k, tpc = tp < 0 ? 0 : tp; xraw[q][k] = *(const u32x4*)(xrnn + (size_t)(b * SEQ + tpc) * 1024 + ch); }
        if (pass1) graw[q] = *(const u32x4*)(gy + (size_t)(b * SEQ + c * RGL + r) * 1024 + ch); }
}
__device__ __forceinline__ void rg_convwrite(const float* cw, const float* cb, int item, int tid, const u32x4 (&xraw)[4][4], const u32x4 (&graw)[4], LAS bf16* xr, LAS bf16* gyt, bool pass1) {
    const int hd = item & 7, c = (item >> 3) & 31, r0 = tid >> 4, c8 = (tid & 15) * 8, ch = hd * 128 + c8;
    const f32x4 b0 = *(const f32x4*)(cb + ch), b1 = *(const f32x4*)(cb + ch + 4);
    f32x4 w0[4], w1[4];
#pragma unroll
    for (int k = 0; k < 4; ++k) { w0[k] = *(const f32x4*)(cw + k * 1024 + ch); w1[k] = *(const f32x4*)(cw + k * 1024 + ch + 4); }
#pragma unroll
    for (int q = 0; q < 4; ++q) { const int r = r0 + 32 * q; f32x4 a0 = b0, a1 = b1;
#pragma unroll
        for (int k = 0; k < 4; ++k) { const int tp = c * RGL + r - 3 + k; f32x4 x0, x1; unpack8(xraw[q][k], x0, x1); if (tp < 0) { x0 = (f32x4){0.f, 0.f, 0.f, 0.f}; x1 = x0; } a0 += w0[k] * x0; a1 += w1[k] * x1; }
        *(LAS u32x4*)(xr + r * XR_LD + c8) = pack8(a0, a1);
        if (pass1) *(LAS u32x4*)(gyt + r * XR_LD + c8) = graw[q]; }
}
template <int PASS>
__device__ __forceinline__ void rglru_phase(Frame& F) {
    const int NIT = NB * RGC * 8;
    const bool skew = (PASS == 0) && (F.G == 256);
    const int nmine = skew ? (F.vcu < 128 ? 7 : 9) : (NIT - F.vcu + F.G - 1) / F.G;
#define RG_ITEM(k) ((skew && (k) >= 7) ? (1792 + (F.vcu - 128) + 128 * ((k) - 7)) : (F.vcu + (k) * F.G))
    if (nmine <= 0) return;
    int it = RG_ITEM(0);
    LAS bf16* xr = (LAS bf16*)F.lds; LAS bf16* gyt0 = xr + XR_TILE;
    const bf16* xrnn = WSP(bf16, WS_XRNN); const bf16* gy = WSP(bf16, WS_GY); bf16* ha = WSP(bf16, WS_HA); const float* cw = F.in[6]; const float* cb = F.in[7];
    const int tid = F.tid, w = F.wave, q = F.lane >> 4, col = F.lane & 15, chl = 16 * w + col;
    u32x4 xraw[4][4], graw[4];
    rg_issue(xrnn, gy, it, tid, xraw, graw, PASS);
    rg_convwrite(cw, cb, it, tid, xraw, graw, xr, gyt0, PASS);
    int hd_loaded = -1; bf16x8 Bf[2][4]; float ba = 0.f, bx = 0.f, sp = 0.f;
    __syncthreads();
    for (int i = 0; i < nmine; ++i) {
        const bool has_next = (i + 1) < nmine; const int nit = has_next ? RG_ITEM(i + 1) : it;
        const int hd = it & 7, c = (it >> 3) & 31, b = it >> 8, t0 = b * SEQ + c * RGL, ch = hd * 128 + chl;
        LAS bf16* gyt = gyt0 + (i & 1) * XR_TILE; LAS bf16* gytn = gyt0 + ((i & 1) ^ 1) * XR_TILE;
        if (has_next) rg_issue(xrnn, gy, nit, tid, xraw, graw, PASS);
        if (hd != hd_loaded) { hd_loaded = hd; const bf16* wg = WSP(bf16, WS_WG) + (size_t)hd * 256 * 128;
#pragma unroll
            for (int gt = 0; gt < 2; ++gt)
#pragma unroll
                for (int kk = 0; kk < 4; ++kk) Bf[gt][kk] = *(const bf16x8*)(wg + (size_t)(gt * 128 + chl) * 128 + kk * 32 + q * 8);
            ba = F.in[9][ch]; bx = F.in[11][ch]; const float lam = F.in[12][ch]; sp = (lam > 15.f) ? __expf(-lam) : log1pf(__expf(-lam)); }
        float carryH = 0.f, carryP = 1.f;
        if (PASS) carryH = WSP(float, WS_HIN)[(size_t)(b * RGC + c) * 1024 + ch];
        __builtin_amdgcn_sched_barrier(0);
        f32x4 acc[8][2];
#pragma unroll
        for (int m = 0; m < 8; ++m) { acc[m][0] = (f32x4){0.f, 0.f, 0.f, 0.f}; acc[m][1] = (f32x4){0.f, 0.f, 0.f, 0.f}; }
#pragma unroll
        for (int kk = 0; kk < 4; ++kk)
#pragma unroll
            for (int m = 0; m < 8; ++m) { const bf16x8 Af = *(const LAS bf16x8*)(xr + (16 * m + col) * XR_LD + kk * 32 + q * 8);
                acc[m][0] = __builtin_amdgcn_mfma_f32_16x16x32_bf16(Af, Bf[0][kk], acc[m][0], 0, 0, 0);
                acc[m][1] = __builtin_amdgcn_mfma_f32_16x16x32_bf16(Af, Bf[1][kk], acc[m][1], 0, 0, 0); }
#pragma unroll
        for (int m = 0; m < 8; ++m) {
            float a[4], uu[4];
#pragma unroll
            for (int j = 0; j < 4; ++j) { const int tl = 16 * m + 4 * q + j;
                const float r = fast_sigmoid(acc[m][0][j] + ba), ii = fast_sigmoid(acc[m][1][j] + bx);
                const float la = -11.541560327f * r * sp; a[j] = __builtin_amdgcn_exp2f(la); const float mult = __builtin_amdgcn_sqrtf(fmaxf(1.0f - a[j] * a[j], 0.f));
                uu[j] = mult * ii * bf1(xr[tl * XR_LD + chl]); }
            float sP = a[0], sH = uu[0];
#pragma unroll
            for (int j = 1; j < 4; ++j) { sH = a[j] * sH + uu[j]; sP *= a[j]; }
            float iP = sP, iH = sH;
            { const float pP = __shfl_up(iP, 16), pH = __shfl_up(iH, 16); if (q >= 1) { iH = iP * pH + iH; iP = iP * pP; } }
            { const float pP = __shfl_up(iP, 32), pH = __shfl_up(iH, 32); if (q >= 2) { iH = iP * pH + iH; iP = iP * pP; } }
            float eP = __shfl_up(iP, 16), eH = __shfl_up(iH, 16); if (q == 0) { eP = 1.f; eH = 0.f; }
            const float tP = __shfl(iP, col + 48), tH = __shfl(iH, col + 48);
            if (PASS) { float h = eP * carryH + eH;
#pragma unroll
                for (int j = 0; j < 4; ++j) { const int tl = 16 * m + 4 * q + j; h = a[j] * h + uu[j]; LAS bf16* gp = gyt + tl * XR_LD + chl; *gp = (bf16)f2bf(h * bf1(*gp)); } }
            carryH = tP * carryH + tH; carryP *= tP;
        }
        if (!PASS && q == 0) { f32x2* ag = WSP(f32x2, WS_RGAGG); ag[(size_t)(b * RGC + c) * 1024 + ch] = (f32x2){carryP, carryH}; }
        __syncthreads();
        if (PASS) { const int r0 = tid >> 4, c8 = (tid & 15) * 8;
#pragma unroll
            for (int qq = 0; qq < 4; ++qq) { const int r = r0 + 32 * qq; f32x4 h0, h1; unpack8(*(const LAS u32x4*)(gyt + r * XR_LD + c8), h0, h1); u32x2 w8; w8.x = pk4_fp8(h0[0], h0[1], h0[2], h0[3]); w8.y = pk4_fp8(h1[0], h1[1], h1[2], h1[3]);
                *(u32x2*)((unsigned char*)ha + (size_t)(t0 + r) * 1024 + hd * 128 + c8) = w8; } }
        if (has_next) rg_convwrite(cw, cb, nit, tid, xraw, graw, xr, gytn, PASS);
        __syncthreads();
        it = nit;
    }
#undef RG_ITEM
}
__device__ __forceinline__ void p4_carries(Frame& F) {
    LAS f32x2* seg = (LAS f32x2*)F.lds;
    for (int job = F.vcu; job < NB * S5G; job += F.G) {
        const int b = job >> 5, g = job & 31, p = F.lane, w = F.wave;
        const f32x2 al = WSP(f32x2, WS_AL)[g * 64 + p];
        const f32x2* Sb = WSP(f32x2, WS_S) + ((size_t)(g * S5M + b * S5CPB + 16 * w)) * 64 + p; unsigned* ac = (unsigned*)(WSP(bf16, WS_ACAT) + ((size_t)(g * S5M + b * S5CPB + 16 * w)) * S5ROW) + p;
        f32x2 sv[16];
#pragma unroll
        for (int i = 0; i < 16; ++i) sv[i] = Sb[(size_t)i * 64];
        float xr_ = 0.f, xi = 0.f;
#pragma unroll
        for (int i = 0; i < 16; ++i) { const float nr = al.x * xr_ - al.y * xi + sv[i].x, ni = al.x * xi + al.y * xr_ + sv[i].y; xr_ = nr; xi = ni; }
        seg[w * 64 + p] = (f32x2){xr_, xi};
        float ar = al.x, ai = al.y;
#pragma unroll
        for (int q = 0; q < 4; ++q) { const float nr = ar * ar - ai * ai, ni = 2.f * ar * ai; ar = nr; ai = ni; }
        __syncthreads();
        xr_ = 0.f; xi = 0.f;
        for (int ww = 0; ww < w; ++ww) { const f32x2 sg = seg[ww * 64 + p]; const float nr = ar * xr_ - ai * xi + sg.x, ni = ar * xi + ai * xr_ + sg.y; xr_ = nr; xi = ni; }
#pragma unroll
        for (int i = 0; i < 16; ++i) { ac[(size_t)i * (S5ROW / 2)] = pk2(xr_, xi); const float nr = al.x * xr_ - al.y * xi + sv[i].x, ni = al.x * xi + al.y * xr_ + sv[i].y; xr_ = nr; xi = ni; }
        __syncthreads();
    }
    if (F.vcu < 16) {
        const int id = F.vcu * 512 + F.tid, ch = id & 1023, b = id >> 10; const f32x2* ag = WSP(f32x2, WS_RGAGG) + (size_t)b * RGC * 1024 + ch; float* hin = WSP(float, WS_HIN) + (size_t)b * RGC * 1024 + ch;
        f32x2 a[RGC];
#pragma unroll
        for (int c = 0; c < RGC; ++c) a[c] = ag[(size_t)c * 1024];
        float h = 0.f;
#pragma unroll
        for (int c = 0; c < RGC; ++c) { hin[(size_t)c * 1024] = h; h = a[c].x * h + a[c].y; }
    }
}
constexpr int WR_LD = 1032;
__device__ __forceinline__ void p9_router(Frame& F) {
    LAS bf16* wH = (LAS bf16*)F.lds; LAS bf16* wL = wH + 32 * WR_LD;
    LAS f32x2* sel = (LAS f32x2*)(wL + 32 * WR_LD);
    LAS unsigned* rec = (LAS unsigned*)(sel + 512);
    LAS float* recp = (LAS float*)(rec + 512);
    LAS int* lcnt = (LAS int*)(recp + 512);
    LAS int* gbase = lcnt + 32;
    { const u32x4* img = WSP(u32x4, WS_WRIMG); LAS u32x4* dst = (LAS u32x4*)wH;
      for (int i = F.tid; i < 2 * 32 * WR_LD * 2 / 16; i += 512) dst[i] = img[i]; }
    if (F.tid < 32) lcnt[F.tid] = 0;
    __syncthreads();
    const float* mod = WSP(float, WS_MOD); const bf16* v1 = WSP(bf16, WS_V1); bf16* x1 = WSP(bf16, WS_X1); unsigned char* h2 = WSP(unsigned char, WS_H2);
    const int lane = F.lane, m = lane & 15, kq = lane >> 4, w = F.wave;
    for (int blk = F.vcu; blk < T / 128; blk += F.G) {
        const int t = blk * 128 + w * 16 + m, b = (blk * 128) >> 12;
        const bf16* vrow = v1 + (size_t)t * 1024 + 8 * kq;
        float sum = 0.f, sq = 0.f;
#pragma unroll 32
        for (int s_ = 0; s_ < 32; ++s_) { f32x4 a, c; unpack8(*(const u32x4*)(vrow + 32 * s_), a, c); sum += ((a[0] + a[1]) + (a[2] + a[3])) + ((c[0] + c[1]) + (c[2] + c[3]));
            sq += ((a[0] * a[0] + a[1] * a[1]) + (a[2] * a[2] + a[3] * a[3])) + ((c[0] * c[0] + c[1] * c[1]) + (c[2] * c[2] + c[3] * c[3])); }
        sum += __shfl_xor(sum, 16); sum += __shfl_xor(sum, 32); sq += __shfl_xor(sq, 16); sq += __shfl_xor(sq, 32);
        const float mean = sum * (1.f / 1024.f); const float rstd = 1.f / sqrtf(fmaxf(sq * (1.f / 1024.f) - mean * mean, 0.f) + LN_EPS);
        f32x4 acc[2] = {(f32x4){0.f, 0.f, 0.f, 0.f}, (f32x4){0.f, 0.f, 0.f, 0.f}};
        const float* lng = F.in[24] + 8 * kq; const float* lnb = F.in[25] + 8 * kq; const float* shp = mod + b * 6144 + 3072 + 8 * kq; const float* scp = mod + b * 6144 + 4096 + 8 * kq;
        bf16* x1row = x1 + (size_t)t * 1024 + 8 * kq; unsigned char* h2row = h2 + (size_t)t * 1024 + 8 * kq;
        const LAS bf16* wHr = wH + m * WR_LD + 8 * kq; const LAS bf16* wLr = wL + m * WR_LD + 8 * kq;
#pragma unroll 4
        for (int s_ = 0; s_ < 32; ++s_) { const int ko = 32 * s_;
            f32x4 a, c; unpack8(*(const u32x4*)(vrow + ko), a, c);
            const f32x4 g0 = *(const f32x4*)(lng + ko), g1 = *(const f32x4*)(lng + ko + 4), b0 = *(const f32x4*)(lnb + ko), b1 = *(const f32x4*)(lnb + ko + 4);
            const f32x4 x0 = (a - mean) * rstd * g0 + b0, x1v = (c - mean) * rstd * g1 + b1;
            *(u32x4*)(x1row + ko) = pack8(x0, x1v);
            const f32x4 sh0 = *(const f32x4*)(shp + ko), sh1 = *(const f32x4*)(shp + ko + 4), sc0 = *(const f32x4*)(scp + ko), sc1 = *(const f32x4*)(scp + ko + 4);
            const f32x4 h0 = x0 * (sc0 + 1.0f) + sh0, h1 = x1v * (sc1 + 1.0f) + sh1;
            u32x2 w8; w8.x = pk4_fp8(h0[0], h0[1], h0[2], h0[3]); w8.y = pk4_fp8(h1[0], h1[1], h1[2], h1[3]); *(u32x2*)(h2row + ko) = w8;
            const u32x4 hi = pack8(h0, h1); f32x4 r0, r1; unpack8(hi, r0, r1); const u32x4 lo = pack8(h0 - r0, h1 - r1);
            const bf16x8 ah = __builtin_bit_cast(bf16x8, hi), al = __builtin_bit_cast(bf16x8, lo);
#pragma unroll
            for (int nf = 0; nf < 2; ++nf) { const bf16x8 bh = *(const LAS bf16x8*)(wHr + nf * 16 * WR_LD + ko), bl = *(const LAS bf16x8*)(wLr + nf * 16 * WR_LD + ko);
                acc[nf] = __builtin_amdgcn_mfma_f32_16x16x32_bf16(bh, ah, acc[nf], 0, 0, 0);
                acc[nf] = __builtin_amdgcn_mfma_f32_16x16x32_bf16(bl, ah, acc[nf], 0, 0, 0);
                acc[nf] = __builtin_amdgcn_mfma_f32_16x16x32_bf16(bh, al, acc[nf], 0, 0, 0); } }
        float lv[8];
#pragma unroll
        for (int nf = 0; nf < 2; ++nf)
#pragma unroll
            for (int j = 0; j < 4; ++j) lv[nf * 4 + j] = acc[nf][j] + F.in[27][nf * 16 + 4 * kq + j];
        int rank[8];
#pragma unroll
        for (int i = 0; i < 8; ++i) { rank[i] = 0;
#pragma unroll
            for (int i2 = 0; i2 < 8; ++i2) if (i2 != i) { const int e1 = (i >> 2) * 16 + 4 * kq + (i & 3), e2 = (i2 >> 2) * 16 + 4 * kq + (i2 & 3); rank[i] += (lv[i2] > lv[i] || (lv[i2] == lv[i] && e2 < e1)) ? 1 : 0; } }
#pragma unroll
        for (int dq = 1; dq < 4; ++dq) { const int q2 = kq ^ dq;
#pragma unroll
            for (int i2 = 0; i2 < 8; ++i2) { const float o = __shfl_xor(lv[i2], 16 * dq); const int e2 = (i2 >> 2) * 16 + 4 * q2 + (i2 & 3);
#pragma unroll
                for (int i = 0; i < 8; ++i) { const int e1 = (i >> 2) * 16 + 4 * kq + (i & 3); rank[i] += (o > lv[i] || (o == lv[i] && e2 < e1)) ? 1 : 0; } } }
#pragma unroll
        for (int i = 0; i < 8; ++i) if (rank[i] < 4) { const int e1 = (i >> 2) * 16 + 4 * kq + (i & 3); sel[(w * 16 + m) * 4 + rank[i]] = (f32x2){__builtin_bit_cast(float, e1), lv[i]}; }
        asm volatile("s_waitcnt lgkmcnt(0)" ::: "memory");
        { const int tm = lane >> 2, k = lane & 3; const f32x2 s0 = sel[(w * 16 + tm) * 4 + 0], s1 = sel[(w * 16 + tm) * 4 + 1], s2 = sel[(w * 16 + tm) * 4 + 2], s3 = sel[(w * 16 + tm) * 4 + 3];
          const float p0 = 1.f, p1 = __expf(s1.y - s0.y), p2 = __expf(s2.y - s0.y), p3 = __expf(s3.y - s0.y), ps = (p0 + p1) + (p2 + p3);
          const f32x2 mine = k == 0 ? s0 : (k == 1 ? s1 : (k == 2 ? s2 : s3)); const float pm = (k == 0 ? p0 : (k == 1 ? p1 : (k == 2 ? p2 : p3))) / ps;
          const int e = __builtin_bit_cast(int, mine.x);
          const int lr = __hip_atomic_fetch_add(lcnt + e, 1, __ATOMIC_RELAXED, __HIP_MEMORY_SCOPE_WORKGROUP);
          rec[(w * 16 + tm) * 4 + k] = ((unsigned)e << 16) | (unsigned)lr; recp[(w * 16 + tm) * 4 + k] = pm; }
        __syncthreads();
        if (F.tid < 32) { const int n = lcnt[F.tid]; gbase[F.tid] = n ? (int)atomicAdd(F.ctl + CW_CNT + 64 * F.tid, (unsigned)n) : 0; lcnt[F.tid] = 0; }
        __syncthreads();
        { const unsigned r = rec[F.tid]; const int e = r >> 16, rk = gbase[e] + (int)(r & 0xffffu), tt = blk * 128 + (F.tid >> 2);
          WSP(int, WS_TOK)[(size_t)e * T + rk] = tt; WSP(unsigned, WS_POS)[(size_t)tt * 4 + (F.tid & 3)] = ((unsigned)e << 20) | (unsigned)rk; WSP(float, WS_PROB)[(size_t)tt * 4 + (F.tid & 3)] = recp[F.tid]; }
        __syncthreads();
    }
}
__device__ __forceinline__ void p12_final(Frame& F) {
    moe_tables(F);
    const LAS int* tstart = (const LAS int*)(F.lds + TAB_OFF);
    const float* mod = WSP(float, WS_MOD); const bf16* x1 = WSP(bf16, WS_X1); const bf16* yb = WSP(bf16, WS_YB); const unsigned* pos = WSP(unsigned, WS_POS); const float* prob = WSP(float, WS_PROB);
    const int lane = F.lane, gw = F.vcu * 8 + F.wave, NGW = F.G * 8;
    f32x4 lg[4], lb[4];
#pragma unroll
    for (int j = 0; j < 4; ++j) { lg[j] = *(const f32x4*)(F.in[32] + 512 * (j >> 1) + 8 * lane + 4 * (j & 1)); lb[j] = *(const f32x4*)(F.in[33] + 512 * (j >> 1) + 8 * lane + 4 * (j & 1)); }
#define P12_ROUTE(PP, PW, tt) do { const u32x4 p4_ = *(const u32x4*)(pos + (size_t)(tt) * 4); const f32x4 w4_ = *(const f32x4*)(prob + (size_t)(tt) * 4); \
        PP[0] = p4_.x; PP[1] = p4_.y; PP[2] = p4_.z; PP[3] = p4_.w; PW[0] = w4_[0]; PW[1] = w4_[1]; PW[2] = w4_[2]; PW[3] = w4_[3]; } while (0)
#define P12_ROWS(YW, XW, PP, tt) do { _Pragma("unroll") for (int k = 0; k < 4; ++k) { const int e_ = PP[k] >> 20, rk_ = PP[k] & 0xfffffu; const size_t slot_ = (size_t)tstart[e_] * 256 + rk_; \
            _Pragma("unroll") for (int j = 0; j < 2; ++j) YW[k][j] = *((const u32x2*)((const unsigned char*)yb + slot_ * 1024) + 64 * j + lane); } \
        _Pragma("unroll") for (int j = 0; j < 2; ++j) XW[j] = *((const u32x4*)(x1 + (size_t)(tt) * 1024) + 64 * j + lane); } while (0)
#define P12_COMPUTE(YW, XW, PW, tt) do { const int b_ = (tt) >> 12; f32x4 v[4]; float s_ = 0.f; \
        _Pragma("unroll") for (int j = 0; j < 2; ++j) { f32x4 f0 = (f32x4){0.f, 0.f, 0.f, 0.f}, f1 = f0; \
            _Pragma("unroll") for (int k = 0; k < 4; ++k) { const u32x2 yv_ = YW[k][j]; const f32x2 q0_ = __builtin_amdgcn_cvt_pk_f32_fp8((int)yv_.x, false), q1_ = __builtin_amdgcn_cvt_pk_f32_fp8((int)yv_.x, true), q2_ = __builtin_amdgcn_cvt_pk_f32_fp8((int)yv_.y, false), q3_ = __builtin_amdgcn_cvt_pk_f32_fp8((int)yv_.y, true); \
                f0 += (f32x4){q0_.x, q0_.y, q1_.x, q1_.y} * PW[k]; f1 += (f32x4){q2_.x, q2_.y, q3_.x, q3_.y} * PW[k]; } \
            f32x4 xa_, xc_; unpack8(XW[j], xa_, xc_); const float* gp_ = mod + b_ * 6144 + 5120 + 512 * j + 8 * lane; \
            v[2 * j] = xa_ * DN_ALPHA + (*(const f32x4*)gp_ + 1.0f) * f0; v[2 * j + 1] = xc_ * DN_ALPHA + (*(const f32x4*)(gp_ + 4) + 1.0f) * f1; \
            s_ += ((v[2 * j][0] + v[2 * j][1]) + (v[2 * j][2] + v[2 * j][3])) + ((v[2 * j + 1][0] + v[2 * j + 1][1]) + (v[2 * j + 1][2] + v[2 * j + 1][3])); } \
        const float mean_ = wave_sum(s_) * (1.f / 1024.f); float s2_ = 0.f; \
        _Pragma("unroll") for (int j = 0; j < 4; ++j) { v[j] = v[j] - mean_; s2_ += (v[j][0] * v[j][0] + v[j][1] * v[j][1]) + (v[j][2] * v[j][2] + v[j][3] * v[j][3]); } \
        const float rstd_ = 1.f / sqrtf(wave_sum(s2_) * (1.f / 1024.f) + LN_EPS); \
        _Pragma("unroll") for (int j = 0; j < 4; ++j) *(f32x4*)(F.out + (size_t)(tt) * 1024 + 512 * (j >> 1) + 8 * lane + 4 * (j & 1)) = v[j] * rstd_ * lg[j] + lb[j]; } while (0)
    const int nmine = (T - gw + NGW - 1) / NGW;
    unsigned ppA[4], ppB[4]; float pwA[4], pwB[4], pwN[4]; u32x2 ywA[4][2], ywB[4][2]; u32x4 xwA[2], xwB[2];
    if (nmine > 0) { P12_ROUTE(ppA, pwA, gw); P12_ROWS(ywA, xwA, ppA, gw); }
    if (nmine > 1) { P12_ROUTE(ppB, pwB, gw + NGW); }
    for (int i = 0; i < nmine; i += 2) {
        const int t0 = gw + i * NGW, t1 = t0 + NGW, t2 = t1 + NGW, t3 = t2 + NGW;
        if (i + 1 < nmine) { P12_ROWS(ywB, xwB, ppB, t1); }
        if (i + 2 < nmine) { P12_ROUTE(ppA, pwN, t2); }
        __builtin_amdgcn_sched_barrier(0);
        P12_COMPUTE(ywA, xwA, pwA, t0);
        if (i + 1 < nmine) {
#pragma unroll
            for (int k = 0; k < 4; ++k) pwA[k] = pwN[k];
            if (i + 2 < nmine) { P12_ROWS(ywA, xwA, ppA, t2); }
            if (i + 3 < nmine) { P12_ROUTE(ppB, pwN, t3); }
            __builtin_amdgcn_sched_barrier(0);
            P12_COMPUTE(ywB, xwB, pwB, t1);
#pragma unroll
            for (int k = 0; k < 4; ++k) pwB[k] = pwN[k];
        }
    }
#undef P12_ROUTE
#undef P12_ROWS
#undef P12_COMPUTE
}

struct Args { const float* in[34]; float* out; unsigned char* ws; int ph_lo, ph_hi; };
__global__ void __launch_bounds__(512, 2) fwd_kernel(Args args) {
    extern __shared__ __attribute__((aligned(16))) unsigned char lds_raw[];
    Frame F;
    F.lds = (LAS unsigned char*)lds_raw; F.MISC = (volatile LAS unsigned*)(F.lds + MISC_OFF);
    F.tid = threadIdx.x; F.lane = F.tid & 63; F.wave = __builtin_amdgcn_readfirstlane(F.tid >> 6);
    F.G = gridDim.x; { const int bx = blockIdx.x; F.vcu = (F.G % 8 == 0) ? (bx % 8) * (F.G / 8) + bx / 8 : bx; }
#pragma unroll
    for (int i = 0; i < 34; ++i) F.in[i] = args.in[i];
    F.out = args.out; F.ws = args.ws; F.ctl = (unsigned*)(args.ws + WS_CTL);
    if (F.tid < 64) F.MISC[F.tid] = 0u;
    __syncthreads();
    XcdBarrier bar; bar.bar = F.ctl + CW_BAR; bar.x = 0; bar.st = nullptr;
    if (MK_N_LAUNCHES == 1) bar = xcd_barrier_post(F.ctl + CW_BAR, F.MISC + 8);
    const int lo = args.ph_lo, hi = args.ph_hi;
#define IN(k) (lo <= (k) && (k) < hi)
#define SEAM(k) do { if (IN(k) && IN((k) + 1)) xcd_barrier(bar); } while (0)

    if (IN(0)) REPS(0) { if (rep_) xcd_barrier(bar);
        for (int j = F.vcu; j < 192; j += F.G) p0_mod_job(F, j);
        for (int j = F.vcu; j < S5G * 8; j += F.G) p0_s5k_job(F, j);
        { bf16* img = WSP(bf16, WS_WRIMG); const float* wr = F.in[26];
          for (int i = F.vcu * 512 + F.tid; i < 1024 * 32; i += F.G * 512) { const float w = wr[i]; const unsigned hb = f2bf(w); const float hf = __builtin_bit_cast(float, hb << 16);
              img[(i & 31) * 1032 + (i >> 5)] = (bf16)hb; img[32 * 1032 + (i & 31) * 1032 + (i >> 5)] = (bf16)f2bf(w - hf); } }
        p0_small_transposes(F);
    }
    SEAM(0);
    if (IN(1)) REPS(1) { if (rep_) xcd_barrier(bar); for (int j = F.vcu; j < S5G * 8; j += F.G) p1_s5w_job(F, j); p1_body(F); }
    SEAM(1);
    if (IN(2)) REPS(2) { if (rep_) xcd_barrier(bar);
        g8::GridOrder S; S.init(T, INC, F.G, (int)blockIdx.x, WSP(bf16, WS_HBF), WSP(bf16, WS_WIN), 1024, 1024);
        EpiInProj E{F.in[5], WSP(bf16, WS_XRNN), WSP(bf16, WS_GY), WSP(bf16, WS_ACAT), WSP(bf16, WS_GATES)};
        g8::gemm_phase<EpiInProj, g8::GridOrder, false, true>(F.lds, 1024, 1024, 1024, S, E);
    }
    SEAM(2);
    if (IN(3)) REPS(3) { if (rep_) xcd_barrier(bar);
        { S5AOrder S{F.G, F.vcu, (const char*)WSP(bf16, WS_ACAT), (const char*)WSP(bf16, WS_WS)}; EpiS5A E{WSP(float, WS_S)};
          g8::gemm_phase<EpiS5A, S5AOrder, false>(F.lds, S5L * 32, S5ROW * 2, S5L * 32, S, E); }
        __syncthreads();
        rglru_phase<0>(F);
    }
    SEAM(3);
    if (IN(4)) REPS(4) { if (rep_) xcd_barrier(bar); p4_carries(F); }
    SEAM(4);
    if (IN(5)) REPS(5) { if (rep_) xcd_barrier(bar);
        { S5COrder S{F.G, F.vcu, (const char*)WSP(bf16, WS_ACAT), (const char*)WSP(bf16, WS_WY)}; EpiS5C E{WSP(bf16, WS_YS)};
          g8::gemm_phase<EpiS5C, S5COrder, false>(F.lds, S5ROW * 2, S5ROW * 2, S5ROW * 2, S, E); }
        __syncthreads();
        rglru_phase<1>(F);
    }
    SEAM(5);
    if (IN(6)) REPS(6) { if (rep_) xcd_barrier(bar);
        g8::GridOrder S; S.init(T, 2048, F.G, (int)blockIdx.x, WSP(bf16, WS_YS), WSP(bf16, WS_WGLU), 512, 512);
        EpiGlu E{WSP(bf16, WS_GATES), WSP(bf16, WS_GB)};
        g8::gemm_phase<EpiGlu, g8::GridOrder, false, true>(F.lds, 512, 512, 512, S, E);
    }
    SEAM(6);
    if (IN(7)) REPS(7) { if (rep_) xcd_barrier(bar);
        g8::GridOrder S; S.init(T, 1024, F.G, (int)blockIdx.x, WSP(bf16, WS_HA), WSP(bf16, WS_WRNN), 1024, 1024);
        EpiRnn E{WSP(bf16, WS_GATES), WSP(bf16, WS_GB), WSP(bf16, WS_MERGED)};
        g8::gemm_phase<EpiRnn, g8::GridOrder, false, true>(F.lds, 1024, 1024, 1024, S, E);
    }
    SEAM(7);
    if (IN(8)) REPS(8) { if (rep_) xcd_barrier(bar);
        g8::GridOrder S; S.init(T, 1024, F.G, (int)blockIdx.x, WSP(bf16, WS_MERGED), WSP(bf16, WS_WOUT), 1024, 1024);
        EpiOut E{F.in[0], WSP(float, WS_MOD), WSP(bf16, WS_V1)};
        g8::gemm_phase<EpiOut, g8::GridOrder, false, true>(F.lds, 1024, 1024, 1024, S, E);
    }
    SEAM(8);
    if (IN(9)) REPS(9) { if (rep_) xcd_barrier(bar); p9_router(F); }
    SEAM(9);
    if (IN(10)) REPS(10) { if (rep_) xcd_barrier(bar);
        moe_tables(F);
        const LAS int* tstart = (const LAS int*)(F.lds + TAB_OFF);
        MoeOrder S{F.G, (int)blockIdx.x, 8, tstart[NE], tstart, tstart + 40, WSP(int, WS_TOK), (const char*)WSP(bf16, WS_H2), (const char*)WSP(bf16, WS_WGU), (size_t)2048 * 1024, 1024, true};
        EpiMoe1 E{F.in[29], WSP(bf16, WS_ACT)};
        g8::gemm_phase<EpiMoe1, MoeOrder, true, true>(F.lds, 1024, 1024, 1024, S, E);
    }
    SEAM(10);
    if (IN(11)) REPS(11) { if (rep_) xcd_barrier(bar);
        moe_tables(F);
        const LAS int* tstart = (const LAS int*)(F.lds + TAB_OFF);
        MoeOrder S{F.G, (int)blockIdx.x, 4, tstart[NE], tstart, tstart + 40, WSP(int, WS_TOK), (const char*)WSP(bf16, WS_ACT), (const char*)WSP(bf16, WS_WD), (size_t)1024 * 1024, 1024, false};
        EpiMoe2 E{F.in[31], WSP(bf16, WS_YB)};
        g8::gemm_phase<EpiMoe2, MoeOrder, false, true>(F.lds, 1024, 1024, 1024, S, E);
    }
    SEAM(11);
    if (IN(12)) REPS(12) { if (rep_) xcd_barrier(bar); p12_final(F); }
#undef IN
#undef SEAM
}

extern "C" void kernel_launch(void* const* d_in, const int* in_sizes, int n_in, void* d_out, int out_size, void* d_ws, size_t ws_size, hipStream_t stream) {
    static int grid = 0;
    if (grid == 0) {
        if (n_in != 34 || in_sizes[0] != T * D || out_size != T * D || ws_size < WS_END) { fprintf(stderr, "kernel_launch: unexpected shapes (n_in %d, ws %zu < %zu)\n", n_in, ws_size, (size_t)WS_END); grid = -1; return; }
        int dev = 0, cus = 0;
        if (hipGetDevice(&dev) != hipSuccess || hipDeviceGetAttribute(&cus, hipDeviceAttributeMultiprocessorCount, dev) != hipSuccess) { grid = -1; return; }
        if (hipFuncSetAttribute((const void*)fwd_kernel, hipFuncAttributeMaxDynamicSharedMemorySize, LDS_BYTES) != hipSuccess) { fprintf(stderr, "kernel_launch: hipFuncSetAttribute failed\n"); grid = -1; return; }
        int per_cu = 0; (void)hipOccupancyMaxActiveBlocksPerMultiprocessor(&per_cu, (const void*)fwd_kernel, 512, LDS_BYTES); (void)hipGetLastError();
        grid = cus;
    }
    if (grid < 0) return;
    (void)hipMemsetAsync((char*)d_ws + WS_CTL, 0, CTL_BYTES, stream);
    Args a{};
    for (int i = 0; i < 34; ++i) a.in[i] = (const float*)d_in[i];
    a.out = (float*)d_out; a.ws = (unsigned char*)d_ws;
    if (MK_N_LAUNCHES == 1) { a.ph_lo = 0; a.ph_hi = N_PHASES; hipLaunchKernelGGL(fwd_kernel, dim3(grid), dim3(512), LDS_BYTES, stream, a); }
    else for (int p = 0; p < N_PHASES; ++p) { a.ph_lo = p; a.ph_hi = p + 1; hipLaunchKernelGGL(fwd_kernel, dim3(grid), dim3(512), LDS_BYTES, stream, a); }
}
```

```cpp
#include <hip/hip_runtime.h>
#include <cstdio>
#include <cstdint>

#ifndef MK_N_LAUNCHES
#define MK_N_LAUNCHES 1
#endif
constexpr int N_PHASES = 13;
#ifndef DUP_PHASE
#define DUP_PHASE -1
#endif
#define REPS(k) for (int rep_ = 0; rep_ < ((DUP_PHASE == (k)) ? 2 : 1); ++rep_)

#define GAS __attribute__((address_space(1)))
#define LAS __attribute__((address_space(3)))
typedef unsigned short bf16;
typedef short bf16x8 __attribute__((ext_vector_type(8)));
typedef float f32x4 __attribute__((ext_vector_type(4)));
typedef float f32x2 __attribute__((ext_vector_type(2)));
typedef unsigned u32x4 __attribute__((ext_vector_type(4)));
typedef unsigned u32x2 __attribute__((ext_vector_type(2)));
typedef GAS unsigned gu32;

constexpr int NB = 8, SEQ = 4096, T = NB * SEQ, D = 1024, INC = 4608, NE = 32, DFF = 1024;
constexpr int S5L = 32, S5G = 32, S5ROW = 128 + S5L * 16  , S5M = T / S5L  , S5CPB = SEQ / S5L  ;
constexpr int RGL = 128, RGC = SEQ / RGL  ;
constexpr float LN_EPS = 1e-5f, DN_ALPHA = 1.189207115002721f;
constexpr int ACT_ROWS = T * 4 + NE * 256;

constexpr size_t MiB = 1u << 20;
constexpr size_t WS_XRNN = 0, WS_GY = 64 * MiB, WS_GATES = 128 * MiB, WS_V1 = 0, WS_ACT = 0;
constexpr size_t WS_HBF = 272 * MiB, WS_HA = 272 * MiB, WS_YS = 336 * MiB, WS_GB = 368 * MiB, WS_MERGED = 432 * MiB, WS_ACAT = 496 * MiB, WS_YB = 272 * MiB;
constexpr size_t WS_X1 = 544 * MiB, WS_H2 = 608 * MiB;
constexpr size_t WS_WGU = 672 * MiB, WS_WD = 800 * MiB, WS_WIN = 864 * MiB, WS_WG = 873 * MiB, WS_WRNN = 874 * MiB, WS_WGLU = 876 * MiB, WS_WOUT = 878 * MiB;
constexpr size_t WS_WS = 880 * MiB, WS_WY = 888 * MiB, WS_S = 908 * MiB;
constexpr size_t WS_MOD = 924 * MiB, WS_AL = 925 * MiB, WS_RGAGG = 926 * MiB, WS_HIN = 928 * MiB, WS_TOK = 929 * MiB, WS_POS = 933 * MiB, WS_PROB = 934 * MiB, WS_CTL = 935 * MiB;
constexpr size_t WS_END = 936 * MiB, CTL_BYTES = 1 * MiB;
static_assert((size_t)ACT_ROWS * DFF * 2 <= 272 * MiB, "act/yb size");
static_assert(WS_ACAT + (size_t)S5G * S5M * S5ROW * 2 <= WS_X1, "acat");
constexpr int CW_BAR = 4096, CW_CNT = 8192  ;

constexpr int LDS_BYTES = 147456, MISC_OFF = LDS_BYTES - 256, TAB_OFF = 131072 + 1024;

__device__ __forceinline__ unsigned f2bf(float f) { unsigned u = __builtin_bit_cast(unsigned, f); return (u + 0x7fffu + ((u >> 16) & 1u)) >> 16; }
typedef __bf16 bf16x2v __attribute__((ext_vector_type(2)));
__device__ __forceinline__ unsigned pk2(float lo, float hi) { const f32x2 v = {lo, hi}; const bf16x2v b = __builtin_convertvector(v, bf16x2v); return __builtin_bit_cast(unsigned, b); }
__device__ __forceinline__ unsigned pk4_fp8(float a, float b, float c, float d) { a = __builtin_amdgcn_fmed3f(a, -448.f, 448.f); b = __builtin_amdgcn_fmed3f(b, -448.f, 448.f); c = __builtin_amdgcn_fmed3f(c, -448.f, 448.f); d = __builtin_amdgcn_fmed3f(d, -448.f, 448.f); int w = 0; w = __builtin_amdgcn_cvt_pk_fp8_f32(a, b, w, false); w = __builtin_amdgcn_cvt_pk_fp8_f32(c, d, w, true); return (unsigned)w; }
__device__ __forceinline__ float bflo(unsigned w) { return __builtin_bit_cast(float, w << 16); }
__device__ __forceinline__ float bfhi(unsigned w) { return __builtin_bit_cast(float, w & 0xffff0000u); }
__device__ __forceinline__ float bf1(bf16 h) { return __builtin_bit_cast(float, ((unsigned)h) << 16); }
__device__ __forceinline__ float fast_sigmoid(float x) { return __builtin_amdgcn_rcpf(1.0f + __builtin_amdgcn_exp2f(-1.4426950409f * x)); }
__device__ __forceinline__ float gelu_tanh(float x) { const float u = x + 0.044715f * x * x * x; return x * __builtin_amdgcn_rcpf(1.0f + __builtin_amdgcn_exp2f(-2.3022082f * u)); }
__device__ __forceinline__ float wave_sum(float v) {
#pragma unroll
    for (int o = 1; o < 64; o <<= 1) v += __shfl_xor(v, o);
    return v;
}
__device__ __forceinline__ u32x4 pack8(f32x4 a, f32x4 b) { u32x4 w; w.x = pk2(a[0], a[1]); w.y = pk2(a[2], a[3]); w.z = pk2(b[0], b[1]); w.w = pk2(b[2], b[3]); return w; }
__device__ __forceinline__ void unpack8(u32x4 w, f32x4& a, f32x4& b) { a = (f32x4){bflo(w.x), bfhi(w.x), bflo(w.y), bfhi(w.y)}; b = (f32x4){bflo(w.z), bfhi(w.z), bflo(w.w), bfhi(w.w)}; }

#define XB_TMO      128
#define XB_XCNT(j)  (256  + 64 * (j))
#define XB_XSUB(j)  (1280 + 64 * (j))
#define XB_XGEN(j)  (2304 + 64 * (j))
#define XB_TOP      3328
#define XB_TOPGEN   3392
#define XCD_BAR_WORDS 3456
#define XB_SPIN_CAP (1u << 18)
__device__ __forceinline__ unsigned xb_ld(unsigned* p)              { return __hip_atomic_load(p, __ATOMIC_RELAXED, __HIP_MEMORY_SCOPE_AGENT); }
__device__ __forceinline__ unsigned xb_add(unsigned* p, unsigned v) { return __hip_atomic_fetch_add(p, v, __ATOMIC_RELAXED, __HIP_MEMORY_SCOPE_AGENT); }
__device__ __forceinline__ unsigned xb_xcc_id() { return (unsigned)__builtin_amdgcn_s_getreg((3 << 11) | 20) & 0xFu; }
#define XB_SPIN(cond, bar) do { unsigned _sp = 0; while (cond) { __builtin_amdgcn_s_sleep(1); \
    if ((++_sp & 255u) == 0u) { if (xb_ld(&(bar)[XB_TMO])) break; if (_sp > XB_SPIN_CAP) { atomicAdd(&(bar)[XB_TMO], 1u); break; } } } } while (0)
struct XcdBarrier { unsigned* bar; unsigned x; volatile LAS unsigned* st; };
__device__ __forceinline__ XcdBarrier xcd_barrier_post(unsigned* bar, volatile LAS unsigned* st) {
    XcdBarrier b; b.bar = bar; b.x = xb_xcc_id(); b.st = st;
    if (threadIdx.x == 0) (void)xb_add(&bar[XB_XCNT(b.x)], 1u);
    return b;
}
__device__ __forceinline__ void xcd_barrier_complete(unsigned* bar, unsigned x, unsigned& nloc, unsigned& nx) {
    const unsigned G = gridDim.x * gridDim.y * gridDim.z;
    unsigned sum, cnt, mine, sp = 0u;
    for (;;) {
        sum = 0u; cnt = 0u; mine = 0u;
#pragma unroll
        for (unsigned j = 0; j < 16; ++j) { const unsigned c = xb_ld(&bar[XB_XCNT(j)]); sum += c; cnt += (c > 0u) ? 1u : 0u; mine = (j == x) ? c : mine; }
        if (sum == G) break;
        __builtin_amdgcn_s_sleep(1);
        if ((++sp & 255u) == 0u) { if (xb_ld(&bar[XB_TMO])) break; if (sp > XB_SPIN_CAP) { atomicAdd(&bar[XB_TMO], 1u); break; } }
    }
    nloc = mine > 0u ? mine : 1u; nx = cnt > 0u ? cnt : 1u;
}
__device__ __forceinline__ void xcd_barrier(const XcdBarrier& b) {
    asm volatile("s_waitcnt vmcnt(0)" ::: "memory");
    __syncthreads();
    if (threadIdx.x == 0) {
        unsigned* bar = b.bar;
        __builtin_amdgcn_s_waitcnt(0);
        unsigned nloc = b.st[0], nx = b.st[1];
        if (nloc == 0u) { xcd_barrier_complete(bar, b.x, nloc, nx); b.st[0] = nloc; b.st[1] = nx; }
        const unsigned old = xb_add(&bar[XB_XSUB(b.x)], 1u);
        const unsigned gen = old / nloc;
        if (old + 1u == (gen + 1u) * nloc) {
            __builtin_amdgcn_fence(__ATOMIC_RELEASE, "agent");
            asm volatile("s_waitcnt vmcnt(0)" ::: "memory");
            const unsigned og = xb_add(&bar[XB_TOP], 1u);
            const unsigned tg = og / nx;
            if (og + 1u == (tg + 1u) * nx) xb_add(&bar[XB_TOPGEN], 1u);
            else XB_SPIN(xb_ld(&bar[XB_TOPGEN]) == tg, bar);
            __builtin_amdgcn_fence(__ATOMIC_ACQUIRE, "agent");
            xb_add(&bar[XB_XGEN(b.x)], 1u);
            asm volatile("s_waitcnt vmcnt(0)" ::: "memory");
        } else {
            XB_SPIN(xb_ld(&bar[XB_XGEN(b.x)]) == gen, bar);
            __builtin_amdgcn_fence(__ATOMIC_ACQUIRE, "agent");
            asm volatile("s_waitcnt vmcnt(0)" ::: "memory");
        }
    }
    __syncthreads();
}

namespace g8 {
constexpr int BM = 256, BK = 64, HALF = 128, HTB = HALF * BK * 2, STAGE_BYTES = 8 * HTB;
__device__ __forceinline__ int lds_byte(int r, int c) { const int st = (r >> 4) * 2 + (c >> 5), rr = r & 15, cc = c & 31, ob = rr * 64 + cc * 2; return st * 1024 + (ob ^ (((ob >> 9) & 1) << 5)); }
__device__ __forceinline__ void stage_rc(int b, int& R, int& C) { const int st = b / 1024, sb = b % 1024, swz = sb ^ (((sb >> 9) & 1) << 5); R = (st >> 1) * 16 + swz / 64; C = (st & 1) * 32 + (swz % 64) / 2; }
__device__ __forceinline__ int perm32(int rho) { const int n = rho >> 4, i = rho & 15; return 8 * (i >> 2) + 4 * n + (i & 3); }

struct Unit { int pm, pn, z, rl; const char* A; const char* B; };

typedef int v8i __attribute__((ext_vector_type(8)));
typedef int v4i __attribute__((ext_vector_type(4)));
typedef short s16x16 __attribute__((ext_vector_type(16)));
typedef s16x16 s16x16_a16 __attribute__((aligned(16)));
__device__ __forceinline__ v8i cat8(bf16x8 lo, bf16x8 hi) { const v4i a = __builtin_bit_cast(v4i, lo), b = __builtin_bit_cast(v4i, hi); return __builtin_shufflevector(a, b, 0, 1, 2, 3, 4, 5, 6, 7); }
template <class Epi, class Sched, bool GATHER, bool FP8 = false>
__device__ __forceinline__ void gemm_phase(LAS unsigned char* lds, const int Kb, const int ldaB, const int ldbB, const Sched& S, const Epi& E) {
    const int tid = threadIdx.x, wid = __builtin_amdgcn_readfirstlane(tid >> 6), lane = tid & 63, wr = wid >> 2, wc = wid & 3, fr = lane & 15, fq = lane >> 4;
    const int nt = Kb / 128;
    unsigned voffB[2], cvo[2][2], nvo[2][2]; int Rr[2], Cc[2];
#pragma unroll
    for (int i = 0; i < 2; ++i) { int R, C; stage_rc(tid * 16 + i * 8192, R, C); const int Rb = (R & ~31) + perm32(R & 31);
        voffB[i] = (unsigned)(Rb * ldbB + C * 2); Rr[i] = R; Cc[i] = C;
#pragma unroll
        for (int h = 0; h < 2; ++h) { cvo[h][i] = (unsigned)((h * HALF + R) * ldaB + C * 2); nvo[h][i] = cvo[h][i]; } }
    const size_t kstep = (size_t)(BK * 2);
    const size_t hstepB = (size_t)HALF * ldbB;
    const unsigned ldsw = (unsigned)wid * 1024u;
    const int aoff = FP8 ? lds_byte(wr * 64 + fr, (fq >> 1) * 32 + (fq & 1) * 24) : lds_byte(wr * 64 + fr, fq * 8), boff = FP8 ? lds_byte(wc * 32 + fr, (fq >> 1) * 32 + (fq & 1) * 24) : lds_byte(wc * 32 + fr, fq * 8);
    const int aoff2 = FP8 ? lds_byte(wr * 64 + fr, (fq >> 1) * 32 + 8 + (fq & 1) * 8) : 0, boff2 = FP8 ? lds_byte(wc * 32 + fr, (fq >> 1) * 32 + 8 + (fq & 1) * 8) : 0;
#define G8_SA(b, h) (((b) * 2 + (h)) * HTB)
#define G8_SB(b, h) ((4 + (b) * 2 + (h)) * HTB)
#define G8_STGB(bufoff, gbase) do { _Pragma("unroll") for (int _i = 0; _i < 2; ++_i) \
        __builtin_amdgcn_global_load_lds((const unsigned*)((const char*)(gbase) + voffB[_i]), (LAS unsigned*)(lds + (bufoff) + ldsw + _i * 8192), 16, 0, 0); } while (0)
#define G8_STGA(bufoff, gbase, VO, h) do { _Pragma("unroll") for (int _i = 0; _i < 2; ++_i) \
        __builtin_amdgcn_global_load_lds((const unsigned*)((const char*)(gbase) + VO[h][_i]), (LAS unsigned*)(lds + (bufoff) + ldsw + _i * 8192), 16, 0, 0); } while (0)
#define G8_LDA(dst, b, h) do { _Pragma("unroll") for (int m = 0; m < 4; ++m) { if constexpr (FP8) { dst##8[m] = cat8(*(const LAS bf16x8*)(lds + G8_SA(b, h) + aoff + m * 2048), *(const LAS bf16x8*)(lds + G8_SA(b, h) + aoff2 + m * 2048)); } \
        else { _Pragma("unroll") for (int k = 0; k < 2; ++k) dst[m][k] = *(const LAS bf16x8*)(lds + G8_SA(b, h) + aoff + m * 2048 + k * 1024); } } } while (0)
#define G8_LDB(dst, b, h) do { _Pragma("unroll") for (int n = 0; n < 2; ++n) { if constexpr (FP8) { dst##8[n] = cat8(*(const LAS bf16x8*)(lds + G8_SB(b, h) + boff + n * 2048), *(const LAS bf16x8*)(lds + G8_SB(b, h) + boff2 + n * 2048)); } \
        else { _Pragma("unroll") for (int k = 0; k < 2; ++k) dst[n][k] = *(const LAS bf16x8*)(lds + G8_SB(b, h) + boff + n * 2048 + k * 1024); } } } while (0)
#define G8_MMA(ai, bj, At, Bt) do { __builtin_amdgcn_s_setprio(1); _Pragma("unroll") for (int m = 0; m < 4; ++m) _Pragma("unroll") for (int n = 0; n < 2; ++n) { \
        if constexpr (FP8) asm volatile("s_nop 1\n\tv_mfma_scale_f32_16x16x128_f8f6f4 %0, %1, %2, %0, %3, %4 op_sel_hi:[0,0,0]" : "+v"(acc[ai][bj][m][n]) : "v"(Bt##8[n]), "v"(At##8[m]), "v"(sc_w), "v"(sc_a)); \
        else { _Pragma("unroll") for (int k = 0; k < 2; ++k) acc[ai][bj][m][n] = __builtin_amdgcn_mfma_f32_16x16x32_bf16(Bt[n][k], At[m][k], acc[ai][bj][m][n], 0, 0, 0); } } __builtin_amdgcn_s_setprio(0); } while (0)
#define G8_WAIT_V(n) asm volatile("s_waitcnt vmcnt(" #n ")" ::: "memory")
#define G8_WAIT_L(n) asm volatile("s_waitcnt lgkmcnt(" #n ")" ::: "memory")
#define G8_BAR __builtin_amdgcn_s_barrier()
#define G8_SCHED __builtin_amdgcn_sched_barrier(0)
    Unit cur, nxt; int ui = 0;
    if (!S.next(0, cur)) return;
    bool has_next = S.next(1, nxt);
    if constexpr (GATHER) { S.gather(cur, Rr, Cc, cvo); if (has_next) S.gather(nxt, Rr, Cc, nvo); else {
#pragma unroll
        for (int h = 0; h < 2; ++h)
#pragma unroll
            for (int i = 0; i < 2; ++i) nvo[h][i] = cvo[h][i]; } }
    f32x4 acc[2][2][4][2];
#pragma unroll
    for (int a = 0; a < 2; ++a)
#pragma unroll
        for (int b = 0; b < 2; ++b)
#pragma unroll
            for (int m = 0; m < 4; ++m)
#pragma unroll
                for (int n = 0; n < 2; ++n) acc[a][b][m][n] = (f32x4){0.f, 0.f, 0.f, 0.f};
    const int sc_w = 0x7a7a7a7a, sc_a = 0x7f7f7f7f;
    bf16x8 At[4][2], B0[2][2], B1[2][2]; v8i At8[4], B08[2], B18[2];
    const char* cA = cur.A; const char* cB = cur.B;
    G8_STGB(G8_SB(0, 0), cB); G8_STGB(G8_SB(0, 1), cB + hstepB); G8_STGA(G8_SA(0, 0), cA, cvo, 0); G8_STGA(G8_SA(0, 1), cA, cvo, 1);
    if (wr == 1) G8_BAR;
    G8_WAIT_V(2); G8_BAR;
    G8_STGB(G8_SB(1, 0), cB + kstep); G8_STGA(G8_SA(1, 0), cA + kstep, cvo, 0); G8_STGB(G8_SB(1, 1), cB + hstepB + kstep);
    G8_WAIT_V(6); G8_BAR;
    for (;;) {
        const char* nA = has_next ? nxt.A : cA; const char* nB = has_next ? nxt.B : cB;
        for (int t = 0; t < nt; t += 2) {
            const bool last = (t == nt - 2);
            const char* a1 = cA + (size_t)(t + 1) * kstep;
            const char* a2 = last ? nA : cA + (size_t)(t + 2) * kstep; const char* b2 = last ? nB : cB + (size_t)(t + 2) * kstep;
            const char* a3 = a2 + kstep; const char* b3 = b2 + kstep;
            unsigned vo2[2][2];
#pragma unroll
            for (int h = 0; h < 2; ++h)
#pragma unroll
                for (int i = 0; i < 2; ++i) vo2[h][i] = (GATHER && last) ? nvo[h][i] : cvo[h][i];
            G8_LDB(B0, 0, 0); G8_LDB(B1, 0, 1); G8_SCHED; G8_LDA(At, 0, 0); G8_STGA(G8_SA(1, 1), a1, cvo, 1);
            G8_WAIT_V(8); G8_WAIT_L(0); G8_BAR; G8_SCHED; G8_MMA(0, 0, At, B0); G8_MMA(0, 1, At, B1); G8_SCHED; G8_BAR; G8_SCHED;
            G8_LDA(At, 0, 1); G8_STGB(G8_SB(0, 0), b2); G8_STGB(G8_SB(0, 1), b2 + hstepB); G8_STGA(G8_SA(0, 0), a2, vo2, 0);
            G8_WAIT_V(8); G8_WAIT_L(0); G8_BAR; G8_SCHED; G8_MMA(1, 0, At, B0); G8_MMA(1, 1, At, B1); G8_SCHED; G8_BAR; G8_SCHED;
            G8_LDB(B0, 1, 0); G8_LDB(B1, 1, 1); G8_SCHED; G8_LDA(At, 1, 0); G8_STGA(G8_SA(0, 1), a2, vo2, 1);
            G8_WAIT_V(8); G8_WAIT_L(0); G8_BAR; G8_SCHED; G8_MMA(0, 0, At, B0); G8_MMA(0, 1, At, B1); G8_SCHED; G8_BAR; G8_SCHED;
            G8_LDA(At, 1, 1); G8_STGB(G8_SB(1, 0), b3); G8_STGB(G8_SB(1, 1), b3 + hstepB); G8_STGA(G8_SA(1, 0), a3, vo2, 0);
            G8_WAIT_V(8); G8_WAIT_L(0); G8_BAR; G8_SCHED; G8_MMA(1, 0, At, B0); G8_MMA(1, 1, At, B1); G8_SCHED; G8_BAR; G8_SCHED;
        }
        if (wr == 0) G8_BAR;
        Unit nn; bool has_nn = false;
        if (has_next) has_nn = S.next(ui + 2, nn);
        unsigned nnvo[2][2];
        if constexpr (GATHER) { if (has_nn) S.gather(nn, Rr, Cc, nnvo); }
        if constexpr (FP8) asm volatile("s_nop 15\n\ts_nop 15" ::: "memory");
        E(acc, cur, wr, wc, fr, fq);
        if (!has_next) break;
#pragma unroll
        for (int a = 0; a < 2; ++a)
#pragma unroll
            for (int b = 0; b < 2; ++b)
#pragma unroll
                for (int m = 0; m < 4; ++m)
#pragma unroll
                    for (int n = 0; n < 2; ++n) acc[a][b][m][n] = (f32x4){0.f, 0.f, 0.f, 0.f};
        cur = nxt; cA = nA; cB = nB; ++ui;
        if constexpr (GATHER) {
#pragma unroll
            for (int h = 0; h < 2; ++h)
#pragma unroll
                for (int i = 0; i < 2; ++i) { cvo[h][i] = nvo[h][i]; if (has_nn) nvo[h][i] = nnvo[h][i]; } }
        nxt = nn; has_next = has_nn;
        if (wr == 1) G8_BAR;
    }
    G8_WAIT_V(0);
    G8_BAR;
#undef G8_SA
#undef G8_SB
#undef G8_STGB
#undef G8_STGA
#undef G8_LDA
#undef G8_LDB
#undef G8_MMA
#undef G8_WAIT_V
#undef G8_WAIT_L
#undef G8_BAR
#undef G8_SCHED
}

struct GridOrder {
    int nM, nN, nwg, G, c; const char* A; const char* B; size_t tstepA, tstepB;
    __device__ __forceinline__ void init(int M, int N, int G_, int c_, const void* A_, const void* B_, int ldaB, int ldbB) { nM = M / BM; nN = N / BM; nwg = nM * nN; G = G_; c = c_; A = (const char*)A_; B = (const char*)B_; tstepA = (size_t)BM * ldaB; tstepB = (size_t)BM * ldbB; }
    __device__ __forceinline__ bool next(int i, Unit& u) const {
        const long L = (long)i * G + c; if (L >= nwg) return false;
        int wgid = (int)L; { const int q = nwg / 8, r = nwg % 8, xcd = wgid % 8, off = wgid / 8; wgid = (xcd < r ? xcd * (q + 1) : r * (q + 1) + (xcd - r) * q) + off; }
        const int nig = 8 * nN, gid = wgid / nig, fm = gid * 8, gsz = (nM - fm) < 8 ? (nM - fm) : 8;
        u.pm = fm + ((wgid % nig) % gsz); u.pn = (wgid % nig) / gsz; u.z = 0; u.rl = 0;
        u.A = A + (size_t)u.pm * tstepA; u.B = B + (size_t)u.pn * tstepB; return true;
    }
};
}

struct Frame {
    LAS unsigned char* lds; volatile LAS unsigned* MISC; unsigned* ctl;
    int tid, lane, wave, vcu, G;
    const float* in[34]; float* out; unsigned char* ws;
};
#define WSP(T_, off) ((T_*)(F.ws + (off)))

struct EpiInProj {
    const float* bias; bf16 *xrnn, *gy, *acat, *gates;
    __device__ __forceinline__ void operator()(const f32x4 (&acc)[2][2][4][2], const g8::Unit& u, int wr, int wc, int fr, int fq) const {
        const int pn = u.pn, colb = pn * 256 + wc * 32 + 8 * fq;
        f32x4 bv[2][2];
#pragma unroll
        for (int bj = 0; bj < 2; ++bj)
#pragma unroll
            for (int n = 0; n < 2; ++n) bv[bj][n] = *(const f32x4*)(bias + colb + bj * 128 + 4 * n);
#pragma unroll
        for (int ai = 0; ai < 2; ++ai)
#pragma unroll
            for (int m = 0; m < 4; ++m) { const int t = u.pm * 256 + ai * 128 + wr * 64 + m * 16 + fr;
#pragma unroll
                for (int bj = 0; bj < 2; ++bj) { f32x4 v0 = acc[ai][bj][m][0] + bv[bj][0], v1 = acc[ai][bj][m][1] + bv[bj][1]; const int col = colb + bj * 128;
                    if (pn < 4) { *(u32x4*)(xrnn + (size_t)t * 1024 + col) = pack8(v0, v1); }
                    else if (pn < 8) {
#pragma unroll
                        for (int j = 0; j < 4; ++j) { v0[j] = gelu_tanh(v0[j]); v1[j] = gelu_tanh(v1[j]); }
                        *(u32x4*)(gy + (size_t)t * 1024 + (col - 1024)) = pack8(v0, v1); }
                    else if (pn < 10) { const int cu = col - 2048, g = cu >> 4, c = cu & 15;
                        *(u32x4*)(acat + ((size_t)(g * S5M + (t >> 5)) * S5ROW + 128 + (t & 31) * 16 + c)) = pack8(v0, v1); }
                    else {
#pragma unroll
                        for (int j = 0; j < 4; ++j) { v0[j] = fast_sigmoid(v0[j]); v1[j] = fast_sigmoid(v1[j]); }
                        *(u32x4*)(gates + (size_t)t * 2048 + (col - 2560)) = pack8(v0, v1); } } }
    }
};
struct EpiS5A {
    float* S;
    __device__ __forceinline__ void operator()(const f32x4 (&acc)[2][2][4][2], const g8::Unit& u, int wr, int wc, int fr, int fq) const {
        const int col = wc * 32 + 8 * fq;
#pragma unroll
        for (int ai = 0; ai < 2; ++ai)
#pragma unroll
            for (int m = 0; m < 4; ++m) { const int row = u.pm * 256 + ai * 128 + wr * 64 + m * 16 + fr; float* p = S + ((size_t)(u.z * S5M + row)) * 128 + col;
                *(f32x4*)p = acc[ai][0][m][0]; *(f32x4*)(p + 4) = acc[ai][0][m][1]; }
    }
};
struct EpiS5C {
    bf16* ys;
    __device__ __forceinline__ void operator()(const f32x4 (&acc)[2][2][4][2], const g8::Unit& u, int wr, int wc, int fr, int fq) const {
#pragma unroll
        for (int ai = 0; ai < 2; ++ai)
#pragma unroll
            for (int m = 0; m < 4; ++m) { const int row = u.pm * 256 + ai * 128 + wr * 64 + m * 16 + fr;
#pragma unroll
                for (int bj = 0; bj < 2; ++bj) { const int n = u.pn * 256 + bj * 128 + wc * 32 + 8 * fq, i = n >> 4, c = n & 15; f32x4 v0 = acc[ai][bj][m][0], v1 = acc[ai][bj][m][1];
#pragma unroll
                    for (int j = 0; j < 4; ++j) { v0[j] = gelu_tanh(v0[j]); v1[j] = gelu_tanh(v1[j]); }
                    u32x2 w8; w8.x = pk4_fp8(v0[0], v0[1], v0[2], v0[3]); w8.y = pk4_fp8(v1[0], v1[1], v1[2], v1[3]); *(u32x2*)((unsigned char*)ys + (size_t)(row * 32 + i) * 512 + u.z * 16 + c) = w8; } }
    }
};
struct EpiGlu {
    const bf16* gates; bf16* gb;
    __device__ __forceinline__ void operator()(const f32x4 (&acc)[2][2][4][2], const g8::Unit& u, int wr, int wc, int fr, int fq) const {
        const int f = u.pn * 128 + wc * 32 + 8 * fq;
#pragma unroll
        for (int ai = 0; ai < 2; ++ai)
#pragma unroll
            for (int m = 0; m < 4; ++m) { const int t = u.pm * 256 + ai * 128 + wr * 64 + m * 16 + fr;
                const u32x4 gw = *(const u32x4*)(gates + (size_t)t * 2048 + 1024 + f); f32x4 g0, g1; unpack8(gw, g0, g1);
                f32x4 v0 = acc[ai][0][m][0], v1 = acc[ai][0][m][1]; const f32x4 s0 = acc[ai][1][m][0], s1 = acc[ai][1][m][1];
#pragma unroll
                for (int j = 0; j < 4; ++j) { v0[j] = g0[j] * v0[j] * fast_sigmoid(s0[j]); v1[j] = g1[j] * v1[j] * fast_sigmoid(s1[j]); }
                *(u32x4*)(gb + (size_t)t * 1024 + f) = pack8(v0, v1); }
    }
};
struct EpiRnn {
    const bf16* gates; const bf16* gb; bf16* merged;
    __device__ __forceinline__ void operator()(const f32x4 (&acc)[2][2][4][2], const g8::Unit& u, int wr, int wc, int fr, int fq) const {
#pragma unroll
        for (int ai = 0; ai < 2; ++ai)
#pragma unroll
            for (int m = 0; m < 4; ++m) { const int t = u.pm * 256 + ai * 128 + wr * 64 + m * 16 + fr;
#pragma unroll
                for (int bj = 0; bj < 2; ++bj) { const int col = u.pn * 256 + bj * 128 + wc * 32 + 8 * fq;
                    const u32x4 gw = *(const u32x4*)(gates + (size_t)t * 2048 + col), bw = *(const u32x4*)(gb + (size_t)t * 1024 + col);
                    f32x4 g0, g1, b0, b1; unpack8(gw, g0, g1); unpack8(bw, b0, b1);
                    const f32x4 v0 = g0 * acc[ai][bj][m][0] + b0, v1 = g1 * acc[ai][bj][m][1] + b1;
                    u32x2 w8; w8.x = pk4_fp8(v0[0], v0[1], v0[2], v0[3]); w8.y = pk4_fp8(v1[0], v1[1], v1[2], v1[3]); *(u32x2*)((unsigned char*)merged + (size_t)t * 1024 + col) = w8; } }
    }
};
struct EpiOut {
    const float* x; const float* mod; bf16* v1;
    __device__ __forceinline__ void operator()(const f32x4 (&acc)[2][2][4][2], const g8::Unit& u, int wr, int wc, int fr, int fq) const {
        const int b = (u.pm * 256) >> 12;
#pragma unroll
        for (int bj = 0; bj < 2; ++bj) { const int col = u.pn * 256 + bj * 128 + wc * 32 + 8 * fq;
            const f32x4 ga = *(const f32x4*)(mod + b * 6144 + 2048 + col) + 1.0f, gb_ = *(const f32x4*)(mod + b * 6144 + 2048 + col + 4) + 1.0f;
#pragma unroll
            for (int ai = 0; ai < 2; ++ai)
#pragma unroll
                for (int m = 0; m < 4; ++m) { const int t = u.pm * 256 + ai * 128 + wr * 64 + m * 16 + fr;
                    const f32x4 x0 = *(const f32x4*)(x + (size_t)t * 1024 + col), x1 = *(const f32x4*)(x + (size_t)t * 1024 + col + 4);
                    const f32x4 v0 = x0 * DN_ALPHA + ga * acc[ai][bj][m][0], v1_ = x1 * DN_ALPHA + gb_ * acc[ai][bj][m][1];
                    *(u32x4*)(v1 + (size_t)t * 1024 + col) = pack8(v0, v1_); } }
    }
};
struct EpiMoe1 {
    const float* bgu; bf16* act;
    __device__ __forceinline__ void operator()(const f32x4 (&acc)[2][2][4][2], const g8::Unit& u, int wr, int wc, int fr, int fq) const {
        const int f = u.pn * 128 + wc * 32 + 8 * fq; const float* bp = bgu + (size_t)u.z * 2048 + f;
        const f32x4 bg0 = *(const f32x4*)bp, bg1 = *(const f32x4*)(bp + 4), bu0 = *(const f32x4*)(bp + 1024), bu1 = *(const f32x4*)(bp + 1028);
#pragma unroll
        for (int ai = 0; ai < 2; ++ai)
#pragma unroll
            for (int m = 0; m < 4; ++m) { const int row = u.pm * 256 + ai * 128 + wr * 64 + m * 16 + fr;
                f32x4 g0 = acc[ai][0][m][0] + bg0, g1 = acc[ai][0][m][1] + bg1, u0 = acc[ai][1][m][0] + bu0, u1 = acc[ai][1][m][1] + bu1;
#pragma unroll
                for (int j = 0; j < 4; ++j) { const float ga = fminf(g0[j], 7.0f), gb_ = fminf(g1[j], 7.0f), ua = fminf(fmaxf(u0[j], -7.0f), 7.0f), ub = fminf(fmaxf(u1[j], -7.0f), 7.0f);
                    g0[j] = ga * fast_sigmoid(1.702f * ga) * (ua + 1.0f); g1[j] = gb_ * fast_sigmoid(1.702f * gb_) * (ub + 1.0f); }
                u32x2 w8; w8.x = pk4_fp8(g0[0], g0[1], g0[2], g0[3]); w8.y = pk4_fp8(g1[0], g1[1], g1[2], g1[3]); *(u32x2*)((unsigned char*)act + (size_t)row * 1024 + f) = w8; }
    }
};
struct EpiMoe2 {
    const float* bd; bf16* yb;
    __device__ __forceinline__ void operator()(const f32x4 (&acc)[2][2][4][2], const g8::Unit& u, int wr, int wc, int fr, int fq) const {
#pragma unroll
        for (int bj = 0; bj < 2; ++bj) { const int col = u.pn * 256 + bj * 128 + wc * 32 + 8 * fq; const float* bp = bd + (size_t)u.z * 1024 + col;
            const f32x4 b0 = *(const f32x4*)bp, b1 = *(const f32x4*)(bp + 4);
#pragma unroll
            for (int ai = 0; ai < 2; ++ai)
#pragma unroll
                for (int m = 0; m < 4; ++m) { const int row = u.pm * 256 + ai * 128 + wr * 64 + m * 16 + fr;
                    const f32x4 y0 = acc[ai][bj][m][0] + b0, y1 = acc[ai][bj][m][1] + b1; u32x2 w8; w8.x = pk4_fp8(y0[0], y0[1], y0[2], y0[3]); w8.y = pk4_fp8(y1[0], y1[1], y1[2], y1[3]);
                    *(u32x2*)((unsigned char*)yb + (size_t)row * 1024 + col) = w8; } }
    }
};

struct S5AOrder { int G, c; const char* acat; const char* ws;
    __device__ __forceinline__ bool next(int i, g8::Unit& u) const { const int L = i * G + c; if (L >= S5G * 4) return false; u.z = L >> 2; u.pm = L & 3; u.pn = 0; u.rl = 0;
        u.A = acat + ((size_t)(u.z * S5M + u.pm * 256) * S5ROW + 128) * 2; u.B = ws + (size_t)u.z * 256 * (S5L * 16) * 2; return true; } };
struct S5COrder { int G, c; const char* acat; const char* wy;
    __device__ __forceinline__ bool next(int i, g8::Unit& u) const { const int L = i * G + c; if (L >= S5G * 8) return false; u.z = L >> 3; u.pm = (L >> 1) & 3; u.pn = L & 1; u.rl = 0;
        u.A = acat + ((size_t)(u.z * S5M + u.pm * 256) * S5ROW) * 2; u.B = wy + ((size_t)(u.z * 512 + u.pn * 256) * S5ROW) * 2; return true; } };
struct MoeOrder { int G, c, NT, RT; const LAS int* tstart; const LAS int* cnt; const int* toklist; const char* A; const char* B; size_t bstride_e; int lda; bool gatherA;
    __device__ __forceinline__ bool next(int i, g8::Unit& u) const { const int per = G >> 3, xcd = c & 7, slot = c >> 3, rpx = per / NT;
        const int rt = (i * 8 + xcd) * rpx + slot / NT; if (rt >= RT) return false; u.pn = slot % NT;
        const int lane_ = threadIdx.x & 63; const unsigned long long mk_ = __ballot(lane_ < NE && tstart[lane_ & 31] <= rt);
        const int e = __builtin_popcountll(mk_) - 1;
        u.z = e; u.pm = rt; u.rl = rt - tstart[e]; u.B = B + (size_t)e * bstride_e + (size_t)u.pn * 256 * 1024; u.A = gatherA ? A : A + (size_t)rt * 256 * 1024; return true; }
    __device__ __forceinline__ void gather(const g8::Unit& u, const int (&Rr)[2], const int (&Cc)[2], unsigned (&vo)[2][2]) const {
        const int n = cnt[u.z];
#pragma unroll
        for (int h = 0; h < 2; ++h)
#pragma unroll
            for (int i = 0; i < 2; ++i) { const int r = u.rl * 256 + h * 128 + Rr[i]; const int tok = r < n ? toklist[u.z * T + r] : 0; vo[h][i] = (unsigned)(tok * lda + Cc[i] * 2); } }
};

__device__ __forceinline__ void transpose_item(const float* W, int N, int k0, int n0, bf16* dst, int ldd, int drow0, LAS float* scr, int lane) {
    float wv_[32];
#pragma unroll
    for (int i = 0; i < 32; ++i) wv_[i] = W[(size_t)(k0 + 2 * i + (lane >> 5)) * N + n0 + (lane & 31)];
#pragma unroll
    for (int i = 0; i < 32; ++i) scr[(2 * i + (lane >> 5)) * 33 + (lane & 31)] = wv_[i];
    asm volatile("s_waitcnt lgkmcnt(0)" ::: "memory");
    const int c = lane & 7;
#pragma unroll
    for (int j = 0; j < 4; ++j) { const int n = (lane >> 3) + 8 * j; const LAS float* s = scr + (8 * c) * 33 + n;
        u32x4 o; o.x = pk2(s[0 * 33], s[1 * 33]); o.y = pk2(s[2 * 33], s[3 * 33]); o.z = pk2(s[4 * 33], s[5 * 33]); o.w = pk2(s[6 * 33], s[7 * 33]);
        *(u32x4*)(dst + (size_t)(drow0 + n) * ldd + k0 + 8 * c) = o; }
    asm volatile("s_waitcnt lgkmcnt(0)" ::: "memory");
}
__device__ __forceinline__ void transpose_item8(const float* W, int N, int k0, int n0, unsigned char* dst, int ldd, int drow0, LAS float* scr, int lane) {
    float wv_[32];
#pragma unroll
    for (int i = 0; i < 32; ++i) wv_[i] = W[(size_t)(k0 + 2 * i + (lane >> 5)) * N + n0 + (lane & 31)];
#pragma unroll
    for (int i = 0; i < 32; ++i) scr[(2 * i + (lane >> 5)) * 33 + (lane & 31)] = wv_[i];
    asm volatile("s_waitcnt lgkmcnt(0)" ::: "memory");
    const int c = lane & 7;
#pragma unroll
    for (int j = 0; j < 4; ++j) { const int n = (lane >> 3) + 8 * j; const LAS float* s = scr + (8 * c) * 33 + n;
        u32x2 o; o.x = pk4_fp8(32.f * s[0 * 33], 32.f * s[1 * 33], 32.f * s[2 * 33], 32.f * s[3 * 33]); o.y = pk4_fp8(32.f * s[4 * 33], 32.f * s[5 * 33], 32.f * s[6 * 33], 32.f * s[7 * 33]);
        *(u32x2*)(dst + (size_t)(drow0 + n) * ldd + k0 + 8 * c) = o; }
    asm volatile("s_waitcnt lgkmcnt(0)" ::: "memory");
}
__device__ __forceinline__ void transpose_item8w(const float* W, int N, int k0, int n0, unsigned char* dst, int ldd, int drow0, LAS float* scr, int lane) {
    float wv[64]; const float* wp = W + (size_t)(k0 + (lane >> 5)) * N + n0 + (lane & 31);
#pragma unroll
    for (int i = 0; i < 64; ++i) wv[i] = wp[(size_t)(2 * i) * N];
#pragma unroll
    for (int i = 0; i < 64; ++i) scr[(2 * i + (lane >> 5)) * 33 + (lane & 31)] = wv[i];
    asm volatile("s_waitcnt lgkmcnt(0)" ::: "memory");
    const int c = lane & 7;
#pragma unroll
    for (int j = 0; j < 4; ++j) { const int n = (lane >> 3) + 8 * j; const LAS float* s = scr + (16 * c) * 33 + n;
        u32x4 o; o.x = pk4_fp8(32.f * s[0 * 33], 32.f * s[1 * 33], 32.f * s[2 * 33], 32.f * s[3 * 33]); o.y = pk4_fp8(32.f * s[4 * 33], 32.f * s[5 * 33], 32.f * s[6 * 33], 32.f * s[7 * 33]);
        o.z = pk4_fp8(32.f * s[8 * 33], 32.f * s[9 * 33], 32.f * s[10 * 33], 32.f * s[11 * 33]); o.w = pk4_fp8(32.f * s[12 * 33], 32.f * s[13 * 33], 32.f * s[14 * 33], 32.f * s[15 * 33]);
        *(u32x4*)(dst + (size_t)(drow0 + n) * ldd + k0 + 16 * c) = o; }
    asm volatile("s_waitcnt lgkmcnt(0)" ::: "memory");
}
__device__ __forceinline__ int pair_row(int n) { const int f = n & 1023, hi = n >> 10; return (f >> 7) * 256 + hi * 128 + (f & 127); }

__device__ __forceinline__ void moe_tables(Frame& F) {
    LAS int* tstart = (LAS int*)(F.lds + TAB_OFF); LAS int* cl = tstart + 40;
    if (F.tid < 64) {
        const int e = F.lane & 31; const int c = (int)F.ctl[CW_CNT + 64 * e]; int inc = (c + 255) >> 8;
#pragma unroll
        for (int o = 1; o < 32; o <<= 1) { const int v = __shfl_up(inc, o); if ((F.lane & 31) >= o) inc += v; }
        if (F.lane < 32) { cl[e] = c; tstart[e] = inc - ((c + 255) >> 8); if (e == NE - 1) tstart[NE] = inc; }
    }
    __syncthreads();
}

__device__ __forceinline__ void p0_mod_job(Frame& F, int job) {
    LAS float* sc = (LAS float*)F.lds;
    LAS float* red = sc + 8 * 1024;
    const float* c = F.in[1]; const float* w = F.in[2]; const float* bias = F.in[3];
    for (int i = F.tid; i < 8 * 1024; i += 512) { const float v = c[i]; sc[i] = v * fast_sigmoid(v); }
    __syncthreads();
    const int col = F.tid & 31, kg = F.tid >> 5, j = job * 32 + col;
    float a[8];
#pragma unroll
    for (int b = 0; b < 8; ++b) a[b] = 0.f;
#pragma unroll 32
    for (int k = kg * 64; k < kg * 64 + 64; ++k) { const float wv = w[(size_t)k * 6144 + j];
#pragma unroll
        for (int b = 0; b < 8; ++b) a[b] += sc[b * 1024 + k] * wv; }
#pragma unroll
    for (int b = 0; b < 8; ++b) red[(kg * 8 + b) * 32 + col] = a[b];
    __syncthreads();
    if (F.tid < 256) { const int b = F.tid >> 5, cc = F.tid & 31; float s = 0.f;
#pragma unroll
        for (int g = 0; g < 16; ++g) s += red[(g * 8 + b) * 32 + cc];
        WSP(float, WS_MOD)[b * 6144 + job * 32 + cc] = s + bias[job * 32 + cc]; }
    __syncthreads();
}
__device__ __forceinline__ void s5_setup(Frame& F, int g, int kmin, int kmax, LAS f32x2* Bb, LAS f32x2* Cc, LAS f32x2* Ap) {
    const float* lre = F.in[14] + g * 64; const float* lim = F.in[15] + g * 64; const float dt = expf(F.in[16][g]);
    const float* bre = F.in[17] + g * 1024; const float* bim = F.in[18] + g * 1024; const float* cre = F.in[19] + g * 1024; const float* cim = F.in[20] + g * 1024;
    for (int i = F.tid; i < 1024; i += 512) { const int p = i >> 4; const float lr = lre[p], li = lim[p]; const float mag = expf(lr * dt); float sn, cs; sincosf(li * dt, &sn, &cs);
        const float ar = mag * cs, ai = mag * sn, den = lr * lr + li * li, qr = ((ar - 1.f) * lr + ai * li) / den, qi = (ai * lr - (ar - 1.f) * li) / den;
        const float br = bre[i], bi = bim[i]; Bb[i] = (f32x2){qr * br - qi * bi, qr * bi + qi * br};
        Cc[i] = (f32x2){cre[i], cim[i]}; }
    if (F.tid < 64) { const int p = F.tid; const float lr = lre[p], li = lim[p]; const float mag = expf(lr * dt); float sn, cs; sincosf(li * dt, &sn, &cs);
        const float ar = mag * cs, ai = mag * sn; float xr_ = 1.f, xi_ = 0.f;
        for (int k = 0; k <= kmax; ++k) { if (k >= kmin) Ap[k * 64 + p] = (f32x2){xr_, xi_}; const float nr = xr_ * ar - xi_ * ai, ni = xr_ * ai + xi_ * ar; xr_ = nr; xi_ = ni; } }
    __syncthreads();
}
constexpr size_t WS_KTAB = WS_S;
constexpr size_t WS_WRIMG = WS_AL + 512 * 1024;
__device__ __forceinline__ void p0_s5k_job(Frame& F, int job) {
    const int g = job >> 3, part = job & 7;
    LAS f32x2* Bb = (LAS f32x2*)F.lds; LAS f32x2* Cc = Bb + 1024; LAS f32x2* Ap = Cc + 1024;
    s5_setup(F, g, 4 * part, 4 * part + 3, Bb, Cc, Ap);
    float* kt = WSP(float, WS_KTAB) + (size_t)g * 32 * 256;
    for (int e = 4 * part * 256 + F.tid; e < (4 * part + 4) * 256; e += 512) { const int k = e >> 8, c = (e >> 4) & 15, c2 = e & 15; float s = 0.f;
        for (int p = 0; p < 64; ++p) { const f32x2 cv = Cc[c * 64 + p], av = Ap[k * 64 + p], bv = Bb[p * 16 + c2];
            const float car = cv.x * av.x - cv.y * av.y, cai = cv.x * av.y + cv.y * av.x; s += car * bv.x - cai * bv.y; }
        kt[e] = s; }
    __syncthreads();
}
__device__ __forceinline__ void p1_s5w_job(Frame& F, int job) {
    const int g = job >> 3, part = job & 7;
    LAS f32x2* Bb = (LAS f32x2*)F.lds; LAS f32x2* Cc = Bb + 1024; LAS f32x2* Ap = Cc + 1024; LAS float* Kt = (LAS float*)(Ap + 33 * 64);
    const float* ktg = WSP(float, WS_KTAB) + (size_t)g * 32 * 256; const float* dsk = F.in[21] + g * 16;
    for (int i = F.tid; i < 32 * 256; i += 512) Kt[i] = ktg[i];
    s5_setup(F, g, 0, S5L, Bb, Cc, Ap);
    if (part == 0 && F.tid < 64) WSP(f32x2, WS_AL)[g * 64 + F.tid] = Ap[S5L * 64 + F.tid];
    bf16* wy = WSP(bf16, WS_WY) + (size_t)g * 512 * S5ROW;
    for (int ch = F.tid; ch < 64 * (S5ROW / 8); ch += 512) { const int n = part * 64 + ch / (S5ROW / 8), k8 = (ch % (S5ROW / 8)) * 8, i = n >> 4, c = n & 15; float v[8];
        if (k8 < 128) {
#pragma unroll
            for (int j = 0; j < 8; j += 2) { const int p = (k8 + j) >> 1; const f32x2 cv = Cc[c * 64 + p], av = Ap[(i + 1) * 64 + p]; v[j] = cv.x * av.x - cv.y * av.y; v[j + 1] = -(cv.x * av.y + cv.y * av.x); } }
        else { const int jj = (k8 - 128) >> 4, c2 = (k8 - 128) & 15;
#pragma unroll
            for (int j = 0; j < 8; ++j) { float x = 0.f; if (jj <= i) { x = Kt[(i - jj) * 256 + c * 16 + c2 + j]; if (jj == i && c == c2 + j) x += dsk[c]; } v[j] = x; } }
        u32x4 o; o.x = pk2(v[0], v[1]); o.y = pk2(v[2], v[3]); o.z = pk2(v[4], v[5]); o.w = pk2(v[6], v[7]);
        *(u32x4*)(wy + (size_t)n * S5ROW + k8) = o; }
    bf16* wsm = WSP(bf16, WS_WS) + (size_t)g * 256 * 512;
    for (int ch = F.tid; ch < 32 * 64; ch += 512) { const int n = part * 32 + (ch >> 6), k8 = (ch & 63) * 8, jj = k8 >> 4, c2 = k8 & 15; float v[8];
#pragma unroll
        for (int j = 0; j < 8; ++j) { float x = 0.f; if (n < 128) { const int p = n >> 1; const f32x2 av = Ap[(S5L - 1 - jj) * 64 + p], bv = Bb[p * 16 + c2 + j]; x = (n & 1) ? (av.x * bv.y + av.y * bv.x) : (av.x * bv.x - av.y * bv.y); } v[j] = x; }
        u32x4 o; o.x = pk2(v[0], v[1]); o.y = pk2(v[2], v[3]); o.z = pk2(v[4], v[5]); o.w = pk2(v[6], v[7]);
        *(u32x4*)(wsm + (size_t)n * 512 + k8) = o; }
    __syncthreads();
}
__device__ __forceinline__ void p0_small_transposes(Frame& F) {
    LAS float* scr = (LAS float*)(F.lds + F.wave * 16384);
    const int gw = F.vcu * 8 + F.wave, NGW = F.G * 8;
    constexpr int I_IN = 16 * 144, I_RNN = 16 * 32, I_OUT = 16 * 32, I_GLU = 8 * 64, I_RG = 16 * 8;
    for (int it = gw; it < I_IN + I_RNN + I_OUT + I_GLU + I_RG; it += NGW) { int r = it;
        if (r < I_IN) { const int kb = r / 144, nb = r % 144; transpose_item8(F.in[4], INC, kb * 64, nb * 32, WSP(unsigned char, WS_WIN), 1024, nb * 32, scr, F.lane); continue; } r -= I_IN;
        if (r < I_RNN) { const int kb = r / 32, nb = r % 32; transpose_item8(F.in[13], 1024, kb * 64, nb * 32, WSP(unsigned char, WS_WRNN), 1024, nb * 32, scr, F.lane); continue; } r -= I_RNN;
        if (r < I_OUT) { const int kb = r / 32, nb = r % 32; transpose_item8(F.in[23], 1024, kb * 64, nb * 32, WSP(unsigned char, WS_WOUT), 1024, nb * 32, scr, F.lane); continue; } r -= I_OUT;
        if (r < I_GLU) { const int kb = r / 64, nb = r % 64; transpose_item8(F.in[22], 2048, kb * 64, nb * 32, WSP(unsigned char, WS_WGLU), 512, pair_row(nb * 32), scr, F.lane); continue; } r -= I_GLU;
        { const int mat = r >> 3, kb = (r >> 2) & 1, nb = r & 3, hd = mat & 7, gx = mat >> 3;
          transpose_item(F.in[gx ? 10 : 8] + (size_t)hd * 128 * 128, 128, kb * 64, nb * 32, WSP(bf16, WS_WG), 128, hd * 256 + gx * 128 + nb * 32, scr, F.lane); }
    }
}
__device__ __forceinline__ void p1_body(Frame& F) {
    const int gw = F.vcu * 8 + F.wave, NGW = F.G * 8; const float* mod = WSP(float, WS_MOD); bf16* hbf = WSP(bf16, WS_HBF);
    for (int tb = gw; tb < T; tb += 4 * NGW) {
        f32x4 xv[4][4];
#pragma unroll
        for (int r = 0; r < 4; ++r) { const int t = tb + r * NGW; const f32x4* xr = (const f32x4*)(F.in[0] + (size_t)(t < T ? t : 0) * 1024) + F.lane;
#pragma unroll
            for (int j = 0; j < 4; ++j) xv[r][j] = xr[64 * j]; }
#pragma unroll
        for (int r = 0; r < 4; ++r) { const int t = tb + r * NGW; if (t < T) { const int b = t >> 12; const f32x4* sh = (const f32x4*)(mod + b * 6144) + F.lane; const f32x4* sc = (const f32x4*)(mod + b * 6144 + 1024) + F.lane;
            unsigned* o = (unsigned*)((unsigned char*)hbf + (size_t)t * 1024) + F.lane;
#pragma unroll
            for (int j = 0; j < 4; ++j) { const f32x4 v = xv[r][j] * (sc[64 * j] + 1.0f) + sh[64 * j]; o[64 * j] = pk4_fp8(v[0], v[1], v[2], v[3]); } } } }
    constexpr int TP = 132;
    LAS float* tile = (LAS float*)F.lds;
    constexpr int TILES_GU = 8 * 16, TILES_D = 8 * 8, TILES_E = TILES_GU + TILES_D;
    const int lr = F.tid >> 5, lc4 = (F.tid & 31) * 4, tn = F.tid >> 2, kc = F.tid & 3;
    f32x4 pre[8];
    int ti = F.vcu;
#define P1_SRC(idx, src, N_, dstp, drow0_, k0_) do { const int e_ = (idx) / TILES_E, r_ = (idx) % TILES_E; \
        if (r_ < TILES_GU) { const int kb_ = r_ >> 4, nb_ = r_ & 15; N_ = 2048; src = F.in[28] + (size_t)e_ * 1024 * 2048 + (size_t)(kb_ * 128) * 2048 + nb_ * 128; dstp = WSP(unsigned char, WS_WGU) + (size_t)e_ * 2048 * 1024; drow0_ = pair_row(nb_ * 128); k0_ = kb_ * 128; } \
        else { const int q_ = r_ - TILES_GU, kb_ = q_ >> 3, nb_ = q_ & 7; N_ = 1024; src = F.in[30] + (size_t)e_ * 1024 * 1024 + (size_t)(kb_ * 128) * 1024 + nb_ * 128; dstp = WSP(unsigned char, WS_WD) + (size_t)e_ * 1024 * 1024; drow0_ = nb_ * 128; k0_ = kb_ * 128; } } while (0)
    if (ti < NE * TILES_E) { const float* src; unsigned char* dstp; int N_, d0, k0; P1_SRC(ti, src, N_, dstp, d0, k0);
#pragma unroll
        for (int i = 0; i < 8; ++i) pre[i] = *(const f32x4*)(src + (size_t)(lr + 16 * i) * N_ + lc4); }
    for (; ti < NE * TILES_E; ti += F.G) {
#pragma unroll
        for (int i = 0; i < 8; ++i) *(LAS f32x4*)(tile + (lr + 16 * i) * TP + lc4) = pre[i];
        __syncthreads();
        const int tnx = ti + F.G;
        if (tnx < NE * TILES_E) { const float* src; unsigned char* dstp; int N_, d0, k0; P1_SRC(tnx, src, N_, dstp, d0, k0);
#pragma unroll
            for (int i = 0; i < 8; ++i) pre[i] = *(const f32x4*)(src + (size_t)(lr + 16 * i) * N_ + lc4); }
        { const float* src; unsigned char* dstp; int N_, d0, k0; P1_SRC(ti, src, N_, dstp, d0, k0); (void)src; (void)N_;
          const LAS float* cp = tile + (32 * kc) * TP + tn; u32x4 o0, o1;
          o0.x = pk4_fp8(32.f * cp[0 * TP], 32.f * cp[1 * TP], 32.f * cp[2 * TP], 32.f * cp[3 * TP]); o0.y = pk4_fp8(32.f * cp[4 * TP], 32.f * cp[5 * TP], 32.f * cp[6 * TP], 32.f * cp[7 * TP]);
          o0.z = pk4_fp8(32.f * cp[8 * TP], 32.f * cp[9 * TP], 32.f * cp[10 * TP], 32.f * cp[11 * TP]); o0.w = pk4_fp8(32.f * cp[12 * TP], 32.f * cp[13 * TP], 32.f * cp[14 * TP], 32.f * cp[15 * TP]);
          o1.x = pk4_fp8(32.f * cp[16 * TP], 32.f * cp[17 * TP], 32.f * cp[18 * TP], 32.f * cp[19 * TP]); o1.y = pk4_fp8(32.f * cp[20 * TP], 32.f * cp[21 * TP], 32.f * cp[22 * TP], 32.f * cp[23 * TP]);
          o1.z = pk4_fp8(32.f * cp[24 * TP], 32.f * cp[25 * TP], 32.f * cp[26 * TP], 32.f * cp[27 * TP]); o1.w = pk4_fp8(32.f * cp[28 * TP], 32.f * cp[29 * TP], 32.f * cp[30 * TP], 32.f * cp[31 * TP]);
          unsigned char* op = dstp + (size_t)(d0 + tn) * 1024 + k0 + 32 * kc; *(u32x4*)op = o0; *(u32x4*)(op + 16) = o1; }
        __syncthreads();
    }
#undef P1_SRC
}
constexpr int XR_LD = 136, XR_TILE = 128 * XR_LD;
__device__ __forceinline__ void rg_issue(const bf16* xrnn, const bf16* gy, int item, int tid, u32x4 (&xraw)[4][4], u32x4 (&graw)[4], bool pass1) {
    const int hd = item & 7, c = (item >> 3) & 31, b = item >> 8, r0 = tid >> 4, ch = hd * 128 + (tid & 15) * 8;
#pragma unroll
    for (int q = 0; q < 4; ++q) { const int r = r0 + 32 * q;
#pragma unroll
        for (int k = 0; k < 4; ++k) { const int tp = c * RGL + r - 3 + k, tpc = tp < 0 ? 0 : tp; xraw[q][k] = *(const u32x4*)(xrnn + (size_t)(b * SEQ + tpc) * 1024 + ch); }
        if (pass1) graw[q] = *(const u32x4*)(gy + (size_t)(b * SEQ + c * RGL + r) * 1024 + ch); }
}
__device__ __forceinline__ void rg_convwrite(const float* cw, const float* cb, int item, int tid, const u32x4 (&xraw)[4][4], const u32x4 (&graw)[4], LAS bf16* xr, LAS bf16* gyt, bool pass1) {
    const int hd = item & 7, c = (item >> 3) & 31, r0 = tid >> 4, c8 = (tid & 15) * 8, ch = hd * 128 + c8;
    const f32x4 b0 = *(const f32x4*)(cb + ch), b1 = *(const f32x4*)(cb + ch + 4);
    f32x4 w0[4], w1[4];
#pragma unroll
    for (int k = 0; k < 4; ++k) { w0[k] = *(const f32x4*)(cw + k * 1024 + ch); w1[k] = *(const f32x4*)(cw + k * 1024 + ch + 4); }
#pragma unroll
    for (int q = 0; q < 4; ++q) { const int r = r0 + 32 * q; f32x4 a0 = b0, a1 = b1;
#pragma unroll
        for (int k = 0; k < 4; ++k) { const int tp = c * RGL + r - 3 + k; f32x4 x0, x1; unpack8(xraw[q][k], x0, x1); if (tp < 0) { x0 = (f32x4){0.f, 0.f, 0.f, 0.f}; x1 = x0; } a0 += w0[k] * x0; a1 += w1[k] * x1; }
        *(LAS u32x4*)(xr + r * XR_LD + c8) = pack8(a0, a1);
        if (pass1) *(LAS u32x4*)(gyt + r * XR_LD + c8) = graw[q]; }
}
template <int PASS>
__device__ __forceinline__ void rglru_phase(Frame& F) {
    const int NIT = NB * RGC * 8;
    const bool skew = (PASS == 0) && (F.G == 256);
    const int nmine = skew ? (F.vcu < 128 ? 7 : 9) : (NIT - F.vcu + F.G - 1) / F.G;
#define RG_ITEM(k) ((skew && (k) >= 7) ? (1792 + (F.vcu - 128) + 128 * ((k) - 7)) : (F.vcu + (k) * F.G))
    if (nmine <= 0) return;
    int it = RG_ITEM(0);
    LAS bf16* xr = (LAS bf16*)F.lds; LAS bf16* gyt0 = xr + XR_TILE;
    const bf16* xrnn = WSP(bf16, WS_XRNN); const bf16* gy = WSP(bf16, WS_GY); bf16* ha = WSP(bf16, WS_HA); const float* cw = F.in[6]; const float* cb = F.in[7];
    const int tid = F.tid, w = F.wave, q = F.lane >> 4, col = F.lane & 15, chl = 16 * w + col;
    u32x4 xraw[4][4], graw[4];
    rg_issue(xrnn, gy, it, tid, xraw, graw, PASS);
    rg_convwrite(cw, cb, it, tid, xraw, graw, xr, gyt0, PASS);
    int hd_loaded = -1; bf16x8 Bf[2][4]; float ba = 0.f, bx = 0.f, sp = 0.f;
    __syncthreads();
    for (int i = 0; i < nmine; ++i) {
        const bool has_next = (i + 1) < nmine; const int nit = has_next ? RG_ITEM(i + 1) : it;
        const int hd = it & 7, c = (it >> 3) & 31, b = it >> 8, t0 = b * SEQ + c * RGL, ch = hd * 128 + chl;
        LAS bf16* gyt = gyt0 + (i & 1) * XR_TILE; LAS bf16* gytn = gyt0 + ((i & 1) ^ 1) * XR_TILE;
        if (has_next) rg_issue(xrnn, gy, nit, tid, xraw, graw, PASS);
        if (hd != hd_loaded) { hd_loaded = hd; const bf16* wg = WSP(bf16, WS_WG) + (size_t)hd * 256 * 128;
#pragma unroll
            for (int gt = 0; gt < 2; ++gt)
#pragma unroll
                for (int kk = 0; kk < 4; ++kk) Bf[gt][kk] = *(const bf16x8*)(wg + (size_t)(gt * 128 + chl) * 128 + kk * 32 + q * 8);
            ba = F.in[9][ch]; bx = F.in[11][ch]; const float lam = F.in[12][ch]; sp = (lam > 15.f) ? __expf(-lam) : log1pf(__expf(-lam)); }
        float carryH = 0.f, carryP = 1.f;
        if (PASS) carryH = WSP(float, WS_HIN)[(size_t)(b * RGC + c) * 1024 + ch];
        __builtin_amdgcn_sched_barrier(0);
        f32x4 acc[8][2];
#pragma unroll
        for (int m = 0; m < 8; ++m) { acc[m][0] = (f32x4){0.f, 0.f, 0.f, 0.f}; acc[m][1] = (f32x4){0.f, 0.f, 0.f, 0.f}; }
#pragma unroll
        for (int kk = 0; kk < 4; ++kk)
#pragma unroll
            for (int m = 0; m < 8; ++m) { const bf16x8 Af = *(const LAS bf16x8*)(xr + (16 * m + col) * XR_LD + kk * 32 + q * 8);
                acc[m][0] = __builtin_amdgcn_mfma_f32_16x16x32_bf16(Af, Bf[0][kk], acc[m][0], 0, 0, 0);
                acc[m][1] = __builtin_amdgcn_mfma_f32_16x16x32_bf16(Af, Bf[1][kk], acc[m][1], 0, 0, 0); }
#pragma unroll
        for (int m = 0; m < 8; ++m) {
            float a[4], uu[4];
#pragma unroll
            for (int j = 0; j < 4; ++j) { const int tl = 16 * m + 4 * q + j;
                const float r = fast_sigmoid(acc[m][0][j] + ba), ii = fast_sigmoid(acc[m][1][j] + bx);
                const float la = -11.541560327f * r * sp; a[j] = __builtin_amdgcn_exp2f(la); const float mult = __builtin_amdgcn_sqrtf(fmaxf(1.0f - a[j] * a[j], 0.f));
                uu[j] = mult * ii * bf1(xr[tl * XR_LD + chl]); }
            float sP = a[0], sH = uu[0];
#pragma unroll
            for (int j = 1; j < 4; ++j) { sH = a[j] * sH + uu[j]; sP *= a[j]; }
            float iP = sP, iH = sH;
            { const float pP = __shfl_up(iP, 16), pH = __shfl_up(iH, 16); if (q >= 1) { iH = iP * pH + iH; iP = iP * pP; } }
            { const float pP = __shfl_up(iP, 32), pH = __shfl_up(iH, 32); if (q >= 2) { iH = iP * pH + iH; iP = iP * pP; } }
            float eP = __shfl_up(iP, 16), eH = __shfl_up(iH, 16); if (q == 0) { eP = 1.f; eH = 0.f; }
            const float tP = __shfl(iP, col + 48), tH = __shfl(iH, col + 48);
            if (PASS) { float h = eP * carryH + eH;
#pragma unroll
                for (int j = 0; j < 4; ++j) { const int tl = 16 * m + 4 * q + j; h = a[j] * h + uu[j]; LAS bf16* gp = gyt + tl * XR_LD + chl; *gp = (bf16)f2bf(h * bf1(*gp)); } }
            carryH = tP * carryH + tH; carryP *= tP;
        }
        if (!PASS && q == 0) { f32x2* ag = WSP(f32x2, WS_RGAGG); ag[(size_t)(b * RGC + c) * 1024 + ch] = (f32x2){carryP, carryH}; }
        __syncthreads();
        if (PASS) { const int r0 = tid >> 4, c8 = (tid & 15) * 8;
#pragma unroll
            for (int qq = 0; qq < 4; ++qq) { const int r = r0 + 32 * qq; f32x4 h0, h1; unpack8(*(const LAS u32x4*)(gyt + r * XR_LD + c8), h0, h1); u32x2 w8; w8.x = pk4_fp8(h0[0], h0[1], h0[2], h0[3]); w8.y = pk4_fp8(h1[0], h1[1], h1[2], h1[3]);
                *(u32x2*)((unsigned char*)ha + (size_t)(t0 + r) * 1024 + hd * 128 + c8) = w8; } }
        if (has_next) rg_convwrite(cw, cb, nit, tid, xraw, graw, xr, gytn, PASS);
        __syncthreads();
        it = nit;
    }
#undef RG_ITEM
}
__device__ __forceinline__ void p4_carries(Frame& F) {
    LAS f32x2* seg = (LAS f32x2*)F.lds;
    for (int job = F.vcu; job < NB * S5G; job += F.G) {
        const int b = job >> 5, g = job & 31, p = F.lane, w = F.wave;
        const f32x2 al = WSP(f32x2, WS_AL)[g * 64 + p];
        const f32x2* Sb = WSP(f32x2, WS_S) + ((size_t)(g * S5M + b * S5CPB + 16 * w)) * 64 + p; unsigned* ac = (unsigned*)(WSP(bf16, WS_ACAT) + ((size_t)(g * S5M + b * S5CPB + 16 * w)) * S5ROW) + p;
        f32x2 sv[16];
#pragma unroll
        for (int i = 0; i < 16; ++i) sv[i] = Sb[(size_t)i * 64];
        float xr_ = 0.f, xi = 0.f;
#pragma unroll
        for (int i = 0; i < 16; ++i) { const float nr = al.x * xr_ - al.y * xi + sv[i].x, ni = al.x * xi + al.y * xr_ + sv[i].y; xr_ = nr; xi = ni; }
        seg[w * 64 + p] = (f32x2){xr_, xi};
        float ar = al.x, ai = al.y;
#pragma unroll
        for (int q = 0; q < 4; ++q) { const float nr = ar * ar - ai * ai, ni = 2.f * ar * ai; ar = nr; ai = ni; }
        __syncthreads();
        xr_ = 0.f; xi = 0.f;
        for (int ww = 0; ww < w; ++ww) { const f32x2 sg = seg[ww * 64 + p]; const float nr = ar * xr_ - ai * xi + sg.x, ni = ar * xi + ai * xr_ + sg.y; xr_ = nr; xi = ni; }
#pragma unroll
        for (int i = 0; i < 16; ++i) { ac[(size_t)i * (S5ROW / 2)] = pk2(xr_, xi); const float nr = al.x * xr_ - al.y * xi + sv[i].x, ni = al.x * xi + al.y * xr_ + sv[i].y; xr_ = nr; xi = ni; }
        __syncthreads();
    }
    if (F.vcu < 16) {
        const int id = F.vcu * 512 + F.tid, ch = id & 1023, b = id >> 10; const f32x2* ag = WSP(f32x2, WS_RGAGG) + (size_t)b * RGC * 1024 + ch; float* hin = WSP(float, WS_HIN) + (size_t)b * RGC * 1024 + ch;
        f32x2 a[RGC];
#pragma unroll
        for (int c = 0; c < RGC; ++c) a[c] = ag[(size_t)c * 1024];
        float h = 0.f;
#pragma unroll
        for (int c = 0; c < RGC; ++c) { hin[(size_t)c * 1024] = h; h = a[c].x * h + a[c].y; }
    }
}
constexpr int WR_LD = 1032;
__device__ __forceinline__ void p9_router(Frame& F) {
    LAS bf16* wH = (LAS bf16*)F.lds; LAS bf16* wL = wH + 32 * WR_LD;
    LAS f32x2* sel = (LAS f32x2*)(wL + 32 * WR_LD);
    LAS unsigned* rec = (LAS unsigned*)(sel + 512);
    LAS float* recp = (LAS float*)(rec + 512);
    LAS int* lcnt = (LAS int*)(recp + 512);
    LAS int* gbase = lcnt + 32;
    { const u32x4* img = WSP(u32x4, WS_WRIMG); LAS u32x4* dst = (LAS u32x4*)wH;
      for (int i = F.tid; i < 2 * 32 * WR_LD * 2 / 16; i += 512) dst[i] = img[i]; }
    if (F.tid < 32) lcnt[F.tid] = 0;
    __syncthreads();
    const float* mod = WSP(float, WS_MOD); const bf16* v1 = WSP(bf16, WS_V1); bf16* x1 = WSP(bf16, WS_X1); unsigned char* h2 = WSP(unsigned char, WS_H2);
    const int lane = F.lane, m = lane & 15, kq = lane >> 4, w = F.wave;
    for (int blk = F.vcu; blk < T / 128; blk += F.G) {
        const int t = blk * 128 + w * 16 + m, b = (blk * 128) >> 12;
        const bf16* vrow = v1 + (size_t)t * 1024 + 8 * kq;
        float sum = 0.f, sq = 0.f;
#pragma unroll 32
        for (int s_ = 0; s_ < 32; ++s_) { f32x4 a, c; unpack8(*(const u32x4*)(vrow + 32 * s_), a, c); sum += ((a[0] + a[1]) + (a[2] + a[3])) + ((c[0] + c[1]) + (c[2] + c[3]));
            sq += ((a[0] * a[0] + a[1] * a[1]) + (a[2] * a[2] + a[3] * a[3])) + ((c[0] * c[0] + c[1] * c[1]) + (c[2] * c[2] + c[3] * c[3])); }
        sum += __shfl_xor(sum, 16); sum += __shfl_xor(sum, 32); sq += __shfl_xor(sq, 16); sq += __shfl_xor(sq, 32);
        const float mean = sum * (1.f / 1024.f); const float rstd = 1.f / sqrtf(fmaxf(sq * (1.f / 1024.f) - mean * mean, 0.f) + LN_EPS);
        f32x4 acc[2] = {(f32x4){0.f, 0.f, 0.f, 0.f}, (f32x4){0.f, 0.f, 0.f, 0.f}};
        const float* lng = F.in[24] + 8 * kq; const float* lnb = F.in[25] + 8 * kq; const float* shp = mod + b * 6144 + 3072 + 8 * kq; const float* scp = mod + b * 6144 + 4096 + 8 * kq;
        bf16* x1row = x1 + (size_t)t * 1024 + 8 * kq; unsigned char* h2row = h2 + (size_t)t * 1024 + 8 * kq;
        const LAS bf16* wHr = wH + m * WR_LD + 8 * kq; const LAS bf16* wLr = wL + m * WR_LD + 8 * kq;
#pragma unroll 4
        for (int s_ = 0; s_ < 32; ++s_) { const int ko = 32 * s_;
            f32x4 a, c; unpack8(*(const u32x4*)(vrow + ko), a, c);
            const f32x4 g0 = *(const f32x4*)(lng + ko), g1 = *(const f32x4*)(lng + ko + 4), b0 = *(const f32x4*)(lnb + ko), b1 = *(const f32x4*)(lnb + ko + 4);
            const f32x4 x0 = (a - mean) * rstd * g0 + b0, x1v = (c - mean) * rstd * g1 + b1;
            *(u32x4*)(x1row + ko) = pack8(x0, x1v);
            const f32x4 sh0 = *(const f32x4*)(shp + ko), sh1 = *(const f32x4*)(shp + ko + 4), sc0 = *(const f32x4*)(scp + ko), sc1 = *(const f32x4*)(scp + ko + 4);
            const f32x4 h0 = x0 * (sc0 + 1.0f) + sh0, h1 = x1v * (sc1 + 1.0f) + sh1;
            u32x2 w8; w8.x = pk4_fp8(h0[0], h0[1], h0[2], h0[3]); w8.y = pk4_fp8(h1[0], h1[1], h1[2], h1[3]); *(u32x2*)(h2row + ko) = w8;
            const u32x4 hi = pack8(h0, h1); f32x4 r0, r1; unpack8(hi, r0, r1); const u32x4 lo = pack8(h0 - r0, h1 - r1);
            const bf16x8 ah = __builtin_bit_cast(bf16x8, hi), al = __builtin_bit_cast(bf16x8, lo);
#pragma unroll
            for (int nf = 0; nf < 2; ++nf) { const bf16x8 bh = *(const LAS bf16x8*)(wHr + nf * 16 * WR_LD + ko), bl = *(const LAS bf16x8*)(wLr + nf * 16 * WR_LD + ko);
                acc[nf] = __builtin_amdgcn_mfma_f32_16x16x32_bf16(bh, ah, acc[nf], 0, 0, 0);
                acc[nf] = __builtin_amdgcn_mfma_f32_16x16x32_bf16(bl, ah, acc[nf], 0, 0, 0);
                acc[nf] = __builtin_amdgcn_mfma_f32_16x16x32_bf16(bh, al, acc[nf], 0, 0, 0); } }
        float lv[8];
#pragma unroll
        for (int nf = 0; nf < 2; ++nf)
#pragma unroll
            for (int j = 0; j < 4; ++j) lv[nf * 4 + j] = acc[nf][j] + F.in[27][nf * 16 + 4 * kq + j];
        int rank[8];
#pragma unroll
        for (int i = 0; i < 8; ++i) { rank[i] = 0;
#pragma unroll
            for (int i2 = 0; i2 < 8; ++i2) if (i2 != i) { const int e1 = (i >> 2) * 16 + 4 * kq + (i & 3), e2 = (i2 >> 2) * 16 + 4 * kq + (i2 & 3); rank[i] += (lv[i2] > lv[i] || (lv[i2] == lv[i] && e2 < e1)) ? 1 : 0; } }
#pragma unroll
        for (int dq = 1; dq < 4; ++dq) { const int q2 = kq ^ dq;
#pragma unroll
            for (int i2 = 0; i2 < 8; ++i2) { const float o = __shfl_xor(lv[i2], 16 * dq); const int e2 = (i2 >> 2) * 16 + 4 * q2 + (i2 & 3);
#pragma unroll
                for (int i = 0; i < 8; ++i) { const int e1 = (i >> 2) * 16 + 4 * kq + (i & 3); rank[i] += (o > lv[i] || (o == lv[i] && e2 < e1)) ? 1 : 0; } } }
#pragma unroll
        for (int i = 0; i < 8; ++i) if (rank[i] < 4) { const int e1 = (i >> 2) * 16 + 4 * kq + (i & 3); sel[(w * 16 + m) * 4 + rank[i]] = (f32x2){__builtin_bit_cast(float, e1), lv[i]}; }
        asm volatile("s_waitcnt lgkmcnt(0)" ::: "memory");
        { const int tm = lane >> 2, k = lane & 3; const f32x2 s0 = sel[(w * 16 + tm) * 4 + 0], s1 = sel[(w * 16 + tm) * 4 + 1], s2 = sel[(w * 16 + tm) * 4 + 2], s3 = sel[(w * 16 + tm) * 4 + 3];
          const float p0 = 1.f, p1 = __expf(s1.y - s0.y), p2 = __expf(s2.y - s0.y), p3 = __expf(s3.y - s0.y), ps = (p0 + p1) + (p2 + p3);
          const f32x2 mine = k == 0 ? s0 : (k == 1 ? s1 : (k == 2 ? s2 : s3)); const float pm = (k == 0 ? p0 : (k == 1 ? p1 : (k == 2 ? p2 : p3))) / ps;
          const int e = __builtin_bit_cast(int, mine.x);
          const int lr = __hip_atomic_fetch_add(lcnt + e, 1, __ATOMIC_RELAXED, __HIP_MEMORY_SCOPE_WORKGROUP);
          rec[(w * 16 + tm) * 4 + k] = ((unsigned)e << 16) | (unsigned)lr; recp[(w * 16 + tm) * 4 + k] = pm; }
        __syncthreads();
        if (F.tid < 32) { const int n = lcnt[F.tid]; gbase[F.tid] = n ? (int)atomicAdd(F.ctl + CW_CNT + 64 * F.tid, (unsigned)n) : 0; lcnt[F.tid] = 0; }
        __syncthreads();
        { const unsigned r = rec[F.tid]; const int e = r >> 16, rk = gbase[e] + (int)(r & 0xffffu), tt = blk * 128 + (F.tid >> 2);
          WSP(int, WS_TOK)[(size_t)e * T + rk] = tt; WSP(unsigned, WS_POS)[(size_t)tt * 4 + (F.tid & 3)] = ((unsigned)e << 20) | (unsigned)rk; WSP(float, WS_PROB)[(size_t)tt * 4 + (F.tid & 3)] = recp[F.tid]; }
        __syncthreads();
    }
}
__device__ __forceinline__ void p12_final(Frame& F) {
    moe_tables(F);
    const LAS int* tstart = (const LAS int*)(F.lds + TAB_OFF);
    const float* mod = WSP(float, WS_MOD); const bf16* x1 = WSP(bf16, WS_X1); const bf16* yb = WSP(bf16, WS_YB); const unsigned* pos = WSP(unsigned, WS_POS); const float* prob = WSP(float, WS_PROB);
    const int lane = F.lane, gw = F.vcu * 8 + F.wave, NGW = F.G * 8;
    f32x4 lg[4], lb[4];
#pragma unroll
    for (int j = 0; j < 4; ++j) { lg[j] = *(const f32x4*)(F.in[32] + 512 * (j >> 1) + 8 * lane + 4 * (j & 1)); lb[j] = *(const f32x4*)(F.in[33] + 512 * (j >> 1) + 8 * lane + 4 * (j & 1)); }
#define P12_ROUTE(PP, PW, tt) do { const u32x4 p4_ = *(const u32x4*)(pos + (size_t)(tt) * 4); const f32x4 w4_ = *(const f32x4*)(prob + (size_t)(tt) * 4); \
        PP[0] = p4_.x; PP[1] = p4_.y; PP[2] = p4_.z; PP[3] = p4_.w; PW[0] = w4_[0]; PW[1] = w4_[1]; PW[2] = w4_[2]; PW[3] = w4_[3]; } while (0)
#define P12_ROWS(YW, XW, PP, tt) do { _Pragma("unroll") for (int k = 0; k < 4; ++k) { const int e_ = PP[k] >> 20, rk_ = PP[k] & 0xfffffu; const size_t slot_ = (size_t)tstart[e_] * 256 + rk_; \
            _Pragma("unroll") for (int j = 0; j < 2; ++j) YW[k][j] = *((const u32x2*)((const unsigned char*)yb + slot_ * 1024) + 64 * j + lane); } \
        _Pragma("unroll") for (int j = 0; j < 2; ++j) XW[j] = *((const u32x4*)(x1 + (size_t)(tt) * 1024) + 64 * j + lane); } while (0)
#define P12_COMPUTE(YW, XW, PW, tt) do { const int b_ = (tt) >> 12; f32x4 v[4]; float s_ = 0.f; \
        _Pragma("unroll") for (int j = 0; j < 2; ++j) { f32x4 f0 = (f32x4){0.f, 0.f, 0.f, 0.f}, f1 = f0; \
            _Pragma("unroll") for (int k = 0; k < 4; ++k) { const u32x2 yv_ = YW[k][j]; const f32x2 q0_ = __builtin_amdgcn_cvt_pk_f32_fp8((int)yv_.x, false), q1_ = __builtin_amdgcn_cvt_pk_f32_fp8((int)yv_.x, true), q2_ = __builtin_amdgcn_cvt_pk_f32_fp8((int)yv_.y, false), q3_ = __builtin_amdgcn_cvt_pk_f32_fp8((int)yv_.y, true); \
                f0 += (f32x4){q0_.x, q0_.y, q1_.x, q1_.y} * PW[k]; f1 += (f32x4){q2_.x, q2_.y, q3_.x, q3_.y} * PW[k]; } \
            f32x4 xa_, xc_; unpack8(XW[j], xa_, xc_); const float* gp_ = mod + b_ * 6144 + 5120 + 512 * j + 8 * lane; \
            v[2 * j] = xa_ * DN_ALPHA + (*(const f32x4*)gp_ + 1.0f) * f0; v[2 * j + 1] = xc_ * DN_ALPHA + (*(const f32x4*)(gp_ + 4) + 1.0f) * f1; \
            s_ += ((v[2 * j][0] + v[2 * j][1]) + (v[2 * j][2] + v[2 * j][3])) + ((v[2 * j + 1][0] + v[2 * j + 1][1]) + (v[2 * j + 1][2] + v[2 * j + 1][3])); } \
        const float mean_ = wave_sum(s_) * (1.f / 1024.f); float s2_ = 0.f; \
        _Pragma("unroll") for (int j = 0; j < 4; ++j) { v[j] = v[j] - mean_; s2_ += (v[j][0] * v[j][0] + v[j][1] * v[j][1]) + (v[j][2] * v[j][2] + v[j][3] * v[j][3]); } \
        const float rstd_ = 1.f / sqrtf(wave_sum(s2_) * (1.f / 1024.f) + LN_EPS); \
        _Pragma("unroll") for (int j = 0; j < 4; ++j) *(f32x4*)(F.out + (size_t)(tt) * 1024 + 512 * (j >> 1) + 8 * lane + 4 * (j & 1)) = v[j] * rstd_ * lg[j] + lb[j]; } while (0)
    const int nmine = (T - gw + NGW - 1) / NGW;
    unsigned ppA[4], ppB[4]; float pwA[4], pwB[4], pwN[4]; u32x2 ywA[4][2], ywB[4][2]; u32x4 xwA[2], xwB[2];
    if (nmine > 0) { P12_ROUTE(ppA, pwA, gw); P12_ROWS(ywA, xwA, ppA, gw); }
    if (nmine > 1) { P12_ROUTE(ppB, pwB, gw + NGW); }
    for (int i = 0; i < nmine; i += 2) {
        const int t0 = gw + i * NGW, t1 = t0 + NGW, t2 = t1 + NGW, t3 = t2 + NGW;
        if (i + 1 < nmine) { P12_ROWS(ywB, xwB, ppB, t1); }
        if (i + 2 < nmine) { P12_ROUTE(ppA, pwN, t2); }
        __builtin_amdgcn_sched_barrier(0);
        P12_COMPUTE(ywA, xwA, pwA, t0);
        if (i + 1 < nmine) {
#pragma unroll
            for (int k = 0; k < 4; ++k) pwA[k] = pwN[k];
            if (i + 2 < nmine) { P12_ROWS(ywA, xwA, ppA, t2); }
            if (i + 3 < nmine) { P12_ROUTE(ppB, pwN, t3); }
            __builtin_amdgcn_sched_barrier(0);
            P12_COMPUTE(ywB, xwB, pwB, t1);
#pragma unroll
            for (int k = 0; k < 4; ++k) pwB[k] = pwN[k];
        }
    }
#undef P12_ROUTE
#undef P12_ROWS
#undef P12_COMPUTE
}

struct Args { const float* in[34]; float* out; unsigned char* ws; int ph_lo, ph_hi; };
__global__ void __launch_bounds__(512, 2) fwd_kernel(Args args) {
    extern __shared__ __attribute__((aligned(16))) unsigned char lds_raw[];
    Frame F;
    F.lds = (LAS unsigned char*)lds_raw; F.MISC = (volatile LAS unsigned*)(F.lds + MISC_OFF);
    F.tid = threadIdx.x; F.lane = F.tid & 63; F.wave = __builtin_amdgcn_readfirstlane(F.tid >> 6);
    F.G = gridDim.x; { const int bx = blockIdx.x; F.vcu = (F.G % 8 == 0) ? (bx % 8) * (F.G / 8) + bx / 8 : bx; }
#pragma unroll
    for (int i = 0; i < 34; ++i) F.in[i] = args.in[i];
    F.out = args.out; F.ws = args.ws; F.ctl = (unsigned*)(args.ws + WS_CTL);
    if (F.tid < 64) F.MISC[F.tid] = 0u;
    __syncthreads();
    XcdBarrier bar; bar.bar = F.ctl + CW_BAR; bar.x = 0; bar.st = nullptr;
    if (MK_N_LAUNCHES == 1) bar = xcd_barrier_post(F.ctl + CW_BAR, F.MISC + 8);
    const int lo = args.ph_lo, hi = args.ph_hi;
#define IN(k) (lo <= (k) && (k) < hi)
#define SEAM(k) do { if (IN(k) && IN((k) + 1)) xcd_barrier(bar); } while (0)

    if (IN(0)) REPS(0) { if (rep_) xcd_barrier(bar);
        for (int j = F.vcu; j < 192; j += F.G) p0_mod_job(F, j);
        for (int j = F.vcu; j < S5G * 8; j += F.G) p0_s5k_job(F, j);
        { bf16* img = WSP(bf16, WS_WRIMG); const float* wr = F.in[26];
          for (int i = F.vcu * 512 + F.tid; i < 1024 * 32; i += F.G * 512) { const float w = wr[i]; const unsigned hb = f2bf(w); const float hf = __builtin_bit_cast(float, hb << 16);
              img[(i & 31) * 1032 + (i >> 5)] = (bf16)hb; img[32 * 1032 + (i & 31) * 1032 + (i >> 5)] = (bf16)f2bf(w - hf); } }
        p0_small_transposes(F);
    }
    SEAM(0);
    if (IN(1)) REPS(1) { if (rep_) xcd_barrier(bar); for (int j = F.vcu; j < S5G * 8; j += F.G) p1_s5w_job(F, j); p1_body(F); }
    SEAM(1);
    if (IN(2)) REPS(2) { if (rep_) xcd_barrier(bar);
        g8::GridOrder S; S.init(T, INC, F.G, (int)blockIdx.x, WSP(bf16, WS_HBF), WSP(bf16, WS_WIN), 1024, 1024);
        EpiInProj E{F.in[5], WSP(bf16, WS_XRNN), WSP(bf16, WS_GY), WSP(bf16, WS_ACAT), WSP(bf16, WS_GATES)};
        g8::gemm_phase<EpiInProj, g8::GridOrder, false, true>(F.lds, 1024, 1024, 1024, S, E);
    }
    SEAM(2);
    if (IN(3)) REPS(3) { if (rep_) xcd_barrier(bar);
        { S5AOrder S{F.G, F.vcu, (const char*)WSP(bf16, WS_ACAT), (const char*)WSP(bf16, WS_WS)}; EpiS5A E{WSP(float, WS_S)};
          g8::gemm_phase<EpiS5A, S5AOrder, false>(F.lds, S5L * 32, S5ROW * 2, S5L * 32, S, E); }
        __syncthreads();
        rglru_phase<0>(F);
    }
    SEAM(3);
    if (IN(4)) REPS(4) { if (rep_) xcd_barrier(bar); p4_carries(F); }
    SEAM(4);
    if (IN(5)) REPS(5) { if (rep_) xcd_barrier(bar);
        { S5COrder S{F.G, F.vcu, (const char*)WSP(bf16, WS_ACAT), (const char*)WSP(bf16, WS_WY)}; EpiS5C E{WSP(bf16, WS_YS)};
          g8::gemm_phase<EpiS5C, S5COrder, false>(F.lds, S5ROW * 2, S5ROW * 2, S5ROW * 2, S, E); }
        __syncthreads();
        rglru_phase<1>(F);
    }
    SEAM(5);
    if (IN(6)) REPS(6) { if (rep_) xcd_barrier(bar);
        g8::GridOrder S; S.init(T, 2048, F.G, (int)blockIdx.x, WSP(bf16, WS_YS), WSP(bf16, WS_WGLU), 512, 512);
        EpiGlu E{WSP(bf16, WS_GATES), WSP(bf16, WS_GB)};
        g8::gemm_phase<EpiGlu, g8::GridOrder, false, true>(F.lds, 512, 512, 512, S, E);
    }
    SEAM(6);
    if (IN(7)) REPS(7) { if (rep_) xcd_barrier(bar);
        g8::GridOrder S; S.init(T, 1024, F.G, (int)blockIdx.x, WSP(bf16, WS_HA), WSP(bf16, WS_WRNN), 1024, 1024);
        EpiRnn E{WSP(bf16, WS_GATES), WSP(bf16, WS_GB), WSP(bf16, WS_MERGED)};
        g8::gemm_phase<EpiRnn, g8::GridOrder, false, true>(F.lds, 1024, 1024, 1024, S, E);
    }
    SEAM(7);
    if (IN(8)) REPS(8) { if (rep_) xcd_barrier(bar);
        g8::GridOrder S; S.init(T, 1024, F.G, (int)blockIdx.x, WSP(bf16, WS_MERGED), WSP(bf16, WS_WOUT), 1024, 1024);
        EpiOut E{F.in[0], WSP(float, WS_MOD), WSP(bf16, WS_V1)};
        g8::gemm_phase<EpiOut, g8::GridOrder, false, true>(F.lds, 1024, 1024, 1024, S, E);
    }
    SEAM(8);
    if (IN(9)) REPS(9) { if (rep_) xcd_barrier(bar); p9_router(F); }
    SEAM(9);
    if (IN(10)) REPS(10) { if (rep_) xcd_barrier(bar);
        moe_tables(F);
        const LAS int* tstart = (const LAS int*)(F.lds + TAB_OFF);
        MoeOrder S{F.G, (int)blockIdx.x, 8, tstart[NE], tstart, tstart + 40, WSP(int, WS_TOK), (const char*)WSP(bf16, WS_H2), (const char*)WSP(bf16, WS_WGU), (size_t)2048 * 1024, 1024, true};
        EpiMoe1 E{F.in[29], WSP(bf16, WS_ACT)};
        g8::gemm_phase<EpiMoe1, MoeOrder, true, true>(F.lds, 1024, 1024, 1024, S, E);
    }
    SEAM(10);
    if (IN(11)) REPS(11) { if (rep_) xcd_barrier(bar);
        moe_tables(F);
        const LAS int* tstart = (const LAS int*)(F.lds + TAB_OFF);
        MoeOrder S{F.G, (int)blockIdx.x, 4, tstart[NE], tstart, tstart + 40, WSP(int, WS_TOK), (const char*)WSP(bf16, WS_ACT), (const char*)WSP(bf16, WS_WD), (size_t)1024 * 1024, 1024, false};
        EpiMoe2 E{F.in[31], WSP(bf16, WS_YB)};
        g8::gemm_phase<EpiMoe2, MoeOrder, false, true>(F.lds, 1024, 1024, 1024, S, E);
    }
    SEAM(11);
    if (IN(12)) REPS(12) { if (rep_) xcd_barrier(bar); p12_final(F); }
#undef IN
#undef SEAM
}

extern "C" void kernel_launch(void* const* d_in, const int* in_sizes, int n_in, void* d_out, int out_size, void* d_ws, size_t ws_size, hipStream_t stream) {
    static int grid = 0;
    if (grid == 0) {
        if (n_in != 34 || in_sizes[0] != T * D || out_size != T * D || ws_size < WS_END) { fprintf(stderr, "kernel_launch: unexpected shapes (n_in %d, ws %zu < %zu)\n", n_in, ws_size, (size_t)WS_END); grid = -1; return; }
        int dev = 0, cus = 0;
        if (hipGetDevice(&dev) != hipSuccess || hipDeviceGetAttribute(&cus, hipDeviceAttributeMultiprocessorCount, dev) != hipSuccess) { grid = -1; return; }
        if (hipFuncSetAttribute((const void*)fwd_kernel, hipFuncAttributeMaxDynamicSharedMemorySize, LDS_BYTES) != hipSuccess) { fprintf(stderr, "kernel_launch: hipFuncSetAttribute failed\n"); grid = -1; return; }
        int per_cu = 0; (void)hipOccupancyMaxActiveBlocksPerMultiprocessor(&per_cu, (const void*)fwd_kernel, 512, LDS_BYTES); (void)hipGetLastError();
        grid = cus;
    }
    if (grid < 0) return;
    (void)hipMemsetAsync((char*)d_ws + WS_CTL, 0, CTL_BYTES, stream);
    Args a{};
    for (int i = 0; i < 34; ++i) a.in[i] = (const float*)d_in[i];
    a.out = (float*)d_out; a.ws = (unsigned char*)d_ws;
    if (MK_N_LAUNCHES == 1) { a.ph_lo = 0; a.ph_hi = N_PHASES; hipLaunchKernelGGL(fwd_kernel, dim3(grid), dim3(512), LDS_BYTES, stream, a); }
    else for (int p = 0; p < N_PHASES; ++p) { a.ph_lo = p; a.ph_hi = p + 1; hipLaunchKernelGGL(fwd_kernel, dim3(grid), dim3(512), LDS_BYTES, stream, a); }
}
```

```cpp
#include <hip/hip_runtime.h>
#include <cstdio>
#include <cstdint>

#ifndef MK_N_LAUNCHES
#define MK_N_LAUNCHES 1
#endif
constexpr int N_PHASES = 13;
#ifndef DUP_PHASE
#define DUP_PHASE -1
#endif
#define REPS(k) for (int rep_ = 0; rep_ < ((DUP_PHASE == (k)) ? 2 : 1); ++rep_)

#define GAS __attribute__((address_space(1)))
#define LAS __attribute__((address_space(3)))
typedef unsigned short bf16;
typedef short bf16x8 __attribute__((ext_vector_type(8)));
typedef float f32x4 __attribute__((ext_vector_type(4)));
typedef float f32x2 __attribute__((ext_vector_type(2)));
typedef unsigned u32x4 __attribute__((ext_vector_type(4)));
typedef unsigned u32x2 __attribute__((ext_vector_type(2)));
typedef GAS unsigned gu32;

constexpr int NB = 8, SEQ = 4096, T = NB * SEQ, D = 1024, INC = 4608, NE = 32, DFF = 1024;
constexpr int S5L = 32, S5G = 32, S5ROW = 128 + S5L * 16  , S5M = T / S5L  , S5CPB = SEQ / S5L  ;
constexpr int RGL = 128, RGC = SEQ / RGL  ;
constexpr float LN_EPS = 1e-5f, DN_ALPHA = 1.189207115002721f;
constexpr int ACT_ROWS = T * 4 + NE * 256;

constexpr size_t MiB = 1u << 20;
constexpr size_t WS_XRNN = 0, WS_GY = 64 * MiB, WS_GATES = 128 * MiB, WS_V1 = 0, WS_ACT = 0;
constexpr size_t WS_HBF = 272 * MiB, WS_HA = 272 * MiB, WS_YS = 336 * MiB, WS_GB = 368 * MiB, WS_MERGED = 432 * MiB, WS_ACAT = 496 * MiB, WS_YB = 272 * MiB;
constexpr size_t WS_X1 = 544 * MiB, WS_H2 = 608 * MiB;
constexpr size_t WS_WGU = 672 * MiB, WS_WD = 800 * MiB, WS_WIN = 864 * MiB, WS_WG = 873 * MiB, WS_WRNN = 874 * MiB, WS_WGLU = 876 * MiB, WS_WOUT = 878 * MiB;
constexpr size_t WS_WS = 880 * MiB, WS_WY = 888 * MiB, WS_S = 908 * MiB;
constexpr size_t WS_MOD = 924 * MiB, WS_AL = 925 * MiB, WS_RGAGG = 926 * MiB, WS_HIN = 928 * MiB, WS_TOK = 929 * MiB, WS_POS = 933 * MiB, WS_PROB = 934 * MiB, WS_CTL = 935 * MiB;
constexpr size_t WS_END = 936 * MiB, CTL_BYTES = 1 * MiB;
static_assert((size_t)ACT_ROWS * DFF * 2 <= 272 * MiB, "act/yb size");
static_assert(WS_ACAT + (size_t)S5G * S5M * S5ROW * 2 <= WS_X1, "acat");
constexpr int CW_BAR = 4096, CW_CNT = 8192  ;

constexpr int LDS_BYTES = 147456, MISC_OFF = LDS_BYTES - 256, TAB_OFF = 131072 + 1024;

__device__ __forceinline__ unsigned f2bf(float f) { unsigned u = __builtin_bit_cast(unsigned, f); return (u + 0x7fffu + ((u >> 16) & 1u)) >> 16; }
typedef __bf16 bf16x2v __attribute__((ext_vector_type(2)));
__device__ __forceinline__ unsigned pk2(float lo, float hi) { const f32x2 v = {lo, hi}; const bf16x2v b = __builtin_convertvector(v, bf16x2v); return __builtin_bit_cast(unsigned, b); }
__device__ __forceinline__ unsigned pk4_fp8(float a, float b, float c, float d) { a = __builtin_amdgcn_fmed3f(a, -448.f, 448.f); b = __builtin_amdgcn_fmed3f(b, -448.f, 448.f); c = __builtin_amdgcn_fmed3f(c, -448.f, 448.f); d = __builtin_amdgcn_fmed3f(d, -448.f, 448.f); int w = 0; w = __builtin_amdgcn_cvt_pk_fp8_f32(a, b, w, false); w = __builtin_amdgcn_cvt_pk_fp8_f32(c, d, w, true); return (unsigned)w; }
__device__ __forceinline__ float bflo(unsigned w) { return __builtin_bit_cast(float, w << 16); }
__device__ __forceinline__ float bfhi(unsigned w) { return __builtin_bit_cast(float, w & 0xffff0000u); }
__device__ __forceinline__ float bf1(bf16 h) { return __builtin_bit_cast(float, ((unsigned)h) << 16); }
__device__ __forceinline__ float fast_sigmoid(float x) { return __builtin_amdgcn_rcpf(1.0f + __builtin_amdgcn_exp2f(-1.4426950409f * x)); }
__device__ __forceinline__ float gelu_tanh(float x) { const float u = x + 0.044715f * x * x * x; return x * __builtin_amdgcn_rcpf(1.0f + __builtin_amdgcn_exp2f(-2.3022082f * u)); }
__device__ __forceinline__ float wave_sum(float v) {
#pragma unroll
    for (int o = 1; o < 64; o <<= 1) v += __shfl_xor(v, o);
    return v;
}
__device__ __forceinline__ u32x4 pack8(f32x4 a, f32x4 b) { u32x4 w; w.x = pk2(a[0], a[1]); w.y = pk2(a[2], a[3]); w.z = pk2(b[0], b[1]); w.w = pk2(b[2], b[3]); return w; }
__device__ __forceinline__ void unpack8(u32x4 w, f32x4& a, f32x4& b) { a = (f32x4){bflo(w.x), bfhi(w.x), bflo(w.y), bfhi(w.y)}; b = (f32x4){bflo(w.z), bfhi(w.z), bflo(w.w), bfhi(w.w)}; }

#define XB_TMO      128
#define XB_XCNT(j)  (256  + 64 * (j))
#define XB_XSUB(j)  (1280 + 64 * (j))
#define XB_XGEN(j)  (2304 + 64 * (j))
#define XB_TOP      3328
#define XB_TOPGEN   3392
#define XCD_BAR_WORDS 3456
#define XB_SPIN_CAP (1u << 18)
__device__ __forceinline__ unsigned xb_ld(unsigned* p)              { return __hip_atomic_load(p, __ATOMIC_RELAXED, __HIP_MEMORY_SCOPE_AGENT); }
__device__ __forceinline__ unsigned xb_add(unsigned* p, unsigned v) { return __hip_atomic_fetch_add(p, v, __ATOMIC_RELAXED, __HIP_MEMORY_SCOPE_AGENT); }
__device__ __forceinline__ unsigned xb_xcc_id() { return (unsigned)__builtin_amdgcn_s_getreg((3 << 11) | 20) & 0xFu; }
#define XB_SPIN(cond, bar) do { unsigned _sp = 0; while (cond) { __builtin_amdgcn_s_sleep(1); \
    if ((++_sp & 255u) == 0u) { if (xb_ld(&(bar)[XB_TMO])) break; if (_sp > XB_SPIN_CAP) { atomicAdd(&(bar)[XB_TMO], 1u); break; } } } } while (0)
struct XcdBarrier { unsigned* bar; unsigned x; volatile LAS unsigned* st; };
__device__ __forceinline__ XcdBarrier xcd_barrier_post(unsigned* bar, volatile LAS unsigned* st) {
    XcdBarrier b; b.bar = bar; b.x = xb_xcc_id(); b.st = st;
    if (threadIdx.x == 0) (void)xb_add(&bar[XB_XCNT(b.x)], 1u);
    return b;
}
__device__ __forceinline__ void xcd_barrier_complete(unsigned* bar, unsigned x, unsigned& nloc, unsigned& nx) {
    const unsigned G = gridDim.x * gridDim.y * gridDim.z;
    unsigned sum, cnt, mine, sp = 0u;
    for (;;) {
        sum = 0u; cnt = 0u; mine = 0u;
#pragma unroll
        for (unsigned j = 0; j < 16; ++j) { const unsigned c = xb_ld(&bar[XB_XCNT(j)]); sum += c; cnt += (c > 0u) ? 1u : 0u; mine = (j == x) ? c : mine; }
        if (sum == G) break;
        __builtin_amdgcn_s_sleep(1);
        if ((++sp & 255u) == 0u) { if (xb_ld(&bar[XB_TMO])) break; if (sp > XB_SPIN_CAP) { atomicAdd(&bar[XB_TMO], 1u); break; } }
    }
    nloc = mine > 0u ? mine : 1u; nx = cnt > 0u ? cnt : 1u;
}
__device__ __forceinline__ void xcd_barrier(const XcdBarrier& b) {
    asm volatile("s_waitcnt vmcnt(0)" ::: "memory");
    __syncthreads();
    if (threadIdx.x == 0) {
        unsigned* bar = b.bar;
        __builtin_amdgcn_s_waitcnt(0);
        unsigned nloc = b.st[0], nx = b.st[1];
        if (nloc == 0u) { xcd_barrier_complete(bar, b.x, nloc, nx); b.st[0] = nloc; b.st[1] = nx; }
        const unsigned old = xb_add(&bar[XB_XSUB(b.x)], 1u);
        const unsigned gen = old / nloc;
        if (old + 1u == (gen + 1u) * nloc) {
            __builtin_amdgcn_fence(__ATOMIC_RELEASE, "agent");
            asm volatile("s_waitcnt vmcnt(0)" ::: "memory");
            const unsigned og = xb_add(&bar[XB_TOP], 1u);
            const unsigned tg = og / nx;
            if (og + 1u == (tg + 1u) * nx) xb_add(&bar[XB_TOPGEN], 1u);
            else XB_SPIN(xb_ld(&bar[XB_TOPGEN]) == tg, bar);
            __builtin_amdgcn_fence(__ATOMIC_ACQUIRE, "agent");
            xb_add(&bar[XB_XGEN(b.x)], 1u);
            asm volatile("s_waitcnt vmcnt(0)" ::: "memory");
        } else {
            XB_SPIN(xb_ld(&bar[XB_XGEN(b.x)]) == gen, bar);
            __builtin_amdgcn_fence(__ATOMIC_ACQUIRE, "agent");
            asm volatile("s_waitcnt vmcnt(0)" ::: "memory");
        }
    }
    __syncthreads();
}

namespace g8 {
constexpr int BM = 256, BK = 64, HALF = 128, HTB = HALF * BK * 2, STAGE_BYTES = 8 * HTB;
__device__ __forceinline__ int lds_byte(int r, int c) { const int st = (r >> 4) * 2 + (c >> 5), rr = r & 15, cc = c & 31, ob = rr * 64 + cc * 2; return st * 1024 + (ob ^ (((ob >> 9) & 1) << 5)); }
__device__ __forceinline__ void stage_rc(int b, int& R, int& C) { const int st = b / 1024, sb = b % 1024, swz = sb ^ (((sb >> 9) & 1) << 5); R = (st >> 1) * 16 + swz / 64; C = (st & 1) * 32 + (swz % 64) / 2; }
__device__ __forceinline__ int perm32(int rho) { const int n = rho >> 4, i = rho & 15; return 8 * (i >> 2) + 4 * n + (i & 3); }

struct Unit { int pm, pn, z, rl; const char* A; const char* B; };

typedef int v8i __attribute__((ext_vector_type(8)));
typedef int v4i __attribute__((ext_vector_type(4)));
typedef short s16x16 __attribute__((ext_vector_type(16)));
typedef s16x16 s16x16_a16 __attribute__((aligned(16)));
__device__ __forceinline__ v8i cat8(bf16x8 lo, bf16x8 hi) { const v4i a = __builtin_bit_cast(v4i, lo), b = __builtin_bit_cast(v4i, hi); return __builtin_shufflevector(a, b, 0, 1, 2, 3, 4, 5, 6, 7); }
template <class Epi, class Sched, bool GATHER, bool FP8 = false>
__device__ __forceinline__ void gemm_phase(LAS unsigned char* lds, const int Kb, const int ldaB, const int ldbB, const Sched& S, const Epi& E) {
    const int tid = threadIdx.x, wid = __builtin_amdgcn_readfirstlane(tid >> 6), lane = tid & 63, wr = wid >> 2, wc = wid & 3, fr = lane & 15, fq = lane >> 4;
    const int nt = Kb / 128;
    unsigned voffB[2], cvo[2][2], nvo[2][2]; int Rr[2], Cc[2];
#pragma unroll
    for (int i = 0; i < 2; ++i) { int R, C; stage_rc(tid * 16 + i * 8192, R, C); const int Rb = (R & ~31) + perm32(R & 31);
        voffB[i] = (unsigned)(Rb * ldbB + C * 2); Rr[i] = R; Cc[i] = C;
#pragma unroll
        for (int h = 0; h < 2; ++h) { cvo[h][i] = (unsigned)((h * HALF + R) * ldaB + C * 2); nvo[h][i] = cvo[h][i]; } }
    const size_t kstep = (size_t)(BK * 2);
    const size_t hstepB = (size_t)HALF * ldbB;
    const unsigned ldsw = (unsigned)wid * 1024u;
    const int aoff = FP8 ? lds_byte(wr * 64 + fr, (fq >> 1) * 32 + (fq & 1) * 24) : lds_byte(wr * 64 + fr, fq * 8), boff = FP8 ? lds_byte(wc * 32 + fr, (fq >> 1) * 32 + (fq & 1) * 24) : lds_byte(wc * 32 + fr, fq * 8);
    const int aoff2 = FP8 ? lds_byte(wr * 64 + fr, (fq >> 1) * 32 + 8 + (fq & 1) * 8) : 0, boff2 = FP8 ? lds_byte(wc * 32 + fr, (fq >> 1) * 32 + 8 + (fq & 1) * 8) : 0;
#define G8_SA(b, h) (((b) * 2 + (h)) * HTB)
#define G8_SB(b, h) ((4 + (b) * 2 + (h)) * HTB)
#define G8_STGB(bufoff, gbase) do { _Pragma("unroll") for (int _i = 0; _i < 2; ++_i) \
        __builtin_amdgcn_global_load_lds((const unsigned*)((const char*)(gbase) + voffB[_i]), (LAS unsigned*)(lds + (bufoff) + ldsw + _i * 8192), 16, 0, 0); } while (0)
#define G8_STGA(bufoff, gbase, VO, h) do { _Pragma("unroll") for (int _i = 0; _i < 2; ++_i) \
        __builtin_amdgcn_global_load_lds((const unsigned*)((const char*)(gbase) + VO[h][_i]), (LAS unsigned*)(lds + (bufoff) + ldsw + _i * 8192), 16, 0, 0); } while (0)
#define G8_LDA(dst, b, h) do { _Pragma("unroll") for (int m = 0; m < 4; ++m) { if constexpr (FP8) { dst##8[m] = cat8(*(const LAS bf16x8*)(lds + G8_SA(b, h) + aoff + m * 2048), *(const LAS bf16x8*)(lds + G8_SA(b, h) + aoff2 + m * 2048)); } \
        else { _Pragma("unroll") for (int k = 0; k < 2; ++k) dst[m][k] = *(const LAS bf16x8*)(lds + G8_SA(b, h) + aoff + m * 2048 + k * 1024); } } } while (0)
#define G8_LDB(dst, b, h) do { _Pragma("unroll") for (int n = 0; n < 2; ++n) { if constexpr (FP8) { dst##8[n] = cat8(*(const LAS bf16x8*)(lds + G8_SB(b, h) + boff + n * 2048), *(const LAS bf16x8*)(lds + G8_SB(b, h) + boff2 + n * 2048)); } \
        else { _Pragma("unroll") for (int k = 0; k < 2; ++k) dst[n][k] = *(const LAS bf16x8*)(lds + G8_SB(b, h) + boff + n * 2048 + k * 1024); } } } while (0)
#define G8_MMA(ai, bj, At, Bt) do { __builtin_amdgcn_s_setprio(1); _Pragma("unroll") for (int m = 0; m < 4; ++m) _Pragma("unroll") for (int n = 0; n < 2; ++n) { \
        if constexpr (FP8) asm volatile("s_nop 1\n\tv_mfma_scale_f32_16x16x128_f8f6f4 %0, %1, %2, %0, %3, %4 op_sel_hi:[0,0,0]" : "+v"(acc[ai][bj][m][n]) : "v"(Bt##8[n]), "v"(At##8[m]), "v"(sc_w), "v"(sc_a)); \
        else { _Pragma("unroll") for (int k = 0; k < 2; ++k) acc[ai][bj][m][n] = __builtin_amdgcn_mfma_f32_16x16x32_bf16(Bt[n][k], At[m][k], acc[ai][bj][m][n], 0, 0, 0); } } __builtin_amdgcn_s_setprio(0); } while (0)
#define G8_WAIT_V(n) asm volatile("s_waitcnt vmcnt(" #n ")" ::: "memory")
#define G8_WAIT_L(n) asm volatile("s_waitcnt lgkmcnt(" #n ")" ::: "memory")
#define G8_BAR __builtin_amdgcn_s_barrier()
#define G8_SCHED __builtin_amdgcn_sched_barrier(0)
    Unit cur, nxt; int ui = 0;
    if (!S.next(0, cur)) return;
    bool has_next = S.next(1, nxt);
    if constexpr (GATHER) { S.gather(cur, Rr, Cc, cvo); if (has_next) S.gather(nxt, Rr, Cc, nvo); else {
#pragma unroll
        for (int h = 0; h < 2; ++h)
#pragma unroll
            for (int i = 0; i < 2; ++i) nvo[h][i] = cvo[h][i]; } }
    f32x4 acc[2][2][4][2];
#pragma unroll
    for (int a = 0; a < 2; ++a)
#pragma unroll
        for (int b = 0; b < 2; ++b)
#pragma unroll
            for (int m = 0; m < 4; ++m)
#pragma unroll
                for (int n = 0; n < 2; ++n) acc[a][b][m][n] = (f32x4){0.f, 0.f, 0.f, 0.f};
    const int sc_w = 0x7a7a7a7a, sc_a = 0x7f7f7f7f;
    bf16x8 At[4][2], B0[2][2], B1[2][2]; v8i At8[4], B08[2], B18[2];
    const char* cA = cur.A; const char* cB = cur.B;
    G8_STGB(G8_SB(0, 0), cB); G8_STGB(G8_SB(0, 1), cB + hstepB); G8_STGA(G8_SA(0, 0), cA, cvo, 0); G8_STGA(G8_SA(0, 1), cA, cvo, 1);
    if (wr == 1) G8_BAR;
    G8_WAIT_V(2); G8_BAR;
    G8_STGB(G8_SB(1, 0), cB + kstep); G8_STGA(G8_SA(1, 0), cA + kstep, cvo, 0); G8_STGB(G8_SB(1, 1), cB + hstepB + kstep);
    G8_WAIT_V(6); G8_BAR;
    for (;;) {
        const char* nA = has_next ? nxt.A : cA; const char* nB = has_next ? nxt.B : cB;
        for (int t = 0; t < nt; t += 2) {
            const bool last = (t == nt - 2);
            const char* a1 = cA + (size_t)(t + 1) * kstep;
            const char* a2 = last ? nA : cA + (size_t)(t + 2) * kstep; const char* b2 = last ? nB : cB + (size_t)(t + 2) * kstep;
            const char* a3 = a2 + kstep; const char* b3 = b2 + kstep;
            unsigned vo2[2][2];
#pragma unroll
            for (int h = 0; h < 2; ++h)
#pragma unroll
                for (int i = 0; i < 2; ++i) vo2[h][i] = (GATHER && last) ? nvo[h][i] : cvo[h][i];
            G8_LDB(B0, 0, 0); G8_LDB(B1, 0, 1); G8_SCHED; G8_LDA(At, 0, 0); G8_STGA(G8_SA(1, 1), a1, cvo, 1);
            G8_WAIT_V(8); G8_WAIT_L(0); G8_BAR; G8_SCHED; G8_MMA(0, 0, At, B0); G8_MMA(0, 1, At, B1); G8_SCHED; G8_BAR; G8_SCHED;
            G8_LDA(At, 0, 1); G8_STGB(G8_SB(0, 0), b2); G8_STGB(G8_SB(0, 1), b2 + hstepB); G8_STGA(G8_SA(0, 0), a2, vo2, 0);
            G8_WAIT_V(8); G8_WAIT_L(0); G8_BAR; G8_SCHED; G8_MMA(1, 0, At, B0); G8_MMA(1, 1, At, B1); G8_SCHED; G8_BAR; G8_SCHED;
            G8_LDB(B0, 1, 0); G8_LDB(B1, 1, 1); G8_SCHED; G8_LDA(At, 1, 0); G8_STGA(G8_SA(0, 1), a2, vo2, 1);
            G8_WAIT_V(8); G8_WAIT_L(0); G8_BAR; G8_SCHED; G8_MMA(0, 0, At, B0); G8_MMA(0, 1, At, B1); G8_SCHED; G8_BAR; G8_SCHED;
            G8_LDA(At, 1, 1); G8_STGB(G8_SB(1, 0), b3); G8_STGB(G8_SB(1, 1), b3 + hstepB); G8_STGA(G8_SA(1, 0), a3, vo2, 0);
            G8_WAIT_V(8); G8_WAIT_L(0); G8_BAR; G8_SCHED; G8_MMA(1, 0, At, B0); G8_MMA(1, 1, At, B1); G8_SCHED; G8_BAR; G8_SCHED;
        }
        f32x4 bpre[4]; E.pre(cur, wr, wc, fr, fq, bpre);
        if (wr == 0) G8_BAR;
        Unit nn; bool has_nn = false;
        if (has_next) has_nn = S.next(ui + 2, nn);
        unsigned nnvo[2][2];
        if constexpr (GATHER) { if (has_nn) S.gather(nn, Rr, Cc, nnvo); }
        if constexpr (FP8) asm volatile("s_nop 15\n\ts_nop 15" ::: "memory");
        E(acc, cur, wr, wc, fr, fq, bpre);
        if (!has_next) break;
#pragma unroll
        for (int a = 0; a < 2; ++a)
#pragma unroll
            for (int b = 0; b < 2; ++b)
#pragma unroll
                for (int m = 0; m < 4; ++m)
#pragma unroll
                    for (int n = 0; n < 2; ++n) acc[a][b][m][n] = (f32x4){0.f, 0.f, 0.f, 0.f};
        cur = nxt; cA = nA; cB = nB; ++ui;
        if constexpr (GATHER) {
#pragma unroll
            for (int h = 0; h < 2; ++h)
#pragma unroll
                for (int i = 0; i < 2; ++i) { cvo[h][i] = nvo[h][i]; if (has_nn) nvo[h][i] = nnvo[h][i]; } }
        nxt = nn; has_next = has_nn;
        if (wr == 1) G8_BAR;
    }
    G8_WAIT_V(0);
    G8_BAR;
#undef G8_SA
#undef G8_SB
#undef G8_STGB
#undef G8_STGA
#undef G8_LDA
#undef G8_LDB
#undef G8_MMA
#undef G8_WAIT_V
#undef G8_WAIT_L
#undef G8_BAR
#undef G8_SCHED
}

struct GridOrder {
    int nM, nN, nwg, G, c; const char* A; const char* B; size_t tstepA, tstepB;
    __device__ __forceinline__ void init(int M, int N, int G_, int c_, const void* A_, const void* B_, int ldaB, int ldbB) { nM = M / BM; nN = N / BM; nwg = nM * nN; G = G_; c = c_; A = (const char*)A_; B = (const char*)B_; tstepA = (size_t)BM * ldaB; tstepB = (size_t)BM * ldbB; }
    __device__ __forceinline__ bool next(int i, Unit& u) const {
        const long L = (long)i * G + c; if (L >= nwg) return false;
        int wgid = (int)L; { const int q = nwg / 8, r = nwg % 8, xcd = wgid % 8, off = wgid / 8; wgid = (xcd < r ? xcd * (q + 1) : r * (q + 1) + (xcd - r) * q) + off; }
        const int nig = 8 * nN, gid = wgid / nig, fm = gid * 8, gsz = (nM - fm) < 8 ? (nM - fm) : 8;
        u.pm = fm + ((wgid % nig) % gsz); u.pn = (wgid % nig) / gsz; u.z = 0; u.rl = 0;
        u.A = A + (size_t)u.pm * tstepA; u.B = B + (size_t)u.pn * tstepB; return true;
    }
};
}

struct Frame {
    LAS unsigned char* lds; volatile LAS unsigned* MISC; unsigned* ctl;
    int tid, lane, wave, vcu, G;
    const float* in[34]; float* out; unsigned char* ws;
};
#define WSP(T_, off) ((T_*)(F.ws + (off)))

struct EpiInProj {
    __device__ __forceinline__ void pre(const g8::Unit& u, int, int wc, int, int fq, f32x4 (&bp)[4]) const { const int colb = u.pn * 256 + wc * 32 + 8 * fq;
#pragma unroll
        for (int bj = 0; bj < 2; ++bj)
#pragma unroll
            for (int n = 0; n < 2; ++n) bp[bj * 2 + n] = *(const f32x4*)(bias + colb + bj * 128 + 4 * n); }
    const float* bias; bf16 *xrnn, *gy, *acat, *gates;
    __device__ __forceinline__ void operator()(const f32x4 (&acc)[2][2][4][2], const g8::Unit& u, int wr, int wc, int fr, int fq, const f32x4 (&bpre)[4]) const {
        const int pn = u.pn, colb = pn * 256 + wc * 32 + 8 * fq;
        f32x4 bv[2][2];
#pragma unroll
        for (int bj = 0; bj < 2; ++bj)
#pragma unroll
            for (int n = 0; n < 2; ++n) bv[bj][n] = bpre[bj * 2 + n];
#pragma unroll
        for (int ai = 0; ai < 2; ++ai)
#pragma unroll
            for (int m = 0; m < 4; ++m) { const int t = u.pm * 256 + ai * 128 + wr * 64 + m * 16 + fr;
#pragma unroll
                for (int bj = 0; bj < 2; ++bj) { f32x4 v0 = acc[ai][bj][m][0] + bv[bj][0], v1 = acc[ai][bj][m][1] + bv[bj][1]; const int col = colb + bj * 128;
                    if (pn < 4) { *(u32x4*)(xrnn + (size_t)t * 1024 + col) = pack8(v0, v1); }
                    else if (pn < 8) {
#pragma unroll
                        for (int j = 0; j < 4; ++j) { v0[j] = gelu_tanh(v0[j]); v1[j] = gelu_tanh(v1[j]); }
                        *(u32x4*)(gy + (size_t)t * 1024 + (col - 1024)) = pack8(v0, v1); }
                    else if (pn < 10) { const int cu = col - 2048, g = cu >> 4, c = cu & 15;
                        *(u32x4*)(acat + ((size_t)(g * S5M + (t >> 5)) * S5ROW + 128 + (t & 31) * 16 + c)) = pack8(v0, v1); }
                    else {
#pragma unroll
                        for (int j = 0; j < 4; ++j) { v0[j] = fast_sigmoid(v0[j]); v1[j] = fast_sigmoid(v1[j]); }
                        *(u32x4*)(gates + (size_t)t * 2048 + (col - 2560)) = pack8(v0, v1); } } }
    }
};
struct EpiS5A {
    __device__ __forceinline__ void pre(const g8::Unit&, int, int, int, int, f32x4 (&)[4]) const {}
    float* S;
    __device__ __forceinline__ void operator()(const f32x4 (&acc)[2][2][4][2], const g8::Unit& u, int wr, int wc, int fr, int fq, const f32x4 (&bpre)[4]) const {
        const int col = wc * 32 + 8 * fq;
#pragma unroll
        for (int ai = 0; ai < 2; ++ai)
#pragma unroll
            for (int m = 0; m < 4; ++m) { const int row = u.pm * 256 + ai * 128 + wr * 64 + m * 16 + fr; float* p = S + ((size_t)(u.z * S5M + row)) * 128 + col;
                *(f32x4*)p = acc[ai][0][m][0]; *(f32x4*)(p + 4) = acc[ai][0][m][1]; }
    }
};
struct EpiS5C {
    __device__ __forceinline__ void pre(const g8::Unit&, int, int, int, int, f32x4 (&)[4]) const {}
    bf16* ys;
    __device__ __forceinline__ void operator()(const f32x4 (&acc)[2][2][4][2], const g8::Unit& u, int wr, int wc, int fr, int fq, const f32x4 (&bpre)[4]) const {
#pragma unroll
        for (int ai = 0; ai < 2; ++ai)
#pragma unroll
            for (int m = 0; m < 4; ++m) { const int row = u.pm * 256 + ai * 128 + wr * 64 + m * 16 + fr;
#pragma unroll
                for (int bj = 0; bj < 2; ++bj) { const int n = u.pn * 256 + bj * 128 + wc * 32 + 8 * fq, i = n >> 4, c = n & 15; f32x4 v0 = acc[ai][bj][m][0], v1 = acc[ai][bj][m][1];
#pragma unroll
                    for (int j = 0; j < 4; ++j) { v0[j] = gelu_tanh(v0[j]); v1[j] = gelu_tanh(v1[j]); }
                    u32x2 w8; w8.x = pk4_fp8(v0[0], v0[1], v0[2], v0[3]); w8.y = pk4_fp8(v1[0], v1[1], v1[2], v1[3]); *(u32x2*)((unsigned char*)ys + (size_t)(row * 32 + i) * 512 + u.z * 16 + c) = w8; } }
    }
};
struct EpiGlu {
    __device__ __forceinline__ void pre(const g8::Unit&, int, int, int, int, f32x4 (&)[4]) const {}
    const bf16* gates; bf16* gb;
    __device__ __forceinline__ void operator()(const f32x4 (&acc)[2][2][4][2], const g8::Unit& u, int wr, int wc, int fr, int fq, const f32x4 (&bpre)[4]) const {
        const int f = u.pn * 128 + wc * 32 + 8 * fq;
#pragma unroll
        for (int ai = 0; ai < 2; ++ai)
#pragma unroll
            for (int m = 0; m < 4; ++m) { const int t = u.pm * 256 + ai * 128 + wr * 64 + m * 16 + fr;
                const u32x4 gw = *(const u32x4*)(gates + (size_t)t * 2048 + 1024 + f); f32x4 g0, g1; unpack8(gw, g0, g1);
                f32x4 v0 = acc[ai][0][m][0], v1 = acc[ai][0][m][1]; const f32x4 s0 = acc[ai][1][m][0], s1 = acc[ai][1][m][1];
#pragma unroll
                for (int j = 0; j < 4; ++j) { v0[j] = g0[j] * v0[j] * fast_sigmoid(s0[j]); v1[j] = g1[j] * v1[j] * fast_sigmoid(s1[j]); }
                *(u32x4*)(gb + (size_t)t * 1024 + f) = pack8(v0, v1); }
    }
};
struct EpiRnn {
    __device__ __forceinline__ void pre(const g8::Unit&, int, int, int, int, f32x4 (&)[4]) const {}
    const bf16* gates; const bf16* gb; bf16* merged;
    __device__ __forceinline__ void operator()(const f32x4 (&acc)[2][2][4][2], const g8::Unit& u, int wr, int wc, int fr, int fq, const f32x4 (&bpre)[4]) const {
#pragma unroll
        for (int ai = 0; ai < 2; ++ai)
#pragma unroll
            for (int m = 0; m < 4; ++m) { const int t = u.pm * 256 + ai * 128 + wr * 64 + m * 16 + fr;
#pragma unroll
                for (int bj = 0; bj < 2; ++bj) { const int col = u.pn * 256 + bj * 128 + wc * 32 + 8 * fq;
                    const u32x4 gw = *(const u32x4*)(gates + (size_t)t * 2048 + col), bw = *(const u32x4*)(gb + (size_t)t * 1024 + col);
                    f32x4 g0, g1, b0, b1; unpack8(gw, g0, g1); unpack8(bw, b0, b1);
                    const f32x4 v0 = g0 * acc[ai][bj][m][0] + b0, v1 = g1 * acc[ai][bj][m][1] + b1;
                    u32x2 w8; w8.x = pk4_fp8(v0[0], v0[1], v0[2], v0[3]); w8.y = pk4_fp8(v1[0], v1[1], v1[2], v1[3]); *(u32x2*)((unsigned char*)merged + (size_t)t * 1024 + col) = w8; } }
    }
};
struct EpiOut {
    __device__ __forceinline__ void pre(const g8::Unit&, int, int, int, int, f32x4 (&)[4]) const {}
    const float* x; const float* mod; bf16* v1;
    __device__ __forceinline__ void operator()(const f32x4 (&acc)[2][2][4][2], const g8::Unit& u, int wr, int wc, int fr, int fq, const f32x4 (&bpre)[4]) const {
        const int b = (u.pm * 256) >> 12;
#pragma unroll
        for (int bj = 0; bj < 2; ++bj) { const int col = u.pn * 256 + bj * 128 + wc * 32 + 8 * fq;
            const f32x4 ga = *(const f32x4*)(mod + b * 6144 + 2048 + col) + 1.0f, gb_ = *(const f32x4*)(mod + b * 6144 + 2048 + col + 4) + 1.0f;
#pragma unroll
            for (int ai = 0; ai < 2; ++ai)
#pragma unroll
                for (int m = 0; m < 4; ++m) { const int t = u.pm * 256 + ai * 128 + wr * 64 + m * 16 + fr;
                    const f32x4 x0 = *(const f32x4*)(x + (size_t)t * 1024 + col), x1 = *(const f32x4*)(x + (size_t)t * 1024 + col + 4);
                    const f32x4 v0 = x0 * DN_ALPHA + ga * acc[ai][bj][m][0], v1_ = x1 * DN_ALPHA + gb_ * acc[ai][bj][m][1];
                    *(u32x4*)(v1 + (size_t)t * 1024 + col) = pack8(v0, v1_); } }
    }
};
struct EpiMoe1 {
    __device__ __forceinline__ void pre(const g8::Unit& u, int, int wc, int, int fq, f32x4 (&bp)[4]) const { const float* p = bgu + (size_t)u.z * 2048 + u.pn * 128 + wc * 32 + 8 * fq; bp[0] = *(const f32x4*)p; bp[1] = *(const f32x4*)(p + 4); bp[2] = *(const f32x4*)(p + 1024); bp[3] = *(const f32x4*)(p + 1028); }
    const float* bgu; bf16* act;
    __device__ __forceinline__ void operator()(const f32x4 (&acc)[2][2][4][2], const g8::Unit& u, int wr, int wc, int fr, int fq, const f32x4 (&bpre)[4]) const {
        const int f = u.pn * 128 + wc * 32 + 8 * fq; const float* bp = bgu + (size_t)u.z * 2048 + f;
        (void)bp; const f32x4 bg0 = bpre[0], bg1 = bpre[1], bu0 = bpre[2], bu1 = bpre[3];
#pragma unroll
        for (int ai = 0; ai < 2; ++ai)
#pragma unroll
            for (int m = 0; m < 4; ++m) { const int row = u.pm * 256 + ai * 128 + wr * 64 + m * 16 + fr;
                f32x4 g0 = acc[ai][0][m][0] + bg0, g1 = acc[ai][0][m][1] + bg1, u0 = acc[ai][1][m][0] + bu0, u1 = acc[ai][1][m][1] + bu1;
#pragma unroll
                for (int j = 0; j < 4; ++j) { const float ga = fminf(g0[j], 7.0f), gb_ = fminf(g1[j], 7.0f), ua = fminf(fmaxf(u0[j], -7.0f), 7.0f), ub = fminf(fmaxf(u1[j], -7.0f), 7.0f);
                    g0[j] = ga * fast_sigmoid(1.702f * ga) * (ua + 1.0f); g1[j] = gb_ * fast_sigmoid(1.702f * gb_) * (ub + 1.0f); }
                u32x2 w8; w8.x = pk4_fp8(g0[0], g0[1], g0[2], g0[3]); w8.y = pk4_fp8(g1[0], g1[1], g1[2], g1[3]); *(u32x2*)((unsigned char*)act + (size_t)row * 1024 + f) = w8; }
    }
};
struct EpiMoe2 {
    __device__ __forceinline__ void pre(const g8::Unit& u, int, int wc, int, int fq, f32x4 (&bp)[4]) const { const float* p = bd + (size_t)u.z * 1024 + u.pn * 256 + wc * 32 + 8 * fq; bp[0] = *(const f32x4*)p; bp[1] = *(const f32x4*)(p + 4); bp[2] = *(const f32x4*)(p + 128); bp[3] = *(const f32x4*)(p + 132); }
    const float* bd; bf16* yb;
    __device__ __forceinline__ void operator()(const f32x4 (&acc)[2][2][4][2], const g8::Unit& u, int wr, int wc, int fr, int fq, const f32x4 (&bpre)[4]) const {
#pragma unroll
        for (int bj = 0; bj < 2; ++bj) { const int col = u.pn * 256 + bj * 128 + wc * 32 + 8 * fq; const float* bp = bd + (size_t)u.z * 1024 + col;
            (void)bp; const f32x4 b0 = bpre[bj * 2], b1 = bpre[bj * 2 + 1];
#pragma unroll
            for (int ai = 0; ai < 2; ++ai)
#pragma unroll
                for (int m = 0; m < 4; ++m) { const int row = u.pm * 256 + ai * 128 + wr * 64 + m * 16 + fr;
                    const f32x4 y0 = acc[ai][bj][m][0] + b0, y1 = acc[ai][bj][m][1] + b1; u32x2 w8; w8.x = pk4_fp8(y0[0], y0[1], y0[2], y0[3]); w8.y = pk4_fp8(y1[0], y1[1], y1[2], y1[3]);
                    *(u32x2*)((unsigned char*)yb + (size_t)row * 1024 + col) = w8; } }
    }
};

struct S5AOrder { int G, c; const char* acat; const char* ws;
    __device__ __forceinline__ bool next(int i, g8::Unit& u) const { const int L = i * G + c; if (L >= S5G * 4) return false; u.z = L >> 2; u.pm = L & 3; u.pn = 0; u.rl = 0;
        u.A = acat + ((size_t)(u.z * S5M + u.pm * 256) * S5ROW + 128) * 2; u.B = ws + (size_t)u.z * 256 * (S5L * 16) * 2; return true; } };
struct S5COrder { int G, c; const char* acat; const char* wy;
    __device__ __forceinline__ bool next(int i, g8::Unit& u) const { const int L = i * G + c; if (L >= S5G * 8) return false; u.z = L >> 3; u.pm = (L >> 1) & 3; u.pn = L & 1; u.rl = 0;
        u.A = acat + ((size_t)(u.z * S5M + u.pm * 256) * S5ROW) * 2; u.B = wy + ((size_t)(u.z * 512 + u.pn * 256) * S5ROW) * 2; return true; } };
struct MoeOrder { int G, c, NT, RT; const LAS int* tstart; const LAS int* cnt; const int* toklist; const char* A; const char* B; size_t bstride_e; int lda; bool gatherA;
    __device__ __forceinline__ bool next(int i, g8::Unit& u) const { const int per = G >> 3, xcd = c & 7, slot = c >> 3, rpx = per / NT;
        const int rt = (i * 8 + xcd) * rpx + slot / NT; if (rt >= RT) return false; u.pn = slot % NT;
        const int lane_ = threadIdx.x & 63; const unsigned long long mk_ = __ballot(lane_ < NE && tstart[lane_ & 31] <= rt);
        const int e = __builtin_popcountll(mk_) - 1;
        u.z = e; u.pm = rt; u.rl = rt - tstart[e]; u.B = B + (size_t)e * bstride_e + (size_t)u.pn * 256 * 1024; u.A = gatherA ? A : A + (size_t)rt * 256 * 1024; return true; }
    __device__ __forceinline__ void gather(const g8::Unit& u, const int (&Rr)[2], const int (&Cc)[2], unsigned (&vo)[2][2]) const {
        const int n = cnt[u.z];
#pragma unroll
        for (int h = 0; h < 2; ++h)
#pragma unroll
            for (int i = 0; i < 2; ++i) { const int r = u.rl * 256 + h * 128 + Rr[i]; const int tok = r < n ? toklist[u.z * T + r] : 0; vo[h][i] = (unsigned)(tok * lda + Cc[i] * 2); } }
};

__device__ __forceinline__ void transpose_item(const float* W, int N, int k0, int n0, bf16* dst, int ldd, int drow0, LAS float* scr, int lane) {
    float wv_[32];
#pragma unroll
    for (int i = 0; i < 32; ++i) wv_[i] = W[(size_t)(k0 + 2 * i + (lane >> 5)) * N + n0 + (lane & 31)];
#pragma unroll
    for (int i = 0; i < 32; ++i) scr[(2 * i + (lane >> 5)) * 33 + (lane & 31)] = wv_[i];
    asm volatile("s_waitcnt lgkmcnt(0)" ::: "memory");
    const int c = lane & 7;
#pragma unroll
    for (int j = 0; j < 4; ++j) { const int n = (lane >> 3) + 8 * j; const LAS float* s = scr + (8 * c) * 33 + n;
        u32x4 o; o.x = pk2(s[0 * 33], s[1 * 33]); o.y = pk2(s[2 * 33], s[3 * 33]); o.z = pk2(s[4 * 33], s[5 * 33]); o.w = pk2(s[6 * 33], s[7 * 33]);
        *(u32x4*)(dst + (size_t)(drow0 + n) * ldd + k0 + 8 * c) = o; }
    asm volatile("s_waitcnt lgkmcnt(0)" ::: "memory");
}
__device__ __forceinline__ void transpose_item8(const float* W, int N, int k0, int n0, unsigned char* dst, int ldd, int drow0, LAS float* scr, int lane) {
    float wv_[32];
#pragma unroll
    for (int i = 0; i < 32; ++i) wv_[i] = W[(size_t)(k0 + 2 * i + (lane >> 5)) * N + n0 + (lane & 31)];
#pragma unroll
    for (int i = 0; i < 32; ++i) scr[(2 * i + (lane >> 5)) * 33 + (lane & 31)] = wv_[i];
    asm volatile("s_waitcnt lgkmcnt(0)" ::: "memory");
    const int c = lane & 7;
#pragma unroll
    for (int j = 0; j < 4; ++j) { const int n = (lane >> 3) + 8 * j; const LAS float* s = scr + (8 * c) * 33 + n;
        u32x2 o; o.x = pk4_fp8(32.f * s[0 * 33], 32.f * s[1 * 33], 32.f * s[2 * 33], 32.f * s[3 * 33]); o.y = pk4_fp8(32.f * s[4 * 33], 32.f * s[5 * 33], 32.f * s[6 * 33], 32.f * s[7 * 33]);
        *(u32x2*)(dst + (size_t)(drow0 + n) * ldd + k0 + 8 * c) = o; }
    asm volatile("s_waitcnt lgkmcnt(0)" ::: "memory");
}
__device__ __forceinline__ void transpose_item8w(const float* W, int N, int k0, int n0, unsigned char* dst, int ldd, int drow0, LAS float* scr, int lane) {
    float wv[64]; const float* wp = W + (size_t)(k0 + (lane >> 5)) * N + n0 + (lane & 31);
#pragma unroll
    for (int i = 0; i < 64; ++i) wv[i] = wp[(size_t)(2 * i) * N];
#pragma unroll
    for (int i = 0; i < 64; ++i) scr[(2 * i + (lane >> 5)) * 33 + (lane & 31)] = wv[i];
    asm volatile("s_waitcnt lgkmcnt(0)" ::: "memory");
    const int c = lane & 7;
#pragma unroll
    for (int j = 0; j < 4; ++j) { const int n = (lane >> 3) + 8 * j; const LAS float* s = scr + (16 * c) * 33 + n;
        u32x4 o; o.x = pk4_fp8(32.f * s[0 * 33], 32.f * s[1 * 33], 32.f * s[2 * 33], 32.f * s[3 * 33]); o.y = pk4_fp8(32.f * s[4 * 33], 32.f * s[5 * 33], 32.f * s[6 * 33], 32.f * s[7 * 33]);
        o.z = pk4_fp8(32.f * s[8 * 33], 32.f * s[9 * 33], 32.f * s[10 * 33], 32.f * s[11 * 33]); o.w = pk4_fp8(32.f * s[12 * 33], 32.f * s[13 * 33], 32.f * s[14 * 33], 32.f * s[15 * 33]);
        *(u32x4*)(dst + (size_t)(drow0 + n) * ldd + k0 + 16 * c) = o; }
    asm volatile("s_waitcnt lgkmcnt(0)" ::: "memory");
}
__device__ __forceinline__ int pair_row(int n) { const int f = n & 1023, hi = n >> 10; return (f >> 7) * 256 + hi * 128 + (f & 127); }

__device__ __forceinline__ void moe_tables(Frame& F) {
    LAS int* tstart = (LAS int*)(F.lds + TAB_OFF); LAS int* cl = tstart + 40;
    if (F.tid < 64) {
        const int e = F.lane & 31; const int c = (int)F.ctl[CW_CNT + 64 * e]; int inc = (c + 255) >> 8;
#pragma unroll
        for (int o = 1; o < 32; o <<= 1) { const int v = __shfl_up(inc, o); if ((F.lane & 31) >= o) inc += v; }
        if (F.lane < 32) { cl[e] = c; tstart[e] = inc - ((c + 255) >> 8); if (e == NE - 1) tstart[NE] = inc; }
    }
    __syncthreads();
}

__device__ __forceinline__ void p0_mod_job(Frame& F, int job) {
    LAS float* sc = (LAS float*)F.lds;
    LAS float* red = sc + 8 * 1024;
    const float* c = F.in[1]; const float* w = F.in[2]; const float* bias = F.in[3];
    for (int i = F.tid; i < 8 * 1024; i += 512) { const float v = c[i]; sc[i] = v * fast_sigmoid(v); }
    __syncthreads();
    const int col = F.tid & 31, kg = F.tid >> 5, j = job * 32 + col;
    float a[8];
#pragma unroll
    for (int b = 0; b < 8; ++b) a[b] = 0.f;
#pragma unroll 32
    for (int k = kg * 64; k < kg * 64 + 64; ++k) { const float wv = w[(size_t)k * 6144 + j];
#pragma unroll
        for (int b = 0; b < 8; ++b) a[b] += sc[b * 1024 + k] * wv; }
#pragma unroll
    for (int b = 0; b < 8; ++b) red[(kg * 8 + b) * 32 + col] = a[b];
    __syncthreads();
    if (F.tid < 256) { const int b = F.tid >> 5, cc = F.tid & 31; float s = 0.f;
#pragma unroll
        for (int g = 0; g < 16; ++g) s += red[(g * 8 + b) * 32 + cc];
        WSP(float, WS_MOD)[b * 6144 + job * 32 + cc] = s + bias[job * 32 + cc]; }
    __syncthreads();
}
__device__ __forceinline__ void s5_setup(Frame& F, int g, int kmin, int kmax, LAS f32x2* Bb, LAS f32x2* Cc, LAS f32x2* Ap) {
    const float* lre = F.in[14] + g * 64; const float* lim = F.in[15] + g * 64; const float dt = expf(F.in[16][g]);
    const float* bre = F.in[17] + g * 1024; const float* bim = F.in[18] + g * 1024; const float* cre = F.in[19] + g * 1024; const float* cim = F.in[20] + g * 1024;
    for (int i = F.tid; i < 1024; i += 512) { const int p = i >> 4; const float lr = lre[p], li = lim[p]; const float mag = expf(lr * dt); float sn, cs; sincosf(li * dt, &sn, &cs);
        const float ar = mag * cs, ai = mag * sn, den = lr * lr + li * li, qr = ((ar - 1.f) * lr + ai * li) / den, qi = (ai * lr - (ar - 1.f) * li) / den;
        const float br = bre[i], bi = bim[i]; Bb[i] = (f32x2){qr * br - qi * bi, qr * bi + qi * br};
        Cc[i] = (f32x2){cre[i], cim[i]}; }
    if (F.tid < 64) { const int p = F.tid; const float lr = lre[p], li = lim[p]; const float mag = expf(lr * dt); float sn, cs; sincosf(li * dt, &sn, &cs);
        const float ar = mag * cs, ai = mag * sn; float xr_ = 1.f, xi_ = 0.f;
        for (int k = 0; k <= kmax; ++k) { if (k >= kmin) Ap[k * 64 + p] = (f32x2){xr_, xi_}; const float nr = xr_ * ar - xi_ * ai, ni = xr_ * ai + xi_ * ar; xr_ = nr; xi_ = ni; } }
    __syncthreads();
}
constexpr size_t WS_KTAB = WS_S;
constexpr size_t WS_WRIMG = WS_AL + 512 * 1024;
__device__ __forceinline__ void p0_s5k_job(Frame& F, int job) {
    const int g = job >> 3, part = job & 7;
    LAS f32x2* Bb = (LAS f32x2*)F.lds; LAS f32x2* Cc = Bb + 1024; LAS f32x2* Ap = Cc + 1024;
    s5_setup(F, g, 4 * part, 4 * part + 3, Bb, Cc, Ap);
    float* kt = WSP(float, WS_KTAB) + (size_t)g * 32 * 256;
    for (int e = 4 * part * 256 + F.tid; e < (4 * part + 4) * 256; e += 512) { const int k = e >> 8, c = (e >> 4) & 15, c2 = e & 15; float s = 0.f;
        for (int p = 0; p < 64; ++p) { const f32x2 cv = Cc[c * 64 + p], av = Ap[k * 64 + p], bv = Bb[p * 16 + c2];
            const float car = cv.x * av.x - cv.y * av.y, cai = cv.x * av.y + cv.y * av.x; s += car * bv.x - cai * bv.y; }
        kt[e] = s; }
    __syncthreads();
}
__device__ __forceinline__ void p1_s5w_job(Frame& F, int job) {
    const int g = job >> 3, part = job & 7;
    LAS f32x2* Bb = (LAS f32x2*)F.lds; LAS f32x2* Cc = Bb + 1024; LAS f32x2* Ap = Cc + 1024; LAS float* Kt = (LAS float*)(Ap + 33 * 64);
    const float* ktg = WSP(float, WS_KTAB) + (size_t)g * 32 * 256; const float* dsk = F.in[21] + g * 16;
    for (int i = F.tid; i < 32 * 256; i += 512) Kt[i] = ktg[i];
    s5_setup(F, g, 0, S5L, Bb, Cc, Ap);
    if (part == 0 && F.tid < 64) WSP(f32x2, WS_AL)[g * 64 + F.tid] = Ap[S5L * 64 + F.tid];
    bf16* wy = WSP(bf16, WS_WY) + (size_t)g * 512 * S5ROW;
    for (int ch = F.tid; ch < 64 * (S5ROW / 8); ch += 512) { const int n = part * 64 + ch / (S5ROW / 8), k8 = (ch % (S5ROW / 8)) * 8, i = n >> 4, c = n & 15; float v[8];
        if (k8 < 128) {
#pragma unroll
            for (int j = 0; j < 8; j += 2) { const int p = (k8 + j) >> 1; const f32x2 cv = Cc[c * 64 + p], av = Ap[(i + 1) * 64 + p]; v[j] = cv.x * av.x - cv.y * av.y; v[j + 1] = -(cv.x * av.y + cv.y * av.x); } }
        else { const int jj = (k8 - 128) >> 4, c2 = (k8 - 128) & 15;
#pragma unroll
            for (int j = 0; j < 8; ++j) { float x = 0.f; if (jj <= i) { x = Kt[(i - jj) * 256 + c * 16 + c2 + j]; if (jj == i && c == c2 + j) x += dsk[c]; } v[j] = x; } }
        u32x4 o; o.x = pk2(v[0], v[1]); o.y = pk2(v[2], v[3]); o.z = pk2(v[4], v[5]); o.w = pk2(v[6], v[7]);
        *(u32x4*)(wy + (size_t)n * S5ROW + k8) = o; }
    bf16* wsm = WSP(bf16, WS_WS) + (size_t)g * 256 * 512;
    for (int ch = F.tid; ch < 32 * 64; ch += 512) { const int n = part * 32 + (ch >> 6), k8 = (ch & 63) * 8, jj = k8 >> 4, c2 = k8 & 15; float v[8];
#pragma unroll
        for (int j = 0; j < 8; ++j) { float x = 0.f; if (n < 128) { const int p = n >> 1; const f32x2 av = Ap[(S5L - 1 - jj) * 64 + p], bv = Bb[p * 16 + c2 + j]; x = (n & 1) ? (av.x * bv.y + av.y * bv.x) : (av.x * bv.x - av.y * bv.y); } v[j] = x; }
        u32x4 o; o.x = pk2(v[0], v[1]); o.y = pk2(v[2], v[3]); o.z = pk2(v[4], v[5]); o.w = pk2(v[6], v[7]);
        *(u32x4*)(wsm + (size_t)n * 512 + k8) = o; }
    __syncthreads();
}
__device__ __forceinline__ void p0_small_transposes(Frame& F) {
    LAS float* scr = (LAS float*)(F.lds + F.wave * 16384);
    const int gw = F.vcu * 8 + F.wave, NGW = F.G * 8;
    constexpr int I_IN = 16 * 144, I_RNN = 16 * 32, I_OUT = 16 * 32, I_GLU = 8 * 64, I_RG = 16 * 8;
    for (int it = gw; it < I_IN + I_RNN + I_OUT + I_GLU + I_RG; it += NGW) { int r = it;
        if (r < I_IN) { const int kb = r / 144, nb = r % 144; transpose_item8(F.in[4], INC, kb * 64, nb * 32, WSP(unsigned char, WS_WIN), 1024, nb * 32, scr, F.lane); continue; } r -= I_IN;
        if (r < I_RNN) { const int kb = r / 32, nb = r % 32; transpose_item8(F.in[13], 1024, kb * 64, nb * 32, WSP(unsigned char, WS_WRNN), 1024, nb * 32, scr, F.lane); continue; } r -= I_RNN;
        if (r < I_OUT) { const int kb = r / 32, nb = r % 32; transpose_item8(F.in[23], 1024, kb * 64, nb * 32, WSP(unsigned char, WS_WOUT), 1024, nb * 32, scr, F.lane); continue; } r -= I_OUT;
        if (r < I_GLU) { const int kb = r / 64, nb = r % 64; transpose_item8(F.in[22], 2048, kb * 64, nb * 32, WSP(unsigned char, WS_WGLU), 512, pair_row(nb * 32), scr, F.lane); continue; } r -= I_GLU;
        { const int mat = r >> 3, kb = (r >> 2) & 1, nb = r & 3, hd = mat & 7, gx = mat >> 3;
          transpose_item(F.in[gx ? 10 : 8] + (size_t)hd * 128 * 128, 128, kb * 64, nb * 32, WSP(bf16, WS_WG), 128, hd * 256 + gx * 128 + nb * 32, scr, F.lane); }
    }
}
__device__ __forceinline__ void p1_body(Frame& F) {
    const int gw = F.vcu * 8 + F.wave, NGW = F.G * 8; const float* mod = WSP(float, WS_MOD); bf16* hbf = WSP(bf16, WS_HBF);
    for (int tb = gw; tb < T; tb += 4 * NGW) {
        f32x4 xv[4][4];
#pragma unroll
        for (int r = 0; r < 4; ++r) { const int t = tb + r * NGW; const f32x4* xr = (const f32x4*)(F.in[0] + (size_t)(t < T ? t : 0) * 1024) + F.lane;
#pragma unroll
            for (int j = 0; j < 4; ++j) xv[r][j] = xr[64 * j]; }
#pragma unroll
        for (int r = 0; r < 4; ++r) { const int t = tb + r * NGW; if (t < T) { const int b = t >> 12; const f32x4* sh = (const f32x4*)(mod + b * 6144) + F.lane; const f32x4* sc = (const f32x4*)(mod + b * 6144 + 1024) + F.lane;
            unsigned* o = (unsigned*)((unsigned char*)hbf + (size_t)t * 1024) + F.lane;
#pragma unroll
            for (int j = 0; j < 4; ++j) { const f32x4 v = xv[r][j] * (sc[64 * j] + 1.0f) + sh[64 * j]; o[64 * j] = pk4_fp8(v[0], v[1], v[2], v[3]); } } } }
    constexpr int TP = 132;
    LAS float* tile = (LAS float*)F.lds;
    constexpr int TILES_GU = 8 * 16, TILES_D = 8 * 8, TILES_E = TILES_GU + TILES_D;
    const int lr = F.tid >> 5, lc4 = (F.tid & 31) * 4, tn = F.tid >> 2, kc = F.tid & 3;
    f32x4 pre[8];
    int ti = F.vcu;
#define P1_SRC(idx, src, N_, dstp, drow0_, k0_) do { const int e_ = (idx) / TILES_E, r_ = (idx) % TILES_E; \
        if (r_ < TILES_GU) { const int kb_ = r_ >> 4, nb_ = r_ & 15; N_ = 2048; src = F.in[28] + (size_t)e_ * 1024 * 2048 + (size_t)(kb_ * 128) * 2048 + nb_ * 128; dstp = WSP(unsigned char, WS_WGU) + (size_t)e_ * 2048 * 1024; drow0_ = pair_row(nb_ * 128); k0_ = kb_ * 128; } \
        else { const int q_ = r_ - TILES_GU, kb_ = q_ >> 3, nb_ = q_ & 7; N_ = 1024; src = F.in[30] + (size_t)e_ * 1024 * 1024 + (size_t)(kb_ * 128) * 1024 + nb_ * 128; dstp = WSP(unsigned char, WS_WD) + (size_t)e_ * 1024 * 1024; drow0_ = nb_ * 128; k0_ = kb_ * 128; } } while (0)
    if (ti < NE * TILES_E) { const float* src; unsigned char* dstp; int N_, d0, k0; P1_SRC(ti, src, N_, dstp, d0, k0);
#pragma unroll
        for (int i = 0; i < 8; ++i) pre[i] = *(const f32x4*)(src + (size_t)(lr + 16 * i) * N_ + lc4); }
    for (; ti < NE * TILES_E; ti += F.G) {
#pragma unroll
        for (int i = 0; i < 8; ++i) *(LAS f32x4*)(tile + (lr + 16 * i) * TP + lc4) = pre[i];
        __syncthreads();
        const int tnx = ti + F.G;
        if (tnx < NE * TILES_E) { const float* src; unsigned char* dstp; int N_, d0, k0; P1_SRC(tnx, src, N_, dstp, d0, k0);
#pragma unroll
            for (int i = 0; i < 8; ++i) pre[i] = *(const f32x4*)(src + (size_t)(lr + 16 * i) * N_ + lc4); }
        { const float* src; unsigned char* dstp; int N_, d0, k0; P1_SRC(ti, src, N_, dstp, d0, k0); (void)src; (void)N_;
          const LAS float* cp = tile + (32 * kc) * TP + tn; u32x4 o0, o1;
          o0.x = pk4_fp8(32.f * cp[0 * TP], 32.f * cp[1 * TP], 32.f * cp[2 * TP], 32.f * cp[3 * TP]); o0.y = pk4_fp8(32.f * cp[4 * TP], 32.f * cp[5 * TP], 32.f * cp[6 * TP], 32.f * cp[7 * TP]);
          o0.z = pk4_fp8(32.f * cp[8 * TP], 32.f * cp[9 * TP], 32.f * cp[10 * TP], 32.f * cp[11 * TP]); o0.w = pk4_fp8(32.f * cp[12 * TP], 32.f * cp[13 * TP], 32.f * cp[14 * TP], 32.f * cp[15 * TP]);
          o1.x = pk4_fp8(32.f * cp[16 * TP], 32.f * cp[17 * TP], 32.f * cp[18 * TP], 32.f * cp[19 * TP]); o1.y = pk4_fp8(32.f * cp[20 * TP], 32.f * cp[21 * TP], 32.f * cp[22 * TP], 32.f * cp[23 * TP]);
          o1.z = pk4_fp8(32.f * cp[24 * TP], 32.f * cp[25 * TP], 32.f * cp[26 * TP], 32.f * cp[27 * TP]); o1.w = pk4_fp8(32.f * cp[28 * TP], 32.f * cp[29 * TP], 32.f * cp[30 * TP], 32.f * cp[31 * TP]);
          unsigned char* op = dstp + (size_t)(d0 + tn) * 1024 + k0 + 32 * kc; *(u32x4*)op = o0; *(u32x4*)(op + 16) = o1; }
        __syncthreads();
    }
#undef P1_SRC
}
constexpr int XR_LD = 136, XR_TILE = 128 * XR_LD;
__device__ __forceinline__ void rg_issue(const bf16* xrnn, const bf16* gy, int item, int tid, u32x4 (&xraw)[4][4], u32x4 (&graw)[4], bool pass1) {
    const int hd = item & 7, c = (item >> 3) & 31, b = item >> 8, r0 = tid >> 4, ch = hd * 128 + (tid & 15) * 8;
#pragma unroll
    for (int q = 0; q < 4; ++q) { const int r = r0 + 32 * q;
#pragma unroll
        for (int k = 0; k < 4; ++k) { const int tp = c * RGL + r - 3 + k, tpc = tp < 0 ? 0 : tp; xraw[q][k] = *(const u32x4*)(xrnn + (size_t)(b * SEQ + tpc) * 1024 + ch); }
        if (pass1) graw[q] = *(const u32x4*)(gy + (size_t)(b * SEQ + c * RGL + r) * 1024 + ch); }
}
__device__ __forceinline__ void rg_convwrite(const float* cw, const float* cb, int item, int tid, const u32x4 (&xraw)[4][4], const u32x4 (&graw)[4], LAS bf16* xr, LAS bf16* gyt, bool pass1) {
    const int hd = item & 7, c = (item >> 3) & 31, r0 = tid >> 4, c8 = (tid & 15) * 8, ch = hd * 128 + c8;
    const f32x4 b0 = *(const f32x4*)(cb + ch), b1 = *(const f32x4*)(cb + ch + 4);
    f32x4 w0[4], w1[4];
#pragma unroll
    for (int k = 0; k < 4; ++k) { w0[k] = *(const f32x4*)(cw + k * 1024 + ch); w1[k] = *(const f32x4*)(cw + k * 1024 + ch + 4); }
#pragma unroll
    for (int q = 0; q < 4; ++q) { const int r = r0 + 32 * q; f32x4 a0 = b0, a1 = b1;
#pragma unroll
        for (int k = 0; k < 4; ++k) { const int tp = c * RGL + r - 3 + k; f32x4 x0, x1; unpack8(xraw[q][k], x0, x1); if (tp < 0) { x0 = (f32x4){0.f, 0.f, 0.f, 0.f}; x1 = x0; } a0 += w0[k] * x0; a1 += w1[k] * x1; }
        *(LAS u32x4*)(xr + r * XR_LD + c8) = pack8(a0, a1);
        if (pass1) *(LAS u32x4*)(gyt + r * XR_LD + c8) = graw[q]; }
}
template <int PASS>
__device__ __forceinline__ void rglru_phase(Frame& F) {
    const int NIT = NB * RGC * 8;
    const bool skew = (PASS == 0) && (F.G == 256);
    const int nmine = skew ? (F.vcu < 128 ? 7 : 9) : (NIT - F.vcu + F.G - 1) / F.G;
#define RG_ITEM(k) ((skew && (k) >= 7) ? (1792 + (F.vcu - 128) + 128 * ((k) - 7)) : (F.vcu + (k) * F.G))
    if (nmine <= 0) return;
    int it = RG_ITEM(0);
    LAS bf16* xr = (LAS bf16*)F.lds; LAS bf16* gyt0 = xr + XR_TILE;
    const bf16* xrnn = WSP(bf16, WS_XRNN); const bf16* gy = WSP(bf16, WS_GY); bf16* ha = WSP(bf16, WS_HA); const float* cw = F.in[6]; const float* cb = F.in[7];
    const int tid = F.tid, w = F.wave, q = F.lane >> 4, col = F.lane & 15, chl = 16 * w + col;
    u32x4 xraw[4][4], graw[4];
    rg_issue(xrnn, gy, it, tid, xraw, graw, PASS);
    rg_convwrite(cw, cb, it, tid, xraw, graw, xr, gyt0, PASS);
    int hd_loaded = -1; bf16x8 Bf[2][4]; float ba = 0.f, bx = 0.f, sp = 0.f;
    __syncthreads();
    for (int i = 0; i < nmine; ++i) {
        const bool has_next = (i + 1) < nmine; const int nit = has_next ? RG_ITEM(i + 1) : it;
        const int hd = it & 7, c = (it >> 3) & 31, b = it >> 8, t0 = b * SEQ + c * RGL, ch = hd * 128 + chl;
        LAS bf16* gyt = gyt0 + (i & 1) * XR_TILE; LAS bf16* gytn = gyt0 + ((i & 1) ^ 1) * XR_TILE;
        if (has_next) rg_issue(xrnn, gy, nit, tid, xraw, graw, PASS);
        if (hd != hd_loaded) { hd_loaded = hd; const bf16* wg = WSP(bf16, WS_WG) + (size_t)hd * 256 * 128;
#pragma unroll
            for (int gt = 0; gt < 2; ++gt)
#pragma unroll
                for (int kk = 0; kk < 4; ++kk) Bf[gt][kk] = *(const bf16x8*)(wg + (size_t)(gt * 128 + chl) * 128 + kk * 32 + q * 8);
            ba = F.in[9][ch]; bx = F.in[11][ch]; const float lam = F.in[12][ch]; sp = (lam > 15.f) ? __expf(-lam) : log1pf(__expf(-lam)); }
        float carryH = 0.f, carryP = 1.f;
        if (PASS) carryH = WSP(float, WS_HIN)[(size_t)(b * RGC + c) * 1024 + ch];
        __builtin_amdgcn_sched_barrier(0);
        f32x4 acc[8][2];
#pragma unroll
        for (int m = 0; m < 8; ++m) { acc[m][0] = (f32x4){0.f, 0.f, 0.f, 0.f}; acc[m][1] = (f32x4){0.f, 0.f, 0.f, 0.f}; }
#pragma unroll
        for (int kk = 0; kk < 4; ++kk)
#pragma unroll
            for (int m = 0; m < 8; ++m) { const bf16x8 Af = *(const LAS bf16x8*)(xr + (16 * m + col) * XR_LD + kk * 32 + q * 8);
                acc[m][0] = __builtin_amdgcn_mfma_f32_16x16x32_bf16(Af, Bf[0][kk], acc[m][0], 0, 0, 0);
                acc[m][1] = __builtin_amdgcn_mfma_f32_16x16x32_bf16(Af, Bf[1][kk], acc[m][1], 0, 0, 0); }
#pragma unroll
        for (int m = 0; m < 8; ++m) {
            float a[4], uu[4];
#pragma unroll
            for (int j = 0; j < 4; ++j) { const int tl = 16 * m + 4 * q + j;
                const float r = fast_sigmoid(acc[m][0][j] + ba), ii = fast_sigmoid(acc[m][1][j] + bx);
                const float la = -11.541560327f * r * sp; a[j] = __builtin_amdgcn_exp2f(la); const float mult = __builtin_amdgcn_sqrtf(fmaxf(1.0f - a[j] * a[j], 0.f));
                uu[j] = mult * ii * bf1(xr[tl * XR_LD + chl]); }
            float sP = a[0], sH = uu[0];
#pragma unroll
            for (int j = 1; j < 4; ++j) { sH = a[j] * sH + uu[j]; sP *= a[j]; }
            float iP = sP, iH = sH;
            { const float pP = __shfl_up(iP, 16), pH = __shfl_up(iH, 16); if (q >= 1) { iH = iP * pH + iH; iP = iP * pP; } }
            { const float pP = __shfl_up(iP, 32), pH = __shfl_up(iH, 32); if (q >= 2) { iH = iP * pH + iH; iP = iP * pP; } }
            float eP = __shfl_up(iP, 16), eH = __shfl_up(iH, 16); if (q == 0) { eP = 1.f; eH = 0.f; }
            const float tP = __shfl(iP, col + 48), tH = __shfl(iH, col + 48);
            if (PASS) { float h = eP * carryH + eH;
#pragma unroll
                for (int j = 0; j < 4; ++j) { const int tl = 16 * m + 4 * q + j; h = a[j] * h + uu[j]; LAS bf16* gp = gyt + tl * XR_LD + chl; *gp = (bf16)f2bf(h * bf1(*gp)); } }
            carryH = tP * carryH + tH; carryP *= tP;
        }
        if (!PASS && q == 0) { f32x2* ag = WSP(f32x2, WS_RGAGG); ag[(size_t)(b * RGC + c) * 1024 + ch] = (f32x2){carryP, carryH}; }
        __syncthreads();
        if (PASS) { const int r0 = tid >> 4, c8 = (tid & 15) * 8;
#pragma unroll
            for (int qq = 0; qq < 4; ++qq) { const int r = r0 + 32 * qq; f32x4 h0, h1; unpack8(*(const LAS u32x4*)(gyt + r * XR_LD + c8), h0, h1); u32x2 w8; w8.x = pk4_fp8(h0[0], h0[1], h0[2], h0[3]); w8.y = pk4_fp8(h1[0], h1[1], h1[2], h1[3]);
                *(u32x2*)((unsigned char*)ha + (size_t)(t0 + r) * 1024 + hd * 128 + c8) = w8; } }
        if (has_next) rg_convwrite(cw, cb, nit, tid, xraw, graw, xr, gytn, PASS);
        __syncthreads();
        it = nit;
    }
#undef RG_ITEM
}
__device__ __forceinline__ void p4_carries(Frame& F) {
    LAS f32x2* seg = (LAS f32x2*)F.lds;
    for (int job = F.vcu; job < NB * S5G; job += F.G) {
        const int b = job >> 5, g = job & 31, p = F.lane, w = F.wave;
        const f32x2 al = WSP(f32x2, WS_AL)[g * 64 + p];
        const f32x2* Sb = WSP(f32x2, WS_S) + ((size_t)(g * S5M + b * S5CPB + 16 * w)) * 64 + p; unsigned* ac = (unsigned*)(WSP(bf16, WS_ACAT) + ((size_t)(g * S5M + b * S5CPB + 16 * w)) * S5ROW) + p;
        f32x2 sv[16];
#pragma unroll
        for (int i = 0; i < 16; ++i) sv[i] = Sb[(size_t)i * 64];
        float xr_ = 0.f, xi = 0.f;
#pragma unroll
        for (int i = 0; i < 16; ++i) { const float nr = al.x * xr_ - al.y * xi + sv[i].x, ni = al.x * xi + al.y * xr_ + sv[i].y; xr_ = nr; xi = ni; }
        seg[w * 64 + p] = (f32x2){xr_, xi};
        float ar = al.x, ai = al.y;
#pragma unroll
        for (int q = 0; q < 4; ++q) { const float nr = ar * ar - ai * ai, ni = 2.f * ar * ai; ar = nr; ai = ni; }
        __syncthreads();
        xr_ = 0.f; xi = 0.f;
        for (int ww = 0; ww < w; ++ww) { const f32x2 sg = seg[ww * 64 + p]; const float nr = ar * xr_ - ai * xi + sg.x, ni = ar * xi + ai * xr_ + sg.y; xr_ = nr; xi = ni; }
#pragma unroll
        for (int i = 0; i < 16; ++i) { ac[(size_t)i * (S5ROW / 2)] = pk2(xr_, xi); const float nr = al.x * xr_ - al.y * xi + sv[i].x, ni = al.x * xi + al.y * xr_ + sv[i].y; xr_ = nr; xi = ni; }
        __syncthreads();
    }
    if (F.vcu < 16) {
        const int id = F.vcu * 512 + F.tid, ch = id & 1023, b = id >> 10; const f32x2* ag = WSP(f32x2, WS_RGAGG) + (size_t)b * RGC * 1024 + ch; float* hin = WSP(float, WS_HIN) + (size_t)b * RGC * 1024 + ch;
        f32x2 a[RGC];
#pragma unroll
        for (int c = 0; c < RGC; ++c) a[c] = ag[(size_t)c * 1024];
        float h = 0.f;
#pragma unroll
        for (int c = 0; c < RGC; ++c) { hin[(size_t)c * 1024] = h; h = a[c].x * h + a[c].y; }
    }
}
constexpr int WR_LD = 1032;
__device__ __forceinline__ void p9_router(Frame& F) {
    LAS bf16* wH = (LAS bf16*)F.lds; LAS bf16* wL = wH + 32 * WR_LD;
    LAS f32x2* sel = (LAS f32x2*)(wL + 32 * WR_LD);
    LAS unsigned* rec = (LAS unsigned*)(sel + 512);
    LAS float* recp = (LAS float*)(rec + 512);
    LAS int* lcnt = (LAS int*)(recp + 512);
    LAS int* gbase = lcnt + 32;
    { const u32x4* img = WSP(u32x4, WS_WRIMG); LAS u32x4* dst = (LAS u32x4*)wH;
      for (int i = F.tid; i < 2 * 32 * WR_LD * 2 / 16; i += 512) dst[i] = img[i]; }
    if (F.tid < 32) lcnt[F.tid] = 0;
    __syncthreads();
    const float* mod = WSP(float, WS_MOD); const bf16* v1 = WSP(bf16, WS_V1); bf16* x1 = WSP(bf16, WS_X1); unsigned char* h2 = WSP(unsigned char, WS_H2);
    const int lane = F.lane, m = lane & 15, kq = lane >> 4, w = F.wave;
    for (int blk = F.vcu; blk < T / 128; blk += F.G) {
        const int t = blk * 128 + w * 16 + m, b = (blk * 128) >> 12;
        const bf16* vrow = v1 + (size_t)t * 1024 + 8 * kq;
        float sum = 0.f, sq = 0.f;
#pragma unroll 32
        for (int s_ = 0; s_ < 32; ++s_) { f32x4 a, c; unpack8(*(const u32x4*)(vrow + 32 * s_), a, c); sum += ((a[0] + a[1]) + (a[2] + a[3])) + ((c[0] + c[1]) + (c[2] + c[3]));
            sq += ((a[0] * a[0] + a[1] * a[1]) + (a[2] * a[2] + a[3] * a[3])) + ((c[0] * c[0] + c[1] * c[1]) + (c[2] * c[2] + c[3] * c[3])); }
        sum += __shfl_xor(sum, 16); sum += __shfl_xor(sum, 32); sq += __shfl_xor(sq, 16); sq += __shfl_xor(sq, 32);
        const float mean = sum * (1.f / 1024.f); const float rstd = 1.f / sqrtf(fmaxf(sq * (1.f / 1024.f) - mean * mean, 0.f) + LN_EPS);
        f32x4 acc[2] = {(f32x4){0.f, 0.f, 0.f, 0.f}, (f32x4){0.f, 0.f, 0.f, 0.f}};
        const float* lng = F.in[24] + 8 * kq; const float* lnb = F.in[25] + 8 * kq; const float* shp = mod + b * 6144 + 3072 + 8 * kq; const float* scp = mod + b * 6144 + 4096 + 8 * kq;
        bf16* x1row = x1 + (size_t)t * 1024 + 8 * kq; unsigned char* h2row = h2 + (size_t)t * 1024 + 8 * kq;
        const LAS bf16* wHr = wH + m * WR_LD + 8 * kq; const LAS bf16* wLr = wL + m * WR_LD + 8 * kq;
#pragma unroll 4
        for (int s_ = 0; s_ < 32; ++s_) { const int ko = 32 * s_;
            f32x4 a, c; unpack8(*(const u32x4*)(vrow + ko), a, c);
            const f32x4 g0 = *(const f32x4*)(lng + ko), g1 = *(const f32x4*)(lng + ko + 4), b0 = *(const f32x4*)(lnb + ko), b1 = *(const f32x4*)(lnb + ko + 4);
            const f32x4 x0 = (a - mean) * rstd * g0 + b0, x1v = (c - mean) * rstd * g1 + b1;
            *(u32x4*)(x1row + ko) = pack8(x0, x1v);
            const f32x4 sh0 = *(const f32x4*)(shp + ko), sh1 = *(const f32x4*)(shp + ko + 4), sc0 = *(const f32x4*)(scp + ko), sc1 = *(const f32x4*)(scp + ko + 4);
            const f32x4 h0 = x0 * (sc0 + 1.0f) + sh0, h1 = x1v * (sc1 + 1.0f) + sh1;
            u32x2 w8; w8.x = pk4_fp8(h0[0], h0[1], h0[2], h0[3]); w8.y = pk4_fp8(h1[0], h1[1], h1[2], h1[3]); *(u32x2*)(h2row + ko) = w8;
            const u32x4 hi = pack8(h0, h1); f32x4 r0, r1; unpack8(hi, r0, r1); const u32x4 lo = pack8(h0 - r0, h1 - r1);
            const bf16x8 ah = __builtin_bit_cast(bf16x8, hi), al = __builtin_bit_cast(bf16x8, lo);
#pragma unroll
            for (int nf = 0; nf < 2; ++nf) { const bf16x8 bh = *(const LAS bf16x8*)(wHr + nf * 16 * WR_LD + ko), bl = *(const LAS bf16x8*)(wLr + nf * 16 * WR_LD + ko);
                acc[nf] = __builtin_amdgcn_mfma_f32_16x16x32_bf16(bh, ah, acc[nf], 0, 0, 0);
                acc[nf] = __builtin_amdgcn_mfma_f32_16x16x32_bf16(bl, ah, acc[nf], 0, 0, 0);
                acc[nf] = __builtin_amdgcn_mfma_f32_16x16x32_bf16(bh, al, acc[nf], 0, 0, 0); } }
        float lv[8];
#pragma unroll
        for (int nf = 0; nf < 2; ++nf)
#pragma unroll
            for (int j = 0; j < 4; ++j) lv[nf * 4 + j] = acc[nf][j] + F.in[27][nf * 16 + 4 * kq + j];
        int rank[8];
#pragma unroll
        for (int i = 0; i < 8; ++i) { rank[i] = 0;
#pragma unroll
            for (int i2 = 0; i2 < 8; ++i2) if (i2 != i) { const int e1 = (i >> 2) * 16 + 4 * kq + (i & 3), e2 = (i2 >> 2) * 16 + 4 * kq + (i2 & 3); rank[i] += (lv[i2] > lv[i] || (lv[i2] == lv[i] && e2 < e1)) ? 1 : 0; } }
#pragma unroll
        for (int dq = 1; dq < 4; ++dq) { const int q2 = kq ^ dq;
#pragma unroll
            for (int i2 = 0; i2 < 8; ++i2) { const float o = __shfl_xor(lv[i2], 16 * dq); const int e2 = (i2 >> 2) * 16 + 4 * q2 + (i2 & 3);
#pragma unroll
                for (int i = 0; i < 8; ++i) { const int e1 = (i >> 2) * 16 + 4 * kq + (i & 3); rank[i] += (o > lv[i] || (o == lv[i] && e2 < e1)) ? 1 : 0; } } }
#pragma unroll
        for (int i = 0; i < 8; ++i) if (rank[i] < 4) { const int e1 = (i >> 2) * 16 + 4 * kq + (i & 3); sel[(w * 16 + m) * 4 + rank[i]] = (f32x2){__builtin_bit_cast(float, e1), lv[i]}; }
        asm volatile("s_waitcnt lgkmcnt(0)" ::: "memory");
        { const int tm = lane >> 2, k = lane & 3; const f32x2 s0 = sel[(w * 16 + tm) * 4 + 0], s1 = sel[(w * 16 + tm) * 4 + 1], s2 = sel[(w * 16 + tm) * 4 + 2], s3 = sel[(w * 16 + tm) * 4 + 3];
          const float p0 = 1.f, p1 = __expf(s1.y - s0.y), p2 = __expf(s2.y - s0.y), p3 = __expf(s3.y - s0.y), ps = (p0 + p1) + (p2 + p3);
          const f32x2 mine = k == 0 ? s0 : (k == 1 ? s1 : (k == 2 ? s2 : s3)); const float pm = (k == 0 ? p0 : (k == 1 ? p1 : (k == 2 ? p2 : p3))) / ps;
          const int e = __builtin_bit_cast(int, mine.x);
          const int lr = __hip_atomic_fetch_add(lcnt + e, 1, __ATOMIC_RELAXED, __HIP_MEMORY_SCOPE_WORKGROUP);
          rec[(w * 16 + tm) * 4 + k] = ((unsigned)e << 16) | (unsigned)lr; recp[(w * 16 + tm) * 4 + k] = pm; }
        __syncthreads();
        if (F.tid < 32) { const int n = lcnt[F.tid]; gbase[F.tid] = n ? (int)atomicAdd(F.ctl + CW_CNT + 64 * F.tid, (unsigned)n) : 0; lcnt[F.tid] = 0; }
        __syncthreads();
        { const unsigned r = rec[F.tid]; const int e = r >> 16, rk = gbase[e] + (int)(r & 0xffffu), tt = blk * 128 + (F.tid >> 2);
          WSP(int, WS_TOK)[(size_t)e * T + rk] = tt; WSP(unsigned, WS_POS)[(size_t)tt * 4 + (F.tid & 3)] = ((unsigned)e << 20) | (unsigned)rk; WSP(float, WS_PROB)[(size_t)tt * 4 + (F.tid & 3)] = recp[F.tid]; }
        __syncthreads();
    }
}
__device__ __forceinline__ void p12_final(Frame& F) {
    moe_tables(F);
    const LAS int* tstart = (const LAS int*)(F.lds + TAB_OFF);
    const float* mod = WSP(float, WS_MOD); const bf16* x1 = WSP(bf16, WS_X1); const bf16* yb = WSP(bf16, WS_YB); const unsigned* pos = WSP(unsigned, WS_POS); const float* prob = WSP(float, WS_PROB);
    const int lane = F.lane, gw = F.vcu * 8 + F.wave, NGW = F.G * 8;
    f32x4 lg[4], lb[4];
#pragma unroll
    for (int j = 0; j < 4; ++j) { lg[j] = *(const f32x4*)(F.in[32] + 512 * (j >> 1) + 8 * lane + 4 * (j & 1)); lb[j] = *(const f32x4*)(F.in[33] + 512 * (j >> 1) + 8 * lane + 4 * (j & 1)); }
#define P12_ROUTE(PP, PW, tt) do { const u32x4 p4_ = *(const u32x4*)(pos + (size_t)(tt) * 4); const f32x4 w4_ = *(const f32x4*)(prob + (size_t)(tt) * 4); \
        PP[0] = p4_.x; PP[1] = p4_.y; PP[2] = p4_.z; PP[3] = p4_.w; PW[0] = w4_[0]; PW[1] = w4_[1]; PW[2] = w4_[2]; PW[3] = w4_[3]; } while (0)
#define P12_ROWS(YW, XW, PP, tt) do { _Pragma("unroll") for (int k = 0; k < 4; ++k) { const int e_ = PP[k] >> 20, rk_ = PP[k] & 0xfffffu; const size_t slot_ = (size_t)tstart[e_] * 256 + rk_; \
            _Pragma("unroll") for (int j = 0; j < 2; ++j) YW[k][j] = *((const u32x2*)((const unsigned char*)yb + slot_ * 1024) + 64 * j + lane); } \
        _Pragma("unroll") for (int j = 0; j < 2; ++j) XW[j] = *((const u32x4*)(x1 + (size_t)(tt) * 1024) + 64 * j + lane); } while (0)
#define P12_COMPUTE(YW, XW, PW, tt) do { const int b_ = (tt) >> 12; f32x4 v[4]; float s_ = 0.f; \
        _Pragma("unroll") for (int j = 0; j < 2; ++j) { f32x4 f0 = (f32x4){0.f, 0.f, 0.f, 0.f}, f1 = f0; \
            _Pragma("unroll") for (int k = 0; k < 4; ++k) { const u32x2 yv_ = YW[k][j]; const f32x2 q0_ = __builtin_amdgcn_cvt_pk_f32_fp8((int)yv_.x, false), q1_ = __builtin_amdgcn_cvt_pk_f32_fp8((int)yv_.x, true), q2_ = __builtin_amdgcn_cvt_pk_f32_fp8((int)yv_.y, false), q3_ = __builtin_amdgcn_cvt_pk_f32_fp8((int)yv_.y, true); \
                f0 += (f32x4){q0_.x, q0_.y, q1_.x, q1_.y} * PW[k]; f1 += (f32x4){q2_.x, q2_.y, q3_.x, q3_.y} * PW[k]; } \
            f32x4 xa_, xc_; unpack8(XW[j], xa_, xc_); const float* gp_ = mod + b_ * 6144 + 5120 + 512 * j + 8 * lane; \
            v[2 * j] = xa_ * DN_ALPHA + (*(const f32x4*)gp_ + 1.0f) * f0; v[2 * j + 1] = xc_ * DN_ALPHA + (*(const f32x4*)(gp_ + 4) + 1.0f) * f1; \
            s_ += ((v[2 * j][0] + v[2 * j][1]) + (v[2 * j][2] + v[2 * j][3])) + ((v[2 * j + 1][0] + v[2 * j + 1][1]) + (v[2 * j + 1][2] + v[2 * j + 1][3])); } \
        const float mean_ = wave_sum(s_) * (1.f / 1024.f); float s2_ = 0.f; \
        _Pragma("unroll") for (int j = 0; j < 4; ++j) { v[j] = v[j] - mean_; s2_ += (v[j][0] * v[j][0] + v[j][1] * v[j][1]) + (v[j][2] * v[j][2] + v[j][3] * v[j][3]); } \
        const float rstd_ = 1.f / sqrtf(wave_sum(s2_) * (1.f / 1024.f) + LN_EPS); \
        _Pragma("unroll") for (int j = 0; j < 4; ++j) *(f32x4*)(F.out + (size_t)(tt) * 1024 + 512 * (j >> 1) + 8 * lane + 4 * (j & 1)) = v[j] * rstd_ * lg[j] + lb[j]; } while (0)
    const int nmine = (T - gw + NGW - 1) / NGW;
    unsigned ppA[4], ppB[4]; float pwA[4], pwB[4], pwN[4]; u32x2 ywA[4][2], ywB[4][2]; u32x4 xwA[2], xwB[2];
    if (nmine > 0) { P12_ROUTE(ppA, pwA, gw); P12_ROWS(ywA, xwA, ppA, gw); }
    if (nmine > 1) { P12_ROUTE(ppB, pwB, gw + NGW); }
    for (int i = 0; i < nmine; i += 2) {
        const int t0 = gw + i * NGW, t1 = t0 + NGW, t2 = t1 + NGW, t3 = t2 + NGW;
        if (i + 1 < nmine) { P12_ROWS(ywB, xwB, ppB, t1); }
        if (i + 2 < nmine) { P12_ROUTE(ppA, pwN, t2); }
        __builtin_amdgcn_sched_barrier(0);
        P12_COMPUTE(ywA, xwA, pwA, t0);
        if (i + 1 < nmine) {
#pragma unroll
            for (int k = 0; k < 4; ++k) pwA[k] = pwN[k];
            if (i + 2 < nmine) { P12_ROWS(ywA, xwA, ppA, t2); }
            if (i + 3 < nmine) { P12_ROUTE(ppB, pwN, t3); }
            __builtin_amdgcn_sched_barrier(0);
            P12_COMPUTE(ywB, xwB, pwB, t1);
#pragma unroll
            for (int k = 0; k < 4; ++k) pwB[k] = pwN[k];
        }
    }
#undef P12_ROUTE
#undef P12_ROWS
#undef P12_COMPUTE
}

struct Args { const float* in[34]; float* out; unsigned char* ws; int ph_lo, ph_hi; };
__global__ void __launch_bounds__(512, 2) fwd_kernel(Args args) {
    extern __shared__ __attribute__((aligned(16))) unsigned char lds_raw[];
    Frame F;
    F.lds = (LAS unsigned char*)lds_raw; F.MISC = (volatile LAS unsigned*)(F.lds + MISC_OFF);
    F.tid = threadIdx.x; F.lane = F.tid & 63; F.wave = __builtin_amdgcn_readfirstlane(F.tid >> 6);
    F.G = gridDim.x; { const int bx = blockIdx.x; F.vcu = (F.G % 8 == 0) ? (bx % 8) * (F.G / 8) + bx / 8 : bx; }
#pragma unroll
    for (int i = 0; i < 34; ++i) F.in[i] = args.in[i];
    F.out = args.out; F.ws = args.ws; F.ctl = (unsigned*)(args.ws + WS_CTL);
    if (F.tid < 64) F.MISC[F.tid] = 0u;
    __syncthreads();
    XcdBarrier bar; bar.bar = F.ctl + CW_BAR; bar.x = 0; bar.st = nullptr;
    if (MK_N_LAUNCHES == 1) bar = xcd_barrier_post(F.ctl + CW_BAR, F.MISC + 8);
    const int lo = args.ph_lo, hi = args.ph_hi;
#define IN(k) (lo <= (k) && (k) < hi)
#define SEAM(k) do { if (IN(k) && IN((k) + 1)) xcd_barrier(bar); } while (0)

    if (IN(0)) REPS(0) { if (rep_) xcd_barrier(bar);
        for (int j = F.vcu; j < 192; j += F.G) p0_mod_job(F, j);
        for (int j = F.vcu; j < S5G * 8; j += F.G) p0_s5k_job(F, j);
        { bf16* img = WSP(bf16, WS_WRIMG); const float* wr = F.in[26];
          for (int i = F.vcu * 512 + F.tid; i < 1024 * 32; i += F.G * 512) { const float w = wr[i]; const unsigned hb = f2bf(w); const float hf = __builtin_bit_cast(float, hb << 16);
              img[(i & 31) * 1032 + (i >> 5)] = (bf16)hb; img[32 * 1032 + (i & 31) * 1032 + (i >> 5)] = (bf16)f2bf(w - hf); } }
        p0_small_transposes(F);
    }
    SEAM(0);
    if (IN(1)) REPS(1) { if (rep_) xcd_barrier(bar); for (int j = F.vcu; j < S5G * 8; j += F.G) p1_s5w_job(F, j); p1_body(F); }
    SEAM(1);
    if (IN(2)) REPS(2) { if (rep_) xcd_barrier(bar);
        g8::GridOrder S; S.init(T, INC, F.G, (int)blockIdx.x, WSP(bf16, WS_HBF), WSP(bf16, WS_WIN), 1024, 1024);
        EpiInProj E{F.in[5], WSP(bf16, WS_XRNN), WSP(bf16, WS_GY), WSP(bf16, WS_ACAT), WSP(bf16, WS_GATES)};
        g8::gemm_phase<EpiInProj, g8::GridOrder, false, true>(F.lds, 1024, 1024, 1024, S, E);
    }
    SEAM(2);
    if (IN(3)) REPS(3) { if (rep_) xcd_barrier(bar);
        { S5AOrder S{F.G, F.vcu, (const char*)WSP(bf16, WS_ACAT), (const char*)WSP(bf16, WS_WS)}; EpiS5A E{WSP(float, WS_S)};
          g8::gemm_phase<EpiS5A, S5AOrder, false>(F.lds, S5L * 32, S5ROW * 2, S5L * 32, S, E); }
        __syncthreads();
        rglru_phase<0>(F);
    }
    SEAM(3);
    if (IN(4)) REPS(4) { if (rep_) xcd_barrier(bar); p4_carries(F); }
    SEAM(4);
    if (IN(5)) REPS(5) { if (rep_) xcd_barrier(bar);
        { S5COrder S{F.G, F.vcu, (const char*)WSP(bf16, WS_ACAT), (const char*)WSP(bf16, WS_WY)}; EpiS5C E{WSP(bf16, WS_YS)};
          g8::gemm_phase<EpiS5C, S5COrder, false>(F.lds, S5ROW * 2, S5ROW * 2, S5ROW * 2, S, E); }
        __syncthreads();
        rglru_phase<1>(F);
    }
    SEAM(5);
    if (IN(6)) REPS(6) { if (rep_) xcd_barrier(bar);
        g8::GridOrder S; S.init(T, 2048, F.G, (int)blockIdx.x, WSP(bf16, WS_YS), WSP(bf16, WS_WGLU), 512, 512);
        EpiGlu E{WSP(bf16, WS_GATES), WSP(bf16, WS_GB)};
        g8::gemm_phase<EpiGlu, g8::GridOrder, false, true>(F.lds, 512, 512, 512, S, E);
    }
    SEAM(6);
    if (IN(7)) REPS(7) { if (rep_) xcd_barrier(bar);
        g8::GridOrder S; S.init(T, 1024, F.G, (int)blockIdx.x, WSP(bf16, WS_HA), WSP(bf16, WS_WRNN), 1024, 1024);
        EpiRnn E{WSP(bf16, WS_GATES), WSP(bf16, WS_GB), WSP(bf16, WS_MERGED)};
        g8::gemm_phase<EpiRnn, g8::GridOrder, false, true>(F.lds, 1024, 1024, 1024, S, E);
    }
    SEAM(7);
    if (IN(8)) REPS(8) { if (rep_) xcd_barrier(bar);
        g8::GridOrder S; S.init(T, 1024, F.G, (int)blockIdx.x, WSP(bf16, WS_MERGED), WSP(bf16, WS_WOUT), 1024, 1024);
        EpiOut E{F.in[0], WSP(float, WS_MOD), WSP(bf16, WS_V1)};
        g8::gemm_phase<EpiOut, g8::GridOrder, false, true>(F.lds, 1024, 1024, 1024, S, E);
    }
    SEAM(8);
    if (IN(9)) REPS(9) { if (rep_) xcd_barrier(bar); p9_router(F); }
    SEAM(9);
    if (IN(10)) REPS(10) { if (rep_) xcd_barrier(bar);
        moe_tables(F);
        const LAS int* tstart = (const LAS int*)(F.lds + TAB_OFF);
        MoeOrder S{F.G, (int)blockIdx.x, 8, tstart[NE], tstart, tstart + 40, WSP(int, WS_TOK), (const char*)WSP(bf16, WS_H2), (const char*)WSP(bf16, WS_WGU), (size_t)2048 * 1024, 1024, true};
        EpiMoe1 E{F.in[29], WSP(bf16, WS_ACT)};
        g8::gemm_phase<EpiMoe1, MoeOrder, true, true>(F.lds, 1024, 1024, 1024, S, E);
    }
    SEAM(10);
    if (IN(11)) REPS(11) { if (rep_) xcd_barrier(bar);
        moe_tables(F);
        const LAS int* tstart = (const LAS int*)(F.lds + TAB_OFF);
        MoeOrder S{F.G, (int)blockIdx.x, 4, tstart[NE], tstart, tstart + 40, WSP(int, WS_TOK), (const char*)WSP(bf16, WS_ACT), (const char*)WSP(bf16, WS_WD), (size_t)1024 * 1024, 1024, false};
        EpiMoe2 E{F.in[31], WSP(bf16, WS_YB)};
        g8::gemm_phase<EpiMoe2, MoeOrder, false, true>(F.lds, 1024, 1024, 1024, S, E);
    }
    SEAM(11);
    if (IN(12)) REPS(12) { if (rep_) xcd_barrier(bar); p12_final(F); }
#undef IN
#undef SEAM
}

extern "C" void kernel_launch(void* const* d_in, const int* in_sizes, int n_in, void* d_out, int out_size, void* d_ws, size_t ws_size, hipStream_t stream) {
    static int grid = 0;
    if (grid == 0) {
        if (n_in != 34 || in_sizes[0] != T * D || out_size != T * D || ws_size < WS_END) { fprintf(stderr, "kernel_launch: unexpected shapes (n_in %d, ws %zu < %zu)\n", n_in, ws_size, (size_t)WS_END); grid = -1; return; }
        int dev = 0, cus = 0;
        if (hipGetDevice(&dev) != hipSuccess || hipDeviceGetAttribute(&cus, hipDeviceAttributeMultiprocessorCount, dev) != hipSuccess) { grid = -1; return; }
        if (hipFuncSetAttribute((const void*)fwd_kernel, hipFuncAttributeMaxDynamicSharedMemorySize, LDS_BYTES) != hipSuccess) { fprintf(stderr, "kernel_launch: hipFuncSetAttribute failed\n"); grid = -1; return; }
        int per_cu = 0; (void)hipOccupancyMaxActiveBlocksPerMultiprocessor(&per_cu, (const void*)fwd_kernel, 512, LDS_BYTES); (void)hipGetLastError();
        grid = cus;
    }
    if (grid < 0) return;
    (void)hipMemsetAsync((char*)d_ws + WS_CTL, 0, CTL_BYTES, stream);
    Args a{};
    for (int i = 0; i < 34; ++i) a.in[i] = (const float*)d_in[i];
    a.out = (float*)d_out; a.ws = (unsigned char*)d_ws;
    if (MK_N_LAUNCHES == 1) { a.ph_lo = 0; a.ph_hi = N_PHASES; hipLaunchKernelGGL(fwd_kernel, dim3(grid), dim3(512), LDS_BYTES, stream, a); }
    else for (int p = 0; p < N_PHASES; ++p) { a.ph_lo = p; a.ph_hi = p + 1; hipLaunchKernelGGL(fwd_kernel, dim3(grid), dim3(512), LDS_BYTES, stream, a); }
}
```

```cpp
#include <hip/hip_runtime.h>
#include <cstdio>
#include <cstdint>

#ifndef MK_N_LAUNCHES
#define MK_N_LAUNCHES 1
#endif
constexpr int N_PHASES = 13;
#ifndef DUP_PHASE
#define DUP_PHASE -1
#endif
#define REPS(k) for (int rep_ = 0; rep_ < ((DUP_PHASE == (k)) ? 2 : 1); ++rep_)

#define GAS __attribute__((address_space(1)))
#define LAS __attribute__((address_space(3)))
typedef unsigned short bf16;
typedef short bf16x8 __attribute__((ext_vector_type(8)));
typedef float f32x4 __attribute__((ext_vector_type(4)));
typedef float f32x2 __attribute__((ext_vector_type(2)));
typedef unsigned u32x4 __attribute__((ext_vector_type(4)));
typedef unsigned u32x2 __attribute__((ext_vector_type(2)));
typedef GAS unsigned gu32;

constexpr int NB = 8, SEQ = 4096, T = NB * SEQ, D = 1024, INC = 4608, NE = 32, DFF = 1024;
constexpr int S5L = 32, S5G = 32, S5ROW = 128 + S5L * 16  , S5M = T / S5L  , S5CPB = SEQ / S5L  ;
constexpr int RGL = 128, RGC = SEQ / RGL  ;
constexpr float LN_EPS = 1e-5f, DN_ALPHA = 1.189207115002721f;
constexpr int ACT_ROWS = T * 4 + NE * 256;

constexpr size_t MiB = 1u << 20;
constexpr size_t WS_XRNN = 0, WS_GY = 64 * MiB, WS_GATES = 128 * MiB, WS_V1 = 0, WS_ACT = 0;
constexpr size_t WS_HBF = 272 * MiB, WS_HA = 272 * MiB, WS_YS = 336 * MiB, WS_GB = 368 * MiB, WS_MERGED = 432 * MiB, WS_ACAT = 496 * MiB, WS_YB = 272 * MiB;
constexpr size_t WS_X1 = 544 * MiB, WS_H2 = 608 * MiB;
constexpr size_t WS_WGU = 672 * MiB, WS_WD = 800 * MiB, WS_WIN = 864 * MiB, WS_WG = 873 * MiB, WS_WRNN = 874 * MiB, WS_WGLU = 876 * MiB, WS_WOUT = 878 * MiB;
constexpr size_t WS_WS = 880 * MiB, WS_WY = 888 * MiB, WS_S = 908 * MiB;
constexpr size_t WS_MOD = 924 * MiB, WS_AL = 925 * MiB, WS_RGAGG = 926 * MiB, WS_HIN = 928 * MiB, WS_TOK = 929 * MiB, WS_POS = 933 * MiB, WS_PROB = 934 * MiB, WS_CTL = 935 * MiB;
constexpr size_t WS_END = 936 * MiB, CTL_BYTES = 1 * MiB;
static_assert((size_t)ACT_ROWS * DFF * 2 <= 272 * MiB, "act/yb size");
static_assert(WS_ACAT + (size_t)S5G * S5M * S5ROW * 2 <= WS_X1, "acat");
constexpr int CW_BAR = 4096, CW_CNT = 8192  ;

constexpr int LDS_BYTES = 147456, MISC_OFF = LDS_BYTES - 256, TAB_OFF = 131072 + 1024;

__device__ __forceinline__ unsigned f2bf(float f) { unsigned u = __builtin_bit_cast(unsigned, f); return (u + 0x7fffu + ((u >> 16) & 1u)) >> 16; }
typedef __bf16 bf16x2v __attribute__((ext_vector_type(2)));
__device__ __forceinline__ unsigned pk2(float lo, float hi) { const f32x2 v = {lo, hi}; const bf16x2v b = __builtin_convertvector(v, bf16x2v); return __builtin_bit_cast(unsigned, b); }
__device__ __forceinline__ unsigned pk4_fp8(float a, float b, float c, float d) { a = __builtin_amdgcn_fmed3f(a, -448.f, 448.f); b = __builtin_amdgcn_fmed3f(b, -448.f, 448.f); c = __builtin_amdgcn_fmed3f(c, -448.f, 448.f); d = __builtin_amdgcn_fmed3f(d, -448.f, 448.f); int w = 0; w = __builtin_amdgcn_cvt_pk_fp8_f32(a, b, w, false); w = __builtin_amdgcn_cvt_pk_fp8_f32(c, d, w, true); return (unsigned)w; }
__device__ __forceinline__ float bflo(unsigned w) { return __builtin_bit_cast(float, w << 16); }
__device__ __forceinline__ float bfhi(unsigned w) { return __builtin_bit_cast(float, w & 0xffff0000u); }
__device__ __forceinline__ float bf1(bf16 h) { return __builtin_bit_cast(float, ((unsigned)h) << 16); }
__device__ __forceinline__ float fast_sigmoid(float x) { return __builtin_amdgcn_rcpf(1.0f + __builtin_amdgcn_exp2f(-1.4426950409f * x)); }
__device__ __forceinline__ float gelu_tanh(float x) { const float u = x + 0.044715f * x * x * x; return x * __builtin_amdgcn_rcpf(1.0f + __builtin_amdgcn_exp2f(-2.3022082f * u)); }
__device__ __forceinline__ float wave_sum(float v) {
#pragma unroll
    for (int o = 1; o < 64; o <<= 1) v += __shfl_xor(v, o);
    return v;
}
__device__ __forceinline__ u32x4 pack8(f32x4 a, f32x4 b) { u32x4 w; w.x = pk2(a[0], a[1]); w.y = pk2(a[2], a[3]); w.z = pk2(b[0], b[1]); w.w = pk2(b[2], b[3]); return w; }
__device__ __forceinline__ void unpack8(u32x4 w, f32x4& a, f32x4& b) { a = (f32x4){bflo(w.x), bfhi(w.x), bflo(w.y), bfhi(w.y)}; b = (f32x4){bflo(w.z), bfhi(w.z), bflo(w.w), bfhi(w.w)}; }

#define XB_TMO      128
#define XB_XCNT(j)  (256  + 64 * (j))
#define XB_XSUB(j)  (1280 + 64 * (j))
#define XB_XGEN(j)  (2304 + 64 * (j))
#define XB_TOP      3328
#define XB_TOPGEN   3392
#define XCD_BAR_WORDS 3456
#define XB_SPIN_CAP (1u << 18)
__device__ __forceinline__ unsigned xb_ld(unsigned* p)              { return __hip_atomic_load(p, __ATOMIC_RELAXED, __HIP_MEMORY_SCOPE_AGENT); }
__device__ __forceinline__ unsigned xb_add(unsigned* p, unsigned v) { return __hip_atomic_fetch_add(p, v, __ATOMIC_RELAXED, __HIP_MEMORY_SCOPE_AGENT); }
__device__ __forceinline__ unsigned xb_xcc_id() { return (unsigned)__builtin_amdgcn_s_getreg((3 << 11) | 20) & 0xFu; }
#define XB_SPIN(cond, bar) do { unsigned _sp = 0; while (cond) { __builtin_amdgcn_s_sleep(1); \
    if ((++_sp & 255u) == 0u) { if (xb_ld(&(bar)[XB_TMO])) break; if (_sp > XB_SPIN_CAP) { atomicAdd(&(bar)[XB_TMO], 1u); break; } } } } while (0)
struct XcdBarrier { unsigned* bar; unsigned x; volatile LAS unsigned* st; };
__device__ __forceinline__ XcdBarrier xcd_barrier_post(unsigned* bar, volatile LAS unsigned* st) {
    XcdBarrier b; b.bar = bar; b.x = xb_xcc_id(); b.st = st;
    if (threadIdx.x == 0) (void)xb_add(&bar[XB_XCNT(b.x)], 1u);
    return b;
}
__device__ __forceinline__ void xcd_barrier_complete(unsigned* bar, unsigned x, unsigned& nloc, unsigned& nx) {
    const unsigned G = gridDim.x * gridDim.y * gridDim.z;
    unsigned sum, cnt, mine, sp = 0u;
    for (;;) {
        sum = 0u; cnt = 0u; mine = 0u;
#pragma unroll
        for (unsigned j = 0; j < 16; ++j) { const unsigned c = xb_ld(&bar[XB_XCNT(j)]); sum += c; cnt += (c > 0u) ? 1u : 0u; mine = (j == x) ? c : mine; }
        if (sum == G) break;
        __builtin_amdgcn_s_sleep(1);
        if ((++sp & 255u) == 0u) { if (xb_ld(&bar[XB_TMO])) break; if (sp > XB_SPIN_CAP) { atomicAdd(&bar[XB_TMO], 1u); break; } }
    }
    nloc = mine > 0u ? mine : 1u; nx = cnt > 0u ? cnt : 1u;
}
__device__ __forceinline__ void xcd_barrier(const XcdBarrier& b) {
    asm volatile("s_waitcnt vmcnt(0)" ::: "memory");
    __syncthreads();
    if (threadIdx.x == 0) {
        unsigned* bar = b.bar;
        __builtin_amdgcn_s_waitcnt(0);
        unsigned nloc = b.st[0], nx = b.st[1];
        if (nloc == 0u) { xcd_barrier_complete(bar, b.x, nloc, nx); b.st[0] = nloc; b.st[1] = nx; }
        const unsigned old = xb_add(&bar[XB_XSUB(b.x)], 1u);
        const unsigned gen = old / nloc;
        if (old + 1u == (gen + 1u) * nloc) {
            __builtin_amdgcn_fence(__ATOMIC_RELEASE, "agent");
            asm volatile("s_waitcnt vmcnt(0)" ::: "memory");
            const unsigned og = xb_add(&bar[XB_TOP], 1u);
            const unsigned tg = og / nx;
            if (og + 1u == (tg + 1u) * nx) xb_add(&bar[XB_TOPGEN], 1u);
            else XB_SPIN(xb_ld(&bar[XB_TOPGEN]) == tg, bar);
            __builtin_amdgcn_fence(__ATOMIC_ACQUIRE, "agent");
            xb_add(&bar[XB_XGEN(b.x)], 1u);
            asm volatile("s_waitcnt vmcnt(0)" ::: "memory");
        } else {
            XB_SPIN(xb_ld(&bar[XB_XGEN(b.x)]) == gen, bar);
            __builtin_amdgcn_fence(__ATOMIC_ACQUIRE, "agent");
            asm volatile("s_waitcnt vmcnt(0)" ::: "memory");
        }
    }
    __syncthreads();
}

namespace g8 {
constexpr int BM = 256, BK = 64, HALF = 128, HTB = HALF * BK * 2, STAGE_BYTES = 8 * HTB;
__device__ __forceinline__ int lds_byte(int r, int c) { const int st = (r >> 4) * 2 + (c >> 5), rr = r & 15, cc = c & 31, ob = rr * 64 + cc * 2; return st * 1024 + (ob ^ (((ob >> 9) & 1) << 5)); }
__device__ __forceinline__ void stage_rc(int b, int& R, int& C) { const int st = b / 1024, sb = b % 1024, swz = sb ^ (((sb >> 9) & 1) << 5); R = (st >> 1) * 16 + swz / 64; C = (st & 1) * 32 + (swz % 64) / 2; }
__device__ __forceinline__ int perm32(int rho) { const int n = rho >> 4, i = rho & 15; return 8 * (i >> 2) + 4 * n + (i & 3); }

struct Unit { int pm, pn, z, rl; const char* A; const char* B; };

typedef int v8i __attribute__((ext_vector_type(8)));
typedef int v4i __attribute__((ext_vector_type(4)));
typedef short s16x16 __attribute__((ext_vector_type(16)));
typedef s16x16 s16x16_a16 __attribute__((aligned(16)));
__device__ __forceinline__ v8i cat8(bf16x8 lo, bf16x8 hi) { const v4i a = __builtin_bit_cast(v4i, lo), b = __builtin_bit_cast(v4i, hi); return __builtin_shufflevector(a, b, 0, 1, 2, 3, 4, 5, 6, 7); }
template <class Epi, class Sched, bool GATHER, bool FP8 = false>
__device__ __forceinline__ void gemm_phase(LAS unsigned char* lds, const int Kb, const int ldaB, const int ldbB, const Sched& S, const Epi& E) {
    const int tid = threadIdx.x, wid = __builtin_amdgcn_readfirstlane(tid >> 6), lane = tid & 63, wr = wid >> 2, wc = wid & 3, fr = lane & 15, fq = lane >> 4;
    const int nt = Kb / 128;
    unsigned voffB[2], cvo[2][2], nvo[2][2]; int Rr[2], Cc[2];
#pragma unroll
    for (int i = 0; i < 2; ++i) { int R, C; stage_rc(tid * 16 + i * 8192, R, C); const int Rb = (R & ~31) + perm32(R & 31);
        voffB[i] = (unsigned)(Rb * ldbB + C * 2); Rr[i] = R; Cc[i] = C;
#pragma unroll
        for (int h = 0; h < 2; ++h) { cvo[h][i] = (unsigned)((h * HALF + R) * ldaB + C * 2); nvo[h][i] = cvo[h][i]; } }
    const size_t kstep = (size_t)(BK * 2);
    const size_t hstepB = (size_t)HALF * ldbB;
    const unsigned ldsw = (unsigned)wid * 1024u;
    const int aoff = FP8 ? lds_byte(wr * 64 + fr, (fq >> 1) * 32 + (fq & 1) * 24) : lds_byte(wr * 64 + fr, fq * 8), boff = FP8 ? lds_byte(wc * 32 + fr, (fq >> 1) * 32 + (fq & 1) * 24) : lds_byte(wc * 32 + fr, fq * 8);
    const int aoff2 = FP8 ? lds_byte(wr * 64 + fr, (fq >> 1) * 32 + 8 + (fq & 1) * 8) : 0, boff2 = FP8 ? lds_byte(wc * 32 + fr, (fq >> 1) * 32 + 8 + (fq & 1) * 8) : 0;
#define G8_SA(b, h) (((b) * 2 + (h)) * HTB)
#define G8_SB(b, h) ((4 + (b) * 2 + (h)) * HTB)
#define G8_STGB(bufoff, gbase) do { _Pragma("unroll") for (int _i = 0; _i < 2; ++_i) \
        __builtin_amdgcn_global_load_lds((const unsigned*)((const char*)(gbase) + voffB[_i]), (LAS unsigned*)(lds + (bufoff) + ldsw + _i * 8192), 16, 0, 0); } while (0)
#define G8_STGA(bufoff, gbase, VO, h) do { _Pragma("unroll") for (int _i = 0; _i < 2; ++_i) \
        __builtin_amdgcn_global_load_lds((const unsigned*)((const char*)(gbase) + VO[h][_i]), (LAS unsigned*)(lds + (bufoff) + ldsw + _i * 8192), 16, 0, 0); } while (0)
#define G8_LDA(dst, b, h) do { _Pragma("unroll") for (int m = 0; m < 4; ++m) { if constexpr (FP8) { dst##8[m] = cat8(*(const LAS bf16x8*)(lds + G8_SA(b, h) + aoff + m * 2048), *(const LAS bf16x8*)(lds + G8_SA(b, h) + aoff2 + m * 2048)); } \
        else { _Pragma("unroll") for (int k = 0; k < 2; ++k) dst[m][k] = *(const LAS bf16x8*)(lds + G8_SA(b, h) + aoff + m * 2048 + k * 1024); } } } while (0)
#define G8_LDB(dst, b, h) do { _Pragma("unroll") for (int n = 0; n < 2; ++n) { if constexpr (FP8) { dst##8[n] = cat8(*(const LAS bf16x8*)(lds + G8_SB(b, h) + boff + n * 2048), *(const LAS bf16x8*)(lds + G8_SB(b, h) + boff2 + n * 2048)); } \
        else { _Pragma("unroll") for (int k = 0; k < 2; ++k) dst[n][k] = *(const LAS bf16x8*)(lds + G8_SB(b, h) + boff + n * 2048 + k * 1024); } } } while (0)
#define G8_MMA(ai, bj, At, Bt) do { __builtin_amdgcn_s_setprio(1); _Pragma("unroll") for (int m = 0; m < 4; ++m) _Pragma("unroll") for (int n = 0; n < 2; ++n) { \
        if constexpr (FP8) asm volatile("s_nop 1\n\tv_mfma_scale_f32_16x16x128_f8f6f4 %0, %1, %2, %0, %3, %4 op_sel_hi:[0,0,0]" : "+v"(acc[ai][bj][m][n]) : "v"(Bt##8[n]), "v"(At##8[m]), "v"(sc_w), "v"(sc_a)); \
        else { _Pragma("unroll") for (int k = 0; k < 2; ++k) acc[ai][bj][m][n] = __builtin_amdgcn_mfma_f32_16x16x32_bf16(Bt[n][k], At[m][k], acc[ai][bj][m][n], 0, 0, 0); } } __builtin_amdgcn_s_setprio(0); } while (0)
#define G8_WAIT_V(n) asm volatile("s_waitcnt vmcnt(" #n ")" ::: "memory")
#define G8_WAIT_L(n) asm volatile("s_waitcnt lgkmcnt(" #n ")" ::: "memory")
#define G8_BAR __builtin_amdgcn_s_barrier()
#define G8_SCHED __builtin_amdgcn_sched_barrier(0)
    Unit cur, nxt; int ui = 0;
    if (!S.next(0, cur)) return;
    bool has_next = S.next(1, nxt);
    if constexpr (GATHER) { S.gather(cur, Rr, Cc, cvo); if (has_next) S.gather(nxt, Rr, Cc, nvo); else {
#pragma unroll
        for (int h = 0; h < 2; ++h)
#pragma unroll
            for (int i = 0; i < 2; ++i) nvo[h][i] = cvo[h][i]; } }
    f32x4 acc[2][2][4][2];
#pragma unroll
    for (int a = 0; a < 2; ++a)
#pragma unroll
        for (int b = 0; b < 2; ++b)
#pragma unroll
            for (int m = 0; m < 4; ++m)
#pragma unroll
                for (int n = 0; n < 2; ++n) acc[a][b][m][n] = (f32x4){0.f, 0.f, 0.f, 0.f};
    const int sc_w = 0x7a7a7a7a, sc_a = 0x7f7f7f7f;
    bf16x8 At[4][2], B0[2][2], B1[2][2]; v8i At8[4], B08[2], B18[2];
    const char* cA = cur.A; const char* cB = cur.B;
    G8_STGB(G8_SB(0, 0), cB); G8_STGB(G8_SB(0, 1), cB + hstepB); G8_STGA(G8_SA(0, 0), cA, cvo, 0); G8_STGA(G8_SA(0, 1), cA, cvo, 1);
    if (wr == 1) G8_BAR;
    G8_WAIT_V(2); G8_BAR;
    G8_STGB(G8_SB(1, 0), cB + kstep); G8_STGA(G8_SA(1, 0), cA + kstep, cvo, 0); G8_STGB(G8_SB(1, 1), cB + hstepB + kstep);
    G8_WAIT_V(6); G8_BAR;
    for (;;) {
        const char* nA = has_next ? nxt.A : cA; const char* nB = has_next ? nxt.B : cB;
        for (int t = 0; t < nt; t += 2) {
            const bool last = (t == nt - 2);
            const char* a1 = cA + (size_t)(t + 1) * kstep;
            const char* a2 = last ? nA : cA + (size_t)(t + 2) * kstep; const char* b2 = last ? nB : cB + (size_t)(t + 2) * kstep;
            const char* a3 = a2 + kstep; const char* b3 = b2 + kstep;
            unsigned vo2[2][2];
#pragma unroll
            for (int h = 0; h < 2; ++h)
#pragma unroll
                for (int i = 0; i < 2; ++i) vo2[h][i] = (GATHER && last) ? nvo[h][i] : cvo[h][i];
            G8_LDB(B0, 0, 0); G8_LDB(B1, 0, 1); G8_SCHED; G8_LDA(At, 0, 0); G8_STGA(G8_SA(1, 1), a1, cvo, 1);
            G8_WAIT_V(8); G8_WAIT_L(0); G8_BAR; G8_SCHED; G8_MMA(0, 0, At, B0); G8_MMA(0, 1, At, B1); G8_SCHED; G8_BAR; G8_SCHED;
            G8_LDA(At, 0, 1); G8_STGB(G8_SB(0, 0), b2); G8_STGB(G8_SB(0, 1), b2 + hstepB); G8_STGA(G8_SA(0, 0), a2, vo2, 0);
            G8_WAIT_V(8); G8_WAIT_L(0); G8_BAR; G8_SCHED; G8_MMA(1, 0, At, B0); G8_MMA(1, 1, At, B1); G8_SCHED; G8_BAR; G8_SCHED;
            G8_LDB(B0, 1, 0); G8_LDB(B1, 1, 1); G8_SCHED; G8_LDA(At, 1, 0); G8_STGA(G8_SA(0, 1), a2, vo2, 1);
            G8_WAIT_V(8); G8_WAIT_L(0); G8_BAR; G8_SCHED; G8_MMA(0, 0, At, B0); G8_MMA(0, 1, At, B1); G8_SCHED; G8_BAR; G8_SCHED;
            G8_LDA(At, 1, 1); G8_STGB(G8_SB(1, 0), b3); G8_STGB(G8_SB(1, 1), b3 + hstepB); G8_STGA(G8_SA(1, 0), a3, vo2, 0);
            G8_WAIT_V(8); G8_WAIT_L(0); G8_BAR; G8_SCHED; G8_MMA(1, 0, At, B0); G8_MMA(1, 1, At, B1); G8_SCHED; G8_BAR; G8_SCHED;
        }
        f32x4 bpre[4]; E.pre(cur, wr, wc, fr, fq, bpre);
        if (wr == 0) G8_BAR;
        Unit nn; bool has_nn = false;
        if (has_next) has_nn = S.next(ui + 2, nn);
        unsigned nnvo[2][2];
        if constexpr (GATHER) { if (has_nn) S.gather(nn, Rr, Cc, nnvo); }
        if constexpr (FP8) asm volatile("s_nop 15\n\ts_nop 15" ::: "memory");
        E(acc, cur, wr, wc, fr, fq, bpre);
        if (!has_next) break;
#pragma unroll
        for (int a = 0; a < 2; ++a)
#pragma unroll
            for (int b = 0; b < 2; ++b)
#pragma unroll
                for (int m = 0; m < 4; ++m)
#pragma unroll
                    for (int n = 0; n < 2; ++n) acc[a][b][m][n] = (f32x4){0.f, 0.f, 0.f, 0.f};
        cur = nxt; cA = nA; cB = nB; ++ui;
        if constexpr (GATHER) {
#pragma unroll
            for (int h = 0; h < 2; ++h)
#pragma unroll
                for (int i = 0; i < 2; ++i) { cvo[h][i] = nvo[h][i]; if (has_nn) nvo[h][i] = nnvo[h][i]; } }
        nxt = nn; has_next = has_nn;
        if (wr == 1) G8_BAR;
    }
    G8_WAIT_V(0);
    G8_BAR;
#undef G8_SA
#undef G8_SB
#undef G8_STGB
#undef G8_STGA
#undef G8_LDA
#undef G8_LDB
#undef G8_MMA
#undef G8_WAIT_V
#undef G8_WAIT_L
#undef G8_BAR
#undef G8_SCHED
}

struct GridOrder {
    int nM, nN, nwg, G, c; const char* A; const char* B; size_t tstepA, tstepB;
    __device__ __forceinline__ void init(int M, int N, int G_, int c_, const void* A_, const void* B_, int ldaB, int ldbB) { nM = M / BM; nN = N / BM; nwg = nM * nN; G = G_; c = c_; A = (const char*)A_; B = (const char*)B_; tstepA = (size_t)BM * ldaB; tstepB = (size_t)BM * ldbB; }
    __device__ __forceinline__ bool next(int i, Unit& u) const {
        const long L = (long)i * G + c; if (L >= nwg) return false;
        int wgid = (int)L; { const int q = nwg / 8, r = nwg % 8, xcd = wgid % 8, off = wgid / 8; wgid = (xcd < r ? xcd * (q + 1) : r * (q + 1) + (xcd - r) * q) + off; }
        const int nig = 8 * nN, gid = wgid / nig, fm = gid * 8, gsz = (nM - fm) < 8 ? (nM - fm) : 8;
        u.pm = fm + ((wgid % nig) % gsz); u.pn = (wgid % nig) / gsz; u.z = 0; u.rl = 0;
        u.A = A + (size_t)u.pm * tstepA; u.B = B + (size_t)u.pn * tstepB; return true;
    }
};
}

struct Frame {
    LAS unsigned char* lds; volatile LAS unsigned* MISC; unsigned* ctl;
    int tid, lane, wave, vcu, G;
    const float* in[34]; float* out; unsigned char* ws;
};
#define WSP(T_, off) ((T_*)(F.ws + (off)))

struct EpiInProj {
    __device__ __forceinline__ void pre(const g8::Unit& u, int, int wc, int, int fq, f32x4 (&bp)[4]) const { const int colb = u.pn * 256 + wc * 32 + 8 * fq;
#pragma unroll
        for (int bj = 0; bj < 2; ++bj)
#pragma unroll
            for (int n = 0; n < 2; ++n) bp[bj * 2 + n] = *(const f32x4*)(bias + colb + bj * 128 + 4 * n); }
    const float* bias; bf16 *xrnn, *gy, *acat, *gates;
    __device__ __forceinline__ void operator()(const f32x4 (&acc)[2][2][4][2], const g8::Unit& u, int wr, int wc, int fr, int fq, const f32x4 (&bpre)[4]) const {
        const int pn = u.pn, colb = pn * 256 + wc * 32 + 8 * fq;
        f32x4 bv[2][2];
#pragma unroll
        for (int bj = 0; bj < 2; ++bj)
#pragma unroll
            for (int n = 0; n < 2; ++n) bv[bj][n] = bpre[bj * 2 + n];
#pragma unroll
        for (int ai = 0; ai < 2; ++ai)
#pragma unroll
            for (int m = 0; m < 4; ++m) { const int t = u.pm * 256 + ai * 128 + wr * 64 + m * 16 + fr;
#pragma unroll
                for (int bj = 0; bj < 2; ++bj) { f32x4 v0 = acc[ai][bj][m][0] + bv[bj][0], v1 = acc[ai][bj][m][1] + bv[bj][1]; const int col = colb + bj * 128;
                    if (pn < 4) { *(u32x4*)(xrnn + (size_t)t * 1024 + col) = pack8(v0, v1); }
                    else if (pn < 8) {
#pragma unroll
                        for (int j = 0; j < 4; ++j) { v0[j] = gelu_tanh(v0[j]); v1[j] = gelu_tanh(v1[j]); }
                        *(u32x4*)(gy + (size_t)t * 1024 + (col - 1024)) = pack8(v0, v1); }
                    else if (pn < 10) { const int cu = col - 2048, g = cu >> 4, c = cu & 15;
                        *(u32x4*)(acat + ((size_t)(g * S5M + (t >> 5)) * S5ROW + 128 + (t & 31) * 16 + c)) = pack8(v0, v1); }
                    else {
#pragma unroll
                        for (int j = 0; j < 4; ++j) { v0[j] = fast_sigmoid(v0[j]); v1[j] = fast_sigmoid(v1[j]); }
                        *(u32x4*)(gates + (size_t)t * 2048 + (col - 2560)) = pack8(v0, v1); } } }
    }
};
struct EpiS5A {
    __device__ __forceinline__ void pre(const g8::Unit&, int, int, int, int, f32x4 (&)[4]) const {}
    float* S;
    __device__ __forceinline__ void operator()(const f32x4 (&acc)[2][2][4][2], const g8::Unit& u, int wr, int wc, int fr, int fq, const f32x4 (&bpre)[4]) const {
        const int col = wc * 32 + 8 * fq;
#pragma unroll
        for (int ai = 0; ai < 2; ++ai)
#pragma unroll
            for (int m = 0; m < 4; ++m) { const int row = u.pm * 256 + ai * 128 + wr * 64 + m * 16 + fr; float* p = S + ((size_t)(u.z * S5M + row)) * 128 + col;
                *(f32x4*)p = acc[ai][0][m][0]; *(f32x4*)(p + 4) = acc[ai][0][m][1]; }
    }
};
struct EpiS5C {
    __device__ __forceinline__ void pre(const g8::Unit&, int, int, int, int, f32x4 (&)[4]) const {}
    bf16* ys;
    __device__ __forceinline__ void operator()(const f32x4 (&acc)[2][2][4][2], const g8::Unit& u, int wr, int wc, int fr, int fq, const f32x4 (&bpre)[4]) const {
#pragma unroll
        for (int ai = 0; ai < 2; ++ai)
#pragma unroll
            for (int m = 0; m < 4; ++m) { const int row = u.pm * 256 + ai * 128 + wr * 64 + m * 16 + fr;
#pragma unroll
                for (int bj = 0; bj < 2; ++bj) { const int n = u.pn * 256 + bj * 128 + wc * 32 + 8 * fq, i = n >> 4, c = n & 15; f32x4 v0 = acc[ai][bj][m][0], v1 = acc[ai][bj][m][1];
#pragma unroll
                    for (int j = 0; j < 4; ++j) { v0[j] = gelu_tanh(v0[j]); v1[j] = gelu_tanh(v1[j]); }
                    u32x2 w8; w8.x = pk4_fp8(v0[0], v0[1], v0[2], v0[3]); w8.y = pk4_fp8(v1[0], v1[1], v1[2], v1[3]); *(u32x2*)((unsigned char*)ys + (size_t)(row * 32 + i) * 512 + u.z * 16 + c) = w8; } }
    }
};
struct EpiGlu { static constexpr int NST = 8;
    __device__ __forceinline__ void pre(const g8::Unit&, int, int, int, int, f32x4 (&)[4]) const {}
    const bf16* gates; bf16* gb;
    __device__ __forceinline__ void operator()(const f32x4 (&acc)[2][2][4][2], const g8::Unit& u, int wr, int wc, int fr, int fq, const f32x4 (&bpre)[4]) const {
        const int f = u.pn * 128 + wc * 32 + 8 * fq;
#pragma unroll
        for (int ai = 0; ai < 2; ++ai) { u32x4 gw[4];
#pragma unroll
            for (int m = 0; m < 4; ++m) { const int t = u.pm * 256 + ai * 128 + wr * 64 + m * 16 + fr; gw[m] = *(const u32x4*)(gates + (size_t)t * 2048 + 1024 + f); }
#pragma unroll
            for (int m = 0; m < 4; ++m) { const int t = u.pm * 256 + ai * 128 + wr * 64 + m * 16 + fr;
                f32x4 g0, g1; unpack8(gw[m], g0, g1);
                f32x4 v0 = acc[ai][0][m][0], v1 = acc[ai][0][m][1]; const f32x4 s0 = acc[ai][1][m][0], s1 = acc[ai][1][m][1];
#pragma unroll
                for (int j = 0; j < 4; ++j) { v0[j] = g0[j] * v0[j] * fast_sigmoid(s0[j]); v1[j] = g1[j] * v1[j] * fast_sigmoid(s1[j]); }
                *(u32x4*)(gb + (size_t)t * 1024 + f) = pack8(v0, v1); } }
    }
};
struct EpiRnn { static constexpr int NST = 16;
    __device__ __forceinline__ void pre(const g8::Unit&, int, int, int, int, f32x4 (&)[4]) const {}
    const bf16* gates; const bf16* gb; bf16* merged;
    __device__ __forceinline__ void operator()(const f32x4 (&acc)[2][2][4][2], const g8::Unit& u, int wr, int wc, int fr, int fq, const f32x4 (&bpre)[4]) const {
#pragma unroll
        for (int ai = 0; ai < 2; ++ai)
#pragma unroll
            for (int mh = 0; mh < 2; ++mh) { u32x4 gw[2][2], bw[2][2];
#pragma unroll
                for (int mm = 0; mm < 2; ++mm) { const int t = u.pm * 256 + ai * 128 + wr * 64 + (2 * mh + mm) * 16 + fr;
#pragma unroll
                    for (int bj = 0; bj < 2; ++bj) { const int col = u.pn * 256 + bj * 128 + wc * 32 + 8 * fq; gw[mm][bj] = *(const u32x4*)(gates + (size_t)t * 2048 + col); bw[mm][bj] = *(const u32x4*)(gb + (size_t)t * 1024 + col); } }
#pragma unroll
                for (int mm = 0; mm < 2; ++mm) { const int m = 2 * mh + mm, t = u.pm * 256 + ai * 128 + wr * 64 + m * 16 + fr;
#pragma unroll
                    for (int bj = 0; bj < 2; ++bj) { const int col = u.pn * 256 + bj * 128 + wc * 32 + 8 * fq;
                        f32x4 g0, g1, b0, b1; unpack8(gw[mm][bj], g0, g1); unpack8(bw[mm][bj], b0, b1);
                        const f32x4 v0 = g0 * acc[ai][bj][m][0] + b0, v1 = g1 * acc[ai][bj][m][1] + b1;
                        u32x2 w8; w8.x = pk4_fp8(v0[0], v0[1], v0[2], v0[3]); w8.y = pk4_fp8(v1[0], v1[1], v1[2], v1[3]); *(u32x2*)((unsigned char*)merged + (size_t)t * 1024 + col) = w8; } } }
    }
};
struct EpiOut { static constexpr int NST = 16;
    const float* x; const float* mod; bf16* v1;
    __device__ __forceinline__ void pre(const g8::Unit& u, int, int wc, int, int fq, f32x4 (&bp)[4]) const { const int b = (u.pm * 256) >> 12; const float* p = mod + b * 6144 + 2048 + u.pn * 256 + wc * 32 + 8 * fq;
        bp[0] = *(const f32x4*)p; bp[1] = *(const f32x4*)(p + 4); bp[2] = *(const f32x4*)(p + 128); bp[3] = *(const f32x4*)(p + 132); }
    __device__ __forceinline__ void operator()(const f32x4 (&acc)[2][2][4][2], const g8::Unit& u, int wr, int wc, int fr, int fq, const f32x4 (&bpre)[4]) const {
#pragma unroll
        for (int ai = 0; ai < 2; ++ai)
#pragma unroll
            for (int mh = 0; mh < 2; ++mh) { f32x4 xv[2][2][2];
#pragma unroll
                for (int mm = 0; mm < 2; ++mm) { const int t = u.pm * 256 + ai * 128 + wr * 64 + (2 * mh + mm) * 16 + fr;
#pragma unroll
                    for (int bj = 0; bj < 2; ++bj) { const int col = u.pn * 256 + bj * 128 + wc * 32 + 8 * fq; xv[mm][bj][0] = *(const f32x4*)(x + (size_t)t * 1024 + col); xv[mm][bj][1] = *(const f32x4*)(x + (size_t)t * 1024 + col + 4); } }
#pragma unroll
                for (int mm = 0; mm < 2; ++mm) { const int m = 2 * mh + mm, t = u.pm * 256 + ai * 128 + wr * 64 + m * 16 + fr;
#pragma unroll
                    for (int bj = 0; bj < 2; ++bj) { const int col = u.pn * 256 + bj * 128 + wc * 32 + 8 * fq;
                        const f32x4 v0 = xv[mm][bj][0] * DN_ALPHA + (bpre[2 * bj] + 1.0f) * acc[ai][bj][m][0], v1_ = xv[mm][bj][1] * DN_ALPHA + (bpre[2 * bj + 1] + 1.0f) * acc[ai][bj][m][1];
                        *(u32x4*)(v1 + (size_t)t * 1024 + col) = pack8(v0, v1_); } } }
    }
};
struct EpiMoe1 {
    __device__ __forceinline__ void pre(const g8::Unit& u, int, int wc, int, int fq, f32x4 (&bp)[4]) const { const float* p = bgu + (size_t)u.z * 2048 + u.pn * 128 + wc * 32 + 8 * fq; bp[0] = *(const f32x4*)p; bp[1] = *(const f32x4*)(p + 4); bp[2] = *(const f32x4*)(p + 1024); bp[3] = *(const f32x4*)(p + 1028); }
    const float* bgu; bf16* act;
    __device__ __forceinline__ void operator()(const f32x4 (&acc)[2][2][4][2], const g8::Unit& u, int wr, int wc, int fr, int fq, const f32x4 (&bpre)[4]) const {
        const int f = u.pn * 128 + wc * 32 + 8 * fq; const float* bp = bgu + (size_t)u.z * 2048 + f;
        (void)bp; const f32x4 bg0 = bpre[0], bg1 = bpre[1], bu0 = bpre[2], bu1 = bpre[3];
#pragma unroll
        for (int ai = 0; ai < 2; ++ai)
#pragma unroll
            for (int m = 0; m < 4; ++m) { const int row = u.pm * 256 + ai * 128 + wr * 64 + m * 16 + fr;
                f32x4 g0 = acc[ai][0][m][0] + bg0, g1 = acc[ai][0][m][1] + bg1, u0 = acc[ai][1][m][0] + bu0, u1 = acc[ai][1][m][1] + bu1;
#pragma unroll
                for (int j = 0; j < 4; ++j) { const float ga = fminf(g0[j], 7.0f), gb_ = fminf(g1[j], 7.0f), ua = fminf(fmaxf(u0[j], -7.0f), 7.0f), ub = fminf(fmaxf(u1[j], -7.0f), 7.0f);
                    g0[j] = ga * fast_sigmoid(1.702f * ga) * (ua + 1.0f); g1[j] = gb_ * fast_sigmoid(1.702f * gb_) * (ub + 1.0f); }
                u32x2 w8; w8.x = pk4_fp8(g0[0], g0[1], g0[2], g0[3]); w8.y = pk4_fp8(g1[0], g1[1], g1[2], g1[3]); *(u32x2*)((unsigned char*)act + (size_t)row * 1024 + f) = w8; }
    }
};
struct EpiMoe2 {
    __device__ __forceinline__ void pre(const g8::Unit& u, int, int wc, int, int fq, f32x4 (&bp)[4]) const { const float* p = bd + (size_t)u.z * 1024 + u.pn * 256 + wc * 32 + 8 * fq; bp[0] = *(const f32x4*)p; bp[1] = *(const f32x4*)(p + 4); bp[2] = *(const f32x4*)(p + 128); bp[3] = *(const f32x4*)(p + 132); }
    const float* bd; bf16* yb;
    __device__ __forceinline__ void operator()(const f32x4 (&acc)[2][2][4][2], const g8::Unit& u, int wr, int wc, int fr, int fq, const f32x4 (&bpre)[4]) const {
#pragma unroll
        for (int bj = 0; bj < 2; ++bj) { const int col = u.pn * 256 + bj * 128 + wc * 32 + 8 * fq; const float* bp = bd + (size_t)u.z * 1024 + col;
            (void)bp; const f32x4 b0 = bpre[bj * 2], b1 = bpre[bj * 2 + 1];
#pragma unroll
            for (int ai = 0; ai < 2; ++ai)
#pragma unroll
                for (int m = 0; m < 4; ++m) { const int row = u.pm * 256 + ai * 128 + wr * 64 + m * 16 + fr;
                    const f32x4 y0 = acc[ai][bj][m][0] + b0, y1 = acc[ai][bj][m][1] + b1; u32x2 w8; w8.x = pk4_fp8(y0[0], y0[1], y0[2], y0[3]); w8.y = pk4_fp8(y1[0], y1[1], y1[2], y1[3]);
                    *(u32x2*)((unsigned char*)yb + (size_t)row * 1024 + col) = w8; } }
    }
};

struct S5AOrder { int G, c; const char* acat; const char* ws;
    __device__ __forceinline__ bool next(int i, g8::Unit& u) const { const int L = i * G + c; if (L >= S5G * 4) return false; u.z = L >> 2; u.pm = L & 3; u.pn = 0; u.rl = 0;
        u.A = acat + ((size_t)(u.z * S5M + u.pm * 256) * S5ROW + 128) * 2; u.B = ws + (size_t)u.z * 256 * (S5L * 16) * 2; return true; } };
struct S5COrder { int G, c; const char* acat; const char* wy;
    __device__ __forceinline__ bool next(int i, g8::Unit& u) const { const int L = i * G + c; if (L >= S5G * 8) return false; u.z = L >> 3; u.pm = (L >> 1) & 3; u.pn = L & 1; u.rl = 0;
        u.A = acat + ((size_t)(u.z * S5M + u.pm * 256) * S5ROW) * 2; u.B = wy + ((size_t)(u.z * 512 + u.pn * 256) * S5ROW) * 2; return true; } };
struct MoeOrder { int G, c, NT, RT; const LAS int* tstart; const LAS int* cnt; const int* toklist; const char* A; const char* B; size_t bstride_e; int lda; bool gatherA;
    __device__ __forceinline__ bool next(int i, g8::Unit& u) const { const int per = G >> 3, xcd = c & 7, slot = c >> 3, rpx = per / NT;
        const int rt = (i * 8 + xcd) * rpx + slot / NT; if (rt >= RT) return false; u.pn = slot % NT;
        const int lane_ = threadIdx.x & 63; const unsigned long long mk_ = __ballot(lane_ < NE && tstart[lane_ & 31] <= rt);
        const int e = __builtin_popcountll(mk_) - 1;
        u.z = e; u.pm = rt; u.rl = rt - tstart[e]; u.B = B + (size_t)e * bstride_e + (size_t)u.pn * 256 * 1024; u.A = gatherA ? A : A + (size_t)rt * 256 * 1024; return true; }
    __device__ __forceinline__ void gather(const g8::Unit& u, const int (&Rr)[2], const int (&Cc)[2], unsigned (&vo)[2][2]) const {
        const int n = cnt[u.z];
#pragma unroll
        for (int h = 0; h < 2; ++h)
#pragma unroll
            for (int i = 0; i < 2; ++i) { const int r = u.rl * 256 + h * 128 + Rr[i]; const int tok = r < n ? toklist[u.z * T + r] : 0; vo[h][i] = (unsigned)(tok * lda + Cc[i] * 2); } }
};

__device__ __forceinline__ void transpose_item(const float* W, int N, int k0, int n0, bf16* dst, int ldd, int drow0, LAS float* scr, int lane) {
    float wv_[32];
#pragma unroll
    for (int i = 0; i < 32; ++i) wv_[i] = W[(size_t)(k0 + 2 * i + (lane >> 5)) * N + n0 + (lane & 31)];
#pragma unroll
    for (int i = 0; i < 32; ++i) scr[(2 * i + (lane >> 5)) * 33 + (lane & 31)] = wv_[i];
    asm volatile("s_waitcnt lgkmcnt(0)" ::: "memory");
    const int c = lane & 7;
#pragma unroll
    for (int j = 0; j < 4; ++j) { const int n = (lane >> 3) + 8 * j; const LAS float* s = scr + (8 * c) * 33 + n;
        u32x4 o; o.x = pk2(s[0 * 33], s[1 * 33]); o.y = pk2(s[2 * 33], s[3 * 33]); o.z = pk2(s[4 * 33], s[5 * 33]); o.w = pk2(s[6 * 33], s[7 * 33]);
        *(u32x4*)(dst + (size_t)(drow0 + n) * ldd + k0 + 8 * c) = o; }
    asm volatile("s_waitcnt lgkmcnt(0)" ::: "memory");
}
__device__ __forceinline__ void transpose_item8(const float* W, int N, int k0, int n0, unsigned char* dst, int ldd, int drow0, LAS float* scr, int lane) {
    float wv_[32];
#pragma unroll
    for (int i = 0; i < 32; ++i) wv_[i] = W[(size_t)(k0 + 2 * i + (lane >> 5)) * N + n0 + (lane & 31)];
#pragma unroll
    for (int i = 0; i < 32; ++i) scr[(2 * i + (lane >> 5)) * 33 + (lane & 31)] = wv_[i];
    asm volatile("s_waitcnt lgkmcnt(0)" ::: "memory");
    const int c = lane & 7;
#pragma unroll
    for (int j = 0; j < 4; ++j) { const int n = (lane >> 3) + 8 * j; const LAS float* s = scr + (8 * c) * 33 + n;
        u32x2 o; o.x = pk4_fp8(32.f * s[0 * 33], 32.f * s[1 * 33], 32.f * s[2 * 33], 32.f * s[3 * 33]); o.y = pk4_fp8(32.f * s[4 * 33], 32.f * s[5 * 33], 32.f * s[6 * 33], 32.f * s[7 * 33]);
        *(u32x2*)(dst + (size_t)(drow0 + n) * ldd + k0 + 8 * c) = o; }
    asm volatile("s_waitcnt lgkmcnt(0)" ::: "memory");
}
__device__ __forceinline__ void transpose_item8w(const float* W, int N, int k0, int n0, unsigned char* dst, int ldd, int drow0, LAS float* scr, int lane) {
    float wv[64]; const float* wp = W + (size_t)(k0 + (lane >> 5)) * N + n0 + (lane & 31);
#pragma unroll
    for (int i = 0; i < 64; ++i) wv[i] = wp[(size_t)(2 * i) * N];
#pragma unroll
    for (int i = 0; i < 64; ++i) scr[(2 * i + (lane >> 5)) * 33 + (lane & 31)] = wv[i];
    asm volatile("s_waitcnt lgkmcnt(0)" ::: "memory");
    const int c = lane & 7;
#pragma unroll
    for (int j = 0; j < 4; ++j) { const int n = (lane >> 3) + 8 * j; const LAS float* s = scr + (16 * c) * 33 + n;
        u32x4 o; o.x = pk4_fp8(32.f * s[0 * 33], 32.f * s[1 * 33], 32.f * s[2 * 33], 32.f * s[3 * 33]); o.y = pk4_fp8(32.f * s[4 * 33], 32.f * s[5 * 33], 32.f * s[6 * 33], 32.f * s[7 * 33]);
        o.z = pk4_fp8(32.f * s[8 * 33], 32.f * s[9 * 33], 32.f * s[10 * 33], 32.f * s[11 * 33]); o.w = pk4_fp8(32.f * s[12 * 33], 32.f * s[13 * 33], 32.f * s[14 * 33], 32.f * s[15 * 33]);
        *(u32x4*)(dst + (size_t)(drow0 + n) * ldd + k0 + 16 * c) = o; }
    asm volatile("s_waitcnt lgkmcnt(0)" ::: "memory");
}
__device__ __forceinline__ int pair_row(int n) { const int f = n & 1023, hi = n >> 10; return (f >> 7) * 256 + hi * 128 + (f & 127); }

__device__ __forceinline__ void moe_tables(Frame& F) {
    LAS int* tstart = (LAS int*)(F.lds + TAB_OFF); LAS int* cl = tstart + 40;
    if (F.tid < 64) {
        const int e = F.lane & 31; const int c = (int)F.ctl[CW_CNT + 64 * e]; int inc = (c + 255) >> 8;
#pragma unroll
        for (int o = 1; o < 32; o <<= 1) { const int v = __shfl_up(inc, o); if ((F.lane & 31) >= o) inc += v; }
        if (F.lane < 32) { cl[e] = c; tstart[e] = inc - ((c + 255) >> 8); if (e == NE - 1) tstart[NE] = inc; }
    }
    __syncthreads();
}

__device__ __forceinline__ void p0_mod_job(Frame& F, int job) {
    LAS float* sc = (LAS float*)F.lds;
    LAS float* red = sc + 8 * 1024;
    const float* c = F.in[1]; const float* w = F.in[2]; const float* bias = F.in[3];
    for (int i = F.tid; i < 8 * 1024; i += 512) { const float v = c[i]; sc[i] = v * fast_sigmoid(v); }
    __syncthreads();
    const int col = F.tid & 31, kg = F.tid >> 5, j = job * 32 + col;
    float a[8];
#pragma unroll
    for (int b = 0; b < 8; ++b) a[b] = 0.f;
#pragma unroll 32
    for (int k = kg * 64; k < kg * 64 + 64; ++k) { const float wv = w[(size_t)k * 6144 + j];
#pragma unroll
        for (int b = 0; b < 8; ++b) a[b] += sc[b * 1024 + k] * wv; }
#pragma unroll
    for (int b = 0; b < 8; ++b) red[(kg * 8 + b) * 32 + col] = a[b];
    __syncthreads();
    if (F.tid < 256) { const int b = F.tid >> 5, cc = F.tid & 31; float s = 0.f;
#pragma unroll
        for (int g = 0; g < 16; ++g) s += red[(g * 8 + b) * 32 + cc];
        WSP(float, WS_MOD)[b * 6144 + job * 32 + cc] = s + bias[job * 32 + cc]; }
    __syncthreads();
}
__device__ __forceinline__ void s5_setup(Frame& F, int g, int kmin, int kmax, LAS f32x2* Bb, LAS f32x2* Cc, LAS f32x2* Ap) {
    const float* lre = F.in[14] + g * 64; const float* lim = F.in[15] + g * 64; const float dt = expf(F.in[16][g]);
    const float* bre = F.in[17] + g * 1024; const float* bim = F.in[18] + g * 1024; const float* cre = F.in[19] + g * 1024; const float* cim = F.in[20] + g * 1024;
    for (int i = F.tid; i < 1024; i += 512) { const int p = i >> 4; const float lr = lre[p], li = lim[p]; const float mag = expf(lr * dt); float sn, cs; sincosf(li * dt, &sn, &cs);
        const float ar = mag * cs, ai = mag * sn, den = lr * lr + li * li, qr = ((ar - 1.f) * lr + ai * li) / den, qi = (ai * lr - (ar - 1.f) * li) / den;
        const float br = bre[i], bi = bim[i]; Bb[i] = (f32x2){qr * br - qi * bi, qr * bi + qi * br};
        Cc[i] = (f32x2){cre[i], cim[i]}; }
    if (F.tid < 64) { const int p = F.tid; const float lr = lre[p], li = lim[p]; const float mag = expf(lr * dt); float sn, cs; sincosf(li * dt, &sn, &cs);
        const float ar = mag * cs, ai = mag * sn; float xr_ = 1.f, xi_ = 0.f;
        for (int k = 0; k <= kmax; ++k) { if (k >= kmin) Ap[k * 64 + p] = (f32x2){xr_, xi_}; const float nr = xr_ * ar - xi_ * ai, ni = xr_ * ai + xi_ * ar; xr_ = nr; xi_ = ni; } }
    __syncthreads();
}
constexpr size_t WS_KTAB = WS_S;
constexpr size_t WS_WRIMG = WS_AL + 512 * 1024;
__device__ __forceinline__ void p0_s5k_job(Frame& F, int job) {
    const int g = job >> 3, part = job & 7;
    LAS f32x2* Bb = (LAS f32x2*)F.lds; LAS f32x2* Cc = Bb + 1024; LAS f32x2* Ap = Cc + 1024;
    s5_setup(F, g, 4 * part, 4 * part + 3, Bb, Cc, Ap);
    float* kt = WSP(float, WS_KTAB) + (size_t)g * 32 * 256;
    for (int e = 4 * part * 256 + F.tid; e < (4 * part + 4) * 256; e += 512) { const int k = e >> 8, c = (e >> 4) & 15, c2 = e & 15; float s = 0.f;
        for (int p = 0; p < 64; ++p) { const f32x2 cv = Cc[c * 64 + p], av = Ap[k * 64 + p], bv = Bb[p * 16 + c2];
            const float car = cv.x * av.x - cv.y * av.y, cai = cv.x * av.y + cv.y * av.x; s += car * bv.x - cai * bv.y; }
        kt[e] = s; }
    __syncthreads();
}
__device__ __forceinline__ void p1_s5w_job(Frame& F, int job) {
    const int g = job >> 3, part = job & 7;
    LAS f32x2* Bb = (LAS f32x2*)F.lds; LAS f32x2* Cc = Bb + 1024; LAS f32x2* Ap = Cc + 1024; LAS float* Kt = (LAS float*)(Ap + 33 * 64);
    const float* ktg = WSP(float, WS_KTAB) + (size_t)g * 32 * 256; const float* dsk = F.in[21] + g * 16;
    for (int i = F.tid; i < 32 * 256; i += 512) Kt[i] = ktg[i];
    s5_setup(F, g, 0, S5L, Bb, Cc, Ap);
    if (part == 0 && F.tid < 64) WSP(f32x2, WS_AL)[g * 64 + F.tid] = Ap[S5L * 64 + F.tid];
    bf16* wy = WSP(bf16, WS_WY) + (size_t)g * 512 * S5ROW;
    for (int ch = F.tid; ch < 64 * (S5ROW / 8); ch += 512) { const int n = part * 64 + ch / (S5ROW / 8), k8 = (ch % (S5ROW / 8)) * 8, i = n >> 4, c = n & 15; float v[8];
        if (k8 < 128) {
#pragma unroll
            for (int j = 0; j < 8; j += 2) { const int p = (k8 + j) >> 1; const f32x2 cv = Cc[c * 64 + p], av = Ap[(i + 1) * 64 + p]; v[j] = cv.x * av.x - cv.y * av.y; v[j + 1] = -(cv.x * av.y + cv.y * av.x); } }
        else { const int jj = (k8 - 128) >> 4, c2 = (k8 - 128) & 15;
#pragma unroll
            for (int j = 0; j < 8; ++j) { float x = 0.f; if (jj <= i) { x = Kt[(i - jj) * 256 + c * 16 + c2 + j]; if (jj == i && c == c2 + j) x += dsk[c]; } v[j] = x; } }
        u32x4 o; o.x = pk2(v[0], v[1]); o.y = pk2(v[2], v[3]); o.z = pk2(v[4], v[5]); o.w = pk2(v[6], v[7]);
        *(u32x4*)(wy + (size_t)n * S5ROW + k8) = o; }
    bf16* wsm = WSP(bf16, WS_WS) + (size_t)g * 256 * 512;
    for (int ch = F.tid; ch < 32 * 64; ch += 512) { const int n = part * 32 + (ch >> 6), k8 = (ch & 63) * 8, jj = k8 >> 4, c2 = k8 & 15; float v[8];
#pragma unroll
        for (int j = 0; j < 8; ++j) { float x = 0.f; if (n < 128) { const int p = n >> 1; const f32x2 av = Ap[(S5L - 1 - jj) * 64 + p], bv = Bb[p * 16 + c2 + j]; x = (n & 1) ? (av.x * bv.y + av.y * bv.x) : (av.x * bv.x - av.y * bv.y); } v[j] = x; }
        u32x4 o; o.x = pk2(v[0], v[1]); o.y = pk2(v[2], v[3]); o.z = pk2(v[4], v[5]); o.w = pk2(v[6], v[7]);
        *(u32x4*)(wsm + (size_t)n * 512 + k8) = o; }
    __syncthreads();
}
__device__ __forceinline__ void p0_small_transposes(Frame& F) {
    LAS float* scr = (LAS float*)(F.lds + F.wave * 16384);
    const int gw = F.vcu * 8 + F.wave, NGW = F.G * 8;
    constexpr int I_IN = 16 * 144, I_RNN = 16 * 32, I_OUT = 16 * 32, I_GLU = 8 * 64, I_RG = 16 * 8;
    for (int it = gw; it < I_IN + I_RNN + I_OUT + I_GLU + I_RG; it += NGW) { int r = it;
        if (r < I_IN) { const int kb = r / 144, nb = r % 144; transpose_item8(F.in[4], INC, kb * 64, nb * 32, WSP(unsigned char, WS_WIN), 1024, nb * 32, scr, F.lane); continue; } r -= I_IN;
        if (r < I_RNN) { const int kb = r / 32, nb = r % 32; transpose_item8(F.in[13], 1024, kb * 64, nb * 32, WSP(unsigned char, WS_WRNN), 1024, nb * 32, scr, F.lane); continue; } r -= I_RNN;
        if (r < I_OUT) { const int kb = r / 32, nb = r % 32; transpose_item8(F.in[23], 1024, kb * 64, nb * 32, WSP(unsigned char, WS_WOUT), 1024, nb * 32, scr, F.lane); continue; } r -= I_OUT;
        if (r < I_GLU) { const int kb = r / 64, nb = r % 64; transpose_item8(F.in[22], 2048, kb * 64, nb * 32, WSP(unsigned char, WS_WGLU), 512, pair_row(nb * 32), scr, F.lane); continue; } r -= I_GLU;
        { const int mat = r >> 3, kb = (r >> 2) & 1, nb = r & 3, hd = mat & 7, gx = mat >> 3;
          transpose_item(F.in[gx ? 10 : 8] + (size_t)hd * 128 * 128, 128, kb * 64, nb * 32, WSP(bf16, WS_WG), 128, hd * 256 + gx * 128 + nb * 32, scr, F.lane); }
    }
}
__device__ __forceinline__ void p1_body(Frame& F) {
    const int gw = F.vcu * 8 + F.wave, NGW = F.G * 8; const float* mod = WSP(float, WS_MOD); bf16* hbf = WSP(bf16, WS_HBF);
    for (int tb = gw; tb < T; tb += 4 * NGW) {
        f32x4 xv[4][4];
#pragma unroll
        for (int r = 0; r < 4; ++r) { const int t = tb + r * NGW; const f32x4* xr = (const f32x4*)(F.in[0] + (size_t)(t < T ? t : 0) * 1024) + F.lane;
#pragma unroll
            for (int j = 0; j < 4; ++j) xv[r][j] = xr[64 * j]; }
#pragma unroll
        for (int r = 0; r < 4; ++r) { const int t = tb + r * NGW; if (t < T) { const int b = t >> 12; const f32x4* sh = (const f32x4*)(mod + b * 6144) + F.lane; const f32x4* sc = (const f32x4*)(mod + b * 6144 + 1024) + F.lane;
            unsigned* o = (unsigned*)((unsigned char*)hbf + (size_t)t * 1024) + F.lane;
#pragma unroll
            for (int j = 0; j < 4; ++j) { const f32x4 v = xv[r][j] * (sc[64 * j] + 1.0f) + sh[64 * j]; o[64 * j] = pk4_fp8(v[0], v[1], v[2], v[3]); } } } }
    constexpr int TP = 132;
    LAS float* tile = (LAS float*)F.lds;
    constexpr int TILES_GU = 8 * 16, TILES_D = 8 * 8, TILES_E = TILES_GU + TILES_D;
    const int lr = F.tid >> 5, lc4 = (F.tid & 31) * 4, tn = F.tid >> 2, kc = F.tid & 3;
    f32x4 pre[8];
    int ti = F.vcu;
#define P1_SRC(idx, src, N_, dstp, drow0_, k0_) do { const int e_ = (idx) / TILES_E, r_ = (idx) % TILES_E; \
        if (r_ < TILES_GU) { const int kb_ = r_ >> 4, nb_ = r_ & 15; N_ = 2048; src = F.in[28] + (size_t)e_ * 1024 * 2048 + (size_t)(kb_ * 128) * 2048 + nb_ * 128; dstp = WSP(unsigned char, WS_WGU) + (size_t)e_ * 2048 * 1024; drow0_ = pair_row(nb_ * 128); k0_ = kb_ * 128; } \
        else { const int q_ = r_ - TILES_GU, kb_ = q_ >> 3, nb_ = q_ & 7; N_ = 1024; src = F.in[30] + (size_t)e_ * 1024 * 1024 + (size_t)(kb_ * 128) * 1024 + nb_ * 128; dstp = WSP(unsigned char, WS_WD) + (size_t)e_ * 1024 * 1024; drow0_ = nb_ * 128; k0_ = kb_ * 128; } } while (0)
    if (ti < NE * TILES_E) { const float* src; unsigned char* dstp; int N_, d0, k0; P1_SRC(ti, src, N_, dstp, d0, k0);
#pragma unroll
        for (int i = 0; i < 8; ++i) pre[i] = *(const f32x4*)(src + (size_t)(lr + 16 * i) * N_ + lc4); }
    for (; ti < NE * TILES_E; ti += F.G) {
#pragma unroll
        for (int i = 0; i < 8; ++i) *(LAS f32x4*)(tile + (lr + 16 * i) * TP + lc4) = pre[i];
        __syncthreads();
        const int tnx = ti + F.G;
        if (tnx < NE * TILES_E) { const float* src; unsigned char* dstp; int N_, d0, k0; P1_SRC(tnx, src, N_, dstp, d0, k0);
#pragma unroll
            for (int i = 0; i < 8; ++i) pre[i] = *(const f32x4*)(src + (size_t)(lr + 16 * i) * N_ + lc4); }
        { const float* src; unsigned char* dstp; int N_, d0, k0; P1_SRC(ti, src, N_, dstp, d0, k0); (void)src; (void)N_;
          const LAS float* cp = tile + (32 * kc) * TP + tn; u32x4 o0, o1;
          o0.x = pk4_fp8(32.f * cp[0 * TP], 32.f * cp[1 * TP], 32.f * cp[2 * TP], 32.f * cp[3 * TP]); o0.y = pk4_fp8(32.f * cp[4 * TP], 32.f * cp[5 * TP], 32.f * cp[6 * TP], 32.f * cp[7 * TP]);
          o0.z = pk4_fp8(32.f * cp[8 * TP], 32.f * cp[9 * TP], 32.f * cp[10 * TP], 32.f * cp[11 * TP]); o0.w = pk4_fp8(32.f * cp[12 * TP], 32.f * cp[13 * TP], 32.f * cp[14 * TP], 32.f * cp[15 * TP]);
          o1.x = pk4_fp8(32.f * cp[16 * TP], 32.f * cp[17 * TP], 32.f * cp[18 * TP], 32.f * cp[19 * TP]); o1.y = pk4_fp8(32.f * cp[20 * TP], 32.f * cp[21 * TP], 32.f * cp[22 * TP], 32.f * cp[23 * TP]);
          o1.z = pk4_fp8(32.f * cp[24 * TP], 32.f * cp[25 * TP], 32.f * cp[26 * TP], 32.f * cp[27 * TP]); o1.w = pk4_fp8(32.f * cp[28 * TP], 32.f * cp[29 * TP], 32.f * cp[30 * TP], 32.f * cp[31 * TP]);
          unsigned char* op = dstp + (size_t)(d0 + tn) * 1024 + k0 + 32 * kc; *(u32x4*)op = o0; *(u32x4*)(op + 16) = o1; }
        __syncthreads();
    }
#undef P1_SRC
}
constexpr int XR_LD = 136, XR_TILE = 128 * XR_LD;
__device__ __forceinline__ void rg_issue(const bf16* xrnn, const bf16* gy, int item, int tid, u32x4 (&xraw)[4][4], u32x4 (&graw)[4], bool pass1) {
    const int hd = item & 7, c = (item >> 3) & 31, b = item >> 8, r0 = tid >> 4, ch = hd * 128 + (tid & 15) * 8;
#pragma unroll
    for (int q = 0; q < 4; ++q) { const int r = r0 + 32 * q;
#pragma unroll
        for (int k = 0; k < 4; ++k) { const int tp = c * RGL + r - 3 + k, tpc = tp < 0 ? 0 : tp; xraw[q][k] = *(const u32x4*)(xrnn + (size_t)(b * SEQ + tpc) * 1024 + ch); }
        if (pass1) graw[q] = *(const u32x4*)(gy + (size_t)(b * SEQ + c * RGL + r) * 1024 + ch); }
}
__device__ __forceinline__ void rg_convwrite(const float* cw, const float* cb, int item, int tid, const u32x4 (&xraw)[4][4], const u32x4 (&graw)[4], LAS bf16* xr, LAS bf16* gyt, bool pass1) {
    const int hd = item & 7, c = (item >> 3) & 31, r0 = tid >> 4, c8 = (tid & 15) * 8, ch = hd * 128 + c8;
    const f32x4 b0 = *(const f32x4*)(cb + ch), b1 = *(const f32x4*)(cb + ch + 4);
    f32x4 w0[4], w1[4];
#pragma unroll
    for (int k = 0; k < 4; ++k) { w0[k] = *(const f32x4*)(cw + k * 1024 + ch); w1[k] = *(const f32x4*)(cw + k * 1024 + ch + 4); }
#pragma unroll
    for (int q = 0; q < 4; ++q) { const int r = r0 + 32 * q; f32x4 a0 = b0, a1 = b1;
#pragma unroll
        for (int k = 0; k < 4; ++k) { const int tp = c * RGL + r - 3 + k; f32x4 x0, x1; unpack8(xraw[q][k], x0, x1); if (tp < 0) { x0 = (f32x4){0.f, 0.f, 0.f, 0.f}; x1 = x0; } a0 += w0[k] * x0; a1 += w1[k] * x1; }
        *(LAS u32x4*)(xr + r * XR_LD + c8) = pack8(a0, a1);
        if (pass1) *(LAS u32x4*)(gyt + r * XR_LD + c8) = graw[q]; }
}
template <int PASS>
__device__ __forceinline__ void rglru_phase(Frame& F) {
    const int NIT = NB * RGC * 8;
    const bool skew = (PASS == 0) && (F.G == 256);
    const int nmine = skew ? (F.vcu < 128 ? 7 : 9) : (NIT - F.vcu + F.G - 1) / F.G;
#define RG_ITEM(k) ((skew && (k) >= 7) ? (1792 + (F.vcu - 128) + 128 * ((k) - 7)) : (F.vcu + (k) * F.G))
    if (nmine <= 0) return;
    int it = RG_ITEM(0);
    LAS bf16* xr = (LAS bf16*)F.lds; LAS bf16* gyt0 = xr + XR_TILE;
    const bf16* xrnn = WSP(bf16, WS_XRNN); const bf16* gy = WSP(bf16, WS_GY); bf16* ha = WSP(bf16, WS_HA); const float* cw = F.in[6]; const float* cb = F.in[7];
    const int tid = F.tid, w = F.wave, q = F.lane >> 4, col = F.lane & 15, chl = 16 * w + col;
    u32x4 xraw[4][4], graw[4];
    rg_issue(xrnn, gy, it, tid, xraw, graw, PASS);
    rg_convwrite(cw, cb, it, tid, xraw, graw, xr, gyt0, PASS);
    int hd_loaded = -1; bf16x8 Bf[2][4]; float ba = 0.f, bx = 0.f, sp = 0.f;
    __syncthreads();
    for (int i = 0; i < nmine; ++i) {
        const bool has_next = (i + 1) < nmine; const int nit = has_next ? RG_ITEM(i + 1) : it;
        const int hd = it & 7, c = (it >> 3) & 31, b = it >> 8, t0 = b * SEQ + c * RGL, ch = hd * 128 + chl;
        LAS bf16* gyt = gyt0 + (i & 1) * XR_TILE; LAS bf16* gytn = gyt0 + ((i & 1) ^ 1) * XR_TILE;
        if (hd != hd_loaded) { hd_loaded = hd; const bf16* wg = WSP(bf16, WS_WG) + (size_t)hd * 256 * 128;
#pragma unroll
            for (int gt = 0; gt < 2; ++gt)
#pragma unroll
                for (int kk = 0; kk < 4; ++kk) Bf[gt][kk] = *(const bf16x8*)(wg + (size_t)(gt * 128 + chl) * 128 + kk * 32 + q * 8);
            ba = F.in[9][ch]; bx = F.in[11][ch]; const float lam = F.in[12][ch]; sp = (lam > 15.f) ? __expf(-lam) : log1pf(__expf(-lam)); }
        float carryH = 0.f, carryP = 1.f;
        if (PASS) carryH = WSP(float, WS_HIN)[(size_t)(b * RGC + c) * 1024 + ch];
        __builtin_amdgcn_sched_barrier(0);
        if (has_next) rg_issue(xrnn, gy, nit, tid, xraw, graw, PASS);
        __builtin_amdgcn_sched_barrier(0);
        f32x4 acc[8][2];
#pragma unroll
        for (int m = 0; m < 8; ++m) { acc[m][0] = (f32x4){0.f, 0.f, 0.f, 0.f}; acc[m][1] = (f32x4){0.f, 0.f, 0.f, 0.f}; }
#pragma unroll
        for (int kk = 0; kk < 4; ++kk)
#pragma unroll
            for (int m = 0; m < 8; ++m) { const bf16x8 Af = *(const LAS bf16x8*)(xr + (16 * m + col) * XR_LD + kk * 32 + q * 8);
                acc[m][0] = __builtin_amdgcn_mfma_f32_16x16x32_bf16(Af, Bf[0][kk], acc[m][0], 0, 0, 0);
                acc[m][1] = __builtin_amdgcn_mfma_f32_16x16x32_bf16(Af, Bf[1][kk], acc[m][1], 0, 0, 0); }
#pragma unroll
        for (int m = 0; m < 8; ++m) {
            float a[4], uu[4];
#pragma unroll
            for (int j = 0; j < 4; ++j) { const int tl = 16 * m + 4 * q + j;
                const float r = fast_sigmoid(acc[m][0][j] + ba), ii = fast_sigmoid(acc[m][1][j] + bx);
                const float la = -11.541560327f * r * sp; a[j] = __builtin_amdgcn_exp2f(la); const float mult = __builtin_amdgcn_sqrtf(fmaxf(1.0f - a[j] * a[j], 0.f));
                uu[j] = mult * ii * bf1(xr[tl * XR_LD + chl]); }
            float sP = a[0], sH = uu[0];
#pragma unroll
            for (int j = 1; j < 4; ++j) { sH = a[j] * sH + uu[j]; sP *= a[j]; }
            float iP = sP, iH = sH;
            { const float pP = __shfl_up(iP, 16), pH = __shfl_up(iH, 16); if (q >= 1) { iH = iP * pH + iH; iP = iP * pP; } }
            { const float pP = __shfl_up(iP, 32), pH = __shfl_up(iH, 32); if (q >= 2) { iH = iP * pH + iH; iP = iP * pP; } }
            float eP = __shfl_up(iP, 16), eH = __shfl_up(iH, 16); if (q == 0) { eP = 1.f; eH = 0.f; }
            const float tP = __shfl(iP, col + 48), tH = __shfl(iH, col + 48);
            if (PASS) { float h = eP * carryH + eH;
#pragma unroll
                for (int j = 0; j < 4; ++j) { const int tl = 16 * m + 4 * q + j; h = a[j] * h + uu[j]; LAS bf16* gp = gyt + tl * XR_LD + chl; *gp = (bf16)f2bf(h * bf1(*gp)); } }
            carryH = tP * carryH + tH; carryP *= tP;
        }
        if (!PASS && q == 0) { f32x2* ag = WSP(f32x2, WS_RGAGG); ag[(size_t)(b * RGC + c) * 1024 + ch] = (f32x2){carryP, carryH}; }
        __syncthreads();
        if (PASS) { const int r0 = tid >> 4, c8 = (tid & 15) * 8;
#pragma unroll
            for (int qq = 0; qq < 4; ++qq) { const int r = r0 + 32 * qq; f32x4 h0, h1; unpack8(*(const LAS u32x4*)(gyt + r * XR_LD + c8), h0, h1); u32x2 w8; w8.x = pk4_fp8(h0[0], h0[1], h0[2], h0[3]); w8.y = pk4_fp8(h1[0], h1[1], h1[2], h1[3]);
                *(u32x2*)((unsigned char*)ha + (size_t)(t0 + r) * 1024 + hd * 128 + c8) = w8; } }
#pragma unroll
        for (int qq = 0; qq < 4; ++qq) {
#pragma unroll
            for (int k = 0; k < 4; ++k) asm volatile("" : "+v"(xraw[qq][k]));
            if (PASS) asm volatile("" : "+v"(graw[qq])); }
        if (has_next) rg_convwrite(cw, cb, nit, tid, xraw, graw, xr, gytn, PASS);
        __syncthreads();
        it = nit;
    }
#undef RG_ITEM
}
__device__ __forceinline__ void p4_carries(Frame& F) {
    LAS f32x2* seg = (LAS f32x2*)F.lds;
    for (int job = F.vcu; job < NB * S5G; job += F.G) {
        const int b = job >> 5, g = job & 31, p = F.lane, w = F.wave;
        const f32x2 al = WSP(f32x2, WS_AL)[g * 64 + p];
        const f32x2* Sb = WSP(f32x2, WS_S) + ((size_t)(g * S5M + b * S5CPB + 16 * w)) * 64 + p; unsigned* ac = (unsigned*)(WSP(bf16, WS_ACAT) + ((size_t)(g * S5M + b * S5CPB + 16 * w)) * S5ROW) + p;
        f32x2 sv[16];
#pragma unroll
        for (int i = 0; i < 16; ++i) sv[i] = Sb[(size_t)i * 64];
        float xr_ = 0.f, xi = 0.f;
#pragma unroll
        for (int i = 0; i < 16; ++i) { const float nr = al.x * xr_ - al.y * xi + sv[i].x, ni = al.x * xi + al.y * xr_ + sv[i].y; xr_ = nr; xi = ni; }
        seg[w * 64 + p] = (f32x2){xr_, xi};
        float ar = al.x, ai = al.y;
#pragma unroll
        for (int q = 0; q < 4; ++q) { const float nr = ar * ar - ai * ai, ni = 2.f * ar * ai; ar = nr; ai = ni; }
        __syncthreads();
        xr_ = 0.f; xi = 0.f;
        for (int ww = 0; ww < w; ++ww) { const f32x2 sg = seg[ww * 64 + p]; const float nr = ar * xr_ - ai * xi + sg.x, ni = ar * xi + ai * xr_ + sg.y; xr_ = nr; xi = ni; }
#pragma unroll
        for (int i = 0; i < 16; ++i) { ac[(size_t)i * (S5ROW / 2)] = pk2(xr_, xi); const float nr = al.x * xr_ - al.y * xi + sv[i].x, ni = al.x * xi + al.y * xr_ + sv[i].y; xr_ = nr; xi = ni; }
        __syncthreads();
    }
    if (F.vcu < 16) {
        const int id = F.vcu * 512 + F.tid, ch = id & 1023, b = id >> 10; const f32x2* ag = WSP(f32x2, WS_RGAGG) + (size_t)b * RGC * 1024 + ch; float* hin = WSP(float, WS_HIN) + (size_t)b * RGC * 1024 + ch;
        f32x2 a[RGC];
#pragma unroll
        for (int c = 0; c < RGC; ++c) a[c] = ag[(size_t)c * 1024];
        float h = 0.f;
#pragma unroll
        for (int c = 0; c < RGC; ++c) { hin[(size_t)c * 1024] = h; h = a[c].x * h + a[c].y; }
    }
}
constexpr int WR_LD = 1032;
__device__ __forceinline__ void p9_router(Frame& F) {
    LAS bf16* wH = (LAS bf16*)F.lds; LAS bf16* wL = wH + 32 * WR_LD;
    LAS f32x2* sel = (LAS f32x2*)(wL + 32 * WR_LD);
    LAS unsigned* rec = (LAS unsigned*)(sel + 512);
    LAS float* recp = (LAS float*)(rec + 512);
    LAS int* lcnt = (LAS int*)(recp + 512);
    LAS int* gbase = lcnt + 32;
    { const u32x4* img = WSP(u32x4, WS_WRIMG); LAS u32x4* dst = (LAS u32x4*)wH;
      for (int i = F.tid; i < 2 * 32 * WR_LD * 2 / 16; i += 512) dst[i] = img[i]; }
    if (F.tid < 32) lcnt[F.tid] = 0;
    __syncthreads();
    const float* mod = WSP(float, WS_MOD); const bf16* v1 = WSP(bf16, WS_V1); bf16* x1 = WSP(bf16, WS_X1); unsigned char* h2 = WSP(unsigned char, WS_H2);
    const int lane = F.lane, m = lane & 15, kq = lane >> 4, w = F.wave;
    for (int blk = F.vcu; blk < T / 128; blk += F.G) {
        const int t = blk * 128 + w * 16 + m, b = (blk * 128) >> 12;
        const bf16* vrow = v1 + (size_t)t * 1024 + 8 * kq;
        float sum = 0.f, sq = 0.f;
#pragma unroll 32
        for (int s_ = 0; s_ < 32; ++s_) { f32x4 a, c; unpack8(*(const u32x4*)(vrow + 32 * s_), a, c); sum += ((a[0] + a[1]) + (a[2] + a[3])) + ((c[0] + c[1]) + (c[2] + c[3]));
            sq += ((a[0] * a[0] + a[1] * a[1]) + (a[2] * a[2] + a[3] * a[3])) + ((c[0] * c[0] + c[1] * c[1]) + (c[2] * c[2] + c[3] * c[3])); }
        sum += __shfl_xor(sum, 16); sum += __shfl_xor(sum, 32); sq += __shfl_xor(sq, 16); sq += __shfl_xor(sq, 32);
        const float mean = sum * (1.f / 1024.f); const float rstd = 1.f / sqrtf(fmaxf(sq * (1.f / 1024.f) - mean * mean, 0.f) + LN_EPS);
        f32x4 acc[2] = {(f32x4){0.f, 0.f, 0.f, 0.f}, (f32x4){0.f, 0.f, 0.f, 0.f}};
        const float* lng = F.in[24] + 8 * kq; const float* lnb = F.in[25] + 8 * kq; const float* shp = mod + b * 6144 + 3072 + 8 * kq; const float* scp = mod + b * 6144 + 4096 + 8 * kq;
        bf16* x1row = x1 + (size_t)t * 1024 + 8 * kq; unsigned char* h2row = h2 + (size_t)t * 1024 + 8 * kq;
        const LAS bf16* wHr = wH + m * WR_LD + 8 * kq; const LAS bf16* wLr = wL + m * WR_LD + 8 * kq;
#pragma unroll 2
        for (int s2 = 0; s2 < 32; s2 += 2) {
            u32x4 rw[2]; f32x4 pg[2][2], pb[2][2], psh[2][2], psc[2][2];
#pragma unroll
            for (int h = 0; h < 2; ++h) { const int ko = 32 * (s2 + h); rw[h] = *(const u32x4*)(vrow + ko);
                pg[h][0] = *(const f32x4*)(lng + ko); pg[h][1] = *(const f32x4*)(lng + ko + 4); pb[h][0] = *(const f32x4*)(lnb + ko); pb[h][1] = *(const f32x4*)(lnb + ko + 4);
                psh[h][0] = *(const f32x4*)(shp + ko); psh[h][1] = *(const f32x4*)(shp + ko + 4); psc[h][0] = *(const f32x4*)(scp + ko); psc[h][1] = *(const f32x4*)(scp + ko + 4); }
#pragma unroll
            for (int h = 0; h < 2; ++h) { const int ko = 32 * (s2 + h);
                f32x4 a, c; unpack8(rw[h], a, c);
                const f32x4 x0 = (a - mean) * rstd * pg[h][0] + pb[h][0], x1v = (c - mean) * rstd * pg[h][1] + pb[h][1];
                *(u32x4*)(x1row + ko) = pack8(x0, x1v);
                const f32x4 h0 = x0 * (psc[h][0] + 1.0f) + psh[h][0], h1 = x1v * (psc[h][1] + 1.0f) + psh[h][1];
                u32x2 w8; w8.x = pk4_fp8(h0[0], h0[1], h0[2], h0[3]); w8.y = pk4_fp8(h1[0], h1[1], h1[2], h1[3]); *(u32x2*)(h2row + ko) = w8;
                const u32x4 hi = pack8(h0, h1); f32x4 r0, r1; unpack8(hi, r0, r1); const u32x4 lo = pack8(h0 - r0, h1 - r1);
                const bf16x8 ah = __builtin_bit_cast(bf16x8, hi), al = __builtin_bit_cast(bf16x8, lo);
#pragma unroll
                for (int nf = 0; nf < 2; ++nf) { const bf16x8 bh = *(const LAS bf16x8*)(wHr + nf * 16 * WR_LD + ko), bl = *(const LAS bf16x8*)(wLr + nf * 16 * WR_LD + ko);
                    acc[nf] = __builtin_amdgcn_mfma_f32_16x16x32_bf16(bh, ah, acc[nf], 0, 0, 0);
                    acc[nf] = __builtin_amdgcn_mfma_f32_16x16x32_bf16(bl, ah, acc[nf], 0, 0, 0);
                    acc[nf] = __builtin_amdgcn_mfma_f32_16x16x32_bf16(bh, al, acc[nf], 0, 0, 0); } } }
        float lv[8];
#pragma unroll
        for (int nf = 0; nf < 2; ++nf)
#pragma unroll
            for (int j = 0; j < 4; ++j) lv[nf * 4 + j] = acc[nf][j] + F.in[27][nf * 16 + 4 * kq + j];
        int rank[8];
#pragma unroll
        for (int i = 0; i < 8; ++i) { rank[i] = 0;
#pragma unroll
            for (int i2 = 0; i2 < 8; ++i2) if (i2 != i) { const int e1 = (i >> 2) * 16 + 4 * kq + (i & 3), e2 = (i2 >> 2) * 16 + 4 * kq + (i2 & 3); rank[i] += (lv[i2] > lv[i] || (lv[i2] == lv[i] && e2 < e1)) ? 1 : 0; } }
#pragma unroll
        for (int dq = 1; dq < 4; ++dq) { const int q2 = kq ^ dq;
#pragma unroll
            for (int i2 = 0; i2 < 8; ++i2) { const float o = __shfl_xor(lv[i2], 16 * dq); const int e2 = (i2 >> 2) * 16 + 4 * q2 + (i2 & 3);
#pragma unroll
                for (int i = 0; i < 8; ++i) { const int e1 = (i >> 2) * 16 + 4 * kq + (i & 3); rank[i] += (o > lv[i] || (o == lv[i] && e2 < e1)) ? 1 : 0; } } }
#pragma unroll
        for (int i = 0; i < 8; ++i) if (rank[i] < 4) { const int e1 = (i >> 2) * 16 + 4 * kq + (i & 3); sel[(w * 16 + m) * 4 + rank[i]] = (f32x2){__builtin_bit_cast(float, e1), lv[i]}; }
        asm volatile("s_waitcnt lgkmcnt(0)" ::: "memory");
        { const int tm = lane >> 2, k = lane & 3; const f32x2 s0 = sel[(w * 16 + tm) * 4 + 0], s1 = sel[(w * 16 + tm) * 4 + 1], s2 = sel[(w * 16 + tm) * 4 + 2], s3 = sel[(w * 16 + tm) * 4 + 3];
          const float p0 = 1.f, p1 = __expf(s1.y - s0.y), p2 = __expf(s2.y - s0.y), p3 = __expf(s3.y - s0.y), ps = (p0 + p1) + (p2 + p3);
          const f32x2 mine = k == 0 ? s0 : (k == 1 ? s1 : (k == 2 ? s2 : s3)); const float pm = (k == 0 ? p0 : (k == 1 ? p1 : (k == 2 ? p2 : p3))) / ps;
          const int e = __builtin_bit_cast(int, mine.x);
          const int lr = __hip_atomic_fetch_add(lcnt + e, 1, __ATOMIC_RELAXED, __HIP_MEMORY_SCOPE_WORKGROUP);
          rec[(w * 16 + tm) * 4 + k] = ((unsigned)e << 16) | (unsigned)lr; recp[(w * 16 + tm) * 4 + k] = pm; }
        __syncthreads();
        if (F.tid < 32) { const int n = lcnt[F.tid]; gbase[F.tid] = n ? (int)atomicAdd(F.ctl + CW_CNT + 64 * F.tid, (unsigned)n) : 0; lcnt[F.tid] = 0; }
        __syncthreads();
        { const unsigned r = rec[F.tid]; const int e = r >> 16, rk = gbase[e] + (int)(r & 0xffffu), tt = blk * 128 + (F.tid >> 2);
          WSP(int, WS_TOK)[(size_t)e * T + rk] = tt; WSP(unsigned, WS_POS)[(size_t)tt * 4 + (F.tid & 3)] = ((unsigned)e << 20) | (unsigned)rk; WSP(float, WS_PROB)[(size_t)tt * 4 + (F.tid & 3)] = recp[F.tid]; }
        __syncthreads();
    }
}
__device__ __forceinline__ void p12_final(Frame& F) {
    moe_tables(F);
    const LAS int* tstart = (const LAS int*)(F.lds + TAB_OFF);
    const float* mod = WSP(float, WS_MOD); const bf16* x1 = WSP(bf16, WS_X1); const bf16* yb = WSP(bf16, WS_YB); const unsigned* pos = WSP(unsigned, WS_POS); const float* prob = WSP(float, WS_PROB);
    const int lane = F.lane, gw = F.vcu * 8 + F.wave, NGW = F.G * 8;
    f32x4 lg[4], lb[4];
#pragma unroll
    for (int j = 0; j < 4; ++j) { lg[j] = *(const f32x4*)(F.in[32] + 512 * (j >> 1) + 8 * lane + 4 * (j & 1)); lb[j] = *(const f32x4*)(F.in[33] + 512 * (j >> 1) + 8 * lane + 4 * (j & 1)); }
#define P12_ROUTE(PP, PW, tt) do { const u32x4 p4_ = *(const u32x4*)(pos + (size_t)(tt) * 4); const f32x4 w4_ = *(const f32x4*)(prob + (size_t)(tt) * 4); \
        PP[0] = p4_.x; PP[1] = p4_.y; PP[2] = p4_.z; PP[3] = p4_.w; PW[0] = w4_[0]; PW[1] = w4_[1]; PW[2] = w4_[2]; PW[3] = w4_[3]; } while (0)
#define P12_ROWS(YW, XW, PP, tt) do { _Pragma("unroll") for (int k = 0; k < 4; ++k) { const int e_ = PP[k] >> 20, rk_ = PP[k] & 0xfffffu; const size_t slot_ = (size_t)tstart[e_] * 256 + rk_; \
            _Pragma("unroll") for (int j = 0; j < 2; ++j) YW[k][j] = *((const u32x2*)((const unsigned char*)yb + slot_ * 1024) + 64 * j + lane); } \
        _Pragma("unroll") for (int j = 0; j < 2; ++j) XW[j] = *((const u32x4*)(x1 + (size_t)(tt) * 1024) + 64 * j + lane); } while (0)
#define P12_COMPUTE(YW, XW, PW, tt) do { const int b_ = (tt) >> 12; f32x4 v[4]; float s_ = 0.f; \
        _Pragma("unroll") for (int j = 0; j < 2; ++j) { f32x4 f0 = (f32x4){0.f, 0.f, 0.f, 0.f}, f1 = f0; \
            _Pragma("unroll") for (int k = 0; k < 4; ++k) { const u32x2 yv_ = YW[k][j]; const f32x2 q0_ = __builtin_amdgcn_cvt_pk_f32_fp8((int)yv_.x, false), q1_ = __builtin_amdgcn_cvt_pk_f32_fp8((int)yv_.x, true), q2_ = __builtin_amdgcn_cvt_pk_f32_fp8((int)yv_.y, false), q3_ = __builtin_amdgcn_cvt_pk_f32_fp8((int)yv_.y, true); \
                f0 += (f32x4){q0_.x, q0_.y, q1_.x, q1_.y} * PW[k]; f1 += (f32x4){q2_.x, q2_.y, q3_.x, q3_.y} * PW[k]; } \
            f32x4 xa_, xc_; unpack8(XW[j], xa_, xc_); const float* gp_ = mod + b_ * 6144 + 5120 + 512 * j + 8 * lane; \
            v[2 * j] = xa_ * DN_ALPHA + (*(const f32x4*)gp_ + 1.0f) * f0; v[2 * j + 1] = xc_ * DN_ALPHA + (*(const f32x4*)(gp_ + 4) + 1.0f) * f1; \
            s_ += ((v[2 * j][0] + v[2 * j][1]) + (v[2 * j][2] + v[2 * j][3])) + ((v[2 * j + 1][0] + v[2 * j + 1][1]) + (v[2 * j + 1][2] + v[2 * j + 1][3])); } \
        const float mean_ = wave_sum(s_) * (1.f / 1024.f); float s2_ = 0.f; \
        _Pragma("unroll") for (int j = 0; j < 4; ++j) { v[j] = v[j] - mean_; s2_ += (v[j][0] * v[j][0] + v[j][1] * v[j][1]) + (v[j][2] * v[j][2] + v[j][3] * v[j][3]); } \
        const float rstd_ = 1.f / sqrtf(wave_sum(s2_) * (1.f / 1024.f) + LN_EPS); \
        _Pragma("unroll") for (int j = 0; j < 4; ++j) *(f32x4*)(F.out + (size_t)(tt) * 1024 + 512 * (j >> 1) + 8 * lane + 4 * (j & 1)) = v[j] * rstd_ * lg[j] + lb[j]; } while (0)
    const int nmine = (T - gw + NGW - 1) / NGW;
    unsigned ppA[4], ppB[4]; float pwA[4], pwB[4], pwN[4]; u32x2 ywA[4][2], ywB[4][2]; u32x4 xwA[2], xwB[2];
    if (nmine > 0) { P12_ROUTE(ppA, pwA, gw); P12_ROWS(ywA, xwA, ppA, gw); }
    if (nmine > 1) { P12_ROUTE(ppB, pwB, gw + NGW); }
    for (int i = 0; i < nmine; i += 2) {
        const int t0 = gw + i * NGW, t1 = t0 + NGW, t2 = t1 + NGW, t3 = t2 + NGW;
        if (i + 1 < nmine) { P12_ROWS(ywB, xwB, ppB, t1); }
        if (i + 2 < nmine) { P12_ROUTE(ppA, pwN, t2); }
        __builtin_amdgcn_sched_barrier(0);
        P12_COMPUTE(ywA, xwA, pwA, t0);
        if (i + 1 < nmine) {
#pragma unroll
            for (int k = 0; k < 4; ++k) pwA[k] = pwN[k];
            if (i + 2 < nmine) { P12_ROWS(ywA, xwA, ppA, t2); }
            if (i + 3 < nmine) { P12_ROUTE(ppB, pwN, t3); }
            __builtin_amdgcn_sched_barrier(0);
            P12_COMPUTE(ywB, xwB, pwB, t1);
#pragma unroll
            for (int k = 0; k < 4; ++k) pwB[k] = pwN[k];
        }
    }
#undef P12_ROUTE
#undef P12_ROWS
#undef P12_COMPUTE
}

struct Args { const float* in[34]; float* out; unsigned char* ws; int ph_lo, ph_hi; };
__global__ void __launch_bounds__(512, 2) fwd_kernel(Args args) {
    extern __shared__ __attribute__((aligned(16))) unsigned char lds_raw[];
    Frame F;
    F.lds = (LAS unsigned char*)lds_raw; F.MISC = (volatile LAS unsigned*)(F.lds + MISC_OFF);
    F.tid = threadIdx.x; F.lane = F.tid & 63; F.wave = __builtin_amdgcn_readfirstlane(F.tid >> 6);
    F.G = gridDim.x; { const int bx = blockIdx.x; F.vcu = (F.G % 8 == 0) ? (bx % 8) * (F.G / 8) + bx / 8 : bx; }
#pragma unroll
    for (int i = 0; i < 34; ++i) F.in[i] = args.in[i];
    F.out = args.out; F.ws = args.ws; F.ctl = (unsigned*)(args.ws + WS_CTL);
    if (F.tid < 64) F.MISC[F.tid] = 0u;
    __syncthreads();
    XcdBarrier bar; bar.bar = F.ctl + CW_BAR; bar.x = 0; bar.st = nullptr;
    if (MK_N_LAUNCHES == 1) bar = xcd_barrier_post(F.ctl + CW_BAR, F.MISC + 8);
    const int lo = args.ph_lo, hi = args.ph_hi;
#define IN(k) (lo <= (k) && (k) < hi)
#define SEAM(k) do { if (IN(k) && IN((k) + 1)) xcd_barrier(bar); } while (0)

    if (IN(0)) REPS(0) { if (rep_) xcd_barrier(bar);
        for (int j = F.vcu; j < 192; j += F.G) p0_mod_job(F, j);
        for (int j = F.vcu; j < S5G * 8; j += F.G) p0_s5k_job(F, j);
        { bf16* img = WSP(bf16, WS_WRIMG); const float* wr = F.in[26];
          for (int i = F.vcu * 512 + F.tid; i < 1024 * 32; i += F.G * 512) { const float w = wr[i]; const unsigned hb = f2bf(w); const float hf = __builtin_bit_cast(float, hb << 16);
              img[(i & 31) * 1032 + (i >> 5)] = (bf16)hb; img[32 * 1032 + (i & 31) * 1032 + (i >> 5)] = (bf16)f2bf(w - hf); } }
        p0_small_transposes(F);
    }
    SEAM(0);
    if (IN(1)) REPS(1) { if (rep_) xcd_barrier(bar); for (int j = F.vcu; j < S5G * 8; j += F.G) p1_s5w_job(F, j); p1_body(F); }
    SEAM(1);
    if (IN(2)) REPS(2) { if (rep_) xcd_barrier(bar);
        g8::GridOrder S; S.init(T, INC, F.G, (int)blockIdx.x, WSP(bf16, WS_HBF), WSP(bf16, WS_WIN), 1024, 1024);
        EpiInProj E{F.in[5], WSP(bf16, WS_XRNN), WSP(bf16, WS_GY), WSP(bf16, WS_ACAT), WSP(bf16, WS_GATES)};
        g8::gemm_phase<EpiInProj, g8::GridOrder, false, true>(F.lds, 1024, 1024, 1024, S, E);
    }
    SEAM(2);
    if (IN(3)) REPS(3) { if (rep_) xcd_barrier(bar);
        { S5AOrder S{F.G, F.vcu, (const char*)WSP(bf16, WS_ACAT), (const char*)WSP(bf16, WS_WS)}; EpiS5A E{WSP(float, WS_S)};
          g8::gemm_phase<EpiS5A, S5AOrder, false>(F.lds, S5L * 32, S5ROW * 2, S5L * 32, S, E); }
        __syncthreads();
        rglru_phase<0>(F);
    }
    SEAM(3);
    if (IN(4)) REPS(4) { if (rep_) xcd_barrier(bar); p4_carries(F); }
    SEAM(4);
    if (IN(5)) REPS(5) { if (rep_) xcd_barrier(bar);
        { S5COrder S{F.G, F.vcu, (const char*)WSP(bf16, WS_ACAT), (const char*)WSP(bf16, WS_WY)}; EpiS5C E{WSP(bf16, WS_YS)};
          g8::gemm_phase<EpiS5C, S5COrder, false>(F.lds, S5ROW * 2, S5ROW * 2, S5ROW * 2, S, E); }
        __syncthreads();
        rglru_phase<1>(F);
    }
    SEAM(5);
    if (IN(6)) REPS(6) { if (rep_) xcd_barrier(bar);
        g8::GridOrder S; S.init(T, 2048, F.G, (int)blockIdx.x, WSP(bf16, WS_YS), WSP(bf16, WS_WGLU), 512, 512);
        EpiGlu E{WSP(bf16, WS_GATES), WSP(bf16, WS_GB)};
        g8::gemm_phase<EpiGlu, g8::GridOrder, false, true>(F.lds, 512, 512, 512, S, E);
    }
    SEAM(6);
    if (IN(7)) REPS(7) { if (rep_) xcd_barrier(bar);
        g8::GridOrder S; S.init(T, 1024, F.G, (int)blockIdx.x, WSP(bf16, WS_HA), WSP(bf16, WS_WRNN), 1024, 1024);
        EpiRnn E{WSP(bf16, WS_GATES), WSP(bf16, WS_GB), WSP(bf16, WS_MERGED)};
        g8::gemm_phase<EpiRnn, g8::GridOrder, false, true>(F.lds, 1024, 1024, 1024, S, E);
    }
    SEAM(7);
    if (IN(8)) REPS(8) { if (rep_) xcd_barrier(bar);
        g8::GridOrder S; S.init(T, 1024, F.G, (int)blockIdx.x, WSP(bf16, WS_MERGED), WSP(bf16, WS_WOUT), 1024, 1024);
        EpiOut E{F.in[0], WSP(float, WS_MOD), WSP(bf16, WS_V1)};
        g8::gemm_phase<EpiOut, g8::GridOrder, false, true>(F.lds, 1024, 1024, 1024, S, E);
    }
    SEAM(8);
    if (IN(9)) REPS(9) { if (rep_) xcd_barrier(bar); p9_router(F); }
    SEAM(9);
    if (IN(10)) REPS(10) { if (rep_) xcd_barrier(bar);
        moe_tables(F);
        const LAS int* tstart = (const LAS int*)(F.lds + TAB_OFF);
        MoeOrder S{F.G, (int)blockIdx.x, 8, tstart[NE], tstart, tstart + 40, WSP(int, WS_TOK), (const char*)WSP(bf16, WS_H2), (const char*)WSP(bf16, WS_WGU), (size_t)2048 * 1024, 1024, true};
        EpiMoe1 E{F.in[29], WSP(bf16, WS_ACT)};
        g8::gemm_phase<EpiMoe1, MoeOrder, true, true>(F.lds, 1024, 1024, 1024, S, E);
    }
    SEAM(10);
    if (IN(11)) REPS(11) { if (rep_) xcd_barrier(bar);
        moe_tables(F);
        const LAS int* tstart = (const LAS int*)(F.lds + TAB_OFF);
        MoeOrder S{F.G, (int)blockIdx.x, 4, tstart[NE], tstart, tstart + 40, WSP(int, WS_TOK), (const char*)WSP(bf16, WS_ACT), (const char*)WSP(bf16, WS_WD), (size_t)1024 * 1024, 1024, false};
        EpiMoe2 E{F.in[31], WSP(bf16, WS_YB)};
        g8::gemm_phase<EpiMoe2, MoeOrder, false, true>(F.lds, 1024, 1024, 1024, S, E);
    }
    SEAM(11);
    if (IN(12)) REPS(12) { if (rep_) xcd_barrier(bar); p12_final(F); }
#undef IN
#undef SEAM
}

extern "C" void kernel_launch(void* const* d_in, const int* in_sizes, int n_in, void* d_out, int out_size, void* d_ws, size_t ws_size, hipStream_t stream) {
    static int grid = 0;
    if (grid == 0) {
        if (n_in != 34 || in_sizes[0] != T * D || out_size != T * D || ws_size < WS_END) { fprintf(stderr, "kernel_launch: unexpected shapes (n_in %d, ws %zu < %zu)\n", n_in, ws_size, (size_t)WS_END); grid = -1; return; }
        int dev = 0, cus = 0;
        if (hipGetDevice(&dev) != hipSuccess || hipDeviceGetAttribute(&cus, hipDeviceAttributeMultiprocessorCount, dev) != hipSuccess) { grid = -1; return; }
        if (hipFuncSetAttribute((const void*)fwd_kernel, hipFuncAttributeMaxDynamicSharedMemorySize, LDS_BYTES) != hipSuccess) { fprintf(stderr, "kernel_launch: hipFuncSetAttribute failed\n"); grid = -1; return; }
        int per_cu = 0; (void)hipOccupancyMaxActiveBlocksPerMultiprocessor(&per_cu, (const void*)fwd_kernel, 512, LDS_BYTES); (void)hipGetLastError();
        grid = cus;
    }
    if (grid < 0) return;
    (void)hipMemsetAsync((char*)d_ws + WS_CTL, 0, CTL_BYTES, stream);
    Args a{};
    for (int i = 0; i < 34; ++i) a.in[i] = (const float*)d_in[i];
    a.out = (float*)d_out; a.ws = (unsigned char*)d_ws;
    if (MK_N_LAUNCHES == 1) { a.ph_lo = 0; a.ph_hi = N_PHASES; hipLaunchKernelGGL(fwd_kernel, dim3(grid), dim3(512), LDS_BYTES, stream, a); }
    else for (int p = 0; p < N_PHASES; ++p) { a.ph_lo = p; a.ph_hi = p + 1; hipLaunchKernelGGL(fwd_kernel, dim3(grid), dim3(512), LDS_BYTES, stream, a); }
}
```

```cpp
#include <hip/hip_runtime.h>
#include <cstdio>
#include <cstdint>

#ifndef MK_N_LAUNCHES
#define MK_N_LAUNCHES 1
#endif
constexpr int N_PHASES = 13;
#ifndef DUP_PHASE
#define DUP_PHASE -1
#endif
#define REPS(k) for (int rep_ = 0; rep_ < ((DUP_PHASE == (k)) ? 2 : 1); ++rep_)

#define GAS __attribute__((address_space(1)))
#define LAS __attribute__((address_space(3)))
typedef unsigned short bf16;
typedef short bf16x8 __attribute__((ext_vector_type(8)));
typedef float f32x4 __attribute__((ext_vector_type(4)));
typedef float f32x2 __attribute__((ext_vector_type(2)));
typedef unsigned u32x4 __attribute__((ext_vector_type(4)));
typedef unsigned u32x2 __attribute__((ext_vector_type(2)));
typedef GAS unsigned gu32;

constexpr int NB = 8, SEQ = 4096, T = NB * SEQ, D = 1024, INC = 4608, NE = 32, DFF = 1024;
constexpr int S5L = 32, S5G = 32, S5ROW = 128 + S5L * 16  , S5M = T / S5L  , S5CPB = SEQ / S5L  ;
constexpr int RGL = 128, RGC = SEQ / RGL  ;
constexpr float LN_EPS = 1e-5f, DN_ALPHA = 1.189207115002721f;
constexpr int ACT_ROWS = T * 4 + NE * 256;

constexpr size_t MiB = 1u << 20;
constexpr size_t WS_XRNN = 0, WS_GY = 64 * MiB, WS_GATES = 128 * MiB, WS_V1 = 0, WS_ACT = 0;
constexpr size_t WS_HBF = 272 * MiB, WS_HA = 272 * MiB, WS_YS = 336 * MiB, WS_GB = 368 * MiB, WS_MERGED = 432 * MiB, WS_ACAT = 496 * MiB, WS_YB = 272 * MiB;
constexpr size_t WS_X1 = 544 * MiB, WS_H2 = 608 * MiB;
constexpr size_t WS_WGU = 672 * MiB, WS_WD = 800 * MiB, WS_WIN = 864 * MiB, WS_WG = 873 * MiB, WS_WRNN = 874 * MiB, WS_WGLU = 876 * MiB, WS_WOUT = 878 * MiB;
constexpr size_t WS_WS = 880 * MiB, WS_WY = 888 * MiB, WS_S = 908 * MiB;
constexpr size_t WS_MOD = 924 * MiB, WS_AL = 925 * MiB, WS_RGAGG = 926 * MiB, WS_HIN = 928 * MiB, WS_TOK = 929 * MiB, WS_POS = 933 * MiB, WS_PROB = 934 * MiB, WS_CTL = 935 * MiB;
constexpr size_t WS_END = 936 * MiB, CTL_BYTES = 1 * MiB;
static_assert((size_t)ACT_ROWS * DFF * 2 <= 272 * MiB, "act/yb size");
static_assert(WS_ACAT + (size_t)S5G * S5M * S5ROW * 2 <= WS_X1, "acat");
constexpr int CW_BAR = 4096, CW_CNT = 8192  ;

constexpr int LDS_BYTES = 147456, MISC_OFF = LDS_BYTES - 256, TAB_OFF = 131072 + 1024;

__device__ __forceinline__ unsigned f2bf(float f) { unsigned u = __builtin_bit_cast(unsigned, f); return (u + 0x7fffu + ((u >> 16) & 1u)) >> 16; }
typedef __bf16 bf16x2v __attribute__((ext_vector_type(2)));
__device__ __forceinline__ unsigned pk2(float lo, float hi) { const f32x2 v = {lo, hi}; const bf16x2v b = __builtin_convertvector(v, bf16x2v); return __builtin_bit_cast(unsigned, b); }
__device__ __forceinline__ unsigned pk4_fp8(float a, float b, float c, float d) { a = __builtin_amdgcn_fmed3f(a, -448.f, 448.f); b = __builtin_amdgcn_fmed3f(b, -448.f, 448.f); c = __builtin_amdgcn_fmed3f(c, -448.f, 448.f); d = __builtin_amdgcn_fmed3f(d, -448.f, 448.f); int w = 0; w = __builtin_amdgcn_cvt_pk_fp8_f32(a, b, w, false); w = __builtin_amdgcn_cvt_pk_fp8_f32(c, d, w, true); return (unsigned)w; }
__device__ __forceinline__ float bflo(unsigned w) { return __builtin_bit_cast(float, w << 16); }
__device__ __forceinline__ float bfhi(unsigned w) { return __builtin_bit_cast(float, w & 0xffff0000u); }
__device__ __forceinline__ float bf1(bf16 h) { return __builtin_bit_cast(float, ((unsigned)h) << 16); }
__device__ __forceinline__ float fast_sigmoid(float x) { return __builtin_amdgcn_rcpf(1.0f + __builtin_amdgcn_exp2f(-1.4426950409f * x)); }
__device__ __forceinline__ float gelu_tanh(float x) { const float u = x + 0.044715f * x * x * x; return x * __builtin_amdgcn_rcpf(1.0f + __builtin_amdgcn_exp2f(-2.3022082f * u)); }
__device__ __forceinline__ float wave_sum(float v) {
#pragma unroll
    for (int o = 1; o < 64; o <<= 1) v += __shfl_xor(v, o);
    return v;
}
__device__ __forceinline__ u32x4 pack8(f32x4 a, f32x4 b) { u32x4 w; w.x = pk2(a[0], a[1]); w.y = pk2(a[2], a[3]); w.z = pk2(b[0], b[1]); w.w = pk2(b[2], b[3]); return w; }
__device__ __forceinline__ void unpack8(u32x4 w, f32x4& a, f32x4& b) { a = (f32x4){bflo(w.x), bfhi(w.x), bflo(w.y), bfhi(w.y)}; b = (f32x4){bflo(w.z), bfhi(w.z), bflo(w.w), bfhi(w.w)}; }

#define XB_TMO      128
#define XB_XCNT(j)  (256  + 64 * (j))
#define XB_XSUB(j)  (1280 + 64 * (j))
#define XB_XGEN(j)  (2304 + 64 * (j))
#define XB_TOP      3328
#define XB_TOPGEN   3392
#define XCD_BAR_WORDS 3456
#define XB_SPIN_CAP (1u << 18)
__device__ __forceinline__ unsigned xb_ld(unsigned* p)              { return __hip_atomic_load(p, __ATOMIC_RELAXED, __HIP_MEMORY_SCOPE_AGENT); }
__device__ __forceinline__ unsigned xb_add(unsigned* p, unsigned v) { return __hip_atomic_fetch_add(p, v, __ATOMIC_RELAXED, __HIP_MEMORY_SCOPE_AGENT); }
__device__ __forceinline__ unsigned xb_xcc_id() { return (unsigned)__builtin_amdgcn_s_getreg((3 << 11) | 20) & 0xFu; }
#define XB_SPIN(cond, bar) do { unsigned _sp = 0; while (cond) { __builtin_amdgcn_s_sleep(1); \
    if ((++_sp & 255u) == 0u) { if (xb_ld(&(bar)[XB_TMO])) break; if (_sp > XB_SPIN_CAP) { atomicAdd(&(bar)[XB_TMO], 1u); break; } } } } while (0)
struct XcdBarrier { unsigned* bar; unsigned x; volatile LAS unsigned* st; };
__device__ __forceinline__ XcdBarrier xcd_barrier_post(unsigned* bar, volatile LAS unsigned* st) {
    XcdBarrier b; b.bar = bar; b.x = xb_xcc_id(); b.st = st;
    if (threadIdx.x == 0) (void)xb_add(&bar[XB_XCNT(b.x)], 1u);
    return b;
}
__device__ __forceinline__ void xcd_barrier_complete(unsigned* bar, unsigned x, unsigned& nloc, unsigned& nx) {
    const unsigned G = gridDim.x * gridDim.y * gridDim.z;
    unsigned sum, cnt, mine, sp = 0u;
    for (;;) {
        sum = 0u; cnt = 0u; mine = 0u;
#pragma unroll
        for (unsigned j = 0; j < 16; ++j) { const unsigned c = xb_ld(&bar[XB_XCNT(j)]); sum += c; cnt += (c > 0u) ? 1u : 0u; mine = (j == x) ? c : mine; }
        if (sum == G) break;
        __builtin_amdgcn_s_sleep(1);
        if ((++sp & 255u) == 0u) { if (xb_ld(&bar[XB_TMO])) break; if (sp > XB_SPIN_CAP) { atomicAdd(&bar[XB_TMO], 1u); break; } }
    }
    nloc = mine > 0u ? mine : 1u; nx = cnt > 0u ? cnt : 1u;
}
__device__ __forceinline__ void xcd_barrier(const XcdBarrier& b) {
    asm volatile("s_waitcnt vmcnt(0)" ::: "memory");
    __syncthreads();
    if (threadIdx.x == 0) {
        unsigned* bar = b.bar;
        __builtin_amdgcn_s_waitcnt(0);
        unsigned nloc = b.st[0], nx = b.st[1];
        if (nloc == 0u) { xcd_barrier_complete(bar, b.x, nloc, nx); b.st[0] = nloc; b.st[1] = nx; }
        const unsigned old = xb_add(&bar[XB_XSUB(b.x)], 1u);
        const unsigned gen = old / nloc;
        if (old + 1u == (gen + 1u) * nloc) {
            __builtin_amdgcn_fence(__ATOMIC_RELEASE, "agent");
            asm volatile("s_waitcnt vmcnt(0)" ::: "memory");
            const unsigned og = xb_add(&bar[XB_TOP], 1u);
            const unsigned tg = og / nx;
            if (og + 1u == (tg + 1u) * nx) xb_add(&bar[XB_TOPGEN], 1u);
            else XB_SPIN(xb_ld(&bar[XB_TOPGEN]) == tg, bar);
            __builtin_amdgcn_fence(__ATOMIC_ACQUIRE, "agent");
            xb_add(&bar[XB_XGEN(b.x)], 1u);
            asm volatile("s_waitcnt vmcnt(0)" ::: "memory");
        } else {
            XB_SPIN(xb_ld(&bar[XB_XGEN(b.x)]) == gen, bar);
            __builtin_amdgcn_fence(__ATOMIC_ACQUIRE, "agent");
            asm volatile("s_waitcnt vmcnt(0)" ::: "memory");
        }
    }
    __syncthreads();
}

namespace g8 {
constexpr int BM = 256, BK = 64, HALF = 128, HTB = HALF * BK * 2, STAGE_BYTES = 8 * HTB;
__device__ __forceinline__ int lds_byte(int r, int c) { const int st = (r >> 4) * 2 + (c >> 5), rr = r & 15, cc = c & 31, ob = rr * 64 + cc * 2; return st * 1024 + (ob ^ (((ob >> 9) & 1) << 5)); }
__device__ __forceinline__ void stage_rc(int b, int& R, int& C) { const int st = b / 1024, sb = b % 1024, swz = sb ^ (((sb >> 9) & 1) << 5); R = (st >> 1) * 16 + swz / 64; C = (st & 1) * 32 + (swz % 64) / 2; }
__device__ __forceinline__ int perm32(int rho) { const int n = rho >> 4, i = rho & 15; return 8 * (i >> 2) + 4 * n + (i & 3); }

struct Unit { int pm, pn, z, rl; const char* A; const char* B; };

typedef int v8i __attribute__((ext_vector_type(8)));
typedef int v4i __attribute__((ext_vector_type(4)));
typedef short s16x16 __attribute__((ext_vector_type(16)));
typedef s16x16 s16x16_a16 __attribute__((aligned(16)));
__device__ __forceinline__ v8i cat8(bf16x8 lo, bf16x8 hi) { const v4i a = __builtin_bit_cast(v4i, lo), b = __builtin_bit_cast(v4i, hi); return __builtin_shufflevector(a, b, 0, 1, 2, 3, 4, 5, 6, 7); }
template <class Epi, class Sched, bool GATHER, bool FP8 = false>
__device__ __forceinline__ void gemm_phase(LAS unsigned char* lds, const int Kb, const int ldaB, const int ldbB, const Sched& S, const Epi& E) {
    const int tid = threadIdx.x, wid = __builtin_amdgcn_readfirstlane(tid >> 6), lane = tid & 63, wr = wid >> 2, wc = wid & 3, fr = lane & 15, fq = lane >> 4;
    const int nt = Kb / 128;
    unsigned voffB[2], cvo[2][2], nvo[2][2]; int Rr[2], Cc[2];
#pragma unroll
    for (int i = 0; i < 2; ++i) { int R, C; stage_rc(tid * 16 + i * 8192, R, C); const int Rb = (R & ~31) + perm32(R & 31);
        voffB[i] = (unsigned)(Rb * ldbB + C * 2); Rr[i] = R; Cc[i] = C;
#pragma unroll
        for (int h = 0; h < 2; ++h) { cvo[h][i] = (unsigned)((h * HALF + R) * ldaB + C * 2); nvo[h][i] = cvo[h][i]; } }
    const size_t kstep = (size_t)(BK * 2);
    const size_t hstepB = (size_t)HALF * ldbB;
    const unsigned ldsw = (unsigned)wid * 1024u;
    const int aoff = FP8 ? lds_byte(wr * 64 + fr, (fq >> 1) * 32 + (fq & 1) * 24) : lds_byte(wr * 64 + fr, fq * 8), boff = FP8 ? lds_byte(wc * 32 + fr, (fq >> 1) * 32 + (fq & 1) * 24) : lds_byte(wc * 32 + fr, fq * 8);
    const int aoff2 = FP8 ? lds_byte(wr * 64 + fr, (fq >> 1) * 32 + 8 + (fq & 1) * 8) : 0, boff2 = FP8 ? lds_byte(wc * 32 + fr, (fq >> 1) * 32 + 8 + (fq & 1) * 8) : 0;
#define G8_SA(b, h) (((b) * 2 + (h)) * HTB)
#define G8_SB(b, h) ((4 + (b) * 2 + (h)) * HTB)
#define G8_STGB(bufoff, gbase) do { _Pragma("unroll") for (int _i = 0; _i < 2; ++_i) \
        __builtin_amdgcn_global_load_lds((const unsigned*)((const char*)(gbase) + voffB[_i]), (LAS unsigned*)(lds + (bufoff) + ldsw + _i * 8192), 16, 0, 0); } while (0)
#define G8_STGA(bufoff, gbase, VO, h) do { _Pragma("unroll") for (int _i = 0; _i < 2; ++_i) \
        __builtin_amdgcn_global_load_lds((const unsigned*)((const char*)(gbase) + VO[h][_i]), (LAS unsigned*)(lds + (bufoff) + ldsw + _i * 8192), 16, 0, 0); } while (0)
#define G8_LDA(dst, b, h) do { _Pragma("unroll") for (int m = 0; m < 4; ++m) { if constexpr (FP8) { dst##8[m] = cat8(*(const LAS bf16x8*)(lds + G8_SA(b, h) + aoff + m * 2048), *(const LAS bf16x8*)(lds + G8_SA(b, h) + aoff2 + m * 2048)); } \
        else { _Pragma("unroll") for (int k = 0; k < 2; ++k) dst[m][k] = *(const LAS bf16x8*)(lds + G8_SA(b, h) + aoff + m * 2048 + k * 1024); } } } while (0)
#define G8_LDB(dst, b, h) do { _Pragma("unroll") for (int n = 0; n < 2; ++n) { if constexpr (FP8) { dst##8[n] = cat8(*(const LAS bf16x8*)(lds + G8_SB(b, h) + boff + n * 2048), *(const LAS bf16x8*)(lds + G8_SB(b, h) + boff2 + n * 2048)); } \
        else { _Pragma("unroll") for (int k = 0; k < 2; ++k) dst[n][k] = *(const LAS bf16x8*)(lds + G8_SB(b, h) + boff + n * 2048 + k * 1024); } } } while (0)
#define G8_MMA(ai, bj, At, Bt) do { __builtin_amdgcn_s_setprio(1); _Pragma("unroll") for (int m = 0; m < 4; ++m) _Pragma("unroll") for (int n = 0; n < 2; ++n) { \
        if constexpr (FP8) asm volatile("s_nop 1\n\tv_mfma_scale_f32_16x16x128_f8f6f4 %0, %1, %2, %0, %3, %4 op_sel_hi:[0,0,0]" : "+v"(acc[ai][bj][m][n]) : "v"(Bt##8[n]), "v"(At##8[m]), "v"(sc_w), "v"(sc_a)); \
        else { _Pragma("unroll") for (int k = 0; k < 2; ++k) acc[ai][bj][m][n] = __builtin_amdgcn_mfma_f32_16x16x32_bf16(Bt[n][k], At[m][k], acc[ai][bj][m][n], 0, 0, 0); } } __builtin_amdgcn_s_setprio(0); } while (0)
#define G8_WAIT_V(n) asm volatile("s_waitcnt vmcnt(" #n ")" ::: "memory")
#define G8_WAIT_L(n) asm volatile("s_waitcnt lgkmcnt(" #n ")" ::: "memory")
#define G8_BAR __builtin_amdgcn_s_barrier()
#define G8_SCHED __builtin_amdgcn_sched_barrier(0)
    Unit cur, nxt; int ui = 0;
    if (!S.next(0, cur)) return;
    bool has_next = S.next(1, nxt);
    if constexpr (GATHER) { S.gather(cur, Rr, Cc, cvo); if (has_next) S.gather(nxt, Rr, Cc, nvo); else {
#pragma unroll
        for (int h = 0; h < 2; ++h)
#pragma unroll
            for (int i = 0; i < 2; ++i) nvo[h][i] = cvo[h][i]; } }
    f32x4 acc[2][2][4][2];
#pragma unroll
    for (int a = 0; a < 2; ++a)
#pragma unroll
        for (int b = 0; b < 2; ++b)
#pragma unroll
            for (int m = 0; m < 4; ++m)
#pragma unroll
                for (int n = 0; n < 2; ++n) acc[a][b][m][n] = (f32x4){0.f, 0.f, 0.f, 0.f};
    const int sc_w = 0x7a7a7a7a, sc_a = 0x7f7f7f7f;
    bf16x8 At[4][2], B0[2][2], B1[2][2]; v8i At8[4], B08[2], B18[2];
    const char* cA = cur.A; const char* cB = cur.B;
    G8_STGB(G8_SB(0, 0), cB); G8_STGB(G8_SB(0, 1), cB + hstepB); G8_STGA(G8_SA(0, 0), cA, cvo, 0); G8_STGA(G8_SA(0, 1), cA, cvo, 1);
    if (wr == 1) G8_BAR;
    G8_WAIT_V(2); G8_BAR;
    G8_STGB(G8_SB(1, 0), cB + kstep); G8_STGA(G8_SA(1, 0), cA + kstep, cvo, 0); G8_STGB(G8_SB(1, 1), cB + hstepB + kstep);
    G8_WAIT_V(6); G8_BAR;
    for (;;) {
        const char* nA = has_next ? nxt.A : cA; const char* nB = has_next ? nxt.B : cB;
        for (int t = 0; t < nt; t += 2) {
            const bool last = (t == nt - 2);
            const char* a1 = cA + (size_t)(t + 1) * kstep;
            const char* a2 = last ? nA : cA + (size_t)(t + 2) * kstep; const char* b2 = last ? nB : cB + (size_t)(t + 2) * kstep;
            const char* a3 = a2 + kstep; const char* b3 = b2 + kstep;
            unsigned vo2[2][2];
#pragma unroll
            for (int h = 0; h < 2; ++h)
#pragma unroll
                for (int i = 0; i < 2; ++i) vo2[h][i] = (GATHER && last) ? nvo[h][i] : cvo[h][i];
            G8_LDB(B0, 0, 0); G8_LDB(B1, 0, 1); G8_SCHED; G8_LDA(At, 0, 0); G8_STGA(G8_SA(1, 1), a1, cvo, 1);
            G8_WAIT_V(8); G8_WAIT_L(0); G8_BAR; G8_SCHED; G8_MMA(0, 0, At, B0); G8_MMA(0, 1, At, B1); G8_SCHED; G8_BAR; G8_SCHED;
            G8_LDA(At, 0, 1); G8_STGB(G8_SB(0, 0), b2); G8_STGB(G8_SB(0, 1), b2 + hstepB); G8_STGA(G8_SA(0, 0), a2, vo2, 0);
            G8_WAIT_V(8); G8_WAIT_L(0); G8_BAR; G8_SCHED; G8_MMA(1, 0, At, B0); G8_MMA(1, 1, At, B1); G8_SCHED; G8_BAR; G8_SCHED;
            G8_LDB(B0, 1, 0); G8_LDB(B1, 1, 1); G8_SCHED; G8_LDA(At, 1, 0); G8_STGA(G8_SA(0, 1), a2, vo2, 1);
            G8_WAIT_V(8); G8_WAIT_L(0); G8_BAR; G8_SCHED; G8_MMA(0, 0, At, B0); G8_MMA(0, 1, At, B1); G8_SCHED; G8_BAR; G8_SCHED;
            G8_LDA(At, 1, 1); G8_STGB(G8_SB(1, 0), b3); G8_STGB(G8_SB(1, 1), b3 + hstepB); G8_STGA(G8_SA(1, 0), a3, vo2, 0);
            G8_WAIT_V(8); G8_WAIT_L(0); G8_BAR; G8_SCHED; G8_MMA(1, 0, At, B0); G8_MMA(1, 1, At, B1); G8_SCHED; G8_BAR; G8_SCHED;
        }
        f32x4 bpre[4]; E.pre(cur, wr, wc, fr, fq, bpre);
        if (wr == 0) G8_BAR;
        Unit nn; bool has_nn = false;
        if (has_next) has_nn = S.next(ui + 2, nn);
        unsigned nnvo[2][2];
        if constexpr (GATHER) { if (has_nn) S.gather(nn, Rr, Cc, nnvo); }
        if constexpr (FP8) asm volatile("s_nop 15\n\ts_nop 15" ::: "memory");
        E(acc, cur, wr, wc, fr, fq, bpre);
        if (!has_next) break;
#pragma unroll
        for (int a = 0; a < 2; ++a)
#pragma unroll
            for (int b = 0; b < 2; ++b)
#pragma unroll
                for (int m = 0; m < 4; ++m)
#pragma unroll
                    for (int n = 0; n < 2; ++n) acc[a][b][m][n] = (f32x4){0.f, 0.f, 0.f, 0.f};
        cur = nxt; cA = nA; cB = nB; ++ui;
        if constexpr (GATHER) {
#pragma unroll
            for (int h = 0; h < 2; ++h)
#pragma unroll
                for (int i = 0; i < 2; ++i) { cvo[h][i] = nvo[h][i]; if (has_nn) nvo[h][i] = nnvo[h][i]; } }
        nxt = nn; has_next = has_nn;
        if (wr == 1) G8_BAR;
    }
    G8_WAIT_V(0);
    G8_BAR;
#undef G8_SA
#undef G8_SB
#undef G8_STGB
#undef G8_STGA
#undef G8_LDA
#undef G8_LDB
#undef G8_MMA
#undef G8_WAIT_V
#undef G8_WAIT_L
#undef G8_BAR
#undef G8_SCHED
}

struct GridOrder {
    int nM, nN, nwg, G, c; const char* A; const char* B; size_t tstepA, tstepB;
    __device__ __forceinline__ void init(int M, int N, int G_, int c_, const void* A_, const void* B_, int ldaB, int ldbB) { nM = M / BM; nN = N / BM; nwg = nM * nN; G = G_; c = c_; A = (const char*)A_; B = (const char*)B_; tstepA = (size_t)BM * ldaB; tstepB = (size_t)BM * ldbB; }
    __device__ __forceinline__ bool next(int i, Unit& u) const {
        const long L = (long)i * G + c; if (L >= nwg) return false;
        int wgid = (int)L; { const int q = nwg / 8, r = nwg % 8, xcd = wgid % 8, off = wgid / 8; wgid = (xcd < r ? xcd * (q + 1) : r * (q + 1) + (xcd - r) * q) + off; }
        const int nig = 8 * nN, gid = wgid / nig, fm = gid * 8, gsz = (nM - fm) < 8 ? (nM - fm) : 8;
        u.pm = fm + ((wgid % nig) % gsz); u.pn = (wgid % nig) / gsz; u.z = 0; u.rl = 0;
        u.A = A + (size_t)u.pm * tstepA; u.B = B + (size_t)u.pn * tstepB; return true;
    }
};
}

struct Frame {
    LAS unsigned char* lds; volatile LAS unsigned* MISC; unsigned* ctl;
    int tid, lane, wave, vcu, G;
    const float* in[34]; float* out; unsigned char* ws;
};
#define WSP(T_, off) ((T_*)(F.ws + (off)))

struct EpiInProj {
    __device__ __forceinline__ void pre(const g8::Unit& u, int, int wc, int, int fq, f32x4 (&bp)[4]) const { const int colb = u.pn * 256 + wc * 32 + 8 * fq;
#pragma unroll
        for (int bj = 0; bj < 2; ++bj)
#pragma unroll
            for (int n = 0; n < 2; ++n) bp[bj * 2 + n] = *(const f32x4*)(bias + colb + bj * 128 + 4 * n); }
    const float* bias; bf16 *xrnn, *gy, *acat, *gates;
    __device__ __forceinline__ void operator()(const f32x4 (&acc)[2][2][4][2], const g8::Unit& u, int wr, int wc, int fr, int fq, const f32x4 (&bpre)[4]) const {
        const int pn = u.pn, colb = pn * 256 + wc * 32 + 8 * fq;
        f32x4 bv[2][2];
#pragma unroll
        for (int bj = 0; bj < 2; ++bj)
#pragma unroll
            for (int n = 0; n < 2; ++n) bv[bj][n] = bpre[bj * 2 + n];
#pragma unroll
        for (int ai = 0; ai < 2; ++ai)
#pragma unroll
            for (int m = 0; m < 4; ++m) { const int t = u.pm * 256 + ai * 128 + wr * 64 + m * 16 + fr;
#pragma unroll
                for (int bj = 0; bj < 2; ++bj) { f32x4 v0 = acc[ai][bj][m][0] + bv[bj][0], v1 = acc[ai][bj][m][1] + bv[bj][1]; const int col = colb + bj * 128;
                    if (pn < 4) { *(u32x4*)(xrnn + (size_t)t * 1024 + col) = pack8(v0, v1); }
                    else if (pn < 8) {
#pragma unroll
                        for (int j = 0; j < 4; ++j) { v0[j] = gelu_tanh(v0[j]); v1[j] = gelu_tanh(v1[j]); }
                        *(u32x4*)(gy + (size_t)t * 1024 + (col - 1024)) = pack8(v0, v1); }
                    else if (pn < 10) { const int cu = col - 2048, g = cu >> 4, c = cu & 15;
                        *(u32x4*)(acat + ((size_t)(g * S5M + (t >> 5)) * S5ROW + 128 + (t & 31) * 16 + c)) = pack8(v0, v1); }
                    else {
#pragma unroll
                        for (int j = 0; j < 4; ++j) { v0[j] = fast_sigmoid(v0[j]); v1[j] = fast_sigmoid(v1[j]); }
                        *(u32x4*)(gates + (size_t)t * 2048 + (col - 2560)) = pack8(v0, v1); } } }
    }
};
struct EpiS5A {
    __device__ __forceinline__ void pre(const g8::Unit&, int, int, int, int, f32x4 (&)[4]) const {}
    float* S;
    __device__ __forceinline__ void operator()(const f32x4 (&acc)[2][2][4][2], const g8::Unit& u, int wr, int wc, int fr, int fq, const f32x4 (&bpre)[4]) const {
        const int col = wc * 32 + 8 * fq;
#pragma unroll
        for (int ai = 0; ai < 2; ++ai)
#pragma unroll
            for (int m = 0; m < 4; ++m) { const int row = u.pm * 256 + ai * 128 + wr * 64 + m * 16 + fr; float* p = S + ((size_t)(u.z * S5M + row)) * 128 + col;
                *(f32x4*)p = acc[ai][0][m][0]; *(f32x4*)(p + 4) = acc[ai][0][m][1]; }
    }
};
struct EpiS5C {
    __device__ __forceinline__ void pre(const g8::Unit&, int, int, int, int, f32x4 (&)[4]) const {}
    bf16* ys;
    __device__ __forceinline__ void operator()(const f32x4 (&acc)[2][2][4][2], const g8::Unit& u, int wr, int wc, int fr, int fq, const f32x4 (&bpre)[4]) const {
#pragma unroll
        for (int ai = 0; ai < 2; ++ai)
#pragma unroll
            for (int m = 0; m < 4; ++m) { const int row = u.pm * 256 + ai * 128 + wr * 64 + m * 16 + fr;
#pragma unroll
                for (int bj = 0; bj < 2; ++bj) { const int n = u.pn * 256 + bj * 128 + wc * 32 + 8 * fq, i = n >> 4, c = n & 15; f32x4 v0 = acc[ai][bj][m][0], v1 = acc[ai][bj][m][1];
#pragma unroll
                    for (int j = 0; j < 4; ++j) { v0[j] = gelu_tanh(v0[j]); v1[j] = gelu_tanh(v1[j]); }
                    u32x2 w8; w8.x = pk4_fp8(v0[0], v0[1], v0[2], v0[3]); w8.y = pk4_fp8(v1[0], v1[1], v1[2], v1[3]); *(u32x2*)((unsigned char*)ys + (size_t)(row * 32 + i) * 512 + u.z * 16 + c) = w8; } }
    }
};
struct EpiGlu { static constexpr int NST = 8;
    __device__ __forceinline__ void pre(const g8::Unit&, int, int, int, int, f32x4 (&)[4]) const {}
    const bf16* gates; bf16* gb;
    __device__ __forceinline__ void operator()(const f32x4 (&acc)[2][2][4][2], const g8::Unit& u, int wr, int wc, int fr, int fq, const f32x4 (&bpre)[4]) const {
        const int f = u.pn * 128 + wc * 32 + 8 * fq;
#pragma unroll
        for (int ai = 0; ai < 2; ++ai) { u32x4 gw[4];
#pragma unroll
            for (int m = 0; m < 4; ++m) { const int t = u.pm * 256 + ai * 128 + wr * 64 + m * 16 + fr; gw[m] = *(const u32x4*)(gates + (size_t)t * 2048 + 1024 + f); }
#pragma unroll
            for (int m = 0; m < 4; ++m) { const int t = u.pm * 256 + ai * 128 + wr * 64 + m * 16 + fr;
                f32x4 g0, g1; unpack8(gw[m], g0, g1);
                f32x4 v0 = acc[ai][0][m][0], v1 = acc[ai][0][m][1]; const f32x4 s0 = acc[ai][1][m][0], s1 = acc[ai][1][m][1];
#pragma unroll
                for (int j = 0; j < 4; ++j) { v0[j] = g0[j] * v0[j] * fast_sigmoid(s0[j]); v1[j] = g1[j] * v1[j] * fast_sigmoid(s1[j]); }
                *(u32x4*)(gb + (size_t)t * 1024 + f) = pack8(v0, v1); } }
    }
};
struct EpiRnn { static constexpr int NST = 16;
    __device__ __forceinline__ void pre(const g8::Unit&, int, int, int, int, f32x4 (&)[4]) const {}
    const bf16* gates; const bf16* gb; bf16* merged;
    __device__ __forceinline__ void operator()(const f32x4 (&acc)[2][2][4][2], const g8::Unit& u, int wr, int wc, int fr, int fq, const f32x4 (&bpre)[4]) const {
#pragma unroll
        for (int ai = 0; ai < 2; ++ai)
#pragma unroll
            for (int mh = 0; mh < 2; ++mh) { u32x4 gw[2][2], bw[2][2];
#pragma unroll
                for (int mm = 0; mm < 2; ++mm) { const int t = u.pm * 256 + ai * 128 + wr * 64 + (2 * mh + mm) * 16 + fr;
#pragma unroll
                    for (int bj = 0; bj < 2; ++bj) { const int col = u.pn * 256 + bj * 128 + wc * 32 + 8 * fq; gw[mm][bj] = *(const u32x4*)(gates + (size_t)t * 2048 + col); bw[mm][bj] = *(const u32x4*)(gb + (size_t)t * 1024 + col); } }
#pragma unroll
                for (int mm = 0; mm < 2; ++mm) { const int m = 2 * mh + mm, t = u.pm * 256 + ai * 128 + wr * 64 + m * 16 + fr;
#pragma unroll
                    for (int bj = 0; bj < 2; ++bj) { const int col = u.pn * 256 + bj * 128 + wc * 32 + 8 * fq;
                        f32x4 g0, g1, b0, b1; unpack8(gw[mm][bj], g0, g1); unpack8(bw[mm][bj], b0, b1);
                        const f32x4 v0 = g0 * acc[ai][bj][m][0] + b0, v1 = g1 * acc[ai][bj][m][1] + b1;
                        u32x2 w8; w8.x = pk4_fp8(v0[0], v0[1], v0[2], v0[3]); w8.y = pk4_fp8(v1[0], v1[1], v1[2], v1[3]); *(u32x2*)((unsigned char*)merged + (size_t)t * 1024 + col) = w8; } } }
    }
};
struct EpiOut { static constexpr int NST = 16;
    const float* x; const float* mod; bf16* v1;
    __device__ __forceinline__ void pre(const g8::Unit& u, int, int wc, int, int fq, f32x4 (&bp)[4]) const { const int b = (u.pm * 256) >> 12; const float* p = mod + b * 6144 + 2048 + u.pn * 256 + wc * 32 + 8 * fq;
        bp[0] = *(const f32x4*)p; bp[1] = *(const f32x4*)(p + 4); bp[2] = *(const f32x4*)(p + 128); bp[3] = *(const f32x4*)(p + 132); }
    __device__ __forceinline__ void operator()(const f32x4 (&acc)[2][2][4][2], const g8::Unit& u, int wr, int wc, int fr, int fq, const f32x4 (&bpre)[4]) const {
#pragma unroll
        for (int ai = 0; ai < 2; ++ai)
#pragma unroll
            for (int mh = 0; mh < 2; ++mh) { f32x4 xv[2][2][2];
#pragma unroll
                for (int mm = 0; mm < 2; ++mm) { const int t = u.pm * 256 + ai * 128 + wr * 64 + (2 * mh + mm) * 16 + fr;
#pragma unroll
                    for (int bj = 0; bj < 2; ++bj) { const int col = u.pn * 256 + bj * 128 + wc * 32 + 8 * fq; xv[mm][bj][0] = *(const f32x4*)(x + (size_t)t * 1024 + col); xv[mm][bj][1] = *(const f32x4*)(x + (size_t)t * 1024 + col + 4); } }
#pragma unroll
                for (int mm = 0; mm < 2; ++mm) { const int m = 2 * mh + mm, t = u.pm * 256 + ai * 128 + wr * 64 + m * 16 + fr;
#pragma unroll
                    for (int bj = 0; bj < 2; ++bj) { const int col = u.pn * 256 + bj * 128 + wc * 32 + 8 * fq;
                        const f32x4 v0 = xv[mm][bj][0] * DN_ALPHA + (bpre[2 * bj] + 1.0f) * acc[ai][bj][m][0], v1_ = xv[mm][bj][1] * DN_ALPHA + (bpre[2 * bj + 1] + 1.0f) * acc[ai][bj][m][1];
                        *(u32x4*)(v1 + (size_t)t * 1024 + col) = pack8(v0, v1_); } } }
    }
};
struct EpiMoe1 {
    __device__ __forceinline__ void pre(const g8::Unit& u, int, int wc, int, int fq, f32x4 (&bp)[4]) const { const float* p = bgu + (size_t)u.z * 2048 + u.pn * 128 + wc * 32 + 8 * fq; bp[0] = *(const f32x4*)p; bp[1] = *(const f32x4*)(p + 4); bp[2] = *(const f32x4*)(p + 1024); bp[3] = *(const f32x4*)(p + 1028); }
    const float* bgu; bf16* act;
    __device__ __forceinline__ void operator()(const f32x4 (&acc)[2][2][4][2], const g8::Unit& u, int wr, int wc, int fr, int fq, const f32x4 (&bpre)[4]) const {
        const int f = u.pn * 128 + wc * 32 + 8 * fq; const float* bp = bgu + (size_t)u.z * 2048 + f;
        (void)bp; const f32x4 bg0 = bpre[0], bg1 = bpre[1], bu0 = bpre[2], bu1 = bpre[3];
#pragma unroll
        for (int ai = 0; ai < 2; ++ai)
#pragma unroll
            for (int m = 0; m < 4; ++m) { const int row = u.pm * 256 + ai * 128 + wr * 64 + m * 16 + fr;
                f32x4 g0 = acc[ai][0][m][0] + bg0, g1 = acc[ai][0][m][1] + bg1, u0 = acc[ai][1][m][0] + bu0, u1 = acc[ai][1][m][1] + bu1;
#pragma unroll
                for (int j = 0; j < 4; ++j) { const float ga = fminf(g0[j], 7.0f), gb_ = fminf(g1[j], 7.0f), ua = fminf(fmaxf(u0[j], -7.0f), 7.0f), ub = fminf(fmaxf(u1[j], -7.0f), 7.0f);
                    g0[j] = ga * fast_sigmoid(1.702f * ga) * (ua + 1.0f); g1[j] = gb_ * fast_sigmoid(1.702f * gb_) * (ub + 1.0f); }
                u32x2 w8; w8.x = pk4_fp8(g0[0], g0[1], g0[2], g0[3]); w8.y = pk4_fp8(g1[0], g1[1], g1[2], g1[3]); *(u32x2*)((unsigned char*)act + (size_t)row * 1024 + f) = w8; }
    }
};
struct EpiMoe2 {
    __device__ __forceinline__ void pre(const g8::Unit& u, int, int wc, int, int fq, f32x4 (&bp)[4]) const { const float* p = bd + (size_t)u.z * 1024 + u.pn * 256 + wc * 32 + 8 * fq; bp[0] = *(const f32x4*)p; bp[1] = *(const f32x4*)(p + 4); bp[2] = *(const f32x4*)(p + 128); bp[3] = *(const f32x4*)(p + 132); }
    const float* bd; bf16* yb;
    __device__ __forceinline__ void operator()(const f32x4 (&acc)[2][2][4][2], const g8::Unit& u, int wr, int wc, int fr, int fq, const f32x4 (&bpre)[4]) const {
#pragma unroll
        for (int bj = 0; bj < 2; ++bj) { const int col = u.pn * 256 + bj * 128 + wc * 32 + 8 * fq; const float* bp = bd + (size_t)u.z * 1024 + col;
            (void)bp; const f32x4 b0 = bpre[bj * 2], b1 = bpre[bj * 2 + 1];
#pragma unroll
            for (int ai = 0; ai < 2; ++ai)
#pragma unroll
                for (int m = 0; m < 4; ++m) { const int row = u.pm * 256 + ai * 128 + wr * 64 + m * 16 + fr;
                    const f32x4 y0 = acc[ai][bj][m][0] + b0, y1 = acc[ai][bj][m][1] + b1; u32x2 w8; w8.x = pk4_fp8(y0[0], y0[1], y0[2], y0[3]); w8.y = pk4_fp8(y1[0], y1[1], y1[2], y1[3]);
                    *(u32x2*)((unsigned char*)yb + (size_t)row * 1024 + col) = w8; } }
    }
};

struct S5AOrder { int G, c; const char* acat; const char* ws;
    __device__ __forceinline__ bool next(int i, g8::Unit& u) const { const int L = i * G + c; if (L >= S5G * 4) return false; u.z = L >> 2; u.pm = L & 3; u.pn = 0; u.rl = 0;
        u.A = acat + ((size_t)(u.z * S5M + u.pm * 256) * S5ROW + 128) * 2; u.B = ws + (size_t)u.z * 256 * (S5L * 16) * 2; return true; } };
struct S5COrder { int G, c; const char* acat; const char* wy;
    __device__ __forceinline__ bool next(int i, g8::Unit& u) const { const int L = i * G + c; if (L >= S5G * 8) return false; u.z = L >> 3; u.pm = (L >> 1) & 3; u.pn = L & 1; u.rl = 0;
        u.A = acat + ((size_t)(u.z * S5M + u.pm * 256) * S5ROW) * 2; u.B = wy + ((size_t)(u.z * 512 + u.pn * 256) * S5ROW) * 2; return true; } };
struct MoeOrder { int G, c, NT, RT; const LAS int* tstart; const LAS int* cnt; const int* toklist; const char* A; const char* B; size_t bstride_e; int lda; bool gatherA;
    __device__ __forceinline__ bool next(int i, g8::Unit& u) const { const int per = G >> 3, xcd = c & 7, slot = c >> 3, rpx = per / NT;
        const int rt = (i * 8 + xcd) * rpx + slot / NT; if (rt >= RT) return false; u.pn = slot % NT;
        const int lane_ = threadIdx.x & 63; const unsigned long long mk_ = __ballot(lane_ < NE && tstart[lane_ & 31] <= rt);
        const int e = __builtin_popcountll(mk_) - 1;
        u.z = e; u.pm = rt; u.rl = rt - tstart[e]; u.B = B + (size_t)e * bstride_e + (size_t)u.pn * 256 * 1024; u.A = gatherA ? A : A + (size_t)rt * 256 * 1024; return true; }
    __device__ __forceinline__ void gather(const g8::Unit& u, const int (&Rr)[2], const int (&Cc)[2], unsigned (&vo)[2][2]) const {
        const int n = cnt[u.z];
#pragma unroll
        for (int h = 0; h < 2; ++h)
#pragma unroll
            for (int i = 0; i < 2; ++i) { const int r = u.rl * 256 + h * 128 + Rr[i]; const int rc = r < n ? r : n - 1; const int tok = toklist[u.z * T + rc]; vo[h][i] = (unsigned)(tok * lda + Cc[i] * 2); } }
};

__device__ __forceinline__ void transpose_item(const float* W, int N, int k0, int n0, bf16* dst, int ldd, int drow0, LAS float* scr, int lane) {
    float wv_[32];
#pragma unroll
    for (int i = 0; i < 32; ++i) wv_[i] = W[(size_t)(k0 + 2 * i + (lane >> 5)) * N + n0 + (lane & 31)];
#pragma unroll
    for (int i = 0; i < 32; ++i) scr[(2 * i + (lane >> 5)) * 33 + (lane & 31)] = wv_[i];
    asm volatile("s_waitcnt lgkmcnt(0)" ::: "memory");
    const int c = lane & 7;
#pragma unroll
    for (int j = 0; j < 4; ++j) { const int n = (lane >> 3) + 8 * j; const LAS float* s = scr + (8 * c) * 33 + n;
        u32x4 o; o.x = pk2(s[0 * 33], s[1 * 33]); o.y = pk2(s[2 * 33], s[3 * 33]); o.z = pk2(s[4 * 33], s[5 * 33]); o.w = pk2(s[6 * 33], s[7 * 33]);
        *(u32x4*)(dst + (size_t)(drow0 + n) * ldd + k0 + 8 * c) = o; }
    asm volatile("s_waitcnt lgkmcnt(0)" ::: "memory");
}
__device__ __forceinline__ void transpose_item8(const float* W, int N, int k0, int n0, unsigned char* dst, int ldd, int drow0, LAS float* scr, int lane) {
    float wv_[32];
#pragma unroll
    for (int i = 0; i < 32; ++i) wv_[i] = W[(size_t)(k0 + 2 * i + (lane >> 5)) * N + n0 + (lane & 31)];
#pragma unroll
    for (int i = 0; i < 32; ++i) scr[(2 * i + (lane >> 5)) * 33 + (lane & 31)] = wv_[i];
    asm volatile("s_waitcnt lgkmcnt(0)" ::: "memory");
    const int c = lane & 7;
#pragma unroll
    for (int j = 0; j < 4; ++j) { const int n = (lane >> 3) + 8 * j; const LAS float* s = scr + (8 * c) * 33 + n;
        u32x2 o; o.x = pk4_fp8(32.f * s[0 * 33], 32.f * s[1 * 33], 32.f * s[2 * 33], 32.f * s[3 * 33]); o.y = pk4_fp8(32.f * s[4 * 33], 32.f * s[5 * 33], 32.f * s[6 * 33], 32.f * s[7 * 33]);
        *(u32x2*)(dst + (size_t)(drow0 + n) * ldd + k0 + 8 * c) = o; }
    asm volatile("s_waitcnt lgkmcnt(0)" ::: "memory");
}
__device__ __forceinline__ void transpose_item8w(const float* W, int N, int k0, int n0, unsigned char* dst, int ldd, int drow0, LAS float* scr, int lane) {
    float wv[64]; const float* wp = W + (size_t)(k0 + (lane >> 5)) * N + n0 + (lane & 31);
#pragma unroll
    for (int i = 0; i < 64; ++i) wv[i] = wp[(size_t)(2 * i) * N];
#pragma unroll
    for (int i = 0; i < 64; ++i) scr[(2 * i + (lane >> 5)) * 33 + (lane & 31)] = wv[i];
    asm volatile("s_waitcnt lgkmcnt(0)" ::: "memory");
    const int c = lane & 7;
#pragma unroll
    for (int j = 0; j < 4; ++j) { const int n = (lane >> 3) + 8 * j; const LAS float* s = scr + (16 * c) * 33 + n;
        u32x4 o; o.x = pk4_fp8(32.f * s[0 * 33], 32.f * s[1 * 33], 32.f * s[2 * 33], 32.f * s[3 * 33]); o.y = pk4_fp8(32.f * s[4 * 33], 32.f * s[5 * 33], 32.f * s[6 * 33], 32.f * s[7 * 33]);
        o.z = pk4_fp8(32.f * s[8 * 33], 32.f * s[9 * 33], 32.f * s[10 * 33], 32.f * s[11 * 33]); o.w = pk4_fp8(32.f * s[12 * 33], 32.f * s[13 * 33], 32.f * s[14 * 33], 32.f * s[15 * 33]);
        *(u32x4*)(dst + (size_t)(drow0 + n) * ldd + k0 + 16 * c) = o; }
    asm volatile("s_waitcnt lgkmcnt(0)" ::: "memory");
}
__device__ __forceinline__ int pair_row(int n) { const int f = n & 1023, hi = n >> 10; return (f >> 7) * 256 + hi * 128 + (f & 127); }

__device__ __forceinline__ void moe_tables(Frame& F) {
    LAS int* tstart = (LAS int*)(F.lds + TAB_OFF); LAS int* cl = tstart + 40;
    if (F.tid < 64) {
        const int e = F.lane & 31; const int c = (int)F.ctl[CW_CNT + 64 * e]; int inc = (c + 255) >> 8;
#pragma unroll
        for (int o = 1; o < 32; o <<= 1) { const int v = __shfl_up(inc, o); if ((F.lane & 31) >= o) inc += v; }
        if (F.lane < 32) { cl[e] = c; tstart[e] = inc - ((c + 255) >> 8); if (e == NE - 1) tstart[NE] = inc; }
    }
    __syncthreads();
}

__device__ __forceinline__ void p0_mod_job(Frame& F, int job) {
    LAS float* sc = (LAS float*)F.lds;
    LAS float* red = sc + 8 * 1024;
    const float* c = F.in[1]; const float* w = F.in[2]; const float* bias = F.in[3];
    for (int i = F.tid; i < 8 * 1024; i += 512) { const float v = c[i]; sc[i] = v * fast_sigmoid(v); }
    __syncthreads();
    const int col = F.tid & 31, kg = F.tid >> 5, j = job * 32 + col;
    float a[8];
#pragma unroll
    for (int b = 0; b < 8; ++b) a[b] = 0.f;
#pragma unroll 32
    for (int k = kg * 64; k < kg * 64 + 64; ++k) { const float wv = w[(size_t)k * 6144 + j];
#pragma unroll
        for (int b = 0; b < 8; ++b) a[b] += sc[b * 1024 + k] * wv; }
#pragma unroll
    for (int b = 0; b < 8; ++b) red[(kg * 8 + b) * 32 + col] = a[b];
    __syncthreads();
    if (F.tid < 256) { const int b = F.tid >> 5, cc = F.tid & 31; float s = 0.f;
#pragma unroll
        for (int g = 0; g < 16; ++g) s += red[(g * 8 + b) * 32 + cc];
        WSP(float, WS_MOD)[b * 6144 + job * 32 + cc] = s + bias[job * 32 + cc]; }
    __syncthreads();
}
__device__ __forceinline__ void s5_setup(Frame& F, int g, int kmin, int kmax, LAS f32x2* Bb, LAS f32x2* Cc, LAS f32x2* Ap) {
    const float* lre = F.in[14] + g * 64; const float* lim = F.in[15] + g * 64; const float dt = expf(F.in[16][g]);
    const float* bre = F.in[17] + g * 1024; const float* bim = F.in[18] + g * 1024; const float* cre = F.in[19] + g * 1024; const float* cim = F.in[20] + g * 1024;
    for (int i = F.tid; i < 1024; i += 512) { const int p = i >> 4; const float lr = lre[p], li = lim[p]; const float mag = expf(lr * dt); float sn, cs; sincosf(li * dt, &sn, &cs);
        const float ar = mag * cs, ai = mag * sn, den = lr * lr + li * li, qr = ((ar - 1.f) * lr + ai * li) / den, qi = (ai * lr - (ar - 1.f) * li) / den;
        const float br = bre[i], bi = bim[i]; Bb[i] = (f32x2){qr * br - qi * bi, qr * bi + qi * br};
        Cc[i] = (f32x2){cre[i], cim[i]}; }
    if (F.tid < 64) { const int p = F.tid; const float lr = lre[p], li = lim[p]; const float mag = expf(lr * dt); float sn, cs; sincosf(li * dt, &sn, &cs);
        const float ar = mag * cs, ai = mag * sn; float xr_ = 1.f, xi_ = 0.f;
        for (int k = 0; k <= kmax; ++k) { if (k >= kmin) Ap[k * 64 + p] = (f32x2){xr_, xi_}; const float nr = xr_ * ar - xi_ * ai, ni = xr_ * ai + xi_ * ar; xr_ = nr; xi_ = ni; } }
    __syncthreads();
}
constexpr size_t WS_KTAB = WS_S;
constexpr size_t WS_WRIMG = WS_AL + 512 * 1024;
__device__ __forceinline__ void p0_s5k_job(Frame& F, int job) {
    const int g = job >> 3, part = job & 7;
    LAS f32x2* Bb = (LAS f32x2*)F.lds; LAS f32x2* Cc = Bb + 1024; LAS f32x2* Ap = Cc + 1024;
    s5_setup(F, g, 4 * part, 4 * part + 3, Bb, Cc, Ap);
    float* kt = WSP(float, WS_KTAB) + (size_t)g * 32 * 256;
    for (int e = 4 * part * 256 + F.tid; e < (4 * part + 4) * 256; e += 512) { const int k = e >> 8, c = (e >> 4) & 15, c2 = e & 15; float s = 0.f;
        for (int p = 0; p < 64; ++p) { const f32x2 cv = Cc[c * 64 + p], av = Ap[k * 64 + p], bv = Bb[p * 16 + c2];
            const float car = cv.x * av.x - cv.y * av.y, cai = cv.x * av.y + cv.y * av.x; s += car * bv.x - cai * bv.y; }
        kt[e] = s; }
    __syncthreads();
}
__device__ __forceinline__ void p1_s5w_job(Frame& F, int job) {
    const int g = job >> 3, part = job & 7;
    LAS f32x2* Bb = (LAS f32x2*)F.lds; LAS f32x2* Cc = Bb + 1024; LAS f32x2* Ap = Cc + 1024; LAS float* Kt = (LAS float*)(Ap + 33 * 64);
    const float* ktg = WSP(float, WS_KTAB) + (size_t)g * 32 * 256; const float* dsk = F.in[21] + g * 16;
    for (int i = F.tid; i < 32 * 256; i += 512) Kt[i] = ktg[i];
    s5_setup(F, g, 0, S5L, Bb, Cc, Ap);
    if (part == 0 && F.tid < 64) WSP(f32x2, WS_AL)[g * 64 + F.tid] = Ap[S5L * 64 + F.tid];
    bf16* wy = WSP(bf16, WS_WY) + (size_t)g * 512 * S5ROW;
    for (int ch = F.tid; ch < 64 * (S5ROW / 8); ch += 512) { const int n = part * 64 + ch / (S5ROW / 8), k8 = (ch % (S5ROW / 8)) * 8, i = n >> 4, c = n & 15; float v[8]; const float dskc = dsk[c];
        if (k8 < 128) {
#pragma unroll
            for (int j = 0; j < 8; j += 2) { const int p = (k8 + j) >> 1; const f32x2 cv = Cc[c * 64 + p], av = Ap[(i + 1) * 64 + p]; v[j] = cv.x * av.x - cv.y * av.y; v[j + 1] = -(cv.x * av.y + cv.y * av.x); } }
        else { const int jj = (k8 - 128) >> 4, c2 = (k8 - 128) & 15;
#pragma unroll
            for (int j = 0; j < 8; ++j) { float x = 0.f; if (jj <= i) { x = Kt[(i - jj) * 256 + c * 16 + c2 + j]; x += (jj == i && c == c2 + j) ? dskc : 0.f; } v[j] = x; } }
        u32x4 o; o.x = pk2(v[0], v[1]); o.y = pk2(v[2], v[3]); o.z = pk2(v[4], v[5]); o.w = pk2(v[6], v[7]);
        *(u32x4*)(wy + (size_t)n * S5ROW + k8) = o; }
    bf16* wsm = WSP(bf16, WS_WS) + (size_t)g * 256 * 512;
    for (int ch = F.tid; ch < 32 * 64; ch += 512) { const int n = part * 32 + (ch >> 6), k8 = (ch & 63) * 8, jj = k8 >> 4, c2 = k8 & 15; float v[8];
#pragma unroll
        for (int j = 0; j < 8; ++j) { float x = 0.f; if (n < 128) { const int p = n >> 1; const f32x2 av = Ap[(S5L - 1 - jj) * 64 + p], bv = Bb[p * 16 + c2 + j]; x = (n & 1) ? (av.x * bv.y + av.y * bv.x) : (av.x * bv.x - av.y * bv.y); } v[j] = x; }
        u32x4 o; o.x = pk2(v[0], v[1]); o.y = pk2(v[2], v[3]); o.z = pk2(v[4], v[5]); o.w = pk2(v[6], v[7]);
        *(u32x4*)(wsm + (size_t)n * 512 + k8) = o; }
    __syncthreads();
}
__device__ __forceinline__ void p0_small_transposes(Frame& F) {
    LAS float* scr = (LAS float*)(F.lds + F.wave * 16384);
    const int gw = F.vcu * 8 + F.wave, NGW = F.G * 8;
    constexpr int I_IN = 16 * 144, I_RNN = 16 * 32, I_OUT = 16 * 32, I_GLU = 8 * 64, I_RG = 16 * 8;
    for (int it = gw; it < I_IN + I_RNN + I_OUT + I_GLU + I_RG; it += NGW) { int r = it;
        if (r < I_IN) { const int kb = r / 144, nb = r % 144; transpose_item8(F.in[4], INC, kb * 64, nb * 32, WSP(unsigned char, WS_WIN), 1024, nb * 32, scr, F.lane); continue; } r -= I_IN;
        if (r < I_RNN) { const int kb = r / 32, nb = r % 32; transpose_item8(F.in[13], 1024, kb * 64, nb * 32, WSP(unsigned char, WS_WRNN), 1024, nb * 32, scr, F.lane); continue; } r -= I_RNN;
        if (r < I_OUT) { const int kb = r / 32, nb = r % 32; transpose_item8(F.in[23], 1024, kb * 64, nb * 32, WSP(unsigned char, WS_WOUT), 1024, nb * 32, scr, F.lane); continue; } r -= I_OUT;
        if (r < I_GLU) { const int kb = r / 64, nb = r % 64; transpose_item8(F.in[22], 2048, kb * 64, nb * 32, WSP(unsigned char, WS_WGLU), 512, pair_row(nb * 32), scr, F.lane); continue; } r -= I_GLU;
        { const int mat = r >> 3, kb = (r >> 2) & 1, nb = r & 3, hd = mat & 7, gx = mat >> 3;
          transpose_item(F.in[gx ? 10 : 8] + (size_t)hd * 128 * 128, 128, kb * 64, nb * 32, WSP(bf16, WS_WG), 128, hd * 256 + gx * 128 + nb * 32, scr, F.lane); }
    }
}
__device__ __forceinline__ void p1_body(Frame& F) {
    const int gw = F.vcu * 8 + F.wave, NGW = F.G * 8; const float* mod = WSP(float, WS_MOD); bf16* hbf = WSP(bf16, WS_HBF);
    for (int tb = 4 * gw; tb < T; tb += 4 * NGW) {
        const int b = tb >> 12; f32x4 xv[4][4], shv[4], scv[4];
#pragma unroll
        for (int r = 0; r < 4; ++r) { const f32x4* xr = (const f32x4*)(F.in[0] + (size_t)(tb + r) * 1024) + F.lane;
#pragma unroll
            for (int j = 0; j < 4; ++j) xv[r][j] = xr[64 * j]; }
#pragma unroll
        for (int j = 0; j < 4; ++j) { shv[j] = *((const f32x4*)(mod + b * 6144) + F.lane + 64 * j); scv[j] = *((const f32x4*)(mod + b * 6144 + 1024) + F.lane + 64 * j) + 1.0f; }
#pragma unroll
        for (int r = 0; r < 4; ++r) { unsigned* o = (unsigned*)((unsigned char*)hbf + (size_t)(tb + r) * 1024) + F.lane;
#pragma unroll
            for (int j = 0; j < 4; ++j) { const f32x4 v = xv[r][j] * scv[j] + shv[j]; o[64 * j] = pk4_fp8(v[0], v[1], v[2], v[3]); } } }
    constexpr int TP = 132;
    LAS float* tile = (LAS float*)F.lds;
    constexpr int TILES_GU = 8 * 16, TILES_D = 8 * 8, TILES_E = TILES_GU + TILES_D;
    const int lr = F.tid >> 5, lc4 = (F.tid & 31) * 4, tn = F.tid >> 2, kc = F.tid & 3;
    f32x4 pre[8];
    int ti = F.vcu;
#define P1_SRC(idx, src, N_, dstp, drow0_, k0_) do { const int e_ = (idx) / TILES_E, r_ = (idx) % TILES_E; \
        if (r_ < TILES_GU) { const int kb_ = r_ >> 4, nb_ = r_ & 15; N_ = 2048; src = F.in[28] + (size_t)e_ * 1024 * 2048 + (size_t)(kb_ * 128) * 2048 + nb_ * 128; dstp = WSP(unsigned char, WS_WGU) + (size_t)e_ * 2048 * 1024; drow0_ = pair_row(nb_ * 128); k0_ = kb_ * 128; } \
        else { const int q_ = r_ - TILES_GU, kb_ = q_ >> 3, nb_ = q_ & 7; N_ = 1024; src = F.in[30] + (size_t)e_ * 1024 * 1024 + (size_t)(kb_ * 128) * 1024 + nb_ * 128; dstp = WSP(unsigned char, WS_WD) + (size_t)e_ * 1024 * 1024; drow0_ = nb_ * 128; k0_ = kb_ * 128; } } while (0)
    if (ti < NE * TILES_E) { const float* src; unsigned char* dstp; int N_, d0, k0; P1_SRC(ti, src, N_, dstp, d0, k0);
#pragma unroll
        for (int i = 0; i < 8; ++i) pre[i] = *(const f32x4*)(src + (size_t)(lr + 16 * i) * N_ + lc4); }
    for (; ti < NE * TILES_E; ti += F.G) {
#pragma unroll
        for (int i = 0; i < 8; ++i) *(LAS f32x4*)(tile + (lr + 16 * i) * TP + lc4) = pre[i];
        __syncthreads();
        const int tnx = (ti + F.G < NE * TILES_E) ? ti + F.G : ti;
        { const float* src; unsigned char* dstp; int N_, d0, k0; P1_SRC(tnx, src, N_, dstp, d0, k0);
#pragma unroll
            for (int i = 0; i < 8; ++i) pre[i] = *(const f32x4*)(src + (size_t)(lr + 16 * i) * N_ + lc4); }
        { const float* src; unsigned char* dstp; int N_, d0, k0; P1_SRC(ti, src, N_, dstp, d0, k0); (void)src; (void)N_;
          const LAS float* cp = tile + (32 * kc) * TP + tn; u32x4 o0, o1;
          o0.x = pk4_fp8(32.f * cp[0 * TP], 32.f * cp[1 * TP], 32.f * cp[2 * TP], 32.f * cp[3 * TP]); o0.y = pk4_fp8(32.f * cp[4 * TP], 32.f * cp[5 * TP], 32.f * cp[6 * TP], 32.f * cp[7 * TP]);
          o0.z = pk4_fp8(32.f * cp[8 * TP], 32.f * cp[9 * TP], 32.f * cp[10 * TP], 32.f * cp[11 * TP]); o0.w = pk4_fp8(32.f * cp[12 * TP], 32.f * cp[13 * TP], 32.f * cp[14 * TP], 32.f * cp[15 * TP]);
          o1.x = pk4_fp8(32.f * cp[16 * TP], 32.f * cp[17 * TP], 32.f * cp[18 * TP], 32.f * cp[19 * TP]); o1.y = pk4_fp8(32.f * cp[20 * TP], 32.f * cp[21 * TP], 32.f * cp[22 * TP], 32.f * cp[23 * TP]);
          o1.z = pk4_fp8(32.f * cp[24 * TP], 32.f * cp[25 * TP], 32.f * cp[26 * TP], 32.f * cp[27 * TP]); o1.w = pk4_fp8(32.f * cp[28 * TP], 32.f * cp[29 * TP], 32.f * cp[30 * TP], 32.f * cp[31 * TP]);
          unsigned char* op = dstp + (size_t)(d0 + tn) * 1024 + k0 + 32 * kc; *(u32x4*)op = o0; *(u32x4*)(op + 16) = o1; }
        __syncthreads();
    }
#undef P1_SRC
}
constexpr int XR_LD = 136, XR_TILE = 128 * XR_LD;
__device__ __forceinline__ void rg_issue(const bf16* xrnn, const bf16* gy, int item, int tid, u32x4 (&xraw)[4][4], u32x4 (&graw)[4], bool pass1) {
    const int hd = item & 7, c = (item >> 3) & 31, b = item >> 8, r0 = tid >> 4, ch = hd * 128 + (tid & 15) * 8;
#pragma unroll
    for (int q = 0; q < 4; ++q) { const int r = r0 + 32 * q;
#pragma unroll
        for (int k = 0; k < 4; ++k) { const int tp = c * RGL + r - 3 + k, tpc = tp < 0 ? 0 : tp; xraw[q][k] = *(const u32x4*)(xrnn + (size_t)(b * SEQ + tpc) * 1024 + ch); }
        if (pass1) graw[q] = *(const u32x4*)(gy + (size_t)(b * SEQ + c * RGL + r) * 1024 + ch); }
}
__device__ __forceinline__ void rg_convwrite(const LAS float* cwl, int item, int tid, const u32x4 (&xraw)[4][4], const u32x4 (&graw)[4], LAS bf16* xr, LAS bf16* gyt, bool pass1) {
    const int c = (item >> 3) & 31, r0 = tid >> 4, c8 = (tid & 15) * 8;
    const f32x4 b0 = *(const LAS f32x4*)(cwl + 4 * 128 + c8), b1 = *(const LAS f32x4*)(cwl + 4 * 128 + c8 + 4);
    f32x4 w0[4], w1[4];
#pragma unroll
    for (int k = 0; k < 4; ++k) { w0[k] = *(const LAS f32x4*)(cwl + k * 128 + c8); w1[k] = *(const LAS f32x4*)(cwl + k * 128 + c8 + 4); }
#pragma unroll
    for (int q = 0; q < 4; ++q) { const int r = r0 + 32 * q; f32x4 a0 = b0, a1 = b1;
#pragma unroll
        for (int k = 0; k < 4; ++k) { const int tp = c * RGL + r - 3 + k; f32x4 x0, x1; unpack8(xraw[q][k], x0, x1); if (tp < 0) { x0 = (f32x4){0.f, 0.f, 0.f, 0.f}; x1 = x0; } a0 += w0[k] * x0; a1 += w1[k] * x1; }
        *(LAS u32x4*)(xr + r * XR_LD + c8) = pack8(a0, a1);
        if (pass1) *(LAS u32x4*)(gyt + r * XR_LD + c8) = graw[q]; }
}
template <int PASS>
__device__ __forceinline__ void rglru_phase(Frame& F) {
    const int NIT = NB * RGC * 8;
    const bool skew = (PASS == 0) && (F.G == 256);
    const int nmine = skew ? (F.vcu < 128 ? 7 : 9) : (NIT - F.vcu + F.G - 1) / F.G;
#define RG_ITEM(k) ((skew && (k) >= 7) ? (1792 + (F.vcu - 128) + 128 * ((k) - 7)) : (F.vcu + (k) * F.G))
    if (nmine <= 0) return;
    int it = RG_ITEM(0);
    LAS bf16* xr = (LAS bf16*)F.lds; LAS bf16* gyt0 = xr + XR_TILE;
    const bf16* xrnn = WSP(bf16, WS_XRNN); const bf16* gy = WSP(bf16, WS_GY); bf16* ha = WSP(bf16, WS_HA); const float* cw = F.in[6]; const float* cb = F.in[7];
    const int tid = F.tid, w = F.wave, q = F.lane >> 4, col = F.lane & 15, chl = 16 * w + col;
    u32x4 xraw[4][4], graw[4];
    LAS float* cwl = (LAS float*)(gyt0 + 2 * XR_TILE);
    for (int i = tid; i < 5 * 128; i += 512) { const int k = i >> 7, chh = (it & 7) * 128 + (i & 127); cwl[i] = (k < 4) ? cw[k * 1024 + chh] : cb[chh]; }
    rg_issue(xrnn, gy, it, tid, xraw, graw, PASS);
    __syncthreads();
    rg_convwrite(cwl, it, tid, xraw, graw, xr, gyt0, PASS);
    bf16x8 Bf[2][4]; float ba, bx, sp;
    { const int hd0 = it & 7, ch0 = hd0 * 128 + chl; const bf16* wg = WSP(bf16, WS_WG) + (size_t)hd0 * 256 * 128;
#pragma unroll
      for (int gt = 0; gt < 2; ++gt)
#pragma unroll
          for (int kk = 0; kk < 4; ++kk) Bf[gt][kk] = *(const bf16x8*)(wg + (size_t)(gt * 128 + chl) * 128 + kk * 32 + q * 8);
      ba = F.in[9][ch0]; bx = F.in[11][ch0]; const float lam = F.in[12][ch0]; sp = (lam > 15.f) ? __expf(-lam) : log1pf(__expf(-lam)); }
#pragma unroll
    for (int gt = 0; gt < 2; ++gt)
#pragma unroll
        for (int kk = 0; kk < 4; ++kk) asm volatile("" :: "v"(Bf[gt][kk]));
    asm volatile("" :: "v"(ba), "v"(bx), "v"(sp));
    __syncthreads();
    for (int i = 0; i < nmine; ++i) {
        const bool has_next = (i + 1) < nmine; const int nit = has_next ? RG_ITEM(i + 1) : it;
        const int hd = it & 7, c = (it >> 3) & 31, b = it >> 8, t0 = b * SEQ + c * RGL, ch = hd * 128 + chl;
        LAS bf16* gyt = gyt0 + (i & 1) * XR_TILE; LAS bf16* gytn = gyt0 + ((i & 1) ^ 1) * XR_TILE;
        float carryH = 0.f, carryP = 1.f;
        if (PASS) carryH = WSP(float, WS_HIN)[(size_t)(b * RGC + c) * 1024 + ch];
        __builtin_amdgcn_sched_barrier(0);
        rg_issue(xrnn, gy, nit, tid, xraw, graw, PASS);
        __builtin_amdgcn_sched_barrier(0);
        f32x4 acc[8][2];
#pragma unroll
        for (int m = 0; m < 8; ++m) { acc[m][0] = (f32x4){0.f, 0.f, 0.f, 0.f}; acc[m][1] = (f32x4){0.f, 0.f, 0.f, 0.f}; }
#pragma unroll
        for (int kk = 0; kk < 4; ++kk)
#pragma unroll
            for (int m = 0; m < 8; ++m) { const bf16x8 Af = *(const LAS bf16x8*)(xr + (16 * m + col) * XR_LD + kk * 32 + q * 8);
                acc[m][0] = __builtin_amdgcn_mfma_f32_16x16x32_bf16(Af, Bf[0][kk], acc[m][0], 0, 0, 0);
                acc[m][1] = __builtin_amdgcn_mfma_f32_16x16x32_bf16(Af, Bf[1][kk], acc[m][1], 0, 0, 0); }
#pragma unroll
        for (int m = 0; m < 8; ++m) {
            float a[4], uu[4];
#pragma unroll
            for (int j = 0; j < 4; ++j) { const int tl = 16 * m + 4 * q + j;
                const float r = fast_sigmoid(acc[m][0][j] + ba), ii = fast_sigmoid(acc[m][1][j] + bx);
                const float la = -11.541560327f * r * sp; a[j] = __builtin_amdgcn_exp2f(la); const float mult = __builtin_amdgcn_sqrtf(fmaxf(1.0f - a[j] * a[j], 0.f));
                uu[j] = mult * ii * bf1(xr[tl * XR_LD + chl]); }
            float sP = a[0], sH = uu[0];
#pragma unroll
            for (int j = 1; j < 4; ++j) { sH = a[j] * sH + uu[j]; sP *= a[j]; }
            float iP = sP, iH = sH;
            { const float pP = __shfl_up(iP, 16), pH = __shfl_up(iH, 16); if (q >= 1) { iH = iP * pH + iH; iP = iP * pP; } }
            { const float pP = __shfl_up(iP, 32), pH = __shfl_up(iH, 32); if (q >= 2) { iH = iP * pH + iH; iP = iP * pP; } }
            float eP = __shfl_up(iP, 16), eH = __shfl_up(iH, 16); if (q == 0) { eP = 1.f; eH = 0.f; }
            const float tP = __shfl(iP, col + 48), tH = __shfl(iH, col + 48);
            if (PASS) { float h = eP * carryH + eH;
#pragma unroll
                for (int j = 0; j < 4; ++j) { const int tl = 16 * m + 4 * q + j; h = a[j] * h + uu[j]; LAS bf16* gp = gyt + tl * XR_LD + chl; *gp = (bf16)f2bf(h * bf1(*gp)); } }
            carryH = tP * carryH + tH; carryP *= tP;
        }
        if (!PASS && q == 0) { f32x2* ag = WSP(f32x2, WS_RGAGG); ag[(size_t)(b * RGC + c) * 1024 + ch] = (f32x2){carryP, carryH}; }
        __syncthreads();
        if (PASS) { const int r0 = tid >> 4, c8 = (tid & 15) * 8;
#pragma unroll
            for (int qq = 0; qq < 4; ++qq) { const int r = r0 + 32 * qq; f32x4 h0, h1; unpack8(*(const LAS u32x4*)(gyt + r * XR_LD + c8), h0, h1); u32x2 w8; w8.x = pk4_fp8(h0[0], h0[1], h0[2], h0[3]); w8.y = pk4_fp8(h1[0], h1[1], h1[2], h1[3]);
                *(u32x2*)((unsigned char*)ha + (size_t)(t0 + r) * 1024 + hd * 128 + c8) = w8; } }
#pragma unroll
        for (int qq = 0; qq < 4; ++qq) {
#pragma unroll
            for (int k = 0; k < 4; ++k) asm volatile("" : "+v"(xraw[qq][k]));
            if (PASS) asm volatile("" : "+v"(graw[qq])); }
        if (has_next) rg_convwrite(cwl, nit, tid, xraw, graw, xr, gytn, PASS);
        __syncthreads();
        it = nit;
    }
#undef RG_ITEM
}
__device__ __forceinline__ void p4_carries(Frame& F) {
    LAS f32x2* seg = (LAS f32x2*)F.lds;
    for (int job = F.vcu; job < NB * S5G; job += F.G) {
        const int b = job >> 5, g = job & 31, p = F.lane, w = F.wave;
        const f32x2 al = WSP(f32x2, WS_AL)[g * 64 + p];
        const f32x2* Sb = WSP(f32x2, WS_S) + ((size_t)(g * S5M + b * S5CPB + 16 * w)) * 64 + p; unsigned* ac = (unsigned*)(WSP(bf16, WS_ACAT) + ((size_t)(g * S5M + b * S5CPB + 16 * w)) * S5ROW) + p;
        f32x2 sv[16];
#pragma unroll
        for (int i = 0; i < 16; ++i) sv[i] = Sb[(size_t)i * 64];
        float xr_ = 0.f, xi = 0.f;
#pragma unroll
        for (int i = 0; i < 16; ++i) { const float nr = al.x * xr_ - al.y * xi + sv[i].x, ni = al.x * xi + al.y * xr_ + sv[i].y; xr_ = nr; xi = ni; }
        seg[w * 64 + p] = (f32x2){xr_, xi};
        float ar = al.x, ai = al.y;
#pragma unroll
        for (int q = 0; q < 4; ++q) { const float nr = ar * ar - ai * ai, ni = 2.f * ar * ai; ar = nr; ai = ni; }
        __syncthreads();
        xr_ = 0.f; xi = 0.f;
        for (int ww = 0; ww < w; ++ww) { const f32x2 sg = seg[ww * 64 + p]; const float nr = ar * xr_ - ai * xi + sg.x, ni = ar * xi + ai * xr_ + sg.y; xr_ = nr; xi = ni; }
#pragma unroll
        for (int i = 0; i < 16; ++i) { ac[(size_t)i * (S5ROW / 2)] = pk2(xr_, xi); const float nr = al.x * xr_ - al.y * xi + sv[i].x, ni = al.x * xi + al.y * xr_ + sv[i].y; xr_ = nr; xi = ni; }
        __syncthreads();
    }
    if (F.vcu < 16) {
        const int id = F.vcu * 512 + F.tid, ch = id & 1023, b = id >> 10; const f32x2* ag = WSP(f32x2, WS_RGAGG) + (size_t)b * RGC * 1024 + ch; float* hin = WSP(float, WS_HIN) + (size_t)b * RGC * 1024 + ch;
        f32x2 a[RGC];
#pragma unroll
        for (int c = 0; c < RGC; ++c) a[c] = ag[(size_t)c * 1024];
        float h = 0.f;
#pragma unroll
        for (int c = 0; c < RGC; ++c) { hin[(size_t)c * 1024] = h; h = a[c].x * h + a[c].y; }
    }
}
constexpr int WR_LD = 1032;
__device__ __forceinline__ void p9_router(Frame& F) {
    LAS bf16* wH = (LAS bf16*)F.lds; LAS bf16* wL = wH + 32 * WR_LD;
    LAS f32x2* sel = (LAS f32x2*)(wL + 32 * WR_LD);
    LAS unsigned* rec = (LAS unsigned*)(sel + 512);
    LAS float* recp = (LAS float*)(rec + 512);
    LAS int* lcnt = (LAS int*)(recp + 512);
    LAS int* gbase = lcnt + 32;
    { const u32x4* img = WSP(u32x4, WS_WRIMG); LAS u32x4* dst = (LAS u32x4*)wH;
      for (int i = F.tid; i < 2 * 32 * WR_LD * 2 / 16; i += 512) dst[i] = img[i]; }
    if (F.tid < 32) lcnt[F.tid] = 0;
    __syncthreads();
    const float* mod = WSP(float, WS_MOD); const bf16* v1 = WSP(bf16, WS_V1); bf16* x1 = WSP(bf16, WS_X1); unsigned char* h2 = WSP(unsigned char, WS_H2);
    const int lane = F.lane, m = lane & 15, kq = lane >> 4, w = F.wave;
    for (int blk = F.vcu; blk < T / 128; blk += F.G) {
        const int t = blk * 128 + w * 16 + m, b = (blk * 128) >> 12;
        const bf16* vrow = v1 + (size_t)t * 1024 + 8 * kq;
        float sum = 0.f, sq = 0.f;
#pragma unroll 32
        for (int s_ = 0; s_ < 32; ++s_) { f32x4 a, c; unpack8(*(const u32x4*)(vrow + 32 * s_), a, c); sum += ((a[0] + a[1]) + (a[2] + a[3])) + ((c[0] + c[1]) + (c[2] + c[3]));
            sq += ((a[0] * a[0] + a[1] * a[1]) + (a[2] * a[2] + a[3] * a[3])) + ((c[0] * c[0] + c[1] * c[1]) + (c[2] * c[2] + c[3] * c[3])); }
        sum += __shfl_xor(sum, 16); sum += __shfl_xor(sum, 32); sq += __shfl_xor(sq, 16); sq += __shfl_xor(sq, 32);
        const float mean = sum * (1.f / 1024.f); const float rstd = 1.f / sqrtf(fmaxf(sq * (1.f / 1024.f) - mean * mean, 0.f) + LN_EPS);
        f32x4 acc[2] = {(f32x4){0.f, 0.f, 0.f, 0.f}, (f32x4){0.f, 0.f, 0.f, 0.f}};
        const float* lng = F.in[24] + 8 * kq; const float* lnb = F.in[25] + 8 * kq; const float* shp = mod + b * 6144 + 3072 + 8 * kq; const float* scp = mod + b * 6144 + 4096 + 8 * kq;
        bf16* x1row = x1 + (size_t)t * 1024 + 8 * kq; unsigned char* h2row = h2 + (size_t)t * 1024 + 8 * kq;
        const LAS bf16* wHr = wH + m * WR_LD + 8 * kq; const LAS bf16* wLr = wL + m * WR_LD + 8 * kq;
#pragma unroll 2
        for (int s2 = 0; s2 < 32; s2 += 2) {
            u32x4 rw[2]; f32x4 pg[2][2], pb[2][2], psh[2][2], psc[2][2];
#pragma unroll
            for (int h = 0; h < 2; ++h) { const int ko = 32 * (s2 + h); rw[h] = *(const u32x4*)(vrow + ko);
                pg[h][0] = *(const f32x4*)(lng + ko); pg[h][1] = *(const f32x4*)(lng + ko + 4); pb[h][0] = *(const f32x4*)(lnb + ko); pb[h][1] = *(const f32x4*)(lnb + ko + 4);
                psh[h][0] = *(const f32x4*)(shp + ko); psh[h][1] = *(const f32x4*)(shp + ko + 4); psc[h][0] = *(const f32x4*)(scp + ko); psc[h][1] = *(const f32x4*)(scp + ko + 4); }
#pragma unroll
            for (int h = 0; h < 2; ++h) { const int ko = 32 * (s2 + h);
                f32x4 a, c; unpack8(rw[h], a, c);
                const f32x4 x0 = (a - mean) * rstd * pg[h][0] + pb[h][0], x1v = (c - mean) * rstd * pg[h][1] + pb[h][1];
                *(u32x4*)(x1row + ko) = pack8(x0, x1v);
                const f32x4 h0 = x0 * (psc[h][0] + 1.0f) + psh[h][0], h1 = x1v * (psc[h][1] + 1.0f) + psh[h][1];
                u32x2 w8; w8.x = pk4_fp8(h0[0], h0[1], h0[2], h0[3]); w8.y = pk4_fp8(h1[0], h1[1], h1[2], h1[3]); *(u32x2*)(h2row + ko) = w8;
                const u32x4 hi = pack8(h0, h1); f32x4 r0, r1; unpack8(hi, r0, r1); const u32x4 lo = pack8(h0 - r0, h1 - r1);
                const bf16x8 ah = __builtin_bit_cast(bf16x8, hi), al = __builtin_bit_cast(bf16x8, lo);
#pragma unroll
                for (int nf = 0; nf < 2; ++nf) { const bf16x8 bh = *(const LAS bf16x8*)(wHr + nf * 16 * WR_LD + ko), bl = *(const LAS bf16x8*)(wLr + nf * 16 * WR_LD + ko);
                    acc[nf] = __builtin_amdgcn_mfma_f32_16x16x32_bf16(bh, ah, acc[nf], 0, 0, 0);
                    acc[nf] = __builtin_amdgcn_mfma_f32_16x16x32_bf16(bl, ah, acc[nf], 0, 0, 0);
                    acc[nf] = __builtin_amdgcn_mfma_f32_16x16x32_bf16(bh, al, acc[nf], 0, 0, 0); } } }
        float lv[8];
#pragma unroll
        for (int nf = 0; nf < 2; ++nf)
#pragma unroll
            for (int j = 0; j < 4; ++j) lv[nf * 4 + j] = acc[nf][j] + F.in[27][nf * 16 + 4 * kq + j];
        int rank[8];
#pragma unroll
        for (int i = 0; i < 8; ++i) { rank[i] = 0;
#pragma unroll
            for (int i2 = 0; i2 < 8; ++i2) if (i2 != i) { const int e1 = (i >> 2) * 16 + 4 * kq + (i & 3), e2 = (i2 >> 2) * 16 + 4 * kq + (i2 & 3); rank[i] += (lv[i2] > lv[i] || (lv[i2] == lv[i] && e2 < e1)) ? 1 : 0; } }
#pragma unroll
        for (int dq = 1; dq < 4; ++dq) { const int q2 = kq ^ dq;
#pragma unroll
            for (int i2 = 0; i2 < 8; ++i2) { const float o = __shfl_xor(lv[i2], 16 * dq); const int e2 = (i2 >> 2) * 16 + 4 * q2 + (i2 & 3);
#pragma unroll
                for (int i = 0; i < 8; ++i) { const int e1 = (i >> 2) * 16 + 4 * kq + (i & 3); rank[i] += (o > lv[i] || (o == lv[i] && e2 < e1)) ? 1 : 0; } } }
#pragma unroll
        for (int i = 0; i < 8; ++i) if (rank[i] < 4) { const int e1 = (i >> 2) * 16 + 4 * kq + (i & 3); sel[(w * 16 + m) * 4 + rank[i]] = (f32x2){__builtin_bit_cast(float, e1), lv[i]}; }
        asm volatile("s_waitcnt lgkmcnt(0)" ::: "memory");
        { const int tm = lane >> 2, k = lane & 3; const f32x2 s0 = sel[(w * 16 + tm) * 4 + 0], s1 = sel[(w * 16 + tm) * 4 + 1], s2 = sel[(w * 16 + tm) * 4 + 2], s3 = sel[(w * 16 + tm) * 4 + 3];
          const float p0 = 1.f, p1 = __expf(s1.y - s0.y), p2 = __expf(s2.y - s0.y), p3 = __expf(s3.y - s0.y), ps = (p0 + p1) + (p2 + p3);
          const f32x2 mine = k == 0 ? s0 : (k == 1 ? s1 : (k == 2 ? s2 : s3)); const float pm = (k == 0 ? p0 : (k == 1 ? p1 : (k == 2 ? p2 : p3))) / ps;
          const int e = __builtin_bit_cast(int, mine.x);
          const int lr = __hip_atomic_fetch_add(lcnt + e, 1, __ATOMIC_RELAXED, __HIP_MEMORY_SCOPE_WORKGROUP);
          rec[(w * 16 + tm) * 4 + k] = ((unsigned)e << 16) | (unsigned)lr; recp[(w * 16 + tm) * 4 + k] = pm; }
        __syncthreads();
        if (F.tid < 32) { const int n = lcnt[F.tid]; gbase[F.tid] = n ? (int)atomicAdd(F.ctl + CW_CNT + 64 * F.tid, (unsigned)n) : 0; lcnt[F.tid] = 0; }
        __syncthreads();
        { const unsigned r = rec[F.tid]; const int e = r >> 16, rk = gbase[e] + (int)(r & 0xffffu), tt = blk * 128 + (F.tid >> 2);
          WSP(int, WS_TOK)[(size_t)e * T + rk] = tt; WSP(unsigned, WS_POS)[(size_t)tt * 4 + (F.tid & 3)] = ((unsigned)e << 20) | (unsigned)rk; WSP(float, WS_PROB)[(size_t)tt * 4 + (F.tid & 3)] = recp[F.tid]; }
        __syncthreads();
    }
}
__device__ __forceinline__ void p12_final(Frame& F) {
    moe_tables(F);
    const LAS int* tstart = (const LAS int*)(F.lds + TAB_OFF);
    const float* mod = WSP(float, WS_MOD); const bf16* x1 = WSP(bf16, WS_X1); const bf16* yb = WSP(bf16, WS_YB); const unsigned* pos = WSP(unsigned, WS_POS); const float* prob = WSP(float, WS_PROB);
    const int lane = F.lane, gw = F.vcu * 8 + F.wave, NGW = F.G * 8;
    f32x4 lg[4], lb[4];
#pragma unroll
    for (int j = 0; j < 4; ++j) { lg[j] = *(const f32x4*)(F.in[32] + 512 * (j >> 1) + 8 * lane + 4 * (j & 1)); lb[j] = *(const f32x4*)(F.in[33] + 512 * (j >> 1) + 8 * lane + 4 * (j & 1)); }
#define P12_ROUTE(PP, PW, tt) do { const u32x4 p4_ = *(const u32x4*)(pos + (size_t)(tt) * 4); const f32x4 w4_ = *(const f32x4*)(prob + (size_t)(tt) * 4); \
        PP[0] = p4_.x; PP[1] = p4_.y; PP[2] = p4_.z; PP[3] = p4_.w; PW[0] = w4_[0]; PW[1] = w4_[1]; PW[2] = w4_[2]; PW[3] = w4_[3]; } while (0)
#define P12_ROWS(YW, XW, PP, tt) do { _Pragma("unroll") for (int k = 0; k < 4; ++k) { const int e_ = PP[k] >> 20, rk_ = PP[k] & 0xfffffu; const size_t slot_ = (size_t)tstart[e_] * 256 + rk_; \
            _Pragma("unroll") for (int j = 0; j < 2; ++j) YW[k][j] = *((const u32x2*)((const unsigned char*)yb + slot_ * 1024) + 64 * j + lane); } \
        _Pragma("unroll") for (int j = 0; j < 2; ++j) XW[j] = *((const u32x4*)(x1 + (size_t)(tt) * 1024) + 64 * j + lane); } while (0)
#define P12_COMPUTE(YW, XW, PW, tt) do { const int b_ = (tt) >> 12; f32x4 v[4]; float s_ = 0.f; \
        _Pragma("unroll") for (int j = 0; j < 2; ++j) { f32x4 f0 = (f32x4){0.f, 0.f, 0.f, 0.f}, f1 = f0; \
            _Pragma("unroll") for (int k = 0; k < 4; ++k) { const u32x2 yv_ = YW[k][j]; const f32x2 q0_ = __builtin_amdgcn_cvt_pk_f32_fp8((int)yv_.x, false), q1_ = __builtin_amdgcn_cvt_pk_f32_fp8((int)yv_.x, true), q2_ = __builtin_amdgcn_cvt_pk_f32_fp8((int)yv_.y, false), q3_ = __builtin_amdgcn_cvt_pk_f32_fp8((int)yv_.y, true); \
                f0 += (f32x4){q0_.x, q0_.y, q1_.x, q1_.y} * PW[k]; f1 += (f32x4){q2_.x, q2_.y, q3_.x, q3_.y} * PW[k]; } \
            f32x4 xa_, xc_; unpack8(XW[j], xa_, xc_); const float* gp_ = mod + b_ * 6144 + 5120 + 512 * j + 8 * lane; \
            v[2 * j] = xa_ * DN_ALPHA + (*(const f32x4*)gp_ + 1.0f) * f0; v[2 * j + 1] = xc_ * DN_ALPHA + (*(const f32x4*)(gp_ + 4) + 1.0f) * f1; \
            s_ += ((v[2 * j][0] + v[2 * j][1]) + (v[2 * j][2] + v[2 * j][3])) + ((v[2 * j + 1][0] + v[2 * j + 1][1]) + (v[2 * j + 1][2] + v[2 * j + 1][3])); } \
        const float mean_ = wave_sum(s_) * (1.f / 1024.f); float s2_ = 0.f; \
        _Pragma("unroll") for (int j = 0; j < 4; ++j) { v[j] = v[j] - mean_; s2_ += (v[j][0] * v[j][0] + v[j][1] * v[j][1]) + (v[j][2] * v[j][2] + v[j][3] * v[j][3]); } \
        const float rstd_ = 1.f / sqrtf(wave_sum(s2_) * (1.f / 1024.f) + LN_EPS); \
        _Pragma("unroll") for (int j = 0; j < 4; ++j) *(f32x4*)(F.out + (size_t)(tt) * 1024 + 512 * (j >> 1) + 8 * lane + 4 * (j & 1)) = v[j] * rstd_ * lg[j] + lb[j]; } while (0)
    const int nmine = (T - gw + NGW - 1) / NGW;
    unsigned ppA[4], ppB[4]; float pwA[4], pwB[4], pwN[4]; u32x2 ywA[4][2], ywB[4][2]; u32x4 xwA[2], xwB[2];
    if (nmine > 0) { P12_ROUTE(ppA, pwA, gw); P12_ROWS(ywA, xwA, ppA, gw); }
    if (nmine > 1) { P12_ROUTE(ppB, pwB, gw + NGW); }
    for (int i = 0; i < nmine; i += 2) {
        const int t0 = gw + i * NGW, t1 = t0 + NGW, t2 = t1 + NGW, t3 = t2 + NGW;
        if (i + 1 < nmine) { P12_ROWS(ywB, xwB, ppB, t1); }
        if (i + 2 < nmine) { P12_ROUTE(ppA, pwN, t2); }
        __builtin_amdgcn_sched_barrier(0);
        P12_COMPUTE(ywA, xwA, pwA, t0);
        if (i + 1 < nmine) {
#pragma unroll
            for (int k = 0; k < 4; ++k) pwA[k] = pwN[k];
            if (i + 2 < nmine) { P12_ROWS(ywA, xwA, ppA, t2); }
            if (i + 3 < nmine) { P12_ROUTE(ppB, pwN, t3); }
            __builtin_amdgcn_sched_barrier(0);
            P12_COMPUTE(ywB, xwB, pwB, t1);
#pragma unroll
            for (int k = 0; k < 4; ++k) pwB[k] = pwN[k];
        }
    }
#undef P12_ROUTE
#undef P12_ROWS
#undef P12_COMPUTE
}

struct Args { const float* in[34]; float* out; unsigned char* ws; int ph_lo, ph_hi; };
__global__ void __launch_bounds__(512, 2) fwd_kernel(Args args) {
    extern __shared__ __attribute__((aligned(16))) unsigned char lds_raw[];
    Frame F;
    F.lds = (LAS unsigned char*)lds_raw; F.MISC = (volatile LAS unsigned*)(F.lds + MISC_OFF);
    F.tid = threadIdx.x; F.lane = F.tid & 63; F.wave = __builtin_amdgcn_readfirstlane(F.tid >> 6);
    F.G = gridDim.x; { const int bx = blockIdx.x; F.vcu = (F.G % 8 == 0) ? (bx % 8) * (F.G / 8) + bx / 8 : bx; }
#pragma unroll
    for (int i = 0; i < 34; ++i) F.in[i] = args.in[i];
    F.out = args.out; F.ws = args.ws; F.ctl = (unsigned*)(args.ws + WS_CTL);
    if (F.tid < 64) F.MISC[F.tid] = 0u;
    __syncthreads();
    XcdBarrier bar; bar.bar = F.ctl + CW_BAR; bar.x = 0; bar.st = nullptr;
    if (MK_N_LAUNCHES == 1) bar = xcd_barrier_post(F.ctl + CW_BAR, F.MISC + 8);
    const int lo = args.ph_lo, hi = args.ph_hi;
#define IN(k) (lo <= (k) && (k) < hi)
#define SEAM(k) do { if (IN(k) && IN((k) + 1)) xcd_barrier(bar); } while (0)

    if (IN(0)) REPS(0) { if (rep_) xcd_barrier(bar);
        for (int j = F.vcu; j < 192; j += F.G) p0_mod_job(F, j);
        for (int j = F.vcu; j < S5G * 8; j += F.G) p0_s5k_job(F, j);
        { bf16* img = WSP(bf16, WS_WRIMG); const float* wr = F.in[26];
          for (int i = F.vcu * 512 + F.tid; i < 1024 * 32; i += F.G * 512) { const float w = wr[i]; const unsigned hb = f2bf(w); const float hf = __builtin_bit_cast(float, hb << 16);
              img[(i & 31) * 1032 + (i >> 5)] = (bf16)hb; img[32 * 1032 + (i & 31) * 1032 + (i >> 5)] = (bf16)f2bf(w - hf); } }
        p0_small_transposes(F);
    }
    SEAM(0);
    if (IN(1)) REPS(1) { if (rep_) xcd_barrier(bar); for (int j = F.vcu; j < S5G * 8; j += F.G) p1_s5w_job(F, j); p1_body(F); }
    SEAM(1);
    if (IN(2)) REPS(2) { if (rep_) xcd_barrier(bar);
        g8::GridOrder S; S.init(T, INC, F.G, (int)blockIdx.x, WSP(bf16, WS_HBF), WSP(bf16, WS_WIN), 1024, 1024);
        EpiInProj E{F.in[5], WSP(bf16, WS_XRNN), WSP(bf16, WS_GY), WSP(bf16, WS_ACAT), WSP(bf16, WS_GATES)};
        g8::gemm_phase<EpiInProj, g8::GridOrder, false, true>(F.lds, 1024, 1024, 1024, S, E);
    }
    SEAM(2);
    if (IN(3)) REPS(3) { if (rep_) xcd_barrier(bar);
        { S5AOrder S{F.G, F.vcu, (const char*)WSP(bf16, WS_ACAT), (const char*)WSP(bf16, WS_WS)}; EpiS5A E{WSP(float, WS_S)};
          g8::gemm_phase<EpiS5A, S5AOrder, false>(F.lds, S5L * 32, S5ROW * 2, S5L * 32, S, E); }
        __syncthreads();
        rglru_phase<0>(F);
    }
    SEAM(3);
    if (IN(4)) REPS(4) { if (rep_) xcd_barrier(bar); p4_carries(F); }
    SEAM(4);
    if (IN(5)) REPS(5) { if (rep_) xcd_barrier(bar);
        { S5COrder S{F.G, F.vcu, (const char*)WSP(bf16, WS_ACAT), (const char*)WSP(bf16, WS_WY)}; EpiS5C E{WSP(bf16, WS_YS)};
          g8::gemm_phase<EpiS5C, S5COrder, false>(F.lds, S5ROW * 2, S5ROW * 2, S5ROW * 2, S, E); }
        __syncthreads();
        rglru_phase<1>(F);
    }
    SEAM(5);
    if (IN(6)) REPS(6) { if (rep_) xcd_barrier(bar);
        g8::GridOrder S; S.init(T, 2048, F.G, (int)blockIdx.x, WSP(bf16, WS_YS), WSP(bf16, WS_WGLU), 512, 512);
        EpiGlu E{WSP(bf16, WS_GATES), WSP(bf16, WS_GB)};
        g8::gemm_phase<EpiGlu, g8::GridOrder, false, true>(F.lds, 512, 512, 512, S, E);
    }
    SEAM(6);
    if (IN(7)) REPS(7) { if (rep_) xcd_barrier(bar);
        g8::GridOrder S; S.init(T, 1024, F.G, (int)blockIdx.x, WSP(bf16, WS_HA), WSP(bf16, WS_WRNN), 1024, 1024);
        EpiRnn E{WSP(bf16, WS_GATES), WSP(bf16, WS_GB), WSP(bf16, WS_MERGED)};
        g8::gemm_phase<EpiRnn, g8::GridOrder, false, true>(F.lds, 1024, 1024, 1024, S, E);
    }
    SEAM(7);
    if (IN(8)) REPS(8) { if (rep_) xcd_barrier(bar);
        g8::GridOrder S; S.init(T, 1024, F.G, (int)blockIdx.x, WSP(bf16, WS_MERGED), WSP(bf16, WS_WOUT), 1024, 1024);
        EpiOut E{F.in[0], WSP(float, WS_MOD), WSP(bf16, WS_V1)};
        g8::gemm_phase<EpiOut, g8::GridOrder, false, true>(F.lds, 1024, 1024, 1024, S, E);
    }
    SEAM(8);
    if (IN(9)) REPS(9) { if (rep_) xcd_barrier(bar); p9_router(F); }
    SEAM(9);
    if (IN(10)) REPS(10) { if (rep_) xcd_barrier(bar);
        moe_tables(F);
        const LAS int* tstart = (const LAS int*)(F.lds + TAB_OFF);
        MoeOrder S{F.G, (int)blockIdx.x, 8, tstart[NE], tstart, tstart + 40, WSP(int, WS_TOK), (const char*)WSP(bf16, WS_H2), (const char*)WSP(bf16, WS_WGU), (size_t)2048 * 1024, 1024, true};
        EpiMoe1 E{F.in[29], WSP(bf16, WS_ACT)};
        g8::gemm_phase<EpiMoe1, MoeOrder, true, true>(F.lds, 1024, 1024, 1024, S, E);
    }
    SEAM(10);
    if (IN(11)) REPS(11) { if (rep_) xcd_barrier(bar);
        moe_tables(F);
        const LAS int* tstart = (const LAS int*)(F.lds + TAB_OFF);
        MoeOrder S{F.G, (int)blockIdx.x, 4, tstart[NE], tstart, tstart + 40, WSP(int, WS_TOK), (const char*)WSP(bf16, WS_ACT), (const char*)WSP(bf16, WS_WD), (size_t)1024 * 1024, 1024, false};
        EpiMoe2 E{F.in[31], WSP(bf16, WS_YB)};
        g8::gemm_phase<EpiMoe2, MoeOrder, false, true>(F.lds, 1024, 1024, 1024, S, E);
    }
    SEAM(11);
    if (IN(12)) REPS(12) { if (rep_) xcd_barrier(bar); p12_final(F); }
#undef IN
#undef SEAM
}

extern "C" void kernel_launch(void* const* d_in, const int* in_sizes, int n_in, void* d_out, int out_size, void* d_ws, size_t ws_size, hipStream_t stream) {
    static int grid = 0;
    if (grid == 0) {
        if (n_in != 34 || in_sizes[0] != T * D || out_size != T * D || ws_size < WS_END) { fprintf(stderr, "kernel_launch: unexpected shapes (n_in %d, ws %zu < %zu)\n", n_in, ws_size, (size_t)WS_END); grid = -1; return; }
        int dev = 0, cus = 0;
        if (hipGetDevice(&dev) != hipSuccess || hipDeviceGetAttribute(&cus, hipDeviceAttributeMultiprocessorCount, dev) != hipSuccess) { grid = -1; return; }
        if (hipFuncSetAttribute((const void*)fwd_kernel, hipFuncAttributeMaxDynamicSharedMemorySize, LDS_BYTES) != hipSuccess) { fprintf(stderr, "kernel_launch: hipFuncSetAttribute failed\n"); grid = -1; return; }
        int per_cu = 0; (void)hipOccupancyMaxActiveBlocksPerMultiprocessor(&per_cu, (const void*)fwd_kernel, 512, LDS_BYTES); (void)hipGetLastError();
        grid = cus;
    }
    if (grid < 0) return;
    (void)hipMemsetAsync((char*)d_ws + WS_CTL, 0, CTL_BYTES, stream);
    Args a{};
    for (int i = 0; i < 34; ++i) a.in[i] = (const float*)d_in[i];
    a.out = (float*)d_out; a.ws = (unsigned char*)d_ws;
    if (MK_N_LAUNCHES == 1) { a.ph_lo = 0; a.ph_hi = N_PHASES; hipLaunchKernelGGL(fwd_kernel, dim3(grid), dim3(512), LDS_BYTES, stream, a); }
    else for (int p = 0; p < N_PHASES; ++p) { a.ph_lo = p; a.ph_hi = p + 1; hipLaunchKernelGGL(fwd_kernel, dim3(grid), dim3(512), LDS_BYTES, stream, a); }
}
```

```cpp
#include <hip/hip_runtime.h>
#include <cstdio>
#include <cstdint>

#ifndef MK_N_LAUNCHES
#define MK_N_LAUNCHES 1
#endif
constexpr int N_PHASES = 13;
#ifndef DUP_PHASE
#define DUP_PHASE -1
#endif
#define REPS(k) for (int rep_ = 0; rep_ < ((DUP_PHASE == (k)) ? 2 : 1); ++rep_)

#define GAS __attribute__((address_space(1)))
#define LAS __attribute__((address_space(3)))
typedef unsigned short bf16;
typedef short bf16x8 __attribute__((ext_vector_type(8)));
typedef float f32x4 __attribute__((ext_vector_type(4)));
typedef float f32x2 __attribute__((ext_vector_type(2)));
typedef unsigned u32x4 __attribute__((ext_vector_type(4)));
typedef unsigned u32x2 __attribute__((ext_vector_type(2)));
typedef GAS unsigned gu32;

constexpr int NB = 8, SEQ = 4096, T = NB * SEQ, D = 1024, INC = 4608, NE = 32, DFF = 1024;
constexpr int S5L = 32, S5G = 32, S5ROW = 128 + S5L * 16  , S5M = T / S5L  , S5CPB = SEQ / S5L  ;
constexpr int RGL = 128, RGC = SEQ / RGL  ;
constexpr float LN_EPS = 1e-5f, DN_ALPHA = 1.189207115002721f;
constexpr int ACT_ROWS = T * 4 + NE * 256;

constexpr size_t MiB = 1u << 20;
constexpr size_t WS_XRNN = 0, WS_GY = 64 * MiB, WS_GATES = 128 * MiB, WS_V1 = 0, WS_ACT = 0;
constexpr size_t WS_HBF = 272 * MiB, WS_HA = 272 * MiB, WS_YS = 336 * MiB, WS_GB = 368 * MiB, WS_MERGED = 432 * MiB, WS_ACAT = 496 * MiB, WS_YB = 272 * MiB;
constexpr size_t WS_X1 = 544 * MiB, WS_H2 = 608 * MiB;
constexpr size_t WS_WGU = 672 * MiB, WS_WD = 800 * MiB, WS_WIN = 864 * MiB, WS_WG = 873 * MiB, WS_WRNN = 874 * MiB, WS_WGLU = 876 * MiB, WS_WOUT = 878 * MiB;
constexpr size_t WS_WS = 880 * MiB, WS_WY = 888 * MiB, WS_S = 908 * MiB;
constexpr size_t WS_MOD = 924 * MiB, WS_AL = 925 * MiB, WS_RGAGG = 926 * MiB, WS_HIN = 928 * MiB, WS_TOK = 929 * MiB, WS_POS = 933 * MiB, WS_PROB = 934 * MiB, WS_CTL = 935 * MiB;
constexpr size_t WS_END = 936 * MiB, CTL_BYTES = 1 * MiB;
static_assert((size_t)ACT_ROWS * DFF * 2 <= 272 * MiB, "act/yb size");
static_assert(WS_ACAT + (size_t)S5G * S5M * S5ROW * 2 <= WS_X1, "acat");
constexpr int CW_BAR = 4096, CW_CNT = 8192  ;

constexpr int LDS_BYTES = 147456, MISC_OFF = LDS_BYTES - 256, TAB_OFF = 131072 + 1024;

__device__ __forceinline__ unsigned f2bf(float f) { unsigned u = __builtin_bit_cast(unsigned, f); return (u + 0x7fffu + ((u >> 16) & 1u)) >> 16; }
typedef __bf16 bf16x2v __attribute__((ext_vector_type(2)));
__device__ __forceinline__ unsigned pk2(float lo, float hi) { const f32x2 v = {lo, hi}; const bf16x2v b = __builtin_convertvector(v, bf16x2v); return __builtin_bit_cast(unsigned, b); }
__device__ __forceinline__ unsigned pk4_fp8(float a, float b, float c, float d) { a = __builtin_amdgcn_fmed3f(a, -448.f, 448.f); b = __builtin_amdgcn_fmed3f(b, -448.f, 448.f); c = __builtin_amdgcn_fmed3f(c, -448.f, 448.f); d = __builtin_amdgcn_fmed3f(d, -448.f, 448.f); int w = 0; w = __builtin_amdgcn_cvt_pk_fp8_f32(a, b, w, false); w = __builtin_amdgcn_cvt_pk_fp8_f32(c, d, w, true); return (unsigned)w; }
__device__ __forceinline__ float bflo(unsigned w) { return __builtin_bit_cast(float, w << 16); }
__device__ __forceinline__ float bfhi(unsigned w) { return __builtin_bit_cast(float, w & 0xffff0000u); }
__device__ __forceinline__ float bf1(bf16 h) { return __builtin_bit_cast(float, ((unsigned)h) << 16); }
__device__ __forceinline__ float fast_sigmoid(float x) { return __builtin_amdgcn_rcpf(1.0f + __builtin_amdgcn_exp2f(-1.4426950409f * x)); }
__device__ __forceinline__ float gelu_tanh(float x) { const float u = x + 0.044715f * x * x * x; return x * __builtin_amdgcn_rcpf(1.0f + __builtin_amdgcn_exp2f(-2.3022082f * u)); }
__device__ __forceinline__ float wave_sum(float v) {
#pragma unroll
    for (int o = 1; o < 64; o <<= 1) v += __shfl_xor(v, o);
    return v;
}
__device__ __forceinline__ u32x4 pack8(f32x4 a, f32x4 b) { u32x4 w; w.x = pk2(a[0], a[1]); w.y = pk2(a[2], a[3]); w.z = pk2(b[0], b[1]); w.w = pk2(b[2], b[3]); return w; }
__device__ __forceinline__ void unpack8(u32x4 w, f32x4& a, f32x4& b) { a = (f32x4){bflo(w.x), bfhi(w.x), bflo(w.y), bfhi(w.y)}; b = (f32x4){bflo(w.z), bfhi(w.z), bflo(w.w), bfhi(w.w)}; }

#define XB_TMO      128
#define XB_XCNT(j)  (256  + 64 * (j))
#define XB_XSUB(j)  (1280 + 64 * (j))
#define XB_XGEN(j)  (2304 + 64 * (j))
#define XB_TOP      3328
#define XB_TOPGEN   3392
#define XCD_BAR_WORDS 3456
#define XB_SPIN_CAP (1u << 18)
__device__ __forceinline__ unsigned xb_ld(unsigned* p)              { return __hip_atomic_load(p, __ATOMIC_RELAXED, __HIP_MEMORY_SCOPE_AGENT); }
__device__ __forceinline__ unsigned xb_add(unsigned* p, unsigned v) { return __hip_atomic_fetch_add(p, v, __ATOMIC_RELAXED, __HIP_MEMORY_SCOPE_AGENT); }
__device__ __forceinline__ unsigned xb_xcc_id() { return (unsigned)__builtin_amdgcn_s_getreg((3 << 11) | 20) & 0xFu; }
#define XB_SPIN(cond, bar) do { unsigned _sp = 0; while (cond) { __builtin_amdgcn_s_sleep(1); \
    if ((++_sp & 255u) == 0u) { if (xb_ld(&(bar)[XB_TMO])) break; if (_sp > XB_SPIN_CAP) { atomicAdd(&(bar)[XB_TMO], 1u); break; } } } } while (0)
struct XcdBarrier { unsigned* bar; unsigned x; volatile LAS unsigned* st; };
__device__ __forceinline__ XcdBarrier xcd_barrier_post(unsigned* bar, volatile LAS unsigned* st) {
    XcdBarrier b; b.bar = bar; b.x = xb_xcc_id(); b.st = st;
    if (threadIdx.x == 0) (void)xb_add(&bar[XB_XCNT(b.x)], 1u);
    return b;
}
__device__ __forceinline__ void xcd_barrier_complete(unsigned* bar, unsigned x, unsigned& nloc, unsigned& nx) {
    const unsigned G = gridDim.x * gridDim.y * gridDim.z;
    unsigned sum, cnt, mine, sp = 0u;
    for (;;) {
        sum = 0u; cnt = 0u; mine = 0u;
#pragma unroll
        for (unsigned j = 0; j < 16; ++j) { const unsigned c = xb_ld(&bar[XB_XCNT(j)]); sum += c; cnt += (c > 0u) ? 1u : 0u; mine = (j == x) ? c : mine; }
        if (sum == G) break;
        __builtin_amdgcn_s_sleep(1);
        if ((++sp & 255u) == 0u) { if (xb_ld(&bar[XB_TMO])) break; if (sp > XB_SPIN_CAP) { atomicAdd(&bar[XB_TMO], 1u); break; } }
    }
    nloc = mine > 0u ? mine : 1u; nx = cnt > 0u ? cnt : 1u;
}
__device__ __forceinline__ void xcd_barrier(const XcdBarrier& b) {
    asm volatile("s_waitcnt vmcnt(0)" ::: "memory");
    __syncthreads();
    if (threadIdx.x == 0) {
        unsigned* bar = b.bar;
        __builtin_amdgcn_s_waitcnt(0);
        unsigned nloc = b.st[0], nx = b.st[1];
        if (nloc == 0u) { xcd_barrier_complete(bar, b.x, nloc, nx); b.st[0] = nloc; b.st[1] = nx; }
        const unsigned old = xb_add(&bar[XB_XSUB(b.x)], 1u);
        const unsigned gen = old / nloc;
        if (old + 1u == (gen + 1u) * nloc) {
            __builtin_amdgcn_fence(__ATOMIC_RELEASE, "agent");
            asm volatile("s_waitcnt vmcnt(0)" ::: "memory");
            const unsigned og = xb_add(&bar[XB_TOP], 1u);
            const unsigned tg = og / nx;
            if (og + 1u == (tg + 1u) * nx) xb_add(&bar[XB_TOPGEN], 1u);
            else XB_SPIN(xb_ld(&bar[XB_TOPGEN]) == tg, bar);
            __builtin_amdgcn_fence(__ATOMIC_ACQUIRE, "agent");
            xb_add(&bar[XB_XGEN(b.x)], 1u);
            asm volatile("s_waitcnt vmcnt(0)" ::: "memory");
        } else {
            XB_SPIN(xb_ld(&bar[XB_XGEN(b.x)]) == gen, bar);
            __builtin_amdgcn_fence(__ATOMIC_ACQUIRE, "agent");
            asm volatile("s_waitcnt vmcnt(0)" ::: "memory");
        }
    }
    __syncthreads();
}

namespace g8 {
constexpr int BM = 256, BK = 64, HALF = 128, HTB = HALF * BK * 2, STAGE_BYTES = 8 * HTB;
__device__ __forceinline__ int lds_byte(int r, int c) { const int st = (r >> 4) * 2 + (c >> 5), rr = r & 15, cc = c & 31, ob = rr * 64 + cc * 2; return st * 1024 + (ob ^ (((ob >> 9) & 1) << 5)); }
__device__ __forceinline__ void stage_rc(int b, int& R, int& C) { const int st = b / 1024, sb = b % 1024, swz = sb ^ (((sb >> 9) & 1) << 5); R = (st >> 1) * 16 + swz / 64; C = (st & 1) * 32 + (swz % 64) / 2; }
__device__ __forceinline__ int perm32(int rho) { const int n = rho >> 4, i = rho & 15; return 8 * (i >> 2) + 4 * n + (i & 3); }

struct Unit { int pm, pn, z, rl; const char* A; const char* B; };

typedef int v8i __attribute__((ext_vector_type(8)));
typedef int v4i __attribute__((ext_vector_type(4)));
typedef short s16x16 __attribute__((ext_vector_type(16)));
typedef s16x16 s16x16_a16 __attribute__((aligned(16)));
__device__ __forceinline__ v8i cat8(bf16x8 lo, bf16x8 hi) { const v4i a = __builtin_bit_cast(v4i, lo), b = __builtin_bit_cast(v4i, hi); return __builtin_shufflevector(a, b, 0, 1, 2, 3, 4, 5, 6, 7); }
template <class Epi, class Sched, bool GATHER, bool FP8 = false>
__device__ __forceinline__ void gemm_phase(LAS unsigned char* lds, const int Kb, const int ldaB, const int ldbB, const Sched& S, const Epi& E) {
    const int tid = threadIdx.x, wid = __builtin_amdgcn_readfirstlane(tid >> 6), lane = tid & 63, wr = wid >> 2, wc = wid & 3, fr = lane & 15, fq = lane >> 4;
    const int nt = Kb / 128;
    unsigned voffB[2], cvo[2][2], nvo[2][2]; int Rr[2], Cc[2];
#pragma unroll
    for (int i = 0; i < 2; ++i) { int R, C; stage_rc(tid * 16 + i * 8192, R, C); const int Rb = (R & ~31) + perm32(R & 31);
        voffB[i] = (unsigned)(Rb * ldbB + C * 2); Rr[i] = R; Cc[i] = C;
#pragma unroll
        for (int h = 0; h < 2; ++h) { cvo[h][i] = (unsigned)((h * HALF + R) * ldaB + C * 2); nvo[h][i] = cvo[h][i]; } }
    const size_t kstep = (size_t)(BK * 2);
    const size_t hstepB = (size_t)HALF * ldbB;
    const unsigned ldsw = (unsigned)wid * 1024u;
    const int aoff = FP8 ? lds_byte(wr * 64 + fr, (fq >> 1) * 32 + (fq & 1) * 24) : lds_byte(wr * 64 + fr, fq * 8), boff = FP8 ? lds_byte(wc * 32 + fr, (fq >> 1) * 32 + (fq & 1) * 24) : lds_byte(wc * 32 + fr, fq * 8);
    const int aoff2 = FP8 ? lds_byte(wr * 64 + fr, (fq >> 1) * 32 + 8 + (fq & 1) * 8) : 0, boff2 = FP8 ? lds_byte(wc * 32 + fr, (fq >> 1) * 32 + 8 + (fq & 1) * 8) : 0;
#define G8_SA(b, h) (((b) * 2 + (h)) * HTB)
#define G8_SB(b, h) ((4 + (b) * 2 + (h)) * HTB)
#define G8_STGB(bufoff, gbase) do { _Pragma("unroll") for (int _i = 0; _i < 2; ++_i) \
        __builtin_amdgcn_global_load_lds((const unsigned*)((const char*)(gbase) + voffB[_i]), (LAS unsigned*)(lds + (bufoff) + ldsw + _i * 8192), 16, 0, 0); } while (0)
#define G8_STGA(bufoff, gbase, VO, h) do { _Pragma("unroll") for (int _i = 0; _i < 2; ++_i) \
        __builtin_amdgcn_global_load_lds((const unsigned*)((const char*)(gbase) + VO[h][_i]), (LAS unsigned*)(lds + (bufoff) + ldsw + _i * 8192), 16, 0, 0); } while (0)
#define G8_LDA(dst, b, h) do { _Pragma("unroll") for (int m = 0; m < 4; ++m) { if constexpr (FP8) { dst##8[m] = cat8(*(const LAS bf16x8*)(lds + G8_SA(b, h) + aoff + m * 2048), *(const LAS bf16x8*)(lds + G8_SA(b, h) + aoff2 + m * 2048)); } \
        else { _Pragma("unroll") for (int k = 0; k < 2; ++k) dst[m][k] = *(const LAS bf16x8*)(lds + G8_SA(b, h) + aoff + m * 2048 + k * 1024); } } } while (0)
#define G8_LDB(dst, b, h) do { _Pragma("unroll") for (int n = 0; n < 2; ++n) { if constexpr (FP8) { dst##8[n] = cat8(*(const LAS bf16x8*)(lds + G8_SB(b, h) + boff + n * 2048), *(const LAS bf16x8*)(lds + G8_SB(b, h) + boff2 + n * 2048)); } \
        else { _Pragma("unroll") for (int k = 0; k < 2; ++k) dst[n][k] = *(const LAS bf16x8*)(lds + G8_SB(b, h) + boff + n * 2048 + k * 1024); } } } while (0)
#define G8_MMA(ai, bj, At, Bt) do { __builtin_amdgcn_s_setprio(1); _Pragma("unroll") for (int m = 0; m < 4; ++m) _Pragma("unroll") for (int n = 0; n < 2; ++n) { \
        if constexpr (FP8) asm volatile("s_nop 1\n\tv_mfma_scale_f32_16x16x128_f8f6f4 %0, %1, %2, %0, %3, %4 op_sel_hi:[0,0,0]" : "+v"(acc[ai][bj][m][n]) : "v"(Bt##8[n]), "v"(At##8[m]), "v"(sc_w), "v"(sc_a)); \
        else { _Pragma("unroll") for (int k = 0; k < 2; ++k) acc[ai][bj][m][n] = __builtin_amdgcn_mfma_f32_16x16x32_bf16(Bt[n][k], At[m][k], acc[ai][bj][m][n], 0, 0, 0); } } __builtin_amdgcn_s_setprio(0); } while (0)
#define G8_WAIT_V(n) asm volatile("s_waitcnt vmcnt(" #n ")" ::: "memory")
#define G8_WAIT_L(n) asm volatile("s_waitcnt lgkmcnt(" #n ")" ::: "memory")
#define G8_BAR __builtin_amdgcn_s_barrier()
#define G8_SCHED __builtin_amdgcn_sched_barrier(0)
    Unit cur, nxt; int ui = 0;
    if (!S.next(0, cur)) return;
    bool has_next = S.next(1, nxt);
    if constexpr (GATHER) { S.gather(cur, Rr, Cc, cvo); if (has_next) S.gather(nxt, Rr, Cc, nvo); else {
#pragma unroll
        for (int h = 0; h < 2; ++h)
#pragma unroll
            for (int i = 0; i < 2; ++i) nvo[h][i] = cvo[h][i]; } }
    f32x4 acc[2][2][4][2];
#pragma unroll
    for (int a = 0; a < 2; ++a)
#pragma unroll
        for (int b = 0; b < 2; ++b)
#pragma unroll
            for (int m = 0; m < 4; ++m)
#pragma unroll
                for (int n = 0; n < 2; ++n) acc[a][b][m][n] = (f32x4){0.f, 0.f, 0.f, 0.f};
    const int sc_w = 0x7a7a7a7a, sc_a = 0x7f7f7f7f;
    bf16x8 At[4][2], B0[2][2], B1[2][2]; v8i At8[4], B08[2], B18[2];
    const char* cA = cur.A; const char* cB = cur.B;
    G8_STGB(G8_SB(0, 0), cB); G8_STGB(G8_SB(0, 1), cB + hstepB); G8_STGA(G8_SA(0, 0), cA, cvo, 0); G8_STGA(G8_SA(0, 1), cA, cvo, 1);
    if (wr == 1) G8_BAR;
    G8_WAIT_V(2); G8_BAR;
    G8_STGB(G8_SB(1, 0), cB + kstep); G8_STGA(G8_SA(1, 0), cA + kstep, cvo, 0); G8_STGB(G8_SB(1, 1), cB + hstepB + kstep);
    G8_WAIT_V(6); G8_BAR;
    for (;;) {
        const char* nA = has_next ? nxt.A : cA; const char* nB = has_next ? nxt.B : cB;
        for (int t = 0; t < nt; t += 2) {
            const bool last = (t == nt - 2);
            const char* a1 = cA + (size_t)(t + 1) * kstep;
            const char* a2 = last ? nA : cA + (size_t)(t + 2) * kstep; const char* b2 = last ? nB : cB + (size_t)(t + 2) * kstep;
            const char* a3 = a2 + kstep; const char* b3 = b2 + kstep;
            unsigned vo2[2][2];
#pragma unroll
            for (int h = 0; h < 2; ++h)
#pragma unroll
                for (int i = 0; i < 2; ++i) vo2[h][i] = (GATHER && last) ? nvo[h][i] : cvo[h][i];
            G8_LDB(B0, 0, 0); G8_LDB(B1, 0, 1); G8_SCHED; G8_LDA(At, 0, 0); G8_STGA(G8_SA(1, 1), a1, cvo, 1);
            G8_WAIT_V(8); G8_WAIT_L(0); G8_BAR; G8_SCHED; G8_MMA(0, 0, At, B0); G8_MMA(0, 1, At, B1); G8_SCHED; G8_BAR; G8_SCHED;
            G8_LDA(At, 0, 1); G8_STGB(G8_SB(0, 0), b2); G8_STGB(G8_SB(0, 1), b2 + hstepB); G8_STGA(G8_SA(0, 0), a2, vo2, 0);
            G8_WAIT_V(8); G8_WAIT_L(0); G8_BAR; G8_SCHED; G8_MMA(1, 0, At, B0); G8_MMA(1, 1, At, B1); G8_SCHED; G8_BAR; G8_SCHED;
            G8_LDB(B0, 1, 0); G8_LDB(B1, 1, 1); G8_SCHED; G8_LDA(At, 1, 0); G8_STGA(G8_SA(0, 1), a2, vo2, 1);
            G8_WAIT_V(8); G8_WAIT_L(0); G8_BAR; G8_SCHED; G8_MMA(0, 0, At, B0); G8_MMA(0, 1, At, B1); G8_SCHED; G8_BAR; G8_SCHED;
            G8_LDA(At, 1, 1); G8_STGB(G8_SB(1, 0), b3); G8_STGB(G8_SB(1, 1), b3 + hstepB); G8_STGA(G8_SA(1, 0), a3, vo2, 0);
            G8_WAIT_V(8); G8_WAIT_L(0); G8_BAR; G8_SCHED; G8_MMA(1, 0, At, B0); G8_MMA(1, 1, At, B1); G8_SCHED; G8_BAR; G8_SCHED;
        }
        f32x4 bpre[4]; E.pre(cur, wr, wc, fr, fq, bpre);
        if (wr == 0) G8_BAR;
        Unit nn; bool has_nn = false;
        if (has_next) has_nn = S.next(ui + 2, nn);
        unsigned nnvo[2][2];
        if constexpr (GATHER) { if (has_nn) S.gather(nn, Rr, Cc, nnvo); }
        if constexpr (FP8) asm volatile("s_nop 15\n\ts_nop 15" ::: "memory");
        E(acc, cur, wr, wc, fr, fq, bpre);
        if (!has_next) break;
#pragma unroll
        for (int a = 0; a < 2; ++a)
#pragma unroll
            for (int b = 0; b < 2; ++b)
#pragma unroll
                for (int m = 0; m < 4; ++m)
#pragma unroll
                    for (int n = 0; n < 2; ++n) acc[a][b][m][n] = (f32x4){0.f, 0.f, 0.f, 0.f};
        cur = nxt; cA = nA; cB = nB; ++ui;
        if constexpr (GATHER) {
#pragma unroll
            for (int h = 0; h < 2; ++h)
#pragma unroll
                for (int i = 0; i < 2; ++i) { cvo[h][i] = nvo[h][i]; if (has_nn) nvo[h][i] = nnvo[h][i]; } }
        nxt = nn; has_next = has_nn;
        if (wr == 1) G8_BAR;
    }
    G8_WAIT_V(0);
    G8_BAR;
#undef G8_SA
#undef G8_SB
#undef G8_STGB
#undef G8_STGA
#undef G8_LDA
#undef G8_LDB
#undef G8_MMA
#undef G8_WAIT_V
#undef G8_WAIT_L
#undef G8_BAR
#undef G8_SCHED
}

struct GridOrder {
    int nM, nN, nwg, G, c; const char* A; const char* B; size_t tstepA, tstepB;
    __device__ __forceinline__ void init(int M, int N, int G_, int c_, const void* A_, const void* B_, int ldaB, int ldbB) { nM = M / BM; nN = N / BM; nwg = nM * nN; G = G_; c = c_; A = (const char*)A_; B = (const char*)B_; tstepA = (size_t)BM * ldaB; tstepB = (size_t)BM * ldbB; }
    __device__ __forceinline__ bool next(int i, Unit& u) const {
        const long L = (long)i * G + c; if (L >= nwg) return false;
        int wgid = (int)L; { const int q = nwg / 8, r = nwg % 8, xcd = wgid % 8, off = wgid / 8; wgid = (xcd < r ? xcd * (q + 1) : r * (q + 1) + (xcd - r) * q) + off; }
        const int nig = 8 * nN, gid = wgid / nig, fm = gid * 8, gsz = (nM - fm) < 8 ? (nM - fm) : 8;
        u.pm = fm + ((wgid % nig) % gsz); u.pn = (wgid % nig) / gsz; u.z = 0; u.rl = 0;
        u.A = A + (size_t)u.pm * tstepA; u.B = B + (size_t)u.pn * tstepB; return true;
    }
};
}

struct Frame {
    LAS unsigned char* lds; volatile LAS unsigned* MISC; unsigned* ctl;
    int tid, lane, wave, vcu, G;
    const float* in[34]; float* out; unsigned char* ws;
};
#define WSP(T_, off) ((T_*)(F.ws + (off)))

struct EpiInProj { static constexpr int NST = 16;
    __device__ __forceinline__ void pre(const g8::Unit& u, int, int wc, int, int fq, f32x4 (&bp)[4]) const { const int colb = u.pn * 256 + wc * 32 + 8 * fq;
#pragma unroll
        for (int bj = 0; bj < 2; ++bj)
#pragma unroll
            for (int n = 0; n < 2; ++n) bp[bj * 2 + n] = *(const f32x4*)(bias + colb + bj * 128 + 4 * n); }
    const float* bias; bf16 *xrnn, *gy, *acat, *gates;
    template <int KIND>
    __device__ __forceinline__ void run(const f32x4 (&acc)[2][2][4][2], const g8::Unit& u, int wr, int wc, int fr, int fq, const f32x4 (&bpre)[4]) const {
        const int colb = u.pn * 256 + wc * 32 + 8 * fq;
#pragma unroll
        for (int ai = 0; ai < 2; ++ai)
#pragma unroll
            for (int m = 0; m < 4; ++m) { const int t = u.pm * 256 + ai * 128 + wr * 64 + m * 16 + fr;
#pragma unroll
                for (int bj = 0; bj < 2; ++bj) { f32x4 v0 = acc[ai][bj][m][0] + bpre[bj * 2], v1 = acc[ai][bj][m][1] + bpre[bj * 2 + 1]; const int col = colb + bj * 128;
                    if (KIND == 0) { *(u32x4*)(xrnn + (size_t)t * 1024 + col) = pack8(v0, v1); }
                    else if (KIND == 1) {
#pragma unroll
                        for (int j = 0; j < 4; ++j) { v0[j] = gelu_tanh(v0[j]); v1[j] = gelu_tanh(v1[j]); }
                        *(u32x4*)(gy + (size_t)t * 1024 + (col - 1024)) = pack8(v0, v1); }
                    else if (KIND == 2) { const int cu = col - 2048, g = cu >> 4, c = cu & 15;
                        *(u32x4*)(acat + ((size_t)(g * S5M + (t >> 5)) * S5ROW + 128 + (t & 31) * 16 + c)) = pack8(v0, v1); }
                    else {
#pragma unroll
                        for (int j = 0; j < 4; ++j) { v0[j] = fast_sigmoid(v0[j]); v1[j] = fast_sigmoid(v1[j]); }
                        *(u32x4*)(gates + (size_t)t * 2048 + (col - 2560)) = pack8(v0, v1); } } }
    }
    __device__ __forceinline__ void operator()(const f32x4 (&acc)[2][2][4][2], const g8::Unit& u, int wr, int wc, int fr, int fq, const f32x4 (&bpre)[4]) const {
        const int pn = u.pn;
        if (pn < 4) run<0>(acc, u, wr, wc, fr, fq, bpre); else if (pn < 8) run<1>(acc, u, wr, wc, fr, fq, bpre); else if (pn < 10) run<2>(acc, u, wr, wc, fr, fq, bpre); else run<3>(acc, u, wr, wc, fr, fq, bpre);
    }
};
struct EpiS5A {
    __device__ __forceinline__ void pre(const g8::Unit&, int, int, int, int, f32x4 (&)[4]) const {}
    float* S;
    __device__ __forceinline__ void operator()(const f32x4 (&acc)[2][2][4][2], const g8::Unit& u, int wr, int wc, int fr, int fq, const f32x4 (&bpre)[4]) const {
        const int col = wc * 32 + 8 * fq;
#pragma unroll
        for (int ai = 0; ai < 2; ++ai)
#pragma unroll
            for (int m = 0; m < 4; ++m) { const int row = u.pm * 256 + ai * 128 + wr * 64 + m * 16 + fr; float* p = S + ((size_t)(u.z * S5M + row)) * 128 + col;
                *(f32x4*)p = acc[ai][0][m][0]; *(f32x4*)(p + 4) = acc[ai][0][m][1]; }
    }
};
struct EpiS5C {
    __device__ __forceinline__ void pre(const g8::Unit&, int, int, int, int, f32x4 (&)[4]) const {}
    bf16* ys;
    __device__ __forceinline__ void operator()(const f32x4 (&acc)[2][2][4][2], const g8::Unit& u, int wr, int wc, int fr, int fq, const f32x4 (&bpre)[4]) const {
#pragma unroll
        for (int ai = 0; ai < 2; ++ai)
#pragma unroll
            for (int m = 0; m < 4; ++m) { const int row = u.pm * 256 + ai * 128 + wr * 64 + m * 16 + fr;
#pragma unroll
                for (int bj = 0; bj < 2; ++bj) { const int n = u.pn * 256 + bj * 128 + wc * 32 + 8 * fq, i = n >> 4, c = n & 15; f32x4 v0 = acc[ai][bj][m][0], v1 = acc[ai][bj][m][1];
#pragma unroll
                    for (int j = 0; j < 4; ++j) { v0[j] = gelu_tanh(v0[j]); v1[j] = gelu_tanh(v1[j]); }
                    u32x2 w8; w8.x = pk4_fp8(v0[0], v0[1], v0[2], v0[3]); w8.y = pk4_fp8(v1[0], v1[1], v1[2], v1[3]); *(u32x2*)((unsigned char*)ys + (size_t)(row * 32 + i) * 512 + u.z * 16 + c) = w8; } }
    }
};
struct EpiGlu { static constexpr int NST = 8;
    __device__ __forceinline__ void pre(const g8::Unit&, int, int, int, int, f32x4 (&)[4]) const {}
    const bf16* gates; bf16* gb;
    __device__ __forceinline__ void operator()(const f32x4 (&acc)[2][2][4][2], const g8::Unit& u, int wr, int wc, int fr, int fq, const f32x4 (&bpre)[4]) const {
        const int f = u.pn * 128 + wc * 32 + 8 * fq;
#pragma unroll
        for (int ai = 0; ai < 2; ++ai) { u32x4 gw[4];
#pragma unroll
            for (int m = 0; m < 4; ++m) { const int t = u.pm * 256 + ai * 128 + wr * 64 + m * 16 + fr; gw[m] = *(const u32x4*)(gates + (size_t)t * 2048 + 1024 + f); }
#pragma unroll
            for (int m = 0; m < 4; ++m) { const int t = u.pm * 256 + ai * 128 + wr * 64 + m * 16 + fr;
                f32x4 g0, g1; unpack8(gw[m], g0, g1);
                f32x4 v0 = acc[ai][0][m][0], v1 = acc[ai][0][m][1]; const f32x4 s0 = acc[ai][1][m][0], s1 = acc[ai][1][m][1];
#pragma unroll
                for (int j = 0; j < 4; ++j) { v0[j] = g0[j] * v0[j] * fast_sigmoid(s0[j]); v1[j] = g1[j] * v1[j] * fast_sigmoid(s1[j]); }
                *(u32x4*)(gb + (size_t)t * 1024 + f) = pack8(v0, v1); } }
    }
};
struct EpiRnn { static constexpr int NST = 16;
    __device__ __forceinline__ void pre(const g8::Unit&, int, int, int, int, f32x4 (&)[4]) const {}
    const bf16* gates; const bf16* gb; bf16* merged;
    __device__ __forceinline__ void operator()(const f32x4 (&acc)[2][2][4][2], const g8::Unit& u, int wr, int wc, int fr, int fq, const f32x4 (&bpre)[4]) const {
#pragma unroll
        for (int ai = 0; ai < 2; ++ai)
#pragma unroll
            for (int mh = 0; mh < 2; ++mh) { u32x4 gw[2][2], bw[2][2];
#pragma unroll
                for (int mm = 0; mm < 2; ++mm) { const int t = u.pm * 256 + ai * 128 + wr * 64 + (2 * mh + mm) * 16 + fr;
#pragma unroll
                    for (int bj = 0; bj < 2; ++bj) { const int col = u.pn * 256 + bj * 128 + wc * 32 + 8 * fq; gw[mm][bj] = *(const u32x4*)(gates + (size_t)t * 2048 + col); bw[mm][bj] = *(const u32x4*)(gb + (size_t)t * 1024 + col); } }
#pragma unroll
                for (int mm = 0; mm < 2; ++mm) { const int m = 2 * mh + mm, t = u.pm * 256 + ai * 128 + wr * 64 + m * 16 + fr;
#pragma unroll
                    for (int bj = 0; bj < 2; ++bj) { const int col = u.pn * 256 + bj * 128 + wc * 32 + 8 * fq;
                        f32x4 g0, g1, b0, b1; unpack8(gw[mm][bj], g0, g1); unpack8(bw[mm][bj], b0, b1);
                        const f32x4 v0 = g0 * acc[ai][bj][m][0] + b0, v1 = g1 * acc[ai][bj][m][1] + b1;
                        u32x2 w8; w8.x = pk4_fp8(v0[0], v0[1], v0[2], v0[3]); w8.y = pk4_fp8(v1[0], v1[1], v1[2], v1[3]); *(u32x2*)((unsigned char*)merged + (size_t)t * 1024 + col) = w8; } } }
    }
};
struct EpiOut { static constexpr int NST = 16;
    const float* x; const float* mod; bf16* v1;
    __device__ __forceinline__ void pre(const g8::Unit& u, int, int wc, int, int fq, f32x4 (&bp)[4]) const { const int b = (u.pm * 256) >> 12; const float* p = mod + b * 6144 + 2048 + u.pn * 256 + wc * 32 + 8 * fq;
        bp[0] = *(const f32x4*)p; bp[1] = *(const f32x4*)(p + 4); bp[2] = *(const f32x4*)(p + 128); bp[3] = *(const f32x4*)(p + 132); }
    __device__ __forceinline__ void operator()(const f32x4 (&acc)[2][2][4][2], const g8::Unit& u, int wr, int wc, int fr, int fq, const f32x4 (&bpre)[4]) const {
#pragma unroll
        for (int ai = 0; ai < 2; ++ai)
#pragma unroll
            for (int mh = 0; mh < 2; ++mh) { f32x4 xv[2][2][2];
#pragma unroll
                for (int mm = 0; mm < 2; ++mm) { const int t = u.pm * 256 + ai * 128 + wr * 64 + (2 * mh + mm) * 16 + fr;
#pragma unroll
                    for (int bj = 0; bj < 2; ++bj) { const int col = u.pn * 256 + bj * 128 + wc * 32 + 8 * fq; xv[mm][bj][0] = *(const f32x4*)(x + (size_t)t * 1024 + col); xv[mm][bj][1] = *(const f32x4*)(x + (size_t)t * 1024 + col + 4); } }
#pragma unroll
                for (int mm = 0; mm < 2; ++mm) { const int m = 2 * mh + mm, t = u.pm * 256 + ai * 128 + wr * 64 + m * 16 + fr;
#pragma unroll
                    for (int bj = 0; bj < 2; ++bj) { const int col = u.pn * 256 + bj * 128 + wc * 32 + 8 * fq;
                        const f32x4 v0 = xv[mm][bj][0] * DN_ALPHA + (bpre[2 * bj] + 1.0f) * acc[ai][bj][m][0], v1_ = xv[mm][bj][1] * DN_ALPHA + (bpre[2 * bj + 1] + 1.0f) * acc[ai][bj][m][1];
                        *(u32x4*)(v1 + (size_t)t * 1024 + col) = pack8(v0, v1_); } } }
    }
};
struct EpiMoe1 {
    __device__ __forceinline__ void pre(const g8::Unit& u, int, int wc, int, int fq, f32x4 (&bp)[4]) const { const float* p = bgu + (size_t)u.z * 2048 + u.pn * 128 + wc * 32 + 8 * fq; bp[0] = *(const f32x4*)p; bp[1] = *(const f32x4*)(p + 4); bp[2] = *(const f32x4*)(p + 1024); bp[3] = *(const f32x4*)(p + 1028); }
    const float* bgu; bf16* act;
    __device__ __forceinline__ void operator()(const f32x4 (&acc)[2][2][4][2], const g8::Unit& u, int wr, int wc, int fr, int fq, const f32x4 (&bpre)[4]) const {
        const int f = u.pn * 128 + wc * 32 + 8 * fq; const float* bp = bgu + (size_t)u.z * 2048 + f;
        (void)bp; const f32x4 bg0 = bpre[0], bg1 = bpre[1], bu0 = bpre[2], bu1 = bpre[3];
#pragma unroll
        for (int ai = 0; ai < 2; ++ai)
#pragma unroll
            for (int m = 0; m < 4; ++m) { const int row = u.pm * 256 + ai * 128 + wr * 64 + m * 16 + fr;
                f32x4 g0 = acc[ai][0][m][0] + bg0, g1 = acc[ai][0][m][1] + bg1, u0 = acc[ai][1][m][0] + bu0, u1 = acc[ai][1][m][1] + bu1;
#pragma unroll
                for (int j = 0; j < 4; ++j) { const float ga = fminf(g0[j], 7.0f), gb_ = fminf(g1[j], 7.0f), ua = fminf(fmaxf(u0[j], -7.0f), 7.0f), ub = fminf(fmaxf(u1[j], -7.0f), 7.0f);
                    g0[j] = ga * fast_sigmoid(1.702f * ga) * (ua + 1.0f); g1[j] = gb_ * fast_sigmoid(1.702f * gb_) * (ub + 1.0f); }
                u32x2 w8; w8.x = pk4_fp8(g0[0], g0[1], g0[2], g0[3]); w8.y = pk4_fp8(g1[0], g1[1], g1[2], g1[3]); *(u32x2*)((unsigned char*)act + (size_t)row * 1024 + f) = w8; }
    }
};
struct EpiMoe2 {
    __device__ __forceinline__ void pre(const g8::Unit& u, int, int wc, int, int fq, f32x4 (&bp)[4]) const { const float* p = bd + (size_t)u.z * 1024 + u.pn * 256 + wc * 32 + 8 * fq; bp[0] = *(const f32x4*)p; bp[1] = *(const f32x4*)(p + 4); bp[2] = *(const f32x4*)(p + 128); bp[3] = *(const f32x4*)(p + 132); }
    const float* bd; bf16* yb;
    __device__ __forceinline__ void operator()(const f32x4 (&acc)[2][2][4][2], const g8::Unit& u, int wr, int wc, int fr, int fq, const f32x4 (&bpre)[4]) const {
#pragma unroll
        for (int bj = 0; bj < 2; ++bj) { const int col = u.pn * 256 + bj * 128 + wc * 32 + 8 * fq; const float* bp = bd + (size_t)u.z * 1024 + col;
            (void)bp; const f32x4 b0 = bpre[bj * 2], b1 = bpre[bj * 2 + 1];
#pragma unroll
            for (int ai = 0; ai < 2; ++ai)
#pragma unroll
                for (int m = 0; m < 4; ++m) { const int row = u.pm * 256 + ai * 128 + wr * 64 + m * 16 + fr;
                    const f32x4 y0 = acc[ai][bj][m][0] + b0, y1 = acc[ai][bj][m][1] + b1; u32x2 w8; w8.x = pk4_fp8(y0[0], y0[1], y0[2], y0[3]); w8.y = pk4_fp8(y1[0], y1[1], y1[2], y1[3]);
                    *(u32x2*)((unsigned char*)yb + (size_t)row * 1024 + col) = w8; } }
    }
};

struct S5AOrder { int G, c; const char* acat; const char* ws;
    __device__ __forceinline__ bool next(int i, g8::Unit& u) const { const int L = i * G + c; if (L >= S5G * 4) return false; u.z = L >> 2; u.pm = L & 3; u.pn = 0; u.rl = 0;
        u.A = acat + ((size_t)(u.z * S5M + u.pm * 256) * S5ROW + 128) * 2; u.B = ws + (size_t)u.z * 256 * (S5L * 16) * 2; return true; } };
struct S5COrder { int G, c; const char* acat; const char* wy;
    __device__ __forceinline__ bool next(int i, g8::Unit& u) const { const int L = i * G + c; if (L >= S5G * 8) return false; u.z = L >> 3; u.pm = (L >> 1) & 3; u.pn = L & 1; u.rl = 0;
        u.A = acat + ((size_t)(u.z * S5M + u.pm * 256) * S5ROW) * 2; u.B = wy + ((size_t)(u.z * 512 + u.pn * 256) * S5ROW) * 2; return true; } };
struct MoeOrder { int G, c, NT, RT; const LAS int* tstart; const LAS int* cnt; const int* toklist; const char* A; const char* B; size_t bstride_e; int lda; bool gatherA;
    __device__ __forceinline__ bool next(int i, g8::Unit& u) const { const int per = G >> 3, xcd = c & 7, slot = c >> 3, rpx = per / NT;
        const int rt = (i * 8 + xcd) * rpx + slot / NT; if (rt >= RT) return false; u.pn = slot % NT;
        const int lane_ = threadIdx.x & 63; const unsigned long long mk_ = __ballot(lane_ < NE && tstart[lane_ & 31] <= rt);
        const int e = __builtin_popcountll(mk_) - 1;
        u.z = e; u.pm = rt; u.rl = rt - tstart[e]; u.B = B + (size_t)e * bstride_e + (size_t)u.pn * 256 * 1024; u.A = gatherA ? A : A + (size_t)rt * 256 * 1024; return true; }
    __device__ __forceinline__ void gather(const g8::Unit& u, const int (&Rr)[2], const int (&Cc)[2], unsigned (&vo)[2][2]) const {
        const int n = cnt[u.z];
#pragma unroll
        for (int h = 0; h < 2; ++h)
#pragma unroll
            for (int i = 0; i < 2; ++i) { const int r = u.rl * 256 + h * 128 + Rr[i]; const int rc = r < n ? r : n - 1; const int tok = toklist[u.z * T + rc]; vo[h][i] = (unsigned)(tok * lda + Cc[i] * 2); } }
};

__device__ __forceinline__ void transpose_item(const float* W, int N, int k0, int n0, bf16* dst, int ldd, int drow0, LAS float* scr, int lane) {
    float wv_[32];
#pragma unroll
    for (int i = 0; i < 32; ++i) wv_[i] = W[(size_t)(k0 + 2 * i + (lane >> 5)) * N + n0 + (lane & 31)];
#pragma unroll
    for (int i = 0; i < 32; ++i) scr[(2 * i + (lane >> 5)) * 33 + (lane & 31)] = wv_[i];
    asm volatile("s_waitcnt lgkmcnt(0)" ::: "memory");
    const int c = lane & 7;
#pragma unroll
    for (int j = 0; j < 4; ++j) { const int n = (lane >> 3) + 8 * j; const LAS float* s = scr + (8 * c) * 33 + n;
        u32x4 o; o.x = pk2(s[0 * 33], s[1 * 33]); o.y = pk2(s[2 * 33], s[3 * 33]); o.z = pk2(s[4 * 33], s[5 * 33]); o.w = pk2(s[6 * 33], s[7 * 33]);
        *(u32x4*)(dst + (size_t)(drow0 + n) * ldd + k0 + 8 * c) = o; }
    asm volatile("s_waitcnt lgkmcnt(0)" ::: "memory");
}
__device__ __forceinline__ void transpose_item8(const float* W, int N, int k0, int n0, unsigned char* dst, int ldd, int drow0, LAS float* scr, int lane) {
    float wv_[32];
#pragma unroll
    for (int i = 0; i < 32; ++i) wv_[i] = W[(size_t)(k0 + 2 * i + (lane >> 5)) * N + n0 + (lane & 31)];
#pragma unroll
    for (int i = 0; i < 32; ++i) scr[(2 * i + (lane >> 5)) * 33 + (lane & 31)] = wv_[i];
    asm volatile("s_waitcnt lgkmcnt(0)" ::: "memory");
    const int c = lane & 7;
#pragma unroll
    for (int j = 0; j < 4; ++j) { const int n = (lane >> 3) + 8 * j; const LAS float* s = scr + (8 * c) * 33 + n;
        u32x2 o; o.x = pk4_fp8(32.f * s[0 * 33], 32.f * s[1 * 33], 32.f * s[2 * 33], 32.f * s[3 * 33]); o.y = pk4_fp8(32.f * s[4 * 33], 32.f * s[5 * 33], 32.f * s[6 * 33], 32.f * s[7 * 33]);
        *(u32x2*)(dst + (size_t)(drow0 + n) * ldd + k0 + 8 * c) = o; }
    asm volatile("s_waitcnt lgkmcnt(0)" ::: "memory");
}
__device__ __forceinline__ void transpose_item8w(const float* W, int N, int k0, int n0, unsigned char* dst, int ldd, int drow0, LAS float* scr, int lane) {
    float wv[64]; const float* wp = W + (size_t)(k0 + (lane >> 5)) * N + n0 + (lane & 31);
#pragma unroll
    for (int i = 0; i < 64; ++i) wv[i] = wp[(size_t)(2 * i) * N];
#pragma unroll
    for (int i = 0; i < 64; ++i) scr[(2 * i + (lane >> 5)) * 33 + (lane & 31)] = wv[i];
    asm volatile("s_waitcnt lgkmcnt(0)" ::: "memory");
    const int c = lane & 7;
#pragma unroll
    for (int j = 0; j < 4; ++j) { const int n = (lane >> 3) + 8 * j; const LAS float* s = scr + (16 * c) * 33 + n;
        u32x4 o; o.x = pk4_fp8(32.f * s[0 * 33], 32.f * s[1 * 33], 32.f * s[2 * 33], 32.f * s[3 * 33]); o.y = pk4_fp8(32.f * s[4 * 33], 32.f * s[5 * 33], 32.f * s[6 * 33], 32.f * s[7 * 33]);
        o.z = pk4_fp8(32.f * s[8 * 33], 32.f * s[9 * 33], 32.f * s[10 * 33], 32.f * s[11 * 33]); o.w = pk4_fp8(32.f * s[12 * 33], 32.f * s[13 * 33], 32.f * s[14 * 33], 32.f * s[15 * 33]);
        *(u32x4*)(dst + (size_t)(drow0 + n) * ldd + k0 + 16 * c) = o; }
    asm volatile("s_waitcnt lgkmcnt(0)" ::: "memory");
}
__device__ __forceinline__ int pair_row(int n) { const int f = n & 1023, hi = n >> 10; return (f >> 7) * 256 + hi * 128 + (f & 127); }

__device__ __forceinline__ void moe_tables(Frame& F) {
    LAS int* tstart = (LAS int*)(F.lds + TAB_OFF); LAS int* cl = tstart + 40;
    if (F.tid < 64) {
        const int e = F.lane & 31; const int c = (int)F.ctl[CW_CNT + 64 * e]; int inc = (c + 255) >> 8;
#pragma unroll
        for (int o = 1; o < 32; o <<= 1) { const int v = __shfl_up(inc, o); if ((F.lane & 31) >= o) inc += v; }
        if (F.lane < 32) { cl[e] = c; tstart[e] = inc - ((c + 255) >> 8); if (e == NE - 1) tstart[NE] = inc; }
    }
    __syncthreads();
}

__device__ __forceinline__ void p0_mod_job(Frame& F, int job) {
    LAS float* sc = (LAS float*)F.lds;
    LAS float* red = sc + 8 * 1024;
    const float* c = F.in[1]; const float* w = F.in[2]; const float* bias = F.in[3];
    for (int i = F.tid; i < 8 * 1024; i += 512) { const float v = c[i]; sc[i] = v * fast_sigmoid(v); }
    __syncthreads();
    const int col = F.tid & 31, kg = F.tid >> 5, j = job * 32 + col;
    float a[8];
#pragma unroll
    for (int b = 0; b < 8; ++b) a[b] = 0.f;
#pragma unroll 32
    for (int k = kg * 64; k < kg * 64 + 64; ++k) { const float wv = w[(size_t)k * 6144 + j];
#pragma unroll
        for (int b = 0; b < 8; ++b) a[b] += sc[b * 1024 + k] * wv; }
#pragma unroll
    for (int b = 0; b < 8; ++b) red[(kg * 8 + b) * 32 + col] = a[b];
    __syncthreads();
    if (F.tid < 256) { const int b = F.tid >> 5, cc = F.tid & 31; float s = 0.f;
#pragma unroll
        for (int g = 0; g < 16; ++g) s += red[(g * 8 + b) * 32 + cc];
        WSP(float, WS_MOD)[b * 6144 + job * 32 + cc] = s + bias[job * 32 + cc]; }
    __syncthreads();
}
__device__ __forceinline__ void s5_setup(Frame& F, int g, int kmin, int kmax, LAS f32x2* Bb, LAS f32x2* Cc, LAS f32x2* Ap) {
    const float* lre = F.in[14] + g * 64; const float* lim = F.in[15] + g * 64; const float dt = expf(F.in[16][g]);
    const float* bre = F.in[17] + g * 1024; const float* bim = F.in[18] + g * 1024; const float* cre = F.in[19] + g * 1024; const float* cim = F.in[20] + g * 1024;
    for (int i = F.tid; i < 1024; i += 512) { const int p = i >> 4; const float lr = lre[p], li = lim[p]; const float mag = expf(lr * dt); float sn, cs; sincosf(li * dt, &sn, &cs);
        const float ar = mag * cs, ai = mag * sn, den = lr * lr + li * li, qr = ((ar - 1.f) * lr + ai * li) / den, qi = (ai * lr - (ar - 1.f) * li) / den;
        const float br = bre[i], bi = bim[i]; Bb[i] = (f32x2){qr * br - qi * bi, qr * bi + qi * br};
        Cc[i] = (f32x2){cre[i], cim[i]}; }
    if (F.tid < 64) { const int p = F.tid; const float lr = lre[p], li = lim[p]; const float mag = expf(lr * dt); float sn, cs; sincosf(li * dt, &sn, &cs);
        const float ar = mag * cs, ai = mag * sn; float xr_ = 1.f, xi_ = 0.f;
        for (int k = 0; k <= kmax; ++k) { if (k >= kmin) Ap[k * 64 + p] = (f32x2){xr_, xi_}; const float nr = xr_ * ar - xi_ * ai, ni = xr_ * ai + xi_ * ar; xr_ = nr; xi_ = ni; } }
    __syncthreads();
}
constexpr size_t WS_KTAB = WS_S;
constexpr size_t WS_WRIMG = WS_AL + 512 * 1024;
__device__ __forceinline__ void p0_s5k_job(Frame& F, int job) {
    const int g = job >> 3, part = job & 7;
    LAS f32x2* Bb = (LAS f32x2*)F.lds; LAS f32x2* Cc = Bb + 1024; LAS f32x2* Ap = Cc + 1024;
    s5_setup(F, g, 4 * part, 4 * part + 3, Bb, Cc, Ap);
    float* kt = WSP(float, WS_KTAB) + (size_t)g * 32 * 256;
    for (int e = 4 * part * 256 + F.tid; e < (4 * part + 4) * 256; e += 512) { const int k = e >> 8, c = (e >> 4) & 15, c2 = e & 15; float s = 0.f;
        for (int p = 0; p < 64; ++p) { const f32x2 cv = Cc[c * 64 + p], av = Ap[k * 64 + p], bv = Bb[p * 16 + c2];
            const float car = cv.x * av.x - cv.y * av.y, cai = cv.x * av.y + cv.y * av.x; s += car * bv.x - cai * bv.y; }
        kt[e] = s; }
    __syncthreads();
}
__device__ __forceinline__ void p1_s5w_job(Frame& F, int job) {
    const int g = job >> 3, part = job & 7;
    LAS f32x2* Bb = (LAS f32x2*)F.lds; LAS f32x2* Cc = Bb + 1024; LAS f32x2* Ap = Cc + 1024; LAS float* Kt = (LAS float*)(Ap + 33 * 64);
    const float* ktg = WSP(float, WS_KTAB) + (size_t)g * 32 * 256; const float* dsk = F.in[21] + g * 16;
    for (int i = F.tid; i < 32 * 256; i += 512) Kt[i] = ktg[i];
    s5_setup(F, g, 0, S5L, Bb, Cc, Ap);
    if (part == 0 && F.tid < 64) WSP(f32x2, WS_AL)[g * 64 + F.tid] = Ap[S5L * 64 + F.tid];
    bf16* wy = WSP(bf16, WS_WY) + (size_t)g * 512 * S5ROW;
    for (int ch = F.tid; ch < 64 * (S5ROW / 8); ch += 512) { const int n = part * 64 + ch / (S5ROW / 8), k8 = (ch % (S5ROW / 8)) * 8, i = n >> 4, c = n & 15; float v[8]; const float dskc = dsk[c];
        if (k8 < 128) {
#pragma unroll
            for (int j = 0; j < 8; j += 2) { const int p = (k8 + j) >> 1; const f32x2 cv = Cc[c * 64 + p], av = Ap[(i + 1) * 64 + p]; v[j] = cv.x * av.x - cv.y * av.y; v[j + 1] = -(cv.x * av.y + cv.y * av.x); } }
        else { const int jj = (k8 - 128) >> 4, c2 = (k8 - 128) & 15;
#pragma unroll
            for (int j = 0; j < 8; ++j) { float x = 0.f; if (jj <= i) { x = Kt[(i - jj) * 256 + c * 16 + c2 + j]; x += (jj == i && c == c2 + j) ? dskc : 0.f; } v[j] = x; } }
        u32x4 o; o.x = pk2(v[0], v[1]); o.y = pk2(v[2], v[3]); o.z = pk2(v[4], v[5]); o.w = pk2(v[6], v[7]);
        *(u32x4*)(wy + (size_t)n * S5ROW + k8) = o; }
    bf16* wsm = WSP(bf16, WS_WS) + (size_t)g * 256 * 512;
    for (int ch = F.tid; ch < 32 * 64; ch += 512) { const int n = part * 32 + (ch >> 6), k8 = (ch & 63) * 8, jj = k8 >> 4, c2 = k8 & 15; float v[8];
#pragma unroll
        for (int j = 0; j < 8; ++j) { float x = 0.f; if (n < 128) { const int p = n >> 1; const f32x2 av = Ap[(S5L - 1 - jj) * 64 + p], bv = Bb[p * 16 + c2 + j]; x = (n & 1) ? (av.x * bv.y + av.y * bv.x) : (av.x * bv.x - av.y * bv.y); } v[j] = x; }
        u32x4 o; o.x = pk2(v[0], v[1]); o.y = pk2(v[2], v[3]); o.z = pk2(v[4], v[5]); o.w = pk2(v[6], v[7]);
        *(u32x4*)(wsm + (size_t)n * 512 + k8) = o; }
    __syncthreads();
}
__device__ __forceinline__ void p0_small_transposes(Frame& F) {
    LAS float* scr = (LAS float*)(F.lds + F.wave * 16384);
    const int gw = F.vcu * 8 + F.wave, NGW = F.G * 8;
    constexpr int I_IN = 16 * 144, I_RNN = 16 * 32, I_OUT = 16 * 32, I_GLU = 8 * 64, I_RG = 16 * 8;
    for (int it = gw; it < I_IN + I_RNN + I_OUT + I_GLU + I_RG; it += NGW) { int r = it;
        if (r < I_IN) { const int kb = r / 144, nb = r % 144; transpose_item8(F.in[4], INC, kb * 64, nb * 32, WSP(unsigned char, WS_WIN), 1024, nb * 32, scr, F.lane); continue; } r -= I_IN;
        if (r < I_RNN) { const int kb = r / 32, nb = r % 32; transpose_item8(F.in[13], 1024, kb * 64, nb * 32, WSP(unsigned char, WS_WRNN), 1024, nb * 32, scr, F.lane); continue; } r -= I_RNN;
        if (r < I_OUT) { const int kb = r / 32, nb = r % 32; transpose_item8(F.in[23], 1024, kb * 64, nb * 32, WSP(unsigned char, WS_WOUT), 1024, nb * 32, scr, F.lane); continue; } r -= I_OUT;
        if (r < I_GLU) { const int kb = r / 64, nb = r % 64; transpose_item8(F.in[22], 2048, kb * 64, nb * 32, WSP(unsigned char, WS_WGLU), 512, pair_row(nb * 32), scr, F.lane); continue; } r -= I_GLU;
        { const int mat = r >> 3, kb = (r >> 2) & 1, nb = r & 3, hd = mat & 7, gx = mat >> 3;
          transpose_item(F.in[gx ? 10 : 8] + (size_t)hd * 128 * 128, 128, kb * 64, nb * 32, WSP(bf16, WS_WG), 128, hd * 256 + gx * 128 + nb * 32, scr, F.lane); }
    }
}
__device__ __forceinline__ void p1_body(Frame& F) {
    const int gw = F.vcu * 8 + F.wave, NGW = F.G * 8; const float* mod = WSP(float, WS_MOD); bf16* hbf = WSP(bf16, WS_HBF);
    for (int tb = 4 * gw; tb < T; tb += 4 * NGW) {
        const int b = tb >> 12; f32x4 xv[4][4], shv[4], scv[4];
#pragma unroll
        for (int r = 0; r < 4; ++r) { const f32x4* xr = (const f32x4*)(F.in[0] + (size_t)(tb + r) * 1024) + F.lane;
#pragma unroll
            for (int j = 0; j < 4; ++j) xv[r][j] = xr[64 * j]; }
#pragma unroll
        for (int j = 0; j < 4; ++j) { shv[j] = *((const f32x4*)(mod + b * 6144) + F.lane + 64 * j); scv[j] = *((const f32x4*)(mod + b * 6144 + 1024) + F.lane + 64 * j) + 1.0f; }
#pragma unroll
        for (int r = 0; r < 4; ++r) { unsigned* o = (unsigned*)((unsigned char*)hbf + (size_t)(tb + r) * 1024) + F.lane;
#pragma unroll
            for (int j = 0; j < 4; ++j) { const f32x4 v = xv[r][j] * scv[j] + shv[j]; o[64 * j] = pk4_fp8(v[0], v[1], v[2], v[3]); } } }
    constexpr int TP = 132;
    LAS float* tile = (LAS float*)F.lds;
    constexpr int TILES_GU = 8 * 16, TILES_D = 8 * 8, TILES_E = TILES_GU + TILES_D;
    const int lr = F.tid >> 5, lc4 = (F.tid & 31) * 4, tn = F.tid >> 2, kc = F.tid & 3;
    f32x4 pre[8];
    int ti = F.vcu;
#define P1_SRC(idx, src, N_, dstp, drow0_, k0_) do { const int e_ = (idx) / TILES_E, r_ = (idx) % TILES_E; \
        if (r_ < TILES_GU) { const int kb_ = r_ >> 4, nb_ = r_ & 15; N_ = 2048; src = F.in[28] + (size_t)e_ * 1024 * 2048 + (size_t)(kb_ * 128) * 2048 + nb_ * 128; dstp = WSP(unsigned char, WS_WGU) + (size_t)e_ * 2048 * 1024; drow0_ = pair_row(nb_ * 128); k0_ = kb_ * 128; } \
        else { const int q_ = r_ - TILES_GU, kb_ = q_ >> 3, nb_ = q_ & 7; N_ = 1024; src = F.in[30] + (size_t)e_ * 1024 * 1024 + (size_t)(kb_ * 128) * 1024 + nb_ * 128; dstp = WSP(unsigned char, WS_WD) + (size_t)e_ * 1024 * 1024; drow0_ = nb_ * 128; k0_ = kb_ * 128; } } while (0)
    if (ti < NE * TILES_E) { const float* src; unsigned char* dstp; int N_, d0, k0; P1_SRC(ti, src, N_, dstp, d0, k0);
#pragma unroll
        for (int i = 0; i < 8; ++i) pre[i] = *(const f32x4*)(src + (size_t)(lr + 16 * i) * N_ + lc4); }
    for (; ti < NE * TILES_E; ti += F.G) {
#pragma unroll
        for (int i = 0; i < 8; ++i) *(LAS f32x4*)(tile + (lr + 16 * i) * TP + lc4) = pre[i];
        __syncthreads();
        const int tnx = (ti + F.G < NE * TILES_E) ? ti + F.G : ti;
        { const float* src; unsigned char* dstp; int N_, d0, k0; P1_SRC(tnx, src, N_, dstp, d0, k0);
#pragma unroll
            for (int i = 0; i < 8; ++i) pre[i] = *(const f32x4*)(src + (size_t)(lr + 16 * i) * N_ + lc4); }
        { const float* src; unsigned char* dstp; int N_, d0, k0; P1_SRC(ti, src, N_, dstp, d0, k0); (void)src; (void)N_;
          const LAS float* cp = tile + (32 * kc) * TP + tn; u32x4 o0, o1; float cv[32];
#pragma unroll
          for (int i = 0; i < 32; ++i) cv[i] = cp[i * TP];
          asm volatile("s_waitcnt lgkmcnt(0)" ::: "memory");
#pragma unroll
          for (int i = 0; i < 32; ++i) cv[i] *= 32.f;
          o0.x = pk4_fp8(cv[0], cv[1], cv[2], cv[3]); o0.y = pk4_fp8(cv[4], cv[5], cv[6], cv[7]); o0.z = pk4_fp8(cv[8], cv[9], cv[10], cv[11]); o0.w = pk4_fp8(cv[12], cv[13], cv[14], cv[15]);
          o1.x = pk4_fp8(cv[16], cv[17], cv[18], cv[19]); o1.y = pk4_fp8(cv[20], cv[21], cv[22], cv[23]); o1.z = pk4_fp8(cv[24], cv[25], cv[26], cv[27]); o1.w = pk4_fp8(cv[28], cv[29], cv[30], cv[31]);
          unsigned char* op = dstp + (size_t)(d0 + tn) * 1024 + k0 + 32 * kc; *(u32x4*)op = o0; *(u32x4*)(op + 16) = o1; }
        __syncthreads();
    }
#undef P1_SRC
}
constexpr int XR_LD = 136, XR_TILE = 128 * XR_LD;
__device__ __forceinline__ void rg_issue(const bf16* xrnn, const bf16* gy, int item, int tid, u32x4 (&xraw)[4][4], u32x4 (&graw)[4], bool pass1) {
    const int hd = item & 7, c = (item >> 3) & 31, b = item >> 8, r0 = tid >> 4, ch = hd * 128 + (tid & 15) * 8;
#pragma unroll
    for (int q = 0; q < 4; ++q) { const int r = r0 + 32 * q;
#pragma unroll
        for (int k = 0; k < 4; ++k) { const int tp = c * RGL + r - 3 + k, tpc = tp < 0 ? 0 : tp; xraw[q][k] = *(const u32x4*)(xrnn + (size_t)(b * SEQ + tpc) * 1024 + ch); }
        if (pass1) graw[q] = *(const u32x4*)(gy + (size_t)(b * SEQ + c * RGL + r) * 1024 + ch); }
}
__device__ __forceinline__ void rg_convwrite(const LAS float* cwl, int item, int tid, const u32x4 (&xraw)[4][4], const u32x4 (&graw)[4], LAS bf16* xr, LAS bf16* gyt, bool pass1) {
    const int c = (item >> 3) & 31, r0 = tid >> 4, c8 = (tid & 15) * 8;
    const f32x4 b0 = *(const LAS f32x4*)(cwl + 4 * 128 + c8), b1 = *(const LAS f32x4*)(cwl + 4 * 128 + c8 + 4);
    f32x4 w0[4], w1[4];
#pragma unroll
    for (int k = 0; k < 4; ++k) { w0[k] = *(const LAS f32x4*)(cwl + k * 128 + c8); w1[k] = *(const LAS f32x4*)(cwl + k * 128 + c8 + 4); }
#pragma unroll
    for (int q = 0; q < 4; ++q) { const int r = r0 + 32 * q; f32x4 a0 = b0, a1 = b1;
#pragma unroll
        for (int k = 0; k < 4; ++k) { const int tp = c * RGL + r - 3 + k; f32x4 x0, x1; unpack8(xraw[q][k], x0, x1); if (tp < 0) { x0 = (f32x4){0.f, 0.f, 0.f, 0.f}; x1 = x0; } a0 += w0[k] * x0; a1 += w1[k] * x1; }
        *(LAS u32x4*)(xr + r * XR_LD + c8) = pack8(a0, a1);
        if (pass1) *(LAS u32x4*)(gyt + r * XR_LD + c8) = graw[q]; }
}
template <int PASS>
__device__ __forceinline__ void rglru_phase(Frame& F) {
    const int NIT = NB * RGC * 8;
    const bool skew = (PASS == 0) && (F.G == 256);
    const int nmine = skew ? (F.vcu < 128 ? 7 : 9) : (NIT - F.vcu + F.G - 1) / F.G;
#define RG_ITEM(k) ((skew && (k) >= 7) ? (1792 + (F.vcu - 128) + 128 * ((k) - 7)) : (F.vcu + (k) * F.G))
    if (nmine <= 0) return;
    int it = RG_ITEM(0);
    LAS bf16* xr = (LAS bf16*)F.lds; LAS bf16* gyt0 = xr + XR_TILE;
    const bf16* xrnn = WSP(bf16, WS_XRNN); const bf16* gy = WSP(bf16, WS_GY); bf16* ha = WSP(bf16, WS_HA); const float* cw = F.in[6]; const float* cb = F.in[7];
    const int tid = F.tid, w = F.wave, q = F.lane >> 4, col = F.lane & 15, chl = 16 * w + col;
    u32x4 xraw[4][4], graw[4];
    LAS float* cwl = (LAS float*)(gyt0 + 2 * XR_TILE);
    for (int i = tid; i < 5 * 128; i += 512) { const int k = i >> 7, chh = (it & 7) * 128 + (i & 127); cwl[i] = (k < 4) ? cw[k * 1024 + chh] : cb[chh]; }
    rg_issue(xrnn, gy, it, tid, xraw, graw, PASS);
    __syncthreads();
    rg_convwrite(cwl, it, tid, xraw, graw, xr, gyt0, PASS);
    bf16x8 Bf[2][4]; float ba, bx, sp;
    { const int hd0 = it & 7, ch0 = hd0 * 128 + chl; const bf16* wg = WSP(bf16, WS_WG) + (size_t)hd0 * 256 * 128;
#pragma unroll
      for (int gt = 0; gt < 2; ++gt)
#pragma unroll
          for (int kk = 0; kk < 4; ++kk) Bf[gt][kk] = *(const bf16x8*)(wg + (size_t)(gt * 128 + chl) * 128 + kk * 32 + q * 8);
      ba = F.in[9][ch0]; bx = F.in[11][ch0]; const float lam = F.in[12][ch0]; sp = (lam > 15.f) ? __expf(-lam) : log1pf(__expf(-lam)); }
#pragma unroll
    for (int gt = 0; gt < 2; ++gt)
#pragma unroll
        for (int kk = 0; kk < 4; ++kk) asm volatile("" :: "v"(Bf[gt][kk]));
    asm volatile("" :: "v"(ba), "v"(bx), "v"(sp));
    __syncthreads();
    for (int i = 0; i < nmine; ++i) {
        const bool has_next = (i + 1) < nmine; const int nit = has_next ? RG_ITEM(i + 1) : it;
        const int hd = it & 7, c = (it >> 3) & 31, b = it >> 8, t0 = b * SEQ + c * RGL, ch = hd * 128 + chl;
        LAS bf16* gyt = gyt0 + (i & 1) * XR_TILE; LAS bf16* gytn = gyt0 + ((i & 1) ^ 1) * XR_TILE;
        float carryH = 0.f, carryP = 1.f;
        if (PASS) carryH = WSP(float, WS_HIN)[(size_t)(b * RGC + c) * 1024 + ch];
        __builtin_amdgcn_sched_barrier(0);
        rg_issue(xrnn, gy, nit, tid, xraw, graw, PASS);
        __builtin_amdgcn_sched_barrier(0);
        f32x4 acc[8][2];
#pragma unroll
        for (int m = 0; m < 8; ++m) { acc[m][0] = (f32x4){0.f, 0.f, 0.f, 0.f}; acc[m][1] = (f32x4){0.f, 0.f, 0.f, 0.f}; }
#pragma unroll
        for (int kk = 0; kk < 4; ++kk)
#pragma unroll
            for (int m = 0; m < 8; ++m) { const bf16x8 Af = *(const LAS bf16x8*)(xr + (16 * m + col) * XR_LD + kk * 32 + q * 8);
                acc[m][0] = __builtin_amdgcn_mfma_f32_16x16x32_bf16(Af, Bf[0][kk], acc[m][0], 0, 0, 0);
                acc[m][1] = __builtin_amdgcn_mfma_f32_16x16x32_bf16(Af, Bf[1][kk], acc[m][1], 0, 0, 0); }
#pragma unroll
        for (int m = 0; m < 8; ++m) {
            float a[4], uu[4];
#pragma unroll
            for (int j = 0; j < 4; ++j) { const int tl = 16 * m + 4 * q + j;
                const float r = fast_sigmoid(acc[m][0][j] + ba), ii = fast_sigmoid(acc[m][1][j] + bx);
                const float la = -11.541560327f * r * sp; a[j] = __builtin_amdgcn_exp2f(la); const float mult = __builtin_amdgcn_sqrtf(fmaxf(1.0f - a[j] * a[j], 0.f));
                uu[j] = mult * ii * bf1(xr[tl * XR_LD + chl]); }
            float sP = a[0], sH = uu[0];
#pragma unroll
            for (int j = 1; j < 4; ++j) { sH = a[j] * sH + uu[j]; sP *= a[j]; }
            float iP = sP, iH = sH;
            { const float pP = __shfl_up(iP, 16), pH = __shfl_up(iH, 16); if (q >= 1) { iH = iP * pH + iH; iP = iP * pP; } }
            { const float pP = __shfl_up(iP, 32), pH = __shfl_up(iH, 32); if (q >= 2) { iH = iP * pH + iH; iP = iP * pP; } }
            float eP = __shfl_up(iP, 16), eH = __shfl_up(iH, 16); if (q == 0) { eP = 1.f; eH = 0.f; }
            const float tP = __shfl(iP, col + 48), tH = __shfl(iH, col + 48);
            if (PASS) { float h = eP * carryH + eH;
#pragma unroll
                for (int j = 0; j < 4; ++j) { const int tl = 16 * m + 4 * q + j; h = a[j] * h + uu[j]; LAS bf16* gp = gyt + tl * XR_LD + chl; *gp = (bf16)f2bf(h * bf1(*gp)); } }
            carryH = tP * carryH + tH; carryP *= tP;
        }
        if (!PASS && q == 0) { f32x2* ag = WSP(f32x2, WS_RGAGG); ag[(size_t)(b * RGC + c) * 1024 + ch] = (f32x2){carryP, carryH}; }
        __syncthreads();
        if (PASS) { const int r0 = tid >> 4, c8 = (tid & 15) * 8;
#pragma unroll
            for (int qq = 0; qq < 4; ++qq) { const int r = r0 + 32 * qq; f32x4 h0, h1; unpack8(*(const LAS u32x4*)(gyt + r * XR_LD + c8), h0, h1); u32x2 w8; w8.x = pk4_fp8(h0[0], h0[1], h0[2], h0[3]); w8.y = pk4_fp8(h1[0], h1[1], h1[2], h1[3]);
                *(u32x2*)((unsigned char*)ha + (size_t)(t0 + r) * 1024 + hd * 128 + c8) = w8; } }
#pragma unroll
        for (int qq = 0; qq < 4; ++qq) {
#pragma unroll
            for (int k = 0; k < 4; ++k) asm volatile("" : "+v"(xraw[qq][k]));
            if (PASS) asm volatile("" : "+v"(graw[qq])); }
        if (has_next) rg_convwrite(cwl, nit, tid, xraw, graw, xr, gytn, PASS);
        __syncthreads();
        it = nit;
    }
#undef RG_ITEM
}
__device__ __forceinline__ void p4_carries(Frame& F) {
    LAS f32x2* seg = (LAS f32x2*)F.lds;
    for (int job = F.vcu; job < NB * S5G; job += F.G) {
        const int b = job >> 5, g = job & 31, p = F.lane, w = F.wave;
        const f32x2 al = WSP(f32x2, WS_AL)[g * 64 + p];
        const f32x2* Sb = WSP(f32x2, WS_S) + ((size_t)(g * S5M + b * S5CPB + 16 * w)) * 64 + p; unsigned* ac = (unsigned*)(WSP(bf16, WS_ACAT) + ((size_t)(g * S5M + b * S5CPB + 16 * w)) * S5ROW) + p;
        f32x2 sv[16];
#pragma unroll
        for (int i = 0; i < 16; ++i) sv[i] = Sb[(size_t)i * 64];
        float xr_ = 0.f, xi = 0.f;
#pragma unroll
        for (int i = 0; i < 16; ++i) { const float nr = al.x * xr_ - al.y * xi + sv[i].x, ni = al.x * xi + al.y * xr_ + sv[i].y; xr_ = nr; xi = ni; }
        seg[w * 64 + p] = (f32x2){xr_, xi};
        float ar = al.x, ai = al.y;
#pragma unroll
        for (int q = 0; q < 4; ++q) { const float nr = ar * ar - ai * ai, ni = 2.f * ar * ai; ar = nr; ai = ni; }
        __syncthreads();
        xr_ = 0.f; xi = 0.f;
        for (int ww = 0; ww < w; ++ww) { const f32x2 sg = seg[ww * 64 + p]; const float nr = ar * xr_ - ai * xi + sg.x, ni = ar * xi + ai * xr_ + sg.y; xr_ = nr; xi = ni; }
#pragma unroll
        for (int i = 0; i < 16; ++i) { ac[(size_t)i * (S5ROW / 2)] = pk2(xr_, xi); const float nr = al.x * xr_ - al.y * xi + sv[i].x, ni = al.x * xi + al.y * xr_ + sv[i].y; xr_ = nr; xi = ni; }
        __syncthreads();
    }
    if (F.vcu < 16) {
        const int id = F.vcu * 512 + F.tid, ch = id & 1023, b = id >> 10; const f32x2* ag = WSP(f32x2, WS_RGAGG) + (size_t)b * RGC * 1024 + ch; float* hin = WSP(float, WS_HIN) + (size_t)b * RGC * 1024 + ch;
        f32x2 a[RGC];
#pragma unroll
        for (int c = 0; c < RGC; ++c) a[c] = ag[(size_t)c * 1024];
        float h = 0.f;
#pragma unroll
        for (int c = 0; c < RGC; ++c) { hin[(size_t)c * 1024] = h; h = a[c].x * h + a[c].y; }
    }
}
constexpr int WR_LD = 1032;
__device__ __forceinline__ void p9_router(Frame& F) {
    LAS bf16* wH = (LAS bf16*)F.lds; LAS bf16* wL = wH + 32 * WR_LD;
    LAS f32x2* sel = (LAS f32x2*)(wL + 32 * WR_LD);
    LAS unsigned* rec = (LAS unsigned*)(sel + 512);
    LAS float* recp = (LAS float*)(rec + 512);
    LAS int* lcnt = (LAS int*)(recp + 512);
    LAS int* gbase = lcnt + 32;
    { const u32x4* img = WSP(u32x4, WS_WRIMG); LAS u32x4* dst = (LAS u32x4*)wH;
      for (int i = F.tid; i < 2 * 32 * WR_LD * 2 / 16; i += 512) dst[i] = img[i]; }
    if (F.tid < 32) lcnt[F.tid] = 0;
    __syncthreads();
    const float* mod = WSP(float, WS_MOD); const bf16* v1 = WSP(bf16, WS_V1); bf16* x1 = WSP(bf16, WS_X1); unsigned char* h2 = WSP(unsigned char, WS_H2);
    const int lane = F.lane, m = lane & 15, kq = lane >> 4, w = F.wave;
    for (int blk = F.vcu; blk < T / 128; blk += F.G) {
        const int t = blk * 128 + w * 16 + m, b = (blk * 128) >> 12;
        const bf16* vrow = v1 + (size_t)t * 1024 + 8 * kq;
        float sum = 0.f, sq = 0.f;
#pragma unroll 32
        for (int s_ = 0; s_ < 32; ++s_) { f32x4 a, c; unpack8(*(const u32x4*)(vrow + 32 * s_), a, c); sum += ((a[0] + a[1]) + (a[2] + a[3])) + ((c[0] + c[1]) + (c[2] + c[3]));
            sq += ((a[0] * a[0] + a[1] * a[1]) + (a[2] * a[2] + a[3] * a[3])) + ((c[0] * c[0] + c[1] * c[1]) + (c[2] * c[2] + c[3] * c[3])); }
        sum += __shfl_xor(sum, 16); sum += __shfl_xor(sum, 32); sq += __shfl_xor(sq, 16); sq += __shfl_xor(sq, 32);
        const float mean = sum * (1.f / 1024.f); const float rstd = 1.f / sqrtf(fmaxf(sq * (1.f / 1024.f) - mean * mean, 0.f) + LN_EPS);
        f32x4 acc[2] = {(f32x4){0.f, 0.f, 0.f, 0.f}, (f32x4){0.f, 0.f, 0.f, 0.f}};
        const float* lng = F.in[24] + 8 * kq; const float* lnb = F.in[25] + 8 * kq; const float* shp = mod + b * 6144 + 3072 + 8 * kq; const float* scp = mod + b * 6144 + 4096 + 8 * kq;
        bf16* x1row = x1 + (size_t)t * 1024 + 8 * kq; unsigned char* h2row = h2 + (size_t)t * 1024 + 8 * kq;
        const LAS bf16* wHr = wH + m * WR_LD + 8 * kq; const LAS bf16* wLr = wL + m * WR_LD + 8 * kq;
#pragma unroll 2
        for (int s2 = 0; s2 < 32; s2 += 2) {
            u32x4 rw[2]; f32x4 pg[2][2], pb[2][2], psh[2][2], psc[2][2];
#pragma unroll
            for (int h = 0; h < 2; ++h) { const int ko = 32 * (s2 + h); rw[h] = *(const u32x4*)(vrow + ko);
                pg[h][0] = *(const f32x4*)(lng + ko); pg[h][1] = *(const f32x4*)(lng + ko + 4); pb[h][0] = *(const f32x4*)(lnb + ko); pb[h][1] = *(const f32x4*)(lnb + ko + 4);
                psh[h][0] = *(const f32x4*)(shp + ko); psh[h][1] = *(const f32x4*)(shp + ko + 4); psc[h][0] = *(const f32x4*)(scp + ko); psc[h][1] = *(const f32x4*)(scp + ko + 4); }
#pragma unroll
            for (int h = 0; h < 2; ++h) { const int ko = 32 * (s2 + h);
                f32x4 a, c; unpack8(rw[h], a, c);
                const f32x4 x0 = (a - mean) * rstd * pg[h][0] + pb[h][0], x1v = (c - mean) * rstd * pg[h][1] + pb[h][1];
                *(u32x4*)(x1row + ko) = pack8(x0, x1v);
                const f32x4 h0 = x0 * (psc[h][0] + 1.0f) + psh[h][0], h1 = x1v * (psc[h][1] + 1.0f) + psh[h][1];
                u32x2 w8; w8.x = pk4_fp8(h0[0], h0[1], h0[2], h0[3]); w8.y = pk4_fp8(h1[0], h1[1], h1[2], h1[3]); *(u32x2*)(h2row + ko) = w8;
                const u32x4 hi = pack8(h0, h1); f32x4 r0, r1; unpack8(hi, r0, r1); const u32x4 lo = pack8(h0 - r0, h1 - r1);
                const bf16x8 ah = __builtin_bit_cast(bf16x8, hi), al = __builtin_bit_cast(bf16x8, lo);
#pragma unroll
                for (int nf = 0; nf < 2; ++nf) { const bf16x8 bh = *(const LAS bf16x8*)(wHr + nf * 16 * WR_LD + ko), bl = *(const LAS bf16x8*)(wLr + nf * 16 * WR_LD + ko);
                    acc[nf] = __builtin_amdgcn_mfma_f32_16x16x32_bf16(bh, ah, acc[nf], 0, 0, 0);
                    acc[nf] = __builtin_amdgcn_mfma_f32_16x16x32_bf16(bl, ah, acc[nf], 0, 0, 0);
                    acc[nf] = __builtin_amdgcn_mfma_f32_16x16x32_bf16(bh, al, acc[nf], 0, 0, 0); } } }
        float lv[8];
#pragma unroll
        for (int nf = 0; nf < 2; ++nf)
#pragma unroll
            for (int j = 0; j < 4; ++j) lv[nf * 4 + j] = acc[nf][j] + F.in[27][nf * 16 + 4 * kq + j];
        int rank[8];
#pragma unroll
        for (int i = 0; i < 8; ++i) { rank[i] = 0;
#pragma unroll
            for (int i2 = 0; i2 < 8; ++i2) if (i2 != i) { const int e1 = (i >> 2) * 16 + 4 * kq + (i & 3), e2 = (i2 >> 2) * 16 + 4 * kq + (i2 & 3); rank[i] += (lv[i2] > lv[i] || (lv[i2] == lv[i] && e2 < e1)) ? 1 : 0; } }
#pragma unroll
        for (int dq = 1; dq < 4; ++dq) { const int q2 = kq ^ dq;
#pragma unroll
            for (int i2 = 0; i2 < 8; ++i2) { const float o = __shfl_xor(lv[i2], 16 * dq); const int e2 = (i2 >> 2) * 16 + 4 * q2 + (i2 & 3);
#pragma unroll
                for (int i = 0; i < 8; ++i) { const int e1 = (i >> 2) * 16 + 4 * kq + (i & 3); rank[i] += (o > lv[i] || (o == lv[i] && e2 < e1)) ? 1 : 0; } } }
#pragma unroll
        for (int i = 0; i < 8; ++i) if (rank[i] < 4) { const int e1 = (i >> 2) * 16 + 4 * kq + (i & 3); sel[(w * 16 + m) * 4 + rank[i]] = (f32x2){__builtin_bit_cast(float, e1), lv[i]}; }
        asm volatile("s_waitcnt lgkmcnt(0)" ::: "memory");
        { const int tm = lane >> 2, k = lane & 3; const f32x2 s0 = sel[(w * 16 + tm) * 4 + 0], s1 = sel[(w * 16 + tm) * 4 + 1], s2 = sel[(w * 16 + tm) * 4 + 2], s3 = sel[(w * 16 + tm) * 4 + 3];
          const float p0 = 1.f, p1 = __expf(s1.y - s0.y), p2 = __expf(s2.y - s0.y), p3 = __expf(s3.y - s0.y), ps = (p0 + p1) + (p2 + p3);
          const f32x2 mine = k == 0 ? s0 : (k == 1 ? s1 : (k == 2 ? s2 : s3)); const float pm = (k == 0 ? p0 : (k == 1 ? p1 : (k == 2 ? p2 : p3))) / ps;
          const int e = __builtin_bit_cast(int, mine.x);
          const int lr = __hip_atomic_fetch_add(lcnt + e, 1, __ATOMIC_RELAXED, __HIP_MEMORY_SCOPE_WORKGROUP);
          rec[(w * 16 + tm) * 4 + k] = ((unsigned)e << 16) | (unsigned)lr; recp[(w * 16 + tm) * 4 + k] = pm; }
        __syncthreads();
        if (F.tid < 32) { const int n = lcnt[F.tid]; gbase[F.tid] = n ? (int)atomicAdd(F.ctl + CW_CNT + 64 * F.tid, (unsigned)n) : 0; lcnt[F.tid] = 0; }
        __syncthreads();
        { const unsigned r = rec[F.tid]; const int e = r >> 16, rk = gbase[e] + (int)(r & 0xffffu), tt = blk * 128 + (F.tid >> 2);
          WSP(int, WS_TOK)[(size_t)e * T + rk] = tt; WSP(unsigned, WS_POS)[(size_t)tt * 4 + (F.tid & 3)] = ((unsigned)e << 20) | (unsigned)rk; WSP(float, WS_PROB)[(size_t)tt * 4 + (F.tid & 3)] = recp[F.tid]; }
        __syncthreads();
    }
}
__device__ __forceinline__ void p12_final(Frame& F) {
    moe_tables(F);
    const LAS int* tstart = (const LAS int*)(F.lds + TAB_OFF);
    const float* mod = WSP(float, WS_MOD); const bf16* x1 = WSP(bf16, WS_X1); const bf16* yb = WSP(bf16, WS_YB); const unsigned* pos = WSP(unsigned, WS_POS); const float* prob = WSP(float, WS_PROB);
    const int lane = F.lane, gw = F.vcu * 8 + F.wave, NGW = F.G * 8;
    f32x4 lg[4], lb[4];
#pragma unroll
    for (int j = 0; j < 4; ++j) { lg[j] = *(const f32x4*)(F.in[32] + 512 * (j >> 1) + 8 * lane + 4 * (j & 1)); lb[j] = *(const f32x4*)(F.in[33] + 512 * (j >> 1) + 8 * lane + 4 * (j & 1)); }
#define P12_ROUTE(PP, PW, tt) do { const u32x4 p4_ = *(const u32x4*)(pos + (size_t)(tt) * 4); const f32x4 w4_ = *(const f32x4*)(prob + (size_t)(tt) * 4); \
        PP[0] = p4_.x; PP[1] = p4_.y; PP[2] = p4_.z; PP[3] = p4_.w; PW[0] = w4_[0]; PW[1] = w4_[1]; PW[2] = w4_[2]; PW[3] = w4_[3]; } while (0)
#define P12_ROWS(YW, XW, PP, tt) do { _Pragma("unroll") for (int k = 0; k < 4; ++k) { const int e_ = PP[k] >> 20, rk_ = PP[k] & 0xfffffu; const size_t slot_ = (size_t)tstart[e_] * 256 + rk_; \
            _Pragma("unroll") for (int j = 0; j < 2; ++j) YW[k][j] = *((const u32x2*)((const unsigned char*)yb + slot_ * 1024) + 64 * j + lane); } \
        _Pragma("unroll") for (int j = 0; j < 2; ++j) XW[j] = *((const u32x4*)(x1 + (size_t)(tt) * 1024) + 64 * j + lane); } while (0)
#define P12_COMPUTE(YW, XW, PW, tt) do { const int b_ = (tt) >> 12; f32x4 v[4]; float s_ = 0.f; \
        _Pragma("unroll") for (int j = 0; j < 2; ++j) { f32x4 f0 = (f32x4){0.f, 0.f, 0.f, 0.f}, f1 = f0; \
            _Pragma("unroll") for (int k = 0; k < 4; ++k) { const u32x2 yv_ = YW[k][j]; const f32x2 q0_ = __builtin_amdgcn_cvt_pk_f32_fp8((int)yv_.x, false), q1_ = __builtin_amdgcn_cvt_pk_f32_fp8((int)yv_.x, true), q2_ = __builtin_amdgcn_cvt_pk_f32_fp8((int)yv_.y, false), q3_ = __builtin_amdgcn_cvt_pk_f32_fp8((int)yv_.y, true); \
                f0 += (f32x4){q0_.x, q0_.y, q1_.x, q1_.y} * PW[k]; f1 += (f32x4){q2_.x, q2_.y, q3_.x, q3_.y} * PW[k]; } \
            f32x4 xa_, xc_; unpack8(XW[j], xa_, xc_); const float* gp_ = mod + b_ * 6144 + 5120 + 512 * j + 8 * lane; \
            v[2 * j] = xa_ * DN_ALPHA + (*(const f32x4*)gp_ + 1.0f) * f0; v[2 * j + 1] = xc_ * DN_ALPHA + (*(const f32x4*)(gp_ + 4) + 1.0f) * f1; \
            s_ += ((v[2 * j][0] + v[2 * j][1]) + (v[2 * j][2] + v[2 * j][3])) + ((v[2 * j + 1][0] + v[2 * j + 1][1]) + (v[2 * j + 1][2] + v[2 * j + 1][3])); } \
        const float mean_ = wave_sum(s_) * (1.f / 1024.f); float s2_ = 0.f; \
        _Pragma("unroll") for (int j = 0; j < 4; ++j) { v[j] = v[j] - mean_; s2_ += (v[j][0] * v[j][0] + v[j][1] * v[j][1]) + (v[j][2] * v[j][2] + v[j][3] * v[j][3]); } \
        const float rstd_ = 1.f / sqrtf(wave_sum(s2_) * (1.f / 1024.f) + LN_EPS); \
        _Pragma("unroll") for (int j = 0; j < 4; ++j) *(f32x4*)(F.out + (size_t)(tt) * 1024 + 512 * (j >> 1) + 8 * lane + 4 * (j & 1)) = v[j] * rstd_ * lg[j] + lb[j]; } while (0)
    const int nmine = (T - gw + NGW - 1) / NGW;
    unsigned ppA[4], ppB[4]; float pwA[4], pwB[4], pwN[4]; u32x2 ywA[4][2], ywB[4][2]; u32x4 xwA[2], xwB[2];
    if (nmine > 0) { P12_ROUTE(ppA, pwA, gw); P12_ROWS(ywA, xwA, ppA, gw); }
    if (nmine > 1) { P12_ROUTE(ppB, pwB, gw + NGW); }
    for (int i = 0; i < nmine; i += 2) {
        const int t0 = gw + i * NGW, t1 = t0 + NGW, t2 = t1 + NGW, t3 = t2 + NGW;
        if (i + 1 < nmine) { P12_ROWS(ywB, xwB, ppB, t1); }
        if (i + 2 < nmine) { P12_ROUTE(ppA, pwN, t2); }
        __builtin_amdgcn_sched_barrier(0);
        P12_COMPUTE(ywA, xwA, pwA, t0);
        if (i + 1 < nmine) {
#pragma unroll
            for (int k = 0; k < 4; ++k) pwA[k] = pwN[k];
            if (i + 2 < nmine) { P12_ROWS(ywA, xwA, ppA, t2); }
            if (i + 3 < nmine) { P12_ROUTE(ppB, pwN, t3); }
            __builtin_amdgcn_sched_barrier(0);
            P12_COMPUTE(ywB, xwB, pwB, t1);
#pragma unroll
            for (int k = 0; k < 4; ++k) pwB[k] = pwN[k];
        }
    }
#undef P12_ROUTE
#undef P12_ROWS
#undef P12_COMPUTE
}

struct Args { const float* in[34]; float* out; unsigned char* ws; int ph_lo, ph_hi; };
__global__ void __launch_bounds__(512, 2) fwd_kernel(Args args) {
    extern __shared__ __attribute__((aligned(16))) unsigned char lds_raw[];
    Frame F;
    F.lds = (LAS unsigned char*)lds_raw; F.MISC = (volatile LAS unsigned*)(F.lds + MISC_OFF);
    F.tid = threadIdx.x; F.lane = F.tid & 63; F.wave = __builtin_amdgcn_readfirstlane(F.tid >> 6);
    F.G = gridDim.x; { const int bx = blockIdx.x; F.vcu = (F.G % 8 == 0) ? (bx % 8) * (F.G / 8) + bx / 8 : bx; }
#pragma unroll
    for (int i = 0; i < 34; ++i) F.in[i] = args.in[i];
    F.out = args.out; F.ws = args.ws; F.ctl = (unsigned*)(args.ws + WS_CTL);
    if (F.tid < 64) F.MISC[F.tid] = 0u;
    __syncthreads();
    XcdBarrier bar; bar.bar = F.ctl + CW_BAR; bar.x = 0; bar.st = nullptr;
    if (MK_N_LAUNCHES == 1) bar = xcd_barrier_post(F.ctl + CW_BAR, F.MISC + 8);
    const int lo = args.ph_lo, hi = args.ph_hi;
#define IN(k) (lo <= (k) && (k) < hi)
#define SEAM(k) do { if (IN(k) && IN((k) + 1)) xcd_barrier(bar); } while (0)

    if (IN(0)) REPS(0) { if (rep_) xcd_barrier(bar);
        for (int j = F.vcu; j < 192; j += F.G) p0_mod_job(F, j);
        for (int j = F.vcu; j < S5G * 8; j += F.G) p0_s5k_job(F, j);
        { bf16* img = WSP(bf16, WS_WRIMG); const float* wr = F.in[26];
          for (int i = F.vcu * 512 + F.tid; i < 1024 * 32; i += F.G * 512) { const float w = wr[i]; const unsigned hb = f2bf(w); const float hf = __builtin_bit_cast(float, hb << 16);
              img[(i & 31) * 1032 + (i >> 5)] = (bf16)hb; img[32 * 1032 + (i & 31) * 1032 + (i >> 5)] = (bf16)f2bf(w - hf); } }
        p0_small_transposes(F);
    }
    SEAM(0);
    if (IN(1)) REPS(1) { if (rep_) xcd_barrier(bar); for (int j = F.vcu; j < S5G * 8; j += F.G) p1_s5w_job(F, j); p1_body(F); }
    SEAM(1);
    if (IN(2)) REPS(2) { if (rep_) xcd_barrier(bar);
        g8::GridOrder S; S.init(T, INC, F.G, (int)blockIdx.x, WSP(bf16, WS_HBF), WSP(bf16, WS_WIN), 1024, 1024);
        EpiInProj E{F.in[5], WSP(bf16, WS_XRNN), WSP(bf16, WS_GY), WSP(bf16, WS_ACAT), WSP(bf16, WS_GATES)};
        g8::gemm_phase<EpiInProj, g8::GridOrder, false, true>(F.lds, 1024, 1024, 1024, S, E);
    }
    SEAM(2);
    if (IN(3)) REPS(3) { if (rep_) xcd_barrier(bar);
        { S5AOrder S{F.G, F.vcu, (const char*)WSP(bf16, WS_ACAT), (const char*)WSP(bf16, WS_WS)}; EpiS5A E{WSP(float, WS_S)};
          g8::gemm_phase<EpiS5A, S5AOrder, false>(F.lds, S5L * 32, S5ROW * 2, S5L * 32, S, E); }
        __syncthreads();
        rglru_phase<0>(F);
    }
    SEAM(3);
    if (IN(4)) REPS(4) { if (rep_) xcd_barrier(bar); p4_carries(F); }
    SEAM(4);
    if (IN(5)) REPS(5) { if (rep_) xcd_barrier(bar);
        { S5COrder S{F.G, F.vcu, (const char*)WSP(bf16, WS_ACAT), (const char*)WSP(bf16, WS_WY)}; EpiS5C E{WSP(bf16, WS_YS)};
          g8::gemm_phase<EpiS5C, S5COrder, false>(F.lds, S5ROW * 2, S5ROW * 2, S5ROW * 2, S, E); }
        __syncthreads();
        rglru_phase<1>(F);
    }
    SEAM(5);
    if (IN(6)) REPS(6) { if (rep_) xcd_barrier(bar);
        g8::GridOrder S; S.init(T, 2048, F.G, (int)blockIdx.x, WSP(bf16, WS_YS), WSP(bf16, WS_WGLU), 512, 512);
        EpiGlu E{WSP(bf16, WS_GATES), WSP(bf16, WS_GB)};
        g8::gemm_phase<EpiGlu, g8::GridOrder, false, true>(F.lds, 512, 512, 512, S, E);
    }
    SEAM(6);
    if (IN(7)) REPS(7) { if (rep_) xcd_barrier(bar);
        g8::GridOrder S; S.init(T, 1024, F.G, (int)blockIdx.x, WSP(bf16, WS_HA), WSP(bf16, WS_WRNN), 1024, 1024);
        EpiRnn E{WSP(bf16, WS_GATES), WSP(bf16, WS_GB), WSP(bf16, WS_MERGED)};
        g8::gemm_phase<EpiRnn, g8::GridOrder, false, true>(F.lds, 1024, 1024, 1024, S, E);
    }
    SEAM(7);
    if (IN(8)) REPS(8) { if (rep_) xcd_barrier(bar);
        g8::GridOrder S; S.init(T, 1024, F.G, (int)blockIdx.x, WSP(bf16, WS_MERGED), WSP(bf16, WS_WOUT), 1024, 1024);
        EpiOut E{F.in[0], WSP(float, WS_MOD), WSP(bf16, WS_V1)};
        g8::gemm_phase<EpiOut, g8::GridOrder, false, true>(F.lds, 1024, 1024, 1024, S, E);
    }
    SEAM(8);
    if (IN(9)) REPS(9) { if (rep_) xcd_barrier(bar); p9_router(F); }
    SEAM(9);
    if (IN(10)) REPS(10) { if (rep_) xcd_barrier(bar);
        moe_tables(F);
        const LAS int* tstart = (const LAS int*)(F.lds + TAB_OFF);
        MoeOrder S{F.G, (int)blockIdx.x, 8, tstart[NE], tstart, tstart + 40, WSP(int, WS_TOK), (const char*)WSP(bf16, WS_H2), (const char*)WSP(bf16, WS_WGU), (size_t)2048 * 1024, 1024, true};
        EpiMoe1 E{F.in[29], WSP(bf16, WS_ACT)};
        g8::gemm_phase<EpiMoe1, MoeOrder, true, true>(F.lds, 1024, 1024, 1024, S, E);
    }
    SEAM(10);
    if (IN(11)) REPS(11) { if (rep_) xcd_barrier(bar);
        moe_tables(F);
        const LAS int* tstart = (const LAS int*)(F.lds + TAB_OFF);
        MoeOrder S{F.G, (int)blockIdx.x, 4, tstart[NE], tstart, tstart + 40, WSP(int, WS_TOK), (const char*)WSP(bf16, WS_ACT), (const char*)WSP(bf16, WS_WD), (size_t)1024 * 1024, 1024, false};
        EpiMoe2 E{F.in[31], WSP(bf16, WS_YB)};
        g8::gemm_phase<EpiMoe2, MoeOrder, false, true>(F.lds, 1024, 1024, 1024, S, E);
    }
    SEAM(11);
    if (IN(12)) REPS(12) { if (rep_) xcd_barrier(bar); p12_final(F); }
#undef IN
#undef SEAM
}

extern "C" void kernel_launch(void* const* d_in, const int* in_sizes, int n_in, void* d_out, int out_size, void* d_ws, size_t ws_size, hipStream_t stream) {
    static int grid = 0;
    if (grid == 0) {
        if (n_in != 34 || in_sizes[0] != T * D || out_size != T * D || ws_size < WS_END) { fprintf(stderr, "kernel_launch: unexpected shapes (n_in %d, ws %zu < %zu)\n", n_in, ws_size, (size_t)WS_END); grid = -1; return; }
        int dev = 0, cus = 0;
        if (hipGetDevice(&dev) != hipSuccess || hipDeviceGetAttribute(&cus, hipDeviceAttributeMultiprocessorCount, dev) != hipSuccess) { grid = -1; return; }
        if (hipFuncSetAttribute((const void*)fwd_kernel, hipFuncAttributeMaxDynamicSharedMemorySize, LDS_BYTES) != hipSuccess) { fprintf(stderr, "kernel_launch: hipFuncSetAttribute failed\n"); grid = -1; return; }
        int per_cu = 0; (void)hipOccupancyMaxActiveBlocksPerMultiprocessor(&per_cu, (const void*)fwd_kernel, 512, LDS_BYTES); (void)hipGetLastError();
        grid = cus;
    }
    if (grid < 0) return;
    (void)hipMemsetAsync((char*)d_ws + WS_CTL, 0, CTL_BYTES, stream);
    Args a{};
    for (int i = 0; i < 34; ++i) a.in[i] = (const float*)d_in[i];
    a.out = (float*)d_out; a.ws = (unsigned char*)d_ws;
    if (MK_N_LAUNCHES == 1) { a.ph_lo = 0; a.ph_hi = N_PHASES; hipLaunchKernelGGL(fwd_kernel, dim3(grid), dim3(512), LDS_BYTES, stream, a); }
    else for (int p = 0; p < N_PHASES; ++p) { a.ph_lo = p; a.ph_hi = p + 1; hipLaunchKernelGGL(fwd_kernel, dim3(grid), dim3(512), LDS_BYTES, stream, a); }
}
```

```cpp
#include <hip/hip_runtime.h>
#include <cstdio>
#include <cstdint>

#ifndef MK_N_LAUNCHES
#define MK_N_LAUNCHES 1
#endif
constexpr int N_PHASES = 13;
#ifndef DUP_PHASE
#define DUP_PHASE -1
#endif
#define REPS(k) for (int rep_ = 0; rep_ < ((DUP_PHASE == (k)) ? 2 : 1); ++rep_)

#define GAS __attribute__((address_space(1)))
#define LAS __attribute__((address_space(3)))
typedef unsigned short bf16;
typedef short bf16x8 __attribute__((ext_vector_type(8)));
typedef float f32x4 __attribute__((ext_vector_type(4)));
typedef float f32x2 __attribute__((ext_vector_type(2)));
typedef unsigned u32x4 __attribute__((ext_vector_type(4)));
typedef unsigned u32x2 __attribute__((ext_vector_type(2)));
typedef GAS unsigned gu32;

constexpr int NB = 8, SEQ = 4096, T = NB * SEQ, D = 1024, INC = 4608, NE = 32, DFF = 1024;
constexpr int S5L = 32, S5G = 32, S5ROW = 128 + S5L * 16  , S5M = T / S5L  , S5CPB = SEQ / S5L  ;
constexpr int RGL = 128, RGC = SEQ / RGL  ;
constexpr float LN_EPS = 1e-5f, DN_ALPHA = 1.189207115002721f;
constexpr int ACT_ROWS = T * 4 + NE * 256;

constexpr size_t MiB = 1u << 20;
constexpr size_t WS_XRNN = 0, WS_GY = 64 * MiB, WS_GATES = 128 * MiB, WS_V1 = 0, WS_ACT = 0;
constexpr size_t WS_HBF = 272 * MiB, WS_HA = 272 * MiB, WS_YS = 336 * MiB, WS_GB = 368 * MiB, WS_MERGED = 432 * MiB, WS_ACAT = 496 * MiB, WS_YB = 272 * MiB;
constexpr size_t WS_X1 = 544 * MiB, WS_H2 = 608 * MiB;
constexpr size_t WS_WGU = 672 * MiB, WS_WD = 800 * MiB, WS_WIN = 864 * MiB, WS_WG = 873 * MiB, WS_WRNN = 874 * MiB, WS_WGLU = 876 * MiB, WS_WOUT = 878 * MiB;
constexpr size_t WS_WS = 880 * MiB, WS_WY = 888 * MiB, WS_S = 908 * MiB;
constexpr size_t WS_MOD = 924 * MiB, WS_AL = 925 * MiB, WS_RGAGG = 926 * MiB, WS_HIN = 928 * MiB, WS_TOK = 929 * MiB, WS_POS = 933 * MiB, WS_PROB = 934 * MiB, WS_CTL = 935 * MiB;
constexpr size_t WS_END = 936 * MiB, CTL_BYTES = 1 * MiB;
static_assert((size_t)ACT_ROWS * DFF * 2 <= 272 * MiB, "act/yb size");
static_assert(WS_ACAT + (size_t)S5G * S5M * S5ROW * 2 <= WS_X1, "acat");
constexpr int CW_BAR = 4096, CW_CNT = 8192  ;

constexpr int LDS_BYTES = 147456, MISC_OFF = LDS_BYTES - 256, TAB_OFF = 131072 + 1024;

__device__ __forceinline__ unsigned f2bf(float f) { unsigned u = __builtin_bit_cast(unsigned, f); return (u + 0x7fffu + ((u >> 16) & 1u)) >> 16; }
typedef __bf16 bf16x2v __attribute__((ext_vector_type(2)));
__device__ __forceinline__ unsigned pk2(float lo, float hi) { const f32x2 v = {lo, hi}; const bf16x2v b = __builtin_convertvector(v, bf16x2v); return __builtin_bit_cast(unsigned, b); }
__device__ __forceinline__ unsigned pk4_fp8(float a, float b, float c, float d) { a = __builtin_amdgcn_fmed3f(a, -448.f, 448.f); b = __builtin_amdgcn_fmed3f(b, -448.f, 448.f); c = __builtin_amdgcn_fmed3f(c, -448.f, 448.f); d = __builtin_amdgcn_fmed3f(d, -448.f, 448.f); int w = 0; w = __builtin_amdgcn_cvt_pk_fp8_f32(a, b, w, false); w = __builtin_amdgcn_cvt_pk_fp8_f32(c, d, w, true); return (unsigned)w; }
__device__ __forceinline__ void unpack8_fp8(u32x2 w, f32x4& a, f32x4& b) { const f32x2 q0 = __builtin_amdgcn_cvt_pk_f32_fp8((int)w.x, false), q1 = __builtin_amdgcn_cvt_pk_f32_fp8((int)w.x, true), q2 = __builtin_amdgcn_cvt_pk_f32_fp8((int)w.y, false), q3 = __builtin_amdgcn_cvt_pk_f32_fp8((int)w.y, true);
    a = (f32x4){q0.x, q0.y, q1.x, q1.y}; b = (f32x4){q2.x, q2.y, q3.x, q3.y}; }
__device__ __forceinline__ float bflo(unsigned w) { return __builtin_bit_cast(float, w << 16); }
__device__ __forceinline__ float bfhi(unsigned w) { return __builtin_bit_cast(float, w & 0xffff0000u); }
__device__ __forceinline__ float bf1(bf16 h) { return __builtin_bit_cast(float, ((unsigned)h) << 16); }
__device__ __forceinline__ float fast_sigmoid(float x) { return __builtin_amdgcn_rcpf(1.0f + __builtin_amdgcn_exp2f(-1.4426950409f * x)); }
__device__ __forceinline__ float gelu_tanh(float x) { const float u = x + 0.044715f * x * x * x; return x * __builtin_amdgcn_rcpf(1.0f + __builtin_amdgcn_exp2f(-2.3022082f * u)); }
__device__ __forceinline__ float wave_sum(float v) {
#pragma unroll
    for (int o = 1; o < 64; o <<= 1) v += __shfl_xor(v, o);
    return v;
}
__device__ __forceinline__ u32x4 pack8(f32x4 a, f32x4 b) { u32x4 w; w.x = pk2(a[0], a[1]); w.y = pk2(a[2], a[3]); w.z = pk2(b[0], b[1]); w.w = pk2(b[2], b[3]); return w; }
__device__ __forceinline__ void unpack8(u32x4 w, f32x4& a, f32x4& b) { a = (f32x4){bflo(w.x), bfhi(w.x), bflo(w.y), bfhi(w.y)}; b = (f32x4){bflo(w.z), bfhi(w.z), bflo(w.w), bfhi(w.w)}; }

#define XB_TMO      128
#define XB_XCNT(j)  (256  + 64 * (j))
#define XB_XSUB(j)  (1280 + 64 * (j))
#define XB_XGEN(j)  (2304 + 64 * (j))
#define XB_TOP      3328
#define XB_TOPGEN   3392
#define XCD_BAR_WORDS 3456
#define XB_SPIN_CAP (1u << 18)
__device__ __forceinline__ unsigned xb_ld(unsigned* p)              { return __hip_atomic_load(p, __ATOMIC_RELAXED, __HIP_MEMORY_SCOPE_AGENT); }
__device__ __forceinline__ unsigned xb_add(unsigned* p, unsigned v) { return __hip_atomic_fetch_add(p, v, __ATOMIC_RELAXED, __HIP_MEMORY_SCOPE_AGENT); }
__device__ __forceinline__ unsigned xb_xcc_id() { return (unsigned)__builtin_amdgcn_s_getreg((3 << 11) | 20) & 0xFu; }
#define XB_SPIN(cond, bar) do { unsigned _sp = 0; while (cond) { __builtin_amdgcn_s_sleep(1); \
    if ((++_sp & 255u) == 0u) { if (xb_ld(&(bar)[XB_TMO])) break; if (_sp > XB_SPIN_CAP) { atomicAdd(&(bar)[XB_TMO], 1u); break; } } } } while (0)
struct XcdBarrier { unsigned* bar; unsigned x; volatile LAS unsigned* st; };
__device__ __forceinline__ XcdBarrier xcd_barrier_post(unsigned* bar, volatile LAS unsigned* st) {
    XcdBarrier b; b.bar = bar; b.x = xb_xcc_id(); b.st = st;
    if (threadIdx.x == 0) (void)xb_add(&bar[XB_XCNT(b.x)], 1u);
    return b;
}
__device__ __forceinline__ void xcd_barrier_complete(unsigned* bar, unsigned x, unsigned& nloc, unsigned& nx) {
    const unsigned G = gridDim.x * gridDim.y * gridDim.z;
    unsigned sum, cnt, mine, sp = 0u;
    for (;;) {
        sum = 0u; cnt = 0u; mine = 0u;
#pragma unroll
        for (unsigned j = 0; j < 16; ++j) { const unsigned c = xb_ld(&bar[XB_XCNT(j)]); sum += c; cnt += (c > 0u) ? 1u : 0u; mine = (j == x) ? c : mine; }
        if (sum == G) break;
        __builtin_amdgcn_s_sleep(1);
        if ((++sp & 255u) == 0u) { if (xb_ld(&bar[XB_TMO])) break; if (sp > XB_SPIN_CAP) { atomicAdd(&bar[XB_TMO], 1u); break; } }
    }
    nloc = mine > 0u ? mine : 1u; nx = cnt > 0u ? cnt : 1u;
}
__device__ __forceinline__ void xcd_barrier(const XcdBarrier& b) {
    asm volatile("s_waitcnt vmcnt(0)" ::: "memory");
    __syncthreads();
    if (threadIdx.x == 0) {
        unsigned* bar = b.bar;
        __builtin_amdgcn_s_waitcnt(0);
        unsigned nloc = b.st[0], nx = b.st[1];
        if (nloc == 0u) { xcd_barrier_complete(bar, b.x, nloc, nx); b.st[0] = nloc; b.st[1] = nx; }
        const unsigned old = xb_add(&bar[XB_XSUB(b.x)], 1u);
        const unsigned gen = old / nloc;
        if (old + 1u == (gen + 1u) * nloc) {
            __builtin_amdgcn_fence(__ATOMIC_RELEASE, "agent");
            asm volatile("s_waitcnt vmcnt(0)" ::: "memory");
            const unsigned og = xb_add(&bar[XB_TOP], 1u);
            const unsigned tg = og / nx;
            if (og + 1u == (tg + 1u) * nx) xb_add(&bar[XB_TOPGEN], 1u);
            else XB_SPIN(xb_ld(&bar[XB_TOPGEN]) == tg, bar);
            __builtin_amdgcn_fence(__ATOMIC_ACQUIRE, "agent");
            xb_add(&bar[XB_XGEN(b.x)], 1u);
            asm volatile("s_waitcnt vmcnt(0)" ::: "memory");
        } else {
            XB_SPIN(xb_ld(&bar[XB_XGEN(b.x)]) == gen, bar);
            __builtin_amdgcn_fence(__ATOMIC_ACQUIRE, "agent");
            asm volatile("s_waitcnt vmcnt(0)" ::: "memory");
        }
    }
    __syncthreads();
}

namespace g8 {
constexpr int BM = 256, BK = 64, HALF = 128, HTB = HALF * BK * 2, STAGE_BYTES = 8 * HTB;
__device__ __forceinline__ int lds_byte(int r, int c) { const int st = (r >> 4) * 2 + (c >> 5), rr = r & 15, cc = c & 31, ob = rr * 64 + cc * 2; return st * 1024 + (ob ^ (((ob >> 9) & 1) << 5)); }
__device__ __forceinline__ void stage_rc(int b, int& R, int& C) { const int st = b / 1024, sb = b % 1024, swz = sb ^ (((sb >> 9) & 1) << 5); R = (st >> 1) * 16 + swz / 64; C = (st & 1) * 32 + (swz % 64) / 2; }
__device__ __forceinline__ int perm32(int rho) { const int n = rho >> 4, i = rho & 15; return 8 * (i >> 2) + 4 * n + (i & 3); }

struct Unit { int pm, pn, z, rl; const char* A; const char* B; };

typedef int v8i __attribute__((ext_vector_type(8)));
typedef int v4i __attribute__((ext_vector_type(4)));
typedef short s16x16 __attribute__((ext_vector_type(16)));
typedef s16x16 s16x16_a16 __attribute__((aligned(16)));
__device__ __forceinline__ v8i cat8(bf16x8 lo, bf16x8 hi) { const v4i a = __builtin_bit_cast(v4i, lo), b = __builtin_bit_cast(v4i, hi); return __builtin_shufflevector(a, b, 0, 1, 2, 3, 4, 5, 6, 7); }
template <class Epi, class Sched, bool GATHER, bool FP8 = false>
__device__ __forceinline__ void gemm_phase(LAS unsigned char* lds, const int Kb, const int ldaB, const int ldbB, const Sched& S, const Epi& E) {
    const int tid = threadIdx.x, wid = __builtin_amdgcn_readfirstlane(tid >> 6), lane = tid & 63, wr = wid >> 2, wc = wid & 3, fr = lane & 15, fq = lane >> 4;
    const int nt = Kb / 128;
    unsigned voffB[2], cvo[2][2], nvo[2][2]; int Rr[2], Cc[2];
#pragma unroll
    for (int i = 0; i < 2; ++i) { int R, C; stage_rc(tid * 16 + i * 8192, R, C); const int Rb = (R & ~31) + perm32(R & 31);
        voffB[i] = (unsigned)(Rb * ldbB + C * 2); Rr[i] = R; Cc[i] = C;
#pragma unroll
        for (int h = 0; h < 2; ++h) { cvo[h][i] = (unsigned)((h * HALF + R) * ldaB + C * 2); nvo[h][i] = cvo[h][i]; } }
    const size_t kstep = (size_t)(BK * 2);
    const size_t hstepB = (size_t)HALF * ldbB;
    const unsigned ldsw = (unsigned)wid * 1024u;
    const int aoff = FP8 ? lds_byte(wr * 64 + fr, (fq >> 1) * 32 + (fq & 1) * 24) : lds_byte(wr * 64 + fr, fq * 8), boff = FP8 ? lds_byte(wc * 32 + fr, (fq >> 1) * 32 + (fq & 1) * 24) : lds_byte(wc * 32 + fr, fq * 8);
    const int aoff2 = FP8 ? lds_byte(wr * 64 + fr, (fq >> 1) * 32 + 8 + (fq & 1) * 8) : 0, boff2 = FP8 ? lds_byte(wc * 32 + fr, (fq >> 1) * 32 + 8 + (fq & 1) * 8) : 0;
#define G8_SA(b, h) (((b) * 2 + (h)) * HTB)
#define G8_SB(b, h) ((4 + (b) * 2 + (h)) * HTB)
#define G8_STGB(bufoff, gbase) do { _Pragma("unroll") for (int _i = 0; _i < 2; ++_i) \
        __builtin_amdgcn_global_load_lds((const unsigned*)((const char*)(gbase) + voffB[_i]), (LAS unsigned*)(lds + (bufoff) + ldsw + _i * 8192), 16, 0, 0); } while (0)
#define G8_STGA(bufoff, gbase, VO, h) do { _Pragma("unroll") for (int _i = 0; _i < 2; ++_i) \
        __builtin_amdgcn_global_load_lds((const unsigned*)((const char*)(gbase) + VO[h][_i]), (LAS unsigned*)(lds + (bufoff) + ldsw + _i * 8192), 16, 0, 0); } while (0)
#define G8_LDA(dst, b, h) do { _Pragma("unroll") for (int m = 0; m < 4; ++m) { if constexpr (FP8) { dst##8[m] = cat8(*(const LAS bf16x8*)(lds + G8_SA(b, h) + aoff + m * 2048), *(const LAS bf16x8*)(lds + G8_SA(b, h) + aoff2 + m * 2048)); } \
        else { _Pragma("unroll") for (int k = 0; k < 2; ++k) dst[m][k] = *(const LAS bf16x8*)(lds + G8_SA(b, h) + aoff + m * 2048 + k * 1024); } } } while (0)
#define G8_LDB(dst, b, h) do { _Pragma("unroll") for (int n = 0; n < 2; ++n) { if constexpr (FP8) { dst##8[n] = cat8(*(const LAS bf16x8*)(lds + G8_SB(b, h) + boff + n * 2048), *(const LAS bf16x8*)(lds + G8_SB(b, h) + boff2 + n * 2048)); } \
        else { _Pragma("unroll") for (int k = 0; k < 2; ++k) dst[n][k] = *(const LAS bf16x8*)(lds + G8_SB(b, h) + boff + n * 2048 + k * 1024); } } } while (0)
#define G8_MMA(ai, bj, At, Bt) do { __builtin_amdgcn_s_setprio(1); _Pragma("unroll") for (int m = 0; m < 4; ++m) _Pragma("unroll") for (int n = 0; n < 2; ++n) { \
        if constexpr (FP8) asm volatile("s_nop 1\n\tv_mfma_scale_f32_16x16x128_f8f6f4 %0, %1, %2, %0, %3, %4 op_sel_hi:[0,0,0]" : "+v"(acc[ai][bj][m][n]) : "v"(Bt##8[n]), "v"(At##8[m]), "v"(sc_w), "v"(sc_a)); \
        else { _Pragma("unroll") for (int k = 0; k < 2; ++k) acc[ai][bj][m][n] = __builtin_amdgcn_mfma_f32_16x16x32_bf16(Bt[n][k], At[m][k], acc[ai][bj][m][n], 0, 0, 0); } } __builtin_amdgcn_s_setprio(0); } while (0)
#define G8_WAIT_V(n) asm volatile("s_waitcnt vmcnt(" #n ")" ::: "memory")
#define G8_WAIT_L(n) asm volatile("s_waitcnt lgkmcnt(" #n ")" ::: "memory")
#define G8_BAR __builtin_amdgcn_s_barrier()
#define G8_SCHED __builtin_amdgcn_sched_barrier(0)
    Unit cur, nxt; int ui = 0;
    if (!S.next(0, cur)) return;
    bool has_next = S.next(1, nxt);
    if constexpr (GATHER) { S.gather(cur, Rr, Cc, cvo); if (has_next) S.gather(nxt, Rr, Cc, nvo); else {
#pragma unroll
        for (int h = 0; h < 2; ++h)
#pragma unroll
            for (int i = 0; i < 2; ++i) nvo[h][i] = cvo[h][i]; } }
    f32x4 acc[2][2][4][2];
#pragma unroll
    for (int a = 0; a < 2; ++a)
#pragma unroll
        for (int b = 0; b < 2; ++b)
#pragma unroll
            for (int m = 0; m < 4; ++m)
#pragma unroll
                for (int n = 0; n < 2; ++n) acc[a][b][m][n] = (f32x4){0.f, 0.f, 0.f, 0.f};
    const int sc_w = 0x7a7a7a7a, sc_a = 0x7f7f7f7f;
    bf16x8 At[4][2], B0[2][2], B1[2][2]; v8i At8[4], B08[2], B18[2];
    const char* cA = cur.A; const char* cB = cur.B;
    G8_STGB(G8_SB(0, 0), cB); G8_STGB(G8_SB(0, 1), cB + hstepB); G8_STGA(G8_SA(0, 0), cA, cvo, 0); G8_STGA(G8_SA(0, 1), cA, cvo, 1);
    if (wr == 1) G8_BAR;
    G8_WAIT_V(2); G8_BAR;
    G8_STGB(G8_SB(1, 0), cB + kstep); G8_STGA(G8_SA(1, 0), cA + kstep, cvo, 0); G8_STGB(G8_SB(1, 1), cB + hstepB + kstep);
    G8_WAIT_V(6); G8_BAR;
    for (;;) {
        const char* nA = has_next ? nxt.A : cA; const char* nB = has_next ? nxt.B : cB;
        for (int t = 0; t < nt; t += 2) {
            const bool last = (t == nt - 2);
            const char* a1 = cA + (size_t)(t + 1) * kstep;
            const char* a2 = last ? nA : cA + (size_t)(t + 2) * kstep; const char* b2 = last ? nB : cB + (size_t)(t + 2) * kstep;
            const char* a3 = a2 + kstep; const char* b3 = b2 + kstep;
            unsigned vo2[2][2];
#pragma unroll
            for (int h = 0; h < 2; ++h)
#pragma unroll
                for (int i = 0; i < 2; ++i) vo2[h][i] = (GATHER && last) ? nvo[h][i] : cvo[h][i];
            G8_LDB(B0, 0, 0); G8_LDB(B1, 0, 1); G8_SCHED; G8_LDA(At, 0, 0); G8_STGA(G8_SA(1, 1), a1, cvo, 1);
            G8_WAIT_V(8); G8_WAIT_L(0); G8_BAR; G8_SCHED; G8_MMA(0, 0, At, B0); G8_MMA(0, 1, At, B1); G8_SCHED; G8_BAR; G8_SCHED;
            G8_LDA(At, 0, 1); G8_STGB(G8_SB(0, 0), b2); G8_STGB(G8_SB(0, 1), b2 + hstepB); G8_STGA(G8_SA(0, 0), a2, vo2, 0);
            G8_WAIT_V(8); G8_WAIT_L(0); G8_BAR; G8_SCHED; G8_MMA(1, 0, At, B0); G8_MMA(1, 1, At, B1); G8_SCHED; G8_BAR; G8_SCHED;
            G8_LDB(B0, 1, 0); G8_LDB(B1, 1, 1); G8_SCHED; G8_LDA(At, 1, 0); G8_STGA(G8_SA(0, 1), a2, vo2, 1);
            G8_WAIT_V(8); G8_WAIT_L(0); G8_BAR; G8_SCHED; G8_MMA(0, 0, At, B0); G8_MMA(0, 1, At, B1); G8_SCHED; G8_BAR; G8_SCHED;
            G8_LDA(At, 1, 1); G8_STGB(G8_SB(1, 0), b3); G8_STGB(G8_SB(1, 1), b3 + hstepB); G8_STGA(G8_SA(1, 0), a3, vo2, 0);
            G8_WAIT_V(8); G8_WAIT_L(0); G8_BAR; G8_SCHED; G8_MMA(1, 0, At, B0); G8_MMA(1, 1, At, B1); G8_SCHED; G8_BAR; G8_SCHED;
        }
        f32x4 bpre[4]; E.pre(cur, wr, wc, fr, fq, bpre);
        if (wr == 0) G8_BAR;
        Unit nn; bool has_nn = false;
        if (has_next) has_nn = S.next(ui + 2, nn);
        unsigned nnvo[2][2];
        if constexpr (GATHER) { if (has_nn) S.gather(nn, Rr, Cc, nnvo); }
        if constexpr (FP8) asm volatile("s_nop 15\n\ts_nop 15" ::: "memory");
        E(acc, cur, wr, wc, fr, fq, bpre);
        if (!has_next) break;
#pragma unroll
        for (int a = 0; a < 2; ++a)
#pragma unroll
            for (int b = 0; b < 2; ++b)
#pragma unroll
                for (int m = 0; m < 4; ++m)
#pragma unroll
                    for (int n = 0; n < 2; ++n) acc[a][b][m][n] = (f32x4){0.f, 0.f, 0.f, 0.f};
        cur = nxt; cA = nA; cB = nB; ++ui;
        if constexpr (GATHER) {
#pragma unroll
            for (int h = 0; h < 2; ++h)
#pragma unroll
                for (int i = 0; i < 2; ++i) { cvo[h][i] = nvo[h][i]; if (has_nn) nvo[h][i] = nnvo[h][i]; } }
        nxt = nn; has_next = has_nn;
        if (wr == 1) G8_BAR;
    }
    G8_WAIT_V(0);
    G8_BAR;
#undef G8_SA
#undef G8_SB
#undef G8_STGB
#undef G8_STGA
#undef G8_LDA
#undef G8_LDB
#undef G8_MMA
#undef G8_WAIT_V
#undef G8_WAIT_L
#undef G8_BAR
#undef G8_SCHED
}

struct GridOrder {
    int nM, nN, nwg, G, c; const char* A; const char* B; size_t tstepA, tstepB;
    __device__ __forceinline__ void init(int M, int N, int G_, int c_, const void* A_, const void* B_, int ldaB, int ldbB) { nM = M / BM; nN = N / BM; nwg = nM * nN; G = G_; c = c_; A = (const char*)A_; B = (const char*)B_; tstepA = (size_t)BM * ldaB; tstepB = (size_t)BM * ldbB; }
    __device__ __forceinline__ bool next(int i, Unit& u) const {
        const long L = (long)i * G + c; if (L >= nwg) return false;
        int wgid = (int)L; { const int q = nwg / 8, r = nwg % 8, xcd = wgid % 8, off = wgid / 8; wgid = (xcd < r ? xcd * (q + 1) : r * (q + 1) + (xcd - r) * q) + off; }
        const int nig = 8 * nN, gid = wgid / nig, fm = gid * 8, gsz = (nM - fm) < 8 ? (nM - fm) : 8;
        u.pm = fm + ((wgid % nig) % gsz); u.pn = (wgid % nig) / gsz; u.z = 0; u.rl = 0;
        u.A = A + (size_t)u.pm * tstepA; u.B = B + (size_t)u.pn * tstepB; return true;
    }
};
}

struct Frame {
    LAS unsigned char* lds; volatile LAS unsigned* MISC; unsigned* ctl;
    int tid, lane, wave, vcu, G;
    const float* in[34]; float* out; unsigned char* ws;
};
#define WSP(T_, off) ((T_*)(F.ws + (off)))

struct EpiInProj { static constexpr int NST = 16;
    __device__ __forceinline__ void pre(const g8::Unit& u, int, int wc, int, int fq, f32x4 (&bp)[4]) const { const int colb = u.pn * 256 + wc * 32 + 8 * fq;
#pragma unroll
        for (int bj = 0; bj < 2; ++bj)
#pragma unroll
            for (int n = 0; n < 2; ++n) bp[bj * 2 + n] = *(const f32x4*)(bias + colb + bj * 128 + 4 * n); }
    const float* bias; bf16 *xrnn, *gy, *acat, *gates;
    template <int KIND>
    __device__ __forceinline__ void run(const f32x4 (&acc)[2][2][4][2], const g8::Unit& u, int wr, int wc, int fr, int fq, const f32x4 (&bpre)[4]) const {
        const int colb = u.pn * 256 + wc * 32 + 8 * fq;
#pragma unroll
        for (int ai = 0; ai < 2; ++ai)
#pragma unroll
            for (int m = 0; m < 4; ++m) { const int t = u.pm * 256 + ai * 128 + wr * 64 + m * 16 + fr;
#pragma unroll
                for (int bj = 0; bj < 2; ++bj) { f32x4 v0 = acc[ai][bj][m][0] + bpre[bj * 2], v1 = acc[ai][bj][m][1] + bpre[bj * 2 + 1]; const int col = colb + bj * 128;
                    if (KIND == 0) { *(u32x4*)(xrnn + (size_t)t * 1024 + col) = pack8(v0, v1); }
                    else if (KIND == 1) {
#pragma unroll
                        for (int j = 0; j < 4; ++j) { v0[j] = gelu_tanh(v0[j]); v1[j] = gelu_tanh(v1[j]); }
                        *(u32x4*)(gy + (size_t)t * 1024 + (col - 1024)) = pack8(v0, v1); }
                    else if (KIND == 2) { const int cu = col - 2048, g = cu >> 4, c = cu & 15;
                        *(u32x4*)(acat + ((size_t)(g * S5M + (t >> 5)) * S5ROW + 128 + (t & 31) * 16 + c)) = pack8(v0, v1); }
                    else {
#pragma unroll
                        for (int j = 0; j < 4; ++j) { v0[j] = fast_sigmoid(v0[j]); v1[j] = fast_sigmoid(v1[j]); }
                        u32x2 w8; w8.x = pk4_fp8(v0[0], v0[1], v0[2], v0[3]); w8.y = pk4_fp8(v1[0], v1[1], v1[2], v1[3]); *(u32x2*)((unsigned char*)gates + (size_t)t * 2048 + (col - 2560)) = w8; } } }
    }
    __device__ __forceinline__ void operator()(const f32x4 (&acc)[2][2][4][2], const g8::Unit& u, int wr, int wc, int fr, int fq, const f32x4 (&bpre)[4]) const {
        const int pn = u.pn;
        if (pn < 4) run<0>(acc, u, wr, wc, fr, fq, bpre); else if (pn < 8) run<1>(acc, u, wr, wc, fr, fq, bpre); else if (pn < 10) run<2>(acc, u, wr, wc, fr, fq, bpre); else run<3>(acc, u, wr, wc, fr, fq, bpre);
    }
};
struct EpiS5A {
    __device__ __forceinline__ void pre(const g8::Unit&, int, int, int, int, f32x4 (&)[4]) const {}
    float* S;
    __device__ __forceinline__ void operator()(const f32x4 (&acc)[2][2][4][2], const g8::Unit& u, int wr, int wc, int fr, int fq, const f32x4 (&bpre)[4]) const {
        const int col = wc * 32 + 8 * fq;
#pragma unroll
        for (int ai = 0; ai < 2; ++ai)
#pragma unroll
            for (int m = 0; m < 4; ++m) { const int row = u.pm * 256 + ai * 128 + wr * 64 + m * 16 + fr; float* p = S + ((size_t)(u.z * S5M + row)) * 128 + col;
                *(f32x4*)p = acc[ai][0][m][0]; *(f32x4*)(p + 4) = acc[ai][0][m][1]; }
    }
};
struct EpiS5C {
    __device__ __forceinline__ void pre(const g8::Unit&, int, int, int, int, f32x4 (&)[4]) const {}
    bf16* ys;
    __device__ __forceinline__ void operator()(const f32x4 (&acc)[2][2][4][2], const g8::Unit& u, int wr, int wc, int fr, int fq, const f32x4 (&bpre)[4]) const {
#pragma unroll
        for (int ai = 0; ai < 2; ++ai)
#pragma unroll
            for (int m = 0; m < 4; ++m) { const int row = u.pm * 256 + ai * 128 + wr * 64 + m * 16 + fr;
#pragma unroll
                for (int bj = 0; bj < 2; ++bj) { const int n = u.pn * 256 + bj * 128 + wc * 32 + 8 * fq, i = n >> 4, c = n & 15; f32x4 v0 = acc[ai][bj][m][0], v1 = acc[ai][bj][m][1];
#pragma unroll
                    for (int j = 0; j < 4; ++j) { v0[j] = gelu_tanh(v0[j]); v1[j] = gelu_tanh(v1[j]); }
                    u32x2 w8; w8.x = pk4_fp8(v0[0], v0[1], v0[2], v0[3]); w8.y = pk4_fp8(v1[0], v1[1], v1[2], v1[3]); *(u32x2*)((unsigned char*)ys + (size_t)(row * 32 + i) * 512 + u.z * 16 + c) = w8; } }
    }
};
struct EpiGlu { static constexpr int NST = 8;
    __device__ __forceinline__ void pre(const g8::Unit&, int, int, int, int, f32x4 (&)[4]) const {}
    const bf16* gates; bf16* gb;
    __device__ __forceinline__ void operator()(const f32x4 (&acc)[2][2][4][2], const g8::Unit& u, int wr, int wc, int fr, int fq, const f32x4 (&bpre)[4]) const {
        const int f = u.pn * 128 + wc * 32 + 8 * fq;
#pragma unroll
        for (int ai = 0; ai < 2; ++ai) { u32x2 gw[4];
#pragma unroll
            for (int m = 0; m < 4; ++m) { const int t = u.pm * 256 + ai * 128 + wr * 64 + m * 16 + fr; gw[m] = *(const u32x2*)((const unsigned char*)gates + (size_t)t * 2048 + 1024 + f); }
#pragma unroll
            for (int m = 0; m < 4; ++m) { const int t = u.pm * 256 + ai * 128 + wr * 64 + m * 16 + fr;
                f32x4 g0, g1; unpack8_fp8(gw[m], g0, g1);
                f32x4 v0 = acc[ai][0][m][0], v1 = acc[ai][0][m][1]; const f32x4 s0 = acc[ai][1][m][0], s1 = acc[ai][1][m][1];
#pragma unroll
                for (int j = 0; j < 4; ++j) { v0[j] = g0[j] * v0[j] * fast_sigmoid(s0[j]); v1[j] = g1[j] * v1[j] * fast_sigmoid(s1[j]); }
                u32x2 w8; w8.x = pk4_fp8(v0[0], v0[1], v0[2], v0[3]); w8.y = pk4_fp8(v1[0], v1[1], v1[2], v1[3]); *(u32x2*)((unsigned char*)gb + (size_t)t * 1024 + f) = w8; } }
    }
};
struct EpiRnn { static constexpr int NST = 16;
    __device__ __forceinline__ void pre(const g8::Unit&, int, int, int, int, f32x4 (&)[4]) const {}
    const bf16* gates; const bf16* gb; bf16* merged;
    __device__ __forceinline__ void operator()(const f32x4 (&acc)[2][2][4][2], const g8::Unit& u, int wr, int wc, int fr, int fq, const f32x4 (&bpre)[4]) const {
#pragma unroll
        for (int ai = 0; ai < 2; ++ai)
#pragma unroll
            for (int mh = 0; mh < 2; ++mh) { u32x2 gw[2][2], bw[2][2];
#pragma unroll
                for (int mm = 0; mm < 2; ++mm) { const int t = u.pm * 256 + ai * 128 + wr * 64 + (2 * mh + mm) * 16 + fr;
#pragma unroll
                    for (int bj = 0; bj < 2; ++bj) { const int col = u.pn * 256 + bj * 128 + wc * 32 + 8 * fq; gw[mm][bj] = *(const u32x2*)((const unsigned char*)gates + (size_t)t * 2048 + col); bw[mm][bj] = *(const u32x2*)((const unsigned char*)gb + (size_t)t * 1024 + col); } }
#pragma unroll
                for (int mm = 0; mm < 2; ++mm) { const int m = 2 * mh + mm, t = u.pm * 256 + ai * 128 + wr * 64 + m * 16 + fr;
#pragma unroll
                    for (int bj = 0; bj < 2; ++bj) { const int col = u.pn * 256 + bj * 128 + wc * 32 + 8 * fq;
                        f32x4 g0, g1, b0, b1; unpack8_fp8(gw[mm][bj], g0, g1); unpack8_fp8(bw[mm][bj], b0, b1);
                        const f32x4 v0 = g0 * acc[ai][bj][m][0] + b0, v1 = g1 * acc[ai][bj][m][1] + b1;
                        u32x2 w8; w8.x = pk4_fp8(v0[0], v0[1], v0[2], v0[3]); w8.y = pk4_fp8(v1[0], v1[1], v1[2], v1[3]); *(u32x2*)((unsigned char*)merged + (size_t)t * 1024 + col) = w8; } } }
    }
};
struct EpiOut { static constexpr int NST = 16;
    const float* x; const float* mod; bf16* v1;
    __device__ __forceinline__ void pre(const g8::Unit& u, int, int wc, int, int fq, f32x4 (&bp)[4]) const { const int b = (u.pm * 256) >> 12; const float* p = mod + b * 6144 + 2048 + u.pn * 256 + wc * 32 + 8 * fq;
        bp[0] = *(const f32x4*)p; bp[1] = *(const f32x4*)(p + 4); bp[2] = *(const f32x4*)(p + 128); bp[3] = *(const f32x4*)(p + 132); }
    __device__ __forceinline__ void operator()(const f32x4 (&acc)[2][2][4][2], const g8::Unit& u, int wr, int wc, int fr, int fq, const f32x4 (&bpre)[4]) const {
#pragma unroll
        for (int ai = 0; ai < 2; ++ai)
#pragma unroll
            for (int mh = 0; mh < 2; ++mh) { f32x4 xv[2][2][2];
#pragma unroll
                for (int mm = 0; mm < 2; ++mm) { const int t = u.pm * 256 + ai * 128 + wr * 64 + (2 * mh + mm) * 16 + fr;
#pragma unroll
                    for (int bj = 0; bj < 2; ++bj) { const int col = u.pn * 256 + bj * 128 + wc * 32 + 8 * fq; xv[mm][bj][0] = *(const f32x4*)(x + (size_t)t * 1024 + col); xv[mm][bj][1] = *(const f32x4*)(x + (size_t)t * 1024 + col + 4); } }
#pragma unroll
                for (int mm = 0; mm < 2; ++mm) { const int m = 2 * mh + mm, t = u.pm * 256 + ai * 128 + wr * 64 + m * 16 + fr;
#pragma unroll
                    for (int bj = 0; bj < 2; ++bj) { const int col = u.pn * 256 + bj * 128 + wc * 32 + 8 * fq;
                        const f32x4 v0 = xv[mm][bj][0] * DN_ALPHA + (bpre[2 * bj] + 1.0f) * acc[ai][bj][m][0], v1_ = xv[mm][bj][1] * DN_ALPHA + (bpre[2 * bj + 1] + 1.0f) * acc[ai][bj][m][1];
                        *(u32x4*)(v1 + (size_t)t * 1024 + col) = pack8(v0, v1_); } } }
    }
};
struct EpiMoe1 {
    __device__ __forceinline__ void pre(const g8::Unit& u, int, int wc, int, int fq, f32x4 (&bp)[4]) const { const float* p = bgu + (size_t)u.z * 2048 + u.pn * 128 + wc * 32 + 8 * fq; bp[0] = *(const f32x4*)p; bp[1] = *(const f32x4*)(p + 4); bp[2] = *(const f32x4*)(p + 1024); bp[3] = *(const f32x4*)(p + 1028); }
    const float* bgu; bf16* act;
    __device__ __forceinline__ void operator()(const f32x4 (&acc)[2][2][4][2], const g8::Unit& u, int wr, int wc, int fr, int fq, const f32x4 (&bpre)[4]) const {
        const int f = u.pn * 128 + wc * 32 + 8 * fq; const float* bp = bgu + (size_t)u.z * 2048 + f;
        (void)bp; const f32x4 bg0 = bpre[0], bg1 = bpre[1], bu0 = bpre[2], bu1 = bpre[3];
#pragma unroll
        for (int ai = 0; ai < 2; ++ai)
#pragma unroll
            for (int m = 0; m < 4; ++m) { const int row = u.pm * 256 + ai * 128 + wr * 64 + m * 16 + fr;
                f32x4 g0 = acc[ai][0][m][0] + bg0, g1 = acc[ai][0][m][1] + bg1, u0 = acc[ai][1][m][0] + bu0, u1 = acc[ai][1][m][1] + bu1;
#pragma unroll
                for (int j = 0; j < 4; ++j) { const float ga = fminf(g0[j], 7.0f), gb_ = fminf(g1[j], 7.0f), ua = fminf(fmaxf(u0[j], -7.0f), 7.0f), ub = fminf(fmaxf(u1[j], -7.0f), 7.0f);
                    g0[j] = ga * fast_sigmoid(1.702f * ga) * (ua + 1.0f); g1[j] = gb_ * fast_sigmoid(1.702f * gb_) * (ub + 1.0f); }
                u32x2 w8; w8.x = pk4_fp8(g0[0], g0[1], g0[2], g0[3]); w8.y = pk4_fp8(g1[0], g1[1], g1[2], g1[3]); *(u32x2*)((unsigned char*)act + (size_t)row * 1024 + f) = w8; }
    }
};
struct EpiMoe2 {
    __device__ __forceinline__ void pre(const g8::Unit& u, int, int wc, int, int fq, f32x4 (&bp)[4]) const { const float* p = bd + (size_t)u.z * 1024 + u.pn * 256 + wc * 32 + 8 * fq; bp[0] = *(const f32x4*)p; bp[1] = *(const f32x4*)(p + 4); bp[2] = *(const f32x4*)(p + 128); bp[3] = *(const f32x4*)(p + 132); }
    const float* bd; bf16* yb;
    __device__ __forceinline__ void operator()(const f32x4 (&acc)[2][2][4][2], const g8::Unit& u, int wr, int wc, int fr, int fq, const f32x4 (&bpre)[4]) const {
#pragma unroll
        for (int bj = 0; bj < 2; ++bj) { const int col = u.pn * 256 + bj * 128 + wc * 32 + 8 * fq; const float* bp = bd + (size_t)u.z * 1024 + col;
            (void)bp; const f32x4 b0 = bpre[bj * 2], b1 = bpre[bj * 2 + 1];
#pragma unroll
            for (int ai = 0; ai < 2; ++ai)
#pragma unroll
                for (int m = 0; m < 4; ++m) { const int row = u.pm * 256 + ai * 128 + wr * 64 + m * 16 + fr;
                    const f32x4 y0 = acc[ai][bj][m][0] + b0, y1 = acc[ai][bj][m][1] + b1; u32x2 w8; w8.x = pk4_fp8(y0[0], y0[1], y0[2], y0[3]); w8.y = pk4_fp8(y1[0], y1[1], y1[2], y1[3]);
                    *(u32x2*)((unsigned char*)yb + (size_t)row * 1024 + col) = w8; } }
    }
};

struct S5AOrder { int G, c; const char* acat; const char* ws;
    __device__ __forceinline__ bool next(int i, g8::Unit& u) const { const int L = i * G + c; if (L >= S5G * 4) return false; u.z = L >> 2; u.pm = L & 3; u.pn = 0; u.rl = 0;
        u.A = acat + ((size_t)(u.z * S5M + u.pm * 256) * S5ROW + 128) * 2; u.B = ws + (size_t)u.z * 256 * (S5L * 16) * 2; return true; } };
struct S5COrder { int G, c; const char* acat; const char* wy;
    __device__ __forceinline__ bool next(int i, g8::Unit& u) const { const int L = i * G + c; if (L >= S5G * 8) return false; u.z = L >> 3; u.pm = (L >> 1) & 3; u.pn = L & 1; u.rl = 0;
        u.A = acat + ((size_t)(u.z * S5M + u.pm * 256) * S5ROW) * 2; u.B = wy + ((size_t)(u.z * 512 + u.pn * 256) * S5ROW) * 2; return true; } };
struct MoeOrder { int G, c, NT, RT; const LAS int* tstart; const LAS int* cnt; const int* toklist; const char* A; const char* B; size_t bstride_e; int lda; bool gatherA;
    __device__ __forceinline__ bool next(int i, g8::Unit& u) const { const int per = G >> 3, xcd = c & 7, slot = c >> 3, rpx = per / NT;
        const int rt = (i * 8 + xcd) * rpx + slot / NT; if (rt >= RT) return false; u.pn = slot % NT;
        const int lane_ = threadIdx.x & 63; const unsigned long long mk_ = __ballot(lane_ < NE && tstart[lane_ & 31] <= rt);
        const int e = __builtin_popcountll(mk_) - 1;
        u.z = e; u.pm = rt; u.rl = rt - tstart[e]; u.B = B + (size_t)e * bstride_e + (size_t)u.pn * 256 * 1024; u.A = gatherA ? A : A + (size_t)rt * 256 * 1024; return true; }
    __device__ __forceinline__ void gather(const g8::Unit& u, const int (&Rr)[2], const int (&Cc)[2], unsigned (&vo)[2][2]) const {
        const int n = cnt[u.z];
#pragma unroll
        for (int h = 0; h < 2; ++h)
#pragma unroll
            for (int i = 0; i < 2; ++i) { const int r = u.rl * 256 + h * 128 + Rr[i]; const int rc = r < n ? r : n - 1; const int tok = toklist[u.z * T + rc]; vo[h][i] = (unsigned)(tok * lda + Cc[i] * 2); } }
};

__device__ __forceinline__ void transpose_item(const float* W, int N, int k0, int n0, bf16* dst, int ldd, int drow0, LAS float* scr, int lane) {
    float wv_[32];
#pragma unroll
    for (int i = 0; i < 32; ++i) wv_[i] = W[(size_t)(k0 + 2 * i + (lane >> 5)) * N + n0 + (lane & 31)];
#pragma unroll
    for (int i = 0; i < 32; ++i) scr[(2 * i + (lane >> 5)) * 33 + (lane & 31)] = wv_[i];
    asm volatile("s_waitcnt lgkmcnt(0)" ::: "memory");
    const int c = lane & 7;
#pragma unroll
    for (int j = 0; j < 4; ++j) { const int n = (lane >> 3) + 8 * j; const LAS float* s = scr + (8 * c) * 33 + n;
        u32x4 o; o.x = pk2(s[0 * 33], s[1 * 33]); o.y = pk2(s[2 * 33], s[3 * 33]); o.z = pk2(s[4 * 33], s[5 * 33]); o.w = pk2(s[6 * 33], s[7 * 33]);
        *(u32x4*)(dst + (size_t)(drow0 + n) * ldd + k0 + 8 * c) = o; }
    asm volatile("s_waitcnt lgkmcnt(0)" ::: "memory");
}
__device__ __forceinline__ void transpose_item8(const float* W, int N, int k0, int n0, unsigned char* dst, int ldd, int drow0, LAS float* scr, int lane) {
    float wv_[32];
#pragma unroll
    for (int i = 0; i < 32; ++i) wv_[i] = W[(size_t)(k0 + 2 * i + (lane >> 5)) * N + n0 + (lane & 31)];
#pragma unroll
    for (int i = 0; i < 32; ++i) scr[(2 * i + (lane >> 5)) * 33 + (lane & 31)] = wv_[i];
    asm volatile("s_waitcnt lgkmcnt(0)" ::: "memory");
    const int c = lane & 7;
#pragma unroll
    for (int j = 0; j < 4; ++j) { const int n = (lane >> 3) + 8 * j; const LAS float* s = scr + (8 * c) * 33 + n;
        u32x2 o; o.x = pk4_fp8(32.f * s[0 * 33], 32.f * s[1 * 33], 32.f * s[2 * 33], 32.f * s[3 * 33]); o.y = pk4_fp8(32.f * s[4 * 33], 32.f * s[5 * 33], 32.f * s[6 * 33], 32.f * s[7 * 33]);
        *(u32x2*)(dst + (size_t)(drow0 + n) * ldd + k0 + 8 * c) = o; }
    asm volatile("s_waitcnt lgkmcnt(0)" ::: "memory");
}
__device__ __forceinline__ void transpose_item8w(const float* W, int N, int k0, int n0, unsigned char* dst, int ldd, int drow0, LAS float* scr, int lane) {
    float wv[64]; const float* wp = W + (size_t)(k0 + (lane >> 5)) * N + n0 + (lane & 31);
#pragma unroll
    for (int i = 0; i < 64; ++i) wv[i] = wp[(size_t)(2 * i) * N];
#pragma unroll
    for (int i = 0; i < 64; ++i) scr[(2 * i + (lane >> 5)) * 33 + (lane & 31)] = wv[i];
    asm volatile("s_waitcnt lgkmcnt(0)" ::: "memory");
    const int c = lane & 7;
#pragma unroll
    for (int j = 0; j < 4; ++j) { const int n = (lane >> 3) + 8 * j; const LAS float* s = scr + (16 * c) * 33 + n;
        u32x4 o; o.x = pk4_fp8(32.f * s[0 * 33], 32.f * s[1 * 33], 32.f * s[2 * 33], 32.f * s[3 * 33]); o.y = pk4_fp8(32.f * s[4 * 33], 32.f * s[5 * 33], 32.f * s[6 * 33], 32.f * s[7 * 33]);
        o.z = pk4_fp8(32.f * s[8 * 33], 32.f * s[9 * 33], 32.f * s[10 * 33], 32.f * s[11 * 33]); o.w = pk4_fp8(32.f * s[12 * 33], 32.f * s[13 * 33], 32.f * s[14 * 33], 32.f * s[15 * 33]);
        *(u32x4*)(dst + (size_t)(drow0 + n) * ldd + k0 + 16 * c) = o; }
    asm volatile("s_waitcnt lgkmcnt(0)" ::: "memory");
}
__device__ __forceinline__ int pair_row(int n) { const int f = n & 1023, hi = n >> 10; return (f >> 7) * 256 + hi * 128 + (f & 127); }

__device__ __forceinline__ void moe_tables(Frame& F) {
    LAS int* tstart = (LAS int*)(F.lds + TAB_OFF); LAS int* cl = tstart + 40;
    if (F.tid < 64) {
        const int e = F.lane & 31; const int c = (int)F.ctl[CW_CNT + 64 * e]; int inc = (c + 255) >> 8;
#pragma unroll
        for (int o = 1; o < 32; o <<= 1) { const int v = __shfl_up(inc, o); if ((F.lane & 31) >= o) inc += v; }
        if (F.lane < 32) { cl[e] = c; tstart[e] = inc - ((c + 255) >> 8); if (e == NE - 1) tstart[NE] = inc; }
    }
    __syncthreads();
}

__device__ __forceinline__ void p0_mod_job(Frame& F, int job) {
    LAS float* sc = (LAS float*)F.lds;
    LAS float* red = sc + 8 * 1024;
    const float* c = F.in[1]; const float* w = F.in[2]; const float* bias = F.in[3];
    for (int i = F.tid; i < 8 * 1024; i += 512) { const float v = c[i]; sc[i] = v * fast_sigmoid(v); }
    __syncthreads();
    const int col = F.tid & 31, kg = F.tid >> 5, j = job * 32 + col;
    float a[8];
#pragma unroll
    for (int b = 0; b < 8; ++b) a[b] = 0.f;
#pragma unroll 32
    for (int k = kg * 64; k < kg * 64 + 64; ++k) { const float wv = w[(size_t)k * 6144 + j];
#pragma unroll
        for (int b = 0; b < 8; ++b) a[b] += sc[b * 1024 + k] * wv; }
#pragma unroll
    for (int b = 0; b < 8; ++b) red[(kg * 8 + b) * 32 + col] = a[b];
    __syncthreads();
    if (F.tid < 256) { const int b = F.tid >> 5, cc = F.tid & 31; float s = 0.f;
#pragma unroll
        for (int g = 0; g < 16; ++g) s += red[(g * 8 + b) * 32 + cc];
        WSP(float, WS_MOD)[b * 6144 + job * 32 + cc] = s + bias[job * 32 + cc]; }
    __syncthreads();
}
__device__ __forceinline__ void s5_setup(Frame& F, int g, int kmin, int kmax, LAS f32x2* Bb, LAS f32x2* Cc, LAS f32x2* Ap) {
    const float* lre = F.in[14] + g * 64; const float* lim = F.in[15] + g * 64; const float dt = expf(F.in[16][g]);
    const float* bre = F.in[17] + g * 1024; const float* bim = F.in[18] + g * 1024; const float* cre = F.in[19] + g * 1024; const float* cim = F.in[20] + g * 1024;
    for (int i = F.tid; i < 1024; i += 512) { const int p = i >> 4; const float lr = lre[p], li = lim[p]; const float mag = expf(lr * dt); float sn, cs; sincosf(li * dt, &sn, &cs);
        const float ar = mag * cs, ai = mag * sn, den = lr * lr + li * li, qr = ((ar - 1.f) * lr + ai * li) / den, qi = (ai * lr - (ar - 1.f) * li) / den;
        const float br = bre[i], bi = bim[i]; Bb[i] = (f32x2){qr * br - qi * bi, qr * bi + qi * br};
        Cc[i] = (f32x2){cre[i], cim[i]}; }
    if (F.tid < 64) { const int p = F.tid; const float lr = lre[p], li = lim[p]; const float mag = expf(lr * dt); float sn, cs; sincosf(li * dt, &sn, &cs);
        const float ar = mag * cs, ai = mag * sn; float xr_ = 1.f, xi_ = 0.f;
        for (int k = 0; k <= kmax; ++k) { if (k >= kmin) Ap[k * 64 + p] = (f32x2){xr_, xi_}; const float nr = xr_ * ar - xi_ * ai, ni = xr_ * ai + xi_ * ar; xr_ = nr; xi_ = ni; } }
    __syncthreads();
}
constexpr size_t WS_KTAB = WS_S;
constexpr size_t WS_WRIMG = WS_AL + 512 * 1024;
__device__ __forceinline__ void p0_s5k_job(Frame& F, int job) {
    const int g = job >> 3, part = job & 7;
    LAS f32x2* Bb = (LAS f32x2*)F.lds; LAS f32x2* Cc = Bb + 1024; LAS f32x2* Ap = Cc + 1024;
    s5_setup(F, g, 4 * part, 4 * part + 3, Bb, Cc, Ap);
    float* kt = WSP(float, WS_KTAB) + (size_t)g * 32 * 256;
    for (int e = 4 * part * 256 + F.tid; e < (4 * part + 4) * 256; e += 512) { const int k = e >> 8, c = (e >> 4) & 15, c2 = e & 15; float s = 0.f;
        for (int p = 0; p < 64; ++p) { const f32x2 cv = Cc[c * 64 + p], av = Ap[k * 64 + p], bv = Bb[p * 16 + c2];
            const float car = cv.x * av.x - cv.y * av.y, cai = cv.x * av.y + cv.y * av.x; s += car * bv.x - cai * bv.y; }
        kt[e] = s; }
    __syncthreads();
}
__device__ __forceinline__ void p1_s5w_job(Frame& F, int job) {
    const int g = job >> 3, part = job & 7;
    LAS f32x2* Bb = (LAS f32x2*)F.lds; LAS f32x2* Cc = Bb + 1024; LAS f32x2* Ap = Cc + 1024; LAS float* Kt = (LAS float*)(Ap + 33 * 64);
    const float* ktg = WSP(float, WS_KTAB) + (size_t)g * 32 * 256; const float* dsk = F.in[21] + g * 16;
    for (int i = F.tid; i < 32 * 256; i += 512) Kt[i] = ktg[i];
    s5_setup(F, g, 0, S5L, Bb, Cc, Ap);
    if (part == 0 && F.tid < 64) WSP(f32x2, WS_AL)[g * 64 + F.tid] = Ap[S5L * 64 + F.tid];
    bf16* wy = WSP(bf16, WS_WY) + (size_t)g * 512 * S5ROW;
    for (int ch = F.tid; ch < 64 * (S5ROW / 8); ch += 512) { const int n = part * 64 + ch / (S5ROW / 8), k8 = (ch % (S5ROW / 8)) * 8, i = n >> 4, c = n & 15; float v[8]; const float dskc = dsk[c];
        if (k8 < 128) {
#pragma unroll
            for (int j = 0; j < 8; j += 2) { const int p = (k8 + j) >> 1; const f32x2 cv = Cc[c * 64 + p], av = Ap[(i + 1) * 64 + p]; v[j] = cv.x * av.x - cv.y * av.y; v[j + 1] = -(cv.x * av.y + cv.y * av.x); } }
        else { const int jj = (k8 - 128) >> 4, c2 = (k8 - 128) & 15;
#pragma unroll
            for (int j = 0; j < 8; ++j) { float x = 0.f; if (jj <= i) { x = Kt[(i - jj) * 256 + c * 16 + c2 + j]; x += (jj == i && c == c2 + j) ? dskc : 0.f; } v[j] = x; } }
        u32x4 o; o.x = pk2(v[0], v[1]); o.y = pk2(v[2], v[3]); o.z = pk2(v[4], v[5]); o.w = pk2(v[6], v[7]);
        *(u32x4*)(wy + (size_t)n * S5ROW + k8) = o; }
    bf16* wsm = WSP(bf16, WS_WS) + (size_t)g * 256 * 512;
    for (int ch = F.tid; ch < 32 * 64; ch += 512) { const int n = part * 32 + (ch >> 6), k8 = (ch & 63) * 8, jj = k8 >> 4, c2 = k8 & 15; float v[8];
#pragma unroll
        for (int j = 0; j < 8; ++j) { float x = 0.f; if (n < 128) { const int p = n >> 1; const f32x2 av = Ap[(S5L - 1 - jj) * 64 + p], bv = Bb[p * 16 + c2 + j]; x = (n & 1) ? (av.x * bv.y + av.y * bv.x) : (av.x * bv.x - av.y * bv.y); } v[j] = x; }
        u32x4 o; o.x = pk2(v[0], v[1]); o.y = pk2(v[2], v[3]); o.z = pk2(v[4], v[5]); o.w = pk2(v[6], v[7]);
        *(u32x4*)(wsm + (size_t)n * 512 + k8) = o; }
    __syncthreads();
}
__device__ __forceinline__ void p0_small_transposes(Frame& F) {
    LAS float* scr = (LAS float*)(F.lds + F.wave * 16384);
    const int gw = F.vcu * 8 + F.wave, NGW = F.G * 8;
    constexpr int I_IN = 16 * 144, I_RNN = 16 * 32, I_OUT = 16 * 32, I_GLU = 8 * 64, I_RG = 16 * 8;
    for (int it = gw; it < I_IN + I_RNN + I_OUT + I_GLU + I_RG; it += NGW) { int r = it;
        if (r < I_IN) { const int kb = r / 144, nb = r % 144; transpose_item8(F.in[4], INC, kb * 64, nb * 32, WSP(unsigned char, WS_WIN), 1024, nb * 32, scr, F.lane); continue; } r -= I_IN;
        if (r < I_RNN) { const int kb = r / 32, nb = r % 32; transpose_item8(F.in[13], 1024, kb * 64, nb * 32, WSP(unsigned char, WS_WRNN), 1024, nb * 32, scr, F.lane); continue; } r -= I_RNN;
        if (r < I_OUT) { const int kb = r / 32, nb = r % 32; transpose_item8(F.in[23], 1024, kb * 64, nb * 32, WSP(unsigned char, WS_WOUT), 1024, nb * 32, scr, F.lane); continue; } r -= I_OUT;
        if (r < I_GLU) { const int kb = r / 64, nb = r % 64; transpose_item8(F.in[22], 2048, kb * 64, nb * 32, WSP(unsigned char, WS_WGLU), 512, pair_row(nb * 32), scr, F.lane); continue; } r -= I_GLU;
        { const int mat = r >> 3, kb = (r >> 2) & 1, nb = r & 3, hd = mat & 7, gx = mat >> 3;
          transpose_item(F.in[gx ? 10 : 8] + (size_t)hd * 128 * 128, 128, kb * 64, nb * 32, WSP(bf16, WS_WG), 128, hd * 256 + gx * 128 + nb * 32, scr, F.lane); }
    }
}
__device__ __forceinline__ void p1_body(Frame& F) {
    const int gw = F.vcu * 8 + F.wave, NGW = F.G * 8; const float* mod = WSP(float, WS_MOD); bf16* hbf = WSP(bf16, WS_HBF);
    for (int tb = 4 * gw; tb < T; tb += 4 * NGW) {
        const int b = tb >> 12; f32x4 xv[4][4], shv[4], scv[4];
#pragma unroll
        for (int r = 0; r < 4; ++r) { const f32x4* xr = (const f32x4*)(F.in[0] + (size_t)(tb + r) * 1024) + F.lane;
#pragma unroll
            for (int j = 0; j < 4; ++j) xv[r][j] = xr[64 * j]; }
#pragma unroll
        for (int j = 0; j < 4; ++j) { shv[j] = *((const f32x4*)(mod + b * 6144) + F.lane + 64 * j); scv[j] = *((const f32x4*)(mod + b * 6144 + 1024) + F.lane + 64 * j) + 1.0f; }
#pragma unroll
        for (int r = 0; r < 4; ++r) { unsigned* o = (unsigned*)((unsigned char*)hbf + (size_t)(tb + r) * 1024) + F.lane;
#pragma unroll
            for (int j = 0; j < 4; ++j) { const f32x4 v = xv[r][j] * scv[j] + shv[j]; o[64 * j] = pk4_fp8(v[0], v[1], v[2], v[3]); } } }
    constexpr int TP = 132;
    LAS float* tile = (LAS float*)F.lds;
    constexpr int TILES_GU = 8 * 16, TILES_D = 8 * 8, TILES_E = TILES_GU + TILES_D;
    const int lr = F.tid >> 5, lc4 = (F.tid & 31) * 4, tn = F.tid >> 2, kc = F.tid & 3;
    f32x4 pre[8];
    int ti = F.vcu;
#define P1_SRC(idx, src, N_, dstp, drow0_, k0_) do { const int e_ = (idx) / TILES_E, r_ = (idx) % TILES_E; \
        if (r_ < TILES_GU) { const int kb_ = r_ >> 4, nb_ = r_ & 15; N_ = 2048; src = F.in[28] + (size_t)e_ * 1024 * 2048 + (size_t)(kb_ * 128) * 2048 + nb_ * 128; dstp = WSP(unsigned char, WS_WGU) + (size_t)e_ * 2048 * 1024; drow0_ = pair_row(nb_ * 128); k0_ = kb_ * 128; } \
        else { const int q_ = r_ - TILES_GU, kb_ = q_ >> 3, nb_ = q_ & 7; N_ = 1024; src = F.in[30] + (size_t)e_ * 1024 * 1024 + (size_t)(kb_ * 128) * 1024 + nb_ * 128; dstp = WSP(unsigned char, WS_WD) + (size_t)e_ * 1024 * 1024; drow0_ = nb_ * 128; k0_ = kb_ * 128; } } while (0)
    if (ti < NE * TILES_E) { const float* src; unsigned char* dstp; int N_, d0, k0; P1_SRC(ti, src, N_, dstp, d0, k0);
#pragma unroll
        for (int i = 0; i < 8; ++i) pre[i] = *(const f32x4*)(src + (size_t)(lr + 16 * i) * N_ + lc4); }
    for (; ti < NE * TILES_E; ti += F.G) {
#pragma unroll
        for (int i = 0; i < 8; ++i) *(LAS f32x4*)(tile + (lr + 16 * i) * TP + lc4) = pre[i];
        __syncthreads();
        const int tnx = (ti + F.G < NE * TILES_E) ? ti + F.G : ti;
        { const float* src; unsigned char* dstp; int N_, d0, k0; P1_SRC(tnx, src, N_, dstp, d0, k0);
#pragma unroll
            for (int i = 0; i < 8; ++i) pre[i] = *(const f32x4*)(src + (size_t)(lr + 16 * i) * N_ + lc4); }
        { const float* src; unsigned char* dstp; int N_, d0, k0; P1_SRC(ti, src, N_, dstp, d0, k0); (void)src; (void)N_;
          const LAS float* cp = tile + (32 * kc) * TP + tn; u32x4 o0, o1; float cv[32];
#pragma unroll
          for (int i = 0; i < 32; ++i) cv[i] = cp[i * TP];
          asm volatile("s_waitcnt lgkmcnt(0)" ::: "memory");
#pragma unroll
          for (int i = 0; i < 32; ++i) cv[i] *= 32.f;
          o0.x = pk4_fp8(cv[0], cv[1], cv[2], cv[3]); o0.y = pk4_fp8(cv[4], cv[5], cv[6], cv[7]); o0.z = pk4_fp8(cv[8], cv[9], cv[10], cv[11]); o0.w = pk4_fp8(cv[12], cv[13], cv[14], cv[15]);
          o1.x = pk4_fp8(cv[16], cv[17], cv[18], cv[19]); o1.y = pk4_fp8(cv[20], cv[21], cv[22], cv[23]); o1.z = pk4_fp8(cv[24], cv[25], cv[26], cv[27]); o1.w = pk4_fp8(cv[28], cv[29], cv[30], cv[31]);
          unsigned char* op = dstp + (size_t)(d0 + tn) * 1024 + k0 + 32 * kc; *(u32x4*)op = o0; *(u32x4*)(op + 16) = o1; }
        __syncthreads();
    }
#undef P1_SRC
}
constexpr int XR_LD = 136, XR_TILE = 128 * XR_LD;
__device__ __forceinline__ void rg_issue(const bf16* xrnn, const bf16* gy, int item, int tid, u32x4 (&xraw)[4][4], u32x4 (&graw)[4], bool pass1) {
    const int hd = item & 7, c = (item >> 3) & 31, b = item >> 8, r0 = tid >> 4, ch = hd * 128 + (tid & 15) * 8;
#pragma unroll
    for (int q = 0; q < 4; ++q) { const int r = r0 + 32 * q;
#pragma unroll
        for (int k = 0; k < 4; ++k) { const int tp = c * RGL + r - 3 + k, tpc = tp < 0 ? 0 : tp; xraw[q][k] = *(const u32x4*)(xrnn + (size_t)(b * SEQ + tpc) * 1024 + ch); }
        if (pass1) graw[q] = *(const u32x4*)(gy + (size_t)(b * SEQ + c * RGL + r) * 1024 + ch); }
}
__device__ __forceinline__ void rg_convwrite(const LAS float* cwl, int item, int tid, const u32x4 (&xraw)[4][4], const u32x4 (&graw)[4], LAS bf16* xr, LAS bf16* gyt, bool pass1) {
    const int c = (item >> 3) & 31, r0 = tid >> 4, c8 = (tid & 15) * 8;
    const f32x4 b0 = *(const LAS f32x4*)(cwl + 4 * 128 + c8), b1 = *(const LAS f32x4*)(cwl + 4 * 128 + c8 + 4);
    f32x4 w0[4], w1[4];
#pragma unroll
    for (int k = 0; k < 4; ++k) { w0[k] = *(const LAS f32x4*)(cwl + k * 128 + c8); w1[k] = *(const LAS f32x4*)(cwl + k * 128 + c8 + 4); }
#pragma unroll
    for (int q = 0; q < 4; ++q) { const int r = r0 + 32 * q; f32x4 a0 = b0, a1 = b1;
#pragma unroll
        for (int k = 0; k < 4; ++k) { const int tp = c * RGL + r - 3 + k; f32x4 x0, x1; unpack8(xraw[q][k], x0, x1); if (tp < 0) { x0 = (f32x4){0.f, 0.f, 0.f, 0.f}; x1 = x0; } a0 += w0[k] * x0; a1 += w1[k] * x1; }
        *(LAS u32x4*)(xr + r * XR_LD + c8) = pack8(a0, a1);
        if (pass1) *(LAS u32x4*)(gyt + r * XR_LD + c8) = graw[q]; }
}
template <int PASS>
__device__ __forceinline__ void rglru_phase(Frame& F) {
    const int NIT = NB * RGC * 8;
    const bool skew = (PASS == 0) && (F.G == 256);
    const int nmine = skew ? (F.vcu < 128 ? 7 : 9) : (NIT - F.vcu + F.G - 1) / F.G;
#define RG_ITEM(k) ((skew && (k) >= 7) ? (1792 + (F.vcu - 128) + 128 * ((k) - 7)) : (F.vcu + (k) * F.G))
    if (nmine <= 0) return;
    int it = RG_ITEM(0);
    LAS bf16* xr = (LAS bf16*)F.lds; LAS bf16* gyt0 = xr + XR_TILE;
    const bf16* xrnn = WSP(bf16, WS_XRNN); const bf16* gy = WSP(bf16, WS_GY); bf16* ha = WSP(bf16, WS_HA); const float* cw = F.in[6]; const float* cb = F.in[7];
    const int tid = F.tid, w = F.wave, q = F.lane >> 4, col = F.lane & 15, chl = 16 * w + col;
    u32x4 xraw[4][4], graw[4];
    LAS float* cwl = (LAS float*)(gyt0 + 2 * XR_TILE);
    for (int i = tid; i < 5 * 128; i += 512) { const int k = i >> 7, chh = (it & 7) * 128 + (i & 127); cwl[i] = (k < 4) ? cw[k * 1024 + chh] : cb[chh]; }
    rg_issue(xrnn, gy, it, tid, xraw, graw, PASS);
    __syncthreads();
    rg_convwrite(cwl, it, tid, xraw, graw, xr, gyt0, PASS);
    bf16x8 Bf[2][4]; float ba, bx, sp;
    { const int hd0 = it & 7, ch0 = hd0 * 128 + chl; const bf16* wg = WSP(bf16, WS_WG) + (size_t)hd0 * 256 * 128;
#pragma unroll
      for (int gt = 0; gt < 2; ++gt)
#pragma unroll
          for (int kk = 0; kk < 4; ++kk) Bf[gt][kk] = *(const bf16x8*)(wg + (size_t)(gt * 128 + chl) * 128 + kk * 32 + q * 8);
      ba = F.in[9][ch0]; bx = F.in[11][ch0]; const float lam = F.in[12][ch0]; sp = (lam > 15.f) ? __expf(-lam) : log1pf(__expf(-lam)); }
#pragma unroll
    for (int gt = 0; gt < 2; ++gt)
#pragma unroll
        for (int kk = 0; kk < 4; ++kk) asm volatile("" :: "v"(Bf[gt][kk]));
    asm volatile("" :: "v"(ba), "v"(bx), "v"(sp));
    __syncthreads();
    for (int i = 0; i < nmine; ++i) {
        const bool has_next = (i + 1) < nmine; const int nit = has_next ? RG_ITEM(i + 1) : it;
        const int hd = it & 7, c = (it >> 3) & 31, b = it >> 8, t0 = b * SEQ + c * RGL, ch = hd * 128 + chl;
        LAS bf16* gyt = gyt0 + (i & 1) * XR_TILE; LAS bf16* gytn = gyt0 + ((i & 1) ^ 1) * XR_TILE;
        float carryH = 0.f, carryP = 1.f;
        if (PASS) carryH = WSP(float, WS_HIN)[(size_t)(b * RGC + c) * 1024 + ch];
        __builtin_amdgcn_sched_barrier(0);
        rg_issue(xrnn, gy, nit, tid, xraw, graw, PASS);
        __builtin_amdgcn_sched_barrier(0);
        f32x4 acc[8][2];
#pragma unroll
        for (int m = 0; m < 8; ++m) { acc[m][0] = (f32x4){0.f, 0.f, 0.f, 0.f}; acc[m][1] = (f32x4){0.f, 0.f, 0.f, 0.f}; }
#pragma unroll
        for (int kk = 0; kk < 4; ++kk)
#pragma unroll
            for (int m = 0; m < 8; ++m) { const bf16x8 Af = *(const LAS bf16x8*)(xr + (16 * m + col) * XR_LD + kk * 32 + q * 8);
                acc[m][0] = __builtin_amdgcn_mfma_f32_16x16x32_bf16(Af, Bf[0][kk], acc[m][0], 0, 0, 0);
                acc[m][1] = __builtin_amdgcn_mfma_f32_16x16x32_bf16(Af, Bf[1][kk], acc[m][1], 0, 0, 0); }
#pragma unroll
        for (int m = 0; m < 8; ++m) {
            float a[4], uu[4];
#pragma unroll
            for (int j = 0; j < 4; ++j) { const int tl = 16 * m + 4 * q + j;
                const float r = fast_sigmoid(acc[m][0][j] + ba), ii = fast_sigmoid(acc[m][1][j] + bx);
                const float la = -11.541560327f * r * sp; a[j] = __builtin_amdgcn_exp2f(la); const float mult = __builtin_amdgcn_sqrtf(fmaxf(1.0f - a[j] * a[j], 0.f));
                uu[j] = mult * ii * bf1(xr[tl * XR_LD + chl]); }
            float sP = a[0], sH = uu[0];
#pragma unroll
            for (int j = 1; j < 4; ++j) { sH = a[j] * sH + uu[j]; sP *= a[j]; }
            float iP = sP, iH = sH;
            { const float pP = __shfl_up(iP, 16), pH = __shfl_up(iH, 16); if (q >= 1) { iH = iP * pH + iH; iP = iP * pP; } }
            { const float pP = __shfl_up(iP, 32), pH = __shfl_up(iH, 32); if (q >= 2) { iH = iP * pH + iH; iP = iP * pP; } }
            float eP = __shfl_up(iP, 16), eH = __shfl_up(iH, 16); if (q == 0) { eP = 1.f; eH = 0.f; }
            const float tP = __shfl(iP, col + 48), tH = __shfl(iH, col + 48);
            if (PASS) { float h = eP * carryH + eH;
#pragma unroll
                for (int j = 0; j < 4; ++j) { const int tl = 16 * m + 4 * q + j; h = a[j] * h + uu[j]; LAS bf16* gp = gyt + tl * XR_LD + chl; *gp = (bf16)f2bf(h * bf1(*gp)); } }
            carryH = tP * carryH + tH; carryP *= tP;
        }
        if (!PASS && q == 0) { f32x2* ag = WSP(f32x2, WS_RGAGG); ag[(size_t)(b * RGC + c) * 1024 + ch] = (f32x2){carryP, carryH}; }
        __syncthreads();
        if (PASS) { const int r0 = tid >> 4, c8 = (tid & 15) * 8;
#pragma unroll
            for (int qq = 0; qq < 4; ++qq) { const int r = r0 + 32 * qq; f32x4 h0, h1; unpack8(*(const LAS u32x4*)(gyt + r * XR_LD + c8), h0, h1); u32x2 w8; w8.x = pk4_fp8(h0[0], h0[1], h0[2], h0[3]); w8.y = pk4_fp8(h1[0], h1[1], h1[2], h1[3]);
                *(u32x2*)((unsigned char*)ha + (size_t)(t0 + r) * 1024 + hd * 128 + c8) = w8; } }
#pragma unroll
        for (int qq = 0; qq < 4; ++qq) {
#pragma unroll
            for (int k = 0; k < 4; ++k) asm volatile("" : "+v"(xraw[qq][k]));
            if (PASS) asm volatile("" : "+v"(graw[qq])); }
        if (has_next) rg_convwrite(cwl, nit, tid, xraw, graw, xr, gytn, PASS);
        __syncthreads();
        it = nit;
    }
#undef RG_ITEM
}
__device__ __forceinline__ void p4_carries(Frame& F) {
    LAS f32x2* seg = (LAS f32x2*)F.lds;
    for (int job = F.vcu; job < NB * S5G; job += F.G) {
        const int b = job >> 5, g = job & 31, p = F.lane, w = F.wave;
        const f32x2 al = WSP(f32x2, WS_AL)[g * 64 + p];
        const f32x2* Sb = WSP(f32x2, WS_S) + ((size_t)(g * S5M + b * S5CPB + 16 * w)) * 64 + p; unsigned* ac = (unsigned*)(WSP(bf16, WS_ACAT) + ((size_t)(g * S5M + b * S5CPB + 16 * w)) * S5ROW) + p;
        f32x2 sv[16];
#pragma unroll
        for (int i = 0; i < 16; ++i) sv[i] = Sb[(size_t)i * 64];
        float xr_ = 0.f, xi = 0.f;
#pragma unroll
        for (int i = 0; i < 16; ++i) { const float nr = al.x * xr_ - al.y * xi + sv[i].x, ni = al.x * xi + al.y * xr_ + sv[i].y; xr_ = nr; xi = ni; }
        seg[w * 64 + p] = (f32x2){xr_, xi};
        float ar = al.x, ai = al.y;
#pragma unroll
        for (int q = 0; q < 4; ++q) { const float nr = ar * ar - ai * ai, ni = 2.f * ar * ai; ar = nr; ai = ni; }
        __syncthreads();
        xr_ = 0.f; xi = 0.f;
        for (int ww = 0; ww < w; ++ww) { const f32x2 sg = seg[ww * 64 + p]; const float nr = ar * xr_ - ai * xi + sg.x, ni = ar * xi + ai * xr_ + sg.y; xr_ = nr; xi = ni; }
#pragma unroll
        for (int i = 0; i < 16; ++i) { ac[(size_t)i * (S5ROW / 2)] = pk2(xr_, xi); const float nr = al.x * xr_ - al.y * xi + sv[i].x, ni = al.x * xi + al.y * xr_ + sv[i].y; xr_ = nr; xi = ni; }
        __syncthreads();
    }
    if (F.vcu < 16) {
        const int id = F.vcu * 512 + F.tid, ch = id & 1023, b = id >> 10; const f32x2* ag = WSP(f32x2, WS_RGAGG) + (size_t)b * RGC * 1024 + ch; float* hin = WSP(float, WS_HIN) + (size_t)b * RGC * 1024 + ch;
        f32x2 a[RGC];
#pragma unroll
        for (int c = 0; c < RGC; ++c) a[c] = ag[(size_t)c * 1024];
        float h = 0.f;
#pragma unroll
        for (int c = 0; c < RGC; ++c) { hin[(size_t)c * 1024] = h; h = a[c].x * h + a[c].y; }
    }
}
constexpr int WR_LD = 1032;
__device__ __forceinline__ void p9_router(Frame& F) {
    LAS bf16* wH = (LAS bf16*)F.lds; LAS bf16* wL = wH + 32 * WR_LD;
    LAS f32x2* sel = (LAS f32x2*)(wL + 32 * WR_LD);
    LAS unsigned* rec = (LAS unsigned*)(sel + 512);
    LAS float* recp = (LAS float*)(rec + 512);
    LAS int* lcnt = (LAS int*)(recp + 512);
    LAS int* gbase = lcnt + 32;
    { const u32x4* img = WSP(u32x4, WS_WRIMG); LAS u32x4* dst = (LAS u32x4*)wH;
      for (int i = F.tid; i < 2 * 32 * WR_LD * 2 / 16; i += 512) dst[i] = img[i]; }
    if (F.tid < 32) lcnt[F.tid] = 0;
    __syncthreads();
    const float* mod = WSP(float, WS_MOD); const bf16* v1 = WSP(bf16, WS_V1); bf16* x1 = WSP(bf16, WS_X1); unsigned char* h2 = WSP(unsigned char, WS_H2);
    const int lane = F.lane, m = lane & 15, kq = lane >> 4, w = F.wave;
    for (int blk = F.vcu; blk < T / 128; blk += F.G) {
        const int t = blk * 128 + w * 16 + m, b = (blk * 128) >> 12;
        const bf16* vrow = v1 + (size_t)t * 1024 + 8 * kq;
        float sum = 0.f, sq = 0.f;
#pragma unroll 32
        for (int s_ = 0; s_ < 32; ++s_) { f32x4 a, c; unpack8(*(const u32x4*)(vrow + 32 * s_), a, c); sum += ((a[0] + a[1]) + (a[2] + a[3])) + ((c[0] + c[1]) + (c[2] + c[3]));
            sq += ((a[0] * a[0] + a[1] * a[1]) + (a[2] * a[2] + a[3] * a[3])) + ((c[0] * c[0] + c[1] * c[1]) + (c[2] * c[2] + c[3] * c[3])); }
        sum += __shfl_xor(sum, 16); sum += __shfl_xor(sum, 32); sq += __shfl_xor(sq, 16); sq += __shfl_xor(sq, 32);
        const float mean = sum * (1.f / 1024.f); const float rstd = 1.f / sqrtf(fmaxf(sq * (1.f / 1024.f) - mean * mean, 0.f) + LN_EPS);
        f32x4 acc[2] = {(f32x4){0.f, 0.f, 0.f, 0.f}, (f32x4){0.f, 0.f, 0.f, 0.f}};
        const float* lng = F.in[24] + 8 * kq; const float* lnb = F.in[25] + 8 * kq; const float* shp = mod + b * 6144 + 3072 + 8 * kq; const float* scp = mod + b * 6144 + 4096 + 8 * kq;
        bf16* x1row = x1 + (size_t)t * 1024 + 8 * kq; unsigned char* h2row = h2 + (size_t)t * 1024 + 8 * kq;
        const LAS bf16* wHr = wH + m * WR_LD + 8 * kq; const LAS bf16* wLr = wL + m * WR_LD + 8 * kq;
#pragma unroll 2
        for (int s2 = 0; s2 < 32; s2 += 2) {
            u32x4 rw[2]; f32x4 pg[2][2], pb[2][2], psh[2][2], psc[2][2];
#pragma unroll
            for (int h = 0; h < 2; ++h) { const int ko = 32 * (s2 + h); rw[h] = *(const u32x4*)(vrow + ko);
                pg[h][0] = *(const f32x4*)(lng + ko); pg[h][1] = *(const f32x4*)(lng + ko + 4); pb[h][0] = *(const f32x4*)(lnb + ko); pb[h][1] = *(const f32x4*)(lnb + ko + 4);
                psh[h][0] = *(const f32x4*)(shp + ko); psh[h][1] = *(const f32x4*)(shp + ko + 4); psc[h][0] = *(const f32x4*)(scp + ko); psc[h][1] = *(const f32x4*)(scp + ko + 4); }
#pragma unroll
            for (int h = 0; h < 2; ++h) { const int ko = 32 * (s2 + h);
                f32x4 a, c; unpack8(rw[h], a, c);
                const f32x4 x0 = (a - mean) * rstd * pg[h][0] + pb[h][0], x1v = (c - mean) * rstd * pg[h][1] + pb[h][1];
                *(u32x4*)(x1row + ko) = pack8(x0, x1v);
                const f32x4 h0 = x0 * (psc[h][0] + 1.0f) + psh[h][0], h1 = x1v * (psc[h][1] + 1.0f) + psh[h][1];
                u32x2 w8; w8.x = pk4_fp8(h0[0], h0[1], h0[2], h0[3]); w8.y = pk4_fp8(h1[0], h1[1], h1[2], h1[3]); *(u32x2*)(h2row + ko) = w8;
                const u32x4 hi = pack8(h0, h1); f32x4 r0, r1; unpack8(hi, r0, r1); const u32x4 lo = pack8(h0 - r0, h1 - r1);
                const bf16x8 ah = __builtin_bit_cast(bf16x8, hi), al = __builtin_bit_cast(bf16x8, lo);
#pragma unroll
                for (int nf = 0; nf < 2; ++nf) { const bf16x8 bh = *(const LAS bf16x8*)(wHr + nf * 16 * WR_LD + ko), bl = *(const LAS bf16x8*)(wLr + nf * 16 * WR_LD + ko);
                    acc[nf] = __builtin_amdgcn_mfma_f32_16x16x32_bf16(bh, ah, acc[nf], 0, 0, 0);
                    acc[nf] = __builtin_amdgcn_mfma_f32_16x16x32_bf16(bl, ah, acc[nf], 0, 0, 0);
                    acc[nf] = __builtin_amdgcn_mfma_f32_16x16x32_bf16(bh, al, acc[nf], 0, 0, 0); } } }
        float lv[8];
#pragma unroll
        for (int nf = 0; nf < 2; ++nf)
#pragma unroll
            for (int j = 0; j < 4; ++j) lv[nf * 4 + j] = acc[nf][j] + F.in[27][nf * 16 + 4 * kq + j];
        int rank[8];
#pragma unroll
        for (int i = 0; i < 8; ++i) { rank[i] = 0;
#pragma unroll
            for (int i2 = 0; i2 < 8; ++i2) if (i2 != i) { const int e1 = (i >> 2) * 16 + 4 * kq + (i & 3), e2 = (i2 >> 2) * 16 + 4 * kq + (i2 & 3); rank[i] += (lv[i2] > lv[i] || (lv[i2] == lv[i] && e2 < e1)) ? 1 : 0; } }
#pragma unroll
        for (int dq = 1; dq < 4; ++dq) { const int q2 = kq ^ dq;
#pragma unroll
            for (int i2 = 0; i2 < 8; ++i2) { const float o = __shfl_xor(lv[i2], 16 * dq); const int e2 = (i2 >> 2) * 16 + 4 * q2 + (i2 & 3);
#pragma unroll
                for (int i = 0; i < 8; ++i) { const int e1 = (i >> 2) * 16 + 4 * kq + (i & 3); rank[i] += (o > lv[i] || (o == lv[i] && e2 < e1)) ? 1 : 0; } } }
#pragma unroll
        for (int i = 0; i < 8; ++i) if (rank[i] < 4) { const int e1 = (i >> 2) * 16 + 4 * kq + (i & 3); sel[(w * 16 + m) * 4 + rank[i]] = (f32x2){__builtin_bit_cast(float, e1), lv[i]}; }
        asm volatile("s_waitcnt lgkmcnt(0)" ::: "memory");
        { const int tm = lane >> 2, k = lane & 3; const f32x2 s0 = sel[(w * 16 + tm) * 4 + 0], s1 = sel[(w * 16 + tm) * 4 + 1], s2 = sel[(w * 16 + tm) * 4 + 2], s3 = sel[(w * 16 + tm) * 4 + 3];
          const float p0 = 1.f, p1 = __expf(s1.y - s0.y), p2 = __expf(s2.y - s0.y), p3 = __expf(s3.y - s0.y), ps = (p0 + p1) + (p2 + p3);
          const f32x2 mine = k == 0 ? s0 : (k == 1 ? s1 : (k == 2 ? s2 : s3)); const float pm = (k == 0 ? p0 : (k == 1 ? p1 : (k == 2 ? p2 : p3))) / ps;
          const int e = __builtin_bit_cast(int, mine.x);
          const int lr = __hip_atomic_fetch_add(lcnt + e, 1, __ATOMIC_RELAXED, __HIP_MEMORY_SCOPE_WORKGROUP);
          rec[(w * 16 + tm) * 4 + k] = ((unsigned)e << 16) | (unsigned)lr; recp[(w * 16 + tm) * 4 + k] = pm; }
        __syncthreads();
        if (F.tid < 32) { const int n = lcnt[F.tid]; gbase[F.tid] = n ? (int)atomicAdd(F.ctl + CW_CNT + 64 * F.tid, (unsigned)n) : 0; lcnt[F.tid] = 0; }
        __syncthreads();
        { const unsigned r = rec[F.tid]; const int e = r >> 16, rk = gbase[e] + (int)(r & 0xffffu), tt = blk * 128 + (F.tid >> 2);
          WSP(int, WS_TOK)[(size_t)e * T + rk] = tt; WSP(unsigned, WS_POS)[(size_t)tt * 4 + (F.tid & 3)] = ((unsigned)e << 20) | (unsigned)rk; WSP(float, WS_PROB)[(size_t)tt * 4 + (F.tid & 3)] = recp[F.tid]; }
        __syncthreads();
    }
}
__device__ __forceinline__ void p12_final(Frame& F) {
    moe_tables(F);
    const LAS int* tstart = (const LAS int*)(F.lds + TAB_OFF);
    const float* mod = WSP(float, WS_MOD); const bf16* x1 = WSP(bf16, WS_X1); const bf16* yb = WSP(bf16, WS_YB); const unsigned* pos = WSP(unsigned, WS_POS); const float* prob = WSP(float, WS_PROB);
    const int lane = F.lane, gw = F.vcu * 8 + F.wave, NGW = F.G * 8;
    f32x4 lg[4], lb[4];
#pragma unroll
    for (int j = 0; j < 4; ++j) { lg[j] = *(const f32x4*)(F.in[32] + 512 * (j >> 1) + 8 * lane + 4 * (j & 1)); lb[j] = *(const f32x4*)(F.in[33] + 512 * (j >> 1) + 8 * lane + 4 * (j & 1)); }
#define P12_ROUTE(PP, PW, tt) do { const u32x4 p4_ = *(const u32x4*)(pos + (size_t)(tt) * 4); const f32x4 w4_ = *(const f32x4*)(prob + (size_t)(tt) * 4); \
        PP[0] = p4_.x; PP[1] = p4_.y; PP[2] = p4_.z; PP[3] = p4_.w; PW[0] = w4_[0]; PW[1] = w4_[1]; PW[2] = w4_[2]; PW[3] = w4_[3]; } while (0)
#define P12_ROWS(YW, XW, PP, tt) do { _Pragma("unroll") for (int k = 0; k < 4; ++k) { const int e_ = PP[k] >> 20, rk_ = PP[k] & 0xfffffu; const size_t slot_ = (size_t)tstart[e_] * 256 + rk_; \
            _Pragma("unroll") for (int j = 0; j < 2; ++j) YW[k][j] = *((const u32x2*)((const unsigned char*)yb + slot_ * 1024) + 64 * j + lane); } \
        _Pragma("unroll") for (int j = 0; j < 2; ++j) XW[j] = *((const u32x4*)(x1 + (size_t)(tt) * 1024) + 64 * j + lane); } while (0)
#define P12_COMPUTE(YW, XW, PW, tt) do { const int b_ = (tt) >> 12; f32x4 v[4]; float s_ = 0.f; \
        _Pragma("unroll") for (int j = 0; j < 2; ++j) { f32x4 f0 = (f32x4){0.f, 0.f, 0.f, 0.f}, f1 = f0; \
            _Pragma("unroll") for (int k = 0; k < 4; ++k) { const u32x2 yv_ = YW[k][j]; const f32x2 q0_ = __builtin_amdgcn_cvt_pk_f32_fp8((int)yv_.x, false), q1_ = __builtin_amdgcn_cvt_pk_f32_fp8((int)yv_.x, true), q2_ = __builtin_amdgcn_cvt_pk_f32_fp8((int)yv_.y, false), q3_ = __builtin_amdgcn_cvt_pk_f32_fp8((int)yv_.y, true); \
                f0 += (f32x4){q0_.x, q0_.y, q1_.x, q1_.y} * PW[k]; f1 += (f32x4){q2_.x, q2_.y, q3_.x, q3_.y} * PW[k]; } \
            f32x4 xa_, xc_; unpack8(XW[j], xa_, xc_); const float* gp_ = mod + b_ * 6144 + 5120 + 512 * j + 8 * lane; \
            v[2 * j] = xa_ * DN_ALPHA + (*(const f32x4*)gp_ + 1.0f) * f0; v[2 * j + 1] = xc_ * DN_ALPHA + (*(const f32x4*)(gp_ + 4) + 1.0f) * f1; \
            s_ += ((v[2 * j][0] + v[2 * j][1]) + (v[2 * j][2] + v[2 * j][3])) + ((v[2 * j + 1][0] + v[2 * j + 1][1]) + (v[2 * j + 1][2] + v[2 * j + 1][3])); } \
        const float mean_ = wave_sum(s_) * (1.f / 1024.f); float s2_ = 0.f; \
        _Pragma("unroll") for (int j = 0; j < 4; ++j) { v[j] = v[j] - mean_; s2_ += (v[j][0] * v[j][0] + v[j][1] * v[j][1]) + (v[j][2] * v[j][2] + v[j][3] * v[j][3]); } \
        const float rstd_ = 1.f / sqrtf(wave_sum(s2_) * (1.f / 1024.f) + LN_EPS); \
        _Pragma("unroll") for (int j = 0; j < 4; ++j) *(f32x4*)(F.out + (size_t)(tt) * 1024 + 512 * (j >> 1) + 8 * lane + 4 * (j & 1)) = v[j] * rstd_ * lg[j] + lb[j]; } while (0)
    const int nmine = (T - gw + NGW - 1) / NGW;
    unsigned ppA[4], ppB[4]; float pwA[4], pwB[4], pwN[4]; u32x2 ywA[4][2], ywB[4][2]; u32x4 xwA[2], xwB[2];
    if (nmine > 0) { P12_ROUTE(ppA, pwA, gw); P12_ROWS(ywA, xwA, ppA, gw); }
    if (nmine > 1) { P12_ROUTE(ppB, pwB, gw + NGW); }
    for (int i = 0; i < nmine; i += 2) {
        const int t0 = gw + i * NGW, t1 = t0 + NGW, t2 = t1 + NGW, t3 = t2 + NGW;
        if (i + 1 < nmine) { P12_ROWS(ywB, xwB, ppB, t1); }
        if (i + 2 < nmine) { P12_ROUTE(ppA, pwN, t2); }
        __builtin_amdgcn_sched_barrier(0);
        P12_COMPUTE(ywA, xwA, pwA, t0);
        if (i + 1 < nmine) {
#pragma unroll
            for (int k = 0; k < 4; ++k) pwA[k] = pwN[k];
            if (i + 2 < nmine) { P12_ROWS(ywA, xwA, ppA, t2); }
            if (i + 3 < nmine) { P12_ROUTE(ppB, pwN, t3); }
            __builtin_amdgcn_sched_barrier(0);
            P12_COMPUTE(ywB, xwB, pwB, t1);
#pragma unroll
            for (int k = 0; k < 4; ++k) pwB[k] = pwN[k];
        }
    }
#undef P12_ROUTE
#undef P12_ROWS
#undef P12_COMPUTE
}

struct Args { const float* in[34]; float* out; unsigned char* ws; int ph_lo, ph_hi; };
__global__ void __launch_bounds__(512, 2) fwd_kernel(Args args) {
    extern __shared__ __attribute__((aligned(16))) unsigned char lds_raw[];
    Frame F;
    F.lds = (LAS unsigned char*)lds_raw; F.MISC = (volatile LAS unsigned*)(F.lds + MISC_OFF);
    F.tid = threadIdx.x; F.lane = F.tid & 63; F.wave = __builtin_amdgcn_readfirstlane(F.tid >> 6);
    F.G = gridDim.x; { const int bx = blockIdx.x; F.vcu = (F.G % 8 == 0) ? (bx % 8) * (F.G / 8) + bx / 8 : bx; }
#pragma unroll
    for (int i = 0; i < 34; ++i) F.in[i] = args.in[i];
    F.out = args.out; F.ws = args.ws; F.ctl = (unsigned*)(args.ws + WS_CTL);
    if (F.tid < 64) F.MISC[F.tid] = 0u;
    __syncthreads();
    XcdBarrier bar; bar.bar = F.ctl + CW_BAR; bar.x = 0; bar.st = nullptr;
    if (MK_N_LAUNCHES == 1) bar = xcd_barrier_post(F.ctl + CW_BAR, F.MISC + 8);
    const int lo = args.ph_lo, hi = args.ph_hi;
#define IN(k) (lo <= (k) && (k) < hi)
#define SEAM(k) do { if (IN(k) && IN((k) + 1)) xcd_barrier(bar); } while (0)

    if (IN(0)) REPS(0) { if (rep_) xcd_barrier(bar);
        for (int j = F.vcu; j < 192; j += F.G) p0_mod_job(F, j);
        for (int j = F.vcu; j < S5G * 8; j += F.G) p0_s5k_job(F, j);
        { bf16* img = WSP(bf16, WS_WRIMG); const float* wr = F.in[26];
          for (int i = F.vcu * 512 + F.tid; i < 1024 * 32; i += F.G * 512) { const float w = wr[i]; const unsigned hb = f2bf(w); const float hf = __builtin_bit_cast(float, hb << 16);
              img[(i & 31) * 1032 + (i >> 5)] = (bf16)hb; img[32 * 1032 + (i & 31) * 1032 + (i >> 5)] = (bf16)f2bf(w - hf); } }
        p0_small_transposes(F);
    }
    SEAM(0);
    if (IN(1)) REPS(1) { if (rep_) xcd_barrier(bar); for (int j = F.vcu; j < S5G * 8; j += F.G) p1_s5w_job(F, j); p1_body(F); }
    SEAM(1);
    if (IN(2)) REPS(2) { if (rep_) xcd_barrier(bar);
        g8::GridOrder S; S.init(T, INC, F.G, (int)blockIdx.x, WSP(bf16, WS_HBF), WSP(bf16, WS_WIN), 1024, 1024);
        EpiInProj E{F.in[5], WSP(bf16, WS_XRNN), WSP(bf16, WS_GY), WSP(bf16, WS_ACAT), WSP(bf16, WS_GATES)};
        g8::gemm_phase<EpiInProj, g8::GridOrder, false, true>(F.lds, 1024, 1024, 1024, S, E);
    }
    SEAM(2);
    if (IN(3)) REPS(3) { if (rep_) xcd_barrier(bar);
        { S5AOrder S{F.G, F.vcu, (const char*)WSP(bf16, WS_ACAT), (const char*)WSP(bf16, WS_WS)}; EpiS5A E{WSP(float, WS_S)};
          g8::gemm_phase<EpiS5A, S5AOrder, false>(F.lds, S5L * 32, S5ROW * 2, S5L * 32, S, E); }
        __syncthreads();
        rglru_phase<0>(F);
    }
    SEAM(3);
    if (IN(4)) REPS(4) { if (rep_) xcd_barrier(bar); p4_carries(F); }
    SEAM(4);
    if (IN(5)) REPS(5) { if (rep_) xcd_barrier(bar);
        { S5COrder S{F.G, F.vcu, (const char*)WSP(bf16, WS_ACAT), (const char*)WSP(bf16, WS_WY)}; EpiS5C E{WSP(bf16, WS_YS)};
          g8::gemm_phase<EpiS5C, S5COrder, false>(F.lds, S5ROW * 2, S5ROW * 2, S5ROW * 2, S, E); }
        __syncthreads();
        rglru_phase<1>(F);
    }
    SEAM(5);
    if (IN(6)) REPS(6) { if (rep_) xcd_barrier(bar);
        g8::GridOrder S; S.init(T, 2048, F.G, (int)blockIdx.x, WSP(bf16, WS_YS), WSP(bf16, WS_WGLU), 512, 512);
        EpiGlu E{WSP(bf16, WS_GATES), WSP(bf16, WS_GB)};
        g8::gemm_phase<EpiGlu, g8::GridOrder, false, true>(F.lds, 512, 512, 512, S, E);
    }
    SEAM(6);
    if (IN(7)) REPS(7) { if (rep_) xcd_barrier(bar);
        g8::GridOrder S; S.init(T, 1024, F.G, (int)blockIdx.x, WSP(bf16, WS_HA), WSP(bf16, WS_WRNN), 1024, 1024);
        EpiRnn E{WSP(bf16, WS_GATES), WSP(bf16, WS_GB), WSP(bf16, WS_MERGED)};
        g8::gemm_phase<EpiRnn, g8::GridOrder, false, true>(F.lds, 1024, 1024, 1024, S, E);
    }
    SEAM(7);
    if (IN(8)) REPS(8) { if (rep_) xcd_barrier(bar);
        g8::GridOrder S; S.init(T, 1024, F.G, (int)blockIdx.x, WSP(bf16, WS_MERGED), WSP(bf16, WS_WOUT), 1024, 1024);
        EpiOut E{F.in[0], WSP(float, WS_MOD), WSP(bf16, WS_V1)};
        g8::gemm_phase<EpiOut, g8::GridOrder, false, true>(F.lds, 1024, 1024, 1024, S, E);
    }
    SEAM(8);
    if (IN(9)) REPS(9) { if (rep_) xcd_barrier(bar); p9_router(F); }
    SEAM(9);
    if (IN(10)) REPS(10) { if (rep_) xcd_barrier(bar);
        moe_tables(F);
        const LAS int* tstart = (const LAS int*)(F.lds + TAB_OFF);
        MoeOrder S{F.G, (int)blockIdx.x, 8, tstart[NE], tstart, tstart + 40, WSP(int, WS_TOK), (const char*)WSP(bf16, WS_H2), (const char*)WSP(bf16, WS_WGU), (size_t)2048 * 1024, 1024, true};
        EpiMoe1 E{F.in[29], WSP(bf16, WS_ACT)};
        g8::gemm_phase<EpiMoe1, MoeOrder, true, true>(F.lds, 1024, 1024, 1024, S, E);
    }
    SEAM(10);
    if (IN(11)) REPS(11) { if (rep_) xcd_barrier(bar);
        moe_tables(F);
        const LAS int* tstart = (const LAS int*)(F.lds + TAB_OFF);
        MoeOrder S{F.G, (int)blockIdx.x, 4, tstart[NE], tstart, tstart + 40, WSP(int, WS_TOK), (const char*)WSP(bf16, WS_ACT), (const char*)WSP(bf16, WS_WD), (size_t)1024 * 1024, 1024, false};
        EpiMoe2 E{F.in[31], WSP(bf16, WS_YB)};
        g8::gemm_phase<EpiMoe2, MoeOrder, false, true>(F.lds, 1024, 1024, 1024, S, E);
    }
    SEAM(11);
    if (IN(12)) REPS(12) { if (rep_) xcd_barrier(bar); p12_final(F); }
#undef IN
#undef SEAM
}

extern "C" void kernel_launch(void* const* d_in, const int* in_sizes, int n_in, void* d_out, int out_size, void* d_ws, size_t ws_size, hipStream_t stream) {
    static int grid = 0;
    if (grid == 0) {
        if (n_in != 34 || in_sizes[0] != T * D || out_size != T * D || ws_size < WS_END) { fprintf(stderr, "kernel_launch: unexpected shapes (n_in %d, ws %zu < %zu)\n", n_in, ws_size, (size_t)WS_END); grid = -1; return; }
        int dev = 0, cus = 0;
        if (hipGetDevice(&dev) != hipSuccess || hipDeviceGetAttribute(&cus, hipDeviceAttributeMultiprocessorCount, dev) != hipSuccess) { grid = -1; return; }
        if (hipFuncSetAttribute((const void*)fwd_kernel, hipFuncAttributeMaxDynamicSharedMemorySize, LDS_BYTES) != hipSuccess) { fprintf(stderr, "kernel_launch: hipFuncSetAttribute failed\n"); grid = -1; return; }
        int per_cu = 0; (void)hipOccupancyMaxActiveBlocksPerMultiprocessor(&per_cu, (const void*)fwd_kernel, 512, LDS_BYTES); (void)hipGetLastError();
        grid = cus;
    }
    if (grid < 0) return;
    (void)hipMemsetAsync((char*)d_ws + WS_CTL, 0, CTL_BYTES, stream);
    Args a{};
    for (int i = 0; i < 34; ++i) a.in[i] = (const float*)d_in[i];
    a.out = (float*)d_out; a.ws = (unsigned char*)d_ws;
    if (MK_N_LAUNCHES == 1) { a.ph_lo = 0; a.ph_hi = N_PHASES; hipLaunchKernelGGL(fwd_kernel, dim3(grid), dim3(512), LDS_BYTES, stream, a); }
    else for (int p = 0; p < N_PHASES; ++p) { a.ph_lo = p; a.ph_hi = p + 1; hipLaunchKernelGGL(fwd_kernel, dim3(grid), dim3(512), LDS_BYTES, stream, a); }
}
```

```cpp
#include <hip/hip_runtime.h>
#include <cstdio>
#include <cstdint>

#ifndef MK_N_LAUNCHES
#define MK_N_LAUNCHES 1
#endif
constexpr int N_PHASES = 13;
#ifndef DUP_PHASE
#define DUP_PHASE -1
#endif
#define REPS(k) for (int rep_ = 0; rep_ < ((DUP_PHASE == (k)) ? 2 : 1); ++rep_)

#define GAS __attribute__((address_space(1)))
#define LAS __attribute__((address_space(3)))
typedef unsigned short bf16;
typedef short bf16x8 __attribute__((ext_vector_type(8)));
typedef float f32x4 __attribute__((ext_vector_type(4)));
typedef float f32x2 __attribute__((ext_vector_type(2)));
typedef unsigned u32x4 __attribute__((ext_vector_type(4)));
typedef unsigned u32x2 __attribute__((ext_vector_type(2)));
typedef GAS unsigned gu32;

constexpr int NB = 8, SEQ = 4096, T = NB * SEQ, D = 1024, INC = 4608, NE = 32, DFF = 1024;
constexpr int S5L = 32, S5G = 32, S5ROW = 128 + S5L * 16  , S5M = T / S5L  , S5CPB = SEQ / S5L  ;
constexpr int RGL = 128, RGC = SEQ / RGL  ;
constexpr float LN_EPS = 1e-5f, DN_ALPHA = 1.189207115002721f;
constexpr int ACT_ROWS = T * 4 + NE * 256;

constexpr size_t MiB = 1u << 20;
constexpr size_t WS_XRNN = 0, WS_GY = 64 * MiB, WS_GATES = 128 * MiB, WS_V1 = 0, WS_ACT = 0;
constexpr size_t WS_HBF = 272 * MiB, WS_HA = 272 * MiB, WS_YS = 336 * MiB, WS_GB = 368 * MiB, WS_MERGED = 432 * MiB, WS_ACAT = 496 * MiB, WS_YB = 272 * MiB;
constexpr size_t WS_X1 = 544 * MiB, WS_H2 = 608 * MiB;
constexpr size_t WS_WGU = 672 * MiB, WS_WD = 800 * MiB, WS_WIN = 864 * MiB, WS_WG = 873 * MiB, WS_WRNN = 874 * MiB, WS_WGLU = 876 * MiB, WS_WOUT = 878 * MiB;
constexpr size_t WS_WS = 880 * MiB, WS_WY = 888 * MiB, WS_S = 908 * MiB;
constexpr size_t WS_MOD = 924 * MiB, WS_AL = 925 * MiB, WS_RGAGG = 926 * MiB, WS_HIN = 928 * MiB, WS_TOK = 929 * MiB, WS_POS = 933 * MiB, WS_PROB = 934 * MiB, WS_CTL = 935 * MiB;
constexpr size_t WS_END = 936 * MiB, CTL_BYTES = 1 * MiB;
static_assert((size_t)ACT_ROWS * DFF * 2 <= 272 * MiB, "act/yb size");
static_assert(WS_ACAT + (size_t)S5G * S5M * S5ROW * 2 <= WS_X1, "acat");
constexpr int CW_BAR = 4096, CW_CNT = 8192  ;

constexpr int LDS_BYTES = 147456, MISC_OFF = LDS_BYTES - 256, TAB_OFF = 131072 + 1024;

__device__ __forceinline__ unsigned f2bf(float f) { unsigned u = __builtin_bit_cast(unsigned, f); return (u + 0x7fffu + ((u >> 16) & 1u)) >> 16; }
typedef __bf16 bf16x2v __attribute__((ext_vector_type(2)));
__device__ __forceinline__ unsigned pk2(float lo, float hi) { const f32x2 v = {lo, hi}; const bf16x2v b = __builtin_convertvector(v, bf16x2v); return __builtin_bit_cast(unsigned, b); }
__device__ __forceinline__ unsigned pk4_fp8(float a, float b, float c, float d) { a = __builtin_amdgcn_fmed3f(a, -448.f, 448.f); b = __builtin_amdgcn_fmed3f(b, -448.f, 448.f); c = __builtin_amdgcn_fmed3f(c, -448.f, 448.f); d = __builtin_amdgcn_fmed3f(d, -448.f, 448.f); int w = 0; w = __builtin_amdgcn_cvt_pk_fp8_f32(a, b, w, false); w = __builtin_amdgcn_cvt_pk_fp8_f32(c, d, w, true); return (unsigned)w; }
__device__ __forceinline__ void unpack8_fp8(u32x2 w, f32x4& a, f32x4& b) { const f32x2 q0 = __builtin_amdgcn_cvt_pk_f32_fp8((int)w.x, false), q1 = __builtin_amdgcn_cvt_pk_f32_fp8((int)w.x, true), q2 = __builtin_amdgcn_cvt_pk_f32_fp8((int)w.y, false), q3 = __builtin_amdgcn_cvt_pk_f32_fp8((int)w.y, true);
    a = (f32x4){q0.x, q0.y, q1.x, q1.y}; b = (f32x4){q2.x, q2.y, q3.x, q3.y}; }
__device__ __forceinline__ float bflo(unsigned w) { return __builtin_bit_cast(float, w << 16); }
__device__ __forceinline__ float bfhi(unsigned w) { return __builtin_bit_cast(float, w & 0xffff0000u); }
__device__ __forceinline__ float bf1(bf16 h) { return __builtin_bit_cast(float, ((unsigned)h) << 16); }
__device__ __forceinline__ float fast_sigmoid(float x) { return __builtin_amdgcn_rcpf(1.0f + __builtin_amdgcn_exp2f(-1.4426950409f * x)); }
__device__ __forceinline__ float gelu_tanh(float x) { const float u = x + 0.044715f * x * x * x; return x * __builtin_amdgcn_rcpf(1.0f + __builtin_amdgcn_exp2f(-2.3022082f * u)); }
__device__ __forceinline__ float wave_sum(float v) {
#pragma unroll
    for (int o = 1; o < 64; o <<= 1) v += __shfl_xor(v, o);
    return v;
}
__device__ __forceinline__ u32x4 pack8(f32x4 a, f32x4 b) { u32x4 w; w.x = pk2(a[0], a[1]); w.y = pk2(a[2], a[3]); w.z = pk2(b[0], b[1]); w.w = pk2(b[2], b[3]); return w; }
__device__ __forceinline__ void unpack8(u32x4 w, f32x4& a, f32x4& b) { a = (f32x4){bflo(w.x), bfhi(w.x), bflo(w.y), bfhi(w.y)}; b = (f32x4){bflo(w.z), bfhi(w.z), bflo(w.w), bfhi(w.w)}; }

#define XB_TMO      128
#define XB_XCNT(j)  (256  + 64 * (j))
#define XB_XSUB(j)  (1280 + 64 * (j))
#define XB_XGEN(j)  (2304 + 64 * (j))
#define XB_TOP      3328
#define XB_TOPGEN   3392
#define XCD_BAR_WORDS 3456
#define XB_SPIN_CAP (1u << 18)
__device__ __forceinline__ unsigned xb_ld(unsigned* p)              { return __hip_atomic_load(p, __ATOMIC_RELAXED, __HIP_MEMORY_SCOPE_AGENT); }
__device__ __forceinline__ unsigned xb_add(unsigned* p, unsigned v) { return __hip_atomic_fetch_add(p, v, __ATOMIC_RELAXED, __HIP_MEMORY_SCOPE_AGENT); }
__device__ __forceinline__ unsigned xb_xcc_id() { return (unsigned)__builtin_amdgcn_s_getreg((3 << 11) | 20) & 0xFu; }
#define XB_SPIN(cond, bar) do { unsigned _sp = 0; while (cond) { __builtin_amdgcn_s_sleep(1); \
    if ((++_sp & 255u) == 0u) { if (xb_ld(&(bar)[XB_TMO])) break; if (_sp > XB_SPIN_CAP) { atomicAdd(&(bar)[XB_TMO], 1u); break; } } } } while (0)
struct XcdBarrier { unsigned* bar; unsigned x; volatile LAS unsigned* st; };
__device__ __forceinline__ XcdBarrier xcd_barrier_post(unsigned* bar, volatile LAS unsigned* st) {
    XcdBarrier b; b.bar = bar; b.x = xb_xcc_id(); b.st = st;
    if (threadIdx.x == 0) (void)xb_add(&bar[XB_XCNT(b.x)], 1u);
    return b;
}
__device__ __forceinline__ void xcd_barrier_complete(unsigned* bar, unsigned x, unsigned& nloc, unsigned& nx) {
    const unsigned G = gridDim.x * gridDim.y * gridDim.z;
    unsigned sum, cnt, mine, sp = 0u;
    for (;;) {
        sum = 0u; cnt = 0u; mine = 0u;
#pragma unroll
        for (unsigned j = 0; j < 16; ++j) { const unsigned c = xb_ld(&bar[XB_XCNT(j)]); sum += c; cnt += (c > 0u) ? 1u : 0u; mine = (j == x) ? c : mine; }
        if (sum == G) break;
        __builtin_amdgcn_s_sleep(1);
        if ((++sp & 255u) == 0u) { if (xb_ld(&bar[XB_TMO])) break; if (sp > XB_SPIN_CAP) { atomicAdd(&bar[XB_TMO], 1u); break; } }
    }
    nloc = mine > 0u ? mine : 1u; nx = cnt > 0u ? cnt : 1u;
}
__device__ __forceinline__ void xcd_barrier(const XcdBarrier& b) {
    asm volatile("s_waitcnt vmcnt(0)" ::: "memory");
    __syncthreads();
    if (threadIdx.x == 0) {
        unsigned* bar = b.bar;
        __builtin_amdgcn_s_waitcnt(0);
        unsigned nloc = b.st[0], nx = b.st[1];
        if (nloc == 0u) { xcd_barrier_complete(bar, b.x, nloc, nx); b.st[0] = nloc; b.st[1] = nx; }
        const unsigned old = xb_add(&bar[XB_XSUB(b.x)], 1u);
        const unsigned gen = old / nloc;
        if (old + 1u == (gen + 1u) * nloc) {
            __builtin_amdgcn_fence(__ATOMIC_RELEASE, "agent");
            asm volatile("s_waitcnt vmcnt(0)" ::: "memory");
            const unsigned og = xb_add(&bar[XB_TOP], 1u);
            const unsigned tg = og / nx;
            if (og + 1u == (tg + 1u) * nx) xb_add(&bar[XB_TOPGEN], 1u);
            else XB_SPIN(xb_ld(&bar[XB_TOPGEN]) == tg, bar);
            __builtin_amdgcn_fence(__ATOMIC_ACQUIRE, "agent");
            xb_add(&bar[XB_XGEN(b.x)], 1u);
            asm volatile("s_waitcnt vmcnt(0)" ::: "memory");
        } else {
            XB_SPIN(xb_ld(&bar[XB_XGEN(b.x)]) == gen, bar);
            __builtin_amdgcn_fence(__ATOMIC_ACQUIRE, "agent");
            asm volatile("s_waitcnt vmcnt(0)" ::: "memory");
        }
    }
    __syncthreads();
}

namespace g8 {
constexpr int BM = 256, BK = 64, HALF = 128, HTB = HALF * BK * 2, STAGE_BYTES = 8 * HTB;
__device__ __forceinline__ int lds_byte(int r, int c) { const int st = (r >> 4) * 2 + (c >> 5), rr = r & 15, cc = c & 31, ob = rr * 64 + cc * 2; return st * 1024 + (ob ^ (((ob >> 9) & 1) << 5)); }
__device__ __forceinline__ void stage_rc(int b, int& R, int& C) { const int st = b / 1024, sb = b % 1024, swz = sb ^ (((sb >> 9) & 1) << 5); R = (st >> 1) * 16 + swz / 64; C = (st & 1) * 32 + (swz % 64) / 2; }
__device__ __forceinline__ int perm32(int rho) { const int n = rho >> 4, i = rho & 15; return 8 * (i >> 2) + 4 * n + (i & 3); }

struct Unit { int pm, pn, z, rl; const char* A; const char* B; };

typedef int v8i __attribute__((ext_vector_type(8)));
typedef int v4i __attribute__((ext_vector_type(4)));
typedef short s16x16 __attribute__((ext_vector_type(16)));
typedef s16x16 s16x16_a16 __attribute__((aligned(16)));
__device__ __forceinline__ v8i cat8(bf16x8 lo, bf16x8 hi) { const v4i a = __builtin_bit_cast(v4i, lo), b = __builtin_bit_cast(v4i, hi); return __builtin_shufflevector(a, b, 0, 1, 2, 3, 4, 5, 6, 7); }
template <class Epi, class Sched, bool GATHER, bool FP8 = false>
__device__ __forceinline__ void gemm_phase(LAS unsigned char* lds, const int Kb, const int ldaB, const int ldbB, const Sched& S, const Epi& E) {
    const int tid = threadIdx.x, wid = __builtin_amdgcn_readfirstlane(tid >> 6), lane = tid & 63, wr = wid >> 2, wc = wid & 3, fr = lane & 15, fq = lane >> 4;
    const int nt = Kb / 128;
    unsigned voffB[2], cvo[2][2], nvo[2][2]; int Rr[2], Cc[2];
#pragma unroll
    for (int i = 0; i < 2; ++i) { int R, C; stage_rc(tid * 16 + i * 8192, R, C); const int Rb = (R & ~31) + perm32(R & 31);
        voffB[i] = (unsigned)(Rb * ldbB + C * 2); Rr[i] = R; Cc[i] = C;
#pragma unroll
        for (int h = 0; h < 2; ++h) { cvo[h][i] = (unsigned)((h * HALF + R) * ldaB + C * 2); nvo[h][i] = cvo[h][i]; } }
    const size_t kstep = (size_t)(BK * 2);
    const size_t hstepB = (size_t)HALF * ldbB;
    const unsigned ldsw = (unsigned)wid * 1024u;
    const int aoff = FP8 ? lds_byte(wr * 64 + fr, (fq >> 1) * 32 + (fq & 1) * 24) : lds_byte(wr * 64 + fr, fq * 8), boff = FP8 ? lds_byte(wc * 32 + fr, (fq >> 1) * 32 + (fq & 1) * 24) : lds_byte(wc * 32 + fr, fq * 8);
    const int aoff2 = FP8 ? lds_byte(wr * 64 + fr, (fq >> 1) * 32 + 8 + (fq & 1) * 8) : 0, boff2 = FP8 ? lds_byte(wc * 32 + fr, (fq >> 1) * 32 + 8 + (fq & 1) * 8) : 0;
#define G8_SA(b, h) (((b) * 2 + (h)) * HTB)
#define G8_SB(b, h) ((4 + (b) * 2 + (h)) * HTB)
#define G8_STGB(bufoff, gbase) do { _Pragma("unroll") for (int _i = 0; _i < 2; ++_i) \
        __builtin_amdgcn_global_load_lds((const unsigned*)((const char*)(gbase) + voffB[_i]), (LAS unsigned*)(lds + (bufoff) + ldsw + _i * 8192), 16, 0, 0); } while (0)
#define G8_STGA(bufoff, gbase, VO, h) do { _Pragma("unroll") for (int _i = 0; _i < 2; ++_i) \
        __builtin_amdgcn_global_load_lds((const unsigned*)((const char*)(gbase) + VO[h][_i]), (LAS unsigned*)(lds + (bufoff) + ldsw + _i * 8192), 16, 0, 0); } while (0)
#define G8_LDA(dst, b, h) do { _Pragma("unroll") for (int m = 0; m < 4; ++m) { if constexpr (FP8) { dst##8[m] = cat8(*(const LAS bf16x8*)(lds + G8_SA(b, h) + aoff + m * 2048), *(const LAS bf16x8*)(lds + G8_SA(b, h) + aoff2 + m * 2048)); } \
        else { _Pragma("unroll") for (int k = 0; k < 2; ++k) dst[m][k] = *(const LAS bf16x8*)(lds + G8_SA(b, h) + aoff + m * 2048 + k * 1024); } } } while (0)
#define G8_LDB(dst, b, h) do { _Pragma("unroll") for (int n = 0; n < 2; ++n) { if constexpr (FP8) { dst##8[n] = cat8(*(const LAS bf16x8*)(lds + G8_SB(b, h) + boff + n * 2048), *(const LAS bf16x8*)(lds + G8_SB(b, h) + boff2 + n * 2048)); } \
        else { _Pragma("unroll") for (int k = 0; k < 2; ++k) dst[n][k] = *(const LAS bf16x8*)(lds + G8_SB(b, h) + boff + n * 2048 + k * 1024); } } } while (0)
#define G8_MMA(ai, bj, At, Bt) do { __builtin_amdgcn_s_setprio(1); _Pragma("unroll") for (int m = 0; m < 4; ++m) _Pragma("unroll") for (int n = 0; n < 2; ++n) { \
        if constexpr (FP8) asm volatile("s_nop 1\n\tv_mfma_scale_f32_16x16x128_f8f6f4 %0, %1, %2, %0, %3, %4 op_sel_hi:[0,0,0]" : "+v"(acc[ai][bj][m][n]) : "v"(Bt##8[n]), "v"(At##8[m]), "v"(sc_w), "v"(sc_a)); \
        else { _Pragma("unroll") for (int k = 0; k < 2; ++k) acc[ai][bj][m][n] = __builtin_amdgcn_mfma_f32_16x16x32_bf16(Bt[n][k], At[m][k], acc[ai][bj][m][n], 0, 0, 0); } } __builtin_amdgcn_s_setprio(0); } while (0)
#define G8_WAIT_V(n) asm volatile("s_waitcnt vmcnt(" #n ")" ::: "memory")
#define G8_WAIT_L(n) asm volatile("s_waitcnt lgkmcnt(" #n ")" ::: "memory")
#define G8_BAR __builtin_amdgcn_s_barrier()
#define G8_SCHED __builtin_amdgcn_sched_barrier(0)
    Unit cur, nxt; int ui = 0;
    if (!S.next(0, cur)) return;
    bool has_next = S.next(1, nxt);
    if constexpr (GATHER) { S.gather(cur, Rr, Cc, cvo); if (has_next) S.gather(nxt, Rr, Cc, nvo); else {
#pragma unroll
        for (int h = 0; h < 2; ++h)
#pragma unroll
            for (int i = 0; i < 2; ++i) nvo[h][i] = cvo[h][i]; } }
    f32x4 acc[2][2][4][2];
#pragma unroll
    for (int a = 0; a < 2; ++a)
#pragma unroll
        for (int b = 0; b < 2; ++b)
#pragma unroll
            for (int m = 0; m < 4; ++m)
#pragma unroll
                for (int n = 0; n < 2; ++n) acc[a][b][m][n] = (f32x4){0.f, 0.f, 0.f, 0.f};
    const int sc_w = 0x7a7a7a7a, sc_a = 0x7f7f7f7f;
    bf16x8 At[4][2], B0[2][2], B1[2][2]; v8i At8[4], B08[2], B18[2];
    const char* cA = cur.A; const char* cB = cur.B;
    G8_STGB(G8_SB(0, 0), cB); G8_STGB(G8_SB(0, 1), cB + hstepB); G8_STGA(G8_SA(0, 0), cA, cvo, 0); G8_STGA(G8_SA(0, 1), cA, cvo, 1);
    if (wr == 1) G8_BAR;
    G8_WAIT_V(2); G8_BAR;
    G8_STGB(G8_SB(1, 0), cB + kstep); G8_STGA(G8_SA(1, 0), cA + kstep, cvo, 0); G8_STGB(G8_SB(1, 1), cB + hstepB + kstep);
    G8_WAIT_V(6); G8_BAR;
    for (;;) {
        const char* nA = has_next ? nxt.A : cA; const char* nB = has_next ? nxt.B : cB;
        for (int t = 0; t < nt; t += 2) {
            const bool last = (t == nt - 2);
            const char* a1 = cA + (size_t)(t + 1) * kstep;
            const char* a2 = last ? nA : cA + (size_t)(t + 2) * kstep; const char* b2 = last ? nB : cB + (size_t)(t + 2) * kstep;
            const char* a3 = a2 + kstep; const char* b3 = b2 + kstep;
            unsigned vo2[2][2];
#pragma unroll
            for (int h = 0; h < 2; ++h)
#pragma unroll
                for (int i = 0; i < 2; ++i) vo2[h][i] = (GATHER && last) ? nvo[h][i] : cvo[h][i];
            G8_LDB(B0, 0, 0); G8_LDB(B1, 0, 1); G8_SCHED; G8_LDA(At, 0, 0); G8_STGA(G8_SA(1, 1), a1, cvo, 1);
            G8_WAIT_V(8); G8_WAIT_L(0); G8_BAR; G8_SCHED; G8_MMA(0, 0, At, B0); G8_MMA(0, 1, At, B1); G8_SCHED; G8_BAR; G8_SCHED;
            G8_LDA(At, 0, 1); G8_STGB(G8_SB(0, 0), b2); G8_STGB(G8_SB(0, 1), b2 + hstepB); G8_STGA(G8_SA(0, 0), a2, vo2, 0);
            G8_WAIT_V(8); G8_WAIT_L(0); G8_BAR; G8_SCHED; G8_MMA(1, 0, At, B0); G8_MMA(1, 1, At, B1); G8_SCHED; G8_BAR; G8_SCHED;
            G8_LDB(B0, 1, 0); G8_LDB(B1, 1, 1); G8_SCHED; G8_LDA(At, 1, 0); G8_STGA(G8_SA(0, 1), a2, vo2, 1);
            G8_WAIT_V(8); G8_WAIT_L(0); G8_BAR; G8_SCHED; G8_MMA(0, 0, At, B0); G8_MMA(0, 1, At, B1); G8_SCHED; G8_BAR; G8_SCHED;
            G8_LDA(At, 1, 1); G8_STGB(G8_SB(1, 0), b3); G8_STGB(G8_SB(1, 1), b3 + hstepB); G8_STGA(G8_SA(1, 0), a3, vo2, 0);
            G8_WAIT_V(8); G8_WAIT_L(0); G8_BAR; G8_SCHED; G8_MMA(1, 0, At, B0); G8_MMA(1, 1, At, B1); G8_SCHED; G8_BAR; G8_SCHED;
        }
        f32x4 bpre[4]; E.pre(cur, wr, wc, fr, fq, bpre);
        if (wr == 0) G8_BAR;
        Unit nn; bool has_nn = false;
        if (has_next) has_nn = S.next(ui + 2, nn);
        unsigned nnvo[2][2];
        if constexpr (GATHER) { if (has_nn) S.gather(nn, Rr, Cc, nnvo); }
        if constexpr (FP8) asm volatile("s_nop 15\n\ts_nop 15" ::: "memory");
        E(acc, cur, wr, wc, fr, fq, bpre);
        if (!has_next) break;
#pragma unroll
        for (int a = 0; a < 2; ++a)
#pragma unroll
            for (int b = 0; b < 2; ++b)
#pragma unroll
                for (int m = 0; m < 4; ++m)
#pragma unroll
                    for (int n = 0; n < 2; ++n) acc[a][b][m][n] = (f32x4){0.f, 0.f, 0.f, 0.f};
        cur = nxt; cA = nA; cB = nB; ++ui;
        if constexpr (GATHER) {
#pragma unroll
            for (int h = 0; h < 2; ++h)
#pragma unroll
                for (int i = 0; i < 2; ++i) { cvo[h][i] = nvo[h][i]; if (has_nn) nvo[h][i] = nnvo[h][i]; } }
        nxt = nn; has_next = has_nn;
        if (wr == 1) G8_BAR;
    }
    G8_WAIT_V(0);
    G8_BAR;
#undef G8_SA
#undef G8_SB
#undef G8_STGB
#undef G8_STGA
#undef G8_LDA
#undef G8_LDB
#undef G8_MMA
#undef G8_WAIT_V
#undef G8_WAIT_L
#undef G8_BAR
#undef G8_SCHED
}

struct GridOrder {
    int nM, nN, nwg, G, c; const char* A; const char* B; size_t tstepA, tstepB;
    __device__ __forceinline__ void init(int M, int N, int G_, int c_, const void* A_, const void* B_, int ldaB, int ldbB) { nM = M / BM; nN = N / BM; nwg = nM * nN; G = G_; c = c_; A = (const char*)A_; B = (const char*)B_; tstepA = (size_t)BM * ldaB; tstepB = (size_t)BM * ldbB; }
    __device__ __forceinline__ bool next(int i, Unit& u) const {
        const long L = (long)i * G + c; if (L >= nwg) return false;
        int wgid = (int)L; { const int q = nwg / 8, r = nwg % 8, xcd = wgid % 8, off = wgid / 8; wgid = (xcd < r ? xcd * (q + 1) : r * (q + 1) + (xcd - r) * q) + off; }
        const int nig = 8 * nN, gid = wgid / nig, fm = gid * 8, gsz = (nM - fm) < 8 ? (nM - fm) : 8;
        u.pm = fm + ((wgid % nig) % gsz); u.pn = (wgid % nig) / gsz; u.z = 0; u.rl = 0;
        u.A = A + (size_t)u.pm * tstepA; u.B = B + (size_t)u.pn * tstepB; return true;
    }
};
}

struct Frame {
    LAS unsigned char* lds; volatile LAS unsigned* MISC; unsigned* ctl;
    int tid, lane, wave, vcu, G;
    const float* in[34]; float* out; unsigned char* ws;
};
#define WSP(T_, off) ((T_*)(F.ws + (off)))

struct EpiInProj { static constexpr int NST = 16;
    __device__ __forceinline__ void pre(const g8::Unit& u, int, int wc, int, int fq, f32x4 (&bp)[4]) const { const int colb = u.pn * 256 + wc * 32 + 8 * fq;
#pragma unroll
        for (int bj = 0; bj < 2; ++bj)
#pragma unroll
            for (int n = 0; n < 2; ++n) bp[bj * 2 + n] = *(const f32x4*)(bias + colb + bj * 128 + 4 * n); }
    const float* bias; bf16 *xrnn, *gy, *acat, *gates;
    template <int KIND>
    __device__ __forceinline__ void run(const f32x4 (&acc)[2][2][4][2], const g8::Unit& u, int wr, int wc, int fr, int fq, const f32x4 (&bpre)[4]) const {
        const int colb = u.pn * 256 + wc * 32 + 8 * fq;
#pragma unroll
        for (int ai = 0; ai < 2; ++ai)
#pragma unroll
            for (int m = 0; m < 4; ++m) { const int t = u.pm * 256 + ai * 128 + wr * 64 + m * 16 + fr;
#pragma unroll
                for (int bj = 0; bj < 2; ++bj) { f32x4 v0 = acc[ai][bj][m][0] + bpre[bj * 2], v1 = acc[ai][bj][m][1] + bpre[bj * 2 + 1]; const int col = colb + bj * 128;
                    if (KIND == 0) { *(u32x4*)(xrnn + (size_t)t * 1024 + col) = pack8(v0, v1); }
                    else if (KIND == 1) {
#pragma unroll
                        for (int j = 0; j < 4; ++j) { v0[j] = gelu_tanh(v0[j]); v1[j] = gelu_tanh(v1[j]); }
                        u32x2 w8; w8.x = pk4_fp8(v0[0], v0[1], v0[2], v0[3]); w8.y = pk4_fp8(v1[0], v1[1], v1[2], v1[3]); *(u32x2*)((unsigned char*)gy + (size_t)t * 1024 + (col - 1024)) = w8; }
                    else if (KIND == 2) { const int cu = col - 2048, g = cu >> 4, c = cu & 15;
                        *(u32x4*)(acat + ((size_t)(g * S5M + (t >> 5)) * S5ROW + 128 + (t & 31) * 16 + c)) = pack8(v0, v1); }
                    else {
#pragma unroll
                        for (int j = 0; j < 4; ++j) { v0[j] = fast_sigmoid(v0[j]); v1[j] = fast_sigmoid(v1[j]); }
                        u32x2 w8; w8.x = pk4_fp8(v0[0], v0[1], v0[2], v0[3]); w8.y = pk4_fp8(v1[0], v1[1], v1[2], v1[3]); *(u32x2*)((unsigned char*)gates + (size_t)t * 2048 + (col - 2560)) = w8; } } }
    }
    __device__ __forceinline__ void operator()(const f32x4 (&acc)[2][2][4][2], const g8::Unit& u, int wr, int wc, int fr, int fq, const f32x4 (&bpre)[4]) const {
        const int pn = u.pn;
        if (pn < 4) run<0>(acc, u, wr, wc, fr, fq, bpre); else if (pn < 8) run<1>(acc, u, wr, wc, fr, fq, bpre); else if (pn < 10) run<2>(acc, u, wr, wc, fr, fq, bpre); else run<3>(acc, u, wr, wc, fr, fq, bpre);
    }
};
struct EpiS5A {
    __device__ __forceinline__ void pre(const g8::Unit&, int, int, int, int, f32x4 (&)[4]) const {}
    float* S;
    __device__ __forceinline__ void operator()(const f32x4 (&acc)[2][2][4][2], const g8::Unit& u, int wr, int wc, int fr, int fq, const f32x4 (&bpre)[4]) const {
        const int col = wc * 32 + 8 * fq;
#pragma unroll
        for (int ai = 0; ai < 2; ++ai)
#pragma unroll
            for (int m = 0; m < 4; ++m) { const int row = u.pm * 256 + ai * 128 + wr * 64 + m * 16 + fr; float* p = S + ((size_t)(u.z * S5M + row)) * 128 + col;
                *(f32x4*)p = acc[ai][0][m][0]; *(f32x4*)(p + 4) = acc[ai][0][m][1]; }
    }
};
struct EpiS5C {
    __device__ __forceinline__ void pre(const g8::Unit&, int, int, int, int, f32x4 (&)[4]) const {}
    bf16* ys;
    __device__ __forceinline__ void operator()(const f32x4 (&acc)[2][2][4][2], const g8::Unit& u, int wr, int wc, int fr, int fq, const f32x4 (&bpre)[4]) const {
#pragma unroll
        for (int ai = 0; ai < 2; ++ai)
#pragma unroll
            for (int m = 0; m < 4; ++m) { const int row = u.pm * 256 + ai * 128 + wr * 64 + m * 16 + fr;
#pragma unroll
                for (int bj = 0; bj < 2; ++bj) { const int n = u.pn * 256 + bj * 128 + wc * 32 + 8 * fq, i = n >> 4, c = n & 15; f32x4 v0 = acc[ai][bj][m][0], v1 = acc[ai][bj][m][1];
#pragma unroll
                    for (int j = 0; j < 4; ++j) { v0[j] = gelu_tanh(v0[j]); v1[j] = gelu_tanh(v1[j]); }
                    u32x2 w8; w8.x = pk4_fp8(v0[0], v0[1], v0[2], v0[3]); w8.y = pk4_fp8(v1[0], v1[1], v1[2], v1[3]); *(u32x2*)((unsigned char*)ys + (size_t)(row * 32 + i) * 512 + u.z * 16 + c) = w8; } }
    }
};
struct EpiGlu { static constexpr int NST = 8;
    __device__ __forceinline__ void pre(const g8::Unit&, int, int, int, int, f32x4 (&)[4]) const {}
    const bf16* gates; bf16* gb;
    __device__ __forceinline__ void operator()(const f32x4 (&acc)[2][2][4][2], const g8::Unit& u, int wr, int wc, int fr, int fq, const f32x4 (&bpre)[4]) const {
        const int f = u.pn * 128 + wc * 32 + 8 * fq;
#pragma unroll
        for (int ai = 0; ai < 2; ++ai) { u32x2 gw[4];
#pragma unroll
            for (int m = 0; m < 4; ++m) { const int t = u.pm * 256 + ai * 128 + wr * 64 + m * 16 + fr; gw[m] = *(const u32x2*)((const unsigned char*)gates + (size_t)t * 2048 + 1024 + f); }
#pragma unroll
            for (int m = 0; m < 4; ++m) { const int t = u.pm * 256 + ai * 128 + wr * 64 + m * 16 + fr;
                f32x4 g0, g1; unpack8_fp8(gw[m], g0, g1);
                f32x4 v0 = acc[ai][0][m][0], v1 = acc[ai][0][m][1]; const f32x4 s0 = acc[ai][1][m][0], s1 = acc[ai][1][m][1];
#pragma unroll
                for (int j = 0; j < 4; ++j) { v0[j] = g0[j] * v0[j] * fast_sigmoid(s0[j]); v1[j] = g1[j] * v1[j] * fast_sigmoid(s1[j]); }
                u32x2 w8; w8.x = pk4_fp8(v0[0], v0[1], v0[2], v0[3]); w8.y = pk4_fp8(v1[0], v1[1], v1[2], v1[3]); *(u32x2*)((unsigned char*)gb + (size_t)t * 1024 + f) = w8; } }
    }
};
struct EpiRnn { static constexpr int NST = 16;
    __device__ __forceinline__ void pre(const g8::Unit&, int, int, int, int, f32x4 (&)[4]) const {}
    const bf16* gates; const bf16* gb; bf16* merged;
    __device__ __forceinline__ void operator()(const f32x4 (&acc)[2][2][4][2], const g8::Unit& u, int wr, int wc, int fr, int fq, const f32x4 (&bpre)[4]) const {
#pragma unroll
        for (int ai = 0; ai < 2; ++ai)
#pragma unroll
            for (int mh = 0; mh < 2; ++mh) { u32x2 gw[2][2], bw[2][2];
#pragma unroll
                for (int mm = 0; mm < 2; ++mm) { const int t = u.pm * 256 + ai * 128 + wr * 64 + (2 * mh + mm) * 16 + fr;
#pragma unroll
                    for (int bj = 0; bj < 2; ++bj) { const int col = u.pn * 256 + bj * 128 + wc * 32 + 8 * fq; gw[mm][bj] = *(const u32x2*)((const unsigned char*)gates + (size_t)t * 2048 + col); bw[mm][bj] = *(const u32x2*)((const unsigned char*)gb + (size_t)t * 1024 + col); } }
#pragma unroll
                for (int mm = 0; mm < 2; ++mm) { const int m = 2 * mh + mm, t = u.pm * 256 + ai * 128 + wr * 64 + m * 16 + fr;
#pragma unroll
                    for (int bj = 0; bj < 2; ++bj) { const int col = u.pn * 256 + bj * 128 + wc * 32 + 8 * fq;
                        f32x4 g0, g1, b0, b1; unpack8_fp8(gw[mm][bj], g0, g1); unpack8_fp8(bw[mm][bj], b0, b1);
                        const f32x4 v0 = g0 * acc[ai][bj][m][0] + b0, v1 = g1 * acc[ai][bj][m][1] + b1;
                        u32x2 w8; w8.x = pk4_fp8(v0[0], v0[1], v0[2], v0[3]); w8.y = pk4_fp8(v1[0], v1[1], v1[2], v1[3]); *(u32x2*)((unsigned char*)merged + (size_t)t * 1024 + col) = w8; } } }
    }
};
struct EpiOut { static constexpr int NST = 16;
    const float* x; const float* mod; bf16* v1;
    __device__ __forceinline__ void pre(const g8::Unit& u, int, int wc, int, int fq, f32x4 (&bp)[4]) const { const int b = (u.pm * 256) >> 12; const float* p = mod + b * 6144 + 2048 + u.pn * 256 + wc * 32 + 8 * fq;
        bp[0] = *(const f32x4*)p; bp[1] = *(const f32x4*)(p + 4); bp[2] = *(const f32x4*)(p + 128); bp[3] = *(const f32x4*)(p + 132); }
    __device__ __forceinline__ void operator()(const f32x4 (&acc)[2][2][4][2], const g8::Unit& u, int wr, int wc, int fr, int fq, const f32x4 (&bpre)[4]) const {
#pragma unroll
        for (int ai = 0; ai < 2; ++ai)
#pragma unroll
            for (int mh = 0; mh < 2; ++mh) { f32x4 xv[2][2][2];
#pragma unroll
                for (int mm = 0; mm < 2; ++mm) { const int t = u.pm * 256 + ai * 128 + wr * 64 + (2 * mh + mm) * 16 + fr;
#pragma unroll
                    for (int bj = 0; bj < 2; ++bj) { const int col = u.pn * 256 + bj * 128 + wc * 32 + 8 * fq; xv[mm][bj][0] = *(const f32x4*)(x + (size_t)t * 1024 + col); xv[mm][bj][1] = *(const f32x4*)(x + (size_t)t * 1024 + col + 4); } }
#pragma unroll
                for (int mm = 0; mm < 2; ++mm) { const int m = 2 * mh + mm, t = u.pm * 256 + ai * 128 + wr * 64 + m * 16 + fr;
#pragma unroll
                    for (int bj = 0; bj < 2; ++bj) { const int col = u.pn * 256 + bj * 128 + wc * 32 + 8 * fq;
                        const f32x4 v0 = xv[mm][bj][0] * DN_ALPHA + (bpre[2 * bj] + 1.0f) * acc[ai][bj][m][0], v1_ = xv[mm][bj][1] * DN_ALPHA + (bpre[2 * bj + 1] + 1.0f) * acc[ai][bj][m][1];
                        *(u32x4*)(v1 + (size_t)t * 1024 + col) = pack8(v0, v1_); } } }
    }
};
struct EpiMoe1 {
    __device__ __forceinline__ void pre(const g8::Unit& u, int, int wc, int, int fq, f32x4 (&bp)[4]) const { const float* p = bgu + (size_t)u.z * 2048 + u.pn * 128 + wc * 32 + 8 * fq; bp[0] = *(const f32x4*)p; bp[1] = *(const f32x4*)(p + 4); bp[2] = *(const f32x4*)(p + 1024); bp[3] = *(const f32x4*)(p + 1028); }
    const float* bgu; bf16* act;
    __device__ __forceinline__ void operator()(const f32x4 (&acc)[2][2][4][2], const g8::Unit& u, int wr, int wc, int fr, int fq, const f32x4 (&bpre)[4]) const {
        const int f = u.pn * 128 + wc * 32 + 8 * fq; const float* bp = bgu + (size_t)u.z * 2048 + f;
        (void)bp; const f32x4 bg0 = bpre[0], bg1 = bpre[1], bu0 = bpre[2], bu1 = bpre[3];
#pragma unroll
        for (int ai = 0; ai < 2; ++ai)
#pragma unroll
            for (int m = 0; m < 4; ++m) { const int row = u.pm * 256 + ai * 128 + wr * 64 + m * 16 + fr;
                f32x4 g0 = acc[ai][0][m][0] + bg0, g1 = acc[ai][0][m][1] + bg1, u0 = acc[ai][1][m][0] + bu0, u1 = acc[ai][1][m][1] + bu1;
#pragma unroll
                for (int j = 0; j < 4; ++j) { const float ga = fminf(g0[j], 7.0f), gb_ = fminf(g1[j], 7.0f), ua = fminf(fmaxf(u0[j], -7.0f), 7.0f), ub = fminf(fmaxf(u1[j], -7.0f), 7.0f);
                    g0[j] = ga * fast_sigmoid(1.702f * ga) * (ua + 1.0f); g1[j] = gb_ * fast_sigmoid(1.702f * gb_) * (ub + 1.0f); }
                u32x2 w8; w8.x = pk4_fp8(g0[0], g0[1], g0[2], g0[3]); w8.y = pk4_fp8(g1[0], g1[1], g1[2], g1[3]); *(u32x2*)((unsigned char*)act + (size_t)row * 1024 + f) = w8; }
    }
};
struct EpiMoe2 {
    __device__ __forceinline__ void pre(const g8::Unit& u, int, int wc, int, int fq, f32x4 (&bp)[4]) const { const float* p = bd + (size_t)u.z * 1024 + u.pn * 256 + wc * 32 + 8 * fq; bp[0] = *(const f32x4*)p; bp[1] = *(const f32x4*)(p + 4); bp[2] = *(const f32x4*)(p + 128); bp[3] = *(const f32x4*)(p + 132); }
    const float* bd; bf16* yb;
    __device__ __forceinline__ void operator()(const f32x4 (&acc)[2][2][4][2], const g8::Unit& u, int wr, int wc, int fr, int fq, const f32x4 (&bpre)[4]) const {
#pragma unroll
        for (int bj = 0; bj < 2; ++bj) { const int col = u.pn * 256 + bj * 128 + wc * 32 + 8 * fq; const float* bp = bd + (size_t)u.z * 1024 + col;
            (void)bp; const f32x4 b0 = bpre[bj * 2], b1 = bpre[bj * 2 + 1];
#pragma unroll
            for (int ai = 0; ai < 2; ++ai)
#pragma unroll
                for (int m = 0; m < 4; ++m) { const int row = u.pm * 256 + ai * 128 + wr * 64 + m * 16 + fr;
                    const f32x4 y0 = acc[ai][bj][m][0] + b0, y1 = acc[ai][bj][m][1] + b1; u32x2 w8; w8.x = pk4_fp8(y0[0], y0[1], y0[2], y0[3]); w8.y = pk4_fp8(y1[0], y1[1], y1[2], y1[3]);
                    *(u32x2*)((unsigned char*)yb + (size_t)row * 1024 + col) = w8; } }
    }
};

struct S5AOrder { int G, c; const char* acat; const char* ws;
    __device__ __forceinline__ bool next(int i, g8::Unit& u) const { const int L = i * G + c; if (L >= S5G * 4) return false; u.z = L >> 2; u.pm = L & 3; u.pn = 0; u.rl = 0;
        u.A = acat + ((size_t)(u.z * S5M + u.pm * 256) * S5ROW + 128) * 2; u.B = ws + (size_t)u.z * 256 * (S5L * 16) * 2; return true; } };
struct S5COrder { int G, c; const char* acat; const char* wy;
    __device__ __forceinline__ bool next(int i, g8::Unit& u) const { const int L = i * G + c; if (L >= S5G * 8) return false; u.z = L >> 3; u.pm = (L >> 1) & 3; u.pn = L & 1; u.rl = 0;
        u.A = acat + ((size_t)(u.z * S5M + u.pm * 256) * S5ROW) * 2; u.B = wy + ((size_t)(u.z * 512 + u.pn * 256) * S5ROW) * 2; return true; } };
struct MoeOrder { int G, c, NT, RT; const LAS int* tstart; const LAS int* cnt; const int* toklist; const char* A; const char* B; size_t bstride_e; int lda; bool gatherA;
    __device__ __forceinline__ bool next(int i, g8::Unit& u) const { const int per = G >> 3, xcd = c & 7, slot = c >> 3, rpx = per / NT;
        const int rt = (i * 8 + xcd) * rpx + slot / NT; if (rt >= RT) return false; u.pn = slot % NT;
        const int lane_ = threadIdx.x & 63; const unsigned long long mk_ = __ballot(lane_ < NE && tstart[lane_ & 31] <= rt);
        const int e = __builtin_popcountll(mk_) - 1;
        u.z = e; u.pm = rt; u.rl = rt - tstart[e]; u.B = B + (size_t)e * bstride_e + (size_t)u.pn * 256 * 1024; u.A = gatherA ? A : A + (size_t)rt * 256 * 1024; return true; }
    __device__ __forceinline__ void gather(const g8::Unit& u, const int (&Rr)[2], const int (&Cc)[2], unsigned (&vo)[2][2]) const {
        const int n = cnt[u.z];
#pragma unroll
        for (int h = 0; h < 2; ++h)
#pragma unroll
            for (int i = 0; i < 2; ++i) { const int r = u.rl * 256 + h * 128 + Rr[i]; const int rc = r < n ? r : n - 1; const int tok = toklist[u.z * T + rc]; vo[h][i] = (unsigned)(tok * lda + Cc[i] * 2); } }
};

__device__ __forceinline__ void transpose_item(const float* W, int N, int k0, int n0, bf16* dst, int ldd, int drow0, LAS float* scr, int lane) {
    float wv_[32];
#pragma unroll
    for (int i = 0; i < 32; ++i) wv_[i] = W[(size_t)(k0 + 2 * i + (lane >> 5)) * N + n0 + (lane & 31)];
#pragma unroll
    for (int i = 0; i < 32; ++i) scr[(2 * i + (lane >> 5)) * 33 + (lane & 31)] = wv_[i];
    asm volatile("s_waitcnt lgkmcnt(0)" ::: "memory");
    const int c = lane & 7;
#pragma unroll
    for (int j = 0; j < 4; ++j) { const int n = (lane >> 3) + 8 * j; const LAS float* s = scr + (8 * c) * 33 + n;
        u32x4 o; o.x = pk2(s[0 * 33], s[1 * 33]); o.y = pk2(s[2 * 33], s[3 * 33]); o.z = pk2(s[4 * 33], s[5 * 33]); o.w = pk2(s[6 * 33], s[7 * 33]);
        *(u32x4*)(dst + (size_t)(drow0 + n) * ldd + k0 + 8 * c) = o; }
    asm volatile("s_waitcnt lgkmcnt(0)" ::: "memory");
}
__device__ __forceinline__ void transpose_item8(const float* W, int N, int k0, int n0, unsigned char* dst, int ldd, int drow0, LAS float* scr, int lane) {
    float wv_[32];
#pragma unroll
    for (int i = 0; i < 32; ++i) wv_[i] = W[(size_t)(k0 + 2 * i + (lane >> 5)) * N + n0 + (lane & 31)];
#pragma unroll
    for (int i = 0; i < 32; ++i) scr[(2 * i + (lane >> 5)) * 33 + (lane & 31)] = wv_[i];
    asm volatile("s_waitcnt lgkmcnt(0)" ::: "memory");
    const int c = lane & 7;
#pragma unroll
    for (int j = 0; j < 4; ++j) { const int n = (lane >> 3) + 8 * j; const LAS float* s = scr + (8 * c) * 33 + n;
        u32x2 o; o.x = pk4_fp8(32.f * s[0 * 33], 32.f * s[1 * 33], 32.f * s[2 * 33], 32.f * s[3 * 33]); o.y = pk4_fp8(32.f * s[4 * 33], 32.f * s[5 * 33], 32.f * s[6 * 33], 32.f * s[7 * 33]);
        *(u32x2*)(dst + (size_t)(drow0 + n) * ldd + k0 + 8 * c) = o; }
    asm volatile("s_waitcnt lgkmcnt(0)" ::: "memory");
}
__device__ __forceinline__ void transpose_item8w(const float* W, int N, int k0, int n0, unsigned char* dst, int ldd, int drow0, LAS float* scr, int lane) {
    float wv[64]; const float* wp = W + (size_t)(k0 + (lane >> 5)) * N + n0 + (lane & 31);
#pragma unroll
    for (int i = 0; i < 64; ++i) wv[i] = wp[(size_t)(2 * i) * N];
#pragma unroll
    for (int i = 0; i < 64; ++i) scr[(2 * i + (lane >> 5)) * 33 + (lane & 31)] = wv[i];
    asm volatile("s_waitcnt lgkmcnt(0)" ::: "memory");
    const int c = lane & 7;
#pragma unroll
    for (int j = 0; j < 4; ++j) { const int n = (lane >> 3) + 8 * j; const LAS float* s = scr + (16 * c) * 33 + n;
        u32x4 o; o.x = pk4_fp8(32.f * s[0 * 33], 32.f * s[1 * 33], 32.f * s[2 * 33], 32.f * s[3 * 33]); o.y = pk4_fp8(32.f * s[4 * 33], 32.f * s[5 * 33], 32.f * s[6 * 33], 32.f * s[7 * 33]);
        o.z = pk4_fp8(32.f * s[8 * 33], 32.f * s[9 * 33], 32.f * s[10 * 33], 32.f * s[11 * 33]); o.w = pk4_fp8(32.f * s[12 * 33], 32.f * s[13 * 33], 32.f * s[14 * 33], 32.f * s[15 * 33]);
        *(u32x4*)(dst + (size_t)(drow0 + n) * ldd + k0 + 16 * c) = o; }
    asm volatile("s_waitcnt lgkmcnt(0)" ::: "memory");
}
__device__ __forceinline__ int pair_row(int n) { const int f = n & 1023, hi = n >> 10; return (f >> 7) * 256 + hi * 128 + (f & 127); }

__device__ __forceinline__ void moe_tables(Frame& F) {
    LAS int* tstart = (LAS int*)(F.lds + TAB_OFF); LAS int* cl = tstart + 40;
    if (F.tid < 64) {
        const int e = F.lane & 31; const int c = (int)F.ctl[CW_CNT + 64 * e]; int inc = (c + 255) >> 8;
#pragma unroll
        for (int o = 1; o < 32; o <<= 1) { const int v = __shfl_up(inc, o); if ((F.lane & 31) >= o) inc += v; }
        if (F.lane < 32) { cl[e] = c; tstart[e] = inc - ((c + 255) >> 8); if (e == NE - 1) tstart[NE] = inc; }
    }
    __syncthreads();
}

__device__ __forceinline__ void p0_mod_job(Frame& F, int job) {
    LAS float* sc = (LAS float*)F.lds;
    LAS float* red = sc + 8 * 1024;
    const float* c = F.in[1]; const float* w = F.in[2]; const float* bias = F.in[3];
    for (int i = F.tid; i < 8 * 1024; i += 512) { const float v = c[i]; sc[i] = v * fast_sigmoid(v); }
    __syncthreads();
    const int col = F.tid & 31, kg = F.tid >> 5, j = job * 32 + col;
    float a[8];
#pragma unroll
    for (int b = 0; b < 8; ++b) a[b] = 0.f;
#pragma unroll 32
    for (int k = kg * 64; k < kg * 64 + 64; ++k) { const float wv = w[(size_t)k * 6144 + j];
#pragma unroll
        for (int b = 0; b < 8; ++b) a[b] += sc[b * 1024 + k] * wv; }
#pragma unroll
    for (int b = 0; b < 8; ++b) red[(kg * 8 + b) * 32 + col] = a[b];
    __syncthreads();
    if (F.tid < 256) { const int b = F.tid >> 5, cc = F.tid & 31; float s = 0.f;
#pragma unroll
        for (int g = 0; g < 16; ++g) s += red[(g * 8 + b) * 32 + cc];
        WSP(float, WS_MOD)[b * 6144 + job * 32 + cc] = s + bias[job * 32 + cc]; }
    __syncthreads();
}
__device__ __forceinline__ void s5_setup(Frame& F, int g, int kmin, int kmax, LAS f32x2* Bb, LAS f32x2* Cc, LAS f32x2* Ap) {
    const float* lre = F.in[14] + g * 64; const float* lim = F.in[15] + g * 64; const float dt = expf(F.in[16][g]);
    const float* bre = F.in[17] + g * 1024; const float* bim = F.in[18] + g * 1024; const float* cre = F.in[19] + g * 1024; const float* cim = F.in[20] + g * 1024;
    for (int i = F.tid; i < 1024; i += 512) { const int p = i >> 4; const float lr = lre[p], li = lim[p]; const float mag = expf(lr * dt); float sn, cs; sincosf(li * dt, &sn, &cs);
        const float ar = mag * cs, ai = mag * sn, den = lr * lr + li * li, qr = ((ar - 1.f) * lr + ai * li) / den, qi = (ai * lr - (ar - 1.f) * li) / den;
        const float br = bre[i], bi = bim[i]; Bb[i] = (f32x2){qr * br - qi * bi, qr * bi + qi * br};
        Cc[i] = (f32x2){cre[i], cim[i]}; }
    if (F.tid < 64) { const int p = F.tid; const float lr = lre[p], li = lim[p]; const float mag = expf(lr * dt); float sn, cs; sincosf(li * dt, &sn, &cs);
        const float ar = mag * cs, ai = mag * sn; float xr_ = 1.f, xi_ = 0.f;
        for (int k = 0; k <= kmax; ++k) { if (k >= kmin) Ap[k * 64 + p] = (f32x2){xr_, xi_}; const float nr = xr_ * ar - xi_ * ai, ni = xr_ * ai + xi_ * ar; xr_ = nr; xi_ = ni; } }
    __syncthreads();
}
constexpr size_t WS_KTAB = WS_S;
constexpr size_t WS_WRIMG = WS_AL + 512 * 1024;
__device__ __forceinline__ void p0_s5k_job(Frame& F, int job) {
    const int g = job >> 3, part = job & 7;
    LAS f32x2* Bb = (LAS f32x2*)F.lds; LAS f32x2* Cc = Bb + 1024; LAS f32x2* Ap = Cc + 1024;
    s5_setup(F, g, 4 * part, 4 * part + 3, Bb, Cc, Ap);
    float* kt = WSP(float, WS_KTAB) + (size_t)g * 32 * 256;
    for (int e = 4 * part * 256 + F.tid; e < (4 * part + 4) * 256; e += 512) { const int k = e >> 8, c = (e >> 4) & 15, c2 = e & 15; float s = 0.f;
        for (int p = 0; p < 64; ++p) { const f32x2 cv = Cc[c * 64 + p], av = Ap[k * 64 + p], bv = Bb[p * 16 + c2];
            const float car = cv.x * av.x - cv.y * av.y, cai = cv.x * av.y + cv.y * av.x; s += car * bv.x - cai * bv.y; }
        kt[e] = s; }
    __syncthreads();
}
__device__ __forceinline__ void p1_s5w_job(Frame& F, int job) {
    const int g = job >> 3, part = job & 7;
    LAS f32x2* Bb = (LAS f32x2*)F.lds; LAS f32x2* Cc = Bb + 1024; LAS f32x2* Ap = Cc + 1024; LAS float* Kt = (LAS float*)(Ap + 33 * 64);
    const float* ktg = WSP(float, WS_KTAB) + (size_t)g * 32 * 256; const float* dsk = F.in[21] + g * 16;
    for (int i = F.tid; i < 32 * 256; i += 512) Kt[i] = ktg[i];
    s5_setup(F, g, 0, S5L, Bb, Cc, Ap);
    if (part == 0 && F.tid < 64) WSP(f32x2, WS_AL)[g * 64 + F.tid] = Ap[S5L * 64 + F.tid];
    bf16* wy = WSP(bf16, WS_WY) + (size_t)g * 512 * S5ROW;
    for (int ch = F.tid; ch < 64 * (S5ROW / 8); ch += 512) { const int n = part * 64 + ch / (S5ROW / 8), k8 = (ch % (S5ROW / 8)) * 8, i = n >> 4, c = n & 15; float v[8]; const float dskc = dsk[c];
        if (k8 < 128) {
#pragma unroll
            for (int j = 0; j < 8; j += 2) { const int p = (k8 + j) >> 1; const f32x2 cv = Cc[c * 64 + p], av = Ap[(i + 1) * 64 + p]; v[j] = cv.x * av.x - cv.y * av.y; v[j + 1] = -(cv.x * av.y + cv.y * av.x); } }
        else { const int jj = (k8 - 128) >> 4, c2 = (k8 - 128) & 15;
#pragma unroll
            for (int j = 0; j < 8; ++j) { float x = 0.f; if (jj <= i) { x = Kt[(i - jj) * 256 + c * 16 + c2 + j]; x += (jj == i && c == c2 + j) ? dskc : 0.f; } v[j] = x; } }
        u32x4 o; o.x = pk2(v[0], v[1]); o.y = pk2(v[2], v[3]); o.z = pk2(v[4], v[5]); o.w = pk2(v[6], v[7]);
        *(u32x4*)(wy + (size_t)n * S5ROW + k8) = o; }
    bf16* wsm = WSP(bf16, WS_WS) + (size_t)g * 256 * 512;
    for (int ch = F.tid; ch < 32 * 64; ch += 512) { const int n = part * 32 + (ch >> 6), k8 = (ch & 63) * 8, jj = k8 >> 4, c2 = k8 & 15; float v[8];
#pragma unroll
        for (int j = 0; j < 8; ++j) { float x = 0.f; if (n < 128) { const int p = n >> 1; const f32x2 av = Ap[(S5L - 1 - jj) * 64 + p], bv = Bb[p * 16 + c2 + j]; x = (n & 1) ? (av.x * bv.y + av.y * bv.x) : (av.x * bv.x - av.y * bv.y); } v[j] = x; }
        u32x4 o; o.x = pk2(v[0], v[1]); o.y = pk2(v[2], v[3]); o.z = pk2(v[4], v[5]); o.w = pk2(v[6], v[7]);
        *(u32x4*)(wsm + (size_t)n * 512 + k8) = o; }
    __syncthreads();
}
__device__ __forceinline__ void p0_small_transposes(Frame& F) {
    LAS float* scr = (LAS float*)(F.lds + F.wave * 16384);
    const int gw = F.vcu * 8 + F.wave, NGW = F.G * 8;
    constexpr int I_IN = 16 * 144, I_RNN = 16 * 32, I_OUT = 16 * 32, I_GLU = 8 * 64, I_RG = 16 * 8;
    for (int it = gw; it < I_IN + I_RNN + I_OUT + I_GLU + I_RG; it += NGW) { int r = it;
        if (r < I_IN) { const int kb = r / 144, nb = r % 144; transpose_item8(F.in[4], INC, kb * 64, nb * 32, WSP(unsigned char, WS_WIN), 1024, nb * 32, scr, F.lane); continue; } r -= I_IN;
        if (r < I_RNN) { const int kb = r / 32, nb = r % 32; transpose_item8(F.in[13], 1024, kb * 64, nb * 32, WSP(unsigned char, WS_WRNN), 1024, nb * 32, scr, F.lane); continue; } r -= I_RNN;
        if (r < I_OUT) { const int kb = r / 32, nb = r % 32; transpose_item8(F.in[23], 1024, kb * 64, nb * 32, WSP(unsigned char, WS_WOUT), 1024, nb * 32, scr, F.lane); continue; } r -= I_OUT;
        if (r < I_GLU) { const int kb = r / 64, nb = r % 64; transpose_item8(F.in[22], 2048, kb * 64, nb * 32, WSP(unsigned char, WS_WGLU), 512, pair_row(nb * 32), scr, F.lane); continue; } r -= I_GLU;
        { const int mat = r >> 3, kb = (r >> 2) & 1, nb = r & 3, hd = mat & 7, gx = mat >> 3;
          transpose_item(F.in[gx ? 10 : 8] + (size_t)hd * 128 * 128, 128, kb * 64, nb * 32, WSP(bf16, WS_WG), 128, hd * 256 + gx * 128 + nb * 32, scr, F.lane); }
    }
}
__device__ __forceinline__ void p1_body(Frame& F) {
    const int gw = F.vcu * 8 + F.wave, NGW = F.G * 8; const float* mod = WSP(float, WS_MOD); bf16* hbf = WSP(bf16, WS_HBF);
    for (int tb = 4 * gw; tb < T; tb += 4 * NGW) {
        const int b = tb >> 12; f32x4 xv[4][4], shv[4], scv[4];
#pragma unroll
        for (int r = 0; r < 4; ++r) { const f32x4* xr = (const f32x4*)(F.in[0] + (size_t)(tb + r) * 1024) + F.lane;
#pragma unroll
            for (int j = 0; j < 4; ++j) xv[r][j] = xr[64 * j]; }
#pragma unroll
        for (int j = 0; j < 4; ++j) { shv[j] = *((const f32x4*)(mod + b * 6144) + F.lane + 64 * j); scv[j] = *((const f32x4*)(mod + b * 6144 + 1024) + F.lane + 64 * j) + 1.0f; }
#pragma unroll
        for (int r = 0; r < 4; ++r) { unsigned* o = (unsigned*)((unsigned char*)hbf + (size_t)(tb + r) * 1024) + F.lane;
#pragma unroll
            for (int j = 0; j < 4; ++j) { const f32x4 v = xv[r][j] * scv[j] + shv[j]; o[64 * j] = pk4_fp8(v[0], v[1], v[2], v[3]); } } }
    constexpr int TP = 132;
    LAS float* tile = (LAS float*)F.lds;
    constexpr int TILES_GU = 8 * 16, TILES_D = 8 * 8, TILES_E = TILES_GU + TILES_D;
    const int lr = F.tid >> 5, lc4 = (F.tid & 31) * 4, tn = F.tid >> 2, kc = F.tid & 3;
    f32x4 pre[8];
    int ti = F.vcu;
#define P1_SRC(idx, src, N_, dstp, drow0_, k0_) do { const int e_ = (idx) / TILES_E, r_ = (idx) % TILES_E; \
        if (r_ < TILES_GU) { const int kb_ = r_ >> 4, nb_ = r_ & 15; N_ = 2048; src = F.in[28] + (size_t)e_ * 1024 * 2048 + (size_t)(kb_ * 128) * 2048 + nb_ * 128; dstp = WSP(unsigned char, WS_WGU) + (size_t)e_ * 2048 * 1024; drow0_ = pair_row(nb_ * 128); k0_ = kb_ * 128; } \
        else { const int q_ = r_ - TILES_GU, kb_ = q_ >> 3, nb_ = q_ & 7; N_ = 1024; src = F.in[30] + (size_t)e_ * 1024 * 1024 + (size_t)(kb_ * 128) * 1024 + nb_ * 128; dstp = WSP(unsigned char, WS_WD) + (size_t)e_ * 1024 * 1024; drow0_ = nb_ * 128; k0_ = kb_ * 128; } } while (0)
    if (ti < NE * TILES_E) { const float* src; unsigned char* dstp; int N_, d0, k0; P1_SRC(ti, src, N_, dstp, d0, k0);
#pragma unroll
        for (int i = 0; i < 8; ++i) pre[i] = *(const f32x4*)(src + (size_t)(lr + 16 * i) * N_ + lc4); }
    for (; ti < NE * TILES_E; ti += F.G) {
#pragma unroll
        for (int i = 0; i < 8; ++i) *(LAS f32x4*)(tile + (lr + 16 * i) * TP + lc4) = pre[i];
        __syncthreads();
        const int tnx = (ti + F.G < NE * TILES_E) ? ti + F.G : ti;
        { const float* src; unsigned char* dstp; int N_, d0, k0; P1_SRC(tnx, src, N_, dstp, d0, k0);
#pragma unroll
            for (int i = 0; i < 8; ++i) pre[i] = *(const f32x4*)(src + (size_t)(lr + 16 * i) * N_ + lc4); }
        { const float* src; unsigned char* dstp; int N_, d0, k0; P1_SRC(ti, src, N_, dstp, d0, k0); (void)src; (void)N_;
          const LAS float* cp = tile + (32 * kc) * TP + tn; u32x4 o0, o1; float cv[32];
#pragma unroll
          for (int i = 0; i < 32; ++i) cv[i] = cp[i * TP];
          asm volatile("s_waitcnt lgkmcnt(0)" ::: "memory");
#pragma unroll
          for (int i = 0; i < 32; ++i) cv[i] *= 32.f;
          o0.x = pk4_fp8(cv[0], cv[1], cv[2], cv[3]); o0.y = pk4_fp8(cv[4], cv[5], cv[6], cv[7]); o0.z = pk4_fp8(cv[8], cv[9], cv[10], cv[11]); o0.w = pk4_fp8(cv[12], cv[13], cv[14], cv[15]);
          o1.x = pk4_fp8(cv[16], cv[17], cv[18], cv[19]); o1.y = pk4_fp8(cv[20], cv[21], cv[22], cv[23]); o1.z = pk4_fp8(cv[24], cv[25], cv[26], cv[27]); o1.w = pk4_fp8(cv[28], cv[29], cv[30], cv[31]);
          unsigned char* op = dstp + (size_t)(d0 + tn) * 1024 + k0 + 32 * kc; *(u32x4*)op = o0; *(u32x4*)(op + 16) = o1; }
        __syncthreads();
    }
#undef P1_SRC
}
constexpr int XR_LD = 136, XR_TILE = 128 * XR_LD;
__device__ __forceinline__ void rg_issue(const bf16* xrnn, const bf16* gy, int item, int tid, u32x4 (&xraw)[4][4], u32x4 (&graw)[4], bool pass1) {
    const int hd = item & 7, c = (item >> 3) & 31, b = item >> 8, r0 = tid >> 4, ch = hd * 128 + (tid & 15) * 8;
#pragma unroll
    for (int q = 0; q < 4; ++q) { const int r = r0 + 32 * q;
#pragma unroll
        for (int k = 0; k < 4; ++k) { const int tp = c * RGL + r - 3 + k, tpc = tp < 0 ? 0 : tp; xraw[q][k] = *(const u32x4*)(xrnn + (size_t)(b * SEQ + tpc) * 1024 + ch); }
        if (pass1) { const u32x2 g8 = *(const u32x2*)((const unsigned char*)gy + (size_t)(b * SEQ + c * RGL + r) * 1024 + ch); graw[q] = (u32x4){g8.x, g8.y, 0u, 0u}; } }
}
__device__ __forceinline__ void rg_convwrite(const LAS float* cwl, int item, int tid, const u32x4 (&xraw)[4][4], const u32x4 (&graw)[4], LAS bf16* xr, LAS bf16* gyt, bool pass1) {
    const int c = (item >> 3) & 31, r0 = tid >> 4, c8 = (tid & 15) * 8;
    const f32x4 b0 = *(const LAS f32x4*)(cwl + 4 * 128 + c8), b1 = *(const LAS f32x4*)(cwl + 4 * 128 + c8 + 4);
    f32x4 w0[4], w1[4];
#pragma unroll
    for (int k = 0; k < 4; ++k) { w0[k] = *(const LAS f32x4*)(cwl + k * 128 + c8); w1[k] = *(const LAS f32x4*)(cwl + k * 128 + c8 + 4); }
#pragma unroll
    for (int q = 0; q < 4; ++q) { const int r = r0 + 32 * q; f32x4 a0 = b0, a1 = b1;
#pragma unroll
        for (int k = 0; k < 4; ++k) { const int tp = c * RGL + r - 3 + k; f32x4 x0, x1; unpack8(xraw[q][k], x0, x1); if (tp < 0) { x0 = (f32x4){0.f, 0.f, 0.f, 0.f}; x1 = x0; } a0 += w0[k] * x0; a1 += w1[k] * x1; }
        *(LAS u32x4*)(xr + r * XR_LD + c8) = pack8(a0, a1);
        if (pass1) { f32x4 ga_, gb_; unpack8_fp8((u32x2){graw[q].x, graw[q].y}, ga_, gb_); *(LAS u32x4*)(gyt + r * XR_LD + c8) = pack8(ga_, gb_); } }
}
template <int PASS>
__device__ __forceinline__ void rglru_phase(Frame& F) {
    const int NIT = NB * RGC * 8;
    const bool skew = (PASS == 0) && (F.G == 256);
    const int nmine = skew ? (F.vcu < 128 ? 7 : 9) : (NIT - F.vcu + F.G - 1) / F.G;
#define RG_ITEM(k) ((skew && (k) >= 7) ? (1792 + (F.vcu - 128) + 128 * ((k) - 7)) : (F.vcu + (k) * F.G))
    if (nmine <= 0) return;
    int it = RG_ITEM(0);
    LAS bf16* xr = (LAS bf16*)F.lds; LAS bf16* gyt0 = xr + XR_TILE;
    const bf16* xrnn = WSP(bf16, WS_XRNN); const bf16* gy = WSP(bf16, WS_GY); bf16* ha = WSP(bf16, WS_HA); const float* cw = F.in[6]; const float* cb = F.in[7];
    const int tid = F.tid, w = F.wave, q = F.lane >> 4, col = F.lane & 15, chl = 16 * w + col;
    u32x4 xraw[4][4], graw[4];
    LAS float* cwl = (LAS float*)(gyt0 + 2 * XR_TILE);
    for (int i = tid; i < 5 * 128; i += 512) { const int k = i >> 7, chh = (it & 7) * 128 + (i & 127); cwl[i] = (k < 4) ? cw[k * 1024 + chh] : cb[chh]; }
    rg_issue(xrnn, gy, it, tid, xraw, graw, PASS);
    __syncthreads();
    rg_convwrite(cwl, it, tid, xraw, graw, xr, gyt0, PASS);
    bf16x8 Bf[2][4]; float ba, bx, sp;
    { const int hd0 = it & 7, ch0 = hd0 * 128 + chl; const bf16* wg = WSP(bf16, WS_WG) + (size_t)hd0 * 256 * 128;
#pragma unroll
      for (int gt = 0; gt < 2; ++gt)
#pragma unroll
          for (int kk = 0; kk < 4; ++kk) Bf[gt][kk] = *(const bf16x8*)(wg + (size_t)(gt * 128 + chl) * 128 + kk * 32 + q * 8);
      ba = F.in[9][ch0]; bx = F.in[11][ch0]; const float lam = F.in[12][ch0]; sp = (lam > 15.f) ? __expf(-lam) : log1pf(__expf(-lam)); }
#pragma unroll
    for (int gt = 0; gt < 2; ++gt)
#pragma unroll
        for (int kk = 0; kk < 4; ++kk) asm volatile("" :: "v"(Bf[gt][kk]));
    asm volatile("" :: "v"(ba), "v"(bx), "v"(sp));
    __syncthreads();
    for (int i = 0; i < nmine; ++i) {
        const bool has_next = (i + 1) < nmine; const int nit = has_next ? RG_ITEM(i + 1) : it;
        const int hd = it & 7, c = (it >> 3) & 31, b = it >> 8, t0 = b * SEQ + c * RGL, ch = hd * 128 + chl;
        LAS bf16* gyt = gyt0 + (i & 1) * XR_TILE; LAS bf16* gytn = gyt0 + ((i & 1) ^ 1) * XR_TILE;
        float carryH = 0.f, carryP = 1.f;
        if (PASS) carryH = WSP(float, WS_HIN)[(size_t)(b * RGC + c) * 1024 + ch];
        __builtin_amdgcn_sched_barrier(0);
        rg_issue(xrnn, gy, nit, tid, xraw, graw, PASS);
        __builtin_amdgcn_sched_barrier(0);
        f32x4 acc[8][2];
#pragma unroll
        for (int m = 0; m < 8; ++m) { acc[m][0] = (f32x4){0.f, 0.f, 0.f, 0.f}; acc[m][1] = (f32x4){0.f, 0.f, 0.f, 0.f}; }
#pragma unroll
        for (int kk = 0; kk < 4; ++kk)
#pragma unroll
            for (int m = 0; m < 8; ++m) { const bf16x8 Af = *(const LAS bf16x8*)(xr + (16 * m + col) * XR_LD + kk * 32 + q * 8);
                acc[m][0] = __builtin_amdgcn_mfma_f32_16x16x32_bf16(Af, Bf[0][kk], acc[m][0], 0, 0, 0);
                acc[m][1] = __builtin_amdgcn_mfma_f32_16x16x32_bf16(Af, Bf[1][kk], acc[m][1], 0, 0, 0); }
#pragma unroll
        for (int m = 0; m < 8; ++m) {
            float a[4], uu[4];
#pragma unroll
            for (int j = 0; j < 4; ++j) { const int tl = 16 * m + 4 * q + j;
                const float r = fast_sigmoid(acc[m][0][j] + ba), ii = fast_sigmoid(acc[m][1][j] + bx);
                const float la = -11.541560327f * r * sp; a[j] = __builtin_amdgcn_exp2f(la); const float mult = __builtin_amdgcn_sqrtf(fmaxf(1.0f - a[j] * a[j], 0.f));
                uu[j] = mult * ii * bf1(xr[tl * XR_LD + chl]); }
            float sP = a[0], sH = uu[0];
#pragma unroll
            for (int j = 1; j < 4; ++j) { sH = a[j] * sH + uu[j]; sP *= a[j]; }
            float iP = sP, iH = sH;
            { const float pP = __shfl_up(iP, 16), pH = __shfl_up(iH, 16); if (q >= 1) { iH = iP * pH + iH; iP = iP * pP; } }
            { const float pP = __shfl_up(iP, 32), pH = __shfl_up(iH, 32); if (q >= 2) { iH = iP * pH + iH; iP = iP * pP; } }
            float eP = __shfl_up(iP, 16), eH = __shfl_up(iH, 16); if (q == 0) { eP = 1.f; eH = 0.f; }
            const float tP = __shfl(iP, col + 48), tH = __shfl(iH, col + 48);
            if (PASS) { float h = eP * carryH + eH;
#pragma unroll
                for (int j = 0; j < 4; ++j) { const int tl = 16 * m + 4 * q + j; h = a[j] * h + uu[j]; LAS bf16* gp = gyt + tl * XR_LD + chl; *gp = (bf16)f2bf(h * bf1(*gp)); } }
            carryH = tP * carryH + tH; carryP *= tP;
        }
        if (!PASS && q == 0) { f32x2* ag = WSP(f32x2, WS_RGAGG); ag[(size_t)(b * RGC + c) * 1024 + ch] = (f32x2){carryP, carryH}; }
        __syncthreads();
        if (PASS) { const int r0 = tid >> 4, c8 = (tid & 15) * 8;
#pragma unroll
            for (int qq = 0; qq < 4; ++qq) { const int r = r0 + 32 * qq; f32x4 h0, h1; unpack8(*(const LAS u32x4*)(gyt + r * XR_LD + c8), h0, h1); u32x2 w8; w8.x = pk4_fp8(h0[0], h0[1], h0[2], h0[3]); w8.y = pk4_fp8(h1[0], h1[1], h1[2], h1[3]);
                *(u32x2*)((unsigned char*)ha + (size_t)(t0 + r) * 1024 + hd * 128 + c8) = w8; } }
#pragma unroll
        for (int qq = 0; qq < 4; ++qq) {
#pragma unroll
            for (int k = 0; k < 4; ++k) asm volatile("" : "+v"(xraw[qq][k]));
            if (PASS) asm volatile("" : "+v"(graw[qq])); }
        if (has_next) rg_convwrite(cwl, nit, tid, xraw, graw, xr, gytn, PASS);
        __syncthreads();
        it = nit;
    }
#undef RG_ITEM
}
__device__ __forceinline__ void p4_carries(Frame& F) {
    LAS f32x2* seg = (LAS f32x2*)F.lds;
    for (int job = F.vcu; job < NB * S5G; job += F.G) {
        const int b = job >> 5, g = job & 31, p = F.lane, w = F.wave;
        const f32x2 al = WSP(f32x2, WS_AL)[g * 64 + p];
        const f32x2* Sb = WSP(f32x2, WS_S) + ((size_t)(g * S5M + b * S5CPB + 16 * w)) * 64 + p; unsigned* ac = (unsigned*)(WSP(bf16, WS_ACAT) + ((size_t)(g * S5M + b * S5CPB + 16 * w)) * S5ROW) + p;
        f32x2 sv[16];
#pragma unroll
        for (int i = 0; i < 16; ++i) sv[i] = Sb[(size_t)i * 64];
        float xr_ = 0.f, xi = 0.f;
#pragma unroll
        for (int i = 0; i < 16; ++i) { const float nr = al.x * xr_ - al.y * xi + sv[i].x, ni = al.x * xi + al.y * xr_ + sv[i].y; xr_ = nr; xi = ni; }
        seg[w * 64 + p] = (f32x2){xr_, xi};
        float ar = al.x, ai = al.y;
#pragma unroll
        for (int q = 0; q < 4; ++q) { const float nr = ar * ar - ai * ai, ni = 2.f * ar * ai; ar = nr; ai = ni; }
        __syncthreads();
        xr_ = 0.f; xi = 0.f;
        for (int ww = 0; ww < w; ++ww) { const f32x2 sg = seg[ww * 64 + p]; const float nr = ar * xr_ - ai * xi + sg.x, ni = ar * xi + ai * xr_ + sg.y; xr_ = nr; xi = ni; }
#pragma unroll
        for (int i = 0; i < 16; ++i) { ac[(size_t)i * (S5ROW / 2)] = pk2(xr_, xi); const float nr = al.x * xr_ - al.y * xi + sv[i].x, ni = al.x * xi + al.y * xr_ + sv[i].y; xr_ = nr; xi = ni; }
        __syncthreads();
    }
    if (F.vcu < 16) {
        const int id = F.vcu * 512 + F.tid, ch = id & 1023, b = id >> 10; const f32x2* ag = WSP(f32x2, WS_RGAGG) + (size_t)b * RGC * 1024 + ch; float* hin = WSP(float, WS_HIN) + (size_t)b * RGC * 1024 + ch;
        f32x2 a[RGC];
#pragma unroll
        for (int c = 0; c < RGC; ++c) a[c] = ag[(size_t)c * 1024];
        float h = 0.f;
#pragma unroll
        for (int c = 0; c < RGC; ++c) { hin[(size_t)c * 1024] = h; h = a[c].x * h + a[c].y; }
    }
}
constexpr int WR_LD = 1032;
__device__ __forceinline__ void p9_router(Frame& F) {
    LAS bf16* wH = (LAS bf16*)F.lds; LAS bf16* wL = wH + 32 * WR_LD;
    LAS f32x2* sel = (LAS f32x2*)(wL + 32 * WR_LD);
    LAS unsigned* rec = (LAS unsigned*)(sel + 512);
    LAS float* recp = (LAS float*)(rec + 512);
    LAS int* lcnt = (LAS int*)(recp + 512);
    LAS int* gbase = lcnt + 32;
    { const u32x4* img = WSP(u32x4, WS_WRIMG); LAS u32x4* dst = (LAS u32x4*)wH;
      for (int i = F.tid; i < 2 * 32 * WR_LD * 2 / 16; i += 512) dst[i] = img[i]; }
    if (F.tid < 32) lcnt[F.tid] = 0;
    __syncthreads();
    const float* mod = WSP(float, WS_MOD); const bf16* v1 = WSP(bf16, WS_V1); bf16* x1 = WSP(bf16, WS_X1); unsigned char* h2 = WSP(unsigned char, WS_H2);
    const int lane = F.lane, m = lane & 15, kq = lane >> 4, w = F.wave;
    for (int blk = F.vcu; blk < T / 128; blk += F.G) {
        const int t = blk * 128 + w * 16 + m, b = (blk * 128) >> 12;
        const bf16* vrow = v1 + (size_t)t * 1024 + 8 * kq;
        float sum = 0.f, sq = 0.f;
#pragma unroll 32
        for (int s_ = 0; s_ < 32; ++s_) { f32x4 a, c; unpack8(*(const u32x4*)(vrow + 32 * s_), a, c); sum += ((a[0] + a[1]) + (a[2] + a[3])) + ((c[0] + c[1]) + (c[2] + c[3]));
            sq += ((a[0] * a[0] + a[1] * a[1]) + (a[2] * a[2] + a[3] * a[3])) + ((c[0] * c[0] + c[1] * c[1]) + (c[2] * c[2] + c[3] * c[3])); }
        sum += __shfl_xor(sum, 16); sum += __shfl_xor(sum, 32); sq += __shfl_xor(sq, 16); sq += __shfl_xor(sq, 32);
        const float mean = sum * (1.f / 1024.f); const float rstd = 1.f / sqrtf(fmaxf(sq * (1.f / 1024.f) - mean * mean, 0.f) + LN_EPS);
        f32x4 acc[2] = {(f32x4){0.f, 0.f, 0.f, 0.f}, (f32x4){0.f, 0.f, 0.f, 0.f}};
        const float* lng = F.in[24] + 8 * kq; const float* lnb = F.in[25] + 8 * kq; const float* shp = mod + b * 6144 + 3072 + 8 * kq; const float* scp = mod + b * 6144 + 4096 + 8 * kq;
        bf16* x1row = x1 + (size_t)t * 1024 + 8 * kq; unsigned char* h2row = h2 + (size_t)t * 1024 + 8 * kq;
        const LAS bf16* wHr = wH + m * WR_LD + 8 * kq; const LAS bf16* wLr = wL + m * WR_LD + 8 * kq;
#pragma unroll 2
        for (int s2 = 0; s2 < 32; s2 += 2) {
            u32x4 rw[2]; f32x4 pg[2][2], pb[2][2], psh[2][2], psc[2][2];
#pragma unroll
            for (int h = 0; h < 2; ++h) { const int ko = 32 * (s2 + h); rw[h] = *(const u32x4*)(vrow + ko);
                pg[h][0] = *(const f32x4*)(lng + ko); pg[h][1] = *(const f32x4*)(lng + ko + 4); pb[h][0] = *(const f32x4*)(lnb + ko); pb[h][1] = *(const f32x4*)(lnb + ko + 4);
                psh[h][0] = *(const f32x4*)(shp + ko); psh[h][1] = *(const f32x4*)(shp + ko + 4); psc[h][0] = *(const f32x4*)(scp + ko); psc[h][1] = *(const f32x4*)(scp + ko + 4); }
#pragma unroll
            for (int h = 0; h < 2; ++h) { const int ko = 32 * (s2 + h);
                f32x4 a, c; unpack8(rw[h], a, c);
                const f32x4 x0 = (a - mean) * rstd * pg[h][0] + pb[h][0], x1v = (c - mean) * rstd * pg[h][1] + pb[h][1];
                *(u32x4*)(x1row + ko) = pack8(x0, x1v);
                const f32x4 h0 = x0 * (psc[h][0] + 1.0f) + psh[h][0], h1 = x1v * (psc[h][1] + 1.0f) + psh[h][1];
                u32x2 w8; w8.x = pk4_fp8(h0[0], h0[1], h0[2], h0[3]); w8.y = pk4_fp8(h1[0], h1[1], h1[2], h1[3]); *(u32x2*)(h2row + ko) = w8;
                const u32x4 hi = pack8(h0, h1); f32x4 r0, r1; unpack8(hi, r0, r1); const u32x4 lo = pack8(h0 - r0, h1 - r1);
                const bf16x8 ah = __builtin_bit_cast(bf16x8, hi), al = __builtin_bit_cast(bf16x8, lo);
#pragma unroll
                for (int nf = 0; nf < 2; ++nf) { const bf16x8 bh = *(const LAS bf16x8*)(wHr + nf * 16 * WR_LD + ko), bl = *(const LAS bf16x8*)(wLr + nf * 16 * WR_LD + ko);
                    acc[nf] = __builtin_amdgcn_mfma_f32_16x16x32_bf16(bh, ah, acc[nf], 0, 0, 0);
                    acc[nf] = __builtin_amdgcn_mfma_f32_16x16x32_bf16(bl, ah, acc[nf], 0, 0, 0);
                    acc[nf] = __builtin_amdgcn_mfma_f32_16x16x32_bf16(bh, al, acc[nf], 0, 0, 0); } } }
        float lv[8];
#pragma unroll
        for (int nf = 0; nf < 2; ++nf)
#pragma unroll
            for (int j = 0; j < 4; ++j) lv[nf * 4 + j] = acc[nf][j] + F.in[27][nf * 16 + 4 * kq + j];
        int rank[8];
#pragma unroll
        for (int i = 0; i < 8; ++i) { rank[i] = 0;
#pragma unroll
            for (int i2 = 0; i2 < 8; ++i2) if (i2 != i) { const int e1 = (i >> 2) * 16 + 4 * kq + (i & 3), e2 = (i2 >> 2) * 16 + 4 * kq + (i2 & 3); rank[i] += (lv[i2] > lv[i] || (lv[i2] == lv[i] && e2 < e1)) ? 1 : 0; } }
#pragma unroll
        for (int dq = 1; dq < 4; ++dq) { const int q2 = kq ^ dq;
#pragma unroll
            for (int i2 = 0; i2 < 8; ++i2) { const float o = __shfl_xor(lv[i2], 16 * dq); const int e2 = (i2 >> 2) * 16 + 4 * q2 + (i2 & 3);
#pragma unroll
                for (int i = 0; i < 8; ++i) { const int e1 = (i >> 2) * 16 + 4 * kq + (i & 3); rank[i] += (o > lv[i] || (o == lv[i] && e2 < e1)) ? 1 : 0; } } }
#pragma unroll
        for (int i = 0; i < 8; ++i) if (rank[i] < 4) { const int e1 = (i >> 2) * 16 + 4 * kq + (i & 3); sel[(w * 16 + m) * 4 + rank[i]] = (f32x2){__builtin_bit_cast(float, e1), lv[i]}; }
        asm volatile("s_waitcnt lgkmcnt(0)" ::: "memory");
        { const int tm = lane >> 2, k = lane & 3; const f32x2 s0 = sel[(w * 16 + tm) * 4 + 0], s1 = sel[(w * 16 + tm) * 4 + 1], s2 = sel[(w * 16 + tm) * 4 + 2], s3 = sel[(w * 16 + tm) * 4 + 3];
          const float p0 = 1.f, p1 = __expf(s1.y - s0.y), p2 = __expf(s2.y - s0.y), p3 = __expf(s3.y - s0.y), ps = (p0 + p1) + (p2 + p3);
          const f32x2 mine = k == 0 ? s0 : (k == 1 ? s1 : (k == 2 ? s2 : s3)); const float pm = (k == 0 ? p0 : (k == 1 ? p1 : (k == 2 ? p2 : p3))) / ps;
          const int e = __builtin_bit_cast(int, mine.x);
          const int lr = __hip_atomic_fetch_add(lcnt + e, 1, __ATOMIC_RELAXED, __HIP_MEMORY_SCOPE_WORKGROUP);
          rec[(w * 16 + tm) * 4 + k] = ((unsigned)e << 16) | (unsigned)lr; recp[(w * 16 + tm) * 4 + k] = pm; }
        __syncthreads();
        if (F.tid < 32) { const int n = lcnt[F.tid]; gbase[F.tid] = n ? (int)atomicAdd(F.ctl + CW_CNT + 64 * F.tid, (unsigned)n) : 0; lcnt[F.tid] = 0; }
        __syncthreads();
        { const unsigned r = rec[F.tid]; const int e = r >> 16, rk = gbase[e] + (int)(r & 0xffffu), tt = blk * 128 + (F.tid >> 2);
          WSP(int, WS_TOK)[(size_t)e * T + rk] = tt; WSP(unsigned, WS_POS)[(size_t)tt * 4 + (F.tid & 3)] = ((unsigned)e << 20) | (unsigned)rk; WSP(float, WS_PROB)[(size_t)tt * 4 + (F.tid & 3)] = recp[F.tid]; }
        __syncthreads();
    }
}
__device__ __forceinline__ void p12_final(Frame& F) {
    moe_tables(F);
    const LAS int* tstart = (const LAS int*)(F.lds + TAB_OFF);
    const float* mod = WSP(float, WS_MOD); const bf16* x1 = WSP(bf16, WS_X1); const bf16* yb = WSP(bf16, WS_YB); const unsigned* pos = WSP(unsigned, WS_POS); const float* prob = WSP(float, WS_PROB);
    const int lane = F.lane, gw = F.vcu * 8 + F.wave, NGW = F.G * 8;
    f32x4 lg[4], lb[4];
#pragma unroll
    for (int j = 0; j < 4; ++j) { lg[j] = *(const f32x4*)(F.in[32] + 512 * (j >> 1) + 8 * lane + 4 * (j & 1)); lb[j] = *(const f32x4*)(F.in[33] + 512 * (j >> 1) + 8 * lane + 4 * (j & 1)); }
#define P12_ROUTE(PP, PW, tt) do { const u32x4 p4_ = *(const u32x4*)(pos + (size_t)(tt) * 4); const f32x4 w4_ = *(const f32x4*)(prob + (size_t)(tt) * 4); \
        PP[0] = p4_.x; PP[1] = p4_.y; PP[2] = p4_.z; PP[3] = p4_.w; PW[0] = w4_[0]; PW[1] = w4_[1]; PW[2] = w4_[2]; PW[3] = w4_[3]; } while (0)
#define P12_ROWS(YW, XW, PP, tt) do { _Pragma("unroll") for (int k = 0; k < 4; ++k) { const int e_ = PP[k] >> 20, rk_ = PP[k] & 0xfffffu; const size_t slot_ = (size_t)tstart[e_] * 256 + rk_; \
            _Pragma("unroll") for (int j = 0; j < 2; ++j) YW[k][j] = *((const u32x2*)((const unsigned char*)yb + slot_ * 1024) + 64 * j + lane); } \
        _Pragma("unroll") for (int j = 0; j < 2; ++j) XW[j] = *((const u32x4*)(x1 + (size_t)(tt) * 1024) + 64 * j + lane); } while (0)
#define P12_COMPUTE(YW, XW, PW, tt) do { const int b_ = (tt) >> 12; f32x4 v[4]; float s_ = 0.f; \
        _Pragma("unroll") for (int j = 0; j < 2; ++j) { f32x4 f0 = (f32x4){0.f, 0.f, 0.f, 0.f}, f1 = f0; \
            _Pragma("unroll") for (int k = 0; k < 4; ++k) { const u32x2 yv_ = YW[k][j]; const f32x2 q0_ = __builtin_amdgcn_cvt_pk_f32_fp8((int)yv_.x, false), q1_ = __builtin_amdgcn_cvt_pk_f32_fp8((int)yv_.x, true), q2_ = __builtin_amdgcn_cvt_pk_f32_fp8((int)yv_.y, false), q3_ = __builtin_amdgcn_cvt_pk_f32_fp8((int)yv_.y, true); \
                f0 += (f32x4){q0_.x, q0_.y, q1_.x, q1_.y} * PW[k]; f1 += (f32x4){q2_.x, q2_.y, q3_.x, q3_.y} * PW[k]; } \
            f32x4 xa_, xc_; unpack8(XW[j], xa_, xc_); const float* gp_ = mod + b_ * 6144 + 5120 + 512 * j + 8 * lane; \
            v[2 * j] = xa_ * DN_ALPHA + (*(const f32x4*)gp_ + 1.0f) * f0; v[2 * j + 1] = xc_ * DN_ALPHA + (*(const f32x4*)(gp_ + 4) + 1.0f) * f1; \
            s_ += ((v[2 * j][0] + v[2 * j][1]) + (v[2 * j][2] + v[2 * j][3])) + ((v[2 * j + 1][0] + v[2 * j + 1][1]) + (v[2 * j + 1][2] + v[2 * j + 1][3])); } \
        const float mean_ = wave_sum(s_) * (1.f / 1024.f); float s2_ = 0.f; \
        _Pragma("unroll") for (int j = 0; j < 4; ++j) { v[j] = v[j] - mean_; s2_ += (v[j][0] * v[j][0] + v[j][1] * v[j][1]) + (v[j][2] * v[j][2] + v[j][3] * v[j][3]); } \
        const float rstd_ = 1.f / sqrtf(wave_sum(s2_) * (1.f / 1024.f) + LN_EPS); \
        _Pragma("unroll") for (int j = 0; j < 4; ++j) *(f32x4*)(F.out + (size_t)(tt) * 1024 + 512 * (j >> 1) + 8 * lane + 4 * (j & 1)) = v[j] * rstd_ * lg[j] + lb[j]; } while (0)
    const int nmine = (T - gw + NGW - 1) / NGW;
    unsigned ppA[4], ppB[4]; float pwA[4], pwB[4], pwN[4]; u32x2 ywA[4][2], ywB[4][2]; u32x4 xwA[2], xwB[2];
    if (nmine > 0) { P12_ROUTE(ppA, pwA, gw); P12_ROWS(ywA, xwA, ppA, gw); }
    if (nmine > 1) { P12_ROUTE(ppB, pwB, gw + NGW); }
    for (int i = 0; i < nmine; i += 2) {
        const int t0 = gw + i * NGW, t1 = t0 + NGW, t2 = t1 + NGW, t3 = t2 + NGW;
        if (i + 1 < nmine) { P12_ROWS(ywB, xwB, ppB, t1); }
        if (i + 2 < nmine) { P12_ROUTE(ppA, pwN, t2); }
        __builtin_amdgcn_sched_barrier(0);
        P12_COMPUTE(ywA, xwA, pwA, t0);
        if (i + 1 < nmine) {
#pragma unroll
            for (int k = 0; k < 4; ++k) pwA[k] = pwN[k];
            if (i + 2 < nmine) { P12_ROWS(ywA, xwA, ppA, t2); }
            if (i + 3 < nmine) { P12_ROUTE(ppB, pwN, t3); }
            __builtin_amdgcn_sched_barrier(0);
            P12_COMPUTE(ywB, xwB, pwB, t1);
#pragma unroll
            for (int k = 0; k < 4; ++k) pwB[k] = pwN[k];
        }
    }
#undef P12_ROUTE
#undef P12_ROWS
#undef P12_COMPUTE
}

struct Args { const float* in[34]; float* out; unsigned char* ws; int ph_lo, ph_hi; };
__global__ void __launch_bounds__(512, 2) fwd_kernel(Args args) {
    extern __shared__ __attribute__((aligned(16))) unsigned char lds_raw[];
    Frame F;
    F.lds = (LAS unsigned char*)lds_raw; F.MISC = (volatile LAS unsigned*)(F.lds + MISC_OFF);
    F.tid = threadIdx.x; F.lane = F.tid & 63; F.wave = __builtin_amdgcn_readfirstlane(F.tid >> 6);
    F.G = gridDim.x; { const int bx = blockIdx.x; F.vcu = (F.G % 8 == 0) ? (bx % 8) * (F.G / 8) + bx / 8 : bx; }
#pragma unroll
    for (int i = 0; i < 34; ++i) F.in[i] = args.in[i];
    F.out = args.out; F.ws = args.ws; F.ctl = (unsigned*)(args.ws + WS_CTL);
    if (F.tid < 64) F.MISC[F.tid] = 0u;
    __syncthreads();
    XcdBarrier bar; bar.bar = F.ctl + CW_BAR; bar.x = 0; bar.st = nullptr;
    if (MK_N_LAUNCHES == 1) bar = xcd_barrier_post(F.ctl + CW_BAR, F.MISC + 8);
    const int lo = args.ph_lo, hi = args.ph_hi;
#define IN(k) (lo <= (k) && (k) < hi)
#define SEAM(k) do { if (IN(k) && IN((k) + 1)) xcd_barrier(bar); } while (0)

    if (IN(0)) REPS(0) { if (rep_) xcd_barrier(bar);
        for (int j = F.vcu; j < 192; j += F.G) p0_mod_job(F, j);
        for (int j = F.vcu; j < S5G * 8; j += F.G) p0_s5k_job(F, j);
        { bf16* img = WSP(bf16, WS_WRIMG); const float* wr = F.in[26];
          for (int i = F.vcu * 512 + F.tid; i < 1024 * 32; i += F.G * 512) { const float w = wr[i]; const unsigned hb = f2bf(w); const float hf = __builtin_bit_cast(float, hb << 16);
              img[(i & 31) * 1032 + (i >> 5)] = (bf16)hb; img[32 * 1032 + (i & 31) * 1032 + (i >> 5)] = (bf16)f2bf(w - hf); } }
        p0_small_transposes(F);
    }
    SEAM(0);
    if (IN(1)) REPS(1) { if (rep_) xcd_barrier(bar); for (int j = F.vcu; j < S5G * 8; j += F.G) p1_s5w_job(F, j); p1_body(F); }
    SEAM(1);
    if (IN(2)) REPS(2) { if (rep_) xcd_barrier(bar);
        g8::GridOrder S; S.init(T, INC, F.G, (int)blockIdx.x, WSP(bf16, WS_HBF), WSP(bf16, WS_WIN), 1024, 1024);
        EpiInProj E{F.in[5], WSP(bf16, WS_XRNN), WSP(bf16, WS_GY), WSP(bf16, WS_ACAT), WSP(bf16, WS_GATES)};
        g8::gemm_phase<EpiInProj, g8::GridOrder, false, true>(F.lds, 1024, 1024, 1024, S, E);
    }
    SEAM(2);
    if (IN(3)) REPS(3) { if (rep_) xcd_barrier(bar);
        { S5AOrder S{F.G, F.vcu, (const char*)WSP(bf16, WS_ACAT), (const char*)WSP(bf16, WS_WS)}; EpiS5A E{WSP(float, WS_S)};
          g8::gemm_phase<EpiS5A, S5AOrder, false>(F.lds, S5L * 32, S5ROW * 2, S5L * 32, S, E); }
        __syncthreads();
        rglru_phase<0>(F);
    }
    SEAM(3);
    if (IN(4)) REPS(4) { if (rep_) xcd_barrier(bar); p4_carries(F); }
    SEAM(4);
    if (IN(5)) REPS(5) { if (rep_) xcd_barrier(bar);
        { S5COrder S{F.G, F.vcu, (const char*)WSP(bf16, WS_ACAT), (const char*)WSP(bf16, WS_WY)}; EpiS5C E{WSP(bf16, WS_YS)};
          g8::gemm_phase<EpiS5C, S5COrder, false>(F.lds, S5ROW * 2, S5ROW * 2, S5ROW * 2, S, E); }
        __syncthreads();
        rglru_phase<1>(F);
    }
    SEAM(5);
    if (IN(6)) REPS(6) { if (rep_) xcd_barrier(bar);
        g8::GridOrder S; S.init(T, 2048, F.G, (int)blockIdx.x, WSP(bf16, WS_YS), WSP(bf16, WS_WGLU), 512, 512);
        EpiGlu E{WSP(bf16, WS_GATES), WSP(bf16, WS_GB)};
        g8::gemm_phase<EpiGlu, g8::GridOrder, false, true>(F.lds, 512, 512, 512, S, E);
    }
    SEAM(6);
    if (IN(7)) REPS(7) { if (rep_) xcd_barrier(bar);
        g8::GridOrder S; S.init(T, 1024, F.G, (int)blockIdx.x, WSP(bf16, WS_HA), WSP(bf16, WS_WRNN), 1024, 1024);
        EpiRnn E{WSP(bf16, WS_GATES), WSP(bf16, WS_GB), WSP(bf16, WS_MERGED)};
        g8::gemm_phase<EpiRnn, g8::GridOrder, false, true>(F.lds, 1024, 1024, 1024, S, E);
    }
    SEAM(7);
    if (IN(8)) REPS(8) { if (rep_) xcd_barrier(bar);
        g8::GridOrder S; S.init(T, 1024, F.G, (int)blockIdx.x, WSP(bf16, WS_MERGED), WSP(bf16, WS_WOUT), 1024, 1024);
        EpiOut E{F.in[0], WSP(float, WS_MOD), WSP(bf16, WS_V1)};
        g8::gemm_phase<EpiOut, g8::GridOrder, false, true>(F.lds, 1024, 1024, 1024, S, E);
    }
    SEAM(8);
    if (IN(9)) REPS(9) { if (rep_) xcd_barrier(bar); p9_router(F); }
    SEAM(9);
    if (IN(10)) REPS(10) { if (rep_) xcd_barrier(bar);
        moe_tables(F);
        const LAS int* tstart = (const LAS int*)(F.lds + TAB_OFF);
        MoeOrder S{F.G, (int)blockIdx.x, 8, tstart[NE], tstart, tstart + 40, WSP(int, WS_TOK), (const char*)WSP(bf16, WS_H2), (const char*)WSP(bf16, WS_WGU), (size_t)2048 * 1024, 1024, true};
        EpiMoe1 E{F.in[29], WSP(bf16, WS_ACT)};
        g8::gemm_phase<EpiMoe1, MoeOrder, true, true>(F.lds, 1024, 1024, 1024, S, E);
    }
    SEAM(10);
    if (IN(11)) REPS(11) { if (rep_) xcd_barrier(bar);
        moe_tables(F);
        const LAS int* tstart = (const LAS int*)(F.lds + TAB_OFF);
        MoeOrder S{F.G, (int)blockIdx.x, 4, tstart[NE], tstart, tstart + 40, WSP(int, WS_TOK), (const char*)WSP(bf16, WS_ACT), (const char*)WSP(bf16, WS_WD), (size_t)1024 * 1024, 1024, false};
        EpiMoe2 E{F.in[31], WSP(bf16, WS_YB)};
        g8::gemm_phase<EpiMoe2, MoeOrder, false, true>(F.lds, 1024, 1024, 1024, S, E);
    }
    SEAM(11);
    if (IN(12)) REPS(12) { if (rep_) xcd_barrier(bar); p12_final(F); }
#undef IN
#undef SEAM
}

extern "C" void kernel_launch(void* const* d_in, const int* in_sizes, int n_in, void* d_out, int out_size, void* d_ws, size_t ws_size, hipStream_t stream) {
    static int grid = 0;
    if (grid == 0) {
        if (n_in != 34 || in_sizes[0] != T * D || out_size != T * D || ws_size < WS_END) { fprintf(stderr, "kernel_launch: unexpected shapes (n_in %d, ws %zu < %zu)\n", n_in, ws_size, (size_t)WS_END); grid = -1; return; }
        int dev = 0, cus = 0;
        if (hipGetDevice(&dev) != hipSuccess || hipDeviceGetAttribute(&cus, hipDeviceAttributeMultiprocessorCount, dev) != hipSuccess) { grid = -1; return; }
        if (hipFuncSetAttribute((const void*)fwd_kernel, hipFuncAttributeMaxDynamicSharedMemorySize, LDS_BYTES) != hipSuccess) { fprintf(stderr, "kernel_launch: hipFuncSetAttribute failed\n"); grid = -1; return; }
        int per_cu = 0; (void)hipOccupancyMaxActiveBlocksPerMultiprocessor(&per_cu, (const void*)fwd_kernel, 512, LDS_BYTES); (void)hipGetLastError();
        grid = cus;
    }
    if (grid < 0) return;
    (void)hipMemsetAsync((char*)d_ws + WS_CTL, 0, CTL_BYTES, stream);
    Args a{};
    for (int i = 0; i < 34; ++i) a.in[i] = (const float*)d_in[i];
    a.out = (float*)d_out; a.ws = (unsigned char*)d_ws;
    if (MK_N_LAUNCHES == 1) { a.ph_lo = 0; a.ph_hi = N_PHASES; hipLaunchKernelGGL(fwd_kernel, dim3(grid), dim3(512), LDS_BYTES, stream, a); }
    else for (int p = 0; p < N_PHASES; ++p) { a.ph_lo = p; a.ph_hi = p + 1; hipLaunchKernelGGL(fwd_kernel, dim3(grid), dim3(512), LDS_BYTES, stream, a); }
}
```

```cpp
#include <hip/hip_runtime.h>
#include <cstdio>
#include <cstdint>

#ifndef MK_N_LAUNCHES
#define MK_N_LAUNCHES 1
#endif
constexpr int N_PHASES = 13;
#ifndef DUP_PHASE
#define DUP_PHASE -1
#endif
#define REPS(k) for (int rep_ = 0; rep_ < ((DUP_PHASE == (k)) ? 2 : 1); ++rep_)

#define GAS __attribute__((address_space(1)))
#define LAS __attribute__((address_space(3)))
typedef unsigned short bf16;
typedef short bf16x8 __attribute__((ext_vector_type(8)));
typedef float f32x4 __attribute__((ext_vector_type(4)));
typedef float f32x2 __attribute__((ext_vector_type(2)));
typedef unsigned u32x4 __attribute__((ext_vector_type(4)));
typedef unsigned u32x2 __attribute__((ext_vector_type(2)));
typedef GAS unsigned gu32;

constexpr int NB = 8, SEQ = 4096, T = NB * SEQ, D = 1024, INC = 4608, NE = 32, DFF = 1024;
constexpr int S5L = 32, S5G = 32, S5ROW = 128 + S5L * 16  , S5M = T / S5L  , S5CPB = SEQ / S5L  ;
constexpr int RGL = 128, RGC = SEQ / RGL  ;
constexpr float LN_EPS = 1e-5f, DN_ALPHA = 1.189207115002721f;
constexpr int ACT_ROWS = T * 4 + NE * 256;

constexpr size_t MiB = 1u << 20;
constexpr size_t WS_XRNN = 0, WS_GY = 64 * MiB, WS_GATES = 128 * MiB, WS_V1 = 0, WS_ACT = 0;
constexpr size_t WS_HBF = 272 * MiB, WS_HA = 272 * MiB, WS_YS = 336 * MiB, WS_GB = 368 * MiB, WS_MERGED = 432 * MiB, WS_ACAT = 496 * MiB, WS_YB = 272 * MiB;
constexpr size_t WS_X1 = 544 * MiB, WS_H2 = 608 * MiB;
constexpr size_t WS_WGU = 672 * MiB, WS_WD = 800 * MiB, WS_WIN = 864 * MiB, WS_WG = 873 * MiB, WS_WRNN = 874 * MiB, WS_WGLU = 876 * MiB, WS_WOUT = 878 * MiB;
constexpr size_t WS_WS = 880 * MiB, WS_WY = 888 * MiB, WS_S = 908 * MiB;
constexpr size_t WS_MOD = 924 * MiB, WS_AL = 925 * MiB, WS_RGAGG = 926 * MiB, WS_HIN = 928 * MiB, WS_TOK = 929 * MiB, WS_POS = 933 * MiB, WS_PROB = 934 * MiB, WS_CTL = 935 * MiB;
constexpr size_t WS_END = 936 * MiB, CTL_BYTES = 1 * MiB;
static_assert((size_t)ACT_ROWS * DFF * 2 <= 272 * MiB, "act/yb size");
static_assert(WS_ACAT + (size_t)S5G * S5M * S5ROW * 2 <= WS_X1, "acat");
constexpr int CW_BAR = 4096, CW_CNT = 8192  ;

constexpr int LDS_BYTES = 147456, MISC_OFF = LDS_BYTES - 256, TAB_OFF = 131072 + 1024;

__device__ __forceinline__ unsigned f2bf(float f) { unsigned u = __builtin_bit_cast(unsigned, f); return (u + 0x7fffu + ((u >> 16) & 1u)) >> 16; }
typedef __bf16 bf16x2v __attribute__((ext_vector_type(2)));
__device__ __forceinline__ unsigned pk2(float lo, float hi) { const f32x2 v = {lo, hi}; const bf16x2v b = __builtin_convertvector(v, bf16x2v); return __builtin_bit_cast(unsigned, b); }
__device__ __forceinline__ unsigned pk4_fp8(float a, float b, float c, float d) { a = __builtin_amdgcn_fmed3f(a, -448.f, 448.f); b = __builtin_amdgcn_fmed3f(b, -448.f, 448.f); c = __builtin_amdgcn_fmed3f(c, -448.f, 448.f); d = __builtin_amdgcn_fmed3f(d, -448.f, 448.f); int w = 0; w = __builtin_amdgcn_cvt_pk_fp8_f32(a, b, w, false); w = __builtin_amdgcn_cvt_pk_fp8_f32(c, d, w, true); return (unsigned)w; }
__device__ __forceinline__ void unpack8_fp8(u32x2 w, f32x4& a, f32x4& b) { const f32x2 q0 = __builtin_amdgcn_cvt_pk_f32_fp8((int)w.x, false), q1 = __builtin_amdgcn_cvt_pk_f32_fp8((int)w.x, true), q2 = __builtin_amdgcn_cvt_pk_f32_fp8((int)w.y, false), q3 = __builtin_amdgcn_cvt_pk_f32_fp8((int)w.y, true);
    a = (f32x4){q0.x, q0.y, q1.x, q1.y}; b = (f32x4){q2.x, q2.y, q3.x, q3.y}; }
__device__ __forceinline__ float bflo(unsigned w) { return __builtin_bit_cast(float, w << 16); }
__device__ __forceinline__ float bfhi(unsigned w) { return __builtin_bit_cast(float, w & 0xffff0000u); }
__device__ __forceinline__ float bf1(bf16 h) { return __builtin_bit_cast(float, ((unsigned)h) << 16); }
__device__ __forceinline__ float fast_sigmoid(float x) { return __builtin_amdgcn_rcpf(1.0f + __builtin_amdgcn_exp2f(-1.4426950409f * x)); }
__device__ __forceinline__ float gelu_tanh(float x) { const float u = x + 0.044715f * x * x * x; return x * __builtin_amdgcn_rcpf(1.0f + __builtin_amdgcn_exp2f(-2.3022082f * u)); }
__device__ __forceinline__ float wave_sum(float v) {
#pragma unroll
    for (int o = 1; o < 64; o <<= 1) v += __shfl_xor(v, o);
    return v;
}
__device__ __forceinline__ u32x4 pack8(f32x4 a, f32x4 b) { u32x4 w; w.x = pk2(a[0], a[1]); w.y = pk2(a[2], a[3]); w.z = pk2(b[0], b[1]); w.w = pk2(b[2], b[3]); return w; }
__device__ __forceinline__ void unpack8(u32x4 w, f32x4& a, f32x4& b) { a = (f32x4){bflo(w.x), bfhi(w.x), bflo(w.y), bfhi(w.y)}; b = (f32x4){bflo(w.z), bfhi(w.z), bflo(w.w), bfhi(w.w)}; }

#define XB_TMO      128
#define XB_XCNT(j)  (256  + 64 * (j))
#define XB_XSUB(j)  (1280 + 64 * (j))
#define XB_XGEN(j)  (2304 + 64 * (j))
#define XB_TOP      3328
#define XB_TOPGEN   3392
#define XCD_BAR_WORDS 3456
#define XB_SPIN_CAP (1u << 18)
__device__ __forceinline__ unsigned xb_ld(unsigned* p)              { return __hip_atomic_load(p, __ATOMIC_RELAXED, __HIP_MEMORY_SCOPE_AGENT); }
__device__ __forceinline__ unsigned xb_add(unsigned* p, unsigned v) { return __hip_atomic_fetch_add(p, v, __ATOMIC_RELAXED, __HIP_MEMORY_SCOPE_AGENT); }
__device__ __forceinline__ unsigned xb_xcc_id() { return (unsigned)__builtin_amdgcn_s_getreg((3 << 11) | 20) & 0xFu; }
#define XB_SPIN(cond, bar) do { unsigned _sp = 0; while (cond) { __builtin_amdgcn_s_sleep(1); \
    if ((++_sp & 255u) == 0u) { if (xb_ld(&(bar)[XB_TMO])) break; if (_sp > XB_SPIN_CAP) { atomicAdd(&(bar)[XB_TMO], 1u); break; } } } } while (0)
struct XcdBarrier { unsigned* bar; unsigned x; volatile LAS unsigned* st; };
__device__ __forceinline__ XcdBarrier xcd_barrier_post(unsigned* bar, volatile LAS unsigned* st) {
    XcdBarrier b; b.bar = bar; b.x = xb_xcc_id(); b.st = st;
    if (threadIdx.x == 0) (void)xb_add(&bar[XB_XCNT(b.x)], 1u);
    return b;
}
__device__ __forceinline__ void xcd_barrier_complete(unsigned* bar, unsigned x, unsigned& nloc, unsigned& nx) {
    const unsigned G = gridDim.x * gridDim.y * gridDim.z;
    unsigned sum, cnt, mine, sp = 0u;
    for (;;) {
        sum = 0u; cnt = 0u; mine = 0u;
#pragma unroll
        for (unsigned j = 0; j < 16; ++j) { const unsigned c = xb_ld(&bar[XB_XCNT(j)]); sum += c; cnt += (c > 0u) ? 1u : 0u; mine = (j == x) ? c : mine; }
        if (sum == G) break;
        __builtin_amdgcn_s_sleep(1);
        if ((++sp & 255u) == 0u) { if (xb_ld(&bar[XB_TMO])) break; if (sp > XB_SPIN_CAP) { atomicAdd(&bar[XB_TMO], 1u); break; } }
    }
    nloc = mine > 0u ? mine : 1u; nx = cnt > 0u ? cnt : 1u;
}
__device__ __forceinline__ void xcd_barrier(const XcdBarrier& b) {
    asm volatile("s_waitcnt vmcnt(0)" ::: "memory");
    __syncthreads();
    if (threadIdx.x == 0) {
        unsigned* bar = b.bar;
        __builtin_amdgcn_s_waitcnt(0);
        unsigned nloc = b.st[0], nx = b.st[1];
        if (nloc == 0u) { xcd_barrier_complete(bar, b.x, nloc, nx); b.st[0] = nloc; b.st[1] = nx; }
        const unsigned old = xb_add(&bar[XB_XSUB(b.x)], 1u);
        const unsigned gen = old / nloc;
        if (old + 1u == (gen + 1u) * nloc) {
            __builtin_amdgcn_fence(__ATOMIC_RELEASE, "agent");
            asm volatile("s_waitcnt vmcnt(0)" ::: "memory");
            const unsigned og = xb_add(&bar[XB_TOP], 1u);
            const unsigned tg = og / nx;
            if (og + 1u == (tg + 1u) * nx) xb_add(&bar[XB_TOPGEN], 1u);
            else XB_SPIN(xb_ld(&bar[XB_TOPGEN]) == tg, bar);
            __builtin_amdgcn_fence(__ATOMIC_ACQUIRE, "agent");
            xb_add(&bar[XB_XGEN(b.x)], 1u);
            asm volatile("s_waitcnt vmcnt(0)" ::: "memory");
        } else {
            XB_SPIN(xb_ld(&bar[XB_XGEN(b.x)]) == gen, bar);
            __builtin_amdgcn_fence(__ATOMIC_ACQUIRE, "agent");
            asm volatile("s_waitcnt vmcnt(0)" ::: "memory");
        }
    }
    __syncthreads();
}

namespace g8 {
constexpr int BM = 256, BK = 64, HALF = 128, HTB = HALF * BK * 2, STAGE_BYTES = 8 * HTB;
__device__ __forceinline__ int lds_byte(int r, int c) { const int st = (r >> 4) * 2 + (c >> 5), rr = r & 15, cc = c & 31, ob = rr * 64 + cc * 2; return st * 1024 + (ob ^ (((ob >> 9) & 1) << 5)); }
__device__ __forceinline__ void stage_rc(int b, int& R, int& C) { const int st = b / 1024, sb = b % 1024, swz = sb ^ (((sb >> 9) & 1) << 5); R = (st >> 1) * 16 + swz / 64; C = (st & 1) * 32 + (swz % 64) / 2; }
__device__ __forceinline__ int perm32(int rho) { const int n = rho >> 4, i = rho & 15; return 8 * (i >> 2) + 4 * n + (i & 3); }

struct Unit { int pm, pn, z, rl; const char* A; const char* B; };

typedef int v8i __attribute__((ext_vector_type(8)));
typedef int v4i __attribute__((ext_vector_type(4)));
typedef short s16x16 __attribute__((ext_vector_type(16)));
typedef s16x16 s16x16_a16 __attribute__((aligned(16)));
__device__ __forceinline__ v8i cat8(bf16x8 lo, bf16x8 hi) { const v4i a = __builtin_bit_cast(v4i, lo), b = __builtin_bit_cast(v4i, hi); return __builtin_shufflevector(a, b, 0, 1, 2, 3, 4, 5, 6, 7); }
template <class Epi, class Sched, bool GATHER, bool FP8 = false>
__device__ __forceinline__ void gemm_phase(LAS unsigned char* lds, const int Kb, const int ldaB, const int ldbB, const Sched& S, const Epi& E) {
    const int tid = threadIdx.x, wid = __builtin_amdgcn_readfirstlane(tid >> 6), lane = tid & 63, wr = wid >> 2, wc = wid & 3, fr = lane & 15, fq = lane >> 4;
    const int nt = Kb / 128;
    unsigned voffB[2], cvo[2][2], nvo[2][2]; int Rr[2], Cc[2];
#pragma unroll
    for (int i = 0; i < 2; ++i) { int R, C; stage_rc(tid * 16 + i * 8192, R, C); const int Rb = (R & ~31) + perm32(R & 31);
        voffB[i] = (unsigned)(Rb * ldbB + C * 2); Rr[i] = R; Cc[i] = C;
#pragma unroll
        for (int h = 0; h < 2; ++h) { cvo[h][i] = (unsigned)((h * HALF + R) * ldaB + C * 2); nvo[h][i] = cvo[h][i]; } }
    const size_t kstep = (size_t)(BK * 2);
    const size_t hstepB = (size_t)HALF * ldbB;
    const unsigned ldsw = (unsigned)wid * 1024u;
    const int aoff = FP8 ? lds_byte(wr * 64 + fr, (fq >> 1) * 32 + (fq & 1) * 24) : lds_byte(wr * 64 + fr, fq * 8), boff = FP8 ? lds_byte(wc * 32 + fr, (fq >> 1) * 32 + (fq & 1) * 24) : lds_byte(wc * 32 + fr, fq * 8);
    const int aoff2 = FP8 ? lds_byte(wr * 64 + fr, (fq >> 1) * 32 + 8 + (fq & 1) * 8) : 0, boff2 = FP8 ? lds_byte(wc * 32 + fr, (fq >> 1) * 32 + 8 + (fq & 1) * 8) : 0;
#define G8_SA(b, h) (((b) * 2 + (h)) * HTB)
#define G8_SB(b, h) ((4 + (b) * 2 + (h)) * HTB)
#define G8_STGB(bufoff, gbase) do { _Pragma("unroll") for (int _i = 0; _i < 2; ++_i) \
        __builtin_amdgcn_global_load_lds((const unsigned*)((const char*)(gbase) + voffB[_i]), (LAS unsigned*)(lds + (bufoff) + ldsw + _i * 8192), 16, 0, 0); } while (0)
#define G8_STGA(bufoff, gbase, VO, h) do { _Pragma("unroll") for (int _i = 0; _i < 2; ++_i) \
        __builtin_amdgcn_global_load_lds((const unsigned*)((const char*)(gbase) + VO[h][_i]), (LAS unsigned*)(lds + (bufoff) + ldsw + _i * 8192), 16, 0, 0); } while (0)
#define G8_LDA(dst, b, h) do { _Pragma("unroll") for (int m = 0; m < 4; ++m) { if constexpr (FP8) { dst##8[m] = cat8(*(const LAS bf16x8*)(lds + G8_SA(b, h) + aoff + m * 2048), *(const LAS bf16x8*)(lds + G8_SA(b, h) + aoff2 + m * 2048)); } \
        else { _Pragma("unroll") for (int k = 0; k < 2; ++k) dst[m][k] = *(const LAS bf16x8*)(lds + G8_SA(b, h) + aoff + m * 2048 + k * 1024); } } } while (0)
#define G8_LDB(dst, b, h) do { _Pragma("unroll") for (int n = 0; n < 2; ++n) { if constexpr (FP8) { dst##8[n] = cat8(*(const LAS bf16x8*)(lds + G8_SB(b, h) + boff + n * 2048), *(const LAS bf16x8*)(lds + G8_SB(b, h) + boff2 + n * 2048)); } \
        else { _Pragma("unroll") for (int k = 0; k < 2; ++k) dst[n][k] = *(const LAS bf16x8*)(lds + G8_SB(b, h) + boff + n * 2048 + k * 1024); } } } while (0)
#define G8_MMA(ai, bj, At, Bt) do { __builtin_amdgcn_s_setprio(1); _Pragma("unroll") for (int m = 0; m < 4; ++m) _Pragma("unroll") for (int n = 0; n < 2; ++n) { \
        if constexpr (FP8) asm volatile("s_nop 1\n\tv_mfma_scale_f32_16x16x128_f8f6f4 %0, %1, %2, %0, %3, %4 op_sel_hi:[0,0,0]" : "+v"(acc[ai][bj][m][n]) : "v"(Bt##8[n]), "v"(At##8[m]), "v"(sc_w), "v"(sc_a)); \
        else { _Pragma("unroll") for (int k = 0; k < 2; ++k) acc[ai][bj][m][n] = __builtin_amdgcn_mfma_f32_16x16x32_bf16(Bt[n][k], At[m][k], acc[ai][bj][m][n], 0, 0, 0); } } __builtin_amdgcn_s_setprio(0); } while (0)
#define G8_WAIT_V(n) asm volatile("s_waitcnt vmcnt(" #n ")" ::: "memory")
#define G8_WAIT_L(n) asm volatile("s_waitcnt lgkmcnt(" #n ")" ::: "memory")
#define G8_BAR __builtin_amdgcn_s_barrier()
#define G8_SCHED __builtin_amdgcn_sched_barrier(0)
    Unit cur, nxt; int ui = 0;
    if (!S.next(0, cur)) return;
    bool has_next = S.next(1, nxt);
    if constexpr (GATHER) { S.gather(cur, Rr, Cc, cvo); if (has_next) S.gather(nxt, Rr, Cc, nvo); else {
#pragma unroll
        for (int h = 0; h < 2; ++h)
#pragma unroll
            for (int i = 0; i < 2; ++i) nvo[h][i] = cvo[h][i]; } }
    f32x4 acc[2][2][4][2];
#pragma unroll
    for (int a = 0; a < 2; ++a)
#pragma unroll
        for (int b = 0; b < 2; ++b)
#pragma unroll
            for (int m = 0; m < 4; ++m)
#pragma unroll
                for (int n = 0; n < 2; ++n) acc[a][b][m][n] = (f32x4){0.f, 0.f, 0.f, 0.f};
    const int sc_w = 0x7a7a7a7a, sc_a = 0x7f7f7f7f;
    bf16x8 At[4][2], B0[2][2], B1[2][2]; v8i At8[4], B08[2], B18[2];
    const char* cA = cur.A; const char* cB = cur.B;
    G8_STGB(G8_SB(0, 0), cB); G8_STGB(G8_SB(0, 1), cB + hstepB); G8_STGA(G8_SA(0, 0), cA, cvo, 0); G8_STGA(G8_SA(0, 1), cA, cvo, 1);
    if (wr == 1) G8_BAR;
    G8_WAIT_V(2); G8_BAR;
    G8_STGB(G8_SB(1, 0), cB + kstep); G8_STGA(G8_SA(1, 0), cA + kstep, cvo, 0); G8_STGB(G8_SB(1, 1), cB + hstepB + kstep);
    G8_WAIT_V(6); G8_BAR;
    for (;;) {
        const char* nA = has_next ? nxt.A : cA; const char* nB = has_next ? nxt.B : cB;
        for (int t = 0; t < nt; t += 2) {
            const bool last = (t == nt - 2);
            const char* a1 = cA + (size_t)(t + 1) * kstep;
            const char* a2 = last ? nA : cA + (size_t)(t + 2) * kstep; const char* b2 = last ? nB : cB + (size_t)(t + 2) * kstep;
            const char* a3 = a2 + kstep; const char* b3 = b2 + kstep;
            unsigned vo2[2][2];
#pragma unroll
            for (int h = 0; h < 2; ++h)
#pragma unroll
                for (int i = 0; i < 2; ++i) vo2[h][i] = (GATHER && last) ? nvo[h][i] : cvo[h][i];
            G8_LDB(B0, 0, 0); G8_LDB(B1, 0, 1); G8_SCHED; G8_LDA(At, 0, 0); G8_STGA(G8_SA(1, 1), a1, cvo, 1);
            G8_WAIT_V(8); G8_WAIT_L(0); G8_BAR; G8_SCHED; G8_MMA(0, 0, At, B0); G8_MMA(0, 1, At, B1); G8_SCHED; G8_BAR; G8_SCHED;
            G8_LDA(At, 0, 1); G8_STGB(G8_SB(0, 0), b2); G8_STGB(G8_SB(0, 1), b2 + hstepB); G8_STGA(G8_SA(0, 0), a2, vo2, 0);
            G8_WAIT_V(8); G8_WAIT_L(0); G8_BAR; G8_SCHED; G8_MMA(1, 0, At, B0); G8_MMA(1, 1, At, B1); G8_SCHED; G8_BAR; G8_SCHED;
            G8_LDB(B0, 1, 0); G8_LDB(B1, 1, 1); G8_SCHED; G8_LDA(At, 1, 0); G8_STGA(G8_SA(0, 1), a2, vo2, 1);
            G8_WAIT_V(8); G8_WAIT_L(0); G8_BAR; G8_SCHED; G8_MMA(0, 0, At, B0); G8_MMA(0, 1, At, B1); G8_SCHED; G8_BAR; G8_SCHED;
            G8_LDA(At, 1, 1); G8_STGB(G8_SB(1, 0), b3); G8_STGB(G8_SB(1, 1), b3 + hstepB); G8_STGA(G8_SA(1, 0), a3, vo2, 0);
            G8_WAIT_V(8); G8_WAIT_L(0); G8_BAR; G8_SCHED; G8_MMA(1, 0, At, B0); G8_MMA(1, 1, At, B1); G8_SCHED; G8_BAR; G8_SCHED;
        }
        f32x4 bpre[4]; E.pre(cur, wr, wc, fr, fq, bpre);
        if (wr == 0) G8_BAR;
        Unit nn; bool has_nn = false;
        if (has_next) has_nn = S.next(ui + 2, nn);
        unsigned nnvo[2][2];
        if constexpr (GATHER) { if (has_nn) S.gather(nn, Rr, Cc, nnvo); }
        if constexpr (FP8) asm volatile("s_nop 15\n\ts_nop 15" ::: "memory");
        E(acc, cur, wr, wc, fr, fq, bpre);
        if (!has_next) break;
#pragma unroll
        for (int a = 0; a < 2; ++a)
#pragma unroll
            for (int b = 0; b < 2; ++b)
#pragma unroll
                for (int m = 0; m < 4; ++m)
#pragma unroll
                    for (int n = 0; n < 2; ++n) acc[a][b][m][n] = (f32x4){0.f, 0.f, 0.f, 0.f};
        cur = nxt; cA = nA; cB = nB; ++ui;
        if constexpr (GATHER) {
#pragma unroll
            for (int h = 0; h < 2; ++h)
#pragma unroll
                for (int i = 0; i < 2; ++i) { cvo[h][i] = nvo[h][i]; if (has_nn) nvo[h][i] = nnvo[h][i]; } }
        nxt = nn; has_next = has_nn;
        if (wr == 1) G8_BAR;
    }
    G8_WAIT_V(0);
    G8_BAR;
#undef G8_SA
#undef G8_SB
#undef G8_STGB
#undef G8_STGA
#undef G8_LDA
#undef G8_LDB
#undef G8_MMA
#undef G8_WAIT_V
#undef G8_WAIT_L
#undef G8_BAR
#undef G8_SCHED
}

struct GridOrder {
    int nM, nN, nwg, G, c; const char* A; const char* B; size_t tstepA, tstepB;
    __device__ __forceinline__ void init(int M, int N, int G_, int c_, const void* A_, const void* B_, int ldaB, int ldbB) { nM = M / BM; nN = N / BM; nwg = nM * nN; G = G_; c = c_; A = (const char*)A_; B = (const char*)B_; tstepA = (size_t)BM * ldaB; tstepB = (size_t)BM * ldbB; }
    __device__ __forceinline__ bool next(int i, Unit& u) const {
        const long L = (long)i * G + c; if (L >= nwg) return false;
        int wgid = (int)L; { const int q = nwg / 8, r = nwg % 8, xcd = wgid % 8, off = wgid / 8; wgid = (xcd < r ? xcd * (q + 1) : r * (q + 1) + (xcd - r) * q) + off; }
        const int nig = 8 * nN, gid = wgid / nig, fm = gid * 8, gsz = (nM - fm) < 8 ? (nM - fm) : 8;
        u.pm = fm + ((wgid % nig) % gsz); u.pn = (wgid % nig) / gsz; u.z = 0; u.rl = 0;
        u.A = A + (size_t)u.pm * tstepA; u.B = B + (size_t)u.pn * tstepB; return true;
    }
};
}

struct Frame {
    LAS unsigned char* lds; volatile LAS unsigned* MISC; unsigned* ctl;
    int tid, lane, wave, vcu, G;
    const float* in[34]; float* out; unsigned char* ws;
};
#define WSP(T_, off) ((T_*)(F.ws + (off)))

struct EpiInProj { static constexpr int NST = 16;
    __device__ __forceinline__ void pre(const g8::Unit& u, int, int wc, int, int fq, f32x4 (&bp)[4]) const { const int colb = u.pn * 256 + wc * 32 + 8 * fq;
#pragma unroll
        for (int bj = 0; bj < 2; ++bj)
#pragma unroll
            for (int n = 0; n < 2; ++n) bp[bj * 2 + n] = *(const f32x4*)(bias + colb + bj * 128 + 4 * n); }
    const float* bias; bf16 *xrnn, *gy, *acat, *gates;
    template <int KIND>
    __device__ __forceinline__ void run(const f32x4 (&acc)[2][2][4][2], const g8::Unit& u, int wr, int wc, int fr, int fq, const f32x4 (&bpre)[4]) const {
        const int colb = u.pn * 256 + wc * 32 + 8 * fq;
#pragma unroll
        for (int ai = 0; ai < 2; ++ai)
#pragma unroll
            for (int m = 0; m < 4; ++m) { const int t = u.pm * 256 + ai * 128 + wr * 64 + m * 16 + fr;
#pragma unroll
                for (int bj = 0; bj < 2; ++bj) { f32x4 v0 = acc[ai][bj][m][0] + bpre[bj * 2], v1 = acc[ai][bj][m][1] + bpre[bj * 2 + 1]; const int col = colb + bj * 128;
                    if (KIND == 0) { u32x2 w8; w8.x = pk4_fp8(v0[0], v0[1], v0[2], v0[3]); w8.y = pk4_fp8(v1[0], v1[1], v1[2], v1[3]); *(u32x2*)((unsigned char*)xrnn + (size_t)t * 1024 + col) = w8; }
                    else if (KIND == 1) {
#pragma unroll
                        for (int j = 0; j < 4; ++j) { v0[j] = gelu_tanh(v0[j]); v1[j] = gelu_tanh(v1[j]); }
                        u32x2 w8; w8.x = pk4_fp8(v0[0], v0[1], v0[2], v0[3]); w8.y = pk4_fp8(v1[0], v1[1], v1[2], v1[3]); *(u32x2*)((unsigned char*)gy + (size_t)t * 1024 + (col - 1024)) = w8; }
                    else if (KIND == 2) { const int cu = col - 2048, g = cu >> 4, c = cu & 15;
                        *(u32x4*)(acat + ((size_t)(g * S5M + (t >> 5)) * S5ROW + 128 + (t & 31) * 16 + c)) = pack8(v0, v1); }
                    else {
#pragma unroll
                        for (int j = 0; j < 4; ++j) { v0[j] = fast_sigmoid(v0[j]); v1[j] = fast_sigmoid(v1[j]); }
                        u32x2 w8; w8.x = pk4_fp8(v0[0], v0[1], v0[2], v0[3]); w8.y = pk4_fp8(v1[0], v1[1], v1[2], v1[3]); *(u32x2*)((unsigned char*)gates + (size_t)t * 2048 + (col - 2560)) = w8; } } }
    }
    __device__ __forceinline__ void operator()(const f32x4 (&acc)[2][2][4][2], const g8::Unit& u, int wr, int wc, int fr, int fq, const f32x4 (&bpre)[4]) const {
        const int pn = u.pn;
        if (pn < 4) run<0>(acc, u, wr, wc, fr, fq, bpre); else if (pn < 8) run<1>(acc, u, wr, wc, fr, fq, bpre); else if (pn < 10) run<2>(acc, u, wr, wc, fr, fq, bpre); else run<3>(acc, u, wr, wc, fr, fq, bpre);
    }
};
struct EpiS5A {
    __device__ __forceinline__ void pre(const g8::Unit&, int, int, int, int, f32x4 (&)[4]) const {}
    float* S;
    __device__ __forceinline__ void operator()(const f32x4 (&acc)[2][2][4][2], const g8::Unit& u, int wr, int wc, int fr, int fq, const f32x4 (&bpre)[4]) const {
        const int col = wc * 32 + 8 * fq;
#pragma unroll
        for (int ai = 0; ai < 2; ++ai)
#pragma unroll
            for (int m = 0; m < 4; ++m) { const int row = u.pm * 256 + ai * 128 + wr * 64 + m * 16 + fr; float* p = S + ((size_t)(u.z * S5M + row)) * 128 + col;
                *(f32x4*)p = acc[ai][0][m][0]; *(f32x4*)(p + 4) = acc[ai][0][m][1]; }
    }
};
struct EpiS5C {
    __device__ __forceinline__ void pre(const g8::Unit&, int, int, int, int, f32x4 (&)[4]) const {}
    bf16* ys;
    __device__ __forceinline__ void operator()(const f32x4 (&acc)[2][2][4][2], const g8::Unit& u, int wr, int wc, int fr, int fq, const f32x4 (&bpre)[4]) const {
#pragma unroll
        for (int ai = 0; ai < 2; ++ai)
#pragma unroll
            for (int m = 0; m < 4; ++m) { const int row = u.pm * 256 + ai * 128 + wr * 64 + m * 16 + fr;
#pragma unroll
                for (int bj = 0; bj < 2; ++bj) { const int n = u.pn * 256 + bj * 128 + wc * 32 + 8 * fq, i = n >> 4, c = n & 15; f32x4 v0 = acc[ai][bj][m][0], v1 = acc[ai][bj][m][1];
#pragma unroll
                    for (int j = 0; j < 4; ++j) { v0[j] = gelu_tanh(v0[j]); v1[j] = gelu_tanh(v1[j]); }
                    u32x2 w8; w8.x = pk4_fp8(v0[0], v0[1], v0[2], v0[3]); w8.y = pk4_fp8(v1[0], v1[1], v1[2], v1[3]); *(u32x2*)((unsigned char*)ys + (size_t)(row * 32 + i) * 512 + u.z * 16 + c) = w8; } }
    }
};
struct EpiGlu { static constexpr int NST = 8;
    __device__ __forceinline__ void pre(const g8::Unit&, int, int, int, int, f32x4 (&)[4]) const {}
    const bf16* gates; bf16* gb;
    __device__ __forceinline__ void operator()(const f32x4 (&acc)[2][2][4][2], const g8::Unit& u, int wr, int wc, int fr, int fq, const f32x4 (&bpre)[4]) const {
        const int f = u.pn * 128 + wc * 32 + 8 * fq;
#pragma unroll
        for (int ai = 0; ai < 2; ++ai) { u32x2 gw[4];
#pragma unroll
            for (int m = 0; m < 4; ++m) { const int t = u.pm * 256 + ai * 128 + wr * 64 + m * 16 + fr; gw[m] = *(const u32x2*)((const unsigned char*)gates + (size_t)t * 2048 + 1024 + f); }
#pragma unroll
            for (int m = 0; m < 4; ++m) { const int t = u.pm * 256 + ai * 128 + wr * 64 + m * 16 + fr;
                f32x4 g0, g1; unpack8_fp8(gw[m], g0, g1);
                f32x4 v0 = acc[ai][0][m][0], v1 = acc[ai][0][m][1]; const f32x4 s0 = acc[ai][1][m][0], s1 = acc[ai][1][m][1];
#pragma unroll
                for (int j = 0; j < 4; ++j) { v0[j] = g0[j] * v0[j] * fast_sigmoid(s0[j]); v1[j] = g1[j] * v1[j] * fast_sigmoid(s1[j]); }
                u32x2 w8; w8.x = pk4_fp8(v0[0], v0[1], v0[2], v0[3]); w8.y = pk4_fp8(v1[0], v1[1], v1[2], v1[3]); *(u32x2*)((unsigned char*)gb + (size_t)t * 1024 + f) = w8; } }
    }
};
struct EpiRnn { static constexpr int NST = 16;
    __device__ __forceinline__ void pre(const g8::Unit&, int, int, int, int, f32x4 (&)[4]) const {}
    const bf16* gates; const bf16* gb; bf16* merged;
    __device__ __forceinline__ void operator()(const f32x4 (&acc)[2][2][4][2], const g8::Unit& u, int wr, int wc, int fr, int fq, const f32x4 (&bpre)[4]) const {
#pragma unroll
        for (int ai = 0; ai < 2; ++ai)
#pragma unroll
            for (int mh = 0; mh < 2; ++mh) { u32x2 gw[2][2], bw[2][2];
#pragma unroll
                for (int mm = 0; mm < 2; ++mm) { const int t = u.pm * 256 + ai * 128 + wr * 64 + (2 * mh + mm) * 16 + fr;
#pragma unroll
                    for (int bj = 0; bj < 2; ++bj) { const int col = u.pn * 256 + bj * 128 + wc * 32 + 8 * fq; gw[mm][bj] = *(const u32x2*)((const unsigned char*)gates + (size_t)t * 2048 + col); bw[mm][bj] = *(const u32x2*)((const unsigned char*)gb + (size_t)t * 1024 + col); } }
#pragma unroll
                for (int mm = 0; mm < 2; ++mm) { const int m = 2 * mh + mm, t = u.pm * 256 + ai * 128 + wr * 64 + m * 16 + fr;
#pragma unroll
                    for (int bj = 0; bj < 2; ++bj) { const int col = u.pn * 256 + bj * 128 + wc * 32 + 8 * fq;
                        f32x4 g0, g1, b0, b1; unpack8_fp8(gw[mm][bj], g0, g1); unpack8_fp8(bw[mm][bj], b0, b1);
                        const f32x4 v0 = g0 * acc[ai][bj][m][0] + b0, v1 = g1 * acc[ai][bj][m][1] + b1;
                        u32x2 w8; w8.x = pk4_fp8(v0[0], v0[1], v0[2], v0[3]); w8.y = pk4_fp8(v1[0], v1[1], v1[2], v1[3]); *(u32x2*)((unsigned char*)merged + (size_t)t * 1024 + col) = w8; } } }
    }
};
struct EpiOut { static constexpr int NST = 16;
    const float* x; const float* mod; bf16* v1;
    __device__ __forceinline__ void pre(const g8::Unit& u, int, int wc, int, int fq, f32x4 (&bp)[4]) const { const int b = (u.pm * 256) >> 12; const float* p = mod + b * 6144 + 2048 + u.pn * 256 + wc * 32 + 8 * fq;
        bp[0] = *(const f32x4*)p; bp[1] = *(const f32x4*)(p + 4); bp[2] = *(const f32x4*)(p + 128); bp[3] = *(const f32x4*)(p + 132); }
    __device__ __forceinline__ void operator()(const f32x4 (&acc)[2][2][4][2], const g8::Unit& u, int wr, int wc, int fr, int fq, const f32x4 (&bpre)[4]) const {
#pragma unroll
        for (int ai = 0; ai < 2; ++ai)
#pragma unroll
            for (int mh = 0; mh < 2; ++mh) { f32x4 xv[2][2][2];
#pragma unroll
                for (int mm = 0; mm < 2; ++mm) { const int t = u.pm * 256 + ai * 128 + wr * 64 + (2 * mh + mm) * 16 + fr;
#pragma unroll
                    for (int bj = 0; bj < 2; ++bj) { const int col = u.pn * 256 + bj * 128 + wc * 32 + 8 * fq; xv[mm][bj][0] = *(const f32x4*)(x + (size_t)t * 1024 + col); xv[mm][bj][1] = *(const f32x4*)(x + (size_t)t * 1024 + col + 4); } }
#pragma unroll
                for (int mm = 0; mm < 2; ++mm) { const int m = 2 * mh + mm, t = u.pm * 256 + ai * 128 + wr * 64 + m * 16 + fr;
#pragma unroll
                    for (int bj = 0; bj < 2; ++bj) { const int col = u.pn * 256 + bj * 128 + wc * 32 + 8 * fq;
                        const f32x4 v0 = xv[mm][bj][0] * DN_ALPHA + (bpre[2 * bj] + 1.0f) * acc[ai][bj][m][0], v1_ = xv[mm][bj][1] * DN_ALPHA + (bpre[2 * bj + 1] + 1.0f) * acc[ai][bj][m][1];
                        *(u32x4*)(v1 + (size_t)t * 1024 + col) = pack8(v0, v1_); } } }
    }
};
struct EpiMoe1 {
    __device__ __forceinline__ void pre(const g8::Unit& u, int, int wc, int, int fq, f32x4 (&bp)[4]) const { const float* p = bgu + (size_t)u.z * 2048 + u.pn * 128 + wc * 32 + 8 * fq; bp[0] = *(const f32x4*)p; bp[1] = *(const f32x4*)(p + 4); bp[2] = *(const f32x4*)(p + 1024); bp[3] = *(const f32x4*)(p + 1028); }
    const float* bgu; bf16* act;
    __device__ __forceinline__ void operator()(const f32x4 (&acc)[2][2][4][2], const g8::Unit& u, int wr, int wc, int fr, int fq, const f32x4 (&bpre)[4]) const {
        const int f = u.pn * 128 + wc * 32 + 8 * fq; const float* bp = bgu + (size_t)u.z * 2048 + f;
        (void)bp; const f32x4 bg0 = bpre[0], bg1 = bpre[1], bu0 = bpre[2], bu1 = bpre[3];
#pragma unroll
        for (int ai = 0; ai < 2; ++ai)
#pragma unroll
            for (int m = 0; m < 4; ++m) { const int row = u.pm * 256 + ai * 128 + wr * 64 + m * 16 + fr;
                f32x4 g0 = acc[ai][0][m][0] + bg0, g1 = acc[ai][0][m][1] + bg1, u0 = acc[ai][1][m][0] + bu0, u1 = acc[ai][1][m][1] + bu1;
#pragma unroll
                for (int j = 0; j < 4; ++j) { const float ga = fminf(g0[j], 7.0f), gb_ = fminf(g1[j], 7.0f), ua = fminf(fmaxf(u0[j], -7.0f), 7.0f), ub = fminf(fmaxf(u1[j], -7.0f), 7.0f);
                    g0[j] = ga * fast_sigmoid(1.702f * ga) * (ua + 1.0f); g1[j] = gb_ * fast_sigmoid(1.702f * gb_) * (ub + 1.0f); }
                u32x2 w8; w8.x = pk4_fp8(g0[0], g0[1], g0[2], g0[3]); w8.y = pk4_fp8(g1[0], g1[1], g1[2], g1[3]); *(u32x2*)((unsigned char*)act + (size_t)row * 1024 + f) = w8; }
    }
};
struct EpiMoe2 {
    __device__ __forceinline__ void pre(const g8::Unit& u, int, int wc, int, int fq, f32x4 (&bp)[4]) const { const float* p = bd + (size_t)u.z * 1024 + u.pn * 256 + wc * 32 + 8 * fq; bp[0] = *(const f32x4*)p; bp[1] = *(const f32x4*)(p + 4); bp[2] = *(const f32x4*)(p + 128); bp[3] = *(const f32x4*)(p + 132); }
    const float* bd; bf16* yb;
    __device__ __forceinline__ void operator()(const f32x4 (&acc)[2][2][4][2], const g8::Unit& u, int wr, int wc, int fr, int fq, const f32x4 (&bpre)[4]) const {
#pragma unroll
        for (int bj = 0; bj < 2; ++bj) { const int col = u.pn * 256 + bj * 128 + wc * 32 + 8 * fq; const float* bp = bd + (size_t)u.z * 1024 + col;
            (void)bp; const f32x4 b0 = bpre[bj * 2], b1 = bpre[bj * 2 + 1];
#pragma unroll
            for (int ai = 0; ai < 2; ++ai)
#pragma unroll
                for (int m = 0; m < 4; ++m) { const int row = u.pm * 256 + ai * 128 + wr * 64 + m * 16 + fr;
                    const f32x4 y0 = acc[ai][bj][m][0] + b0, y1 = acc[ai][bj][m][1] + b1; u32x2 w8; w8.x = pk4_fp8(y0[0], y0[1], y0[2], y0[3]); w8.y = pk4_fp8(y1[0], y1[1], y1[2], y1[3]);
                    *(u32x2*)((unsigned char*)yb + (size_t)row * 1024 + col) = w8; } }
    }
};

struct S5AOrder { int G, c; const char* acat; const char* ws;
    __device__ __forceinline__ bool next(int i, g8::Unit& u) const { const int L = i * G + c; if (L >= S5G * 4) return false; u.z = L >> 2; u.pm = L & 3; u.pn = 0; u.rl = 0;
        u.A = acat + ((size_t)(u.z * S5M + u.pm * 256) * S5ROW + 128) * 2; u.B = ws + (size_t)u.z * 256 * (S5L * 16) * 2; return true; } };
struct S5COrder { int G, c; const char* acat; const char* wy;
    __device__ __forceinline__ bool next(int i, g8::Unit& u) const { const int L = i * G + c; if (L >= S5G * 8) return false; u.z = L >> 3; u.pm = (L >> 1) & 3; u.pn = L & 1; u.rl = 0;
        u.A = acat + ((size_t)(u.z * S5M + u.pm * 256) * S5ROW) * 2; u.B = wy + ((size_t)(u.z * 512 + u.pn * 256) * S5ROW) * 2; return true; } };
struct MoeOrder { int G, c, NT, RT; const LAS int* tstart; const LAS int* cnt; const int* toklist; const char* A; const char* B; size_t bstride_e; int lda; bool gatherA;
    __device__ __forceinline__ bool next(int i, g8::Unit& u) const { const int per = G >> 3, xcd = c & 7, slot = c >> 3, rpx = per / NT;
        const int rt = (i * 8 + xcd) * rpx + slot / NT; if (rt >= RT) return false; u.pn = slot % NT;
        const int lane_ = threadIdx.x & 63; const unsigned long long mk_ = __ballot(lane_ < NE && tstart[lane_ & 31] <= rt);
        const int e = __builtin_popcountll(mk_) - 1;
        u.z = e; u.pm = rt; u.rl = rt - tstart[e]; u.B = B + (size_t)e * bstride_e + (size_t)u.pn * 256 * 1024; u.A = gatherA ? A : A + (size_t)rt * 256 * 1024; return true; }
    __device__ __forceinline__ void gather(const g8::Unit& u, const int (&Rr)[2], const int (&Cc)[2], unsigned (&vo)[2][2]) const {
        const int n = cnt[u.z];
#pragma unroll
        for (int h = 0; h < 2; ++h)
#pragma unroll
            for (int i = 0; i < 2; ++i) { const int r = u.rl * 256 + h * 128 + Rr[i]; const int rc = r < n ? r : n - 1; const int tok = toklist[u.z * T + rc]; vo[h][i] = (unsigned)(tok * lda + Cc[i] * 2); } }
};

__device__ __forceinline__ void transpose_item(const float* W, int N, int k0, int n0, bf16* dst, int ldd, int drow0, LAS float* scr, int lane) {
    float wv_[32];
#pragma unroll
    for (int i = 0; i < 32; ++i) wv_[i] = W[(size_t)(k0 + 2 * i + (lane >> 5)) * N + n0 + (lane & 31)];
#pragma unroll
    for (int i = 0; i < 32; ++i) scr[(2 * i + (lane >> 5)) * 33 + (lane & 31)] = wv_[i];
    asm volatile("s_waitcnt lgkmcnt(0)" ::: "memory");
    const int c = lane & 7;
#pragma unroll
    for (int j = 0; j < 4; ++j) { const int n = (lane >> 3) + 8 * j; const LAS float* s = scr + (8 * c) * 33 + n;
        u32x4 o; o.x = pk2(s[0 * 33], s[1 * 33]); o.y = pk2(s[2 * 33], s[3 * 33]); o.z = pk2(s[4 * 33], s[5 * 33]); o.w = pk2(s[6 * 33], s[7 * 33]);
        *(u32x4*)(dst + (size_t)(drow0 + n) * ldd + k0 + 8 * c) = o; }
    asm volatile("s_waitcnt lgkmcnt(0)" ::: "memory");
}
__device__ __forceinline__ void transpose_item8(const float* W, int N, int k0, int n0, unsigned char* dst, int ldd, int drow0, LAS float* scr, int lane) {
    float wv_[32];
#pragma unroll
    for (int i = 0; i < 32; ++i) wv_[i] = W[(size_t)(k0 + 2 * i + (lane >> 5)) * N + n0 + (lane & 31)];
#pragma unroll
    for (int i = 0; i < 32; ++i) scr[(2 * i + (lane >> 5)) * 33 + (lane & 31)] = wv_[i];
    asm volatile("s_waitcnt lgkmcnt(0)" ::: "memory");
    const int c = lane & 7;
#pragma unroll
    for (int j = 0; j < 4; ++j) { const int n = (lane >> 3) + 8 * j; const LAS float* s = scr + (8 * c) * 33 + n;
        u32x2 o; o.x = pk4_fp8(32.f * s[0 * 33], 32.f * s[1 * 33], 32.f * s[2 * 33], 32.f * s[3 * 33]); o.y = pk4_fp8(32.f * s[4 * 33], 32.f * s[5 * 33], 32.f * s[6 * 33], 32.f * s[7 * 33]);
        *(u32x2*)(dst + (size_t)(drow0 + n) * ldd + k0 + 8 * c) = o; }
    asm volatile("s_waitcnt lgkmcnt(0)" ::: "memory");
}
__device__ __forceinline__ void transpose_item8w(const float* W, int N, int k0, int n0, unsigned char* dst, int ldd, int drow0, LAS float* scr, int lane) {
    float wv[64]; const float* wp = W + (size_t)(k0 + (lane >> 5)) * N + n0 + (lane & 31);
#pragma unroll
    for (int i = 0; i < 64; ++i) wv[i] = wp[(size_t)(2 * i) * N];
#pragma unroll
    for (int i = 0; i < 64; ++i) scr[(2 * i + (lane >> 5)) * 33 + (lane & 31)] = wv[i];
    asm volatile("s_waitcnt lgkmcnt(0)" ::: "memory");
    const int c = lane & 7;
#pragma unroll
    for (int j = 0; j < 4; ++j) { const int n = (lane >> 3) + 8 * j; const LAS float* s = scr + (16 * c) * 33 + n;
        u32x4 o; o.x = pk4_fp8(32.f * s[0 * 33], 32.f * s[1 * 33], 32.f * s[2 * 33], 32.f * s[3 * 33]); o.y = pk4_fp8(32.f * s[4 * 33], 32.f * s[5 * 33], 32.f * s[6 * 33], 32.f * s[7 * 33]);
        o.z = pk4_fp8(32.f * s[8 * 33], 32.f * s[9 * 33], 32.f * s[10 * 33], 32.f * s[11 * 33]); o.w = pk4_fp8(32.f * s[12 * 33], 32.f * s[13 * 33], 32.f * s[14 * 33], 32.f * s[15 * 33]);
        *(u32x4*)(dst + (size_t)(drow0 + n) * ldd + k0 + 16 * c) = o; }
    asm volatile("s_waitcnt lgkmcnt(0)" ::: "memory");
}
__device__ __forceinline__ int pair_row(int n) { const int f = n & 1023, hi = n >> 10; return (f >> 7) * 256 + hi * 128 + (f & 127); }

__device__ __forceinline__ void moe_tables(Frame& F) {
    LAS int* tstart = (LAS int*)(F.lds + TAB_OFF); LAS int* cl = tstart + 40;
    if (F.tid < 64) {
        const int e = F.lane & 31; const int c = (int)F.ctl[CW_CNT + 64 * e]; int inc = (c + 255) >> 8;
#pragma unroll
        for (int o = 1; o < 32; o <<= 1) { const int v = __shfl_up(inc, o); if ((F.lane & 31) >= o) inc += v; }
        if (F.lane < 32) { cl[e] = c; tstart[e] = inc - ((c + 255) >> 8); if (e == NE - 1) tstart[NE] = inc; }
    }
    __syncthreads();
}

__device__ __forceinline__ void p0_mod_job(Frame& F, int job) {
    LAS float* sc = (LAS float*)F.lds;
    LAS float* red = sc + 8 * 1024;
    const float* c = F.in[1]; const float* w = F.in[2]; const float* bias = F.in[3];
    for (int i = F.tid; i < 8 * 1024; i += 512) { const float v = c[i]; sc[i] = v * fast_sigmoid(v); }
    __syncthreads();
    const int col = F.tid & 31, kg = F.tid >> 5, j = job * 32 + col;
    float a[8];
#pragma unroll
    for (int b = 0; b < 8; ++b) a[b] = 0.f;
#pragma unroll 32
    for (int k = kg * 64; k < kg * 64 + 64; ++k) { const float wv = w[(size_t)k * 6144 + j];
#pragma unroll
        for (int b = 0; b < 8; ++b) a[b] += sc[b * 1024 + k] * wv; }
#pragma unroll
    for (int b = 0; b < 8; ++b) red[(kg * 8 + b) * 32 + col] = a[b];
    __syncthreads();
    if (F.tid < 256) { const int b = F.tid >> 5, cc = F.tid & 31; float s = 0.f;
#pragma unroll
        for (int g = 0; g < 16; ++g) s += red[(g * 8 + b) * 32 + cc];
        WSP(float, WS_MOD)[b * 6144 + job * 32 + cc] = s + bias[job * 32 + cc]; }
    __syncthreads();
}
__device__ __forceinline__ void s5_setup(Frame& F, int g, int kmin, int kmax, LAS f32x2* Bb, LAS f32x2* Cc, LAS f32x2* Ap) {
    const float* lre = F.in[14] + g * 64; const float* lim = F.in[15] + g * 64; const float dt = expf(F.in[16][g]);
    const float* bre = F.in[17] + g * 1024; const float* bim = F.in[18] + g * 1024; const float* cre = F.in[19] + g * 1024; const float* cim = F.in[20] + g * 1024;
    for (int i = F.tid; i < 1024; i += 512) { const int p = i >> 4; const float lr = lre[p], li = lim[p]; const float mag = expf(lr * dt); float sn, cs; sincosf(li * dt, &sn, &cs);
        const float ar = mag * cs, ai = mag * sn, den = lr * lr + li * li, qr = ((ar - 1.f) * lr + ai * li) / den, qi = (ai * lr - (ar - 1.f) * li) / den;
        const float br = bre[i], bi = bim[i]; Bb[i] = (f32x2){qr * br - qi * bi, qr * bi + qi * br};
        Cc[i] = (f32x2){cre[i], cim[i]}; }
    if (F.tid < 64) { const int p = F.tid; const float lr = lre[p], li = lim[p]; const float mag = expf(lr * dt); float sn, cs; sincosf(li * dt, &sn, &cs);
        const float ar = mag * cs, ai = mag * sn; float xr_ = 1.f, xi_ = 0.f;
        for (int k = 0; k <= kmax; ++k) { if (k >= kmin) Ap[k * 64 + p] = (f32x2){xr_, xi_}; const float nr = xr_ * ar - xi_ * ai, ni = xr_ * ai + xi_ * ar; xr_ = nr; xi_ = ni; } }
    __syncthreads();
}
constexpr size_t WS_KTAB = WS_S;
constexpr size_t WS_WRIMG = WS_AL + 512 * 1024;
__device__ __forceinline__ void p0_s5k_job(Frame& F, int job) {
    const int g = job >> 3, part = job & 7;
    LAS f32x2* Bb = (LAS f32x2*)F.lds; LAS f32x2* Cc = Bb + 1024; LAS f32x2* Ap = Cc + 1024;
    s5_setup(F, g, 4 * part, 4 * part + 3, Bb, Cc, Ap);
    float* kt = WSP(float, WS_KTAB) + (size_t)g * 32 * 256;
    for (int e = 4 * part * 256 + F.tid; e < (4 * part + 4) * 256; e += 512) { const int k = e >> 8, c = (e >> 4) & 15, c2 = e & 15; float s = 0.f;
        for (int p = 0; p < 64; ++p) { const f32x2 cv = Cc[c * 64 + p], av = Ap[k * 64 + p], bv = Bb[p * 16 + c2];
            const float car = cv.x * av.x - cv.y * av.y, cai = cv.x * av.y + cv.y * av.x; s += car * bv.x - cai * bv.y; }
        kt[e] = s; }
    __syncthreads();
}
__device__ __forceinline__ void p1_s5w_job(Frame& F, int job) {
    const int g = job >> 3, part = job & 7;
    LAS f32x2* Bb = (LAS f32x2*)F.lds; LAS f32x2* Cc = Bb + 1024; LAS f32x2* Ap = Cc + 1024; LAS float* Kt = (LAS float*)(Ap + 33 * 64);
    const float* ktg = WSP(float, WS_KTAB) + (size_t)g * 32 * 256; const float* dsk = F.in[21] + g * 16;
    for (int i = F.tid; i < 32 * 256; i += 512) Kt[i] = ktg[i];
    s5_setup(F, g, 0, S5L, Bb, Cc, Ap);
    if (part == 0 && F.tid < 64) WSP(f32x2, WS_AL)[g * 64 + F.tid] = Ap[S5L * 64 + F.tid];
    bf16* wy = WSP(bf16, WS_WY) + (size_t)g * 512 * S5ROW;
    for (int ch = F.tid; ch < 64 * (S5ROW / 8); ch += 512) { const int n = part * 64 + ch / (S5ROW / 8), k8 = (ch % (S5ROW / 8)) * 8, i = n >> 4, c = n & 15; float v[8]; const float dskc = dsk[c];
        if (k8 < 128) {
#pragma unroll
            for (int j = 0; j < 8; j += 2) { const int p = (k8 + j) >> 1; const f32x2 cv = Cc[c * 64 + p], av = Ap[(i + 1) * 64 + p]; v[j] = cv.x * av.x - cv.y * av.y; v[j + 1] = -(cv.x * av.y + cv.y * av.x); } }
        else { const int jj = (k8 - 128) >> 4, c2 = (k8 - 128) & 15;
#pragma unroll
            for (int j = 0; j < 8; ++j) { float x = 0.f; if (jj <= i) { x = Kt[(i - jj) * 256 + c * 16 + c2 + j]; x += (jj == i && c == c2 + j) ? dskc : 0.f; } v[j] = x; } }
        u32x4 o; o.x = pk2(v[0], v[1]); o.y = pk2(v[2], v[3]); o.z = pk2(v[4], v[5]); o.w = pk2(v[6], v[7]);
        *(u32x4*)(wy + (size_t)n * S5ROW + k8) = o; }
    bf16* wsm = WSP(bf16, WS_WS) + (size_t)g * 256 * 512;
    for (int ch = F.tid; ch < 32 * 64; ch += 512) { const int n = part * 32 + (ch >> 6), k8 = (ch & 63) * 8, jj = k8 >> 4, c2 = k8 & 15; float v[8];
#pragma unroll
        for (int j = 0; j < 8; ++j) { float x = 0.f; if (n < 128) { const int p = n >> 1; const f32x2 av = Ap[(S5L - 1 - jj) * 64 + p], bv = Bb[p * 16 + c2 + j]; x = (n & 1) ? (av.x * bv.y + av.y * bv.x) : (av.x * bv.x - av.y * bv.y); } v[j] = x; }
        u32x4 o; o.x = pk2(v[0], v[1]); o.y = pk2(v[2], v[3]); o.z = pk2(v[4], v[5]); o.w = pk2(v[6], v[7]);
        *(u32x4*)(wsm + (size_t)n * 512 + k8) = o; }
    __syncthreads();
}
__device__ __forceinline__ void p0_small_transposes(Frame& F) {
    LAS float* scr = (LAS float*)(F.lds + F.wave * 16384);
    const int gw = F.vcu * 8 + F.wave, NGW = F.G * 8;
    constexpr int I_IN = 16 * 144, I_RNN = 16 * 32, I_OUT = 16 * 32, I_GLU = 8 * 64, I_RG = 16 * 8;
    for (int it = gw; it < I_IN + I_RNN + I_OUT + I_GLU + I_RG; it += NGW) { int r = it;
        if (r < I_IN) { const int kb = r / 144, nb = r % 144; transpose_item8(F.in[4], INC, kb * 64, nb * 32, WSP(unsigned char, WS_WIN), 1024, nb * 32, scr, F.lane); continue; } r -= I_IN;
        if (r < I_RNN) { const int kb = r / 32, nb = r % 32; transpose_item8(F.in[13], 1024, kb * 64, nb * 32, WSP(unsigned char, WS_WRNN), 1024, nb * 32, scr, F.lane); continue; } r -= I_RNN;
        if (r < I_OUT) { const int kb = r / 32, nb = r % 32; transpose_item8(F.in[23], 1024, kb * 64, nb * 32, WSP(unsigned char, WS_WOUT), 1024, nb * 32, scr, F.lane); continue; } r -= I_OUT;
        if (r < I_GLU) { const int kb = r / 64, nb = r % 64; transpose_item8(F.in[22], 2048, kb * 64, nb * 32, WSP(unsigned char, WS_WGLU), 512, pair_row(nb * 32), scr, F.lane); continue; } r -= I_GLU;
        { const int mat = r >> 3, kb = (r >> 2) & 1, nb = r & 3, hd = mat & 7, gx = mat >> 3;
          transpose_item(F.in[gx ? 10 : 8] + (size_t)hd * 128 * 128, 128, kb * 64, nb * 32, WSP(bf16, WS_WG), 128, hd * 256 + gx * 128 + nb * 32, scr, F.lane); }
    }
}
__device__ __forceinline__ void p1_body(Frame& F) {
    const int gw = F.vcu * 8 + F.wave, NGW = F.G * 8; const float* mod = WSP(float, WS_MOD); bf16* hbf = WSP(bf16, WS_HBF);
    for (int tb = 4 * gw; tb < T; tb += 4 * NGW) {
        const int b = tb >> 12; f32x4 xv[4][4], shv[4], scv[4];
#pragma unroll
        for (int r = 0; r < 4; ++r) { const f32x4* xr = (const f32x4*)(F.in[0] + (size_t)(tb + r) * 1024) + F.lane;
#pragma unroll
            for (int j = 0; j < 4; ++j) xv[r][j] = xr[64 * j]; }
#pragma unroll
        for (int j = 0; j < 4; ++j) { shv[j] = *((const f32x4*)(mod + b * 6144) + F.lane + 64 * j); scv[j] = *((const f32x4*)(mod + b * 6144 + 1024) + F.lane + 64 * j) + 1.0f; }
#pragma unroll
        for (int r = 0; r < 4; ++r) { unsigned* o = (unsigned*)((unsigned char*)hbf + (size_t)(tb + r) * 1024) + F.lane;
#pragma unroll
            for (int j = 0; j < 4; ++j) { const f32x4 v = xv[r][j] * scv[j] + shv[j]; o[64 * j] = pk4_fp8(v[0], v[1], v[2], v[3]); } } }
    constexpr int TP = 132;
    LAS float* tile = (LAS float*)F.lds;
    constexpr int TILES_GU = 8 * 16, TILES_D = 8 * 8, TILES_E = TILES_GU + TILES_D;
    const int lr = F.tid >> 5, lc4 = (F.tid & 31) * 4, tn = F.tid >> 2, kc = F.tid & 3;
    f32x4 pre[8];
    int ti = F.vcu;
#define P1_SRC(idx, src, N_, dstp, drow0_, k0_) do { const int e_ = (idx) / TILES_E, r_ = (idx) % TILES_E; \
        if (r_ < TILES_GU) { const int kb_ = r_ >> 4, nb_ = r_ & 15; N_ = 2048; src = F.in[28] + (size_t)e_ * 1024 * 2048 + (size_t)(kb_ * 128) * 2048 + nb_ * 128; dstp = WSP(unsigned char, WS_WGU) + (size_t)e_ * 2048 * 1024; drow0_ = pair_row(nb_ * 128); k0_ = kb_ * 128; } \
        else { const int q_ = r_ - TILES_GU, kb_ = q_ >> 3, nb_ = q_ & 7; N_ = 1024; src = F.in[30] + (size_t)e_ * 1024 * 1024 + (size_t)(kb_ * 128) * 1024 + nb_ * 128; dstp = WSP(unsigned char, WS_WD) + (size_t)e_ * 1024 * 1024; drow0_ = nb_ * 128; k0_ = kb_ * 128; } } while (0)
    if (ti < NE * TILES_E) { const float* src; unsigned char* dstp; int N_, d0, k0; P1_SRC(ti, src, N_, dstp, d0, k0);
#pragma unroll
        for (int i = 0; i < 8; ++i) pre[i] = *(const f32x4*)(src + (size_t)(lr + 16 * i) * N_ + lc4); }
    for (; ti < NE * TILES_E; ti += F.G) {
#pragma unroll
        for (int i = 0; i < 8; ++i) *(LAS f32x4*)(tile + (lr + 16 * i) * TP + lc4) = pre[i];
        __syncthreads();
        const int tnx = (ti + F.G < NE * TILES_E) ? ti + F.G : ti;
        { const float* src; unsigned char* dstp; int N_, d0, k0; P1_SRC(tnx, src, N_, dstp, d0, k0);
#pragma unroll
            for (int i = 0; i < 8; ++i) pre[i] = *(const f32x4*)(src + (size_t)(lr + 16 * i) * N_ + lc4); }
        { const float* src; unsigned char* dstp; int N_, d0, k0; P1_SRC(ti, src, N_, dstp, d0, k0); (void)src; (void)N_;
          const LAS float* cp = tile + (32 * kc) * TP + tn; u32x4 o0, o1; float cv[32];
#pragma unroll
          for (int i = 0; i < 32; ++i) cv[i] = cp[i * TP];
          asm volatile("s_waitcnt lgkmcnt(0)" ::: "memory");
#pragma unroll
          for (int i = 0; i < 32; ++i) cv[i] *= 32.f;
          o0.x = pk4_fp8(cv[0], cv[1], cv[2], cv[3]); o0.y = pk4_fp8(cv[4], cv[5], cv[6], cv[7]); o0.z = pk4_fp8(cv[8], cv[9], cv[10], cv[11]); o0.w = pk4_fp8(cv[12], cv[13], cv[14], cv[15]);
          o1.x = pk4_fp8(cv[16], cv[17], cv[18], cv[19]); o1.y = pk4_fp8(cv[20], cv[21], cv[22], cv[23]); o1.z = pk4_fp8(cv[24], cv[25], cv[26], cv[27]); o1.w = pk4_fp8(cv[28], cv[29], cv[30], cv[31]);
          unsigned char* op = dstp + (size_t)(d0 + tn) * 1024 + k0 + 32 * kc; *(u32x4*)op = o0; *(u32x4*)(op + 16) = o1; }
        __syncthreads();
    }
#undef P1_SRC
}
constexpr int XR_LD = 136, XR_TILE = 128 * XR_LD;
__device__ __forceinline__ void rg_issue(const bf16* xrnn, const bf16* gy, int item, int tid, u32x2 (&xraw)[4][4], u32x2 (&graw)[4], bool pass1) {
    const int hd = item & 7, c = (item >> 3) & 31, b = item >> 8, r0 = tid >> 4, ch = hd * 128 + (tid & 15) * 8;
#pragma unroll
    for (int q = 0; q < 4; ++q) { const int r = r0 + 32 * q;
#pragma unroll
        for (int k = 0; k < 4; ++k) { const int tp = c * RGL + r - 3 + k, tpc = tp < 0 ? 0 : tp; xraw[q][k] = *(const u32x2*)((const unsigned char*)xrnn + (size_t)(b * SEQ + tpc) * 1024 + ch); }
        if (pass1) graw[q] = *(const u32x2*)((const unsigned char*)gy + (size_t)(b * SEQ + c * RGL + r) * 1024 + ch); }
}
__device__ __forceinline__ void rg_convwrite(const LAS float* cwl, int item, int tid, const u32x2 (&xraw)[4][4], const u32x2 (&graw)[4], LAS bf16* xr, LAS bf16* gyt, bool pass1) {
    const int c = (item >> 3) & 31, r0 = tid >> 4, c8 = (tid & 15) * 8;
    const f32x4 b0 = *(const LAS f32x4*)(cwl + 4 * 128 + c8), b1 = *(const LAS f32x4*)(cwl + 4 * 128 + c8 + 4);
    f32x4 w0[4], w1[4];
#pragma unroll
    for (int k = 0; k < 4; ++k) { w0[k] = *(const LAS f32x4*)(cwl + k * 128 + c8); w1[k] = *(const LAS f32x4*)(cwl + k * 128 + c8 + 4); }
#pragma unroll
    for (int q = 0; q < 4; ++q) { const int r = r0 + 32 * q; f32x4 a0 = b0, a1 = b1;
#pragma unroll
        for (int k = 0; k < 4; ++k) { const int tp = c * RGL + r - 3 + k; f32x4 x0, x1; unpack8_fp8(xraw[q][k], x0, x1); if (tp < 0) { x0 = (f32x4){0.f, 0.f, 0.f, 0.f}; x1 = x0; } a0 += w0[k] * x0; a1 += w1[k] * x1; }
        *(LAS u32x4*)(xr + r * XR_LD + c8) = pack8(a0, a1);
        if (pass1) { f32x4 ga_, gb_; unpack8_fp8(graw[q], ga_, gb_); *(LAS u32x4*)(gyt + r * XR_LD + c8) = pack8(ga_, gb_); } }
}
template <int PASS>
__device__ __forceinline__ void rglru_phase(Frame& F) {
    const int NIT = NB * RGC * 8;
    const bool skew = (PASS == 0) && (F.G == 256);
    const int nmine = skew ? (F.vcu < 128 ? 7 : 9) : (NIT - F.vcu + F.G - 1) / F.G;
#define RG_ITEM(k) ((skew && (k) >= 7) ? (1792 + (F.vcu - 128) + 128 * ((k) - 7)) : (F.vcu + (k) * F.G))
    if (nmine <= 0) return;
    int it = RG_ITEM(0);
    LAS bf16* xr = (LAS bf16*)F.lds; LAS bf16* gyt0 = xr + XR_TILE;
    const bf16* xrnn = WSP(bf16, WS_XRNN); const bf16* gy = WSP(bf16, WS_GY); bf16* ha = WSP(bf16, WS_HA); const float* cw = F.in[6]; const float* cb = F.in[7];
    const int tid = F.tid, w = F.wave, q = F.lane >> 4, col = F.lane & 15, chl = 16 * w + col;
    u32x2 xraw[4][4], graw[4];
    LAS float* cwl = (LAS float*)(gyt0 + 2 * XR_TILE);
    for (int i = tid; i < 5 * 128; i += 512) { const int k = i >> 7, chh = (it & 7) * 128 + (i & 127); cwl[i] = (k < 4) ? cw[k * 1024 + chh] : cb[chh]; }
    rg_issue(xrnn, gy, it, tid, xraw, graw, PASS);
    __syncthreads();
    rg_convwrite(cwl, it, tid, xraw, graw, xr, gyt0, PASS);
    bf16x8 Bf[2][4]; float ba, bx, sp;
    { const int hd0 = it & 7, ch0 = hd0 * 128 + chl; const bf16* wg = WSP(bf16, WS_WG) + (size_t)hd0 * 256 * 128;
#pragma unroll
      for (int gt = 0; gt < 2; ++gt)
#pragma unroll
          for (int kk = 0; kk < 4; ++kk) Bf[gt][kk] = *(const bf16x8*)(wg + (size_t)(gt * 128 + chl) * 128 + kk * 32 + q * 8);
      ba = F.in[9][ch0]; bx = F.in[11][ch0]; const float lam = F.in[12][ch0]; sp = (lam > 15.f) ? __expf(-lam) : log1pf(__expf(-lam)); }
#pragma unroll
    for (int gt = 0; gt < 2; ++gt)
#pragma unroll
        for (int kk = 0; kk < 4; ++kk) asm volatile("" :: "v"(Bf[gt][kk]));
    asm volatile("" :: "v"(ba), "v"(bx), "v"(sp));
    __syncthreads();
    for (int i = 0; i < nmine; ++i) {
        const bool has_next = (i + 1) < nmine; const int nit = has_next ? RG_ITEM(i + 1) : it;
        const int hd = it & 7, c = (it >> 3) & 31, b = it >> 8, t0 = b * SEQ + c * RGL, ch = hd * 128 + chl;
        LAS bf16* gyt = gyt0 + (i & 1) * XR_TILE; LAS bf16* gytn = gyt0 + ((i & 1) ^ 1) * XR_TILE;
        float carryH = 0.f, carryP = 1.f;
        if (PASS) carryH = WSP(float, WS_HIN)[(size_t)(b * RGC + c) * 1024 + ch];
        __builtin_amdgcn_sched_barrier(0);
        rg_issue(xrnn, gy, nit, tid, xraw, graw, PASS);
        __builtin_amdgcn_sched_barrier(0);
        f32x4 acc[8][2];
#pragma unroll
        for (int m = 0; m < 8; ++m) { acc[m][0] = (f32x4){0.f, 0.f, 0.f, 0.f}; acc[m][1] = (f32x4){0.f, 0.f, 0.f, 0.f}; }
#pragma unroll
        for (int kk = 0; kk < 4; ++kk)
#pragma unroll
            for (int m = 0; m < 8; ++m) { const bf16x8 Af = *(const LAS bf16x8*)(xr + (16 * m + col) * XR_LD + kk * 32 + q * 8);
                acc[m][0] = __builtin_amdgcn_mfma_f32_16x16x32_bf16(Af, Bf[0][kk], acc[m][0], 0, 0, 0);
                acc[m][1] = __builtin_amdgcn_mfma_f32_16x16x32_bf16(Af, Bf[1][kk], acc[m][1], 0, 0, 0); }
#pragma unroll
        for (int m = 0; m < 8; ++m) {
            float a[4], uu[4];
#pragma unroll
            for (int j = 0; j < 4; ++j) { const int tl = 16 * m + 4 * q + j;
                const float r = fast_sigmoid(acc[m][0][j] + ba), ii = fast_sigmoid(acc[m][1][j] + bx);
                const float la = -11.541560327f * r * sp; a[j] = __builtin_amdgcn_exp2f(la); const float mult = __builtin_amdgcn_sqrtf(fmaxf(1.0f - a[j] * a[j], 0.f));
                uu[j] = mult * ii * bf1(xr[tl * XR_LD + chl]); }
            float sP = a[0], sH = uu[0];
#pragma unroll
            for (int j = 1; j < 4; ++j) { sH = a[j] * sH + uu[j]; sP *= a[j]; }
            float iP = sP, iH = sH;
            { const float pP = __shfl_up(iP, 16), pH = __shfl_up(iH, 16); if (q >= 1) { iH = iP * pH + iH; iP = iP * pP; } }
            { const float pP = __shfl_up(iP, 32), pH = __shfl_up(iH, 32); if (q >= 2) { iH = iP * pH + iH; iP = iP * pP; } }
            float eP = __shfl_up(iP, 16), eH = __shfl_up(iH, 16); if (q == 0) { eP = 1.f; eH = 0.f; }
            const float tP = __shfl(iP, col + 48), tH = __shfl(iH, col + 48);
            if (PASS) { float h = eP * carryH + eH;
#pragma unroll
                for (int j = 0; j < 4; ++j) { const int tl = 16 * m + 4 * q + j; h = a[j] * h + uu[j]; LAS bf16* gp = gyt + tl * XR_LD + chl; *gp = (bf16)f2bf(h * bf1(*gp)); } }
            carryH = tP * carryH + tH; carryP *= tP;
        }
        if (!PASS && q == 0) { f32x2* ag = WSP(f32x2, WS_RGAGG); ag[(size_t)(b * RGC + c) * 1024 + ch] = (f32x2){carryP, carryH}; }
        __syncthreads();
        if (PASS) { const int r0 = tid >> 4, c8 = (tid & 15) * 8;
#pragma unroll
            for (int qq = 0; qq < 4; ++qq) { const int r = r0 + 32 * qq; f32x4 h0, h1; unpack8(*(const LAS u32x4*)(gyt + r * XR_LD + c8), h0, h1); u32x2 w8; w8.x = pk4_fp8(h0[0], h0[1], h0[2], h0[3]); w8.y = pk4_fp8(h1[0], h1[1], h1[2], h1[3]);
                *(u32x2*)((unsigned char*)ha + (size_t)(t0 + r) * 1024 + hd * 128 + c8) = w8; } }
#pragma unroll
        for (int qq = 0; qq < 4; ++qq) {
#pragma unroll
            for (int k = 0; k < 4; ++k) asm volatile("" : "+v"(xraw[qq][k]));
            if (PASS) asm volatile("" : "+v"(graw[qq])); }
        if (has_next) rg_convwrite(cwl, nit, tid, xraw, graw, xr, gytn, PASS);
        __syncthreads();
        it = nit;
    }
#undef RG_ITEM
}
__device__ __forceinline__ void p4_carries(Frame& F) {
    LAS f32x2* seg = (LAS f32x2*)F.lds;
    for (int job = F.vcu; job < NB * S5G; job += F.G) {
        const int b = job >> 5, g = job & 31, p = F.lane, w = F.wave;
        const f32x2 al = WSP(f32x2, WS_AL)[g * 64 + p];
        const f32x2* Sb = WSP(f32x2, WS_S) + ((size_t)(g * S5M + b * S5CPB + 16 * w)) * 64 + p; unsigned* ac = (unsigned*)(WSP(bf16, WS_ACAT) + ((size_t)(g * S5M + b * S5CPB + 16 * w)) * S5ROW) + p;
        f32x2 sv[16];
#pragma unroll
        for (int i = 0; i < 16; ++i) sv[i] = Sb[(size_t)i * 64];
        float xr_ = 0.f, xi = 0.f;
#pragma unroll
        for (int i = 0; i < 16; ++i) { const float nr = al.x * xr_ - al.y * xi + sv[i].x, ni = al.x * xi + al.y * xr_ + sv[i].y; xr_ = nr; xi = ni; }
        seg[w * 64 + p] = (f32x2){xr_, xi};
        float ar = al.x, ai = al.y;
#pragma unroll
        for (int q = 0; q < 4; ++q) { const float nr = ar * ar - ai * ai, ni = 2.f * ar * ai; ar = nr; ai = ni; }
        __syncthreads();
        xr_ = 0.f; xi = 0.f;
        for (int ww = 0; ww < w; ++ww) { const f32x2 sg = seg[ww * 64 + p]; const float nr = ar * xr_ - ai * xi + sg.x, ni = ar * xi + ai * xr_ + sg.y; xr_ = nr; xi = ni; }
#pragma unroll
        for (int i = 0; i < 16; ++i) { ac[(size_t)i * (S5ROW / 2)] = pk2(xr_, xi); const float nr = al.x * xr_ - al.y * xi + sv[i].x, ni = al.x * xi + al.y * xr_ + sv[i].y; xr_ = nr; xi = ni; }
        __syncthreads();
    }
    if (F.vcu < 16) {
        const int id = F.vcu * 512 + F.tid, ch = id & 1023, b = id >> 10; const f32x2* ag = WSP(f32x2, WS_RGAGG) + (size_t)b * RGC * 1024 + ch; float* hin = WSP(float, WS_HIN) + (size_t)b * RGC * 1024 + ch;
        f32x2 a[RGC];
#pragma unroll
        for (int c = 0; c < RGC; ++c) a[c] = ag[(size_t)c * 1024];
        float h = 0.f;
#pragma unroll
        for (int c = 0; c < RGC; ++c) { hin[(size_t)c * 1024] = h; h = a[c].x * h + a[c].y; }
    }
}
constexpr int WR_LD = 1032;
__device__ __forceinline__ void p9_router(Frame& F) {
    LAS bf16* wH = (LAS bf16*)F.lds; LAS bf16* wL = wH + 32 * WR_LD;
    LAS f32x2* sel = (LAS f32x2*)(wL + 32 * WR_LD);
    LAS unsigned* rec = (LAS unsigned*)(sel + 512);
    LAS float* recp = (LAS float*)(rec + 512);
    LAS int* lcnt = (LAS int*)(recp + 512);
    LAS int* gbase = lcnt + 32;
    { const u32x4* img = WSP(u32x4, WS_WRIMG); LAS u32x4* dst = (LAS u32x4*)wH;
      for (int i = F.tid; i < 2 * 32 * WR_LD * 2 / 16; i += 512) dst[i] = img[i]; }
    if (F.tid < 32) lcnt[F.tid] = 0;
    __syncthreads();
    const float* mod = WSP(float, WS_MOD); const bf16* v1 = WSP(bf16, WS_V1); bf16* x1 = WSP(bf16, WS_X1); unsigned char* h2 = WSP(unsigned char, WS_H2);
    const int lane = F.lane, m = lane & 15, kq = lane >> 4, w = F.wave;
    for (int blk = F.vcu; blk < T / 128; blk += F.G) {
        const int t = blk * 128 + w * 16 + m, b = (blk * 128) >> 12;
        const bf16* vrow = v1 + (size_t)t * 1024 + 8 * kq;
        float sum = 0.f, sq = 0.f;
#pragma unroll 32
        for (int s_ = 0; s_ < 32; ++s_) { f32x4 a, c; unpack8(*(const u32x4*)(vrow + 32 * s_), a, c); sum += ((a[0] + a[1]) + (a[2] + a[3])) + ((c[0] + c[1]) + (c[2] + c[3]));
            sq += ((a[0] * a[0] + a[1] * a[1]) + (a[2] * a[2] + a[3] * a[3])) + ((c[0] * c[0] + c[1] * c[1]) + (c[2] * c[2] + c[3] * c[3])); }
        sum += __shfl_xor(sum, 16); sum += __shfl_xor(sum, 32); sq += __shfl_xor(sq, 16); sq += __shfl_xor(sq, 32);
        const float mean = sum * (1.f / 1024.f); const float rstd = 1.f / sqrtf(fmaxf(sq * (1.f / 1024.f) - mean * mean, 0.f) + LN_EPS);
        f32x4 acc[2] = {(f32x4){0.f, 0.f, 0.f, 0.f}, (f32x4){0.f, 0.f, 0.f, 0.f}};
        const float* lng = F.in[24] + 8 * kq; const float* lnb = F.in[25] + 8 * kq; const float* shp = mod + b * 6144 + 3072 + 8 * kq; const float* scp = mod + b * 6144 + 4096 + 8 * kq;
        bf16* x1row = x1 + (size_t)t * 1024 + 8 * kq; unsigned char* h2row = h2 + (size_t)t * 1024 + 8 * kq;
        const LAS bf16* wHr = wH + m * WR_LD + 8 * kq; const LAS bf16* wLr = wL + m * WR_LD + 8 * kq;
#pragma unroll 2
        for (int s2 = 0; s2 < 32; s2 += 2) {
            u32x4 rw[2]; f32x4 pg[2][2], pb[2][2], psh[2][2], psc[2][2];
#pragma unroll
            for (int h = 0; h < 2; ++h) { const int ko = 32 * (s2 + h); rw[h] = *(const u32x4*)(vrow + ko);
                pg[h][0] = *(const f32x4*)(lng + ko); pg[h][1] = *(const f32x4*)(lng + ko + 4); pb[h][0] = *(const f32x4*)(lnb + ko); pb[h][1] = *(const f32x4*)(lnb + ko + 4);
                psh[h][0] = *(const f32x4*)(shp + ko); psh[h][1] = *(const f32x4*)(shp + ko + 4); psc[h][0] = *(const f32x4*)(scp + ko); psc[h][1] = *(const f32x4*)(scp + ko + 4); }
#pragma unroll
            for (int h = 0; h < 2; ++h) { const int ko = 32 * (s2 + h);
                f32x4 a, c; unpack8(rw[h], a, c);
                const f32x4 x0 = (a - mean) * rstd * pg[h][0] + pb[h][0], x1v = (c - mean) * rstd * pg[h][1] + pb[h][1];
                *(u32x4*)(x1row + ko) = pack8(x0, x1v);
                const f32x4 h0 = x0 * (psc[h][0] + 1.0f) + psh[h][0], h1 = x1v * (psc[h][1] + 1.0f) + psh[h][1];
                u32x2 w8; w8.x = pk4_fp8(h0[0], h0[1], h0[2], h0[3]); w8.y = pk4_fp8(h1[0], h1[1], h1[2], h1[3]); *(u32x2*)(h2row + ko) = w8;
                const u32x4 hi = pack8(h0, h1); f32x4 r0, r1; unpack8(hi, r0, r1); const u32x4 lo = pack8(h0 - r0, h1 - r1);
                const bf16x8 ah = __builtin_bit_cast(bf16x8, hi), al = __builtin_bit_cast(bf16x8, lo);
#pragma unroll
                for (int nf = 0; nf < 2; ++nf) { const bf16x8 bh = *(const LAS bf16x8*)(wHr + nf * 16 * WR_LD + ko), bl = *(const LAS bf16x8*)(wLr + nf * 16 * WR_LD + ko);
                    acc[nf] = __builtin_amdgcn_mfma_f32_16x16x32_bf16(bh, ah, acc[nf], 0, 0, 0);
                    acc[nf] = __builtin_amdgcn_mfma_f32_16x16x32_bf16(bl, ah, acc[nf], 0, 0, 0);
                    acc[nf] = __builtin_amdgcn_mfma_f32_16x16x32_bf16(bh, al, acc[nf], 0, 0, 0); } } }
        float lv[8];
#pragma unroll
        for (int nf = 0; nf < 2; ++nf)
#pragma unroll
            for (int j = 0; j < 4; ++j) lv[nf * 4 + j] = acc[nf][j] + F.in[27][nf * 16 + 4 * kq + j];
        int rank[8];
#pragma unroll
        for (int i = 0; i < 8; ++i) { rank[i] = 0;
#pragma unroll
            for (int i2 = 0; i2 < 8; ++i2) if (i2 != i) { const int e1 = (i >> 2) * 16 + 4 * kq + (i & 3), e2 = (i2 >> 2) * 16 + 4 * kq + (i2 & 3); rank[i] += (lv[i2] > lv[i] || (lv[i2] == lv[i] && e2 < e1)) ? 1 : 0; } }
#pragma unroll
        for (int dq = 1; dq < 4; ++dq) { const int q2 = kq ^ dq;
#pragma unroll
            for (int i2 = 0; i2 < 8; ++i2) { const float o = __shfl_xor(lv[i2], 16 * dq); const int e2 = (i2 >> 2) * 16 + 4 * q2 + (i2 & 3);
#pragma unroll
                for (int i = 0; i < 8; ++i) { const int e1 = (i >> 2) * 16 + 4 * kq + (i & 3); rank[i] += (o > lv[i] || (o == lv[i] && e2 < e1)) ? 1 : 0; } } }
#pragma unroll
        for (int i = 0; i < 8; ++i) if (rank[i] < 4) { const int e1 = (i >> 2) * 16 + 4 * kq + (i & 3); sel[(w * 16 + m) * 4 + rank[i]] = (f32x2){__builtin_bit_cast(float, e1), lv[i]}; }
        asm volatile("s_waitcnt lgkmcnt(0)" ::: "memory");
        { const int tm = lane >> 2, k = lane & 3; const f32x2 s0 = sel[(w * 16 + tm) * 4 + 0], s1 = sel[(w * 16 + tm) * 4 + 1], s2 = sel[(w * 16 + tm) * 4 + 2], s3 = sel[(w * 16 + tm) * 4 + 3];
          const float p0 = 1.f, p1 = __expf(s1.y - s0.y), p2 = __expf(s2.y - s0.y), p3 = __expf(s3.y - s0.y), ps = (p0 + p1) + (p2 + p3);
          const f32x2 mine = k == 0 ? s0 : (k == 1 ? s1 : (k == 2 ? s2 : s3)); const float pm = (k == 0 ? p0 : (k == 1 ? p1 : (k == 2 ? p2 : p3))) / ps;
          const int e = __builtin_bit_cast(int, mine.x);
          const int lr = __hip_atomic_fetch_add(lcnt + e, 1, __ATOMIC_RELAXED, __HIP_MEMORY_SCOPE_WORKGROUP);
          rec[(w * 16 + tm) * 4 + k] = ((unsigned)e << 16) | (unsigned)lr; recp[(w * 16 + tm) * 4 + k] = pm; }
        __syncthreads();
        if (F.tid < 32) { const int n = lcnt[F.tid]; gbase[F.tid] = n ? (int)atomicAdd(F.ctl + CW_CNT + 64 * F.tid, (unsigned)n) : 0; lcnt[F.tid] = 0; }
        __syncthreads();
        { const unsigned r = rec[F.tid]; const int e = r >> 16, rk = gbase[e] + (int)(r & 0xffffu), tt = blk * 128 + (F.tid >> 2);
          WSP(int, WS_TOK)[(size_t)e * T + rk] = tt; WSP(unsigned, WS_POS)[(size_t)tt * 4 + (F.tid & 3)] = ((unsigned)e << 20) | (unsigned)rk; WSP(float, WS_PROB)[(size_t)tt * 4 + (F.tid & 3)] = recp[F.tid]; }
        __syncthreads();
    }
}
__device__ __forceinline__ void p12_final(Frame& F) {
    moe_tables(F);
    const LAS int* tstart = (const LAS int*)(F.lds + TAB_OFF);
    const float* mod = WSP(float, WS_MOD); const bf16* x1 = WSP(bf16, WS_X1); const bf16* yb = WSP(bf16, WS_YB); const unsigned* pos = WSP(unsigned, WS_POS); const float* prob = WSP(float, WS_PROB);
    const int lane = F.lane, gw = F.vcu * 8 + F.wave, NGW = F.G * 8;
    f32x4 lg[4], lb[4];
#pragma unroll
    for (int j = 0; j < 4; ++j) { lg[j] = *(const f32x4*)(F.in[32] + 512 * (j >> 1) + 8 * lane + 4 * (j & 1)); lb[j] = *(const f32x4*)(F.in[33] + 512 * (j >> 1) + 8 * lane + 4 * (j & 1)); }
#define P12_ROUTE(PP, PW, tt) do { const u32x4 p4_ = *(const u32x4*)(pos + (size_t)(tt) * 4); const f32x4 w4_ = *(const f32x4*)(prob + (size_t)(tt) * 4); \
        PP[0] = p4_.x; PP[1] = p4_.y; PP[2] = p4_.z; PP[3] = p4_.w; PW[0] = w4_[0]; PW[1] = w4_[1]; PW[2] = w4_[2]; PW[3] = w4_[3]; } while (0)
#define P12_ROWS(YW, XW, PP, tt) do { _Pragma("unroll") for (int k = 0; k < 4; ++k) { const int e_ = PP[k] >> 20, rk_ = PP[k] & 0xfffffu; const size_t slot_ = (size_t)tstart[e_] * 256 + rk_; \
            _Pragma("unroll") for (int j = 0; j < 2; ++j) YW[k][j] = *((const u32x2*)((const unsigned char*)yb + slot_ * 1024) + 64 * j + lane); } \
        _Pragma("unroll") for (int j = 0; j < 2; ++j) XW[j] = *((const u32x4*)(x1 + (size_t)(tt) * 1024) + 64 * j + lane); } while (0)
#define P12_COMPUTE(YW, XW, PW, tt) do { const int b_ = (tt) >> 12; f32x4 v[4]; float s_ = 0.f; \
        _Pragma("unroll") for (int j = 0; j < 2; ++j) { f32x4 f0 = (f32x4){0.f, 0.f, 0.f, 0.f}, f1 = f0; \
            _Pragma("unroll") for (int k = 0; k < 4; ++k) { const u32x2 yv_ = YW[k][j]; const f32x2 q0_ = __builtin_amdgcn_cvt_pk_f32_fp8((int)yv_.x, false), q1_ = __builtin_amdgcn_cvt_pk_f32_fp8((int)yv_.x, true), q2_ = __builtin_amdgcn_cvt_pk_f32_fp8((int)yv_.y, false), q3_ = __builtin_amdgcn_cvt_pk_f32_fp8((int)yv_.y, true); \
                f0 += (f32x4){q0_.x, q0_.y, q1_.x, q1_.y} * PW[k]; f1 += (f32x4){q2_.x, q2_.y, q3_.x, q3_.y} * PW[k]; } \
            f32x4 xa_, xc_; unpack8(XW[j], xa_, xc_); const float* gp_ = mod + b_ * 6144 + 5120 + 512 * j + 8 * lane; \
            v[2 * j] = xa_ * DN_ALPHA + (*(const f32x4*)gp_ + 1.0f) * f0; v[2 * j + 1] = xc_ * DN_ALPHA + (*(const f32x4*)(gp_ + 4) + 1.0f) * f1; \
            s_ += ((v[2 * j][0] + v[2 * j][1]) + (v[2 * j][2] + v[2 * j][3])) + ((v[2 * j + 1][0] + v[2 * j + 1][1]) + (v[2 * j + 1][2] + v[2 * j + 1][3])); } \
        const float mean_ = wave_sum(s_) * (1.f / 1024.f); float s2_ = 0.f; \
        _Pragma("unroll") for (int j = 0; j < 4; ++j) { v[j] = v[j] - mean_; s2_ += (v[j][0] * v[j][0] + v[j][1] * v[j][1]) + (v[j][2] * v[j][2] + v[j][3] * v[j][3]); } \
        const float rstd_ = 1.f / sqrtf(wave_sum(s2_) * (1.f / 1024.f) + LN_EPS); \
        _Pragma("unroll") for (int j = 0; j < 4; ++j) *(f32x4*)(F.out + (size_t)(tt) * 1024 + 512 * (j >> 1) + 8 * lane + 4 * (j & 1)) = v[j] * rstd_ * lg[j] + lb[j]; } while (0)
    const int nmine = (T - gw + NGW - 1) / NGW;
    unsigned ppA[4], ppB[4]; float pwA[4], pwB[4], pwN[4]; u32x2 ywA[4][2], ywB[4][2]; u32x4 xwA[2], xwB[2];
    if (nmine > 0) { P12_ROUTE(ppA, pwA, gw); P12_ROWS(ywA, xwA, ppA, gw); }
    if (nmine > 1) { P12_ROUTE(ppB, pwB, gw + NGW); }
    for (int i = 0; i < nmine; i += 2) {
        const int t0 = gw + i * NGW, t1 = t0 + NGW, t2 = t1 + NGW, t3 = t2 + NGW;
        if (i + 1 < nmine) { P12_ROWS(ywB, xwB, ppB, t1); }
        if (i + 2 < nmine) { P12_ROUTE(ppA, pwN, t2); }
        __builtin_amdgcn_sched_barrier(0);
        P12_COMPUTE(ywA, xwA, pwA, t0);
        if (i + 1 < nmine) {
#pragma unroll
            for (int k = 0; k < 4; ++k) pwA[k] = pwN[k];
            if (i + 2 < nmine) { P12_ROWS(ywA, xwA, ppA, t2); }
            if (i + 3 < nmine) { P12_ROUTE(ppB, pwN, t3); }
            __builtin_amdgcn_sched_barrier(0);
            P12_COMPUTE(ywB, xwB, pwB, t1);
#pragma unroll
            for (int k = 0; k < 4; ++k) pwB[k] = pwN[k];
        }
    }
#undef P12_ROUTE
#undef P12_ROWS
#undef P12_COMPUTE
}

struct Args { const float* in[34]; float* out; unsigned char* ws; int ph_lo, ph_hi; };
__global__ void __launch_bounds__(512, 2) fwd_kernel(Args args) {
    extern __shared__ __attribute__((aligned(16))) unsigned char lds_raw[];
    Frame F;
    F.lds = (LAS unsigned char*)lds_raw; F.MISC = (volatile LAS unsigned*)(F.lds + MISC_OFF);
    F.tid = threadIdx.x; F.lane = F.tid & 63; F.wave = __builtin_amdgcn_readfirstlane(F.tid >> 6);
    F.G = gridDim.x; { const int bx = blockIdx.x; F.vcu = (F.G % 8 == 0) ? (bx % 8) * (F.G / 8) + bx / 8 : bx; }
#pragma unroll
    for (int i = 0; i < 34; ++i) F.in[i] = args.in[i];
    F.out = args.out; F.ws = args.ws; F.ctl = (unsigned*)(args.ws + WS_CTL);
    if (F.tid < 64) F.MISC[F.tid] = 0u;
    __syncthreads();
    XcdBarrier bar; bar.bar = F.ctl + CW_BAR; bar.x = 0; bar.st = nullptr;
    if (MK_N_LAUNCHES == 1) bar = xcd_barrier_post(F.ctl + CW_BAR, F.MISC + 8);
    const int lo = args.ph_lo, hi = args.ph_hi;
#define IN(k) (lo <= (k) && (k) < hi)
#define SEAM(k) do { if (IN(k) && IN((k) + 1)) xcd_barrier(bar); } while (0)

    if (IN(0)) REPS(0) { if (rep_) xcd_barrier(bar);
        for (int j = F.vcu; j < 192; j += F.G) p0_mod_job(F, j);
        for (int j = F.vcu; j < S5G * 8; j += F.G) p0_s5k_job(F, j);
        { bf16* img = WSP(bf16, WS_WRIMG); const float* wr = F.in[26];
          for (int i = F.vcu * 512 + F.tid; i < 1024 * 32; i += F.G * 512) { const float w = wr[i]; const unsigned hb = f2bf(w); const float hf = __builtin_bit_cast(float, hb << 16);
              img[(i & 31) * 1032 + (i >> 5)] = (bf16)hb; img[32 * 1032 + (i & 31) * 1032 + (i >> 5)] = (bf16)f2bf(w - hf); } }
        p0_small_transposes(F);
    }
    SEAM(0);
    if (IN(1)) REPS(1) { if (rep_) xcd_barrier(bar); for (int j = F.vcu; j < S5G * 8; j += F.G) p1_s5w_job(F, j); p1_body(F); }
    SEAM(1);
    if (IN(2)) REPS(2) { if (rep_) xcd_barrier(bar);
        g8::GridOrder S; S.init(T, INC, F.G, (int)blockIdx.x, WSP(bf16, WS_HBF), WSP(bf16, WS_WIN), 1024, 1024);
        EpiInProj E{F.in[5], WSP(bf16, WS_XRNN), WSP(bf16, WS_GY), WSP(bf16, WS_ACAT), WSP(bf16, WS_GATES)};
        g8::gemm_phase<EpiInProj, g8::GridOrder, false, true>(F.lds, 1024, 1024, 1024, S, E);
    }
    SEAM(2);
    if (IN(3)) REPS(3) { if (rep_) xcd_barrier(bar);
        { S5AOrder S{F.G, F.vcu, (const char*)WSP(bf16, WS_ACAT), (const char*)WSP(bf16, WS_WS)}; EpiS5A E{WSP(float, WS_S)};
          g8::gemm_phase<EpiS5A, S5AOrder, false>(F.lds, S5L * 32, S5ROW * 2, S5L * 32, S, E); }
        __syncthreads();
        rglru_phase<0>(F);
    }
    SEAM(3);
    if (IN(4)) REPS(4) { if (rep_) xcd_barrier(bar); p4_carries(F); }
    SEAM(4);
    if (IN(5)) REPS(5) { if (rep_) xcd_barrier(bar);
        { S5COrder S{F.G, F.vcu, (const char*)WSP(bf16, WS_ACAT), (const char*)WSP(bf16, WS_WY)}; EpiS5C E{WSP(bf16, WS_YS)};
          g8::gemm_phase<EpiS5C, S5COrder, false>(F.lds, S5ROW * 2, S5ROW * 2, S5ROW * 2, S, E); }
        __syncthreads();
        rglru_phase<1>(F);
    }
    SEAM(5);
    if (IN(6)) REPS(6) { if (rep_) xcd_barrier(bar);
        g8::GridOrder S; S.init(T, 2048, F.G, (int)blockIdx.x, WSP(bf16, WS_YS), WSP(bf16, WS_WGLU), 512, 512);
        EpiGlu E{WSP(bf16, WS_GATES), WSP(bf16, WS_GB)};
        g8::gemm_phase<EpiGlu, g8::GridOrder, false, true>(F.lds, 512, 512, 512, S, E);
    }
    SEAM(6);
    if (IN(7)) REPS(7) { if (rep_) xcd_barrier(bar);
        g8::GridOrder S; S.init(T, 1024, F.G, (int)blockIdx.x, WSP(bf16, WS_HA), WSP(bf16, WS_WRNN), 1024, 1024);
        EpiRnn E{WSP(bf16, WS_GATES), WSP(bf16, WS_GB), WSP(bf16, WS_MERGED)};
        g8::gemm_phase<EpiRnn, g8::GridOrder, false, true>(F.lds, 1024, 1024, 1024, S, E);
    }
    SEAM(7);
    if (IN(8)) REPS(8) { if (rep_) xcd_barrier(bar);
        g8::GridOrder S; S.init(T, 1024, F.G, (int)blockIdx.x, WSP(bf16, WS_MERGED), WSP(bf16, WS_WOUT), 1024, 1024);
        EpiOut E{F.in[0], WSP(float, WS_MOD), WSP(bf16, WS_V1)};
        g8::gemm_phase<EpiOut, g8::GridOrder, false, true>(F.lds, 1024, 1024, 1024, S, E);
    }
    SEAM(8);
    if (IN(9)) REPS(9) { if (rep_) xcd_barrier(bar); p9_router(F); }
    SEAM(9);
    if (IN(10)) REPS(10) { if (rep_) xcd_barrier(bar);
        moe_tables(F);
        const LAS int* tstart = (const LAS int*)(F.lds + TAB_OFF);
        MoeOrder S{F.G, (int)blockIdx.x, 8, tstart[NE], tstart, tstart + 40, WSP(int, WS_TOK), (const char*)WSP(bf16, WS_H2), (const char*)WSP(bf16, WS_WGU), (size_t)2048 * 1024, 1024, true};
        EpiMoe1 E{F.in[29], WSP(bf16, WS_ACT)};
        g8::gemm_phase<EpiMoe1, MoeOrder, true, true>(F.lds, 1024, 1024, 1024, S, E);
    }
    SEAM(10);
    if (IN(11)) REPS(11) { if (rep_) xcd_barrier(bar);
        moe_tables(F);
        const LAS int* tstart = (const LAS int*)(F.lds + TAB_OFF);
        MoeOrder S{F.G, (int)blockIdx.x, 4, tstart[NE], tstart, tstart + 40, WSP(int, WS_TOK), (const char*)WSP(bf16, WS_ACT), (const char*)WSP(bf16, WS_WD), (size_t)1024 * 1024, 1024, false};
        EpiMoe2 E{F.in[31], WSP(bf16, WS_YB)};
        g8::gemm_phase<EpiMoe2, MoeOrder, false, true>(F.lds, 1024, 1024, 1024, S, E);
    }
    SEAM(11);
    if (IN(12)) REPS(12) { if (rep_) xcd_barrier(bar); p12_final(F); }
#undef IN
#undef SEAM
}

extern "C" void kernel_launch(void* const* d_in, const int* in_sizes, int n_in, void* d_out, int out_size, void* d_ws, size_t ws_size, hipStream_t stream) {
    static int grid = 0;
    if (grid == 0) {
        if (n_in != 34 || in_sizes[0] != T * D || out_size != T * D || ws_size < WS_END) { fprintf(stderr, "kernel_launch: unexpected shapes (n_in %d, ws %zu < %zu)\n", n_in, ws_size, (size_t)WS_END); grid = -1; return; }
        int dev = 0, cus = 0;
        if (hipGetDevice(&dev) != hipSuccess || hipDeviceGetAttribute(&cus, hipDeviceAttributeMultiprocessorCount, dev) != hipSuccess) { grid = -1; return; }
        if (hipFuncSetAttribute((const void*)fwd_kernel, hipFuncAttributeMaxDynamicSharedMemorySize, LDS_BYTES) != hipSuccess) { fprintf(stderr, "kernel_launch: hipFuncSetAttribute failed\n"); grid = -1; return; }
        int per_cu = 0; (void)hipOccupancyMaxActiveBlocksPerMultiprocessor(&per_cu, (const void*)fwd_kernel, 512, LDS_BYTES); (void)hipGetLastError();
        grid = cus;
    }
    if (grid < 0) return;
    (void)hipMemsetAsync((char*)d_ws + WS_CTL, 0, CTL_BYTES, stream);
    Args a{};
    for (int i = 0; i < 34; ++i) a.in[i] = (const float*)d_in[i];
    a.out = (float*)d_out; a.ws = (unsigned char*)d_ws;
    if (MK_N_LAUNCHES == 1) { a.ph_lo = 0; a.ph_hi = N_PHASES; hipLaunchKernelGGL(fwd_kernel, dim3(grid), dim3(512), LDS_BYTES, stream, a); }
    else for (int p = 0; p < N_PHASES; ++p) { a.ph_lo = p; a.ph_hi = p + 1; hipLaunchKernelGGL(fwd_kernel, dim3(grid), dim3(512), LDS_BYTES, stream, a); }
}
```

```cpp
#include <hip/hip_runtime.h>
#include <cstdio>
#include <cstdint>

#ifndef MK_N_LAUNCHES
#define MK_N_LAUNCHES 1
#endif
constexpr int N_PHASES = 13;
#ifndef DUP_PHASE
#define DUP_PHASE -1
#endif
#define REPS(k) for (int rep_ = 0; rep_ < ((DUP_PHASE == (k)) ? 2 : 1); ++rep_)

#define GAS __attribute__((address_space(1)))
#define LAS __attribute__((address_space(3)))
typedef unsigned short bf16;
typedef short bf16x8 __attribute__((ext_vector_type(8)));
typedef float f32x4 __attribute__((ext_vector_type(4)));
typedef float f32x2 __attribute__((ext_vector_type(2)));
typedef unsigned u32x4 __attribute__((ext_vector_type(4)));
typedef unsigned u32x2 __attribute__((ext_vector_type(2)));
typedef GAS unsigned gu32;

constexpr int NB = 8, SEQ = 4096, T = NB * SEQ, D = 1024, INC = 4608, NE = 32, DFF = 1024;
constexpr int S5L = 32, S5G = 32, S5ROW = 128 + S5L * 16  , S5M = T / S5L  , S5CPB = SEQ / S5L  ;
constexpr int RGL = 128, RGC = SEQ / RGL  ;
constexpr float LN_EPS = 1e-5f, DN_ALPHA = 1.189207115002721f;
constexpr int ACT_ROWS = T * 4 + NE * 256;

constexpr size_t MiB = 1u << 20;
constexpr size_t WS_XRNN = 0, WS_GY = 64 * MiB, WS_GATES = 128 * MiB, WS_V1 = 0, WS_ACT = 0;
constexpr size_t WS_HBF = 272 * MiB, WS_HA = 272 * MiB, WS_YS = 336 * MiB, WS_GB = 368 * MiB, WS_MERGED = 432 * MiB, WS_ACAT = 496 * MiB, WS_YB = 272 * MiB;
constexpr size_t WS_X1 = 544 * MiB, WS_H2 = 608 * MiB;
constexpr size_t WS_WGU = 672 * MiB, WS_WD = 800 * MiB, WS_WIN = 864 * MiB, WS_WG = 873 * MiB, WS_WRNN = 874 * MiB, WS_WGLU = 876 * MiB, WS_WOUT = 878 * MiB;
constexpr size_t WS_WS = 880 * MiB, WS_WY = 888 * MiB, WS_S = 908 * MiB;
constexpr size_t WS_MOD = 924 * MiB, WS_AL = 925 * MiB, WS_RGAGG = 926 * MiB, WS_HIN = 928 * MiB, WS_TOK = 929 * MiB, WS_POS = 933 * MiB, WS_PROB = 934 * MiB, WS_CTL = 935 * MiB;
constexpr size_t WS_END = 936 * MiB, CTL_BYTES = 1 * MiB;
static_assert((size_t)ACT_ROWS * DFF * 2 <= 272 * MiB, "act/yb size");
static_assert(WS_ACAT + (size_t)S5G * S5M * S5ROW * 2 <= WS_X1, "acat");
constexpr int CW_BAR = 4096, CW_CNT = 8192  , CW_P0DONE = 12288  , CW_S5CDONE = 12352  ;

constexpr int LDS_BYTES = 147456, MISC_OFF = LDS_BYTES - 256, TAB_OFF = 131072 + 1024;

__device__ __forceinline__ unsigned f2bf(float f) { unsigned u = __builtin_bit_cast(unsigned, f); return (u + 0x7fffu + ((u >> 16) & 1u)) >> 16; }
typedef __bf16 bf16x2v __attribute__((ext_vector_type(2)));
__device__ __forceinline__ unsigned pk2(float lo, float hi) { const f32x2 v = {lo, hi}; const bf16x2v b = __builtin_convertvector(v, bf16x2v); return __builtin_bit_cast(unsigned, b); }
__device__ __forceinline__ unsigned pk4_fp8(float a, float b, float c, float d) { a = __builtin_amdgcn_fmed3f(a, -448.f, 448.f); b = __builtin_amdgcn_fmed3f(b, -448.f, 448.f); c = __builtin_amdgcn_fmed3f(c, -448.f, 448.f); d = __builtin_amdgcn_fmed3f(d, -448.f, 448.f); int w = 0; w = __builtin_amdgcn_cvt_pk_fp8_f32(a, b, w, false); w = __builtin_amdgcn_cvt_pk_fp8_f32(c, d, w, true); return (unsigned)w; }
__device__ __forceinline__ void unpack8_fp8(u32x2 w, f32x4& a, f32x4& b) { const f32x2 q0 = __builtin_amdgcn_cvt_pk_f32_fp8((int)w.x, false), q1 = __builtin_amdgcn_cvt_pk_f32_fp8((int)w.x, true), q2 = __builtin_amdgcn_cvt_pk_f32_fp8((int)w.y, false), q3 = __builtin_amdgcn_cvt_pk_f32_fp8((int)w.y, true);
    a = (f32x4){q0.x, q0.y, q1.x, q1.y}; b = (f32x4){q2.x, q2.y, q3.x, q3.y}; }
__device__ __forceinline__ float bflo(unsigned w) { return __builtin_bit_cast(float, w << 16); }
__device__ __forceinline__ float bfhi(unsigned w) { return __builtin_bit_cast(float, w & 0xffff0000u); }
__device__ __forceinline__ float bf1(bf16 h) { return __builtin_bit_cast(float, ((unsigned)h) << 16); }
__device__ __forceinline__ float fast_sigmoid(float x) { return __builtin_amdgcn_rcpf(1.0f + __builtin_amdgcn_exp2f(-1.4426950409f * x)); }
__device__ __forceinline__ float gelu_tanh(float x) { const float u = x + 0.044715f * x * x * x; return x * __builtin_amdgcn_rcpf(1.0f + __builtin_amdgcn_exp2f(-2.3022082f * u)); }
__device__ __forceinline__ float wave_sum(float v) {
#pragma unroll
    for (int o = 1; o < 64; o <<= 1) v += __shfl_xor(v, o);
    return v;
}
__device__ __forceinline__ u32x4 pack8(f32x4 a, f32x4 b) { u32x4 w; w.x = pk2(a[0], a[1]); w.y = pk2(a[2], a[3]); w.z = pk2(b[0], b[1]); w.w = pk2(b[2], b[3]); return w; }
__device__ __forceinline__ void unpack8(u32x4 w, f32x4& a, f32x4& b) { a = (f32x4){bflo(w.x), bfhi(w.x), bflo(w.y), bfhi(w.y)}; b = (f32x4){bflo(w.z), bfhi(w.z), bflo(w.w), bfhi(w.w)}; }

#define XB_TMO      128
#define XB_XCNT(j)  (256  + 64 * (j))
#define XB_XSUB(j)  (1280 + 64 * (j))
#define XB_XGEN(j)  (2304 + 64 * (j))
#define XB_TOP      3328
#define XB_TOPGEN   3392
#define XCD_BAR_WORDS 3456
#define XB_SPIN_CAP (1u << 18)
__device__ __forceinline__ unsigned xb_ld(unsigned* p)              { return __hip_atomic_load(p, __ATOMIC_RELAXED, __HIP_MEMORY_SCOPE_AGENT); }
__device__ __forceinline__ unsigned xb_add(unsigned* p, unsigned v) { return __hip_atomic_fetch_add(p, v, __ATOMIC_RELAXED, __HIP_MEMORY_SCOPE_AGENT); }
__device__ __forceinline__ unsigned xb_xcc_id() { return (unsigned)__builtin_amdgcn_s_getreg((3 << 11) | 20) & 0xFu; }
#define XB_SPIN(cond, bar) do { unsigned _sp = 0; while (cond) { __builtin_amdgcn_s_sleep(1); \
    if ((++_sp & 255u) == 0u) { if (xb_ld(&(bar)[XB_TMO])) break; if (_sp > XB_SPIN_CAP) { atomicAdd(&(bar)[XB_TMO], 1u); break; } } } } while (0)
struct XcdBarrier { unsigned* bar; unsigned x; volatile LAS unsigned* st; };
__device__ __forceinline__ XcdBarrier xcd_barrier_post(unsigned* bar, volatile LAS unsigned* st) {
    XcdBarrier b; b.bar = bar; b.x = xb_xcc_id(); b.st = st;
    if (threadIdx.x == 0) (void)xb_add(&bar[XB_XCNT(b.x)], 1u);
    return b;
}
__device__ __forceinline__ void xcd_barrier_complete(unsigned* bar, unsigned x, unsigned& nloc, unsigned& nx) {
    const unsigned G = gridDim.x * gridDim.y * gridDim.z;
    unsigned sum, cnt, mine, sp = 0u;
    for (;;) {
        sum = 0u; cnt = 0u; mine = 0u;
#pragma unroll
        for (unsigned j = 0; j < 16; ++j) { const unsigned c = xb_ld(&bar[XB_XCNT(j)]); sum += c; cnt += (c > 0u) ? 1u : 0u; mine = (j == x) ? c : mine; }
        if (sum == G) break;
        __builtin_amdgcn_s_sleep(1);
        if ((++sp & 255u) == 0u) { if (xb_ld(&bar[XB_TMO])) break; if (sp > XB_SPIN_CAP) { atomicAdd(&bar[XB_TMO], 1u); break; } }
    }
    nloc = mine > 0u ? mine : 1u; nx = cnt > 0u ? cnt : 1u;
}
__device__ __forceinline__ void xcd_barrier(const XcdBarrier& b) {
    asm volatile("s_waitcnt vmcnt(0)" ::: "memory");
    __syncthreads();
    if (threadIdx.x == 0) {
        unsigned* bar = b.bar;
        __builtin_amdgcn_s_waitcnt(0);
        unsigned nloc = b.st[0], nx = b.st[1];
        if (nloc == 0u) { xcd_barrier_complete(bar, b.x, nloc, nx); b.st[0] = nloc; b.st[1] = nx; }
        const unsigned old = xb_add(&bar[XB_XSUB(b.x)], 1u);
        const unsigned gen = old / nloc;
        if (old + 1u == (gen + 1u) * nloc) {
            __builtin_amdgcn_fence(__ATOMIC_RELEASE, "agent");
            asm volatile("s_waitcnt vmcnt(0)" ::: "memory");
            const unsigned og = xb_add(&bar[XB_TOP], 1u);
            const unsigned tg = og / nx;
            if (og + 1u == (tg + 1u) * nx) xb_add(&bar[XB_TOPGEN], 1u);
            else XB_SPIN(xb_ld(&bar[XB_TOPGEN]) == tg, bar);
            __builtin_amdgcn_fence(__ATOMIC_ACQUIRE, "agent");
            xb_add(&bar[XB_XGEN(b.x)], 1u);
            asm volatile("s_waitcnt vmcnt(0)" ::: "memory");
        } else {
            XB_SPIN(xb_ld(&bar[XB_XGEN(b.x)]) == gen, bar);
            __builtin_amdgcn_fence(__ATOMIC_ACQUIRE, "agent");
            asm volatile("s_waitcnt vmcnt(0)" ::: "memory");
        }
    }
    __syncthreads();
}

namespace g8 {
constexpr int BM = 256, BK = 64, HALF = 128, HTB = HALF * BK * 2, STAGE_BYTES = 8 * HTB;
__device__ __forceinline__ int lds_byte(int r, int c) { const int st = (r >> 4) * 2 + (c >> 5), rr = r & 15, cc = c & 31, ob = rr * 64 + cc * 2; return st * 1024 + (ob ^ (((ob >> 9) & 1) << 5)); }
__device__ __forceinline__ void stage_rc(int b, int& R, int& C) { const int st = b / 1024, sb = b % 1024, swz = sb ^ (((sb >> 9) & 1) << 5); R = (st >> 1) * 16 + swz / 64; C = (st & 1) * 32 + (swz % 64) / 2; }
__device__ __forceinline__ int perm32(int rho) { const int n = rho >> 4, i = rho & 15; return 8 * (i >> 2) + 4 * n + (i & 3); }

struct Unit { int pm, pn, z, rl; const char* A; const char* B; };

typedef int v8i __attribute__((ext_vector_type(8)));
typedef int v4i __attribute__((ext_vector_type(4)));
typedef short s16x16 __attribute__((ext_vector_type(16)));
typedef s16x16 s16x16_a16 __attribute__((aligned(16)));
__device__ __forceinline__ v8i cat8(bf16x8 lo, bf16x8 hi) { const v4i a = __builtin_bit_cast(v4i, lo), b = __builtin_bit_cast(v4i, hi); return __builtin_shufflevector(a, b, 0, 1, 2, 3, 4, 5, 6, 7); }
template <class Epi, class Sched, bool GATHER, bool FP8 = false>
__device__ __forceinline__ void gemm_phase(LAS unsigned char* lds, const int Kb, const int ldaB, const int ldbB, const Sched& S, const Epi& E) {
    const int tid = threadIdx.x, wid = __builtin_amdgcn_readfirstlane(tid >> 6), lane = tid & 63, wr = wid >> 2, wc = wid & 3, fr = lane & 15, fq = lane >> 4;
    const int nt = Kb / 128;
    unsigned voffB[2], cvo[2][2], nvo[2][2]; int Rr[2], Cc[2];
#pragma unroll
    for (int i = 0; i < 2; ++i) { int R, C; stage_rc(tid * 16 + i * 8192, R, C); const int Rb = (R & ~31) + perm32(R & 31);
        voffB[i] = (unsigned)(Rb * ldbB + C * 2); Rr[i] = R; Cc[i] = C;
#pragma unroll
        for (int h = 0; h < 2; ++h) { cvo[h][i] = (unsigned)((h * HALF + R) * ldaB + C * 2); nvo[h][i] = cvo[h][i]; } }
    const size_t kstep = (size_t)(BK * 2);
    const size_t hstepB = (size_t)HALF * ldbB;
    const unsigned ldsw = (unsigned)wid * 1024u;
    const int aoff = FP8 ? lds_byte(wr * 64 + fr, (fq >> 1) * 32 + (fq & 1) * 24) : lds_byte(wr * 64 + fr, fq * 8), boff = FP8 ? lds_byte(wc * 32 + fr, (fq >> 1) * 32 + (fq & 1) * 24) : lds_byte(wc * 32 + fr, fq * 8);
    const int aoff2 = FP8 ? lds_byte(wr * 64 + fr, (fq >> 1) * 32 + 8 + (fq & 1) * 8) : 0, boff2 = FP8 ? lds_byte(wc * 32 + fr, (fq >> 1) * 32 + 8 + (fq & 1) * 8) : 0;
#define G8_SA(b, h) (((b) * 2 + (h)) * HTB)
#define G8_SB(b, h) ((4 + (b) * 2 + (h)) * HTB)
#define G8_STGB(bufoff, gbase) do { _Pragma("unroll") for (int _i = 0; _i < 2; ++_i) \
        __builtin_amdgcn_global_load_lds((const unsigned*)((const char*)(gbase) + voffB[_i]), (LAS unsigned*)(lds + (bufoff) + ldsw + _i * 8192), 16, 0, 0); } while (0)
#define G8_STGA(bufoff, gbase, VO, h) do { _Pragma("unroll") for (int _i = 0; _i < 2; ++_i) \
        __builtin_amdgcn_global_load_lds((const unsigned*)((const char*)(gbase) + VO[h][_i]), (LAS unsigned*)(lds + (bufoff) + ldsw + _i * 8192), 16, 0, 0); } while (0)
#define G8_LDA(dst, b, h) do { _Pragma("unroll") for (int m = 0; m < 4; ++m) { if constexpr (FP8) { dst##8[m] = cat8(*(const LAS bf16x8*)(lds + G8_SA(b, h) + aoff + m * 2048), *(const LAS bf16x8*)(lds + G8_SA(b, h) + aoff2 + m * 2048)); } \
        else { _Pragma("unroll") for (int k = 0; k < 2; ++k) dst[m][k] = *(const LAS bf16x8*)(lds + G8_SA(b, h) + aoff + m * 2048 + k * 1024); } } } while (0)
#define G8_LDB(dst, b, h) do { _Pragma("unroll") for (int n = 0; n < 2; ++n) { if constexpr (FP8) { dst##8[n] = cat8(*(const LAS bf16x8*)(lds + G8_SB(b, h) + boff + n * 2048), *(const LAS bf16x8*)(lds + G8_SB(b, h) + boff2 + n * 2048)); } \
        else { _Pragma("unroll") for (int k = 0; k < 2; ++k) dst[n][k] = *(const LAS bf16x8*)(lds + G8_SB(b, h) + boff + n * 2048 + k * 1024); } } } while (0)
#define G8_MMA(ai, bj, At, Bt) do { __builtin_amdgcn_s_setprio(1); _Pragma("unroll") for (int m = 0; m < 4; ++m) _Pragma("unroll") for (int n = 0; n < 2; ++n) { \
        if constexpr (FP8) asm volatile("s_nop 1\n\tv_mfma_scale_f32_16x16x128_f8f6f4 %0, %1, %2, %0, %3, %4 op_sel_hi:[0,0,0]" : "+v"(acc[ai][bj][m][n]) : "v"(Bt##8[n]), "v"(At##8[m]), "v"(sc_w), "v"(sc_a)); \
        else { _Pragma("unroll") for (int k = 0; k < 2; ++k) acc[ai][bj][m][n] = __builtin_amdgcn_mfma_f32_16x16x32_bf16(Bt[n][k], At[m][k], acc[ai][bj][m][n], 0, 0, 0); } } __builtin_amdgcn_s_setprio(0); } while (0)
#define G8_WAIT_V(n) asm volatile("s_waitcnt vmcnt(" #n ")" ::: "memory")
#define G8_WAIT_L(n) asm volatile("s_waitcnt lgkmcnt(" #n ")" ::: "memory")
#define G8_BAR __builtin_amdgcn_s_barrier()
#define G8_SCHED __builtin_amdgcn_sched_barrier(0)
    Unit cur, nxt; int ui = 0;
    if (!S.next(0, cur)) return;
    bool has_next = S.next(1, nxt);
    if constexpr (GATHER) { S.gather(cur, Rr, Cc, cvo); if (has_next) S.gather(nxt, Rr, Cc, nvo); else {
#pragma unroll
        for (int h = 0; h < 2; ++h)
#pragma unroll
            for (int i = 0; i < 2; ++i) nvo[h][i] = cvo[h][i]; } }
    f32x4 acc[2][2][4][2];
#pragma unroll
    for (int a = 0; a < 2; ++a)
#pragma unroll
        for (int b = 0; b < 2; ++b)
#pragma unroll
            for (int m = 0; m < 4; ++m)
#pragma unroll
                for (int n = 0; n < 2; ++n) acc[a][b][m][n] = (f32x4){0.f, 0.f, 0.f, 0.f};
    const int sc_w = 0x7a7a7a7a, sc_a = 0x7f7f7f7f;
    bf16x8 At[4][2], B0[2][2], B1[2][2]; v8i At8[4], B08[2], B18[2];
    const char* cA = cur.A; const char* cB = cur.B;
    G8_STGB(G8_SB(0, 0), cB); G8_STGB(G8_SB(0, 1), cB + hstepB); G8_STGA(G8_SA(0, 0), cA, cvo, 0); G8_STGA(G8_SA(0, 1), cA, cvo, 1);
    if (wr == 1) G8_BAR;
    G8_WAIT_V(2); G8_BAR;
    G8_STGB(G8_SB(1, 0), cB + kstep); G8_STGA(G8_SA(1, 0), cA + kstep, cvo, 0); G8_STGB(G8_SB(1, 1), cB + hstepB + kstep);
    G8_WAIT_V(6); G8_BAR;
    for (;;) {
        const char* nA = has_next ? nxt.A : cA; const char* nB = has_next ? nxt.B : cB;
        for (int t = 0; t < nt; t += 2) {
            const bool last = (t == nt - 2);
            const char* a1 = cA + (size_t)(t + 1) * kstep;
            const char* a2 = last ? nA : cA + (size_t)(t + 2) * kstep; const char* b2 = last ? nB : cB + (size_t)(t + 2) * kstep;
            const char* a3 = a2 + kstep; const char* b3 = b2 + kstep;
            unsigned vo2[2][2];
#pragma unroll
            for (int h = 0; h < 2; ++h)
#pragma unroll
                for (int i = 0; i < 2; ++i) vo2[h][i] = (GATHER && last) ? nvo[h][i] : cvo[h][i];
            G8_LDB(B0, 0, 0); G8_LDB(B1, 0, 1); G8_SCHED; G8_LDA(At, 0, 0); G8_STGA(G8_SA(1, 1), a1, cvo, 1);
            G8_WAIT_V(8); G8_WAIT_L(0); G8_BAR; G8_SCHED; G8_MMA(0, 0, At, B0); G8_MMA(0, 1, At, B1); G8_SCHED; G8_BAR; G8_SCHED;
            G8_LDA(At, 0, 1); G8_STGB(G8_SB(0, 0), b2); G8_STGB(G8_SB(0, 1), b2 + hstepB); G8_STGA(G8_SA(0, 0), a2, vo2, 0);
            G8_WAIT_V(8); G8_WAIT_L(0); G8_BAR; G8_SCHED; G8_MMA(1, 0, At, B0); G8_MMA(1, 1, At, B1); G8_SCHED; G8_BAR; G8_SCHED;
            G8_LDB(B0, 1, 0); G8_LDB(B1, 1, 1); G8_SCHED; G8_LDA(At, 1, 0); G8_STGA(G8_SA(0, 1), a2, vo2, 1);
            G8_WAIT_V(8); G8_WAIT_L(0); G8_BAR; G8_SCHED; G8_MMA(0, 0, At, B0); G8_MMA(0, 1, At, B1); G8_SCHED; G8_BAR; G8_SCHED;
            G8_LDA(At, 1, 1); G8_STGB(G8_SB(1, 0), b3); G8_STGB(G8_SB(1, 1), b3 + hstepB); G8_STGA(G8_SA(1, 0), a3, vo2, 0);
            G8_WAIT_V(8); G8_WAIT_L(0); G8_BAR; G8_SCHED; G8_MMA(1, 0, At, B0); G8_MMA(1, 1, At, B1); G8_SCHED; G8_BAR; G8_SCHED;
        }
        f32x4 bpre[4]; E.pre(cur, wr, wc, fr, fq, bpre);
        if (wr == 0) G8_BAR;
        Unit nn; bool has_nn = false;
        if (has_next) has_nn = S.next(ui + 2, nn);
        unsigned nnvo[2][2];
        if constexpr (GATHER) { if (has_nn) S.gather(nn, Rr, Cc, nnvo); }
        if constexpr (FP8) asm volatile("s_nop 15\n\ts_nop 15" ::: "memory");
        E(acc, cur, wr, wc, fr, fq, bpre);
        if (!has_next) break;
#pragma unroll
        for (int a = 0; a < 2; ++a)
#pragma unroll
            for (int b = 0; b < 2; ++b)
#pragma unroll
                for (int m = 0; m < 4; ++m)
#pragma unroll
                    for (int n = 0; n < 2; ++n) acc[a][b][m][n] = (f32x4){0.f, 0.f, 0.f, 0.f};
        cur = nxt; cA = nA; cB = nB; ++ui;
        if constexpr (GATHER) {
#pragma unroll
            for (int h = 0; h < 2; ++h)
#pragma unroll
                for (int i = 0; i < 2; ++i) { cvo[h][i] = nvo[h][i]; if (has_nn) nvo[h][i] = nnvo[h][i]; } }
        nxt = nn; has_next = has_nn;
        if (wr == 1) G8_BAR;
    }
    G8_WAIT_V(0);
    G8_BAR;
#undef G8_SA
#undef G8_SB
#undef G8_STGB
#undef G8_STGA
#undef G8_LDA
#undef G8_LDB
#undef G8_MMA
#undef G8_WAIT_V
#undef G8_WAIT_L
#undef G8_BAR
#undef G8_SCHED
}

struct GridOrder {
    int nM, nN, nwg, G, c; const char* A; const char* B; size_t tstepA, tstepB;
    __device__ __forceinline__ void init(int M, int N, int G_, int c_, const void* A_, const void* B_, int ldaB, int ldbB) { nM = M / BM; nN = N / BM; nwg = nM * nN; G = G_; c = c_; A = (const char*)A_; B = (const char*)B_; tstepA = (size_t)BM * ldaB; tstepB = (size_t)BM * ldbB; }
    __device__ __forceinline__ bool next(int i, Unit& u) const {
        const long L = (long)i * G + c; if (L >= nwg) return false;
        int wgid = (int)L; { const int q = nwg / 8, r = nwg % 8, xcd = wgid % 8, off = wgid / 8; wgid = (xcd < r ? xcd * (q + 1) : r * (q + 1) + (xcd - r) * q) + off; }
        const int nig = 8 * nN, gid = wgid / nig, fm = gid * 8, gsz = (nM - fm) < 8 ? (nM - fm) : 8;
        u.pm = fm + ((wgid % nig) % gsz); u.pn = (wgid % nig) / gsz; u.z = 0; u.rl = 0;
        u.A = A + (size_t)u.pm * tstepA; u.B = B + (size_t)u.pn * tstepB; return true;
    }
};
}

struct Frame {
    LAS unsigned char* lds; volatile LAS unsigned* MISC; unsigned* ctl;
    int tid, lane, wave, vcu, G;
    const float* in[34]; float* out; unsigned char* ws;
};
#define WSP(T_, off) ((T_*)(F.ws + (off)))

struct EpiInProj { static constexpr int NST = 16;
    __device__ __forceinline__ void pre(const g8::Unit& u, int, int wc, int, int fq, f32x4 (&bp)[4]) const { const int colb = u.pn * 256 + wc * 32 + 8 * fq;
#pragma unroll
        for (int bj = 0; bj < 2; ++bj)
#pragma unroll
            for (int n = 0; n < 2; ++n) bp[bj * 2 + n] = *(const f32x4*)(bias + colb + bj * 128 + 4 * n); }
    const float* bias; bf16 *xrnn, *gy, *acat, *gates;
    template <int KIND>
    __device__ __forceinline__ void run(const f32x4 (&acc)[2][2][4][2], const g8::Unit& u, int wr, int wc, int fr, int fq, const f32x4 (&bpre)[4]) const {
        const int colb = u.pn * 256 + wc * 32 + 8 * fq;
#pragma unroll
        for (int ai = 0; ai < 2; ++ai)
#pragma unroll
            for (int m = 0; m < 4; ++m) { const int t = u.pm * 256 + ai * 128 + wr * 64 + m * 16 + fr;
#pragma unroll
                for (int bj = 0; bj < 2; ++bj) { f32x4 v0 = acc[ai][bj][m][0] + bpre[bj * 2], v1 = acc[ai][bj][m][1] + bpre[bj * 2 + 1]; const int col = colb + bj * 128;
                    if (KIND == 0) { u32x2 w8; w8.x = pk4_fp8(v0[0], v0[1], v0[2], v0[3]); w8.y = pk4_fp8(v1[0], v1[1], v1[2], v1[3]); *(u32x2*)((unsigned char*)xrnn + (size_t)t * 1024 + col) = w8; }
                    else if (KIND == 1) {
#pragma unroll
                        for (int j = 0; j < 4; ++j) { v0[j] = gelu_tanh(v0[j]); v1[j] = gelu_tanh(v1[j]); }
                        u32x2 w8; w8.x = pk4_fp8(v0[0], v0[1], v0[2], v0[3]); w8.y = pk4_fp8(v1[0], v1[1], v1[2], v1[3]); *(u32x2*)((unsigned char*)gy + (size_t)t * 1024 + (col - 1024)) = w8; }
                    else if (KIND == 2) { const int cu = col - 2048, g = cu >> 4, c = cu & 15;
                        *(u32x4*)(acat + ((size_t)(g * S5M + (t >> 5)) * S5ROW + 128 + (t & 31) * 16 + c)) = pack8(v0, v1); }
                    else {
#pragma unroll
                        for (int j = 0; j < 4; ++j) { v0[j] = fast_sigmoid(v0[j]); v1[j] = fast_sigmoid(v1[j]); }
                        u32x2 w8; w8.x = pk4_fp8(v0[0], v0[1], v0[2], v0[3]); w8.y = pk4_fp8(v1[0], v1[1], v1[2], v1[3]); *(u32x2*)((unsigned char*)gates + (size_t)t * 2048 + (col - 2560)) = w8; } } }
    }
    __device__ __forceinline__ void operator()(const f32x4 (&acc)[2][2][4][2], const g8::Unit& u, int wr, int wc, int fr, int fq, const f32x4 (&bpre)[4]) const {
        const int pn = u.pn;
        if (pn < 4) run<0>(acc, u, wr, wc, fr, fq, bpre); else if (pn < 8) run<1>(acc, u, wr, wc, fr, fq, bpre); else if (pn < 10) run<2>(acc, u, wr, wc, fr, fq, bpre); else run<3>(acc, u, wr, wc, fr, fq, bpre);
    }
};
struct EpiS5A {
    __device__ __forceinline__ void pre(const g8::Unit&, int, int, int, int, f32x4 (&)[4]) const {}
    float* S;
    __device__ __forceinline__ void operator()(const f32x4 (&acc)[2][2][4][2], const g8::Unit& u, int wr, int wc, int fr, int fq, const f32x4 (&bpre)[4]) const {
        const int col = wc * 32 + 8 * fq;
#pragma unroll
        for (int ai = 0; ai < 2; ++ai)
#pragma unroll
            for (int m = 0; m < 4; ++m) { const int row = u.pm * 256 + ai * 128 + wr * 64 + m * 16 + fr; float* p = S + ((size_t)(u.z * S5M + row)) * 128 + col;
                *(f32x4*)p = acc[ai][0][m][0]; *(f32x4*)(p + 4) = acc[ai][0][m][1]; }
    }
};
struct EpiS5C {
    __device__ __forceinline__ void pre(const g8::Unit&, int, int, int, int, f32x4 (&)[4]) const {}
    bf16* ys;
    __device__ __forceinline__ void operator()(const f32x4 (&acc)[2][2][4][2], const g8::Unit& u, int wr, int wc, int fr, int fq, const f32x4 (&bpre)[4]) const {
#pragma unroll
        for (int ai = 0; ai < 2; ++ai)
#pragma unroll
            for (int m = 0; m < 4; ++m) { const int row = u.pm * 256 + ai * 128 + wr * 64 + m * 16 + fr;
#pragma unroll
                for (int bj = 0; bj < 2; ++bj) { const int n = u.pn * 256 + bj * 128 + wc * 32 + 8 * fq, i = n >> 4, c = n & 15; f32x4 v0 = acc[ai][bj][m][0], v1 = acc[ai][bj][m][1];
#pragma unroll
                    for (int j = 0; j < 4; ++j) { v0[j] = gelu_tanh(v0[j]); v1[j] = gelu_tanh(v1[j]); }
                    u32x2 w8; w8.x = pk4_fp8(v0[0], v0[1], v0[2], v0[3]); w8.y = pk4_fp8(v1[0], v1[1], v1[2], v1[3]); *(u32x2*)((unsigned char*)ys + (size_t)(row * 32 + i) * 512 + u.z * 16 + c) = w8; } }
    }
};
struct EpiGlu { static constexpr int NST = 8;
    __device__ __forceinline__ void pre(const g8::Unit&, int, int, int, int, f32x4 (&)[4]) const {}
    const bf16* gates; bf16* gb;
    __device__ __forceinline__ void operator()(const f32x4 (&acc)[2][2][4][2], const g8::Unit& u, int wr, int wc, int fr, int fq, const f32x4 (&bpre)[4]) const {
        const int f = u.pn * 128 + wc * 32 + 8 * fq;
#pragma unroll
        for (int ai = 0; ai < 2; ++ai) { u32x2 gw[4];
#pragma unroll
            for (int m = 0; m < 4; ++m) { const int t = u.pm * 256 + ai * 128 + wr * 64 + m * 16 + fr; gw[m] = *(const u32x2*)((const unsigned char*)gates + (size_t)t * 2048 + 1024 + f); }
#pragma unroll
            for (int m = 0; m < 4; ++m) { const int t = u.pm * 256 + ai * 128 + wr * 64 + m * 16 + fr;
                f32x4 g0, g1; unpack8_fp8(gw[m], g0, g1);
                f32x4 v0 = acc[ai][0][m][0], v1 = acc[ai][0][m][1]; const f32x4 s0 = acc[ai][1][m][0], s1 = acc[ai][1][m][1];
#pragma unroll
                for (int j = 0; j < 4; ++j) { v0[j] = g0[j] * v0[j] * fast_sigmoid(s0[j]); v1[j] = g1[j] * v1[j] * fast_sigmoid(s1[j]); }
                u32x2 w8; w8.x = pk4_fp8(v0[0], v0[1], v0[2], v0[3]); w8.y = pk4_fp8(v1[0], v1[1], v1[2], v1[3]); *(u32x2*)((unsigned char*)gb + (size_t)t * 1024 + f) = w8; } }
    }
};
struct EpiRnn { static constexpr int NST = 16;
    __device__ __forceinline__ void pre(const g8::Unit&, int, int, int, int, f32x4 (&)[4]) const {}
    const bf16* gates; const bf16* gb; bf16* merged;
    __device__ __forceinline__ void operator()(const f32x4 (&acc)[2][2][4][2], const g8::Unit& u, int wr, int wc, int fr, int fq, const f32x4 (&bpre)[4]) const {
#pragma unroll
        for (int ai = 0; ai < 2; ++ai)
#pragma unroll
            for (int mh = 0; mh < 2; ++mh) { u32x2 gw[2][2], bw[2][2];
#pragma unroll
                for (int mm = 0; mm < 2; ++mm) { const int t = u.pm * 256 + ai * 128 + wr * 64 + (2 * mh + mm) * 16 + fr;
#pragma unroll
                    for (int bj = 0; bj < 2; ++bj) { const int col = u.pn * 256 + bj * 128 + wc * 32 + 8 * fq; gw[mm][bj] = *(const u32x2*)((const unsigned char*)gates + (size_t)t * 2048 + col); bw[mm][bj] = *(const u32x2*)((const unsigned char*)gb + (size_t)t * 1024 + col); } }
#pragma unroll
                for (int mm = 0; mm < 2; ++mm) { const int m = 2 * mh + mm, t = u.pm * 256 + ai * 128 + wr * 64 + m * 16 + fr;
#pragma unroll
                    for (int bj = 0; bj < 2; ++bj) { const int col = u.pn * 256 + bj * 128 + wc * 32 + 8 * fq;
                        f32x4 g0, g1, b0, b1; unpack8_fp8(gw[mm][bj], g0, g1); unpack8_fp8(bw[mm][bj], b0, b1);
                        const f32x4 v0 = g0 * acc[ai][bj][m][0] + b0, v1 = g1 * acc[ai][bj][m][1] + b1;
                        u32x2 w8; w8.x = pk4_fp8(v0[0], v0[1], v0[2], v0[3]); w8.y = pk4_fp8(v1[0], v1[1], v1[2], v1[3]); *(u32x2*)((unsigned char*)merged + (size_t)t * 1024 + col) = w8; } } }
    }
};
struct EpiOut { static constexpr int NST = 16;
    const float* x; const float* mod; bf16* v1;
    __device__ __forceinline__ void pre(const g8::Unit& u, int, int wc, int, int fq, f32x4 (&bp)[4]) const { const int b = (u.pm * 256) >> 12; const float* p = mod + b * 6144 + 2048 + u.pn * 256 + wc * 32 + 8 * fq;
        bp[0] = *(const f32x4*)p; bp[1] = *(const f32x4*)(p + 4); bp[2] = *(const f32x4*)(p + 128); bp[3] = *(const f32x4*)(p + 132); }
    __device__ __forceinline__ void operator()(const f32x4 (&acc)[2][2][4][2], const g8::Unit& u, int wr, int wc, int fr, int fq, const f32x4 (&bpre)[4]) const {
#pragma unroll
        for (int ai = 0; ai < 2; ++ai)
#pragma unroll
            for (int mh = 0; mh < 2; ++mh) { f32x4 xv[2][2][2];
#pragma unroll
                for (int mm = 0; mm < 2; ++mm) { const int t = u.pm * 256 + ai * 128 + wr * 64 + (2 * mh + mm) * 16 + fr;
#pragma unroll
                    for (int bj = 0; bj < 2; ++bj) { const int col = u.pn * 256 + bj * 128 + wc * 32 + 8 * fq; xv[mm][bj][0] = *(const f32x4*)(x + (size_t)t * 1024 + col); xv[mm][bj][1] = *(const f32x4*)(x + (size_t)t * 1024 + col + 4); } }
#pragma unroll
                for (int mm = 0; mm < 2; ++mm) { const int m = 2 * mh + mm, t = u.pm * 256 + ai * 128 + wr * 64 + m * 16 + fr;
#pragma unroll
                    for (int bj = 0; bj < 2; ++bj) { const int col = u.pn * 256 + bj * 128 + wc * 32 + 8 * fq;
                        const f32x4 v0 = xv[mm][bj][0] * DN_ALPHA + (bpre[2 * bj] + 1.0f) * acc[ai][bj][m][0], v1_ = xv[mm][bj][1] * DN_ALPHA + (bpre[2 * bj + 1] + 1.0f) * acc[ai][bj][m][1];
                        *(u32x4*)(v1 + (size_t)t * 1024 + col) = pack8(v0, v1_); } } }
    }
};
struct EpiMoe1 {
    __device__ __forceinline__ void pre(const g8::Unit& u, int, int wc, int, int fq, f32x4 (&bp)[4]) const { const float* p = bgu + (size_t)u.z * 2048 + u.pn * 128 + wc * 32 + 8 * fq; bp[0] = *(const f32x4*)p; bp[1] = *(const f32x4*)(p + 4); bp[2] = *(const f32x4*)(p + 1024); bp[3] = *(const f32x4*)(p + 1028); }
    const float* bgu; bf16* act;
    __device__ __forceinline__ void operator()(const f32x4 (&acc)[2][2][4][2], const g8::Unit& u, int wr, int wc, int fr, int fq, const f32x4 (&bpre)[4]) const {
        const int f = u.pn * 128 + wc * 32 + 8 * fq; const float* bp = bgu + (size_t)u.z * 2048 + f;
        (void)bp; const f32x4 bg0 = bpre[0], bg1 = bpre[1], bu0 = bpre[2], bu1 = bpre[3];
#pragma unroll
        for (int ai = 0; ai < 2; ++ai)
#pragma unroll
            for (int m = 0; m < 4; ++m) { const int row = u.pm * 256 + ai * 128 + wr * 64 + m * 16 + fr;
                f32x4 g0 = acc[ai][0][m][0] + bg0, g1 = acc[ai][0][m][1] + bg1, u0 = acc[ai][1][m][0] + bu0, u1 = acc[ai][1][m][1] + bu1;
#pragma unroll
                for (int j = 0; j < 4; ++j) { const float ga = fminf(g0[j], 7.0f), gb_ = fminf(g1[j], 7.0f), ua = fminf(fmaxf(u0[j], -7.0f), 7.0f), ub = fminf(fmaxf(u1[j], -7.0f), 7.0f);
                    g0[j] = ga * fast_sigmoid(1.702f * ga) * (ua + 1.0f); g1[j] = gb_ * fast_sigmoid(1.702f * gb_) * (ub + 1.0f); }
                u32x2 w8; w8.x = pk4_fp8(g0[0], g0[1], g0[2], g0[3]); w8.y = pk4_fp8(g1[0], g1[1], g1[2], g1[3]); *(u32x2*)((unsigned char*)act + (size_t)row * 1024 + f) = w8; }
    }
};
struct EpiMoe2 {
    __device__ __forceinline__ void pre(const g8::Unit& u, int, int wc, int, int fq, f32x4 (&bp)[4]) const { const float* p = bd + (size_t)u.z * 1024 + u.pn * 256 + wc * 32 + 8 * fq; bp[0] = *(const f32x4*)p; bp[1] = *(const f32x4*)(p + 4); bp[2] = *(const f32x4*)(p + 128); bp[3] = *(const f32x4*)(p + 132); }
    const float* bd; bf16* yb;
    __device__ __forceinline__ void operator()(const f32x4 (&acc)[2][2][4][2], const g8::Unit& u, int wr, int wc, int fr, int fq, const f32x4 (&bpre)[4]) const {
#pragma unroll
        for (int bj = 0; bj < 2; ++bj) { const int col = u.pn * 256 + bj * 128 + wc * 32 + 8 * fq; const float* bp = bd + (size_t)u.z * 1024 + col;
            (void)bp; const f32x4 b0 = bpre[bj * 2], b1 = bpre[bj * 2 + 1];
#pragma unroll
            for (int ai = 0; ai < 2; ++ai)
#pragma unroll
                for (int m = 0; m < 4; ++m) { const int row = u.pm * 256 + ai * 128 + wr * 64 + m * 16 + fr;
                    const f32x4 y0 = acc[ai][bj][m][0] + b0, y1 = acc[ai][bj][m][1] + b1; u32x2 w8; w8.x = pk4_fp8(y0[0], y0[1], y0[2], y0[3]); w8.y = pk4_fp8(y1[0], y1[1], y1[2], y1[3]);
                    *(u32x2*)((unsigned char*)yb + (size_t)row * 1024 + col) = w8; } }
    }
};

struct S5AOrder { int G, c; const char* acat; const char* ws;
    __device__ __forceinline__ bool next(int i, g8::Unit& u) const { const int L = i * G + c; if (L >= S5G * 4) return false; u.z = L >> 2; u.pm = L & 3; u.pn = 0; u.rl = 0;
        u.A = acat + ((size_t)(u.z * S5M + u.pm * 256) * S5ROW + 128) * 2; u.B = ws + (size_t)u.z * 256 * (S5L * 16) * 2; return true; } };
struct S5COrder { int G, c; const char* acat; const char* wy;
    __device__ __forceinline__ bool next(int i, g8::Unit& u) const { const int L = i * G + c; if (L >= S5G * 8) return false; u.z = L >> 3; u.pm = (L >> 1) & 3; u.pn = L & 1; u.rl = 0;
        u.A = acat + ((size_t)(u.z * S5M + u.pm * 256) * S5ROW) * 2; u.B = wy + ((size_t)(u.z * 512 + u.pn * 256) * S5ROW) * 2; return true; } };
struct MoeOrder { int G, c, NT, RT; const LAS int* tstart; const LAS int* cnt; const int* toklist; const char* A; const char* B; size_t bstride_e; int lda; bool gatherA;
    __device__ __forceinline__ bool next(int i, g8::Unit& u) const { const int per = G >> 3, xcd = c & 7, slot = c >> 3, rpx = per / NT;
        const int rt = (i * 8 + xcd) * rpx + slot / NT; if (rt >= RT) return false; u.pn = slot % NT;
        const int lane_ = threadIdx.x & 63; const unsigned long long mk_ = __ballot(lane_ < NE && tstart[lane_ & 31] <= rt);
        const int e = __builtin_popcountll(mk_) - 1;
        u.z = e; u.pm = rt; u.rl = rt - tstart[e]; u.B = B + (size_t)e * bstride_e + (size_t)u.pn * 256 * 1024; u.A = gatherA ? A : A + (size_t)rt * 256 * 1024; return true; }
    __device__ __forceinline__ void gather(const g8::Unit& u, const int (&Rr)[2], const int (&Cc)[2], unsigned (&vo)[2][2]) const {
        const int n = cnt[u.z];
#pragma unroll
        for (int h = 0; h < 2; ++h)
#pragma unroll
            for (int i = 0; i < 2; ++i) { const int r = u.rl * 256 + h * 128 + Rr[i]; const int rc = r < n ? r : n - 1; const int tok = toklist[u.z * T + rc]; vo[h][i] = (unsigned)(tok * lda + Cc[i] * 2); } }
};

__device__ __forceinline__ void transpose_item(const float* W, int N, int k0, int n0, bf16* dst, int ldd, int drow0, LAS float* scr, int lane) {
    float wv_[32];
#pragma unroll
    for (int i = 0; i < 32; ++i) wv_[i] = W[(size_t)(k0 + 2 * i + (lane >> 5)) * N + n0 + (lane & 31)];
#pragma unroll
    for (int i = 0; i < 32; ++i) scr[(2 * i + (lane >> 5)) * 33 + (lane & 31)] = wv_[i];
    asm volatile("s_waitcnt lgkmcnt(0)" ::: "memory");
    const int c = lane & 7;
#pragma unroll
    for (int j = 0; j < 4; ++j) { const int n = (lane >> 3) + 8 * j; const LAS float* s = scr + (8 * c) * 33 + n;
        u32x4 o; o.x = pk2(s[0 * 33], s[1 * 33]); o.y = pk2(s[2 * 33], s[3 * 33]); o.z = pk2(s[4 * 33], s[5 * 33]); o.w = pk2(s[6 * 33], s[7 * 33]);
        *(u32x4*)(dst + (size_t)(drow0 + n) * ldd + k0 + 8 * c) = o; }
    asm volatile("s_waitcnt lgkmcnt(0)" ::: "memory");
}
__device__ __forceinline__ void transpose_item8(const float* W, int N, int k0, int n0, unsigned char* dst, int ldd, int drow0, LAS float* scr, int lane) {
    float wv_[32];
#pragma unroll
    for (int i = 0; i < 32; ++i) wv_[i] = W[(size_t)(k0 + 2 * i + (lane >> 5)) * N + n0 + (lane & 31)];
#pragma unroll
    for (int i = 0; i < 32; ++i) scr[(2 * i + (lane >> 5)) * 33 + (lane & 31)] = wv_[i];
    asm volatile("s_waitcnt lgkmcnt(0)" ::: "memory");
    const int c = lane & 7;
#pragma unroll
    for (int j = 0; j < 4; ++j) { const int n = (lane >> 3) + 8 * j; const LAS float* s = scr + (8 * c) * 33 + n;
        u32x2 o; o.x = pk4_fp8(32.f * s[0 * 33], 32.f * s[1 * 33], 32.f * s[2 * 33], 32.f * s[3 * 33]); o.y = pk4_fp8(32.f * s[4 * 33], 32.f * s[5 * 33], 32.f * s[6 * 33], 32.f * s[7 * 33]);
        *(u32x2*)(dst + (size_t)(drow0 + n) * ldd + k0 + 8 * c) = o; }
    asm volatile("s_waitcnt lgkmcnt(0)" ::: "memory");
}
__device__ __forceinline__ void transpose_item8w(const float* W, int N, int k0, int n0, unsigned char* dst, int ldd, int drow0, LAS float* scr, int lane) {
    float wv[64]; const float* wp = W + (size_t)(k0 + (lane >> 5)) * N + n0 + (lane & 31);
#pragma unroll
    for (int i = 0; i < 64; ++i) wv[i] = wp[(size_t)(2 * i) * N];
#pragma unroll
    for (int i = 0; i < 64; ++i) scr[(2 * i + (lane >> 5)) * 33 + (lane & 31)] = wv[i];
    asm volatile("s_waitcnt lgkmcnt(0)" ::: "memory");
    const int c = lane & 7;
#pragma unroll
    for (int j = 0; j < 4; ++j) { const int n = (lane >> 3) + 8 * j; const LAS float* s = scr + (16 * c) * 33 + n;
        u32x4 o; o.x = pk4_fp8(32.f * s[0 * 33], 32.f * s[1 * 33], 32.f * s[2 * 33], 32.f * s[3 * 33]); o.y = pk4_fp8(32.f * s[4 * 33], 32.f * s[5 * 33], 32.f * s[6 * 33], 32.f * s[7 * 33]);
        o.z = pk4_fp8(32.f * s[8 * 33], 32.f * s[9 * 33], 32.f * s[10 * 33], 32.f * s[11 * 33]); o.w = pk4_fp8(32.f * s[12 * 33], 32.f * s[13 * 33], 32.f * s[14 * 33], 32.f * s[15 * 33]);
        *(u32x4*)(dst + (size_t)(drow0 + n) * ldd + k0 + 16 * c) = o; }
    asm volatile("s_waitcnt lgkmcnt(0)" ::: "memory");
}
__device__ __forceinline__ int pair_row(int n) { const int f = n & 1023, hi = n >> 10; return (f >> 7) * 256 + hi * 128 + (f & 127); }

__device__ __forceinline__ void moe_tables(Frame& F) {
    LAS int* tstart = (LAS int*)(F.lds + TAB_OFF); LAS int* cl = tstart + 40;
    if (F.tid < 64) {
        const int e = F.lane & 31; const int c = (int)F.ctl[CW_CNT + 64 * e]; int inc = (c + 255) >> 8;
#pragma unroll
        for (int o = 1; o < 32; o <<= 1) { const int v = __shfl_up(inc, o); if ((F.lane & 31) >= o) inc += v; }
        if (F.lane < 32) { cl[e] = c; tstart[e] = inc - ((c + 255) >> 8); if (e == NE - 1) tstart[NE] = inc; }
    }
    __syncthreads();
}

__device__ __forceinline__ void p0_mod_job(Frame& F, int job) {
    LAS float* sc = (LAS float*)F.lds;
    LAS float* red = sc + 8 * 1024;
    const float* c = F.in[1]; const float* w = F.in[2]; const float* bias = F.in[3];
    for (int i = F.tid; i < 8 * 1024; i += 512) { const float v = c[i]; sc[i] = v * fast_sigmoid(v); }
    __syncthreads();
    const int col = F.tid & 31, kg = F.tid >> 5, j = job * 32 + col;
    float a[8];
#pragma unroll
    for (int b = 0; b < 8; ++b) a[b] = 0.f;
#pragma unroll 32
    for (int k = kg * 64; k < kg * 64 + 64; ++k) { const float wv = w[(size_t)k * 6144 + j];
#pragma unroll
        for (int b = 0; b < 8; ++b) a[b] += sc[b * 1024 + k] * wv; }
#pragma unroll
    for (int b = 0; b < 8; ++b) red[(kg * 8 + b) * 32 + col] = a[b];
    __syncthreads();
    if (F.tid < 256) { const int b = F.tid >> 5, cc = F.tid & 31; float s = 0.f;
#pragma unroll
        for (int g = 0; g < 16; ++g) s += red[(g * 8 + b) * 32 + cc];
        WSP(float, WS_MOD)[b * 6144 + job * 32 + cc] = s + bias[job * 32 + cc]; }
    __syncthreads();
}
__device__ __forceinline__ void s5_setup(Frame& F, int g, int kmin, int kmax, LAS f32x2* Bb, LAS f32x2* Cc, LAS f32x2* Ap) {
    const float* lre = F.in[14] + g * 64; const float* lim = F.in[15] + g * 64; const float dt = expf(F.in[16][g]);
    const float* bre = F.in[17] + g * 1024; const float* bim = F.in[18] + g * 1024; const float* cre = F.in[19] + g * 1024; const float* cim = F.in[20] + g * 1024;
    for (int i = F.tid; i < 1024; i += 512) { const int p = i >> 4; const float lr = lre[p], li = lim[p]; const float mag = expf(lr * dt); float sn, cs; sincosf(li * dt, &sn, &cs);
        const float ar = mag * cs, ai = mag * sn, den = lr * lr + li * li, qr = ((ar - 1.f) * lr + ai * li) / den, qi = (ai * lr - (ar - 1.f) * li) / den;
        const float br = bre[i], bi = bim[i]; Bb[i] = (f32x2){qr * br - qi * bi, qr * bi + qi * br};
        Cc[i] = (f32x2){cre[i], cim[i]}; }
    if (F.tid < 64) { const int p = F.tid; const float lr = lre[p], li = lim[p]; const float mag = expf(lr * dt); float sn, cs; sincosf(li * dt, &sn, &cs);
        const float ar = mag * cs, ai = mag * sn; float xr_ = 1.f, xi_ = 0.f;
        for (int k = 0; k <= kmax; ++k) { if (k >= kmin) Ap[k * 64 + p] = (f32x2){xr_, xi_}; const float nr = xr_ * ar - xi_ * ai, ni = xr_ * ai + xi_ * ar; xr_ = nr; xi_ = ni; } }
    __syncthreads();
}
constexpr size_t WS_KTAB = WS_S;
constexpr size_t WS_WRIMG = WS_AL + 512 * 1024;
__device__ __forceinline__ void p0_s5k_job(Frame& F, int job) {
    const int g = job >> 3, part = job & 7;
    LAS f32x2* Bb = (LAS f32x2*)F.lds; LAS f32x2* Cc = Bb + 1024; LAS f32x2* Ap = Cc + 1024;
    s5_setup(F, g, 4 * part, 4 * part + 3, Bb, Cc, Ap);
    float* kt = WSP(float, WS_KTAB) + (size_t)g * 32 * 256;
    for (int e = 4 * part * 256 + F.tid; e < (4 * part + 4) * 256; e += 512) { const int k = e >> 8, c = (e >> 4) & 15, c2 = e & 15; float s = 0.f;
        for (int p = 0; p < 64; ++p) { const f32x2 cv = Cc[c * 64 + p], av = Ap[k * 64 + p], bv = Bb[p * 16 + c2];
            const float car = cv.x * av.x - cv.y * av.y, cai = cv.x * av.y + cv.y * av.x; s += car * bv.x - cai * bv.y; }
        kt[e] = s; }
    __syncthreads();
}
__device__ __forceinline__ void p1_s5w_job(Frame& F, int job) {
    const int g = job >> 3, part = job & 7;
    LAS f32x2* Bb = (LAS f32x2*)F.lds; LAS f32x2* Cc = Bb + 1024; LAS f32x2* Ap = Cc + 1024; LAS float* Kt = (LAS float*)(Ap + 33 * 64);
    const float* ktg = WSP(float, WS_KTAB) + (size_t)g * 32 * 256; const float* dsk = F.in[21] + g * 16;
    for (int i = F.tid; i < 32 * 256; i += 512) Kt[i] = ktg[i];
    s5_setup(F, g, 0, S5L, Bb, Cc, Ap);
    if (part == 0 && F.tid < 64) WSP(f32x2, WS_AL)[g * 64 + F.tid] = Ap[S5L * 64 + F.tid];
    bf16* wy = WSP(bf16, WS_WY) + (size_t)g * 512 * S5ROW;
    for (int ch = F.tid; ch < 64 * (S5ROW / 8); ch += 512) { const int n = part * 64 + ch / (S5ROW / 8), k8 = (ch % (S5ROW / 8)) * 8, i = n >> 4, c = n & 15; float v[8]; const float dskc = dsk[c];
        if (k8 < 128) {
#pragma unroll
            for (int j = 0; j < 8; j += 2) { const int p = (k8 + j) >> 1; const f32x2 cv = Cc[c * 64 + p], av = Ap[(i + 1) * 64 + p]; v[j] = cv.x * av.x - cv.y * av.y; v[j + 1] = -(cv.x * av.y + cv.y * av.x); } }
        else { const int jj = (k8 - 128) >> 4, c2 = (k8 - 128) & 15;
#pragma unroll
            for (int j = 0; j < 8; ++j) { float x = 0.f; if (jj <= i) { x = Kt[(i - jj) * 256 + c * 16 + c2 + j]; x += (jj == i && c == c2 + j) ? dskc : 0.f; } v[j] = x; } }
        u32x4 o; o.x = pk2(v[0], v[1]); o.y = pk2(v[2], v[3]); o.z = pk2(v[4], v[5]); o.w = pk2(v[6], v[7]);
        *(u32x4*)(wy + (size_t)n * S5ROW + k8) = o; }
    bf16* wsm = WSP(bf16, WS_WS) + (size_t)g * 256 * 512;
    for (int ch = F.tid; ch < 32 * 64; ch += 512) { const int n = part * 32 + (ch >> 6), k8 = (ch & 63) * 8, jj = k8 >> 4, c2 = k8 & 15; float v[8];
#pragma unroll
        for (int j = 0; j < 8; ++j) { float x = 0.f; if (n < 128) { const int p = n >> 1; const f32x2 av = Ap[(S5L - 1 - jj) * 64 + p], bv = Bb[p * 16 + c2 + j]; x = (n & 1) ? (av.x * bv.y + av.y * bv.x) : (av.x * bv.x - av.y * bv.y); } v[j] = x; }
        u32x4 o; o.x = pk2(v[0], v[1]); o.y = pk2(v[2], v[3]); o.z = pk2(v[4], v[5]); o.w = pk2(v[6], v[7]);
        *(u32x4*)(wsm + (size_t)n * 512 + k8) = o; }
    __syncthreads();
}
__device__ __forceinline__ void p0_small_transposes(Frame& F) {
    LAS float* scr = (LAS float*)(F.lds + F.wave * 16384);
    const int gw = F.vcu * 8 + F.wave, NGW = F.G * 8;
    constexpr int I_IN = 16 * 144, I_RNN = 16 * 32, I_OUT = 16 * 32, I_GLU = 8 * 64, I_RG = 16 * 8;
    for (int it = gw; it < I_IN + I_RNN + I_OUT + I_GLU + I_RG; it += NGW) { int r = it;
        if (r < I_IN) { const int kb = r / 144, nb = r % 144; transpose_item8(F.in[4], INC, kb * 64, nb * 32, WSP(unsigned char, WS_WIN), 1024, nb * 32, scr, F.lane); continue; } r -= I_IN;
        if (r < I_RNN) { const int kb = r / 32, nb = r % 32; transpose_item8(F.in[13], 1024, kb * 64, nb * 32, WSP(unsigned char, WS_WRNN), 1024, nb * 32, scr, F.lane); continue; } r -= I_RNN;
        if (r < I_OUT) { const int kb = r / 32, nb = r % 32; transpose_item8(F.in[23], 1024, kb * 64, nb * 32, WSP(unsigned char, WS_WOUT), 1024, nb * 32, scr, F.lane); continue; } r -= I_OUT;
        if (r < I_GLU) { const int kb = r / 64, nb = r % 64; transpose_item8(F.in[22], 2048, kb * 64, nb * 32, WSP(unsigned char, WS_WGLU), 512, pair_row(nb * 32), scr, F.lane); continue; } r -= I_GLU;
        { const int mat = r >> 3, kb = (r >> 2) & 1, nb = r & 3, hd = mat & 7, gx = mat >> 3;
          transpose_item(F.in[gx ? 10 : 8] + (size_t)hd * 128 * 128, 128, kb * 64, nb * 32, WSP(bf16, WS_WG), 128, hd * 256 + gx * 128 + nb * 32, scr, F.lane); }
    }
}
__device__ __forceinline__ void p1_hbf(Frame& F) {
    const int gw = F.vcu * 8 + F.wave, NGW = F.G * 8; const float* mod = WSP(float, WS_MOD); bf16* hbf = WSP(bf16, WS_HBF);
    for (int tb = 4 * gw; tb < T; tb += 4 * NGW) {
        const int b = tb >> 12; f32x4 xv[4][4], shv[4], scv[4];
#pragma unroll
        for (int r = 0; r < 4; ++r) { const f32x4* xr = (const f32x4*)(F.in[0] + (size_t)(tb + r) * 1024) + F.lane;
#pragma unroll
            for (int j = 0; j < 4; ++j) xv[r][j] = xr[64 * j]; }
#pragma unroll
        for (int j = 0; j < 4; ++j) { shv[j] = *((const f32x4*)(mod + b * 6144) + F.lane + 64 * j); scv[j] = *((const f32x4*)(mod + b * 6144 + 1024) + F.lane + 64 * j) + 1.0f; }
#pragma unroll
        for (int r = 0; r < 4; ++r) { unsigned* o = (unsigned*)((unsigned char*)hbf + (size_t)(tb + r) * 1024) + F.lane;
#pragma unroll
            for (int j = 0; j < 4; ++j) { const f32x4 v = xv[r][j] * scv[j] + shv[j]; o[64 * j] = pk4_fp8(v[0], v[1], v[2], v[3]); } } }
}
__device__ __forceinline__ void p1_moe_weights(Frame& F) {
    constexpr int TP = 132;
    LAS float* tile = (LAS float*)F.lds;
    constexpr int TILES_GU = 8 * 16, TILES_D = 8 * 8, TILES_E = TILES_GU + TILES_D;
    const int lr = F.tid >> 5, lc4 = (F.tid & 31) * 4, tn = F.tid >> 2, kc = F.tid & 3;
    f32x4 pre[8];
    int ti = F.vcu;
#define P1_SRC(idx, src, N_, dstp, drow0_, k0_) do { const int e_ = (idx) / TILES_E, r_ = (idx) % TILES_E; \
        if (r_ < TILES_GU) { const int kb_ = r_ >> 4, nb_ = r_ & 15; N_ = 2048; src = F.in[28] + (size_t)e_ * 1024 * 2048 + (size_t)(kb_ * 128) * 2048 + nb_ * 128; dstp = WSP(unsigned char, WS_WGU) + (size_t)e_ * 2048 * 1024; drow0_ = pair_row(nb_ * 128); k0_ = kb_ * 128; } \
        else { const int q_ = r_ - TILES_GU, kb_ = q_ >> 3, nb_ = q_ & 7; N_ = 1024; src = F.in[30] + (size_t)e_ * 1024 * 1024 + (size_t)(kb_ * 128) * 1024 + nb_ * 128; dstp = WSP(unsigned char, WS_WD) + (size_t)e_ * 1024 * 1024; drow0_ = nb_ * 128; k0_ = kb_ * 128; } } while (0)
    if (ti < NE * TILES_E) { const float* src; unsigned char* dstp; int N_, d0, k0; P1_SRC(ti, src, N_, dstp, d0, k0);
#pragma unroll
        for (int i = 0; i < 8; ++i) pre[i] = *(const f32x4*)(src + (size_t)(lr + 16 * i) * N_ + lc4); }
    for (; ti < NE * TILES_E; ti += F.G) {
#pragma unroll
        for (int i = 0; i < 8; ++i) *(LAS f32x4*)(tile + (lr + 16 * i) * TP + lc4) = pre[i];
        __syncthreads();
        const int tnx = (ti + F.G < NE * TILES_E) ? ti + F.G : ti;
        { const float* src; unsigned char* dstp; int N_, d0, k0; P1_SRC(tnx, src, N_, dstp, d0, k0);
#pragma unroll
            for (int i = 0; i < 8; ++i) pre[i] = *(const f32x4*)(src + (size_t)(lr + 16 * i) * N_ + lc4); }
        { const float* src; unsigned char* dstp; int N_, d0, k0; P1_SRC(ti, src, N_, dstp, d0, k0); (void)src; (void)N_;
          const LAS float* cp = tile + (32 * kc) * TP + tn; u32x4 o0, o1; float cv[32];
#pragma unroll
          for (int i = 0; i < 32; ++i) cv[i] = cp[i * TP];
          asm volatile("s_waitcnt lgkmcnt(0)" ::: "memory");
#pragma unroll
          for (int i = 0; i < 32; ++i) cv[i] *= 32.f;
          o0.x = pk4_fp8(cv[0], cv[1], cv[2], cv[3]); o0.y = pk4_fp8(cv[4], cv[5], cv[6], cv[7]); o0.z = pk4_fp8(cv[8], cv[9], cv[10], cv[11]); o0.w = pk4_fp8(cv[12], cv[13], cv[14], cv[15]);
          o1.x = pk4_fp8(cv[16], cv[17], cv[18], cv[19]); o1.y = pk4_fp8(cv[20], cv[21], cv[22], cv[23]); o1.z = pk4_fp8(cv[24], cv[25], cv[26], cv[27]); o1.w = pk4_fp8(cv[28], cv[29], cv[30], cv[31]);
          unsigned char* op = dstp + (size_t)(d0 + tn) * 1024 + k0 + 32 * kc; *(u32x4*)op = o0; *(u32x4*)(op + 16) = o1; }
        __syncthreads();
    }
#undef P1_SRC
}
constexpr int XR_LD = 136, XR_TILE = 128 * XR_LD;
__device__ __forceinline__ void rg_issue(const bf16* xrnn, const bf16* gy, int item, int tid, u32x2 (&xraw)[4][4], u32x2 (&graw)[4], bool pass1) {
    const int hd = item & 7, c = (item >> 3) & 31, b = item >> 8, r0 = tid >> 4, ch = hd * 128 + (tid & 15) * 8;
#pragma unroll
    for (int q = 0; q < 4; ++q) { const int r = r0 + 32 * q;
#pragma unroll
        for (int k = 0; k < 4; ++k) { const int tp = c * RGL + r - 3 + k, tpc = tp < 0 ? 0 : tp; xraw[q][k] = *(const u32x2*)((const unsigned char*)xrnn + (size_t)(b * SEQ + tpc) * 1024 + ch); }
        if (pass1) graw[q] = *(const u32x2*)((const unsigned char*)gy + (size_t)(b * SEQ + c * RGL + r) * 1024 + ch); }
}
__device__ __forceinline__ void rg_convwrite(const LAS float* cwl, int item, int tid, const u32x2 (&xraw)[4][4], const u32x2 (&graw)[4], LAS bf16* xr, LAS bf16* gyt, bool pass1) {
    const int c = (item >> 3) & 31, r0 = tid >> 4, c8 = (tid & 15) * 8;
    const f32x4 b0 = *(const LAS f32x4*)(cwl + 4 * 128 + c8), b1 = *(const LAS f32x4*)(cwl + 4 * 128 + c8 + 4);
    f32x4 w0[4], w1[4];
#pragma unroll
    for (int k = 0; k < 4; ++k) { w0[k] = *(const LAS f32x4*)(cwl + k * 128 + c8); w1[k] = *(const LAS f32x4*)(cwl + k * 128 + c8 + 4); }
#pragma unroll
    for (int q = 0; q < 4; ++q) { const int r = r0 + 32 * q; f32x4 a0 = b0, a1 = b1;
#pragma unroll
        for (int k = 0; k < 4; ++k) { const int tp = c * RGL + r - 3 + k; f32x4 x0, x1; unpack8_fp8(xraw[q][k], x0, x1); if (tp < 0) { x0 = (f32x4){0.f, 0.f, 0.f, 0.f}; x1 = x0; } a0 += w0[k] * x0; a1 += w1[k] * x1; }
        *(LAS u32x4*)(xr + r * XR_LD + c8) = pack8(a0, a1);
        if (pass1) { f32x4 ga_, gb_; unpack8_fp8(graw[q], ga_, gb_); *(LAS u32x4*)(gyt + r * XR_LD + c8) = pack8(ga_, gb_); } }
}
template <int PASS>
__device__ __forceinline__ void rglru_phase(Frame& F) {
    const int NIT = NB * RGC * 8;
    const bool skew = (PASS == 0) && (F.G == 256);
    const int nmine = skew ? (F.vcu < 128 ? 7 : 9) : (NIT - F.vcu + F.G - 1) / F.G;
#define RG_ITEM(k) ((skew && (k) >= 7) ? (1792 + (F.vcu - 128) + 128 * ((k) - 7)) : (F.vcu + (k) * F.G))
    if (nmine <= 0) return;
    int it = RG_ITEM(0);
    LAS bf16* xr = (LAS bf16*)F.lds; LAS bf16* gyt0 = xr + XR_TILE;
    const bf16* xrnn = WSP(bf16, WS_XRNN); const bf16* gy = WSP(bf16, WS_GY); bf16* ha = WSP(bf16, WS_HA); const float* cw = F.in[6]; const float* cb = F.in[7];
    const int tid = F.tid, w = F.wave, q = F.lane >> 4, col = F.lane & 15, chl = 16 * w + col;
    u32x2 xraw[4][4], graw[4];
    LAS float* cwl = (LAS float*)(gyt0 + 2 * XR_TILE);
    for (int i = tid; i < 5 * 128; i += 512) { const int k = i >> 7, chh = (it & 7) * 128 + (i & 127); cwl[i] = (k < 4) ? cw[k * 1024 + chh] : cb[chh]; }
    rg_issue(xrnn, gy, it, tid, xraw, graw, PASS);
    __syncthreads();
    rg_convwrite(cwl, it, tid, xraw, graw, xr, gyt0, PASS);
    bf16x8 Bf[2][4]; float ba, bx, sp;
    { const int hd0 = it & 7, ch0 = hd0 * 128 + chl; const bf16* wg = WSP(bf16, WS_WG) + (size_t)hd0 * 256 * 128;
#pragma unroll
      for (int gt = 0; gt < 2; ++gt)
#pragma unroll
          for (int kk = 0; kk < 4; ++kk) Bf[gt][kk] = *(const bf16x8*)(wg + (size_t)(gt * 128 + chl) * 128 + kk * 32 + q * 8);
      ba = F.in[9][ch0]; bx = F.in[11][ch0]; const float lam = F.in[12][ch0]; sp = (lam > 15.f) ? __expf(-lam) : log1pf(__expf(-lam)); }
#pragma unroll
    for (int gt = 0; gt < 2; ++gt)
#pragma unroll
        for (int kk = 0; kk < 4; ++kk) asm volatile("" :: "v"(Bf[gt][kk]));
    asm volatile("" :: "v"(ba), "v"(bx), "v"(sp));
    __syncthreads();
    for (int i = 0; i < nmine; ++i) {
        const bool has_next = (i + 1) < nmine; const int nit = has_next ? RG_ITEM(i + 1) : it;
        const int hd = it & 7, c = (it >> 3) & 31, b = it >> 8, t0 = b * SEQ + c * RGL, ch = hd * 128 + chl;
        LAS bf16* gyt = gyt0 + (i & 1) * XR_TILE; LAS bf16* gytn = gyt0 + ((i & 1) ^ 1) * XR_TILE;
        float carryH = 0.f, carryP = 1.f;
        if (PASS) carryH = WSP(float, WS_HIN)[(size_t)(b * RGC + c) * 1024 + ch];
        __builtin_amdgcn_sched_barrier(0);
        rg_issue(xrnn, gy, nit, tid, xraw, graw, PASS);
        __builtin_amdgcn_sched_barrier(0);
        f32x4 acc[8][2];
#pragma unroll
        for (int m = 0; m < 8; ++m) { acc[m][0] = (f32x4){0.f, 0.f, 0.f, 0.f}; acc[m][1] = (f32x4){0.f, 0.f, 0.f, 0.f}; }
#pragma unroll
        for (int kk = 0; kk < 4; ++kk)
#pragma unroll
            for (int m = 0; m < 8; ++m) { const bf16x8 Af = *(const LAS bf16x8*)(xr + (16 * m + col) * XR_LD + kk * 32 + q * 8);
                acc[m][0] = __builtin_amdgcn_mfma_f32_16x16x32_bf16(Af, Bf[0][kk], acc[m][0], 0, 0, 0);
                acc[m][1] = __builtin_amdgcn_mfma_f32_16x16x32_bf16(Af, Bf[1][kk], acc[m][1], 0, 0, 0); }
#pragma unroll
        for (int m = 0; m < 8; ++m) {
            float a[4], uu[4];
#pragma unroll
            for (int j = 0; j < 4; ++j) { const int tl = 16 * m + 4 * q + j;
                const float r = fast_sigmoid(acc[m][0][j] + ba), ii = fast_sigmoid(acc[m][1][j] + bx);
                const float la = -11.541560327f * r * sp; a[j] = __builtin_amdgcn_exp2f(la); const float mult = __builtin_amdgcn_sqrtf(fmaxf(1.0f - a[j] * a[j], 0.f));
                uu[j] = mult * ii * bf1(xr[tl * XR_LD + chl]); }
            float sP = a[0], sH = uu[0];
#pragma unroll
            for (int j = 1; j < 4; ++j) { sH = a[j] * sH + uu[j]; sP *= a[j]; }
            float iP = sP, iH = sH;
            { const float pP = __shfl_up(iP, 16), pH = __shfl_up(iH, 16); if (q >= 1) { iH = iP * pH + iH; iP = iP * pP; } }
            { const float pP = __shfl_up(iP, 32), pH = __shfl_up(iH, 32); if (q >= 2) { iH = iP * pH + iH; iP = iP * pP; } }
            float eP = __shfl_up(iP, 16), eH = __shfl_up(iH, 16); if (q == 0) { eP = 1.f; eH = 0.f; }
            const float tP = __shfl(iP, col + 48), tH = __shfl(iH, col + 48);
            if (PASS) { float h = eP * carryH + eH;
#pragma unroll
                for (int j = 0; j < 4; ++j) { const int tl = 16 * m + 4 * q + j; h = a[j] * h + uu[j]; LAS bf16* gp = gyt + tl * XR_LD + chl; *gp = (bf16)f2bf(h * bf1(*gp)); } }
            carryH = tP * carryH + tH; carryP *= tP;
        }
        if (!PASS && q == 0) { f32x2* ag = WSP(f32x2, WS_RGAGG); ag[(size_t)(b * RGC + c) * 1024 + ch] = (f32x2){carryP, carryH}; }
        __syncthreads();
        if (PASS) { const int r0 = tid >> 4, c8 = (tid & 15) * 8;
#pragma unroll
            for (int qq = 0; qq < 4; ++qq) { const int r = r0 + 32 * qq; f32x4 h0, h1; unpack8(*(const LAS u32x4*)(gyt + r * XR_LD + c8), h0, h1); u32x2 w8; w8.x = pk4_fp8(h0[0], h0[1], h0[2], h0[3]); w8.y = pk4_fp8(h1[0], h1[1], h1[2], h1[3]);
                *(u32x2*)((unsigned char*)ha + (size_t)(t0 + r) * 1024 + hd * 128 + c8) = w8; } }
#pragma unroll
        for (int qq = 0; qq < 4; ++qq) {
#pragma unroll
            for (int k = 0; k < 4; ++k) asm volatile("" : "+v"(xraw[qq][k]));
            if (PASS) asm volatile("" : "+v"(graw[qq])); }
        if (has_next) rg_convwrite(cwl, nit, tid, xraw, graw, xr, gytn, PASS);
        __syncthreads();
        it = nit;
    }
#undef RG_ITEM
}
__device__ __forceinline__ void p4_carries(Frame& F) {
    LAS f32x2* seg = (LAS f32x2*)F.lds;
    for (int job = F.vcu; job < NB * S5G; job += F.G) {
        const int b = job >> 5, g = job & 31, p = F.lane, w = F.wave;
        const f32x2 al = WSP(f32x2, WS_AL)[g * 64 + p];
        const f32x2* Sb = WSP(f32x2, WS_S) + ((size_t)(g * S5M + b * S5CPB + 16 * w)) * 64 + p; unsigned* ac = (unsigned*)(WSP(bf16, WS_ACAT) + ((size_t)(g * S5M + b * S5CPB + 16 * w)) * S5ROW) + p;
        f32x2 sv[16];
#pragma unroll
        for (int i = 0; i < 16; ++i) sv[i] = Sb[(size_t)i * 64];
        float xr_ = 0.f, xi = 0.f;
#pragma unroll
        for (int i = 0; i < 16; ++i) { const float nr = al.x * xr_ - al.y * xi + sv[i].x, ni = al.x * xi + al.y * xr_ + sv[i].y; xr_ = nr; xi = ni; }
        seg[w * 64 + p] = (f32x2){xr_, xi};
        float ar = al.x, ai = al.y;
#pragma unroll
        for (int q = 0; q < 4; ++q) { const float nr = ar * ar - ai * ai, ni = 2.f * ar * ai; ar = nr; ai = ni; }
        __syncthreads();
        xr_ = 0.f; xi = 0.f;
        for (int ww = 0; ww < w; ++ww) { const f32x2 sg = seg[ww * 64 + p]; const float nr = ar * xr_ - ai * xi + sg.x, ni = ar * xi + ai * xr_ + sg.y; xr_ = nr; xi = ni; }
#pragma unroll
        for (int i = 0; i < 16; ++i) { ac[(size_t)i * (S5ROW / 2)] = pk2(xr_, xi); const float nr = al.x * xr_ - al.y * xi + sv[i].x, ni = al.x * xi + al.y * xr_ + sv[i].y; xr_ = nr; xi = ni; }
        __syncthreads();
    }
    if (F.vcu < 16) {
        const int id = F.vcu * 512 + F.tid, ch = id & 1023, b = id >> 10; const f32x2* ag = WSP(f32x2, WS_RGAGG) + (size_t)b * RGC * 1024 + ch; float* hin = WSP(float, WS_HIN) + (size_t)b * RGC * 1024 + ch;
        f32x2 a[RGC];
#pragma unroll
        for (int c = 0; c < RGC; ++c) a[c] = ag[(size_t)c * 1024];
        float h = 0.f;
#pragma unroll
        for (int c = 0; c < RGC; ++c) { hin[(size_t)c * 1024] = h; h = a[c].x * h + a[c].y; }
    }
}
constexpr int WR_LD = 1032;
__device__ __forceinline__ void p9_router(Frame& F) {
    LAS bf16* wH = (LAS bf16*)F.lds; LAS bf16* wL = wH + 32 * WR_LD;
    LAS f32x2* sel = (LAS f32x2*)(wL + 32 * WR_LD);
    LAS unsigned* rec = (LAS unsigned*)(sel + 512);
    LAS float* recp = (LAS float*)(rec + 512);
    LAS int* lcnt = (LAS int*)(recp + 512);
    LAS int* gbase = lcnt + 32;
    { const u32x4* img = WSP(u32x4, WS_WRIMG); LAS u32x4* dst = (LAS u32x4*)wH;
      for (int i = F.tid; i < 2 * 32 * WR_LD * 2 / 16; i += 512) dst[i] = img[i]; }
    if (F.tid < 32) lcnt[F.tid] = 0;
    __syncthreads();
    const float* mod = WSP(float, WS_MOD); const bf16* v1 = WSP(bf16, WS_V1); bf16* x1 = WSP(bf16, WS_X1); unsigned char* h2 = WSP(unsigned char, WS_H2);
    const int lane = F.lane, m = lane & 15, kq = lane >> 4, w = F.wave;
    for (int blk = F.vcu; blk < T / 128; blk += F.G) {
        const int t = blk * 128 + w * 16 + m, b = (blk * 128) >> 12;
        const bf16* vrow = v1 + (size_t)t * 1024 + 8 * kq;
        float sum = 0.f, sq = 0.f;
#pragma unroll 32
        for (int s_ = 0; s_ < 32; ++s_) { f32x4 a, c; unpack8(*(const u32x4*)(vrow + 32 * s_), a, c); sum += ((a[0] + a[1]) + (a[2] + a[3])) + ((c[0] + c[1]) + (c[2] + c[3]));
            sq += ((a[0] * a[0] + a[1] * a[1]) + (a[2] * a[2] + a[3] * a[3])) + ((c[0] * c[0] + c[1] * c[1]) + (c[2] * c[2] + c[3] * c[3])); }
        sum += __shfl_xor(sum, 16); sum += __shfl_xor(sum, 32); sq += __shfl_xor(sq, 16); sq += __shfl_xor(sq, 32);
        const float mean = sum * (1.f / 1024.f); const float rstd = 1.f / sqrtf(fmaxf(sq * (1.f / 1024.f) - mean * mean, 0.f) + LN_EPS);
        f32x4 acc[2] = {(f32x4){0.f, 0.f, 0.f, 0.f}, (f32x4){0.f, 0.f, 0.f, 0.f}};
        const float* lng = F.in[24] + 8 * kq; const float* lnb = F.in[25] + 8 * kq; const float* shp = mod + b * 6144 + 3072 + 8 * kq; const float* scp = mod + b * 6144 + 4096 + 8 * kq;
        bf16* x1row = x1 + (size_t)t * 1024 + 8 * kq; unsigned char* h2row = h2 + (size_t)t * 1024 + 8 * kq;
        const LAS bf16* wHr = wH + m * WR_LD + 8 * kq; const LAS bf16* wLr = wL + m * WR_LD + 8 * kq;
#pragma unroll 2
        for (int s2 = 0; s2 < 32; s2 += 2) {
            u32x4 rw[2]; f32x4 pg[2][2], pb[2][2], psh[2][2], psc[2][2];
#pragma unroll
            for (int h = 0; h < 2; ++h) { const int ko = 32 * (s2 + h); rw[h] = *(const u32x4*)(vrow + ko);
                pg[h][0] = *(const f32x4*)(lng + ko); pg[h][1] = *(const f32x4*)(lng + ko + 4); pb[h][0] = *(const f32x4*)(lnb + ko); pb[h][1] = *(const f32x4*)(lnb + ko + 4);
                psh[h][0] = *(const f32x4*)(shp + ko); psh[h][1] = *(const f32x4*)(shp + ko + 4); psc[h][0] = *(const f32x4*)(scp + ko); psc[h][1] = *(const f32x4*)(scp + ko + 4); }
#pragma unroll
            for (int h = 0; h < 2; ++h) { const int ko = 32 * (s2 + h);
                f32x4 a, c; unpack8(rw[h], a, c);
                const f32x4 x0 = (a - mean) * rstd * pg[h][0] + pb[h][0], x1v = (c - mean) * rstd * pg[h][1] + pb[h][1];
                *(u32x4*)(x1row + ko) = pack8(x0, x1v);
                const f32x4 h0 = x0 * (psc[h][0] + 1.0f) + psh[h][0], h1 = x1v * (psc[h][1] + 1.0f) + psh[h][1];
                u32x2 w8; w8.x = pk4_fp8(h0[0], h0[1], h0[2], h0[3]); w8.y = pk4_fp8(h1[0], h1[1], h1[2], h1[3]); *(u32x2*)(h2row + ko) = w8;
                const u32x4 hi = pack8(h0, h1); f32x4 r0, r1; unpack8(hi, r0, r1); const u32x4 lo = pack8(h0 - r0, h1 - r1);
                const bf16x8 ah = __builtin_bit_cast(bf16x8, hi), al = __builtin_bit_cast(bf16x8, lo);
#pragma unroll
                for (int nf = 0; nf < 2; ++nf) { const bf16x8 bh = *(const LAS bf16x8*)(wHr + nf * 16 * WR_LD + ko), bl = *(const LAS bf16x8*)(wLr + nf * 16 * WR_LD + ko);
                    acc[nf] = __builtin_amdgcn_mfma_f32_16x16x32_bf16(bh, ah, acc[nf], 0, 0, 0);
                    acc[nf] = __builtin_amdgcn_mfma_f32_16x16x32_bf16(bl, ah, acc[nf], 0, 0, 0);
                    acc[nf] = __builtin_amdgcn_mfma_f32_16x16x32_bf16(bh, al, acc[nf], 0, 0, 0); } } }
        float lv[8];
#pragma unroll
        for (int nf = 0; nf < 2; ++nf)
#pragma unroll
            for (int j = 0; j < 4; ++j) lv[nf * 4 + j] = acc[nf][j] + F.in[27][nf * 16 + 4 * kq + j];
        int rank[8];
#pragma unroll
        for (int i = 0; i < 8; ++i) { rank[i] = 0;
#pragma unroll
            for (int i2 = 0; i2 < 8; ++i2) if (i2 != i) { const int e1 = (i >> 2) * 16 + 4 * kq + (i & 3), e2 = (i2 >> 2) * 16 + 4 * kq + (i2 & 3); rank[i] += (lv[i2] > lv[i] || (lv[i2] == lv[i] && e2 < e1)) ? 1 : 0; } }
#pragma unroll
        for (int dq = 1; dq < 4; ++dq) { const int q2 = kq ^ dq;
#pragma unroll
            for (int i2 = 0; i2 < 8; ++i2) { const float o = __shfl_xor(lv[i2], 16 * dq); const int e2 = (i2 >> 2) * 16 + 4 * q2 + (i2 & 3);
#pragma unroll
                for (int i = 0; i < 8; ++i) { const int e1 = (i >> 2) * 16 + 4 * kq + (i & 3); rank[i] += (o > lv[i] || (o == lv[i] && e2 < e1)) ? 1 : 0; } } }
#pragma unroll
        for (int i = 0; i < 8; ++i) if (rank[i] < 4) { const int e1 = (i >> 2) * 16 + 4 * kq + (i & 3); sel[(w * 16 + m) * 4 + rank[i]] = (f32x2){__builtin_bit_cast(float, e1), lv[i]}; }
        asm volatile("s_waitcnt lgkmcnt(0)" ::: "memory");
        { const int tm = lane >> 2, k = lane & 3; const f32x2 s0 = sel[(w * 16 + tm) * 4 + 0], s1 = sel[(w * 16 + tm) * 4 + 1], s2 = sel[(w * 16 + tm) * 4 + 2], s3 = sel[(w * 16 + tm) * 4 + 3];
          const float p0 = 1.f, p1 = __expf(s1.y - s0.y), p2 = __expf(s2.y - s0.y), p3 = __expf(s3.y - s0.y), ps = (p0 + p1) + (p2 + p3);
          const f32x2 mine = k == 0 ? s0 : (k == 1 ? s1 : (k == 2 ? s2 : s3)); const float pm = (k == 0 ? p0 : (k == 1 ? p1 : (k == 2 ? p2 : p3))) / ps;
          const int e = __builtin_bit_cast(int, mine.x);
          const int lr = __hip_atomic_fetch_add(lcnt + e, 1, __ATOMIC_RELAXED, __HIP_MEMORY_SCOPE_WORKGROUP);
          rec[(w * 16 + tm) * 4 + k] = ((unsigned)e << 16) | (unsigned)lr; recp[(w * 16 + tm) * 4 + k] = pm; }
        __syncthreads();
        if (F.tid < 32) { const int n = lcnt[F.tid]; gbase[F.tid] = n ? (int)atomicAdd(F.ctl + CW_CNT + 64 * F.tid, (unsigned)n) : 0; lcnt[F.tid] = 0; }
        __syncthreads();
        { const unsigned r = rec[F.tid]; const int e = r >> 16, rk = gbase[e] + (int)(r & 0xffffu), tt = blk * 128 + (F.tid >> 2);
          WSP(int, WS_TOK)[(size_t)e * T + rk] = tt; WSP(unsigned, WS_POS)[(size_t)tt * 4 + (F.tid & 3)] = ((unsigned)e << 20) | (unsigned)rk; WSP(float, WS_PROB)[(size_t)tt * 4 + (F.tid & 3)] = recp[F.tid]; }
        __syncthreads();
    }
}
__device__ __forceinline__ void p12_final(Frame& F) {
    moe_tables(F);
    const LAS int* tstart = (const LAS int*)(F.lds + TAB_OFF);
    const float* mod = WSP(float, WS_MOD); const bf16* x1 = WSP(bf16, WS_X1); const bf16* yb = WSP(bf16, WS_YB); const unsigned* pos = WSP(unsigned, WS_POS); const float* prob = WSP(float, WS_PROB);
    const int lane = F.lane, gw = F.vcu * 8 + F.wave, NGW = F.G * 8;
    f32x4 lg[4], lb[4];
#pragma unroll
    for (int j = 0; j < 4; ++j) { lg[j] = *(const f32x4*)(F.in[32] + 512 * (j >> 1) + 8 * lane + 4 * (j & 1)); lb[j] = *(const f32x4*)(F.in[33] + 512 * (j >> 1) + 8 * lane + 4 * (j & 1)); }
#define P12_ROUTE(PP, PW, tt) do { const u32x4 p4_ = *(const u32x4*)(pos + (size_t)(tt) * 4); const f32x4 w4_ = *(const f32x4*)(prob + (size_t)(tt) * 4); \
        PP[0] = p4_.x; PP[1] = p4_.y; PP[2] = p4_.z; PP[3] = p4_.w; PW[0] = w4_[0]; PW[1] = w4_[1]; PW[2] = w4_[2]; PW[3] = w4_[3]; } while (0)
#define P12_ROWS(YW, XW, PP, tt) do { _Pragma("unroll") for (int k = 0; k < 4; ++k) { const int e_ = PP[k] >> 20, rk_ = PP[k] & 0xfffffu; const size_t slot_ = (size_t)tstart[e_] * 256 + rk_; \
            _Pragma("unroll") for (int j = 0; j < 2; ++j) YW[k][j] = *((const u32x2*)((const unsigned char*)yb + slot_ * 1024) + 64 * j + lane); } \
        _Pragma("unroll") for (int j = 0; j < 2; ++j) XW[j] = *((const u32x4*)(x1 + (size_t)(tt) * 1024) + 64 * j + lane); } while (0)
#define P12_COMPUTE(YW, XW, PW, tt) do { const int b_ = (tt) >> 12; f32x4 v[4]; float s_ = 0.f; \
        _Pragma("unroll") for (int j = 0; j < 2; ++j) { f32x4 f0 = (f32x4){0.f, 0.f, 0.f, 0.f}, f1 = f0; \
            _Pragma("unroll") for (int k = 0; k < 4; ++k) { const u32x2 yv_ = YW[k][j]; const f32x2 q0_ = __builtin_amdgcn_cvt_pk_f32_fp8((int)yv_.x, false), q1_ = __builtin_amdgcn_cvt_pk_f32_fp8((int)yv_.x, true), q2_ = __builtin_amdgcn_cvt_pk_f32_fp8((int)yv_.y, false), q3_ = __builtin_amdgcn_cvt_pk_f32_fp8((int)yv_.y, true); \
                f0 += (f32x4){q0_.x, q0_.y, q1_.x, q1_.y} * PW[k]; f1 += (f32x4){q2_.x, q2_.y, q3_.x, q3_.y} * PW[k]; } \
            f32x4 xa_, xc_; unpack8(XW[j], xa_, xc_); const float* gp_ = mod + b_ * 6144 + 5120 + 512 * j + 8 * lane; \
            v[2 * j] = xa_ * DN_ALPHA + (*(const f32x4*)gp_ + 1.0f) * f0; v[2 * j + 1] = xc_ * DN_ALPHA + (*(const f32x4*)(gp_ + 4) + 1.0f) * f1; \
            s_ += ((v[2 * j][0] + v[2 * j][1]) + (v[2 * j][2] + v[2 * j][3])) + ((v[2 * j + 1][0] + v[2 * j + 1][1]) + (v[2 * j + 1][2] + v[2 * j + 1][3])); } \
        const float mean_ = wave_sum(s_) * (1.f / 1024.f); float s2_ = 0.f; \
        _Pragma("unroll") for (int j = 0; j < 4; ++j) { v[j] = v[j] - mean_; s2_ += (v[j][0] * v[j][0] + v[j][1] * v[j][1]) + (v[j][2] * v[j][2] + v[j][3] * v[j][3]); } \
        const float rstd_ = 1.f / sqrtf(wave_sum(s2_) * (1.f / 1024.f) + LN_EPS); \
        _Pragma("unroll") for (int j = 0; j < 4; ++j) *(f32x4*)(F.out + (size_t)(tt) * 1024 + 512 * (j >> 1) + 8 * lane + 4 * (j & 1)) = v[j] * rstd_ * lg[j] + lb[j]; } while (0)
    const int nmine = (T - gw + NGW - 1) / NGW;
    unsigned ppA[4], ppB[4]; float pwA[4], pwB[4], pwN[4]; u32x2 ywA[4][2], ywB[4][2]; u32x4 xwA[2], xwB[2];
    if (nmine > 0) { P12_ROUTE(ppA, pwA, gw); P12_ROWS(ywA, xwA, ppA, gw); }
    if (nmine > 1) { P12_ROUTE(ppB, pwB, gw + NGW); }
    for (int i = 0; i < nmine; i += 2) {
        const int t0 = gw + i * NGW, t1 = t0 + NGW, t2 = t1 + NGW, t3 = t2 + NGW;
        if (i + 1 < nmine) { P12_ROWS(ywB, xwB, ppB, t1); }
        if (i + 2 < nmine) { P12_ROUTE(ppA, pwN, t2); }
        __builtin_amdgcn_sched_barrier(0);
        P12_COMPUTE(ywA, xwA, pwA, t0);
        if (i + 1 < nmine) {
#pragma unroll
            for (int k = 0; k < 4; ++k) pwA[k] = pwN[k];
            if (i + 2 < nmine) { P12_ROWS(ywA, xwA, ppA, t2); }
            if (i + 3 < nmine) { P12_ROUTE(ppB, pwN, t3); }
            __builtin_amdgcn_sched_barrier(0);
            P12_COMPUTE(ywB, xwB, pwB, t1);
#pragma unroll
            for (int k = 0; k < 4; ++k) pwB[k] = pwN[k];
        }
    }
#undef P12_ROUTE
#undef P12_ROWS
#undef P12_COMPUTE
}

__device__ __forceinline__ void wg_publish(Frame& F, int word) {
    asm volatile("s_waitcnt vmcnt(0)" ::: "memory"); __syncthreads();
    if (F.tid == 0) { __builtin_amdgcn_fence(__ATOMIC_RELEASE, "agent"); asm volatile("s_waitcnt vmcnt(0)" ::: "memory"); __hip_atomic_fetch_add(F.ctl + word, 1u, __ATOMIC_RELAXED, __HIP_MEMORY_SCOPE_AGENT); }
}
__device__ __forceinline__ void wg_wait(Frame& F, int word, unsigned need) {
    if (F.tid < 64) { unsigned sp_ = 0;
        while ((unsigned)__builtin_amdgcn_readfirstlane(__hip_atomic_load(F.ctl + word, __ATOMIC_RELAXED, __HIP_MEMORY_SCOPE_AGENT)) < need) { __builtin_amdgcn_s_sleep(2);
            if (++sp_ > (1u << 20)) { if (F.tid == 0) atomicAdd(F.ctl + CW_BAR + XB_TMO, 1u); break; } }
        __builtin_amdgcn_fence(__ATOMIC_ACQUIRE, "agent"); asm volatile("s_waitcnt vmcnt(0)" ::: "memory"); }
    __syncthreads();
}
struct Args { const float* in[34]; float* out; unsigned char* ws; int ph_lo, ph_hi; };
__global__ void __launch_bounds__(512, 2) fwd_kernel(Args args) {
    extern __shared__ __attribute__((aligned(16))) unsigned char lds_raw[];
    Frame F;
    F.lds = (LAS unsigned char*)lds_raw; F.MISC = (volatile LAS unsigned*)(F.lds + MISC_OFF);
    F.tid = threadIdx.x; F.lane = F.tid & 63; F.wave = __builtin_amdgcn_readfirstlane(F.tid >> 6);
    F.G = gridDim.x; { const int bx = blockIdx.x; F.vcu = (F.G % 8 == 0) ? (bx % 8) * (F.G / 8) + bx / 8 : bx; }
#pragma unroll
    for (int i = 0; i < 34; ++i) F.in[i] = args.in[i];
    F.out = args.out; F.ws = args.ws; F.ctl = (unsigned*)(args.ws + WS_CTL);
    if (F.tid < 64) F.MISC[F.tid] = 0u;
    __syncthreads();
    XcdBarrier bar; bar.bar = F.ctl + CW_BAR; bar.x = 0; bar.st = nullptr;
    if (MK_N_LAUNCHES == 1) bar = xcd_barrier_post(F.ctl + CW_BAR, F.MISC + 8);
    const int lo = args.ph_lo, hi = args.ph_hi;
#define IN(k) (lo <= (k) && (k) < hi)
#define SEAM(k) do { if (IN(k) && IN((k) + 1)) xcd_barrier(bar); } while (0)

    if (IN(0)) REPS(0) { if (rep_) xcd_barrier(bar);
        for (int j = F.vcu; j < 192; j += F.G) p0_mod_job(F, j);
        for (int j = F.vcu; j < S5G * 8; j += F.G) p0_s5k_job(F, j);
        { bf16* img = WSP(bf16, WS_WRIMG); const float* wr = F.in[26];
          for (int i = F.vcu * 512 + F.tid; i < 1024 * 32; i += F.G * 512) { const float w = wr[i]; const unsigned hb = f2bf(w); const float hf = __builtin_bit_cast(float, hb << 16);
              img[(i & 31) * 1032 + (i >> 5)] = (bf16)hb; img[32 * 1032 + (i & 31) * 1032 + (i >> 5)] = (bf16)f2bf(w - hf); } }
        p0_small_transposes(F);
    }
    const bool chain01 = IN(0) && IN(1);
    if (chain01) wg_publish(F, CW_P0DONE); else SEAM(0);
    if (IN(1)) REPS(1) { if (rep_) xcd_barrier(bar);
        p1_moe_weights(F);
        if (chain01) wg_wait(F, CW_P0DONE, (unsigned)F.G);
        for (int j = F.vcu; j < S5G * 8; j += F.G) p1_s5w_job(F, j);
        p1_hbf(F); }
    SEAM(1);
    if (IN(2)) REPS(2) { if (rep_) xcd_barrier(bar);
        g8::GridOrder S; S.init(T, INC, F.G, (int)blockIdx.x, WSP(bf16, WS_HBF), WSP(bf16, WS_WIN), 1024, 1024);
        EpiInProj E{F.in[5], WSP(bf16, WS_XRNN), WSP(bf16, WS_GY), WSP(bf16, WS_ACAT), WSP(bf16, WS_GATES)};
        g8::gemm_phase<EpiInProj, g8::GridOrder, false, true>(F.lds, 1024, 1024, 1024, S, E);
    }
    SEAM(2);
    if (IN(3)) REPS(3) { if (rep_) xcd_barrier(bar);
        { S5AOrder S{F.G, F.vcu, (const char*)WSP(bf16, WS_ACAT), (const char*)WSP(bf16, WS_WS)}; EpiS5A E{WSP(float, WS_S)};
          g8::gemm_phase<EpiS5A, S5AOrder, false>(F.lds, S5L * 32, S5ROW * 2, S5L * 32, S, E); }
        __syncthreads();
        rglru_phase<0>(F);
    }
    SEAM(3);
    if (IN(4)) REPS(4) { if (rep_) xcd_barrier(bar); p4_carries(F); }
    SEAM(4);
    if (IN(5)) REPS(5) { if (rep_) xcd_barrier(bar);
        { S5COrder S{F.G, F.vcu, (const char*)WSP(bf16, WS_ACAT), (const char*)WSP(bf16, WS_WY)}; EpiS5C E{WSP(bf16, WS_YS)};
          g8::gemm_phase<EpiS5C, S5COrder, false>(F.lds, S5ROW * 2, S5ROW * 2, S5ROW * 2, S, E); }
        if (IN(6)) wg_publish(F, CW_S5CDONE);
        __syncthreads();
        rglru_phase<1>(F);
    }
    if (IN(5) && IN(6)) wg_wait(F, CW_S5CDONE, (unsigned)F.G); else SEAM(5);
    if (IN(6)) REPS(6) { if (rep_) xcd_barrier(bar);
        g8::GridOrder S; S.init(T, 2048, F.G, (int)blockIdx.x, WSP(bf16, WS_YS), WSP(bf16, WS_WGLU), 512, 512);
        EpiGlu E{WSP(bf16, WS_GATES), WSP(bf16, WS_GB)};
        g8::gemm_phase<EpiGlu, g8::GridOrder, false, true>(F.lds, 512, 512, 512, S, E);
    }
    SEAM(6);
    if (IN(7)) REPS(7) { if (rep_) xcd_barrier(bar);
        g8::GridOrder S; S.init(T, 1024, F.G, (int)blockIdx.x, WSP(bf16, WS_HA), WSP(bf16, WS_WRNN), 1024, 1024);
        EpiRnn E{WSP(bf16, WS_GATES), WSP(bf16, WS_GB), WSP(bf16, WS_MERGED)};
        g8::gemm_phase<EpiRnn, g8::GridOrder, false, true>(F.lds, 1024, 1024, 1024, S, E);
    }
    SEAM(7);
    if (IN(8)) REPS(8) { if (rep_) xcd_barrier(bar);
        g8::GridOrder S; S.init(T, 1024, F.G, (int)blockIdx.x, WSP(bf16, WS_MERGED), WSP(bf16, WS_WOUT), 1024, 1024);
        EpiOut E{F.in[0], WSP(float, WS_MOD), WSP(bf16, WS_V1)};
        g8::gemm_phase<EpiOut, g8::GridOrder, false, true>(F.lds, 1024, 1024, 1024, S, E);
    }
    SEAM(8);
    if (IN(9)) REPS(9) { if (rep_) xcd_barrier(bar); p9_router(F); }
    SEAM(9);
    if (IN(10)) REPS(10) { if (rep_) xcd_barrier(bar);
        moe_tables(F);
        const LAS int* tstart = (const LAS int*)(F.lds + TAB_OFF);
        MoeOrder S{F.G, (int)blockIdx.x, 8, tstart[NE], tstart, tstart + 40, WSP(int, WS_TOK), (const char*)WSP(bf16, WS_H2), (const char*)WSP(bf16, WS_WGU), (size_t)2048 * 1024, 1024, true};
        EpiMoe1 E{F.in[29], WSP(bf16, WS_ACT)};
        g8::gemm_phase<EpiMoe1, MoeOrder, true, true>(F.lds, 1024, 1024, 1024, S, E);
    }
    SEAM(10);
    if (IN(11)) REPS(11) { if (rep_) xcd_barrier(bar);
        moe_tables(F);
        const LAS int* tstart = (const LAS int*)(F.lds + TAB_OFF);
        MoeOrder S{F.G, (int)blockIdx.x, 4, tstart[NE], tstart, tstart + 40, WSP(int, WS_TOK), (const char*)WSP(bf16, WS_ACT), (const char*)WSP(bf16, WS_WD), (size_t)1024 * 1024, 1024, false};
        EpiMoe2 E{F.in[31], WSP(bf16, WS_YB)};
        g8::gemm_phase<EpiMoe2, MoeOrder, false, true>(F.lds, 1024, 1024, 1024, S, E);
    }
    SEAM(11);
    if (IN(12)) REPS(12) { if (rep_) xcd_barrier(bar); p12_final(F); }
#undef IN
#undef SEAM
}

extern "C" void kernel_launch(void* const* d_in, const int* in_sizes, int n_in, void* d_out, int out_size, void* d_ws, size_t ws_size, hipStream_t stream) {
    static int grid = 0;
    if (grid == 0) {
        if (n_in != 34 || in_sizes[0] != T * D || out_size != T * D || ws_size < WS_END) { fprintf(stderr, "kernel_launch: unexpected shapes (n_in %d, ws %zu < %zu)\n", n_in, ws_size, (size_t)WS_END); grid = -1; return; }
        int dev = 0, cus = 0;
        if (hipGetDevice(&dev) != hipSuccess || hipDeviceGetAttribute(&cus, hipDeviceAttributeMultiprocessorCount, dev) != hipSuccess) { grid = -1; return; }
        if (hipFuncSetAttribute((const void*)fwd_kernel, hipFuncAttributeMaxDynamicSharedMemorySize, LDS_BYTES) != hipSuccess) { fprintf(stderr, "kernel_launch: hipFuncSetAttribute failed\n"); grid = -1; return; }
        int per_cu = 0; (void)hipOccupancyMaxActiveBlocksPerMultiprocessor(&per_cu, (const void*)fwd_kernel, 512, LDS_BYTES); (void)hipGetLastError();
        grid = cus;
    }
    if (grid < 0) return;
    (void)hipMemsetAsync((char*)d_ws + WS_CTL, 0, CTL_BYTES, stream);
    Args a{};
    for (int i = 0; i < 34; ++i) a.in[i] = (const float*)d_in[i];
    a.out = (float*)d_out; a.ws = (unsigned char*)d_ws;
    if (MK_N_LAUNCHES == 1) { a.ph_lo = 0; a.ph_hi = N_PHASES; hipLaunchKernelGGL(fwd_kernel, dim3(grid), dim3(512), LDS_BYTES, stream, a); }
    else for (int p = 0; p < N_PHASES; ++p) { a.ph_lo = p; a.ph_hi = p + 1; hipLaunchKernelGGL(fwd_kernel, dim3(grid), dim3(512), LDS_BYTES, stream, a); }
}
```

```cpp
#include <hip/hip_runtime.h>
#include <cstdio>
#include <cstdint>

#ifndef MK_N_LAUNCHES
#define MK_N_LAUNCHES 1
#endif
constexpr int N_PHASES = 13;
#ifndef DUP_PHASE
#define DUP_PHASE -1
#endif
#define REPS(k) for (int rep_ = 0; rep_ < ((DUP_PHASE == (k)) ? 2 : 1); ++rep_)

#define GAS __attribute__((address_space(1)))
#define LAS __attribute__((address_space(3)))
typedef unsigned short bf16;
typedef short bf16x8 __attribute__((ext_vector_type(8)));
typedef float f32x4 __attribute__((ext_vector_type(4)));
typedef float f32x2 __attribute__((ext_vector_type(2)));
typedef unsigned u32x4 __attribute__((ext_vector_type(4)));
typedef unsigned u32x2 __attribute__((ext_vector_type(2)));
typedef GAS unsigned gu32;

constexpr int NB = 8, SEQ = 4096, T = NB * SEQ, D = 1024, INC = 4608, NE = 32, DFF = 1024;
constexpr int S5L = 32, S5G = 32, S5ROW = 128 + S5L * 16  , S5M = T / S5L  , S5CPB = SEQ / S5L  ;
constexpr int RGL = 128, RGC = SEQ / RGL  ;
constexpr float LN_EPS = 1e-5f, DN_ALPHA = 1.189207115002721f;
constexpr int ACT_ROWS = T * 4 + NE * 256;

constexpr size_t MiB = 1u << 20;
constexpr size_t WS_XRNN = 0, WS_GY = 64 * MiB, WS_GATES = 128 * MiB, WS_V1 = 0, WS_ACT = 0;
constexpr size_t WS_HBF = 272 * MiB, WS_HA = 272 * MiB, WS_YS = 336 * MiB, WS_GB = 368 * MiB, WS_MERGED = 432 * MiB, WS_ACAT = 496 * MiB, WS_YB = 272 * MiB;
constexpr size_t WS_X1 = 544 * MiB, WS_H2 = 608 * MiB;
constexpr size_t WS_WGU = 672 * MiB, WS_WD = 800 * MiB, WS_WIN = 864 * MiB, WS_WG = 873 * MiB, WS_WRNN = 874 * MiB, WS_WGLU = 876 * MiB, WS_WOUT = 878 * MiB;
constexpr size_t WS_WS = 880 * MiB, WS_WY = 888 * MiB, WS_S = 908 * MiB;
constexpr size_t WS_MOD = 924 * MiB, WS_AL = 925 * MiB, WS_RGAGG = 926 * MiB, WS_HIN = 928 * MiB, WS_TOK = 929 * MiB, WS_POS = 933 * MiB, WS_PROB = 934 * MiB, WS_CTL = 935 * MiB;
constexpr size_t WS_END = 936 * MiB, CTL_BYTES = 1 * MiB;
static_assert((size_t)ACT_ROWS * DFF * 2 <= 272 * MiB, "act/yb size");
static_assert(WS_ACAT + (size_t)S5G * S5M * S5ROW * 2 <= WS_X1, "acat");
constexpr int CW_BAR = 4096, CW_CNT = 8192  , CW_P0DONE = 12288  , CW_S5CDONE = 12352  ;

constexpr int LDS_BYTES = 147456, MISC_OFF = LDS_BYTES - 256, TAB_OFF = 131072 + 1024;

__device__ __forceinline__ unsigned f2bf(float f) { unsigned u = __builtin_bit_cast(unsigned, f); return (u + 0x7fffu + ((u >> 16) & 1u)) >> 16; }
typedef __bf16 bf16x2v __attribute__((ext_vector_type(2)));
__device__ __forceinline__ unsigned pk2(float lo, float hi) { const f32x2 v = {lo, hi}; const bf16x2v b = __builtin_convertvector(v, bf16x2v); return __builtin_bit_cast(unsigned, b); }
__device__ __forceinline__ unsigned pk4_fp8(float a, float b, float c, float d) { a = __builtin_amdgcn_fmed3f(a, -448.f, 448.f); b = __builtin_amdgcn_fmed3f(b, -448.f, 448.f); c = __builtin_amdgcn_fmed3f(c, -448.f, 448.f); d = __builtin_amdgcn_fmed3f(d, -448.f, 448.f); int w = 0; w = __builtin_amdgcn_cvt_pk_fp8_f32(a, b, w, false); w = __builtin_amdgcn_cvt_pk_fp8_f32(c, d, w, true); return (unsigned)w; }
__device__ __forceinline__ void unpack8_fp8(u32x2 w, f32x4& a, f32x4& b) { const f32x2 q0 = __builtin_amdgcn_cvt_pk_f32_fp8((int)w.x, false), q1 = __builtin_amdgcn_cvt_pk_f32_fp8((int)w.x, true), q2 = __builtin_amdgcn_cvt_pk_f32_fp8((int)w.y, false), q3 = __builtin_amdgcn_cvt_pk_f32_fp8((int)w.y, true);
    a = (f32x4){q0.x, q0.y, q1.x, q1.y}; b = (f32x4){q2.x, q2.y, q3.x, q3.y}; }
__device__ __forceinline__ float bflo(unsigned w) { return __builtin_bit_cast(float, w << 16); }
__device__ __forceinline__ float bfhi(unsigned w) { return __builtin_bit_cast(float, w & 0xffff0000u); }
__device__ __forceinline__ float bf1(bf16 h) { return __builtin_bit_cast(float, ((unsigned)h) << 16); }
__device__ __forceinline__ float fast_sigmoid(float x) { return __builtin_amdgcn_rcpf(1.0f + __builtin_amdgcn_exp2f(-1.4426950409f * x)); }
__device__ __forceinline__ float gelu_tanh(float x) { const float u = x + 0.044715f * x * x * x; return x * __builtin_amdgcn_rcpf(1.0f + __builtin_amdgcn_exp2f(-2.3022082f * u)); }
__device__ __forceinline__ f32x4 exp2_v(f32x4 x) { return (f32x4){__builtin_amdgcn_exp2f(x[0]), __builtin_amdgcn_exp2f(x[1]), __builtin_amdgcn_exp2f(x[2]), __builtin_amdgcn_exp2f(x[3])}; }
__device__ __forceinline__ f32x4 rcp_v(f32x4 x) { return (f32x4){__builtin_amdgcn_rcpf(x[0]), __builtin_amdgcn_rcpf(x[1]), __builtin_amdgcn_rcpf(x[2]), __builtin_amdgcn_rcpf(x[3])}; }
__device__ __forceinline__ f32x4 sigmoid_v(f32x4 x) { return rcp_v(exp2_v(x * -1.4426950409f) + 1.0f); }
__device__ __forceinline__ f32x4 gelu_v(f32x4 x) { const f32x4 u = x * x * 0.044715f * x + x; return x * rcp_v(exp2_v(u * -2.3022082f) + 1.0f); }
__device__ __forceinline__ unsigned pk4_fp8_nc(f32x4 v) { int w = 0; w = __builtin_amdgcn_cvt_pk_fp8_f32(v[0], v[1], w, false); w = __builtin_amdgcn_cvt_pk_fp8_f32(v[2], v[3], w, true); return (unsigned)w; }
__device__ __forceinline__ float wave_sum(float v) {
#pragma unroll
    for (int o = 1; o < 64; o <<= 1) v += __shfl_xor(v, o);
    return v;
}
__device__ __forceinline__ u32x4 pack8(f32x4 a, f32x4 b) { u32x4 w; w.x = pk2(a[0], a[1]); w.y = pk2(a[2], a[3]); w.z = pk2(b[0], b[1]); w.w = pk2(b[2], b[3]); return w; }
__device__ __forceinline__ void unpack8(u32x4 w, f32x4& a, f32x4& b) { a = (f32x4){bflo(w.x), bfhi(w.x), bflo(w.y), bfhi(w.y)}; b = (f32x4){bflo(w.z), bfhi(w.z), bflo(w.w), bfhi(w.w)}; }

#define XB_TMO      128
#define XB_XCNT(j)  (256  + 64 * (j))
#define XB_XSUB(j)  (1280 + 64 * (j))
#define XB_XGEN(j)  (2304 + 64 * (j))
#define XB_TOP      3328
#define XB_TOPGEN   3392
#define XCD_BAR_WORDS 3456
#define XB_SPIN_CAP (1u << 18)
__device__ __forceinline__ unsigned xb_ld(unsigned* p)              { return __hip_atomic_load(p, __ATOMIC_RELAXED, __HIP_MEMORY_SCOPE_AGENT); }
__device__ __forceinline__ unsigned xb_add(unsigned* p, unsigned v) { return __hip_atomic_fetch_add(p, v, __ATOMIC_RELAXED, __HIP_MEMORY_SCOPE_AGENT); }
__device__ __forceinline__ unsigned xb_xcc_id() { return (unsigned)__builtin_amdgcn_s_getreg((3 << 11) | 20) & 0xFu; }
#define XB_SPIN(cond, bar) do { unsigned _sp = 0; while (cond) { __builtin_amdgcn_s_sleep(1); \
    if ((++_sp & 255u) == 0u) { if (xb_ld(&(bar)[XB_TMO])) break; if (_sp > XB_SPIN_CAP) { atomicAdd(&(bar)[XB_TMO], 1u); break; } } } } while (0)
struct XcdBarrier { unsigned* bar; unsigned x; volatile LAS unsigned* st; };
__device__ __forceinline__ XcdBarrier xcd_barrier_post(unsigned* bar, volatile LAS unsigned* st) {
    XcdBarrier b; b.bar = bar; b.x = xb_xcc_id(); b.st = st;
    if (threadIdx.x == 0) (void)xb_add(&bar[XB_XCNT(b.x)], 1u);
    return b;
}
__device__ __forceinline__ void xcd_barrier_complete(unsigned* bar, unsigned x, unsigned& nloc, unsigned& nx) {
    const unsigned G = gridDim.x * gridDim.y * gridDim.z;
    unsigned sum, cnt, mine, sp = 0u;
    for (;;) {
        sum = 0u; cnt = 0u; mine = 0u;
#pragma unroll
        for (unsigned j = 0; j < 16; ++j) { const unsigned c = xb_ld(&bar[XB_XCNT(j)]); sum += c; cnt += (c > 0u) ? 1u : 0u; mine = (j == x) ? c : mine; }
        if (sum == G) break;
        __builtin_amdgcn_s_sleep(1);
        if ((++sp & 255u) == 0u) { if (xb_ld(&bar[XB_TMO])) break; if (sp > XB_SPIN_CAP) { atomicAdd(&bar[XB_TMO], 1u); break; } }
    }
    nloc = mine > 0u ? mine : 1u; nx = cnt > 0u ? cnt : 1u;
}
__device__ __forceinline__ void xcd_barrier(const XcdBarrier& b) {
    asm volatile("s_waitcnt vmcnt(0)" ::: "memory");
    __syncthreads();
    if (threadIdx.x == 0) {
        unsigned* bar = b.bar;
        __builtin_amdgcn_s_waitcnt(0);
        unsigned nloc = b.st[0], nx = b.st[1];
        if (nloc == 0u) { xcd_barrier_complete(bar, b.x, nloc, nx); b.st[0] = nloc; b.st[1] = nx; }
        const unsigned old = xb_add(&bar[XB_XSUB(b.x)], 1u);
        const unsigned gen = old / nloc;
        if (old + 1u == (gen + 1u) * nloc) {
            __builtin_amdgcn_fence(__ATOMIC_RELEASE, "agent");
            asm volatile("s_waitcnt vmcnt(0)" ::: "memory");
            const unsigned og = xb_add(&bar[XB_TOP], 1u);
            const unsigned tg = og / nx;
            if (og + 1u == (tg + 1u) * nx) xb_add(&bar[XB_TOPGEN], 1u);
            else XB_SPIN(xb_ld(&bar[XB_TOPGEN]) == tg, bar);
            __builtin_amdgcn_fence(__ATOMIC_ACQUIRE, "agent");
            xb_add(&bar[XB_XGEN(b.x)], 1u);
            asm volatile("s_waitcnt vmcnt(0)" ::: "memory");
        } else {
            XB_SPIN(xb_ld(&bar[XB_XGEN(b.x)]) == gen, bar);
            __builtin_amdgcn_fence(__ATOMIC_ACQUIRE, "agent");
            asm volatile("s_waitcnt vmcnt(0)" ::: "memory");
        }
    }
    __syncthreads();
}

namespace g8 {
constexpr int BM = 256, BK = 64, HALF = 128, HTB = HALF * BK * 2, STAGE_BYTES = 8 * HTB;
__device__ __forceinline__ int lds_byte(int r, int c) { const int st = (r >> 4) * 2 + (c >> 5), rr = r & 15, cc = c & 31, ob = rr * 64 + cc * 2; return st * 1024 + (ob ^ (((ob >> 9) & 1) << 5)); }
__device__ __forceinline__ void stage_rc(int b, int& R, int& C) { const int st = b / 1024, sb = b % 1024, swz = sb ^ (((sb >> 9) & 1) << 5); R = (st >> 1) * 16 + swz / 64; C = (st & 1) * 32 + (swz % 64) / 2; }
__device__ __forceinline__ int perm32(int rho) { const int n = rho >> 4, i = rho & 15; return 8 * (i >> 2) + 4 * n + (i & 3); }

struct Unit { int pm, pn, z, rl; const char* A; const char* B; };

typedef int v8i __attribute__((ext_vector_type(8)));
typedef int v4i __attribute__((ext_vector_type(4)));
typedef short s16x16 __attribute__((ext_vector_type(16)));
typedef s16x16 s16x16_a16 __attribute__((aligned(16)));
__device__ __forceinline__ v8i cat8(bf16x8 lo, bf16x8 hi) { const v4i a = __builtin_bit_cast(v4i, lo), b = __builtin_bit_cast(v4i, hi); return __builtin_shufflevector(a, b, 0, 1, 2, 3, 4, 5, 6, 7); }
template <class Epi, class Sched, bool GATHER, bool FP8 = false>
__device__ __forceinline__ void gemm_phase(LAS unsigned char* lds, const int Kb, const int ldaB, const int ldbB, const Sched& S, const Epi& E) {
    const int tid = threadIdx.x, wid = __builtin_amdgcn_readfirstlane(tid >> 6), lane = tid & 63, wr = wid >> 2, wc = wid & 3, fr = lane & 15, fq = lane >> 4;
    const int nt = Kb / 128;
    unsigned voffB[2], cvo[2][2], nvo[2][2]; int Rr[2], Cc[2];
#pragma unroll
    for (int i = 0; i < 2; ++i) { int R, C; stage_rc(tid * 16 + i * 8192, R, C); const int Rb = (R & ~31) + perm32(R & 31);
        voffB[i] = (unsigned)(Rb * ldbB + C * 2); Rr[i] = R; Cc[i] = C;
#pragma unroll
        for (int h = 0; h < 2; ++h) { cvo[h][i] = (unsigned)((h * HALF + R) * ldaB + C * 2); nvo[h][i] = cvo[h][i]; } }
    const size_t kstep = (size_t)(BK * 2);
    const size_t hstepB = (size_t)HALF * ldbB;
    const unsigned ldsw = (unsigned)wid * 1024u;
    const int aoff = FP8 ? lds_byte(wr * 64 + fr, (fq >> 1) * 32 + (fq & 1) * 24) : lds_byte(wr * 64 + fr, fq * 8), boff = FP8 ? lds_byte(wc * 32 + fr, (fq >> 1) * 32 + (fq & 1) * 24) : lds_byte(wc * 32 + fr, fq * 8);
    const int aoff2 = FP8 ? lds_byte(wr * 64 + fr, (fq >> 1) * 32 + 8 + (fq & 1) * 8) : 0, boff2 = FP8 ? lds_byte(wc * 32 + fr, (fq >> 1) * 32 + 8 + (fq & 1) * 8) : 0;
#define G8_SA(b, h) (((b) * 2 + (h)) * HTB)
#define G8_SB(b, h) ((4 + (b) * 2 + (h)) * HTB)
#define G8_STGB(bufoff, gbase) do { _Pragma("unroll") for (int _i = 0; _i < 2; ++_i) \
        __builtin_amdgcn_global_load_lds((const unsigned*)((const char*)(gbase) + voffB[_i]), (LAS unsigned*)(lds + (bufoff) + ldsw + _i * 8192), 16, 0, 0); } while (0)
#define G8_STGA(bufoff, gbase, VO, h) do { _Pragma("unroll") for (int _i = 0; _i < 2; ++_i) \
        __builtin_amdgcn_global_load_lds((const unsigned*)((const char*)(gbase) + VO[h][_i]), (LAS unsigned*)(lds + (bufoff) + ldsw + _i * 8192), 16, 0, 0); } while (0)
#define G8_LDA(dst, b, h) do { _Pragma("unroll") for (int m = 0; m < 4; ++m) { if constexpr (FP8) { dst##8[m] = cat8(*(const LAS bf16x8*)(lds + G8_SA(b, h) + aoff + m * 2048), *(const LAS bf16x8*)(lds + G8_SA(b, h) + aoff2 + m * 2048)); } \
        else { _Pragma("unroll") for (int k = 0; k < 2; ++k) dst[m][k] = *(const LAS bf16x8*)(lds + G8_SA(b, h) + aoff + m * 2048 + k * 1024); } } } while (0)
#define G8_LDB(dst, b, h) do { _Pragma("unroll") for (int n = 0; n < 2; ++n) { if constexpr (FP8) { dst##8[n] = cat8(*(const LAS bf16x8*)(lds + G8_SB(b, h) + boff + n * 2048), *(const LAS bf16x8*)(lds + G8_SB(b, h) + boff2 + n * 2048)); } \
        else { _Pragma("unroll") for (int k = 0; k < 2; ++k) dst[n][k] = *(const LAS bf16x8*)(lds + G8_SB(b, h) + boff + n * 2048 + k * 1024); } } } while (0)
#define G8_MMA(ai, bj, At, Bt) do { __builtin_amdgcn_s_setprio(1); _Pragma("unroll") for (int m = 0; m < 4; ++m) _Pragma("unroll") for (int n = 0; n < 2; ++n) { \
        if constexpr (FP8) asm volatile("s_nop 1\n\tv_mfma_scale_f32_16x16x128_f8f6f4 %0, %1, %2, %0, %3, %4 op_sel_hi:[0,0,0]" : "+v"(acc[ai][bj][m][n]) : "v"(Bt##8[n]), "v"(At##8[m]), "v"(sc_w), "v"(sc_a)); \
        else { _Pragma("unroll") for (int k = 0; k < 2; ++k) acc[ai][bj][m][n] = __builtin_amdgcn_mfma_f32_16x16x32_bf16(Bt[n][k], At[m][k], acc[ai][bj][m][n], 0, 0, 0); } } __builtin_amdgcn_s_setprio(0); } while (0)
#define G8_WAIT_V(n) asm volatile("s_waitcnt vmcnt(" #n ")" ::: "memory")
#define G8_WAIT_L(n) asm volatile("s_waitcnt lgkmcnt(" #n ")" ::: "memory")
#define G8_BAR __builtin_amdgcn_s_barrier()
#define G8_SCHED __builtin_amdgcn_sched_barrier(0)
    Unit cur, nxt; int ui = 0;
    if (!S.next(0, cur)) return;
    bool has_next = S.next(1, nxt);
    if constexpr (GATHER) { S.gather(cur, Rr, Cc, cvo); if (has_next) S.gather(nxt, Rr, Cc, nvo); else {
#pragma unroll
        for (int h = 0; h < 2; ++h)
#pragma unroll
            for (int i = 0; i < 2; ++i) nvo[h][i] = cvo[h][i]; } }
    f32x4 acc[2][2][4][2];
#pragma unroll
    for (int a = 0; a < 2; ++a)
#pragma unroll
        for (int b = 0; b < 2; ++b)
#pragma unroll
            for (int m = 0; m < 4; ++m)
#pragma unroll
                for (int n = 0; n < 2; ++n) acc[a][b][m][n] = (f32x4){0.f, 0.f, 0.f, 0.f};
    const int sc_w = 0x7a7a7a7a, sc_a = 0x7f7f7f7f;
    bf16x8 At[4][2], B0[2][2], B1[2][2]; v8i At8[4], B08[2], B18[2];
    const char* cA = cur.A; const char* cB = cur.B;
    G8_STGB(G8_SB(0, 0), cB); G8_STGB(G8_SB(0, 1), cB + hstepB); G8_STGA(G8_SA(0, 0), cA, cvo, 0); G8_STGA(G8_SA(0, 1), cA, cvo, 1);
    if (wr == 1) G8_BAR;
    G8_WAIT_V(2); G8_BAR;
    G8_STGB(G8_SB(1, 0), cB + kstep); G8_STGA(G8_SA(1, 0), cA + kstep, cvo, 0); G8_STGB(G8_SB(1, 1), cB + hstepB + kstep);
    G8_WAIT_V(6); G8_BAR;
    for (;;) {
        const char* nA = has_next ? nxt.A : cA; const char* nB = has_next ? nxt.B : cB;
        for (int t = 0; t < nt; t += 2) {
            const bool last = (t == nt - 2);
            const char* a1 = cA + (size_t)(t + 1) * kstep;
            const char* a2 = last ? nA : cA + (size_t)(t + 2) * kstep; const char* b2 = last ? nB : cB + (size_t)(t + 2) * kstep;
            const char* a3 = a2 + kstep; const char* b3 = b2 + kstep;
            unsigned vo2[2][2];
#pragma unroll
            for (int h = 0; h < 2; ++h)
#pragma unroll
                for (int i = 0; i < 2; ++i) vo2[h][i] = (GATHER && last) ? nvo[h][i] : cvo[h][i];
            G8_LDB(B0, 0, 0); G8_LDB(B1, 0, 1); G8_SCHED; G8_LDA(At, 0, 0); G8_STGA(G8_SA(1, 1), a1, cvo, 1);
            G8_WAIT_V(8); G8_WAIT_L(0); G8_BAR; G8_SCHED; G8_MMA(0, 0, At, B0); G8_MMA(0, 1, At, B1); G8_SCHED; G8_BAR; G8_SCHED;
            G8_LDA(At, 0, 1); G8_STGB(G8_SB(0, 0), b2); G8_STGB(G8_SB(0, 1), b2 + hstepB); G8_STGA(G8_SA(0, 0), a2, vo2, 0);
            G8_WAIT_V(8); G8_WAIT_L(0); G8_BAR; G8_SCHED; G8_MMA(1, 0, At, B0); G8_MMA(1, 1, At, B1); G8_SCHED; G8_BAR; G8_SCHED;
            G8_LDB(B0, 1, 0); G8_LDB(B1, 1, 1); G8_SCHED; G8_LDA(At, 1, 0); G8_STGA(G8_SA(0, 1), a2, vo2, 1);
            G8_WAIT_V(8); G8_WAIT_L(0); G8_BAR; G8_SCHED; G8_MMA(0, 0, At, B0); G8_MMA(0, 1, At, B1); G8_SCHED; G8_BAR; G8_SCHED;
            G8_LDA(At, 1, 1); G8_STGB(G8_SB(1, 0), b3); G8_STGB(G8_SB(1, 1), b3 + hstepB); G8_STGA(G8_SA(1, 0), a3, vo2, 0);
            G8_WAIT_V(8); G8_WAIT_L(0); G8_BAR; G8_SCHED; G8_MMA(1, 0, At, B0); G8_MMA(1, 1, At, B1); G8_SCHED; G8_BAR; G8_SCHED;
        }
        f32x4 bpre[4]; E.pre(cur, wr, wc, fr, fq, bpre);
        if (wr == 0) G8_BAR;
        Unit nn; bool has_nn = false;
        if (has_next) has_nn = S.next(ui + 2, nn);
        unsigned nnvo[2][2];
        if constexpr (GATHER) { if (has_nn) S.gather(nn, Rr, Cc, nnvo); }
        if constexpr (FP8) asm volatile("s_nop 15\n\ts_nop 15" ::: "memory");
        E(acc, cur, wr, wc, fr, fq, bpre);
        if (!has_next) break;
#pragma unroll
        for (int a = 0; a < 2; ++a)
#pragma unroll
            for (int b = 0; b < 2; ++b)
#pragma unroll
                for (int m = 0; m < 4; ++m)
#pragma unroll
                    for (int n = 0; n < 2; ++n) acc[a][b][m][n] = (f32x4){0.f, 0.f, 0.f, 0.f};
        cur = nxt; cA = nA; cB = nB; ++ui;
        if constexpr (GATHER) {
#pragma unroll
            for (int h = 0; h < 2; ++h)
#pragma unroll
                for (int i = 0; i < 2; ++i) { cvo[h][i] = nvo[h][i]; if (has_nn) nvo[h][i] = nnvo[h][i]; } }
        nxt = nn; has_next = has_nn;
        if (wr == 1) G8_BAR;
    }
    G8_WAIT_V(0);
    G8_BAR;
#undef G8_SA
#undef G8_SB
#undef G8_STGB
#undef G8_STGA
#undef G8_LDA
#undef G8_LDB
#undef G8_MMA
#undef G8_WAIT_V
#undef G8_WAIT_L
#undef G8_BAR
#undef G8_SCHED
}

struct GridOrder {
    int nM, nN, nwg, G, c; const char* A; const char* B; size_t tstepA, tstepB;
    __device__ __forceinline__ void init(int M, int N, int G_, int c_, const void* A_, const void* B_, int ldaB, int ldbB) { nM = M / BM; nN = N / BM; nwg = nM * nN; G = G_; c = c_; A = (const char*)A_; B = (const char*)B_; tstepA = (size_t)BM * ldaB; tstepB = (size_t)BM * ldbB; }
    __device__ __forceinline__ bool next(int i, Unit& u) const {
        const long L = (long)i * G + c; if (L >= nwg) return false;
        int wgid = (int)L; { const int q = nwg / 8, r = nwg % 8, xcd = wgid % 8, off = wgid / 8; wgid = (xcd < r ? xcd * (q + 1) : r * (q + 1) + (xcd - r) * q) + off; }
        const int nig = 8 * nN, gid = wgid / nig, fm = gid * 8, gsz = (nM - fm) < 8 ? (nM - fm) : 8;
        u.pm = fm + ((wgid % nig) % gsz); u.pn = (wgid % nig) / gsz; u.z = 0; u.rl = 0;
        u.A = A + (size_t)u.pm * tstepA; u.B = B + (size_t)u.pn * tstepB; return true;
    }
};
}

struct Frame {
    LAS unsigned char* lds; volatile LAS unsigned* MISC; unsigned* ctl;
    int tid, lane, wave, vcu, G;
    const float* in[34]; float* out; unsigned char* ws;
};
#define WSP(T_, off) ((T_*)(F.ws + (off)))

struct EpiInProj { static constexpr int NST = 16;
    __device__ __forceinline__ void pre(const g8::Unit& u, int, int wc, int, int fq, f32x4 (&bp)[4]) const { const int colb = u.pn * 256 + wc * 32 + 8 * fq;
#pragma unroll
        for (int bj = 0; bj < 2; ++bj)
#pragma unroll
            for (int n = 0; n < 2; ++n) bp[bj * 2 + n] = *(const f32x4*)(bias + colb + bj * 128 + 4 * n); }
    const float* bias; bf16 *xrnn, *gy, *acat, *gates;
    template <int KIND>
    __device__ __forceinline__ void run(const f32x4 (&acc)[2][2][4][2], const g8::Unit& u, int wr, int wc, int fr, int fq, const f32x4 (&bpre)[4]) const {
        const int colb = u.pn * 256 + wc * 32 + 8 * fq;
#pragma unroll
        for (int ai = 0; ai < 2; ++ai)
#pragma unroll
            for (int m = 0; m < 4; ++m) { const int t = u.pm * 256 + ai * 128 + wr * 64 + m * 16 + fr;
#pragma unroll
                for (int bj = 0; bj < 2; ++bj) { f32x4 v0 = acc[ai][bj][m][0] + bpre[bj * 2], v1 = acc[ai][bj][m][1] + bpre[bj * 2 + 1]; const int col = colb + bj * 128;
                    if (KIND == 0) { u32x2 w8; w8.x = pk4_fp8(v0[0], v0[1], v0[2], v0[3]); w8.y = pk4_fp8(v1[0], v1[1], v1[2], v1[3]); *(u32x2*)((unsigned char*)xrnn + (size_t)t * 1024 + col) = w8; }
                    else if (KIND == 1) {
#pragma unroll
                        for (int j = 0; j < 1; ++j) { v0 = gelu_v(v0); v1 = gelu_v(v1); }
                        u32x2 w8; w8.x = pk4_fp8(v0[0], v0[1], v0[2], v0[3]); w8.y = pk4_fp8(v1[0], v1[1], v1[2], v1[3]); *(u32x2*)((unsigned char*)gy + (size_t)t * 1024 + (col - 1024)) = w8; }
                    else if (KIND == 2) { const int cu = col - 2048, g = cu >> 4, c = cu & 15;
                        *(u32x4*)(acat + ((size_t)(g * S5M + (t >> 5)) * S5ROW + 128 + (t & 31) * 16 + c)) = pack8(v0, v1); }
                    else {
#pragma unroll
                        for (int j = 0; j < 1; ++j) { v0 = sigmoid_v(v0); v1 = sigmoid_v(v1); }
                        u32x2 w8; w8.x = pk4_fp8_nc(v0); w8.y = pk4_fp8_nc(v1); *(u32x2*)((unsigned char*)gates + (size_t)t * 2048 + (col - 2560)) = w8; } } }
    }
    __device__ __forceinline__ void operator()(const f32x4 (&acc)[2][2][4][2], const g8::Unit& u, int wr, int wc, int fr, int fq, const f32x4 (&bpre)[4]) const {
        const int pn = u.pn;
        if (pn < 4) run<0>(acc, u, wr, wc, fr, fq, bpre); else if (pn < 8) run<1>(acc, u, wr, wc, fr, fq, bpre); else if (pn < 10) run<2>(acc, u, wr, wc, fr, fq, bpre); else run<3>(acc, u, wr, wc, fr, fq, bpre);
    }
};
struct EpiS5A {
    __device__ __forceinline__ void pre(const g8::Unit&, int, int, int, int, f32x4 (&)[4]) const {}
    float* S;
    __device__ __forceinline__ void operator()(const f32x4 (&acc)[2][2][4][2], const g8::Unit& u, int wr, int wc, int fr, int fq, const f32x4 (&bpre)[4]) const {
        const int col = wc * 32 + 8 * fq;
#pragma unroll
        for (int ai = 0; ai < 2; ++ai)
#pragma unroll
            for (int m = 0; m < 4; ++m) { const int row = u.pm * 256 + ai * 128 + wr * 64 + m * 16 + fr; float* p = S + ((size_t)(u.z * S5M + row)) * 128 + col;
                *(f32x4*)p = acc[ai][0][m][0]; *(f32x4*)(p + 4) = acc[ai][0][m][1]; }
    }
};
struct EpiS5C {
    __device__ __forceinline__ void pre(const g8::Unit&, int, int, int, int, f32x4 (&)[4]) const {}
    bf16* ys;
    __device__ __forceinline__ void operator()(const f32x4 (&acc)[2][2][4][2], const g8::Unit& u, int wr, int wc, int fr, int fq, const f32x4 (&bpre)[4]) const {
#pragma unroll
        for (int ai = 0; ai < 2; ++ai)
#pragma unroll
            for (int m = 0; m < 4; ++m) { const int row = u.pm * 256 + ai * 128 + wr * 64 + m * 16 + fr;
#pragma unroll
                for (int bj = 0; bj < 2; ++bj) { const int n = u.pn * 256 + bj * 128 + wc * 32 + 8 * fq, i = n >> 4, c = n & 15; f32x4 v0 = acc[ai][bj][m][0], v1 = acc[ai][bj][m][1];
#pragma unroll
                    for (int j = 0; j < 1; ++j) { v0 = gelu_v(v0); v1 = gelu_v(v1); }
                    u32x2 w8; w8.x = pk4_fp8(v0[0], v0[1], v0[2], v0[3]); w8.y = pk4_fp8(v1[0], v1[1], v1[2], v1[3]); *(u32x2*)((unsigned char*)ys + (size_t)(row * 32 + i) * 512 + u.z * 16 + c) = w8; } }
    }
};
struct EpiGlu { static constexpr int NST = 8;
    __device__ __forceinline__ void pre(const g8::Unit&, int, int, int, int, f32x4 (&)[4]) const {}
    const bf16* gates; bf16* gb;
    __device__ __forceinline__ void operator()(const f32x4 (&acc)[2][2][4][2], const g8::Unit& u, int wr, int wc, int fr, int fq, const f32x4 (&bpre)[4]) const {
        const int f = u.pn * 128 + wc * 32 + 8 * fq;
#pragma unroll
        for (int ai = 0; ai < 2; ++ai) { u32x2 gw[4];
#pragma unroll
            for (int m = 0; m < 4; ++m) { const int t = u.pm * 256 + ai * 128 + wr * 64 + m * 16 + fr; gw[m] = *(const u32x2*)((const unsigned char*)gates + (size_t)t * 2048 + 1024 + f); }
#pragma unroll
            for (int m = 0; m < 4; ++m) { const int t = u.pm * 256 + ai * 128 + wr * 64 + m * 16 + fr;
                f32x4 g0, g1; unpack8_fp8(gw[m], g0, g1);
                f32x4 v0 = acc[ai][0][m][0], v1 = acc[ai][0][m][1]; const f32x4 s0 = acc[ai][1][m][0], s1 = acc[ai][1][m][1];
#pragma unroll
                for (int j = 0; j < 1; ++j) { v0 = g0 * v0 * sigmoid_v(s0); v1 = g1 * v1 * sigmoid_v(s1); }
                u32x2 w8; w8.x = pk4_fp8(v0[0], v0[1], v0[2], v0[3]); w8.y = pk4_fp8(v1[0], v1[1], v1[2], v1[3]); *(u32x2*)((unsigned char*)gb + (size_t)t * 1024 + f) = w8; } }
    }
};
struct EpiRnn { static constexpr int NST = 16;
    __device__ __forceinline__ void pre(const g8::Unit&, int, int, int, int, f32x4 (&)[4]) const {}
    const bf16* gates; const bf16* gb; bf16* merged;
    __device__ __forceinline__ void operator()(const f32x4 (&acc)[2][2][4][2], const g8::Unit& u, int wr, int wc, int fr, int fq, const f32x4 (&bpre)[4]) const {
#pragma unroll
        for (int ai = 0; ai < 2; ++ai)
#pragma unroll
            for (int mh = 0; mh < 2; ++mh) { u32x2 gw[2][2], bw[2][2];
#pragma unroll
                for (int mm = 0; mm < 2; ++mm) { const int t = u.pm * 256 + ai * 128 + wr * 64 + (2 * mh + mm) * 16 + fr;
#pragma unroll
                    for (int bj = 0; bj < 2; ++bj) { const int col = u.pn * 256 + bj * 128 + wc * 32 + 8 * fq; gw[mm][bj] = *(const u32x2*)((const unsigned char*)gates + (size_t)t * 2048 + col); bw[mm][bj] = *(const u32x2*)((const unsigned char*)gb + (size_t)t * 1024 + col); } }
#pragma unroll
                for (int mm = 0; mm < 2; ++mm) { const int m = 2 * mh + mm, t = u.pm * 256 + ai * 128 + wr * 64 + m * 16 + fr;
#pragma unroll
                    for (int bj = 0; bj < 2; ++bj) { const int col = u.pn * 256 + bj * 128 + wc * 32 + 8 * fq;
                        f32x4 g0, g1, b0, b1; unpack8_fp8(gw[mm][bj], g0, g1); unpack8_fp8(bw[mm][bj], b0, b1);
                        const f32x4 v0 = g0 * acc[ai][bj][m][0] + b0, v1 = g1 * acc[ai][bj][m][1] + b1;
                        u32x2 w8; w8.x = pk4_fp8(v0[0], v0[1], v0[2], v0[3]); w8.y = pk4_fp8(v1[0], v1[1], v1[2], v1[3]); *(u32x2*)((unsigned char*)merged + (size_t)t * 1024 + col) = w8; } } }
    }
};
struct EpiOut { static constexpr int NST = 16;
    const float* x; const float* mod; bf16* v1;
    __device__ __forceinline__ void pre(const g8::Unit& u, int, int wc, int, int fq, f32x4 (&bp)[4]) const { const int b = (u.pm * 256) >> 12; const float* p = mod + b * 6144 + 2048 + u.pn * 256 + wc * 32 + 8 * fq;
        bp[0] = *(const f32x4*)p; bp[1] = *(const f32x4*)(p + 4); bp[2] = *(const f32x4*)(p + 128); bp[3] = *(const f32x4*)(p + 132); }
    __device__ __forceinline__ void operator()(const f32x4 (&acc)[2][2][4][2], const g8::Unit& u, int wr, int wc, int fr, int fq, const f32x4 (&bpre)[4]) const {
#pragma unroll
        for (int ai = 0; ai < 2; ++ai)
#pragma unroll
            for (int mh = 0; mh < 2; ++mh) { f32x4 xv[2][2][2];
#pragma unroll
                for (int mm = 0; mm < 2; ++mm) { const int t = u.pm * 256 + ai * 128 + wr * 64 + (2 * mh + mm) * 16 + fr;
#pragma unroll
                    for (int bj = 0; bj < 2; ++bj) { const int col = u.pn * 256 + bj * 128 + wc * 32 + 8 * fq; xv[mm][bj][0] = *(const f32x4*)(x + (size_t)t * 1024 + col); xv[mm][bj][1] = *(const f32x4*)(x + (size_t)t * 1024 + col + 4); } }
#pragma unroll
                for (int mm = 0; mm < 2; ++mm) { const int m = 2 * mh + mm, t = u.pm * 256 + ai * 128 + wr * 64 + m * 16 + fr;
#pragma unroll
                    for (int bj = 0; bj < 2; ++bj) { const int col = u.pn * 256 + bj * 128 + wc * 32 + 8 * fq;
                        const f32x4 v0 = xv[mm][bj][0] * DN_ALPHA + (bpre[2 * bj] + 1.0f) * acc[ai][bj][m][0], v1_ = xv[mm][bj][1] * DN_ALPHA + (bpre[2 * bj + 1] + 1.0f) * acc[ai][bj][m][1];
                        *(u32x4*)(v1 + (size_t)t * 1024 + col) = pack8(v0, v1_); } } }
    }
};
struct EpiMoe1 {
    __device__ __forceinline__ void pre(const g8::Unit& u, int, int wc, int, int fq, f32x4 (&bp)[4]) const { const float* p = bgu + (size_t)u.z * 2048 + u.pn * 128 + wc * 32 + 8 * fq; bp[0] = *(const f32x4*)p; bp[1] = *(const f32x4*)(p + 4); bp[2] = *(const f32x4*)(p + 1024); bp[3] = *(const f32x4*)(p + 1028); }
    const float* bgu; bf16* act;
    __device__ __forceinline__ void operator()(const f32x4 (&acc)[2][2][4][2], const g8::Unit& u, int wr, int wc, int fr, int fq, const f32x4 (&bpre)[4]) const {
        const int f = u.pn * 128 + wc * 32 + 8 * fq; const float* bp = bgu + (size_t)u.z * 2048 + f;
        (void)bp; const f32x4 bg0 = bpre[0], bg1 = bpre[1], bu0 = bpre[2], bu1 = bpre[3];
#pragma unroll
        for (int ai = 0; ai < 2; ++ai)
#pragma unroll
            for (int m = 0; m < 4; ++m) { const int row = u.pm * 256 + ai * 128 + wr * 64 + m * 16 + fr;
                f32x4 g0 = acc[ai][0][m][0] + bg0, g1 = acc[ai][0][m][1] + bg1, u0 = acc[ai][1][m][0] + bu0, u1 = acc[ai][1][m][1] + bu1;
#pragma unroll
                for (int j = 0; j < 4; ++j) { g0[j] = fminf(g0[j], 7.0f); g1[j] = fminf(g1[j], 7.0f); u0[j] = __builtin_amdgcn_fmed3f(u0[j], -7.0f, 7.0f); u1[j] = __builtin_amdgcn_fmed3f(u1[j], -7.0f, 7.0f); }
                g0 = g0 * rcp_v(exp2_v(g0 * (-1.702f * 1.4426950409f)) + 1.0f) * (u0 + 1.0f); g1 = g1 * rcp_v(exp2_v(g1 * (-1.702f * 1.4426950409f)) + 1.0f) * (u1 + 1.0f);
                u32x2 w8; w8.x = pk4_fp8_nc(g0); w8.y = pk4_fp8_nc(g1); *(u32x2*)((unsigned char*)act + (size_t)row * 1024 + f) = w8; }
    }
};
struct EpiMoe2 {
    __device__ __forceinline__ void pre(const g8::Unit& u, int, int wc, int, int fq, f32x4 (&bp)[4]) const { const float* p = bd + (size_t)u.z * 1024 + u.pn * 256 + wc * 32 + 8 * fq; bp[0] = *(const f32x4*)p; bp[1] = *(const f32x4*)(p + 4); bp[2] = *(const f32x4*)(p + 128); bp[3] = *(const f32x4*)(p + 132); }
    const float* bd; bf16* yb;
    __device__ __forceinline__ void operator()(const f32x4 (&acc)[2][2][4][2], const g8::Unit& u, int wr, int wc, int fr, int fq, const f32x4 (&bpre)[4]) const {
#pragma unroll
        for (int bj = 0; bj < 2; ++bj) { const int col = u.pn * 256 + bj * 128 + wc * 32 + 8 * fq; const float* bp = bd + (size_t)u.z * 1024 + col;
            (void)bp; const f32x4 b0 = bpre[bj * 2], b1 = bpre[bj * 2 + 1];
#pragma unroll
            for (int ai = 0; ai < 2; ++ai)
#pragma unroll
                for (int m = 0; m < 4; ++m) { const int row = u.pm * 256 + ai * 128 + wr * 64 + m * 16 + fr;
                    const f32x4 y0 = acc[ai][bj][m][0] + b0, y1 = acc[ai][bj][m][1] + b1; u32x2 w8; w8.x = pk4_fp8(y0[0], y0[1], y0[2], y0[3]); w8.y = pk4_fp8(y1[0], y1[1], y1[2], y1[3]);
                    *(u32x2*)((unsigned char*)yb + (size_t)row * 1024 + col) = w8; } }
    }
};

struct S5AOrder { int G, c; const char* acat; const char* ws;
    __device__ __forceinline__ bool next(int i, g8::Unit& u) const { const int L = i * G + c; if (L >= S5G * 4) return false; u.z = L >> 2; u.pm = L & 3; u.pn = 0; u.rl = 0;
        u.A = acat + ((size_t)(u.z * S5M + u.pm * 256) * S5ROW + 128) * 2; u.B = ws + (size_t)u.z * 256 * (S5L * 16) * 2; return true; } };
struct S5COrder { int G, c; const char* acat; const char* wy;
    __device__ __forceinline__ bool next(int i, g8::Unit& u) const { const int L = i * G + c; if (L >= S5G * 8) return false; u.z = L >> 3; u.pm = (L >> 1) & 3; u.pn = L & 1; u.rl = 0;
        u.A = acat + ((size_t)(u.z * S5M + u.pm * 256) * S5ROW) * 2; u.B = wy + ((size_t)(u.z * 512 + u.pn * 256) * S5ROW) * 2; return true; } };
struct MoeOrder { int G, c, NT, RT; const LAS int* tstart; const LAS int* cnt; const int* toklist; const char* A; const char* B; size_t bstride_e; int lda; bool gatherA;
    __device__ __forceinline__ bool next(int i, g8::Unit& u) const { const int per = G >> 3, xcd = c & 7, slot = c >> 3, rpx = per / NT;
        const int rt = (i * 8 + xcd) * rpx + slot / NT; if (rt >= RT) return false; u.pn = slot % NT;
        const int lane_ = threadIdx.x & 63; const unsigned long long mk_ = __ballot(lane_ < NE && tstart[lane_ & 31] <= rt);
        const int e = __builtin_popcountll(mk_) - 1;
        u.z = e; u.pm = rt; u.rl = rt - tstart[e]; u.B = B + (size_t)e * bstride_e + (size_t)u.pn * 256 * 1024; u.A = gatherA ? A : A + (size_t)rt * 256 * 1024; return true; }
    __device__ __forceinline__ void gather(const g8::Unit& u, const int (&Rr)[2], const int (&Cc)[2], unsigned (&vo)[2][2]) const {
        const int n = cnt[u.z];
#pragma unroll
        for (int h = 0; h < 2; ++h)
#pragma unroll
            for (int i = 0; i < 2; ++i) { const int r = u.rl * 256 + h * 128 + Rr[i]; const int rc = r < n ? r : n - 1; const int tok = toklist[u.z * T + rc]; vo[h][i] = (unsigned)(tok * lda + Cc[i] * 2); } }
};

__device__ __forceinline__ void transpose_item(const float* W, int N, int k0, int n0, bf16* dst, int ldd, int drow0, LAS float* scr, int lane) {
    float wv_[32];
#pragma unroll
    for (int i = 0; i < 32; ++i) wv_[i] = W[(size_t)(k0 + 2 * i + (lane >> 5)) * N + n0 + (lane & 31)];
#pragma unroll
    for (int i = 0; i < 32; ++i) scr[(2 * i + (lane >> 5)) * 33 + (lane & 31)] = wv_[i];
    asm volatile("s_waitcnt lgkmcnt(0)" ::: "memory");
    const int c = lane & 7;
#pragma unroll
    for (int j = 0; j < 4; ++j) { const int n = (lane >> 3) + 8 * j; const LAS float* s = scr + (8 * c) * 33 + n;
        u32x4 o; o.x = pk2(s[0 * 33], s[1 * 33]); o.y = pk2(s[2 * 33], s[3 * 33]); o.z = pk2(s[4 * 33], s[5 * 33]); o.w = pk2(s[6 * 33], s[7 * 33]);
        *(u32x4*)(dst + (size_t)(drow0 + n) * ldd + k0 + 8 * c) = o; }
    asm volatile("s_waitcnt lgkmcnt(0)" ::: "memory");
}
__device__ __forceinline__ void transpose_item8(const float* W, int N, int k0, int n0, unsigned char* dst, int ldd, int drow0, LAS float* scr, int lane) {
    float wv_[32];
#pragma unroll
    for (int i = 0; i < 32; ++i) wv_[i] = W[(size_t)(k0 + 2 * i + (lane >> 5)) * N + n0 + (lane & 31)];
#pragma unroll
    for (int i = 0; i < 32; ++i) scr[(2 * i + (lane >> 5)) * 33 + (lane & 31)] = wv_[i];
    asm volatile("s_waitcnt lgkmcnt(0)" ::: "memory");
    const int c = lane & 7;
#pragma unroll
    for (int j = 0; j < 4; ++j) { const int n = (lane >> 3) + 8 * j; const LAS float* s = scr + (8 * c) * 33 + n;
        u32x2 o; o.x = pk4_fp8(32.f * s[0 * 33], 32.f * s[1 * 33], 32.f * s[2 * 33], 32.f * s[3 * 33]); o.y = pk4_fp8(32.f * s[4 * 33], 32.f * s[5 * 33], 32.f * s[6 * 33], 32.f * s[7 * 33]);
        *(u32x2*)(dst + (size_t)(drow0 + n) * ldd + k0 + 8 * c) = o; }
    asm volatile("s_waitcnt lgkmcnt(0)" ::: "memory");
}
__device__ __forceinline__ void transpose_item8w(const float* W, int N, int k0, int n0, unsigned char* dst, int ldd, int drow0, LAS float* scr, int lane) {
    float wv[64]; const float* wp = W + (size_t)(k0 + (lane >> 5)) * N + n0 + (lane & 31);
#pragma unroll
    for (int i = 0; i < 64; ++i) wv[i] = wp[(size_t)(2 * i) * N];
#pragma unroll
    for (int i = 0; i < 64; ++i) scr[(2 * i + (lane >> 5)) * 33 + (lane & 31)] = wv[i];
    asm volatile("s_waitcnt lgkmcnt(0)" ::: "memory");
    const int c = lane & 7;
#pragma unroll
    for (int j = 0; j < 4; ++j) { const int n = (lane >> 3) + 8 * j; const LAS float* s = scr + (16 * c) * 33 + n;
        u32x4 o; o.x = pk4_fp8(32.f * s[0 * 33], 32.f * s[1 * 33], 32.f * s[2 * 33], 32.f * s[3 * 33]); o.y = pk4_fp8(32.f * s[4 * 33], 32.f * s[5 * 33], 32.f * s[6 * 33], 32.f * s[7 * 33]);
        o.z = pk4_fp8(32.f * s[8 * 33], 32.f * s[9 * 33], 32.f * s[10 * 33], 32.f * s[11 * 33]); o.w = pk4_fp8(32.f * s[12 * 33], 32.f * s[13 * 33], 32.f * s[14 * 33], 32.f * s[15 * 33]);
        *(u32x4*)(dst + (size_t)(drow0 + n) * ldd + k0 + 16 * c) = o; }
    asm volatile("s_waitcnt lgkmcnt(0)" ::: "memory");
}
__device__ __forceinline__ int pair_row(int n) { const int f = n & 1023, hi = n >> 10; return (f >> 7) * 256 + hi * 128 + (f & 127); }

__device__ __forceinline__ void moe_tables(Frame& F) {
    LAS int* tstart = (LAS int*)(F.lds + TAB_OFF); LAS int* cl = tstart + 40;
    if (F.tid < 64) {
        const int e = F.lane & 31; const int c = (int)F.ctl[CW_CNT + 64 * e]; int inc = (c + 255) >> 8;
#pragma unroll
        for (int o = 1; o < 32; o <<= 1) { const int v = __shfl_up(inc, o); if ((F.lane & 31) >= o) inc += v; }
        if (F.lane < 32) { cl[e] = c; tstart[e] = inc - ((c + 255) >> 8); if (e == NE - 1) tstart[NE] = inc; }
    }
    __syncthreads();
}

__device__ __forceinline__ void p0_mod_job(Frame& F, int job) {
    LAS float* sc = (LAS float*)F.lds;
    LAS float* red = sc + 8 * 1024;
    const float* c = F.in[1]; const float* w = F.in[2]; const float* bias = F.in[3];
    { float cv[16];
#pragma unroll
      for (int k = 0; k < 16; ++k) cv[k] = c[F.tid + 512 * k];
#pragma unroll
      for (int k = 0; k < 16; ++k) sc[F.tid + 512 * k] = cv[k] * fast_sigmoid(cv[k]); }
    __syncthreads();
    const int col = F.tid & 31, kg = F.tid >> 5, j = job * 32 + col;
    float a[8];
#pragma unroll
    for (int b = 0; b < 8; ++b) a[b] = 0.f;
#pragma unroll 32
    for (int k = kg * 64; k < kg * 64 + 64; ++k) { const float wv = w[(size_t)k * 6144 + j];
#pragma unroll
        for (int b = 0; b < 8; ++b) a[b] += sc[b * 1024 + k] * wv; }
#pragma unroll
    for (int b = 0; b < 8; ++b) red[(kg * 8 + b) * 32 + col] = a[b];
    __syncthreads();
    if (F.tid < 256) { const int b = F.tid >> 5, cc = F.tid & 31; float s = 0.f;
#pragma unroll
        for (int g = 0; g < 16; ++g) s += red[(g * 8 + b) * 32 + cc];
        WSP(float, WS_MOD)[b * 6144 + job * 32 + cc] = s + bias[job * 32 + cc]; }
    __syncthreads();
}
__device__ __forceinline__ void s5_setup(Frame& F, int g, int kmin, int kmax, LAS f32x2* Bb, LAS f32x2* Cc, LAS f32x2* Ap) {
    const float* lre = F.in[14] + g * 64; const float* lim = F.in[15] + g * 64; const float dt = expf(F.in[16][g]);
    const float* bre = F.in[17] + g * 1024; const float* bim = F.in[18] + g * 1024; const float* cre = F.in[19] + g * 1024; const float* cim = F.in[20] + g * 1024;
    for (int i = F.tid; i < 1024; i += 512) { const int p = i >> 4; const float lr = lre[p], li = lim[p]; const float mag = expf(lr * dt); float sn, cs; sincosf(li * dt, &sn, &cs);
        const float ar = mag * cs, ai = mag * sn, den = lr * lr + li * li, qr = ((ar - 1.f) * lr + ai * li) / den, qi = (ai * lr - (ar - 1.f) * li) / den;
        const float br = bre[i], bi = bim[i]; Bb[i] = (f32x2){qr * br - qi * bi, qr * bi + qi * br};
        Cc[i] = (f32x2){cre[i], cim[i]}; }
    if (F.tid < 64) { const int p = F.tid; const float lr = lre[p], li = lim[p]; const float mag = expf(lr * dt); float sn, cs; sincosf(li * dt, &sn, &cs);
        const float ar = mag * cs, ai = mag * sn; float xr_ = 1.f, xi_ = 0.f;
        for (int k = 0; k <= kmax; ++k) { if (k >= kmin) Ap[k * 64 + p] = (f32x2){xr_, xi_}; const float nr = xr_ * ar - xi_ * ai, ni = xr_ * ai + xi_ * ar; xr_ = nr; xi_ = ni; } }
    __syncthreads();
}
constexpr size_t WS_KTAB = WS_S;
constexpr size_t WS_WRIMG = WS_AL + 512 * 1024;
__device__ __forceinline__ void p0_s5k_job(Frame& F, int job) {
    const int g = job >> 3, part = job & 7;
    LAS f32x2* Bb = (LAS f32x2*)F.lds; LAS f32x2* Cc = Bb + 1024; LAS f32x2* Ap = Cc + 1024;
    s5_setup(F, g, 4 * part, 4 * part + 3, Bb, Cc, Ap);
    float* kt = WSP(float, WS_KTAB) + (size_t)g * 32 * 256;
    for (int e = 4 * part * 256 + F.tid; e < (4 * part + 4) * 256; e += 512) { const int k = e >> 8, c = (e >> 4) & 15, c2 = e & 15; float s = 0.f;
        for (int p = 0; p < 64; ++p) { const f32x2 cv = Cc[c * 64 + p], av = Ap[k * 64 + p], bv = Bb[p * 16 + c2];
            const float car = cv.x * av.x - cv.y * av.y, cai = cv.x * av.y + cv.y * av.x; s += car * bv.x - cai * bv.y; }
        kt[e] = s; }
    __syncthreads();
}
__device__ __forceinline__ void p1_s5w_job(Frame& F, int job) {
    const int g = job >> 3, part = job & 7;
    LAS f32x2* Bb = (LAS f32x2*)F.lds; LAS f32x2* Cc = Bb + 1024; LAS f32x2* Ap = Cc + 1024; LAS float* Kt = (LAS float*)(Ap + 33 * 64);
    const float* ktg = WSP(float, WS_KTAB) + (size_t)g * 32 * 256; const float* dsk = F.in[21] + g * 16;
    { f32x4 kv[4];
#pragma unroll
      for (int k = 0; k < 4; ++k) kv[k] = *(const f32x4*)(ktg + 4 * (F.tid + 512 * k));
#pragma unroll
      for (int k = 0; k < 4; ++k) *(LAS f32x4*)(Kt + 4 * (F.tid + 512 * k)) = kv[k]; }
    s5_setup(F, g, 0, S5L, Bb, Cc, Ap);
    if (part == 0 && F.tid < 64) WSP(f32x2, WS_AL)[g * 64 + F.tid] = Ap[S5L * 64 + F.tid];
    bf16* wy = WSP(bf16, WS_WY) + (size_t)g * 512 * S5ROW;
    for (int ch = F.tid; ch < 64 * (S5ROW / 8); ch += 512) { const int n = part * 64 + ch / (S5ROW / 8), k8 = (ch % (S5ROW / 8)) * 8, i = n >> 4, c = n & 15; float v[8]; const float dskc = dsk[c];
        if (k8 < 128) {
#pragma unroll
            for (int j = 0; j < 8; j += 2) { const int p = (k8 + j) >> 1; const f32x2 cv = Cc[c * 64 + p], av = Ap[(i + 1) * 64 + p]; v[j] = cv.x * av.x - cv.y * av.y; v[j + 1] = -(cv.x * av.y + cv.y * av.x); } }
        else { const int jj = (k8 - 128) >> 4, c2 = (k8 - 128) & 15;
#pragma unroll
            for (int j = 0; j < 8; ++j) { float x = 0.f; if (jj <= i) { x = Kt[(i - jj) * 256 + c * 16 + c2 + j]; x += (jj == i && c == c2 + j) ? dskc : 0.f; } v[j] = x; } }
        u32x4 o; o.x = pk2(v[0], v[1]); o.y = pk2(v[2], v[3]); o.z = pk2(v[4], v[5]); o.w = pk2(v[6], v[7]);
        *(u32x4*)(wy + (size_t)n * S5ROW + k8) = o; }
    bf16* wsm = WSP(bf16, WS_WS) + (size_t)g * 256 * 512;
    for (int ch = F.tid; ch < 32 * 64; ch += 512) { const int n = part * 32 + (ch >> 6), k8 = (ch & 63) * 8, jj = k8 >> 4, c2 = k8 & 15; float v[8];
#pragma unroll
        for (int j = 0; j < 8; ++j) { float x = 0.f; if (n < 128) { const int p = n >> 1; const f32x2 av = Ap[(S5L - 1 - jj) * 64 + p], bv = Bb[p * 16 + c2 + j]; x = (n & 1) ? (av.x * bv.y + av.y * bv.x) : (av.x * bv.x - av.y * bv.y); } v[j] = x; }
        u32x4 o; o.x = pk2(v[0], v[1]); o.y = pk2(v[2], v[3]); o.z = pk2(v[4], v[5]); o.w = pk2(v[6], v[7]);
        *(u32x4*)(wsm + (size_t)n * 512 + k8) = o; }
    __syncthreads();
}
__device__ __forceinline__ void p0_small_transposes(Frame& F) {
    LAS float* scr = (LAS float*)(F.lds + F.wave * 16384);
    const int gw = F.vcu * 8 + F.wave, NGW = F.G * 8;
    constexpr int I_IN = 16 * 144, I_RNN = 16 * 32, I_OUT = 16 * 32, I_GLU = 8 * 64, I_RG = 16 * 8;
    for (int it = gw; it < I_IN + I_RNN + I_OUT + I_GLU + I_RG; it += NGW) { int r = it;
        if (r < I_IN) { const int kb = r / 144, nb = r % 144; transpose_item8(F.in[4], INC, kb * 64, nb * 32, WSP(unsigned char, WS_WIN), 1024, nb * 32, scr, F.lane); continue; } r -= I_IN;
        if (r < I_RNN) { const int kb = r / 32, nb = r % 32; transpose_item8(F.in[13], 1024, kb * 64, nb * 32, WSP(unsigned char, WS_WRNN), 1024, nb * 32, scr, F.lane); continue; } r -= I_RNN;
        if (r < I_OUT) { const int kb = r / 32, nb = r % 32; transpose_item8(F.in[23], 1024, kb * 64, nb * 32, WSP(unsigned char, WS_WOUT), 1024, nb * 32, scr, F.lane); continue; } r -= I_OUT;
        if (r < I_GLU) { const int kb = r / 64, nb = r % 64; transpose_item8(F.in[22], 2048, kb * 64, nb * 32, WSP(unsigned char, WS_WGLU), 512, pair_row(nb * 32), scr, F.lane); continue; } r -= I_GLU;
        { const int mat = r >> 3, kb = (r >> 2) & 1, nb = r & 3, hd = mat & 7, gx = mat >> 3;
          transpose_item(F.in[gx ? 10 : 8] + (size_t)hd * 128 * 128, 128, kb * 64, nb * 32, WSP(bf16, WS_WG), 128, hd * 256 + gx * 128 + nb * 32, scr, F.lane); }
    }
}
__device__ __forceinline__ void p1_hbf(Frame& F) {
    const int gw = F.vcu * 8 + F.wave, NGW = F.G * 8; const float* mod = WSP(float, WS_MOD); bf16* hbf = WSP(bf16, WS_HBF);
    for (int tb = 4 * gw; tb < T; tb += 4 * NGW) {
        const int b = tb >> 12; f32x4 xv[4][4], shv[4], scv[4];
#pragma unroll
        for (int r = 0; r < 4; ++r) { const f32x4* xr = (const f32x4*)(F.in[0] + (size_t)(tb + r) * 1024) + F.lane;
#pragma unroll
            for (int j = 0; j < 4; ++j) xv[r][j] = xr[64 * j]; }
#pragma unroll
        for (int j = 0; j < 4; ++j) { shv[j] = *((const f32x4*)(mod + b * 6144) + F.lane + 64 * j); scv[j] = *((const f32x4*)(mod + b * 6144 + 1024) + F.lane + 64 * j) + 1.0f; }
#pragma unroll
        for (int r = 0; r < 4; ++r) { unsigned* o = (unsigned*)((unsigned char*)hbf + (size_t)(tb + r) * 1024) + F.lane;
#pragma unroll
            for (int j = 0; j < 4; ++j) { const f32x4 v = xv[r][j] * scv[j] + shv[j]; o[64 * j] = pk4_fp8(v[0], v[1], v[2], v[3]); } } }
}
__device__ __forceinline__ void p1_moe_weights(Frame& F) {
    constexpr int TP = 132;
    LAS float* tile = (LAS float*)F.lds;
    constexpr int TILES_GU = 8 * 16, TILES_D = 8 * 8, TILES_E = TILES_GU + TILES_D;
    const int lr = F.tid >> 5, lc4 = (F.tid & 31) * 4, tn = F.tid >> 2, kc = F.tid & 3;
    f32x4 pre[8];
    int ti = F.vcu;
#define P1_SRC(idx, src, N_, dstp, drow0_, k0_) do { const int e_ = (idx) / TILES_E, r_ = (idx) % TILES_E; \
        if (r_ < TILES_GU) { const int kb_ = r_ >> 4, nb_ = r_ & 15; N_ = 2048; src = F.in[28] + (size_t)e_ * 1024 * 2048 + (size_t)(kb_ * 128) * 2048 + nb_ * 128; dstp = WSP(unsigned char, WS_WGU) + (size_t)e_ * 2048 * 1024; drow0_ = pair_row(nb_ * 128); k0_ = kb_ * 128; } \
        else { const int q_ = r_ - TILES_GU, kb_ = q_ >> 3, nb_ = q_ & 7; N_ = 1024; src = F.in[30] + (size_t)e_ * 1024 * 1024 + (size_t)(kb_ * 128) * 1024 + nb_ * 128; dstp = WSP(unsigned char, WS_WD) + (size_t)e_ * 1024 * 1024; drow0_ = nb_ * 128; k0_ = kb_ * 128; } } while (0)
    if (ti < NE * TILES_E) { const float* src; unsigned char* dstp; int N_, d0, k0; P1_SRC(ti, src, N_, dstp, d0, k0);
#pragma unroll
        for (int i = 0; i < 8; ++i) pre[i] = *(const f32x4*)(src + (size_t)(lr + 16 * i) * N_ + lc4); }
    for (; ti < NE * TILES_E; ti += F.G) {
#pragma unroll
        for (int i = 0; i < 8; ++i) *(LAS f32x4*)(tile + (lr + 16 * i) * TP + lc4) = pre[i];
        __syncthreads();
        const int tnx = (ti + F.G < NE * TILES_E) ? ti + F.G : ti;
        { const float* src; unsigned char* dstp; int N_, d0, k0; P1_SRC(tnx, src, N_, dstp, d0, k0);
#pragma unroll
            for (int i = 0; i < 8; ++i) pre[i] = *(const f32x4*)(src + (size_t)(lr + 16 * i) * N_ + lc4); }
        { const float* src; unsigned char* dstp; int N_, d0, k0; P1_SRC(ti, src, N_, dstp, d0, k0); (void)src; (void)N_;
          const LAS float* cp = tile + (32 * kc) * TP + tn; u32x4 o0, o1; float cv[32];
#pragma unroll
          for (int i = 0; i < 32; ++i) cv[i] = cp[i * TP];
          asm volatile("s_waitcnt lgkmcnt(0)" ::: "memory");
#pragma unroll
          for (int i = 0; i < 32; ++i) cv[i] *= 32.f;
          o0.x = pk4_fp8(cv[0], cv[1], cv[2], cv[3]); o0.y = pk4_fp8(cv[4], cv[5], cv[6], cv[7]); o0.z = pk4_fp8(cv[8], cv[9], cv[10], cv[11]); o0.w = pk4_fp8(cv[12], cv[13], cv[14], cv[15]);
          o1.x = pk4_fp8(cv[16], cv[17], cv[18], cv[19]); o1.y = pk4_fp8(cv[20], cv[21], cv[22], cv[23]); o1.z = pk4_fp8(cv[24], cv[25], cv[26], cv[27]); o1.w = pk4_fp8(cv[28], cv[29], cv[30], cv[31]);
          unsigned char* op = dstp + (size_t)(d0 + tn) * 1024 + k0 + 32 * kc; *(u32x4*)op = o0; *(u32x4*)(op + 16) = o1; }
        __syncthreads();
    }
#undef P1_SRC
}
constexpr int XR_LD = 136, XR_TILE = 128 * XR_LD;
__device__ __forceinline__ void rg_issue(const bf16* xrnn, const bf16* gy, int item, int tid, u32x2 (&xraw)[4][4], u32x2 (&graw)[4], bool pass1) {
    const int hd = item & 7, c = (item >> 3) & 31, b = item >> 8, r0 = tid >> 4, ch = hd * 128 + (tid & 15) * 8;
#pragma unroll
    for (int q = 0; q < 4; ++q) { const int r = r0 + 32 * q;
#pragma unroll
        for (int k = 0; k < 4; ++k) { const int tp = c * RGL + r - 3 + k, tpc = tp < 0 ? 0 : tp; xraw[q][k] = *(const u32x2*)((const unsigned char*)xrnn + (size_t)(b * SEQ + tpc) * 1024 + ch); }
        if (pass1) graw[q] = *(const u32x2*)((const unsigned char*)gy + (size_t)(b * SEQ + c * RGL + r) * 1024 + ch); }
}
__device__ __forceinline__ void rg_convwrite(const LAS float* cwl, int item, int tid, const u32x2 (&xraw)[4][4], const u32x2 (&graw)[4], LAS bf16* xr, LAS bf16* gyt, bool pass1) {
    const int c = (item >> 3) & 31, r0 = tid >> 4, c8 = (tid & 15) * 8;
    const f32x4 b0 = *(const LAS f32x4*)(cwl + 4 * 128 + c8), b1 = *(const LAS f32x4*)(cwl + 4 * 128 + c8 + 4);
    f32x4 w0[4], w1[4];
#pragma unroll
    for (int k = 0; k < 4; ++k) { w0[k] = *(const LAS f32x4*)(cwl + k * 128 + c8); w1[k] = *(const LAS f32x4*)(cwl + k * 128 + c8 + 4); }
#pragma unroll
    for (int q = 0; q < 4; ++q) { const int r = r0 + 32 * q; f32x4 a0 = b0, a1 = b1;
#pragma unroll
        for (int k = 0; k < 4; ++k) { const int tp = c * RGL + r - 3 + k; f32x4 x0, x1; unpack8_fp8(xraw[q][k], x0, x1); if (tp < 0) { x0 = (f32x4){0.f, 0.f, 0.f, 0.f}; x1 = x0; } a0 += w0[k] * x0; a1 += w1[k] * x1; }
        *(LAS u32x4*)(xr + r * XR_LD + c8) = pack8(a0, a1);
        if (pass1) { f32x4 ga_, gb_; unpack8_fp8(graw[q], ga_, gb_); *(LAS u32x4*)(gyt + r * XR_LD + c8) = pack8(ga_, gb_); } }
}
template <int PASS>
__device__ __forceinline__ void rglru_phase(Frame& F) {
    const int NIT = NB * RGC * 8;
    const bool skew = (PASS == 0) && (F.G == 256);
    const int nmine = skew ? (F.vcu < 128 ? 7 : 9) : (NIT - F.vcu + F.G - 1) / F.G;
#define RG_ITEM(k) ((skew && (k) >= 7) ? (1792 + (F.vcu - 128) + 128 * ((k) - 7)) : (F.vcu + (k) * F.G))
    if (nmine <= 0) return;
    int it = RG_ITEM(0);
    LAS bf16* xr = (LAS bf16*)F.lds; LAS bf16* gyt0 = xr + XR_TILE;
    const bf16* xrnn = WSP(bf16, WS_XRNN); const bf16* gy = WSP(bf16, WS_GY); bf16* ha = WSP(bf16, WS_HA); const float* cw = F.in[6]; const float* cb = F.in[7];
    const int tid = F.tid, w = F.wave, q = F.lane >> 4, col = F.lane & 15, chl = 16 * w + col;
    u32x2 xraw[4][4], graw[4];
    LAS float* cwl = (LAS float*)(gyt0 + 2 * XR_TILE);
    { const int chh = (it & 7) * 128 + (tid & 127); const float v0 = cw[(tid >> 7) * 1024 + chh], v1 = cb[chh]; cwl[tid] = v0; if (tid < 128) cwl[512 + tid] = v1; }
    rg_issue(xrnn, gy, it, tid, xraw, graw, PASS);
    __syncthreads();
    rg_convwrite(cwl, it, tid, xraw, graw, xr, gyt0, PASS);
    bf16x8 Bf[2][4]; float ba, bx, sp;
    { const int hd0 = it & 7, ch0 = hd0 * 128 + chl; const bf16* wg = WSP(bf16, WS_WG) + (size_t)hd0 * 256 * 128;
#pragma unroll
      for (int gt = 0; gt < 2; ++gt)
#pragma unroll
          for (int kk = 0; kk < 4; ++kk) Bf[gt][kk] = *(const bf16x8*)(wg + (size_t)(gt * 128 + chl) * 128 + kk * 32 + q * 8);
      ba = F.in[9][ch0]; bx = F.in[11][ch0]; const float lam = F.in[12][ch0]; sp = (lam > 15.f) ? __expf(-lam) : log1pf(__expf(-lam)); }
#pragma unroll
    for (int gt = 0; gt < 2; ++gt)
#pragma unroll
        for (int kk = 0; kk < 4; ++kk) asm volatile("" :: "v"(Bf[gt][kk]));
    asm volatile("" :: "v"(ba), "v"(bx), "v"(sp));
    const float spc = -11.541560327f * sp;
    __syncthreads();
    for (int i = 0; i < nmine; ++i) {
        const bool has_next = (i + 1) < nmine; const int nit = has_next ? RG_ITEM(i + 1) : it;
        const int hd = it & 7, c = (it >> 3) & 31, b = it >> 8, t0 = b * SEQ + c * RGL, ch = hd * 128 + chl;
        LAS bf16* gyt = gyt0 + (i & 1) * XR_TILE; LAS bf16* gytn = gyt0 + ((i & 1) ^ 1) * XR_TILE;
        float carryH = 0.f, carryP = 1.f;
        if (PASS) carryH = WSP(float, WS_HIN)[(size_t)(b * RGC + c) * 1024 + ch];
        __builtin_amdgcn_sched_barrier(0);
        rg_issue(xrnn, gy, nit, tid, xraw, graw, PASS);
        __builtin_amdgcn_sched_barrier(0);
        f32x4 acc[8][2];
#pragma unroll
        for (int m = 0; m < 8; ++m) { acc[m][0] = (f32x4){0.f, 0.f, 0.f, 0.f}; acc[m][1] = (f32x4){0.f, 0.f, 0.f, 0.f}; }
#pragma unroll
        for (int kk = 0; kk < 4; ++kk)
#pragma unroll
            for (int m = 0; m < 8; ++m) { const bf16x8 Af = *(const LAS bf16x8*)(xr + (16 * m + col) * XR_LD + kk * 32 + q * 8);
                acc[m][0] = __builtin_amdgcn_mfma_f32_16x16x32_bf16(Af, Bf[0][kk], acc[m][0], 0, 0, 0);
                acc[m][1] = __builtin_amdgcn_mfma_f32_16x16x32_bf16(Af, Bf[1][kk], acc[m][1], 0, 0, 0); }
#pragma unroll
        for (int m = 0; m < 8; ++m) {
            f32x4 a, uu;
            { const LAS bf16* xp = xr + (16 * m + 4 * q) * XR_LD + chl; const f32x4 xv = {bf1(xp[0]), bf1(xp[XR_LD]), bf1(xp[2 * XR_LD]), bf1(xp[3 * XR_LD])};
              const f32x4 r = sigmoid_v(acc[m][0] + ba), ii = sigmoid_v(acc[m][1] + bx);
              a = exp2_v(r * spc); f32x4 om = 1.0f - a * a;
#pragma unroll
              for (int j = 0; j < 4; ++j) om[j] = __builtin_amdgcn_sqrtf(fmaxf(om[j], 0.f));
              uu = om * ii * xv; }
            float sP = a[0], sH = uu[0];
#pragma unroll
            for (int j = 1; j < 4; ++j) { sH = a[j] * sH + uu[j]; sP *= a[j]; }
            float iP = sP, iH = sH;
            { const float pP = __shfl_up(iP, 16), pH = __shfl_up(iH, 16); if (q >= 1) { iH = iP * pH + iH; iP = iP * pP; } }
            { const float pP = __shfl_up(iP, 32), pH = __shfl_up(iH, 32); if (q >= 2) { iH = iP * pH + iH; iP = iP * pP; } }
            float eP = __shfl_up(iP, 16), eH = __shfl_up(iH, 16); if (q == 0) { eP = 1.f; eH = 0.f; }
            const float tP = __shfl(iP, col + 48), tH = __shfl(iH, col + 48);
            if (PASS) { float h = eP * carryH + eH;
#pragma unroll
                for (int j = 0; j < 4; ++j) { const int tl = 16 * m + 4 * q + j; h = a[j] * h + uu[j]; LAS bf16* gp = gyt + tl * XR_LD + chl; *gp = (bf16)f2bf(h * bf1(*gp)); } }
            carryH = tP * carryH + tH; carryP *= tP;
        }
        if (!PASS && q == 0) { f32x2* ag = WSP(f32x2, WS_RGAGG); ag[(size_t)(b * RGC + c) * 1024 + ch] = (f32x2){carryP, carryH}; }
        __syncthreads();
        if (PASS) { const int r0 = tid >> 4, c8 = (tid & 15) * 8;
#pragma unroll
            for (int qq = 0; qq < 4; ++qq) { const int r = r0 + 32 * qq; f32x4 h0, h1; unpack8(*(const LAS u32x4*)(gyt + r * XR_LD + c8), h0, h1); u32x2 w8; w8.x = pk4_fp8(h0[0], h0[1], h0[2], h0[3]); w8.y = pk4_fp8(h1[0], h1[1], h1[2], h1[3]);
                *(u32x2*)((unsigned char*)ha + (size_t)(t0 + r) * 1024 + hd * 128 + c8) = w8; } }
#pragma unroll
        for (int qq = 0; qq < 4; ++qq) {
#pragma unroll
            for (int k = 0; k < 4; ++k) asm volatile("" : "+v"(xraw[qq][k]));
            if (PASS) asm volatile("" : "+v"(graw[qq])); }
        if (has_next) rg_convwrite(cwl, nit, tid, xraw, graw, xr, gytn, PASS);
        __syncthreads();
        it = nit;
    }
#undef RG_ITEM
}
__device__ __forceinline__ void p4_carries(Frame& F) {
    LAS f32x2* seg = (LAS f32x2*)F.lds;
    for (int job = F.vcu; job < NB * S5G; job += F.G) {
        const int b = job >> 5, g = job & 31, p = F.lane, w = F.wave;
        const f32x2 al = WSP(f32x2, WS_AL)[g * 64 + p];
        const f32x2* Sb = WSP(f32x2, WS_S) + ((size_t)(g * S5M + b * S5CPB + 16 * w)) * 64 + p; unsigned* ac = (unsigned*)(WSP(bf16, WS_ACAT) + ((size_t)(g * S5M + b * S5CPB + 16 * w)) * S5ROW) + p;
        f32x2 sv[16];
#pragma unroll
        for (int i = 0; i < 16; ++i) sv[i] = Sb[(size_t)i * 64];
        float xr_ = 0.f, xi = 0.f;
#pragma unroll
        for (int i = 0; i < 16; ++i) { const float nr = al.x * xr_ - al.y * xi + sv[i].x, ni = al.x * xi + al.y * xr_ + sv[i].y; xr_ = nr; xi = ni; }
        seg[w * 64 + p] = (f32x2){xr_, xi};
        float ar = al.x, ai = al.y;
#pragma unroll
        for (int q = 0; q < 4; ++q) { const float nr = ar * ar - ai * ai, ni = 2.f * ar * ai; ar = nr; ai = ni; }
        __syncthreads();
        xr_ = 0.f; xi = 0.f;
        for (int ww = 0; ww < w; ++ww) { const f32x2 sg = seg[ww * 64 + p]; const float nr = ar * xr_ - ai * xi + sg.x, ni = ar * xi + ai * xr_ + sg.y; xr_ = nr; xi = ni; }
#pragma unroll
        for (int i = 0; i < 16; ++i) { ac[(size_t)i * (S5ROW / 2)] = pk2(xr_, xi); const float nr = al.x * xr_ - al.y * xi + sv[i].x, ni = al.x * xi + al.y * xr_ + sv[i].y; xr_ = nr; xi = ni; }
        __syncthreads();
    }
    if (F.vcu < 16) {
        const int id = F.vcu * 512 + F.tid, ch = id & 1023, b = id >> 10; const f32x2* ag = WSP(f32x2, WS_RGAGG) + (size_t)b * RGC * 1024 + ch; float* hin = WSP(float, WS_HIN) + (size_t)b * RGC * 1024 + ch;
        f32x2 a[RGC];
#pragma unroll
        for (int c = 0; c < RGC; ++c) a[c] = ag[(size_t)c * 1024];
        float h = 0.f;
#pragma unroll
        for (int c = 0; c < RGC; ++c) { hin[(size_t)c * 1024] = h; h = a[c].x * h + a[c].y; }
    }
}
constexpr int WR_LD = 1032;
__device__ __forceinline__ void p9_router(Frame& F) {
    LAS bf16* wH = (LAS bf16*)F.lds; LAS bf16* wL = wH + 32 * WR_LD;
    LAS f32x2* sel = (LAS f32x2*)(wL + 32 * WR_LD);
    LAS unsigned* rec = (LAS unsigned*)(sel + 512);
    LAS float* recp = (LAS float*)(rec + 512);
    LAS int* lcnt = (LAS int*)(recp + 512);
    LAS int* gbase = lcnt + 32;
    { const u32x4* img = WSP(u32x4, WS_WRIMG); LAS u32x4* dst = (LAS u32x4*)wH;
      constexpr int NV = 2 * 32 * WR_LD * 2 / 16, NK = (NV + 511) / 512; u32x4 tv[NK];
#pragma unroll
      for (int k = 0; k < NK; ++k) { const int i = F.tid + 512 * k; tv[k] = img[i < NV ? i : NV - 1]; }
#pragma unroll
      for (int k = 0; k < NK; ++k) { const int i = F.tid + 512 * k; if (i < NV) dst[i] = tv[k]; } }
    if (F.tid < 32) lcnt[F.tid] = 0;
    __syncthreads();
    const float* mod = WSP(float, WS_MOD); const bf16* v1 = WSP(bf16, WS_V1); bf16* x1 = WSP(bf16, WS_X1); unsigned char* h2 = WSP(unsigned char, WS_H2);
    const int lane = F.lane, m = lane & 15, kq = lane >> 4, w = F.wave;
    for (int blk = F.vcu; blk < T / 128; blk += F.G) {
        const int t = blk * 128 + w * 16 + m, b = (blk * 128) >> 12;
        const bf16* vrow = v1 + (size_t)t * 1024 + 8 * kq;
        float sum = 0.f, sq = 0.f;
#pragma unroll 32
        for (int s_ = 0; s_ < 32; ++s_) { f32x4 a, c; unpack8(*(const u32x4*)(vrow + 32 * s_), a, c); sum += ((a[0] + a[1]) + (a[2] + a[3])) + ((c[0] + c[1]) + (c[2] + c[3]));
            sq += ((a[0] * a[0] + a[1] * a[1]) + (a[2] * a[2] + a[3] * a[3])) + ((c[0] * c[0] + c[1] * c[1]) + (c[2] * c[2] + c[3] * c[3])); }
        sum += __shfl_xor(sum, 16); sum += __shfl_xor(sum, 32); sq += __shfl_xor(sq, 16); sq += __shfl_xor(sq, 32);
        const float mean = sum * (1.f / 1024.f); const float rstd = 1.f / sqrtf(fmaxf(sq * (1.f / 1024.f) - mean * mean, 0.f) + LN_EPS);
        f32x4 acc[2] = {(f32x4){0.f, 0.f, 0.f, 0.f}, (f32x4){0.f, 0.f, 0.f, 0.f}};
        const float* lng = F.in[24] + 8 * kq; const float* lnb = F.in[25] + 8 * kq; const float* shp = mod + b * 6144 + 3072 + 8 * kq; const float* scp = mod + b * 6144 + 4096 + 8 * kq;
        bf16* x1row = x1 + (size_t)t * 1024 + 8 * kq; unsigned char* h2row = h2 + (size_t)t * 1024 + 8 * kq;
        const LAS bf16* wHr = wH + m * WR_LD + 8 * kq; const LAS bf16* wLr = wL + m * WR_LD + 8 * kq;
        u32x4 rw[2][2]; f32x4 pg[2][2][2], pb[2][2][2], psh[2][2][2], psc[2][2][2];
#define P9_LOAD(SET, s2_) do { _Pragma("unroll") for (int h = 0; h < 2; ++h) { const int ko = 32 * ((s2_) + h); rw[SET][h] = *(const u32x4*)(vrow + ko); \
                pg[SET][h][0] = *(const f32x4*)(lng + ko); pg[SET][h][1] = *(const f32x4*)(lng + ko + 4); pb[SET][h][0] = *(const f32x4*)(lnb + ko); pb[SET][h][1] = *(const f32x4*)(lnb + ko + 4); \
                psh[SET][h][0] = *(const f32x4*)(shp + ko); psh[SET][h][1] = *(const f32x4*)(shp + ko + 4); psc[SET][h][0] = *(const f32x4*)(scp + ko); psc[SET][h][1] = *(const f32x4*)(scp + ko + 4); } } while (0)
#define P9_COMP(SET, s2_) do { _Pragma("unroll") for (int h = 0; h < 2; ++h) { const int ko = 32 * ((s2_) + h); \
                f32x4 a, c; unpack8(rw[SET][h], a, c); \
                const f32x4 x0 = (a - mean) * rstd * pg[SET][h][0] + pb[SET][h][0], x1v = (c - mean) * rstd * pg[SET][h][1] + pb[SET][h][1]; \
                *(u32x4*)(x1row + ko) = pack8(x0, x1v); \
                const f32x4 h0 = x0 * (psc[SET][h][0] + 1.0f) + psh[SET][h][0], h1 = x1v * (psc[SET][h][1] + 1.0f) + psh[SET][h][1]; \
                u32x2 w8; w8.x = pk4_fp8(h0[0], h0[1], h0[2], h0[3]); w8.y = pk4_fp8(h1[0], h1[1], h1[2], h1[3]); *(u32x2*)(h2row + ko) = w8; \
                const u32x4 hi = pack8(h0, h1); f32x4 r0, r1; unpack8(hi, r0, r1); const u32x4 lo = pack8(h0 - r0, h1 - r1); \
                const bf16x8 ah = __builtin_bit_cast(bf16x8, hi), al = __builtin_bit_cast(bf16x8, lo); \
                _Pragma("unroll") for (int nf = 0; nf < 2; ++nf) { const bf16x8 bh = *(const LAS bf16x8*)(wHr + nf * 16 * WR_LD + ko), bl = *(const LAS bf16x8*)(wLr + nf * 16 * WR_LD + ko); \
                    acc[nf] = __builtin_amdgcn_mfma_f32_16x16x32_bf16(bh, ah, acc[nf], 0, 0, 0); \
                    acc[nf] = __builtin_amdgcn_mfma_f32_16x16x32_bf16(bl, ah, acc[nf], 0, 0, 0); \
                    acc[nf] = __builtin_amdgcn_mfma_f32_16x16x32_bf16(bh, al, acc[nf], 0, 0, 0); } } } while (0)
        P9_LOAD(0, 0);
        for (int s2 = 0; s2 < 32; s2 += 4) {
            P9_LOAD(1, s2 + 2);
            __builtin_amdgcn_sched_barrier(0);
            P9_COMP(0, s2);
            __builtin_amdgcn_sched_barrier(0);
            { const int sn = (s2 + 4 < 32) ? s2 + 4 : 28; P9_LOAD(0, sn); }
            __builtin_amdgcn_sched_barrier(0);
            P9_COMP(1, s2 + 2);
            __builtin_amdgcn_sched_barrier(0);
        }
#undef P9_LOAD
#undef P9_COMP
        float lv[8];
#pragma unroll
        for (int nf = 0; nf < 2; ++nf)
#pragma unroll
            for (int j = 0; j < 4; ++j) lv[nf * 4 + j] = acc[nf][j] + F.in[27][nf * 16 + 4 * kq + j];
        int rank[8];
#pragma unroll
        for (int i = 0; i < 8; ++i) { rank[i] = 0;
#pragma unroll
            for (int i2 = 0; i2 < 8; ++i2) if (i2 != i) { const int e1 = (i >> 2) * 16 + 4 * kq + (i & 3), e2 = (i2 >> 2) * 16 + 4 * kq + (i2 & 3); rank[i] += (lv[i2] > lv[i] || (lv[i2] == lv[i] && e2 < e1)) ? 1 : 0; } }
#pragma unroll
        for (int dq = 1; dq < 4; ++dq) { const int q2 = kq ^ dq;
#pragma unroll
            for (int i2 = 0; i2 < 8; ++i2) { const float o = __shfl_xor(lv[i2], 16 * dq); const int e2 = (i2 >> 2) * 16 + 4 * q2 + (i2 & 3);
#pragma unroll
                for (int i = 0; i < 8; ++i) { const int e1 = (i >> 2) * 16 + 4 * kq + (i & 3); rank[i] += (o > lv[i] || (o == lv[i] && e2 < e1)) ? 1 : 0; } } }
#pragma unroll
        for (int i = 0; i < 8; ++i) if (rank[i] < 4) { const int e1 = (i >> 2) * 16 + 4 * kq + (i & 3); sel[(w * 16 + m) * 4 + rank[i]] = (f32x2){__builtin_bit_cast(float, e1), lv[i]}; }
        asm volatile("s_waitcnt lgkmcnt(0)" ::: "memory");
        { const int tm = lane >> 2, k = lane & 3; const f32x2 s0 = sel[(w * 16 + tm) * 4 + 0], s1 = sel[(w * 16 + tm) * 4 + 1], s2 = sel[(w * 16 + tm) * 4 + 2], s3 = sel[(w * 16 + tm) * 4 + 3];
          const float p0 = 1.f, p1 = __expf(s1.y - s0.y), p2 = __expf(s2.y - s0.y), p3 = __expf(s3.y - s0.y), ps = (p0 + p1) + (p2 + p3);
          const f32x2 mine = k == 0 ? s0 : (k == 1 ? s1 : (k == 2 ? s2 : s3)); const float pm = (k == 0 ? p0 : (k == 1 ? p1 : (k == 2 ? p2 : p3))) / ps;
          const int e = __builtin_bit_cast(int, mine.x);
          const int lr = __hip_atomic_fetch_add(lcnt + e, 1, __ATOMIC_RELAXED, __HIP_MEMORY_SCOPE_WORKGROUP);
          rec[(w * 16 + tm) * 4 + k] = ((unsigned)e << 16) | (unsigned)lr; recp[(w * 16 + tm) * 4 + k] = pm; }
        __syncthreads();
        if (F.tid < 32) { const int n = lcnt[F.tid]; gbase[F.tid] = n ? (int)atomicAdd(F.ctl + CW_CNT + 64 * F.tid, (unsigned)n) : 0; lcnt[F.tid] = 0; }
        __syncthreads();
        { const unsigned r = rec[F.tid]; const int e = r >> 16, rk = gbase[e] + (int)(r & 0xffffu), tt = blk * 128 + (F.tid >> 2);
          WSP(int, WS_TOK)[(size_t)e * T + rk] = tt; WSP(unsigned, WS_POS)[(size_t)tt * 4 + (F.tid & 3)] = ((unsigned)e << 20) | (unsigned)rk; WSP(float, WS_PROB)[(size_t)tt * 4 + (F.tid & 3)] = recp[F.tid]; }
        __syncthreads();
    }
}
__device__ __forceinline__ void p12_final(Frame& F) {
    moe_tables(F);
    const LAS int* tstart = (const LAS int*)(F.lds + TAB_OFF);
    const float* mod = WSP(float, WS_MOD); const bf16* x1 = WSP(bf16, WS_X1); const bf16* yb = WSP(bf16, WS_YB); const unsigned* pos = WSP(unsigned, WS_POS); const float* prob = WSP(float, WS_PROB);
    const int lane = F.lane, gw = F.vcu * 8 + F.wave, NGW = F.G * 8;
    f32x4 lg[4], lb[4];
#pragma unroll
    for (int j = 0; j < 4; ++j) { lg[j] = *(const f32x4*)(F.in[32] + 512 * (j >> 1) + 8 * lane + 4 * (j & 1)); lb[j] = *(const f32x4*)(F.in[33] + 512 * (j >> 1) + 8 * lane + 4 * (j & 1)); }
#define P12_ROUTE(PP, PW, tt) do { const u32x4 p4_ = *(const u32x4*)(pos + (size_t)(tt) * 4); const f32x4 w4_ = *(const f32x4*)(prob + (size_t)(tt) * 4); \
        PP[0] = p4_.x; PP[1] = p4_.y; PP[2] = p4_.z; PP[3] = p4_.w; PW[0] = w4_[0]; PW[1] = w4_[1]; PW[2] = w4_[2]; PW[3] = w4_[3]; } while (0)
#define P12_ROWS(YW, XW, PP, tt) do { _Pragma("unroll") for (int k = 0; k < 4; ++k) { const int e_ = PP[k] >> 20, rk_ = PP[k] & 0xfffffu; const size_t slot_ = (size_t)tstart[e_] * 256 + rk_; \
            _Pragma("unroll") for (int j = 0; j < 2; ++j) YW[k][j] = *((const u32x2*)((const unsigned char*)yb + slot_ * 1024) + 64 * j + lane); } \
        _Pragma("unroll") for (int j = 0; j < 2; ++j) XW[j] = *((const u32x4*)(x1 + (size_t)(tt) * 1024) + 64 * j + lane); } while (0)
#define P12_COMPUTE(YW, XW, PW, tt) do { const int b_ = (tt) >> 12; f32x4 v[4]; float s_ = 0.f; \
        _Pragma("unroll") for (int j = 0; j < 2; ++j) { f32x4 f0 = (f32x4){0.f, 0.f, 0.f, 0.f}, f1 = f0; \
            _Pragma("unroll") for (int k = 0; k < 4; ++k) { const u32x2 yv_ = YW[k][j]; const f32x2 q0_ = __builtin_amdgcn_cvt_pk_f32_fp8((int)yv_.x, false), q1_ = __builtin_amdgcn_cvt_pk_f32_fp8((int)yv_.x, true), q2_ = __builtin_amdgcn_cvt_pk_f32_fp8((int)yv_.y, false), q3_ = __builtin_amdgcn_cvt_pk_f32_fp8((int)yv_.y, true); \
                f0 += (f32x4){q0_.x, q0_.y, q1_.x, q1_.y} * PW[k]; f1 += (f32x4){q2_.x, q2_.y, q3_.x, q3_.y} * PW[k]; } \
            f32x4 xa_, xc_; unpack8(XW[j], xa_, xc_); const float* gp_ = mod + b_ * 6144 + 5120 + 512 * j + 8 * lane; \
            v[2 * j] = xa_ * DN_ALPHA + (*(const f32x4*)gp_ + 1.0f) * f0; v[2 * j + 1] = xc_ * DN_ALPHA + (*(const f32x4*)(gp_ + 4) + 1.0f) * f1; \
            s_ += ((v[2 * j][0] + v[2 * j][1]) + (v[2 * j][2] + v[2 * j][3])) + ((v[2 * j + 1][0] + v[2 * j + 1][1]) + (v[2 * j + 1][2] + v[2 * j + 1][3])); } \
        const float mean_ = wave_sum(s_) * (1.f / 1024.f); float s2_ = 0.f; \
        _Pragma("unroll") for (int j = 0; j < 4; ++j) { v[j] = v[j] - mean_; s2_ += (v[j][0] * v[j][0] + v[j][1] * v[j][1]) + (v[j][2] * v[j][2] + v[j][3] * v[j][3]); } \
        const float rstd_ = 1.f / sqrtf(wave_sum(s2_) * (1.f / 1024.f) + LN_EPS); \
        _Pragma("unroll") for (int j = 0; j < 4; ++j) *(f32x4*)(F.out + (size_t)(tt) * 1024 + 512 * (j >> 1) + 8 * lane + 4 * (j & 1)) = v[j] * rstd_ * lg[j] + lb[j]; } while (0)
    const int nmine = (T - gw + NGW - 1) / NGW;
    unsigned ppA[4], ppB[4]; float pwA[4], pwB[4], pwN[4]; u32x2 ywA[4][2], ywB[4][2]; u32x4 xwA[2], xwB[2];
    if (nmine > 0) { P12_ROUTE(ppA, pwA, gw); P12_ROWS(ywA, xwA, ppA, gw); }
    if (nmine > 1) { P12_ROUTE(ppB, pwB, gw + NGW); }
    for (int i = 0; i < nmine; i += 2) {
        const int t0 = gw + i * NGW, t1 = t0 + NGW, t2 = t1 + NGW, t3 = t2 + NGW;
        if (i + 1 < nmine) { P12_ROWS(ywB, xwB, ppB, t1); }
        if (i + 2 < nmine) { P12_ROUTE(ppA, pwN, t2); }
        __builtin_amdgcn_sched_barrier(0);
        P12_COMPUTE(ywA, xwA, pwA, t0);
        if (i + 1 < nmine) {
#pragma unroll
            for (int k = 0; k < 4; ++k) pwA[k] = pwN[k];
            if (i + 2 < nmine) { P12_ROWS(ywA, xwA, ppA, t2); }
            if (i + 3 < nmine) { P12_ROUTE(ppB, pwN, t3); }
            __builtin_amdgcn_sched_barrier(0);
            P12_COMPUTE(ywB, xwB, pwB, t1);
#pragma unroll
            for (int k = 0; k < 4; ++k) pwB[k] = pwN[k];
        }
    }
#undef P12_ROUTE
#undef P12_ROWS
#undef P12_COMPUTE
}

__device__ __forceinline__ void wg_publish(Frame& F, int word) {
    asm volatile("s_waitcnt vmcnt(0)" ::: "memory"); __syncthreads();
    if (F.tid == 0) { __builtin_amdgcn_fence(__ATOMIC_RELEASE, "agent"); asm volatile("s_waitcnt vmcnt(0)" ::: "memory"); __hip_atomic_fetch_add(F.ctl + word, 1u, __ATOMIC_RELAXED, __HIP_MEMORY_SCOPE_AGENT); }
}
__device__ __forceinline__ void wg_wait(Frame& F, int word, unsigned need) {
    if (F.tid < 64) { unsigned sp_ = 0;
        while ((unsigned)__builtin_amdgcn_readfirstlane(__hip_atomic_load(F.ctl + word, __ATOMIC_RELAXED, __HIP_MEMORY_SCOPE_AGENT)) < need) { __builtin_amdgcn_s_sleep(2);
            if (++sp_ > (1u << 20)) { if (F.tid == 0) atomicAdd(F.ctl + CW_BAR + XB_TMO, 1u); break; } }
        __builtin_amdgcn_fence(__ATOMIC_ACQUIRE, "agent"); asm volatile("s_waitcnt vmcnt(0)" ::: "memory"); }
    __syncthreads();
}
struct Args { const float* in[34]; float* out; unsigned char* ws; int ph_lo, ph_hi; };
__global__ void __launch_bounds__(512, 2) fwd_kernel(Args args) {
    extern __shared__ __attribute__((aligned(16))) unsigned char lds_raw[];
    Frame F;
    F.lds = (LAS unsigned char*)lds_raw; F.MISC = (volatile LAS unsigned*)(F.lds + MISC_OFF);
    F.tid = threadIdx.x; F.lane = F.tid & 63; F.wave = __builtin_amdgcn_readfirstlane(F.tid >> 6);
    F.G = gridDim.x; { const int bx = blockIdx.x; F.vcu = (F.G % 8 == 0) ? (bx % 8) * (F.G / 8) + bx / 8 : bx; }
#pragma unroll
    for (int i = 0; i < 34; ++i) F.in[i] = args.in[i];
    F.out = args.out; F.ws = args.ws; F.ctl = (unsigned*)(args.ws + WS_CTL);
    if (F.tid < 64) F.MISC[F.tid] = 0u;
    __syncthreads();
    XcdBarrier bar; bar.bar = F.ctl + CW_BAR; bar.x = 0; bar.st = nullptr;
    if (MK_N_LAUNCHES == 1) bar = xcd_barrier_post(F.ctl + CW_BAR, F.MISC + 8);
    const int lo = args.ph_lo, hi = args.ph_hi;
#define IN(k) (lo <= (k) && (k) < hi)
#define SEAM(k) do { if (IN(k) && IN((k) + 1)) xcd_barrier(bar); } while (0)

    if (IN(0)) REPS(0) { if (rep_) xcd_barrier(bar);
        for (int j = F.vcu; j < 192; j += F.G) p0_mod_job(F, j);
        for (int j = F.vcu; j < S5G * 8; j += F.G) p0_s5k_job(F, j);
        { bf16* img = WSP(bf16, WS_WRIMG); const float* wr = F.in[26];
          for (int i = F.vcu * 512 + F.tid; i < 1024 * 32; i += F.G * 512) { const float w = wr[i]; const unsigned hb = f2bf(w); const float hf = __builtin_bit_cast(float, hb << 16);
              img[(i & 31) * 1032 + (i >> 5)] = (bf16)hb; img[32 * 1032 + (i & 31) * 1032 + (i >> 5)] = (bf16)f2bf(w - hf); } }
        p0_small_transposes(F);
    }
    const bool chain01 = IN(0) && IN(1);
    if (chain01) wg_publish(F, CW_P0DONE); else SEAM(0);
    if (IN(1)) REPS(1) { if (rep_) xcd_barrier(bar);
        p1_moe_weights(F);
        if (chain01) wg_wait(F, CW_P0DONE, (unsigned)F.G);
        for (int j = F.vcu; j < S5G * 8; j += F.G) p1_s5w_job(F, j);
        p1_hbf(F); }
    SEAM(1);
    if (IN(2)) REPS(2) { if (rep_) xcd_barrier(bar);
        g8::GridOrder S; S.init(T, INC, F.G, (int)blockIdx.x, WSP(bf16, WS_HBF), WSP(bf16, WS_WIN), 1024, 1024);
        EpiInProj E{F.in[5], WSP(bf16, WS_XRNN), WSP(bf16, WS_GY), WSP(bf16, WS_ACAT), WSP(bf16, WS_GATES)};
        g8::gemm_phase<EpiInProj, g8::GridOrder, false, true>(F.lds, 1024, 1024, 1024, S, E);
    }
    SEAM(2);
    if (IN(3)) REPS(3) { if (rep_) xcd_barrier(bar);
        { S5AOrder S{F.G, F.vcu, (const char*)WSP(bf16, WS_ACAT), (const char*)WSP(bf16, WS_WS)}; EpiS5A E{WSP(float, WS_S)};
          g8::gemm_phase<EpiS5A, S5AOrder, false>(F.lds, S5L * 32, S5ROW * 2, S5L * 32, S, E); }
        __syncthreads();
        rglru_phase<0>(F);
    }
    SEAM(3);
    if (IN(4)) REPS(4) { if (rep_) xcd_barrier(bar); p4_carries(F); }
    SEAM(4);
    if (IN(5)) REPS(5) { if (rep_) xcd_barrier(bar);
        { S5COrder S{F.G, F.vcu, (const char*)WSP(bf16, WS_ACAT), (const char*)WSP(bf16, WS_WY)}; EpiS5C E{WSP(bf16, WS_YS)};
          g8::gemm_phase<EpiS5C, S5COrder, false>(F.lds, S5ROW * 2, S5ROW * 2, S5ROW * 2, S, E); }
        if (IN(6)) wg_publish(F, CW_S5CDONE);
        __syncthreads();
        rglru_phase<1>(F);
    }
    if (IN(5) && IN(6)) wg_wait(F, CW_S5CDONE, (unsigned)F.G); else SEAM(5);
    if (IN(6)) REPS(6) { if (rep_) xcd_barrier(bar);
        g8::GridOrder S; S.init(T, 2048, F.G, (int)blockIdx.x, WSP(bf16, WS_YS), WSP(bf16, WS_WGLU), 512, 512);
        EpiGlu E{WSP(bf16, WS_GATES), WSP(bf16, WS_GB)};
        g8::gemm_phase<EpiGlu, g8::GridOrder, false, true>(F.lds, 512, 512, 512, S, E);
    }
    SEAM(6);
    if (IN(7)) REPS(7) { if (rep_) xcd_barrier(bar);
        g8::GridOrder S; S.init(T, 1024, F.G, (int)blockIdx.x, WSP(bf16, WS_HA), WSP(bf16, WS_WRNN), 1024, 1024);
        EpiRnn E{WSP(bf16, WS_GATES), WSP(bf16, WS_GB), WSP(bf16, WS_MERGED)};
        g8::gemm_phase<EpiRnn, g8::GridOrder, false, true>(F.lds, 1024, 1024, 1024, S, E);
    }
    SEAM(7);
    if (IN(8)) REPS(8) { if (rep_) xcd_barrier(bar);
        g8::GridOrder S; S.init(T, 1024, F.G, (int)blockIdx.x, WSP(bf16, WS_MERGED), WSP(bf16, WS_WOUT), 1024, 1024);
        EpiOut E{F.in[0], WSP(float, WS_MOD), WSP(bf16, WS_V1)};
        g8::gemm_phase<EpiOut, g8::GridOrder, false, true>(F.lds, 1024, 1024, 1024, S, E);
    }
    SEAM(8);
    if (IN(9)) REPS(9) { if (rep_) xcd_barrier(bar); p9_router(F); }
    SEAM(9);
    if (IN(10)) REPS(10) { if (rep_) xcd_barrier(bar);
        moe_tables(F);
        const LAS int* tstart = (const LAS int*)(F.lds + TAB_OFF);
        MoeOrder S{F.G, (int)blockIdx.x, 8, tstart[NE], tstart, tstart + 40, WSP(int, WS_TOK), (const char*)WSP(bf16, WS_H2), (const char*)WSP(bf16, WS_WGU), (size_t)2048 * 1024, 1024, true};
        EpiMoe1 E{F.in[29], WSP(bf16, WS_ACT)};
        g8::gemm_phase<EpiMoe1, MoeOrder, true, true>(F.lds, 1024, 1024, 1024, S, E);
    }
    SEAM(10);
    if (IN(11)) REPS(11) { if (rep_) xcd_barrier(bar);
        moe_tables(F);
        const LAS int* tstart = (const LAS int*)(F.lds + TAB_OFF);
        MoeOrder S{F.G, (int)blockIdx.x, 4, tstart[NE], tstart, tstart + 40, WSP(int, WS_TOK), (const char*)WSP(bf16, WS_ACT), (const char*)WSP(bf16, WS_WD), (size_t)1024 * 1024, 1024, false};
        EpiMoe2 E{F.in[31], WSP(bf16, WS_YB)};
        g8::gemm_phase<EpiMoe2, MoeOrder, false, true>(F.lds, 1024, 1024, 1024, S, E);
    }
    SEAM(11);
    if (IN(12)) REPS(12) { if (rep_) xcd_barrier(bar); p12_final(F); }
#undef IN
#undef SEAM
}

extern "C" void kernel_launch(void* const* d_in, const int* in_sizes, int n_in, void* d_out, int out_size, void* d_ws, size_t ws_size, hipStream_t stream) {
    static int grid = 0;
    if (grid == 0) {
        if (n_in != 34 || in_sizes[0] != T * D || out_size != T * D || ws_size < WS_END) { fprintf(stderr, "kernel_launch: unexpected shapes (n_in %d, ws %zu < %zu)\n", n_in, ws_size, (size_t)WS_END); grid = -1; return; }
        int dev = 0, cus = 0;
        if (hipGetDevice(&dev) != hipSuccess || hipDeviceGetAttribute(&cus, hipDeviceAttributeMultiprocessorCount, dev) != hipSuccess) { grid = -1; return; }
        if (hipFuncSetAttribute((const void*)fwd_kernel, hipFuncAttributeMaxDynamicSharedMemorySize, LDS_BYTES) != hipSuccess) { fprintf(stderr, "kernel_launch: hipFuncSetAttribute failed\n"); grid = -1; return; }
        int per_cu = 0; (void)hipOccupancyMaxActiveBlocksPerMultiprocessor(&per_cu, (const void*)fwd_kernel, 512, LDS_BYTES); (void)hipGetLastError();
        grid = cus;
    }
    if (grid < 0) return;
    (void)hipMemsetAsync((char*)d_ws + WS_CTL, 0, CTL_BYTES, stream);
    Args a{};
    for (int i = 0; i < 34; ++i) a.in[i] = (const float*)d_in[i];
    a.out = (float*)d_out; a.ws = (unsigned char*)d_ws;
    if (MK_N_LAUNCHES == 1) { a.ph_lo = 0; a.ph_hi = N_PHASES; hipLaunchKernelGGL(fwd_kernel, dim3(grid), dim3(512), LDS_BYTES, stream, a); }
    else for (int p = 0; p < N_PHASES; ++p) { a.ph_lo = p; a.ph_hi = p + 1; hipLaunchKernelGGL(fwd_kernel, dim3(grid), dim3(512), LDS_BYTES, stream, a); }
}
```

```cpp
#include <hip/hip_runtime.h>
#include <cstdio>
#include <cstdint>

#ifndef MK_N_LAUNCHES
#define MK_N_LAUNCHES 1
#endif
constexpr int N_PHASES = 13;
#ifndef DUP_PHASE
#define DUP_PHASE -1
#endif
#define REPS(k) for (int rep_ = 0; rep_ < ((DUP_PHASE == (k)) ? 2 : 1); ++rep_)

#define GAS __attribute__((address_space(1)))
#define LAS __attribute__((address_space(3)))
typedef unsigned short bf16;
typedef short bf16x8 __attribute__((ext_vector_type(8)));
typedef float f32x4 __attribute__((ext_vector_type(4)));
typedef float f32x2 __attribute__((ext_vector_type(2)));
typedef unsigned u32x4 __attribute__((ext_vector_type(4)));
typedef unsigned u32x2 __attribute__((ext_vector_type(2)));
typedef GAS unsigned gu32;

constexpr int NB = 8, SEQ = 4096, T = NB * SEQ, D = 1024, INC = 4608, NE = 32, DFF = 1024;
constexpr int S5L = 32, S5G = 32, S5ROW = 128 + S5L * 16  , S5M = T / S5L  , S5CPB = SEQ / S5L  ;
constexpr int RGL = 128, RGC = SEQ / RGL  ;
constexpr float LN_EPS = 1e-5f, DN_ALPHA = 1.189207115002721f;
constexpr int ACT_ROWS = T * 4 + NE * 256;

constexpr size_t MiB = 1u << 20;
constexpr size_t WS_XRNN = 0, WS_GY = 64 * MiB, WS_GATES = 128 * MiB, WS_V1 = 0, WS_ACT = 0;
constexpr size_t WS_HBF = 272 * MiB, WS_HA = 272 * MiB, WS_YS = 336 * MiB, WS_GB = 368 * MiB, WS_MERGED = 432 * MiB, WS_ACAT = 496 * MiB, WS_YB = 272 * MiB;
constexpr size_t WS_X1 = 544 * MiB, WS_H2 = 608 * MiB;
constexpr size_t WS_LU = 544 * MiB;
constexpr size_t WS_WGU = 672 * MiB, WS_WD = 800 * MiB, WS_WIN = 864 * MiB, WS_WG = 873 * MiB, WS_WRNN = 874 * MiB, WS_WGLU = 876 * MiB, WS_WOUT = 878 * MiB;
constexpr size_t WS_WS = 880 * MiB, WS_WY = 888 * MiB, WS_S = 908 * MiB;
constexpr size_t WS_MOD = 924 * MiB, WS_AL = 925 * MiB, WS_RGAGG = 926 * MiB, WS_HIN = 928 * MiB, WS_TOK = 929 * MiB, WS_POS = 933 * MiB, WS_PROB = 934 * MiB, WS_CTL = 935 * MiB;
constexpr size_t WS_END = 936 * MiB, CTL_BYTES = 1 * MiB;
static_assert((size_t)ACT_ROWS * DFF * 2 <= 272 * MiB, "act/yb size");
static_assert(WS_ACAT + (size_t)S5G * S5M * S5ROW * 2 <= WS_X1, "acat");
constexpr int CW_BAR = 4096, CW_CNT = 8192  , CW_P0DONE = 12288  , CW_S5CDONE = 12352  ;

constexpr int LDS_BYTES = 147456, MISC_OFF = LDS_BYTES - 256, TAB_OFF = 131072 + 1024;

__device__ __forceinline__ unsigned f2bf(float f) { unsigned u = __builtin_bit_cast(unsigned, f); return (u + 0x7fffu + ((u >> 16) & 1u)) >> 16; }
typedef __bf16 bf16x2v __attribute__((ext_vector_type(2)));
__device__ __forceinline__ unsigned pk2(float lo, float hi) { const f32x2 v = {lo, hi}; const bf16x2v b = __builtin_convertvector(v, bf16x2v); return __builtin_bit_cast(unsigned, b); }
__device__ __forceinline__ unsigned pk4_fp8(float a, float b, float c, float d) { a = __builtin_amdgcn_fmed3f(a, -448.f, 448.f); b = __builtin_amdgcn_fmed3f(b, -448.f, 448.f); c = __builtin_amdgcn_fmed3f(c, -448.f, 448.f); d = __builtin_amdgcn_fmed3f(d, -448.f, 448.f); int w = 0; w = __builtin_amdgcn_cvt_pk_fp8_f32(a, b, w, false); w = __builtin_amdgcn_cvt_pk_fp8_f32(c, d, w, true); return (unsigned)w; }
__device__ __forceinline__ void unpack8_fp8(u32x2 w, f32x4& a, f32x4& b) { const f32x2 q0 = __builtin_amdgcn_cvt_pk_f32_fp8((int)w.x, false), q1 = __builtin_amdgcn_cvt_pk_f32_fp8((int)w.x, true), q2 = __builtin_amdgcn_cvt_pk_f32_fp8((int)w.y, false), q3 = __builtin_amdgcn_cvt_pk_f32_fp8((int)w.y, true);
    a = (f32x4){q0.x, q0.y, q1.x, q1.y}; b = (f32x4){q2.x, q2.y, q3.x, q3.y}; }
__device__ __forceinline__ float bflo(unsigned w) { return __builtin_bit_cast(float, w << 16); }
__device__ __forceinline__ float bfhi(unsigned w) { return __builtin_bit_cast(float, w & 0xffff0000u); }
__device__ __forceinline__ float bf1(bf16 h) { return __builtin_bit_cast(float, ((unsigned)h) << 16); }
__device__ __forceinline__ float fast_sigmoid(float x) { return __builtin_amdgcn_rcpf(1.0f + __builtin_amdgcn_exp2f(-1.4426950409f * x)); }
__device__ __forceinline__ float gelu_tanh(float x) { const float u = x + 0.044715f * x * x * x; return x * __builtin_amdgcn_rcpf(1.0f + __builtin_amdgcn_exp2f(-2.3022082f * u)); }
__device__ __forceinline__ f32x4 exp2_v(f32x4 x) { return (f32x4){__builtin_amdgcn_exp2f(x[0]), __builtin_amdgcn_exp2f(x[1]), __builtin_amdgcn_exp2f(x[2]), __builtin_amdgcn_exp2f(x[3])}; }
__device__ __forceinline__ f32x4 rcp_v(f32x4 x) { return (f32x4){__builtin_amdgcn_rcpf(x[0]), __builtin_amdgcn_rcpf(x[1]), __builtin_amdgcn_rcpf(x[2]), __builtin_amdgcn_rcpf(x[3])}; }
__device__ __forceinline__ f32x4 sigmoid_v(f32x4 x) { return rcp_v(exp2_v(x * -1.4426950409f) + 1.0f); }
__device__ __forceinline__ f32x4 gelu_v(f32x4 x) { const f32x4 u = x * x * 0.044715f * x + x; return x * rcp_v(exp2_v(u * -2.3022082f) + 1.0f); }
__device__ __forceinline__ unsigned pk4_fp8_nc(f32x4 v) { int w = 0; w = __builtin_amdgcn_cvt_pk_fp8_f32(v[0], v[1], w, false); w = __builtin_amdgcn_cvt_pk_fp8_f32(v[2], v[3], w, true); return (unsigned)w; }
__device__ __forceinline__ float wave_sum(float v) {
#pragma unroll
    for (int o = 1; o < 64; o <<= 1) v += __shfl_xor(v, o);
    return v;
}
__device__ __forceinline__ u32x4 pack8(f32x4 a, f32x4 b) { u32x4 w; w.x = pk2(a[0], a[1]); w.y = pk2(a[2], a[3]); w.z = pk2(b[0], b[1]); w.w = pk2(b[2], b[3]); return w; }
__device__ __forceinline__ void unpack8(u32x4 w, f32x4& a, f32x4& b) { a = (f32x4){bflo(w.x), bfhi(w.x), bflo(w.y), bfhi(w.y)}; b = (f32x4){bflo(w.z), bfhi(w.z), bflo(w.w), bfhi(w.w)}; }

#define XB_TMO      128
#define XB_XCNT(j)  (256  + 64 * (j))
#define XB_XSUB(j)  (1280 + 64 * (j))
#define XB_XGEN(j)  (2304 + 64 * (j))
#define XB_TOP      3328
#define XB_TOPGEN   3392
#define XCD_BAR_WORDS 3456
#define XB_SPIN_CAP (1u << 18)
__device__ __forceinline__ unsigned xb_ld(unsigned* p)              { return __hip_atomic_load(p, __ATOMIC_RELAXED, __HIP_MEMORY_SCOPE_AGENT); }
__device__ __forceinline__ unsigned xb_add(unsigned* p, unsigned v) { return __hip_atomic_fetch_add(p, v, __ATOMIC_RELAXED, __HIP_MEMORY_SCOPE_AGENT); }
__device__ __forceinline__ unsigned xb_xcc_id() { return (unsigned)__builtin_amdgcn_s_getreg((3 << 11) | 20) & 0xFu; }
#define XB_SPIN(cond, bar) do { unsigned _sp = 0; while (cond) { __builtin_amdgcn_s_sleep(1); \
    if ((++_sp & 255u) == 0u) { if (xb_ld(&(bar)[XB_TMO])) break; if (_sp > XB_SPIN_CAP) { atomicAdd(&(bar)[XB_TMO], 1u); break; } } } } while (0)
struct XcdBarrier { unsigned* bar; unsigned x; volatile LAS unsigned* st; };
__device__ __forceinline__ XcdBarrier xcd_barrier_post(unsigned* bar, volatile LAS unsigned* st) {
    XcdBarrier b; b.bar = bar; b.x = xb_xcc_id(); b.st = st;
    if (threadIdx.x == 0) (void)xb_add(&bar[XB_XCNT(b.x)], 1u);
    return b;
}
__device__ __forceinline__ void xcd_barrier_complete(unsigned* bar, unsigned x, unsigned& nloc, unsigned& nx) {
    const unsigned G = gridDim.x * gridDim.y * gridDim.z;
    unsigned sum, cnt, mine, sp = 0u;
    for (;;) {
        sum = 0u; cnt = 0u; mine = 0u;
#pragma unroll
        for (unsigned j = 0; j < 16; ++j) { const unsigned c = xb_ld(&bar[XB_XCNT(j)]); sum += c; cnt += (c > 0u) ? 1u : 0u; mine = (j == x) ? c : mine; }
        if (sum == G) break;
        __builtin_amdgcn_s_sleep(1);
        if ((++sp & 255u) == 0u) { if (xb_ld(&bar[XB_TMO])) break; if (sp > XB_SPIN_CAP) { atomicAdd(&bar[XB_TMO], 1u); break; } }
    }
    nloc = mine > 0u ? mine : 1u; nx = cnt > 0u ? cnt : 1u;
}
__device__ __forceinline__ void xcd_barrier(const XcdBarrier& b) {
    asm volatile("s_waitcnt vmcnt(0)" ::: "memory");
    __syncthreads();
    if (threadIdx.x == 0) {
        unsigned* bar = b.bar;
        __builtin_amdgcn_s_waitcnt(0);
        unsigned nloc = b.st[0], nx = b.st[1];
        if (nloc == 0u) { xcd_barrier_complete(bar, b.x, nloc, nx); b.st[0] = nloc; b.st[1] = nx; }
        const unsigned old = xb_add(&bar[XB_XSUB(b.x)], 1u);
        const unsigned gen = old / nloc;
        if (old + 1u == (gen + 1u) * nloc) {
            __builtin_amdgcn_fence(__ATOMIC_RELEASE, "agent");
            asm volatile("s_waitcnt vmcnt(0)" ::: "memory");
            (void)xb_add(&bar[XB_TOP], 1u);
        }
        XB_SPIN(xb_ld(&bar[XB_TOP]) < (gen + 1u) * nx, bar);
        __builtin_amdgcn_fence(__ATOMIC_ACQUIRE, "agent");
        asm volatile("s_waitcnt vmcnt(0)" ::: "memory");
    }
    __syncthreads();
}

namespace g8 {
constexpr int BM = 256, BK = 64, HALF = 128, HTB = HALF * BK * 2, STAGE_BYTES = 8 * HTB;
__device__ __forceinline__ int lds_byte(int r, int c) { const int st = (r >> 4) * 2 + (c >> 5), rr = r & 15, cc = c & 31, ob = rr * 64 + cc * 2; return st * 1024 + (ob ^ (((ob >> 9) & 1) << 5)); }
__device__ __forceinline__ void stage_rc(int b, int& R, int& C) { const int st = b / 1024, sb = b % 1024, swz = sb ^ (((sb >> 9) & 1) << 5); R = (st >> 1) * 16 + swz / 64; C = (st & 1) * 32 + (swz % 64) / 2; }
__device__ __forceinline__ int perm32(int rho) { const int n = rho >> 4, i = rho & 15; return 8 * (i >> 2) + 4 * n + (i & 3); }

struct Unit { int pm, pn, z, rl; const char* A; const char* B; };

typedef int v8i __attribute__((ext_vector_type(8)));
typedef int v4i __attribute__((ext_vector_type(4)));
typedef short s16x16 __attribute__((ext_vector_type(16)));
typedef s16x16 s16x16_a16 __attribute__((aligned(16)));
__device__ __forceinline__ v8i cat8(bf16x8 lo, bf16x8 hi) { const v4i a = __builtin_bit_cast(v4i, lo), b = __builtin_bit_cast(v4i, hi); return __builtin_shufflevector(a, b, 0, 1, 2, 3, 4, 5, 6, 7); }
template <class Epi, class Sched, bool GATHER, bool FP8 = false>
__device__ __forceinline__ void gemm_phase(LAS unsigned char* lds, const int Kb, const int ldaB, const int ldbB, const Sched& S, const Epi& E) {
    const int tid = threadIdx.x, wid = __builtin_amdgcn_readfirstlane(tid >> 6), lane = tid & 63, wr = wid >> 2, wc = wid & 3, fr = lane & 15, fq = lane >> 4;
    const int nt = Kb / 128;
    unsigned voffB[2], cvo[2][2], nvo[2][2]; int Rr[2], Cc[2];
#pragma unroll
    for (int i = 0; i < 2; ++i) { int R, C; stage_rc(tid * 16 + i * 8192, R, C); const int Rb = (R & ~31) + perm32(R & 31);
        voffB[i] = (unsigned)(Rb * ldbB + C * 2); Rr[i] = R; Cc[i] = C;
#pragma unroll
        for (int h = 0; h < 2; ++h) { cvo[h][i] = (unsigned)((h * HALF + R) * ldaB + C * 2); nvo[h][i] = cvo[h][i]; } }
    const size_t kstep = (size_t)(BK * 2);
    const size_t hstepB = (size_t)HALF * ldbB;
    const unsigned ldsw = (unsigned)wid * 1024u;
    const int aoff = FP8 ? lds_byte(wr * 64 + fr, (fq >> 1) * 32 + (fq & 1) * 24) : lds_byte(wr * 64 + fr, fq * 8), boff = FP8 ? lds_byte(wc * 32 + fr, (fq >> 1) * 32 + (fq & 1) * 24) : lds_byte(wc * 32 + fr, fq * 8);
    const int aoff2 = FP8 ? lds_byte(wr * 64 + fr, (fq >> 1) * 32 + 8 + (fq & 1) * 8) : 0, boff2 = FP8 ? lds_byte(wc * 32 + fr, (fq >> 1) * 32 + 8 + (fq & 1) * 8) : 0;
#define G8_SA(b, h) (((b) * 2 + (h)) * HTB)
#define G8_SB(b, h) ((4 + (b) * 2 + (h)) * HTB)
#define G8_STGB(bufoff, gbase) do { _Pragma("unroll") for (int _i = 0; _i < 2; ++_i) \
        __builtin_amdgcn_global_load_lds((const unsigned*)((const char*)(gbase) + voffB[_i]), (LAS unsigned*)(lds + (bufoff) + ldsw + _i * 8192), 16, 0, 0); } while (0)
#define G8_STGA(bufoff, gbase, VO, h) do { _Pragma("unroll") for (int _i = 0; _i < 2; ++_i) \
        __builtin_amdgcn_global_load_lds((const unsigned*)((const char*)(gbase) + VO[h][_i]), (LAS unsigned*)(lds + (bufoff) + ldsw + _i * 8192), 16, 0, 0); } while (0)
#define G8_LDA(dst, b, h) do { _Pragma("unroll") for (int m = 0; m < 4; ++m) { if constexpr (FP8) { dst##8[m] = cat8(*(const LAS bf16x8*)(lds + G8_SA(b, h) + aoff + m * 2048), *(const LAS bf16x8*)(lds + G8_SA(b, h) + aoff2 + m * 2048)); } \
        else { _Pragma("unroll") for (int k = 0; k < 2; ++k) dst[m][k] = *(const LAS bf16x8*)(lds + G8_SA(b, h) + aoff + m * 2048 + k * 1024); } } } while (0)
#define G8_LDB(dst, b, h) do { _Pragma("unroll") for (int n = 0; n < 2; ++n) { if constexpr (FP8) { dst##8[n] = cat8(*(const LAS bf16x8*)(lds + G8_SB(b, h) + boff + n * 2048), *(const LAS bf16x8*)(lds + G8_SB(b, h) + boff2 + n * 2048)); } \
        else { _Pragma("unroll") for (int k = 0; k < 2; ++k) dst[n][k] = *(const LAS bf16x8*)(lds + G8_SB(b, h) + boff + n * 2048 + k * 1024); } } } while (0)
#define G8_MMA(ai, bj, At, Bt) do { __builtin_amdgcn_s_setprio(1); _Pragma("unroll") for (int m = 0; m < 4; ++m) _Pragma("unroll") for (int n = 0; n < 2; ++n) { \
        if constexpr (FP8) asm volatile("s_nop 1\n\tv_mfma_scale_f32_16x16x128_f8f6f4 %0, %1, %2, %0, %3, %4 op_sel_hi:[0,0,0]" : "+v"(acc[ai][bj][m][n]) : "v"(Bt##8[n]), "v"(At##8[m]), "v"(sc_w), "v"(sc_a)); \
        else { _Pragma("unroll") for (int k = 0; k < 2; ++k) acc[ai][bj][m][n] = __builtin_amdgcn_mfma_f32_16x16x32_bf16(Bt[n][k], At[m][k], acc[ai][bj][m][n], 0, 0, 0); } } __builtin_amdgcn_s_setprio(0); } while (0)
#define G8_WAIT_V(n) asm volatile("s_waitcnt vmcnt(" #n ")" ::: "memory")
#define G8_WAIT_L(n) asm volatile("s_waitcnt lgkmcnt(" #n ")" ::: "memory")
#define G8_BAR __builtin_amdgcn_s_barrier()
#define G8_SCHED __builtin_amdgcn_sched_barrier(0)
    Unit cur, nxt; int ui = 0;
    if (!S.next(0, cur)) return;
    bool has_next = S.next(1, nxt);
    if constexpr (GATHER) { S.gather(cur, Rr, Cc, cvo); if (has_next) S.gather(nxt, Rr, Cc, nvo); else {
#pragma unroll
        for (int h = 0; h < 2; ++h)
#pragma unroll
            for (int i = 0; i < 2; ++i) nvo[h][i] = cvo[h][i]; } }
    f32x4 acc[2][2][4][2];
#pragma unroll
    for (int a = 0; a < 2; ++a)
#pragma unroll
        for (int b = 0; b < 2; ++b)
#pragma unroll
            for (int m = 0; m < 4; ++m)
#pragma unroll
                for (int n = 0; n < 2; ++n) acc[a][b][m][n] = (f32x4){0.f, 0.f, 0.f, 0.f};
    const int sc_w = 0x7a7a7a7a, sc_a = 0x7f7f7f7f;
    bf16x8 At[4][2], B0[2][2], B1[2][2]; v8i At8[4], B08[2], B18[2];
    const char* cA = cur.A; const char* cB = cur.B;
    G8_STGB(G8_SB(0, 0), cB); G8_STGB(G8_SB(0, 1), cB + hstepB); G8_STGA(G8_SA(0, 0), cA, cvo, 0); G8_STGA(G8_SA(0, 1), cA, cvo, 1);
    if (wr == 1) G8_BAR;
    G8_WAIT_V(2); G8_BAR;
    G8_STGB(G8_SB(1, 0), cB + kstep); G8_STGA(G8_SA(1, 0), cA + kstep, cvo, 0); G8_STGB(G8_SB(1, 1), cB + hstepB + kstep);
    G8_WAIT_V(6); G8_BAR;
    for (;;) {
        const char* nA = has_next ? nxt.A : cA; const char* nB = has_next ? nxt.B : cB;
        for (int t = 0; t < nt; t += 2) {
            const bool last = (t == nt - 2);
            const char* a1 = cA + (size_t)(t + 1) * kstep;
            const char* a2 = last ? nA : cA + (size_t)(t + 2) * kstep; const char* b2 = last ? nB : cB + (size_t)(t + 2) * kstep;
            const char* a3 = a2 + kstep; const char* b3 = b2 + kstep;
            unsigned vo2[2][2];
#pragma unroll
            for (int h = 0; h < 2; ++h)
#pragma unroll
                for (int i = 0; i < 2; ++i) vo2[h][i] = (GATHER && last) ? nvo[h][i] : cvo[h][i];
            G8_LDB(B0, 0, 0); G8_LDB(B1, 0, 1); G8_SCHED; G8_LDA(At, 0, 0); G8_STGA(G8_SA(1, 1), a1, cvo, 1);
            G8_WAIT_V(8); G8_WAIT_L(0); G8_BAR; G8_SCHED; G8_MMA(0, 0, At, B0); G8_MMA(0, 1, At, B1); G8_SCHED; G8_BAR; G8_SCHED;
            G8_LDA(At, 0, 1); G8_STGB(G8_SB(0, 0), b2); G8_STGB(G8_SB(0, 1), b2 + hstepB); G8_STGA(G8_SA(0, 0), a2, vo2, 0);
            G8_WAIT_V(8); G8_WAIT_L(0); G8_BAR; G8_SCHED; G8_MMA(1, 0, At, B0); G8_MMA(1, 1, At, B1); G8_SCHED; G8_BAR; G8_SCHED;
            G8_LDB(B0, 1, 0); G8_LDB(B1, 1, 1); G8_SCHED; G8_LDA(At, 1, 0); G8_STGA(G8_SA(0, 1), a2, vo2, 1);
            G8_WAIT_V(8); G8_WAIT_L(0); G8_BAR; G8_SCHED; G8_MMA(0, 0, At, B0); G8_MMA(0, 1, At, B1); G8_SCHED; G8_BAR; G8_SCHED;
            G8_LDA(At, 1, 1); G8_STGB(G8_SB(1, 0), b3); G8_STGB(G8_SB(1, 1), b3 + hstepB); G8_STGA(G8_SA(1, 0), a3, vo2, 0);
            G8_WAIT_V(8); G8_WAIT_L(0); G8_BAR; G8_SCHED; G8_MMA(1, 0, At, B0); G8_MMA(1, 1, At, B1); G8_SCHED; G8_BAR; G8_SCHED;
        }
        f32x4 bpre[Epi::NPRE]; E.pre(cur, wr, wc, fr, fq, bpre);
        if (wr == 0) G8_BAR;
        Unit nn; bool has_nn = false;
        if (has_next) has_nn = S.next(ui + 2, nn);
        unsigned nnvo[2][2];
        if constexpr (GATHER) { if (has_nn) S.gather(nn, Rr, Cc, nnvo); }
        if constexpr (FP8) asm volatile("s_nop 15\n\ts_nop 15" ::: "memory");
        E(acc, cur, wr, wc, fr, fq, bpre);
        if (!has_next) break;
#pragma unroll
        for (int a = 0; a < 2; ++a)
#pragma unroll
            for (int b = 0; b < 2; ++b)
#pragma unroll
                for (int m = 0; m < 4; ++m)
#pragma unroll
                    for (int n = 0; n < 2; ++n) acc[a][b][m][n] = (f32x4){0.f, 0.f, 0.f, 0.f};
        cur = nxt; cA = nA; cB = nB; ++ui;
        if constexpr (GATHER) {
#pragma unroll
            for (int h = 0; h < 2; ++h)
#pragma unroll
                for (int i = 0; i < 2; ++i) { cvo[h][i] = nvo[h][i]; if (has_nn) nvo[h][i] = nnvo[h][i]; } }
        nxt = nn; has_next = has_nn;
        if (wr == 1) G8_BAR;
    }
    G8_WAIT_V(0);
    G8_BAR;
#undef G8_SA
#undef G8_SB
#undef G8_STGB
#undef G8_STGA
#undef G8_LDA
#undef G8_LDB
#undef G8_MMA
#undef G8_WAIT_V
#undef G8_WAIT_L
#undef G8_BAR
#undef G8_SCHED
}

struct GridOrder {
    int nM, nN, nwg, G, c; const char* A; const char* B; size_t tstepA, tstepB; int dup = 0;
    __device__ __forceinline__ void init(int M, int N, int G_, int c_, const void* A_, const void* B_, int ldaB, int ldbB) { nM = M / BM; nN = N / BM; nwg = nM * nN; G = G_; c = c_; A = (const char*)A_; B = (const char*)B_; tstepA = (size_t)BM * ldaB; tstepB = (size_t)BM * ldbB; }
    __device__ __forceinline__ bool next(int i0, Unit& u) const { const int i = dup ? (i0 >> 1) : i0;
        const long L = (long)i * G + c; if (L >= nwg) return false;
        int wgid = (int)L; { const int q = nwg / 8, r = nwg % 8, xcd = wgid % 8, off = wgid / 8; wgid = (xcd < r ? xcd * (q + 1) : r * (q + 1) + (xcd - r) * q) + off; }
        const int nig = 8 * nN, gid = wgid / nig, fm = gid * 8, gsz = (nM - fm) < 8 ? (nM - fm) : 8;
        u.pm = fm + ((wgid % nig) % gsz); u.pn = (wgid % nig) / gsz; u.z = 0; u.rl = 0;
        u.A = A + (size_t)u.pm * tstepA; u.B = B + (size_t)u.pn * tstepB; return true;
    }
};
}

struct Frame {
    LAS unsigned char* lds; volatile LAS unsigned* MISC; unsigned* ctl;
    int tid, lane, wave, vcu, G;
    const float* in[34]; float* out; unsigned char* ws;
};
#define WSP(T_, off) ((T_*)(F.ws + (off)))

struct EpiInProj { static constexpr int NPRE = 4; static constexpr int NST = 16;
    __device__ __forceinline__ void pre(const g8::Unit& u, int, int wc, int, int fq, f32x4 (&bp)[4]) const { const int colb = u.pn * 256 + wc * 32 + 8 * fq;
#pragma unroll
        for (int bj = 0; bj < 2; ++bj)
#pragma unroll
            for (int n = 0; n < 2; ++n) bp[bj * 2 + n] = *(const f32x4*)(bias + colb + bj * 128 + 4 * n); }
    const float* bias; bf16 *xrnn, *gy, *acat, *gates;
    template <int KIND>
    __device__ __forceinline__ void run(const f32x4 (&acc)[2][2][4][2], const g8::Unit& u, int wr, int wc, int fr, int fq, const f32x4 (&bpre)[4]) const {
        const int colb = u.pn * 256 + wc * 32 + 8 * fq;
#pragma unroll
        for (int ai = 0; ai < 2; ++ai)
#pragma unroll
            for (int m = 0; m < 4; ++m) { const int t = u.pm * 256 + ai * 128 + wr * 64 + m * 16 + fr;
#pragma unroll
                for (int bj = 0; bj < 2; ++bj) { f32x4 v0 = acc[ai][bj][m][0] + bpre[bj * 2], v1 = acc[ai][bj][m][1] + bpre[bj * 2 + 1]; const int col = colb + bj * 128;
                    if (KIND == 0) { u32x2 w8; w8.x = pk4_fp8(v0[0], v0[1], v0[2], v0[3]); w8.y = pk4_fp8(v1[0], v1[1], v1[2], v1[3]); *(u32x2*)((unsigned char*)xrnn + (size_t)t * 1024 + col) = w8; }
                    else if (KIND == 1) {
#pragma unroll
                        for (int j = 0; j < 1; ++j) { v0 = gelu_v(v0); v1 = gelu_v(v1); }
                        u32x2 w8; w8.x = pk4_fp8(v0[0], v0[1], v0[2], v0[3]); w8.y = pk4_fp8(v1[0], v1[1], v1[2], v1[3]); *(u32x2*)((unsigned char*)gy + (size_t)t * 1024 + (col - 1024)) = w8; }
                    else if (KIND == 2) { const int cu = col - 2048, g = cu >> 4, c = cu & 15;
                        *(u32x4*)(acat + ((size_t)(g * S5M + (t >> 5)) * S5ROW + 128 + (t & 31) * 16 + c)) = pack8(v0, v1); }
                    else {
#pragma unroll
                        for (int j = 0; j < 1; ++j) { v0 = sigmoid_v(v0); v1 = sigmoid_v(v1); }
                        u32x2 w8; w8.x = pk4_fp8_nc(v0); w8.y = pk4_fp8_nc(v1); *(u32x2*)((unsigned char*)gates + (size_t)t * 2048 + (col - 2560)) = w8; } } }
    }
    __device__ __forceinline__ void operator()(const f32x4 (&acc)[2][2][4][2], const g8::Unit& u, int wr, int wc, int fr, int fq, const f32x4 (&bpre)[4]) const {
        const int pn = u.pn;
        if (pn < 4) run<0>(acc, u, wr, wc, fr, fq, bpre); else if (pn < 8) run<1>(acc, u, wr, wc, fr, fq, bpre); else if (pn < 10) run<2>(acc, u, wr, wc, fr, fq, bpre); else run<3>(acc, u, wr, wc, fr, fq, bpre);
    }
};
struct EpiS5A { static constexpr int NPRE = 4;
    __device__ __forceinline__ void pre(const g8::Unit&, int, int, int, int, f32x4 (&)[4]) const {}
    float* S;
    __device__ __forceinline__ void operator()(const f32x4 (&acc)[2][2][4][2], const g8::Unit& u, int wr, int wc, int fr, int fq, const f32x4 (&bpre)[4]) const {
        const int col = wc * 32 + 8 * fq;
#pragma unroll
        for (int ai = 0; ai < 2; ++ai)
#pragma unroll
            for (int m = 0; m < 4; ++m) { const int row = u.pm * 256 + ai * 128 + wr * 64 + m * 16 + fr; float* p = S + ((size_t)(u.z * S5M + row)) * 128 + col;
                *(f32x4*)p = acc[ai][0][m][0]; *(f32x4*)(p + 4) = acc[ai][0][m][1]; }
    }
};
struct EpiS5C { static constexpr int NPRE = 4;
    __device__ __forceinline__ void pre(const g8::Unit&, int, int, int, int, f32x4 (&)[4]) const {}
    bf16* ys;
    __device__ __forceinline__ void operator()(const f32x4 (&acc)[2][2][4][2], const g8::Unit& u, int wr, int wc, int fr, int fq, const f32x4 (&bpre)[4]) const {
#pragma unroll
        for (int ai = 0; ai < 2; ++ai)
#pragma unroll
            for (int m = 0; m < 4; ++m) { const int row = u.pm * 256 + ai * 128 + wr * 64 + m * 16 + fr;
#pragma unroll
                for (int bj = 0; bj < 2; ++bj) { const int n = u.pn * 256 + bj * 128 + wc * 32 + 8 * fq, i = n >> 4, c = n & 15; f32x4 v0 = acc[ai][bj][m][0], v1 = acc[ai][bj][m][1];
#pragma unroll
                    for (int j = 0; j < 1; ++j) { v0 = gelu_v(v0); v1 = gelu_v(v1); }
                    u32x2 w8; w8.x = pk4_fp8(v0[0], v0[1], v0[2], v0[3]); w8.y = pk4_fp8(v1[0], v1[1], v1[2], v1[3]); *(u32x2*)((unsigned char*)ys + (size_t)(row * 32 + i) * 512 + u.z * 16 + c) = w8; } }
    }
};
struct EpiGlu { static constexpr int NPRE = 4; static constexpr int NST = 8;
    __device__ __forceinline__ void pre(const g8::Unit& u, int wr, int wc, int fr, int fq, f32x4 (&bp)[4]) const { const int f = u.pn * 128 + wc * 32 + 8 * fq;
#pragma unroll
        for (int ai = 0; ai < 2; ++ai)
#pragma unroll
            for (int mh = 0; mh < 2; ++mh) { const int t = u.pm * 256 + ai * 128 + wr * 64 + (2 * mh) * 16 + fr;
                const u32x2 a = *(const u32x2*)((const unsigned char*)gates + (size_t)t * 2048 + 1024 + f), b = *(const u32x2*)((const unsigned char*)gates + (size_t)(t + 16) * 2048 + 1024 + f);
                bp[ai * 2 + mh] = __builtin_bit_cast(f32x4, (u32x4){a.x, a.y, b.x, b.y}); } }
    const bf16* gates; bf16* gb;
    __device__ __forceinline__ void operator()(const f32x4 (&acc)[2][2][4][2], const g8::Unit& u, int wr, int wc, int fr, int fq, const f32x4 (&bpre)[4]) const {
        const int f = u.pn * 128 + wc * 32 + 8 * fq;
#pragma unroll
        for (int ai = 0; ai < 2; ++ai) {
#pragma unroll
            for (int m = 0; m < 4; ++m) { const int t = u.pm * 256 + ai * 128 + wr * 64 + m * 16 + fr;
                const u32x4 pw = __builtin_bit_cast(u32x4, bpre[ai * 2 + (m >> 1)]); const u32x2 gwm = (m & 1) ? (u32x2){pw.z, pw.w} : (u32x2){pw.x, pw.y};
                f32x4 g0, g1; unpack8_fp8(gwm, g0, g1);
                f32x4 v0 = acc[ai][0][m][0], v1 = acc[ai][0][m][1]; const f32x4 s0 = acc[ai][1][m][0], s1 = acc[ai][1][m][1];
                v0 = g0 * v0 * sigmoid_v(s0); v1 = g1 * v1 * sigmoid_v(s1);
                u32x2 w8; w8.x = pk4_fp8(v0[0], v0[1], v0[2], v0[3]); w8.y = pk4_fp8(v1[0], v1[1], v1[2], v1[3]); *(u32x2*)((unsigned char*)gb + (size_t)t * 1024 + f) = w8; } }
    }
};
struct EpiRnn { static constexpr int NPRE = 16; static constexpr int NST = 16;
    __device__ __forceinline__ void pre(const g8::Unit& u, int wr, int wc, int fr, int fq, f32x4 (&bp)[16]) const {
#pragma unroll
        for (int ai = 0; ai < 2; ++ai)
#pragma unroll
            for (int m = 0; m < 4; ++m) { const int t = u.pm * 256 + ai * 128 + wr * 64 + m * 16 + fr;
                u32x2 g[2], b[2];
#pragma unroll
                for (int bj = 0; bj < 2; ++bj) { const int col = u.pn * 256 + bj * 128 + wc * 32 + 8 * fq; g[bj] = *(const u32x2*)((const unsigned char*)gates + (size_t)t * 2048 + col); b[bj] = *(const u32x2*)((const unsigned char*)gb + (size_t)t * 1024 + col); }
                bp[(ai * 4 + m) * 2] = __builtin_bit_cast(f32x4, (u32x4){g[0].x, g[0].y, g[1].x, g[1].y}); bp[(ai * 4 + m) * 2 + 1] = __builtin_bit_cast(f32x4, (u32x4){b[0].x, b[0].y, b[1].x, b[1].y}); } }
    const bf16* gates; const bf16* gb; bf16* merged;
    __device__ __forceinline__ void operator()(const f32x4 (&acc)[2][2][4][2], const g8::Unit& u, int wr, int wc, int fr, int fq, const f32x4 (&bpre)[16]) const {
#pragma unroll
        for (int ai = 0; ai < 2; ++ai)
#pragma unroll
            for (int m = 0; m < 4; ++m) { const int t = u.pm * 256 + ai * 128 + wr * 64 + m * 16 + fr;
                const u32x4 gq = __builtin_bit_cast(u32x4, bpre[(ai * 4 + m) * 2]), bq = __builtin_bit_cast(u32x4, bpre[(ai * 4 + m) * 2 + 1]);
#pragma unroll
                for (int bj = 0; bj < 2; ++bj) { const int col = u.pn * 256 + bj * 128 + wc * 32 + 8 * fq;
                    f32x4 g0, g1, b0, b1; unpack8_fp8(bj ? (u32x2){gq.z, gq.w} : (u32x2){gq.x, gq.y}, g0, g1); unpack8_fp8(bj ? (u32x2){bq.z, bq.w} : (u32x2){bq.x, bq.y}, b0, b1);
                    const f32x4 v0 = g0 * acc[ai][bj][m][0] + b0, v1 = g1 * acc[ai][bj][m][1] + b1;
                    u32x2 w8; w8.x = pk4_fp8(v0[0], v0[1], v0[2], v0[3]); w8.y = pk4_fp8(v1[0], v1[1], v1[2], v1[3]); *(u32x2*)((unsigned char*)merged + (size_t)t * 1024 + col) = w8; } }
    }
};
struct EpiOut { static constexpr int NPRE = 12; static constexpr int NST = 16;
    const float* x; const float* mod; bf16* v1;
    __device__ __forceinline__ void xbatch(const g8::Unit& u, int wr, int wc, int fr, int fq, int bt, f32x4* d) const { const int ai = bt >> 1, mh = bt & 1;
#pragma unroll
        for (int mm = 0; mm < 2; ++mm) { const int t = u.pm * 256 + ai * 128 + wr * 64 + (2 * mh + mm) * 16 + fr;
#pragma unroll
            for (int bj = 0; bj < 2; ++bj) { const int col = u.pn * 256 + bj * 128 + wc * 32 + 8 * fq; d[(mm * 2 + bj) * 2] = *(const f32x4*)(x + (size_t)t * 1024 + col); d[(mm * 2 + bj) * 2 + 1] = *(const f32x4*)(x + (size_t)t * 1024 + col + 4); } } }
    __device__ __forceinline__ void pre(const g8::Unit& u, int wr, int wc, int fr, int fq, f32x4 (&bp)[12]) const { const int b = (u.pm * 256) >> 12; const float* p = mod + b * 6144 + 2048 + u.pn * 256 + wc * 32 + 8 * fq;
        bp[0] = *(const f32x4*)p; bp[1] = *(const f32x4*)(p + 4); bp[2] = *(const f32x4*)(p + 128); bp[3] = *(const f32x4*)(p + 132);
        xbatch(u, wr, wc, fr, fq, 0, &bp[4]); }
    __device__ __forceinline__ void cbatch(const f32x4 (&acc)[2][2][4][2], const g8::Unit& u, int wr, int wc, int fr, int fq, int bt, const f32x4* d, const f32x4* g) const { const int ai = bt >> 1, mh = bt & 1;
#pragma unroll
        for (int mm = 0; mm < 2; ++mm) { const int m = 2 * mh + mm, t = u.pm * 256 + ai * 128 + wr * 64 + m * 16 + fr;
#pragma unroll
            for (int bj = 0; bj < 2; ++bj) { const int col = u.pn * 256 + bj * 128 + wc * 32 + 8 * fq;
                const f32x4 v0 = d[(mm * 2 + bj) * 2] * DN_ALPHA + (g[2 * bj] + 1.0f) * acc[ai][bj][m][0], v1_ = d[(mm * 2 + bj) * 2 + 1] * DN_ALPHA + (g[2 * bj + 1] + 1.0f) * acc[ai][bj][m][1];
                *(u32x4*)(v1 + (size_t)t * 1024 + col) = pack8(v0, v1_); } } }
    __device__ __forceinline__ void operator()(const f32x4 (&acc)[2][2][4][2], const g8::Unit& u, int wr, int wc, int fr, int fq, const f32x4 (&bpre)[12]) const {
        f32x4 xa[8], xb[8];
        xbatch(u, wr, wc, fr, fq, 1, xa);
        __builtin_amdgcn_sched_barrier(0);
        cbatch(acc, u, wr, wc, fr, fq, 0, &bpre[4], &bpre[0]);
        __builtin_amdgcn_sched_barrier(0);
        xbatch(u, wr, wc, fr, fq, 2, xb);
        __builtin_amdgcn_sched_barrier(0);
        cbatch(acc, u, wr, wc, fr, fq, 1, xa, &bpre[0]);
        __builtin_amdgcn_sched_barrier(0);
        xbatch(u, wr, wc, fr, fq, 3, xa);
        __builtin_amdgcn_sched_barrier(0);
        cbatch(acc, u, wr, wc, fr, fq, 2, xb, &bpre[0]);
        cbatch(acc, u, wr, wc, fr, fq, 3, xa, &bpre[0]);
    }
};
struct EpiMoe1 { static constexpr int NPRE = 4;
    __device__ __forceinline__ void pre(const g8::Unit& u, int, int wc, int, int fq, f32x4 (&bp)[4]) const { const float* p = bgu + (size_t)u.z * 2048 + u.pn * 128 + wc * 32 + 8 * fq; bp[0] = *(const f32x4*)p; bp[1] = *(const f32x4*)(p + 4); bp[2] = *(const f32x4*)(p + 1024); bp[3] = *(const f32x4*)(p + 1028); }
    const float* bgu; bf16* act;
    __device__ __forceinline__ void operator()(const f32x4 (&acc)[2][2][4][2], const g8::Unit& u, int wr, int wc, int fr, int fq, const f32x4 (&bpre)[4]) const {
        const int f = u.pn * 128 + wc * 32 + 8 * fq; const float* bp = bgu + (size_t)u.z * 2048 + f;
        (void)bp; const f32x4 bg0 = bpre[0], bg1 = bpre[1], bu0 = bpre[2], bu1 = bpre[3];
#pragma unroll
        for (int ai = 0; ai < 2; ++ai)
#pragma unroll
            for (int m = 0; m < 4; ++m) { const int row = u.pm * 256 + ai * 128 + wr * 64 + m * 16 + fr;
                f32x4 g0 = acc[ai][0][m][0] + bg0, g1 = acc[ai][0][m][1] + bg1, u0 = acc[ai][1][m][0] + bu0, u1 = acc[ai][1][m][1] + bu1;
#pragma unroll
                for (int j = 0; j < 4; ++j) { g0[j] = fminf(g0[j], 7.0f); g1[j] = fminf(g1[j], 7.0f); u0[j] = __builtin_amdgcn_fmed3f(u0[j], -7.0f, 7.0f); u1[j] = __builtin_amdgcn_fmed3f(u1[j], -7.0f, 7.0f); }
                g0 = g0 * rcp_v(exp2_v(g0 * (-1.702f * 1.4426950409f)) + 1.0f) * (u0 + 1.0f); g1 = g1 * rcp_v(exp2_v(g1 * (-1.702f * 1.4426950409f)) + 1.0f) * (u1 + 1.0f);
                u32x2 w8; w8.x = pk4_fp8_nc(g0); w8.y = pk4_fp8_nc(g1); *(u32x2*)((unsigned char*)act + (size_t)row * 1024 + f) = w8; }
    }
};
struct EpiMoe2 { static constexpr int NPRE = 4;
    __device__ __forceinline__ void pre(const g8::Unit& u, int, int wc, int, int fq, f32x4 (&bp)[4]) const { const float* p = bd + (size_t)u.z * 1024 + u.pn * 256 + wc * 32 + 8 * fq; bp[0] = *(const f32x4*)p; bp[1] = *(const f32x4*)(p + 4); bp[2] = *(const f32x4*)(p + 128); bp[3] = *(const f32x4*)(p + 132); }
    const float* bd; bf16* yb;
    __device__ __forceinline__ void operator()(const f32x4 (&acc)[2][2][4][2], const g8::Unit& u, int wr, int wc, int fr, int fq, const f32x4 (&bpre)[4]) const {
#pragma unroll
        for (int bj = 0; bj < 2; ++bj) { const int col = u.pn * 256 + bj * 128 + wc * 32 + 8 * fq; const float* bp = bd + (size_t)u.z * 1024 + col;
            (void)bp; const f32x4 b0 = bpre[bj * 2], b1 = bpre[bj * 2 + 1];
#pragma unroll
            for (int ai = 0; ai < 2; ++ai)
#pragma unroll
                for (int m = 0; m < 4; ++m) { const int row = u.pm * 256 + ai * 128 + wr * 64 + m * 16 + fr;
                    const f32x4 y0 = acc[ai][bj][m][0] + b0, y1 = acc[ai][bj][m][1] + b1; u32x2 w8; w8.x = pk4_fp8(y0[0], y0[1], y0[2], y0[3]); w8.y = pk4_fp8(y1[0], y1[1], y1[2], y1[3]);
                    *(u32x2*)((unsigned char*)yb + (size_t)row * 1024 + col) = w8; } }
    }
};

struct S5AOrder { int G, c; const char* acat; const char* ws;
    __device__ __forceinline__ bool next(int i, g8::Unit& u) const { const int L = i * G + c; if (L >= S5G * 4) return false; u.z = L >> 2; u.pm = L & 3; u.pn = 0; u.rl = 0;
        u.A = acat + ((size_t)(u.z * S5M + u.pm * 256) * S5ROW + 128) * 2; u.B = ws + (size_t)u.z * 256 * (S5L * 16) * 2; return true; } };
struct S5COrder { int G, c; const char* acat; const char* wy;
    __device__ __forceinline__ bool next(int i, g8::Unit& u) const { const int L = i * G + c; if (L >= S5G * 8) return false; u.z = L >> 3; u.pm = (L >> 1) & 3; u.pn = L & 1; u.rl = 0;
        u.A = acat + ((size_t)(u.z * S5M + u.pm * 256) * S5ROW) * 2; u.B = wy + ((size_t)(u.z * 512 + u.pn * 256) * S5ROW) * 2; return true; } };
struct MoeOrder { int G, c, NT, RT; const LAS int* tstart; const LAS int* cnt; const int* toklist; const char* A; const char* B; size_t bstride_e; int lda; bool gatherA; int dup = 0;
    __device__ __forceinline__ bool next(int i0, g8::Unit& u) const { const int i = dup ? (i0 >> 1) : i0; const int per = G >> 3, xcd = c & 7, slot = c >> 3, rpx = per / NT;
        const int rt = (i * 8 + xcd) * rpx + slot / NT; if (rt >= RT) return false; u.pn = slot % NT;
        const int lane_ = threadIdx.x & 63; const unsigned long long mk_ = __ballot(lane_ < NE && tstart[lane_ & 31] <= rt);
        const int e = __builtin_popcountll(mk_) - 1;
        u.z = e; u.pm = rt; u.rl = rt - tstart[e]; u.B = B + (size_t)e * bstride_e + (size_t)u.pn * 256 * 1024; u.A = gatherA ? A : A + (size_t)rt * 256 * 1024; return true; }
    __device__ __forceinline__ void gather(const g8::Unit& u, const int (&Rr)[2], const int (&Cc)[2], unsigned (&vo)[2][2]) const {
        const int n = cnt[u.z];
#pragma unroll
        for (int h = 0; h < 2; ++h)
#pragma unroll
            for (int i = 0; i < 2; ++i) { const int r = u.rl * 256 + h * 128 + Rr[i]; const int rc = r < n ? r : n - 1; const int tok = toklist[u.z * T + rc]; vo[h][i] = (unsigned)(tok * lda + Cc[i] * 2); } }
};

__device__ __forceinline__ void transpose_item(const float* W, int N, int k0, int n0, bf16* dst, int ldd, int drow0, LAS float* scr, int lane) {
    float wv_[32];
#pragma unroll
    for (int i = 0; i < 32; ++i) wv_[i] = W[(size_t)(k0 + 2 * i + (lane >> 5)) * N + n0 + (lane & 31)];
#pragma unroll
    for (int i = 0; i < 32; ++i) scr[(2 * i + (lane >> 5)) * 33 + (lane & 31)] = wv_[i];
    asm volatile("s_waitcnt lgkmcnt(0)" ::: "memory");
    const int c = lane & 7;
#pragma unroll
    for (int j = 0; j < 4; ++j) { const int n = (lane >> 3) + 8 * j; const LAS float* s = scr + (8 * c) * 33 + n;
        u32x4 o; o.x = pk2(s[0 * 33], s[1 * 33]); o.y = pk2(s[2 * 33], s[3 * 33]); o.z = pk2(s[4 * 33], s[5 * 33]); o.w = pk2(s[6 * 33], s[7 * 33]);
        *(u32x4*)(dst + (size_t)(drow0 + n) * ldd + k0 + 8 * c) = o; }
    asm volatile("s_waitcnt lgkmcnt(0)" ::: "memory");
}
__device__ __forceinline__ void transpose_item8(const float* W, int N, int k0, int n0, unsigned char* dst, int ldd, int drow0, LAS float* scr, int lane) {
    float wv_[32];
#pragma unroll
    for (int i = 0; i < 32; ++i) wv_[i] = W[(size_t)(k0 + 2 * i + (lane >> 5)) * N + n0 + (lane & 31)];
#pragma unroll
    for (int i = 0; i < 32; ++i) scr[(2 * i + (lane >> 5)) * 33 + (lane & 31)] = wv_[i];
    asm volatile("s_waitcnt lgkmcnt(0)" ::: "memory");
    const int c = lane & 7;
#pragma unroll
    for (int j = 0; j < 4; ++j) { const int n = (lane >> 3) + 8 * j; const LAS float* s = scr + (8 * c) * 33 + n;
        u32x2 o; o.x = pk4_fp8(32.f * s[0 * 33], 32.f * s[1 * 33], 32.f * s[2 * 33], 32.f * s[3 * 33]); o.y = pk4_fp8(32.f * s[4 * 33], 32.f * s[5 * 33], 32.f * s[6 * 33], 32.f * s[7 * 33]);
        *(u32x2*)(dst + (size_t)(drow0 + n) * ldd + k0 + 8 * c) = o; }
    asm volatile("s_waitcnt lgkmcnt(0)" ::: "memory");
}
__device__ __forceinline__ void transpose_item8w(const float* W, int N, int k0, int n0, unsigned char* dst, int ldd, int drow0, LAS float* scr, int lane) {
    float wv[64]; const float* wp = W + (size_t)(k0 + (lane >> 5)) * N + n0 + (lane & 31);
#pragma unroll
    for (int i = 0; i < 64; ++i) wv[i] = wp[(size_t)(2 * i) * N];
#pragma unroll
    for (int i = 0; i < 64; ++i) scr[(2 * i + (lane >> 5)) * 33 + (lane & 31)] = wv[i];
    asm volatile("s_waitcnt lgkmcnt(0)" ::: "memory");
    const int c = lane & 7;
#pragma unroll
    for (int j = 0; j < 4; ++j) { const int n = (lane >> 3) + 8 * j; const LAS float* s = scr + (16 * c) * 33 + n;
        u32x4 o; o.x = pk4_fp8(32.f * s[0 * 33], 32.f * s[1 * 33], 32.f * s[2 * 33], 32.f * s[3 * 33]); o.y = pk4_fp8(32.f * s[4 * 33], 32.f * s[5 * 33], 32.f * s[6 * 33], 32.f * s[7 * 33]);
        o.z = pk4_fp8(32.f * s[8 * 33], 32.f * s[9 * 33], 32.f * s[10 * 33], 32.f * s[11 * 33]); o.w = pk4_fp8(32.f * s[12 * 33], 32.f * s[13 * 33], 32.f * s[14 * 33], 32.f * s[15 * 33]);
        *(u32x4*)(dst + (size_t)(drow0 + n) * ldd + k0 + 16 * c) = o; }
    asm volatile("s_waitcnt lgkmcnt(0)" ::: "memory");
}
__device__ __forceinline__ int pair_row(int n) { const int f = n & 1023, hi = n >> 10; return (f >> 7) * 256 + hi * 128 + (f & 127); }

__device__ __forceinline__ void moe_tables(Frame& F) {
    LAS int* tstart = (LAS int*)(F.lds + TAB_OFF); LAS int* cl = tstart + 40;
    if (F.tid < 64) {
        const int e = F.lane & 31; const int c = (int)F.ctl[CW_CNT + 64 * e]; int inc = (c + 255) >> 8;
#pragma unroll
        for (int o = 1; o < 32; o <<= 1) { const int v = __shfl_up(inc, o); if ((F.lane & 31) >= o) inc += v; }
        if (F.lane < 32) { cl[e] = c; tstart[e] = inc - ((c + 255) >> 8); if (e == NE - 1) tstart[NE] = inc; }
    }
    __syncthreads();
}

__device__ __forceinline__ void p0_mod_job(Frame& F, int job) {
    LAS float* sc = (LAS float*)F.lds;
    LAS float* red = sc + 8 * 1024;
    const float* c = F.in[1]; const float* w = F.in[2]; const float* bias = F.in[3];
    { float cv[16];
#pragma unroll
      for (int k = 0; k < 16; ++k) cv[k] = c[F.tid + 512 * k];
#pragma unroll
      for (int k = 0; k < 16; ++k) sc[F.tid + 512 * k] = cv[k] * fast_sigmoid(cv[k]); }
    __syncthreads();
    const int col = F.tid & 31, kg = F.tid >> 5, j = job * 32 + col;
    float a[8];
#pragma unroll
    for (int b = 0; b < 8; ++b) a[b] = 0.f;
#pragma unroll 32
    for (int k = kg * 64; k < kg * 64 + 64; ++k) { const float wv = w[(size_t)k * 6144 + j];
#pragma unroll
        for (int b = 0; b < 8; ++b) a[b] += sc[b * 1024 + k] * wv; }
#pragma unroll
    for (int b = 0; b < 8; ++b) red[(kg * 8 + b) * 32 + col] = a[b];
    __syncthreads();
    if (F.tid < 256) { const int b = F.tid >> 5, cc = F.tid & 31; float s = 0.f;
#pragma unroll
        for (int g = 0; g < 16; ++g) s += red[(g * 8 + b) * 32 + cc];
        WSP(float, WS_MOD)[b * 6144 + job * 32 + cc] = s + bias[job * 32 + cc]; }
    __syncthreads();
}
__device__ __forceinline__ void s5_setup(Frame& F, int g, int kmin, int kmax, LAS f32x2* Bb, LAS f32x2* Cc, LAS f32x2* Ap) {
    const float* lre = F.in[14] + g * 64; const float* lim = F.in[15] + g * 64; const float dt = expf(F.in[16][g]);
    const float* bre = F.in[17] + g * 1024; const float* bim = F.in[18] + g * 1024; const float* cre = F.in[19] + g * 1024; const float* cim = F.in[20] + g * 1024;
    for (int i = F.tid; i < 1024; i += 512) { const int p = i >> 4; const float lr = lre[p], li = lim[p]; const float mag = expf(lr * dt); float sn, cs; sincosf(li * dt, &sn, &cs);
        const float ar = mag * cs, ai = mag * sn, den = lr * lr + li * li, qr = ((ar - 1.f) * lr + ai * li) / den, qi = (ai * lr - (ar - 1.f) * li) / den;
        const float br = bre[i], bi = bim[i]; Bb[i] = (f32x2){qr * br - qi * bi, qr * bi + qi * br};
        Cc[i] = (f32x2){cre[i], cim[i]}; }
    if (F.tid < 64) { const int p = F.tid; const float lr = lre[p], li = lim[p]; const float mag = expf(lr * dt); float sn, cs; sincosf(li * dt, &sn, &cs);
        const float ar = mag * cs, ai = mag * sn; float xr_ = 1.f, xi_ = 0.f;
        for (int k = 0; k <= kmax; ++k) { if (k >= kmin) Ap[k * 64 + p] = (f32x2){xr_, xi_}; const float nr = xr_ * ar - xi_ * ai, ni = xr_ * ai + xi_ * ar; xr_ = nr; xi_ = ni; } }
    __syncthreads();
}
constexpr size_t WS_KTAB = WS_S;
constexpr size_t WS_WRIMG = WS_AL + 512 * 1024;
__device__ __forceinline__ void p0_s5k_job(Frame& F, int job) {
    const int g = job >> 3, part = job & 7;
    LAS f32x2* Bb = (LAS f32x2*)F.lds; LAS f32x2* Cc = Bb + 1024; LAS f32x2* Ap = Cc + 1024;
    s5_setup(F, g, 4 * part, 4 * part + 3, Bb, Cc, Ap);
    float* kt = WSP(float, WS_KTAB) + (size_t)g * 32 * 256;
    for (int e = 4 * part * 256 + F.tid; e < (4 * part + 4) * 256; e += 512) { const int k = e >> 8, c = (e >> 4) & 15, c2 = e & 15; float s = 0.f;
        for (int p = 0; p < 64; ++p) { const f32x2 cv = Cc[c * 64 + p], av = Ap[k * 64 + p], bv = Bb[p * 16 + c2];
            const float car = cv.x * av.x - cv.y * av.y, cai = cv.x * av.y + cv.y * av.x; s += car * bv.x - cai * bv.y; }
        kt[e] = s; }
    __syncthreads();
}
__device__ __forceinline__ void p1_s5w_job(Frame& F, int job) {
    const int g = job >> 3, part = job & 7;
    LAS f32x2* Bb = (LAS f32x2*)F.lds; LAS f32x2* Cc = Bb + 1024; LAS f32x2* Ap = Cc + 1024; LAS float* Kt = (LAS float*)(Ap + 33 * 64);
    const float* ktg = WSP(float, WS_KTAB) + (size_t)g * 32 * 256; const float* dsk = F.in[21] + g * 16;
    { f32x4 kv[4];
#pragma unroll
      for (int k = 0; k < 4; ++k) kv[k] = *(const f32x4*)(ktg + 4 * (F.tid + 512 * k));
#pragma unroll
      for (int k = 0; k < 4; ++k) *(LAS f32x4*)(Kt + 4 * (F.tid + 512 * k)) = kv[k]; }
    s5_setup(F, g, 0, S5L, Bb, Cc, Ap);
    if (part == 0 && F.tid < 64) WSP(f32x2, WS_AL)[g * 64 + F.tid] = Ap[S5L * 64 + F.tid];
    bf16* wy = WSP(bf16, WS_WY) + (size_t)g * 512 * S5ROW;
    for (int ch = F.tid; ch < 64 * (S5ROW / 8); ch += 512) { const int n = part * 64 + ch / (S5ROW / 8), k8 = (ch % (S5ROW / 8)) * 8, i = n >> 4, c = n & 15; float v[8]; const float dskc = dsk[c];
        if (k8 < 128) {
#pragma unroll
            for (int j = 0; j < 8; j += 2) { const int p = (k8 + j) >> 1; const f32x2 cv = Cc[c * 64 + p], av = Ap[(i + 1) * 64 + p]; v[j] = cv.x * av.x - cv.y * av.y; v[j + 1] = -(cv.x * av.y + cv.y * av.x); } }
        else { const int jj = (k8 - 128) >> 4, c2 = (k8 - 128) & 15;
#pragma unroll
            for (int j = 0; j < 8; ++j) { float x = 0.f; if (jj <= i) { x = Kt[(i - jj) * 256 + c * 16 + c2 + j]; x += (jj == i && c == c2 + j) ? dskc : 0.f; } v[j] = x; } }
        u32x4 o; o.x = pk2(v[0], v[1]); o.y = pk2(v[2], v[3]); o.z = pk2(v[4], v[5]); o.w = pk2(v[6], v[7]);
        *(u32x4*)(wy + (size_t)n * S5ROW + k8) = o; }
    bf16* wsm = WSP(bf16, WS_WS) + (size_t)g * 256 * 512;
    for (int ch = F.tid; ch < 32 * 64; ch += 512) { const int n = part * 32 + (ch >> 6), k8 = (ch & 63) * 8, jj = k8 >> 4, c2 = k8 & 15; float v[8];
#pragma unroll
        for (int j = 0; j < 8; ++j) { float x = 0.f; if (n < 128) { const int p = n >> 1; const f32x2 av = Ap[(S5L - 1 - jj) * 64 + p], bv = Bb[p * 16 + c2 + j]; x = (n & 1) ? (av.x * bv.y + av.y * bv.x) : (av.x * bv.x - av.y * bv.y); } v[j] = x; }
        u32x4 o; o.x = pk2(v[0], v[1]); o.y = pk2(v[2], v[3]); o.z = pk2(v[4], v[5]); o.w = pk2(v[6], v[7]);
        *(u32x4*)(wsm + (size_t)n * 512 + k8) = o; }
    __syncthreads();
}
__device__ __forceinline__ void p0_small_transposes(Frame& F) {
    LAS float* scr = (LAS float*)(F.lds + F.wave * 16384);
    const int gw = F.vcu * 8 + F.wave, NGW = F.G * 8;
    constexpr int I_IN = 16 * 144, I_RNN = 16 * 32, I_OUT = 16 * 32, I_GLU = 8 * 64, I_RG = 16 * 8;
    for (int it = gw; it < I_IN + I_RNN + I_OUT + I_GLU + I_RG; it += NGW) { int r = it;
        if (r < I_IN) { const int kb = r / 144, nb = r % 144; transpose_item8(F.in[4], INC, kb * 64, nb * 32, WSP(unsigned char, WS_WIN), 1024, nb * 32, scr, F.lane); continue; } r -= I_IN;
        if (r < I_RNN) { const int kb = r / 32, nb = r % 32; transpose_item8(F.in[13], 1024, kb * 64, nb * 32, WSP(unsigned char, WS_WRNN), 1024, nb * 32, scr, F.lane); continue; } r -= I_RNN;
        if (r < I_OUT) { const int kb = r / 32, nb = r % 32; transpose_item8(F.in[23], 1024, kb * 64, nb * 32, WSP(unsigned char, WS_WOUT), 1024, nb * 32, scr, F.lane); continue; } r -= I_OUT;
        if (r < I_GLU) { const int kb = r / 64, nb = r % 64; transpose_item8(F.in[22], 2048, kb * 64, nb * 32, WSP(unsigned char, WS_WGLU), 512, pair_row(nb * 32), scr, F.lane); continue; } r -= I_GLU;
        { const int mat = r >> 3, kb = (r >> 2) & 1, nb = r & 3, hd = mat & 7, gx = mat >> 3;
          transpose_item(F.in[gx ? 10 : 8] + (size_t)hd * 128 * 128, 128, kb * 64, nb * 32, WSP(bf16, WS_WG), 128, hd * 256 + gx * 128 + nb * 32, scr, F.lane); }
    }
}
__device__ __forceinline__ void p1_hbf(Frame& F) {
    const int gw = F.vcu * 8 + F.wave, NGW = F.G * 8; const float* mod = WSP(float, WS_MOD); bf16* hbf = WSP(bf16, WS_HBF);
    for (int tb = 4 * gw; tb < T; tb += 4 * NGW) {
        const int b = tb >> 12; f32x4 xv[4][4], shv[4], scv[4];
#pragma unroll
        for (int r = 0; r < 4; ++r) { const f32x4* xr = (const f32x4*)(F.in[0] + (size_t)(tb + r) * 1024) + F.lane;
#pragma unroll
            for (int j = 0; j < 4; ++j) xv[r][j] = xr[64 * j]; }
#pragma unroll
        for (int j = 0; j < 4; ++j) { shv[j] = *((const f32x4*)(mod + b * 6144) + F.lane + 64 * j); scv[j] = *((const f32x4*)(mod + b * 6144 + 1024) + F.lane + 64 * j) + 1.0f; }
#pragma unroll
        for (int r = 0; r < 4; ++r) { unsigned* o = (unsigned*)((unsigned char*)hbf + (size_t)(tb + r) * 1024) + F.lane;
#pragma unroll
            for (int j = 0; j < 4; ++j) { const f32x4 v = xv[r][j] * scv[j] + shv[j]; o[64 * j] = pk4_fp8(v[0], v[1], v[2], v[3]); } } }
}
__device__ __forceinline__ void p1_moe_weights(Frame& F) {
    constexpr int TP = 132;
    LAS float* tile = (LAS float*)F.lds;
    constexpr int TILES_GU = 8 * 16, TILES_D = 8 * 8, TILES_E = TILES_GU + TILES_D;
    const int lr = F.tid >> 5, lc4 = (F.tid & 31) * 4, tn = F.tid >> 2, kc = F.tid & 3;
    f32x4 pre[8];
    int ti = F.vcu;
#define P1_SRC(idx, src, N_, dstp, drow0_, k0_) do { const int e_ = (idx) / TILES_E, r_ = (idx) % TILES_E; \
        if (r_ < TILES_GU) { const int kb_ = r_ >> 4, nb_ = r_ & 15; N_ = 2048; src = F.in[28] + (size_t)e_ * 1024 * 2048 + (size_t)(kb_ * 128) * 2048 + nb_ * 128; dstp = WSP(unsigned char, WS_WGU) + (size_t)e_ * 2048 * 1024; drow0_ = pair_row(nb_ * 128); k0_ = kb_ * 128; } \
        else { const int q_ = r_ - TILES_GU, kb_ = q_ >> 3, nb_ = q_ & 7; N_ = 1024; src = F.in[30] + (size_t)e_ * 1024 * 1024 + (size_t)(kb_ * 128) * 1024 + nb_ * 128; dstp = WSP(unsigned char, WS_WD) + (size_t)e_ * 1024 * 1024; drow0_ = nb_ * 128; k0_ = kb_ * 128; } } while (0)
    if (ti < NE * TILES_E) { const float* src; unsigned char* dstp; int N_, d0, k0; P1_SRC(ti, src, N_, dstp, d0, k0);
#pragma unroll
        for (int i = 0; i < 8; ++i) pre[i] = *(const f32x4*)(src + (size_t)(lr + 16 * i) * N_ + lc4); }
    for (; ti < NE * TILES_E; ti += F.G) {
#pragma unroll
        for (int i = 0; i < 8; ++i) *(LAS f32x4*)(tile + (lr + 16 * i) * TP + lc4) = pre[i];
        __syncthreads();
        const int tnx = (ti + F.G < NE * TILES_E) ? ti + F.G : ti;
        { const float* src; unsigned char* dstp; int N_, d0, k0; P1_SRC(tnx, src, N_, dstp, d0, k0);
#pragma unroll
            for (int i = 0; i < 8; ++i) pre[i] = *(const f32x4*)(src + (size_t)(lr + 16 * i) * N_ + lc4); }
        { const float* src; unsigned char* dstp; int N_, d0, k0; P1_SRC(ti, src, N_, dstp, d0, k0); (void)src; (void)N_;
          const LAS float* cp = tile + (32 * kc) * TP + tn; u32x4 o0, o1; float cv[32];
#pragma unroll
          for (int i = 0; i < 32; ++i) cv[i] = cp[i * TP];
          asm volatile("s_waitcnt lgkmcnt(0)" ::: "memory");
#pragma unroll
          for (int i = 0; i < 32; ++i) cv[i] *= 32.f;
          o0.x = pk4_fp8(cv[0], cv[1], cv[2], cv[3]); o0.y = pk4_fp8(cv[4], cv[5], cv[6], cv[7]); o0.z = pk4_fp8(cv[8], cv[9], cv[10], cv[11]); o0.w = pk4_fp8(cv[12], cv[13], cv[14], cv[15]);
          o1.x = pk4_fp8(cv[16], cv[17], cv[18], cv[19]); o1.y = pk4_fp8(cv[20], cv[21], cv[22], cv[23]); o1.z = pk4_fp8(cv[24], cv[25], cv[26], cv[27]); o1.w = pk4_fp8(cv[28], cv[29], cv[30], cv[31]);
          unsigned char* op = dstp + (size_t)(d0 + tn) * 1024 + k0 + 32 * kc; *(u32x4*)op = o0; *(u32x4*)(op + 16) = o1; }
        __syncthreads();
    }
#undef P1_SRC
}
constexpr int XR_LD = 136, XR_TILE = 128 * XR_LD, LU_LD = 132, GYP = 144;
static_assert(128 * LU_LD * 4 <= 2 * XR_TILE * 2, "pass-A pair tile must fit in the gy tile area");
__device__ __forceinline__ void rg_issue(const bf16* xrnn, const bf16* gy, int item, int tid, u32x2 (&xraw)[4][4], u32x2 (&graw)[4], bool pass1) {
    const int hd = item & 7, c = (item >> 3) & 31, b = item >> 8, r0 = tid >> 4, ch = hd * 128 + (tid & 15) * 8;
#pragma unroll
    for (int q = 0; q < 4; ++q) { const int r = r0 + 32 * q;
#pragma unroll
        for (int k = 0; k < 4; ++k) { const int tp = c * RGL + r - 3 + k, tpc = tp < 0 ? 0 : tp; xraw[q][k] = *(const u32x2*)((const unsigned char*)xrnn + (size_t)(b * SEQ + tpc) * 1024 + ch); }
        if (pass1) graw[q] = *(const u32x2*)((const unsigned char*)gy + (size_t)(b * SEQ + c * RGL + r) * 1024 + ch); }
}
__device__ __forceinline__ void rg_convwrite(const LAS float* cwl, int item, int tid, const u32x2 (&xraw)[4][4], const u32x2 (&graw)[4], LAS bf16* xr, LAS bf16* gyt, bool pass1) {
    const int c = (item >> 3) & 31, r0 = tid >> 4, c8 = (tid & 15) * 8;
    const f32x4 b0 = *(const LAS f32x4*)(cwl + 4 * 128 + c8), b1 = *(const LAS f32x4*)(cwl + 4 * 128 + c8 + 4);
    f32x4 w0[4], w1[4];
#pragma unroll
    for (int k = 0; k < 4; ++k) { w0[k] = *(const LAS f32x4*)(cwl + k * 128 + c8); w1[k] = *(const LAS f32x4*)(cwl + k * 128 + c8 + 4); }
#pragma unroll
    for (int q = 0; q < 4; ++q) { const int r = r0 + 32 * q; f32x4 a0 = b0, a1 = b1;
#pragma unroll
        for (int k = 0; k < 4; ++k) { const int tp = c * RGL + r - 3 + k; f32x4 x0, x1; unpack8_fp8(xraw[q][k], x0, x1); if (tp < 0) { x0 = (f32x4){0.f, 0.f, 0.f, 0.f}; x1 = x0; } a0 += w0[k] * x0; a1 += w1[k] * x1; }
        *(LAS u32x4*)(xr + r * XR_LD + c8) = pack8(a0, a1);
        if (pass1) { f32x4 ga_, gb_; unpack8_fp8(graw[q], ga_, gb_); *(LAS u32x4*)(gyt + r * XR_LD + c8) = pack8(ga_, gb_); } }
}
template <int PASS>
__device__ __forceinline__ void rglru_phase(Frame& F) {
    const int NIT = NB * RGC * 8;
    const bool skew = (PASS == 0) && (F.G == 256);
    const int nmine = skew ? (F.vcu < 128 ? 7 : 9) : (NIT - F.vcu + F.G - 1) / F.G;
#define RG_ITEM(k) ((skew && (k) >= 7) ? (1792 + (F.vcu - 128) + 128 * ((k) - 7)) : (F.vcu + (k) * F.G))
    if (nmine <= 0) return;
    int it = RG_ITEM(0);
    LAS bf16* xr = (LAS bf16*)F.lds; LAS bf16* gyt0 = xr + XR_TILE;
    const bf16* xrnn = WSP(bf16, WS_XRNN); const bf16* gy = WSP(bf16, WS_GY); bf16* ha = WSP(bf16, WS_HA); const float* cw = F.in[6]; const float* cb = F.in[7];
    const int tid = F.tid, w = F.wave, q = F.lane >> 4, col = F.lane & 15, chl = 16 * w + col;
    u32x2 xraw[4][4], graw[4];
    LAS float* cwl = (LAS float*)(gyt0 + 2 * XR_TILE);
    LAS unsigned* lut = (LAS unsigned*)gyt0;
    { const int chh = (it & 7) * 128 + (tid & 127); const float v0 = cw[(tid >> 7) * 1024 + chh], v1 = cb[chh]; cwl[tid] = v0; if (tid < 128) cwl[512 + tid] = v1; }
    rg_issue(xrnn, gy, it, tid, xraw, graw, PASS);
    __syncthreads();
    rg_convwrite(cwl, it, tid, xraw, graw, xr, gyt0, PASS);
    bf16x8 Bf[2][4]; float ba, bx, sp;
    { const int hd0 = it & 7, ch0 = hd0 * 128 + chl; const bf16* wg = WSP(bf16, WS_WG) + (size_t)hd0 * 256 * 128;
#pragma unroll
      for (int gt = 0; gt < 2; ++gt)
#pragma unroll
          for (int kk = 0; kk < 4; ++kk) Bf[gt][kk] = *(const bf16x8*)(wg + (size_t)(gt * 128 + chl) * 128 + kk * 32 + q * 8);
      ba = F.in[9][ch0]; bx = F.in[11][ch0]; const float lam = F.in[12][ch0]; sp = (lam > 15.f) ? __expf(-lam) : log1pf(__expf(-lam)); }
#pragma unroll
    for (int gt = 0; gt < 2; ++gt)
#pragma unroll
        for (int kk = 0; kk < 4; ++kk) asm volatile("" :: "v"(Bf[gt][kk]));
    asm volatile("" :: "v"(ba), "v"(bx), "v"(sp));
    const float spc = -11.541560327f * sp;
    __syncthreads();
    for (int i = 0; i < nmine; ++i) {
        const bool has_next = (i + 1) < nmine; const int nit = has_next ? RG_ITEM(i + 1) : it;
        const int hd = it & 7, c = (it >> 3) & 31, b = it >> 8, t0 = b * SEQ + c * RGL, ch = hd * 128 + chl;
        LAS bf16* gyt = gyt0 + (i & 1) * XR_TILE; LAS bf16* gytn = gyt0 + ((i & 1) ^ 1) * XR_TILE;
        float carryH = 0.f, carryP = 1.f;
        if (PASS) carryH = WSP(float, WS_HIN)[(size_t)(b * RGC + c) * 1024 + ch];
        __builtin_amdgcn_sched_barrier(0);
        rg_issue(xrnn, gy, nit, tid, xraw, graw, PASS);
        __builtin_amdgcn_sched_barrier(0);
        f32x4 acc[8][2];
#pragma unroll
        for (int m = 0; m < 8; ++m) { acc[m][0] = (f32x4){0.f, 0.f, 0.f, 0.f}; acc[m][1] = (f32x4){0.f, 0.f, 0.f, 0.f}; }
#pragma unroll
        for (int kk = 0; kk < 4; ++kk)
#pragma unroll
            for (int m = 0; m < 8; ++m) { const bf16x8 Af = *(const LAS bf16x8*)(xr + (16 * m + col) * XR_LD + kk * 32 + q * 8);
                acc[m][0] = __builtin_amdgcn_mfma_f32_16x16x32_bf16(Af, Bf[0][kk], acc[m][0], 0, 0, 0);
                acc[m][1] = __builtin_amdgcn_mfma_f32_16x16x32_bf16(Af, Bf[1][kk], acc[m][1], 0, 0, 0); }
#pragma unroll
        for (int m = 0; m < 8; ++m) {
            f32x4 a, uu;
            { const LAS bf16* xp = xr + (16 * m + 4 * q) * XR_LD + chl; const f32x4 xv = {bf1(xp[0]), bf1(xp[XR_LD]), bf1(xp[2 * XR_LD]), bf1(xp[3 * XR_LD])};
              const f32x4 r = sigmoid_v(acc[m][0] + ba), ii = sigmoid_v(acc[m][1] + bx);
              const f32x4 la = r * spc; a = exp2_v(la); f32x4 om = 1.0f - a * a;
#pragma unroll
              for (int j = 0; j < 4; ++j) om[j] = __builtin_amdgcn_sqrtf(fmaxf(om[j], 0.f));
              uu = om * ii * xv;
              if (!PASS) {
#pragma unroll
                  for (int j = 0; j < 4; ++j) lut[(16 * m + 4 * q + j) * LU_LD + chl] = pk2(la[j], uu[j]); } }
            float sP = a[0], sH = uu[0];
#pragma unroll
            for (int j = 1; j < 4; ++j) { sH = a[j] * sH + uu[j]; sP *= a[j]; }
            if (PASS) {
            float iP = sP, iH = sH;
            { const float pP = __shfl_up(iP, 16), pH = __shfl_up(iH, 16); if (q >= 1) { iH = iP * pH + iH; iP = iP * pP; } }
            { const float pP = __shfl_up(iP, 32), pH = __shfl_up(iH, 32); if (q >= 2) { iH = iP * pH + iH; iP = iP * pP; } }
            float eP = __shfl_up(iP, 16), eH = __shfl_up(iH, 16); if (q == 0) { eP = 1.f; eH = 0.f; }
            const float tP = __shfl(iP, col + 48), tH = __shfl(iH, col + 48);
            { float h = eP * carryH + eH;
#pragma unroll
                for (int j = 0; j < 4; ++j) { const int tl = 16 * m + 4 * q + j; h = a[j] * h + uu[j]; LAS bf16* gp = gyt + tl * XR_LD + chl; *gp = (bf16)f2bf(h * bf1(*gp)); } }
            carryH = tP * carryH + tH; carryP *= tP;
            } else {
            { const float nP = __shfl_down(sP, 16), nH = __shfl_down(sH, 16); sH = nP * sH + nH; sP = sP * nP; }
            { const float nP = __shfl_down(sP, 32), nH = __shfl_down(sH, 32); sH = nP * sH + nH; sP = sP * nP; }
            carryH = sP * carryH + sH; carryP *= sP; }
        }
        if (!PASS && q == 0) { f32x2* ag = WSP(f32x2, WS_RGAGG); ag[(size_t)(b * RGC + c) * 1024 + ch] = (f32x2){carryP, carryH}; }
        __syncthreads();
        if (!PASS) { unsigned* LU = WSP(unsigned, WS_LU);
#pragma unroll
            for (int k = 0; k < 8; ++k) { const int p = tid + 512 * k, row = p >> 5, c4 = (p & 31) * 4; *(u32x4*)(LU + (size_t)(t0 + row) * 1024 + hd * 128 + c4) = *(const LAS u32x4*)(lut + row * LU_LD + c4); } }
        if (PASS) { const int r0 = tid >> 4, c8 = (tid & 15) * 8;
#pragma unroll
            for (int qq = 0; qq < 4; ++qq) { const int r = r0 + 32 * qq; f32x4 h0, h1; unpack8(*(const LAS u32x4*)(gyt + r * XR_LD + c8), h0, h1); u32x2 w8; w8.x = pk4_fp8(h0[0], h0[1], h0[2], h0[3]); w8.y = pk4_fp8(h1[0], h1[1], h1[2], h1[3]);
                *(u32x2*)((unsigned char*)ha + (size_t)(t0 + r) * 1024 + hd * 128 + c8) = w8; } }
#pragma unroll
        for (int qq = 0; qq < 4; ++qq) {
#pragma unroll
            for (int k = 0; k < 4; ++k) asm volatile("" : "+v"(xraw[qq][k]));
            if (PASS) asm volatile("" : "+v"(graw[qq])); }
        if (has_next) rg_convwrite(cwl, nit, tid, xraw, graw, xr, gytn, PASS);
        __syncthreads();
        it = nit;
    }
#undef RG_ITEM
}
__device__ __forceinline__ void rg_passB(Frame& F) {
    const int NIT = NB * RGC * 8; const int nmine = (NIT - F.vcu + F.G - 1) / F.G; if (nmine <= 0) return;
    LAS unsigned* lut = (LAS unsigned*)F.lds;
    LAS unsigned char* gyl = (LAS unsigned char*)F.lds + 128 * LU_LD * 4;
    LAS unsigned char* outl = gyl + 128 * GYP;
    LAS float* agg = (LAS float*)(outl + 128 * GYP);
    const unsigned* LU = WSP(unsigned, WS_LU); const unsigned char* gy = WSP(unsigned char, WS_GY); unsigned char* ha = WSP(unsigned char, WS_HA); const float* hin = WSP(float, WS_HIN);
    const int tid = F.tid, cg = tid & 63, seg = F.wave;
    u32x4 lu[8], gq[2]; f32x2 cin;
#define RGB_ISSUE(item) do { const int hd_ = (item) & 7, c_ = ((item) >> 3) & 31, b_ = (item) >> 8, t0_ = b_ * SEQ + c_ * RGL; \
        _Pragma("unroll") for (int k = 0; k < 8; ++k) { const int p = tid + 512 * k, row = p >> 5, c4 = (p & 31) * 4; lu[k] = *(const u32x4*)(LU + (size_t)(t0_ + row) * 1024 + hd_ * 128 + c4); } \
        _Pragma("unroll") for (int k = 0; k < 2; ++k) { const int p = tid + 512 * k, row = p >> 3, c16 = (p & 7) * 16; gq[k] = *(const u32x4*)(gy + (size_t)(t0_ + row) * 1024 + hd_ * 128 + c16); } \
        cin = *(const f32x2*)(hin + (size_t)(b_ * RGC + c_) * 1024 + hd_ * 128 + 2 * cg); } while (0)
    int it = F.vcu;
    RGB_ISSUE(it);
    for (int i = 0; i < nmine; ++i) {
        const bool has_next = (i + 1) < nmine; const int nit = has_next ? it + F.G : it;
        const int hd = it & 7, c = (it >> 3) & 31, b = it >> 8, t0 = b * SEQ + c * RGL;
#pragma unroll
        for (int k = 0; k < 8; ++k) { const int p = tid + 512 * k, row = p >> 5, c4 = (p & 31) * 4; *(LAS u32x4*)(lut + row * LU_LD + c4) = lu[k]; }
#pragma unroll
        for (int k = 0; k < 2; ++k) { const int p = tid + 512 * k, row = p >> 3, c16 = (p & 7) * 16; *(LAS u32x4*)(gyl + row * GYP + c16) = gq[k]; }
        f32x2 h = cin;
        __syncthreads();
        __builtin_amdgcn_sched_barrier(0);
        RGB_ISSUE(nit);
        __builtin_amdgcn_sched_barrier(0);
        f32x2 av[16], uv[16]; f32x2 P = {1.f, 1.f}, H = {0.f, 0.f};
#pragma unroll
        for (int s_ = 0; s_ < 16; ++s_) { const u32x2 w = *(const LAS u32x2*)(lut + (16 * seg + s_) * LU_LD + 2 * cg);
            uv[s_] = (f32x2){bfhi(w.x), bfhi(w.y)}; av[s_] = (f32x2){__builtin_amdgcn_exp2f(bflo(w.x)), __builtin_amdgcn_exp2f(bflo(w.y))};
            H = av[s_] * H + uv[s_]; P = P * av[s_]; }
        *(LAS f32x4*)(agg + (seg * 128 + 2 * cg) * 2) = (f32x4){P.x, H.x, P.y, H.y};
        __syncthreads();
        for (int s2 = 0; s2 < seg; ++s2) { const f32x4 g = *(const LAS f32x4*)(agg + (s2 * 128 + 2 * cg) * 2); h.x = g[0] * h.x + g[1]; h.y = g[2] * h.y + g[3]; }
#pragma unroll
        for (int s_ = 0; s_ < 16; ++s_) { const int t = 16 * seg + s_; h = av[s_] * h + uv[s_];
            const int gb2 = (int)*(const LAS unsigned short*)(gyl + t * GYP + 2 * cg); const f32x2 g = __builtin_amdgcn_cvt_pk_f32_fp8(gb2, false);
            const f32x2 o = h * g; const int w8 = __builtin_amdgcn_cvt_pk_fp8_f32(__builtin_amdgcn_fmed3f(o.x, -448.f, 448.f), __builtin_amdgcn_fmed3f(o.y, -448.f, 448.f), 0, false);
            *(LAS unsigned short*)(outl + t * GYP + 2 * cg) = (unsigned short)w8; }
        __syncthreads();
#pragma unroll
        for (int k = 0; k < 2; ++k) { const int p = tid + 512 * k, row = p >> 3, c16 = (p & 7) * 16; *(u32x4*)(ha + (size_t)(t0 + row) * 1024 + hd * 128 + c16) = *(const LAS u32x4*)(outl + row * GYP + c16); }
        it = nit;
    }
#undef RGB_ISSUE
}
__device__ __forceinline__ void p4_carries(Frame& F) {
    LAS f32x2* seg = (LAS f32x2*)F.lds;
    for (int job = F.vcu; job < NB * S5G; job += F.G) {
        const int b = job >> 5, g = job & 31, p = F.lane, w = F.wave;
        const f32x2 al = WSP(f32x2, WS_AL)[g * 64 + p];
        const f32x2* Sb = WSP(f32x2, WS_S) + ((size_t)(g * S5M + b * S5CPB + 16 * w)) * 64 + p; unsigned* ac = (unsigned*)(WSP(bf16, WS_ACAT) + ((size_t)(g * S5M + b * S5CPB + 16 * w)) * S5ROW) + p;
        f32x2 sv[16];
#pragma unroll
        for (int i = 0; i < 16; ++i) sv[i] = Sb[(size_t)i * 64];
        float xr_ = 0.f, xi = 0.f;
#pragma unroll
        for (int i = 0; i < 16; ++i) { const float nr = al.x * xr_ - al.y * xi + sv[i].x, ni = al.x * xi + al.y * xr_ + sv[i].y; xr_ = nr; xi = ni; }
        seg[w * 64 + p] = (f32x2){xr_, xi};
        float ar = al.x, ai = al.y;
#pragma unroll
        for (int q = 0; q < 4; ++q) { const float nr = ar * ar - ai * ai, ni = 2.f * ar * ai; ar = nr; ai = ni; }
        __syncthreads();
        xr_ = 0.f; xi = 0.f;
        for (int ww = 0; ww < w; ++ww) { const f32x2 sg = seg[ww * 64 + p]; const float nr = ar * xr_ - ai * xi + sg.x, ni = ar * xi + ai * xr_ + sg.y; xr_ = nr; xi = ni; }
#pragma unroll
        for (int i = 0; i < 16; ++i) { ac[(size_t)i * (S5ROW / 2)] = pk2(xr_, xi); const float nr = al.x * xr_ - al.y * xi + sv[i].x, ni = al.x * xi + al.y * xr_ + sv[i].y; xr_ = nr; xi = ni; }
        __syncthreads();
    }
    if (F.vcu < 16) {
        const int id = F.vcu * 512 + F.tid, ch = id & 1023, b = id >> 10; const f32x2* ag = WSP(f32x2, WS_RGAGG) + (size_t)b * RGC * 1024 + ch; float* hin = WSP(float, WS_HIN) + (size_t)b * RGC * 1024 + ch;
        f32x2 a[RGC];
#pragma unroll
        for (int c = 0; c < RGC; ++c) a[c] = ag[(size_t)c * 1024];
        float h = 0.f;
#pragma unroll
        for (int c = 0; c < RGC; ++c) { hin[(size_t)c * 1024] = h; h = a[c].x * h + a[c].y; }
    }
}
constexpr int WR_LD = 1032;
__device__ __forceinline__ void p9_router(Frame& F) {
    LAS bf16* wH = (LAS bf16*)F.lds; LAS bf16* wL = wH + 32 * WR_LD;
    LAS f32x2* sel = (LAS f32x2*)(wL + 32 * WR_LD);
    LAS unsigned* rec = (LAS unsigned*)(sel + 512);
    LAS float* recp = (LAS float*)(rec + 512);
    LAS int* lcnt = (LAS int*)(recp + 512);
    LAS int* gbase = lcnt + 32;
    { const u32x4* img = WSP(u32x4, WS_WRIMG); LAS u32x4* dst = (LAS u32x4*)wH;
      constexpr int NV = 2 * 32 * WR_LD * 2 / 16, NK = (NV + 511) / 512; u32x4 tv[NK];
#pragma unroll
      for (int k = 0; k < NK; ++k) { const int i = F.tid + 512 * k; tv[k] = img[i < NV ? i : NV - 1]; }
#pragma unroll
      for (int k = 0; k < NK; ++k) { const int i = F.tid + 512 * k; if (i < NV) dst[i] = tv[k]; } }
    if (F.tid < 32) lcnt[F.tid] = 0;
    __syncthreads();
    const float* mod = WSP(float, WS_MOD); const bf16* v1 = WSP(bf16, WS_V1); bf16* x1 = WSP(bf16, WS_X1); unsigned char* h2 = WSP(unsigned char, WS_H2);
    const int lane = F.lane, m = lane & 15, kq = lane >> 4, w = F.wave;
    for (int blk = F.vcu; blk < T / 128; blk += F.G) {
        const int t = blk * 128 + w * 16 + m, b = (blk * 128) >> 12;
        const bf16* vrow = v1 + (size_t)t * 1024 + 8 * kq;
        float sum = 0.f, sq = 0.f;
#pragma unroll 32
        for (int s_ = 0; s_ < 32; ++s_) { f32x4 a, c; unpack8(*(const u32x4*)(vrow + 32 * s_), a, c); sum += ((a[0] + a[1]) + (a[2] + a[3])) + ((c[0] + c[1]) + (c[2] + c[3]));
            sq += ((a[0] * a[0] + a[1] * a[1]) + (a[2] * a[2] + a[3] * a[3])) + ((c[0] * c[0] + c[1] * c[1]) + (c[2] * c[2] + c[3] * c[3])); }
        sum += __shfl_xor(sum, 16); sum += __shfl_xor(sum, 32); sq += __shfl_xor(sq, 16); sq += __shfl_xor(sq, 32);
        const float mean = sum * (1.f / 1024.f); const float rstd = 1.f / sqrtf(fmaxf(sq * (1.f / 1024.f) - mean * mean, 0.f) + LN_EPS);
        f32x4 acc[2] = {(f32x4){0.f, 0.f, 0.f, 0.f}, (f32x4){0.f, 0.f, 0.f, 0.f}};
        const float* lng = F.in[24] + 8 * kq; const float* lnb = F.in[25] + 8 * kq; const float* shp = mod + b * 6144 + 3072 + 8 * kq; const float* scp = mod + b * 6144 + 4096 + 8 * kq;
        bf16* x1row = x1 + (size_t)t * 1024 + 8 * kq; unsigned char* h2row = h2 + (size_t)t * 1024 + 8 * kq;
        const LAS bf16* wHr = wH + m * WR_LD + 8 * kq; const LAS bf16* wLr = wL + m * WR_LD + 8 * kq;
        u32x4 rw[2][2]; f32x4 pg[2][2][2], pb[2][2][2], psh[2][2][2], psc[2][2][2];
#define P9_LOAD(SET, s2_) do { _Pragma("unroll") for (int h = 0; h < 2; ++h) { const int ko = 32 * ((s2_) + h); rw[SET][h] = *(const u32x4*)(vrow + ko); \
                pg[SET][h][0] = *(const f32x4*)(lng + ko); pg[SET][h][1] = *(const f32x4*)(lng + ko + 4); pb[SET][h][0] = *(const f32x4*)(lnb + ko); pb[SET][h][1] = *(const f32x4*)(lnb + ko + 4); \
                psh[SET][h][0] = *(const f32x4*)(shp + ko); psh[SET][h][1] = *(const f32x4*)(shp + ko + 4); psc[SET][h][0] = *(const f32x4*)(scp + ko); psc[SET][h][1] = *(const f32x4*)(scp + ko + 4); } } while (0)
#define P9_COMP(SET, s2_) do { _Pragma("unroll") for (int h = 0; h < 2; ++h) { const int ko = 32 * ((s2_) + h); \
                f32x4 a, c; unpack8(rw[SET][h], a, c); \
                const f32x4 x0 = (a - mean) * rstd * pg[SET][h][0] + pb[SET][h][0], x1v = (c - mean) * rstd * pg[SET][h][1] + pb[SET][h][1]; \
                *(u32x4*)(x1row + ko) = pack8(x0, x1v); \
                const f32x4 h0 = x0 * (psc[SET][h][0] + 1.0f) + psh[SET][h][0], h1 = x1v * (psc[SET][h][1] + 1.0f) + psh[SET][h][1]; \
                u32x2 w8; w8.x = pk4_fp8(h0[0], h0[1], h0[2], h0[3]); w8.y = pk4_fp8(h1[0], h1[1], h1[2], h1[3]); *(u32x2*)(h2row + ko) = w8; \
                const u32x4 hi = pack8(h0, h1); f32x4 r0, r1; unpack8(hi, r0, r1); const u32x4 lo = pack8(h0 - r0, h1 - r1); \
                const bf16x8 ah = __builtin_bit_cast(bf16x8, hi), al = __builtin_bit_cast(bf16x8, lo); \
                _Pragma("unroll") for (int nf = 0; nf < 2; ++nf) { const bf16x8 bh = *(const LAS bf16x8*)(wHr + nf * 16 * WR_LD + ko), bl = *(const LAS bf16x8*)(wLr + nf * 16 * WR_LD + ko); \
                    acc[nf] = __builtin_amdgcn_mfma_f32_16x16x32_bf16(bh, ah, acc[nf], 0, 0, 0); \
                    acc[nf] = __builtin_amdgcn_mfma_f32_16x16x32_bf16(bl, ah, acc[nf], 0, 0, 0); \
                    acc[nf] = __builtin_amdgcn_mfma_f32_16x16x32_bf16(bh, al, acc[nf], 0, 0, 0); } } } while (0)
        P9_LOAD(0, 0);
        for (int s2 = 0; s2 < 32; s2 += 4) {
            P9_LOAD(1, s2 + 2);
            __builtin_amdgcn_sched_barrier(0);
            P9_COMP(0, s2);
            __builtin_amdgcn_sched_barrier(0);
            { const int sn = (s2 + 4 < 32) ? s2 + 4 : 28; P9_LOAD(0, sn); }
            __builtin_amdgcn_sched_barrier(0);
            P9_COMP(1, s2 + 2);
            __builtin_amdgcn_sched_barrier(0);
        }
#undef P9_LOAD
#undef P9_COMP
        float lv[8];
#pragma unroll
        for (int nf = 0; nf < 2; ++nf)
#pragma unroll
            for (int j = 0; j < 4; ++j) lv[nf * 4 + j] = acc[nf][j] + F.in[27][nf * 16 + 4 * kq + j];
        int rank[8];
#pragma unroll
        for (int i = 0; i < 8; ++i) { rank[i] = 0;
#pragma unroll
            for (int i2 = 0; i2 < 8; ++i2) if (i2 != i) { const int e1 = (i >> 2) * 16 + 4 * kq + (i & 3), e2 = (i2 >> 2) * 16 + 4 * kq + (i2 & 3); rank[i] += (lv[i2] > lv[i] || (lv[i2] == lv[i] && e2 < e1)) ? 1 : 0; } }
#pragma unroll
        for (int dq = 1; dq < 4; ++dq) { const int q2 = kq ^ dq;
#pragma unroll
            for (int i2 = 0; i2 < 8; ++i2) { const float o = __shfl_xor(lv[i2], 16 * dq); const int e2 = (i2 >> 2) * 16 + 4 * q2 + (i2 & 3);
#pragma unroll
                for (int i = 0; i < 8; ++i) { const int e1 = (i >> 2) * 16 + 4 * kq + (i & 3); rank[i] += (o > lv[i] || (o == lv[i] && e2 < e1)) ? 1 : 0; } } }
#pragma unroll
        for (int i = 0; i < 8; ++i) if (rank[i] < 4) { const int e1 = (i >> 2) * 16 + 4 * kq + (i & 3); sel[(w * 16 + m) * 4 + rank[i]] = (f32x2){__builtin_bit_cast(float, e1), lv[i]}; }
        asm volatile("s_waitcnt lgkmcnt(0)" ::: "memory");
        { const int tm = lane >> 2, k = lane & 3; const f32x2 s0 = sel[(w * 16 + tm) * 4 + 0], s1 = sel[(w * 16 + tm) * 4 + 1], s2 = sel[(w * 16 + tm) * 4 + 2], s3 = sel[(w * 16 + tm) * 4 + 3];
          const float p0 = 1.f, p1 = __expf(s1.y - s0.y), p2 = __expf(s2.y - s0.y), p3 = __expf(s3.y - s0.y), ps = (p0 + p1) + (p2 + p3);
          const f32x2 mine = k == 0 ? s0 : (k == 1 ? s1 : (k == 2 ? s2 : s3)); const float pm = (k == 0 ? p0 : (k == 1 ? p1 : (k == 2 ? p2 : p3))) / ps;
          const int e = __builtin_bit_cast(int, mine.x);
          const int lr = __hip_atomic_fetch_add(lcnt + e, 1, __ATOMIC_RELAXED, __HIP_MEMORY_SCOPE_WORKGROUP);
          rec[(w * 16 + tm) * 4 + k] = ((unsigned)e << 16) | (unsigned)lr; recp[(w * 16 + tm) * 4 + k] = pm; }
        __syncthreads();
        if (F.tid < 32) { const int n = lcnt[F.tid]; gbase[F.tid] = n ? (int)atomicAdd(F.ctl + CW_CNT + 64 * F.tid, (unsigned)n) : 0; lcnt[F.tid] = 0; }
        __syncthreads();
        { const unsigned r = rec[F.tid]; const int e = r >> 16, rk = gbase[e] + (int)(r & 0xffffu), tt = blk * 128 + (F.tid >> 2);
          WSP(int, WS_TOK)[(size_t)e * T + rk] = tt; WSP(unsigned, WS_POS)[(size_t)tt * 4 + (F.tid & 3)] = ((unsigned)e << 20) | (unsigned)rk; WSP(float, WS_PROB)[(size_t)tt * 4 + (F.tid & 3)] = recp[F.tid]; }
        __syncthreads();
    }
}
__device__ __forceinline__ void p12_final(Frame& F, bool have_tables) {
    if (!have_tables) moe_tables(F);
    const LAS int* tstart = (const LAS int*)(F.lds + TAB_OFF);
    const float* mod = WSP(float, WS_MOD); const bf16* x1 = WSP(bf16, WS_X1); const bf16* yb = WSP(bf16, WS_YB); const unsigned* pos = WSP(unsigned, WS_POS); const float* prob = WSP(float, WS_PROB);
    const int lane = F.lane, gw = F.vcu * 8 + F.wave, NGW = F.G * 8;
    f32x4 lg[4], lb[4];
#pragma unroll
    for (int j = 0; j < 4; ++j) { lg[j] = *(const f32x4*)(F.in[32] + 512 * (j >> 1) + 8 * lane + 4 * (j & 1)); lb[j] = *(const f32x4*)(F.in[33] + 512 * (j >> 1) + 8 * lane + 4 * (j & 1)); }
#define P12_ROUTE(PP, PW, tt) do { const u32x4 p4_ = *(const u32x4*)(pos + (size_t)(tt) * 4); const f32x4 w4_ = *(const f32x4*)(prob + (size_t)(tt) * 4); \
        PP[0] = p4_.x; PP[1] = p4_.y; PP[2] = p4_.z; PP[3] = p4_.w; PW[0] = w4_[0]; PW[1] = w4_[1]; PW[2] = w4_[2]; PW[3] = w4_[3]; } while (0)
#define P12_ROWS(YW, XW, PP, tt) do { _Pragma("unroll") for (int k = 0; k < 4; ++k) { const int e_ = PP[k] >> 20, rk_ = PP[k] & 0xfffffu; const size_t slot_ = (size_t)tstart[e_] * 256 + rk_; \
            _Pragma("unroll") for (int j = 0; j < 2; ++j) YW[k][j] = *((const u32x2*)((const unsigned char*)yb + slot_ * 1024) + 64 * j + lane); } \
        _Pragma("unroll") for (int j = 0; j < 2; ++j) XW[j] = *((const u32x4*)(x1 + (size_t)(tt) * 1024) + 64 * j + lane); } while (0)
#define P12_COMPUTE(YW, XW, PW, tt) do { const int b_ = (tt) >> 12; f32x4 v[4]; float s_ = 0.f; \
        _Pragma("unroll") for (int j = 0; j < 2; ++j) { f32x4 f0 = (f32x4){0.f, 0.f, 0.f, 0.f}, f1 = f0; \
            _Pragma("unroll") for (int k = 0; k < 4; ++k) { const u32x2 yv_ = YW[k][j]; const f32x2 q0_ = __builtin_amdgcn_cvt_pk_f32_fp8((int)yv_.x, false), q1_ = __builtin_amdgcn_cvt_pk_f32_fp8((int)yv_.x, true), q2_ = __builtin_amdgcn_cvt_pk_f32_fp8((int)yv_.y, false), q3_ = __builtin_amdgcn_cvt_pk_f32_fp8((int)yv_.y, true); \
                f0 += (f32x4){q0_.x, q0_.y, q1_.x, q1_.y} * PW[k]; f1 += (f32x4){q2_.x, q2_.y, q3_.x, q3_.y} * PW[k]; } \
            f32x4 xa_, xc_; unpack8(XW[j], xa_, xc_); const float* gp_ = mod + b_ * 6144 + 5120 + 512 * j + 8 * lane; \
            v[2 * j] = xa_ * DN_ALPHA + (*(const f32x4*)gp_ + 1.0f) * f0; v[2 * j + 1] = xc_ * DN_ALPHA + (*(const f32x4*)(gp_ + 4) + 1.0f) * f1; \
            s_ += ((v[2 * j][0] + v[2 * j][1]) + (v[2 * j][2] + v[2 * j][3])) + ((v[2 * j + 1][0] + v[2 * j + 1][1]) + (v[2 * j + 1][2] + v[2 * j + 1][3])); } \
        const float mean_ = wave_sum(s_) * (1.f / 1024.f); float s2_ = 0.f; \
        _Pragma("unroll") for (int j = 0; j < 4; ++j) { v[j] = v[j] - mean_; s2_ += (v[j][0] * v[j][0] + v[j][1] * v[j][1]) + (v[j][2] * v[j][2] + v[j][3] * v[j][3]); } \
        const float rstd_ = 1.f / sqrtf(wave_sum(s2_) * (1.f / 1024.f) + LN_EPS); \
        _Pragma("unroll") for (int j = 0; j < 4; ++j) *(f32x4*)(F.out + (size_t)(tt) * 1024 + 512 * (j >> 1) + 8 * lane + 4 * (j & 1)) = v[j] * rstd_ * lg[j] + lb[j]; } while (0)
    const int nmine = (T - gw + NGW - 1) / NGW;
    unsigned ppA[4], ppB[4]; float pwA[4], pwB[4], pwN[4]; u32x2 ywA[4][2], ywB[4][2]; u32x4 xwA[2], xwB[2];
    if (nmine > 0) { P12_ROUTE(ppA, pwA, gw); P12_ROWS(ywA, xwA, ppA, gw); }
    if (nmine > 1) { P12_ROUTE(ppB, pwB, gw + NGW); }
    for (int i = 0; i < nmine; i += 2) {
        const int t0 = gw + i * NGW, t1 = t0 + NGW, t2 = t1 + NGW, t3 = t2 + NGW;
        if (i + 1 < nmine) { P12_ROWS(ywB, xwB, ppB, t1); }
        if (i + 2 < nmine) { P12_ROUTE(ppA, pwN, t2); }
        __builtin_amdgcn_sched_barrier(0);
        P12_COMPUTE(ywA, xwA, pwA, t0);
        if (i + 1 < nmine) {
#pragma unroll
            for (int k = 0; k < 4; ++k) pwA[k] = pwN[k];
            if (i + 2 < nmine) { P12_ROWS(ywA, xwA, ppA, t2); }
            if (i + 3 < nmine) { P12_ROUTE(ppB, pwN, t3); }
            __builtin_amdgcn_sched_barrier(0);
            P12_COMPUTE(ywB, xwB, pwB, t1);
#pragma unroll
            for (int k = 0; k < 4; ++k) pwB[k] = pwN[k];
        }
    }
#undef P12_ROUTE
#undef P12_ROWS
#undef P12_COMPUTE
}

__device__ __forceinline__ void wg_publish(Frame& F, int word) {
    asm volatile("s_waitcnt vmcnt(0)" ::: "memory"); __syncthreads();
    if (F.tid == 0) { __builtin_amdgcn_fence(__ATOMIC_RELEASE, "agent"); asm volatile("s_waitcnt vmcnt(0)" ::: "memory"); __hip_atomic_fetch_add(F.ctl + word, 1u, __ATOMIC_RELAXED, __HIP_MEMORY_SCOPE_AGENT); }
}
__device__ __forceinline__ void wg_wait(Frame& F, int word, unsigned need) {
    if (F.tid < 64) { unsigned sp_ = 0;
        while ((unsigned)__builtin_amdgcn_readfirstlane(__hip_atomic_load(F.ctl + word, __ATOMIC_RELAXED, __HIP_MEMORY_SCOPE_AGENT)) < need) { __builtin_amdgcn_s_sleep(2);
            if (++sp_ > (1u << 20)) { if (F.tid == 0) atomicAdd(F.ctl + CW_BAR + XB_TMO, 1u); break; } }
        __builtin_amdgcn_fence(__ATOMIC_ACQUIRE, "agent"); asm volatile("s_waitcnt vmcnt(0)" ::: "memory"); }
    __syncthreads();
}
struct Args { const float* in[34]; float* out; unsigned char* ws; int ph_lo, ph_hi; };
__global__ void __launch_bounds__(512, 2) fwd_kernel(Args args) {
    extern __shared__ __attribute__((aligned(16))) unsigned char lds_raw[];
    Frame F;
    F.lds = (LAS unsigned char*)lds_raw; F.MISC = (volatile LAS unsigned*)(F.lds + MISC_OFF);
    F.tid = threadIdx.x; F.lane = F.tid & 63; F.wave = __builtin_amdgcn_readfirstlane(F.tid >> 6);
    F.G = gridDim.x; { const int bx = blockIdx.x; F.vcu = (F.G % 8 == 0) ? (bx % 8) * (F.G / 8) + bx / 8 : bx; }
#pragma unroll
    for (int i = 0; i < 34; ++i) F.in[i] = args.in[i];
    F.out = args.out; F.ws = args.ws; F.ctl = (unsigned*)(args.ws + WS_CTL);
    if (F.tid < 64) F.MISC[F.tid] = 0u;
    __syncthreads();
    XcdBarrier bar; bar.bar = F.ctl + CW_BAR; bar.x = 0; bar.st = nullptr;
    if (MK_N_LAUNCHES == 1) bar = xcd_barrier_post(F.ctl + CW_BAR, F.MISC + 8);
    const int lo = args.ph_lo, hi = args.ph_hi;
#define IN(k) (lo <= (k) && (k) < hi)
#ifndef DUP_UNITS
#define DUP_UNITS -1
#endif
#define SEAM(k) do { if (IN(k) && IN((k) + 1)) xcd_barrier(bar); } while (0)

    if (IN(0)) REPS(0) { if (rep_) xcd_barrier(bar);
        for (int j = F.vcu; j < 192; j += F.G) p0_mod_job(F, j);
        for (int j = F.vcu; j < S5G * 8; j += F.G) p0_s5k_job(F, j);
        { bf16* img = WSP(bf16, WS_WRIMG); const float* wr = F.in[26];
          for (int i = F.vcu * 512 + F.tid; i < 1024 * 32; i += F.G * 512) { const float w = wr[i]; const unsigned hb = f2bf(w); const float hf = __builtin_bit_cast(float, hb << 16);
              img[(i & 31) * 1032 + (i >> 5)] = (bf16)hb; img[32 * 1032 + (i & 31) * 1032 + (i >> 5)] = (bf16)f2bf(w - hf); } }
        p0_small_transposes(F);
    }
    const bool chain01 = IN(0) && IN(1);
    if (chain01) wg_publish(F, CW_P0DONE); else SEAM(0);
    if (IN(1)) REPS(1) { if (rep_) xcd_barrier(bar);
        p1_moe_weights(F);
        if (chain01) wg_wait(F, CW_P0DONE, (unsigned)F.G);
        for (int j = F.vcu; j < S5G * 8; j += F.G) p1_s5w_job(F, j);
        p1_hbf(F); }
    SEAM(1);
    if (IN(2)) REPS(2) { if (rep_) xcd_barrier(bar);
        g8::GridOrder S; S.init(T, INC, F.G, (int)blockIdx.x, WSP(bf16, WS_HBF), WSP(bf16, WS_WIN), 1024, 1024); S.dup = (DUP_UNITS == 2);
        EpiInProj E{F.in[5], WSP(bf16, WS_XRNN), WSP(bf16, WS_GY), WSP(bf16, WS_ACAT), WSP(bf16, WS_GATES)};
        g8::gemm_phase<EpiInProj, g8::GridOrder, false, true>(F.lds, 1024, 1024, 1024, S, E);
    }
    SEAM(2);
    if (IN(3)) REPS(3) { if (rep_) xcd_barrier(bar);
        { S5AOrder S{F.G, F.vcu, (const char*)WSP(bf16, WS_ACAT), (const char*)WSP(bf16, WS_WS)}; EpiS5A E{WSP(float, WS_S)};
          g8::gemm_phase<EpiS5A, S5AOrder, false>(F.lds, S5L * 32, S5ROW * 2, S5L * 32, S, E); }
        __syncthreads();
        rglru_phase<0>(F);
    }
    SEAM(3);
    if (IN(4)) REPS(4) { if (rep_) xcd_barrier(bar); p4_carries(F); }
    SEAM(4);
    if (IN(5)) REPS(5) { if (rep_) xcd_barrier(bar);
        { S5COrder S{F.G, F.vcu, (const char*)WSP(bf16, WS_ACAT), (const char*)WSP(bf16, WS_WY)}; EpiS5C E{WSP(bf16, WS_YS)};
          g8::gemm_phase<EpiS5C, S5COrder, false>(F.lds, S5ROW * 2, S5ROW * 2, S5ROW * 2, S, E); }
        if (IN(6)) wg_publish(F, CW_S5CDONE);
        __syncthreads();
        rg_passB(F);
    }
    if (IN(5) && IN(6)) wg_wait(F, CW_S5CDONE, (unsigned)F.G); else SEAM(5);
    if (IN(6)) REPS(6) { if (rep_) xcd_barrier(bar);
        g8::GridOrder S; S.init(T, 2048, F.G, (int)blockIdx.x, WSP(bf16, WS_YS), WSP(bf16, WS_WGLU), 512, 512); S.dup = (DUP_UNITS == 6);
        EpiGlu E{WSP(bf16, WS_GATES), WSP(bf16, WS_GB)};
        g8::gemm_phase<EpiGlu, g8::GridOrder, false, true>(F.lds, 512, 512, 512, S, E);
    }
    SEAM(6);
    if (IN(7)) REPS(7) { if (rep_) xcd_barrier(bar);
        g8::GridOrder S; S.init(T, 1024, F.G, (int)blockIdx.x, WSP(bf16, WS_HA), WSP(bf16, WS_WRNN), 1024, 1024); S.dup = (DUP_UNITS == 7);
        EpiRnn E{WSP(bf16, WS_GATES), WSP(bf16, WS_GB), WSP(bf16, WS_MERGED)};
        g8::gemm_phase<EpiRnn, g8::GridOrder, false, true>(F.lds, 1024, 1024, 1024, S, E);
    }
    SEAM(7);
    if (IN(8)) REPS(8) { if (rep_) xcd_barrier(bar);
        g8::GridOrder S; S.init(T, 1024, F.G, (int)blockIdx.x, WSP(bf16, WS_MERGED), WSP(bf16, WS_WOUT), 1024, 1024); S.dup = (DUP_UNITS == 8);
        EpiOut E{F.in[0], WSP(float, WS_MOD), WSP(bf16, WS_V1)};
        g8::gemm_phase<EpiOut, g8::GridOrder, false, true>(F.lds, 1024, 1024, 1024, S, E);
    }
    SEAM(8);
    if (IN(9)) REPS(9) { if (rep_) xcd_barrier(bar); p9_router(F); }
    SEAM(9);
    if (IN(10)) REPS(10) { if (rep_) xcd_barrier(bar);
        moe_tables(F);
        const LAS int* tstart = (const LAS int*)(F.lds + TAB_OFF);
        MoeOrder S{F.G, (int)blockIdx.x, 8, tstart[NE], tstart, tstart + 40, WSP(int, WS_TOK), (const char*)WSP(bf16, WS_H2), (const char*)WSP(bf16, WS_WGU), (size_t)2048 * 1024, 1024, true, (DUP_UNITS == 10)};
        EpiMoe1 E{F.in[29], WSP(bf16, WS_ACT)};
        g8::gemm_phase<EpiMoe1, MoeOrder, true, true>(F.lds, 1024, 1024, 1024, S, E);
    }
    SEAM(10);
    if (IN(11)) REPS(11) { if (rep_) xcd_barrier(bar);
        if (!IN(10)) moe_tables(F);
        const LAS int* tstart = (const LAS int*)(F.lds + TAB_OFF);
        MoeOrder S{F.G, (int)blockIdx.x, 4, tstart[NE], tstart, tstart + 40, WSP(int, WS_TOK), (const char*)WSP(bf16, WS_ACT), (const char*)WSP(bf16, WS_WD), (size_t)1024 * 1024, 1024, false, (DUP_UNITS == 11)};
        EpiMoe2 E{F.in[31], WSP(bf16, WS_YB)};
        g8::gemm_phase<EpiMoe2, MoeOrder, false, true>(F.lds, 1024, 1024, 1024, S, E);
    }
    SEAM(11);
    if (IN(12)) REPS(12) { if (rep_) xcd_barrier(bar); p12_final(F, IN(10)); }
#undef IN
#undef SEAM
}

extern "C" void kernel_launch(void* const* d_in, const int* in_sizes, int n_in, void* d_out, int out_size, void* d_ws, size_t ws_size, hipStream_t stream) {
    static int grid = 0;
    if (grid == 0) {
        if (n_in != 34 || in_sizes[0] != T * D || out_size != T * D || ws_size < WS_END) { fprintf(stderr, "kernel_launch: unexpected shapes (n_in %d, ws %zu < %zu)\n", n_in, ws_size, (size_t)WS_END); grid = -1; return; }
        int dev = 0, cus = 0;
        if (hipGetDevice(&dev) != hipSuccess || hipDeviceGetAttribute(&cus, hipDeviceAttributeMultiprocessorCount, dev) != hipSuccess) { grid = -1; return; }
        if (hipFuncSetAttribute((const void*)fwd_kernel, hipFuncAttributeMaxDynamicSharedMemorySize, LDS_BYTES) != hipSuccess) { fprintf(stderr, "kernel_launch: hipFuncSetAttribute failed\n"); grid = -1; return; }
        int per_cu = 0; (void)hipOccupancyMaxActiveBlocksPerMultiprocessor(&per_cu, (const void*)fwd_kernel, 512, LDS_BYTES); (void)hipGetLastError();
        grid = cus;
    }
    if (grid < 0) return;
    (void)hipMemsetAsync((char*)d_ws + WS_CTL, 0, CTL_BYTES, stream);
    Args a{};
    for (int i = 0; i < 34; ++i) a.in[i] = (const float*)d_in[i];
    a.out = (float*)d_out; a.ws = (unsigned char*)d_ws;
    if (MK_N_LAUNCHES == 1) { a.ph_lo = 0; a.ph_hi = N_PHASES; hipLaunchKernelGGL(fwd_kernel, dim3(grid), dim3(512), LDS_BYTES, stream, a); }
    else for (int p = 0; p < N_PHASES; ++p) { a.ph_lo = p; a.ph_hi = p + 1; hipLaunchKernelGGL(fwd_kernel, dim3(grid), dim3(512), LDS_BYTES, stream, a); }
}
```

```cpp
#include <hip/hip_runtime.h>
#include <cstdio>
#include <cstdint>

#ifndef MK_N_LAUNCHES
#define MK_N_LAUNCHES 1
#endif
constexpr int N_PHASES = 13;
#ifndef DUP_PHASE
#define DUP_PHASE -1
#endif
#define REPS(k) for (int rep_ = 0; rep_ < ((DUP_PHASE == (k)) ? 2 : 1); ++rep_)

#define GAS __attribute__((address_space(1)))
#define LAS __attribute__((address_space(3)))
typedef unsigned short bf16;
typedef short bf16x8 __attribute__((ext_vector_type(8)));
typedef float f32x4 __attribute__((ext_vector_type(4)));
typedef float f32x2 __attribute__((ext_vector_type(2)));
typedef unsigned u32x4 __attribute__((ext_vector_type(4)));
typedef unsigned u32x2 __attribute__((ext_vector_type(2)));
typedef GAS unsigned gu32;

constexpr int NB = 8, SEQ = 4096, T = NB * SEQ, D = 1024, INC = 4608, NE = 32, DFF = 1024;
constexpr int S5L = 32, S5G = 32, S5ROW = 128 + S5L * 16  , S5M = T / S5L  , S5CPB = SEQ / S5L  ;
constexpr int RGL = 128, RGC = SEQ / RGL  ;
constexpr float LN_EPS = 1e-5f, DN_ALPHA = 1.189207115002721f;
constexpr int ACT_ROWS = T * 4 + NE * 256;

constexpr size_t MiB = 1u << 20;
constexpr size_t WS_XRNN = 0, WS_GY = 64 * MiB, WS_GATES = 128 * MiB, WS_ACT = 0;
constexpr size_t WS_HBF = 272 * MiB, WS_HA = 272 * MiB, WS_YS = 336 * MiB, WS_GB = 368 * MiB, WS_MERGED = 432 * MiB, WS_ACAT = 496 * MiB, WS_YB = 272 * MiB;
constexpr size_t WS_X1 = 544 * MiB, WS_V1 = 544 * MiB, WS_H2 = 608 * MiB;
constexpr size_t WS_LU = 544 * MiB;
constexpr size_t WS_WGU = 672 * MiB, WS_WD = 800 * MiB, WS_WIN = 864 * MiB, WS_WG = 873 * MiB, WS_WRNN = 874 * MiB, WS_WGLU = 876 * MiB, WS_WOUT = 878 * MiB;
constexpr size_t WS_WS = 880 * MiB, WS_WY = 888 * MiB, WS_S = 908 * MiB;
constexpr int S5ROW8 = 768;
constexpr size_t WS_ACAT8 = 432 * MiB;
constexpr size_t WS_MOD = 924 * MiB, WS_AL = 925 * MiB, WS_RGAGG = 926 * MiB, WS_HIN = 928 * MiB, WS_TOK = 929 * MiB, WS_POS = 933 * MiB, WS_PROB = 934 * MiB, WS_STAT = 934 * MiB + 512 * 1024  , WS_CTL = 935 * MiB;
constexpr size_t WS_END = 936 * MiB, CTL_BYTES = 128 * 1024;
static_assert((size_t)ACT_ROWS * DFF * 2 <= 272 * MiB, "act/yb size");
static_assert(WS_ACAT + (size_t)S5G * S5M * S5ROW * 2 <= WS_X1, "acat");
constexpr int CW_BAR = 4096, CW_CNT = 8192  , CW_P0DONE = 12288  , CW_S5CDONE = 12352  ;

constexpr int LDS_BYTES = 147456, MISC_OFF = LDS_BYTES - 256, TAB_OFF = 131072 + 1024;

__device__ __forceinline__ unsigned f2bf(float f) { unsigned u = __builtin_bit_cast(unsigned, f); return (u + 0x7fffu + ((u >> 16) & 1u)) >> 16; }
typedef __bf16 bf16x2v __attribute__((ext_vector_type(2)));
__device__ __forceinline__ unsigned pk2(float lo, float hi) { const f32x2 v = {lo, hi}; const bf16x2v b = __builtin_convertvector(v, bf16x2v); return __builtin_bit_cast(unsigned, b); }
__device__ __forceinline__ unsigned pk4_fp8(float a, float b, float c, float d) { a = __builtin_amdgcn_fmed3f(a, -448.f, 448.f); b = __builtin_amdgcn_fmed3f(b, -448.f, 448.f); c = __builtin_amdgcn_fmed3f(c, -448.f, 448.f); d = __builtin_amdgcn_fmed3f(d, -448.f, 448.f); int w = 0; w = __builtin_amdgcn_cvt_pk_fp8_f32(a, b, w, false); w = __builtin_amdgcn_cvt_pk_fp8_f32(c, d, w, true); return (unsigned)w; }
__device__ __forceinline__ void unpack8_fp8(u32x2 w, f32x4& a, f32x4& b) { const f32x2 q0 = __builtin_amdgcn_cvt_pk_f32_fp8((int)w.x, false), q1 = __builtin_amdgcn_cvt_pk_f32_fp8((int)w.x, true), q2 = __builtin_amdgcn_cvt_pk_f32_fp8((int)w.y, false), q3 = __builtin_amdgcn_cvt_pk_f32_fp8((int)w.y, true);
    a = (f32x4){q0.x, q0.y, q1.x, q1.y}; b = (f32x4){q2.x, q2.y, q3.x, q3.y}; }
__device__ __forceinline__ float bflo(unsigned w) { return __builtin_bit_cast(float, w << 16); }
__device__ __forceinline__ float bfhi(unsigned w) { return __builtin_bit_cast(float, w & 0xffff0000u); }
__device__ __forceinline__ float bf1(bf16 h) { return __builtin_bit_cast(float, ((unsigned)h) << 16); }
__device__ __forceinline__ float fast_sigmoid(float x) { return __builtin_amdgcn_rcpf(1.0f + __builtin_amdgcn_exp2f(-1.4426950409f * x)); }
__device__ __forceinline__ float gelu_tanh(float x) { const float u = x + 0.044715f * x * x * x; return x * __builtin_amdgcn_rcpf(1.0f + __builtin_amdgcn_exp2f(-2.3022082f * u)); }
__device__ __forceinline__ f32x4 exp2_v(f32x4 x) { return (f32x4){__builtin_amdgcn_exp2f(x[0]), __builtin_amdgcn_exp2f(x[1]), __builtin_amdgcn_exp2f(x[2]), __builtin_amdgcn_exp2f(x[3])}; }
__device__ __forceinline__ f32x4 rcp_v(f32x4 x) { return (f32x4){__builtin_amdgcn_rcpf(x[0]), __builtin_amdgcn_rcpf(x[1]), __builtin_amdgcn_rcpf(x[2]), __builtin_amdgcn_rcpf(x[3])}; }
__device__ __forceinline__ f32x4 sigmoid_v(f32x4 x) { return rcp_v(exp2_v(x * -1.4426950409f) + 1.0f); }
__device__ __forceinline__ f32x4 gelu_v(f32x4 x) { const f32x4 u = x * x * 0.044715f * x + x; return x * rcp_v(exp2_v(u * -2.3022082f) + 1.0f); }
__device__ __forceinline__ unsigned pk4_fp8_nc(f32x4 v) { int w = 0; w = __builtin_amdgcn_cvt_pk_fp8_f32(v[0], v[1], w, false); w = __builtin_amdgcn_cvt_pk_fp8_f32(v[2], v[3], w, true); return (unsigned)w; }
__device__ __forceinline__ float wave_sum(float v) {
#pragma unroll
    for (int o = 1; o < 64; o <<= 1) v += __shfl_xor(v, o);
    return v;
}
__device__ __forceinline__ u32x4 pack8(f32x4 a, f32x4 b) { u32x4 w; w.x = pk2(a[0], a[1]); w.y = pk2(a[2], a[3]); w.z = pk2(b[0], b[1]); w.w = pk2(b[2], b[3]); return w; }
__device__ __forceinline__ void unpack8(u32x4 w, f32x4& a, f32x4& b) { a = (f32x4){bflo(w.x), bfhi(w.x), bflo(w.y), bfhi(w.y)}; b = (f32x4){bflo(w.z), bfhi(w.z), bflo(w.w), bfhi(w.w)}; }

#define XB_TMO      128
#define XB_XCNT(j)  (256  + 64 * (j))
#define XB_XSUB(j)  (1280 + 64 * (j))
#define XB_XGEN(j)  (2304 + 64 * (j))
#define XB_TOP      3328
#define XB_TOPGEN   3392
#define XCD_BAR_WORDS 3456
#define XB_SPIN_CAP (1u << 18)
__device__ __forceinline__ unsigned xb_ld(unsigned* p)              { return __hip_atomic_load(p, __ATOMIC_RELAXED, __HIP_MEMORY_SCOPE_AGENT); }
__device__ __forceinline__ unsigned xb_add(unsigned* p, unsigned v) { return __hip_atomic_fetch_add(p, v, __ATOMIC_RELAXED, __HIP_MEMORY_SCOPE_AGENT); }
__device__ __forceinline__ unsigned xb_xcc_id() { return (unsigned)__builtin_amdgcn_s_getreg((3 << 11) | 20) & 0xFu; }
#define XB_SPIN(cond, bar) do { unsigned _sp = 0; while (cond) { __builtin_amdgcn_s_sleep(1); \
    if ((++_sp & 255u) == 0u) { if (xb_ld(&(bar)[XB_TMO])) break; if (_sp > XB_SPIN_CAP) { atomicAdd(&(bar)[XB_TMO], 1u); break; } } } } while (0)
struct XcdBarrier { unsigned* bar; unsigned x; volatile LAS unsigned* st; };
__device__ __forceinline__ XcdBarrier xcd_barrier_post(unsigned* bar, volatile LAS unsigned* st) {
    XcdBarrier b; b.bar = bar; b.x = xb_xcc_id(); b.st = st;
    if (threadIdx.x == 0) (void)xb_add(&bar[XB_XCNT(b.x)], 1u);
    return b;
}
__device__ __forceinline__ void xcd_barrier_complete(unsigned* bar, unsigned x, unsigned& nloc, unsigned& nx) {
    const unsigned G = gridDim.x * gridDim.y * gridDim.z;
    unsigned sum, cnt, mine, sp = 0u;
    for (;;) {
        sum = 0u; cnt = 0u; mine = 0u;
#pragma unroll
        for (unsigned j = 0; j < 16; ++j) { const unsigned c = xb_ld(&bar[XB_XCNT(j)]); sum += c; cnt += (c > 0u) ? 1u : 0u; mine = (j == x) ? c : mine; }
        if (sum == G) break;
        __builtin_amdgcn_s_sleep(1);
        if ((++sp & 255u) == 0u) { if (xb_ld(&bar[XB_TMO])) break; if (sp > XB_SPIN_CAP) { atomicAdd(&bar[XB_TMO], 1u); break; } }
    }
    nloc = mine > 0u ? mine : 1u; nx = cnt > 0u ? cnt : 1u;
}
__device__ __forceinline__ void xcd_barrier(const XcdBarrier& b) {
    asm volatile("s_waitcnt vmcnt(0)" ::: "memory");
    __syncthreads();
    if (threadIdx.x == 0) {
        unsigned* bar = b.bar;
        __builtin_amdgcn_s_waitcnt(0);
        unsigned nloc = b.st[0], nx = b.st[1];
        if (nloc == 0u) { xcd_barrier_complete(bar, b.x, nloc, nx); b.st[0] = nloc; b.st[1] = nx; }
        unsigned old; { unsigned* ap_ = &bar[XB_XSUB(b.x)]; const unsigned one_ = 1u;
            asm volatile("global_atomic_add %0, %1, %2, off sc0\n\tbuffer_inv sc1\n\ts_waitcnt vmcnt(1)" : "=v"(old) : "v"(ap_), "v"(one_) : "memory"); }
        const unsigned gen = old / nloc;
        if (old + 1u == (gen + 1u) * nloc) {
            __builtin_amdgcn_fence(__ATOMIC_RELEASE, "agent");
            asm volatile("s_waitcnt vmcnt(0)" ::: "memory");
            (void)xb_add(&bar[XB_TOP], 1u);
        }
        XB_SPIN(xb_ld(&bar[XB_TOP]) < (gen + 1u) * nx, bar);
        asm volatile("s_waitcnt vmcnt(0)" ::: "memory");
    }
    __syncthreads();
}

namespace g8 {
constexpr int BM = 256, BK = 64, HALF = 128, HTB = HALF * BK * 2, STAGE_BYTES = 8 * HTB;
__device__ __forceinline__ int lds_byte(int r, int c) { const int st = (r >> 4) * 2 + (c >> 5), rr = r & 15, cc = c & 31, ob = rr * 64 + cc * 2; return st * 1024 + (ob ^ (((ob >> 9) & 1) << 5)); }
__device__ __forceinline__ void stage_rc(int b, int& R, int& C) { const int st = b / 1024, sb = b % 1024, swz = sb ^ (((sb >> 9) & 1) << 5); R = (st >> 1) * 16 + swz / 64; C = (st & 1) * 32 + (swz % 64) / 2; }
__device__ __forceinline__ int perm32(int rho) { const int n = rho >> 4, i = rho & 15; return 8 * (i >> 2) + 4 * n + (i & 3); }

struct Unit { int pm, pn, z, rl; const char* A; const char* B; };

typedef int v8i __attribute__((ext_vector_type(8)));
typedef int v4i __attribute__((ext_vector_type(4)));
typedef short s16x16 __attribute__((ext_vector_type(16)));
typedef s16x16 s16x16_a16 __attribute__((aligned(16)));
__device__ __forceinline__ v8i cat8(bf16x8 lo, bf16x8 hi) { const v4i a = __builtin_bit_cast(v4i, lo), b = __builtin_bit_cast(v4i, hi); return __builtin_shufflevector(a, b, 0, 1, 2, 3, 4, 5, 6, 7); }
template <class Epi, class Sched, bool GATHER, bool FP8 = false, bool HALF_N = false, int RELAXN = 0>
__device__ __forceinline__ void gemm_phase(LAS unsigned char* lds, const int Kb, const int ldaB, const int ldbB, const Sched& S, const Epi& E) {
    const int tid = threadIdx.x, wid = __builtin_amdgcn_readfirstlane(tid >> 6), lane = tid & 63, wr = wid >> 2, wc = wid & 3, fr = lane & 15, fq = lane >> 4;
    const int nt = Kb / 128;
    unsigned voffB[2], cvo[2][2], nvo[2][2]; int Rr[2], Cc[2];
#pragma unroll
    for (int i = 0; i < 2; ++i) { int R, C; stage_rc(tid * 16 + i * 8192, R, C); const int Rb = (R & ~31) + perm32(R & 31);
        voffB[i] = (unsigned)(Rb * ldbB + C * 2); Rr[i] = R; Cc[i] = C;
#pragma unroll
        for (int h = 0; h < 2; ++h) { cvo[h][i] = (unsigned)((h * HALF + R) * ldaB + C * 2); nvo[h][i] = cvo[h][i]; } }
    const size_t kstep = (size_t)(BK * 2);
    const size_t hstepB = (size_t)HALF * ldbB;
    const unsigned ldsw = (unsigned)wid * 1024u;
    const int aoff = FP8 ? lds_byte(wr * 64 + fr, (fq >> 1) * 32 + (fq & 1) * 24) : lds_byte(wr * 64 + fr, fq * 8), boff = FP8 ? lds_byte(wc * 32 + fr, (fq >> 1) * 32 + (fq & 1) * 24) : lds_byte(wc * 32 + fr, fq * 8);
    const int aoff2 = FP8 ? lds_byte(wr * 64 + fr, (fq >> 1) * 32 + 8 + (fq & 1) * 8) : 0, boff2 = FP8 ? lds_byte(wc * 32 + fr, (fq >> 1) * 32 + 8 + (fq & 1) * 8) : 0;
#define G8_SA(b, h) (((b) * 2 + (h)) * HTB)
#define G8_SB(b, h) ((4 + (b) * 2 + (h)) * HTB)
#define G8_STGB(bufoff, gbase) do { _Pragma("unroll") for (int _i = 0; _i < 2; ++_i) \
        __builtin_amdgcn_global_load_lds((const unsigned*)((const char*)(gbase) + voffB[_i]), (LAS unsigned*)(lds + (bufoff) + ldsw + _i * 8192), 16, 0, 0); } while (0)
#define G8_STGA(bufoff, gbase, VO, h) do { _Pragma("unroll") for (int _i = 0; _i < 2; ++_i) \
        __builtin_amdgcn_global_load_lds((const unsigned*)((const char*)(gbase) + VO[h][_i]), (LAS unsigned*)(lds + (bufoff) + ldsw + _i * 8192), 16, 0, 0); } while (0)
#define G8_LDA(dst, b, h) do { _Pragma("unroll") for (int m = 0; m < 4; ++m) { if constexpr (FP8) { dst##8[m] = cat8(*(const LAS bf16x8*)(lds + G8_SA(b, h) + aoff + m * 2048), *(const LAS bf16x8*)(lds + G8_SA(b, h) + aoff2 + m * 2048)); } \
        else { _Pragma("unroll") for (int k = 0; k < 2; ++k) dst[m][k] = *(const LAS bf16x8*)(lds + G8_SA(b, h) + aoff + m * 2048 + k * 1024); } } } while (0)
#define G8_LDB(dst, b, h) do { _Pragma("unroll") for (int n = 0; n < 2; ++n) { if constexpr (FP8) { dst##8[n] = cat8(*(const LAS bf16x8*)(lds + G8_SB(b, h) + boff + n * 2048), *(const LAS bf16x8*)(lds + G8_SB(b, h) + boff2 + n * 2048)); } \
        else { _Pragma("unroll") for (int k = 0; k < 2; ++k) dst[n][k] = *(const LAS bf16x8*)(lds + G8_SB(b, h) + boff + n * 2048 + k * 1024); } } } while (0)
#define G8_MMA(ai, bj, At, Bt) do { __builtin_amdgcn_s_setprio(1); _Pragma("unroll") for (int m = 0; m < 4; ++m) _Pragma("unroll") for (int n = 0; n < 2; ++n) { \
        if constexpr (FP8) asm volatile("s_nop 1\n\tv_mfma_scale_f32_16x16x128_f8f6f4 %0, %1, %2, %0, %3, %4 op_sel_hi:[0,0,0]" : "+v"(acc[ai][bj][m][n]) : "v"(Bt##8[n]), "v"(At##8[m]), "v"(sc_w), "v"(sc_a)); \
        else { _Pragma("unroll") for (int k = 0; k < 2; ++k) acc[ai][bj][m][n] = __builtin_amdgcn_mfma_f32_16x16x32_bf16(Bt[n][k], At[m][k], acc[ai][bj][m][n], 0, 0, 0); } } __builtin_amdgcn_s_setprio(0); } while (0)
#define G8_WAIT_V(n) asm volatile("s_waitcnt vmcnt(" #n ")" ::: "memory")
#define G8_WAIT_L(n) asm volatile("s_waitcnt lgkmcnt(" #n ")" ::: "memory")
#define G8_WAIT_V01() do { if constexpr (RELAXN > 0) { const int rf_ = __builtin_amdgcn_readfirstlane((t == 0 && ui > 0) ? 1 : 0); \
        asm volatile("s_cmp_lg_u32 %0, 0\n\ts_cbranch_scc1 1f\n\ts_waitcnt vmcnt(8)\n\ts_branch 2f\n1:\n\ts_waitcnt vmcnt(%1)\n2:" :: "s"(rf_), "n"(8 + RELAXN) : "memory", "scc"); } else G8_WAIT_V(8); } while (0)
#define G8_BAR __builtin_amdgcn_s_barrier()
#define G8_SCHED __builtin_amdgcn_sched_barrier(0)
    Unit cur, nxt; int ui = 0;
    if (!S.next(0, cur)) return;
    bool has_next = S.next(1, nxt);
    if constexpr (GATHER) { S.gather(cur, Rr, Cc, cvo); if (has_next) S.gather(nxt, Rr, Cc, nvo); else {
#pragma unroll
        for (int h = 0; h < 2; ++h)
#pragma unroll
            for (int i = 0; i < 2; ++i) nvo[h][i] = cvo[h][i]; } }
    f32x4 acc[2][2][4][2];
#pragma unroll
    for (int a = 0; a < 2; ++a)
#pragma unroll
        for (int b = 0; b < 2; ++b)
#pragma unroll
            for (int m = 0; m < 4; ++m)
#pragma unroll
                for (int n = 0; n < 2; ++n) acc[a][b][m][n] = (f32x4){0.f, 0.f, 0.f, 0.f};
    const int sc_w = 0x7a7a7a7a, sc_a = 0x7f7f7f7f;
    bf16x8 At[4][2], B0[2][2], B1[2][2]; v8i At8[4], B08[2], B18[2];
    const char* cA = cur.A; const char* cB = cur.B;
    G8_STGB(G8_SB(0, 0), cB); G8_STGB(G8_SB(0, 1), cB + hstepB); G8_STGA(G8_SA(0, 0), cA, cvo, 0); G8_STGA(G8_SA(0, 1), cA, cvo, 1);
    if (wr == 1) G8_BAR;
    G8_WAIT_V(2); G8_BAR;
    G8_STGB(G8_SB(1, 0), cB + kstep); G8_STGA(G8_SA(1, 0), cA + kstep, cvo, 0); G8_STGB(G8_SB(1, 1), cB + hstepB + kstep);
    G8_WAIT_V(6); G8_BAR;
    for (;;) {
        const char* nA = has_next ? nxt.A : cA; const char* nB = has_next ? nxt.B : cB;
        for (int t = 0; t < nt; t += 2) {
            const bool last = (t == nt - 2);
            const char* a1 = cA + (size_t)(t + 1) * kstep;
            const char* a2 = last ? nA : cA + (size_t)(t + 2) * kstep; const char* b2 = last ? nB : cB + (size_t)(t + 2) * kstep;
            const char* a3 = a2 + kstep; const char* b3 = b2 + kstep;
            unsigned vo2[2][2];
#pragma unroll
            for (int h = 0; h < 2; ++h)
#pragma unroll
                for (int i = 0; i < 2; ++i) vo2[h][i] = (GATHER && last) ? nvo[h][i] : cvo[h][i];
            G8_LDB(B0, 0, 0); if constexpr (!HALF_N) G8_LDB(B1, 0, 1); G8_SCHED; G8_LDA(At, 0, 0); G8_STGA(G8_SA(1, 1), a1, cvo, 1);
            G8_WAIT_V01(); G8_WAIT_L(0); G8_BAR; G8_SCHED; G8_MMA(0, 0, At, B0); if constexpr (!HALF_N) G8_MMA(0, 1, At, B1); G8_SCHED; G8_BAR; G8_SCHED;
            G8_LDA(At, 0, 1); G8_STGB(G8_SB(0, 0), b2); G8_STGB(G8_SB(0, 1), b2 + hstepB); G8_STGA(G8_SA(0, 0), a2, vo2, 0);
            G8_WAIT_V01(); G8_WAIT_L(0); G8_BAR; G8_SCHED; G8_MMA(1, 0, At, B0); if constexpr (!HALF_N) G8_MMA(1, 1, At, B1); G8_SCHED; G8_BAR; G8_SCHED;
            G8_LDB(B0, 1, 0); if constexpr (!HALF_N) G8_LDB(B1, 1, 1); G8_SCHED; G8_LDA(At, 1, 0); G8_STGA(G8_SA(0, 1), a2, vo2, 1);
            G8_WAIT_V(8); G8_WAIT_L(0); G8_BAR; G8_SCHED; G8_MMA(0, 0, At, B0); if constexpr (!HALF_N) G8_MMA(0, 1, At, B1); G8_SCHED; G8_BAR; G8_SCHED;
            G8_LDA(At, 1, 1); G8_STGB(G8_SB(1, 0), b3); G8_STGB(G8_SB(1, 1), b3 + hstepB); G8_STGA(G8_SA(1, 0), a3, vo2, 0);
            G8_WAIT_V(8); G8_WAIT_L(0); G8_BAR; G8_SCHED; G8_MMA(1, 0, At, B0); if constexpr (!HALF_N) G8_MMA(1, 1, At, B1); G8_SCHED; G8_BAR; G8_SCHED;
        }
        f32x4 bpre[Epi::NPRE]; E.pre(cur, wr, wc, fr, fq, bpre);
        if (wr == 0) G8_BAR;
        Unit nn; bool has_nn = false;
        if (has_next) has_nn = S.next(ui + 2, nn);
        unsigned nnvo[2][2];
        if constexpr (GATHER) { if (has_nn) S.gather(nn, Rr, Cc, nnvo); }
        if constexpr (FP8) asm volatile("s_nop 15\n\ts_nop 15" ::: "memory");
        E(acc, cur, wr, wc, fr, fq, bpre);
        if (!has_next) break;
#pragma unroll
        for (int a = 0; a < 2; ++a)
#pragma unroll
            for (int b = 0; b < 2; ++b)
#pragma unroll
                for (int m = 0; m < 4; ++m)
#pragma unroll
                    for (int n = 0; n < 2; ++n) acc[a][b][m][n] = (f32x4){0.f, 0.f, 0.f, 0.f};
        cur = nxt; cA = nA; cB = nB; ++ui;
        if constexpr (GATHER) {
#pragma unroll
            for (int h = 0; h < 2; ++h)
#pragma unroll
                for (int i = 0; i < 2; ++i) { cvo[h][i] = nvo[h][i]; if (has_nn) nvo[h][i] = nnvo[h][i]; } }
        nxt = nn; has_next = has_nn;
        if (wr == 1) G8_BAR;
    }
    G8_WAIT_V(0);
    G8_BAR;
#undef G8_SA
#undef G8_SB
#undef G8_STGB
#undef G8_STGA
#undef G8_LDA
#undef G8_LDB
#undef G8_MMA
#undef G8_WAIT_V
#undef G8_WAIT_L
#undef G8_WAIT_V01
#undef G8_BAR
#undef G8_SCHED
}

struct GridOrder {
    int nM, nN, nwg, G, c; const char* A; const char* B; size_t tstepA, tstepB; int dup = 0;
    __device__ __forceinline__ void init(int M, int N, int G_, int c_, const void* A_, const void* B_, int ldaB, int ldbB) { nM = M / BM; nN = N / BM; nwg = nM * nN; G = G_; c = c_; A = (const char*)A_; B = (const char*)B_; tstepA = (size_t)BM * ldaB; tstepB = (size_t)BM * ldbB; }
    __device__ __forceinline__ bool next(int i0, Unit& u) const { const int i = dup ? (i0 >> 1) : i0;
        const long L = (long)i * G + c; if (L >= nwg) return false;
        int wgid = (int)L; { const int q = nwg / 8, r = nwg % 8, xcd = wgid % 8, off = wgid / 8; wgid = (xcd < r ? xcd * (q + 1) : r * (q + 1) + (xcd - r) * q) + off; }
        const int nig = 8 * nN, gid = wgid / nig, fm = gid * 8, gsz = (nM - fm) < 8 ? (nM - fm) : 8;
        u.pm = fm + ((wgid % nig) % gsz); u.pn = (wgid % nig) / gsz; u.z = 0; u.rl = 0;
        u.A = A + (size_t)u.pm * tstepA; u.B = B + (size_t)u.pn * tstepB; return true;
    }
};
}

struct Frame {
    LAS unsigned char* lds; volatile LAS unsigned* MISC; unsigned* ctl;
    int tid, lane, wave, vcu, G;
    const float* in[34]; float* out; unsigned char* ws;
};
#define WSP(T_, off) ((T_*)(F.ws + (off)))

struct EpiInProj { static constexpr int NPRE = 4; static constexpr int NST = 16;
    __device__ __forceinline__ void pre(const g8::Unit& u, int, int wc, int, int fq, f32x4 (&bp)[4]) const { const int colb = u.pn * 256 + wc * 32 + 8 * fq;
#pragma unroll
        for (int bj = 0; bj < 2; ++bj)
#pragma unroll
            for (int n = 0; n < 2; ++n) bp[bj * 2 + n] = *(const f32x4*)(bias + colb + bj * 128 + 4 * n); }
    const float* bias; bf16 *xrnn, *gy, *acat, *gates; unsigned char* acat8;
    template <int KIND>
    __device__ __forceinline__ void run(const f32x4 (&acc)[2][2][4][2], const g8::Unit& u, int wr, int wc, int fr, int fq, const f32x4 (&bpre)[4]) const {
        const int colb = u.pn * 256 + wc * 32 + 8 * fq;
#pragma unroll
        for (int ai = 0; ai < 2; ++ai)
#pragma unroll
            for (int m = 0; m < 4; ++m) { const int t = u.pm * 256 + ai * 128 + wr * 64 + m * 16 + fr;
#pragma unroll
                for (int bj = 0; bj < 2; ++bj) { f32x4 v0 = acc[ai][bj][m][0] + bpre[bj * 2], v1 = acc[ai][bj][m][1] + bpre[bj * 2 + 1]; const int col = colb + bj * 128;
                    if (KIND == 0) { u32x2 w8; w8.x = pk4_fp8(v0[0], v0[1], v0[2], v0[3]); w8.y = pk4_fp8(v1[0], v1[1], v1[2], v1[3]); *(u32x2*)((unsigned char*)xrnn + (size_t)t * 1024 + col) = w8; }
                    else if (KIND == 1) {
#pragma unroll
                        for (int j = 0; j < 1; ++j) { v0 = gelu_v(v0); v1 = gelu_v(v1); }
                        u32x2 w8; w8.x = pk4_fp8(v0[0], v0[1], v0[2], v0[3]); w8.y = pk4_fp8(v1[0], v1[1], v1[2], v1[3]); *(u32x2*)((unsigned char*)gy + (size_t)t * 1024 + (col - 1024)) = w8; }
                    else if (KIND == 2) { const int cu = col - 2048, g = cu >> 4, c = cu & 15;
                        *(u32x4*)(acat + ((size_t)(g * S5M + (t >> 5)) * S5ROW + 128 + (t & 31) * 16 + c)) = pack8(v0, v1);
                        u32x2 w8; w8.x = pk4_fp8(v0[0], v0[1], v0[2], v0[3]); w8.y = pk4_fp8(v1[0], v1[1], v1[2], v1[3]);
                        *(u32x2*)(acat8 + ((size_t)(g * S5M + (t >> 5)) * S5ROW8 + 128 + (t & 31) * 16 + c)) = w8; }
                    else {
#pragma unroll
                        for (int j = 0; j < 1; ++j) { v0 = sigmoid_v(v0); v1 = sigmoid_v(v1); }
                        u32x2 w8; w8.x = pk4_fp8_nc(v0); w8.y = pk4_fp8_nc(v1); *(u32x2*)((unsigned char*)gates + (size_t)t * 2048 + (col - 2560)) = w8; } } }
    }
    __device__ __forceinline__ void operator()(const f32x4 (&acc)[2][2][4][2], const g8::Unit& u, int wr, int wc, int fr, int fq, const f32x4 (&bpre)[4]) const {
        const int pn = u.pn;
        if (pn < 4) run<0>(acc, u, wr, wc, fr, fq, bpre); else if (pn < 8) run<1>(acc, u, wr, wc, fr, fq, bpre); else if (pn < 10) run<2>(acc, u, wr, wc, fr, fq, bpre); else run<3>(acc, u, wr, wc, fr, fq, bpre);
    }
};
struct EpiS5A { static constexpr int NPRE = 4;
    __device__ __forceinline__ void pre(const g8::Unit&, int, int, int, int, f32x4 (&)[4]) const {}
    float* S;
    __device__ __forceinline__ void operator()(const f32x4 (&acc)[2][2][4][2], const g8::Unit& u, int wr, int wc, int fr, int fq, const f32x4 (&bpre)[4]) const {
        const int col = wc * 32 + 8 * fq;
#pragma unroll
        for (int ai = 0; ai < 2; ++ai)
#pragma unroll
            for (int m = 0; m < 4; ++m) { const int row = u.pm * 256 + ai * 128 + wr * 64 + m * 16 + fr; float* p = S + ((size_t)(u.z * S5M + row)) * 128 + col;
                *(f32x4*)p = acc[ai][0][m][0]; *(f32x4*)(p + 4) = acc[ai][0][m][1]; }
    }
};
struct EpiS5C { static constexpr int NPRE = 4;
    __device__ __forceinline__ void pre(const g8::Unit&, int, int, int, int, f32x4 (&)[4]) const {}
    bf16* ys;
    __device__ __forceinline__ void operator()(const f32x4 (&acc)[2][2][4][2], const g8::Unit& u, int wr, int wc, int fr, int fq, const f32x4 (&bpre)[4]) const {
#pragma unroll
        for (int ai = 0; ai < 2; ++ai)
#pragma unroll
            for (int m = 0; m < 4; ++m) { const int row = u.pm * 256 + ai * 128 + wr * 64 + m * 16 + fr;
#pragma unroll
                for (int bj = 0; bj < 2; ++bj) { const int n = u.pn * 256 + bj * 128 + wc * 32 + 8 * fq, i = n >> 4, c = n & 15; f32x4 v0 = acc[ai][bj][m][0], v1 = acc[ai][bj][m][1];
#pragma unroll
                    for (int j = 0; j < 1; ++j) { v0 = gelu_v(v0); v1 = gelu_v(v1); }
                    u32x2 w8; w8.x = pk4_fp8(v0[0], v0[1], v0[2], v0[3]); w8.y = pk4_fp8(v1[0], v1[1], v1[2], v1[3]); *(u32x2*)((unsigned char*)ys + (size_t)(row * 32 + i) * 512 + u.z * 16 + c) = w8; } }
    }
};
struct EpiGlu { static constexpr int NPRE = 4; static constexpr int NST = 8;
    __device__ __forceinline__ void pre(const g8::Unit& u, int wr, int wc, int fr, int fq, f32x4 (&bp)[4]) const { const int f = u.pn * 128 + wc * 32 + 8 * fq;
#pragma unroll
        for (int ai = 0; ai < 2; ++ai)
#pragma unroll
            for (int mh = 0; mh < 2; ++mh) { const int t = u.pm * 256 + ai * 128 + wr * 64 + (2 * mh) * 16 + fr;
                const u32x2 a = *(const u32x2*)((const unsigned char*)gates + (size_t)t * 2048 + 1024 + f), b = *(const u32x2*)((const unsigned char*)gates + (size_t)(t + 16) * 2048 + 1024 + f);
                bp[ai * 2 + mh] = __builtin_bit_cast(f32x4, (u32x4){a.x, a.y, b.x, b.y}); } }
    const bf16* gates; bf16* gb;
    __device__ __forceinline__ void operator()(const f32x4 (&acc)[2][2][4][2], const g8::Unit& u, int wr, int wc, int fr, int fq, const f32x4 (&bpre)[4]) const {
        const int f = u.pn * 128 + wc * 32 + 8 * fq;
#pragma unroll
        for (int ai = 0; ai < 2; ++ai) {
#pragma unroll
            for (int m = 0; m < 4; ++m) { const int t = u.pm * 256 + ai * 128 + wr * 64 + m * 16 + fr;
                const u32x4 pw = __builtin_bit_cast(u32x4, bpre[ai * 2 + (m >> 1)]); const u32x2 gwm = (m & 1) ? (u32x2){pw.z, pw.w} : (u32x2){pw.x, pw.y};
                f32x4 g0, g1; unpack8_fp8(gwm, g0, g1);
                f32x4 v0 = acc[ai][0][m][0], v1 = acc[ai][0][m][1]; const f32x4 s0 = acc[ai][1][m][0], s1 = acc[ai][1][m][1];
                v0 = g0 * v0 * sigmoid_v(s0); v1 = g1 * v1 * sigmoid_v(s1);
                u32x2 w8; w8.x = pk4_fp8(v0[0], v0[1], v0[2], v0[3]); w8.y = pk4_fp8(v1[0], v1[1], v1[2], v1[3]); *(u32x2*)((unsigned char*)gb + (size_t)t * 1024 + f) = w8; } }
    }
};
struct EpiRnn { static constexpr int NPRE = 16; static constexpr int NST = 16;
    __device__ __forceinline__ void pre(const g8::Unit& u, int wr, int wc, int fr, int fq, f32x4 (&bp)[16]) const {
#pragma unroll
        for (int ai = 0; ai < 2; ++ai)
#pragma unroll
            for (int m = 0; m < 4; ++m) { const int t = u.pm * 256 + ai * 128 + wr * 64 + m * 16 + fr;
                u32x2 g[2], b[2];
#pragma unroll
                for (int bj = 0; bj < 2; ++bj) { const int col = u.pn * 256 + bj * 128 + wc * 32 + 8 * fq; g[bj] = *(const u32x2*)((const unsigned char*)gates + (size_t)t * 2048 + col); b[bj] = *(const u32x2*)((const unsigned char*)gb + (size_t)t * 1024 + col); }
                bp[(ai * 4 + m) * 2] = __builtin_bit_cast(f32x4, (u32x4){g[0].x, g[0].y, g[1].x, g[1].y}); bp[(ai * 4 + m) * 2 + 1] = __builtin_bit_cast(f32x4, (u32x4){b[0].x, b[0].y, b[1].x, b[1].y}); } }
    const bf16* gates; const bf16* gb; bf16* merged;
    __device__ __forceinline__ void operator()(const f32x4 (&acc)[2][2][4][2], const g8::Unit& u, int wr, int wc, int fr, int fq, const f32x4 (&bpre)[16]) const {
#pragma unroll
        for (int ai = 0; ai < 2; ++ai)
#pragma unroll
            for (int m = 0; m < 4; ++m) { const int t = u.pm * 256 + ai * 128 + wr * 64 + m * 16 + fr;
                const u32x4 gq = __builtin_bit_cast(u32x4, bpre[(ai * 4 + m) * 2]), bq = __builtin_bit_cast(u32x4, bpre[(ai * 4 + m) * 2 + 1]);
#pragma unroll
                for (int bj = 0; bj < 2; ++bj) { const int col = u.pn * 256 + bj * 128 + wc * 32 + 8 * fq;
                    f32x4 g0, g1, b0, b1; unpack8_fp8(bj ? (u32x2){gq.z, gq.w} : (u32x2){gq.x, gq.y}, g0, g1); unpack8_fp8(bj ? (u32x2){bq.z, bq.w} : (u32x2){bq.x, bq.y}, b0, b1);
                    const f32x4 v0 = g0 * acc[ai][bj][m][0] + b0, v1 = g1 * acc[ai][bj][m][1] + b1;
                    u32x2 w8; w8.x = pk4_fp8(v0[0], v0[1], v0[2], v0[3]); w8.y = pk4_fp8(v1[0], v1[1], v1[2], v1[3]); *(u32x2*)((unsigned char*)merged + (size_t)t * 1024 + col) = w8; } }
    }
};
struct EpiOut { static constexpr int NPRE = 12; static constexpr int NST = 16;
    const float* x; const float* mod; bf16* v1;
    __device__ __forceinline__ void xbatch(const g8::Unit& u, int wr, int wc, int fr, int fq, int bt, f32x4* d) const { const int ai = bt >> 1, mh = bt & 1;
#pragma unroll
        for (int mm = 0; mm < 2; ++mm) { const int t = u.pm * 256 + ai * 128 + wr * 64 + (2 * mh + mm) * 16 + fr;
#pragma unroll
            for (int bj = 0; bj < 2; ++bj) { const int col = u.pn * 256 + bj * 128 + wc * 32 + 8 * fq; d[(mm * 2 + bj) * 2] = *(const f32x4*)(x + (size_t)t * 1024 + col); d[(mm * 2 + bj) * 2 + 1] = *(const f32x4*)(x + (size_t)t * 1024 + col + 4); } } }
    __device__ __forceinline__ void pre(const g8::Unit& u, int wr, int wc, int fr, int fq, f32x4 (&bp)[12]) const { const int b = (u.pm * 256) >> 12; const float* p = mod + b * 6144 + 2048 + u.pn * 256 + wc * 32 + 8 * fq;
        bp[0] = *(const f32x4*)p; bp[1] = *(const f32x4*)(p + 4); bp[2] = *(const f32x4*)(p + 128); bp[3] = *(const f32x4*)(p + 132);
        xbatch(u, wr, wc, fr, fq, 0, &bp[4]); }
    __device__ __forceinline__ void cbatch(const f32x4 (&acc)[2][2][4][2], const g8::Unit& u, int wr, int wc, int fr, int fq, int bt, const f32x4* d, const f32x4* g) const { const int ai = bt >> 1, mh = bt & 1;
#pragma unroll
        for (int mm = 0; mm < 2; ++mm) { const int m = 2 * mh + mm, t = u.pm * 256 + ai * 128 + wr * 64 + m * 16 + fr;
#pragma unroll
            for (int bj = 0; bj < 2; ++bj) { const int col = u.pn * 256 + bj * 128 + wc * 32 + 8 * fq;
                const f32x4 v0 = d[(mm * 2 + bj) * 2] * DN_ALPHA + (g[2 * bj] + 1.0f) * acc[ai][bj][m][0], v1_ = d[(mm * 2 + bj) * 2 + 1] * DN_ALPHA + (g[2 * bj + 1] + 1.0f) * acc[ai][bj][m][1];
                *(u32x4*)(v1 + (size_t)t * 1024 + col) = pack8(v0, v1_); } } }
    __device__ __forceinline__ void operator()(const f32x4 (&acc)[2][2][4][2], const g8::Unit& u, int wr, int wc, int fr, int fq, const f32x4 (&bpre)[12]) const {
        f32x4 xa[8], xb[8];
        xbatch(u, wr, wc, fr, fq, 1, xa);
        __builtin_amdgcn_sched_barrier(0);
        cbatch(acc, u, wr, wc, fr, fq, 0, &bpre[4], &bpre[0]);
        __builtin_amdgcn_sched_barrier(0);
        xbatch(u, wr, wc, fr, fq, 2, xb);
        __builtin_amdgcn_sched_barrier(0);
        cbatch(acc, u, wr, wc, fr, fq, 1, xa, &bpre[0]);
        __builtin_amdgcn_sched_barrier(0);
        xbatch(u, wr, wc, fr, fq, 3, xa);
        __builtin_amdgcn_sched_barrier(0);
        cbatch(acc, u, wr, wc, fr, fq, 2, xb, &bpre[0]);
        cbatch(acc, u, wr, wc, fr, fq, 3, xa, &bpre[0]);
    }
};
struct EpiMoe1 { static constexpr int NPRE = 4;
    __device__ __forceinline__ void pre(const g8::Unit& u, int, int wc, int, int fq, f32x4 (&bp)[4]) const { const float* p = bgu + (size_t)u.z * 2048 + u.pn * 128 + wc * 32 + 8 * fq; bp[0] = *(const f32x4*)p; bp[1] = *(const f32x4*)(p + 4); bp[2] = *(const f32x4*)(p + 1024); bp[3] = *(const f32x4*)(p + 1028); }
    const float* bgu; bf16* act;
    __device__ __forceinline__ void operator()(const f32x4 (&acc)[2][2][4][2], const g8::Unit& u, int wr, int wc, int fr, int fq, const f32x4 (&bpre)[4]) const {
        const int f = u.pn * 128 + wc * 32 + 8 * fq; const float* bp = bgu + (size_t)u.z * 2048 + f;
        (void)bp; const f32x4 bg0 = bpre[0], bg1 = bpre[1], bu0 = bpre[2], bu1 = bpre[3];
#pragma unroll
        for (int ai = 0; ai < 2; ++ai)
#pragma unroll
            for (int m = 0; m < 4; ++m) { const int row = u.pm * 256 + ai * 128 + wr * 64 + m * 16 + fr;
                f32x4 g0 = acc[ai][0][m][0] + bg0, g1 = acc[ai][0][m][1] + bg1, u0 = acc[ai][1][m][0] + bu0, u1 = acc[ai][1][m][1] + bu1;
#pragma unroll
                for (int j = 0; j < 4; ++j) { g0[j] = fminf(g0[j], 7.0f); g1[j] = fminf(g1[j], 7.0f); u0[j] = __builtin_amdgcn_fmed3f(u0[j], -7.0f, 7.0f); u1[j] = __builtin_amdgcn_fmed3f(u1[j], -7.0f, 7.0f); }
                g0 = g0 * rcp_v(exp2_v(g0 * (-1.702f * 1.4426950409f)) + 1.0f) * (u0 + 1.0f); g1 = g1 * rcp_v(exp2_v(g1 * (-1.702f * 1.4426950409f)) + 1.0f) * (u1 + 1.0f);
                u32x2 w8; w8.x = pk4_fp8_nc(g0); w8.y = pk4_fp8_nc(g1); *(u32x2*)((unsigned char*)act + (size_t)row * 1024 + f) = w8; }
    }
};
struct EpiMoe2 { static constexpr int NPRE = 4;
    __device__ __forceinline__ void pre(const g8::Unit& u, int, int wc, int, int fq, f32x4 (&bp)[4]) const { const float* p = bd + (size_t)u.z * 1024 + u.pn * 256 + wc * 32 + 8 * fq; bp[0] = *(const f32x4*)p; bp[1] = *(const f32x4*)(p + 4); bp[2] = *(const f32x4*)(p + 128); bp[3] = *(const f32x4*)(p + 132); }
    const float* bd; bf16* yb;
    __device__ __forceinline__ void operator()(const f32x4 (&acc)[2][2][4][2], const g8::Unit& u, int wr, int wc, int fr, int fq, const f32x4 (&bpre)[4]) const {
#pragma unroll
        for (int bj = 0; bj < 2; ++bj) { const int col = u.pn * 256 + bj * 128 + wc * 32 + 8 * fq; const float* bp = bd + (size_t)u.z * 1024 + col;
            (void)bp; const f32x4 b0 = bpre[bj * 2], b1 = bpre[bj * 2 + 1];
#pragma unroll
            for (int ai = 0; ai < 2; ++ai)
#pragma unroll
                for (int m = 0; m < 4; ++m) { const int row = u.pm * 256 + ai * 128 + wr * 64 + m * 16 + fr;
                    const f32x4 y0 = acc[ai][bj][m][0] + b0, y1 = acc[ai][bj][m][1] + b1; u32x2 w8; w8.x = pk4_fp8(y0[0], y0[1], y0[2], y0[3]); w8.y = pk4_fp8(y1[0], y1[1], y1[2], y1[3]);
                    *(u32x2*)((unsigned char*)yb + (size_t)row * 1024 + col) = w8; } }
    }
};

struct S5AOrder { int G, c; const char* acat; const char* ws;
    __device__ __forceinline__ bool next(int i, g8::Unit& u) const { const int L = i * G + c; if (L >= S5G * 4) return false; u.z = L >> 2; u.pm = L & 3; u.pn = 0; u.rl = 0;
        u.A = acat + ((size_t)(u.z * S5M + u.pm * 256) * S5ROW + 128) * 2; u.B = ws + (size_t)u.z * 256 * (S5L * 16) * 2; return true; } };
struct GluPairOrder { g8::GridOrder r7; const char* A; const char* B;
    __device__ __forceinline__ bool next(int i0, g8::Unit& u) const { g8::Unit v; if (!r7.next(i0 >> 1, v)) return false; u.pm = v.pm; u.pn = 2 * v.pn + (i0 & 1); u.z = 0; u.rl = 0;
        u.A = A + (size_t)u.pm * (256 * 512); u.B = B + (size_t)u.pn * (256 * 512); return true; } };
struct S5COrder { int G, c; const char* acat; const char* wy;
    __device__ __forceinline__ bool next(int i, g8::Unit& u) const { const int L = i * G + c; if (L >= S5G * 8) return false; u.z = L >> 3; u.pm = (L >> 1) & 3; u.pn = L & 1; u.rl = 0;
        u.A = acat + (size_t)(u.z * S5M + u.pm * 256) * S5ROW8; u.B = wy + (size_t)(u.z * 512 + u.pn * 256) * S5ROW8; return true; } };
struct MoeOrder { int G, c, NT, RT; const LAS int* tstart; const LAS int* cnt; const int* toklist; const char* A; const char* B; size_t bstride_e; int lda; bool gatherA; int dup = 0;
    __device__ __forceinline__ bool next(int i0, g8::Unit& u) const { const int i = dup ? (i0 >> 1) : i0; const int per = G >> 3, xcd = c & 7, slot = c >> 3, rpx = per / NT;
        const int rt = (i * 8 + xcd) * rpx + slot / NT; if (rt >= RT) return false; u.pn = slot % NT;
        const int lane_ = threadIdx.x & 63; const unsigned long long mk_ = __ballot(lane_ < NE && tstart[lane_ & 31] <= rt);
        const int e = __builtin_popcountll(mk_) - 1;
        u.z = e; u.pm = rt; u.rl = rt - tstart[e]; u.B = B + (size_t)e * bstride_e + (size_t)u.pn * 256 * 1024; u.A = gatherA ? A : A + (size_t)rt * 256 * 1024; return true; }
    __device__ __forceinline__ void gather(const g8::Unit& u, const int (&Rr)[2], const int (&Cc)[2], unsigned (&vo)[2][2]) const {
        const int n = cnt[u.z];
#pragma unroll
        for (int h = 0; h < 2; ++h)
#pragma unroll
            for (int i = 0; i < 2; ++i) { const int r = u.rl * 256 + h * 128 + Rr[i]; const int rc = r < n ? r : n - 1; const int tok = toklist[u.z * T + rc]; vo[h][i] = (unsigned)(tok * lda + Cc[i] * 2); } }
};

__device__ __forceinline__ void transpose_item(const float* W, int N, int k0, int n0, bf16* dst, int ldd, int drow0, LAS float* scr, int lane) {
    float wv_[32];
#pragma unroll
    for (int i = 0; i < 32; ++i) wv_[i] = W[(size_t)(k0 + 2 * i + (lane >> 5)) * N + n0 + (lane & 31)];
#pragma unroll
    for (int i = 0; i < 32; ++i) scr[(2 * i + (lane >> 5)) * 33 + (lane & 31)] = wv_[i];
    asm volatile("s_waitcnt lgkmcnt(0)" ::: "memory");
    const int c = lane & 7;
#pragma unroll
    for (int j = 0; j < 4; ++j) { const int n = (lane >> 3) + 8 * j; const LAS float* s = scr + (8 * c) * 33 + n;
        u32x4 o; o.x = pk2(s[0 * 33], s[1 * 33]); o.y = pk2(s[2 * 33], s[3 * 33]); o.z = pk2(s[4 * 33], s[5 * 33]); o.w = pk2(s[6 * 33], s[7 * 33]);
        *(u32x4*)(dst + (size_t)(drow0 + n) * ldd + k0 + 8 * c) = o; }
    asm volatile("s_waitcnt lgkmcnt(0)" ::: "memory");
}
__device__ __forceinline__ void transpose_item8(const float* W, int N, int k0, int n0, unsigned char* dst, int ldd, int drow0, LAS float* scr, int lane) {
    float wv_[32];
#pragma unroll
    for (int i = 0; i < 32; ++i) wv_[i] = W[(size_t)(k0 + 2 * i + (lane >> 5)) * N + n0 + (lane & 31)];
#pragma unroll
    for (int i = 0; i < 32; ++i) scr[(2 * i + (lane >> 5)) * 33 + (lane & 31)] = wv_[i];
    asm volatile("s_waitcnt lgkmcnt(0)" ::: "memory");
    const int c = lane & 7;
#pragma unroll
    for (int j = 0; j < 4; ++j) { const int n = (lane >> 3) + 8 * j; const LAS float* s = scr + (8 * c) * 33 + n;
        u32x2 o; o.x = pk4_fp8(32.f * s[0 * 33], 32.f * s[1 * 33], 32.f * s[2 * 33], 32.f * s[3 * 33]); o.y = pk4_fp8(32.f * s[4 * 33], 32.f * s[5 * 33], 32.f * s[6 * 33], 32.f * s[7 * 33]);
        *(u32x2*)(dst + (size_t)(drow0 + n) * ldd + k0 + 8 * c) = o; }
    asm volatile("s_waitcnt lgkmcnt(0)" ::: "memory");
}
__device__ __forceinline__ void transpose_item8w(const float* W, int N, int k0, int n0, unsigned char* dst, int ldd, int drow0, LAS float* scr, int lane) {
    float wv[64]; const float* wp = W + (size_t)(k0 + (lane >> 5)) * N + n0 + (lane & 31);
#pragma unroll
    for (int i = 0; i < 64; ++i) wv[i] = wp[(size_t)(2 * i) * N];
#pragma unroll
    for (int i = 0; i < 64; ++i) scr[(2 * i + (lane >> 5)) * 33 + (lane & 31)] = wv[i];
    asm volatile("s_waitcnt lgkmcnt(0)" ::: "memory");
    const int c = lane & 7;
#pragma unroll
    for (int j = 0; j < 4; ++j) { const int n = (lane >> 3) + 8 * j; const LAS float* s = scr + (16 * c) * 33 + n;
        u32x4 o; o.x = pk4_fp8(32.f * s[0 * 33], 32.f * s[1 * 33], 32.f * s[2 * 33], 32.f * s[3 * 33]); o.y = pk4_fp8(32.f * s[4 * 33], 32.f * s[5 * 33], 32.f * s[6 * 33], 32.f * s[7 * 33]);
        o.z = pk4_fp8(32.f * s[8 * 33], 32.f * s[9 * 33], 32.f * s[10 * 33], 32.f * s[11 * 33]); o.w = pk4_fp8(32.f * s[12 * 33], 32.f * s[13 * 33], 32.f * s[14 * 33], 32.f * s[15 * 33]);
        *(u32x4*)(dst + (size_t)(drow0 + n) * ldd + k0 + 16 * c) = o; }
    asm volatile("s_waitcnt lgkmcnt(0)" ::: "memory");
}
__device__ __forceinline__ int pair_row(int n) { const int f = n & 1023, hi = n >> 10; return (f >> 7) * 256 + hi * 128 + (f & 127); }

__device__ __forceinline__ void moe_tables(Frame& F) {
    LAS int* tstart = (LAS int*)(F.lds + TAB_OFF); LAS int* cl = tstart + 40;
    if (F.tid < 64) {
        const int e = F.lane & 31; const int c = (int)F.ctl[CW_CNT + 64 * e]; int inc = (c + 255) >> 8;
#pragma unroll
        for (int o = 1; o < 32; o <<= 1) { const int v = __shfl_up(inc, o); if ((F.lane & 31) >= o) inc += v; }
        if (F.lane < 32) { cl[e] = c; tstart[e] = inc - ((c + 255) >> 8); if (e == NE - 1) tstart[NE] = inc; }
    }
    __syncthreads();
}

__device__ __forceinline__ void p0_mod_job(Frame& F, int job) {
    LAS float* sc = (LAS float*)F.lds;
    LAS float* red = sc + 8 * 1024;
    const float* c = F.in[1]; const float* w = F.in[2]; const float* bias = F.in[3];
    const int col = F.tid & 31, kg = F.tid >> 5, j = job * 32 + col;
    float cv[16], wv[64];
#pragma unroll
    for (int k = 0; k < 16; ++k) cv[k] = c[F.tid + 512 * k];
#pragma unroll
    for (int k = 0; k < 64; ++k) wv[k] = w[(size_t)(kg * 64 + k) * 6144 + j];
    const float bv = bias[job * 32 + (F.tid & 31)];
#pragma unroll
    for (int k = 0; k < 16; ++k) sc[F.tid + 512 * k] = cv[k] * fast_sigmoid(cv[k]);
    __syncthreads();
    float a[8];
#pragma unroll
    for (int b = 0; b < 8; ++b) a[b] = 0.f;
#pragma unroll
    for (int k = 0; k < 64; ++k) {
#pragma unroll
        for (int b = 0; b < 8; ++b) a[b] += sc[b * 1024 + kg * 64 + k] * wv[k]; }
#pragma unroll
    for (int b = 0; b < 8; ++b) red[(kg * 8 + b) * 32 + col] = a[b];
    __syncthreads();
    if (F.tid < 256) { const int b = F.tid >> 5, cc = F.tid & 31; float s_ = 0.f;
#pragma unroll
        for (int g = 0; g < 16; ++g) s_ += red[(g * 8 + b) * 32 + cc];
        WSP(float, WS_MOD)[b * 6144 + job * 32 + cc] = s_ + bv; }
    __syncthreads();
}
__device__ __forceinline__ void s5_setup(Frame& F, int g, int kmin, int kmax, LAS f32x2* Bb, LAS f32x2* Cc, LAS f32x2* Ap) {
    const float* lre = F.in[14] + g * 64; const float* lim = F.in[15] + g * 64; const float dt = expf(F.in[16][g]);
    const float* bre = F.in[17] + g * 1024; const float* bim = F.in[18] + g * 1024; const float* cre = F.in[19] + g * 1024; const float* cim = F.in[20] + g * 1024;
    for (int i = F.tid; i < 1024; i += 512) { const int p = i >> 4; const float lr = lre[p], li = lim[p]; const float mag = expf(lr * dt); float sn, cs; sincosf(li * dt, &sn, &cs);
        const float ar = mag * cs, ai = mag * sn, den = lr * lr + li * li, qr = ((ar - 1.f) * lr + ai * li) / den, qi = (ai * lr - (ar - 1.f) * li) / den;
        const float br = bre[i], bi = bim[i]; Bb[i] = (f32x2){qr * br - qi * bi, qr * bi + qi * br};
        Cc[i] = (f32x2){cre[i], cim[i]}; }
    if (F.tid < 64) { const int p = F.tid; const float lr = lre[p], li = lim[p]; const float mag = expf(lr * dt); float sn, cs; sincosf(li * dt, &sn, &cs);
        const float ar = mag * cs, ai = mag * sn; float xr_ = 1.f, xi_ = 0.f;
        for (int k = 0; k <= kmax; ++k) { if (k >= kmin) Ap[k * 64 + p] = (f32x2){xr_, xi_}; const float nr = xr_ * ar - xi_ * ai, ni = xr_ * ai + xi_ * ar; xr_ = nr; xi_ = ni; } }
    __syncthreads();
}
constexpr size_t WS_KTAB = WS_S;
constexpr size_t WS_WRIMG = WS_AL + 512 * 1024;
__device__ __forceinline__ void p0_s5k_job(Frame& F, int job) {
    const int g = job >> 3, part = job & 7;
    LAS f32x2* Bb = (LAS f32x2*)F.lds; LAS f32x2* Cc = Bb + 1024; LAS f32x2* Ap = Cc + 1024;
    s5_setup(F, g, 4 * part, 4 * part + 3, Bb, Cc, Ap);
    float* kt = WSP(float, WS_KTAB) + (size_t)g * 32 * 256;
    for (int e = 4 * part * 256 + F.tid; e < (4 * part + 4) * 256; e += 512) { const int k = e >> 8, c = (e >> 4) & 15, c2 = e & 15; float s = 0.f;
        for (int p = 0; p < 64; ++p) { const f32x2 cv = Cc[c * 64 + p], av = Ap[k * 64 + p], bv = Bb[p * 16 + c2];
            const float car = cv.x * av.x - cv.y * av.y, cai = cv.x * av.y + cv.y * av.x; s += car * bv.x - cai * bv.y; }
        kt[e] = s; }
    __syncthreads();
}
__device__ __forceinline__ void p1_s5w_job(Frame& F, int job) {
    const int g = job >> 3, part = job & 7;
    LAS f32x2* Bb = (LAS f32x2*)F.lds; LAS f32x2* Cc = Bb + 1024; LAS f32x2* Ap = Cc + 1024; LAS float* Kt = (LAS float*)(Ap + 33 * 64);
    const float* ktg = WSP(float, WS_KTAB) + (size_t)g * 32 * 256; const float* dsk = F.in[21] + g * 16;
    { f32x4 kv[4];
#pragma unroll
      for (int k = 0; k < 4; ++k) kv[k] = *(const f32x4*)(ktg + 4 * (F.tid + 512 * k));
#pragma unroll
      for (int k = 0; k < 4; ++k) *(LAS f32x4*)(Kt + 4 * (F.tid + 512 * k)) = kv[k]; }
    s5_setup(F, g, 0, S5L, Bb, Cc, Ap);
    if (part == 0 && F.tid < 64) WSP(f32x2, WS_AL)[g * 64 + F.tid] = Ap[S5L * 64 + F.tid];
    unsigned char* wy = WSP(unsigned char, WS_WY) + (size_t)g * 512 * S5ROW8;
    for (int ch = F.tid; ch < 64 * (S5ROW8 / 8); ch += 512) { const int n = part * 64 + ch / (S5ROW8 / 8), k8 = (ch % (S5ROW8 / 8)) * 8, i = n >> 4, c = n & 15; float v[8]; const float dskc = dsk[c];
        if (k8 < 128) {
#pragma unroll
            for (int j = 0; j < 8; j += 2) { const int p = (k8 + j) >> 1; const f32x2 cv = Cc[c * 64 + p], av = Ap[(i + 1) * 64 + p]; v[j] = 2.f * (cv.x * av.x - cv.y * av.y); v[j + 1] = -2.f * (cv.x * av.y + cv.y * av.x); } }
        else if (k8 < 640) { const int jj = (k8 - 128) >> 4, c2 = (k8 - 128) & 15;
#pragma unroll
            for (int j = 0; j < 8; ++j) { float x = 0.f; if (jj <= i) { x = Kt[(i - jj) * 256 + c * 16 + c2 + j]; x += (jj == i && c == c2 + j) ? dskc : 0.f; } v[j] = 32.f * x; } }
        else {
#pragma unroll
            for (int j = 0; j < 8; ++j) v[j] = 0.f; }
        u32x2 o; o.x = pk4_fp8(v[0], v[1], v[2], v[3]); o.y = pk4_fp8(v[4], v[5], v[6], v[7]);
        *(u32x2*)(wy + (size_t)n * S5ROW8 + k8) = o; }
    bf16* wsm = WSP(bf16, WS_WS) + (size_t)g * 256 * 512;
    for (int ch = F.tid; ch < 32 * 64; ch += 512) { const int n = part * 32 + (ch >> 6), k8 = (ch & 63) * 8, jj = k8 >> 4, c2 = k8 & 15; float v[8];
#pragma unroll
        for (int j = 0; j < 8; ++j) { float x = 0.f; if (n < 128) { const int p = n >> 1; const f32x2 av = Ap[(S5L - 1 - jj) * 64 + p], bv = Bb[p * 16 + c2 + j]; x = (n & 1) ? (av.x * bv.y + av.y * bv.x) : (av.x * bv.x - av.y * bv.y); } v[j] = x; }
        u32x4 o; o.x = pk2(v[0], v[1]); o.y = pk2(v[2], v[3]); o.z = pk2(v[4], v[5]); o.w = pk2(v[6], v[7]);
        *(u32x4*)(wsm + (size_t)n * 512 + k8) = o; }
    __syncthreads();
}
struct TrDesc { const float* W; int N, k0, n0, ldd, drow0; void* dst; bool f8; };
__device__ __forceinline__ TrDesc tr_desc(Frame& F, int r) {
    constexpr int I_IN = 16 * 144, I_RNN = 16 * 32, I_OUT = 16 * 32, I_GLU = 8 * 64;
    TrDesc d; d.f8 = true;
    if (r < I_IN) { const int kb = r / 144, nb = r % 144; d.W = F.in[4]; d.N = INC; d.k0 = kb * 64; d.n0 = nb * 32; d.dst = WSP(unsigned char, WS_WIN); d.ldd = 1024; d.drow0 = nb * 32; return d; } r -= I_IN;
    if (r < I_RNN) { const int kb = r / 32, nb = r % 32; d.W = F.in[13]; d.N = 1024; d.k0 = kb * 64; d.n0 = nb * 32; d.dst = WSP(unsigned char, WS_WRNN); d.ldd = 1024; d.drow0 = nb * 32; return d; } r -= I_RNN;
    if (r < I_OUT) { const int kb = r / 32, nb = r % 32; d.W = F.in[23]; d.N = 1024; d.k0 = kb * 64; d.n0 = nb * 32; d.dst = WSP(unsigned char, WS_WOUT); d.ldd = 1024; d.drow0 = nb * 32; return d; } r -= I_OUT;
    if (r < I_GLU) { const int kb = r / 64, nb = r % 64; d.W = F.in[22]; d.N = 2048; d.k0 = kb * 64; d.n0 = nb * 32; d.dst = WSP(unsigned char, WS_WGLU); d.ldd = 512; d.drow0 = pair_row(nb * 32); return d; } r -= I_GLU;
    { const int mat = r >> 3, kb = (r >> 2) & 1, nb = r & 3, hd = mat & 7, gx = mat >> 3;
      d.W = F.in[gx ? 10 : 8] + (size_t)hd * 128 * 128; d.N = 128; d.k0 = kb * 64; d.n0 = nb * 32; d.dst = WSP(bf16, WS_WG); d.ldd = 128; d.drow0 = hd * 256 + gx * 128 + nb * 32; d.f8 = false; }
    return d;
}
__device__ __forceinline__ void tr_load(const TrDesc& d, int lane, float (&wv)[32]) {
#pragma unroll
    for (int i = 0; i < 32; ++i) wv[i] = d.W[(size_t)(d.k0 + 2 * i + (lane >> 5)) * d.N + d.n0 + (lane & 31)];
}
__device__ __forceinline__ void tr_store(const TrDesc& d, int lane, const float (&wv)[32], LAS float* scr) {
#pragma unroll
    for (int i = 0; i < 32; ++i) scr[(2 * i + (lane >> 5)) * 33 + (lane & 31)] = wv[i];
    asm volatile("s_waitcnt lgkmcnt(0)" ::: "memory");
    const int c = lane & 7;
#pragma unroll
    for (int j = 0; j < 4; ++j) { const int n = (lane >> 3) + 8 * j; const LAS float* sp_ = scr + (8 * c) * 33 + n;
        if (d.f8) { u32x2 o; o.x = pk4_fp8(32.f * sp_[0 * 33], 32.f * sp_[1 * 33], 32.f * sp_[2 * 33], 32.f * sp_[3 * 33]); o.y = pk4_fp8(32.f * sp_[4 * 33], 32.f * sp_[5 * 33], 32.f * sp_[6 * 33], 32.f * sp_[7 * 33]);
            *(u32x2*)((unsigned char*)d.dst + (size_t)(d.drow0 + n) * d.ldd + d.k0 + 8 * c) = o; }
        else { u32x4 o; o.x = pk2(sp_[0 * 33], sp_[1 * 33]); o.y = pk2(sp_[2 * 33], sp_[3 * 33]); o.z = pk2(sp_[4 * 33], sp_[5 * 33]); o.w = pk2(sp_[6 * 33], sp_[7 * 33]);
            *(u32x4*)((bf16*)d.dst + (size_t)(d.drow0 + n) * d.ldd + d.k0 + 8 * c) = o; } }
    asm volatile("s_waitcnt lgkmcnt(0)" ::: "memory");
}
__device__ __forceinline__ void p0_small_transposes(Frame& F) {
    LAS float* scr = (LAS float*)(F.lds + F.wave * 16384);
    const int gw = F.vcu * 8 + F.wave, NGW = F.G * 8;
    constexpr int NITEMS = 16 * 144 + 16 * 32 + 16 * 32 + 8 * 64 + 16 * 8;
    for (int it = gw; it < NITEMS; it += 2 * NGW) { const int it2 = it + NGW; const bool two = it2 < NITEMS;
        const TrDesc d0 = tr_desc(F, it), d1 = tr_desc(F, two ? it2 : it);
        float w0[32], w1[32];
        tr_load(d0, F.lane, w0); tr_load(d1, F.lane, w1);
        tr_store(d0, F.lane, w0, scr);
        if (two) tr_store(d1, F.lane, w1, scr);
    }
}
__device__ __forceinline__ void p1_hbf(Frame& F) {
    const int gw = F.vcu * 8 + F.wave, NGW = F.G * 8; const float* mod = WSP(float, WS_MOD); bf16* hbf = WSP(bf16, WS_HBF);
    for (int tb = 4 * gw; tb < T; tb += 4 * NGW) {
        const int b = tb >> 12; f32x4 xv[4][4], shv[4], scv[4];
#pragma unroll
        for (int r = 0; r < 4; ++r) { const f32x4* xr = (const f32x4*)(F.in[0] + (size_t)(tb + r) * 1024) + F.lane;
#pragma unroll
            for (int j = 0; j < 4; ++j) xv[r][j] = xr[64 * j]; }
#pragma unroll
        for (int j = 0; j < 4; ++j) { shv[j] = *((const f32x4*)(mod + b * 6144) + F.lane + 64 * j); scv[j] = *((const f32x4*)(mod + b * 6144 + 1024) + F.lane + 64 * j) + 1.0f; }
#pragma unroll
        for (int r = 0; r < 4; ++r) { unsigned* o = (unsigned*)((unsigned char*)hbf + (size_t)(tb + r) * 1024) + F.lane;
#pragma unroll
            for (int j = 0; j < 4; ++j) { const f32x4 v = xv[r][j] * scv[j] + shv[j]; o[64 * j] = pk4_fp8(v[0], v[1], v[2], v[3]); } } }
}
__device__ __forceinline__ void p1_moe_weights(Frame& F) {
    constexpr int TP = 132;
    LAS float* tile = (LAS float*)F.lds;
    constexpr int TILES_GU = 8 * 16, TILES_D = 8 * 8, TILES_E = TILES_GU + TILES_D;
    const int lr = F.tid >> 5, lc4 = (F.tid & 31) * 4, tn = F.tid >> 2, kc = F.tid & 3;
    f32x4 pre[8];
    int ti = F.vcu;
#define P1_SRC(idx, src, N_, dstp, drow0_, k0_) do { const int e_ = (idx) / TILES_E, r_ = (idx) % TILES_E; \
        if (r_ < TILES_GU) { const int kb_ = r_ >> 4, nb_ = r_ & 15; N_ = 2048; src = F.in[28] + (size_t)e_ * 1024 * 2048 + (size_t)(kb_ * 128) * 2048 + nb_ * 128; dstp = WSP(unsigned char, WS_WGU) + (size_t)e_ * 2048 * 1024; drow0_ = pair_row(nb_ * 128); k0_ = kb_ * 128; } \
        else { const int q_ = r_ - TILES_GU, kb_ = q_ >> 3, nb_ = q_ & 7; N_ = 1024; src = F.in[30] + (size_t)e_ * 1024 * 1024 + (size_t)(kb_ * 128) * 1024 + nb_ * 128; dstp = WSP(unsigned char, WS_WD) + (size_t)e_ * 1024 * 1024; drow0_ = nb_ * 128; k0_ = kb_ * 128; } } while (0)
    if (ti < NE * TILES_E) { const float* src; unsigned char* dstp; int N_, d0, k0; P1_SRC(ti, src, N_, dstp, d0, k0);
#pragma unroll
        for (int i = 0; i < 8; ++i) pre[i] = *(const f32x4*)(src + (size_t)(lr + 16 * i) * N_ + lc4); }
    for (; ti < NE * TILES_E; ti += F.G) {
#pragma unroll
        for (int i = 0; i < 8; ++i) *(LAS f32x4*)(tile + (lr + 16 * i) * TP + lc4) = pre[i];
        __syncthreads();
        const int tnx = (ti + F.G < NE * TILES_E) ? ti + F.G : ti;
        { const float* src; unsigned char* dstp; int N_, d0, k0; P1_SRC(tnx, src, N_, dstp, d0, k0);
#pragma unroll
            for (int i = 0; i < 8; ++i) pre[i] = *(const f32x4*)(src + (size_t)(lr + 16 * i) * N_ + lc4); }
        { const float* src; unsigned char* dstp; int N_, d0, k0; P1_SRC(ti, src, N_, dstp, d0, k0); (void)src; (void)N_;
          const LAS float* cp = tile + (32 * kc) * TP + tn; u32x4 o0, o1; float cv[32];
#pragma unroll
          for (int i = 0; i < 32; ++i) cv[i] = cp[i * TP];
          asm volatile("s_waitcnt lgkmcnt(0)" ::: "memory");
#pragma unroll
          for (int i = 0; i < 32; ++i) cv[i] *= 32.f;
          o0.x = pk4_fp8(cv[0], cv[1], cv[2], cv[3]); o0.y = pk4_fp8(cv[4], cv[5], cv[6], cv[7]); o0.z = pk4_fp8(cv[8], cv[9], cv[10], cv[11]); o0.w = pk4_fp8(cv[12], cv[13], cv[14], cv[15]);
          o1.x = pk4_fp8(cv[16], cv[17], cv[18], cv[19]); o1.y = pk4_fp8(cv[20], cv[21], cv[22], cv[23]); o1.z = pk4_fp8(cv[24], cv[25], cv[26], cv[27]); o1.w = pk4_fp8(cv[28], cv[29], cv[30], cv[31]);
          unsigned char* op = dstp + (size_t)(d0 + tn) * 1024 + k0 + 32 * kc; *(u32x4*)op = o0; *(u32x4*)(op + 16) = o1; }
        __syncthreads();
    }
#undef P1_SRC
}
constexpr int XR_LD = 136, XR_TILE = 128 * XR_LD, LU_LD = 132, GYP = 144;
static_assert(128 * LU_LD * 4 <= 2 * XR_TILE * 2, "pass-A pair tile must fit between the conv tile and the tap table");
__device__ __forceinline__ void rga_issue(const unsigned char* xrnn, int item, int tid, u32x2 (&xraw)[7]) {
    const int hd = item & 7, c = (item >> 3) & 31, b = item >> 8, r0 = tid >> 4, ch = hd * 128 + (tid & 15) * 8;
#pragma unroll
    for (int j = 0; j < 7; ++j) { const int tp = c * RGL + 4 * r0 - 3 + j, tpc = tp < 0 ? 0 : tp; xraw[j] = *(const u32x2*)(xrnn + (size_t)(b * SEQ + tpc) * 1024 + ch); }
}
__device__ __forceinline__ void rga_convwrite(const LAS float* cwl, int item, int tid, const u32x2 (&xraw)[7], LAS bf16* xr) {
    const int c = (item >> 3) & 31, r0 = tid >> 4, c8 = (tid & 15) * 8;
    const f32x4 b0 = *(const LAS f32x4*)(cwl + 4 * 128 + c8), b1 = *(const LAS f32x4*)(cwl + 4 * 128 + c8 + 4);
    f32x4 w0[4], w1[4], x0[7], x1[7];
#pragma unroll
    for (int k = 0; k < 4; ++k) { w0[k] = *(const LAS f32x4*)(cwl + k * 128 + c8); w1[k] = *(const LAS f32x4*)(cwl + k * 128 + c8 + 4); }
#pragma unroll
    for (int j = 0; j < 7; ++j) { const int tp = c * RGL + 4 * r0 - 3 + j; u32x2 w = xraw[j]; if (tp < 0) w = (u32x2){0u, 0u}; unpack8_fp8(w, x0[j], x1[j]); }
#pragma unroll
    for (int i = 0; i < 4; ++i) { f32x4 a0 = b0, a1 = b1;
#pragma unroll
        for (int k = 0; k < 4; ++k) { a0 += w0[k] * x0[i + k]; a1 += w1[k] * x1[i + k]; }
        *(LAS u32x4*)(xr + (4 * r0 + i) * XR_LD + c8) = pack8(a0, a1); }
}
__device__ __forceinline__ void rg_passA(Frame& F) {
    const int NIT = NB * RGC * 8;
    const bool skew = (F.G == 256);
    const int nmine = skew ? (F.vcu < 128 ? 6 : 10) : (NIT - F.vcu + F.G - 1) / F.G;
#define RG_ITEM(k) ((skew && (k) >= 6) ? (1536 + (F.vcu - 128) + 128 * ((k) - 6)) : (F.vcu + (k) * F.G))
    if (nmine <= 0) return;
    int it = RG_ITEM(0);
    LAS bf16* xr = (LAS bf16*)F.lds; LAS unsigned* lut = (LAS unsigned*)(xr + XR_TILE);
    LAS float* cwl = (LAS float*)(xr + 3 * XR_TILE);
    const unsigned char* xrnn = WSP(unsigned char, WS_XRNN); const float* cw = F.in[6]; const float* cb = F.in[7];
    const int tid = F.tid, w = F.wave, q = F.lane >> 4, col = F.lane & 15, chl = 16 * w + col;
    u32x2 xraw[7];
    { const int chh = (it & 7) * 128 + (tid & 127); const float v0 = cw[(tid >> 7) * 1024 + chh], v1 = cb[chh]; cwl[tid] = v0; if (tid < 128) cwl[512 + tid] = v1; }
    rga_issue(xrnn, it, tid, xraw);
    __syncthreads();
    rga_convwrite(cwl, it, tid, xraw, xr);
    bf16x8 Bf[3][4]; float ba, bx, sp;
    { const int hd0 = it & 7, ch0 = hd0 * 128 + chl; const bf16* wg = WSP(bf16, WS_WG) + (size_t)hd0 * 256 * 128;
#pragma unroll
      for (int gt = 0; gt < 2; ++gt)
#pragma unroll
          for (int kk = 0; kk < 4; ++kk) Bf[gt][kk] = *(const bf16x8*)(wg + (size_t)(gt * 128 + chl) * 128 + kk * 32 + q * 8);
#pragma unroll
      for (int kk = 0; kk < 4; ++kk) { u32x4 oh = {0u, 0u, 0u, 0u}; const int d = chl - (kk * 32 + q * 8);
          if (d >= 0 && d < 8) { const unsigned one = (d & 1) ? 0x3f800000u : 0x00003f80u; if ((d >> 1) == 0) oh.x = one; else if ((d >> 1) == 1) oh.y = one; else if ((d >> 1) == 2) oh.z = one; else oh.w = one; }
          Bf[2][kk] = __builtin_bit_cast(bf16x8, oh); }
      ba = F.in[9][ch0]; bx = F.in[11][ch0]; const float lam = F.in[12][ch0]; sp = (lam > 15.f) ? __expf(-lam) : log1pf(__expf(-lam)); }
#pragma unroll
    for (int gt = 0; gt < 2; ++gt)
#pragma unroll
        for (int kk = 0; kk < 4; ++kk) asm volatile("" :: "v"(Bf[gt][kk]));
    asm volatile("" :: "v"(ba), "v"(bx), "v"(sp));
    const float spc = -11.541560327f * sp;
    __syncthreads();
    for (int i = 0; i < nmine; ++i) {
        const bool has_next = (i + 1) < nmine; const int nit = has_next ? RG_ITEM(i + 1) : it;
        const int hd = it & 7, c = (it >> 3) & 31, b = it >> 8, t0 = b * SEQ + c * RGL, ch = hd * 128 + chl;
        float carryH = 0.f, carryP = 1.f;
        __builtin_amdgcn_sched_barrier(0);
        rga_issue(xrnn, nit, tid, xraw);
        __builtin_amdgcn_sched_barrier(0);
        f32x4 acc[8][3];
#pragma unroll
        for (int m = 0; m < 8; ++m) { acc[m][0] = (f32x4){0.f, 0.f, 0.f, 0.f}; acc[m][1] = (f32x4){0.f, 0.f, 0.f, 0.f}; acc[m][2] = (f32x4){0.f, 0.f, 0.f, 0.f}; }
#pragma unroll
        for (int kk = 0; kk < 4; ++kk)
#pragma unroll
            for (int m = 0; m < 8; ++m) { const bf16x8 Af = *(const LAS bf16x8*)(xr + (16 * m + col) * XR_LD + kk * 32 + q * 8);
                acc[m][0] = __builtin_amdgcn_mfma_f32_16x16x32_bf16(Af, Bf[0][kk], acc[m][0], 0, 0, 0);
                acc[m][1] = __builtin_amdgcn_mfma_f32_16x16x32_bf16(Af, Bf[1][kk], acc[m][1], 0, 0, 0);
                acc[m][2] = __builtin_amdgcn_mfma_f32_16x16x32_bf16(Af, Bf[2][kk], acc[m][2], 0, 0, 0); }
#pragma unroll
        for (int m = 0; m < 8; ++m) {
            const f32x4 r = sigmoid_v(acc[m][0] + ba), ii = sigmoid_v(acc[m][1] + bx);
            const f32x4 la = r * spc, a = exp2_v(la); f32x4 om = 1.0f - a * a;
#pragma unroll
            for (int j = 0; j < 4; ++j) om[j] = __builtin_amdgcn_sqrtf(om[j]);
            const f32x4 uu = om * ii * acc[m][2];
#pragma unroll
            for (int j = 0; j < 4; ++j) lut[(16 * m + 4 * q + j) * LU_LD + chl] = pk2(la[j], uu[j]);
            float sP = a[0], sH = uu[0];
#pragma unroll
            for (int j = 1; j < 4; ++j) { sH = a[j] * sH + uu[j]; sP *= a[j]; }
            { const float nP = __shfl_down(sP, 16), nH = __shfl_down(sH, 16); sH = nP * sH + nH; sP = sP * nP; }
            { const float nP = __shfl_down(sP, 32), nH = __shfl_down(sH, 32); sH = nP * sH + nH; sP = sP * nP; }
            carryH = sP * carryH + sH; carryP *= sP;
        }
        if (q == 0) { f32x2* ag = WSP(f32x2, WS_RGAGG); ag[(size_t)(b * RGC + c) * 1024 + ch] = (f32x2){carryP, carryH}; }
        __syncthreads();
        { unsigned* LU = WSP(unsigned, WS_LU);
#pragma unroll
          for (int k = 0; k < 8; ++k) { const int p = tid + 512 * k, row = p >> 5, c4 = (p & 31) * 4; *(u32x4*)(LU + (size_t)(t0 + row) * 1024 + hd * 128 + c4) = *(const LAS u32x4*)(lut + row * LU_LD + c4); } }
#pragma unroll
        for (int j = 0; j < 7; ++j) asm volatile("" : "+v"(xraw[j]));
        if (has_next) rga_convwrite(cwl, nit, tid, xraw, xr);
        __syncthreads();
        it = nit;
    }
#undef RG_ITEM
}
__device__ __forceinline__ void rg_passB(Frame& F) {
    const int NIT = NB * RGC * 8; const int nmine = (NIT - F.vcu + F.G - 1) / F.G; if (nmine <= 0) return;
    LAS unsigned* lut = (LAS unsigned*)F.lds;
    LAS unsigned char* gyl = (LAS unsigned char*)F.lds + 128 * LU_LD * 4;
    LAS unsigned char* outl = gyl + 128 * GYP;
    LAS float* agg = (LAS float*)(outl + 128 * GYP);
    const unsigned* LU = WSP(unsigned, WS_LU); const unsigned char* gy = WSP(unsigned char, WS_GY); unsigned char* ha = WSP(unsigned char, WS_HA); const float* hin = WSP(float, WS_HIN);
    const int tid = F.tid, cg = tid & 63, seg = F.wave;
    u32x4 lu[8], gq[2]; f32x2 cin;
#define RGB_ISSUE(item) do { const int hd_ = (item) & 7, c_ = ((item) >> 3) & 31, b_ = (item) >> 8, t0_ = b_ * SEQ + c_ * RGL; \
        _Pragma("unroll") for (int k = 0; k < 8; ++k) { const int p = tid + 512 * k, row = p >> 5, c4 = (p & 31) * 4; lu[k] = *(const u32x4*)(LU + (size_t)(t0_ + row) * 1024 + hd_ * 128 + c4); } \
        _Pragma("unroll") for (int k = 0; k < 2; ++k) { const int p = tid + 512 * k, row = p >> 3, c16 = (p & 7) * 16; gq[k] = *(const u32x4*)(gy + (size_t)(t0_ + row) * 1024 + hd_ * 128 + c16); } \
        cin = *(const f32x2*)(hin + (size_t)(b_ * RGC + c_) * 1024 + hd_ * 128 + 2 * cg); } while (0)
    int it = F.vcu;
    RGB_ISSUE(it);
    for (int i = 0; i < nmine; ++i) {
        const bool has_next = (i + 1) < nmine; const int nit = has_next ? it + F.G : it;
        const int hd = it & 7, c = (it >> 3) & 31, b = it >> 8, t0 = b * SEQ + c * RGL;
#pragma unroll
        for (int k = 0; k < 8; ++k) { const int p = tid + 512 * k, row = p >> 5, c4 = (p & 31) * 4; *(LAS u32x4*)(lut + row * LU_LD + c4) = lu[k]; }
#pragma unroll
        for (int k = 0; k < 2; ++k) { const int p = tid + 512 * k, row = p >> 3, c16 = (p & 7) * 16; *(LAS u32x4*)(gyl + row * GYP + c16) = gq[k]; }
        f32x2 h = cin;
        __syncthreads();
        __builtin_amdgcn_sched_barrier(0);
        RGB_ISSUE(nit);
        __builtin_amdgcn_sched_barrier(0);
        f32x2 av[16], uv[16]; f32x2 P = {1.f, 1.f}, H = {0.f, 0.f};
#pragma unroll
        for (int s_ = 0; s_ < 16; ++s_) { const u32x2 w = *(const LAS u32x2*)(lut + (16 * seg + s_) * LU_LD + 2 * cg);
            uv[s_] = (f32x2){bfhi(w.x), bfhi(w.y)}; av[s_] = (f32x2){__builtin_amdgcn_exp2f(bflo(w.x)), __builtin_amdgcn_exp2f(bflo(w.y))};
            H = av[s_] * H + uv[s_]; P = P * av[s_]; }
        *(LAS f32x4*)(agg + (seg * 128 + 2 * cg) * 2) = (f32x4){P.x, H.x, P.y, H.y};
        __syncthreads();
        for (int s2 = 0; s2 < seg; ++s2) { const f32x4 g = *(const LAS f32x4*)(agg + (s2 * 128 + 2 * cg) * 2); h.x = g[0] * h.x + g[1]; h.y = g[2] * h.y + g[3]; }
#pragma unroll
        for (int s_ = 0; s_ < 16; ++s_) { const int t = 16 * seg + s_; h = av[s_] * h + uv[s_];
            const int gb2 = (int)*(const LAS unsigned short*)(gyl + t * GYP + 2 * cg); const f32x2 g = __builtin_amdgcn_cvt_pk_f32_fp8(gb2, false);
            const f32x2 o = h * g; const int w8 = __builtin_amdgcn_cvt_pk_fp8_f32(__builtin_amdgcn_fmed3f(o.x, -448.f, 448.f), __builtin_amdgcn_fmed3f(o.y, -448.f, 448.f), 0, false);
            *(LAS unsigned short*)(outl + t * GYP + 2 * cg) = (unsigned short)w8; }
        __syncthreads();
#pragma unroll
        for (int k = 0; k < 2; ++k) { const int p = tid + 512 * k, row = p >> 3, c16 = (p & 7) * 16; *(u32x4*)(ha + (size_t)(t0 + row) * 1024 + hd * 128 + c16) = *(const LAS u32x4*)(outl + row * GYP + c16); }
        it = nit;
    }
#undef RGB_ISSUE
}
__device__ __forceinline__ void p4_s5_jobs(Frame& F, int job0, int jstep, int jend) {
    LAS f32x2* seg = (LAS f32x2*)F.lds;
    for (int job = job0; job < jend; job += jstep) {
        const int b = job >> 5, g = job & 31, p = F.lane, w = F.wave;
        const f32x2 al = WSP(f32x2, WS_AL)[g * 64 + p];
        const f32x2* Sb = WSP(f32x2, WS_S) + ((size_t)(g * S5M + b * S5CPB + 16 * w)) * 64 + p; unsigned short* ac = (unsigned short*)(WSP(unsigned char, WS_ACAT8) + ((size_t)(g * S5M + b * S5CPB + 16 * w)) * S5ROW8) + p;
        f32x2 sv[16];
#pragma unroll
        for (int i = 0; i < 16; ++i) sv[i] = Sb[(size_t)i * 64];
        float xr_ = 0.f, xi = 0.f;
#pragma unroll
        for (int i = 0; i < 16; ++i) { const float nr = al.x * xr_ - al.y * xi + sv[i].x, ni = al.x * xi + al.y * xr_ + sv[i].y; xr_ = nr; xi = ni; }
        seg[w * 64 + p] = (f32x2){xr_, xi};
        float ar = al.x, ai = al.y;
#pragma unroll
        for (int q = 0; q < 4; ++q) { const float nr = ar * ar - ai * ai, ni = 2.f * ar * ai; ar = nr; ai = ni; }
        __syncthreads();
        xr_ = 0.f; xi = 0.f;
        for (int ww = 0; ww < w; ++ww) { const f32x2 sg = seg[ww * 64 + p]; const float nr = ar * xr_ - ai * xi + sg.x, ni = ar * xi + ai * xr_ + sg.y; xr_ = nr; xi = ni; }
#pragma unroll
        for (int i = 0; i < 16; ++i) { ac[(size_t)i * (S5ROW8 / 2)] = (unsigned short)__builtin_amdgcn_cvt_pk_fp8_f32(__builtin_amdgcn_fmed3f(16.f * xr_, -448.f, 448.f), __builtin_amdgcn_fmed3f(16.f * xi, -448.f, 448.f), 0, false); ac[(size_t)i * (S5ROW8 / 2) + 320] = 0; const float nr = al.x * xr_ - al.y * xi + sv[i].x, ni = al.x * xi + al.y * xr_ + sv[i].y; xr_ = nr; xi = ni; }
        __syncthreads();
    }
}
__device__ __forceinline__ void p4_rg_carry(Frame& F) {
    if (F.vcu < 16) {
        const int id = F.vcu * 512 + F.tid, ch = id & 1023, b = id >> 10; const f32x2* ag = WSP(f32x2, WS_RGAGG) + (size_t)b * RGC * 1024 + ch; float* hin = WSP(float, WS_HIN) + (size_t)b * RGC * 1024 + ch;
        f32x2 a[RGC];
#pragma unroll
        for (int c = 0; c < RGC; ++c) a[c] = ag[(size_t)c * 1024];
        float h = 0.f;
#pragma unroll
        for (int c = 0; c < RGC; ++c) { hin[(size_t)c * 1024] = h; h = a[c].x * h + a[c].y; }
    }
}
constexpr int WR_LD = 1032;
__device__ __forceinline__ void p9_router(Frame& F) {
    LAS bf16* wH = (LAS bf16*)F.lds; LAS bf16* wL = wH + 32 * WR_LD;
    LAS f32x2* sel = (LAS f32x2*)(wL + 32 * WR_LD);
    LAS unsigned* rec = (LAS unsigned*)(sel + 512);
    LAS float* recp = (LAS float*)(rec + 512);
    LAS int* lcnt = (LAS int*)(recp + 512);
    LAS int* gbase = lcnt + 32;
    { const u32x4* img = WSP(u32x4, WS_WRIMG); LAS u32x4* dst = (LAS u32x4*)wH;
      constexpr int NV = 2 * 32 * WR_LD * 2 / 16, NK = (NV + 511) / 512; u32x4 tv[NK];
#pragma unroll
      for (int k = 0; k < NK; ++k) { const int i = F.tid + 512 * k; tv[k] = img[i < NV ? i : NV - 1]; }
#pragma unroll
      for (int k = 0; k < NK; ++k) { const int i = F.tid + 512 * k; if (i < NV) dst[i] = tv[k]; } }
    if (F.tid < 32) lcnt[F.tid] = 0;
    __syncthreads();
    const float* mod = WSP(float, WS_MOD); const bf16* v1 = WSP(bf16, WS_V1); unsigned char* h2 = WSP(unsigned char, WS_H2);
    const int lane = F.lane, m = lane & 15, kq = lane >> 4, w = F.wave;
    for (int blk = F.vcu; blk < T / 128; blk += F.G) {
        const int t = blk * 128 + w * 16 + m, b = (blk * 128) >> 12;
        const bf16* vrow = v1 + (size_t)t * 1024 + 8 * kq;
        float sum = 0.f, sq = 0.f;
#pragma unroll 32
        for (int s_ = 0; s_ < 32; ++s_) { f32x4 a, c; unpack8(*(const u32x4*)(vrow + 32 * s_), a, c); sum += ((a[0] + a[1]) + (a[2] + a[3])) + ((c[0] + c[1]) + (c[2] + c[3]));
            sq += ((a[0] * a[0] + a[1] * a[1]) + (a[2] * a[2] + a[3] * a[3])) + ((c[0] * c[0] + c[1] * c[1]) + (c[2] * c[2] + c[3] * c[3])); }
        sum += __shfl_xor(sum, 16); sum += __shfl_xor(sum, 32); sq += __shfl_xor(sq, 16); sq += __shfl_xor(sq, 32);
        const float mean = sum * (1.f / 1024.f); const float rstd = 1.f / sqrtf(fmaxf(sq * (1.f / 1024.f) - mean * mean, 0.f) + LN_EPS);
        f32x4 acc[2] = {(f32x4){0.f, 0.f, 0.f, 0.f}, (f32x4){0.f, 0.f, 0.f, 0.f}};
        unsigned char* h2row = h2 + (size_t)t * 1024 + 8 * kq;
        if (kq == 0) WSP(f32x2, WS_STAT)[t] = (f32x2){mean, rstd};
        const LAS bf16* wHr = wH + m * WR_LD + 8 * kq; const LAS bf16* wLr = wL + m * WR_LD + 8 * kq;
        LAS float* par = (LAS float*)sel;
        u32x4 rw[8];
#pragma unroll
        for (int j = 0; j < 8; ++j) rw[j] = *(const u32x4*)(vrow + 32 * j);
        for (int half = 0; half < 2; ++half) {
            __syncthreads();
            { const int vec = F.tid >> 7, ci = (F.tid & 127) * 4 + 512 * half;
              const float* src = vec == 0 ? F.in[24] : (vec == 1 ? F.in[25] : (vec == 2 ? mod + b * 6144 + 3072 : mod + b * 6144 + 4096));
              f32x4 pv = *(const f32x4*)(src + ci); if (vec == 3) pv = pv + 1.0f;
              *(LAS f32x4*)(par + vec * 512 + (F.tid & 127) * 4) = pv; }
            __syncthreads();
#pragma unroll
            for (int s8 = 0; s8 < 16; s8 += 8) {
#pragma unroll
                for (int j = 0; j < 8; ++j) { const int sl = s8 + j, s_ = 16 * half + sl, ko = 32 * s_;
                    f32x4 a, c; unpack8(rw[j], a, c);
                    { const int sn = s_ + 8 < 32 ? s_ + 8 : s_; rw[j] = *(const u32x4*)(vrow + 32 * sn); }
                    const LAS float* pp = par + 32 * sl + 8 * kq;
                    const f32x4 g0 = *(const LAS f32x4*)(pp), g1 = *(const LAS f32x4*)(pp + 4), b0 = *(const LAS f32x4*)(pp + 512), b1 = *(const LAS f32x4*)(pp + 516);
                    const f32x4 sh0 = *(const LAS f32x4*)(pp + 1024), sh1 = *(const LAS f32x4*)(pp + 1028), sc0 = *(const LAS f32x4*)(pp + 1536), sc1 = *(const LAS f32x4*)(pp + 1540);
                    const f32x4 x0 = (a - mean) * rstd * g0 + b0, x1v = (c - mean) * rstd * g1 + b1;
                    const f32x4 h0 = x0 * sc0 + sh0, h1 = x1v * sc1 + sh1;
                    u32x2 w8; w8.x = pk4_fp8(h0[0], h0[1], h0[2], h0[3]); w8.y = pk4_fp8(h1[0], h1[1], h1[2], h1[3]); *(u32x2*)(h2row + ko) = w8;
                    const u32x4 hi = pack8(h0, h1); f32x4 r0, r1; unpack8(hi, r0, r1); const u32x4 lo = pack8(h0 - r0, h1 - r1);
                    const bf16x8 ah = __builtin_bit_cast(bf16x8, hi), al = __builtin_bit_cast(bf16x8, lo);
#pragma unroll
                    for (int nf = 0; nf < 2; ++nf) { const bf16x8 bh = *(const LAS bf16x8*)(wHr + nf * 16 * WR_LD + ko), bl = *(const LAS bf16x8*)(wLr + nf * 16 * WR_LD + ko);
                        acc[nf] = __builtin_amdgcn_mfma_f32_16x16x32_bf16(bh, ah, acc[nf], 0, 0, 0);
                        acc[nf] = __builtin_amdgcn_mfma_f32_16x16x32_bf16(bl, ah, acc[nf], 0, 0, 0);
                        acc[nf] = __builtin_amdgcn_mfma_f32_16x16x32_bf16(bh, al, acc[nf], 0, 0, 0); } } }
        }
        __syncthreads();
        float lv[8];
#pragma unroll
        for (int nf = 0; nf < 2; ++nf)
#pragma unroll
            for (int j = 0; j < 4; ++j) lv[nf * 4 + j] = acc[nf][j] + F.in[27][nf * 16 + 4 * kq + j];
        int rank[8];
#pragma unroll
        for (int i = 0; i < 8; ++i) { rank[i] = 0;
#pragma unroll
            for (int i2 = 0; i2 < 8; ++i2) if (i2 != i) { const int e1 = (i >> 2) * 16 + 4 * kq + (i & 3), e2 = (i2 >> 2) * 16 + 4 * kq + (i2 & 3); rank[i] += (lv[i2] > lv[i] || (lv[i2] == lv[i] && e2 < e1)) ? 1 : 0; } }
#pragma unroll
        for (int dq = 1; dq < 4; ++dq) { const int q2 = kq ^ dq;
#pragma unroll
            for (int i2 = 0; i2 < 8; ++i2) { const float o = __shfl_xor(lv[i2], 16 * dq); const int e2 = (i2 >> 2) * 16 + 4 * q2 + (i2 & 3);
#pragma unroll
                for (int i = 0; i < 8; ++i) { const int e1 = (i >> 2) * 16 + 4 * kq + (i & 3); rank[i] += (o > lv[i] || (o == lv[i] && e2 < e1)) ? 1 : 0; } } }
#pragma unroll
        for (int i = 0; i < 8; ++i) if (rank[i] < 4) { const int e1 = (i >> 2) * 16 + 4 * kq + (i & 3); sel[(w * 16 + m) * 4 + rank[i]] = (f32x2){__builtin_bit_cast(float, e1), lv[i]}; }
        asm volatile("s_waitcnt lgkmcnt(0)" ::: "memory");
        { const int tm = lane >> 2, k = lane & 3; const f32x2 s0 = sel[(w * 16 + tm) * 4 + 0], s1 = sel[(w * 16 + tm) * 4 + 1], s2 = sel[(w * 16 + tm) * 4 + 2], s3 = sel[(w * 16 + tm) * 4 + 3];
          const float p0 = 1.f, p1 = __expf(s1.y - s0.y), p2 = __expf(s2.y - s0.y), p3 = __expf(s3.y - s0.y), ps = (p0 + p1) + (p2 + p3);
          const f32x2 mine = k == 0 ? s0 : (k == 1 ? s1 : (k == 2 ? s2 : s3)); const float pm = (k == 0 ? p0 : (k == 1 ? p1 : (k == 2 ? p2 : p3))) / ps;
          const int e = __builtin_bit_cast(int, mine.x);
          const int lr = __hip_atomic_fetch_add(lcnt + e, 1, __ATOMIC_RELAXED, __HIP_MEMORY_SCOPE_WORKGROUP);
          rec[(w * 16 + tm) * 4 + k] = ((unsigned)e << 16) | (unsigned)lr; recp[(w * 16 + tm) * 4 + k] = pm; }
        __syncthreads();
        if (F.tid < 32) { const int n = lcnt[F.tid]; gbase[F.tid] = n ? (int)atomicAdd(F.ctl + CW_CNT + 64 * F.tid, (unsigned)n) : 0; lcnt[F.tid] = 0; }
        __syncthreads();
        { const unsigned r = rec[F.tid]; const int e = r >> 16, rk = gbase[e] + (int)(r & 0xffffu), tt = blk * 128 + (F.tid >> 2);
          WSP(int, WS_TOK)[(size_t)e * T + rk] = tt; WSP(unsigned, WS_POS)[(size_t)tt * 4 + (F.tid & 3)] = ((unsigned)e << 20) | (unsigned)rk; WSP(float, WS_PROB)[(size_t)tt * 4 + (F.tid & 3)] = recp[F.tid]; }
        __syncthreads();
    }
}
__device__ __forceinline__ void p12_final(Frame& F, bool have_tables) {
    if (!have_tables) moe_tables(F);
    const LAS int* tstart = (const LAS int*)(F.lds + TAB_OFF);
    const float* mod = WSP(float, WS_MOD); const bf16* x1 = WSP(bf16, WS_V1); const f32x2* stat = WSP(f32x2, WS_STAT); const bf16* yb = WSP(bf16, WS_YB); const unsigned* pos = WSP(unsigned, WS_POS); const float* prob = WSP(float, WS_PROB);
    const int lane = F.lane, gw = F.vcu * 8 + F.wave, NGW = F.G * 8;
    f32x4 lg[4], lb[4];
#pragma unroll
    for (int j = 0; j < 4; ++j) { lg[j] = *(const f32x4*)(F.in[32] + 512 * (j >> 1) + 8 * lane + 4 * (j & 1)); lb[j] = *(const f32x4*)(F.in[33] + 512 * (j >> 1) + 8 * lane + 4 * (j & 1)); }
    f32x4 l1g[4], l1b[4];
#pragma unroll
    for (int j = 0; j < 4; ++j) { l1g[j] = *(const f32x4*)(F.in[24] + 512 * (j >> 1) + 8 * lane + 4 * (j & 1)); l1b[j] = *(const f32x4*)(F.in[25] + 512 * (j >> 1) + 8 * lane + 4 * (j & 1)); }
#define P12_ROUTE(PP, PW, tt) do { const u32x4 p4_ = *(const u32x4*)(pos + (size_t)(tt) * 4); const f32x4 w4_ = *(const f32x4*)(prob + (size_t)(tt) * 4); \
        PP[0] = p4_.x; PP[1] = p4_.y; PP[2] = p4_.z; PP[3] = p4_.w; PW[0] = w4_[0]; PW[1] = w4_[1]; PW[2] = w4_[2]; PW[3] = w4_[3]; } while (0)
#define P12_ROWS(YW, XW, ST, PP, tt) do { ST = stat[(tt)]; _Pragma("unroll") for (int k = 0; k < 4; ++k) { const int e_ = PP[k] >> 20, rk_ = PP[k] & 0xfffffu; const size_t slot_ = (size_t)tstart[e_] * 256 + rk_; \
            _Pragma("unroll") for (int j = 0; j < 2; ++j) YW[k][j] = *((const u32x2*)((const unsigned char*)yb + slot_ * 1024) + 64 * j + lane); } \
        _Pragma("unroll") for (int j = 0; j < 2; ++j) XW[j] = *((const u32x4*)(x1 + (size_t)(tt) * 1024) + 64 * j + lane); } while (0)
#define P12_COMPUTE(YW, XW, ST, PW, tt) do { const int b_ = (tt) >> 12; f32x4 v[4]; float s_ = 0.f; const float rs1_ = ST.y, mr1_ = ST.x * ST.y; \
        _Pragma("unroll") for (int j = 0; j < 2; ++j) { f32x4 f0 = (f32x4){0.f, 0.f, 0.f, 0.f}, f1 = f0; \
            _Pragma("unroll") for (int k = 0; k < 4; ++k) { const u32x2 yv_ = YW[k][j]; const f32x2 q0_ = __builtin_amdgcn_cvt_pk_f32_fp8((int)yv_.x, false), q1_ = __builtin_amdgcn_cvt_pk_f32_fp8((int)yv_.x, true), q2_ = __builtin_amdgcn_cvt_pk_f32_fp8((int)yv_.y, false), q3_ = __builtin_amdgcn_cvt_pk_f32_fp8((int)yv_.y, true); \
                f0 += (f32x4){q0_.x, q0_.y, q1_.x, q1_.y} * PW[k]; f1 += (f32x4){q2_.x, q2_.y, q3_.x, q3_.y} * PW[k]; } \
            f32x4 xa_, xc_; unpack8(XW[j], xa_, xc_); xa_ = (xa_ * rs1_ - mr1_) * l1g[2 * j] + l1b[2 * j]; xc_ = (xc_ * rs1_ - mr1_) * l1g[2 * j + 1] + l1b[2 * j + 1]; const float* gp_ = mod + b_ * 6144 + 5120 + 512 * j + 8 * lane; \
            v[2 * j] = xa_ * DN_ALPHA + (*(const f32x4*)gp_ + 1.0f) * f0; v[2 * j + 1] = xc_ * DN_ALPHA + (*(const f32x4*)(gp_ + 4) + 1.0f) * f1; \
            s_ += ((v[2 * j][0] + v[2 * j][1]) + (v[2 * j][2] + v[2 * j][3])) + ((v[2 * j + 1][0] + v[2 * j + 1][1]) + (v[2 * j + 1][2] + v[2 * j + 1][3])); } \
        const float mean_ = wave_sum(s_) * (1.f / 1024.f); float s2_ = 0.f; \
        _Pragma("unroll") for (int j = 0; j < 4; ++j) { v[j] = v[j] - mean_; s2_ += (v[j][0] * v[j][0] + v[j][1] * v[j][1]) + (v[j][2] * v[j][2] + v[j][3] * v[j][3]); } \
        const float rstd_ = 1.f / sqrtf(wave_sum(s2_) * (1.f / 1024.f) + LN_EPS); \
        _Pragma("unroll") for (int j = 0; j < 4; ++j) *(f32x4*)(F.out + (size_t)(tt) * 1024 + 512 * (j >> 1) + 8 * lane + 4 * (j & 1)) = v[j] * rstd_ * lg[j] + lb[j]; } while (0)
    const int nmine = (T - gw + NGW - 1) / NGW;
    unsigned ppA[4], ppB[4]; float pwA[4], pwB[4], pwN[4]; u32x2 ywA[4][2], ywB[4][2]; u32x4 xwA[2], xwB[2]; f32x2 stA, stB;
    if (nmine > 0) { P12_ROUTE(ppA, pwA, gw); P12_ROWS(ywA, xwA, stA, ppA, gw); }
    if (nmine > 1) { P12_ROUTE(ppB, pwB, gw + NGW); }
    for (int i = 0; i < nmine; i += 2) {
        const int t0 = gw + i * NGW, t1 = t0 + NGW, t2 = t1 + NGW, t3 = t2 + NGW;
        if (i + 1 < nmine) { P12_ROWS(ywB, xwB, stB, ppB, t1); }
        if (i + 2 < nmine) { P12_ROUTE(ppA, pwN, t2); }
        __builtin_amdgcn_sched_barrier(0);
        P12_COMPUTE(ywA, xwA, stA, pwA, t0);
        if (i + 1 < nmine) {
#pragma unroll
            for (int k = 0; k < 4; ++k) pwA[k] = pwN[k];
            if (i + 2 < nmine) { P12_ROWS(ywA, xwA, stA, ppA, t2); }
            if (i + 3 < nmine) { P12_ROUTE(ppB, pwN, t3); }
            __builtin_amdgcn_sched_barrier(0);
            P12_COMPUTE(ywB, xwB, stB, pwB, t1);
#pragma unroll
            for (int k = 0; k < 4; ++k) pwB[k] = pwN[k];
        }
    }
#undef P12_ROUTE
#undef P12_ROWS
#undef P12_COMPUTE
}

__device__ __forceinline__ void wg_publish(Frame& F, int word) {
    asm volatile("s_waitcnt vmcnt(0)" ::: "memory"); __syncthreads();
    if (F.tid == 0) { __builtin_amdgcn_fence(__ATOMIC_RELEASE, "agent"); asm volatile("s_waitcnt vmcnt(0)" ::: "memory"); __hip_atomic_fetch_add(F.ctl + word, 1u, __ATOMIC_RELAXED, __HIP_MEMORY_SCOPE_AGENT); }
}
__device__ __forceinline__ void wg_wait(Frame& F, int word, unsigned need) {
    if (F.tid < 64) { unsigned sp_ = 0;
        while ((unsigned)__builtin_amdgcn_readfirstlane(__hip_atomic_load(F.ctl + word, __ATOMIC_RELAXED, __HIP_MEMORY_SCOPE_AGENT)) < need) { __builtin_amdgcn_s_sleep(2);
            if (++sp_ > (1u << 20)) { if (F.tid == 0) atomicAdd(F.ctl + CW_BAR + XB_TMO, 1u); break; } }
        __builtin_amdgcn_fence(__ATOMIC_ACQUIRE, "agent"); asm volatile("s_waitcnt vmcnt(0)" ::: "memory"); }
    __syncthreads();
}
struct Args { const float* in[34]; float* out; unsigned char* ws; int ph_lo, ph_hi; };
__global__ void __launch_bounds__(512, 2) fwd_kernel(Args args) {
    extern __shared__ __attribute__((aligned(16))) unsigned char lds_raw[];
    Frame F;
    F.lds = (LAS unsigned char*)lds_raw; F.MISC = (volatile LAS unsigned*)(F.lds + MISC_OFF);
    F.tid = threadIdx.x; F.lane = F.tid & 63; F.wave = __builtin_amdgcn_readfirstlane(F.tid >> 6);
    F.G = gridDim.x; { const int bx = blockIdx.x; F.vcu = (F.G % 8 == 0) ? (bx % 8) * (F.G / 8) + bx / 8 : bx; }
#pragma unroll
    for (int i = 0; i < 34; ++i) F.in[i] = args.in[i];
    F.out = args.out; F.ws = args.ws; F.ctl = (unsigned*)(args.ws + WS_CTL);
    if (F.tid < 64) F.MISC[F.tid] = 0u;
    __syncthreads();
    XcdBarrier bar; bar.bar = F.ctl + CW_BAR; bar.x = 0; bar.st = nullptr;
    if (MK_N_LAUNCHES == 1) bar = xcd_barrier_post(F.ctl + CW_BAR, F.MISC + 8);
    const int lo = args.ph_lo, hi = args.ph_hi;
#define IN(k) (lo <= (k) && (k) < hi)
#ifndef DUP_UNITS
#define DUP_UNITS -1
#endif
#define SEAM(k) do { if (IN(k) && IN((k) + 1)) xcd_barrier(bar); } while (0)

    if (IN(0)) REPS(0) { if (rep_) xcd_barrier(bar);
        for (int j = F.vcu; j < 192; j += F.G) p0_mod_job(F, j);
        for (int j = F.vcu; j < S5G * 8; j += F.G) p0_s5k_job(F, j);
        { bf16* img = WSP(bf16, WS_WRIMG); const float* wr = F.in[26];
          for (int i = F.vcu * 512 + F.tid; i < 1024 * 32; i += F.G * 512) { const float w = wr[i]; const unsigned hb = f2bf(w); const float hf = __builtin_bit_cast(float, hb << 16);
              img[(i & 31) * 1032 + (i >> 5)] = (bf16)hb; img[32 * 1032 + (i & 31) * 1032 + (i >> 5)] = (bf16)f2bf(w - hf); } }
        p0_small_transposes(F);
    }
    const bool chain01 = false;
    if (chain01) wg_publish(F, CW_P0DONE); else SEAM(0);
    if (IN(1)) REPS(1) { if (rep_) xcd_barrier(bar);
        p1_moe_weights(F);
        if (chain01) wg_wait(F, CW_P0DONE, (unsigned)F.G);
        for (int j = F.vcu; j < S5G * 8; j += F.G) p1_s5w_job(F, j);
        p1_hbf(F); }
    SEAM(1);
    if (IN(2)) REPS(2) { if (rep_) xcd_barrier(bar);
        g8::GridOrder S; S.init(T, INC, F.G, (int)blockIdx.x, WSP(bf16, WS_HBF), WSP(bf16, WS_WIN), 1024, 1024); S.dup = (DUP_UNITS == 2);
        EpiInProj E{F.in[5], WSP(bf16, WS_XRNN), WSP(bf16, WS_GY), WSP(bf16, WS_ACAT), WSP(bf16, WS_GATES), WSP(unsigned char, WS_ACAT8)};
        g8::gemm_phase<EpiInProj, g8::GridOrder, false, true>(F.lds, 1024, 1024, 1024, S, E);
    }
    SEAM(2);
    const bool carry_in_p3 = IN(3) && IN(4) && F.G == 256;
    if (IN(3)) REPS(3) { if (rep_) xcd_barrier(bar);
        { S5AOrder S{F.G, F.vcu, (const char*)WSP(bf16, WS_ACAT), (const char*)WSP(bf16, WS_WS)}; EpiS5A E{WSP(float, WS_S)};
          g8::gemm_phase<EpiS5A, S5AOrder, false, false, true>(F.lds, S5L * 32, S5ROW * 2, S5L * 32, S, E); }
        __syncthreads();
        if (carry_in_p3 && F.vcu < 128) { const int g_ = F.vcu >> 2, pm_ = F.vcu & 3; p4_s5_jobs(F, (2 * pm_) * 32 + g_, 32, (2 * pm_ + 2) * 32); }
        rg_passA(F);
    }
    SEAM(3);
    if (IN(4)) REPS(4) { if (rep_) xcd_barrier(bar); if (!carry_in_p3) p4_s5_jobs(F, F.vcu, F.G, NB * S5G); p4_rg_carry(F); }
    SEAM(4);
    if (IN(5)) REPS(5) { if (rep_) xcd_barrier(bar);
        { S5COrder S{F.G, F.vcu, (const char*)WSP(unsigned char, WS_ACAT8), (const char*)WSP(unsigned char, WS_WY)}; EpiS5C E{WSP(bf16, WS_YS)};
          g8::gemm_phase<EpiS5C, S5COrder, false, true>(F.lds, S5ROW8, S5ROW8, S5ROW8, S, E); }
        if (false) wg_publish(F, CW_S5CDONE);
        __syncthreads();
        rg_passB(F);
    }
    if (false) wg_wait(F, CW_S5CDONE, (unsigned)F.G); else SEAM(5);
    if (IN(6)) REPS(6) { if (rep_) xcd_barrier(bar);
        GluPairOrder S; S.r7.init(T, 1024, F.G, (int)blockIdx.x, WSP(bf16, WS_HA), WSP(bf16, WS_WRNN), 1024, 1024); S.A = (const char*)WSP(bf16, WS_YS); S.B = (const char*)WSP(bf16, WS_WGLU);
        EpiGlu E{WSP(bf16, WS_GATES), WSP(bf16, WS_GB)};
        g8::gemm_phase<EpiGlu, GluPairOrder, false, true>(F.lds, 512, 512, 512, S, E);
    }
    if (IN(6) && IN(7)) { asm volatile("s_waitcnt vmcnt(0)" ::: "memory"); __syncthreads(); }
    if (IN(7)) REPS(7) { if (rep_) xcd_barrier(bar);
        g8::GridOrder S; S.init(T, 1024, F.G, (int)blockIdx.x, WSP(bf16, WS_HA), WSP(bf16, WS_WRNN), 1024, 1024); S.dup = (DUP_UNITS == 7);
        EpiRnn E{WSP(bf16, WS_GATES), WSP(bf16, WS_GB), WSP(bf16, WS_MERGED)};
        g8::gemm_phase<EpiRnn, g8::GridOrder, false, true>(F.lds, 1024, 1024, 1024, S, E);
    }
    SEAM(7);
    if (IN(8)) REPS(8) { if (rep_) xcd_barrier(bar);
        g8::GridOrder S; S.init(T, 1024, F.G, (int)blockIdx.x, WSP(bf16, WS_MERGED), WSP(bf16, WS_WOUT), 1024, 1024); S.dup = (DUP_UNITS == 8);
        EpiOut E{F.in[0], WSP(float, WS_MOD), WSP(bf16, WS_V1)};
        g8::gemm_phase<EpiOut, g8::GridOrder, false, true>(F.lds, 1024, 1024, 1024, S, E);
    }
    SEAM(8);
    if (IN(9)) REPS(9) { if (rep_) xcd_barrier(bar); p9_router(F); }
    SEAM(9);
    if (IN(10)) REPS(10) { if (rep_) xcd_barrier(bar);
        moe_tables(F);
        const LAS int* tstart = (const LAS int*)(F.lds + TAB_OFF);
        MoeOrder S{F.G, (int)blockIdx.x, 8, tstart[NE], tstart, tstart + 40, WSP(int, WS_TOK), (const char*)WSP(bf16, WS_H2), (const char*)WSP(bf16, WS_WGU), (size_t)2048 * 1024, 1024, true, (DUP_UNITS == 10)};
        EpiMoe1 E{F.in[29], WSP(bf16, WS_ACT)};
        g8::gemm_phase<EpiMoe1, MoeOrder, true, true, false, 12>(F.lds, 1024, 1024, 1024, S, E);
    }
    SEAM(10);
    if (IN(11)) REPS(11) { if (rep_) xcd_barrier(bar);
        if (!IN(10)) moe_tables(F);
        const LAS int* tstart = (const LAS int*)(F.lds + TAB_OFF);
        MoeOrder S{F.G, (int)blockIdx.x, 4, tstart[NE], tstart, tstart + 40, WSP(int, WS_TOK), (const char*)WSP(bf16, WS_ACT), (const char*)WSP(bf16, WS_WD), (size_t)1024 * 1024, 1024, false, (DUP_UNITS == 11)};
        EpiMoe2 E{F.in[31], WSP(bf16, WS_YB)};
        g8::gemm_phase<EpiMoe2, MoeOrder, false, true, false, 20>(F.lds, 1024, 1024, 1024, S, E);
    }
    SEAM(11);
    if (IN(12)) REPS(12) { if (rep_) xcd_barrier(bar); p12_final(F, IN(10)); }
#undef IN
#undef SEAM
}

extern "C" void kernel_launch(void* const* d_in, const int* in_sizes, int n_in, void* d_out, int out_size, void* d_ws, size_t ws_size, hipStream_t stream) {
    static int grid = 0;
    if (grid == 0) {
        if (n_in != 34 || in_sizes[0] != T * D || out_size != T * D || ws_size < WS_END) { fprintf(stderr, "kernel_launch: unexpected shapes (n_in %d, ws %zu < %zu)\n", n_in, ws_size, (size_t)WS_END); grid = -1; return; }
        int dev = 0, cus = 0;
        if (hipGetDevice(&dev) != hipSuccess || hipDeviceGetAttribute(&cus, hipDeviceAttributeMultiprocessorCount, dev) != hipSuccess) { grid = -1; return; }
        if (hipFuncSetAttribute((const void*)fwd_kernel, hipFuncAttributeMaxDynamicSharedMemorySize, LDS_BYTES) != hipSuccess) { fprintf(stderr, "kernel_launch: hipFuncSetAttribute failed\n"); grid = -1; return; }
        int per_cu = 0; (void)hipOccupancyMaxActiveBlocksPerMultiprocessor(&per_cu, (const void*)fwd_kernel, 512, LDS_BYTES); (void)hipGetLastError();
        grid = cus;
    }
    if (grid < 0) return;
    (void)hipMemsetAsync((char*)d_ws + WS_CTL, 0, CTL_BYTES, stream);
    Args a{};
    for (int i = 0; i < 34; ++i) a.in[i] = (const float*)d_in[i];
    a.out = (float*)d_out; a.ws = (unsigned char*)d_ws;
    if (MK_N_LAUNCHES == 1) { a.ph_lo = 0; a.ph_hi = N_PHASES; hipLaunchKernelGGL(fwd_kernel, dim3(grid), dim3(512), LDS_BYTES, stream, a); }
    else for (int p = 0; p < N_PHASES; ++p) { a.ph_lo = p; a.ph_hi = p + 1; hipLaunchKernelGGL(fwd_kernel, dim3(grid), dim3(512), LDS_BYTES, stream, a); }
}
```
